# Optimizing an MI355X kernel written in HIP

```python
import jax, jax.numpy as jnp
from jax import lax
import numpy as np

D_MODEL = 2048
BATCH = 1
SEQ = 16384
DEPTH = 4

PLE_DIM = 256
RET_WIDTH = D_MODEL // 2
RET_HEADS = 4
RET_HEAD_DIM = RET_WIDTH // RET_HEADS
RET_CHUNK = 128
RET_ROT_BASE = 10000.0
ATT_HEAD_DIM = 64
ATT_WIDTH = D_MODEL - RET_WIDTH
ATT_HEADS = ATT_WIDTH // ATT_HEAD_DIM
ATT_KV_HEADS = ATT_HEADS // 8
KV_WIDTH = ATT_KV_HEADS * ATT_HEAD_DIM
WINDOW = 128
ROPE_THETA = 10000.0
MIX_WIDTH = RET_WIDTH + ATT_WIDTH
SPLIT_SIZES = [RET_WIDTH, RET_WIDTH, RET_WIDTH, RET_WIDTH, ATT_WIDTH, KV_WIDTH, KV_WIDTH]
IN_WIDTH = sum(SPLIT_SIZES)
SPLIT_POINTS = np.cumsum(SPLIT_SIZES)[:-1].tolist()
D_FF = 5632
CONV_WIDTH = 3
LN_EPS = 1e-5
GN_EPS = 1e-6
DEEPNORM_ALPHA = (2 * DEPTH) ** 0.25
DEEPNORM_BETA = (8 * DEPTH) ** -0.25

kernel_name = "hybrid_retention_swa_sink_deepnorm"

F32 = jnp.float32


def layer_norm(x, g, b):
    xf = x.astype(F32)
    mu = xf.mean(-1, keepdims=True)
    var = jnp.square(xf - mu).mean(-1, keepdims=True)
    y = (xf - mu) * lax.rsqrt(var + LN_EPS) * g.astype(F32) + b.astype(F32)
    return y.astype(x.dtype)


def rotary(x, positions, inv_freq):
    ang = positions.astype(F32)[..., None] * inv_freq
    cos = jnp.cos(ang)[:, :, None, :]
    sin = jnp.sin(ang)[:, :, None, :]
    x1, x2 = jnp.split(x.astype(F32), 2, axis=-1)
    return jnp.concatenate([x1 * cos - x2 * sin, x1 * sin + x2 * cos], axis=-1).astype(x.dtype)


def retention_chunkwise(q, k, v):
    B, S, H, dk = q.shape
    dv = v.shape[-1]
    C = RET_CHUNK
    N = S // C
    log_g = jnp.log1p(-jnp.exp2(-5.0 - jnp.arange(H, dtype=F32)))
    q = q.astype(F32).reshape(B, N, C, H, dk)
    k = k.astype(F32).reshape(B, N, C, H, dk) * (dk ** -0.5)
    v = v.astype(F32).reshape(B, N, C, H, dv)
    idx = jnp.arange(C, dtype=F32)
    diff = idx[:, None] - idx[None, :]
    decay = jnp.where(diff[None] >= 0, jnp.exp(log_g[:, None, None] * jnp.maximum(diff, 0.0)[None]), 0.0)
    scores = jnp.einsum('bnihd,bnjhd->bnhij', q, k) * decay
    inner = jnp.einsum('bnhij,bnjhe->bnihe', scores, v)
    q_decay = jnp.exp(log_g[None, :] * (idx[:, None] + 1.0))
    k_decay = jnp.exp(log_g[None, :] * (C - 1.0 - idx[:, None]))
    chunk_decay = jnp.exp(log_g * C)

    def step(state, inp):
        qc, kc, vc = inp
        cross = jnp.einsum('bihd,bhde->bihe', qc, state) * q_decay[None, :, :, None]
        state = state * chunk_decay[None, :, None, None] + jnp.einsum(
            'bjhd,bjhe->bhde', kc * k_decay[None, :, :, None], vc)
        return state, cross

    init = jnp.zeros((B, H, dk, dv), F32)
    _, cross = lax.scan(step, init, (jnp.moveaxis(q, 1, 0), jnp.moveaxis(k, 1, 0), jnp.moveaxis(v, 1, 0)))
    cross = jnp.moveaxis(cross, 0, 1)
    return (inner + cross).reshape(B, S, H, dv)


def head_group_norm(y, g, b):
    mu = y.mean(-1, keepdims=True)
    var = jnp.square(y - mu).mean(-1, keepdims=True)
    y = (y - mu) * lax.rsqrt(var + GN_EPS)
    B, S, H, dv = y.shape
    return y.reshape(B, S, H * dv) * g.astype(F32) + b.astype(F32)


def sliding_window_attention_sinks(q, k, v, sinks):
    B, S, Hq, d = q.shape
    Hkv = k.shape[2]
    G = Hq // Hkv
    W = WINDOW
    N = S // W
    qb = q.astype(F32).reshape(B, N, W, Hkv, G, d)

    def band(t):
        t = t.astype(F32)
        prev = jnp.pad(t, ((0, 0), (W, 0), (0, 0), (0, 0)))[:, :S].reshape(B, N, W, Hkv, d)
        return jnp.concatenate([prev, t.reshape(B, N, W, Hkv, d)], axis=2)

    kb = band(k)
    vb = band(v)
    blk = jnp.arange(N)[:, None, None]
    qi = jnp.arange(W)[None, :, None]
    kj = jnp.arange(2 * W)[None, None, :]
    delta = qi + W - kj
    mask = (delta >= 0) & (delta < W) & (blk * W - W + kj >= 0)
    s = jnp.einsum('bnihgd,bnjhd->bnhgij', qb, kb) * (d ** -0.5)
    s = jnp.where(mask[None, :, None, None], s, -jnp.inf)
    sink = sinks.astype(F32).reshape(Hkv, G)[None, None, :, :, None, None]
    m = jnp.maximum(s.max(-1, keepdims=True), sink)
    pr = jnp.exp(s - m)
    pr = pr / (pr.sum(-1, keepdims=True) + jnp.exp(sink - m))
    o = jnp.einsum('bnhgij,bnjhd->bnihgd', pr, vb)
    return o.reshape(B, S, Hq * d)


def causal_depthwise_conv(h, w, b):
    S = h.shape[1]
    hp = jnp.pad(h, ((0, 0), (CONV_WIDTH - 1, 0), (0, 0)))
    out = b
    for kk in range(CONV_WIDTH):
        out = out + hp[:, kk:kk + S] * w[kk]
    return out


def setup_inputs(seed: int = 0) -> dict:
    key = jax.random.key(seed)
    ks = jax.random.split(key, 20)
    nrm = jax.random.normal
    beta = DEEPNORM_BETA
    x = nrm(ks[0], (BATCH, SEQ, D_MODEL), F32)
    p = nrm(ks[1], (DEPTH, BATCH, SEQ, PLE_DIM), F32)
    positions = jnp.broadcast_to(jnp.arange(SEQ, dtype=jnp.int32)[None, :], (BATCH, SEQ))
    col_scale = jnp.concatenate([
        jnp.ones((2 * RET_WIDTH,), F32), jnp.full((RET_WIDTH,), beta, F32), jnp.ones((RET_WIDTH,), F32),
        jnp.ones((ATT_WIDTH + KV_WIDTH,), F32), jnp.full((KV_WIDTH,), beta, F32)])
    w_in = nrm(ks[2], (DEPTH, D_MODEL, IN_WIDTH), F32) * (D_MODEL ** -0.5) * col_scale
    w_out = nrm(ks[3], (DEPTH, MIX_WIDTH, D_MODEL), F32) * (MIX_WIDTH ** -0.5) * beta
    ret_norm_g = 1.0 + 0.02 * nrm(ks[4], (DEPTH, RET_WIDTH), F32)
    ret_norm_b = 0.02 * nrm(ks[5], (DEPTH, RET_WIDTH), F32)
    attn_sinks = nrm(ks[6], (DEPTH, ATT_HEADS), F32)
    ln1_g = 1.0 + 0.02 * nrm(ks[7], (DEPTH, D_MODEL), F32)
    ln1_b = 0.02 * nrm(ks[8], (DEPTH, D_MODEL), F32)
    w_ffn_up = nrm(ks[9], (DEPTH, D_MODEL, 2 * D_FF), F32) * (D_MODEL ** -0.5) * beta
    ffn_conv_w = nrm(ks[10], (DEPTH, CONV_WIDTH, 2 * D_FF), F32) * (CONV_WIDTH ** -0.5)
    ffn_conv_b = 0.02 * nrm(ks[11], (DEPTH, 2 * D_FF), F32)
    w_ffn_down = nrm(ks[12], (DEPTH, D_FF, D_MODEL), F32) * (D_FF ** -0.5) * beta
    ln2_g = 1.0 + 0.02 * nrm(ks[13], (DEPTH, D_MODEL), F32)
    ln2_b = 0.02 * nrm(ks[14], (DEPTH, D_MODEL), F32)
    w_ple_gate = nrm(ks[15], (DEPTH, D_MODEL, D_MODEL), F32) * (D_MODEL ** -0.5)
    b_ple_gate = 0.01 * nrm(ks[16], (DEPTH, D_MODEL), F32)
    w_ple_proj = nrm(ks[17], (DEPTH, PLE_DIM, D_MODEL), F32) * (PLE_DIM ** -0.5) * beta
    return {"x": x, "p": p, "positions": positions, "w_in": w_in, "w_out": w_out,
            "ret_norm_g": ret_norm_g, "ret_norm_b": ret_norm_b, "attn_sinks": attn_sinks,
            "ln1_g": ln1_g, "ln1_b": ln1_b, "w_ffn_up": w_ffn_up, "ffn_conv_w": ffn_conv_w,
            "ffn_conv_b": ffn_conv_b, "w_ffn_down": w_ffn_down, "ln2_g": ln2_g, "ln2_b": ln2_b,
            "w_ple_gate": w_ple_gate, "b_ple_gate": b_ple_gate, "w_ple_proj": w_ple_proj}


def reference(x, p, positions, w_in, w_out, ret_norm_g, ret_norm_b, attn_sinks, ln1_g, ln1_b,
              w_ffn_up, ffn_conv_w, ffn_conv_b, w_ffn_down, ln2_g, ln2_b, w_ple_gate, b_ple_gate,
              w_ple_proj):
    B, S, _ = x.shape
    ret_inv_freq = 1.0 / (RET_ROT_BASE ** jnp.linspace(0.0, 1.0, RET_HEAD_DIM // 2, dtype=F32))
    att_inv_freq = ROPE_THETA ** (-jnp.arange(0, ATT_HEAD_DIM, 2, dtype=F32) / ATT_HEAD_DIM)
    for i in range(DEPTH):
        proj = x @ w_in[i]
        rq, rk, rv, rg, aq, ak, av = jnp.split(proj, SPLIT_POINTS, axis=-1)
        rq = rotary(rq.reshape(B, S, RET_HEADS, RET_HEAD_DIM), positions, ret_inv_freq)
        rk = rotary(rk.reshape(B, S, RET_HEADS, RET_HEAD_DIM), positions, ret_inv_freq)
        ret = retention_chunkwise(rq, rk, rv.reshape(B, S, RET_HEADS, RET_HEAD_DIM))
        ret = jax.nn.silu(rg.astype(F32)) * head_group_norm(ret, ret_norm_g[i], ret_norm_b[i])
        aq = rotary(aq.reshape(B, S, ATT_HEADS, ATT_HEAD_DIM), positions, att_inv_freq)
        ak = rotary(ak.reshape(B, S, ATT_KV_HEADS, ATT_HEAD_DIM), positions, att_inv_freq)
        att = sliding_window_attention_sinks(aq, ak, av.reshape(B, S, ATT_KV_HEADS, ATT_HEAD_DIM),
                                             attn_sinks[i])
        mix = jnp.concatenate([ret, att], axis=-1).astype(x.dtype) @ w_out[i]
        x = layer_norm(DEEPNORM_ALPHA * x + mix, ln1_g[i], ln1_b[i])
        h = causal_depthwise_conv(x @ w_ffn_up[i], ffn_conv_w[i], ffn_conv_b[i])
        gate, up = jnp.split(h, 2, axis=-1)
        ffn = (jax.nn.silu(gate) * up) @ w_ffn_down[i]
        ple = (p[i] @ w_ple_proj[i]) * jax.nn.sigmoid(x @ w_ple_gate[i] + b_ple_gate[i])
        x = layer_norm(DEEPNORM_ALPHA * x + ffn + ple, ln2_g[i], ln2_b[i])
    return x
```

```cpp
#include <hip/hip_runtime.h>
#include <cstdio>
#include <cstdint>
#include <cmath>
#define MK_ONE_LAUNCH 0
namespace pg8 {
#define PG8_LAS __attribute__((address_space(3)))
typedef unsigned short bf16_t;
typedef short bf16x8 __attribute__((ext_vector_type(8)));
typedef float f32x4 __attribute__((ext_vector_type(4)));
typedef unsigned u32x4 __attribute__((ext_vector_type(4)));
constexpr int BM = 256, BK = 64, HALF = 128, HTB = HALF * BK * 2  , STAGE_BYTES = 8 * HTB, NXCD = 8, WGM = 8;

__host__ __device__ __forceinline__ int lds_byte(int r, int c) { const int st = (r >> 4) * 2 + (c >> 5), rr = r & 15, cc = c & 31, ob = rr * 64 + cc * 2; return st * 1024 + (ob ^ (((ob >> 9) & 1) << 5)); }
__host__ __device__ __forceinline__ void stage_rc(int b, int& R, int& C) { const int st = b / 1024, sb = b % 1024, swz = sb ^ (((sb >> 9) & 1) << 5); R = (st >> 1) * 16 + swz / 64; C = (st & 1) * 32 + (swz % 64) / 2; }
__host__ __device__ __forceinline__ int perm32(int rho) { const int n = rho >> 4, i = rho & 15; return 8 * (i >> 2) + 4 * n + (i & 3); }

struct Unit { int pm, pn; };
struct Gemm { const bf16_t* A; const bf16_t* Bt; int M, N, K; };

struct StaticOrder {
    int nM, nN, nwg, G, c;
    __host__ __device__ void init(int M, int N, int G_, int c_) { nM = M / BM; nN = N / BM; nwg = nM * nN; G = G_; c = c_; }
    __host__ __device__ bool next(int i, Unit& u) const {
        const long L = (long)i * G + c; if (L >= nwg) return false;
        int wgid = (int)L; { const int q = nwg / NXCD, r = nwg % NXCD, xcd = wgid % NXCD, off = wgid / NXCD; wgid = (xcd < r ? xcd * (q + 1) : r * (q + 1) + (xcd - r) * q) + off; }
        const int nig = WGM * nN, gid = wgid / nig, fm = gid * WGM, gsz = (nM - fm) < WGM ? (nM - fm) : WGM;
        u.pm = fm + ((wgid % nig) % gsz); u.pn = (wgid % nig) / gsz; return true;
    }
    __device__ __forceinline__ void a_ready(const Unit&) const {}
    __device__ __forceinline__ void done(const Unit&) const {}
};

typedef float f32x2c_t __attribute__((ext_vector_type(2))); typedef __bf16 bf16x2c_t __attribute__((ext_vector_type(2)));
__device__ __forceinline__ unsigned cvt_pk_bf16(float lo, float hi) { f32x2c_t v = {lo, hi}; bf16x2c_t b = __builtin_convertvector(v, bf16x2c_t); return __builtin_bit_cast(unsigned, b); }
typedef float f32x2 __attribute__((ext_vector_type(2)));
typedef unsigned u32x2 __attribute__((ext_vector_type(2)));
__device__ __forceinline__ float bf2f(unsigned short b) { return __uint_as_float(((unsigned)b) << 16); }
__device__ __forceinline__ u32x4 pack8(const f32x4 a, const f32x4 b) { u32x4 w; w.x = cvt_pk_bf16(a[0], a[1]); w.y = cvt_pk_bf16(a[2], a[3]); w.z = cvt_pk_bf16(b[0], b[1]); w.w = cvt_pk_bf16(b[2], b[3]); return w; }
__device__ __forceinline__ float sigmoidf_(float x) { return __builtin_amdgcn_rcpf(1.0f + __expf(-x)); }

struct EpiInProj {
    static constexpr bool PERM = true, AFTER_DRAIN = false;
    bf16_t *Q, *K, *V, *G, *AQ, *AK, *AV; const float *cosr, *sinr, *cosa, *sina;
    __device__ __forceinline__ void operator()(const f32x4 (&acc)[2][2][4][2], const Unit& u, int wr, int wc, int fr, int fq) const {
        const int row0 = u.pm * BM + wr * 64 + fr, pn = u.pn, cw = wc * 32 + 8 * fq;
        if (pn < 8) {
            bf16_t* O = pn < 4 ? Q : K; const int hcol = (pn & 3) * 256; const float sc = pn < 4 ? 1.0f : 0.0625f;
#pragma unroll
            for (int ai = 0; ai < 2; ++ai)
#pragma unroll
                for (int m = 0; m < 4; ++m) { const int row = row0 + ai * HALF + m * 16;
                    const f32x4 c0 = *(const f32x4*)(cosr + (size_t)row * 128 + cw), c1 = *(const f32x4*)(cosr + (size_t)row * 128 + cw + 4);
                    const f32x4 s0 = *(const f32x4*)(sinr + (size_t)row * 128 + cw), s1 = *(const f32x4*)(sinr + (size_t)row * 128 + cw + 4);
                    const f32x4 a0 = acc[ai][0][m][0], a1 = acc[ai][0][m][1], b0 = acc[ai][1][m][0], b1 = acc[ai][1][m][1];
                    const f32x4 o10 = (a0 * c0 - b0 * s0) * sc, o11 = (a1 * c1 - b1 * s1) * sc, o20 = (a0 * s0 + b0 * c0) * sc, o21 = (a1 * s1 + b1 * c1) * sc;
                    bf16_t* rowp = O + (size_t)row * 1024 + hcol + cw;
                    *(u32x4*)(rowp) = pack8(o10, o11); *(u32x4*)(rowp + HALF) = pack8(o20, o21); }
        } else if (pn < 16) {
            const bool gate = pn >= 12; bf16_t* O = gate ? G : V; const int hcol = (pn & 3) * 256;
#pragma unroll
            for (int ai = 0; ai < 2; ++ai)
#pragma unroll
                for (int m = 0; m < 4; ++m) { const int row = row0 + ai * HALF + m * 16; bf16_t* rowp = O + (size_t)row * 1024 + hcol + cw;
#pragma unroll
                    for (int bj = 0; bj < 2; ++bj) { f32x4 v0 = acc[ai][bj][m][0], v1 = acc[ai][bj][m][1];
                        if (gate) {
#pragma unroll
                            for (int j = 0; j < 4; ++j) { v0[j] = v0[j] * sigmoidf_(v0[j]); v1[j] = v1[j] * sigmoidf_(v1[j]); } }
                        *(u32x4*)(rowp + bj * HALF) = pack8(v0, v1); } }
        } else if (pn < 20) {
            const int t = pn - 16, i0 = 8 * fq;
#pragma unroll
            for (int ai = 0; ai < 2; ++ai)
#pragma unroll
                for (int m = 0; m < 4; ++m) { const int row = row0 + ai * HALF + m * 16;
                    const f32x4 c0 = *(const f32x4*)(cosa + (size_t)row * 32 + i0), c1 = *(const f32x4*)(cosa + (size_t)row * 32 + i0 + 4);
                    const f32x4 s0 = *(const f32x4*)(sina + (size_t)row * 32 + i0), s1 = *(const f32x4*)(sina + (size_t)row * 32 + i0 + 4);
                    const f32x4 a0 = acc[ai][0][m][0], a1 = acc[ai][0][m][1], b0 = acc[ai][1][m][0], b1 = acc[ai][1][m][1];
                    const f32x4 o10 = (a0 * c0 - b0 * s0) * 0.125f, o11 = (a1 * c1 - b1 * s1) * 0.125f, o20 = (a0 * s0 + b0 * c0) * 0.125f, o21 = (a1 * s1 + b1 * c1) * 0.125f;
                    bf16_t* rowp = AQ + (size_t)row * 1024 + t * 256 + wc * 64 + i0;
                    *(u32x4*)(rowp) = pack8(o10, o11); *(u32x4*)(rowp + 32) = pack8(o20, o21); }
        } else {
            const int i0 = 8 * fq;
            if (wc < 2) {
#pragma unroll
                for (int ai = 0; ai < 2; ++ai)
#pragma unroll
                    for (int m = 0; m < 4; ++m) { const int row = row0 + ai * HALF + m * 16;
                        const f32x4 c0 = *(const f32x4*)(cosa + (size_t)row * 32 + i0), c1 = *(const f32x4*)(cosa + (size_t)row * 32 + i0 + 4);
                        const f32x4 s0 = *(const f32x4*)(sina + (size_t)row * 32 + i0), s1 = *(const f32x4*)(sina + (size_t)row * 32 + i0 + 4);
                        const f32x4 a0 = acc[ai][0][m][0], a1 = acc[ai][0][m][1], b0 = acc[ai][1][m][0], b1 = acc[ai][1][m][1];
                        const f32x4 o10 = a0 * c0 - b0 * s0, o11 = a1 * c1 - b1 * s1, o20 = a0 * s0 + b0 * c0, o21 = a1 * s1 + b1 * c1;
                        bf16_t* rowp = AK + (size_t)row * 128 + wc * 64 + i0;
                        *(u32x4*)(rowp) = pack8(o10, o11); *(u32x4*)(rowp + 32) = pack8(o20, o21); }
            } else {
#pragma unroll
                for (int ai = 0; ai < 2; ++ai)
#pragma unroll
                    for (int m = 0; m < 4; ++m) { const int row = row0 + ai * HALF + m * 16; bf16_t* rowp = AV + (size_t)row * 128 + (wc - 2) * 32 + i0;
                        *(u32x4*)(rowp) = pack8(acc[ai][0][m][0], acc[ai][0][m][1]); *(u32x4*)(rowp + 64) = pack8(acc[ai][1][m][0], acc[ai][1][m][1]); }
            }
        }
    }
};
template <bool ADD> struct EpiResid {
    static constexpr bool PERM = false, AFTER_DRAIN = false;
    const float* base; float* Y; float alpha;
    __device__ __forceinline__ void operator()(const f32x4 (&acc)[2][2][4][2], const Unit& u, int wr, int wc, int fr, int fq) const {
        const int row0 = u.pm * BM + wr * 64 + fr, col0 = u.pn * BM + wc * 32 + 4 * fq;
#pragma unroll
        for (int ai = 0; ai < 2; ++ai)
#pragma unroll
            for (int m = 0; m < 4; ++m) { const size_t off = (size_t)(row0 + ai * HALF + m * 16) * 2048 + col0;
#pragma unroll
                for (int bj = 0; bj < 2; ++bj)
#pragma unroll
                    for (int n = 0; n < 2; ++n) { const size_t o = off + bj * HALF + n * 16; f32x4 v = acc[ai][bj][m][n] + *(const f32x4*)(base + o) * alpha;
                        if (ADD) v = v + *(const f32x4*)(Y + o); *(f32x4*)(Y + o) = v; } }
    }
};
struct EpiUp {
    static constexpr bool PERM = true, AFTER_DRAIN = false;
    bf16_t* H; bf16_t* SG; const float* bgate;
    __device__ __forceinline__ void operator()(const f32x4 (&acc)[2][2][4][2], const Unit& u, int wr, int wc, int fr, int fq) const {
        const int row0 = u.pm * BM + wr * 64 + fr, cw = wc * 32 + 8 * fq;
        if (u.pn < 44) {
#pragma unroll
            for (int ai = 0; ai < 2; ++ai)
#pragma unroll
                for (int m = 0; m < 4; ++m) { bf16_t* rowp = H + (size_t)(row0 + ai * HALF + m * 16) * 11264 + u.pn * 256 + cw;
#pragma unroll
                    for (int bj = 0; bj < 2; ++bj) *(u32x4*)(rowp + bj * HALF) = pack8(acc[ai][bj][m][0], acc[ai][bj][m][1]); }
        } else {
            const int colg = (u.pn - 44) * 256 + cw;
            f32x4 bv[2][2];
#pragma unroll
            for (int bj = 0; bj < 2; ++bj)
#pragma unroll
                for (int n = 0; n < 2; ++n) bv[bj][n] = *(const f32x4*)(bgate + colg + bj * HALF + 4 * n);
#pragma unroll
            for (int ai = 0; ai < 2; ++ai)
#pragma unroll
                for (int m = 0; m < 4; ++m) { bf16_t* rowp = SG + (size_t)(row0 + ai * HALF + m * 16) * 2048 + colg;
#pragma unroll
                    for (int bj = 0; bj < 2; ++bj) { f32x4 v0 = acc[ai][bj][m][0] + bv[bj][0], v1 = acc[ai][bj][m][1] + bv[bj][1];
#pragma unroll
                        for (int j = 0; j < 4; ++j) { v0[j] = sigmoidf_(v0[j]); v1[j] = sigmoidf_(v1[j]); }
                        *(u32x4*)(rowp + bj * HALF) = pack8(v0, v1); } }
        }
    }
};
struct EpiPle {
    static constexpr bool PERM = false, AFTER_DRAIN = false;
    const bf16_t* SG; float* Y;
    __device__ __forceinline__ void operator()(const f32x4 (&acc)[2][2][4][2], const Unit& u, int wr, int wc, int fr, int fq) const {
        const int row0 = u.pm * BM + wr * 64 + fr, col0 = u.pn * BM + wc * 32 + 4 * fq;
#pragma unroll
        for (int ai = 0; ai < 2; ++ai)
#pragma unroll
            for (int m = 0; m < 4; ++m) { const size_t off = (size_t)(row0 + ai * HALF + m * 16) * 2048 + col0;
#pragma unroll
                for (int bj = 0; bj < 2; ++bj)
#pragma unroll
                    for (int n = 0; n < 2; ++n) { const size_t o = off + bj * HALF + n * 16; const u32x2 sg = *(const u32x2*)(SG + o);
                        f32x4 g; g[0] = __uint_as_float(sg.x << 16); g[1] = __uint_as_float(sg.x & 0xffff0000u); g[2] = __uint_as_float(sg.y << 16); g[3] = __uint_as_float(sg.y & 0xffff0000u);
                        *(f32x4*)(Y + o) = acc[ai][bj][m][n] * g; } }
    }
};
template <class Epi, class Sched, bool ALIGN_EPI = false, bool SP2 = false>
__device__ __forceinline__ void gemm_phase(PG8_LAS unsigned char* lds, const Gemm g, const Sched& S, const Epi& E, const int wid_in) {
    int lane_; asm volatile("v_mbcnt_lo_u32_b32 %0, -1, 0\n\tv_mbcnt_hi_u32_b32 %0, -1, %0" : "=v"(lane_)); const int wid = wid_in, lane = lane_, tid = wid * 64 + lane, wr = wid >> 2, wc = wid & 3, fr = lane & 15, fq = lane >> 4;
    const int K = g.K, nt = K / BK;
    unsigned voffA[2], voffB[2];
#pragma unroll
    for (int i = 0; i < 2; ++i) { int R, C; stage_rc(tid * 16 + i * 8192, R, C); const int Rb = Epi::PERM ? ((R & ~31) + perm32(R & 31)) : R;
        voffA[i] = (unsigned)(R * K + C) * 2u; voffB[i] = (unsigned)(Rb * K + C) * 2u; }
    const size_t kstep = (size_t)(BK * 2);
    const size_t hstep = (size_t)HALF * K * 2;
    const size_t tstep = 2 * hstep;
    const unsigned ldsw = (unsigned)wid * 1024u;
    const int aoff = lds_byte(wr * 64 + fr, fq * 8), boff = lds_byte(wc * 32 + fr, fq * 8);
#define PG8_SA(b, h) (((b) * 2 + (h)) * HTB)
#define PG8_SB(b, h) ((4 + (b) * 2 + (h)) * HTB)
#define PG8_STAGE(bufoff, gbase, voff) do { _Pragma("unroll") for (int _i = 0; _i < 2; ++_i) \
        __builtin_amdgcn_global_load_lds((const unsigned*)((const char*)(gbase) + (voff)[_i]), (PG8_LAS unsigned*)(lds + (bufoff) + ldsw + _i * 8192), 16, 0, 0); } while (0)
#define PG8_LDA(dst, b, h) do { _Pragma("unroll") for (int m = 0; m < 4; ++m) _Pragma("unroll") for (int k = 0; k < 2; ++k) dst[m][k] = *(const PG8_LAS bf16x8*)(lds + PG8_SA(b, h) + aoff + m * 2048 + k * 1024); } while (0)
#define PG8_LDB(dst, b, h) do { _Pragma("unroll") for (int n = 0; n < 2; ++n) _Pragma("unroll") for (int k = 0; k < 2; ++k) dst[n][k] = *(const PG8_LAS bf16x8*)(lds + PG8_SB(b, h) + boff + n * 2048 + k * 1024); } while (0)
#define PG8_MMA(ai, bj, At, Bt) do { __builtin_amdgcn_s_setprio(1); _Pragma("unroll") for (int m = 0; m < 4; ++m) _Pragma("unroll") for (int n = 0; n < 2; ++n) _Pragma("unroll") for (int k = 0; k < 2; ++k) \
        acc[ai][bj][m][n] = __builtin_amdgcn_mfma_f32_16x16x32_bf16(Bt[n][k], At[m][k], acc[ai][bj][m][n], 0, 0, 0); __builtin_amdgcn_s_setprio(0); } while (0)
#define PG8_WAIT_V(n) asm volatile("s_waitcnt vmcnt(" #n ")" ::: "memory")
#define PG8_WAIT_L(n) asm volatile("s_waitcnt lgkmcnt(" #n ")" ::: "memory")
#define PG8_BAR __builtin_amdgcn_s_barrier()
#define PG8_SCHED __builtin_amdgcn_sched_barrier(0)
    Unit cur, nxt; int ui = 0;
    if (!S.next(0, cur)) return;
    f32x4 acc[2][2][4][2];
#pragma unroll
    for (int a = 0; a < 2; ++a)
#pragma unroll
        for (int b = 0; b < 2; ++b)
#pragma unroll
            for (int m = 0; m < 4; ++m)
#pragma unroll
                for (int n = 0; n < 2; ++n) acc[a][b][m][n] = (f32x4){0.f, 0.f, 0.f, 0.f};
    bf16x8 At[4][2], B0[2][2], B1[2][2];
    const char* cA = (const char*)g.A + (size_t)cur.pm * tstep; const char* cB = (const char*)g.Bt + (size_t)cur.pn * tstep;
    S.a_ready(cur);
    if constexpr (SP2) {
        PG8_STAGE(PG8_SB(0, 0), cB, voffB); PG8_STAGE(PG8_SB(0, 1), cB + hstep, voffB); PG8_STAGE(PG8_SA(0, 0), cA, voffA); PG8_STAGE(PG8_SA(0, 1), cA + hstep, voffA);
        if (wr == 1) PG8_BAR;
        PG8_WAIT_V(2); PG8_BAR;
        PG8_STAGE(PG8_SB(1, 0), cB + kstep, voffB); PG8_STAGE(PG8_SA(1, 0), cA + kstep, voffA); PG8_STAGE(PG8_SB(1, 1), cB + hstep + kstep, voffB);
        PG8_WAIT_V(6); PG8_BAR;
    } else {
        PG8_STAGE(PG8_SB(0, 0), cB, voffB); PG8_STAGE(PG8_SA(0, 0), cA, voffA); PG8_STAGE(PG8_SB(0, 1), cB + hstep, voffB); PG8_STAGE(PG8_SA(0, 1), cA + hstep, voffA);
        if (wr == 1) PG8_BAR;
        PG8_WAIT_V(4); PG8_BAR;
        PG8_STAGE(PG8_SB(1, 0), cB + kstep, voffB); PG8_STAGE(PG8_SA(1, 0), cA + kstep, voffA); PG8_STAGE(PG8_SB(1, 1), cB + hstep + kstep, voffB);
        PG8_WAIT_V(6); PG8_BAR;
    }
    for (;;) {
        const bool has_next = S.next(ui + 1, nxt);
        const char* nA = has_next ? (const char*)g.A + (size_t)nxt.pm * tstep : cA; const char* nB = has_next ? (const char*)g.Bt + (size_t)nxt.pn * tstep : cB;
        for (int t = 0; t < nt; t += 2) {
            const bool last = (t == nt - 2);
            const char* a1 = cA + (size_t)(t + 1) * kstep;
            const char* a2 = last ? nA : cA + (size_t)(t + 2) * kstep; const char* b2 = last ? nB : cB + (size_t)(t + 2) * kstep;
            const char* a3 = a2 + kstep; const char* b3 = b2 + kstep;
            if (last && has_next) S.a_ready(nxt);
            if constexpr (SP2) {
            PG8_LDB(B0, 0, 0); PG8_LDB(B1, 0, 1); PG8_SCHED; PG8_LDA(At, 0, 0); PG8_STAGE(PG8_SA(1, 1), a1 + hstep, voffA);
            PG8_WAIT_V(8); PG8_WAIT_L(0); PG8_BAR; PG8_MMA(0, 0, At, B0); PG8_MMA(0, 1, At, B1); PG8_BAR; PG8_SCHED;
            PG8_LDA(At, 0, 1); PG8_STAGE(PG8_SB(0, 0), b2, voffB); PG8_STAGE(PG8_SB(0, 1), b2 + hstep, voffB); PG8_STAGE(PG8_SA(0, 0), a2, voffA);
            PG8_WAIT_V(8); PG8_WAIT_L(0); PG8_BAR; PG8_MMA(1, 0, At, B0); PG8_MMA(1, 1, At, B1); PG8_BAR; PG8_SCHED;
            PG8_LDB(B0, 1, 0); PG8_LDB(B1, 1, 1); PG8_SCHED; PG8_LDA(At, 1, 0); PG8_STAGE(PG8_SA(0, 1), a2 + hstep, voffA);
            PG8_WAIT_V(8); PG8_WAIT_L(0); PG8_BAR; PG8_MMA(0, 0, At, B0); PG8_MMA(0, 1, At, B1); PG8_BAR; PG8_SCHED;
            PG8_LDA(At, 1, 1); PG8_STAGE(PG8_SB(1, 0), b3, voffB); PG8_STAGE(PG8_SB(1, 1), b3 + hstep, voffB); PG8_STAGE(PG8_SA(1, 0), a3, voffA);
            PG8_WAIT_V(8); PG8_WAIT_L(0); PG8_BAR; PG8_MMA(1, 0, At, B0); PG8_MMA(1, 1, At, B1); PG8_BAR; PG8_SCHED;
            } else {
            PG8_LDB(B0, 0, 0); PG8_SCHED; PG8_LDA(At, 0, 0); PG8_STAGE(PG8_SA(1, 1), a1 + hstep, voffA);
            PG8_WAIT_L(8); PG8_BAR; PG8_WAIT_L(0); PG8_MMA(0, 0, At, B0); PG8_BAR; PG8_SCHED;
            PG8_LDB(B1, 0, 1); PG8_STAGE(PG8_SB(0, 0), b2, voffB);
            PG8_BAR; PG8_WAIT_L(0); PG8_MMA(0, 1, At, B1); PG8_BAR;
            PG8_LDA(At, 0, 1); PG8_STAGE(PG8_SA(0, 0), a2, voffA);
            PG8_BAR; PG8_WAIT_L(0); PG8_MMA(1, 0, At, B0); PG8_BAR; PG8_SCHED;
            PG8_STAGE(PG8_SB(0, 1), b2 + hstep, voffB);
            PG8_WAIT_V(6); PG8_BAR; PG8_MMA(1, 1, At, B1); PG8_BAR;
            PG8_LDB(B0, 1, 0); PG8_SCHED; PG8_LDA(At, 1, 0); PG8_STAGE(PG8_SA(0, 1), a2 + hstep, voffA);
            PG8_WAIT_L(8); PG8_BAR; PG8_WAIT_L(0); PG8_MMA(0, 0, At, B0); PG8_BAR; PG8_SCHED;
            PG8_LDB(B1, 1, 1); PG8_STAGE(PG8_SB(1, 0), b3, voffB);
            PG8_BAR; PG8_WAIT_L(0); PG8_MMA(0, 1, At, B1); PG8_BAR;
            PG8_LDA(At, 1, 1); PG8_STAGE(PG8_SA(1, 0), a3, voffA);
            PG8_BAR; PG8_WAIT_L(0); PG8_MMA(1, 0, At, B0); PG8_BAR; PG8_SCHED;
            PG8_STAGE(PG8_SB(1, 1), b3 + hstep, voffB);
            PG8_WAIT_V(6); PG8_BAR; PG8_MMA(1, 1, At, B1); PG8_BAR;
            }
        }
        if constexpr (ALIGN_EPI) { if (wr == 0) PG8_BAR; }
        if constexpr (!Epi::AFTER_DRAIN) { E(acc, cur, wr, wc, fr, fq); S.done(cur); }
        if (!has_next) break;
#pragma unroll
        for (int a = 0; a < 2; ++a)
#pragma unroll
            for (int b = 0; b < 2; ++b)
#pragma unroll
                for (int m = 0; m < 4; ++m)
#pragma unroll
                    for (int n = 0; n < 2; ++n) acc[a][b][m][n] = (f32x4){0.f, 0.f, 0.f, 0.f};
        cur = nxt; cA = nA; cB = nB; ++ui;
        if constexpr (ALIGN_EPI) { if (wr == 1) PG8_BAR; }
    }
    PG8_WAIT_V(0);
    if constexpr (!ALIGN_EPI) { if (wr == 0) PG8_BAR; }
    PG8_BAR;
    if constexpr (Epi::AFTER_DRAIN) { E.fused(acc, cur, wr, wc, fr, fq, lds, wid, lane); S.done(cur); }
#undef PG8_SA
#undef PG8_SB
#undef PG8_STAGE
#undef PG8_LDA
#undef PG8_LDB
#undef PG8_MMA
#undef PG8_WAIT_V
#undef PG8_WAIT_L
#undef PG8_BAR
#undef PG8_SCHED
}
}
#define LAS __attribute__((address_space(3)))
#define XB_TMO      128
#define XB_XCNT(j)  (256  + 64 * (j))
#define XB_XSUB(j)  (1280 + 64 * (j))
#define XB_XGEN(j)  (2304 + 64 * (j))
#define XB_TOP      3328
#define XB_TOPGEN   3392
#define XCD_BAR_WORDS 3456
#define XB_SPIN_CAP (1u << 18)

__device__ __forceinline__ unsigned xb_ld(unsigned* p)              { return __hip_atomic_load(p, __ATOMIC_RELAXED, __HIP_MEMORY_SCOPE_AGENT); }
__device__ __forceinline__ unsigned xb_add(unsigned* p, unsigned v) { return __hip_atomic_fetch_add(p, v, __ATOMIC_RELAXED, __HIP_MEMORY_SCOPE_AGENT); }
__device__ __forceinline__ unsigned xb_xcc_id() { return (unsigned)__builtin_amdgcn_s_getreg((3 << 11) | 20) & 0xFu; }
#define XB_SPIN(cond, bar) do { unsigned _sp = 0; while (cond) { __builtin_amdgcn_s_sleep(1); \
    if ((++_sp & 255u) == 0u) { if (xb_ld(&(bar)[XB_TMO])) break; if (_sp > XB_SPIN_CAP) { atomicAdd(&(bar)[XB_TMO], 1u); break; } } } } while (0)

struct XcdBarrier {
    unsigned* bar; unsigned x;
    volatile LAS unsigned* st;
};

__device__ __forceinline__ XcdBarrier xcd_barrier_post(unsigned* bar, volatile LAS unsigned* st) {
    XcdBarrier b; b.bar = bar; b.x = xb_xcc_id(); b.st = st;
    if (threadIdx.x == 0) (void)xb_add(&bar[XB_XCNT(b.x)], 1u);
    return b;
}
__device__ __forceinline__ void xcd_barrier_complete(unsigned* bar, unsigned x, unsigned& nloc, unsigned& nx) {
    const unsigned G = gridDim.x * gridDim.y * gridDim.z;
    unsigned sum, cnt, mine, sp = 0u;
    for (;;) {
        sum = 0u; cnt = 0u; mine = 0u;
#pragma unroll
        for (unsigned j = 0; j < 16; ++j) { const unsigned c = xb_ld(&bar[XB_XCNT(j)]); sum += c; cnt += (c > 0u) ? 1u : 0u; mine = (j == x) ? c : mine; }
        if (sum == G) break;
        __builtin_amdgcn_s_sleep(1);
        if ((++sp & 255u) == 0u) { if (xb_ld(&bar[XB_TMO])) break; if (sp > XB_SPIN_CAP) { atomicAdd(&bar[XB_TMO], 1u); break; } }
    }
    nloc = mine > 0u ? mine : 1u; nx = cnt > 0u ? cnt : 1u;
}

__device__ __forceinline__ void xcd_barrier(const XcdBarrier& b) {
    asm volatile("s_waitcnt vmcnt(0)" ::: "memory");
    __syncthreads();
    if (threadIdx.x == 0) {
        unsigned* bar = b.bar;
        __builtin_amdgcn_s_waitcnt(0);
        unsigned nloc = b.st[0], nx = b.st[1];
        if (nloc == 0u) { xcd_barrier_complete(bar, b.x, nloc, nx); b.st[0] = nloc; b.st[1] = nx; }
        const unsigned old = xb_add(&bar[XB_XSUB(b.x)], 1u);
        const unsigned gen = old / nloc;
        if (old + 1u == (gen + 1u) * nloc) {
            __builtin_amdgcn_fence(__ATOMIC_RELEASE, "agent");
            asm volatile("s_waitcnt vmcnt(0)" ::: "memory");
            const unsigned og = xb_add(&bar[XB_TOP], 1u);
            const unsigned tg = og / nx;
            if (og + 1u == (tg + 1u) * nx) xb_add(&bar[XB_TOPGEN], 1u);
            else XB_SPIN(xb_ld(&bar[XB_TOPGEN]) == tg, bar);
            __builtin_amdgcn_fence(__ATOMIC_ACQUIRE, "agent");
            xb_add(&bar[XB_XGEN(b.x)], 1u);
            asm volatile("s_waitcnt vmcnt(0)" ::: "memory");
        } else {
            XB_SPIN(xb_ld(&bar[XB_XGEN(b.x)]) == gen, bar);
            __builtin_amdgcn_fence(__ATOMIC_ACQUIRE, "agent");
            asm volatile("s_waitcnt vmcnt(0)" ::: "memory");
        }
    }
    __syncthreads();
}
#define GAS __attribute__((address_space(1)))

typedef unsigned short bf16;
typedef float f32x4 __attribute__((ext_vector_type(4)));
typedef unsigned v4u __attribute__((ext_vector_type(4)));
typedef unsigned v2u __attribute__((ext_vector_type(2)));
#define LDS_WAIT() asm volatile("s_waitcnt lgkmcnt(0)" ::: "memory")

#ifndef MK_ONE_LAUNCH
#define MK_ONE_LAUNCH 0
#endif

constexpr int S = 16384, D = 2048, INW = 5376, DFF = 5632, NUP = 2 * DFF, NUPG = NUP + D, PLE = 256, DEPTH = 4;
constexpr float ALPHA = 1.6817928305074290f, LN_EPS = 1e-5f, GN_EPS = 1e-6f;
constexpr int NPH = 11, NPHASES = 1 + DEPTH * NPH;

constexpr size_t MiB = 1u << 20;
constexpr size_t WS_CTL = 0, CTL_ZERO_BYTES = 1 * MiB;
constexpr size_t WS_COSR = 2 * MiB, WS_SINR = 10 * MiB, WS_COSA = 18 * MiB, WS_SINA = 20 * MiB;
constexpr size_t WS_W = 32 * MiB, WL_BYTES = 104 * MiB;
constexpr size_t WL_IN = 0, WL_OUT = 21 * MiB, WL_UP = 29 * MiB, WL_G = 73 * MiB, WL_DOWN = 81 * MiB, WL_P = 103 * MiB;
constexpr size_t WS_XR = 448 * MiB, WS_XB = 576 * MiB, WS_Y = 640 * MiB;
constexpr size_t WS_Q = 768 * MiB, WS_K = 800 * MiB, WS_V = 832 * MiB, WS_G = 864 * MiB, WS_AQ = 896 * MiB, WS_AK = 928 * MiB, WS_AV = 932 * MiB;
constexpr size_t WS_MIX = 936 * MiB, WS_U = 1000 * MiB, WS_PS = 1128 * MiB, WS_RETY = 1160 * MiB;
constexpr size_t WS_H = 768 * MiB, WS_ACT = 1128 * MiB, WS_SG = 1304 * MiB, WS_PB = 1368 * MiB, WS_END = 1400 * MiB;
constexpr int CW_BAR = 4096;

constexpr int RING_BYTES = 131072, LDSCTL_OFF = RING_BYTES, MISC_OFF = LDSCTL_OFF + 320, LDS_BYTES = 147456;

__device__ __forceinline__ unsigned f2bf(float f) { unsigned u = __builtin_bit_cast(unsigned, f); return (u + 0x7fffu + ((u >> 16) & 1u)) >> 16; }
__device__ __forceinline__ unsigned pk2(float lo, float hi) { return f2bf(lo) | (f2bf(hi) << 16); }
__device__ __forceinline__ float bflo(unsigned w) { return __uint_as_float(w << 16); }
__device__ __forceinline__ float bfhi(unsigned w) { return __uint_as_float(w & 0xffff0000u); }
__device__ __forceinline__ float bf1(const bf16* p) { return __uint_as_float(((unsigned)*p) << 16); }

struct Params {
    const float* in[19]; float* out; unsigned char* ws; int ph_lo, ph_hi;
    float invf_ret[128]; float invf_att[32]; float lg2g[4];
};

struct Ctx { int tid, lane, wave, G, bid; unsigned char* ws; };

__device__ __forceinline__ int lane_id_asm() { int l; asm volatile("v_mbcnt_lo_u32_b32 %0, -1, 0\n\tv_mbcnt_hi_u32_b32 %0, -1, %0" : "=v"(l)); return l; }
__device__ __forceinline__ float wave_sum(float v, int lane) {
#pragma unroll
    for (int o = 1; o < 64; o <<= 1) v += __builtin_bit_cast(float, __builtin_amdgcn_ds_bpermute((lane ^ o) << 2, __builtin_bit_cast(int, v)));
    return v;
}
__device__ __forceinline__ void transpose_item(const float* W, int K, int N, int src_col0, bf16* WT, int dst_row0, int k0, LAS float* scr, int lane) {
#pragma unroll 8
    for (int i = 0; i < 32; ++i) { const int kk = 2 * i + (lane >> 5); scr[kk * 33 + (lane & 31)] = W[(size_t)(k0 + kk) * N + src_col0 + (lane & 31)]; }
    LDS_WAIT(); asm volatile("" ::: "memory");
    const int c = lane & 7;
#pragma unroll
    for (int j = 0; j < 4; ++j) { const int n = (lane >> 3) + 8 * j; const LAS float* s = scr + (8 * c) * 33 + n;
        v4u o; o.x = pk2(s[0 * 33], s[1 * 33]); o.y = pk2(s[2 * 33], s[3 * 33]); o.z = pk2(s[4 * 33], s[5 * 33]); o.w = pk2(s[6 * 33], s[7 * 33]);
        *(v4u*)(WT + (size_t)(dst_row0 + n) * K + k0 + 8 * c) = o; }
    LDS_WAIT(); asm volatile("" ::: "memory");
}
__device__ __forceinline__ int win_src_col(int g) {
    const int tile = g >> 3, bj = (g >> 2) & 1, wcg = g & 3;
    if (tile < 16) return 32 * g;
    if (tile < 20) return 4096 + 256 * (tile - 16) + 64 * wcg + 32 * bj;
    return wcg < 2 ? 5120 + 64 * wcg + 32 * bj : 5248 + 32 * (wcg - 2) + 64 * bj;
}
__device__ __forceinline__ int wup_src_col(int g) { const int tile = g >> 3, bj = (g >> 2) & 1, wcg = g & 3; return (bj ? DFF : 0) + 128 * tile + 32 * wcg; }

__device__ __forceinline__ void sincos_d(float angf, float& s, float& c) {
    const double a = (double)angf;
    const double k = __builtin_rint(a * 0.63661977236758134308);
    double r = __builtin_fma(-k, 1.57079632679489661923, a); r = __builtin_fma(-k, 6.123233995736766e-17, r);
    const double r2 = r * r;
    const double sp = r + r * r2 * (-1.0 / 6 + r2 * (1.0 / 120 + r2 * (-1.0 / 5040 + r2 * (1.0 / 362880 + r2 * (-1.0 / 39916800)))));
    const double cp = 1.0 + r2 * (-0.5 + r2 * (1.0 / 24 + r2 * (-1.0 / 720 + r2 * (1.0 / 40320 + r2 * (-1.0 / 3628800 + r2 * (1.0 / 479001600))))));
    const int q = ((int)k) & 3;
    const double sv = (q == 0) ? sp : (q == 1) ? cp : (q == 2) ? -sp : -cp;
    const double cv = (q == 0) ? cp : (q == 1) ? -sp : (q == 2) ? -cp : sp;
    s = (float)sv; c = (float)cv;
}

__device__ __forceinline__ void phase_prologue(const Params& P, const Ctx& cx, LAS unsigned char* lds) {
    unsigned char* ws = cx.ws; const int tid = cx.tid, lane = cx.lane, wave = cx.wave, G = cx.G;
    LAS float* scr = (LAS float*)(lds + wave * 16384);
    const int gw = cx.bid * 8 + wave, NGW = G * 8;
    constexpr int I_IN = 32 * 168, I_OUT = 32 * 64, I_UP = 32 * 352, I_G = 32 * 64, I_DN = 88 * 64, I_P = 4 * 64, I_L = I_IN + I_OUT + I_UP + I_G + I_DN + I_P;
    for (int it = gw; it < DEPTH * I_L; it += NGW) {
        const int l = it / I_L; int r = it - l * I_L;
        bf16* wl = (bf16*)(ws + WS_W + (size_t)l * WL_BYTES);
        if (r < I_IN) { const int kb = r / 168, g = r % 168; transpose_item(P.in[3] + (size_t)l * D * INW, D, INW, win_src_col(g), wl + WL_IN / 2, 32 * g, 64 * kb, scr, lane); continue; } r -= I_IN;
        if (r < I_OUT) { const int kb = r / 64, g = r % 64; transpose_item(P.in[4] + (size_t)l * D * D, D, D, 32 * g, wl + WL_OUT / 2, 32 * g, 64 * kb, scr, lane); continue; } r -= I_OUT;
        if (r < I_UP) { const int kb = r / 352, g = r % 352; transpose_item(P.in[10] + (size_t)l * D * NUP, D, NUP, wup_src_col(g), wl + WL_UP / 2, 32 * g, 64 * kb, scr, lane); continue; } r -= I_UP;
        if (r < I_G) { const int kb = r / 64, g = r % 64; transpose_item(P.in[16] + (size_t)l * D * D, D, D, 32 * g, wl + WL_G / 2, 32 * g, 64 * kb, scr, lane); continue; } r -= I_G;
        if (r < I_DN) { const int kb = r / 64, g = r % 64; transpose_item(P.in[13] + (size_t)l * DFF * D, DFF, D, 32 * g, wl + WL_DOWN / 2, 32 * g, 64 * kb, scr, lane); continue; } r -= I_DN;
        { const int kb = r / 64, g = r % 64; transpose_item(P.in[18] + (size_t)l * PLE * D, PLE, D, 32 * g, wl + WL_P / 2, 32 * g, 64 * kb, scr, lane); }
    }
    const size_t gt = (size_t)cx.bid * 512 + tid, NT = (size_t)G * 512;
    { const float* x = P.in[0]; bf16* xb = (bf16*)(ws + WS_XB);
      for (size_t i = gt; i < (size_t)S * D / 8; i += NT) { const f32x4 a = *(const f32x4*)(x + i * 8), b = *(const f32x4*)(x + i * 8 + 4);
          v4u o; o.x = pk2(a[0], a[1]); o.y = pk2(a[2], a[3]); o.z = pk2(b[0], b[1]); o.w = pk2(b[2], b[3]); *(v4u*)(xb + i * 8) = o; } }
    { const float* p = P.in[1]; bf16* pb = (bf16*)(ws + WS_PB);
      for (size_t i = gt; i < (size_t)DEPTH * S * PLE / 8; i += NT) { const f32x4 a = *(const f32x4*)(p + i * 8), b = *(const f32x4*)(p + i * 8 + 4);
          v4u o; o.x = pk2(a[0], a[1]); o.y = pk2(a[2], a[3]); o.z = pk2(b[0], b[1]); o.w = pk2(b[2], b[3]); *(v4u*)(pb + i * 8) = o; } }
    { const int* pos = (const int*)P.in[2]; float* cosr = (float*)(ws + WS_COSR); float* sinr = (float*)(ws + WS_SINR); float* cosa = (float*)(ws + WS_COSA); float* sina = (float*)(ws + WS_SINA);
      for (size_t i = gt; i < (size_t)S * 128; i += NT) { const int t = (int)(i >> 7), f = (int)(i & 127); float s, c; sincos_d((float)pos[t] * P.invf_ret[f], s, c); cosr[i] = c; sinr[i] = s; }
      for (size_t i = gt; i < (size_t)S * 32; i += NT) { const int t = (int)(i >> 5), f = (int)(i & 31); float s, c; sincos_d((float)pos[t] * P.invf_att[f], s, c); cosa[i] = c; sina[i] = s; } }
}

template <int MT, int NT_, int KK, bool A_KFAST, bool B_NFAST, class FA, class FB, class FC>
__device__ __forceinline__ void simple_gemm(LAS unsigned char* lds, int nbatch, int tid, int G, int bid, const FA& fa, const FB& fb, const FC& fc) {
    LAS float* As = (LAS float*)lds;
    LAS float* Bs = (LAS float*)(lds + 16 * 132 * 4);
    constexpr int TM = MT / 128, TN = NT_ / 64, ITEMS_PER_B = TM * TN;
    const int tm = tid & 31, tn = tid >> 5;
    for (int item = bid; item < nbatch * ITEMS_PER_B; item += G) {
        const int b = item / ITEMS_PER_B, r = item % ITEMS_PER_B, m0 = (r / TN) * 128, n0 = (r % TN) * 64;
        float c[4][4];
#pragma unroll
        for (int i = 0; i < 4; ++i)
#pragma unroll
            for (int j = 0; j < 4; ++j) c[i][j] = 0.f;
        for (int k0 = 0; k0 < KK; k0 += 16) {
#pragma unroll
            for (int rr = 0; rr < 4; ++rr) { const int e = tid + 512 * rr; int m, k; if (A_KFAST) { k = e & 15; m = e >> 4; } else { m = e & 127; k = e >> 7; }
                As[k * 132 + m] = fa(b, m0 + m, k0 + k); }
#pragma unroll
            for (int rr = 0; rr < 2; ++rr) { const int e = tid + 512 * rr; int n, k; if (B_NFAST) { n = e & 63; k = e >> 6; } else { k = e & 15; n = e >> 4; }
                Bs[k * 68 + n] = fb(b, k0 + k, n0 + n); }
            __syncthreads();
#pragma unroll
            for (int kk = 0; kk < 16; ++kk) { const f32x4 a = *(const LAS f32x4*)(As + kk * 132 + 4 * tm), bb = *(const LAS f32x4*)(Bs + kk * 68 + 4 * tn);
#pragma unroll
                for (int i = 0; i < 4; ++i)
#pragma unroll
                    for (int j = 0; j < 4; ++j) c[i][j] += a[i] * bb[j]; }
            __syncthreads();
        }
#pragma unroll
        for (int i = 0; i < 4; ++i)
#pragma unroll
            for (int j = 0; j < 4; ++j) fc(b, m0 + 4 * tm + i, n0 + 4 * tn + j, c[i][j]);
    }
}

__device__ __forceinline__ void phase_swa(const Params& P, const Ctx& cx, int l, LAS unsigned char* lds) {
    unsigned char* ws = cx.ws; const int tid = cx.tid, G = cx.G;
    const bf16* AQ = (const bf16*)(ws + WS_AQ); const bf16* AK = (const bf16*)(ws + WS_AK); const bf16* AV = (const bf16*)(ws + WS_AV); bf16* MIX = (bf16*)(ws + WS_MIX);
    const float* sinks = P.in[7] + l * 16;
    LAS unsigned* Ks = (LAS unsigned*)lds;
    LAS unsigned* Vs = (LAS unsigned*)(lds + 256 * 33 * 4);
    for (int item = cx.bid; item < 256; item += G) {
        const int nb = item >> 1, hk = item & 1;
        __syncthreads();
        for (int e = tid; e < 256 * 32; e += 512) { const int r = e >> 5, cdw = e & 31; const int gk = nb * 128 - 128 + r;
            unsigned kv = 0u, vv = 0u; if (gk >= 0) { kv = *(const unsigned*)(AK + (size_t)gk * 128 + hk * 64 + 2 * cdw); vv = *(const unsigned*)(AV + (size_t)gk * 128 + hk * 64 + 2 * cdw); }
            Ks[r * 33 + cdw] = kv; Vs[r * 33 + cdw] = vv; }
        __syncthreads();
#pragma unroll 1
        for (int rep = 0; rep < 2; ++rep) {
            const int pair = tid + 512 * rep, i = pair & 127, g = pair >> 7, hq = hk * 8 + g; const int row = nb * 128 + i;
            float q[64], o[64];
            { const v4u* qp = (const v4u*)(AQ + (size_t)row * 1024 + hq * 64);
#pragma unroll
              for (int c8 = 0; c8 < 8; ++c8) { const v4u w = qp[c8]; q[8 * c8 + 0] = bflo(w.x); q[8 * c8 + 1] = bfhi(w.x); q[8 * c8 + 2] = bflo(w.y); q[8 * c8 + 3] = bfhi(w.y); q[8 * c8 + 4] = bflo(w.z); q[8 * c8 + 5] = bfhi(w.z); q[8 * c8 + 6] = bflo(w.w); q[8 * c8 + 7] = bfhi(w.w); } }
#pragma unroll
            for (int d = 0; d < 64; ++d) o[d] = 0.f;
            float mx = sinks[hq], den = 1.0f;
            const int jj0 = (nb == 0) ? (127 - i) : 0;
            for (int jj = jj0; jj < 128; ++jj) { const int kl = i + 1 + jj;
                float s = 0.f;
#pragma unroll
                for (int c = 0; c < 32; ++c) { const unsigned w = Ks[kl * 33 + c]; s += q[2 * c] * bflo(w) + q[2 * c + 1] * bfhi(w); }
                const float mn = fmaxf(mx, s), sc = __expf(mx - mn), p = __expf(s - mn);
                den = den * sc + p; mx = mn;
#pragma unroll
                for (int c = 0; c < 32; ++c) { const unsigned w = Vs[kl * 33 + c]; o[2 * c] = o[2 * c] * sc + p * bflo(w); o[2 * c + 1] = o[2 * c + 1] * sc + p * bfhi(w); }
            }
            const float inv = 1.0f / den;
            v4u* op = (v4u*)(MIX + (size_t)row * 2048 + 1024 + hq * 64);
#pragma unroll
            for (int c8 = 0; c8 < 8; ++c8) { v4u w; w.x = pk2(o[8 * c8] * inv, o[8 * c8 + 1] * inv); w.y = pk2(o[8 * c8 + 2] * inv, o[8 * c8 + 3] * inv); w.z = pk2(o[8 * c8 + 4] * inv, o[8 * c8 + 5] * inv); w.w = pk2(o[8 * c8 + 6] * inv, o[8 * c8 + 7] * inv); op[c8] = w; }
        }
    }
}

__device__ __forceinline__ void phase_ret_u_scores(const Params& P, const Ctx& cx, LAS unsigned char* lds) {
    unsigned char* ws = cx.ws; const int tid = cx.tid, G = cx.G;
    const bf16* Q = (const bf16*)(ws + WS_Q); const bf16* K = (const bf16*)(ws + WS_K); const bf16* V = (const bf16*)(ws + WS_V);
    float* U = (float*)(ws + WS_U); float* PS = (float*)(ws + WS_PS);
    const float lg0 = P.lg2g[0], lg1 = P.lg2g[1], lg2 = P.lg2g[2], lg3 = P.lg2g[3];
    auto lgh = [=](int h) { return h == 0 ? lg0 : h == 1 ? lg1 : h == 2 ? lg2 : lg3; };
    simple_gemm<256, 256, 128, false, true>(lds, 512, tid, G, cx.bid,
        [=](int b, int m, int k) { const int nb = b >> 2, h = b & 3; return bf1(K + (size_t)(nb * 128 + k) * 1024 + h * 256 + m) * exp2f(lgh(h) * (float)(127 - k)); },
        [=](int b, int k, int n) { const int nb = b >> 2, h = b & 3; return bf1(V + (size_t)(nb * 128 + k) * 1024 + h * 256 + n); },
        [=](int b, int m, int n, float v) { U[((size_t)b * 256 + m) * 256 + n] = v; });
    simple_gemm<128, 128, 256, true, false>(lds, 512, tid, G, cx.bid,
        [=](int b, int m, int k) { const int nb = b >> 2, h = b & 3; return bf1(Q + (size_t)(nb * 128 + m) * 1024 + h * 256 + k); },
        [=](int b, int k, int n) { const int nb = b >> 2, h = b & 3; return bf1(K + (size_t)(nb * 128 + n) * 1024 + h * 256 + k); },
        [=](int b, int m, int n, float v) { const int h = b & 3; PS[((size_t)b * 128 + m) * 128 + n] = (m >= n) ? v * exp2f(lgh(h) * (float)(m - n)) : 0.f; });
}
__device__ __forceinline__ void phase_scan(const Params& P, const Ctx& cx) {
    float* U = (float*)(cx.ws + WS_U);
    const size_t gt = (size_t)cx.bid * 512 + cx.tid, NT = (size_t)cx.G * 512;
    for (size_t idx = gt; idx < 4 * 65536; idx += NT) {
        const int h = (int)(idx >> 16); const float cd = exp2f(P.lg2g[h] * 128.0f);
        float r = 0.f;
        for (int n0 = 0; n0 < 128; n0 += 8) { float u[8];
#pragma unroll
            for (int j = 0; j < 8; ++j) u[j] = U[(size_t)(n0 + j) * 262144 + idx];
#pragma unroll
            for (int j = 0; j < 8; ++j) { U[(size_t)(n0 + j) * 262144 + idx] = r; r = r * cd + u[j]; } }
    }
}
__device__ __forceinline__ void phase_ret_out(const Params& P, const Ctx& cx, LAS unsigned char* lds) {
    unsigned char* ws = cx.ws; const int tid = cx.tid, G = cx.G;
    const bf16* Q = (const bf16*)(ws + WS_Q); const bf16* V = (const bf16*)(ws + WS_V);
    const float* Sst = (const float*)(ws + WS_U); const float* PS = (const float*)(ws + WS_PS); float* RY = (float*)(ws + WS_RETY);
    const float lg0 = P.lg2g[0], lg1 = P.lg2g[1], lg2 = P.lg2g[2], lg3 = P.lg2g[3];
    auto lgh = [=](int h) { return h == 0 ? lg0 : h == 1 ? lg1 : h == 2 ? lg2 : lg3; };
    simple_gemm<128, 256, 384, true, true>(lds, 512, tid, G, cx.bid,
        [=](int b, int m, int k) { const int nb = b >> 2, h = b & 3; return k < 128 ? PS[((size_t)b * 128 + m) * 128 + k] : bf1(Q + (size_t)(nb * 128 + m) * 1024 + h * 256 + (k - 128)) * exp2f(lgh(h) * (float)(m + 1)); },
        [=](int b, int k, int n) { const int nb = b >> 2, h = b & 3; return k < 128 ? bf1(V + (size_t)(nb * 128 + k) * 1024 + h * 256 + n) : Sst[((size_t)b * 256 + (k - 128)) * 256 + n]; },
        [=](int b, int m, int n, float v) { const int nb = b >> 2, h = b & 3; RY[(size_t)(nb * 128 + m) * 1024 + h * 256 + n] = v; });
}
__device__ __forceinline__ void phase_groupnorm(const Params& P, const Ctx& cx, int l) {
    unsigned char* ws = cx.ws; const int lane = cx.lane, wave = cx.wave, G = cx.G;
    const float* RY = (const float*)(ws + WS_RETY); const bf16* Gt = (const bf16*)(ws + WS_G); bf16* MIX = (bf16*)(ws + WS_MIX);
    const float* gg = P.in[5] + l * 1024; const float* gb = P.in[6] + l * 1024;
    const int gw = cx.bid * 8 + wave, NGW = G * 8;
    for (int it = gw; it < S * 4; it += NGW) { const int row = it >> 2, h = it & 3; const size_t off = (size_t)row * 1024 + h * 256 + 4 * lane;
        f32x4 v = *(const f32x4*)(RY + off);
        const float mean = wave_sum((v[0] + v[1]) + (v[2] + v[3]), lane) * (1.0f / 256.0f);
        v = v - mean;
        const float var = wave_sum((v[0] * v[0] + v[1] * v[1]) + (v[2] * v[2] + v[3] * v[3]), lane) * (1.0f / 256.0f);
        const float rstd = 1.0f / sqrtf(var + GN_EPS);
        const f32x4 g4 = *(const f32x4*)(gg + h * 256 + 4 * lane), b4 = *(const f32x4*)(gb + h * 256 + 4 * lane);
        const v2u gt2 = *(const v2u*)(Gt + off);
        f32x4 o = v * rstd * g4 + b4;
        o[0] *= bflo(gt2.x); o[1] *= bfhi(gt2.x); o[2] *= bflo(gt2.y); o[3] *= bfhi(gt2.y);
        v2u w; w.x = pk2(o[0], o[1]); w.y = pk2(o[2], o[3]);
        *(v2u*)(MIX + (size_t)row * 2048 + h * 256 + 4 * lane) = w; }
}
__device__ __forceinline__ void phase_ln(const Ctx& cx, const float* Y, const float* g, const float* b, float* xo, bf16* xb) {
    const int lane = cx.lane, wave = cx.wave, G = cx.G; const int gw = cx.bid * 8 + wave, NGW = G * 8;
    for (int row = gw; row < S; row += NGW) {
        const f32x4* yr = (const f32x4*)(Y + (size_t)row * D) + lane;
        f32x4 v[8]; float s = 0.f;
#pragma unroll
        for (int j = 0; j < 8; ++j) { v[j] = yr[64 * j]; s += (v[j][0] + v[j][1]) + (v[j][2] + v[j][3]); }
        const float mean = wave_sum(s, lane) * (1.0f / D); float s2 = 0.f;
#pragma unroll
        for (int j = 0; j < 8; ++j) { v[j] = v[j] - mean; s2 += (v[j][0] * v[j][0] + v[j][1] * v[j][1]) + (v[j][2] * v[j][2] + v[j][3] * v[j][3]); }
        const float rstd = 1.0f / sqrtf(wave_sum(s2, lane) * (1.0f / D) + LN_EPS);
        f32x4* xr = (f32x4*)(xo + (size_t)row * D) + lane;
#pragma unroll
        for (int j = 0; j < 8; ++j) { const f32x4 g4 = ((const f32x4*)g)[64 * j + lane], b4 = ((const f32x4*)b)[64 * j + lane]; const f32x4 o = v[j] * rstd * g4 + b4; xr[64 * j] = o;
            if (xb) { v2u w; w.x = pk2(o[0], o[1]); w.y = pk2(o[2], o[3]); ((v2u*)(xb + (size_t)row * D))[64 * j + lane] = w; } }
    }
}
__device__ __forceinline__ void phase_convact(const Params& P, const Ctx& cx, int l) {
    unsigned char* ws = cx.ws; const int tid = cx.tid, G = cx.G;
    const bf16* H = (const bf16*)(ws + WS_H); bf16* ACT = (bf16*)(ws + WS_ACT);
    const float* cw = P.in[11] + (size_t)l * 3 * NUP; const float* cb = P.in[12] + (size_t)l * NUP;
    const size_t gt = (size_t)cx.bid * 512 + tid, NT = (size_t)G * 512;
    for (size_t idx = gt; idx < (size_t)S * 704; idx += NT) {
        const int t = (int)(idx / 704), r = (int)(idx % 704), tile = r >> 4, q8 = r & 15;
        const int chg = 128 * tile + 8 * q8, chu = DFF + chg;
        float ag[8], au[8];
#pragma unroll
        for (int e = 0; e < 8; ++e) { ag[e] = cb[chg + e]; au[e] = cb[chu + e]; }
#pragma unroll
        for (int k = 0; k < 3; ++k) { const int tt = t - 2 + k; if (tt >= 0) {
            const v4u hg = *(const v4u*)(H + (size_t)tt * NUP + 256 * tile + 8 * q8), hu = *(const v4u*)(H + (size_t)tt * NUP + 256 * tile + 128 + 8 * q8);
            const float g8[8] = {bflo(hg.x), bfhi(hg.x), bflo(hg.y), bfhi(hg.y), bflo(hg.z), bfhi(hg.z), bflo(hg.w), bfhi(hg.w)};
            const float u8[8] = {bflo(hu.x), bfhi(hu.x), bflo(hu.y), bfhi(hu.y), bflo(hu.z), bfhi(hu.z), bflo(hu.w), bfhi(hu.w)};
#pragma unroll
            for (int e = 0; e < 8; ++e) { ag[e] += cw[(size_t)k * NUP + chg + e] * g8[e]; au[e] += cw[(size_t)k * NUP + chu + e] * u8[e]; } } }
        float o[8];
#pragma unroll
        for (int e = 0; e < 8; ++e) o[e] = ag[e] / (1.0f + __expf(-ag[e])) * au[e];
        v4u w; w.x = pk2(o[0], o[1]); w.y = pk2(o[2], o[3]); w.z = pk2(o[4], o[5]); w.w = pk2(o[6], o[7]);
        *(v4u*)(ACT + (size_t)t * DFF + chg) = w;
    }
}

#ifdef DBG_DUMP
__device__ __forceinline__ void phase_dump(const Ctx& cx, float* out, const bf16* a, int lda, const bf16* b, int ldb, const float* f) {
    const size_t gt = (size_t)cx.bid * 512 + cx.tid, NT = (size_t)cx.G * 512;
    for (size_t i = gt; i < (size_t)S * D; i += NT) { const int row = (int)(i >> 11), col = (int)(i & 2047);
        float v; if (f) v = f[i]; else if (b && col >= 1024) v = bf1(b + (size_t)row * ldb + (col - 1024)); else v = lda ? bf1(a + (size_t)row * lda + col) : bf1(a + (size_t)(row & 2047) * 2048 + col);
        out[i] = v; }
}
#endif
__global__ void __launch_bounds__(512, 2) fwd(Params P) {
    extern __shared__ __attribute__((aligned(16))) unsigned char lds_raw[];
    LAS unsigned char* lds = (LAS unsigned char*)lds_raw;
    const int wave = __builtin_amdgcn_readfirstlane(threadIdx.x >> 6), G = gridDim.x;
    unsigned char* ws = P.ws;
    volatile LAS unsigned* MISC = (volatile LAS unsigned*)(lds + MISC_OFF);
    for (int u = threadIdx.x; u < (LDS_BYTES - LDSCTL_OFF) / 4; u += 512) ((LAS unsigned*)(lds + LDSCTL_OFF))[u] = 0u;
    __syncthreads();
    const int lo = P.ph_lo, hi = P.ph_hi;
    XcdBarrier bar; bar.bar = (unsigned*)(ws + WS_CTL) + CW_BAR; bar.x = 0; bar.st = nullptr;
    if (hi - lo > 1) bar = xcd_barrier_post((unsigned*)(ws + WS_CTL) + CW_BAR, MISC + 8);
#define IN(k) (lo <= (k) && (k) < hi)
#define SEAM(k) do { if (IN(k) && IN((k) + 1)) xcd_barrier(bar); } while (0)
#define OPQ() Ctx cx; cx.lane = lane_id_asm(); { int t_ = wave; asm volatile("" : "+s"(t_)); cx.wave = t_; } { int t_ = G; asm volatile("" : "+s"(t_)); cx.G = t_; } { int t_ = blockIdx.x; asm volatile("" : "+s"(t_)); cx.bid = t_; } \
    { unsigned t_ = 0u; asm volatile("" : "+s"(t_)); cx.ws = P.ws + t_; } cx.tid = cx.wave * 64 + cx.lane; int lq = l; asm volatile("" : "+s"(lq)); (void)lq

#ifdef DBG_DUMP
    if (lo >= 1000) { const int l = 0; OPQ(); unsigned char* w = cx.ws; const int kind = lo - 1000;
        if (kind == 1) phase_dump(cx, P.out, (const bf16*)(w + WS_Q), 1024, (const bf16*)(w + WS_AQ), 1024, nullptr);
        else if (kind == 2) phase_dump(cx, P.out, (const bf16*)(w + WS_MIX), 2048, nullptr, 0, nullptr);
        else if (kind == 3) phase_dump(cx, P.out, nullptr, 0, nullptr, 0, (const float*)(w + WS_XR));
        else if (kind == 4) phase_dump(cx, P.out, (const bf16*)(w + WS_ACT), DFF, nullptr, 0, nullptr);
        else if (kind == 5) phase_dump(cx, P.out, nullptr, 0, nullptr, 0, (const float*)(w + WS_Y));
        else if (kind == 6) phase_dump(cx, P.out, (const bf16*)(w + WS_K), 1024, (const bf16*)(w + WS_V), 1024, nullptr);
        else if (kind == 7) phase_dump(cx, P.out, (const bf16*)(w + WS_XB), 2048, nullptr, 0, nullptr);
        else if (kind == 11) phase_dump(cx, P.out, (const bf16*)(w + WS_W + WL_G), 0, nullptr, 0, nullptr);
        else if (kind == 12) phase_dump(cx, P.out, (const bf16*)(w + WS_W + WL_OUT), 0, nullptr, 0, nullptr);
        else if (kind == 10) phase_dump(cx, P.out, (const bf16*)(w + WS_H) + 36 * 256, NUP, nullptr, 0, nullptr);
        else if (kind == 9) phase_dump(cx, P.out, (const bf16*)(w + WS_SG), 2048, nullptr, 0, nullptr);
        else if (kind == 8) phase_dump(cx, P.out, nullptr, 0, nullptr, 0, (const float*)(w + WS_RETY));
        return; }
#endif
    if (IN(0)) { const int l = 0; OPQ(); phase_prologue(P, cx, lds); }
    SEAM(0);

    for (int l = 0; l < DEPTH; ++l) {
        const int pb = 1 + l * NPH;
        if (IN(pb + 0)) { OPQ(); unsigned char* w = cx.ws; const bf16* wl = (const bf16*)(w + WS_W + (size_t)lq * WL_BYTES);
            pg8::Gemm g{(const bf16*)(w + WS_XB), wl + WL_IN / 2, S, INW, D}; pg8::StaticOrder So; So.init(S, INW, cx.G, cx.bid);
            pg8::EpiInProj E{(bf16*)(w + WS_Q), (bf16*)(w + WS_K), (bf16*)(w + WS_V), (bf16*)(w + WS_G), (bf16*)(w + WS_AQ), (bf16*)(w + WS_AK), (bf16*)(w + WS_AV),
                             (const float*)(w + WS_COSR), (const float*)(w + WS_SINR), (const float*)(w + WS_COSA), (const float*)(w + WS_SINA)};
            pg8::gemm_phase<pg8::EpiInProj, pg8::StaticOrder, true, true>(lds, g, So, E, cx.wave);
        }
        SEAM(pb + 0);
        if (IN(pb + 1)) { { OPQ(); phase_ret_u_scores(P, cx, lds); } { OPQ(); phase_swa(P, cx, lq, lds); } }
        SEAM(pb + 1);
        if (IN(pb + 2)) { OPQ(); phase_scan(P, cx); }
        SEAM(pb + 2);
        if (IN(pb + 3)) { OPQ(); phase_ret_out(P, cx, lds); }
        SEAM(pb + 3);
        if (IN(pb + 4)) { OPQ(); phase_groupnorm(P, cx, lq); }
        SEAM(pb + 4);
        if (IN(pb + 5)) { OPQ(); unsigned char* w = cx.ws; const bf16* wl = (const bf16*)(w + WS_W + (size_t)lq * WL_BYTES);
            pg8::Gemm g{(const bf16*)(w + WS_MIX), wl + WL_OUT / 2, S, D, D}; pg8::StaticOrder So; So.init(S, D, cx.G, cx.bid);
            pg8::EpiResid<false> E{(lq == 0) ? P.in[0] : (const float*)(w + WS_XR), (float*)(w + WS_Y), ALPHA};
            pg8::gemm_phase<pg8::EpiResid<false>, pg8::StaticOrder, true, true>(lds, g, So, E, cx.wave);
        }
        SEAM(pb + 5);
        if (IN(pb + 6)) { OPQ(); unsigned char* w = cx.ws; phase_ln(cx, (const float*)(w + WS_Y), P.in[8] + lq * D, P.in[9] + lq * D, (float*)(w + WS_XR), (bf16*)(w + WS_XB)); }
        SEAM(pb + 6);
        if (IN(pb + 7)) { OPQ(); unsigned char* w = cx.ws; const bf16* wl = (const bf16*)(w + WS_W + (size_t)lq * WL_BYTES);
            pg8::Gemm g{(const bf16*)(w + WS_XB), wl + WL_UP / 2, S, NUPG, D}; pg8::StaticOrder So; So.init(S, NUPG, cx.G, cx.bid);
            pg8::EpiUp E{(bf16*)(w + WS_H), (bf16*)(w + WS_SG), P.in[17] + lq * D};
            pg8::gemm_phase<pg8::EpiUp, pg8::StaticOrder, true, true>(lds, g, So, E, cx.wave);
        }
        SEAM(pb + 7);
        if (IN(pb + 8)) {
            { OPQ(); unsigned char* w = cx.ws; const bf16* wl = (const bf16*)(w + WS_W + (size_t)lq * WL_BYTES);
              pg8::Gemm g{(const bf16*)(w + WS_PB) + (size_t)lq * S * PLE, wl + WL_P / 2, S, D, PLE}; pg8::StaticOrder So; So.init(S, D, cx.G, cx.bid);
              pg8::EpiPle E{(const bf16*)(w + WS_SG), (float*)(w + WS_Y)};
              pg8::gemm_phase<pg8::EpiPle, pg8::StaticOrder, true, true>(lds, g, So, E, cx.wave); }
            { OPQ(); phase_convact(P, cx, lq); }
        }
        SEAM(pb + 8);
        if (IN(pb + 9)) { OPQ(); unsigned char* w = cx.ws; const bf16* wl = (const bf16*)(w + WS_W + (size_t)lq * WL_BYTES);
            pg8::Gemm g{(const bf16*)(w + WS_ACT), wl + WL_DOWN / 2, S, D, DFF}; pg8::StaticOrder So; So.init(S, D, cx.G, cx.bid);
            pg8::EpiResid<true> E{(const float*)(w + WS_XR), (float*)(w + WS_Y), ALPHA};
            pg8::gemm_phase<pg8::EpiResid<true>, pg8::StaticOrder, true, true>(lds, g, So, E, cx.wave);
        }
        SEAM(pb + 9);
        if (IN(pb + 10)) { OPQ(); unsigned char* w = cx.ws; const bool last = (lq == DEPTH - 1);
            phase_ln(cx, (const float*)(w + WS_Y), P.in[14] + lq * D, P.in[15] + lq * D, last ? P.out : (float*)(w + WS_XR), last ? (bf16*)nullptr : (bf16*)(w + WS_XB)); }
        SEAM(pb + 10);
    }
#undef IN
#undef SEAM
}

extern "C" void kernel_launch(void* const* d_in, const int* in_sizes, int n_in, void* d_out, int out_size, void* d_ws, size_t ws_size, hipStream_t stream) {
    static int grid = 0;
    if (grid == 0) {
        if (n_in != 19 || in_sizes[0] != S * D || out_size != S * D || ws_size < WS_END) { fprintf(stderr, "kernel_launch: unexpected shapes (n_in %d, in0 %d, out %d, ws %zu)\n", n_in, n_in > 0 ? in_sizes[0] : -1, out_size, ws_size); grid = -1; return; }
        int dev = 0, cus = 0, per_cu = 0;
        if (hipGetDevice(&dev) != hipSuccess || hipDeviceGetAttribute(&cus, hipDeviceAttributeMultiprocessorCount, dev) != hipSuccess) { grid = -1; return; }
        if (hipFuncSetAttribute((const void*)fwd, hipFuncAttributeMaxDynamicSharedMemorySize, LDS_BYTES) != hipSuccess) { fprintf(stderr, "kernel_launch: hipFuncSetAttribute failed\n"); grid = -1; return; }
        if (hipOccupancyMaxActiveBlocksPerMultiprocessor(&per_cu, (const void*)fwd, 512, LDS_BYTES) != hipSuccess || per_cu < 1) fprintf(stderr, "kernel_launch: occupancy query says %d\n", per_cu);
        (void)hipGetLastError();
        grid = cus;
    }
    if (grid < 0) return;
    (void)hipMemsetAsync((char*)d_ws + WS_CTL, 0, CTL_ZERO_BYTES, stream);
#ifdef DBG_NANFILL
    (void)hipMemsetAsync((char*)d_ws + CTL_ZERO_BYTES, 0xFF, WS_END - CTL_ZERO_BYTES, stream);
#endif
    Params p{};
    for (int i = 0; i < 19; ++i) p.in[i] = (const float*)d_in[i];
    p.out = (float*)d_out; p.ws = (unsigned char*)d_ws;
    for (int f = 0; f < 128; ++f) p.invf_ret[f] = (float)(1.0 / std::pow(10000.0, (double)((float)f / 127.0f)));
    for (int f = 0; f < 32; ++f) p.invf_att[f] = (float)std::pow(10000.0, -(double)(2 * f) / 64.0);
    for (int h = 0; h < 4; ++h) p.lg2g[h] = (float)std::log2(1.0 - std::exp2(-5.0 - h));
#if MK_ONE_LAUNCH
    p.ph_lo = 0; p.ph_hi = NPHASES;
    hipLaunchKernelGGL(fwd, dim3(grid), dim3(512), LDS_BYTES, stream, p);
#else
#ifdef DBG_DUMP
    for (int ph = 0; ph <= DBG_STOP; ++ph) { p.ph_lo = ph; p.ph_hi = ph + 1; hipLaunchKernelGGL(fwd, dim3(grid), dim3(512), LDS_BYTES, stream, p); }
    p.ph_lo = 1000 + DBG_DUMP; p.ph_hi = p.ph_lo + 1; hipLaunchKernelGGL(fwd, dim3(grid), dim3(512), LDS_BYTES, stream, p);
#else
    for (int ph = 0; ph < NPHASES; ++ph) { p.ph_lo = ph; p.ph_hi = ph + 1; hipLaunchKernelGGL(fwd, dim3(grid), dim3(512), LDS_BYTES, stream, p); }
#endif
#endif
}
```

```cpp
#include <hip/hip_runtime.h>
#include <cstdio>
#include <cstdint>
#include <cmath>
#define MK_ONE_LAUNCH 1
namespace pg8 {
#define PG8_LAS __attribute__((address_space(3)))
typedef unsigned short bf16_t;
typedef short bf16x8 __attribute__((ext_vector_type(8)));
typedef float f32x4 __attribute__((ext_vector_type(4)));
typedef unsigned u32x4 __attribute__((ext_vector_type(4)));
constexpr int BM = 256, BK = 64, HALF = 128, HTB = HALF * BK * 2  , STAGE_BYTES = 8 * HTB, NXCD = 8, WGM = 8;

__host__ __device__ __forceinline__ int lds_byte(int r, int c) { const int st = (r >> 4) * 2 + (c >> 5), rr = r & 15, cc = c & 31, ob = rr * 64 + cc * 2; return st * 1024 + (ob ^ (((ob >> 9) & 1) << 5)); }
__host__ __device__ __forceinline__ void stage_rc(int b, int& R, int& C) { const int st = b / 1024, sb = b % 1024, swz = sb ^ (((sb >> 9) & 1) << 5); R = (st >> 1) * 16 + swz / 64; C = (st & 1) * 32 + (swz % 64) / 2; }
__host__ __device__ __forceinline__ int perm32(int rho) { const int n = rho >> 4, i = rho & 15; return 8 * (i >> 2) + 4 * n + (i & 3); }

struct Unit { int pm, pn; };
struct Gemm { const bf16_t* A; const bf16_t* Bt; int M, N, K; };

struct StaticOrder {
    int nM, nN, nwg, G, c;
    __host__ __device__ void init(int M, int N, int G_, int c_) { nM = M / BM; nN = N / BM; nwg = nM * nN; G = G_; c = c_; }
    __host__ __device__ bool next(int i, Unit& u) const {
        const long L = (long)i * G + c; if (L >= nwg) return false;
        int wgid = (int)L; { const int q = nwg / NXCD, r = nwg % NXCD, xcd = wgid % NXCD, off = wgid / NXCD; wgid = (xcd < r ? xcd * (q + 1) : r * (q + 1) + (xcd - r) * q) + off; }
        const int nig = WGM * nN, gid = wgid / nig, fm = gid * WGM, gsz = (nM - fm) < WGM ? (nM - fm) : WGM;
        u.pm = fm + ((wgid % nig) % gsz); u.pn = (wgid % nig) / gsz; return true;
    }
    __device__ __forceinline__ void a_ready(const Unit&) const {}
    __device__ __forceinline__ void done(const Unit&) const {}
};

typedef float f32x2c_t __attribute__((ext_vector_type(2))); typedef __bf16 bf16x2c_t __attribute__((ext_vector_type(2)));
__device__ __forceinline__ unsigned cvt_pk_bf16(float lo, float hi) { f32x2c_t v = {lo, hi}; bf16x2c_t b = __builtin_convertvector(v, bf16x2c_t); return __builtin_bit_cast(unsigned, b); }
typedef float f32x2 __attribute__((ext_vector_type(2)));
typedef unsigned u32x2 __attribute__((ext_vector_type(2)));
__device__ __forceinline__ float bf2f(unsigned short b) { return __uint_as_float(((unsigned)b) << 16); }
__device__ __forceinline__ u32x4 pack8(const f32x4 a, const f32x4 b) { u32x4 w; w.x = cvt_pk_bf16(a[0], a[1]); w.y = cvt_pk_bf16(a[2], a[3]); w.z = cvt_pk_bf16(b[0], b[1]); w.w = cvt_pk_bf16(b[2], b[3]); return w; }
__device__ __forceinline__ float sigmoidf_(float x) { return __builtin_amdgcn_rcpf(1.0f + __expf(-x)); }

struct EpiInProj {
    static constexpr bool PERM = true, AFTER_DRAIN = false;
    bf16_t *Q, *K, *V, *G, *AQ, *AK, *AV; const float *cosr, *sinr, *cosa, *sina;
    __device__ __forceinline__ void operator()(const f32x4 (&acc)[2][2][4][2], const Unit& u, int wr, int wc, int fr, int fq) const {
        const int row0 = u.pm * BM + wr * 64 + fr, pn = u.pn, cw = wc * 32 + 8 * fq;
        if (pn < 8) {
            bf16_t* O = pn < 4 ? Q : K; const int hcol = (pn & 3) * 256; const float sc = pn < 4 ? 1.0f : 0.0625f;
#pragma unroll
            for (int ai = 0; ai < 2; ++ai)
#pragma unroll
                for (int m = 0; m < 4; ++m) { const int row = row0 + ai * HALF + m * 16;
                    const f32x4 c0 = *(const f32x4*)(cosr + (size_t)row * 128 + cw), c1 = *(const f32x4*)(cosr + (size_t)row * 128 + cw + 4);
                    const f32x4 s0 = *(const f32x4*)(sinr + (size_t)row * 128 + cw), s1 = *(const f32x4*)(sinr + (size_t)row * 128 + cw + 4);
                    const f32x4 a0 = acc[ai][0][m][0], a1 = acc[ai][0][m][1], b0 = acc[ai][1][m][0], b1 = acc[ai][1][m][1];
                    const f32x4 o10 = (a0 * c0 - b0 * s0) * sc, o11 = (a1 * c1 - b1 * s1) * sc, o20 = (a0 * s0 + b0 * c0) * sc, o21 = (a1 * s1 + b1 * c1) * sc;
                    bf16_t* rowp = O + (size_t)row * 1024 + hcol + cw;
                    *(u32x4*)(rowp) = pack8(o10, o11); *(u32x4*)(rowp + HALF) = pack8(o20, o21); }
        } else if (pn < 16) {
            const bool gate = pn >= 12; bf16_t* O = gate ? G : V; const int hcol = (pn & 3) * 256;
#pragma unroll
            for (int ai = 0; ai < 2; ++ai)
#pragma unroll
                for (int m = 0; m < 4; ++m) { const int row = row0 + ai * HALF + m * 16; bf16_t* rowp = O + (size_t)row * 1024 + hcol + cw;
#pragma unroll
                    for (int bj = 0; bj < 2; ++bj) { f32x4 v0 = acc[ai][bj][m][0], v1 = acc[ai][bj][m][1];
                        if (gate) {
#pragma unroll
                            for (int j = 0; j < 4; ++j) { v0[j] = v0[j] * sigmoidf_(v0[j]); v1[j] = v1[j] * sigmoidf_(v1[j]); } }
                        *(u32x4*)(rowp + bj * HALF) = pack8(v0, v1); } }
        } else if (pn < 20) {
            const int t = pn - 16, i0 = 8 * fq;
#pragma unroll
            for (int ai = 0; ai < 2; ++ai)
#pragma unroll
                for (int m = 0; m < 4; ++m) { const int row = row0 + ai * HALF + m * 16;
                    const f32x4 c0 = *(const f32x4*)(cosa + (size_t)row * 32 + i0), c1 = *(const f32x4*)(cosa + (size_t)row * 32 + i0 + 4);
                    const f32x4 s0 = *(const f32x4*)(sina + (size_t)row * 32 + i0), s1 = *(const f32x4*)(sina + (size_t)row * 32 + i0 + 4);
                    const f32x4 a0 = acc[ai][0][m][0], a1 = acc[ai][0][m][1], b0 = acc[ai][1][m][0], b1 = acc[ai][1][m][1];
                    const f32x4 o10 = (a0 * c0 - b0 * s0) * 0.125f, o11 = (a1 * c1 - b1 * s1) * 0.125f, o20 = (a0 * s0 + b0 * c0) * 0.125f, o21 = (a1 * s1 + b1 * c1) * 0.125f;
                    bf16_t* rowp = AQ + (size_t)row * 1024 + t * 256 + wc * 64 + i0;
                    *(u32x4*)(rowp) = pack8(o10, o11); *(u32x4*)(rowp + 32) = pack8(o20, o21); }
        } else {
            const int i0 = 8 * fq;
            if (wc < 2) {
#pragma unroll
                for (int ai = 0; ai < 2; ++ai)
#pragma unroll
                    for (int m = 0; m < 4; ++m) { const int row = row0 + ai * HALF + m * 16;
                        const f32x4 c0 = *(const f32x4*)(cosa + (size_t)row * 32 + i0), c1 = *(const f32x4*)(cosa + (size_t)row * 32 + i0 + 4);
                        const f32x4 s0 = *(const f32x4*)(sina + (size_t)row * 32 + i0), s1 = *(const f32x4*)(sina + (size_t)row * 32 + i0 + 4);
                        const f32x4 a0 = acc[ai][0][m][0], a1 = acc[ai][0][m][1], b0 = acc[ai][1][m][0], b1 = acc[ai][1][m][1];
                        const f32x4 o10 = a0 * c0 - b0 * s0, o11 = a1 * c1 - b1 * s1, o20 = a0 * s0 + b0 * c0, o21 = a1 * s1 + b1 * c1;
                        bf16_t* rowp = AK + (size_t)row * 128 + wc * 64 + i0;
                        *(u32x4*)(rowp) = pack8(o10, o11); *(u32x4*)(rowp + 32) = pack8(o20, o21); }
            } else {
#pragma unroll
                for (int ai = 0; ai < 2; ++ai)
#pragma unroll
                    for (int m = 0; m < 4; ++m) { const int row = row0 + ai * HALF + m * 16; bf16_t* rowp = AV + (size_t)row * 128 + (wc - 2) * 32 + i0;
                        *(u32x4*)(rowp) = pack8(acc[ai][0][m][0], acc[ai][0][m][1]); *(u32x4*)(rowp + 64) = pack8(acc[ai][1][m][0], acc[ai][1][m][1]); }
            }
        }
    }
};
template <bool ADD> struct EpiResid {
    static constexpr bool PERM = false, AFTER_DRAIN = false;
    const float* base; float* Y; float alpha;
    __device__ __forceinline__ void operator()(const f32x4 (&acc)[2][2][4][2], const Unit& u, int wr, int wc, int fr, int fq) const {
        const int row0 = u.pm * BM + wr * 64 + fr, col0 = u.pn * BM + wc * 32 + 4 * fq;
#pragma unroll
        for (int ai = 0; ai < 2; ++ai)
#pragma unroll
            for (int m = 0; m < 4; ++m) { const size_t off = (size_t)(row0 + ai * HALF + m * 16) * 2048 + col0;
#pragma unroll
                for (int bj = 0; bj < 2; ++bj)
#pragma unroll
                    for (int n = 0; n < 2; ++n) { const size_t o = off + bj * HALF + n * 16; f32x4 v = acc[ai][bj][m][n] + *(const f32x4*)(base + o) * alpha;
                        if (ADD) v = v + *(const f32x4*)(Y + o); *(f32x4*)(Y + o) = v; } }
    }
};
struct EpiUp {
    static constexpr bool PERM = true, AFTER_DRAIN = false;
    bf16_t* H; bf16_t* SG; const float* bgate;
    __device__ __forceinline__ void operator()(const f32x4 (&acc)[2][2][4][2], const Unit& u, int wr, int wc, int fr, int fq) const {
        const int row0 = u.pm * BM + wr * 64 + fr, cw = wc * 32 + 8 * fq;
        if (u.pn < 44) {
#pragma unroll
            for (int ai = 0; ai < 2; ++ai)
#pragma unroll
                for (int m = 0; m < 4; ++m) { bf16_t* rowp = H + (size_t)(row0 + ai * HALF + m * 16) * 11264 + u.pn * 256 + cw;
#pragma unroll
                    for (int bj = 0; bj < 2; ++bj) *(u32x4*)(rowp + bj * HALF) = pack8(acc[ai][bj][m][0], acc[ai][bj][m][1]); }
        } else {
            const int colg = (u.pn - 44) * 256 + cw;
            f32x4 bv[2][2];
#pragma unroll
            for (int bj = 0; bj < 2; ++bj)
#pragma unroll
                for (int n = 0; n < 2; ++n) bv[bj][n] = *(const f32x4*)(bgate + colg + bj * HALF + 4 * n);
#pragma unroll
            for (int ai = 0; ai < 2; ++ai)
#pragma unroll
                for (int m = 0; m < 4; ++m) { bf16_t* rowp = SG + (size_t)(row0 + ai * HALF + m * 16) * 2048 + colg;
#pragma unroll
                    for (int bj = 0; bj < 2; ++bj) { f32x4 v0 = acc[ai][bj][m][0] + bv[bj][0], v1 = acc[ai][bj][m][1] + bv[bj][1];
#pragma unroll
                        for (int j = 0; j < 4; ++j) { v0[j] = sigmoidf_(v0[j]); v1[j] = sigmoidf_(v1[j]); }
                        *(u32x4*)(rowp + bj * HALF) = pack8(v0, v1); } }
        }
    }
};
struct EpiPle {
    static constexpr bool PERM = false, AFTER_DRAIN = false;
    const bf16_t* SG; float* Y;
    __device__ __forceinline__ void operator()(const f32x4 (&acc)[2][2][4][2], const Unit& u, int wr, int wc, int fr, int fq) const {
        const int row0 = u.pm * BM + wr * 64 + fr, col0 = u.pn * BM + wc * 32 + 4 * fq;
#pragma unroll
        for (int ai = 0; ai < 2; ++ai)
#pragma unroll
            for (int m = 0; m < 4; ++m) { const size_t off = (size_t)(row0 + ai * HALF + m * 16) * 2048 + col0;
#pragma unroll
                for (int bj = 0; bj < 2; ++bj)
#pragma unroll
                    for (int n = 0; n < 2; ++n) { const size_t o = off + bj * HALF + n * 16; const u32x2 sg = *(const u32x2*)(SG + o);
                        f32x4 g; g[0] = __uint_as_float(sg.x << 16); g[1] = __uint_as_float(sg.x & 0xffff0000u); g[2] = __uint_as_float(sg.y << 16); g[3] = __uint_as_float(sg.y & 0xffff0000u);
                        *(f32x4*)(Y + o) = acc[ai][bj][m][n] * g; } }
    }
};
template <class Epi, class Sched, bool ALIGN_EPI = false, bool SP2 = false>
__device__ __forceinline__ void gemm_phase(PG8_LAS unsigned char* lds, const Gemm g, const Sched& S, const Epi& E, const int wid_in) {
    int lane_; asm volatile("v_mbcnt_lo_u32_b32 %0, -1, 0\n\tv_mbcnt_hi_u32_b32 %0, -1, %0" : "=v"(lane_)); const int wid = wid_in, lane = lane_, tid = wid * 64 + lane, wr = wid >> 2, wc = wid & 3, fr = lane & 15, fq = lane >> 4;
    const int K = g.K, nt = K / BK;
    unsigned voffA[2], voffB[2];
#pragma unroll
    for (int i = 0; i < 2; ++i) { int R, C; stage_rc(tid * 16 + i * 8192, R, C); const int Rb = Epi::PERM ? ((R & ~31) + perm32(R & 31)) : R;
        voffA[i] = (unsigned)(R * K + C) * 2u; voffB[i] = (unsigned)(Rb * K + C) * 2u; }
    const size_t kstep = (size_t)(BK * 2);
    const size_t hstep = (size_t)HALF * K * 2;
    const size_t tstep = 2 * hstep;
    const unsigned ldsw = (unsigned)wid * 1024u;
    const int aoff = lds_byte(wr * 64 + fr, fq * 8), boff = lds_byte(wc * 32 + fr, fq * 8);
#define PG8_SA(b, h) (((b) * 2 + (h)) * HTB)
#define PG8_SB(b, h) ((4 + (b) * 2 + (h)) * HTB)
#define PG8_STAGE(bufoff, gbase, voff) do { _Pragma("unroll") for (int _i = 0; _i < 2; ++_i) \
        __builtin_amdgcn_global_load_lds((const unsigned*)((const char*)(gbase) + (voff)[_i]), (PG8_LAS unsigned*)(lds + (bufoff) + ldsw + _i * 8192), 16, 0, 0); } while (0)
#define PG8_LDA(dst, b, h) do { _Pragma("unroll") for (int m = 0; m < 4; ++m) _Pragma("unroll") for (int k = 0; k < 2; ++k) dst[m][k] = *(const PG8_LAS bf16x8*)(lds + PG8_SA(b, h) + aoff + m * 2048 + k * 1024); } while (0)
#define PG8_LDB(dst, b, h) do { _Pragma("unroll") for (int n = 0; n < 2; ++n) _Pragma("unroll") for (int k = 0; k < 2; ++k) dst[n][k] = *(const PG8_LAS bf16x8*)(lds + PG8_SB(b, h) + boff + n * 2048 + k * 1024); } while (0)
#define PG8_MMA(ai, bj, At, Bt) do { __builtin_amdgcn_s_setprio(1); _Pragma("unroll") for (int m = 0; m < 4; ++m) _Pragma("unroll") for (int n = 0; n < 2; ++n) _Pragma("unroll") for (int k = 0; k < 2; ++k) \
        acc[ai][bj][m][n] = __builtin_amdgcn_mfma_f32_16x16x32_bf16(Bt[n][k], At[m][k], acc[ai][bj][m][n], 0, 0, 0); __builtin_amdgcn_s_setprio(0); } while (0)
#define PG8_WAIT_V(n) asm volatile("s_waitcnt vmcnt(" #n ")" ::: "memory")
#define PG8_WAIT_L(n) asm volatile("s_waitcnt lgkmcnt(" #n ")" ::: "memory")
#define PG8_BAR __builtin_amdgcn_s_barrier()
#define PG8_SCHED __builtin_amdgcn_sched_barrier(0)
    Unit cur, nxt; int ui = 0;
    if (!S.next(0, cur)) return;
    f32x4 acc[2][2][4][2];
#pragma unroll
    for (int a = 0; a < 2; ++a)
#pragma unroll
        for (int b = 0; b < 2; ++b)
#pragma unroll
            for (int m = 0; m < 4; ++m)
#pragma unroll
                for (int n = 0; n < 2; ++n) acc[a][b][m][n] = (f32x4){0.f, 0.f, 0.f, 0.f};
    bf16x8 At[4][2], B0[2][2], B1[2][2];
    const char* cA = (const char*)g.A + (size_t)cur.pm * tstep; const char* cB = (const char*)g.Bt + (size_t)cur.pn * tstep;
    S.a_ready(cur);
    if constexpr (SP2) {
        PG8_STAGE(PG8_SB(0, 0), cB, voffB); PG8_STAGE(PG8_SB(0, 1), cB + hstep, voffB); PG8_STAGE(PG8_SA(0, 0), cA, voffA); PG8_STAGE(PG8_SA(0, 1), cA + hstep, voffA);
        if (wr == 1) PG8_BAR;
        PG8_WAIT_V(2); PG8_BAR;
        PG8_STAGE(PG8_SB(1, 0), cB + kstep, voffB); PG8_STAGE(PG8_SA(1, 0), cA + kstep, voffA); PG8_STAGE(PG8_SB(1, 1), cB + hstep + kstep, voffB);
        PG8_WAIT_V(6); PG8_BAR;
    } else {
        PG8_STAGE(PG8_SB(0, 0), cB, voffB); PG8_STAGE(PG8_SA(0, 0), cA, voffA); PG8_STAGE(PG8_SB(0, 1), cB + hstep, voffB); PG8_STAGE(PG8_SA(0, 1), cA + hstep, voffA);
        if (wr == 1) PG8_BAR;
        PG8_WAIT_V(4); PG8_BAR;
        PG8_STAGE(PG8_SB(1, 0), cB + kstep, voffB); PG8_STAGE(PG8_SA(1, 0), cA + kstep, voffA); PG8_STAGE(PG8_SB(1, 1), cB + hstep + kstep, voffB);
        PG8_WAIT_V(6); PG8_BAR;
    }
    for (;;) {
        const bool has_next = S.next(ui + 1, nxt);
        const char* nA = has_next ? (const char*)g.A + (size_t)nxt.pm * tstep : cA; const char* nB = has_next ? (const char*)g.Bt + (size_t)nxt.pn * tstep : cB;
        for (int t = 0; t < nt; t += 2) {
            const bool last = (t == nt - 2);
            const char* a1 = cA + (size_t)(t + 1) * kstep;
            const char* a2 = last ? nA : cA + (size_t)(t + 2) * kstep; const char* b2 = last ? nB : cB + (size_t)(t + 2) * kstep;
            const char* a3 = a2 + kstep; const char* b3 = b2 + kstep;
            if (last && has_next) S.a_ready(nxt);
            if constexpr (SP2) {
            PG8_LDB(B0, 0, 0); PG8_LDB(B1, 0, 1); PG8_SCHED; PG8_LDA(At, 0, 0); PG8_STAGE(PG8_SA(1, 1), a1 + hstep, voffA);
            PG8_WAIT_V(8); PG8_WAIT_L(0); PG8_BAR; PG8_MMA(0, 0, At, B0); PG8_MMA(0, 1, At, B1); PG8_BAR; PG8_SCHED;
            PG8_LDA(At, 0, 1); PG8_STAGE(PG8_SB(0, 0), b2, voffB); PG8_STAGE(PG8_SB(0, 1), b2 + hstep, voffB); PG8_STAGE(PG8_SA(0, 0), a2, voffA);
            PG8_WAIT_V(8); PG8_WAIT_L(0); PG8_BAR; PG8_MMA(1, 0, At, B0); PG8_MMA(1, 1, At, B1); PG8_BAR; PG8_SCHED;
            PG8_LDB(B0, 1, 0); PG8_LDB(B1, 1, 1); PG8_SCHED; PG8_LDA(At, 1, 0); PG8_STAGE(PG8_SA(0, 1), a2 + hstep, voffA);
            PG8_WAIT_V(8); PG8_WAIT_L(0); PG8_BAR; PG8_MMA(0, 0, At, B0); PG8_MMA(0, 1, At, B1); PG8_BAR; PG8_SCHED;
            PG8_LDA(At, 1, 1); PG8_STAGE(PG8_SB(1, 0), b3, voffB); PG8_STAGE(PG8_SB(1, 1), b3 + hstep, voffB); PG8_STAGE(PG8_SA(1, 0), a3, voffA);
            PG8_WAIT_V(8); PG8_WAIT_L(0); PG8_BAR; PG8_MMA(1, 0, At, B0); PG8_MMA(1, 1, At, B1); PG8_BAR; PG8_SCHED;
            } else {
            PG8_LDB(B0, 0, 0); PG8_SCHED; PG8_LDA(At, 0, 0); PG8_STAGE(PG8_SA(1, 1), a1 + hstep, voffA);
            PG8_WAIT_L(8); PG8_BAR; PG8_WAIT_L(0); PG8_MMA(0, 0, At, B0); PG8_BAR; PG8_SCHED;
            PG8_LDB(B1, 0, 1); PG8_STAGE(PG8_SB(0, 0), b2, voffB);
            PG8_BAR; PG8_WAIT_L(0); PG8_MMA(0, 1, At, B1); PG8_BAR;
            PG8_LDA(At, 0, 1); PG8_STAGE(PG8_SA(0, 0), a2, voffA);
            PG8_BAR; PG8_WAIT_L(0); PG8_MMA(1, 0, At, B0); PG8_BAR; PG8_SCHED;
            PG8_STAGE(PG8_SB(0, 1), b2 + hstep, voffB);
            PG8_WAIT_V(6); PG8_BAR; PG8_MMA(1, 1, At, B1); PG8_BAR;
            PG8_LDB(B0, 1, 0); PG8_SCHED; PG8_LDA(At, 1, 0); PG8_STAGE(PG8_SA(0, 1), a2 + hstep, voffA);
            PG8_WAIT_L(8); PG8_BAR; PG8_WAIT_L(0); PG8_MMA(0, 0, At, B0); PG8_BAR; PG8_SCHED;
            PG8_LDB(B1, 1, 1); PG8_STAGE(PG8_SB(1, 0), b3, voffB);
            PG8_BAR; PG8_WAIT_L(0); PG8_MMA(0, 1, At, B1); PG8_BAR;
            PG8_LDA(At, 1, 1); PG8_STAGE(PG8_SA(1, 0), a3, voffA);
            PG8_BAR; PG8_WAIT_L(0); PG8_MMA(1, 0, At, B0); PG8_BAR; PG8_SCHED;
            PG8_STAGE(PG8_SB(1, 1), b3 + hstep, voffB);
            PG8_WAIT_V(6); PG8_BAR; PG8_MMA(1, 1, At, B1); PG8_BAR;
            }
        }
        if constexpr (ALIGN_EPI) { if (wr == 0) PG8_BAR; }
        if constexpr (!Epi::AFTER_DRAIN) { E(acc, cur, wr, wc, fr, fq); S.done(cur); }
        if (!has_next) break;
#pragma unroll
        for (int a = 0; a < 2; ++a)
#pragma unroll
            for (int b = 0; b < 2; ++b)
#pragma unroll
                for (int m = 0; m < 4; ++m)
#pragma unroll
                    for (int n = 0; n < 2; ++n) acc[a][b][m][n] = (f32x4){0.f, 0.f, 0.f, 0.f};
        cur = nxt; cA = nA; cB = nB; ++ui;
        if constexpr (ALIGN_EPI) { if (wr == 1) PG8_BAR; }
    }
    PG8_WAIT_V(0);
    if constexpr (!ALIGN_EPI) { if (wr == 0) PG8_BAR; }
    PG8_BAR;
    if constexpr (Epi::AFTER_DRAIN) { E.fused(acc, cur, wr, wc, fr, fq, lds, wid, lane); S.done(cur); }
#undef PG8_SA
#undef PG8_SB
#undef PG8_STAGE
#undef PG8_LDA
#undef PG8_LDB
#undef PG8_MMA
#undef PG8_WAIT_V
#undef PG8_WAIT_L
#undef PG8_BAR
#undef PG8_SCHED
}
}
#define LAS __attribute__((address_space(3)))
#define XB_TMO      128
#define XB_XCNT(j)  (256  + 64 * (j))
#define XB_XSUB(j)  (1280 + 64 * (j))
#define XB_XGEN(j)  (2304 + 64 * (j))
#define XB_TOP      3328
#define XB_TOPGEN   3392
#define XCD_BAR_WORDS 3456
#define XB_SPIN_CAP (1u << 18)

__device__ __forceinline__ unsigned xb_ld(unsigned* p)              { return __hip_atomic_load(p, __ATOMIC_RELAXED, __HIP_MEMORY_SCOPE_AGENT); }
__device__ __forceinline__ unsigned xb_add(unsigned* p, unsigned v) { return __hip_atomic_fetch_add(p, v, __ATOMIC_RELAXED, __HIP_MEMORY_SCOPE_AGENT); }
__device__ __forceinline__ unsigned xb_xcc_id() { return (unsigned)__builtin_amdgcn_s_getreg((3 << 11) | 20) & 0xFu; }
#define XB_SPIN(cond, bar) do { unsigned _sp = 0; while (cond) { __builtin_amdgcn_s_sleep(1); \
    if ((++_sp & 255u) == 0u) { if (xb_ld(&(bar)[XB_TMO])) break; if (_sp > XB_SPIN_CAP) { atomicAdd(&(bar)[XB_TMO], 1u); break; } } } } while (0)

struct XcdBarrier {
    unsigned* bar; unsigned x;
    volatile LAS unsigned* st;
};

__device__ __forceinline__ XcdBarrier xcd_barrier_post(unsigned* bar, volatile LAS unsigned* st) {
    XcdBarrier b; b.bar = bar; b.x = xb_xcc_id(); b.st = st;
    if (threadIdx.x == 0) (void)xb_add(&bar[XB_XCNT(b.x)], 1u);
    return b;
}
__device__ __forceinline__ void xcd_barrier_complete(unsigned* bar, unsigned x, unsigned& nloc, unsigned& nx) {
    const unsigned G = gridDim.x * gridDim.y * gridDim.z;
    unsigned sum, cnt, mine, sp = 0u;
    for (;;) {
        sum = 0u; cnt = 0u; mine = 0u;
#pragma unroll
        for (unsigned j = 0; j < 16; ++j) { const unsigned c = xb_ld(&bar[XB_XCNT(j)]); sum += c; cnt += (c > 0u) ? 1u : 0u; mine = (j == x) ? c : mine; }
        if (sum == G) break;
        __builtin_amdgcn_s_sleep(1);
        if ((++sp & 255u) == 0u) { if (xb_ld(&bar[XB_TMO])) break; if (sp > XB_SPIN_CAP) { atomicAdd(&bar[XB_TMO], 1u); break; } }
    }
    nloc = mine > 0u ? mine : 1u; nx = cnt > 0u ? cnt : 1u;
}

__device__ __forceinline__ void xcd_barrier(const XcdBarrier& b) {
    asm volatile("s_waitcnt vmcnt(0)" ::: "memory");
    __syncthreads();
    if (threadIdx.x == 0) {
        unsigned* bar = b.bar;
        __builtin_amdgcn_s_waitcnt(0);
        unsigned nloc = b.st[0], nx = b.st[1];
        if (nloc == 0u) { xcd_barrier_complete(bar, b.x, nloc, nx); b.st[0] = nloc; b.st[1] = nx; }
        const unsigned old = xb_add(&bar[XB_XSUB(b.x)], 1u);
        const unsigned gen = old / nloc;
        if (old + 1u == (gen + 1u) * nloc) {
            __builtin_amdgcn_fence(__ATOMIC_RELEASE, "agent");
            asm volatile("s_waitcnt vmcnt(0)" ::: "memory");
            const unsigned og = xb_add(&bar[XB_TOP], 1u);
            const unsigned tg = og / nx;
            if (og + 1u == (tg + 1u) * nx) xb_add(&bar[XB_TOPGEN], 1u);
            else XB_SPIN(xb_ld(&bar[XB_TOPGEN]) == tg, bar);
            __builtin_amdgcn_fence(__ATOMIC_ACQUIRE, "agent");
            xb_add(&bar[XB_XGEN(b.x)], 1u);
            asm volatile("s_waitcnt vmcnt(0)" ::: "memory");
        } else {
            XB_SPIN(xb_ld(&bar[XB_XGEN(b.x)]) == gen, bar);
            __builtin_amdgcn_fence(__ATOMIC_ACQUIRE, "agent");
            asm volatile("s_waitcnt vmcnt(0)" ::: "memory");
        }
    }
    __syncthreads();
}
#define GAS __attribute__((address_space(1)))

typedef unsigned short bf16;
typedef float f32x4 __attribute__((ext_vector_type(4)));
typedef unsigned v4u __attribute__((ext_vector_type(4)));
typedef unsigned v2u __attribute__((ext_vector_type(2)));
#define LDS_WAIT() asm volatile("s_waitcnt lgkmcnt(0)" ::: "memory")

#ifndef MK_ONE_LAUNCH
#define MK_ONE_LAUNCH 0
#endif

constexpr int S = 16384, D = 2048, INW = 5376, DFF = 5632, NUP = 2 * DFF, NUPG = NUP + D, PLE = 256, DEPTH = 4;
constexpr float ALPHA = 1.6817928305074290f, LN_EPS = 1e-5f, GN_EPS = 1e-6f;
constexpr int NPH = 11, NPHASES = 1 + DEPTH * NPH;

constexpr size_t MiB = 1u << 20;
constexpr size_t WS_CTL = 0, CTL_ZERO_BYTES = 1 * MiB;
constexpr size_t WS_COSR = 2 * MiB, WS_SINR = 10 * MiB, WS_COSA = 18 * MiB, WS_SINA = 20 * MiB;
constexpr size_t WS_W = 32 * MiB, WL_BYTES = 104 * MiB;
constexpr size_t WL_IN = 0, WL_OUT = 21 * MiB, WL_UP = 29 * MiB, WL_G = 73 * MiB, WL_DOWN = 81 * MiB, WL_P = 103 * MiB;
constexpr size_t WS_XR = 448 * MiB, WS_XB = 576 * MiB, WS_Y = 640 * MiB;
constexpr size_t WS_Q = 768 * MiB, WS_K = 800 * MiB, WS_V = 832 * MiB, WS_G = 864 * MiB, WS_AQ = 896 * MiB, WS_AK = 928 * MiB, WS_AV = 932 * MiB;
constexpr size_t WS_MIX = 936 * MiB, WS_U = 1000 * MiB, WS_PS = 1128 * MiB, WS_RETY = 1160 * MiB;
constexpr size_t WS_H = 768 * MiB, WS_ACT = 1128 * MiB, WS_SG = 1304 * MiB, WS_PB = 1368 * MiB, WS_END = 1400 * MiB;
constexpr int CW_BAR = 4096;

constexpr int RING_BYTES = 131072, LDSCTL_OFF = RING_BYTES, MISC_OFF = LDSCTL_OFF + 320, LDS_BYTES = 147456;

__device__ __forceinline__ unsigned f2bf(float f) { unsigned u = __builtin_bit_cast(unsigned, f); return (u + 0x7fffu + ((u >> 16) & 1u)) >> 16; }
__device__ __forceinline__ unsigned pk2(float lo, float hi) { return f2bf(lo) | (f2bf(hi) << 16); }
__device__ __forceinline__ float bflo(unsigned w) { return __uint_as_float(w << 16); }
__device__ __forceinline__ float bfhi(unsigned w) { return __uint_as_float(w & 0xffff0000u); }
__device__ __forceinline__ float bf1(const bf16* p) { return __uint_as_float(((unsigned)*p) << 16); }

struct Params {
    const float* in[19]; float* out; unsigned char* ws; int ph_lo, ph_hi;
    float invf_ret[128]; float invf_att[32]; float lg2g[4];
};

struct Ctx { int tid, lane, wave, G, bid; unsigned char* ws; };

__device__ __forceinline__ int lane_id_asm() { int l; asm volatile("v_mbcnt_lo_u32_b32 %0, -1, 0\n\tv_mbcnt_hi_u32_b32 %0, -1, %0" : "=v"(l)); return l; }
__device__ __forceinline__ float wave_sum(float v, int lane) {
#pragma unroll
    for (int o = 1; o < 64; o <<= 1) v += __builtin_bit_cast(float, __builtin_amdgcn_ds_bpermute((lane ^ o) << 2, __builtin_bit_cast(int, v)));
    return v;
}
__device__ __forceinline__ void transpose_item(const float* W, int K, int N, int src_col0, bf16* WT, int dst_row0, int k0, LAS float* scr, int lane) {
#pragma unroll 8
    for (int i = 0; i < 32; ++i) { const int kk = 2 * i + (lane >> 5); scr[kk * 33 + (lane & 31)] = W[(size_t)(k0 + kk) * N + src_col0 + (lane & 31)]; }
    LDS_WAIT(); asm volatile("" ::: "memory");
    const int c = lane & 7;
#pragma unroll
    for (int j = 0; j < 4; ++j) { const int n = (lane >> 3) + 8 * j; const LAS float* s = scr + (8 * c) * 33 + n;
        v4u o; o.x = pk2(s[0 * 33], s[1 * 33]); o.y = pk2(s[2 * 33], s[3 * 33]); o.z = pk2(s[4 * 33], s[5 * 33]); o.w = pk2(s[6 * 33], s[7 * 33]);
        *(v4u*)(WT + (size_t)(dst_row0 + n) * K + k0 + 8 * c) = o; }
    LDS_WAIT(); asm volatile("" ::: "memory");
}
__device__ __forceinline__ int win_src_col(int g) {
    const int tile = g >> 3, bj = (g >> 2) & 1, wcg = g & 3;
    if (tile < 16) return 32 * g;
    if (tile < 20) return 4096 + 256 * (tile - 16) + 64 * wcg + 32 * bj;
    return wcg < 2 ? 5120 + 64 * wcg + 32 * bj : 5248 + 32 * (wcg - 2) + 64 * bj;
}
__device__ __forceinline__ int wup_src_col(int g) { const int tile = g >> 3, bj = (g >> 2) & 1, wcg = g & 3; return (bj ? DFF : 0) + 128 * tile + 32 * wcg; }

__device__ __forceinline__ void sincos_d(float angf, float& s, float& c) {
    const double a = (double)angf;
    const double k = __builtin_rint(a * 0.63661977236758134308);
    double r = __builtin_fma(-k, 1.57079632679489661923, a); r = __builtin_fma(-k, 6.123233995736766e-17, r);
    const double r2 = r * r;
    const double sp = r + r * r2 * (-1.0 / 6 + r2 * (1.0 / 120 + r2 * (-1.0 / 5040 + r2 * (1.0 / 362880 + r2 * (-1.0 / 39916800)))));
    const double cp = 1.0 + r2 * (-0.5 + r2 * (1.0 / 24 + r2 * (-1.0 / 720 + r2 * (1.0 / 40320 + r2 * (-1.0 / 3628800 + r2 * (1.0 / 479001600))))));
    const int q = ((int)k) & 3;
    const double sv = (q == 0) ? sp : (q == 1) ? cp : (q == 2) ? -sp : -cp;
    const double cv = (q == 0) ? cp : (q == 1) ? -sp : (q == 2) ? -cp : sp;
    s = (float)sv; c = (float)cv;
}

__device__ __forceinline__ void phase_prologue(const Params& P, const Ctx& cx, LAS unsigned char* lds) {
    unsigned char* ws = cx.ws; const int tid = cx.tid, lane = cx.lane, wave = cx.wave, G = cx.G;
    LAS float* scr = (LAS float*)(lds + wave * 16384);
    const int gw = cx.bid * 8 + wave, NGW = G * 8;
    constexpr int I_IN = 32 * 168, I_OUT = 32 * 64, I_UP = 32 * 352, I_G = 32 * 64, I_DN = 88 * 64, I_P = 4 * 64, I_L = I_IN + I_OUT + I_UP + I_G + I_DN + I_P;
    for (int it = gw; it < DEPTH * I_L; it += NGW) {
        const int l = it / I_L; int r = it - l * I_L;
        bf16* wl = (bf16*)(ws + WS_W + (size_t)l * WL_BYTES);
        if (r < I_IN) { const int kb = r / 168, g = r % 168; transpose_item(P.in[3] + (size_t)l * D * INW, D, INW, win_src_col(g), wl + WL_IN / 2, 32 * g, 64 * kb, scr, lane); continue; } r -= I_IN;
        if (r < I_OUT) { const int kb = r / 64, g = r % 64; transpose_item(P.in[4] + (size_t)l * D * D, D, D, 32 * g, wl + WL_OUT / 2, 32 * g, 64 * kb, scr, lane); continue; } r -= I_OUT;
        if (r < I_UP) { const int kb = r / 352, g = r % 352; transpose_item(P.in[10] + (size_t)l * D * NUP, D, NUP, wup_src_col(g), wl + WL_UP / 2, 32 * g, 64 * kb, scr, lane); continue; } r -= I_UP;
        if (r < I_G) { const int kb = r / 64, g = r % 64; transpose_item(P.in[16] + (size_t)l * D * D, D, D, 32 * g, wl + WL_G / 2, 32 * g, 64 * kb, scr, lane); continue; } r -= I_G;
        if (r < I_DN) { const int kb = r / 64, g = r % 64; transpose_item(P.in[13] + (size_t)l * DFF * D, DFF, D, 32 * g, wl + WL_DOWN / 2, 32 * g, 64 * kb, scr, lane); continue; } r -= I_DN;
        { const int kb = r / 64, g = r % 64; transpose_item(P.in[18] + (size_t)l * PLE * D, PLE, D, 32 * g, wl + WL_P / 2, 32 * g, 64 * kb, scr, lane); }
    }
    const size_t gt = (size_t)cx.bid * 512 + tid, NT = (size_t)G * 512;
    { const float* x = P.in[0]; bf16* xb = (bf16*)(ws + WS_XB);
      for (size_t i = gt; i < (size_t)S * D / 8; i += NT) { const f32x4 a = *(const f32x4*)(x + i * 8), b = *(const f32x4*)(x + i * 8 + 4);
          v4u o; o.x = pk2(a[0], a[1]); o.y = pk2(a[2], a[3]); o.z = pk2(b[0], b[1]); o.w = pk2(b[2], b[3]); *(v4u*)(xb + i * 8) = o; } }
    { const float* p = P.in[1]; bf16* pb = (bf16*)(ws + WS_PB);
      for (size_t i = gt; i < (size_t)DEPTH * S * PLE / 8; i += NT) { const f32x4 a = *(const f32x4*)(p + i * 8), b = *(const f32x4*)(p + i * 8 + 4);
          v4u o; o.x = pk2(a[0], a[1]); o.y = pk2(a[2], a[3]); o.z = pk2(b[0], b[1]); o.w = pk2(b[2], b[3]); *(v4u*)(pb + i * 8) = o; } }
    { const int* pos = (const int*)P.in[2]; float* cosr = (float*)(ws + WS_COSR); float* sinr = (float*)(ws + WS_SINR); float* cosa = (float*)(ws + WS_COSA); float* sina = (float*)(ws + WS_SINA);
      for (size_t i = gt; i < (size_t)S * 128; i += NT) { const int t = (int)(i >> 7), f = (int)(i & 127); float s, c; sincos_d((float)pos[t] * P.invf_ret[f], s, c); cosr[i] = c; sinr[i] = s; }
      for (size_t i = gt; i < (size_t)S * 32; i += NT) { const int t = (int)(i >> 5), f = (int)(i & 31); float s, c; sincos_d((float)pos[t] * P.invf_att[f], s, c); cosa[i] = c; sina[i] = s; } }
}

template <int MT, int NT_, int KK, bool A_KFAST, bool B_NFAST, class FA, class FB, class FC>
__device__ __forceinline__ void simple_gemm(LAS unsigned char* lds, int nbatch, int tid, int G, int bid, const FA& fa, const FB& fb, const FC& fc) {
    LAS float* As = (LAS float*)lds;
    LAS float* Bs = (LAS float*)(lds + 16 * 132 * 4);
    constexpr int TM = MT / 128, TN = NT_ / 64, ITEMS_PER_B = TM * TN;
    const int tm = tid & 31, tn = tid >> 5;
    for (int item = bid; item < nbatch * ITEMS_PER_B; item += G) {
        const int b = item / ITEMS_PER_B, r = item % ITEMS_PER_B, m0 = (r / TN) * 128, n0 = (r % TN) * 64;
        float c[4][4];
#pragma unroll
        for (int i = 0; i < 4; ++i)
#pragma unroll
            for (int j = 0; j < 4; ++j) c[i][j] = 0.f;
        for (int k0 = 0; k0 < KK; k0 += 16) {
#pragma unroll
            for (int rr = 0; rr < 4; ++rr) { const int e = tid + 512 * rr; int m, k; if (A_KFAST) { k = e & 15; m = e >> 4; } else { m = e & 127; k = e >> 7; }
                As[k * 132 + m] = fa(b, m0 + m, k0 + k); }
#pragma unroll
            for (int rr = 0; rr < 2; ++rr) { const int e = tid + 512 * rr; int n, k; if (B_NFAST) { n = e & 63; k = e >> 6; } else { k = e & 15; n = e >> 4; }
                Bs[k * 68 + n] = fb(b, k0 + k, n0 + n); }
            __syncthreads();
#pragma unroll
            for (int kk = 0; kk < 16; ++kk) { const f32x4 a = *(const LAS f32x4*)(As + kk * 132 + 4 * tm), bb = *(const LAS f32x4*)(Bs + kk * 68 + 4 * tn);
#pragma unroll
                for (int i = 0; i < 4; ++i)
#pragma unroll
                    for (int j = 0; j < 4; ++j) c[i][j] += a[i] * bb[j]; }
            __syncthreads();
        }
#pragma unroll
        for (int i = 0; i < 4; ++i)
#pragma unroll
            for (int j = 0; j < 4; ++j) fc(b, m0 + 4 * tm + i, n0 + 4 * tn + j, c[i][j]);
    }
}

__device__ __forceinline__ void phase_swa(const Params& P, const Ctx& cx, int l, LAS unsigned char* lds) {
    unsigned char* ws = cx.ws; const int tid = cx.tid, G = cx.G;
    const bf16* AQ = (const bf16*)(ws + WS_AQ); const bf16* AK = (const bf16*)(ws + WS_AK); const bf16* AV = (const bf16*)(ws + WS_AV); bf16* MIX = (bf16*)(ws + WS_MIX);
    const float* sinks = P.in[7] + l * 16;
    LAS unsigned* Ks = (LAS unsigned*)lds;
    LAS unsigned* Vs = (LAS unsigned*)(lds + 256 * 33 * 4);
    for (int item = cx.bid; item < 256; item += G) {
        const int nb = item >> 1, hk = item & 1;
        __syncthreads();
        for (int e = tid; e < 256 * 32; e += 512) { const int r = e >> 5, cdw = e & 31; const int gk = nb * 128 - 128 + r;
            unsigned kv = 0u, vv = 0u; if (gk >= 0) { kv = *(const unsigned*)(AK + (size_t)gk * 128 + hk * 64 + 2 * cdw); vv = *(const unsigned*)(AV + (size_t)gk * 128 + hk * 64 + 2 * cdw); }
            Ks[r * 33 + cdw] = kv; Vs[r * 33 + cdw] = vv; }
        __syncthreads();
#pragma unroll 1
        for (int rep = 0; rep < 2; ++rep) {
            const int pair = tid + 512 * rep, i = pair & 127, g = pair >> 7, hq = hk * 8 + g; const int row = nb * 128 + i;
            float q[64], o[64];
            { const v4u* qp = (const v4u*)(AQ + (size_t)row * 1024 + hq * 64);
#pragma unroll
              for (int c8 = 0; c8 < 8; ++c8) { const v4u w = qp[c8]; q[8 * c8 + 0] = bflo(w.x); q[8 * c8 + 1] = bfhi(w.x); q[8 * c8 + 2] = bflo(w.y); q[8 * c8 + 3] = bfhi(w.y); q[8 * c8 + 4] = bflo(w.z); q[8 * c8 + 5] = bfhi(w.z); q[8 * c8 + 6] = bflo(w.w); q[8 * c8 + 7] = bfhi(w.w); } }
#pragma unroll
            for (int d = 0; d < 64; ++d) o[d] = 0.f;
            float mx = sinks[hq], den = 1.0f;
            const int jj0 = (nb == 0) ? (127 - i) : 0;
            for (int jj = jj0; jj < 128; ++jj) { const int kl = i + 1 + jj;
                float s = 0.f;
#pragma unroll
                for (int c = 0; c < 32; ++c) { const unsigned w = Ks[kl * 33 + c]; s += q[2 * c] * bflo(w) + q[2 * c + 1] * bfhi(w); }
                const float mn = fmaxf(mx, s), sc = __expf(mx - mn), p = __expf(s - mn);
                den = den * sc + p; mx = mn;
#pragma unroll
                for (int c = 0; c < 32; ++c) { const unsigned w = Vs[kl * 33 + c]; o[2 * c] = o[2 * c] * sc + p * bflo(w); o[2 * c + 1] = o[2 * c + 1] * sc + p * bfhi(w); }
            }
            const float inv = 1.0f / den;
            v4u* op = (v4u*)(MIX + (size_t)row * 2048 + 1024 + hq * 64);
#pragma unroll
            for (int c8 = 0; c8 < 8; ++c8) { v4u w; w.x = pk2(o[8 * c8] * inv, o[8 * c8 + 1] * inv); w.y = pk2(o[8 * c8 + 2] * inv, o[8 * c8 + 3] * inv); w.z = pk2(o[8 * c8 + 4] * inv, o[8 * c8 + 5] * inv); w.w = pk2(o[8 * c8 + 6] * inv, o[8 * c8 + 7] * inv); op[c8] = w; }
        }
    }
}

__device__ __forceinline__ void phase_ret_u_scores(const Params& P, const Ctx& cx, LAS unsigned char* lds) {
    unsigned char* ws = cx.ws; const int tid = cx.tid, G = cx.G;
    const bf16* Q = (const bf16*)(ws + WS_Q); const bf16* K = (const bf16*)(ws + WS_K); const bf16* V = (const bf16*)(ws + WS_V);
    float* U = (float*)(ws + WS_U); float* PS = (float*)(ws + WS_PS);
    const float lg0 = P.lg2g[0], lg1 = P.lg2g[1], lg2 = P.lg2g[2], lg3 = P.lg2g[3];
    auto lgh = [=](int h) { return h == 0 ? lg0 : h == 1 ? lg1 : h == 2 ? lg2 : lg3; };
    simple_gemm<256, 256, 128, false, true>(lds, 512, tid, G, cx.bid,
        [=](int b, int m, int k) { const int nb = b >> 2, h = b & 3; return bf1(K + (size_t)(nb * 128 + k) * 1024 + h * 256 + m) * exp2f(lgh(h) * (float)(127 - k)); },
        [=](int b, int k, int n) { const int nb = b >> 2, h = b & 3; return bf1(V + (size_t)(nb * 128 + k) * 1024 + h * 256 + n); },
        [=](int b, int m, int n, float v) { U[((size_t)b * 256 + m) * 256 + n] = v; });
    simple_gemm<128, 128, 256, true, false>(lds, 512, tid, G, cx.bid,
        [=](int b, int m, int k) { const int nb = b >> 2, h = b & 3; return bf1(Q + (size_t)(nb * 128 + m) * 1024 + h * 256 + k); },
        [=](int b, int k, int n) { const int nb = b >> 2, h = b & 3; return bf1(K + (size_t)(nb * 128 + n) * 1024 + h * 256 + k); },
        [=](int b, int m, int n, float v) { const int h = b & 3; PS[((size_t)b * 128 + m) * 128 + n] = (m >= n) ? v * exp2f(lgh(h) * (float)(m - n)) : 0.f; });
}
__device__ __forceinline__ void phase_scan(const Params& P, const Ctx& cx) {
    float* U = (float*)(cx.ws + WS_U);
    const size_t gt = (size_t)cx.bid * 512 + cx.tid, NT = (size_t)cx.G * 512;
    for (size_t idx = gt; idx < 4 * 65536; idx += NT) {
        const int h = (int)(idx >> 16); const float cd = exp2f(P.lg2g[h] * 128.0f);
        float r = 0.f;
        for (int n0 = 0; n0 < 128; n0 += 8) { float u[8];
#pragma unroll
            for (int j = 0; j < 8; ++j) u[j] = U[(size_t)(n0 + j) * 262144 + idx];
#pragma unroll
            for (int j = 0; j < 8; ++j) { U[(size_t)(n0 + j) * 262144 + idx] = r; r = r * cd + u[j]; } }
    }
}
__device__ __forceinline__ void phase_ret_out(const Params& P, const Ctx& cx, LAS unsigned char* lds) {
    unsigned char* ws = cx.ws; const int tid = cx.tid, G = cx.G;
    const bf16* Q = (const bf16*)(ws + WS_Q); const bf16* V = (const bf16*)(ws + WS_V);
    const float* Sst = (const float*)(ws + WS_U); const float* PS = (const float*)(ws + WS_PS); float* RY = (float*)(ws + WS_RETY);
    const float lg0 = P.lg2g[0], lg1 = P.lg2g[1], lg2 = P.lg2g[2], lg3 = P.lg2g[3];
    auto lgh = [=](int h) { return h == 0 ? lg0 : h == 1 ? lg1 : h == 2 ? lg2 : lg3; };
    simple_gemm<128, 256, 384, true, true>(lds, 512, tid, G, cx.bid,
        [=](int b, int m, int k) { const int nb = b >> 2, h = b & 3; return k < 128 ? PS[((size_t)b * 128 + m) * 128 + k] : bf1(Q + (size_t)(nb * 128 + m) * 1024 + h * 256 + (k - 128)) * exp2f(lgh(h) * (float)(m + 1)); },
        [=](int b, int k, int n) { const int nb = b >> 2, h = b & 3; return k < 128 ? bf1(V + (size_t)(nb * 128 + k) * 1024 + h * 256 + n) : Sst[((size_t)b * 256 + (k - 128)) * 256 + n]; },
        [=](int b, int m, int n, float v) { const int nb = b >> 2, h = b & 3; RY[(size_t)(nb * 128 + m) * 1024 + h * 256 + n] = v; });
}
__device__ __forceinline__ void phase_groupnorm(const Params& P, const Ctx& cx, int l) {
    unsigned char* ws = cx.ws; const int lane = cx.lane, wave = cx.wave, G = cx.G;
    const float* RY = (const float*)(ws + WS_RETY); const bf16* Gt = (const bf16*)(ws + WS_G); bf16* MIX = (bf16*)(ws + WS_MIX);
    const float* gg = P.in[5] + l * 1024; const float* gb = P.in[6] + l * 1024;
    const int gw = cx.bid * 8 + wave, NGW = G * 8;
    for (int it = gw; it < S * 4; it += NGW) { const int row = it >> 2, h = it & 3; const size_t off = (size_t)row * 1024 + h * 256 + 4 * lane;
        f32x4 v = *(const f32x4*)(RY + off);
        const float mean = wave_sum((v[0] + v[1]) + (v[2] + v[3]), lane) * (1.0f / 256.0f);
        v = v - mean;
        const float var = wave_sum((v[0] * v[0] + v[1] * v[1]) + (v[2] * v[2] + v[3] * v[3]), lane) * (1.0f / 256.0f);
        const float rstd = 1.0f / sqrtf(var + GN_EPS);
        const f32x4 g4 = *(const f32x4*)(gg + h * 256 + 4 * lane), b4 = *(const f32x4*)(gb + h * 256 + 4 * lane);
        const v2u gt2 = *(const v2u*)(Gt + off);
        f32x4 o = v * rstd * g4 + b4;
        o[0] *= bflo(gt2.x); o[1] *= bfhi(gt2.x); o[2] *= bflo(gt2.y); o[3] *= bfhi(gt2.y);
        v2u w; w.x = pk2(o[0], o[1]); w.y = pk2(o[2], o[3]);
        *(v2u*)(MIX + (size_t)row * 2048 + h * 256 + 4 * lane) = w; }
}
__device__ __forceinline__ void phase_ln(const Ctx& cx, const float* Y, const float* g, const float* b, float* xo, bf16* xb) {
    const int lane = cx.lane, wave = cx.wave, G = cx.G; const int gw = cx.bid * 8 + wave, NGW = G * 8;
    for (int row = gw; row < S; row += NGW) {
        const f32x4* yr = (const f32x4*)(Y + (size_t)row * D) + lane;
        f32x4 v[8]; float s = 0.f;
#pragma unroll
        for (int j = 0; j < 8; ++j) { v[j] = yr[64 * j]; s += (v[j][0] + v[j][1]) + (v[j][2] + v[j][3]); }
        const float mean = wave_sum(s, lane) * (1.0f / D); float s2 = 0.f;
#pragma unroll
        for (int j = 0; j < 8; ++j) { v[j] = v[j] - mean; s2 += (v[j][0] * v[j][0] + v[j][1] * v[j][1]) + (v[j][2] * v[j][2] + v[j][3] * v[j][3]); }
        const float rstd = 1.0f / sqrtf(wave_sum(s2, lane) * (1.0f / D) + LN_EPS);
        f32x4* xr = (f32x4*)(xo + (size_t)row * D) + lane;
#pragma unroll
        for (int j = 0; j < 8; ++j) { const f32x4 g4 = ((const f32x4*)g)[64 * j + lane], b4 = ((const f32x4*)b)[64 * j + lane]; const f32x4 o = v[j] * rstd * g4 + b4; xr[64 * j] = o;
            if (xb) { v2u w; w.x = pk2(o[0], o[1]); w.y = pk2(o[2], o[3]); ((v2u*)(xb + (size_t)row * D))[64 * j + lane] = w; } }
    }
}
__device__ __forceinline__ void phase_convact(const Params& P, const Ctx& cx, int l) {
    unsigned char* ws = cx.ws; const int tid = cx.tid, G = cx.G;
    const bf16* H = (const bf16*)(ws + WS_H); bf16* ACT = (bf16*)(ws + WS_ACT);
    const float* cw = P.in[11] + (size_t)l * 3 * NUP; const float* cb = P.in[12] + (size_t)l * NUP;
    const size_t gt = (size_t)cx.bid * 512 + tid, NT = (size_t)G * 512;
    for (size_t idx = gt; idx < (size_t)S * 704; idx += NT) {
        const int t = (int)(idx / 704), r = (int)(idx % 704), tile = r >> 4, q8 = r & 15;
        const int chg = 128 * tile + 8 * q8, chu = DFF + chg;
        float ag[8], au[8];
#pragma unroll
        for (int e = 0; e < 8; ++e) { ag[e] = cb[chg + e]; au[e] = cb[chu + e]; }
#pragma unroll
        for (int k = 0; k < 3; ++k) { const int tt = t - 2 + k; if (tt >= 0) {
            const v4u hg = *(const v4u*)(H + (size_t)tt * NUP + 256 * tile + 8 * q8), hu = *(const v4u*)(H + (size_t)tt * NUP + 256 * tile + 128 + 8 * q8);
            const float g8[8] = {bflo(hg.x), bfhi(hg.x), bflo(hg.y), bfhi(hg.y), bflo(hg.z), bfhi(hg.z), bflo(hg.w), bfhi(hg.w)};
            const float u8[8] = {bflo(hu.x), bfhi(hu.x), bflo(hu.y), bfhi(hu.y), bflo(hu.z), bfhi(hu.z), bflo(hu.w), bfhi(hu.w)};
#pragma unroll
            for (int e = 0; e < 8; ++e) { ag[e] += cw[(size_t)k * NUP + chg + e] * g8[e]; au[e] += cw[(size_t)k * NUP + chu + e] * u8[e]; } } }
        float o[8];
#pragma unroll
        for (int e = 0; e < 8; ++e) o[e] = ag[e] / (1.0f + __expf(-ag[e])) * au[e];
        v4u w; w.x = pk2(o[0], o[1]); w.y = pk2(o[2], o[3]); w.z = pk2(o[4], o[5]); w.w = pk2(o[6], o[7]);
        *(v4u*)(ACT + (size_t)t * DFF + chg) = w;
    }
}

#ifdef DBG_DUMP
__device__ __forceinline__ void phase_dump(const Ctx& cx, float* out, const bf16* a, int lda, const bf16* b, int ldb, const float* f) {
    const size_t gt = (size_t)cx.bid * 512 + cx.tid, NT = (size_t)cx.G * 512;
    for (size_t i = gt; i < (size_t)S * D; i += NT) { const int row = (int)(i >> 11), col = (int)(i & 2047);
        float v; if (f) v = f[i]; else if (b && col >= 1024) v = bf1(b + (size_t)row * ldb + (col - 1024)); else v = lda ? bf1(a + (size_t)row * lda + col) : bf1(a + (size_t)(row & 2047) * 2048 + col);
        out[i] = v; }
}
#endif
__global__ void __launch_bounds__(512, 2) fwd(Params P) {
    extern __shared__ __attribute__((aligned(16))) unsigned char lds_raw[];
    LAS unsigned char* lds = (LAS unsigned char*)lds_raw;
    const int wave = __builtin_amdgcn_readfirstlane(threadIdx.x >> 6), G = gridDim.x;
    unsigned char* ws = P.ws;
    volatile LAS unsigned* MISC = (volatile LAS unsigned*)(lds + MISC_OFF);
    for (int u = threadIdx.x; u < (LDS_BYTES - LDSCTL_OFF) / 4; u += 512) ((LAS unsigned*)(lds + LDSCTL_OFF))[u] = 0u;
    __syncthreads();
    const int lo = P.ph_lo, hi = P.ph_hi;
    XcdBarrier bar; bar.bar = (unsigned*)(ws + WS_CTL) + CW_BAR; bar.x = 0; bar.st = nullptr;
    if (hi - lo > 1) bar = xcd_barrier_post((unsigned*)(ws + WS_CTL) + CW_BAR, MISC + 8);
#define IN(k) (lo <= (k) && (k) < hi)
#define SEAM(k) do { if (IN(k) && IN((k) + 1)) xcd_barrier(bar); } while (0)
#define OPQ() Ctx cx; cx.lane = lane_id_asm(); { int t_ = wave; asm volatile("" : "+s"(t_)); cx.wave = t_; } { int t_ = G; asm volatile("" : "+s"(t_)); cx.G = t_; } { int t_ = blockIdx.x; asm volatile("" : "+s"(t_)); cx.bid = t_; } \
    { unsigned t_ = 0u; asm volatile("" : "+s"(t_)); cx.ws = P.ws + t_; } cx.tid = cx.wave * 64 + cx.lane; int lq = l; asm volatile("" : "+s"(lq)); (void)lq

#ifdef DBG_DUMP
    if (lo >= 1000) { const int l = 0; OPQ(); unsigned char* w = cx.ws; const int kind = lo - 1000;
        if (kind == 1) phase_dump(cx, P.out, (const bf16*)(w + WS_Q), 1024, (const bf16*)(w + WS_AQ), 1024, nullptr);
        else if (kind == 2) phase_dump(cx, P.out, (const bf16*)(w + WS_MIX), 2048, nullptr, 0, nullptr);
        else if (kind == 3) phase_dump(cx, P.out, nullptr, 0, nullptr, 0, (const float*)(w + WS_XR));
        else if (kind == 4) phase_dump(cx, P.out, (const bf16*)(w + WS_ACT), DFF, nullptr, 0, nullptr);
        else if (kind == 5) phase_dump(cx, P.out, nullptr, 0, nullptr, 0, (const float*)(w + WS_Y));
        else if (kind == 6) phase_dump(cx, P.out, (const bf16*)(w + WS_K), 1024, (const bf16*)(w + WS_V), 1024, nullptr);
        else if (kind == 7) phase_dump(cx, P.out, (const bf16*)(w + WS_XB), 2048, nullptr, 0, nullptr);
        else if (kind == 11) phase_dump(cx, P.out, (const bf16*)(w + WS_W + WL_G), 0, nullptr, 0, nullptr);
        else if (kind == 12) phase_dump(cx, P.out, (const bf16*)(w + WS_W + WL_OUT), 0, nullptr, 0, nullptr);
        else if (kind == 10) phase_dump(cx, P.out, (const bf16*)(w + WS_H) + 36 * 256, NUP, nullptr, 0, nullptr);
        else if (kind == 9) phase_dump(cx, P.out, (const bf16*)(w + WS_SG), 2048, nullptr, 0, nullptr);
        else if (kind == 8) phase_dump(cx, P.out, nullptr, 0, nullptr, 0, (const float*)(w + WS_RETY));
        return; }
#endif
    if (IN(0)) { const int l = 0; OPQ(); phase_prologue(P, cx, lds); }
    SEAM(0);

    for (int l = 0; l < DEPTH; ++l) {
        const int pb = 1 + l * NPH;
        if (IN(pb + 0)) { OPQ(); unsigned char* w = cx.ws; const bf16* wl = (const bf16*)(w + WS_W + (size_t)lq * WL_BYTES);
            pg8::Gemm g{(const bf16*)(w + WS_XB), wl + WL_IN / 2, S, INW, D}; pg8::StaticOrder So; So.init(S, INW, cx.G, cx.bid);
            pg8::EpiInProj E{(bf16*)(w + WS_Q), (bf16*)(w + WS_K), (bf16*)(w + WS_V), (bf16*)(w + WS_G), (bf16*)(w + WS_AQ), (bf16*)(w + WS_AK), (bf16*)(w + WS_AV),
                             (const float*)(w + WS_COSR), (const float*)(w + WS_SINR), (const float*)(w + WS_COSA), (const float*)(w + WS_SINA)};
            pg8::gemm_phase<pg8::EpiInProj, pg8::StaticOrder, true, true>(lds, g, So, E, cx.wave);
        }
        SEAM(pb + 0);
        if (IN(pb + 1)) { { OPQ(); phase_ret_u_scores(P, cx, lds); } { OPQ(); phase_swa(P, cx, lq, lds); } }
        SEAM(pb + 1);
        if (IN(pb + 2)) { OPQ(); phase_scan(P, cx); }
        SEAM(pb + 2);
        if (IN(pb + 3)) { OPQ(); phase_ret_out(P, cx, lds); }
        SEAM(pb + 3);
        if (IN(pb + 4)) { OPQ(); phase_groupnorm(P, cx, lq); }
        SEAM(pb + 4);
        if (IN(pb + 5)) { OPQ(); unsigned char* w = cx.ws; const bf16* wl = (const bf16*)(w + WS_W + (size_t)lq * WL_BYTES);
            pg8::Gemm g{(const bf16*)(w + WS_MIX), wl + WL_OUT / 2, S, D, D}; pg8::StaticOrder So; So.init(S, D, cx.G, cx.bid);
            pg8::EpiResid<false> E{(lq == 0) ? P.in[0] : (const float*)(w + WS_XR), (float*)(w + WS_Y), ALPHA};
            pg8::gemm_phase<pg8::EpiResid<false>, pg8::StaticOrder, true, true>(lds, g, So, E, cx.wave);
        }
        SEAM(pb + 5);
        if (IN(pb + 6)) { OPQ(); unsigned char* w = cx.ws; phase_ln(cx, (const float*)(w + WS_Y), P.in[8] + lq * D, P.in[9] + lq * D, (float*)(w + WS_XR), (bf16*)(w + WS_XB)); }
        SEAM(pb + 6);
        if (IN(pb + 7)) { OPQ(); unsigned char* w = cx.ws; const bf16* wl = (const bf16*)(w + WS_W + (size_t)lq * WL_BYTES);
            pg8::Gemm g{(const bf16*)(w + WS_XB), wl + WL_UP / 2, S, NUPG, D}; pg8::StaticOrder So; So.init(S, NUPG, cx.G, cx.bid);
            pg8::EpiUp E{(bf16*)(w + WS_H), (bf16*)(w + WS_SG), P.in[17] + lq * D};
            pg8::gemm_phase<pg8::EpiUp, pg8::StaticOrder, true, true>(lds, g, So, E, cx.wave);
        }
        SEAM(pb + 7);
        if (IN(pb + 8)) {
            { OPQ(); unsigned char* w = cx.ws; const bf16* wl = (const bf16*)(w + WS_W + (size_t)lq * WL_BYTES);
              pg8::Gemm g{(const bf16*)(w + WS_PB) + (size_t)lq * S * PLE, wl + WL_P / 2, S, D, PLE}; pg8::StaticOrder So; So.init(S, D, cx.G, cx.bid);
              pg8::EpiPle E{(const bf16*)(w + WS_SG), (float*)(w + WS_Y)};
              pg8::gemm_phase<pg8::EpiPle, pg8::StaticOrder, true, true>(lds, g, So, E, cx.wave); }
            { OPQ(); phase_convact(P, cx, lq); }
        }
        SEAM(pb + 8);
        if (IN(pb + 9)) { OPQ(); unsigned char* w = cx.ws; const bf16* wl = (const bf16*)(w + WS_W + (size_t)lq * WL_BYTES);
            pg8::Gemm g{(const bf16*)(w + WS_ACT), wl + WL_DOWN / 2, S, D, DFF}; pg8::StaticOrder So; So.init(S, D, cx.G, cx.bid);
            pg8::EpiResid<true> E{(const float*)(w + WS_XR), (float*)(w + WS_Y), ALPHA};
            pg8::gemm_phase<pg8::EpiResid<true>, pg8::StaticOrder, true, true>(lds, g, So, E, cx.wave);
        }
        SEAM(pb + 9);
        if (IN(pb + 10)) { OPQ(); unsigned char* w = cx.ws; const bool last = (lq == DEPTH - 1);
            phase_ln(cx, (const float*)(w + WS_Y), P.in[14] + lq * D, P.in[15] + lq * D, last ? P.out : (float*)(w + WS_XR), last ? (bf16*)nullptr : (bf16*)(w + WS_XB)); }
        SEAM(pb + 10);
    }
#undef IN
#undef SEAM
}

extern "C" void kernel_launch(void* const* d_in, const int* in_sizes, int n_in, void* d_out, int out_size, void* d_ws, size_t ws_size, hipStream_t stream) {
    static int grid = 0;
    if (grid == 0) {
        if (n_in != 19 || in_sizes[0] != S * D || out_size != S * D || ws_size < WS_END) { fprintf(stderr, "kernel_launch: unexpected shapes (n_in %d, in0 %d, out %d, ws %zu)\n", n_in, n_in > 0 ? in_sizes[0] : -1, out_size, ws_size); grid = -1; return; }
        int dev = 0, cus = 0, per_cu = 0;
        if (hipGetDevice(&dev) != hipSuccess || hipDeviceGetAttribute(&cus, hipDeviceAttributeMultiprocessorCount, dev) != hipSuccess) { grid = -1; return; }
        if (hipFuncSetAttribute((const void*)fwd, hipFuncAttributeMaxDynamicSharedMemorySize, LDS_BYTES) != hipSuccess) { fprintf(stderr, "kernel_launch: hipFuncSetAttribute failed\n"); grid = -1; return; }
        if (hipOccupancyMaxActiveBlocksPerMultiprocessor(&per_cu, (const void*)fwd, 512, LDS_BYTES) != hipSuccess || per_cu < 1) fprintf(stderr, "kernel_launch: occupancy query says %d\n", per_cu);
        (void)hipGetLastError();
        grid = cus;
    }
    if (grid < 0) return;
    (void)hipMemsetAsync((char*)d_ws + WS_CTL, 0, CTL_ZERO_BYTES, stream);
#ifdef DBG_NANFILL
    (void)hipMemsetAsync((char*)d_ws + CTL_ZERO_BYTES, 0xFF, WS_END - CTL_ZERO_BYTES, stream);
#endif
    Params p{};
    for (int i = 0; i < 19; ++i) p.in[i] = (const float*)d_in[i];
    p.out = (float*)d_out; p.ws = (unsigned char*)d_ws;
    for (int f = 0; f < 128; ++f) p.invf_ret[f] = (float)(1.0 / std::pow(10000.0, (double)((float)f / 127.0f)));
    for (int f = 0; f < 32; ++f) p.invf_att[f] = (float)std::pow(10000.0, -(double)(2 * f) / 64.0);
    for (int h = 0; h < 4; ++h) p.lg2g[h] = (float)std::log2(1.0 - std::exp2(-5.0 - h));
#if MK_ONE_LAUNCH
    p.ph_lo = 0; p.ph_hi = NPHASES;
    hipLaunchKernelGGL(fwd, dim3(grid), dim3(512), LDS_BYTES, stream, p);
#else
#ifdef DBG_DUMP
    for (int ph = 0; ph <= DBG_STOP; ++ph) { p.ph_lo = ph; p.ph_hi = ph + 1; hipLaunchKernelGGL(fwd, dim3(grid), dim3(512), LDS_BYTES, stream, p); }
    p.ph_lo = 1000 + DBG_DUMP; p.ph_hi = p.ph_lo + 1; hipLaunchKernelGGL(fwd, dim3(grid), dim3(512), LDS_BYTES, stream, p);
#else
    for (int ph = 0; ph < NPHASES; ++ph) { p.ph_lo = ph; p.ph_hi = ph + 1; hipLaunchKernelGGL(fwd, dim3(grid), dim3(512), LDS_BYTES, stream, p); }
#endif
#endif
}
```

```cpp
#include <hip/hip_runtime.h>
#include <cstdio>
#include <cstdint>
#include <cmath>
#define MK_ONE_LAUNCH 1
namespace pg8 {
#define PG8_LAS __attribute__((address_space(3)))
typedef unsigned short bf16_t;
typedef short bf16x8 __attribute__((ext_vector_type(8)));
typedef float f32x4 __attribute__((ext_vector_type(4)));
typedef unsigned u32x4 __attribute__((ext_vector_type(4)));
constexpr int BM = 256, BK = 64, HALF = 128, HTB = HALF * BK * 2  , STAGE_BYTES = 8 * HTB, NXCD = 8, WGM = 8;

__host__ __device__ __forceinline__ int lds_byte(int r, int c) { const int st = (r >> 4) * 2 + (c >> 5), rr = r & 15, cc = c & 31, ob = rr * 64 + cc * 2; return st * 1024 + (ob ^ (((ob >> 9) & 1) << 5)); }
__host__ __device__ __forceinline__ void stage_rc(int b, int& R, int& C) { const int st = b / 1024, sb = b % 1024, swz = sb ^ (((sb >> 9) & 1) << 5); R = (st >> 1) * 16 + swz / 64; C = (st & 1) * 32 + (swz % 64) / 2; }
__host__ __device__ __forceinline__ int perm32(int rho) { const int n = rho >> 4, i = rho & 15; return 8 * (i >> 2) + 4 * n + (i & 3); }

struct Unit { int pm, pn; };
struct Gemm { const bf16_t* A; const bf16_t* Bt; int M, N, K; };

struct StaticOrder {
    int nM, nN, nwg, G, c;
    __host__ __device__ void init(int M, int N, int G_, int c_) { nM = M / BM; nN = N / BM; nwg = nM * nN; G = G_; c = c_; }
    __host__ __device__ bool next(int i, Unit& u) const {
        const long L = (long)i * G + c; if (L >= nwg) return false;
        int wgid = (int)L; { const int q = nwg / NXCD, r = nwg % NXCD, xcd = wgid % NXCD, off = wgid / NXCD; wgid = (xcd < r ? xcd * (q + 1) : r * (q + 1) + (xcd - r) * q) + off; }
        const int nig = WGM * nN, gid = wgid / nig, fm = gid * WGM, gsz = (nM - fm) < WGM ? (nM - fm) : WGM;
        u.pm = fm + ((wgid % nig) % gsz); u.pn = (wgid % nig) / gsz; return true;
    }
    __device__ __forceinline__ void a_ready(const Unit&) const {}
    __device__ __forceinline__ void done(const Unit&) const {}
};

typedef float f32x2c_t __attribute__((ext_vector_type(2))); typedef __bf16 bf16x2c_t __attribute__((ext_vector_type(2)));
__device__ __forceinline__ unsigned cvt_pk_bf16(float lo, float hi) { f32x2c_t v = {lo, hi}; bf16x2c_t b = __builtin_convertvector(v, bf16x2c_t); return __builtin_bit_cast(unsigned, b); }
typedef float f32x2 __attribute__((ext_vector_type(2)));
typedef unsigned u32x2 __attribute__((ext_vector_type(2)));
__device__ __forceinline__ float bf2f(unsigned short b) { return __uint_as_float(((unsigned)b) << 16); }
__device__ __forceinline__ u32x4 pack8(const f32x4 a, const f32x4 b) { u32x4 w; w.x = cvt_pk_bf16(a[0], a[1]); w.y = cvt_pk_bf16(a[2], a[3]); w.z = cvt_pk_bf16(b[0], b[1]); w.w = cvt_pk_bf16(b[2], b[3]); return w; }
__device__ __forceinline__ float sigmoidf_(float x) { return __builtin_amdgcn_rcpf(1.0f + __expf(-x)); }

struct EpiInProj {
    static constexpr bool PERM = true, AFTER_DRAIN = false;
    bf16_t *Q, *K, *V, *G, *AQ, *AK, *AV; const float *cosr, *sinr, *cosa, *sina;
    __device__ __forceinline__ void operator()(const f32x4 (&acc)[2][2][4][2], const Unit& u, int wr, int wc, int fr, int fq) const {
        const int row0 = u.pm * BM + wr * 64 + fr, pn = u.pn, cw = wc * 32 + 8 * fq;
        if (pn < 8) {
            bf16_t* O = pn < 4 ? Q : K; const int hcol = (pn & 3) * 256; const float sc = pn < 4 ? 1.0f : 0.0625f;
#pragma unroll
            for (int ai = 0; ai < 2; ++ai)
#pragma unroll
                for (int m = 0; m < 4; ++m) { const int row = row0 + ai * HALF + m * 16;
                    const f32x4 c0 = *(const f32x4*)(cosr + (size_t)row * 128 + cw), c1 = *(const f32x4*)(cosr + (size_t)row * 128 + cw + 4);
                    const f32x4 s0 = *(const f32x4*)(sinr + (size_t)row * 128 + cw), s1 = *(const f32x4*)(sinr + (size_t)row * 128 + cw + 4);
                    const f32x4 a0 = acc[ai][0][m][0], a1 = acc[ai][0][m][1], b0 = acc[ai][1][m][0], b1 = acc[ai][1][m][1];
                    const f32x4 o10 = (a0 * c0 - b0 * s0) * sc, o11 = (a1 * c1 - b1 * s1) * sc, o20 = (a0 * s0 + b0 * c0) * sc, o21 = (a1 * s1 + b1 * c1) * sc;
                    bf16_t* rowp = O + (size_t)row * 1024 + hcol + cw;
                    *(u32x4*)(rowp) = pack8(o10, o11); *(u32x4*)(rowp + HALF) = pack8(o20, o21); }
        } else if (pn < 16) {
            const bool gate = pn >= 12; bf16_t* O = gate ? G : V; const int hcol = (pn & 3) * 256;
#pragma unroll
            for (int ai = 0; ai < 2; ++ai)
#pragma unroll
                for (int m = 0; m < 4; ++m) { const int row = row0 + ai * HALF + m * 16; bf16_t* rowp = O + (size_t)row * 1024 + hcol + cw;
#pragma unroll
                    for (int bj = 0; bj < 2; ++bj) { f32x4 v0 = acc[ai][bj][m][0], v1 = acc[ai][bj][m][1];
                        if (gate) {
#pragma unroll
                            for (int j = 0; j < 4; ++j) { v0[j] = v0[j] * sigmoidf_(v0[j]); v1[j] = v1[j] * sigmoidf_(v1[j]); } }
                        *(u32x4*)(rowp + bj * HALF) = pack8(v0, v1); } }
        } else if (pn < 20) {
            const int t = pn - 16, i0 = 8 * fq;
#pragma unroll
            for (int ai = 0; ai < 2; ++ai)
#pragma unroll
                for (int m = 0; m < 4; ++m) { const int row = row0 + ai * HALF + m * 16;
                    const f32x4 c0 = *(const f32x4*)(cosa + (size_t)row * 32 + i0), c1 = *(const f32x4*)(cosa + (size_t)row * 32 + i0 + 4);
                    const f32x4 s0 = *(const f32x4*)(sina + (size_t)row * 32 + i0), s1 = *(const f32x4*)(sina + (size_t)row * 32 + i0 + 4);
                    const f32x4 a0 = acc[ai][0][m][0], a1 = acc[ai][0][m][1], b0 = acc[ai][1][m][0], b1 = acc[ai][1][m][1];
                    const f32x4 o10 = (a0 * c0 - b0 * s0) * 0.125f, o11 = (a1 * c1 - b1 * s1) * 0.125f, o20 = (a0 * s0 + b0 * c0) * 0.125f, o21 = (a1 * s1 + b1 * c1) * 0.125f;
                    bf16_t* rowp = AQ + (size_t)row * 1024 + t * 256 + wc * 64 + i0;
                    *(u32x4*)(rowp) = pack8(o10, o11); *(u32x4*)(rowp + 32) = pack8(o20, o21); }
        } else {
            const int i0 = 8 * fq;
            if (wc < 2) {
#pragma unroll
                for (int ai = 0; ai < 2; ++ai)
#pragma unroll
                    for (int m = 0; m < 4; ++m) { const int row = row0 + ai * HALF + m * 16;
                        const f32x4 c0 = *(const f32x4*)(cosa + (size_t)row * 32 + i0), c1 = *(const f32x4*)(cosa + (size_t)row * 32 + i0 + 4);
                        const f32x4 s0 = *(const f32x4*)(sina + (size_t)row * 32 + i0), s1 = *(const f32x4*)(sina + (size_t)row * 32 + i0 + 4);
                        const f32x4 a0 = acc[ai][0][m][0], a1 = acc[ai][0][m][1], b0 = acc[ai][1][m][0], b1 = acc[ai][1][m][1];
                        const f32x4 o10 = a0 * c0 - b0 * s0, o11 = a1 * c1 - b1 * s1, o20 = a0 * s0 + b0 * c0, o21 = a1 * s1 + b1 * c1;
                        bf16_t* rowp = AK + (size_t)row * 128 + wc * 64 + i0;
                        *(u32x4*)(rowp) = pack8(o10, o11); *(u32x4*)(rowp + 32) = pack8(o20, o21); }
            } else {
#pragma unroll
                for (int ai = 0; ai < 2; ++ai)
#pragma unroll
                    for (int m = 0; m < 4; ++m) { const int row = row0 + ai * HALF + m * 16; bf16_t* rowp = AV + (size_t)row * 128 + (wc - 2) * 32 + i0;
                        *(u32x4*)(rowp) = pack8(acc[ai][0][m][0], acc[ai][0][m][1]); *(u32x4*)(rowp + 64) = pack8(acc[ai][1][m][0], acc[ai][1][m][1]); }
            }
        }
    }
};
template <bool ADD> struct EpiResid {
    static constexpr bool PERM = false, AFTER_DRAIN = false;
    const float* base; float* Y; float alpha;
    __device__ __forceinline__ void operator()(const f32x4 (&acc)[2][2][4][2], const Unit& u, int wr, int wc, int fr, int fq) const {
        const int row0 = u.pm * BM + wr * 64 + fr, col0 = u.pn * BM + wc * 32 + 4 * fq;
#pragma unroll
        for (int ai = 0; ai < 2; ++ai)
#pragma unroll
            for (int m = 0; m < 4; ++m) { const size_t off = (size_t)(row0 + ai * HALF + m * 16) * 2048 + col0;
#pragma unroll
                for (int bj = 0; bj < 2; ++bj)
#pragma unroll
                    for (int n = 0; n < 2; ++n) { const size_t o = off + bj * HALF + n * 16; f32x4 v = acc[ai][bj][m][n] + *(const f32x4*)(base + o) * alpha;
                        if (ADD) v = v + *(const f32x4*)(Y + o); *(f32x4*)(Y + o) = v; } }
    }
};
struct EpiUp {
    static constexpr bool PERM = true, AFTER_DRAIN = false;
    bf16_t* H; bf16_t* SG; const float* bgate;
    __device__ __forceinline__ void operator()(const f32x4 (&acc)[2][2][4][2], const Unit& u, int wr, int wc, int fr, int fq) const {
        const int row0 = u.pm * BM + wr * 64 + fr, cw = wc * 32 + 8 * fq;
        if (u.pn < 44) {
#pragma unroll
            for (int ai = 0; ai < 2; ++ai)
#pragma unroll
                for (int m = 0; m < 4; ++m) { bf16_t* rowp = H + (size_t)(row0 + ai * HALF + m * 16) * 11264 + u.pn * 256 + cw;
#pragma unroll
                    for (int bj = 0; bj < 2; ++bj) *(u32x4*)(rowp + bj * HALF) = pack8(acc[ai][bj][m][0], acc[ai][bj][m][1]); }
        } else {
            const int colg = (u.pn - 44) * 256 + cw;
            f32x4 bv[2][2];
#pragma unroll
            for (int bj = 0; bj < 2; ++bj)
#pragma unroll
                for (int n = 0; n < 2; ++n) bv[bj][n] = *(const f32x4*)(bgate + colg + bj * HALF + 4 * n);
#pragma unroll
            for (int ai = 0; ai < 2; ++ai)
#pragma unroll
                for (int m = 0; m < 4; ++m) { bf16_t* rowp = SG + (size_t)(row0 + ai * HALF + m * 16) * 2048 + colg;
#pragma unroll
                    for (int bj = 0; bj < 2; ++bj) { f32x4 v0 = acc[ai][bj][m][0] + bv[bj][0], v1 = acc[ai][bj][m][1] + bv[bj][1];
#pragma unroll
                        for (int j = 0; j < 4; ++j) { v0[j] = sigmoidf_(v0[j]); v1[j] = sigmoidf_(v1[j]); }
                        *(u32x4*)(rowp + bj * HALF) = pack8(v0, v1); } }
        }
    }
};
struct EpiPle {
    static constexpr bool PERM = false, AFTER_DRAIN = false;
    const bf16_t* SG; float* Y;
    __device__ __forceinline__ void operator()(const f32x4 (&acc)[2][2][4][2], const Unit& u, int wr, int wc, int fr, int fq) const {
        const int row0 = u.pm * BM + wr * 64 + fr, col0 = u.pn * BM + wc * 32 + 4 * fq;
#pragma unroll
        for (int ai = 0; ai < 2; ++ai)
#pragma unroll
            for (int m = 0; m < 4; ++m) { const size_t off = (size_t)(row0 + ai * HALF + m * 16) * 2048 + col0;
#pragma unroll
                for (int bj = 0; bj < 2; ++bj)
#pragma unroll
                    for (int n = 0; n < 2; ++n) { const size_t o = off + bj * HALF + n * 16; const u32x2 sg = *(const u32x2*)(SG + o);
                        f32x4 g; g[0] = __uint_as_float(sg.x << 16); g[1] = __uint_as_float(sg.x & 0xffff0000u); g[2] = __uint_as_float(sg.y << 16); g[3] = __uint_as_float(sg.y & 0xffff0000u);
                        *(f32x4*)(Y + o) = acc[ai][bj][m][n] * g; } }
    }
};
template <class Epi, class Sched, bool ALIGN_EPI = false, bool SP2 = false>
__device__ __forceinline__ void gemm_phase(PG8_LAS unsigned char* lds, const Gemm g, const Sched& S, const Epi& E, const int wid_in) {
    int lane_; asm volatile("v_mbcnt_lo_u32_b32 %0, -1, 0\n\tv_mbcnt_hi_u32_b32 %0, -1, %0" : "=v"(lane_)); const int wid = wid_in, lane = lane_, tid = wid * 64 + lane, wr = wid >> 2, wc = wid & 3, fr = lane & 15, fq = lane >> 4;
    const int K = g.K, nt = K / BK;
    unsigned voffA[2], voffB[2];
#pragma unroll
    for (int i = 0; i < 2; ++i) { int R, C; stage_rc(tid * 16 + i * 8192, R, C); const int Rb = Epi::PERM ? ((R & ~31) + perm32(R & 31)) : R;
        voffA[i] = (unsigned)(R * K + C) * 2u; voffB[i] = (unsigned)(Rb * K + C) * 2u; }
    const size_t kstep = (size_t)(BK * 2);
    const size_t hstep = (size_t)HALF * K * 2;
    const size_t tstep = 2 * hstep;
    const unsigned ldsw = (unsigned)wid * 1024u;
    const int aoff = lds_byte(wr * 64 + fr, fq * 8), boff = lds_byte(wc * 32 + fr, fq * 8);
#define PG8_SA(b, h) (((b) * 2 + (h)) * HTB)
#define PG8_SB(b, h) ((4 + (b) * 2 + (h)) * HTB)
#define PG8_STAGE(bufoff, gbase, voff) do { _Pragma("unroll") for (int _i = 0; _i < 2; ++_i) \
        __builtin_amdgcn_global_load_lds((const unsigned*)((const char*)(gbase) + (voff)[_i]), (PG8_LAS unsigned*)(lds + (bufoff) + ldsw + _i * 8192), 16, 0, 0); } while (0)
#define PG8_LDA(dst, b, h) do { _Pragma("unroll") for (int m = 0; m < 4; ++m) _Pragma("unroll") for (int k = 0; k < 2; ++k) dst[m][k] = *(const PG8_LAS bf16x8*)(lds + PG8_SA(b, h) + aoff + m * 2048 + k * 1024); } while (0)
#define PG8_LDB(dst, b, h) do { _Pragma("unroll") for (int n = 0; n < 2; ++n) _Pragma("unroll") for (int k = 0; k < 2; ++k) dst[n][k] = *(const PG8_LAS bf16x8*)(lds + PG8_SB(b, h) + boff + n * 2048 + k * 1024); } while (0)
#define PG8_MMA(ai, bj, At, Bt) do { __builtin_amdgcn_s_setprio(1); _Pragma("unroll") for (int m = 0; m < 4; ++m) _Pragma("unroll") for (int n = 0; n < 2; ++n) _Pragma("unroll") for (int k = 0; k < 2; ++k) \
        acc[ai][bj][m][n] = __builtin_amdgcn_mfma_f32_16x16x32_bf16(Bt[n][k], At[m][k], acc[ai][bj][m][n], 0, 0, 0); __builtin_amdgcn_s_setprio(0); } while (0)
#define PG8_WAIT_V(n) asm volatile("s_waitcnt vmcnt(" #n ")" ::: "memory")
#define PG8_WAIT_L(n) asm volatile("s_waitcnt lgkmcnt(" #n ")" ::: "memory")
#define PG8_BAR __builtin_amdgcn_s_barrier()
#define PG8_SCHED __builtin_amdgcn_sched_barrier(0)
    Unit cur, nxt; int ui = 0;
    if (!S.next(0, cur)) return;
    f32x4 acc[2][2][4][2];
#pragma unroll
    for (int a = 0; a < 2; ++a)
#pragma unroll
        for (int b = 0; b < 2; ++b)
#pragma unroll
            for (int m = 0; m < 4; ++m)
#pragma unroll
                for (int n = 0; n < 2; ++n) acc[a][b][m][n] = (f32x4){0.f, 0.f, 0.f, 0.f};
    bf16x8 At[4][2], B0[2][2], B1[2][2];
    const char* cA = (const char*)g.A + (size_t)cur.pm * tstep; const char* cB = (const char*)g.Bt + (size_t)cur.pn * tstep;
    S.a_ready(cur);
    if constexpr (SP2) {
        PG8_STAGE(PG8_SB(0, 0), cB, voffB); PG8_STAGE(PG8_SB(0, 1), cB + hstep, voffB); PG8_STAGE(PG8_SA(0, 0), cA, voffA); PG8_STAGE(PG8_SA(0, 1), cA + hstep, voffA);
        if (wr == 1) PG8_BAR;
        PG8_WAIT_V(2); PG8_BAR;
        PG8_STAGE(PG8_SB(1, 0), cB + kstep, voffB); PG8_STAGE(PG8_SA(1, 0), cA + kstep, voffA); PG8_STAGE(PG8_SB(1, 1), cB + hstep + kstep, voffB);
        PG8_WAIT_V(6); PG8_BAR;
    } else {
        PG8_STAGE(PG8_SB(0, 0), cB, voffB); PG8_STAGE(PG8_SA(0, 0), cA, voffA); PG8_STAGE(PG8_SB(0, 1), cB + hstep, voffB); PG8_STAGE(PG8_SA(0, 1), cA + hstep, voffA);
        if (wr == 1) PG8_BAR;
        PG8_WAIT_V(4); PG8_BAR;
        PG8_STAGE(PG8_SB(1, 0), cB + kstep, voffB); PG8_STAGE(PG8_SA(1, 0), cA + kstep, voffA); PG8_STAGE(PG8_SB(1, 1), cB + hstep + kstep, voffB);
        PG8_WAIT_V(6); PG8_BAR;
    }
    for (;;) {
        const bool has_next = S.next(ui + 1, nxt);
        const char* nA = has_next ? (const char*)g.A + (size_t)nxt.pm * tstep : cA; const char* nB = has_next ? (const char*)g.Bt + (size_t)nxt.pn * tstep : cB;
        for (int t = 0; t < nt; t += 2) {
            const bool last = (t == nt - 2);
            const char* a1 = cA + (size_t)(t + 1) * kstep;
            const char* a2 = last ? nA : cA + (size_t)(t + 2) * kstep; const char* b2 = last ? nB : cB + (size_t)(t + 2) * kstep;
            const char* a3 = a2 + kstep; const char* b3 = b2 + kstep;
            if (last && has_next) S.a_ready(nxt);
            if constexpr (SP2) {
            PG8_LDB(B0, 0, 0); PG8_LDB(B1, 0, 1); PG8_SCHED; PG8_LDA(At, 0, 0); PG8_STAGE(PG8_SA(1, 1), a1 + hstep, voffA);
            PG8_WAIT_V(8); PG8_WAIT_L(0); PG8_BAR; PG8_MMA(0, 0, At, B0); PG8_MMA(0, 1, At, B1); PG8_BAR; PG8_SCHED;
            PG8_LDA(At, 0, 1); PG8_STAGE(PG8_SB(0, 0), b2, voffB); PG8_STAGE(PG8_SB(0, 1), b2 + hstep, voffB); PG8_STAGE(PG8_SA(0, 0), a2, voffA);
            PG8_WAIT_V(8); PG8_WAIT_L(0); PG8_BAR; PG8_MMA(1, 0, At, B0); PG8_MMA(1, 1, At, B1); PG8_BAR; PG8_SCHED;
            PG8_LDB(B0, 1, 0); PG8_LDB(B1, 1, 1); PG8_SCHED; PG8_LDA(At, 1, 0); PG8_STAGE(PG8_SA(0, 1), a2 + hstep, voffA);
            PG8_WAIT_V(8); PG8_WAIT_L(0); PG8_BAR; PG8_MMA(0, 0, At, B0); PG8_MMA(0, 1, At, B1); PG8_BAR; PG8_SCHED;
            PG8_LDA(At, 1, 1); PG8_STAGE(PG8_SB(1, 0), b3, voffB); PG8_STAGE(PG8_SB(1, 1), b3 + hstep, voffB); PG8_STAGE(PG8_SA(1, 0), a3, voffA);
            PG8_WAIT_V(8); PG8_WAIT_L(0); PG8_BAR; PG8_MMA(1, 0, At, B0); PG8_MMA(1, 1, At, B1); PG8_BAR; PG8_SCHED;
            } else {
            PG8_LDB(B0, 0, 0); PG8_SCHED; PG8_LDA(At, 0, 0); PG8_STAGE(PG8_SA(1, 1), a1 + hstep, voffA);
            PG8_WAIT_L(8); PG8_BAR; PG8_WAIT_L(0); PG8_MMA(0, 0, At, B0); PG8_BAR; PG8_SCHED;
            PG8_LDB(B1, 0, 1); PG8_STAGE(PG8_SB(0, 0), b2, voffB);
            PG8_BAR; PG8_WAIT_L(0); PG8_MMA(0, 1, At, B1); PG8_BAR;
            PG8_LDA(At, 0, 1); PG8_STAGE(PG8_SA(0, 0), a2, voffA);
            PG8_BAR; PG8_WAIT_L(0); PG8_MMA(1, 0, At, B0); PG8_BAR; PG8_SCHED;
            PG8_STAGE(PG8_SB(0, 1), b2 + hstep, voffB);
            PG8_WAIT_V(6); PG8_BAR; PG8_MMA(1, 1, At, B1); PG8_BAR;
            PG8_LDB(B0, 1, 0); PG8_SCHED; PG8_LDA(At, 1, 0); PG8_STAGE(PG8_SA(0, 1), a2 + hstep, voffA);
            PG8_WAIT_L(8); PG8_BAR; PG8_WAIT_L(0); PG8_MMA(0, 0, At, B0); PG8_BAR; PG8_SCHED;
            PG8_LDB(B1, 1, 1); PG8_STAGE(PG8_SB(1, 0), b3, voffB);
            PG8_BAR; PG8_WAIT_L(0); PG8_MMA(0, 1, At, B1); PG8_BAR;
            PG8_LDA(At, 1, 1); PG8_STAGE(PG8_SA(1, 0), a3, voffA);
            PG8_BAR; PG8_WAIT_L(0); PG8_MMA(1, 0, At, B0); PG8_BAR; PG8_SCHED;
            PG8_STAGE(PG8_SB(1, 1), b3 + hstep, voffB);
            PG8_WAIT_V(6); PG8_BAR; PG8_MMA(1, 1, At, B1); PG8_BAR;
            }
        }
        if constexpr (ALIGN_EPI) { if (wr == 0) PG8_BAR; }
        if constexpr (!Epi::AFTER_DRAIN) { E(acc, cur, wr, wc, fr, fq); S.done(cur); }
        if (!has_next) break;
#pragma unroll
        for (int a = 0; a < 2; ++a)
#pragma unroll
            for (int b = 0; b < 2; ++b)
#pragma unroll
                for (int m = 0; m < 4; ++m)
#pragma unroll
                    for (int n = 0; n < 2; ++n) acc[a][b][m][n] = (f32x4){0.f, 0.f, 0.f, 0.f};
        cur = nxt; cA = nA; cB = nB; ++ui;
        if constexpr (ALIGN_EPI) { if (wr == 1) PG8_BAR; }
    }
    PG8_WAIT_V(0);
    if constexpr (!ALIGN_EPI) { if (wr == 0) PG8_BAR; }
    PG8_BAR;
    if constexpr (Epi::AFTER_DRAIN) { E.fused(acc, cur, wr, wc, fr, fq, lds, wid, lane); S.done(cur); }
#undef PG8_SA
#undef PG8_SB
#undef PG8_STAGE
#undef PG8_LDA
#undef PG8_LDB
#undef PG8_MMA
#undef PG8_WAIT_V
#undef PG8_WAIT_L
#undef PG8_BAR
#undef PG8_SCHED
}
}
#define LAS __attribute__((address_space(3)))
#define XB_TMO      128
#define XB_XCNT(j)  (256  + 64 * (j))
#define XB_XSUB(j)  (1280 + 64 * (j))
#define XB_XGEN(j)  (2304 + 64 * (j))
#define XB_TOP      3328
#define XB_TOPGEN   3392
#define XCD_BAR_WORDS 3456
#define XB_SPIN_CAP (1u << 18)

__device__ __forceinline__ unsigned xb_ld(unsigned* p)              { return __hip_atomic_load(p, __ATOMIC_RELAXED, __HIP_MEMORY_SCOPE_AGENT); }
__device__ __forceinline__ unsigned xb_add(unsigned* p, unsigned v) { return __hip_atomic_fetch_add(p, v, __ATOMIC_RELAXED, __HIP_MEMORY_SCOPE_AGENT); }
__device__ __forceinline__ unsigned xb_xcc_id() { return (unsigned)__builtin_amdgcn_s_getreg((3 << 11) | 20) & 0xFu; }
#define XB_SPIN(cond, bar) do { unsigned _sp = 0; while (cond) { __builtin_amdgcn_s_sleep(1); \
    if ((++_sp & 255u) == 0u) { if (xb_ld(&(bar)[XB_TMO])) break; if (_sp > XB_SPIN_CAP) { atomicAdd(&(bar)[XB_TMO], 1u); break; } } } } while (0)

struct XcdBarrier {
    unsigned* bar; unsigned x;
    volatile LAS unsigned* st;
};

__device__ __forceinline__ XcdBarrier xcd_barrier_post(unsigned* bar, volatile LAS unsigned* st) {
    XcdBarrier b; b.bar = bar; b.x = xb_xcc_id(); b.st = st;
    if (threadIdx.x == 0) (void)xb_add(&bar[XB_XCNT(b.x)], 1u);
    return b;
}
__device__ __forceinline__ void xcd_barrier_complete(unsigned* bar, unsigned x, unsigned& nloc, unsigned& nx) {
    const unsigned G = gridDim.x * gridDim.y * gridDim.z;
    unsigned sum, cnt, mine, sp = 0u;
    for (;;) {
        sum = 0u; cnt = 0u; mine = 0u;
#pragma unroll
        for (unsigned j = 0; j < 16; ++j) { const unsigned c = xb_ld(&bar[XB_XCNT(j)]); sum += c; cnt += (c > 0u) ? 1u : 0u; mine = (j == x) ? c : mine; }
        if (sum == G) break;
        __builtin_amdgcn_s_sleep(1);
        if ((++sp & 255u) == 0u) { if (xb_ld(&bar[XB_TMO])) break; if (sp > XB_SPIN_CAP) { atomicAdd(&bar[XB_TMO], 1u); break; } }
    }
    nloc = mine > 0u ? mine : 1u; nx = cnt > 0u ? cnt : 1u;
}

__device__ __forceinline__ void xcd_barrier(const XcdBarrier& b) {
    asm volatile("s_waitcnt vmcnt(0)" ::: "memory");
    __syncthreads();
    if (threadIdx.x == 0) {
        unsigned* bar = b.bar;
        __builtin_amdgcn_s_waitcnt(0);
        unsigned nloc = b.st[0], nx = b.st[1];
        if (nloc == 0u) { xcd_barrier_complete(bar, b.x, nloc, nx); b.st[0] = nloc; b.st[1] = nx; }
        const unsigned old = xb_add(&bar[XB_XSUB(b.x)], 1u);
        const unsigned gen = old / nloc;
        if (old + 1u == (gen + 1u) * nloc) {
            __builtin_amdgcn_fence(__ATOMIC_RELEASE, "agent");
            asm volatile("s_waitcnt vmcnt(0)" ::: "memory");
            const unsigned og = xb_add(&bar[XB_TOP], 1u);
            const unsigned tg = og / nx;
            if (og + 1u == (tg + 1u) * nx) xb_add(&bar[XB_TOPGEN], 1u);
            else XB_SPIN(xb_ld(&bar[XB_TOPGEN]) == tg, bar);
            __builtin_amdgcn_fence(__ATOMIC_ACQUIRE, "agent");
            xb_add(&bar[XB_XGEN(b.x)], 1u);
            asm volatile("s_waitcnt vmcnt(0)" ::: "memory");
        } else {
            XB_SPIN(xb_ld(&bar[XB_XGEN(b.x)]) == gen, bar);
            __builtin_amdgcn_fence(__ATOMIC_ACQUIRE, "agent");
            asm volatile("s_waitcnt vmcnt(0)" ::: "memory");
        }
    }
    __syncthreads();
}
#define GAS __attribute__((address_space(1)))

typedef unsigned short bf16;
typedef float f32x4 __attribute__((ext_vector_type(4)));
typedef unsigned v4u __attribute__((ext_vector_type(4)));
typedef unsigned v2u __attribute__((ext_vector_type(2)));
#define LDS_WAIT() asm volatile("s_waitcnt lgkmcnt(0)" ::: "memory")

#ifndef MK_ONE_LAUNCH
#define MK_ONE_LAUNCH 0
#endif
#ifndef RET_MFMA
#define RET_MFMA 1
#endif
#ifndef SWA_MFMA
#define SWA_MFMA 1
#endif

constexpr int S = 16384, D = 2048, INW = 5376, DFF = 5632, NUP = 2 * DFF, NUPG = NUP + D, PLE = 256, DEPTH = 4;
constexpr float ALPHA = 1.6817928305074290f, LN_EPS = 1e-5f, GN_EPS = 1e-6f;
constexpr int NPH = 11, NPHASES = 1 + DEPTH * NPH;

constexpr size_t MiB = 1u << 20;
constexpr size_t WS_CTL = 0, CTL_ZERO_BYTES = 1 * MiB;
constexpr size_t WS_COSR = 2 * MiB, WS_SINR = 10 * MiB, WS_COSA = 18 * MiB, WS_SINA = 20 * MiB;
constexpr size_t WS_W = 32 * MiB, WL_BYTES = 104 * MiB;
constexpr size_t WL_IN = 0, WL_OUT = 21 * MiB, WL_UP = 29 * MiB, WL_G = 73 * MiB, WL_DOWN = 81 * MiB, WL_P = 103 * MiB;
constexpr size_t WS_XR = 448 * MiB, WS_XB = 576 * MiB, WS_Y = 640 * MiB;
constexpr size_t WS_Q = 768 * MiB, WS_K = 800 * MiB, WS_V = 832 * MiB, WS_G = 864 * MiB, WS_AQ = 896 * MiB, WS_AK = 928 * MiB, WS_AV = 932 * MiB;
constexpr size_t WS_MIX = 936 * MiB, WS_U = 1000 * MiB, WS_PS = 1128 * MiB, WS_RETY = 1160 * MiB;
constexpr size_t WS_H = 768 * MiB, WS_ACT = 1128 * MiB, WS_SG = 1304 * MiB, WS_PB = 1368 * MiB, WS_END = 1400 * MiB;
constexpr int CW_BAR = 4096;

constexpr int RING_BYTES = 131072, LDS_BYTES = 147456, LDSCTL_OFF = LDS_BYTES - 1024, MISC_OFF = LDSCTL_OFF + 320;

__device__ __forceinline__ unsigned f2bf(float f) { unsigned u = __builtin_bit_cast(unsigned, f); return (u + 0x7fffu + ((u >> 16) & 1u)) >> 16; }
__device__ __forceinline__ unsigned pk2(float lo, float hi) { return f2bf(lo) | (f2bf(hi) << 16); }
__device__ __forceinline__ float bflo(unsigned w) { return __uint_as_float(w << 16); }
__device__ __forceinline__ float bfhi(unsigned w) { return __uint_as_float(w & 0xffff0000u); }
__device__ __forceinline__ float bf1(const bf16* p) { return __uint_as_float(((unsigned)*p) << 16); }

struct Params {
    const float* in[19]; float* out; unsigned char* ws; int ph_lo, ph_hi;
    float invf_ret[128]; float invf_att[32]; float lg2g[4];
};

struct Ctx { int tid, lane, wave, G, bid; unsigned char* ws; };

__device__ __forceinline__ int lane_id_asm() { int l; asm volatile("v_mbcnt_lo_u32_b32 %0, -1, 0\n\tv_mbcnt_hi_u32_b32 %0, -1, %0" : "=v"(l)); return l; }
__device__ __forceinline__ float wave_sum(float v, int lane) {
#pragma unroll
    for (int o = 1; o < 64; o <<= 1) v += __builtin_bit_cast(float, __builtin_amdgcn_ds_bpermute((lane ^ o) << 2, __builtin_bit_cast(int, v)));
    return v;
}
__device__ __forceinline__ void transpose_item(const float* W, int K, int N, int src_col0, bf16* WT, int dst_row0, int k0, LAS float* scr, int lane) {
#pragma unroll 8
    for (int i = 0; i < 32; ++i) { const int kk = 2 * i + (lane >> 5); scr[kk * 33 + (lane & 31)] = W[(size_t)(k0 + kk) * N + src_col0 + (lane & 31)]; }
    LDS_WAIT(); asm volatile("" ::: "memory");
    const int c = lane & 7;
#pragma unroll
    for (int j = 0; j < 4; ++j) { const int n = (lane >> 3) + 8 * j; const LAS float* s = scr + (8 * c) * 33 + n;
        v4u o; o.x = pk2(s[0 * 33], s[1 * 33]); o.y = pk2(s[2 * 33], s[3 * 33]); o.z = pk2(s[4 * 33], s[5 * 33]); o.w = pk2(s[6 * 33], s[7 * 33]);
        *(v4u*)(WT + (size_t)(dst_row0 + n) * K + k0 + 8 * c) = o; }
    LDS_WAIT(); asm volatile("" ::: "memory");
}
__device__ __forceinline__ int win_src_col(int g) {
    const int tile = g >> 3, bj = (g >> 2) & 1, wcg = g & 3;
    if (tile < 16) return 32 * g;
    if (tile < 20) return 4096 + 256 * (tile - 16) + 64 * wcg + 32 * bj;
    return wcg < 2 ? 5120 + 64 * wcg + 32 * bj : 5248 + 32 * (wcg - 2) + 64 * bj;
}
__device__ __forceinline__ int wup_src_col(int g) { const int tile = g >> 3, bj = (g >> 2) & 1, wcg = g & 3; return (bj ? DFF : 0) + 128 * tile + 32 * wcg; }

__device__ __forceinline__ void sincos_d(float angf, float& s, float& c) {
    const double a = (double)angf;
    const double k = __builtin_rint(a * 0.63661977236758134308);
    double r = __builtin_fma(-k, 1.57079632679489661923, a); r = __builtin_fma(-k, 6.123233995736766e-17, r);
    const double r2 = r * r;
    const double sp = r + r * r2 * (-1.0 / 6 + r2 * (1.0 / 120 + r2 * (-1.0 / 5040 + r2 * (1.0 / 362880 + r2 * (-1.0 / 39916800)))));
    const double cp = 1.0 + r2 * (-0.5 + r2 * (1.0 / 24 + r2 * (-1.0 / 720 + r2 * (1.0 / 40320 + r2 * (-1.0 / 3628800 + r2 * (1.0 / 479001600))))));
    const int q = ((int)k) & 3;
    const double sv = (q == 0) ? sp : (q == 1) ? cp : (q == 2) ? -sp : -cp;
    const double cv = (q == 0) ? cp : (q == 1) ? -sp : (q == 2) ? -cp : sp;
    s = (float)sv; c = (float)cv;
}

__device__ __forceinline__ void phase_prologue(const Params& P, const Ctx& cx, LAS unsigned char* lds) {
    unsigned char* ws = cx.ws; const int tid = cx.tid, lane = cx.lane, wave = cx.wave, G = cx.G;
    LAS float* scr = (LAS float*)(lds + wave * 16384);
    const int gw = cx.bid * 8 + wave, NGW = G * 8;
    constexpr int I_IN = 32 * 168, I_OUT = 32 * 64, I_UP = 32 * 352, I_G = 32 * 64, I_DN = 88 * 64, I_P = 4 * 64, I_L = I_IN + I_OUT + I_UP + I_G + I_DN + I_P;
    for (int it = gw; it < DEPTH * I_L; it += NGW) {
        const int l = it / I_L; int r = it - l * I_L;
        bf16* wl = (bf16*)(ws + WS_W + (size_t)l * WL_BYTES);
        if (r < I_IN) { const int kb = r / 168, g = r % 168; transpose_item(P.in[3] + (size_t)l * D * INW, D, INW, win_src_col(g), wl + WL_IN / 2, 32 * g, 64 * kb, scr, lane); continue; } r -= I_IN;
        if (r < I_OUT) { const int kb = r / 64, g = r % 64; transpose_item(P.in[4] + (size_t)l * D * D, D, D, 32 * g, wl + WL_OUT / 2, 32 * g, 64 * kb, scr, lane); continue; } r -= I_OUT;
        if (r < I_UP) { const int kb = r / 352, g = r % 352; transpose_item(P.in[10] + (size_t)l * D * NUP, D, NUP, wup_src_col(g), wl + WL_UP / 2, 32 * g, 64 * kb, scr, lane); continue; } r -= I_UP;
        if (r < I_G) { const int kb = r / 64, g = r % 64; transpose_item(P.in[16] + (size_t)l * D * D, D, D, 32 * g, wl + WL_G / 2, 32 * g, 64 * kb, scr, lane); continue; } r -= I_G;
        if (r < I_DN) { const int kb = r / 64, g = r % 64; transpose_item(P.in[13] + (size_t)l * DFF * D, DFF, D, 32 * g, wl + WL_DOWN / 2, 32 * g, 64 * kb, scr, lane); continue; } r -= I_DN;
        { const int kb = r / 64, g = r % 64; transpose_item(P.in[18] + (size_t)l * PLE * D, PLE, D, 32 * g, wl + WL_P / 2, 32 * g, 64 * kb, scr, lane); }
    }
    const size_t gt = (size_t)cx.bid * 512 + tid, NT = (size_t)G * 512;
    { const float* x = P.in[0]; bf16* xb = (bf16*)(ws + WS_XB);
      for (size_t i = gt; i < (size_t)S * D / 8; i += NT) { const f32x4 a = *(const f32x4*)(x + i * 8), b = *(const f32x4*)(x + i * 8 + 4);
          v4u o; o.x = pk2(a[0], a[1]); o.y = pk2(a[2], a[3]); o.z = pk2(b[0], b[1]); o.w = pk2(b[2], b[3]); *(v4u*)(xb + i * 8) = o; } }
    { const float* p = P.in[1]; bf16* pb = (bf16*)(ws + WS_PB);
      for (size_t i = gt; i < (size_t)DEPTH * S * PLE / 8; i += NT) { const f32x4 a = *(const f32x4*)(p + i * 8), b = *(const f32x4*)(p + i * 8 + 4);
          v4u o; o.x = pk2(a[0], a[1]); o.y = pk2(a[2], a[3]); o.z = pk2(b[0], b[1]); o.w = pk2(b[2], b[3]); *(v4u*)(pb + i * 8) = o; } }
    { const int* pos = (const int*)P.in[2]; float* cosr = (float*)(ws + WS_COSR); float* sinr = (float*)(ws + WS_SINR); float* cosa = (float*)(ws + WS_COSA); float* sina = (float*)(ws + WS_SINA);
      for (size_t i = gt; i < (size_t)S * 128; i += NT) { const int t = (int)(i >> 7), f = (int)(i & 127); float s, c; sincos_d((float)pos[t] * P.invf_ret[f], s, c); cosr[i] = c; sinr[i] = s; }
      for (size_t i = gt; i < (size_t)S * 32; i += NT) { const int t = (int)(i >> 5), f = (int)(i & 31); float s, c; sincos_d((float)pos[t] * P.invf_att[f], s, c); cosa[i] = c; sina[i] = s; } }
}

template <int MT, int NT_, int KK, bool A_KFAST, bool B_NFAST, class FA, class FB, class FC>
__device__ __forceinline__ void simple_gemm(LAS unsigned char* lds, int nbatch, int tid, int G, int bid, const FA& fa, const FB& fb, const FC& fc) {
    LAS float* As = (LAS float*)lds;
    LAS float* Bs = (LAS float*)(lds + 16 * 132 * 4);
    constexpr int TM = MT / 128, TN = NT_ / 64, ITEMS_PER_B = TM * TN;
    const int tm = tid & 31, tn = tid >> 5;
    for (int item = bid; item < nbatch * ITEMS_PER_B; item += G) {
        const int b = item / ITEMS_PER_B, r = item % ITEMS_PER_B, m0 = (r / TN) * 128, n0 = (r % TN) * 64;
        float c[4][4];
#pragma unroll
        for (int i = 0; i < 4; ++i)
#pragma unroll
            for (int j = 0; j < 4; ++j) c[i][j] = 0.f;
        for (int k0 = 0; k0 < KK; k0 += 16) {
#pragma unroll
            for (int rr = 0; rr < 4; ++rr) { const int e = tid + 512 * rr; int m, k; if (A_KFAST) { k = e & 15; m = e >> 4; } else { m = e & 127; k = e >> 7; }
                As[k * 132 + m] = fa(b, m0 + m, k0 + k); }
#pragma unroll
            for (int rr = 0; rr < 2; ++rr) { const int e = tid + 512 * rr; int n, k; if (B_NFAST) { n = e & 63; k = e >> 6; } else { k = e & 15; n = e >> 4; }
                Bs[k * 68 + n] = fb(b, k0 + k, n0 + n); }
            __syncthreads();
#pragma unroll
            for (int kk = 0; kk < 16; ++kk) { const f32x4 a = *(const LAS f32x4*)(As + kk * 132 + 4 * tm), bb = *(const LAS f32x4*)(Bs + kk * 68 + 4 * tn);
#pragma unroll
                for (int i = 0; i < 4; ++i)
#pragma unroll
                    for (int j = 0; j < 4; ++j) c[i][j] += a[i] * bb[j]; }
            __syncthreads();
        }
#pragma unroll
        for (int i = 0; i < 4; ++i)
#pragma unroll
            for (int j = 0; j < 4; ++j) fc(b, m0 + 4 * tm + i, n0 + 4 * tn + j, c[i][j]);
    }
}

__device__ __forceinline__ void phase_swa(const Params& P, const Ctx& cx, int l, LAS unsigned char* lds) {
    unsigned char* ws = cx.ws; const int tid = cx.tid, G = cx.G;
    const bf16* AQ = (const bf16*)(ws + WS_AQ); const bf16* AK = (const bf16*)(ws + WS_AK); const bf16* AV = (const bf16*)(ws + WS_AV); bf16* MIX = (bf16*)(ws + WS_MIX);
    const float* sinks = P.in[7] + l * 16;
    LAS unsigned* Ks = (LAS unsigned*)lds;
    LAS unsigned* Vs = (LAS unsigned*)(lds + 256 * 33 * 4);
    for (int item = cx.bid; item < 256; item += G) {
        const int nb = item >> 1, hk = item & 1;
        __syncthreads();
        for (int e = tid; e < 256 * 32; e += 512) { const int r = e >> 5, cdw = e & 31; const int gk = nb * 128 - 128 + r;
            unsigned kv = 0u, vv = 0u; if (gk >= 0) { kv = *(const unsigned*)(AK + (size_t)gk * 128 + hk * 64 + 2 * cdw); vv = *(const unsigned*)(AV + (size_t)gk * 128 + hk * 64 + 2 * cdw); }
            Ks[r * 33 + cdw] = kv; Vs[r * 33 + cdw] = vv; }
        __syncthreads();
#pragma unroll 1
        for (int rep = 0; rep < 2; ++rep) {
            const int pair = tid + 512 * rep, i = pair & 127, g = pair >> 7, hq = hk * 8 + g; const int row = nb * 128 + i;
            float q[64], o[64];
            { const v4u* qp = (const v4u*)(AQ + (size_t)row * 1024 + hq * 64);
#pragma unroll
              for (int c8 = 0; c8 < 8; ++c8) { const v4u w = qp[c8]; q[8 * c8 + 0] = bflo(w.x); q[8 * c8 + 1] = bfhi(w.x); q[8 * c8 + 2] = bflo(w.y); q[8 * c8 + 3] = bfhi(w.y); q[8 * c8 + 4] = bflo(w.z); q[8 * c8 + 5] = bfhi(w.z); q[8 * c8 + 6] = bflo(w.w); q[8 * c8 + 7] = bfhi(w.w); } }
#pragma unroll
            for (int d = 0; d < 64; ++d) o[d] = 0.f;
            float mx = sinks[hq], den = 1.0f;
            const int jj0 = (nb == 0) ? (127 - i) : 0;
            for (int jj = jj0; jj < 128; ++jj) { const int kl = i + 1 + jj;
                float s = 0.f;
#pragma unroll
                for (int c = 0; c < 32; ++c) { const unsigned w = Ks[kl * 33 + c]; s += q[2 * c] * bflo(w) + q[2 * c + 1] * bfhi(w); }
                const float mn = fmaxf(mx, s), sc = __expf(mx - mn), p = __expf(s - mn);
                den = den * sc + p; mx = mn;
#pragma unroll
                for (int c = 0; c < 32; ++c) { const unsigned w = Vs[kl * 33 + c]; o[2 * c] = o[2 * c] * sc + p * bflo(w); o[2 * c + 1] = o[2 * c + 1] * sc + p * bfhi(w); }
            }
            const float inv = 1.0f / den;
            v4u* op = (v4u*)(MIX + (size_t)row * 2048 + 1024 + hq * 64);
#pragma unroll
            for (int c8 = 0; c8 < 8; ++c8) { v4u w; w.x = pk2(o[8 * c8] * inv, o[8 * c8 + 1] * inv); w.y = pk2(o[8 * c8 + 2] * inv, o[8 * c8 + 3] * inv); w.z = pk2(o[8 * c8 + 4] * inv, o[8 * c8 + 5] * inv); w.w = pk2(o[8 * c8 + 6] * inv, o[8 * c8 + 7] * inv); op[c8] = w; }
        }
    }
}

__device__ __forceinline__ void phase_ret_u_scores(const Params& P, const Ctx& cx, LAS unsigned char* lds) {
    unsigned char* ws = cx.ws; const int tid = cx.tid, G = cx.G;
    const bf16* Q = (const bf16*)(ws + WS_Q); const bf16* K = (const bf16*)(ws + WS_K); const bf16* V = (const bf16*)(ws + WS_V);
    float* U = (float*)(ws + WS_U); float* PS = (float*)(ws + WS_PS);
    const float lg0 = P.lg2g[0], lg1 = P.lg2g[1], lg2 = P.lg2g[2], lg3 = P.lg2g[3];
    auto lgh = [=](int h) { return h == 0 ? lg0 : h == 1 ? lg1 : h == 2 ? lg2 : lg3; };
    simple_gemm<256, 256, 128, false, true>(lds, 512, tid, G, cx.bid,
        [=](int b, int m, int k) { const int nb = b >> 2, h = b & 3; return bf1(K + (size_t)(nb * 128 + k) * 1024 + h * 256 + m) * exp2f(lgh(h) * (float)(127 - k)); },
        [=](int b, int k, int n) { const int nb = b >> 2, h = b & 3; return bf1(V + (size_t)(nb * 128 + k) * 1024 + h * 256 + n); },
        [=](int b, int m, int n, float v) { U[((size_t)b * 256 + m) * 256 + n] = v; });
    simple_gemm<128, 128, 256, true, false>(lds, 512, tid, G, cx.bid,
        [=](int b, int m, int k) { const int nb = b >> 2, h = b & 3; return bf1(Q + (size_t)(nb * 128 + m) * 1024 + h * 256 + k); },
        [=](int b, int k, int n) { const int nb = b >> 2, h = b & 3; return bf1(K + (size_t)(nb * 128 + n) * 1024 + h * 256 + k); },
        [=](int b, int m, int n, float v) { const int h = b & 3; PS[((size_t)b * 128 + m) * 128 + n] = (m >= n) ? v * exp2f(lgh(h) * (float)(m - n)) : 0.f; });
}
__device__ __forceinline__ void phase_scan(const Params& P, const Ctx& cx) {
    float* U = (float*)(cx.ws + WS_U);
    const size_t gt = (size_t)cx.bid * 512 + cx.tid, NT = (size_t)cx.G * 512;
    for (size_t idx = gt; idx < 4 * 65536; idx += NT) {
        const int h = (int)(idx >> 16); const float cd = exp2f(P.lg2g[h] * 128.0f);
        float r = 0.f;
        for (int n0 = 0; n0 < 128; n0 += 8) { float u[8];
#pragma unroll
            for (int j = 0; j < 8; ++j) u[j] = U[(size_t)(n0 + j) * 262144 + idx];
#pragma unroll
            for (int j = 0; j < 8; ++j) { U[(size_t)(n0 + j) * 262144 + idx] = r; r = r * cd + u[j]; } }
    }
}
__device__ __forceinline__ void phase_ret_out(const Params& P, const Ctx& cx, LAS unsigned char* lds) {
    unsigned char* ws = cx.ws; const int tid = cx.tid, G = cx.G;
    const bf16* Q = (const bf16*)(ws + WS_Q); const bf16* V = (const bf16*)(ws + WS_V);
    const float* Sst = (const float*)(ws + WS_U); const float* PS = (const float*)(ws + WS_PS); float* RY = (float*)(ws + WS_RETY);
    const float lg0 = P.lg2g[0], lg1 = P.lg2g[1], lg2 = P.lg2g[2], lg3 = P.lg2g[3];
    auto lgh = [=](int h) { return h == 0 ? lg0 : h == 1 ? lg1 : h == 2 ? lg2 : lg3; };
    simple_gemm<128, 256, 384, true, true>(lds, 512, tid, G, cx.bid,
        [=](int b, int m, int k) { const int nb = b >> 2, h = b & 3; return k < 128 ? PS[((size_t)b * 128 + m) * 128 + k] : bf1(Q + (size_t)(nb * 128 + m) * 1024 + h * 256 + (k - 128)) * exp2f(lgh(h) * (float)(m + 1)); },
        [=](int b, int k, int n) { const int nb = b >> 2, h = b & 3; return k < 128 ? bf1(V + (size_t)(nb * 128 + k) * 1024 + h * 256 + n) : Sst[((size_t)b * 256 + (k - 128)) * 256 + n]; },
        [=](int b, int m, int n, float v) { const int nb = b >> 2, h = b & 3; RY[(size_t)(nb * 128 + m) * 1024 + h * 256 + n] = v; });
}

typedef short bf16x8 __attribute__((ext_vector_type(8)));
typedef short s16x4 __attribute__((ext_vector_type(4)));
typedef short v4i16_t __attribute__((ext_vector_type(4)));
__device__ __forceinline__ f32x4 mfma16(bf16x8 a, bf16x8 b, f32x4 c) { return __builtin_amdgcn_mfma_f32_16x16x32_bf16(a, b, c, 0, 0, 0); }
__device__ __forceinline__ s16x4 lds_tr(LAS unsigned char* p) { return __builtin_bit_cast(s16x4, __builtin_amdgcn_ds_read_tr16_b64_v4i16((LAS v4i16_t*)p)); }
__device__ __forceinline__ bf16x8 cat44(s16x4 a, s16x4 b) { bf16x8 r; r[0] = a[0]; r[1] = a[1]; r[2] = a[2]; r[3] = a[3]; r[4] = b[0]; r[5] = b[1]; r[6] = b[2]; r[7] = b[3]; return r; }
__device__ __forceinline__ unsigned cvt2(float lo, float hi) { return pg8::cvt_pk_bf16(lo, hi); }
__device__ __forceinline__ bf16x8 pack_frag(const f32x4 a, const f32x4 b) { v4u w; w.x = cvt2(a[0], a[1]); w.y = cvt2(a[2], a[3]); w.z = cvt2(b[0], b[1]); w.w = cvt2(b[2], b[3]); return __builtin_bit_cast(bf16x8, w); }
__device__ __forceinline__ float grp16_sum(float v, int lane) {
#pragma unroll
    for (int o = 1; o < 16; o <<= 1) v += __builtin_bit_cast(float, __builtin_amdgcn_ds_bpermute((lane ^ o) << 2, __builtin_bit_cast(int, v)));
    return v;
}
constexpr int RS_T = 544;
constexpr int TILE_T = 128 * RS_T;
static_assert(2 * TILE_T <= LDSCTL_OFF, "retention tiles vs LDS control words");

template <bool DECAY> __device__ __forceinline__ void stage_tile(LAS unsigned char* img, const bf16* src, int tid, float lg) {
    v4u v[8];
#pragma unroll
    for (int r = 0; r < 8; ++r) { const int pc = tid + 512 * r, row = pc >> 5, c16 = pc & 31; v[r] = *(const v4u*)(src + (size_t)row * 1024 + c16 * 8); }
#pragma unroll
    for (int r = 0; r < 8; ++r) { const int pc = tid + 512 * r, row = pc >> 5, c16 = pc & 31; v4u w = v[r];
        if (DECAY) { const float sc = exp2f(lg * (float)(127 - row));
            w.x = cvt2(bflo(w.x) * sc, bfhi(w.x) * sc); w.y = cvt2(bflo(w.y) * sc, bfhi(w.y) * sc); w.z = cvt2(bflo(w.z) * sc, bfhi(w.z) * sc); w.w = cvt2(bflo(w.w) * sc, bfhi(w.w) * sc); }
        *(LAS v4u*)(img + row * RS_T + c16 * 16) = w; }
}

__device__ __forceinline__ void phase_ret_u_mfma(const Params& P, const Ctx& cx, LAS unsigned char* lds) {
    unsigned char* ws = cx.ws; const int tid = cx.tid, lane = cx.lane, w = cx.wave, r16 = lane & 15, g = lane >> 4, q = r16 >> 2, pp = r16 & 3;
    const bf16* K = (const bf16*)(ws + WS_K); const bf16* V = (const bf16*)(ws + WS_V); bf16* UT = (bf16*)(ws + WS_U);
    LAS unsigned char* Kim = lds; LAS unsigned char* Vim = lds + TILE_T;
    for (int b = cx.bid; b < 512; b += cx.G) {
        const int nb = b >> 2, h = b & 3;
        __syncthreads();
        stage_tile<true>(Kim, K + (size_t)nb * 128 * 1024 + h * 256, tid, P.lg2g[h]);
        stage_tile<false>(Vim, V + (size_t)nb * 128 * 1024 + h * 256, tid, 0.f);
        __syncthreads();
        f32x4 acc[2][16];
#pragma unroll
        for (int mi = 0; mi < 2; ++mi)
#pragma unroll
            for (int n = 0; n < 16; ++n) acc[mi][n] = (f32x4){0.f, 0.f, 0.f, 0.f};
#pragma unroll 1
        for (int s = 0; s < 4; ++s) {
            bf16x8 af[2];
#pragma unroll
            for (int mi = 0; mi < 2; ++mi) { LAS unsigned char* a0 = Kim + (32 * s + 8 * g + q) * RS_T + (16 * (2 * w + mi) + 4 * pp) * 2; af[mi] = cat44(lds_tr(a0), lds_tr(a0 + 4 * RS_T)); }
#pragma unroll
            for (int n = 0; n < 16; ++n) { LAS unsigned char* b0 = Vim + (32 * s + 8 * g + q) * RS_T + (16 * n + 4 * pp) * 2; const bf16x8 bfr = cat44(lds_tr(b0), lds_tr(b0 + 4 * RS_T));
                acc[0][n] = mfma16(af[0], bfr, acc[0][n]); acc[1][n] = mfma16(af[1], bfr, acc[1][n]); }
        }
#pragma unroll
        for (int mi = 0; mi < 2; ++mi)
#pragma unroll
            for (int n = 0; n < 16; ++n) { v2u o; o.x = cvt2(acc[mi][n][0], acc[mi][n][1]); o.y = cvt2(acc[mi][n][2], acc[mi][n][3]);
                *(v2u*)(UT + ((size_t)b * 256 + 16 * n + r16) * 256 + 16 * (2 * w + mi) + 4 * g) = o; }
    }
}
__device__ __forceinline__ void phase_scan_bf16(const Params& P, const Ctx& cx) {
    unsigned* UT = (unsigned*)(cx.ws + WS_U);
    const size_t gt = (size_t)cx.bid * 512 + cx.tid, NT = (size_t)cx.G * 512;
    for (size_t idx = gt; idx < 131072; idx += NT) {
        const int h = (int)(idx >> 15); const float cd = exp2f(P.lg2g[h] * 128.0f);
        float r0 = 0.f, r1 = 0.f;
        for (int n0 = 0; n0 < 128; n0 += 8) { unsigned u[8];
#pragma unroll
            for (int j = 0; j < 8; ++j) u[j] = UT[(size_t)(n0 + j) * 131072 + idx];
#pragma unroll
            for (int j = 0; j < 8; ++j) { UT[(size_t)(n0 + j) * 131072 + idx] = cvt2(r0, r1); r0 = r0 * cd + bflo(u[j]); r1 = r1 * cd + bfhi(u[j]); } }
    }
}
__device__ __forceinline__ void phase_ret_out_mfma(const Params& P, const Ctx& cx, int l, LAS unsigned char* lds) {
    unsigned char* ws = cx.ws; const int tid = cx.tid, lane = cx.lane, w = cx.wave, r16 = lane & 15, g = lane >> 4, q = r16 >> 2, pp = r16 & 3;
    const bf16* Q = (const bf16*)(ws + WS_Q); const bf16* K = (const bf16*)(ws + WS_K); const bf16* V = (const bf16*)(ws + WS_V); const bf16* ST = (const bf16*)(ws + WS_U);
    const bf16* Gt = (const bf16*)(ws + WS_G); bf16* MIX = (bf16*)(ws + WS_MIX);
    const float* gg = P.in[5] + l * 1024; const float* gb = P.in[6] + l * 1024;
    LAS unsigned char* Kim = lds; LAS unsigned char* Vim = lds + TILE_T;
    for (int b = cx.bid; b < 512; b += cx.G) {
        const int nb = b >> 2, h = b & 3; const float lg = P.lg2g[h];
        __syncthreads();
        stage_tile<false>(Kim, K + (size_t)nb * 128 * 1024 + h * 256, tid, 0.f);
        stage_tile<false>(Vim, V + (size_t)nb * 128 * 1024 + h * 256, tid, 0.f);
        bf16x8 qf[8];
        { const bf16* qrow = Q + (size_t)(nb * 128 + 16 * w + r16) * 1024 + h * 256 + 8 * g;
#pragma unroll
          for (int s = 0; s < 8; ++s) qf[s] = *(const bf16x8*)(qrow + 32 * s); }
        f32x4 acc[16];
        const bf16* strow = ST + ((size_t)b * 256 + r16) * 256 + 8 * g;
#pragma unroll
        for (int n = 0; n < 16; ++n) { bf16x8 sb[8];
#pragma unroll
            for (int s = 0; s < 8; ++s) sb[s] = *(const bf16x8*)(strow + (size_t)n * 16 * 256 + 32 * s);
            f32x4 a = (f32x4){0.f, 0.f, 0.f, 0.f};
#pragma unroll
            for (int s = 0; s < 8; ++s) a = mfma16(qf[s], sb[s], a);
            acc[n] = a; }
        { float f[4];
#pragma unroll
          for (int r = 0; r < 4; ++r) f[r] = exp2f(lg * (float)(16 * w + 4 * g + r + 1));
#pragma unroll
          for (int n = 0; n < 16; ++n) { acc[n][0] *= f[0]; acc[n][1] *= f[1]; acc[n][2] *= f[2]; acc[n][3] *= f[3]; } }
        __syncthreads();
        f32x4 sc[8];
#pragma unroll
        for (int mb = 0; mb < 8; ++mb) { sc[mb] = (f32x4){0.f, 0.f, 0.f, 0.f};
            if (mb <= w) { f32x4 a = (f32x4){0.f, 0.f, 0.f, 0.f};
#pragma unroll
                for (int s = 0; s < 8; ++s) { const bf16x8 kf = *(const LAS bf16x8*)(Kim + (16 * mb + r16) * RS_T + (32 * s + 8 * g) * 2); a = mfma16(kf, qf[s], a); }
                const int i = 16 * w + r16;
#pragma unroll
                for (int r = 0; r < 4; ++r) { const int j = 16 * mb + 4 * g + r; a[r] = (i >= j) ? a[r] * exp2f(lg * (float)(i - j)) : 0.f; }
                sc[mb] = a; } }
#pragma unroll
        for (int sk = 0; sk < 4; ++sk) {
            if (2 * sk <= w) { const bf16x8 pf = pack_frag(sc[2 * sk], sc[2 * sk + 1]);
#pragma unroll
                for (int n = 0; n < 16; ++n) { LAS unsigned char* b0 = Vim + (32 * sk + 4 * g + q) * RS_T + (16 * n + 4 * pp) * 2; const bf16x8 bfr = cat44(lds_tr(b0), lds_tr(b0 + 16 * RS_T));
                    acc[n] = mfma16(pf, bfr, acc[n]); } } }
        float mean[4], rstd[4];
#pragma unroll
        for (int r = 0; r < 4; ++r) { float sm = 0.f;
#pragma unroll
            for (int n = 0; n < 16; ++n) sm += acc[n][r];
            mean[r] = grp16_sum(sm, lane) * (1.0f / 256.0f); }
#pragma unroll
        for (int r = 0; r < 4; ++r) { float sq = 0.f;
#pragma unroll
            for (int n = 0; n < 16; ++n) { const float d = acc[n][r] - mean[r]; sq += d * d; }
            rstd[r] = 1.0f / sqrtf(grp16_sum(sq, lane) * (1.0f / 256.0f) + GN_EPS); }
#pragma unroll
        for (int n = 0; n < 16; ++n) { const int e = h * 256 + 16 * n + r16; const float g1 = gg[e], b1 = gb[e];
#pragma unroll
            for (int r = 0; r < 4; ++r) { const size_t row = (size_t)(nb * 128 + 16 * w + 4 * g + r);
                const float o = ((acc[n][r] - mean[r]) * rstd[r] * g1 + b1) * bf1(Gt + row * 1024 + e);
                MIX[row * 2048 + e] = (bf16)f2bf(o); } }
    }
}
constexpr int RS_SK = 144, RS_SV = 160;
__device__ __forceinline__ void phase_swa_mfma(const Params& P, const Ctx& cx, int l, LAS unsigned char* lds) {
    unsigned char* ws = cx.ws; const int tid = cx.tid, lane = cx.lane, w = cx.wave, r16 = lane & 15, g = lane >> 4, q = r16 >> 2, pp = r16 & 3;
    const bf16* AQ = (const bf16*)(ws + WS_AQ); const bf16* AK = (const bf16*)(ws + WS_AK); const bf16* AV = (const bf16*)(ws + WS_AV); bf16* MIX = (bf16*)(ws + WS_MIX);
    LAS unsigned char* Kim = lds; LAS unsigned char* Vim = lds + 256 * RS_SK;
    for (int item = cx.bid; item < 256; item += cx.G) {
        const int nb = item >> 1, hk = item & 1, hq = hk * 8 + w; const float sink = P.in[7][l * 16 + hq];
        __syncthreads();
#pragma unroll
        for (int r = 0; r < 4; ++r) { const int pc = tid + 512 * r, row = pc >> 3, c = pc & 7, gk = nb * 128 - 128 + row;
            v4u kv = (v4u){0u, 0u, 0u, 0u}, vv = (v4u){0u, 0u, 0u, 0u};
            if (gk >= 0) { kv = *(const v4u*)(AK + (size_t)gk * 128 + hk * 64 + c * 8); vv = *(const v4u*)(AV + (size_t)gk * 128 + hk * 64 + c * 8); }
            *(LAS v4u*)(Kim + row * RS_SK + c * 16) = kv; *(LAS v4u*)(Vim + row * RS_SV + c * 16) = vv; }
        __syncthreads();
#pragma unroll 1
        for (int nq = 0; nq < 8; ++nq) {
            const bf16* qrow = AQ + (size_t)(nb * 128 + 16 * nq + r16) * 1024 + hq * 64 + 8 * g;
            const bf16x8 qf0 = *(const bf16x8*)(qrow), qf1 = *(const bf16x8*)(qrow + 32);
            f32x4 sc[10];
            float mx = sink;
#pragma unroll
            for (int kb = 0; kb < 9; ++kb) { const LAS unsigned char* kp = Kim + (16 * (nq + kb) + r16) * RS_SK + 16 * g;
                f32x4 a = (f32x4){0.f, 0.f, 0.f, 0.f};
                a = mfma16(*(const LAS bf16x8*)(kp), qf0, a); a = mfma16(*(const LAS bf16x8*)(kp + 64), qf1, a);
#pragma unroll
                for (int r = 0; r < 4; ++r) { const int dl = 16 * kb + 4 * g + r - r16; const bool vis = (dl >= 1) && (dl <= 128) && (nb > 0 || 16 * (nq + kb) + 4 * g + r >= 128);
                    a[r] = vis ? a[r] : -INFINITY; mx = fmaxf(mx, a[r]); }
                sc[kb] = a; }
            sc[9] = (f32x4){0.f, 0.f, 0.f, 0.f};
            mx = fmaxf(mx, __builtin_bit_cast(float, __builtin_amdgcn_ds_bpermute((lane ^ 16) << 2, __builtin_bit_cast(int, mx))));
            mx = fmaxf(mx, __builtin_bit_cast(float, __builtin_amdgcn_ds_bpermute((lane ^ 32) << 2, __builtin_bit_cast(int, mx))));
            float sum = 0.f;
#pragma unroll
            for (int kb = 0; kb < 9; ++kb)
#pragma unroll
                for (int r = 0; r < 4; ++r) { const float pv = __expf(sc[kb][r] - mx); sc[kb][r] = pv; sum += pv; }
            sum += __builtin_bit_cast(float, __builtin_amdgcn_ds_bpermute((lane ^ 16) << 2, __builtin_bit_cast(int, sum)));
            sum += __builtin_bit_cast(float, __builtin_amdgcn_ds_bpermute((lane ^ 32) << 2, __builtin_bit_cast(int, sum)));
            const float inv = 1.0f / (sum + __expf(sink - mx));
            f32x4 o[4];
#pragma unroll
            for (int nd = 0; nd < 4; ++nd) o[nd] = (f32x4){0.f, 0.f, 0.f, 0.f};
#pragma unroll
            for (int sk = 0; sk < 5; ++sk) { const bf16x8 pf = pack_frag(sc[2 * sk] * inv, sc[2 * sk + 1] * inv);
                const int kb0 = nq + 2 * sk, kb1 = (kb0 + 1 > 15) ? 15 : kb0 + 1;
#pragma unroll
                for (int nd = 0; nd < 4; ++nd) { const bf16x8 bfr = cat44(lds_tr(Vim + (16 * kb0 + 4 * g + q) * RS_SV + (16 * nd + 4 * pp) * 2), lds_tr(Vim + (16 * kb1 + 4 * g + q) * RS_SV + (16 * nd + 4 * pp) * 2));
                    o[nd] = mfma16(pf, bfr, o[nd]); } }
#pragma unroll
            for (int nd = 0; nd < 4; ++nd)
#pragma unroll
                for (int r = 0; r < 4; ++r) MIX[(size_t)(nb * 128 + 16 * nq + 4 * g + r) * 2048 + 1024 + hq * 64 + 16 * nd + r16] = (bf16)f2bf(o[nd][r]);
        }
    }
}

__device__ __forceinline__ void phase_groupnorm(const Params& P, const Ctx& cx, int l) {
    unsigned char* ws = cx.ws; const int lane = cx.lane, wave = cx.wave, G = cx.G;
    const float* RY = (const float*)(ws + WS_RETY); const bf16* Gt = (const bf16*)(ws + WS_G); bf16* MIX = (bf16*)(ws + WS_MIX);
    const float* gg = P.in[5] + l * 1024; const float* gb = P.in[6] + l * 1024;
    const int gw = cx.bid * 8 + wave, NGW = G * 8;
    for (int it = gw; it < S * 4; it += NGW) { const int row = it >> 2, h = it & 3; const size_t off = (size_t)row * 1024 + h * 256 + 4 * lane;
        f32x4 v = *(const f32x4*)(RY + off);
        const float mean = wave_sum((v[0] + v[1]) + (v[2] + v[3]), lane) * (1.0f / 256.0f);
        v = v - mean;
        const float var = wave_sum((v[0] * v[0] + v[1] * v[1]) + (v[2] * v[2] + v[3] * v[3]), lane) * (1.0f / 256.0f);
        const float rstd = 1.0f / sqrtf(var + GN_EPS);
        const f32x4 g4 = *(const f32x4*)(gg + h * 256 + 4 * lane), b4 = *(const f32x4*)(gb + h * 256 + 4 * lane);
        const v2u gt2 = *(const v2u*)(Gt + off);
        f32x4 o = v * rstd * g4 + b4;
        o[0] *= bflo(gt2.x); o[1] *= bfhi(gt2.x); o[2] *= bflo(gt2.y); o[3] *= bfhi(gt2.y);
        v2u w; w.x = pk2(o[0], o[1]); w.y = pk2(o[2], o[3]);
        *(v2u*)(MIX + (size_t)row * 2048 + h * 256 + 4 * lane) = w; }
}
__device__ __forceinline__ void phase_ln(const Ctx& cx, const float* Y, const float* g, const float* b, float* xo, bf16* xb) {
    const int lane = cx.lane, wave = cx.wave, G = cx.G; const int gw = cx.bid * 8 + wave, NGW = G * 8;
    for (int row = gw; row < S; row += NGW) {
        const f32x4* yr = (const f32x4*)(Y + (size_t)row * D) + lane;
        f32x4 v[8]; float s = 0.f;
#pragma unroll
        for (int j = 0; j < 8; ++j) { v[j] = yr[64 * j]; s += (v[j][0] + v[j][1]) + (v[j][2] + v[j][3]); }
        const float mean = wave_sum(s, lane) * (1.0f / D); float s2 = 0.f;
#pragma unroll
        for (int j = 0; j < 8; ++j) { v[j] = v[j] - mean; s2 += (v[j][0] * v[j][0] + v[j][1] * v[j][1]) + (v[j][2] * v[j][2] + v[j][3] * v[j][3]); }
        const float rstd = 1.0f / sqrtf(wave_sum(s2, lane) * (1.0f / D) + LN_EPS);
        f32x4* xr = (f32x4*)(xo + (size_t)row * D) + lane;
#pragma unroll
        for (int j = 0; j < 8; ++j) { const f32x4 g4 = ((const f32x4*)g)[64 * j + lane], b4 = ((const f32x4*)b)[64 * j + lane]; const f32x4 o = v[j] * rstd * g4 + b4; xr[64 * j] = o;
            if (xb) { v2u w; w.x = pk2(o[0], o[1]); w.y = pk2(o[2], o[3]); ((v2u*)(xb + (size_t)row * D))[64 * j + lane] = w; } }
    }
}
__device__ __forceinline__ void phase_convact(const Params& P, const Ctx& cx, int l) {
    unsigned char* ws = cx.ws; const int tid = cx.tid, G = cx.G;
    const bf16* H = (const bf16*)(ws + WS_H); bf16* ACT = (bf16*)(ws + WS_ACT);
    const float* cw = P.in[11] + (size_t)l * 3 * NUP; const float* cb = P.in[12] + (size_t)l * NUP;
    const size_t gt = (size_t)cx.bid * 512 + tid, NT = (size_t)G * 512;
    for (size_t idx = gt; idx < (size_t)S * 704; idx += NT) {
        const int t = (int)(idx / 704), r = (int)(idx % 704), tile = r >> 4, q8 = r & 15;
        const int chg = 128 * tile + 8 * q8, chu = DFF + chg;
        float ag[8], au[8];
#pragma unroll
        for (int e = 0; e < 8; ++e) { ag[e] = cb[chg + e]; au[e] = cb[chu + e]; }
#pragma unroll
        for (int k = 0; k < 3; ++k) { const int tt = t - 2 + k; if (tt >= 0) {
            const v4u hg = *(const v4u*)(H + (size_t)tt * NUP + 256 * tile + 8 * q8), hu = *(const v4u*)(H + (size_t)tt * NUP + 256 * tile + 128 + 8 * q8);
            const float g8[8] = {bflo(hg.x), bfhi(hg.x), bflo(hg.y), bfhi(hg.y), bflo(hg.z), bfhi(hg.z), bflo(hg.w), bfhi(hg.w)};
            const float u8[8] = {bflo(hu.x), bfhi(hu.x), bflo(hu.y), bfhi(hu.y), bflo(hu.z), bfhi(hu.z), bflo(hu.w), bfhi(hu.w)};
#pragma unroll
            for (int e = 0; e < 8; ++e) { ag[e] += cw[(size_t)k * NUP + chg + e] * g8[e]; au[e] += cw[(size_t)k * NUP + chu + e] * u8[e]; } } }
        float o[8];
#pragma unroll
        for (int e = 0; e < 8; ++e) o[e] = ag[e] / (1.0f + __expf(-ag[e])) * au[e];
        v4u w; w.x = pk2(o[0], o[1]); w.y = pk2(o[2], o[3]); w.z = pk2(o[4], o[5]); w.w = pk2(o[6], o[7]);
        *(v4u*)(ACT + (size_t)t * DFF + chg) = w;
    }
}

#ifdef DBG_DUMP
__device__ __forceinline__ void phase_dump(const Ctx& cx, float* out, const bf16* a, int lda, const bf16* b, int ldb, const float* f) {
    const size_t gt = (size_t)cx.bid * 512 + cx.tid, NT = (size_t)cx.G * 512;
    for (size_t i = gt; i < (size_t)S * D; i += NT) { const int row = (int)(i >> 11), col = (int)(i & 2047);
        float v; if (f) v = f[i]; else if (b && col >= 1024) v = bf1(b + (size_t)row * ldb + (col - 1024)); else v = lda ? bf1(a + (size_t)row * lda + col) : bf1(a + (size_t)(row & 2047) * 2048 + col);
        out[i] = v; }
}
#endif
__global__ void __launch_bounds__(512, 2) fwd(Params P) {
    extern __shared__ __attribute__((aligned(16))) unsigned char lds_raw[];
    LAS unsigned char* lds = (LAS unsigned char*)lds_raw;
    const int wave = __builtin_amdgcn_readfirstlane(threadIdx.x >> 6), G = gridDim.x;
    unsigned char* ws = P.ws;
    volatile LAS unsigned* MISC = (volatile LAS unsigned*)(lds + MISC_OFF);
    for (int u = threadIdx.x; u < (LDS_BYTES - LDSCTL_OFF) / 4; u += 512) ((LAS unsigned*)(lds + LDSCTL_OFF))[u] = 0u;
    __syncthreads();
    const int lo = P.ph_lo, hi = P.ph_hi;
    XcdBarrier bar; bar.bar = (unsigned*)(ws + WS_CTL) + CW_BAR; bar.x = 0; bar.st = nullptr;
    if (hi - lo > 1) bar = xcd_barrier_post((unsigned*)(ws + WS_CTL) + CW_BAR, MISC + 8);
#define IN(k) (lo <= (k) && (k) < hi)
#define SEAM(k) do { if (IN(k) && IN((k) + 1)) xcd_barrier(bar); } while (0)
#define OPQ() Ctx cx; cx.lane = lane_id_asm(); { int t_ = wave; asm volatile("" : "+s"(t_)); cx.wave = t_; } { int t_ = G; asm volatile("" : "+s"(t_)); cx.G = t_; } { int t_ = blockIdx.x; asm volatile("" : "+s"(t_)); cx.bid = t_; } \
    { unsigned t_ = 0u; asm volatile("" : "+s"(t_)); cx.ws = P.ws + t_; } cx.tid = cx.wave * 64 + cx.lane; int lq = l; asm volatile("" : "+s"(lq)); (void)lq

#ifdef DBG_DUMP
    if (lo >= 1000) { const int l = 0; OPQ(); unsigned char* w = cx.ws; const int kind = lo - 1000;
        if (kind == 1) phase_dump(cx, P.out, (const bf16*)(w + WS_Q), 1024, (const bf16*)(w + WS_AQ), 1024, nullptr);
        else if (kind == 2) phase_dump(cx, P.out, (const bf16*)(w + WS_MIX), 2048, nullptr, 0, nullptr);
        else if (kind == 3) phase_dump(cx, P.out, nullptr, 0, nullptr, 0, (const float*)(w + WS_XR));
        else if (kind == 4) phase_dump(cx, P.out, (const bf16*)(w + WS_ACT), DFF, nullptr, 0, nullptr);
        else if (kind == 5) phase_dump(cx, P.out, nullptr, 0, nullptr, 0, (const float*)(w + WS_Y));
        else if (kind == 6) phase_dump(cx, P.out, (const bf16*)(w + WS_K), 1024, (const bf16*)(w + WS_V), 1024, nullptr);
        else if (kind == 7) phase_dump(cx, P.out, (const bf16*)(w + WS_XB), 2048, nullptr, 0, nullptr);
        else if (kind == 11) phase_dump(cx, P.out, (const bf16*)(w + WS_W + WL_G), 0, nullptr, 0, nullptr);
        else if (kind == 12) phase_dump(cx, P.out, (const bf16*)(w + WS_W + WL_OUT), 0, nullptr, 0, nullptr);
        else if (kind == 10) phase_dump(cx, P.out, (const bf16*)(w + WS_H) + 36 * 256, NUP, nullptr, 0, nullptr);
        else if (kind == 9) phase_dump(cx, P.out, (const bf16*)(w + WS_SG), 2048, nullptr, 0, nullptr);
        else if (kind == 8) phase_dump(cx, P.out, nullptr, 0, nullptr, 0, (const float*)(w + WS_RETY));
        return; }
#endif
    if (IN(0)) { const int l = 0; OPQ(); phase_prologue(P, cx, lds); }
    SEAM(0);

    for (int l = 0; l < DEPTH; ++l) {
        const int pb = 1 + l * NPH;
        if (IN(pb + 0)) { OPQ(); unsigned char* w = cx.ws; const bf16* wl = (const bf16*)(w + WS_W + (size_t)lq * WL_BYTES);
            pg8::Gemm g{(const bf16*)(w + WS_XB), wl + WL_IN / 2, S, INW, D}; pg8::StaticOrder So; So.init(S, INW, cx.G, cx.bid);
            pg8::EpiInProj E{(bf16*)(w + WS_Q), (bf16*)(w + WS_K), (bf16*)(w + WS_V), (bf16*)(w + WS_G), (bf16*)(w + WS_AQ), (bf16*)(w + WS_AK), (bf16*)(w + WS_AV),
                             (const float*)(w + WS_COSR), (const float*)(w + WS_SINR), (const float*)(w + WS_COSA), (const float*)(w + WS_SINA)};
            pg8::gemm_phase<pg8::EpiInProj, pg8::StaticOrder, true, true>(lds, g, So, E, cx.wave);
        }
        SEAM(pb + 0);
        if (IN(pb + 1)) {
#if RET_MFMA
            { OPQ(); phase_ret_u_mfma(P, cx, lds); }
#else
            { OPQ(); phase_ret_u_scores(P, cx, lds); }
#endif
#if SWA_MFMA
            { OPQ(); phase_swa_mfma(P, cx, lq, lds); }
#else
            { OPQ(); phase_swa(P, cx, lq, lds); }
#endif
        }
        SEAM(pb + 1);
#if RET_MFMA
        if (IN(pb + 2)) { OPQ(); phase_scan_bf16(P, cx); }
        SEAM(pb + 2);
        if (IN(pb + 3)) { OPQ(); phase_ret_out_mfma(P, cx, lq, lds); }
        SEAM(pb + 3);
#else
        if (IN(pb + 2)) { OPQ(); phase_scan(P, cx); }
        SEAM(pb + 2);
        if (IN(pb + 3)) { OPQ(); phase_ret_out(P, cx, lds); }
        SEAM(pb + 3);
        if (IN(pb + 4)) { OPQ(); phase_groupnorm(P, cx, lq); }
        SEAM(pb + 4);
#endif
        if (IN(pb + 5)) { OPQ(); unsigned char* w = cx.ws; const bf16* wl = (const bf16*)(w + WS_W + (size_t)lq * WL_BYTES);
            pg8::Gemm g{(const bf16*)(w + WS_MIX), wl + WL_OUT / 2, S, D, D}; pg8::StaticOrder So; So.init(S, D, cx.G, cx.bid);
            pg8::EpiResid<false> E{(lq == 0) ? P.in[0] : (const float*)(w + WS_XR), (float*)(w + WS_Y), ALPHA};
            pg8::gemm_phase<pg8::EpiResid<false>, pg8::StaticOrder, true, true>(lds, g, So, E, cx.wave);
        }
        SEAM(pb + 5);
        if (IN(pb + 6)) { OPQ(); unsigned char* w = cx.ws; phase_ln(cx, (const float*)(w + WS_Y), P.in[8] + lq * D, P.in[9] + lq * D, (float*)(w + WS_XR), (bf16*)(w + WS_XB)); }
        SEAM(pb + 6);
        if (IN(pb + 7)) { OPQ(); unsigned char* w = cx.ws; const bf16* wl = (const bf16*)(w + WS_W + (size_t)lq * WL_BYTES);
            pg8::Gemm g{(const bf16*)(w + WS_XB), wl + WL_UP / 2, S, NUPG, D}; pg8::StaticOrder So; So.init(S, NUPG, cx.G, cx.bid);
            pg8::EpiUp E{(bf16*)(w + WS_H), (bf16*)(w + WS_SG), P.in[17] + lq * D};
            pg8::gemm_phase<pg8::EpiUp, pg8::StaticOrder, true, true>(lds, g, So, E, cx.wave);
        }
        SEAM(pb + 7);
        if (IN(pb + 8)) {
            { OPQ(); unsigned char* w = cx.ws; const bf16* wl = (const bf16*)(w + WS_W + (size_t)lq * WL_BYTES);
              pg8::Gemm g{(const bf16*)(w + WS_PB) + (size_t)lq * S * PLE, wl + WL_P / 2, S, D, PLE}; pg8::StaticOrder So; So.init(S, D, cx.G, cx.bid);
              pg8::EpiPle E{(const bf16*)(w + WS_SG), (float*)(w + WS_Y)};
              pg8::gemm_phase<pg8::EpiPle, pg8::StaticOrder, true, true>(lds, g, So, E, cx.wave); }
            { OPQ(); phase_convact(P, cx, lq); }
        }
        SEAM(pb + 8);
        if (IN(pb + 9)) { OPQ(); unsigned char* w = cx.ws; const bf16* wl = (const bf16*)(w + WS_W + (size_t)lq * WL_BYTES);
            pg8::Gemm g{(const bf16*)(w + WS_ACT), wl + WL_DOWN / 2, S, D, DFF}; pg8::StaticOrder So; So.init(S, D, cx.G, cx.bid);
            pg8::EpiResid<true> E{(const float*)(w + WS_XR), (float*)(w + WS_Y), ALPHA};
            pg8::gemm_phase<pg8::EpiResid<true>, pg8::StaticOrder, true, true>(lds, g, So, E, cx.wave);
        }
        SEAM(pb + 9);
        if (IN(pb + 10)) { OPQ(); unsigned char* w = cx.ws; const bool last = (lq == DEPTH - 1);
            phase_ln(cx, (const float*)(w + WS_Y), P.in[14] + lq * D, P.in[15] + lq * D, last ? P.out : (float*)(w + WS_XR), last ? (bf16*)nullptr : (bf16*)(w + WS_XB)); }
        SEAM(pb + 10);
    }
#undef IN
#undef SEAM
}

extern "C" void kernel_launch(void* const* d_in, const int* in_sizes, int n_in, void* d_out, int out_size, void* d_ws, size_t ws_size, hipStream_t stream) {
    static int grid = 0;
    if (grid == 0) {
        if (n_in != 19 || in_sizes[0] != S * D || out_size != S * D || ws_size < WS_END) { fprintf(stderr, "kernel_launch: unexpected shapes (n_in %d, in0 %d, out %d, ws %zu)\n", n_in, n_in > 0 ? in_sizes[0] : -1, out_size, ws_size); grid = -1; return; }
        int dev = 0, cus = 0, per_cu = 0;
        if (hipGetDevice(&dev) != hipSuccess || hipDeviceGetAttribute(&cus, hipDeviceAttributeMultiprocessorCount, dev) != hipSuccess) { grid = -1; return; }
        if (hipFuncSetAttribute((const void*)fwd, hipFuncAttributeMaxDynamicSharedMemorySize, LDS_BYTES) != hipSuccess) { fprintf(stderr, "kernel_launch: hipFuncSetAttribute failed\n"); grid = -1; return; }
        if (hipOccupancyMaxActiveBlocksPerMultiprocessor(&per_cu, (const void*)fwd, 512, LDS_BYTES) != hipSuccess || per_cu < 1) fprintf(stderr, "kernel_launch: occupancy query says %d\n", per_cu);
        (void)hipGetLastError();
        grid = cus;
    }
    if (grid < 0) return;
    (void)hipMemsetAsync((char*)d_ws + WS_CTL, 0, CTL_ZERO_BYTES, stream);
#ifdef DBG_NANFILL
    (void)hipMemsetAsync((char*)d_ws + CTL_ZERO_BYTES, 0xFF, WS_END - CTL_ZERO_BYTES, stream);
#endif
    Params p{};
    for (int i = 0; i < 19; ++i) p.in[i] = (const float*)d_in[i];
    p.out = (float*)d_out; p.ws = (unsigned char*)d_ws;
    for (int f = 0; f < 128; ++f) p.invf_ret[f] = (float)(1.0 / std::pow(10000.0, (double)((float)f / 127.0f)));
    for (int f = 0; f < 32; ++f) p.invf_att[f] = (float)std::pow(10000.0, -(double)(2 * f) / 64.0);
    for (int h = 0; h < 4; ++h) p.lg2g[h] = (float)std::log2(1.0 - std::exp2(-5.0 - h));
#if MK_ONE_LAUNCH
    p.ph_lo = 0; p.ph_hi = NPHASES;
    hipLaunchKernelGGL(fwd, dim3(grid), dim3(512), LDS_BYTES, stream, p);
#else
#ifdef DBG_DUMP
    for (int ph = 0; ph <= DBG_STOP; ++ph) { p.ph_lo = ph; p.ph_hi = ph + 1; hipLaunchKernelGGL(fwd, dim3(grid), dim3(512), LDS_BYTES, stream, p); }
    p.ph_lo = 1000 + DBG_DUMP; p.ph_hi = p.ph_lo + 1; hipLaunchKernelGGL(fwd, dim3(grid), dim3(512), LDS_BYTES, stream, p);
#else
    for (int ph = 0; ph < NPHASES; ++ph) { p.ph_lo = ph; p.ph_hi = ph + 1; hipLaunchKernelGGL(fwd, dim3(grid), dim3(512), LDS_BYTES, stream, p); }
#endif
#endif
}
```

```cpp
#include <hip/hip_runtime.h>
#include <cstdio>
#include <cstdint>
#include <cmath>
#define MK_ONE_LAUNCH 1
namespace pg8 {
#define PG8_LAS __attribute__((address_space(3)))
typedef unsigned short bf16_t;
typedef short bf16x8 __attribute__((ext_vector_type(8)));
typedef float f32x4 __attribute__((ext_vector_type(4)));
typedef unsigned u32x4 __attribute__((ext_vector_type(4)));
constexpr int BM = 256, BK = 64, HALF = 128, HTB = HALF * BK * 2  , STAGE_BYTES = 8 * HTB, NXCD = 8, WGM = 8;

__host__ __device__ __forceinline__ int lds_byte(int r, int c) { const int st = (r >> 4) * 2 + (c >> 5), rr = r & 15, cc = c & 31, ob = rr * 64 + cc * 2; return st * 1024 + (ob ^ (((ob >> 9) & 1) << 5)); }
__host__ __device__ __forceinline__ void stage_rc(int b, int& R, int& C) { const int st = b / 1024, sb = b % 1024, swz = sb ^ (((sb >> 9) & 1) << 5); R = (st >> 1) * 16 + swz / 64; C = (st & 1) * 32 + (swz % 64) / 2; }
__host__ __device__ __forceinline__ int perm32(int rho) { const int n = rho >> 4, i = rho & 15; return 8 * (i >> 2) + 4 * n + (i & 3); }

struct Unit { int pm, pn; };
struct Gemm { const bf16_t* A; const bf16_t* Bt; int M, N, K; };

struct StaticOrder {
    int nM, nN, nwg, G, c;
    __host__ __device__ void init(int M, int N, int G_, int c_) { nM = M / BM; nN = N / BM; nwg = nM * nN; G = G_; c = c_; }
    __host__ __device__ bool next(int i, Unit& u) const {
        const long L = (long)i * G + c; if (L >= nwg) return false;
        int wgid = (int)L; { const int q = nwg / NXCD, r = nwg % NXCD, xcd = wgid % NXCD, off = wgid / NXCD; wgid = (xcd < r ? xcd * (q + 1) : r * (q + 1) + (xcd - r) * q) + off; }
        const int nig = WGM * nN, gid = wgid / nig, fm = gid * WGM, gsz = (nM - fm) < WGM ? (nM - fm) : WGM;
        u.pm = fm + ((wgid % nig) % gsz); u.pn = (wgid % nig) / gsz; return true;
    }
    __device__ __forceinline__ void a_ready(const Unit&) const {}
    __device__ __forceinline__ void done(const Unit&) const {}
};

typedef float f32x2c_t __attribute__((ext_vector_type(2))); typedef __bf16 bf16x2c_t __attribute__((ext_vector_type(2)));
__device__ __forceinline__ unsigned cvt_pk_bf16(float lo, float hi) { f32x2c_t v = {lo, hi}; bf16x2c_t b = __builtin_convertvector(v, bf16x2c_t); return __builtin_bit_cast(unsigned, b); }
typedef float f32x2 __attribute__((ext_vector_type(2)));
typedef unsigned u32x2 __attribute__((ext_vector_type(2)));
__device__ __forceinline__ float bf2f(unsigned short b) { return __uint_as_float(((unsigned)b) << 16); }
__device__ __forceinline__ u32x4 pack8(const f32x4 a, const f32x4 b) { u32x4 w; w.x = cvt_pk_bf16(a[0], a[1]); w.y = cvt_pk_bf16(a[2], a[3]); w.z = cvt_pk_bf16(b[0], b[1]); w.w = cvt_pk_bf16(b[2], b[3]); return w; }
__device__ __forceinline__ float sigmoidf_(float x) { return __builtin_amdgcn_rcpf(1.0f + __expf(-x)); }

struct EpiInProj {
    static constexpr bool PERM = true, AFTER_DRAIN = false;
    bf16_t *Q, *K, *V, *G, *AQ, *AK, *AV; const float *cosr, *sinr, *cosa, *sina;
    __device__ __forceinline__ void operator()(const f32x4 (&acc)[2][2][4][2], const Unit& u, int wr, int wc, int fr, int fq) const {
        const int row0 = u.pm * BM + wr * 64 + fr, pn = u.pn, cw = wc * 32 + 8 * fq;
        if (pn < 8) {
            bf16_t* O = pn < 4 ? Q : K; const int hcol = (pn & 3) * 256; const float sc = pn < 4 ? 1.0f : 0.0625f;
#pragma unroll
            for (int ai = 0; ai < 2; ++ai)
#pragma unroll
                for (int m = 0; m < 4; ++m) { const int row = row0 + ai * HALF + m * 16;
                    const f32x4 c0 = *(const f32x4*)(cosr + (size_t)row * 128 + cw), c1 = *(const f32x4*)(cosr + (size_t)row * 128 + cw + 4);
                    const f32x4 s0 = *(const f32x4*)(sinr + (size_t)row * 128 + cw), s1 = *(const f32x4*)(sinr + (size_t)row * 128 + cw + 4);
                    const f32x4 a0 = acc[ai][0][m][0], a1 = acc[ai][0][m][1], b0 = acc[ai][1][m][0], b1 = acc[ai][1][m][1];
                    const f32x4 o10 = (a0 * c0 - b0 * s0) * sc, o11 = (a1 * c1 - b1 * s1) * sc, o20 = (a0 * s0 + b0 * c0) * sc, o21 = (a1 * s1 + b1 * c1) * sc;
                    bf16_t* rowp = O + (size_t)row * 1024 + hcol + cw;
                    *(u32x4*)(rowp) = pack8(o10, o11); *(u32x4*)(rowp + HALF) = pack8(o20, o21); }
        } else if (pn < 16) {
            const bool gate = pn >= 12; bf16_t* O = gate ? G : V; const int hcol = (pn & 3) * 256;
#pragma unroll
            for (int ai = 0; ai < 2; ++ai)
#pragma unroll
                for (int m = 0; m < 4; ++m) { const int row = row0 + ai * HALF + m * 16; bf16_t* rowp = O + (size_t)row * 1024 + hcol + cw;
#pragma unroll
                    for (int bj = 0; bj < 2; ++bj) { f32x4 v0 = acc[ai][bj][m][0], v1 = acc[ai][bj][m][1];
                        if (gate) {
#pragma unroll
                            for (int j = 0; j < 4; ++j) { v0[j] = v0[j] * sigmoidf_(v0[j]); v1[j] = v1[j] * sigmoidf_(v1[j]); } }
                        *(u32x4*)(rowp + bj * HALF) = pack8(v0, v1); } }
        } else if (pn < 20) {
            const int t = pn - 16, i0 = 8 * fq;
#pragma unroll
            for (int ai = 0; ai < 2; ++ai)
#pragma unroll
                for (int m = 0; m < 4; ++m) { const int row = row0 + ai * HALF + m * 16;
                    const f32x4 c0 = *(const f32x4*)(cosa + (size_t)row * 32 + i0), c1 = *(const f32x4*)(cosa + (size_t)row * 32 + i0 + 4);
                    const f32x4 s0 = *(const f32x4*)(sina + (size_t)row * 32 + i0), s1 = *(const f32x4*)(sina + (size_t)row * 32 + i0 + 4);
                    const f32x4 a0 = acc[ai][0][m][0], a1 = acc[ai][0][m][1], b0 = acc[ai][1][m][0], b1 = acc[ai][1][m][1];
                    const f32x4 o10 = (a0 * c0 - b0 * s0) * 0.125f, o11 = (a1 * c1 - b1 * s1) * 0.125f, o20 = (a0 * s0 + b0 * c0) * 0.125f, o21 = (a1 * s1 + b1 * c1) * 0.125f;
                    bf16_t* rowp = AQ + (size_t)row * 1024 + t * 256 + wc * 64 + i0;
                    *(u32x4*)(rowp) = pack8(o10, o11); *(u32x4*)(rowp + 32) = pack8(o20, o21); }
        } else {
            const int i0 = 8 * fq;
            if (wc < 2) {
#pragma unroll
                for (int ai = 0; ai < 2; ++ai)
#pragma unroll
                    for (int m = 0; m < 4; ++m) { const int row = row0 + ai * HALF + m * 16;
                        const f32x4 c0 = *(const f32x4*)(cosa + (size_t)row * 32 + i0), c1 = *(const f32x4*)(cosa + (size_t)row * 32 + i0 + 4);
                        const f32x4 s0 = *(const f32x4*)(sina + (size_t)row * 32 + i0), s1 = *(const f32x4*)(sina + (size_t)row * 32 + i0 + 4);
                        const f32x4 a0 = acc[ai][0][m][0], a1 = acc[ai][0][m][1], b0 = acc[ai][1][m][0], b1 = acc[ai][1][m][1];
                        const f32x4 o10 = a0 * c0 - b0 * s0, o11 = a1 * c1 - b1 * s1, o20 = a0 * s0 + b0 * c0, o21 = a1 * s1 + b1 * c1;
                        bf16_t* rowp = AK + (size_t)row * 128 + wc * 64 + i0;
                        *(u32x4*)(rowp) = pack8(o10, o11); *(u32x4*)(rowp + 32) = pack8(o20, o21); }
            } else {
#pragma unroll
                for (int ai = 0; ai < 2; ++ai)
#pragma unroll
                    for (int m = 0; m < 4; ++m) { const int row = row0 + ai * HALF + m * 16; bf16_t* rowp = AV + (size_t)row * 128 + (wc - 2) * 32 + i0;
                        *(u32x4*)(rowp) = pack8(acc[ai][0][m][0], acc[ai][0][m][1]); *(u32x4*)(rowp + 64) = pack8(acc[ai][1][m][0], acc[ai][1][m][1]); }
            }
        }
    }
};
template <bool ADD> struct EpiResid {
    static constexpr bool PERM = false, AFTER_DRAIN = false;
    const float* base; float* Y; float alpha;
    __device__ __forceinline__ void operator()(const f32x4 (&acc)[2][2][4][2], const Unit& u, int wr, int wc, int fr, int fq) const {
        const int row0 = u.pm * BM + wr * 64 + fr, col0 = u.pn * BM + wc * 32 + 4 * fq;
#pragma unroll
        for (int ai = 0; ai < 2; ++ai)
#pragma unroll
            for (int m = 0; m < 4; ++m) { const size_t off = (size_t)(row0 + ai * HALF + m * 16) * 2048 + col0;
#pragma unroll
                for (int bj = 0; bj < 2; ++bj)
#pragma unroll
                    for (int n = 0; n < 2; ++n) { const size_t o = off + bj * HALF + n * 16; f32x4 v = acc[ai][bj][m][n] + *(const f32x4*)(base + o) * alpha;
                        if (ADD) v = v + *(const f32x4*)(Y + o); *(f32x4*)(Y + o) = v; } }
    }
};
struct EpiUp {
    static constexpr bool PERM = true, AFTER_DRAIN = false;
    bf16_t* H; bf16_t* SG; const float* bgate;
    __device__ __forceinline__ void operator()(const f32x4 (&acc)[2][2][4][2], const Unit& u, int wr, int wc, int fr, int fq) const {
        const int row0 = u.pm * BM + wr * 64 + fr, cw = wc * 32 + 8 * fq;
        if (u.pn < 44) {
#pragma unroll
            for (int ai = 0; ai < 2; ++ai)
#pragma unroll
                for (int m = 0; m < 4; ++m) { bf16_t* rowp = H + (size_t)(row0 + ai * HALF + m * 16) * 11264 + u.pn * 256 + cw;
#pragma unroll
                    for (int bj = 0; bj < 2; ++bj) *(u32x4*)(rowp + bj * HALF) = pack8(acc[ai][bj][m][0], acc[ai][bj][m][1]); }
        } else {
            const int colg = (u.pn - 44) * 256 + cw;
            f32x4 bv[2][2];
#pragma unroll
            for (int bj = 0; bj < 2; ++bj)
#pragma unroll
                for (int n = 0; n < 2; ++n) bv[bj][n] = *(const f32x4*)(bgate + colg + bj * HALF + 4 * n);
#pragma unroll
            for (int ai = 0; ai < 2; ++ai)
#pragma unroll
                for (int m = 0; m < 4; ++m) { bf16_t* rowp = SG + (size_t)(row0 + ai * HALF + m * 16) * 2048 + colg;
#pragma unroll
                    for (int bj = 0; bj < 2; ++bj) { f32x4 v0 = acc[ai][bj][m][0] + bv[bj][0], v1 = acc[ai][bj][m][1] + bv[bj][1];
#pragma unroll
                        for (int j = 0; j < 4; ++j) { v0[j] = sigmoidf_(v0[j]); v1[j] = sigmoidf_(v1[j]); }
                        *(u32x4*)(rowp + bj * HALF) = pack8(v0, v1); } }
        }
    }
};
struct EpiPle {
    static constexpr bool PERM = false, AFTER_DRAIN = false;
    const bf16_t* SG; float* Y;
    __device__ __forceinline__ void operator()(const f32x4 (&acc)[2][2][4][2], const Unit& u, int wr, int wc, int fr, int fq) const {
        const int row0 = u.pm * BM + wr * 64 + fr, col0 = u.pn * BM + wc * 32 + 4 * fq;
#pragma unroll
        for (int ai = 0; ai < 2; ++ai)
#pragma unroll
            for (int m = 0; m < 4; ++m) { const size_t off = (size_t)(row0 + ai * HALF + m * 16) * 2048 + col0;
#pragma unroll
                for (int bj = 0; bj < 2; ++bj)
#pragma unroll
                    for (int n = 0; n < 2; ++n) { const size_t o = off + bj * HALF + n * 16; const u32x2 sg = *(const u32x2*)(SG + o);
                        f32x4 g; g[0] = __uint_as_float(sg.x << 16); g[1] = __uint_as_float(sg.x & 0xffff0000u); g[2] = __uint_as_float(sg.y << 16); g[3] = __uint_as_float(sg.y & 0xffff0000u);
                        *(f32x4*)(Y + o) = acc[ai][bj][m][n] * g; } }
    }
};
template <class Epi, class Sched, bool ALIGN_EPI = false, bool SP2 = false>
__device__ __forceinline__ void gemm_phase(PG8_LAS unsigned char* lds, const Gemm g, const Sched& S, const Epi& E, const int wid_in) {
    int lane_; asm volatile("v_mbcnt_lo_u32_b32 %0, -1, 0\n\tv_mbcnt_hi_u32_b32 %0, -1, %0" : "=v"(lane_)); const int wid = wid_in, lane = lane_, tid = wid * 64 + lane, wr = wid >> 2, wc = wid & 3, fr = lane & 15, fq = lane >> 4;
    const int K = g.K, nt = K / BK;
    unsigned voffA[2], voffB[2];
#pragma unroll
    for (int i = 0; i < 2; ++i) { int R, C; stage_rc(tid * 16 + i * 8192, R, C); const int Rb = Epi::PERM ? ((R & ~31) + perm32(R & 31)) : R;
        voffA[i] = (unsigned)(R * K + C) * 2u; voffB[i] = (unsigned)(Rb * K + C) * 2u; }
    const size_t kstep = (size_t)(BK * 2);
    const size_t hstep = (size_t)HALF * K * 2;
    const size_t tstep = 2 * hstep;
    const unsigned ldsw = (unsigned)wid * 1024u;
    const int aoff = lds_byte(wr * 64 + fr, fq * 8), boff = lds_byte(wc * 32 + fr, fq * 8);
#define PG8_SA(b, h) (((b) * 2 + (h)) * HTB)
#define PG8_SB(b, h) ((4 + (b) * 2 + (h)) * HTB)
#define PG8_STAGE(bufoff, gbase, voff) do { _Pragma("unroll") for (int _i = 0; _i < 2; ++_i) \
        __builtin_amdgcn_global_load_lds((const unsigned*)((const char*)(gbase) + (voff)[_i]), (PG8_LAS unsigned*)(lds + (bufoff) + ldsw + _i * 8192), 16, 0, 0); } while (0)
#define PG8_LDA(dst, b, h) do { _Pragma("unroll") for (int m = 0; m < 4; ++m) _Pragma("unroll") for (int k = 0; k < 2; ++k) dst[m][k] = *(const PG8_LAS bf16x8*)(lds + PG8_SA(b, h) + aoff + m * 2048 + k * 1024); } while (0)
#define PG8_LDB(dst, b, h) do { _Pragma("unroll") for (int n = 0; n < 2; ++n) _Pragma("unroll") for (int k = 0; k < 2; ++k) dst[n][k] = *(const PG8_LAS bf16x8*)(lds + PG8_SB(b, h) + boff + n * 2048 + k * 1024); } while (0)
#define PG8_MMA(ai, bj, At, Bt) do { __builtin_amdgcn_s_setprio(1); _Pragma("unroll") for (int m = 0; m < 4; ++m) _Pragma("unroll") for (int n = 0; n < 2; ++n) _Pragma("unroll") for (int k = 0; k < 2; ++k) \
        acc[ai][bj][m][n] = __builtin_amdgcn_mfma_f32_16x16x32_bf16(Bt[n][k], At[m][k], acc[ai][bj][m][n], 0, 0, 0); __builtin_amdgcn_s_setprio(0); } while (0)
#define PG8_WAIT_V(n) asm volatile("s_waitcnt vmcnt(" #n ")" ::: "memory")
#define PG8_WAIT_L(n) asm volatile("s_waitcnt lgkmcnt(" #n ")" ::: "memory")
#define PG8_BAR __builtin_amdgcn_s_barrier()
#define PG8_SCHED __builtin_amdgcn_sched_barrier(0)
    Unit cur, nxt; int ui = 0;
    if (!S.next(0, cur)) return;
    f32x4 acc[2][2][4][2];
#pragma unroll
    for (int a = 0; a < 2; ++a)
#pragma unroll
        for (int b = 0; b < 2; ++b)
#pragma unroll
            for (int m = 0; m < 4; ++m)
#pragma unroll
                for (int n = 0; n < 2; ++n) acc[a][b][m][n] = (f32x4){0.f, 0.f, 0.f, 0.f};
    bf16x8 At[4][2], B0[2][2], B1[2][2];
    const char* cA = (const char*)g.A + (size_t)cur.pm * tstep; const char* cB = (const char*)g.Bt + (size_t)cur.pn * tstep;
    S.a_ready(cur);
    if constexpr (SP2) {
        PG8_STAGE(PG8_SB(0, 0), cB, voffB); PG8_STAGE(PG8_SB(0, 1), cB + hstep, voffB); PG8_STAGE(PG8_SA(0, 0), cA, voffA); PG8_STAGE(PG8_SA(0, 1), cA + hstep, voffA);
        if (wr == 1) PG8_BAR;
        PG8_WAIT_V(2); PG8_BAR;
        PG8_STAGE(PG8_SB(1, 0), cB + kstep, voffB); PG8_STAGE(PG8_SA(1, 0), cA + kstep, voffA); PG8_STAGE(PG8_SB(1, 1), cB + hstep + kstep, voffB);
        PG8_WAIT_V(6); PG8_BAR;
    } else {
        PG8_STAGE(PG8_SB(0, 0), cB, voffB); PG8_STAGE(PG8_SA(0, 0), cA, voffA); PG8_STAGE(PG8_SB(0, 1), cB + hstep, voffB); PG8_STAGE(PG8_SA(0, 1), cA + hstep, voffA);
        if (wr == 1) PG8_BAR;
        PG8_WAIT_V(4); PG8_BAR;
        PG8_STAGE(PG8_SB(1, 0), cB + kstep, voffB); PG8_STAGE(PG8_SA(1, 0), cA + kstep, voffA); PG8_STAGE(PG8_SB(1, 1), cB + hstep + kstep, voffB);
        PG8_WAIT_V(6); PG8_BAR;
    }
    for (;;) {
        const bool has_next = S.next(ui + 1, nxt);
        const char* nA = has_next ? (const char*)g.A + (size_t)nxt.pm * tstep : cA; const char* nB = has_next ? (const char*)g.Bt + (size_t)nxt.pn * tstep : cB;
        for (int t = 0; t < nt; t += 2) {
            const bool last = (t == nt - 2);
            const char* a1 = cA + (size_t)(t + 1) * kstep;
            const char* a2 = last ? nA : cA + (size_t)(t + 2) * kstep; const char* b2 = last ? nB : cB + (size_t)(t + 2) * kstep;
            const char* a3 = a2 + kstep; const char* b3 = b2 + kstep;
            if (last && has_next) S.a_ready(nxt);
            if constexpr (SP2) {
            PG8_LDB(B0, 0, 0); PG8_LDB(B1, 0, 1); PG8_SCHED; PG8_LDA(At, 0, 0); PG8_STAGE(PG8_SA(1, 1), a1 + hstep, voffA);
            PG8_WAIT_V(8); PG8_WAIT_L(0); PG8_BAR; PG8_MMA(0, 0, At, B0); PG8_MMA(0, 1, At, B1); PG8_BAR; PG8_SCHED;
            PG8_LDA(At, 0, 1); PG8_STAGE(PG8_SB(0, 0), b2, voffB); PG8_STAGE(PG8_SB(0, 1), b2 + hstep, voffB); PG8_STAGE(PG8_SA(0, 0), a2, voffA);
            PG8_WAIT_V(8); PG8_WAIT_L(0); PG8_BAR; PG8_MMA(1, 0, At, B0); PG8_MMA(1, 1, At, B1); PG8_BAR; PG8_SCHED;
            PG8_LDB(B0, 1, 0); PG8_LDB(B1, 1, 1); PG8_SCHED; PG8_LDA(At, 1, 0); PG8_STAGE(PG8_SA(0, 1), a2 + hstep, voffA);
            PG8_WAIT_V(8); PG8_WAIT_L(0); PG8_BAR; PG8_MMA(0, 0, At, B0); PG8_MMA(0, 1, At, B1); PG8_BAR; PG8_SCHED;
            PG8_LDA(At, 1, 1); PG8_STAGE(PG8_SB(1, 0), b3, voffB); PG8_STAGE(PG8_SB(1, 1), b3 + hstep, voffB); PG8_STAGE(PG8_SA(1, 0), a3, voffA);
            PG8_WAIT_V(8); PG8_WAIT_L(0); PG8_BAR; PG8_MMA(1, 0, At, B0); PG8_MMA(1, 1, At, B1); PG8_BAR; PG8_SCHED;
            } else {
            PG8_LDB(B0, 0, 0); PG8_SCHED; PG8_LDA(At, 0, 0); PG8_STAGE(PG8_SA(1, 1), a1 + hstep, voffA);
            PG8_WAIT_L(8); PG8_BAR; PG8_WAIT_L(0); PG8_MMA(0, 0, At, B0); PG8_BAR; PG8_SCHED;
            PG8_LDB(B1, 0, 1); PG8_STAGE(PG8_SB(0, 0), b2, voffB);
            PG8_BAR; PG8_WAIT_L(0); PG8_MMA(0, 1, At, B1); PG8_BAR;
            PG8_LDA(At, 0, 1); PG8_STAGE(PG8_SA(0, 0), a2, voffA);
            PG8_BAR; PG8_WAIT_L(0); PG8_MMA(1, 0, At, B0); PG8_BAR; PG8_SCHED;
            PG8_STAGE(PG8_SB(0, 1), b2 + hstep, voffB);
            PG8_WAIT_V(6); PG8_BAR; PG8_MMA(1, 1, At, B1); PG8_BAR;
            PG8_LDB(B0, 1, 0); PG8_SCHED; PG8_LDA(At, 1, 0); PG8_STAGE(PG8_SA(0, 1), a2 + hstep, voffA);
            PG8_WAIT_L(8); PG8_BAR; PG8_WAIT_L(0); PG8_MMA(0, 0, At, B0); PG8_BAR; PG8_SCHED;
            PG8_LDB(B1, 1, 1); PG8_STAGE(PG8_SB(1, 0), b3, voffB);
            PG8_BAR; PG8_WAIT_L(0); PG8_MMA(0, 1, At, B1); PG8_BAR;
            PG8_LDA(At, 1, 1); PG8_STAGE(PG8_SA(1, 0), a3, voffA);
            PG8_BAR; PG8_WAIT_L(0); PG8_MMA(1, 0, At, B0); PG8_BAR; PG8_SCHED;
            PG8_STAGE(PG8_SB(1, 1), b3 + hstep, voffB);
            PG8_WAIT_V(6); PG8_BAR; PG8_MMA(1, 1, At, B1); PG8_BAR;
            }
        }
        if constexpr (ALIGN_EPI) { if (wr == 0) PG8_BAR; }
        if constexpr (!Epi::AFTER_DRAIN) { E(acc, cur, wr, wc, fr, fq); S.done(cur); }
        if (!has_next) break;
#pragma unroll
        for (int a = 0; a < 2; ++a)
#pragma unroll
            for (int b = 0; b < 2; ++b)
#pragma unroll
                for (int m = 0; m < 4; ++m)
#pragma unroll
                    for (int n = 0; n < 2; ++n) acc[a][b][m][n] = (f32x4){0.f, 0.f, 0.f, 0.f};
        cur = nxt; cA = nA; cB = nB; ++ui;
        if constexpr (ALIGN_EPI) { if (wr == 1) PG8_BAR; }
    }
    PG8_WAIT_V(0);
    if constexpr (!ALIGN_EPI) { if (wr == 0) PG8_BAR; }
    PG8_BAR;
    if constexpr (Epi::AFTER_DRAIN) { E.fused(acc, cur, wr, wc, fr, fq, lds, wid, lane); S.done(cur); }
#undef PG8_SA
#undef PG8_SB
#undef PG8_STAGE
#undef PG8_LDA
#undef PG8_LDB
#undef PG8_MMA
#undef PG8_WAIT_V
#undef PG8_WAIT_L
#undef PG8_BAR
#undef PG8_SCHED
}
}
#define LAS __attribute__((address_space(3)))
#define XB_TMO      128
#define XB_XCNT(j)  (256  + 64 * (j))
#define XB_XSUB(j)  (1280 + 64 * (j))
#define XB_XGEN(j)  (2304 + 64 * (j))
#define XB_TOP      3328
#define XB_TOPGEN   3392
#define XCD_BAR_WORDS 3456
#define XB_SPIN_CAP (1u << 18)

__device__ __forceinline__ unsigned xb_ld(unsigned* p)              { return __hip_atomic_load(p, __ATOMIC_RELAXED, __HIP_MEMORY_SCOPE_AGENT); }
__device__ __forceinline__ unsigned xb_add(unsigned* p, unsigned v) { return __hip_atomic_fetch_add(p, v, __ATOMIC_RELAXED, __HIP_MEMORY_SCOPE_AGENT); }
__device__ __forceinline__ unsigned xb_xcc_id() { return (unsigned)__builtin_amdgcn_s_getreg((3 << 11) | 20) & 0xFu; }
#define XB_SPIN(cond, bar) do { unsigned _sp = 0; while (cond) { __builtin_amdgcn_s_sleep(1); \
    if ((++_sp & 255u) == 0u) { if (xb_ld(&(bar)[XB_TMO])) break; if (_sp > XB_SPIN_CAP) { atomicAdd(&(bar)[XB_TMO], 1u); break; } } } } while (0)

struct XcdBarrier {
    unsigned* bar; unsigned x;
    volatile LAS unsigned* st;
};

__device__ __forceinline__ XcdBarrier xcd_barrier_post(unsigned* bar, volatile LAS unsigned* st) {
    XcdBarrier b; b.bar = bar; b.x = xb_xcc_id(); b.st = st;
    if (threadIdx.x == 0) (void)xb_add(&bar[XB_XCNT(b.x)], 1u);
    return b;
}
__device__ __forceinline__ void xcd_barrier_complete(unsigned* bar, unsigned x, unsigned& nloc, unsigned& nx) {
    const unsigned G = gridDim.x * gridDim.y * gridDim.z;
    unsigned sum, cnt, mine, sp = 0u;
    for (;;) {
        sum = 0u; cnt = 0u; mine = 0u;
#pragma unroll
        for (unsigned j = 0; j < 16; ++j) { const unsigned c = xb_ld(&bar[XB_XCNT(j)]); sum += c; cnt += (c > 0u) ? 1u : 0u; mine = (j == x) ? c : mine; }
        if (sum == G) break;
        __builtin_amdgcn_s_sleep(1);
        if ((++sp & 255u) == 0u) { if (xb_ld(&bar[XB_TMO])) break; if (sp > XB_SPIN_CAP) { atomicAdd(&bar[XB_TMO], 1u); break; } }
    }
    nloc = mine > 0u ? mine : 1u; nx = cnt > 0u ? cnt : 1u;
}

__device__ __forceinline__ void xcd_barrier(const XcdBarrier& b) {
    asm volatile("s_waitcnt vmcnt(0)" ::: "memory");
    __syncthreads();
    if (threadIdx.x == 0) {
        unsigned* bar = b.bar;
        __builtin_amdgcn_s_waitcnt(0);
        unsigned nloc = b.st[0], nx = b.st[1];
        if (nloc == 0u) { xcd_barrier_complete(bar, b.x, nloc, nx); b.st[0] = nloc; b.st[1] = nx; }
        const unsigned old = xb_add(&bar[XB_XSUB(b.x)], 1u);
        const unsigned gen = old / nloc;
        if (old + 1u == (gen + 1u) * nloc) {
            __builtin_amdgcn_fence(__ATOMIC_RELEASE, "agent");
            asm volatile("s_waitcnt vmcnt(0)" ::: "memory");
            const unsigned og = xb_add(&bar[XB_TOP], 1u);
            const unsigned tg = og / nx;
            if (og + 1u == (tg + 1u) * nx) xb_add(&bar[XB_TOPGEN], 1u);
            else XB_SPIN(xb_ld(&bar[XB_TOPGEN]) == tg, bar);
            __builtin_amdgcn_fence(__ATOMIC_ACQUIRE, "agent");
            xb_add(&bar[XB_XGEN(b.x)], 1u);
            asm volatile("s_waitcnt vmcnt(0)" ::: "memory");
        } else {
            XB_SPIN(xb_ld(&bar[XB_XGEN(b.x)]) == gen, bar);
            __builtin_amdgcn_fence(__ATOMIC_ACQUIRE, "agent");
            asm volatile("s_waitcnt vmcnt(0)" ::: "memory");
        }
    }
    __syncthreads();
}
#define GAS __attribute__((address_space(1)))

typedef unsigned short bf16;
typedef float f32x4 __attribute__((ext_vector_type(4)));
typedef unsigned v4u __attribute__((ext_vector_type(4)));
typedef unsigned v2u __attribute__((ext_vector_type(2)));
#define LDS_WAIT() asm volatile("s_waitcnt lgkmcnt(0)" ::: "memory")

#ifndef MK_ONE_LAUNCH
#define MK_ONE_LAUNCH 0
#endif
#ifndef RET_MFMA
#define RET_MFMA 1
#endif
#ifndef SWA_MFMA
#define SWA_MFMA 1
#endif
#ifndef PROBE_DUP
#define PROBE_DUP 0
#endif
#define REPS(k) int nrep_ = (PROBE_DUP == (k)) ? 2 : 1; asm volatile("" : "+s"(nrep_)); for (int rep_ = 0; rep_ < nrep_; ++rep_)

constexpr int S = 16384, D = 2048, INW = 5376, DFF = 5632, NUP = 2 * DFF, NUPG = NUP + D, PLE = 256, DEPTH = 4;
constexpr float ALPHA = 1.6817928305074290f, LN_EPS = 1e-5f, GN_EPS = 1e-6f;
constexpr int NPH = 11, NPHASES = 1 + DEPTH * NPH;

constexpr size_t MiB = 1u << 20;
constexpr size_t WS_CTL = 0, CTL_ZERO_BYTES = 1 * MiB;
constexpr size_t WS_COSR = 2 * MiB, WS_SINR = 10 * MiB, WS_COSA = 18 * MiB, WS_SINA = 20 * MiB;
constexpr size_t WS_W = 32 * MiB, WL_BYTES = 104 * MiB;
constexpr size_t WL_IN = 0, WL_OUT = 21 * MiB, WL_UP = 29 * MiB, WL_G = 73 * MiB, WL_DOWN = 81 * MiB, WL_P = 103 * MiB;
constexpr size_t WS_XR = 448 * MiB, WS_XB = 576 * MiB, WS_Y = 640 * MiB;
constexpr size_t WS_Q = 768 * MiB, WS_K = 800 * MiB, WS_V = 832 * MiB, WS_G = 864 * MiB, WS_AQ = 896 * MiB, WS_AK = 928 * MiB, WS_AV = 932 * MiB;
constexpr size_t WS_MIX = 936 * MiB, WS_U = 1000 * MiB, WS_PS = 1128 * MiB, WS_RETY = 1160 * MiB;
constexpr size_t WS_H = 768 * MiB, WS_ACT = 1128 * MiB, WS_SG = 1304 * MiB, WS_PB = 1368 * MiB, WS_END = 1400 * MiB;
constexpr int CW_BAR = 4096;

constexpr int RING_BYTES = 131072, LDS_BYTES = 147456, LDSCTL_OFF = LDS_BYTES - 1024, MISC_OFF = LDSCTL_OFF + 320;

__device__ __forceinline__ unsigned f2bf(float f) { unsigned u = __builtin_bit_cast(unsigned, f); return (u + 0x7fffu + ((u >> 16) & 1u)) >> 16; }
__device__ __forceinline__ unsigned pk2(float lo, float hi) { return f2bf(lo) | (f2bf(hi) << 16); }
__device__ __forceinline__ float bflo(unsigned w) { return __uint_as_float(w << 16); }
__device__ __forceinline__ float bfhi(unsigned w) { return __uint_as_float(w & 0xffff0000u); }
__device__ __forceinline__ float bf1(const bf16* p) { return __uint_as_float(((unsigned)*p) << 16); }

struct Params {
    const float* in[19]; float* out; unsigned char* ws; int ph_lo, ph_hi;
    float invf_ret[128]; float invf_att[32]; float lg2g[4];
};

struct Ctx { int tid, lane, wave, G, bid; unsigned char* ws; };

__device__ __forceinline__ int lane_id_asm() { int l; asm volatile("v_mbcnt_lo_u32_b32 %0, -1, 0\n\tv_mbcnt_hi_u32_b32 %0, -1, %0" : "=v"(l)); return l; }
__device__ __forceinline__ float wave_sum(float v, int lane) {
#pragma unroll
    for (int o = 1; o < 64; o <<= 1) v += __builtin_bit_cast(float, __builtin_amdgcn_ds_bpermute((lane ^ o) << 2, __builtin_bit_cast(int, v)));
    return v;
}
__device__ __forceinline__ void transpose_item(const float* W, int K, int N, int src_col0, bf16* WT, int dst_row0, int k0, LAS float* scr, int lane) {
#pragma unroll 8
    for (int i = 0; i < 32; ++i) { const int kk = 2 * i + (lane >> 5); scr[kk * 33 + (lane & 31)] = W[(size_t)(k0 + kk) * N + src_col0 + (lane & 31)]; }
    LDS_WAIT(); asm volatile("" ::: "memory");
    const int c = lane & 7;
#pragma unroll
    for (int j = 0; j < 4; ++j) { const int n = (lane >> 3) + 8 * j; const LAS float* s = scr + (8 * c) * 33 + n;
        v4u o; o.x = pk2(s[0 * 33], s[1 * 33]); o.y = pk2(s[2 * 33], s[3 * 33]); o.z = pk2(s[4 * 33], s[5 * 33]); o.w = pk2(s[6 * 33], s[7 * 33]);
        *(v4u*)(WT + (size_t)(dst_row0 + n) * K + k0 + 8 * c) = o; }
    LDS_WAIT(); asm volatile("" ::: "memory");
}
__device__ __forceinline__ int win_src_col(int g) {
    const int tile = g >> 3, bj = (g >> 2) & 1, wcg = g & 3;
    if (tile < 16) return 32 * g;
    if (tile < 20) return 4096 + 256 * (tile - 16) + 64 * wcg + 32 * bj;
    return wcg < 2 ? 5120 + 64 * wcg + 32 * bj : 5248 + 32 * (wcg - 2) + 64 * bj;
}
__device__ __forceinline__ int wup_src_col(int g) { const int tile = g >> 3, bj = (g >> 2) & 1, wcg = g & 3; return (bj ? DFF : 0) + 128 * tile + 32 * wcg; }

__device__ __forceinline__ void sincos_d(float angf, float& s, float& c) {
    const double a = (double)angf;
    const double k = __builtin_rint(a * 0.63661977236758134308);
    double r = __builtin_fma(-k, 1.57079632679489661923, a); r = __builtin_fma(-k, 6.123233995736766e-17, r);
    const double r2 = r * r;
    const double sp = r + r * r2 * (-1.0 / 6 + r2 * (1.0 / 120 + r2 * (-1.0 / 5040 + r2 * (1.0 / 362880 + r2 * (-1.0 / 39916800)))));
    const double cp = 1.0 + r2 * (-0.5 + r2 * (1.0 / 24 + r2 * (-1.0 / 720 + r2 * (1.0 / 40320 + r2 * (-1.0 / 3628800 + r2 * (1.0 / 479001600))))));
    const int q = ((int)k) & 3;
    const double sv = (q == 0) ? sp : (q == 1) ? cp : (q == 2) ? -sp : -cp;
    const double cv = (q == 0) ? cp : (q == 1) ? -sp : (q == 2) ? -cp : sp;
    s = (float)sv; c = (float)cv;
}

__device__ __forceinline__ void phase_prologue(const Params& P, const Ctx& cx, LAS unsigned char* lds) {
    unsigned char* ws = cx.ws; const int tid = cx.tid, lane = cx.lane, wave = cx.wave, G = cx.G;
    LAS float* scr = (LAS float*)(lds + wave * 16384);
    const int gw = cx.bid * 8 + wave, NGW = G * 8;
    constexpr int I_IN = 32 * 168, I_OUT = 32 * 64, I_UP = 32 * 352, I_G = 32 * 64, I_DN = 88 * 64, I_P = 4 * 64, I_L = I_IN + I_OUT + I_UP + I_G + I_DN + I_P;
    for (int it = gw; it < DEPTH * I_L; it += NGW) {
        const int l = it / I_L; int r = it - l * I_L;
        bf16* wl = (bf16*)(ws + WS_W + (size_t)l * WL_BYTES);
        if (r < I_IN) { const int kb = r / 168, g = r % 168; transpose_item(P.in[3] + (size_t)l * D * INW, D, INW, win_src_col(g), wl + WL_IN / 2, 32 * g, 64 * kb, scr, lane); continue; } r -= I_IN;
        if (r < I_OUT) { const int kb = r / 64, g = r % 64; transpose_item(P.in[4] + (size_t)l * D * D, D, D, 32 * g, wl + WL_OUT / 2, 32 * g, 64 * kb, scr, lane); continue; } r -= I_OUT;
        if (r < I_UP) { const int kb = r / 352, g = r % 352; transpose_item(P.in[10] + (size_t)l * D * NUP, D, NUP, wup_src_col(g), wl + WL_UP / 2, 32 * g, 64 * kb, scr, lane); continue; } r -= I_UP;
        if (r < I_G) { const int kb = r / 64, g = r % 64; transpose_item(P.in[16] + (size_t)l * D * D, D, D, 32 * g, wl + WL_G / 2, 32 * g, 64 * kb, scr, lane); continue; } r -= I_G;
        if (r < I_DN) { const int kb = r / 64, g = r % 64; transpose_item(P.in[13] + (size_t)l * DFF * D, DFF, D, 32 * g, wl + WL_DOWN / 2, 32 * g, 64 * kb, scr, lane); continue; } r -= I_DN;
        { const int kb = r / 64, g = r % 64; transpose_item(P.in[18] + (size_t)l * PLE * D, PLE, D, 32 * g, wl + WL_P / 2, 32 * g, 64 * kb, scr, lane); }
    }
    const size_t gt = (size_t)cx.bid * 512 + tid, NT = (size_t)G * 512;
    { const float* x = P.in[0]; bf16* xb = (bf16*)(ws + WS_XB);
      for (size_t i = gt; i < (size_t)S * D / 8; i += NT) { const f32x4 a = *(const f32x4*)(x + i * 8), b = *(const f32x4*)(x + i * 8 + 4);
          v4u o; o.x = pk2(a[0], a[1]); o.y = pk2(a[2], a[3]); o.z = pk2(b[0], b[1]); o.w = pk2(b[2], b[3]); *(v4u*)(xb + i * 8) = o; } }
    { const float* p = P.in[1]; bf16* pb = (bf16*)(ws + WS_PB);
      for (size_t i = gt; i < (size_t)DEPTH * S * PLE / 8; i += NT) { const f32x4 a = *(const f32x4*)(p + i * 8), b = *(const f32x4*)(p + i * 8 + 4);
          v4u o; o.x = pk2(a[0], a[1]); o.y = pk2(a[2], a[3]); o.z = pk2(b[0], b[1]); o.w = pk2(b[2], b[3]); *(v4u*)(pb + i * 8) = o; } }
    { const int* pos = (const int*)P.in[2]; float* cosr = (float*)(ws + WS_COSR); float* sinr = (float*)(ws + WS_SINR); float* cosa = (float*)(ws + WS_COSA); float* sina = (float*)(ws + WS_SINA);
      for (size_t i = gt; i < (size_t)S * 128; i += NT) { const int t = (int)(i >> 7), f = (int)(i & 127); float s, c; sincos_d((float)pos[t] * P.invf_ret[f], s, c); cosr[i] = c; sinr[i] = s; }
      for (size_t i = gt; i < (size_t)S * 32; i += NT) { const int t = (int)(i >> 5), f = (int)(i & 31); float s, c; sincos_d((float)pos[t] * P.invf_att[f], s, c); cosa[i] = c; sina[i] = s; } }
}

template <int MT, int NT_, int KK, bool A_KFAST, bool B_NFAST, class FA, class FB, class FC>
__device__ __forceinline__ void simple_gemm(LAS unsigned char* lds, int nbatch, int tid, int G, int bid, const FA& fa, const FB& fb, const FC& fc) {
    LAS float* As = (LAS float*)lds;
    LAS float* Bs = (LAS float*)(lds + 16 * 132 * 4);
    constexpr int TM = MT / 128, TN = NT_ / 64, ITEMS_PER_B = TM * TN;
    const int tm = tid & 31, tn = tid >> 5;
    for (int item = bid; item < nbatch * ITEMS_PER_B; item += G) {
        const int b = item / ITEMS_PER_B, r = item % ITEMS_PER_B, m0 = (r / TN) * 128, n0 = (r % TN) * 64;
        float c[4][4];
#pragma unroll
        for (int i = 0; i < 4; ++i)
#pragma unroll
            for (int j = 0; j < 4; ++j) c[i][j] = 0.f;
        for (int k0 = 0; k0 < KK; k0 += 16) {
#pragma unroll
            for (int rr = 0; rr < 4; ++rr) { const int e = tid + 512 * rr; int m, k; if (A_KFAST) { k = e & 15; m = e >> 4; } else { m = e & 127; k = e >> 7; }
                As[k * 132 + m] = fa(b, m0 + m, k0 + k); }
#pragma unroll
            for (int rr = 0; rr < 2; ++rr) { const int e = tid + 512 * rr; int n, k; if (B_NFAST) { n = e & 63; k = e >> 6; } else { k = e & 15; n = e >> 4; }
                Bs[k * 68 + n] = fb(b, k0 + k, n0 + n); }
            __syncthreads();
#pragma unroll
            for (int kk = 0; kk < 16; ++kk) { const f32x4 a = *(const LAS f32x4*)(As + kk * 132 + 4 * tm), bb = *(const LAS f32x4*)(Bs + kk * 68 + 4 * tn);
#pragma unroll
                for (int i = 0; i < 4; ++i)
#pragma unroll
                    for (int j = 0; j < 4; ++j) c[i][j] += a[i] * bb[j]; }
            __syncthreads();
        }
#pragma unroll
        for (int i = 0; i < 4; ++i)
#pragma unroll
            for (int j = 0; j < 4; ++j) fc(b, m0 + 4 * tm + i, n0 + 4 * tn + j, c[i][j]);
    }
}

__device__ __forceinline__ void phase_swa(const Params& P, const Ctx& cx, int l, LAS unsigned char* lds) {
    unsigned char* ws = cx.ws; const int tid = cx.tid, G = cx.G;
    const bf16* AQ = (const bf16*)(ws + WS_AQ); const bf16* AK = (const bf16*)(ws + WS_AK); const bf16* AV = (const bf16*)(ws + WS_AV); bf16* MIX = (bf16*)(ws + WS_MIX);
    const float* sinks = P.in[7] + l * 16;
    LAS unsigned* Ks = (LAS unsigned*)lds;
    LAS unsigned* Vs = (LAS unsigned*)(lds + 256 * 33 * 4);
    for (int item = cx.bid; item < 256; item += G) {
        const int nb = item >> 1, hk = item & 1;
        __syncthreads();
        for (int e = tid; e < 256 * 32; e += 512) { const int r = e >> 5, cdw = e & 31; const int gk = nb * 128 - 128 + r;
            unsigned kv = 0u, vv = 0u; if (gk >= 0) { kv = *(const unsigned*)(AK + (size_t)gk * 128 + hk * 64 + 2 * cdw); vv = *(const unsigned*)(AV + (size_t)gk * 128 + hk * 64 + 2 * cdw); }
            Ks[r * 33 + cdw] = kv; Vs[r * 33 + cdw] = vv; }
        __syncthreads();
#pragma unroll 1
        for (int rep = 0; rep < 2; ++rep) {
            const int pair = tid + 512 * rep, i = pair & 127, g = pair >> 7, hq = hk * 8 + g; const int row = nb * 128 + i;
            float q[64], o[64];
            { const v4u* qp = (const v4u*)(AQ + (size_t)row * 1024 + hq * 64);
#pragma unroll
              for (int c8 = 0; c8 < 8; ++c8) { const v4u w = qp[c8]; q[8 * c8 + 0] = bflo(w.x); q[8 * c8 + 1] = bfhi(w.x); q[8 * c8 + 2] = bflo(w.y); q[8 * c8 + 3] = bfhi(w.y); q[8 * c8 + 4] = bflo(w.z); q[8 * c8 + 5] = bfhi(w.z); q[8 * c8 + 6] = bflo(w.w); q[8 * c8 + 7] = bfhi(w.w); } }
#pragma unroll
            for (int d = 0; d < 64; ++d) o[d] = 0.f;
            float mx = sinks[hq], den = 1.0f;
            const int jj0 = (nb == 0) ? (127 - i) : 0;
            for (int jj = jj0; jj < 128; ++jj) { const int kl = i + 1 + jj;
                float s = 0.f;
#pragma unroll
                for (int c = 0; c < 32; ++c) { const unsigned w = Ks[kl * 33 + c]; s += q[2 * c] * bflo(w) + q[2 * c + 1] * bfhi(w); }
                const float mn = fmaxf(mx, s), sc = __expf(mx - mn), p = __expf(s - mn);
                den = den * sc + p; mx = mn;
#pragma unroll
                for (int c = 0; c < 32; ++c) { const unsigned w = Vs[kl * 33 + c]; o[2 * c] = o[2 * c] * sc + p * bflo(w); o[2 * c + 1] = o[2 * c + 1] * sc + p * bfhi(w); }
            }
            const float inv = 1.0f / den;
            v4u* op = (v4u*)(MIX + (size_t)row * 2048 + 1024 + hq * 64);
#pragma unroll
            for (int c8 = 0; c8 < 8; ++c8) { v4u w; w.x = pk2(o[8 * c8] * inv, o[8 * c8 + 1] * inv); w.y = pk2(o[8 * c8 + 2] * inv, o[8 * c8 + 3] * inv); w.z = pk2(o[8 * c8 + 4] * inv, o[8 * c8 + 5] * inv); w.w = pk2(o[8 * c8 + 6] * inv, o[8 * c8 + 7] * inv); op[c8] = w; }
        }
    }
}

__device__ __forceinline__ void phase_ret_u_scores(const Params& P, const Ctx& cx, LAS unsigned char* lds) {
    unsigned char* ws = cx.ws; const int tid = cx.tid, G = cx.G;
    const bf16* Q = (const bf16*)(ws + WS_Q); const bf16* K = (const bf16*)(ws + WS_K); const bf16* V = (const bf16*)(ws + WS_V);
    float* U = (float*)(ws + WS_U); float* PS = (float*)(ws + WS_PS);
    const float lg0 = P.lg2g[0], lg1 = P.lg2g[1], lg2 = P.lg2g[2], lg3 = P.lg2g[3];
    auto lgh = [=](int h) { return h == 0 ? lg0 : h == 1 ? lg1 : h == 2 ? lg2 : lg3; };
    simple_gemm<256, 256, 128, false, true>(lds, 512, tid, G, cx.bid,
        [=](int b, int m, int k) { const int nb = b >> 2, h = b & 3; return bf1(K + (size_t)(nb * 128 + k) * 1024 + h * 256 + m) * exp2f(lgh(h) * (float)(127 - k)); },
        [=](int b, int k, int n) { const int nb = b >> 2, h = b & 3; return bf1(V + (size_t)(nb * 128 + k) * 1024 + h * 256 + n); },
        [=](int b, int m, int n, float v) { U[((size_t)b * 256 + m) * 256 + n] = v; });
    simple_gemm<128, 128, 256, true, false>(lds, 512, tid, G, cx.bid,
        [=](int b, int m, int k) { const int nb = b >> 2, h = b & 3; return bf1(Q + (size_t)(nb * 128 + m) * 1024 + h * 256 + k); },
        [=](int b, int k, int n) { const int nb = b >> 2, h = b & 3; return bf1(K + (size_t)(nb * 128 + n) * 1024 + h * 256 + k); },
        [=](int b, int m, int n, float v) { const int h = b & 3; PS[((size_t)b * 128 + m) * 128 + n] = (m >= n) ? v * exp2f(lgh(h) * (float)(m - n)) : 0.f; });
}
__device__ __forceinline__ void phase_scan(const Params& P, const Ctx& cx) {
    float* U = (float*)(cx.ws + WS_U);
    const size_t gt = (size_t)cx.bid * 512 + cx.tid, NT = (size_t)cx.G * 512;
    for (size_t idx = gt; idx < 4 * 65536; idx += NT) {
        const int h = (int)(idx >> 16); const float cd = exp2f(P.lg2g[h] * 128.0f);
        float r = 0.f;
        for (int n0 = 0; n0 < 128; n0 += 8) { float u[8];
#pragma unroll
            for (int j = 0; j < 8; ++j) u[j] = U[(size_t)(n0 + j) * 262144 + idx];
#pragma unroll
            for (int j = 0; j < 8; ++j) { U[(size_t)(n0 + j) * 262144 + idx] = r; r = r * cd + u[j]; } }
    }
}
__device__ __forceinline__ void phase_ret_out(const Params& P, const Ctx& cx, LAS unsigned char* lds) {
    unsigned char* ws = cx.ws; const int tid = cx.tid, G = cx.G;
    const bf16* Q = (const bf16*)(ws + WS_Q); const bf16* V = (const bf16*)(ws + WS_V);
    const float* Sst = (const float*)(ws + WS_U); const float* PS = (const float*)(ws + WS_PS); float* RY = (float*)(ws + WS_RETY);
    const float lg0 = P.lg2g[0], lg1 = P.lg2g[1], lg2 = P.lg2g[2], lg3 = P.lg2g[3];
    auto lgh = [=](int h) { return h == 0 ? lg0 : h == 1 ? lg1 : h == 2 ? lg2 : lg3; };
    simple_gemm<128, 256, 384, true, true>(lds, 512, tid, G, cx.bid,
        [=](int b, int m, int k) { const int nb = b >> 2, h = b & 3; return k < 128 ? PS[((size_t)b * 128 + m) * 128 + k] : bf1(Q + (size_t)(nb * 128 + m) * 1024 + h * 256 + (k - 128)) * exp2f(lgh(h) * (float)(m + 1)); },
        [=](int b, int k, int n) { const int nb = b >> 2, h = b & 3; return k < 128 ? bf1(V + (size_t)(nb * 128 + k) * 1024 + h * 256 + n) : Sst[((size_t)b * 256 + (k - 128)) * 256 + n]; },
        [=](int b, int m, int n, float v) { const int nb = b >> 2, h = b & 3; RY[(size_t)(nb * 128 + m) * 1024 + h * 256 + n] = v; });
}

typedef short bf16x8 __attribute__((ext_vector_type(8)));
typedef short s16x4 __attribute__((ext_vector_type(4)));
typedef short v4i16_t __attribute__((ext_vector_type(4)));
__device__ __forceinline__ f32x4 mfma16(bf16x8 a, bf16x8 b, f32x4 c) { return __builtin_amdgcn_mfma_f32_16x16x32_bf16(a, b, c, 0, 0, 0); }
__device__ __forceinline__ s16x4 lds_tr(LAS unsigned char* p) { return __builtin_bit_cast(s16x4, __builtin_amdgcn_ds_read_tr16_b64_v4i16((LAS v4i16_t*)p)); }
__device__ __forceinline__ bf16x8 cat44(s16x4 a, s16x4 b) { bf16x8 r; r[0] = a[0]; r[1] = a[1]; r[2] = a[2]; r[3] = a[3]; r[4] = b[0]; r[5] = b[1]; r[6] = b[2]; r[7] = b[3]; return r; }
__device__ __forceinline__ unsigned cvt2(float lo, float hi) { return pg8::cvt_pk_bf16(lo, hi); }
__device__ __forceinline__ bf16x8 pack_frag(const f32x4 a, const f32x4 b) { v4u w; w.x = cvt2(a[0], a[1]); w.y = cvt2(a[2], a[3]); w.z = cvt2(b[0], b[1]); w.w = cvt2(b[2], b[3]); return __builtin_bit_cast(bf16x8, w); }
__device__ __forceinline__ float grp16_sum(float v, int lane) {
#pragma unroll
    for (int o = 1; o < 16; o <<= 1) v += __builtin_bit_cast(float, __builtin_amdgcn_ds_bpermute((lane ^ o) << 2, __builtin_bit_cast(int, v)));
    return v;
}
constexpr int RS_T = 544;
constexpr int TILE_T = 128 * RS_T;
static_assert(2 * TILE_T <= LDSCTL_OFF, "retention tiles vs LDS control words");

template <bool DECAY> __device__ __forceinline__ void stage_tile(LAS unsigned char* img, const bf16* src, int tid, float lg) {
    v4u v[8];
#pragma unroll
    for (int r = 0; r < 8; ++r) { const int pc = tid + 512 * r, row = pc >> 5, c16 = pc & 31; v[r] = *(const v4u*)(src + (size_t)row * 1024 + c16 * 8); }
#pragma unroll
    for (int r = 0; r < 8; ++r) { const int pc = tid + 512 * r, row = pc >> 5, c16 = pc & 31; v4u w = v[r];
        if (DECAY) { const float sc = exp2f(lg * (float)(127 - row));
            w.x = cvt2(bflo(w.x) * sc, bfhi(w.x) * sc); w.y = cvt2(bflo(w.y) * sc, bfhi(w.y) * sc); w.z = cvt2(bflo(w.z) * sc, bfhi(w.z) * sc); w.w = cvt2(bflo(w.w) * sc, bfhi(w.w) * sc); }
        *(LAS v4u*)(img + row * RS_T + c16 * 16) = w; }
}

__device__ __forceinline__ void phase_ret_u_mfma(const Params& P, const Ctx& cx, LAS unsigned char* lds) {
    unsigned char* ws = cx.ws; const int tid = cx.tid, lane = cx.lane, w = cx.wave, r16 = lane & 15, g = lane >> 4, q = r16 >> 2, pp = r16 & 3;
    const bf16* K = (const bf16*)(ws + WS_K); const bf16* V = (const bf16*)(ws + WS_V); bf16* UT = (bf16*)(ws + WS_U);
    LAS unsigned char* Kim = lds; LAS unsigned char* Vim = lds + TILE_T;
    for (int b = cx.bid; b < 512; b += cx.G) {
        const int nb = b >> 2, h = b & 3;
        __syncthreads();
        stage_tile<true>(Kim, K + (size_t)nb * 128 * 1024 + h * 256, tid, P.lg2g[h]);
        stage_tile<false>(Vim, V + (size_t)nb * 128 * 1024 + h * 256, tid, 0.f);
        __syncthreads();
        f32x4 acc[2][16];
#pragma unroll
        for (int mi = 0; mi < 2; ++mi)
#pragma unroll
            for (int n = 0; n < 16; ++n) acc[mi][n] = (f32x4){0.f, 0.f, 0.f, 0.f};
#pragma unroll 1
        for (int s = 0; s < 4; ++s) {
            bf16x8 af[2];
#pragma unroll
            for (int mi = 0; mi < 2; ++mi) { LAS unsigned char* a0 = Kim + (32 * s + 8 * g + q) * RS_T + (16 * (2 * w + mi) + 4 * pp) * 2; af[mi] = cat44(lds_tr(a0), lds_tr(a0 + 4 * RS_T)); }
#pragma unroll
            for (int n = 0; n < 16; ++n) { LAS unsigned char* b0 = Vim + (32 * s + 8 * g + q) * RS_T + (16 * n + 4 * pp) * 2; const bf16x8 bfr = cat44(lds_tr(b0), lds_tr(b0 + 4 * RS_T));
                acc[0][n] = mfma16(af[0], bfr, acc[0][n]); acc[1][n] = mfma16(af[1], bfr, acc[1][n]); }
        }
#pragma unroll
        for (int mi = 0; mi < 2; ++mi)
#pragma unroll
            for (int n = 0; n < 16; ++n) { v2u o; o.x = cvt2(acc[mi][n][0], acc[mi][n][1]); o.y = cvt2(acc[mi][n][2], acc[mi][n][3]);
                *(v2u*)(UT + ((size_t)b * 256 + 16 * n + r16) * 256 + 16 * (2 * w + mi) + 4 * g) = o; }
    }
}
__device__ __forceinline__ void phase_scan_bf16(const Params& P, const Ctx& cx) {
    unsigned* UT = (unsigned*)(cx.ws + WS_U);
    const size_t gt = (size_t)cx.bid * 512 + cx.tid, NT = (size_t)cx.G * 512;
    for (size_t idx = gt; idx < 131072; idx += NT) {
        const int h = (int)(idx >> 15); const float cd = exp2f(P.lg2g[h] * 128.0f);
        float r0 = 0.f, r1 = 0.f;
        for (int n0 = 0; n0 < 128; n0 += 8) { unsigned u[8];
#pragma unroll
            for (int j = 0; j < 8; ++j) u[j] = UT[(size_t)(n0 + j) * 131072 + idx];
#pragma unroll
            for (int j = 0; j < 8; ++j) { UT[(size_t)(n0 + j) * 131072 + idx] = cvt2(r0, r1); r0 = r0 * cd + bflo(u[j]); r1 = r1 * cd + bfhi(u[j]); } }
    }
}
__device__ __forceinline__ void phase_ret_out_mfma(const Params& P, const Ctx& cx, int l, LAS unsigned char* lds) {
    unsigned char* ws = cx.ws; const int tid = cx.tid, lane = cx.lane, w = cx.wave, r16 = lane & 15, g = lane >> 4, q = r16 >> 2, pp = r16 & 3;
    const bf16* Q = (const bf16*)(ws + WS_Q); const bf16* K = (const bf16*)(ws + WS_K); const bf16* V = (const bf16*)(ws + WS_V); const bf16* ST = (const bf16*)(ws + WS_U);
    const bf16* Gt = (const bf16*)(ws + WS_G); bf16* MIX = (bf16*)(ws + WS_MIX);
    const float* gg = P.in[5] + l * 1024; const float* gb = P.in[6] + l * 1024;
    LAS unsigned char* Kim = lds; LAS unsigned char* Vim = lds + TILE_T;
    for (int b = cx.bid; b < 512; b += cx.G) {
        const int nb = b >> 2, h = b & 3; const float lg = P.lg2g[h];
        __syncthreads();
        stage_tile<false>(Kim, K + (size_t)nb * 128 * 1024 + h * 256, tid, 0.f);
        stage_tile<false>(Vim, V + (size_t)nb * 128 * 1024 + h * 256, tid, 0.f);
        bf16x8 qf[8];
        { const bf16* qrow = Q + (size_t)(nb * 128 + 16 * w + r16) * 1024 + h * 256 + 8 * g;
#pragma unroll
          for (int s = 0; s < 8; ++s) qf[s] = *(const bf16x8*)(qrow + 32 * s); }
        f32x4 acc[16];
        const bf16* strow = ST + ((size_t)b * 256 + r16) * 256 + 8 * g;
#pragma unroll
        for (int n = 0; n < 16; ++n) { bf16x8 sb[8];
#pragma unroll
            for (int s = 0; s < 8; ++s) sb[s] = *(const bf16x8*)(strow + (size_t)n * 16 * 256 + 32 * s);
            f32x4 a = (f32x4){0.f, 0.f, 0.f, 0.f};
#pragma unroll
            for (int s = 0; s < 8; ++s) a = mfma16(qf[s], sb[s], a);
            acc[n] = a; }
        { float f[4];
#pragma unroll
          for (int r = 0; r < 4; ++r) f[r] = exp2f(lg * (float)(16 * w + 4 * g + r + 1));
#pragma unroll
          for (int n = 0; n < 16; ++n) { acc[n][0] *= f[0]; acc[n][1] *= f[1]; acc[n][2] *= f[2]; acc[n][3] *= f[3]; } }
        __syncthreads();
        f32x4 sc[8];
#pragma unroll
        for (int mb = 0; mb < 8; ++mb) { sc[mb] = (f32x4){0.f, 0.f, 0.f, 0.f};
            if (mb <= w) { f32x4 a = (f32x4){0.f, 0.f, 0.f, 0.f};
#pragma unroll
                for (int s = 0; s < 8; ++s) { const bf16x8 kf = *(const LAS bf16x8*)(Kim + (16 * mb + r16) * RS_T + (32 * s + 8 * g) * 2); a = mfma16(kf, qf[s], a); }
                const int i = 16 * w + r16;
#pragma unroll
                for (int r = 0; r < 4; ++r) { const int j = 16 * mb + 4 * g + r; a[r] = (i >= j) ? a[r] * exp2f(lg * (float)(i - j)) : 0.f; }
                sc[mb] = a; } }
#pragma unroll
        for (int sk = 0; sk < 4; ++sk) {
            if (2 * sk <= w) { const bf16x8 pf = pack_frag(sc[2 * sk], sc[2 * sk + 1]);
#pragma unroll
                for (int n = 0; n < 16; ++n) { LAS unsigned char* b0 = Vim + (32 * sk + 4 * g + q) * RS_T + (16 * n + 4 * pp) * 2; const bf16x8 bfr = cat44(lds_tr(b0), lds_tr(b0 + 16 * RS_T));
                    acc[n] = mfma16(pf, bfr, acc[n]); } } }
        float mean[4], rstd[4];
#pragma unroll
        for (int r = 0; r < 4; ++r) { float sm = 0.f;
#pragma unroll
            for (int n = 0; n < 16; ++n) sm += acc[n][r];
            mean[r] = grp16_sum(sm, lane) * (1.0f / 256.0f); }
#pragma unroll
        for (int r = 0; r < 4; ++r) { float sq = 0.f;
#pragma unroll
            for (int n = 0; n < 16; ++n) { const float d = acc[n][r] - mean[r]; sq += d * d; }
            rstd[r] = 1.0f / sqrtf(grp16_sum(sq, lane) * (1.0f / 256.0f) + GN_EPS); }
#pragma unroll
        for (int n = 0; n < 16; ++n) { const int e = h * 256 + 16 * n + r16; const float g1 = gg[e], b1 = gb[e];
#pragma unroll
            for (int r = 0; r < 4; ++r) { const size_t row = (size_t)(nb * 128 + 16 * w + 4 * g + r);
                const float o = ((acc[n][r] - mean[r]) * rstd[r] * g1 + b1) * bf1(Gt + row * 1024 + e);
                MIX[row * 2048 + e] = (bf16)f2bf(o); } }
    }
}
constexpr int RS_SK = 144, RS_SV = 160;
__device__ __forceinline__ void phase_swa_mfma(const Params& P, const Ctx& cx, int l, LAS unsigned char* lds) {
    unsigned char* ws = cx.ws; const int tid = cx.tid, lane = cx.lane, w = cx.wave, r16 = lane & 15, g = lane >> 4, q = r16 >> 2, pp = r16 & 3;
    const bf16* AQ = (const bf16*)(ws + WS_AQ); const bf16* AK = (const bf16*)(ws + WS_AK); const bf16* AV = (const bf16*)(ws + WS_AV); bf16* MIX = (bf16*)(ws + WS_MIX);
    LAS unsigned char* Kim = lds; LAS unsigned char* Vim = lds + 256 * RS_SK;
    for (int item = cx.bid; item < 256; item += cx.G) {
        const int nb = item >> 1, hk = item & 1, hq = hk * 8 + w; const float sink = P.in[7][l * 16 + hq];
        __syncthreads();
#pragma unroll
        for (int r = 0; r < 4; ++r) { const int pc = tid + 512 * r, row = pc >> 3, c = pc & 7, gk = nb * 128 - 128 + row;
            v4u kv = (v4u){0u, 0u, 0u, 0u}, vv = (v4u){0u, 0u, 0u, 0u};
            if (gk >= 0) { kv = *(const v4u*)(AK + (size_t)gk * 128 + hk * 64 + c * 8); vv = *(const v4u*)(AV + (size_t)gk * 128 + hk * 64 + c * 8); }
            *(LAS v4u*)(Kim + row * RS_SK + c * 16) = kv; *(LAS v4u*)(Vim + row * RS_SV + c * 16) = vv; }
        __syncthreads();
#pragma unroll 1
        for (int nq = 0; nq < 8; ++nq) {
            const bf16* qrow = AQ + (size_t)(nb * 128 + 16 * nq + r16) * 1024 + hq * 64 + 8 * g;
            const bf16x8 qf0 = *(const bf16x8*)(qrow), qf1 = *(const bf16x8*)(qrow + 32);
            f32x4 sc[10];
            float mx = sink;
#pragma unroll
            for (int kb = 0; kb < 9; ++kb) { const LAS unsigned char* kp = Kim + (16 * (nq + kb) + r16) * RS_SK + 16 * g;
                f32x4 a = (f32x4){0.f, 0.f, 0.f, 0.f};
                a = mfma16(*(const LAS bf16x8*)(kp), qf0, a); a = mfma16(*(const LAS bf16x8*)(kp + 64), qf1, a);
#pragma unroll
                for (int r = 0; r < 4; ++r) { const int dl = 16 * kb + 4 * g + r - r16; const bool vis = (dl >= 1) && (dl <= 128) && (nb > 0 || 16 * (nq + kb) + 4 * g + r >= 128);
                    a[r] = vis ? a[r] : -INFINITY; mx = fmaxf(mx, a[r]); }
                sc[kb] = a; }
            sc[9] = (f32x4){0.f, 0.f, 0.f, 0.f};
            mx = fmaxf(mx, __builtin_bit_cast(float, __builtin_amdgcn_ds_bpermute((lane ^ 16) << 2, __builtin_bit_cast(int, mx))));
            mx = fmaxf(mx, __builtin_bit_cast(float, __builtin_amdgcn_ds_bpermute((lane ^ 32) << 2, __builtin_bit_cast(int, mx))));
            float sum = 0.f;
#pragma unroll
            for (int kb = 0; kb < 9; ++kb)
#pragma unroll
                for (int r = 0; r < 4; ++r) { const float pv = __expf(sc[kb][r] - mx); sc[kb][r] = pv; sum += pv; }
            sum += __builtin_bit_cast(float, __builtin_amdgcn_ds_bpermute((lane ^ 16) << 2, __builtin_bit_cast(int, sum)));
            sum += __builtin_bit_cast(float, __builtin_amdgcn_ds_bpermute((lane ^ 32) << 2, __builtin_bit_cast(int, sum)));
            const float inv = 1.0f / (sum + __expf(sink - mx));
            f32x4 o[4];
#pragma unroll
            for (int nd = 0; nd < 4; ++nd) o[nd] = (f32x4){0.f, 0.f, 0.f, 0.f};
#pragma unroll
            for (int sk = 0; sk < 5; ++sk) { const bf16x8 pf = pack_frag(sc[2 * sk] * inv, sc[2 * sk + 1] * inv);
                const int kb0 = nq + 2 * sk, kb1 = (kb0 + 1 > 15) ? 15 : kb0 + 1;
#pragma unroll
                for (int nd = 0; nd < 4; ++nd) { const bf16x8 bfr = cat44(lds_tr(Vim + (16 * kb0 + 4 * g + q) * RS_SV + (16 * nd + 4 * pp) * 2), lds_tr(Vim + (16 * kb1 + 4 * g + q) * RS_SV + (16 * nd + 4 * pp) * 2));
                    o[nd] = mfma16(pf, bfr, o[nd]); } }
#pragma unroll
            for (int nd = 0; nd < 4; ++nd)
#pragma unroll
                for (int r = 0; r < 4; ++r) MIX[(size_t)(nb * 128 + 16 * nq + 4 * g + r) * 2048 + 1024 + hq * 64 + 16 * nd + r16] = (bf16)f2bf(o[nd][r]);
        }
    }
}

__device__ __forceinline__ void phase_groupnorm(const Params& P, const Ctx& cx, int l) {
    unsigned char* ws = cx.ws; const int lane = cx.lane, wave = cx.wave, G = cx.G;
    const float* RY = (const float*)(ws + WS_RETY); const bf16* Gt = (const bf16*)(ws + WS_G); bf16* MIX = (bf16*)(ws + WS_MIX);
    const float* gg = P.in[5] + l * 1024; const float* gb = P.in[6] + l * 1024;
    const int gw = cx.bid * 8 + wave, NGW = G * 8;
    for (int it = gw; it < S * 4; it += NGW) { const int row = it >> 2, h = it & 3; const size_t off = (size_t)row * 1024 + h * 256 + 4 * lane;
        f32x4 v = *(const f32x4*)(RY + off);
        const float mean = wave_sum((v[0] + v[1]) + (v[2] + v[3]), lane) * (1.0f / 256.0f);
        v = v - mean;
        const float var = wave_sum((v[0] * v[0] + v[1] * v[1]) + (v[2] * v[2] + v[3] * v[3]), lane) * (1.0f / 256.0f);
        const float rstd = 1.0f / sqrtf(var + GN_EPS);
        const f32x4 g4 = *(const f32x4*)(gg + h * 256 + 4 * lane), b4 = *(const f32x4*)(gb + h * 256 + 4 * lane);
        const v2u gt2 = *(const v2u*)(Gt + off);
        f32x4 o = v * rstd * g4 + b4;
        o[0] *= bflo(gt2.x); o[1] *= bfhi(gt2.x); o[2] *= bflo(gt2.y); o[3] *= bfhi(gt2.y);
        v2u w; w.x = pk2(o[0], o[1]); w.y = pk2(o[2], o[3]);
        *(v2u*)(MIX + (size_t)row * 2048 + h * 256 + 4 * lane) = w; }
}
__device__ __forceinline__ void phase_ln(const Ctx& cx, const float* Y, const float* g, const float* b, float* xo, bf16* xb) {
    const int lane = cx.lane, wave = cx.wave, G = cx.G; const int gw = cx.bid * 8 + wave, NGW = G * 8;
    f32x4 g4[8], b4[8];
#pragma unroll
    for (int j = 0; j < 8; ++j) { g4[j] = ((const f32x4*)g)[64 * j + lane]; b4[j] = ((const f32x4*)b)[64 * j + lane]; }
    for (int row = gw; row < S; row += 2 * NGW) {
        const int row2 = row + NGW; const bool has2 = row2 < S; const int rb = has2 ? row2 : row;
        const f32x4* ya = (const f32x4*)(Y + (size_t)row * D) + lane; const f32x4* yb = (const f32x4*)(Y + (size_t)rb * D) + lane;
        f32x4 va[8], vb[8]; float sa = 0.f, sb = 0.f;
#pragma unroll
        for (int j = 0; j < 8; ++j) { va[j] = ya[64 * j]; vb[j] = yb[64 * j]; }
#pragma unroll
        for (int j = 0; j < 8; ++j) { sa += (va[j][0] + va[j][1]) + (va[j][2] + va[j][3]); sb += (vb[j][0] + vb[j][1]) + (vb[j][2] + vb[j][3]); }
        const float ma = wave_sum(sa, lane) * (1.0f / D), mb = wave_sum(sb, lane) * (1.0f / D); float qa = 0.f, qb = 0.f;
#pragma unroll
        for (int j = 0; j < 8; ++j) { va[j] = va[j] - ma; vb[j] = vb[j] - mb; qa += (va[j][0] * va[j][0] + va[j][1] * va[j][1]) + (va[j][2] * va[j][2] + va[j][3] * va[j][3]); qb += (vb[j][0] * vb[j][0] + vb[j][1] * vb[j][1]) + (vb[j][2] * vb[j][2] + vb[j][3] * vb[j][3]); }
        const float ra = 1.0f / sqrtf(wave_sum(qa, lane) * (1.0f / D) + LN_EPS), rbb = 1.0f / sqrtf(wave_sum(qb, lane) * (1.0f / D) + LN_EPS);
        f32x4* xa = (f32x4*)(xo + (size_t)row * D) + lane; f32x4* xbp = (f32x4*)(xo + (size_t)rb * D) + lane;
#pragma unroll
        for (int j = 0; j < 8; ++j) { const f32x4 o = va[j] * ra * g4[j] + b4[j]; xa[64 * j] = o;
            if (xb) { v2u w; w.x = pk2(o[0], o[1]); w.y = pk2(o[2], o[3]); ((v2u*)(xb + (size_t)row * D))[64 * j + lane] = w; } }
        if (has2) {
#pragma unroll
            for (int j = 0; j < 8; ++j) { const f32x4 o = vb[j] * rbb * g4[j] + b4[j]; xbp[64 * j] = o;
                if (xb) { v2u w; w.x = pk2(o[0], o[1]); w.y = pk2(o[2], o[3]); ((v2u*)(xb + (size_t)rb * D))[64 * j + lane] = w; } } }
    }
}
__device__ __forceinline__ void unpack8(const v4u h, float (&o)[8]) { o[0] = bflo(h.x); o[1] = bfhi(h.x); o[2] = bflo(h.y); o[3] = bfhi(h.y); o[4] = bflo(h.z); o[5] = bfhi(h.z); o[6] = bflo(h.w); o[7] = bfhi(h.w); }
__device__ __forceinline__ void phase_convact(const Params& P, const Ctx& cx, int l) {
    unsigned char* ws = cx.ws; const int tid = cx.tid, G = cx.G;
    const bf16* H = (const bf16*)(ws + WS_H); bf16* ACT = (bf16*)(ws + WS_ACT);
    const float* cw = P.in[11] + (size_t)l * 3 * NUP; const float* cb = P.in[12] + (size_t)l * NUP;
    const int gt = cx.bid * 512 + tid, NT = G * 512;
    for (int item = gt; item < 512 * 704; item += NT) {
        const int seg = item / 704, r = item - seg * 704, tile = r >> 4, q8 = r & 15, t0 = seg * 32;
        const int chg = 128 * tile + 8 * q8, chu = DFF + chg;
        float wg[3][8], wu[3][8], bg[8], bu[8];
#pragma unroll
        for (int k = 0; k < 3; ++k) { const f32x4 a0 = *(const f32x4*)(cw + (size_t)k * NUP + chg), a1 = *(const f32x4*)(cw + (size_t)k * NUP + chg + 4), c0 = *(const f32x4*)(cw + (size_t)k * NUP + chu), c1 = *(const f32x4*)(cw + (size_t)k * NUP + chu + 4);
#pragma unroll
            for (int e = 0; e < 4; ++e) { wg[k][e] = a0[e]; wg[k][4 + e] = a1[e]; wu[k][e] = c0[e]; wu[k][4 + e] = c1[e]; } }
        { const f32x4 a0 = *(const f32x4*)(cb + chg), a1 = *(const f32x4*)(cb + chg + 4), c0 = *(const f32x4*)(cb + chu), c1 = *(const f32x4*)(cb + chu + 4);
#pragma unroll
          for (int e = 0; e < 4; ++e) { bg[e] = a0[e]; bg[4 + e] = a1[e]; bu[e] = c0[e]; bu[4 + e] = c1[e]; } }
        const bf16* hp = H + (size_t)t0 * NUP + 256 * tile + 8 * q8;
        float g2[8], g1[8], u2[8], u1[8];
        if (t0 > 0) { unpack8(*(const v4u*)(hp - 2 * (size_t)NUP), g2); unpack8(*(const v4u*)(hp - (size_t)NUP), g1); unpack8(*(const v4u*)(hp - 2 * (size_t)NUP + 128), u2); unpack8(*(const v4u*)(hp - (size_t)NUP + 128), u1); }
        else {
#pragma unroll
            for (int e = 0; e < 8; ++e) { g2[e] = 0.f; g1[e] = 0.f; u2[e] = 0.f; u1[e] = 0.f; } }
        bf16* ap = ACT + (size_t)t0 * DFF + chg;
        v4u ng = *(const v4u*)(hp), nu = *(const v4u*)(hp + 128);
#pragma unroll 2
        for (int tt = 0; tt < 32; ++tt) {
            float g0[8], u0[8]; unpack8(ng, g0); unpack8(nu, u0);
            if (tt < 31) { ng = *(const v4u*)(hp + (size_t)(tt + 1) * NUP); nu = *(const v4u*)(hp + (size_t)(tt + 1) * NUP + 128); }
            float o[8];
#pragma unroll
            for (int e = 0; e < 8; ++e) { const float ga = bg[e] + wg[0][e] * g2[e] + wg[1][e] * g1[e] + wg[2][e] * g0[e], ua = bu[e] + wu[0][e] * u2[e] + wu[1][e] * u1[e] + wu[2][e] * u0[e];
                o[e] = ga * __builtin_amdgcn_rcpf(1.0f + __expf(-ga)) * ua; g2[e] = g1[e]; g1[e] = g0[e]; u2[e] = u1[e]; u1[e] = u0[e]; }
            v4u w; w.x = cvt2(o[0], o[1]); w.y = cvt2(o[2], o[3]); w.z = cvt2(o[4], o[5]); w.w = cvt2(o[6], o[7]);
            *(v4u*)(ap + (size_t)tt * DFF) = w;
        }
    }
}

#ifdef DBG_DUMP
__device__ __forceinline__ void phase_dump(const Ctx& cx, float* out, const bf16* a, int lda, const bf16* b, int ldb, const float* f) {
    const size_t gt = (size_t)cx.bid * 512 + cx.tid, NT = (size_t)cx.G * 512;
    for (size_t i = gt; i < (size_t)S * D; i += NT) { const int row = (int)(i >> 11), col = (int)(i & 2047);
        float v; if (f) v = f[i]; else if (b && col >= 1024) v = bf1(b + (size_t)row * ldb + (col - 1024)); else v = lda ? bf1(a + (size_t)row * lda + col) : bf1(a + (size_t)(row & 2047) * 2048 + col);
        out[i] = v; }
}
#endif
__global__ void __launch_bounds__(512, 2) fwd(Params P) {
    extern __shared__ __attribute__((aligned(16))) unsigned char lds_raw[];
    LAS unsigned char* lds = (LAS unsigned char*)lds_raw;
    const int wave = __builtin_amdgcn_readfirstlane(threadIdx.x >> 6), G = gridDim.x;
    unsigned char* ws = P.ws;
    volatile LAS unsigned* MISC = (volatile LAS unsigned*)(lds + MISC_OFF);
    for (int u = threadIdx.x; u < (LDS_BYTES - LDSCTL_OFF) / 4; u += 512) ((LAS unsigned*)(lds + LDSCTL_OFF))[u] = 0u;
    __syncthreads();
    const int lo = P.ph_lo, hi = P.ph_hi;
    XcdBarrier bar; bar.bar = (unsigned*)(ws + WS_CTL) + CW_BAR; bar.x = 0; bar.st = nullptr;
    if (hi - lo > 1) bar = xcd_barrier_post((unsigned*)(ws + WS_CTL) + CW_BAR, MISC + 8);
#define IN(k) (lo <= (k) && (k) < hi)
#define SEAM(k) do { if (IN(k) && IN((k) + 1)) xcd_barrier(bar); } while (0)
#define OPQ() Ctx cx; cx.lane = lane_id_asm(); { int t_ = wave; asm volatile("" : "+s"(t_)); cx.wave = t_; } { int t_ = G; asm volatile("" : "+s"(t_)); cx.G = t_; } { int t_ = blockIdx.x; asm volatile("" : "+s"(t_)); cx.bid = t_; } \
    { unsigned t_ = 0u; asm volatile("" : "+s"(t_)); cx.ws = P.ws + t_; } cx.tid = cx.wave * 64 + cx.lane; int lq = l; asm volatile("" : "+s"(lq)); (void)lq

#ifdef DBG_DUMP
    if (lo >= 1000) { const int l = 0; OPQ(); unsigned char* w = cx.ws; const int kind = lo - 1000;
        if (kind == 1) phase_dump(cx, P.out, (const bf16*)(w + WS_Q), 1024, (const bf16*)(w + WS_AQ), 1024, nullptr);
        else if (kind == 2) phase_dump(cx, P.out, (const bf16*)(w + WS_MIX), 2048, nullptr, 0, nullptr);
        else if (kind == 3) phase_dump(cx, P.out, nullptr, 0, nullptr, 0, (const float*)(w + WS_XR));
        else if (kind == 4) phase_dump(cx, P.out, (const bf16*)(w + WS_ACT), DFF, nullptr, 0, nullptr);
        else if (kind == 5) phase_dump(cx, P.out, nullptr, 0, nullptr, 0, (const float*)(w + WS_Y));
        else if (kind == 6) phase_dump(cx, P.out, (const bf16*)(w + WS_K), 1024, (const bf16*)(w + WS_V), 1024, nullptr);
        else if (kind == 7) phase_dump(cx, P.out, (const bf16*)(w + WS_XB), 2048, nullptr, 0, nullptr);
        else if (kind == 11) phase_dump(cx, P.out, (const bf16*)(w + WS_W + WL_G), 0, nullptr, 0, nullptr);
        else if (kind == 12) phase_dump(cx, P.out, (const bf16*)(w + WS_W + WL_OUT), 0, nullptr, 0, nullptr);
        else if (kind == 10) phase_dump(cx, P.out, (const bf16*)(w + WS_H) + 36 * 256, NUP, nullptr, 0, nullptr);
        else if (kind == 9) phase_dump(cx, P.out, (const bf16*)(w + WS_SG), 2048, nullptr, 0, nullptr);
        else if (kind == 8) phase_dump(cx, P.out, nullptr, 0, nullptr, 0, (const float*)(w + WS_RETY));
        return; }
#endif
    if (IN(0)) { const int l = 0; REPS(2) { __syncthreads(); OPQ(); phase_prologue(P, cx, lds); } }
    SEAM(0);

    for (int l = 0; l < DEPTH; ++l) {
        const int pb = 1 + l * NPH;
        if (IN(pb + 0)) { OPQ(); unsigned char* w = cx.ws; const bf16* wl = (const bf16*)(w + WS_W + (size_t)lq * WL_BYTES);
            pg8::Gemm g{(const bf16*)(w + WS_XB), wl + WL_IN / 2, S, INW, D}; pg8::StaticOrder So; So.init(S, INW, cx.G, cx.bid);
            pg8::EpiInProj E{(bf16*)(w + WS_Q), (bf16*)(w + WS_K), (bf16*)(w + WS_V), (bf16*)(w + WS_G), (bf16*)(w + WS_AQ), (bf16*)(w + WS_AK), (bf16*)(w + WS_AV),
                             (const float*)(w + WS_COSR), (const float*)(w + WS_SINR), (const float*)(w + WS_COSA), (const float*)(w + WS_SINA)};
            pg8::gemm_phase<pg8::EpiInProj, pg8::StaticOrder, true, true>(lds, g, So, E, cx.wave);
        }
        SEAM(pb + 0);
        if (IN(pb + 1)) {
#if RET_MFMA
            { REPS(2) { OPQ(); phase_ret_u_mfma(P, cx, lds); } }
#else
            { OPQ(); phase_ret_u_scores(P, cx, lds); }
#endif
#if SWA_MFMA
            { REPS(2) { OPQ(); phase_swa_mfma(P, cx, lq, lds); } }
#else
            { OPQ(); phase_swa(P, cx, lq, lds); }
#endif
        }
        SEAM(pb + 1);
#if RET_MFMA
        if (IN(pb + 2)) { OPQ(); phase_scan_bf16(P, cx); }
        SEAM(pb + 2);
        if (IN(pb + 3)) { REPS(2) { OPQ(); phase_ret_out_mfma(P, cx, lq, lds); } }
        SEAM(pb + 3);
#else
        if (IN(pb + 2)) { OPQ(); phase_scan(P, cx); }
        SEAM(pb + 2);
        if (IN(pb + 3)) { OPQ(); phase_ret_out(P, cx, lds); }
        SEAM(pb + 3);
        if (IN(pb + 4)) { OPQ(); phase_groupnorm(P, cx, lq); }
        SEAM(pb + 4);
#endif
        if (IN(pb + 5)) { OPQ(); unsigned char* w = cx.ws; const bf16* wl = (const bf16*)(w + WS_W + (size_t)lq * WL_BYTES);
            pg8::Gemm g{(const bf16*)(w + WS_MIX), wl + WL_OUT / 2, S, D, D}; pg8::StaticOrder So; So.init(S, D, cx.G, cx.bid);
            pg8::EpiResid<false> E{(lq == 0) ? P.in[0] : (const float*)(w + WS_XR), (float*)(w + WS_Y), ALPHA};
            pg8::gemm_phase<pg8::EpiResid<false>, pg8::StaticOrder, true, true>(lds, g, So, E, cx.wave);
        }
        SEAM(pb + 5);
        if (IN(pb + 6)) { REPS(1) { OPQ(); unsigned char* w = cx.ws; phase_ln(cx, (const float*)(w + WS_Y), P.in[8] + lq * D, P.in[9] + lq * D, (float*)(w + WS_XR), (bf16*)(w + WS_XB)); } }
        SEAM(pb + 6);
        if (IN(pb + 7)) { OPQ(); unsigned char* w = cx.ws; const bf16* wl = (const bf16*)(w + WS_W + (size_t)lq * WL_BYTES);
            pg8::Gemm g{(const bf16*)(w + WS_XB), wl + WL_UP / 2, S, NUPG, D}; pg8::StaticOrder So; So.init(S, NUPG, cx.G, cx.bid);
            pg8::EpiUp E{(bf16*)(w + WS_H), (bf16*)(w + WS_SG), P.in[17] + lq * D};
            pg8::gemm_phase<pg8::EpiUp, pg8::StaticOrder, true, true>(lds, g, So, E, cx.wave);
        }
        SEAM(pb + 7);
        if (IN(pb + 8)) {
            { OPQ(); unsigned char* w = cx.ws; const bf16* wl = (const bf16*)(w + WS_W + (size_t)lq * WL_BYTES);
              pg8::Gemm g{(const bf16*)(w + WS_PB) + (size_t)lq * S * PLE, wl + WL_P / 2, S, D, PLE}; pg8::StaticOrder So; So.init(S, D, cx.G, cx.bid);
              pg8::EpiPle E{(const bf16*)(w + WS_SG), (float*)(w + WS_Y)};
              pg8::gemm_phase<pg8::EpiPle, pg8::StaticOrder, true, true>(lds, g, So, E, cx.wave); }
            { REPS(1) { OPQ(); phase_convact(P, cx, lq); } }
        }
        SEAM(pb + 8);
        if (IN(pb + 9)) { OPQ(); unsigned char* w = cx.ws; const bf16* wl = (const bf16*)(w + WS_W + (size_t)lq * WL_BYTES);
            pg8::Gemm g{(const bf16*)(w + WS_ACT), wl + WL_DOWN / 2, S, D, DFF}; pg8::StaticOrder So; So.init(S, D, cx.G, cx.bid);
            pg8::EpiResid<true> E{(const float*)(w + WS_XR), (float*)(w + WS_Y), ALPHA};
            pg8::gemm_phase<pg8::EpiResid<true>, pg8::StaticOrder, true, true>(lds, g, So, E, cx.wave);
        }
        SEAM(pb + 9);
        if (IN(pb + 10)) { REPS(1) { OPQ(); unsigned char* w = cx.ws; const bool last = (lq == DEPTH - 1);
            phase_ln(cx, (const float*)(w + WS_Y), P.in[14] + lq * D, P.in[15] + lq * D, last ? P.out : (float*)(w + WS_XR), last ? (bf16*)nullptr : (bf16*)(w + WS_XB)); } }
        SEAM(pb + 10);
    }
#undef IN
#undef SEAM
}

extern "C" void kernel_launch(void* const* d_in, const int* in_sizes, int n_in, void* d_out, int out_size, void* d_ws, size_t ws_size, hipStream_t stream) {
    static int grid = 0;
    if (grid == 0) {
        if (n_in != 19 || in_sizes[0] != S * D || out_size != S * D || ws_size < WS_END) { fprintf(stderr, "kernel_launch: unexpected shapes (n_in %d, in0 %d, out %d, ws %zu)\n", n_in, n_in > 0 ? in_sizes[0] : -1, out_size, ws_size); grid = -1; return; }
        int dev = 0, cus = 0, per_cu = 0;
        if (hipGetDevice(&dev) != hipSuccess || hipDeviceGetAttribute(&cus, hipDeviceAttributeMultiprocessorCount, dev) != hipSuccess) { grid = -1; return; }
        if (hipFuncSetAttribute((const void*)fwd, hipFuncAttributeMaxDynamicSharedMemorySize, LDS_BYTES) != hipSuccess) { fprintf(stderr, "kernel_launch: hipFuncSetAttribute failed\n"); grid = -1; return; }
        if (hipOccupancyMaxActiveBlocksPerMultiprocessor(&per_cu, (const void*)fwd, 512, LDS_BYTES) != hipSuccess || per_cu < 1) fprintf(stderr, "kernel_launch: occupancy query says %d\n", per_cu);
        (void)hipGetLastError();
        grid = cus;
    }
    if (grid < 0) return;
    (void)hipMemsetAsync((char*)d_ws + WS_CTL, 0, CTL_ZERO_BYTES, stream);
#ifdef DBG_NANFILL
    (void)hipMemsetAsync((char*)d_ws + CTL_ZERO_BYTES, 0xFF, WS_END - CTL_ZERO_BYTES, stream);
#endif
    Params p{};
    for (int i = 0; i < 19; ++i) p.in[i] = (const float*)d_in[i];
    p.out = (float*)d_out; p.ws = (unsigned char*)d_ws;
    for (int f = 0; f < 128; ++f) p.invf_ret[f] = (float)(1.0 / std::pow(10000.0, (double)((float)f / 127.0f)));
    for (int f = 0; f < 32; ++f) p.invf_att[f] = (float)std::pow(10000.0, -(double)(2 * f) / 64.0);
    for (int h = 0; h < 4; ++h) p.lg2g[h] = (float)std::log2(1.0 - std::exp2(-5.0 - h));
#if MK_ONE_LAUNCH
    p.ph_lo = 0; p.ph_hi = NPHASES;
    hipLaunchKernelGGL(fwd, dim3(grid), dim3(512), LDS_BYTES, stream, p);
#else
#ifdef DBG_DUMP
    for (int ph = 0; ph <= DBG_STOP; ++ph) { p.ph_lo = ph; p.ph_hi = ph + 1; hipLaunchKernelGGL(fwd, dim3(grid), dim3(512), LDS_BYTES, stream, p); }
    p.ph_lo = 1000 + DBG_DUMP; p.ph_hi = p.ph_lo + 1; hipLaunchKernelGGL(fwd, dim3(grid), dim3(512), LDS_BYTES, stream, p);
#else
    for (int ph = 0; ph < NPHASES; ++ph) { p.ph_lo = ph; p.ph_hi = ph + 1; hipLaunchKernelGGL(fwd, dim3(grid), dim3(512), LDS_BYTES, stream, p); }
#endif
#endif
}
```

```cpp
#include <hip/hip_runtime.h>
#include <cstdio>
#include <cstdint>
#include <cmath>
#define MK_ONE_LAUNCH 1
namespace pg8 {
#define PG8_LAS __attribute__((address_space(3)))
typedef unsigned short bf16_t;
typedef short bf16x8 __attribute__((ext_vector_type(8)));
typedef float f32x4 __attribute__((ext_vector_type(4)));
typedef unsigned u32x4 __attribute__((ext_vector_type(4)));
constexpr int BM = 256, BK = 64, HALF = 128, HTB = HALF * BK * 2  , STAGE_BYTES = 8 * HTB, NXCD = 8, WGM = 8;

__host__ __device__ __forceinline__ int lds_byte(int r, int c) { const int st = (r >> 4) * 2 + (c >> 5), rr = r & 15, cc = c & 31, ob = rr * 64 + cc * 2; return st * 1024 + (ob ^ (((ob >> 9) & 1) << 5)); }
__host__ __device__ __forceinline__ void stage_rc(int b, int& R, int& C) { const int st = b / 1024, sb = b % 1024, swz = sb ^ (((sb >> 9) & 1) << 5); R = (st >> 1) * 16 + swz / 64; C = (st & 1) * 32 + (swz % 64) / 2; }
__host__ __device__ __forceinline__ int perm32(int rho) { const int n = rho >> 4, i = rho & 15; return 8 * (i >> 2) + 4 * n + (i & 3); }

struct Unit { int pm, pn; };
struct Gemm { const bf16_t* A; const bf16_t* Bt; int M, N, K; };

struct StaticOrder {
    int nM, nN, nwg, G, c;
    __host__ __device__ void init(int M, int N, int G_, int c_) { nM = M / BM; nN = N / BM; nwg = nM * nN; G = G_; c = c_; }
    __host__ __device__ bool next(int i, Unit& u) const {
        const long L = (long)i * G + c; if (L >= nwg) return false;
        int wgid = (int)L; { const int q = nwg / NXCD, r = nwg % NXCD, xcd = wgid % NXCD, off = wgid / NXCD; wgid = (xcd < r ? xcd * (q + 1) : r * (q + 1) + (xcd - r) * q) + off; }
        const int nig = WGM * nN, gid = wgid / nig, fm = gid * WGM, gsz = (nM - fm) < WGM ? (nM - fm) : WGM;
        u.pm = fm + ((wgid % nig) % gsz); u.pn = (wgid % nig) / gsz; return true;
    }
    __device__ __forceinline__ void a_ready(const Unit&) const {}
    __device__ __forceinline__ void done(const Unit&) const {}
};

typedef float f32x2c_t __attribute__((ext_vector_type(2))); typedef __bf16 bf16x2c_t __attribute__((ext_vector_type(2)));
__device__ __forceinline__ unsigned cvt_pk_bf16(float lo, float hi) { f32x2c_t v = {lo, hi}; bf16x2c_t b = __builtin_convertvector(v, bf16x2c_t); return __builtin_bit_cast(unsigned, b); }
typedef float f32x2 __attribute__((ext_vector_type(2)));
typedef unsigned u32x2 __attribute__((ext_vector_type(2)));
__device__ __forceinline__ float bf2f(unsigned short b) { return __uint_as_float(((unsigned)b) << 16); }
__device__ __forceinline__ u32x4 pack8(const f32x4 a, const f32x4 b) { u32x4 w; w.x = cvt_pk_bf16(a[0], a[1]); w.y = cvt_pk_bf16(a[2], a[3]); w.z = cvt_pk_bf16(b[0], b[1]); w.w = cvt_pk_bf16(b[2], b[3]); return w; }
__device__ __forceinline__ float sigmoidf_(float x) { return __builtin_amdgcn_rcpf(1.0f + __expf(-x)); }

struct EpiInProj {
    static constexpr bool PERM = true, AFTER_DRAIN = false;
    bf16_t *Q, *K, *V, *G, *AQ, *AK, *AV; const float *cosr, *sinr, *cosa, *sina;
    __device__ __forceinline__ void operator()(const f32x4 (&acc)[2][2][4][2], const Unit& u, int wr, int wc, int fr, int fq) const {
        const int row0 = u.pm * BM + wr * 64 + fr, pn = u.pn, cw = wc * 32 + 8 * fq;
        if (pn < 8) {
            bf16_t* O = pn < 4 ? Q : K; const int hcol = (pn & 3) * 256; const float sc = pn < 4 ? 1.0f : 0.0625f;
#pragma unroll
            for (int ai = 0; ai < 2; ++ai)
#pragma unroll
                for (int m = 0; m < 4; ++m) { const int row = row0 + ai * HALF + m * 16;
                    const f32x4 c0 = *(const f32x4*)(cosr + (size_t)row * 128 + cw), c1 = *(const f32x4*)(cosr + (size_t)row * 128 + cw + 4);
                    const f32x4 s0 = *(const f32x4*)(sinr + (size_t)row * 128 + cw), s1 = *(const f32x4*)(sinr + (size_t)row * 128 + cw + 4);
                    const f32x4 a0 = acc[ai][0][m][0], a1 = acc[ai][0][m][1], b0 = acc[ai][1][m][0], b1 = acc[ai][1][m][1];
                    const f32x4 o10 = (a0 * c0 - b0 * s0) * sc, o11 = (a1 * c1 - b1 * s1) * sc, o20 = (a0 * s0 + b0 * c0) * sc, o21 = (a1 * s1 + b1 * c1) * sc;
                    bf16_t* rowp = O + (size_t)row * 1024 + hcol + cw;
                    *(u32x4*)(rowp) = pack8(o10, o11); *(u32x4*)(rowp + HALF) = pack8(o20, o21); }
        } else if (pn < 16) {
            const bool gate = pn >= 12; bf16_t* O = gate ? G : V; const int hcol = (pn & 3) * 256;
#pragma unroll
            for (int ai = 0; ai < 2; ++ai)
#pragma unroll
                for (int m = 0; m < 4; ++m) { const int row = row0 + ai * HALF + m * 16; bf16_t* rowp = O + (size_t)row * 1024 + hcol + cw;
#pragma unroll
                    for (int bj = 0; bj < 2; ++bj) { f32x4 v0 = acc[ai][bj][m][0], v1 = acc[ai][bj][m][1];
                        if (gate) {
#pragma unroll
                            for (int j = 0; j < 4; ++j) { v0[j] = v0[j] * sigmoidf_(v0[j]); v1[j] = v1[j] * sigmoidf_(v1[j]); } }
                        *(u32x4*)(rowp + bj * HALF) = pack8(v0, v1); } }
        } else if (pn < 20) {
            const int t = pn - 16, i0 = 8 * fq;
#pragma unroll
            for (int ai = 0; ai < 2; ++ai)
#pragma unroll
                for (int m = 0; m < 4; ++m) { const int row = row0 + ai * HALF + m * 16;
                    const f32x4 c0 = *(const f32x4*)(cosa + (size_t)row * 32 + i0), c1 = *(const f32x4*)(cosa + (size_t)row * 32 + i0 + 4);
                    const f32x4 s0 = *(const f32x4*)(sina + (size_t)row * 32 + i0), s1 = *(const f32x4*)(sina + (size_t)row * 32 + i0 + 4);
                    const f32x4 a0 = acc[ai][0][m][0], a1 = acc[ai][0][m][1], b0 = acc[ai][1][m][0], b1 = acc[ai][1][m][1];
                    const f32x4 o10 = (a0 * c0 - b0 * s0) * 0.125f, o11 = (a1 * c1 - b1 * s1) * 0.125f, o20 = (a0 * s0 + b0 * c0) * 0.125f, o21 = (a1 * s1 + b1 * c1) * 0.125f;
                    bf16_t* rowp = AQ + (size_t)row * 1024 + t * 256 + wc * 64 + i0;
                    *(u32x4*)(rowp) = pack8(o10, o11); *(u32x4*)(rowp + 32) = pack8(o20, o21); }
        } else {
            const int i0 = 8 * fq;
            if (wc < 2) {
#pragma unroll
                for (int ai = 0; ai < 2; ++ai)
#pragma unroll
                    for (int m = 0; m < 4; ++m) { const int row = row0 + ai * HALF + m * 16;
                        const f32x4 c0 = *(const f32x4*)(cosa + (size_t)row * 32 + i0), c1 = *(const f32x4*)(cosa + (size_t)row * 32 + i0 + 4);
                        const f32x4 s0 = *(const f32x4*)(sina + (size_t)row * 32 + i0), s1 = *(const f32x4*)(sina + (size_t)row * 32 + i0 + 4);
                        const f32x4 a0 = acc[ai][0][m][0], a1 = acc[ai][0][m][1], b0 = acc[ai][1][m][0], b1 = acc[ai][1][m][1];
                        const f32x4 o10 = a0 * c0 - b0 * s0, o11 = a1 * c1 - b1 * s1, o20 = a0 * s0 + b0 * c0, o21 = a1 * s1 + b1 * c1;
                        bf16_t* rowp = AK + (size_t)row * 128 + wc * 64 + i0;
                        *(u32x4*)(rowp) = pack8(o10, o11); *(u32x4*)(rowp + 32) = pack8(o20, o21); }
            } else {
#pragma unroll
                for (int ai = 0; ai < 2; ++ai)
#pragma unroll
                    for (int m = 0; m < 4; ++m) { const int row = row0 + ai * HALF + m * 16; bf16_t* rowp = AV + (size_t)row * 128 + (wc - 2) * 32 + i0;
                        *(u32x4*)(rowp) = pack8(acc[ai][0][m][0], acc[ai][0][m][1]); *(u32x4*)(rowp + 64) = pack8(acc[ai][1][m][0], acc[ai][1][m][1]); }
            }
        }
    }
};
template <bool ADD> struct EpiResid {
    static constexpr bool PERM = false, AFTER_DRAIN = false;
    const float* base; float* Y; float alpha;
    __device__ __forceinline__ void operator()(const f32x4 (&acc)[2][2][4][2], const Unit& u, int wr, int wc, int fr, int fq) const {
        const int row0 = u.pm * BM + wr * 64 + fr, col0 = u.pn * BM + wc * 32 + 4 * fq;
#pragma unroll
        for (int ai = 0; ai < 2; ++ai)
#pragma unroll
            for (int m = 0; m < 4; ++m) { const size_t off = (size_t)(row0 + ai * HALF + m * 16) * 2048 + col0;
#pragma unroll
                for (int bj = 0; bj < 2; ++bj)
#pragma unroll
                    for (int n = 0; n < 2; ++n) { const size_t o = off + bj * HALF + n * 16; f32x4 v = acc[ai][bj][m][n] + *(const f32x4*)(base + o) * alpha;
                        if (ADD) v = v + *(const f32x4*)(Y + o); *(f32x4*)(Y + o) = v; } }
    }
};
struct EpiUp {
    static constexpr bool PERM = true, AFTER_DRAIN = false;
    bf16_t* H; bf16_t* SG; const float* bgate;
    __device__ __forceinline__ void operator()(const f32x4 (&acc)[2][2][4][2], const Unit& u, int wr, int wc, int fr, int fq) const {
        const int row0 = u.pm * BM + wr * 64 + fr, cw = wc * 32 + 8 * fq;
        if (u.pn < 44) {
#pragma unroll
            for (int ai = 0; ai < 2; ++ai)
#pragma unroll
                for (int m = 0; m < 4; ++m) { bf16_t* rowp = H + (size_t)(row0 + ai * HALF + m * 16) * 11264 + u.pn * 256 + cw;
#pragma unroll
                    for (int bj = 0; bj < 2; ++bj) *(u32x4*)(rowp + bj * HALF) = pack8(acc[ai][bj][m][0], acc[ai][bj][m][1]); }
        } else {
            const int colg = (u.pn - 44) * 256 + cw;
            f32x4 bv[2][2];
#pragma unroll
            for (int bj = 0; bj < 2; ++bj)
#pragma unroll
                for (int n = 0; n < 2; ++n) bv[bj][n] = *(const f32x4*)(bgate + colg + bj * HALF + 4 * n);
#pragma unroll
            for (int ai = 0; ai < 2; ++ai)
#pragma unroll
                for (int m = 0; m < 4; ++m) { bf16_t* rowp = SG + (size_t)(row0 + ai * HALF + m * 16) * 2048 + colg;
#pragma unroll
                    for (int bj = 0; bj < 2; ++bj) { f32x4 v0 = acc[ai][bj][m][0] + bv[bj][0], v1 = acc[ai][bj][m][1] + bv[bj][1];
#pragma unroll
                        for (int j = 0; j < 4; ++j) { v0[j] = sigmoidf_(v0[j]); v1[j] = sigmoidf_(v1[j]); }
                        *(u32x4*)(rowp + bj * HALF) = pack8(v0, v1); } }
        }
    }
};

__device__ __forceinline__ float ror1f(float x) { return __builtin_bit_cast(float, __builtin_amdgcn_update_dpp(0, __builtin_bit_cast(int, x), 0x121, 0xf, 0xf, false)); }
__device__ __forceinline__ float ror2f(float x) { return __builtin_bit_cast(float, __builtin_amdgcn_update_dpp(0, __builtin_bit_cast(int, x), 0x122, 0xf, 0xf, false)); }
struct EpiUpConv {
    static constexpr bool PERM = true, AFTER_DRAIN = false;
    bf16_t* ACT; bf16_t* HALO; bf16_t* SG; const float* bgate; const float* cw; const float* cb;
    __device__ __forceinline__ void operator()(const f32x4 (&acc)[2][2][4][2], const Unit& u, int wr, int wc, int fr, int fq) const {
        const int row0 = u.pm * BM + wr * 64 + fr, cwp = wc * 32 + 8 * fq;
        if (u.pn < 44) {
#pragma unroll
            for (int n = 0; n < 2; ++n) {
                const int chg = 128 * u.pn + cwp + 4 * n, chu = 5632 + chg;
                const f32x4 wg0 = *(const f32x4*)(cw + chg), wg1 = *(const f32x4*)(cw + 11264 + chg), wg2 = *(const f32x4*)(cw + 2 * 11264 + chg), bg = *(const f32x4*)(cb + chg);
                const f32x4 wu0 = *(const f32x4*)(cw + chu), wu1 = *(const f32x4*)(cw + 11264 + chu), wu2 = *(const f32x4*)(cw + 2 * 11264 + chu), bu = *(const f32x4*)(cb + chu);
#pragma unroll
                for (int ai = 0; ai < 2; ++ai) {
                    const int span = u.pm * 4 + ai * 2 + wr;
#pragma unroll
                    for (int m = 0; m < 4; ++m) {
                        const f32x4 cg = acc[ai][0][m][n], cu = acc[ai][1][m][n];
                        const f32x4 pg = acc[ai][0][m ? m - 1 : 0][n], pu = acc[ai][1][m ? m - 1 : 0][n];
                        f32x4 o;
#pragma unroll
                        for (int j = 0; j < 4; ++j) {
                            const float g1 = ror1f(fr == 15 ? pg[j] : cg[j]), g2 = ror2f(fr >= 14 ? pg[j] : cg[j]);
                            const float u1 = ror1f(fr == 15 ? pu[j] : cu[j]), u2 = ror2f(fr >= 14 ? pu[j] : cu[j]);
                            const float ga = bg[j] + wg0[j] * g2 + wg1[j] * g1 + wg2[j] * cg[j], ua = bu[j] + wu0[j] * u2 + wu1[j] * u1 + wu2[j] * cu[j];
                            o[j] = ga * sigmoidf_(ga) * ua; }
                        const int row = row0 + ai * HALF + m * 16;
                        u32x2 w; w.x = cvt_pk_bf16(o[0], o[1]); w.y = cvt_pk_bf16(o[2], o[3]);
                        if (m > 0 || fr >= 2) *(u32x2*)(ACT + (size_t)row * 5632 + 128 * u.pn + cwp + 4 * n) = w;
                        if ((m == 0 && fr < 2) || (m == 3 && fr >= 14)) { const int slot = (m == 0) ? fr : fr - 12;
                            bf16_t* hp = HALO + ((size_t)(span * 4 + slot)) * 11264 + 256 * u.pn + cwp + 4 * n;
                            u32x2 rg, ru; rg.x = cvt_pk_bf16(cg[0], cg[1]); rg.y = cvt_pk_bf16(cg[2], cg[3]); ru.x = cvt_pk_bf16(cu[0], cu[1]); ru.y = cvt_pk_bf16(cu[2], cu[3]);
                            *(u32x2*)(hp) = rg; *(u32x2*)(hp + HALF) = ru; }
                    }
                }
            }
        } else {
            const int colg = (u.pn - 44) * 256 + cwp;
            f32x4 bv[2][2];
#pragma unroll
            for (int bj = 0; bj < 2; ++bj)
#pragma unroll
                for (int n = 0; n < 2; ++n) bv[bj][n] = *(const f32x4*)(bgate + colg + bj * HALF + 4 * n);
#pragma unroll
            for (int ai = 0; ai < 2; ++ai)
#pragma unroll
                for (int m = 0; m < 4; ++m) { bf16_t* rowp = SG + (size_t)(row0 + ai * HALF + m * 16) * 2048 + colg;
#pragma unroll
                    for (int bj = 0; bj < 2; ++bj) { f32x4 v0 = acc[ai][bj][m][0] + bv[bj][0], v1 = acc[ai][bj][m][1] + bv[bj][1];
#pragma unroll
                        for (int j = 0; j < 4; ++j) { v0[j] = sigmoidf_(v0[j]); v1[j] = sigmoidf_(v1[j]); }
                        *(u32x4*)(rowp + bj * HALF) = pack8(v0, v1); } }
        }
    }
};
struct EpiPle {
    static constexpr bool PERM = false, AFTER_DRAIN = false;
    const bf16_t* SG; float* Y;
    __device__ __forceinline__ void operator()(const f32x4 (&acc)[2][2][4][2], const Unit& u, int wr, int wc, int fr, int fq) const {
        const int row0 = u.pm * BM + wr * 64 + fr, col0 = u.pn * BM + wc * 32 + 4 * fq;
#pragma unroll
        for (int ai = 0; ai < 2; ++ai)
#pragma unroll
            for (int m = 0; m < 4; ++m) { const size_t off = (size_t)(row0 + ai * HALF + m * 16) * 2048 + col0;
#pragma unroll
                for (int bj = 0; bj < 2; ++bj)
#pragma unroll
                    for (int n = 0; n < 2; ++n) { const size_t o = off + bj * HALF + n * 16; const u32x2 sg = *(const u32x2*)(SG + o);
                        f32x4 g; g[0] = __uint_as_float(sg.x << 16); g[1] = __uint_as_float(sg.x & 0xffff0000u); g[2] = __uint_as_float(sg.y << 16); g[3] = __uint_as_float(sg.y & 0xffff0000u);
                        *(f32x4*)(Y + o) = acc[ai][bj][m][n] * g; } }
    }
};
template <class Epi, class Sched, bool ALIGN_EPI = false, bool SP2 = false>
__device__ __forceinline__ void gemm_phase(PG8_LAS unsigned char* lds, const Gemm g, const Sched& S, const Epi& E, const int wid_in) {
    int lane_; asm volatile("v_mbcnt_lo_u32_b32 %0, -1, 0\n\tv_mbcnt_hi_u32_b32 %0, -1, %0" : "=v"(lane_)); const int wid = wid_in, lane = lane_, tid = wid * 64 + lane, wr = wid >> 2, wc = wid & 3, fr = lane & 15, fq = lane >> 4;
    const int K = g.K, nt = K / BK;
    unsigned voffA[2], voffB[2];
#pragma unroll
    for (int i = 0; i < 2; ++i) { int R, C; stage_rc(tid * 16 + i * 8192, R, C); const int Rb = Epi::PERM ? ((R & ~31) + perm32(R & 31)) : R;
        voffA[i] = (unsigned)(R * K + C) * 2u; voffB[i] = (unsigned)(Rb * K + C) * 2u; }
    const size_t kstep = (size_t)(BK * 2);
    const size_t hstep = (size_t)HALF * K * 2;
    const size_t tstep = 2 * hstep;
    const unsigned ldsw = (unsigned)wid * 1024u;
    const int aoff = lds_byte(wr * 64 + fr, fq * 8), boff = lds_byte(wc * 32 + fr, fq * 8);
#define PG8_SA(b, h) (((b) * 2 + (h)) * HTB)
#define PG8_SB(b, h) ((4 + (b) * 2 + (h)) * HTB)
#define PG8_STAGE(bufoff, gbase, voff) do { _Pragma("unroll") for (int _i = 0; _i < 2; ++_i) \
        __builtin_amdgcn_global_load_lds((const unsigned*)((const char*)(gbase) + (voff)[_i]), (PG8_LAS unsigned*)(lds + (bufoff) + ldsw + _i * 8192), 16, 0, 0); } while (0)
#define PG8_LDA(dst, b, h) do { _Pragma("unroll") for (int m = 0; m < 4; ++m) _Pragma("unroll") for (int k = 0; k < 2; ++k) dst[m][k] = *(const PG8_LAS bf16x8*)(lds + PG8_SA(b, h) + aoff + m * 2048 + k * 1024); } while (0)
#define PG8_LDB(dst, b, h) do { _Pragma("unroll") for (int n = 0; n < 2; ++n) _Pragma("unroll") for (int k = 0; k < 2; ++k) dst[n][k] = *(const PG8_LAS bf16x8*)(lds + PG8_SB(b, h) + boff + n * 2048 + k * 1024); } while (0)
#define PG8_MMA(ai, bj, At, Bt) do { __builtin_amdgcn_s_setprio(1); _Pragma("unroll") for (int m = 0; m < 4; ++m) _Pragma("unroll") for (int n = 0; n < 2; ++n) _Pragma("unroll") for (int k = 0; k < 2; ++k) \
        acc[ai][bj][m][n] = __builtin_amdgcn_mfma_f32_16x16x32_bf16(Bt[n][k], At[m][k], acc[ai][bj][m][n], 0, 0, 0); __builtin_amdgcn_s_setprio(0); } while (0)
#define PG8_WAIT_V(n) asm volatile("s_waitcnt vmcnt(" #n ")" ::: "memory")
#define PG8_WAIT_L(n) asm volatile("s_waitcnt lgkmcnt(" #n ")" ::: "memory")
#define PG8_BAR __builtin_amdgcn_s_barrier()
#define PG8_SCHED __builtin_amdgcn_sched_barrier(0)
    Unit cur, nxt; int ui = 0;
    if (!S.next(0, cur)) return;
    f32x4 acc[2][2][4][2];
#pragma unroll
    for (int a = 0; a < 2; ++a)
#pragma unroll
        for (int b = 0; b < 2; ++b)
#pragma unroll
            for (int m = 0; m < 4; ++m)
#pragma unroll
                for (int n = 0; n < 2; ++n) acc[a][b][m][n] = (f32x4){0.f, 0.f, 0.f, 0.f};
    bf16x8 At[4][2], B0[2][2], B1[2][2];
    const char* cA = (const char*)g.A + (size_t)cur.pm * tstep; const char* cB = (const char*)g.Bt + (size_t)cur.pn * tstep;
    S.a_ready(cur);
    if constexpr (SP2) {
        PG8_STAGE(PG8_SB(0, 0), cB, voffB); PG8_STAGE(PG8_SB(0, 1), cB + hstep, voffB); PG8_STAGE(PG8_SA(0, 0), cA, voffA); PG8_STAGE(PG8_SA(0, 1), cA + hstep, voffA);
        if (wr == 1) PG8_BAR;
        PG8_WAIT_V(2); PG8_BAR;
        PG8_STAGE(PG8_SB(1, 0), cB + kstep, voffB); PG8_STAGE(PG8_SA(1, 0), cA + kstep, voffA); PG8_STAGE(PG8_SB(1, 1), cB + hstep + kstep, voffB);
        PG8_WAIT_V(6); PG8_BAR;
    } else {
        PG8_STAGE(PG8_SB(0, 0), cB, voffB); PG8_STAGE(PG8_SA(0, 0), cA, voffA); PG8_STAGE(PG8_SB(0, 1), cB + hstep, voffB); PG8_STAGE(PG8_SA(0, 1), cA + hstep, voffA);
        if (wr == 1) PG8_BAR;
        PG8_WAIT_V(4); PG8_BAR;
        PG8_STAGE(PG8_SB(1, 0), cB + kstep, voffB); PG8_STAGE(PG8_SA(1, 0), cA + kstep, voffA); PG8_STAGE(PG8_SB(1, 1), cB + hstep + kstep, voffB);
        PG8_WAIT_V(6); PG8_BAR;
    }
    for (;;) {
        const bool has_next = S.next(ui + 1, nxt);
        const char* nA = has_next ? (const char*)g.A + (size_t)nxt.pm * tstep : cA; const char* nB = has_next ? (const char*)g.Bt + (size_t)nxt.pn * tstep : cB;
        for (int t = 0; t < nt; t += 2) {
            const bool last = (t == nt - 2);
            const char* a1 = cA + (size_t)(t + 1) * kstep;
            const char* a2 = last ? nA : cA + (size_t)(t + 2) * kstep; const char* b2 = last ? nB : cB + (size_t)(t + 2) * kstep;
            const char* a3 = a2 + kstep; const char* b3 = b2 + kstep;
            if (last && has_next) S.a_ready(nxt);
            if constexpr (SP2) {
            PG8_LDB(B0, 0, 0); PG8_LDB(B1, 0, 1); PG8_SCHED; PG8_LDA(At, 0, 0); PG8_STAGE(PG8_SA(1, 1), a1 + hstep, voffA);
            PG8_WAIT_V(8); PG8_WAIT_L(0); PG8_BAR; PG8_MMA(0, 0, At, B0); PG8_MMA(0, 1, At, B1); PG8_BAR; PG8_SCHED;
            PG8_LDA(At, 0, 1); PG8_STAGE(PG8_SB(0, 0), b2, voffB); PG8_STAGE(PG8_SB(0, 1), b2 + hstep, voffB); PG8_STAGE(PG8_SA(0, 0), a2, voffA);
            PG8_WAIT_V(8); PG8_WAIT_L(0); PG8_BAR; PG8_MMA(1, 0, At, B0); PG8_MMA(1, 1, At, B1); PG8_BAR; PG8_SCHED;
            PG8_LDB(B0, 1, 0); PG8_LDB(B1, 1, 1); PG8_SCHED; PG8_LDA(At, 1, 0); PG8_STAGE(PG8_SA(0, 1), a2 + hstep, voffA);
            PG8_WAIT_V(8); PG8_WAIT_L(0); PG8_BAR; PG8_MMA(0, 0, At, B0); PG8_MMA(0, 1, At, B1); PG8_BAR; PG8_SCHED;
            PG8_LDA(At, 1, 1); PG8_STAGE(PG8_SB(1, 0), b3, voffB); PG8_STAGE(PG8_SB(1, 1), b3 + hstep, voffB); PG8_STAGE(PG8_SA(1, 0), a3, voffA);
            PG8_WAIT_V(8); PG8_WAIT_L(0); PG8_BAR; PG8_MMA(1, 0, At, B0); PG8_MMA(1, 1, At, B1); PG8_BAR; PG8_SCHED;
            } else {
            PG8_LDB(B0, 0, 0); PG8_SCHED; PG8_LDA(At, 0, 0); PG8_STAGE(PG8_SA(1, 1), a1 + hstep, voffA);
            PG8_WAIT_L(8); PG8_BAR; PG8_WAIT_L(0); PG8_MMA(0, 0, At, B0); PG8_BAR; PG8_SCHED;
            PG8_LDB(B1, 0, 1); PG8_STAGE(PG8_SB(0, 0), b2, voffB);
            PG8_BAR; PG8_WAIT_L(0); PG8_MMA(0, 1, At, B1); PG8_BAR;
            PG8_LDA(At, 0, 1); PG8_STAGE(PG8_SA(0, 0), a2, voffA);
            PG8_BAR; PG8_WAIT_L(0); PG8_MMA(1, 0, At, B0); PG8_BAR; PG8_SCHED;
            PG8_STAGE(PG8_SB(0, 1), b2 + hstep, voffB);
            PG8_WAIT_V(6); PG8_BAR; PG8_MMA(1, 1, At, B1); PG8_BAR;
            PG8_LDB(B0, 1, 0); PG8_SCHED; PG8_LDA(At, 1, 0); PG8_STAGE(PG8_SA(0, 1), a2 + hstep, voffA);
            PG8_WAIT_L(8); PG8_BAR; PG8_WAIT_L(0); PG8_MMA(0, 0, At, B0); PG8_BAR; PG8_SCHED;
            PG8_LDB(B1, 1, 1); PG8_STAGE(PG8_SB(1, 0), b3, voffB);
            PG8_BAR; PG8_WAIT_L(0); PG8_MMA(0, 1, At, B1); PG8_BAR;
            PG8_LDA(At, 1, 1); PG8_STAGE(PG8_SA(1, 0), a3, voffA);
            PG8_BAR; PG8_WAIT_L(0); PG8_MMA(1, 0, At, B0); PG8_BAR; PG8_SCHED;
            PG8_STAGE(PG8_SB(1, 1), b3 + hstep, voffB);
            PG8_WAIT_V(6); PG8_BAR; PG8_MMA(1, 1, At, B1); PG8_BAR;
            }
        }
        if constexpr (ALIGN_EPI) { if (wr == 0) PG8_BAR; }
        if constexpr (!Epi::AFTER_DRAIN) { E(acc, cur, wr, wc, fr, fq); S.done(cur); }
        if (!has_next) break;
#pragma unroll
        for (int a = 0; a < 2; ++a)
#pragma unroll
            for (int b = 0; b < 2; ++b)
#pragma unroll
                for (int m = 0; m < 4; ++m)
#pragma unroll
                    for (int n = 0; n < 2; ++n) acc[a][b][m][n] = (f32x4){0.f, 0.f, 0.f, 0.f};
        cur = nxt; cA = nA; cB = nB; ++ui;
        if constexpr (ALIGN_EPI) { if (wr == 1) PG8_BAR; }
    }
    PG8_WAIT_V(0);
    if constexpr (!ALIGN_EPI) { if (wr == 0) PG8_BAR; }
    PG8_BAR;
    if constexpr (Epi::AFTER_DRAIN) { E.fused(acc, cur, wr, wc, fr, fq, lds, wid, lane); S.done(cur); }
#undef PG8_SA
#undef PG8_SB
#undef PG8_STAGE
#undef PG8_LDA
#undef PG8_LDB
#undef PG8_MMA
#undef PG8_WAIT_V
#undef PG8_WAIT_L
#undef PG8_BAR
#undef PG8_SCHED
}
}
#define LAS __attribute__((address_space(3)))
#define XB_TMO      128
#define XB_XCNT(j)  (256  + 64 * (j))
#define XB_XSUB(j)  (1280 + 64 * (j))
#define XB_XGEN(j)  (2304 + 64 * (j))
#define XB_TOP      3328
#define XB_TOPGEN   3392
#define XCD_BAR_WORDS 3456
#define XB_SPIN_CAP (1u << 18)

__device__ __forceinline__ unsigned xb_ld(unsigned* p)              { return __hip_atomic_load(p, __ATOMIC_RELAXED, __HIP_MEMORY_SCOPE_AGENT); }
__device__ __forceinline__ unsigned xb_add(unsigned* p, unsigned v) { return __hip_atomic_fetch_add(p, v, __ATOMIC_RELAXED, __HIP_MEMORY_SCOPE_AGENT); }
__device__ __forceinline__ unsigned xb_xcc_id() { return (unsigned)__builtin_amdgcn_s_getreg((3 << 11) | 20) & 0xFu; }
#define XB_SPIN(cond, bar) do { unsigned _sp = 0; while (cond) { __builtin_amdgcn_s_sleep(1); \
    if ((++_sp & 255u) == 0u) { if (xb_ld(&(bar)[XB_TMO])) break; if (_sp > XB_SPIN_CAP) { atomicAdd(&(bar)[XB_TMO], 1u); break; } } } } while (0)

struct XcdBarrier {
    unsigned* bar; unsigned x;
    volatile LAS unsigned* st;
};

__device__ __forceinline__ XcdBarrier xcd_barrier_post(unsigned* bar, volatile LAS unsigned* st) {
    XcdBarrier b; b.bar = bar; b.x = xb_xcc_id(); b.st = st;
    if (threadIdx.x == 0) (void)xb_add(&bar[XB_XCNT(b.x)], 1u);
    return b;
}
__device__ __forceinline__ void xcd_barrier_complete(unsigned* bar, unsigned x, unsigned& nloc, unsigned& nx) {
    const unsigned G = gridDim.x * gridDim.y * gridDim.z;
    unsigned sum, cnt, mine, sp = 0u;
    for (;;) {
        sum = 0u; cnt = 0u; mine = 0u;
#pragma unroll
        for (unsigned j = 0; j < 16; ++j) { const unsigned c = xb_ld(&bar[XB_XCNT(j)]); sum += c; cnt += (c > 0u) ? 1u : 0u; mine = (j == x) ? c : mine; }
        if (sum == G) break;
        __builtin_amdgcn_s_sleep(1);
        if ((++sp & 255u) == 0u) { if (xb_ld(&bar[XB_TMO])) break; if (sp > XB_SPIN_CAP) { atomicAdd(&bar[XB_TMO], 1u); break; } }
    }
    nloc = mine > 0u ? mine : 1u; nx = cnt > 0u ? cnt : 1u;
}

__device__ __forceinline__ void xcd_barrier(const XcdBarrier& b) {
    asm volatile("s_waitcnt vmcnt(0)" ::: "memory");
    __syncthreads();
    if (threadIdx.x == 0) {
        unsigned* bar = b.bar;
        __builtin_amdgcn_s_waitcnt(0);
        unsigned nloc = b.st[0], nx = b.st[1];
        if (nloc == 0u) { xcd_barrier_complete(bar, b.x, nloc, nx); b.st[0] = nloc; b.st[1] = nx; }
        const unsigned old = xb_add(&bar[XB_XSUB(b.x)], 1u);
        const unsigned gen = old / nloc;
        if (old + 1u == (gen + 1u) * nloc) {
            __builtin_amdgcn_fence(__ATOMIC_RELEASE, "agent");
            asm volatile("s_waitcnt vmcnt(0)" ::: "memory");
            const unsigned og = xb_add(&bar[XB_TOP], 1u);
            const unsigned tg = og / nx;
            if (og + 1u == (tg + 1u) * nx) xb_add(&bar[XB_TOPGEN], 1u);
            else XB_SPIN(xb_ld(&bar[XB_TOPGEN]) == tg, bar);
            __builtin_amdgcn_fence(__ATOMIC_ACQUIRE, "agent");
            xb_add(&bar[XB_XGEN(b.x)], 1u);
            asm volatile("s_waitcnt vmcnt(0)" ::: "memory");
        } else {
            XB_SPIN(xb_ld(&bar[XB_XGEN(b.x)]) == gen, bar);
            __builtin_amdgcn_fence(__ATOMIC_ACQUIRE, "agent");
            asm volatile("s_waitcnt vmcnt(0)" ::: "memory");
        }
    }
    __syncthreads();
}
#define GAS __attribute__((address_space(1)))

typedef unsigned short bf16;
typedef float f32x4 __attribute__((ext_vector_type(4)));
typedef unsigned v4u __attribute__((ext_vector_type(4)));
typedef unsigned v2u __attribute__((ext_vector_type(2)));
#define LDS_WAIT() asm volatile("s_waitcnt lgkmcnt(0)" ::: "memory")

#ifndef MK_ONE_LAUNCH
#define MK_ONE_LAUNCH 0
#endif
#ifndef RET_MFMA
#define RET_MFMA 1
#endif
#ifndef SWA_MFMA
#define SWA_MFMA 1
#endif
#ifndef PROBE_DUP
#define PROBE_DUP 0
#endif
#ifndef CONV_FUSED
#define CONV_FUSED 1
#endif
#define REPS(k) int nrep_ = (PROBE_DUP == (k)) ? 2 : 1; asm volatile("" : "+s"(nrep_)); for (int rep_ = 0; rep_ < nrep_; ++rep_)

constexpr int S = 16384, D = 2048, INW = 5376, DFF = 5632, NUP = 2 * DFF, NUPG = NUP + D, PLE = 256, DEPTH = 4;
constexpr float ALPHA = 1.6817928305074290f, LN_EPS = 1e-5f, GN_EPS = 1e-6f;
constexpr int NPH = 11, NPHASES = 1 + DEPTH * NPH;

constexpr size_t MiB = 1u << 20;
constexpr size_t WS_CTL = 0, CTL_ZERO_BYTES = 1 * MiB;
constexpr size_t WS_COSR = 2 * MiB, WS_SINR = 10 * MiB, WS_COSA = 18 * MiB, WS_SINA = 20 * MiB;
constexpr size_t WS_W = 32 * MiB, WL_BYTES = 104 * MiB;
constexpr size_t WL_IN = 0, WL_OUT = 21 * MiB, WL_UP = 29 * MiB, WL_G = 73 * MiB, WL_DOWN = 81 * MiB, WL_P = 103 * MiB;
constexpr size_t WS_XR = 448 * MiB, WS_XB = 576 * MiB, WS_Y = 640 * MiB;
constexpr size_t WS_Q = 768 * MiB, WS_K = 800 * MiB, WS_V = 832 * MiB, WS_G = 864 * MiB, WS_AQ = 896 * MiB, WS_AK = 928 * MiB, WS_AV = 932 * MiB;
constexpr size_t WS_MIX = 936 * MiB, WS_U = 1000 * MiB, WS_PS = 1128 * MiB, WS_RETY = 1160 * MiB;
constexpr size_t WS_H = 768 * MiB, WS_ACT = 1128 * MiB, WS_SG = 1304 * MiB, WS_PB = 1368 * MiB, WS_END = 1400 * MiB;
constexpr int CW_BAR = 4096;

constexpr int RING_BYTES = 131072, LDS_BYTES = 147456, LDSCTL_OFF = LDS_BYTES - 1024, MISC_OFF = LDSCTL_OFF + 320;

__device__ __forceinline__ unsigned f2bf(float f) { unsigned u = __builtin_bit_cast(unsigned, f); return (u + 0x7fffu + ((u >> 16) & 1u)) >> 16; }
__device__ __forceinline__ unsigned pk2(float lo, float hi) { return f2bf(lo) | (f2bf(hi) << 16); }
__device__ __forceinline__ float bflo(unsigned w) { return __uint_as_float(w << 16); }
__device__ __forceinline__ float bfhi(unsigned w) { return __uint_as_float(w & 0xffff0000u); }
__device__ __forceinline__ float bf1(const bf16* p) { return __uint_as_float(((unsigned)*p) << 16); }

struct Params {
    const float* in[19]; float* out; unsigned char* ws; int ph_lo, ph_hi;
    float invf_ret[128]; float invf_att[32]; float lg2g[4];
};

struct Ctx { int tid, lane, wave, G, bid; unsigned char* ws; };

__device__ __forceinline__ int lane_id_asm() { int l; asm volatile("v_mbcnt_lo_u32_b32 %0, -1, 0\n\tv_mbcnt_hi_u32_b32 %0, -1, %0" : "=v"(l)); return l; }
__device__ __forceinline__ float wave_sum(float v, int lane) {
#pragma unroll
    for (int o = 1; o < 64; o <<= 1) v += __builtin_bit_cast(float, __builtin_amdgcn_ds_bpermute((lane ^ o) << 2, __builtin_bit_cast(int, v)));
    return v;
}
__device__ __forceinline__ void transpose_item(const float* W, int K, int N, int src_col0, bf16* WT, int dst_row0, int k0, LAS float* scr, int lane) {
#pragma unroll 8
    for (int i = 0; i < 32; ++i) { const int kk = 2 * i + (lane >> 5); scr[kk * 33 + (lane & 31)] = W[(size_t)(k0 + kk) * N + src_col0 + (lane & 31)]; }
    LDS_WAIT(); asm volatile("" ::: "memory");
    const int c = lane & 7;
#pragma unroll
    for (int j = 0; j < 4; ++j) { const int n = (lane >> 3) + 8 * j; const LAS float* s = scr + (8 * c) * 33 + n;
        v4u o; o.x = pk2(s[0 * 33], s[1 * 33]); o.y = pk2(s[2 * 33], s[3 * 33]); o.z = pk2(s[4 * 33], s[5 * 33]); o.w = pk2(s[6 * 33], s[7 * 33]);
        *(v4u*)(WT + (size_t)(dst_row0 + n) * K + k0 + 8 * c) = o; }
    LDS_WAIT(); asm volatile("" ::: "memory");
}
__device__ __forceinline__ int win_src_col(int g) {
    const int tile = g >> 3, bj = (g >> 2) & 1, wcg = g & 3;
    if (tile < 16) return 32 * g;
    if (tile < 20) return 4096 + 256 * (tile - 16) + 64 * wcg + 32 * bj;
    return wcg < 2 ? 5120 + 64 * wcg + 32 * bj : 5248 + 32 * (wcg - 2) + 64 * bj;
}
__device__ __forceinline__ int wup_src_col(int g) { const int tile = g >> 3, bj = (g >> 2) & 1, wcg = g & 3; return (bj ? DFF : 0) + 128 * tile + 32 * wcg; }

__device__ __forceinline__ void sincos_d(float angf, float& s, float& c) {
    const double a = (double)angf;
    const double k = __builtin_rint(a * 0.63661977236758134308);
    double r = __builtin_fma(-k, 1.57079632679489661923, a); r = __builtin_fma(-k, 6.123233995736766e-17, r);
    const double r2 = r * r;
    const double sp = r + r * r2 * (-1.0 / 6 + r2 * (1.0 / 120 + r2 * (-1.0 / 5040 + r2 * (1.0 / 362880 + r2 * (-1.0 / 39916800)))));
    const double cp = 1.0 + r2 * (-0.5 + r2 * (1.0 / 24 + r2 * (-1.0 / 720 + r2 * (1.0 / 40320 + r2 * (-1.0 / 3628800 + r2 * (1.0 / 479001600))))));
    const int q = ((int)k) & 3;
    const double sv = (q == 0) ? sp : (q == 1) ? cp : (q == 2) ? -sp : -cp;
    const double cv = (q == 0) ? cp : (q == 1) ? -sp : (q == 2) ? -cp : sp;
    s = (float)sv; c = (float)cv;
}

__device__ __forceinline__ void phase_prologue(const Params& P, const Ctx& cx, LAS unsigned char* lds) {
    unsigned char* ws = cx.ws; const int tid = cx.tid, lane = cx.lane, wave = cx.wave, G = cx.G;
    LAS float* scr = (LAS float*)(lds + wave * 16384);
    const int gw = cx.bid * 8 + wave, NGW = G * 8;
    constexpr int I_IN = 32 * 168, I_OUT = 32 * 64, I_UP = 32 * 352, I_G = 32 * 64, I_DN = 88 * 64, I_P = 4 * 64, I_L = I_IN + I_OUT + I_UP + I_G + I_DN + I_P;
    for (int it = gw; it < DEPTH * I_L; it += NGW) {
        const int l = it / I_L; int r = it - l * I_L;
        bf16* wl = (bf16*)(ws + WS_W + (size_t)l * WL_BYTES);
        if (r < I_IN) { const int kb = r / 168, g = r % 168; transpose_item(P.in[3] + (size_t)l * D * INW, D, INW, win_src_col(g), wl + WL_IN / 2, 32 * g, 64 * kb, scr, lane); continue; } r -= I_IN;
        if (r < I_OUT) { const int kb = r / 64, g = r % 64; transpose_item(P.in[4] + (size_t)l * D * D, D, D, 32 * g, wl + WL_OUT / 2, 32 * g, 64 * kb, scr, lane); continue; } r -= I_OUT;
        if (r < I_UP) { const int kb = r / 352, g = r % 352; transpose_item(P.in[10] + (size_t)l * D * NUP, D, NUP, wup_src_col(g), wl + WL_UP / 2, 32 * g, 64 * kb, scr, lane); continue; } r -= I_UP;
        if (r < I_G) { const int kb = r / 64, g = r % 64; transpose_item(P.in[16] + (size_t)l * D * D, D, D, 32 * g, wl + WL_G / 2, 32 * g, 64 * kb, scr, lane); continue; } r -= I_G;
        if (r < I_DN) { const int kb = r / 64, g = r % 64; transpose_item(P.in[13] + (size_t)l * DFF * D, DFF, D, 32 * g, wl + WL_DOWN / 2, 32 * g, 64 * kb, scr, lane); continue; } r -= I_DN;
        { const int kb = r / 64, g = r % 64; transpose_item(P.in[18] + (size_t)l * PLE * D, PLE, D, 32 * g, wl + WL_P / 2, 32 * g, 64 * kb, scr, lane); }
    }
    const size_t gt = (size_t)cx.bid * 512 + tid, NT = (size_t)G * 512;
    { const float* x = P.in[0]; bf16* xb = (bf16*)(ws + WS_XB);
      for (size_t i = gt; i < (size_t)S * D / 8; i += NT) { const f32x4 a = *(const f32x4*)(x + i * 8), b = *(const f32x4*)(x + i * 8 + 4);
          v4u o; o.x = pk2(a[0], a[1]); o.y = pk2(a[2], a[3]); o.z = pk2(b[0], b[1]); o.w = pk2(b[2], b[3]); *(v4u*)(xb + i * 8) = o; } }
    { const float* p = P.in[1]; bf16* pb = (bf16*)(ws + WS_PB);
      for (size_t i = gt; i < (size_t)DEPTH * S * PLE / 8; i += NT) { const f32x4 a = *(const f32x4*)(p + i * 8), b = *(const f32x4*)(p + i * 8 + 4);
          v4u o; o.x = pk2(a[0], a[1]); o.y = pk2(a[2], a[3]); o.z = pk2(b[0], b[1]); o.w = pk2(b[2], b[3]); *(v4u*)(pb + i * 8) = o; } }
    { const int* pos = (const int*)P.in[2]; float* cosr = (float*)(ws + WS_COSR); float* sinr = (float*)(ws + WS_SINR); float* cosa = (float*)(ws + WS_COSA); float* sina = (float*)(ws + WS_SINA);
      for (size_t i = gt; i < (size_t)S * 128; i += NT) { const int t = (int)(i >> 7), f = (int)(i & 127); float s, c; sincos_d((float)pos[t] * P.invf_ret[f], s, c); cosr[i] = c; sinr[i] = s; }
      for (size_t i = gt; i < (size_t)S * 32; i += NT) { const int t = (int)(i >> 5), f = (int)(i & 31); float s, c; sincos_d((float)pos[t] * P.invf_att[f], s, c); cosa[i] = c; sina[i] = s; } }
}

template <int MT, int NT_, int KK, bool A_KFAST, bool B_NFAST, class FA, class FB, class FC>
__device__ __forceinline__ void simple_gemm(LAS unsigned char* lds, int nbatch, int tid, int G, int bid, const FA& fa, const FB& fb, const FC& fc) {
    LAS float* As = (LAS float*)lds;
    LAS float* Bs = (LAS float*)(lds + 16 * 132 * 4);
    constexpr int TM = MT / 128, TN = NT_ / 64, ITEMS_PER_B = TM * TN;
    const int tm = tid & 31, tn = tid >> 5;
    for (int item = bid; item < nbatch * ITEMS_PER_B; item += G) {
        const int b = item / ITEMS_PER_B, r = item % ITEMS_PER_B, m0 = (r / TN) * 128, n0 = (r % TN) * 64;
        float c[4][4];
#pragma unroll
        for (int i = 0; i < 4; ++i)
#pragma unroll
            for (int j = 0; j < 4; ++j) c[i][j] = 0.f;
        for (int k0 = 0; k0 < KK; k0 += 16) {
#pragma unroll
            for (int rr = 0; rr < 4; ++rr) { const int e = tid + 512 * rr; int m, k; if (A_KFAST) { k = e & 15; m = e >> 4; } else { m = e & 127; k = e >> 7; }
                As[k * 132 + m] = fa(b, m0 + m, k0 + k); }
#pragma unroll
            for (int rr = 0; rr < 2; ++rr) { const int e = tid + 512 * rr; int n, k; if (B_NFAST) { n = e & 63; k = e >> 6; } else { k = e & 15; n = e >> 4; }
                Bs[k * 68 + n] = fb(b, k0 + k, n0 + n); }
            __syncthreads();
#pragma unroll
            for (int kk = 0; kk < 16; ++kk) { const f32x4 a = *(const LAS f32x4*)(As + kk * 132 + 4 * tm), bb = *(const LAS f32x4*)(Bs + kk * 68 + 4 * tn);
#pragma unroll
                for (int i = 0; i < 4; ++i)
#pragma unroll
                    for (int j = 0; j < 4; ++j) c[i][j] += a[i] * bb[j]; }
            __syncthreads();
        }
#pragma unroll
        for (int i = 0; i < 4; ++i)
#pragma unroll
            for (int j = 0; j < 4; ++j) fc(b, m0 + 4 * tm + i, n0 + 4 * tn + j, c[i][j]);
    }
}

__device__ __forceinline__ void phase_swa(const Params& P, const Ctx& cx, int l, LAS unsigned char* lds) {
    unsigned char* ws = cx.ws; const int tid = cx.tid, G = cx.G;
    const bf16* AQ = (const bf16*)(ws + WS_AQ); const bf16* AK = (const bf16*)(ws + WS_AK); const bf16* AV = (const bf16*)(ws + WS_AV); bf16* MIX = (bf16*)(ws + WS_MIX);
    const float* sinks = P.in[7] + l * 16;
    LAS unsigned* Ks = (LAS unsigned*)lds;
    LAS unsigned* Vs = (LAS unsigned*)(lds + 256 * 33 * 4);
    for (int item = cx.bid; item < 256; item += G) {
        const int nb = item >> 1, hk = item & 1;
        __syncthreads();
        for (int e = tid; e < 256 * 32; e += 512) { const int r = e >> 5, cdw = e & 31; const int gk = nb * 128 - 128 + r;
            unsigned kv = 0u, vv = 0u; if (gk >= 0) { kv = *(const unsigned*)(AK + (size_t)gk * 128 + hk * 64 + 2 * cdw); vv = *(const unsigned*)(AV + (size_t)gk * 128 + hk * 64 + 2 * cdw); }
            Ks[r * 33 + cdw] = kv; Vs[r * 33 + cdw] = vv; }
        __syncthreads();
#pragma unroll 1
        for (int rep = 0; rep < 2; ++rep) {
            const int pair = tid + 512 * rep, i = pair & 127, g = pair >> 7, hq = hk * 8 + g; const int row = nb * 128 + i;
            float q[64], o[64];
            { const v4u* qp = (const v4u*)(AQ + (size_t)row * 1024 + hq * 64);
#pragma unroll
              for (int c8 = 0; c8 < 8; ++c8) { const v4u w = qp[c8]; q[8 * c8 + 0] = bflo(w.x); q[8 * c8 + 1] = bfhi(w.x); q[8 * c8 + 2] = bflo(w.y); q[8 * c8 + 3] = bfhi(w.y); q[8 * c8 + 4] = bflo(w.z); q[8 * c8 + 5] = bfhi(w.z); q[8 * c8 + 6] = bflo(w.w); q[8 * c8 + 7] = bfhi(w.w); } }
#pragma unroll
            for (int d = 0; d < 64; ++d) o[d] = 0.f;
            float mx = sinks[hq], den = 1.0f;
            const int jj0 = (nb == 0) ? (127 - i) : 0;
            for (int jj = jj0; jj < 128; ++jj) { const int kl = i + 1 + jj;
                float s = 0.f;
#pragma unroll
                for (int c = 0; c < 32; ++c) { const unsigned w = Ks[kl * 33 + c]; s += q[2 * c] * bflo(w) + q[2 * c + 1] * bfhi(w); }
                const float mn = fmaxf(mx, s), sc = __expf(mx - mn), p = __expf(s - mn);
                den = den * sc + p; mx = mn;
#pragma unroll
                for (int c = 0; c < 32; ++c) { const unsigned w = Vs[kl * 33 + c]; o[2 * c] = o[2 * c] * sc + p * bflo(w); o[2 * c + 1] = o[2 * c + 1] * sc + p * bfhi(w); }
            }
            const float inv = 1.0f / den;
            v4u* op = (v4u*)(MIX + (size_t)row * 2048 + 1024 + hq * 64);
#pragma unroll
            for (int c8 = 0; c8 < 8; ++c8) { v4u w; w.x = pk2(o[8 * c8] * inv, o[8 * c8 + 1] * inv); w.y = pk2(o[8 * c8 + 2] * inv, o[8 * c8 + 3] * inv); w.z = pk2(o[8 * c8 + 4] * inv, o[8 * c8 + 5] * inv); w.w = pk2(o[8 * c8 + 6] * inv, o[8 * c8 + 7] * inv); op[c8] = w; }
        }
    }
}

__device__ __forceinline__ void phase_ret_u_scores(const Params& P, const Ctx& cx, LAS unsigned char* lds) {
    unsigned char* ws = cx.ws; const int tid = cx.tid, G = cx.G;
    const bf16* Q = (const bf16*)(ws + WS_Q); const bf16* K = (const bf16*)(ws + WS_K); const bf16* V = (const bf16*)(ws + WS_V);
    float* U = (float*)(ws + WS_U); float* PS = (float*)(ws + WS_PS);
    const float lg0 = P.lg2g[0], lg1 = P.lg2g[1], lg2 = P.lg2g[2], lg3 = P.lg2g[3];
    auto lgh = [=](int h) { return h == 0 ? lg0 : h == 1 ? lg1 : h == 2 ? lg2 : lg3; };
    simple_gemm<256, 256, 128, false, true>(lds, 512, tid, G, cx.bid,
        [=](int b, int m, int k) { const int nb = b >> 2, h = b & 3; return bf1(K + (size_t)(nb * 128 + k) * 1024 + h * 256 + m) * exp2f(lgh(h) * (float)(127 - k)); },
        [=](int b, int k, int n) { const int nb = b >> 2, h = b & 3; return bf1(V + (size_t)(nb * 128 + k) * 1024 + h * 256 + n); },
        [=](int b, int m, int n, float v) { U[((size_t)b * 256 + m) * 256 + n] = v; });
    simple_gemm<128, 128, 256, true, false>(lds, 512, tid, G, cx.bid,
        [=](int b, int m, int k) { const int nb = b >> 2, h = b & 3; return bf1(Q + (size_t)(nb * 128 + m) * 1024 + h * 256 + k); },
        [=](int b, int k, int n) { const int nb = b >> 2, h = b & 3; return bf1(K + (size_t)(nb * 128 + n) * 1024 + h * 256 + k); },
        [=](int b, int m, int n, float v) { const int h = b & 3; PS[((size_t)b * 128 + m) * 128 + n] = (m >= n) ? v * exp2f(lgh(h) * (float)(m - n)) : 0.f; });
}
__device__ __forceinline__ void phase_scan(const Params& P, const Ctx& cx) {
    float* U = (float*)(cx.ws + WS_U);
    const size_t gt = (size_t)cx.bid * 512 + cx.tid, NT = (size_t)cx.G * 512;
    for (size_t idx = gt; idx < 4 * 65536; idx += NT) {
        const int h = (int)(idx >> 16); const float cd = exp2f(P.lg2g[h] * 128.0f);
        float r = 0.f;
        for (int n0 = 0; n0 < 128; n0 += 8) { float u[8];
#pragma unroll
            for (int j = 0; j < 8; ++j) u[j] = U[(size_t)(n0 + j) * 262144 + idx];
#pragma unroll
            for (int j = 0; j < 8; ++j) { U[(size_t)(n0 + j) * 262144 + idx] = r; r = r * cd + u[j]; } }
    }
}
__device__ __forceinline__ void phase_ret_out(const Params& P, const Ctx& cx, LAS unsigned char* lds) {
    unsigned char* ws = cx.ws; const int tid = cx.tid, G = cx.G;
    const bf16* Q = (const bf16*)(ws + WS_Q); const bf16* V = (const bf16*)(ws + WS_V);
    const float* Sst = (const float*)(ws + WS_U); const float* PS = (const float*)(ws + WS_PS); float* RY = (float*)(ws + WS_RETY);
    const float lg0 = P.lg2g[0], lg1 = P.lg2g[1], lg2 = P.lg2g[2], lg3 = P.lg2g[3];
    auto lgh = [=](int h) { return h == 0 ? lg0 : h == 1 ? lg1 : h == 2 ? lg2 : lg3; };
    simple_gemm<128, 256, 384, true, true>(lds, 512, tid, G, cx.bid,
        [=](int b, int m, int k) { const int nb = b >> 2, h = b & 3; return k < 128 ? PS[((size_t)b * 128 + m) * 128 + k] : bf1(Q + (size_t)(nb * 128 + m) * 1024 + h * 256 + (k - 128)) * exp2f(lgh(h) * (float)(m + 1)); },
        [=](int b, int k, int n) { const int nb = b >> 2, h = b & 3; return k < 128 ? bf1(V + (size_t)(nb * 128 + k) * 1024 + h * 256 + n) : Sst[((size_t)b * 256 + (k - 128)) * 256 + n]; },
        [=](int b, int m, int n, float v) { const int nb = b >> 2, h = b & 3; RY[(size_t)(nb * 128 + m) * 1024 + h * 256 + n] = v; });
}

typedef short bf16x8 __attribute__((ext_vector_type(8)));
typedef short s16x4 __attribute__((ext_vector_type(4)));
typedef short v4i16_t __attribute__((ext_vector_type(4)));
__device__ __forceinline__ f32x4 mfma16(bf16x8 a, bf16x8 b, f32x4 c) { return __builtin_amdgcn_mfma_f32_16x16x32_bf16(a, b, c, 0, 0, 0); }
__device__ __forceinline__ s16x4 lds_tr(LAS unsigned char* p) { return __builtin_bit_cast(s16x4, __builtin_amdgcn_ds_read_tr16_b64_v4i16((LAS v4i16_t*)p)); }
__device__ __forceinline__ bf16x8 cat44(s16x4 a, s16x4 b) { bf16x8 r; r[0] = a[0]; r[1] = a[1]; r[2] = a[2]; r[3] = a[3]; r[4] = b[0]; r[5] = b[1]; r[6] = b[2]; r[7] = b[3]; return r; }
__device__ __forceinline__ unsigned cvt2(float lo, float hi) { return pg8::cvt_pk_bf16(lo, hi); }
__device__ __forceinline__ bf16x8 pack_frag(const f32x4 a, const f32x4 b) { v4u w; w.x = cvt2(a[0], a[1]); w.y = cvt2(a[2], a[3]); w.z = cvt2(b[0], b[1]); w.w = cvt2(b[2], b[3]); return __builtin_bit_cast(bf16x8, w); }
__device__ __forceinline__ float grp16_sum(float v, int lane) {
#pragma unroll
    for (int o = 1; o < 16; o <<= 1) v += __builtin_bit_cast(float, __builtin_amdgcn_ds_bpermute((lane ^ o) << 2, __builtin_bit_cast(int, v)));
    return v;
}
constexpr int RS_T = 544;
constexpr int TILE_T = 128 * RS_T;
static_assert(2 * TILE_T <= LDSCTL_OFF, "retention tiles vs LDS control words");

template <bool DECAY> __device__ __forceinline__ void stage_tile(LAS unsigned char* img, const bf16* src, int tid, float lg) {
    v4u v[8];
#pragma unroll
    for (int r = 0; r < 8; ++r) { const int pc = tid + 512 * r, row = pc >> 5, c16 = pc & 31; v[r] = *(const v4u*)(src + (size_t)row * 1024 + c16 * 8); }
#pragma unroll
    for (int r = 0; r < 8; ++r) { const int pc = tid + 512 * r, row = pc >> 5, c16 = pc & 31; v4u w = v[r];
        if (DECAY) { const float sc = exp2f(lg * (float)(127 - row));
            w.x = cvt2(bflo(w.x) * sc, bfhi(w.x) * sc); w.y = cvt2(bflo(w.y) * sc, bfhi(w.y) * sc); w.z = cvt2(bflo(w.z) * sc, bfhi(w.z) * sc); w.w = cvt2(bflo(w.w) * sc, bfhi(w.w) * sc); }
        *(LAS v4u*)(img + row * RS_T + c16 * 16) = w; }
}

__device__ __forceinline__ void phase_ret_u_mfma(const Params& P, const Ctx& cx, LAS unsigned char* lds) {
    unsigned char* ws = cx.ws; const int tid = cx.tid, lane = cx.lane, w = cx.wave, r16 = lane & 15, g = lane >> 4, q = r16 >> 2, pp = r16 & 3;
    const bf16* K = (const bf16*)(ws + WS_K); const bf16* V = (const bf16*)(ws + WS_V); bf16* UT = (bf16*)(ws + WS_U);
    LAS unsigned char* Kim = lds; LAS unsigned char* Vim = lds + TILE_T;
    for (int b = cx.bid; b < 512; b += cx.G) {
        const int nb = b >> 2, h = b & 3;
        __syncthreads();
        stage_tile<true>(Kim, K + (size_t)nb * 128 * 1024 + h * 256, tid, P.lg2g[h]);
        stage_tile<false>(Vim, V + (size_t)nb * 128 * 1024 + h * 256, tid, 0.f);
        __syncthreads();
        f32x4 acc[2][16];
#pragma unroll
        for (int mi = 0; mi < 2; ++mi)
#pragma unroll
            for (int n = 0; n < 16; ++n) acc[mi][n] = (f32x4){0.f, 0.f, 0.f, 0.f};
#pragma unroll 1
        for (int s = 0; s < 4; ++s) {
            bf16x8 af[2];
#pragma unroll
            for (int mi = 0; mi < 2; ++mi) { LAS unsigned char* a0 = Kim + (32 * s + 8 * g + q) * RS_T + (16 * (2 * w + mi) + 4 * pp) * 2; af[mi] = cat44(lds_tr(a0), lds_tr(a0 + 4 * RS_T)); }
#pragma unroll
            for (int n = 0; n < 16; ++n) { LAS unsigned char* b0 = Vim + (32 * s + 8 * g + q) * RS_T + (16 * n + 4 * pp) * 2; const bf16x8 bfr = cat44(lds_tr(b0), lds_tr(b0 + 4 * RS_T));
                acc[0][n] = mfma16(af[0], bfr, acc[0][n]); acc[1][n] = mfma16(af[1], bfr, acc[1][n]); }
        }
#pragma unroll
        for (int mi = 0; mi < 2; ++mi)
#pragma unroll
            for (int n = 0; n < 16; ++n) { v2u o; o.x = cvt2(acc[mi][n][0], acc[mi][n][1]); o.y = cvt2(acc[mi][n][2], acc[mi][n][3]);
                *(v2u*)(UT + ((size_t)b * 256 + 16 * n + r16) * 256 + 16 * (2 * w + mi) + 4 * g) = o; }
    }
}
__device__ __forceinline__ void phase_scan_bf16(const Params& P, const Ctx& cx) {
    unsigned* UT = (unsigned*)(cx.ws + WS_U);
    const size_t gt = (size_t)cx.bid * 512 + cx.tid, NT = (size_t)cx.G * 512;
    for (size_t idx = gt; idx < 131072; idx += NT) {
        const int h = (int)(idx >> 15); const float cd = exp2f(P.lg2g[h] * 128.0f);
        float r0 = 0.f, r1 = 0.f;
        for (int n0 = 0; n0 < 128; n0 += 8) { unsigned u[8];
#pragma unroll
            for (int j = 0; j < 8; ++j) u[j] = UT[(size_t)(n0 + j) * 131072 + idx];
#pragma unroll
            for (int j = 0; j < 8; ++j) { UT[(size_t)(n0 + j) * 131072 + idx] = cvt2(r0, r1); r0 = r0 * cd + bflo(u[j]); r1 = r1 * cd + bfhi(u[j]); } }
    }
}
__device__ __forceinline__ void phase_ret_out_mfma(const Params& P, const Ctx& cx, int l, LAS unsigned char* lds) {
    unsigned char* ws = cx.ws; const int tid = cx.tid, lane = cx.lane, w = cx.wave, r16 = lane & 15, g = lane >> 4, q = r16 >> 2, pp = r16 & 3;
    const bf16* Q = (const bf16*)(ws + WS_Q); const bf16* K = (const bf16*)(ws + WS_K); const bf16* V = (const bf16*)(ws + WS_V); const bf16* ST = (const bf16*)(ws + WS_U);
    const bf16* Gt = (const bf16*)(ws + WS_G); bf16* MIX = (bf16*)(ws + WS_MIX);
    const float* gg = P.in[5] + l * 1024; const float* gb = P.in[6] + l * 1024;
    LAS unsigned char* Kim = lds; LAS unsigned char* Vim = lds + TILE_T;
    for (int b = cx.bid; b < 512; b += cx.G) {
        const int nb = b >> 2, h = b & 3; const float lg = P.lg2g[h];
        __syncthreads();
        stage_tile<false>(Kim, K + (size_t)nb * 128 * 1024 + h * 256, tid, 0.f);
        stage_tile<false>(Vim, V + (size_t)nb * 128 * 1024 + h * 256, tid, 0.f);
        bf16x8 qf[8];
        { const bf16* qrow = Q + (size_t)(nb * 128 + 16 * w + r16) * 1024 + h * 256 + 8 * g;
#pragma unroll
          for (int s = 0; s < 8; ++s) qf[s] = *(const bf16x8*)(qrow + 32 * s); }
        f32x4 acc[16];
        const bf16* strow = ST + ((size_t)b * 256 + r16) * 256 + 8 * g;
#pragma unroll
        for (int n = 0; n < 16; ++n) { bf16x8 sb[8];
#pragma unroll
            for (int s = 0; s < 8; ++s) sb[s] = *(const bf16x8*)(strow + (size_t)n * 16 * 256 + 32 * s);
            f32x4 a = (f32x4){0.f, 0.f, 0.f, 0.f};
#pragma unroll
            for (int s = 0; s < 8; ++s) a = mfma16(qf[s], sb[s], a);
            acc[n] = a; }
        { float f[4];
#pragma unroll
          for (int r = 0; r < 4; ++r) f[r] = exp2f(lg * (float)(16 * w + 4 * g + r + 1));
#pragma unroll
          for (int n = 0; n < 16; ++n) { acc[n][0] *= f[0]; acc[n][1] *= f[1]; acc[n][2] *= f[2]; acc[n][3] *= f[3]; } }
        __syncthreads();
        f32x4 sc[8];
#pragma unroll
        for (int mb = 0; mb < 8; ++mb) { sc[mb] = (f32x4){0.f, 0.f, 0.f, 0.f};
            if (mb <= w) { f32x4 a = (f32x4){0.f, 0.f, 0.f, 0.f};
#pragma unroll
                for (int s = 0; s < 8; ++s) { const bf16x8 kf = *(const LAS bf16x8*)(Kim + (16 * mb + r16) * RS_T + (32 * s + 8 * g) * 2); a = mfma16(kf, qf[s], a); }
                const int i = 16 * w + r16;
#pragma unroll
                for (int r = 0; r < 4; ++r) { const int j = 16 * mb + 4 * g + r; a[r] = (i >= j) ? a[r] * exp2f(lg * (float)(i - j)) : 0.f; }
                sc[mb] = a; } }
#pragma unroll
        for (int sk = 0; sk < 4; ++sk) {
            if (2 * sk <= w) { const bf16x8 pf = pack_frag(sc[2 * sk], sc[2 * sk + 1]);
#pragma unroll
                for (int n = 0; n < 16; ++n) { LAS unsigned char* b0 = Vim + (32 * sk + 4 * g + q) * RS_T + (16 * n + 4 * pp) * 2; const bf16x8 bfr = cat44(lds_tr(b0), lds_tr(b0 + 16 * RS_T));
                    acc[n] = mfma16(pf, bfr, acc[n]); } } }
        float mean[4], rstd[4];
#pragma unroll
        for (int r = 0; r < 4; ++r) { float sm = 0.f;
#pragma unroll
            for (int n = 0; n < 16; ++n) sm += acc[n][r];
            mean[r] = grp16_sum(sm, lane) * (1.0f / 256.0f); }
#pragma unroll
        for (int r = 0; r < 4; ++r) { float sq = 0.f;
#pragma unroll
            for (int n = 0; n < 16; ++n) { const float d = acc[n][r] - mean[r]; sq += d * d; }
            rstd[r] = 1.0f / sqrtf(grp16_sum(sq, lane) * (1.0f / 256.0f) + GN_EPS); }
#pragma unroll
        for (int n = 0; n < 16; ++n) { const int e = h * 256 + 16 * n + r16; const float g1 = gg[e], b1 = gb[e];
#pragma unroll
            for (int r = 0; r < 4; ++r) { const size_t row = (size_t)(nb * 128 + 16 * w + 4 * g + r);
                const float o = ((acc[n][r] - mean[r]) * rstd[r] * g1 + b1) * bf1(Gt + row * 1024 + e);
                MIX[row * 2048 + e] = (bf16)f2bf(o); } }
    }
}
constexpr int RS_SK = 144, RS_SV = 160;
__device__ __forceinline__ void phase_swa_mfma(const Params& P, const Ctx& cx, int l, LAS unsigned char* lds) {
    unsigned char* ws = cx.ws; const int tid = cx.tid, lane = cx.lane, w = cx.wave, r16 = lane & 15, g = lane >> 4, q = r16 >> 2, pp = r16 & 3;
    const bf16* AQ = (const bf16*)(ws + WS_AQ); const bf16* AK = (const bf16*)(ws + WS_AK); const bf16* AV = (const bf16*)(ws + WS_AV); bf16* MIX = (bf16*)(ws + WS_MIX);
    LAS unsigned char* Kim = lds; LAS unsigned char* Vim = lds + 256 * RS_SK;
    for (int item = cx.bid; item < 256; item += cx.G) {
        const int nb = item >> 1, hk = item & 1, hq = hk * 8 + w; const float sink = P.in[7][l * 16 + hq];
        __syncthreads();
#pragma unroll
        for (int r = 0; r < 4; ++r) { const int pc = tid + 512 * r, row = pc >> 3, c = pc & 7, gk = nb * 128 - 128 + row;
            v4u kv = (v4u){0u, 0u, 0u, 0u}, vv = (v4u){0u, 0u, 0u, 0u};
            if (gk >= 0) { kv = *(const v4u*)(AK + (size_t)gk * 128 + hk * 64 + c * 8); vv = *(const v4u*)(AV + (size_t)gk * 128 + hk * 64 + c * 8); }
            *(LAS v4u*)(Kim + row * RS_SK + c * 16) = kv; *(LAS v4u*)(Vim + row * RS_SV + c * 16) = vv; }
        __syncthreads();
#pragma unroll 1
        for (int nq = 0; nq < 8; ++nq) {
            const bf16* qrow = AQ + (size_t)(nb * 128 + 16 * nq + r16) * 1024 + hq * 64 + 8 * g;
            const bf16x8 qf0 = *(const bf16x8*)(qrow), qf1 = *(const bf16x8*)(qrow + 32);
            f32x4 sc[10];
            float mx = sink;
#pragma unroll
            for (int kb = 0; kb < 9; ++kb) { const LAS unsigned char* kp = Kim + (16 * (nq + kb) + r16) * RS_SK + 16 * g;
                f32x4 a = (f32x4){0.f, 0.f, 0.f, 0.f};
                a = mfma16(*(const LAS bf16x8*)(kp), qf0, a); a = mfma16(*(const LAS bf16x8*)(kp + 64), qf1, a);
#pragma unroll
                for (int r = 0; r < 4; ++r) { const int dl = 16 * kb + 4 * g + r - r16; const bool vis = (dl >= 1) && (dl <= 128) && (nb > 0 || 16 * (nq + kb) + 4 * g + r >= 128);
                    a[r] = vis ? a[r] : -INFINITY; mx = fmaxf(mx, a[r]); }
                sc[kb] = a; }
            sc[9] = (f32x4){0.f, 0.f, 0.f, 0.f};
            mx = fmaxf(mx, __builtin_bit_cast(float, __builtin_amdgcn_ds_bpermute((lane ^ 16) << 2, __builtin_bit_cast(int, mx))));
            mx = fmaxf(mx, __builtin_bit_cast(float, __builtin_amdgcn_ds_bpermute((lane ^ 32) << 2, __builtin_bit_cast(int, mx))));
            float sum = 0.f;
#pragma unroll
            for (int kb = 0; kb < 9; ++kb)
#pragma unroll
                for (int r = 0; r < 4; ++r) { const float pv = __expf(sc[kb][r] - mx); sc[kb][r] = pv; sum += pv; }
            sum += __builtin_bit_cast(float, __builtin_amdgcn_ds_bpermute((lane ^ 16) << 2, __builtin_bit_cast(int, sum)));
            sum += __builtin_bit_cast(float, __builtin_amdgcn_ds_bpermute((lane ^ 32) << 2, __builtin_bit_cast(int, sum)));
            const float inv = 1.0f / (sum + __expf(sink - mx));
            f32x4 o[4];
#pragma unroll
            for (int nd = 0; nd < 4; ++nd) o[nd] = (f32x4){0.f, 0.f, 0.f, 0.f};
#pragma unroll
            for (int sk = 0; sk < 5; ++sk) { const bf16x8 pf = pack_frag(sc[2 * sk] * inv, sc[2 * sk + 1] * inv);
                const int kb0 = nq + 2 * sk, kb1 = (kb0 + 1 > 15) ? 15 : kb0 + 1;
#pragma unroll
                for (int nd = 0; nd < 4; ++nd) { const bf16x8 bfr = cat44(lds_tr(Vim + (16 * kb0 + 4 * g + q) * RS_SV + (16 * nd + 4 * pp) * 2), lds_tr(Vim + (16 * kb1 + 4 * g + q) * RS_SV + (16 * nd + 4 * pp) * 2));
                    o[nd] = mfma16(pf, bfr, o[nd]); } }
#pragma unroll
            for (int nd = 0; nd < 4; ++nd)
#pragma unroll
                for (int r = 0; r < 4; ++r) MIX[(size_t)(nb * 128 + 16 * nq + 4 * g + r) * 2048 + 1024 + hq * 64 + 16 * nd + r16] = (bf16)f2bf(o[nd][r]);
        }
    }
}

__device__ __forceinline__ void phase_groupnorm(const Params& P, const Ctx& cx, int l) {
    unsigned char* ws = cx.ws; const int lane = cx.lane, wave = cx.wave, G = cx.G;
    const float* RY = (const float*)(ws + WS_RETY); const bf16* Gt = (const bf16*)(ws + WS_G); bf16* MIX = (bf16*)(ws + WS_MIX);
    const float* gg = P.in[5] + l * 1024; const float* gb = P.in[6] + l * 1024;
    const int gw = cx.bid * 8 + wave, NGW = G * 8;
    for (int it = gw; it < S * 4; it += NGW) { const int row = it >> 2, h = it & 3; const size_t off = (size_t)row * 1024 + h * 256 + 4 * lane;
        f32x4 v = *(const f32x4*)(RY + off);
        const float mean = wave_sum((v[0] + v[1]) + (v[2] + v[3]), lane) * (1.0f / 256.0f);
        v = v - mean;
        const float var = wave_sum((v[0] * v[0] + v[1] * v[1]) + (v[2] * v[2] + v[3] * v[3]), lane) * (1.0f / 256.0f);
        const float rstd = 1.0f / sqrtf(var + GN_EPS);
        const f32x4 g4 = *(const f32x4*)(gg + h * 256 + 4 * lane), b4 = *(const f32x4*)(gb + h * 256 + 4 * lane);
        const v2u gt2 = *(const v2u*)(Gt + off);
        f32x4 o = v * rstd * g4 + b4;
        o[0] *= bflo(gt2.x); o[1] *= bfhi(gt2.x); o[2] *= bflo(gt2.y); o[3] *= bfhi(gt2.y);
        v2u w; w.x = pk2(o[0], o[1]); w.y = pk2(o[2], o[3]);
        *(v2u*)(MIX + (size_t)row * 2048 + h * 256 + 4 * lane) = w; }
}
__device__ __forceinline__ void phase_ln(const Ctx& cx, const float* Y, const float* g, const float* b, float* xo, bf16* xb) {
    const int lane = cx.lane, wave = cx.wave, G = cx.G; const int gw = cx.bid * 8 + wave, NGW = G * 8;
    f32x4 g4[8], b4[8];
#pragma unroll
    for (int j = 0; j < 8; ++j) { g4[j] = ((const f32x4*)g)[64 * j + lane]; b4[j] = ((const f32x4*)b)[64 * j + lane]; }
    for (int row = gw; row < S; row += 2 * NGW) {
        const int row2 = row + NGW; const bool has2 = row2 < S; const int rb = has2 ? row2 : row;
        const f32x4* ya = (const f32x4*)(Y + (size_t)row * D) + lane; const f32x4* yb = (const f32x4*)(Y + (size_t)rb * D) + lane;
        f32x4 va[8], vb[8]; float sa = 0.f, sb = 0.f;
#pragma unroll
        for (int j = 0; j < 8; ++j) { va[j] = ya[64 * j]; vb[j] = yb[64 * j]; }
#pragma unroll
        for (int j = 0; j < 8; ++j) { sa += (va[j][0] + va[j][1]) + (va[j][2] + va[j][3]); sb += (vb[j][0] + vb[j][1]) + (vb[j][2] + vb[j][3]); }
        const float ma = wave_sum(sa, lane) * (1.0f / D), mb = wave_sum(sb, lane) * (1.0f / D); float qa = 0.f, qb = 0.f;
#pragma unroll
        for (int j = 0; j < 8; ++j) { va[j] = va[j] - ma; vb[j] = vb[j] - mb; qa += (va[j][0] * va[j][0] + va[j][1] * va[j][1]) + (va[j][2] * va[j][2] + va[j][3] * va[j][3]); qb += (vb[j][0] * vb[j][0] + vb[j][1] * vb[j][1]) + (vb[j][2] * vb[j][2] + vb[j][3] * vb[j][3]); }
        const float ra = 1.0f / sqrtf(wave_sum(qa, lane) * (1.0f / D) + LN_EPS), rbb = 1.0f / sqrtf(wave_sum(qb, lane) * (1.0f / D) + LN_EPS);
        f32x4* xa = (f32x4*)(xo + (size_t)row * D) + lane; f32x4* xbp = (f32x4*)(xo + (size_t)rb * D) + lane;
#pragma unroll
        for (int j = 0; j < 8; ++j) { const f32x4 o = va[j] * ra * g4[j] + b4[j]; xa[64 * j] = o;
            if (xb) { v2u w; w.x = pk2(o[0], o[1]); w.y = pk2(o[2], o[3]); ((v2u*)(xb + (size_t)row * D))[64 * j + lane] = w; } }
        if (has2) {
#pragma unroll
            for (int j = 0; j < 8; ++j) { const f32x4 o = vb[j] * rbb * g4[j] + b4[j]; xbp[64 * j] = o;
                if (xb) { v2u w; w.x = pk2(o[0], o[1]); w.y = pk2(o[2], o[3]); ((v2u*)(xb + (size_t)rb * D))[64 * j + lane] = w; } } }
    }
}
__device__ __forceinline__ void unpack8(const v4u h, float (&o)[8]) { o[0] = bflo(h.x); o[1] = bfhi(h.x); o[2] = bflo(h.y); o[3] = bfhi(h.y); o[4] = bflo(h.z); o[5] = bfhi(h.z); o[6] = bflo(h.w); o[7] = bfhi(h.w); }
__device__ __forceinline__ void phase_convact(const Params& P, const Ctx& cx, int l) {
    unsigned char* ws = cx.ws; const int tid = cx.tid, G = cx.G;
    const bf16* H = (const bf16*)(ws + WS_H); bf16* ACT = (bf16*)(ws + WS_ACT);
    const float* cw = P.in[11] + (size_t)l * 3 * NUP; const float* cb = P.in[12] + (size_t)l * NUP;
    const int gt = cx.bid * 512 + tid, NT = G * 512;
    for (int item = gt; item < 512 * 704; item += NT) {
        const int seg = item / 704, r = item - seg * 704, tile = r >> 4, q8 = r & 15, t0 = seg * 32;
        const int chg = 128 * tile + 8 * q8, chu = DFF + chg;
        float wg[3][8], wu[3][8], bg[8], bu[8];
#pragma unroll
        for (int k = 0; k < 3; ++k) { const f32x4 a0 = *(const f32x4*)(cw + (size_t)k * NUP + chg), a1 = *(const f32x4*)(cw + (size_t)k * NUP + chg + 4), c0 = *(const f32x4*)(cw + (size_t)k * NUP + chu), c1 = *(const f32x4*)(cw + (size_t)k * NUP + chu + 4);
#pragma unroll
            for (int e = 0; e < 4; ++e) { wg[k][e] = a0[e]; wg[k][4 + e] = a1[e]; wu[k][e] = c0[e]; wu[k][4 + e] = c1[e]; } }
        { const f32x4 a0 = *(const f32x4*)(cb + chg), a1 = *(const f32x4*)(cb + chg + 4), c0 = *(const f32x4*)(cb + chu), c1 = *(const f32x4*)(cb + chu + 4);
#pragma unroll
          for (int e = 0; e < 4; ++e) { bg[e] = a0[e]; bg[4 + e] = a1[e]; bu[e] = c0[e]; bu[4 + e] = c1[e]; } }
        const bf16* hp = H + (size_t)t0 * NUP + 256 * tile + 8 * q8;
        float g2[8], g1[8], u2[8], u1[8];
        if (t0 > 0) { unpack8(*(const v4u*)(hp - 2 * (size_t)NUP), g2); unpack8(*(const v4u*)(hp - (size_t)NUP), g1); unpack8(*(const v4u*)(hp - 2 * (size_t)NUP + 128), u2); unpack8(*(const v4u*)(hp - (size_t)NUP + 128), u1); }
        else {
#pragma unroll
            for (int e = 0; e < 8; ++e) { g2[e] = 0.f; g1[e] = 0.f; u2[e] = 0.f; u1[e] = 0.f; } }
        bf16* ap = ACT + (size_t)t0 * DFF + chg;
        v4u ng = *(const v4u*)(hp), nu = *(const v4u*)(hp + 128);
#pragma unroll 2
        for (int tt = 0; tt < 32; ++tt) {
            float g0[8], u0[8]; unpack8(ng, g0); unpack8(nu, u0);
            if (tt < 31) { ng = *(const v4u*)(hp + (size_t)(tt + 1) * NUP); nu = *(const v4u*)(hp + (size_t)(tt + 1) * NUP + 128); }
            float o[8];
#pragma unroll
            for (int e = 0; e < 8; ++e) { const float ga = bg[e] + wg[0][e] * g2[e] + wg[1][e] * g1[e] + wg[2][e] * g0[e], ua = bu[e] + wu[0][e] * u2[e] + wu[1][e] * u1[e] + wu[2][e] * u0[e];
                o[e] = ga * __builtin_amdgcn_rcpf(1.0f + __expf(-ga)) * ua; g2[e] = g1[e]; g1[e] = g0[e]; u2[e] = u1[e]; u1[e] = u0[e]; }
            v4u w; w.x = cvt2(o[0], o[1]); w.y = cvt2(o[2], o[3]); w.z = cvt2(o[4], o[5]); w.w = cvt2(o[6], o[7]);
            *(v4u*)(ap + (size_t)tt * DFF) = w;
        }
    }
}

__device__ __forceinline__ void phase_conv_fixup(const Params& P, const Ctx& cx, int l) {
    unsigned char* ws = cx.ws;
    const bf16* HALO = (const bf16*)(ws + WS_H); bf16* ACT = (bf16*)(ws + WS_ACT);
    const float* cw = P.in[11] + (size_t)l * 3 * NUP; const float* cb = P.in[12] + (size_t)l * NUP;
    const int gt = cx.bid * 512 + cx.tid, NT = cx.G * 512;
    for (int item = gt; item < 256 * 704; item += NT) {
        const int k = item / 704, r = item - k * 704, tile = r >> 4, q8 = r & 15, chg = 128 * tile + 8 * q8, chu = DFF + chg;
        float a_g[8], b_g[8], c_g[8], d_g[8], a_u[8], b_u[8], c_u[8], d_u[8];
        const bf16* hk = HALO + (size_t)k * 4 * NUP + 256 * tile + 8 * q8;
        unpack8(*(const v4u*)(hk), c_g); unpack8(*(const v4u*)(hk + NUP), d_g); unpack8(*(const v4u*)(hk + 128), c_u); unpack8(*(const v4u*)(hk + NUP + 128), d_u);
        if (k > 0) { const bf16* hm = hk - 4 * (size_t)NUP; unpack8(*(const v4u*)(hm + 2 * NUP), a_g); unpack8(*(const v4u*)(hm + 3 * NUP), b_g); unpack8(*(const v4u*)(hm + 2 * NUP + 128), a_u); unpack8(*(const v4u*)(hm + 3 * NUP + 128), b_u); }
        else {
#pragma unroll
            for (int e = 0; e < 8; ++e) { a_g[e] = 0.f; b_g[e] = 0.f; a_u[e] = 0.f; b_u[e] = 0.f; } }
        float o0[8], o1[8];
#pragma unroll
        for (int e = 0; e < 8; ++e) { const float w0g = cw[chg + e], w1g = cw[NUP + chg + e], w2g = cw[2 * NUP + chg + e], bgv = cb[chg + e], w0u = cw[chu + e], w1u = cw[NUP + chu + e], w2u = cw[2 * NUP + chu + e], buv = cb[chu + e];
            const float g0 = bgv + w0g * a_g[e] + w1g * b_g[e] + w2g * c_g[e], u0 = buv + w0u * a_u[e] + w1u * b_u[e] + w2u * c_u[e];
            const float g1 = bgv + w0g * b_g[e] + w1g * c_g[e] + w2g * d_g[e], u1 = buv + w0u * b_u[e] + w1u * c_u[e] + w2u * d_u[e];
            o0[e] = g0 * __builtin_amdgcn_rcpf(1.0f + __expf(-g0)) * u0; o1[e] = g1 * __builtin_amdgcn_rcpf(1.0f + __expf(-g1)) * u1; }
        v4u w0, w1; w0.x = cvt2(o0[0], o0[1]); w0.y = cvt2(o0[2], o0[3]); w0.z = cvt2(o0[4], o0[5]); w0.w = cvt2(o0[6], o0[7]); w1.x = cvt2(o1[0], o1[1]); w1.y = cvt2(o1[2], o1[3]); w1.z = cvt2(o1[4], o1[5]); w1.w = cvt2(o1[6], o1[7]);
        *(v4u*)(ACT + (size_t)(64 * k) * DFF + chg) = w0; *(v4u*)(ACT + (size_t)(64 * k + 1) * DFF + chg) = w1;
    }
}

#ifdef DBG_DUMP
__device__ __forceinline__ void phase_dump(const Ctx& cx, float* out, const bf16* a, int lda, const bf16* b, int ldb, const float* f) {
    const size_t gt = (size_t)cx.bid * 512 + cx.tid, NT = (size_t)cx.G * 512;
    for (size_t i = gt; i < (size_t)S * D; i += NT) { const int row = (int)(i >> 11), col = (int)(i & 2047);
        float v; if (f) v = f[i]; else if (b && col >= 1024) v = bf1(b + (size_t)row * ldb + (col - 1024)); else v = lda ? bf1(a + (size_t)row * lda + col) : bf1(a + (size_t)(row & 2047) * 2048 + col);
        out[i] = v; }
}
#endif
__global__ void __launch_bounds__(512, 2) fwd(Params P) {
    extern __shared__ __attribute__((aligned(16))) unsigned char lds_raw[];
    LAS unsigned char* lds = (LAS unsigned char*)lds_raw;
    const int wave = __builtin_amdgcn_readfirstlane(threadIdx.x >> 6), G = gridDim.x;
    unsigned char* ws = P.ws;
    volatile LAS unsigned* MISC = (volatile LAS unsigned*)(lds + MISC_OFF);
    for (int u = threadIdx.x; u < (LDS_BYTES - LDSCTL_OFF) / 4; u += 512) ((LAS unsigned*)(lds + LDSCTL_OFF))[u] = 0u;
    __syncthreads();
    const int lo = P.ph_lo, hi = P.ph_hi;
    XcdBarrier bar; bar.bar = (unsigned*)(ws + WS_CTL) + CW_BAR; bar.x = 0; bar.st = nullptr;
    if (hi - lo > 1) bar = xcd_barrier_post((unsigned*)(ws + WS_CTL) + CW_BAR, MISC + 8);
#define IN(k) (lo <= (k) && (k) < hi)
#define SEAM(k) do { if (IN(k) && IN((k) + 1)) xcd_barrier(bar); } while (0)
#define OPQ() Ctx cx; cx.lane = lane_id_asm(); { int t_ = wave; asm volatile("" : "+s"(t_)); cx.wave = t_; } { int t_ = G; asm volatile("" : "+s"(t_)); cx.G = t_; } { int t_ = blockIdx.x; asm volatile("" : "+s"(t_)); cx.bid = t_; } \
    { unsigned t_ = 0u; asm volatile("" : "+s"(t_)); cx.ws = P.ws + t_; } cx.tid = cx.wave * 64 + cx.lane; int lq = l; asm volatile("" : "+s"(lq)); (void)lq

#ifdef DBG_DUMP
    if (lo >= 1000) { const int l = 0; OPQ(); unsigned char* w = cx.ws; const int kind = lo - 1000;
        if (kind == 1) phase_dump(cx, P.out, (const bf16*)(w + WS_Q), 1024, (const bf16*)(w + WS_AQ), 1024, nullptr);
        else if (kind == 2) phase_dump(cx, P.out, (const bf16*)(w + WS_MIX), 2048, nullptr, 0, nullptr);
        else if (kind == 3) phase_dump(cx, P.out, nullptr, 0, nullptr, 0, (const float*)(w + WS_XR));
        else if (kind == 4) phase_dump(cx, P.out, (const bf16*)(w + WS_ACT), DFF, nullptr, 0, nullptr);
        else if (kind == 5) phase_dump(cx, P.out, nullptr, 0, nullptr, 0, (const float*)(w + WS_Y));
        else if (kind == 6) phase_dump(cx, P.out, (const bf16*)(w + WS_K), 1024, (const bf16*)(w + WS_V), 1024, nullptr);
        else if (kind == 7) phase_dump(cx, P.out, (const bf16*)(w + WS_XB), 2048, nullptr, 0, nullptr);
        else if (kind == 11) phase_dump(cx, P.out, (const bf16*)(w + WS_W + WL_G), 0, nullptr, 0, nullptr);
        else if (kind == 12) phase_dump(cx, P.out, (const bf16*)(w + WS_W + WL_OUT), 0, nullptr, 0, nullptr);
        else if (kind == 10) phase_dump(cx, P.out, (const bf16*)(w + WS_H) + 36 * 256, NUP, nullptr, 0, nullptr);
        else if (kind == 9) phase_dump(cx, P.out, (const bf16*)(w + WS_SG), 2048, nullptr, 0, nullptr);
        else if (kind == 8) phase_dump(cx, P.out, nullptr, 0, nullptr, 0, (const float*)(w + WS_RETY));
        return; }
#endif
    if (IN(0)) { const int l = 0; REPS(2) { __syncthreads(); OPQ(); phase_prologue(P, cx, lds); } }
    SEAM(0);

    for (int l = 0; l < DEPTH; ++l) {
        const int pb = 1 + l * NPH;
        if (IN(pb + 0)) { OPQ(); unsigned char* w = cx.ws; const bf16* wl = (const bf16*)(w + WS_W + (size_t)lq * WL_BYTES);
            pg8::Gemm g{(const bf16*)(w + WS_XB), wl + WL_IN / 2, S, INW, D}; pg8::StaticOrder So; So.init(S, INW, cx.G, cx.bid);
            pg8::EpiInProj E{(bf16*)(w + WS_Q), (bf16*)(w + WS_K), (bf16*)(w + WS_V), (bf16*)(w + WS_G), (bf16*)(w + WS_AQ), (bf16*)(w + WS_AK), (bf16*)(w + WS_AV),
                             (const float*)(w + WS_COSR), (const float*)(w + WS_SINR), (const float*)(w + WS_COSA), (const float*)(w + WS_SINA)};
            pg8::gemm_phase<pg8::EpiInProj, pg8::StaticOrder, true, true>(lds, g, So, E, cx.wave);
        }
        SEAM(pb + 0);
        if (IN(pb + 1)) {
#if RET_MFMA
            { REPS(2) { OPQ(); phase_ret_u_mfma(P, cx, lds); } }
#else
            { OPQ(); phase_ret_u_scores(P, cx, lds); }
#endif
#if SWA_MFMA
            { REPS(2) { OPQ(); phase_swa_mfma(P, cx, lq, lds); } }
#else
            { OPQ(); phase_swa(P, cx, lq, lds); }
#endif
        }
        SEAM(pb + 1);
#if RET_MFMA
        if (IN(pb + 2)) { OPQ(); phase_scan_bf16(P, cx); }
        SEAM(pb + 2);
        if (IN(pb + 3)) { REPS(2) { OPQ(); phase_ret_out_mfma(P, cx, lq, lds); } }
        SEAM(pb + 3);
#else
        if (IN(pb + 2)) { OPQ(); phase_scan(P, cx); }
        SEAM(pb + 2);
        if (IN(pb + 3)) { OPQ(); phase_ret_out(P, cx, lds); }
        SEAM(pb + 3);
        if (IN(pb + 4)) { OPQ(); phase_groupnorm(P, cx, lq); }
        SEAM(pb + 4);
#endif
        if (IN(pb + 5)) { OPQ(); unsigned char* w = cx.ws; const bf16* wl = (const bf16*)(w + WS_W + (size_t)lq * WL_BYTES);
            pg8::Gemm g{(const bf16*)(w + WS_MIX), wl + WL_OUT / 2, S, D, D}; pg8::StaticOrder So; So.init(S, D, cx.G, cx.bid);
            pg8::EpiResid<false> E{(lq == 0) ? P.in[0] : (const float*)(w + WS_XR), (float*)(w + WS_Y), ALPHA};
            pg8::gemm_phase<pg8::EpiResid<false>, pg8::StaticOrder, true, true>(lds, g, So, E, cx.wave);
        }
        SEAM(pb + 5);
        if (IN(pb + 6)) { REPS(1) { OPQ(); unsigned char* w = cx.ws; phase_ln(cx, (const float*)(w + WS_Y), P.in[8] + lq * D, P.in[9] + lq * D, (float*)(w + WS_XR), (bf16*)(w + WS_XB)); } }
        SEAM(pb + 6);
        if (IN(pb + 7)) { OPQ(); unsigned char* w = cx.ws; const bf16* wl = (const bf16*)(w + WS_W + (size_t)lq * WL_BYTES);
            pg8::Gemm g{(const bf16*)(w + WS_XB), wl + WL_UP / 2, S, NUPG, D}; pg8::StaticOrder So; So.init(S, NUPG, cx.G, cx.bid);
#if CONV_FUSED
            pg8::EpiUpConv E{(bf16*)(w + WS_ACT), (bf16*)(w + WS_H), (bf16*)(w + WS_SG), P.in[17] + lq * D, P.in[11] + (size_t)lq * 3 * NUP, P.in[12] + (size_t)lq * NUP};
            pg8::gemm_phase<pg8::EpiUpConv, pg8::StaticOrder, true, true>(lds, g, So, E, cx.wave);
#else
            pg8::EpiUp E{(bf16*)(w + WS_H), (bf16*)(w + WS_SG), P.in[17] + lq * D};
            pg8::gemm_phase<pg8::EpiUp, pg8::StaticOrder, true, true>(lds, g, So, E, cx.wave);
#endif
        }
        SEAM(pb + 7);
        if (IN(pb + 8)) {
            { OPQ(); unsigned char* w = cx.ws; const bf16* wl = (const bf16*)(w + WS_W + (size_t)lq * WL_BYTES);
              pg8::Gemm g{(const bf16*)(w + WS_PB) + (size_t)lq * S * PLE, wl + WL_P / 2, S, D, PLE}; pg8::StaticOrder So; So.init(S, D, cx.G, cx.bid);
              pg8::EpiPle E{(const bf16*)(w + WS_SG), (float*)(w + WS_Y)};
              pg8::gemm_phase<pg8::EpiPle, pg8::StaticOrder, true, true>(lds, g, So, E, cx.wave); }
#if CONV_FUSED
            { OPQ(); phase_conv_fixup(P, cx, lq); }
#else
            { REPS(1) { OPQ(); phase_convact(P, cx, lq); } }
#endif
        }
        SEAM(pb + 8);
        if (IN(pb + 9)) { OPQ(); unsigned char* w = cx.ws; const bf16* wl = (const bf16*)(w + WS_W + (size_t)lq * WL_BYTES);
            pg8::Gemm g{(const bf16*)(w + WS_ACT), wl + WL_DOWN / 2, S, D, DFF}; pg8::StaticOrder So; So.init(S, D, cx.G, cx.bid);
            pg8::EpiResid<true> E{(const float*)(w + WS_XR), (float*)(w + WS_Y), ALPHA};
            pg8::gemm_phase<pg8::EpiResid<true>, pg8::StaticOrder, true, true>(lds, g, So, E, cx.wave);
        }
        SEAM(pb + 9);
        if (IN(pb + 10)) { REPS(1) { OPQ(); unsigned char* w = cx.ws; const bool last = (lq == DEPTH - 1);
            phase_ln(cx, (const float*)(w + WS_Y), P.in[14] + lq * D, P.in[15] + lq * D, last ? P.out : (float*)(w + WS_XR), last ? (bf16*)nullptr : (bf16*)(w + WS_XB)); } }
        SEAM(pb + 10);
    }
#undef IN
#undef SEAM
}

extern "C" void kernel_launch(void* const* d_in, const int* in_sizes, int n_in, void* d_out, int out_size, void* d_ws, size_t ws_size, hipStream_t stream) {
    static int grid = 0;
    if (grid == 0) {
        if (n_in != 19 || in_sizes[0] != S * D || out_size != S * D || ws_size < WS_END) { fprintf(stderr, "kernel_launch: unexpected shapes (n_in %d, in0 %d, out %d, ws %zu)\n", n_in, n_in > 0 ? in_sizes[0] : -1, out_size, ws_size); grid = -1; return; }
        int dev = 0, cus = 0, per_cu = 0;
        if (hipGetDevice(&dev) != hipSuccess || hipDeviceGetAttribute(&cus, hipDeviceAttributeMultiprocessorCount, dev) != hipSuccess) { grid = -1; return; }
        if (hipFuncSetAttribute((const void*)fwd, hipFuncAttributeMaxDynamicSharedMemorySize, LDS_BYTES) != hipSuccess) { fprintf(stderr, "kernel_launch: hipFuncSetAttribute failed\n"); grid = -1; return; }
        if (hipOccupancyMaxActiveBlocksPerMultiprocessor(&per_cu, (const void*)fwd, 512, LDS_BYTES) != hipSuccess || per_cu < 1) fprintf(stderr, "kernel_launch: occupancy query says %d\n", per_cu);
        (void)hipGetLastError();
        grid = cus;
    }
    if (grid < 0) return;
    (void)hipMemsetAsync((char*)d_ws + WS_CTL, 0, CTL_ZERO_BYTES, stream);
#ifdef DBG_NANFILL
    (void)hipMemsetAsync((char*)d_ws + CTL_ZERO_BYTES, 0xFF, WS_END - CTL_ZERO_BYTES, stream);
#endif
    Params p{};
    for (int i = 0; i < 19; ++i) p.in[i] = (const float*)d_in[i];
    p.out = (float*)d_out; p.ws = (unsigned char*)d_ws;
    for (int f = 0; f < 128; ++f) p.invf_ret[f] = (float)(1.0 / std::pow(10000.0, (double)((float)f / 127.0f)));
    for (int f = 0; f < 32; ++f) p.invf_att[f] = (float)std::pow(10000.0, -(double)(2 * f) / 64.0);
    for (int h = 0; h < 4; ++h) p.lg2g[h] = (float)std::log2(1.0 - std::exp2(-5.0 - h));
#if MK_ONE_LAUNCH
    p.ph_lo = 0; p.ph_hi = NPHASES;
    hipLaunchKernelGGL(fwd, dim3(grid), dim3(512), LDS_BYTES, stream, p);
#else
#ifdef DBG_DUMP
    for (int ph = 0; ph <= DBG_STOP; ++ph) { p.ph_lo = ph; p.ph_hi = ph + 1; hipLaunchKernelGGL(fwd, dim3(grid), dim3(512), LDS_BYTES, stream, p); }
    p.ph_lo = 1000 + DBG_DUMP; p.ph_hi = p.ph_lo + 1; hipLaunchKernelGGL(fwd, dim3(grid), dim3(512), LDS_BYTES, stream, p);
#else
    for (int ph = 0; ph < NPHASES; ++ph) { p.ph_lo = ph; p.ph_hi = ph + 1; hipLaunchKernelGGL(fwd, dim3(grid), dim3(512), LDS_BYTES, stream, p); }
#endif
#endif
}
```

```cpp
#include <hip/hip_runtime.h>
#include <cstdio>
#include <cstdint>
#include <cmath>
#define MK_ONE_LAUNCH 1
namespace pg8 {
#define PG8_LAS __attribute__((address_space(3)))
typedef unsigned short bf16_t;
typedef short bf16x8 __attribute__((ext_vector_type(8)));
typedef float f32x4 __attribute__((ext_vector_type(4)));
typedef unsigned u32x4 __attribute__((ext_vector_type(4)));
constexpr int BM = 256, BK = 64, HALF = 128, HTB = HALF * BK * 2  , STAGE_BYTES = 8 * HTB, NXCD = 8, WGM = 8;

__host__ __device__ __forceinline__ int lds_byte(int r, int c) { const int st = (r >> 4) * 2 + (c >> 5), rr = r & 15, cc = c & 31, ob = rr * 64 + cc * 2; return st * 1024 + (ob ^ (((ob >> 9) & 1) << 5)); }
__host__ __device__ __forceinline__ void stage_rc(int b, int& R, int& C) { const int st = b / 1024, sb = b % 1024, swz = sb ^ (((sb >> 9) & 1) << 5); R = (st >> 1) * 16 + swz / 64; C = (st & 1) * 32 + (swz % 64) / 2; }
__host__ __device__ __forceinline__ int perm32(int rho) { const int n = rho >> 4, i = rho & 15; return 8 * (i >> 2) + 4 * n + (i & 3); }

struct Unit { int pm, pn; };
struct Gemm { const bf16_t* A; const bf16_t* Bt; int M, N, K; };

struct StaticOrder {
    int nM, nN, nwg, G, c;
    __host__ __device__ void init(int M, int N, int G_, int c_) { nM = M / BM; nN = N / BM; nwg = nM * nN; G = G_; c = c_; }
    __host__ __device__ bool next(int i, Unit& u) const {
        const long L = (long)i * G + c; if (L >= nwg) return false;
        int wgid = (int)L; { const int q = nwg / NXCD, r = nwg % NXCD, xcd = wgid % NXCD, off = wgid / NXCD; wgid = (xcd < r ? xcd * (q + 1) : r * (q + 1) + (xcd - r) * q) + off; }
        const int nig = WGM * nN, gid = wgid / nig, fm = gid * WGM, gsz = (nM - fm) < WGM ? (nM - fm) : WGM;
        u.pm = fm + ((wgid % nig) % gsz); u.pn = (wgid % nig) / gsz; return true;
    }
    __device__ __forceinline__ void a_ready(const Unit&) const {}
    __device__ __forceinline__ void done(const Unit&) const {}
};

typedef float f32x2c_t __attribute__((ext_vector_type(2))); typedef __bf16 bf16x2c_t __attribute__((ext_vector_type(2)));
__device__ __forceinline__ unsigned cvt_pk_bf16(float lo, float hi) { f32x2c_t v = {lo, hi}; bf16x2c_t b = __builtin_convertvector(v, bf16x2c_t); return __builtin_bit_cast(unsigned, b); }
typedef float f32x2 __attribute__((ext_vector_type(2)));
typedef unsigned u32x2 __attribute__((ext_vector_type(2)));
__device__ __forceinline__ float bf2f(unsigned short b) { return __uint_as_float(((unsigned)b) << 16); }
__device__ __forceinline__ u32x4 pack8(const f32x4 a, const f32x4 b) { u32x4 w; w.x = cvt_pk_bf16(a[0], a[1]); w.y = cvt_pk_bf16(a[2], a[3]); w.z = cvt_pk_bf16(b[0], b[1]); w.w = cvt_pk_bf16(b[2], b[3]); return w; }
__device__ __forceinline__ float sigmoidf_(float x) { return __builtin_amdgcn_rcpf(1.0f + __expf(-x)); }

struct EpiInProj {
    static constexpr bool PERM = true, AFTER_DRAIN = false;
    bf16_t *Q, *K, *V, *G, *AQ, *AK, *AV; const float *cosr, *sinr, *cosa, *sina;
    __device__ __forceinline__ void operator()(const f32x4 (&acc)[2][2][4][2], const Unit& u, int wr, int wc, int fr, int fq) const {
        const int row0 = u.pm * BM + wr * 64 + fr, pn = u.pn, cw = wc * 32 + 8 * fq;
        if (pn < 8) {
            bf16_t* O = pn < 4 ? Q : K; const int hcol = (pn & 3) * 256; const float sc = pn < 4 ? 1.0f : 0.0625f;
#pragma unroll
            for (int ai = 0; ai < 2; ++ai)
#pragma unroll
                for (int m = 0; m < 4; ++m) { const int row = row0 + ai * HALF + m * 16;
                    const f32x4 c0 = *(const f32x4*)(cosr + (size_t)row * 128 + cw), c1 = *(const f32x4*)(cosr + (size_t)row * 128 + cw + 4);
                    const f32x4 s0 = *(const f32x4*)(sinr + (size_t)row * 128 + cw), s1 = *(const f32x4*)(sinr + (size_t)row * 128 + cw + 4);
                    const f32x4 a0 = acc[ai][0][m][0], a1 = acc[ai][0][m][1], b0 = acc[ai][1][m][0], b1 = acc[ai][1][m][1];
                    const f32x4 o10 = (a0 * c0 - b0 * s0) * sc, o11 = (a1 * c1 - b1 * s1) * sc, o20 = (a0 * s0 + b0 * c0) * sc, o21 = (a1 * s1 + b1 * c1) * sc;
                    bf16_t* rowp = O + (size_t)row * 1024 + hcol + cw;
                    *(u32x4*)(rowp) = pack8(o10, o11); *(u32x4*)(rowp + HALF) = pack8(o20, o21); }
        } else if (pn < 16) {
            const bool gate = pn >= 12; bf16_t* O = gate ? G : V; const int hcol = (pn & 3) * 256;
#pragma unroll
            for (int ai = 0; ai < 2; ++ai)
#pragma unroll
                for (int m = 0; m < 4; ++m) { const int row = row0 + ai * HALF + m * 16; bf16_t* rowp = O + (size_t)row * 1024 + hcol + cw;
#pragma unroll
                    for (int bj = 0; bj < 2; ++bj) { f32x4 v0 = acc[ai][bj][m][0], v1 = acc[ai][bj][m][1];
                        if (gate) {
#pragma unroll
                            for (int j = 0; j < 4; ++j) { v0[j] = v0[j] * sigmoidf_(v0[j]); v1[j] = v1[j] * sigmoidf_(v1[j]); } }
                        *(u32x4*)(rowp + bj * HALF) = pack8(v0, v1); } }
        } else if (pn < 20) {
            const int t = pn - 16, i0 = 8 * fq;
#pragma unroll
            for (int ai = 0; ai < 2; ++ai)
#pragma unroll
                for (int m = 0; m < 4; ++m) { const int row = row0 + ai * HALF + m * 16;
                    const f32x4 c0 = *(const f32x4*)(cosa + (size_t)row * 32 + i0), c1 = *(const f32x4*)(cosa + (size_t)row * 32 + i0 + 4);
                    const f32x4 s0 = *(const f32x4*)(sina + (size_t)row * 32 + i0), s1 = *(const f32x4*)(sina + (size_t)row * 32 + i0 + 4);
                    const f32x4 a0 = acc[ai][0][m][0], a1 = acc[ai][0][m][1], b0 = acc[ai][1][m][0], b1 = acc[ai][1][m][1];
                    const f32x4 o10 = (a0 * c0 - b0 * s0) * 0.125f, o11 = (a1 * c1 - b1 * s1) * 0.125f, o20 = (a0 * s0 + b0 * c0) * 0.125f, o21 = (a1 * s1 + b1 * c1) * 0.125f;
                    bf16_t* rowp = AQ + (size_t)row * 1024 + t * 256 + wc * 64 + i0;
                    *(u32x4*)(rowp) = pack8(o10, o11); *(u32x4*)(rowp + 32) = pack8(o20, o21); }
        } else {
            const int i0 = 8 * fq;
            if (wc < 2) {
#pragma unroll
                for (int ai = 0; ai < 2; ++ai)
#pragma unroll
                    for (int m = 0; m < 4; ++m) { const int row = row0 + ai * HALF + m * 16;
                        const f32x4 c0 = *(const f32x4*)(cosa + (size_t)row * 32 + i0), c1 = *(const f32x4*)(cosa + (size_t)row * 32 + i0 + 4);
                        const f32x4 s0 = *(const f32x4*)(sina + (size_t)row * 32 + i0), s1 = *(const f32x4*)(sina + (size_t)row * 32 + i0 + 4);
                        const f32x4 a0 = acc[ai][0][m][0], a1 = acc[ai][0][m][1], b0 = acc[ai][1][m][0], b1 = acc[ai][1][m][1];
                        const f32x4 o10 = a0 * c0 - b0 * s0, o11 = a1 * c1 - b1 * s1, o20 = a0 * s0 + b0 * c0, o21 = a1 * s1 + b1 * c1;
                        bf16_t* rowp = AK + (size_t)row * 128 + wc * 64 + i0;
                        *(u32x4*)(rowp) = pack8(o10, o11); *(u32x4*)(rowp + 32) = pack8(o20, o21); }
            } else {
#pragma unroll
                for (int ai = 0; ai < 2; ++ai)
#pragma unroll
                    for (int m = 0; m < 4; ++m) { const int row = row0 + ai * HALF + m * 16; bf16_t* rowp = AV + (size_t)row * 128 + (wc - 2) * 32 + i0;
                        *(u32x4*)(rowp) = pack8(acc[ai][0][m][0], acc[ai][0][m][1]); *(u32x4*)(rowp + 64) = pack8(acc[ai][1][m][0], acc[ai][1][m][1]); }
            }
        }
    }
};
template <bool ADD> struct EpiResid {
    static constexpr bool PERM = false, AFTER_DRAIN = false;
    const float* base; float* Y; float alpha;
    __device__ __forceinline__ void operator()(const f32x4 (&acc)[2][2][4][2], const Unit& u, int wr, int wc, int fr, int fq) const {
        const int row0 = u.pm * BM + wr * 64 + fr, col0 = u.pn * BM + wc * 32 + 4 * fq;
#pragma unroll
        for (int ai = 0; ai < 2; ++ai)
#pragma unroll
            for (int m = 0; m < 4; ++m) { const size_t off = (size_t)(row0 + ai * HALF + m * 16) * 2048 + col0;
#pragma unroll
                for (int bj = 0; bj < 2; ++bj)
#pragma unroll
                    for (int n = 0; n < 2; ++n) { const size_t o = off + bj * HALF + n * 16; f32x4 v = acc[ai][bj][m][n] + *(const f32x4*)(base + o) * alpha;
                        if (ADD) v = v + *(const f32x4*)(Y + o); *(f32x4*)(Y + o) = v; } }
    }
};
struct EpiUp {
    static constexpr bool PERM = true, AFTER_DRAIN = false;
    bf16_t* H; bf16_t* SG; const float* bgate;
    __device__ __forceinline__ void operator()(const f32x4 (&acc)[2][2][4][2], const Unit& u, int wr, int wc, int fr, int fq) const {
        const int row0 = u.pm * BM + wr * 64 + fr, cw = wc * 32 + 8 * fq;
        if (u.pn < 44) {
#pragma unroll
            for (int ai = 0; ai < 2; ++ai)
#pragma unroll
                for (int m = 0; m < 4; ++m) { bf16_t* rowp = H + (size_t)(row0 + ai * HALF + m * 16) * 11264 + u.pn * 256 + cw;
#pragma unroll
                    for (int bj = 0; bj < 2; ++bj) *(u32x4*)(rowp + bj * HALF) = pack8(acc[ai][bj][m][0], acc[ai][bj][m][1]); }
        } else {
            const int colg = (u.pn - 44) * 256 + cw;
            f32x4 bv[2][2];
#pragma unroll
            for (int bj = 0; bj < 2; ++bj)
#pragma unroll
                for (int n = 0; n < 2; ++n) bv[bj][n] = *(const f32x4*)(bgate + colg + bj * HALF + 4 * n);
#pragma unroll
            for (int ai = 0; ai < 2; ++ai)
#pragma unroll
                for (int m = 0; m < 4; ++m) { bf16_t* rowp = SG + (size_t)(row0 + ai * HALF + m * 16) * 2048 + colg;
#pragma unroll
                    for (int bj = 0; bj < 2; ++bj) { f32x4 v0 = acc[ai][bj][m][0] + bv[bj][0], v1 = acc[ai][bj][m][1] + bv[bj][1];
#pragma unroll
                        for (int j = 0; j < 4; ++j) { v0[j] = sigmoidf_(v0[j]); v1[j] = sigmoidf_(v1[j]); }
                        *(u32x4*)(rowp + bj * HALF) = pack8(v0, v1); } }
        }
    }
};

__device__ __forceinline__ float ror1f(float x) { return __builtin_bit_cast(float, __builtin_amdgcn_update_dpp(0, __builtin_bit_cast(int, x), 0x121, 0xf, 0xf, false)); }
__device__ __forceinline__ float ror2f(float x) { return __builtin_bit_cast(float, __builtin_amdgcn_update_dpp(0, __builtin_bit_cast(int, x), 0x122, 0xf, 0xf, false)); }
struct EpiUpConv {
    static constexpr bool PERM = true, AFTER_DRAIN = false;
    bf16_t* ACT; bf16_t* HALO; bf16_t* SG; const float* bgate; const float* cw; const float* cb;
    __device__ __forceinline__ void operator()(const f32x4 (&acc)[2][2][4][2], const Unit& u, int wr, int wc, int fr, int fq) const {
        const int row0 = u.pm * BM + wr * 64 + fr, cwp = wc * 32 + 8 * fq;
        if (u.pn < 44) {
#pragma unroll
            for (int n = 0; n < 2; ++n) {
                const int chg = 128 * u.pn + cwp + 4 * n, chu = 5632 + chg;
                const f32x4 wg0 = *(const f32x4*)(cw + chg), wg1 = *(const f32x4*)(cw + 11264 + chg), wg2 = *(const f32x4*)(cw + 2 * 11264 + chg), bg = *(const f32x4*)(cb + chg);
                const f32x4 wu0 = *(const f32x4*)(cw + chu), wu1 = *(const f32x4*)(cw + 11264 + chu), wu2 = *(const f32x4*)(cw + 2 * 11264 + chu), bu = *(const f32x4*)(cb + chu);
#pragma unroll
                for (int ai = 0; ai < 2; ++ai) {
                    const int span = u.pm * 4 + ai * 2 + wr;
#pragma unroll
                    for (int m = 0; m < 4; ++m) {
                        const f32x4 cg = acc[ai][0][m][n], cu = acc[ai][1][m][n];
                        const f32x4 pg = acc[ai][0][m ? m - 1 : 0][n], pu = acc[ai][1][m ? m - 1 : 0][n];
                        f32x4 o;
#pragma unroll
                        for (int j = 0; j < 4; ++j) {
                            const float g1 = ror1f(fr == 15 ? pg[j] : cg[j]), g2 = ror2f(fr >= 14 ? pg[j] : cg[j]);
                            const float u1 = ror1f(fr == 15 ? pu[j] : cu[j]), u2 = ror2f(fr >= 14 ? pu[j] : cu[j]);
                            const float ga = bg[j] + wg0[j] * g2 + wg1[j] * g1 + wg2[j] * cg[j], ua = bu[j] + wu0[j] * u2 + wu1[j] * u1 + wu2[j] * cu[j];
                            o[j] = ga * sigmoidf_(ga) * ua; }
                        const int row = row0 + ai * HALF + m * 16;
                        u32x2 w; w.x = cvt_pk_bf16(o[0], o[1]); w.y = cvt_pk_bf16(o[2], o[3]);
                        if (m > 0 || fr >= 2) *(u32x2*)(ACT + (size_t)row * 5632 + 128 * u.pn + cwp + 4 * n) = w;
                        if ((m == 0 && fr < 2) || (m == 3 && fr >= 14)) { const int slot = (m == 0) ? fr : fr - 12;
                            bf16_t* hp = HALO + ((size_t)(span * 4 + slot)) * 11264 + 256 * u.pn + cwp + 4 * n;
                            u32x2 rg, ru; rg.x = cvt_pk_bf16(cg[0], cg[1]); rg.y = cvt_pk_bf16(cg[2], cg[3]); ru.x = cvt_pk_bf16(cu[0], cu[1]); ru.y = cvt_pk_bf16(cu[2], cu[3]);
                            *(u32x2*)(hp) = rg; *(u32x2*)(hp + HALF) = ru; }
                    }
                }
            }
        } else {
            const int colg = (u.pn - 44) * 256 + cwp;
            f32x4 bv[2][2];
#pragma unroll
            for (int bj = 0; bj < 2; ++bj)
#pragma unroll
                for (int n = 0; n < 2; ++n) bv[bj][n] = *(const f32x4*)(bgate + colg + bj * HALF + 4 * n);
#pragma unroll
            for (int ai = 0; ai < 2; ++ai)
#pragma unroll
                for (int m = 0; m < 4; ++m) { bf16_t* rowp = SG + (size_t)(row0 + ai * HALF + m * 16) * 2048 + colg;
#pragma unroll
                    for (int bj = 0; bj < 2; ++bj) { f32x4 v0 = acc[ai][bj][m][0] + bv[bj][0], v1 = acc[ai][bj][m][1] + bv[bj][1];
#pragma unroll
                        for (int j = 0; j < 4; ++j) { v0[j] = sigmoidf_(v0[j]); v1[j] = sigmoidf_(v1[j]); }
                        *(u32x4*)(rowp + bj * HALF) = pack8(v0, v1); } }
        }
    }
};

struct EpiPlain {
    static constexpr bool PERM = true, AFTER_DRAIN = false;
    bf16_t* O;
    __device__ __forceinline__ void operator()(const f32x4 (&acc)[2][2][4][2], const Unit& u, int wr, int wc, int fr, int fq) const {
        const int row0 = u.pm * BM + wr * 64 + fr, cwp = u.pn * BM + wc * 32 + 8 * fq;
#pragma unroll
        for (int ai = 0; ai < 2; ++ai)
#pragma unroll
            for (int m = 0; m < 4; ++m) { bf16_t* rowp = O + (size_t)(row0 + ai * HALF + m * 16) * 2048 + cwp;
#pragma unroll
                for (int bj = 0; bj < 2; ++bj) *(u32x4*)(rowp + bj * HALF) = pack8(acc[ai][bj][m][0], acc[ai][bj][m][1]); }
    }
};
struct EpiDown {
    static constexpr bool PERM = false, AFTER_DRAIN = false;
    const float* base; float* Y; const bf16_t* PP; const bf16_t* SG; float alpha;
    __device__ __forceinline__ void operator()(const f32x4 (&acc)[2][2][4][2], const Unit& u, int wr, int wc, int fr, int fq) const {
        const int row0 = u.pm * BM + wr * 64 + fr, col0 = u.pn * BM + wc * 32 + 4 * fq;
#pragma unroll
        for (int ai = 0; ai < 2; ++ai)
#pragma unroll
            for (int m = 0; m < 4; ++m) { const size_t off = (size_t)(row0 + ai * HALF + m * 16) * 2048 + col0;
#pragma unroll
                for (int bj = 0; bj < 2; ++bj)
#pragma unroll
                    for (int n = 0; n < 2; ++n) { const size_t o = off + bj * HALF + n * 16; const u32x2 pp = *(const u32x2*)(PP + o), sg = *(const u32x2*)(SG + o);
                        f32x4 pl; pl[0] = __uint_as_float(pp.x << 16) * __uint_as_float(sg.x << 16); pl[1] = __uint_as_float(pp.x & 0xffff0000u) * __uint_as_float(sg.x & 0xffff0000u);
                        pl[2] = __uint_as_float(pp.y << 16) * __uint_as_float(sg.y << 16); pl[3] = __uint_as_float(pp.y & 0xffff0000u) * __uint_as_float(sg.y & 0xffff0000u);
                        *(f32x4*)(Y + o) = acc[ai][bj][m][n] + *(const f32x4*)(base + o) * alpha + pl; } }
    }
};
struct EpiPle {
    static constexpr bool PERM = false, AFTER_DRAIN = false;
    const bf16_t* SG; float* Y;
    __device__ __forceinline__ void operator()(const f32x4 (&acc)[2][2][4][2], const Unit& u, int wr, int wc, int fr, int fq) const {
        const int row0 = u.pm * BM + wr * 64 + fr, col0 = u.pn * BM + wc * 32 + 4 * fq;
#pragma unroll
        for (int ai = 0; ai < 2; ++ai)
#pragma unroll
            for (int m = 0; m < 4; ++m) { const size_t off = (size_t)(row0 + ai * HALF + m * 16) * 2048 + col0;
#pragma unroll
                for (int bj = 0; bj < 2; ++bj)
#pragma unroll
                    for (int n = 0; n < 2; ++n) { const size_t o = off + bj * HALF + n * 16; const u32x2 sg = *(const u32x2*)(SG + o);
                        f32x4 g; g[0] = __uint_as_float(sg.x << 16); g[1] = __uint_as_float(sg.x & 0xffff0000u); g[2] = __uint_as_float(sg.y << 16); g[3] = __uint_as_float(sg.y & 0xffff0000u);
                        *(f32x4*)(Y + o) = acc[ai][bj][m][n] * g; } }
    }
};
template <class Epi, class Sched, bool ALIGN_EPI = false, bool SP2 = false>
__device__ __forceinline__ void gemm_phase(PG8_LAS unsigned char* lds, const Gemm g, const Sched& S, const Epi& E, const int wid_in) {
    int lane_; asm volatile("v_mbcnt_lo_u32_b32 %0, -1, 0\n\tv_mbcnt_hi_u32_b32 %0, -1, %0" : "=v"(lane_)); const int wid = wid_in, lane = lane_, tid = wid * 64 + lane, wr = wid >> 2, wc = wid & 3, fr = lane & 15, fq = lane >> 4;
    const int K = g.K, nt = K / BK;
    unsigned voffA[2], voffB[2];
#pragma unroll
    for (int i = 0; i < 2; ++i) { int R, C; stage_rc(tid * 16 + i * 8192, R, C); const int Rb = Epi::PERM ? ((R & ~31) + perm32(R & 31)) : R;
        voffA[i] = (unsigned)(R * K + C) * 2u; voffB[i] = (unsigned)(Rb * K + C) * 2u; }
    const size_t kstep = (size_t)(BK * 2);
    const size_t hstep = (size_t)HALF * K * 2;
    const size_t tstep = 2 * hstep;
    const unsigned ldsw = (unsigned)wid * 1024u;
    const int aoff = lds_byte(wr * 64 + fr, fq * 8), boff = lds_byte(wc * 32 + fr, fq * 8);
#define PG8_SA(b, h) (((b) * 2 + (h)) * HTB)
#define PG8_SB(b, h) ((4 + (b) * 2 + (h)) * HTB)
#define PG8_STAGE(bufoff, gbase, voff) do { _Pragma("unroll") for (int _i = 0; _i < 2; ++_i) \
        __builtin_amdgcn_global_load_lds((const unsigned*)((const char*)(gbase) + (voff)[_i]), (PG8_LAS unsigned*)(lds + (bufoff) + ldsw + _i * 8192), 16, 0, 0); } while (0)
#define PG8_LDA(dst, b, h) do { _Pragma("unroll") for (int m = 0; m < 4; ++m) _Pragma("unroll") for (int k = 0; k < 2; ++k) dst[m][k] = *(const PG8_LAS bf16x8*)(lds + PG8_SA(b, h) + aoff + m * 2048 + k * 1024); } while (0)
#define PG8_LDB(dst, b, h) do { _Pragma("unroll") for (int n = 0; n < 2; ++n) _Pragma("unroll") for (int k = 0; k < 2; ++k) dst[n][k] = *(const PG8_LAS bf16x8*)(lds + PG8_SB(b, h) + boff + n * 2048 + k * 1024); } while (0)
#define PG8_MMA(ai, bj, At, Bt) do { __builtin_amdgcn_s_setprio(1); _Pragma("unroll") for (int m = 0; m < 4; ++m) _Pragma("unroll") for (int n = 0; n < 2; ++n) _Pragma("unroll") for (int k = 0; k < 2; ++k) \
        acc[ai][bj][m][n] = __builtin_amdgcn_mfma_f32_16x16x32_bf16(Bt[n][k], At[m][k], acc[ai][bj][m][n], 0, 0, 0); __builtin_amdgcn_s_setprio(0); } while (0)
#define PG8_WAIT_V(n) asm volatile("s_waitcnt vmcnt(" #n ")" ::: "memory")
#define PG8_WAIT_L(n) asm volatile("s_waitcnt lgkmcnt(" #n ")" ::: "memory")
#define PG8_BAR __builtin_amdgcn_s_barrier()
#define PG8_SCHED __builtin_amdgcn_sched_barrier(0)
    Unit cur, nxt; int ui = 0;
    if (!S.next(0, cur)) return;
    f32x4 acc[2][2][4][2];
#pragma unroll
    for (int a = 0; a < 2; ++a)
#pragma unroll
        for (int b = 0; b < 2; ++b)
#pragma unroll
            for (int m = 0; m < 4; ++m)
#pragma unroll
                for (int n = 0; n < 2; ++n) acc[a][b][m][n] = (f32x4){0.f, 0.f, 0.f, 0.f};
    bf16x8 At[4][2], B0[2][2], B1[2][2];
    const char* cA = (const char*)g.A + (size_t)cur.pm * tstep; const char* cB = (const char*)g.Bt + (size_t)cur.pn * tstep;
    S.a_ready(cur);
    if constexpr (SP2) {
        PG8_STAGE(PG8_SB(0, 0), cB, voffB); PG8_STAGE(PG8_SB(0, 1), cB + hstep, voffB); PG8_STAGE(PG8_SA(0, 0), cA, voffA); PG8_STAGE(PG8_SA(0, 1), cA + hstep, voffA);
        if (wr == 1) PG8_BAR;
        PG8_WAIT_V(2); PG8_BAR;
        PG8_STAGE(PG8_SB(1, 0), cB + kstep, voffB); PG8_STAGE(PG8_SA(1, 0), cA + kstep, voffA); PG8_STAGE(PG8_SB(1, 1), cB + hstep + kstep, voffB);
        PG8_WAIT_V(6); PG8_BAR;
    } else {
        PG8_STAGE(PG8_SB(0, 0), cB, voffB); PG8_STAGE(PG8_SA(0, 0), cA, voffA); PG8_STAGE(PG8_SB(0, 1), cB + hstep, voffB); PG8_STAGE(PG8_SA(0, 1), cA + hstep, voffA);
        if (wr == 1) PG8_BAR;
        PG8_WAIT_V(4); PG8_BAR;
        PG8_STAGE(PG8_SB(1, 0), cB + kstep, voffB); PG8_STAGE(PG8_SA(1, 0), cA + kstep, voffA); PG8_STAGE(PG8_SB(1, 1), cB + hstep + kstep, voffB);
        PG8_WAIT_V(6); PG8_BAR;
    }
    for (;;) {
        const bool has_next = S.next(ui + 1, nxt);
        const char* nA = has_next ? (const char*)g.A + (size_t)nxt.pm * tstep : cA; const char* nB = has_next ? (const char*)g.Bt + (size_t)nxt.pn * tstep : cB;
        for (int t = 0; t < nt; t += 2) {
            const bool last = (t == nt - 2);
            const char* a1 = cA + (size_t)(t + 1) * kstep;
            const char* a2 = last ? nA : cA + (size_t)(t + 2) * kstep; const char* b2 = last ? nB : cB + (size_t)(t + 2) * kstep;
            const char* a3 = a2 + kstep; const char* b3 = b2 + kstep;
            if (last && has_next) S.a_ready(nxt);
            if constexpr (SP2) {
            PG8_LDB(B0, 0, 0); PG8_LDB(B1, 0, 1); PG8_SCHED; PG8_LDA(At, 0, 0); PG8_STAGE(PG8_SA(1, 1), a1 + hstep, voffA);
            PG8_WAIT_V(8); PG8_WAIT_L(0); PG8_BAR; PG8_MMA(0, 0, At, B0); PG8_MMA(0, 1, At, B1); PG8_BAR; PG8_SCHED;
            PG8_LDA(At, 0, 1); PG8_STAGE(PG8_SB(0, 0), b2, voffB); PG8_STAGE(PG8_SB(0, 1), b2 + hstep, voffB); PG8_STAGE(PG8_SA(0, 0), a2, voffA);
            PG8_WAIT_V(8); PG8_WAIT_L(0); PG8_BAR; PG8_MMA(1, 0, At, B0); PG8_MMA(1, 1, At, B1); PG8_BAR; PG8_SCHED;
            PG8_LDB(B0, 1, 0); PG8_LDB(B1, 1, 1); PG8_SCHED; PG8_LDA(At, 1, 0); PG8_STAGE(PG8_SA(0, 1), a2 + hstep, voffA);
            PG8_WAIT_V(8); PG8_WAIT_L(0); PG8_BAR; PG8_MMA(0, 0, At, B0); PG8_MMA(0, 1, At, B1); PG8_BAR; PG8_SCHED;
            PG8_LDA(At, 1, 1); PG8_STAGE(PG8_SB(1, 0), b3, voffB); PG8_STAGE(PG8_SB(1, 1), b3 + hstep, voffB); PG8_STAGE(PG8_SA(1, 0), a3, voffA);
            PG8_WAIT_V(8); PG8_WAIT_L(0); PG8_BAR; PG8_MMA(1, 0, At, B0); PG8_MMA(1, 1, At, B1); PG8_BAR; PG8_SCHED;
            } else {
            PG8_LDB(B0, 0, 0); PG8_SCHED; PG8_LDA(At, 0, 0); PG8_STAGE(PG8_SA(1, 1), a1 + hstep, voffA);
            PG8_WAIT_L(8); PG8_BAR; PG8_WAIT_L(0); PG8_MMA(0, 0, At, B0); PG8_BAR; PG8_SCHED;
            PG8_LDB(B1, 0, 1); PG8_STAGE(PG8_SB(0, 0), b2, voffB);
            PG8_BAR; PG8_WAIT_L(0); PG8_MMA(0, 1, At, B1); PG8_BAR;
            PG8_LDA(At, 0, 1); PG8_STAGE(PG8_SA(0, 0), a2, voffA);
            PG8_BAR; PG8_WAIT_L(0); PG8_MMA(1, 0, At, B0); PG8_BAR; PG8_SCHED;
            PG8_STAGE(PG8_SB(0, 1), b2 + hstep, voffB);
            PG8_WAIT_V(6); PG8_BAR; PG8_MMA(1, 1, At, B1); PG8_BAR;
            PG8_LDB(B0, 1, 0); PG8_SCHED; PG8_LDA(At, 1, 0); PG8_STAGE(PG8_SA(0, 1), a2 + hstep, voffA);
            PG8_WAIT_L(8); PG8_BAR; PG8_WAIT_L(0); PG8_MMA(0, 0, At, B0); PG8_BAR; PG8_SCHED;
            PG8_LDB(B1, 1, 1); PG8_STAGE(PG8_SB(1, 0), b3, voffB);
            PG8_BAR; PG8_WAIT_L(0); PG8_MMA(0, 1, At, B1); PG8_BAR;
            PG8_LDA(At, 1, 1); PG8_STAGE(PG8_SA(1, 0), a3, voffA);
            PG8_BAR; PG8_WAIT_L(0); PG8_MMA(1, 0, At, B0); PG8_BAR; PG8_SCHED;
            PG8_STAGE(PG8_SB(1, 1), b3 + hstep, voffB);
            PG8_WAIT_V(6); PG8_BAR; PG8_MMA(1, 1, At, B1); PG8_BAR;
            }
        }
        if constexpr (ALIGN_EPI) { if (wr == 0) PG8_BAR; }
        if constexpr (!Epi::AFTER_DRAIN) { E(acc, cur, wr, wc, fr, fq); S.done(cur); }
        if (!has_next) break;
#pragma unroll
        for (int a = 0; a < 2; ++a)
#pragma unroll
            for (int b = 0; b < 2; ++b)
#pragma unroll
                for (int m = 0; m < 4; ++m)
#pragma unroll
                    for (int n = 0; n < 2; ++n) acc[a][b][m][n] = (f32x4){0.f, 0.f, 0.f, 0.f};
        cur = nxt; cA = nA; cB = nB; ++ui;
        if constexpr (ALIGN_EPI) { if (wr == 1) PG8_BAR; }
    }
    PG8_WAIT_V(0);
    if constexpr (!ALIGN_EPI) { if (wr == 0) PG8_BAR; }
    PG8_BAR;
    if constexpr (Epi::AFTER_DRAIN) { E.fused(acc, cur, wr, wc, fr, fq, lds, wid, lane); S.done(cur); }
#undef PG8_SA
#undef PG8_SB
#undef PG8_STAGE
#undef PG8_LDA
#undef PG8_LDB
#undef PG8_MMA
#undef PG8_WAIT_V
#undef PG8_WAIT_L
#undef PG8_BAR
#undef PG8_SCHED
}
}
#define LAS __attribute__((address_space(3)))
#define XB_TMO      128
#define XB_XCNT(j)  (256  + 64 * (j))
#define XB_XSUB(j)  (1280 + 64 * (j))
#define XB_XGEN(j)  (2304 + 64 * (j))
#define XB_TOP      3328
#define XB_TOPGEN   3392
#define XCD_BAR_WORDS 3456
#define XB_SPIN_CAP (1u << 18)

__device__ __forceinline__ unsigned xb_ld(unsigned* p)              { return __hip_atomic_load(p, __ATOMIC_RELAXED, __HIP_MEMORY_SCOPE_AGENT); }
__device__ __forceinline__ unsigned xb_add(unsigned* p, unsigned v) { return __hip_atomic_fetch_add(p, v, __ATOMIC_RELAXED, __HIP_MEMORY_SCOPE_AGENT); }
__device__ __forceinline__ unsigned xb_xcc_id() { return (unsigned)__builtin_amdgcn_s_getreg((3 << 11) | 20) & 0xFu; }
#define XB_SPIN(cond, bar) do { unsigned _sp = 0; while (cond) { __builtin_amdgcn_s_sleep(1); \
    if ((++_sp & 255u) == 0u) { if (xb_ld(&(bar)[XB_TMO])) break; if (_sp > XB_SPIN_CAP) { atomicAdd(&(bar)[XB_TMO], 1u); break; } } } } while (0)

struct XcdBarrier {
    unsigned* bar; unsigned x;
    volatile LAS unsigned* st;
};

__device__ __forceinline__ XcdBarrier xcd_barrier_post(unsigned* bar, volatile LAS unsigned* st) {
    XcdBarrier b; b.bar = bar; b.x = xb_xcc_id(); b.st = st;
    if (threadIdx.x == 0) (void)xb_add(&bar[XB_XCNT(b.x)], 1u);
    return b;
}
__device__ __forceinline__ void xcd_barrier_complete(unsigned* bar, unsigned x, unsigned& nloc, unsigned& nx) {
    const unsigned G = gridDim.x * gridDim.y * gridDim.z;
    unsigned sum, cnt, mine, sp = 0u;
    for (;;) {
        sum = 0u; cnt = 0u; mine = 0u;
#pragma unroll
        for (unsigned j = 0; j < 16; ++j) { const unsigned c = xb_ld(&bar[XB_XCNT(j)]); sum += c; cnt += (c > 0u) ? 1u : 0u; mine = (j == x) ? c : mine; }
        if (sum == G) break;
        __builtin_amdgcn_s_sleep(1);
        if ((++sp & 255u) == 0u) { if (xb_ld(&bar[XB_TMO])) break; if (sp > XB_SPIN_CAP) { atomicAdd(&bar[XB_TMO], 1u); break; } }
    }
    nloc = mine > 0u ? mine : 1u; nx = cnt > 0u ? cnt : 1u;
}

__device__ __forceinline__ void xcd_barrier(const XcdBarrier& b) {
    asm volatile("s_waitcnt vmcnt(0)" ::: "memory");
    __syncthreads();
    if (threadIdx.x == 0) {
        unsigned* bar = b.bar;
        __builtin_amdgcn_s_waitcnt(0);
        unsigned nloc = b.st[0], nx = b.st[1];
        if (nloc == 0u) { xcd_barrier_complete(bar, b.x, nloc, nx); b.st[0] = nloc; b.st[1] = nx; }
        const unsigned old = xb_add(&bar[XB_XSUB(b.x)], 1u);
        const unsigned gen = old / nloc;
        if (old + 1u == (gen + 1u) * nloc) {
            __builtin_amdgcn_fence(__ATOMIC_RELEASE, "agent");
            asm volatile("s_waitcnt vmcnt(0)" ::: "memory");
            const unsigned og = xb_add(&bar[XB_TOP], 1u);
            const unsigned tg = og / nx;
            if (og + 1u == (tg + 1u) * nx) xb_add(&bar[XB_TOPGEN], 1u);
            else XB_SPIN(xb_ld(&bar[XB_TOPGEN]) == tg, bar);
            __builtin_amdgcn_fence(__ATOMIC_ACQUIRE, "agent");
            xb_add(&bar[XB_XGEN(b.x)], 1u);
            asm volatile("s_waitcnt vmcnt(0)" ::: "memory");
        } else {
            XB_SPIN(xb_ld(&bar[XB_XGEN(b.x)]) == gen, bar);
            __builtin_amdgcn_fence(__ATOMIC_ACQUIRE, "agent");
            asm volatile("s_waitcnt vmcnt(0)" ::: "memory");
        }
    }
    __syncthreads();
}
#define GAS __attribute__((address_space(1)))

typedef unsigned short bf16;
typedef float f32x4 __attribute__((ext_vector_type(4)));
typedef unsigned v4u __attribute__((ext_vector_type(4)));
typedef unsigned v2u __attribute__((ext_vector_type(2)));
#define LDS_WAIT() asm volatile("s_waitcnt lgkmcnt(0)" ::: "memory")

#ifndef MK_ONE_LAUNCH
#define MK_ONE_LAUNCH 0
#endif
#ifndef RET_MFMA
#define RET_MFMA 1
#endif
#ifndef SWA_MFMA
#define SWA_MFMA 1
#endif
#ifndef PROBE_DUP
#define PROBE_DUP 0
#endif
#ifndef CONV_FUSED
#define CONV_FUSED 1
#endif
#ifndef PLE_EARLY
#define PLE_EARLY 1
#endif
#define REPS(k) int nrep_ = (PROBE_DUP == (k)) ? 2 : 1; asm volatile("" : "+s"(nrep_)); for (int rep_ = 0; rep_ < nrep_; ++rep_)

constexpr int S = 16384, D = 2048, INW = 5376, DFF = 5632, NUP = 2 * DFF, NUPG = NUP + D, PLE = 256, DEPTH = 4;
constexpr float ALPHA = 1.6817928305074290f, LN_EPS = 1e-5f, GN_EPS = 1e-6f;
constexpr int NPH = 11, NPHASES = 1 + DEPTH * NPH;

constexpr size_t MiB = 1u << 20;
constexpr size_t WS_CTL = 0, CTL_ZERO_BYTES = 1 * MiB;
constexpr size_t WS_COSR = 2 * MiB, WS_SINR = 10 * MiB, WS_COSA = 18 * MiB, WS_SINA = 20 * MiB;
constexpr size_t WS_W = 32 * MiB, WL_BYTES = 104 * MiB;
constexpr size_t WL_IN = 0, WL_OUT = 21 * MiB, WL_UP = 29 * MiB, WL_G = 73 * MiB, WL_DOWN = 81 * MiB, WL_P = 103 * MiB;
constexpr size_t WS_XR = 448 * MiB, WS_XB = 576 * MiB, WS_Y = 640 * MiB;
constexpr size_t WS_Q = 768 * MiB, WS_K = 800 * MiB, WS_V = 832 * MiB, WS_G = 864 * MiB, WS_AQ = 896 * MiB, WS_AK = 928 * MiB, WS_AV = 932 * MiB;
constexpr size_t WS_MIX = 936 * MiB, WS_U = 1000 * MiB, WS_PS = 1128 * MiB, WS_RETY = 1160 * MiB;
constexpr size_t WS_H = 768 * MiB, WS_ACT = 1128 * MiB, WS_SG = 1304 * MiB, WS_PB = 1368 * MiB, WS_END = 1400 * MiB;
constexpr size_t WS_PP = 1064 * MiB;
constexpr int CW_BAR = 4096;

constexpr int RING_BYTES = 131072, LDS_BYTES = 147456, LDSCTL_OFF = LDS_BYTES - 1024, MISC_OFF = LDSCTL_OFF + 320;

__device__ __forceinline__ unsigned f2bf(float f) { unsigned u = __builtin_bit_cast(unsigned, f); return (u + 0x7fffu + ((u >> 16) & 1u)) >> 16; }
__device__ __forceinline__ unsigned pk2(float lo, float hi) { return f2bf(lo) | (f2bf(hi) << 16); }
__device__ __forceinline__ float bflo(unsigned w) { return __uint_as_float(w << 16); }
__device__ __forceinline__ float bfhi(unsigned w) { return __uint_as_float(w & 0xffff0000u); }
__device__ __forceinline__ float bf1(const bf16* p) { return __uint_as_float(((unsigned)*p) << 16); }

struct Params {
    const float* in[19]; float* out; unsigned char* ws; int ph_lo, ph_hi;
    float invf_ret[128]; float invf_att[32]; float lg2g[4];
};

struct Ctx { int tid, lane, wave, G, bid; unsigned char* ws; };

__device__ __forceinline__ int lane_id_asm() { int l; asm volatile("v_mbcnt_lo_u32_b32 %0, -1, 0\n\tv_mbcnt_hi_u32_b32 %0, -1, %0" : "=v"(l)); return l; }
__device__ __forceinline__ float wave_sum(float v, int lane) {
#pragma unroll
    for (int o = 1; o < 64; o <<= 1) v += __builtin_bit_cast(float, __builtin_amdgcn_ds_bpermute((lane ^ o) << 2, __builtin_bit_cast(int, v)));
    return v;
}
__device__ __forceinline__ void transpose_item(const float* W, int K, int N, int src_col0, bf16* WT, int dst_row0, int k0, LAS float* scr, int lane) {
#pragma unroll 8
    for (int i = 0; i < 32; ++i) { const int kk = 2 * i + (lane >> 5); scr[kk * 33 + (lane & 31)] = W[(size_t)(k0 + kk) * N + src_col0 + (lane & 31)]; }
    LDS_WAIT(); asm volatile("" ::: "memory");
    const int c = lane & 7;
#pragma unroll
    for (int j = 0; j < 4; ++j) { const int n = (lane >> 3) + 8 * j; const LAS float* s = scr + (8 * c) * 33 + n;
        v4u o; o.x = pk2(s[0 * 33], s[1 * 33]); o.y = pk2(s[2 * 33], s[3 * 33]); o.z = pk2(s[4 * 33], s[5 * 33]); o.w = pk2(s[6 * 33], s[7 * 33]);
        *(v4u*)(WT + (size_t)(dst_row0 + n) * K + k0 + 8 * c) = o; }
    LDS_WAIT(); asm volatile("" ::: "memory");
}
__device__ __forceinline__ void transpose_item64(const float* W, int K, int N, int srcA, int srcB, bf16* WT, int dst_row0, int k0, LAS float* scr, int lane) {
    const int c4 = lane & 15, gsel = c4 >> 3, col = 4 * (c4 & 7), src = (gsel ? srcB : srcA) + col, kq = lane >> 4;
    f32x4 v[16];
#pragma unroll
    for (int i = 0; i < 16; ++i) v[i] = *(const f32x4*)(W + (size_t)(k0 + 4 * i + kq) * N + src);
#pragma unroll
    for (int i = 0; i < 16; ++i) { LAS float* d = scr + (4 * i + kq) * 65 + 32 * gsel + col; d[0] = v[i][0]; d[1] = v[i][1]; d[2] = v[i][2]; d[3] = v[i][3]; }
    LDS_WAIT(); asm volatile("" ::: "memory");
    const int c = lane & 7;
#pragma unroll
    for (int j = 0; j < 8; ++j) { const int n = (lane >> 3) + 8 * j; const LAS float* s = scr + (8 * c) * 65 + n;
        v4u o; o.x = pk2(s[0 * 65], s[1 * 65]); o.y = pk2(s[2 * 65], s[3 * 65]); o.z = pk2(s[4 * 65], s[5 * 65]); o.w = pk2(s[6 * 65], s[7 * 65]);
        *(v4u*)(WT + (size_t)(dst_row0 + n) * K + k0 + 8 * c) = o; }
    LDS_WAIT(); asm volatile("" ::: "memory");
}
__device__ __forceinline__ int win_src_col(int g) {
    const int tile = g >> 3, bj = (g >> 2) & 1, wcg = g & 3;
    if (tile < 16) return 32 * g;
    if (tile < 20) return 4096 + 256 * (tile - 16) + 64 * wcg + 32 * bj;
    return wcg < 2 ? 5120 + 64 * wcg + 32 * bj : 5248 + 32 * (wcg - 2) + 64 * bj;
}
__device__ __forceinline__ int wup_src_col(int g) { const int tile = g >> 3, bj = (g >> 2) & 1, wcg = g & 3; return (bj ? DFF : 0) + 128 * tile + 32 * wcg; }

__device__ __forceinline__ void sincos_d(float angf, float& s, float& c) {
    const double a = (double)angf;
    const double k = __builtin_rint(a * 0.63661977236758134308);
    double r = __builtin_fma(-k, 1.57079632679489661923, a); r = __builtin_fma(-k, 6.123233995736766e-17, r);
    const double r2 = r * r;
    const double sp = r + r * r2 * (-1.0 / 6 + r2 * (1.0 / 120 + r2 * (-1.0 / 5040 + r2 * (1.0 / 362880 + r2 * (-1.0 / 39916800)))));
    const double cp = 1.0 + r2 * (-0.5 + r2 * (1.0 / 24 + r2 * (-1.0 / 720 + r2 * (1.0 / 40320 + r2 * (-1.0 / 3628800 + r2 * (1.0 / 479001600))))));
    const int q = ((int)k) & 3;
    const double sv = (q == 0) ? sp : (q == 1) ? cp : (q == 2) ? -sp : -cp;
    const double cv = (q == 0) ? cp : (q == 1) ? -sp : (q == 2) ? -cp : sp;
    s = (float)sv; c = (float)cv;
}

__device__ __forceinline__ void phase_prologue(const Params& P, const Ctx& cx, LAS unsigned char* lds) {
    unsigned char* ws = cx.ws; const int tid = cx.tid, lane = cx.lane, wave = cx.wave, G = cx.G;
    LAS float* scr = (LAS float*)(lds + wave * 16896);
    const int gw = cx.bid * 8 + wave, NGW = G * 8;
    constexpr int I_IN = 32 * 84, I_OUT = 32 * 32, I_UP = 32 * 176, I_G = 32 * 32, I_DN = 88 * 32, I_P = 4 * 32, I_L = I_IN + I_OUT + I_UP + I_G + I_DN + I_P;
    for (int it = gw; it < DEPTH * I_L; it += NGW) {
        const int l = it / I_L; int r = it - l * I_L;
        bf16* wl = (bf16*)(ws + WS_W + (size_t)l * WL_BYTES);
        if (r < I_IN) { const int kb = r / 84, g = r % 84; transpose_item64(P.in[3] + (size_t)l * D * INW, D, INW, win_src_col(2 * g), win_src_col(2 * g + 1), wl + WL_IN / 2, 64 * g, 64 * kb, scr, lane); continue; } r -= I_IN;
        if (r < I_OUT) { const int kb = r / 32, g = r % 32; transpose_item64(P.in[4] + (size_t)l * D * D, D, D, 64 * g, 64 * g + 32, wl + WL_OUT / 2, 64 * g, 64 * kb, scr, lane); continue; } r -= I_OUT;
        if (r < I_UP) { const int kb = r / 176, g = r % 176; transpose_item64(P.in[10] + (size_t)l * D * NUP, D, NUP, wup_src_col(2 * g), wup_src_col(2 * g + 1), wl + WL_UP / 2, 64 * g, 64 * kb, scr, lane); continue; } r -= I_UP;
        if (r < I_G) { const int kb = r / 32, g = r % 32; transpose_item64(P.in[16] + (size_t)l * D * D, D, D, 64 * g, 64 * g + 32, wl + WL_G / 2, 64 * g, 64 * kb, scr, lane); continue; } r -= I_G;
        if (r < I_DN) { const int kb = r / 32, g = r % 32; transpose_item64(P.in[13] + (size_t)l * DFF * D, DFF, D, 64 * g, 64 * g + 32, wl + WL_DOWN / 2, 64 * g, 64 * kb, scr, lane); continue; } r -= I_DN;
        { const int kb = r / 32, g = r % 32; transpose_item64(P.in[18] + (size_t)l * PLE * D, PLE, D, 64 * g, 64 * g + 32, wl + WL_P / 2, 64 * g, 64 * kb, scr, lane); }
    }
    const size_t gt = (size_t)cx.bid * 512 + tid, NT = (size_t)G * 512;
    { const float* x = P.in[0]; bf16* xb = (bf16*)(ws + WS_XB);
      for (size_t i = gt; i < (size_t)S * D / 8; i += NT) { const f32x4 a = *(const f32x4*)(x + i * 8), b = *(const f32x4*)(x + i * 8 + 4);
          v4u o; o.x = pk2(a[0], a[1]); o.y = pk2(a[2], a[3]); o.z = pk2(b[0], b[1]); o.w = pk2(b[2], b[3]); *(v4u*)(xb + i * 8) = o; } }
    { const float* p = P.in[1]; bf16* pb = (bf16*)(ws + WS_PB);
      for (size_t i = gt; i < (size_t)DEPTH * S * PLE / 8; i += NT) { const f32x4 a = *(const f32x4*)(p + i * 8), b = *(const f32x4*)(p + i * 8 + 4);
          v4u o; o.x = pk2(a[0], a[1]); o.y = pk2(a[2], a[3]); o.z = pk2(b[0], b[1]); o.w = pk2(b[2], b[3]); *(v4u*)(pb + i * 8) = o; } }
    { const int* pos = (const int*)P.in[2]; float* cosr = (float*)(ws + WS_COSR); float* sinr = (float*)(ws + WS_SINR); float* cosa = (float*)(ws + WS_COSA); float* sina = (float*)(ws + WS_SINA);
      for (size_t i = gt; i < (size_t)S * 128; i += NT) { const int t = (int)(i >> 7), f = (int)(i & 127); float s, c; sincos_d((float)pos[t] * P.invf_ret[f], s, c); cosr[i] = c; sinr[i] = s; }
      for (size_t i = gt; i < (size_t)S * 32; i += NT) { const int t = (int)(i >> 5), f = (int)(i & 31); float s, c; sincos_d((float)pos[t] * P.invf_att[f], s, c); cosa[i] = c; sina[i] = s; } }
}

template <int MT, int NT_, int KK, bool A_KFAST, bool B_NFAST, class FA, class FB, class FC>
__device__ __forceinline__ void simple_gemm(LAS unsigned char* lds, int nbatch, int tid, int G, int bid, const FA& fa, const FB& fb, const FC& fc) {
    LAS float* As = (LAS float*)lds;
    LAS float* Bs = (LAS float*)(lds + 16 * 132 * 4);
    constexpr int TM = MT / 128, TN = NT_ / 64, ITEMS_PER_B = TM * TN;
    const int tm = tid & 31, tn = tid >> 5;
    for (int item = bid; item < nbatch * ITEMS_PER_B; item += G) {
        const int b = item / ITEMS_PER_B, r = item % ITEMS_PER_B, m0 = (r / TN) * 128, n0 = (r % TN) * 64;
        float c[4][4];
#pragma unroll
        for (int i = 0; i < 4; ++i)
#pragma unroll
            for (int j = 0; j < 4; ++j) c[i][j] = 0.f;
        for (int k0 = 0; k0 < KK; k0 += 16) {
#pragma unroll
            for (int rr = 0; rr < 4; ++rr) { const int e = tid + 512 * rr; int m, k; if (A_KFAST) { k = e & 15; m = e >> 4; } else { m = e & 127; k = e >> 7; }
                As[k * 132 + m] = fa(b, m0 + m, k0 + k); }
#pragma unroll
            for (int rr = 0; rr < 2; ++rr) { const int e = tid + 512 * rr; int n, k; if (B_NFAST) { n = e & 63; k = e >> 6; } else { k = e & 15; n = e >> 4; }
                Bs[k * 68 + n] = fb(b, k0 + k, n0 + n); }
            __syncthreads();
#pragma unroll
            for (int kk = 0; kk < 16; ++kk) { const f32x4 a = *(const LAS f32x4*)(As + kk * 132 + 4 * tm), bb = *(const LAS f32x4*)(Bs + kk * 68 + 4 * tn);
#pragma unroll
                for (int i = 0; i < 4; ++i)
#pragma unroll
                    for (int j = 0; j < 4; ++j) c[i][j] += a[i] * bb[j]; }
            __syncthreads();
        }
#pragma unroll
        for (int i = 0; i < 4; ++i)
#pragma unroll
            for (int j = 0; j < 4; ++j) fc(b, m0 + 4 * tm + i, n0 + 4 * tn + j, c[i][j]);
    }
}

__device__ __forceinline__ void phase_swa(const Params& P, const Ctx& cx, int l, LAS unsigned char* lds) {
    unsigned char* ws = cx.ws; const int tid = cx.tid, G = cx.G;
    const bf16* AQ = (const bf16*)(ws + WS_AQ); const bf16* AK = (const bf16*)(ws + WS_AK); const bf16* AV = (const bf16*)(ws + WS_AV); bf16* MIX = (bf16*)(ws + WS_MIX);
    const float* sinks = P.in[7] + l * 16;
    LAS unsigned* Ks = (LAS unsigned*)lds;
    LAS unsigned* Vs = (LAS unsigned*)(lds + 256 * 33 * 4);
    for (int item = cx.bid; item < 256; item += G) {
        const int nb = item >> 1, hk = item & 1;
        __syncthreads();
        for (int e = tid; e < 256 * 32; e += 512) { const int r = e >> 5, cdw = e & 31; const int gk = nb * 128 - 128 + r;
            unsigned kv = 0u, vv = 0u; if (gk >= 0) { kv = *(const unsigned*)(AK + (size_t)gk * 128 + hk * 64 + 2 * cdw); vv = *(const unsigned*)(AV + (size_t)gk * 128 + hk * 64 + 2 * cdw); }
            Ks[r * 33 + cdw] = kv; Vs[r * 33 + cdw] = vv; }
        __syncthreads();
#pragma unroll 1
        for (int rep = 0; rep < 2; ++rep) {
            const int pair = tid + 512 * rep, i = pair & 127, g = pair >> 7, hq = hk * 8 + g; const int row = nb * 128 + i;
            float q[64], o[64];
            { const v4u* qp = (const v4u*)(AQ + (size_t)row * 1024 + hq * 64);
#pragma unroll
              for (int c8 = 0; c8 < 8; ++c8) { const v4u w = qp[c8]; q[8 * c8 + 0] = bflo(w.x); q[8 * c8 + 1] = bfhi(w.x); q[8 * c8 + 2] = bflo(w.y); q[8 * c8 + 3] = bfhi(w.y); q[8 * c8 + 4] = bflo(w.z); q[8 * c8 + 5] = bfhi(w.z); q[8 * c8 + 6] = bflo(w.w); q[8 * c8 + 7] = bfhi(w.w); } }
#pragma unroll
            for (int d = 0; d < 64; ++d) o[d] = 0.f;
            float mx = sinks[hq], den = 1.0f;
            const int jj0 = (nb == 0) ? (127 - i) : 0;
            for (int jj = jj0; jj < 128; ++jj) { const int kl = i + 1 + jj;
                float s = 0.f;
#pragma unroll
                for (int c = 0; c < 32; ++c) { const unsigned w = Ks[kl * 33 + c]; s += q[2 * c] * bflo(w) + q[2 * c + 1] * bfhi(w); }
                const float mn = fmaxf(mx, s), sc = __expf(mx - mn), p = __expf(s - mn);
                den = den * sc + p; mx = mn;
#pragma unroll
                for (int c = 0; c < 32; ++c) { const unsigned w = Vs[kl * 33 + c]; o[2 * c] = o[2 * c] * sc + p * bflo(w); o[2 * c + 1] = o[2 * c + 1] * sc + p * bfhi(w); }
            }
            const float inv = 1.0f / den;
            v4u* op = (v4u*)(MIX + (size_t)row * 2048 + 1024 + hq * 64);
#pragma unroll
            for (int c8 = 0; c8 < 8; ++c8) { v4u w; w.x = pk2(o[8 * c8] * inv, o[8 * c8 + 1] * inv); w.y = pk2(o[8 * c8 + 2] * inv, o[8 * c8 + 3] * inv); w.z = pk2(o[8 * c8 + 4] * inv, o[8 * c8 + 5] * inv); w.w = pk2(o[8 * c8 + 6] * inv, o[8 * c8 + 7] * inv); op[c8] = w; }
        }
    }
}

__device__ __forceinline__ void phase_ret_u_scores(const Params& P, const Ctx& cx, LAS unsigned char* lds) {
    unsigned char* ws = cx.ws; const int tid = cx.tid, G = cx.G;
    const bf16* Q = (const bf16*)(ws + WS_Q); const bf16* K = (const bf16*)(ws + WS_K); const bf16* V = (const bf16*)(ws + WS_V);
    float* U = (float*)(ws + WS_U); float* PS = (float*)(ws + WS_PS);
    const float lg0 = P.lg2g[0], lg1 = P.lg2g[1], lg2 = P.lg2g[2], lg3 = P.lg2g[3];
    auto lgh = [=](int h) { return h == 0 ? lg0 : h == 1 ? lg1 : h == 2 ? lg2 : lg3; };
    simple_gemm<256, 256, 128, false, true>(lds, 512, tid, G, cx.bid,
        [=](int b, int m, int k) { const int nb = b >> 2, h = b & 3; return bf1(K + (size_t)(nb * 128 + k) * 1024 + h * 256 + m) * exp2f(lgh(h) * (float)(127 - k)); },
        [=](int b, int k, int n) { const int nb = b >> 2, h = b & 3; return bf1(V + (size_t)(nb * 128 + k) * 1024 + h * 256 + n); },
        [=](int b, int m, int n, float v) { U[((size_t)b * 256 + m) * 256 + n] = v; });
    simple_gemm<128, 128, 256, true, false>(lds, 512, tid, G, cx.bid,
        [=](int b, int m, int k) { const int nb = b >> 2, h = b & 3; return bf1(Q + (size_t)(nb * 128 + m) * 1024 + h * 256 + k); },
        [=](int b, int k, int n) { const int nb = b >> 2, h = b & 3; return bf1(K + (size_t)(nb * 128 + n) * 1024 + h * 256 + k); },
        [=](int b, int m, int n, float v) { const int h = b & 3; PS[((size_t)b * 128 + m) * 128 + n] = (m >= n) ? v * exp2f(lgh(h) * (float)(m - n)) : 0.f; });
}
__device__ __forceinline__ void phase_scan(const Params& P, const Ctx& cx) {
    float* U = (float*)(cx.ws + WS_U);
    const size_t gt = (size_t)cx.bid * 512 + cx.tid, NT = (size_t)cx.G * 512;
    for (size_t idx = gt; idx < 4 * 65536; idx += NT) {
        const int h = (int)(idx >> 16); const float cd = exp2f(P.lg2g[h] * 128.0f);
        float r = 0.f;
        for (int n0 = 0; n0 < 128; n0 += 8) { float u[8];
#pragma unroll
            for (int j = 0; j < 8; ++j) u[j] = U[(size_t)(n0 + j) * 262144 + idx];
#pragma unroll
            for (int j = 0; j < 8; ++j) { U[(size_t)(n0 + j) * 262144 + idx] = r; r = r * cd + u[j]; } }
    }
}
__device__ __forceinline__ void phase_ret_out(const Params& P, const Ctx& cx, LAS unsigned char* lds) {
    unsigned char* ws = cx.ws; const int tid = cx.tid, G = cx.G;
    const bf16* Q = (const bf16*)(ws + WS_Q); const bf16* V = (const bf16*)(ws + WS_V);
    const float* Sst = (const float*)(ws + WS_U); const float* PS = (const float*)(ws + WS_PS); float* RY = (float*)(ws + WS_RETY);
    const float lg0 = P.lg2g[0], lg1 = P.lg2g[1], lg2 = P.lg2g[2], lg3 = P.lg2g[3];
    auto lgh = [=](int h) { return h == 0 ? lg0 : h == 1 ? lg1 : h == 2 ? lg2 : lg3; };
    simple_gemm<128, 256, 384, true, true>(lds, 512, tid, G, cx.bid,
        [=](int b, int m, int k) { const int nb = b >> 2, h = b & 3; return k < 128 ? PS[((size_t)b * 128 + m) * 128 + k] : bf1(Q + (size_t)(nb * 128 + m) * 1024 + h * 256 + (k - 128)) * exp2f(lgh(h) * (float)(m + 1)); },
        [=](int b, int k, int n) { const int nb = b >> 2, h = b & 3; return k < 128 ? bf1(V + (size_t)(nb * 128 + k) * 1024 + h * 256 + n) : Sst[((size_t)b * 256 + (k - 128)) * 256 + n]; },
        [=](int b, int m, int n, float v) { const int nb = b >> 2, h = b & 3; RY[(size_t)(nb * 128 + m) * 1024 + h * 256 + n] = v; });
}

typedef short bf16x8 __attribute__((ext_vector_type(8)));
typedef short s16x4 __attribute__((ext_vector_type(4)));
typedef short v4i16_t __attribute__((ext_vector_type(4)));
__device__ __forceinline__ f32x4 mfma16(bf16x8 a, bf16x8 b, f32x4 c) { return __builtin_amdgcn_mfma_f32_16x16x32_bf16(a, b, c, 0, 0, 0); }
__device__ __forceinline__ s16x4 lds_tr(LAS unsigned char* p) { return __builtin_bit_cast(s16x4, __builtin_amdgcn_ds_read_tr16_b64_v4i16((LAS v4i16_t*)p)); }
__device__ __forceinline__ bf16x8 cat44(s16x4 a, s16x4 b) { bf16x8 r; r[0] = a[0]; r[1] = a[1]; r[2] = a[2]; r[3] = a[3]; r[4] = b[0]; r[5] = b[1]; r[6] = b[2]; r[7] = b[3]; return r; }
__device__ __forceinline__ unsigned cvt2(float lo, float hi) { return pg8::cvt_pk_bf16(lo, hi); }
__device__ __forceinline__ bf16x8 pack_frag(const f32x4 a, const f32x4 b) { v4u w; w.x = cvt2(a[0], a[1]); w.y = cvt2(a[2], a[3]); w.z = cvt2(b[0], b[1]); w.w = cvt2(b[2], b[3]); return __builtin_bit_cast(bf16x8, w); }
__device__ __forceinline__ float grp16_sum(float v, int lane) {
#pragma unroll
    for (int o = 1; o < 16; o <<= 1) v += __builtin_bit_cast(float, __builtin_amdgcn_ds_bpermute((lane ^ o) << 2, __builtin_bit_cast(int, v)));
    return v;
}
constexpr int RS_T = 544;
constexpr int TILE_T = 128 * RS_T;
static_assert(2 * TILE_T <= LDSCTL_OFF, "retention tiles vs LDS control words");

template <bool DECAY> __device__ __forceinline__ void stage_tile(LAS unsigned char* img, const bf16* src, int tid, float lg) {
    v4u v[8];
#pragma unroll
    for (int r = 0; r < 8; ++r) { const int pc = tid + 512 * r, row = pc >> 5, c16 = pc & 31; v[r] = *(const v4u*)(src + (size_t)row * 1024 + c16 * 8); }
#pragma unroll
    for (int r = 0; r < 8; ++r) { const int pc = tid + 512 * r, row = pc >> 5, c16 = pc & 31; v4u w = v[r];
        if (DECAY) { const float sc = exp2f(lg * (float)(127 - row));
            w.x = cvt2(bflo(w.x) * sc, bfhi(w.x) * sc); w.y = cvt2(bflo(w.y) * sc, bfhi(w.y) * sc); w.z = cvt2(bflo(w.z) * sc, bfhi(w.z) * sc); w.w = cvt2(bflo(w.w) * sc, bfhi(w.w) * sc); }
        *(LAS v4u*)(img + row * RS_T + c16 * 16) = w; }
}

__device__ __forceinline__ void phase_ret_u_mfma(const Params& P, const Ctx& cx, LAS unsigned char* lds) {
    unsigned char* ws = cx.ws; const int tid = cx.tid, lane = cx.lane, w = cx.wave, r16 = lane & 15, g = lane >> 4, q = r16 >> 2, pp = r16 & 3;
    const bf16* K = (const bf16*)(ws + WS_K); const bf16* V = (const bf16*)(ws + WS_V); bf16* UT = (bf16*)(ws + WS_U);
    LAS unsigned char* Kim = lds; LAS unsigned char* Vim = lds + TILE_T;
    for (int b = cx.bid; b < 512; b += cx.G) {
        const int nb = b >> 2, h = b & 3;
        __syncthreads();
        stage_tile<true>(Kim, K + (size_t)nb * 128 * 1024 + h * 256, tid, P.lg2g[h]);
        stage_tile<false>(Vim, V + (size_t)nb * 128 * 1024 + h * 256, tid, 0.f);
        __syncthreads();
        f32x4 acc[2][16];
#pragma unroll
        for (int mi = 0; mi < 2; ++mi)
#pragma unroll
            for (int n = 0; n < 16; ++n) acc[mi][n] = (f32x4){0.f, 0.f, 0.f, 0.f};
#pragma unroll 1
        for (int s = 0; s < 4; ++s) {
            bf16x8 af[2];
#pragma unroll
            for (int mi = 0; mi < 2; ++mi) { LAS unsigned char* a0 = Kim + (32 * s + 8 * g + q) * RS_T + (16 * (2 * w + mi) + 4 * pp) * 2; af[mi] = cat44(lds_tr(a0), lds_tr(a0 + 4 * RS_T)); }
#pragma unroll
            for (int n = 0; n < 16; ++n) { LAS unsigned char* b0 = Vim + (32 * s + 8 * g + q) * RS_T + (16 * n + 4 * pp) * 2; const bf16x8 bfr = cat44(lds_tr(b0), lds_tr(b0 + 4 * RS_T));
                acc[0][n] = mfma16(af[0], bfr, acc[0][n]); acc[1][n] = mfma16(af[1], bfr, acc[1][n]); }
        }
#pragma unroll
        for (int mi = 0; mi < 2; ++mi)
#pragma unroll
            for (int n = 0; n < 16; ++n) { v2u o; o.x = cvt2(acc[mi][n][0], acc[mi][n][1]); o.y = cvt2(acc[mi][n][2], acc[mi][n][3]);
                *(v2u*)(UT + ((size_t)b * 256 + 16 * n + r16) * 256 + 16 * (2 * w + mi) + 4 * g) = o; }
    }
}
__device__ __forceinline__ void phase_scan_bf16(const Params& P, const Ctx& cx) {
    unsigned* UT = (unsigned*)(cx.ws + WS_U);
    const size_t gt = (size_t)cx.bid * 512 + cx.tid, NT = (size_t)cx.G * 512;
    for (size_t idx = gt; idx < 131072; idx += NT) {
        const int h = (int)(idx >> 15); const float cd = exp2f(P.lg2g[h] * 128.0f);
        float r0 = 0.f, r1 = 0.f;
        for (int n0 = 0; n0 < 128; n0 += 8) { unsigned u[8];
#pragma unroll
            for (int j = 0; j < 8; ++j) u[j] = UT[(size_t)(n0 + j) * 131072 + idx];
#pragma unroll
            for (int j = 0; j < 8; ++j) { UT[(size_t)(n0 + j) * 131072 + idx] = cvt2(r0, r1); r0 = r0 * cd + bflo(u[j]); r1 = r1 * cd + bfhi(u[j]); } }
    }
}
__device__ __forceinline__ void phase_ret_out_mfma(const Params& P, const Ctx& cx, int l, LAS unsigned char* lds) {
    unsigned char* ws = cx.ws; const int tid = cx.tid, lane = cx.lane, w = cx.wave, r16 = lane & 15, g = lane >> 4, q = r16 >> 2, pp = r16 & 3;
    const bf16* Q = (const bf16*)(ws + WS_Q); const bf16* K = (const bf16*)(ws + WS_K); const bf16* V = (const bf16*)(ws + WS_V); const bf16* ST = (const bf16*)(ws + WS_U);
    const bf16* Gt = (const bf16*)(ws + WS_G); bf16* MIX = (bf16*)(ws + WS_MIX);
    const float* gg = P.in[5] + l * 1024; const float* gb = P.in[6] + l * 1024;
    LAS unsigned char* Kim = lds; LAS unsigned char* Vim = lds + TILE_T;
    for (int b = cx.bid; b < 512; b += cx.G) {
        const int nb = b >> 2, h = b & 3; const float lg = P.lg2g[h];
        __syncthreads();
        stage_tile<false>(Kim, K + (size_t)nb * 128 * 1024 + h * 256, tid, 0.f);
        stage_tile<false>(Vim, V + (size_t)nb * 128 * 1024 + h * 256, tid, 0.f);
        bf16x8 qf[8];
        { const bf16* qrow = Q + (size_t)(nb * 128 + 16 * w + r16) * 1024 + h * 256 + 8 * g;
#pragma unroll
          for (int s = 0; s < 8; ++s) qf[s] = *(const bf16x8*)(qrow + 32 * s); }
        f32x4 acc[16];
        const bf16* strow = ST + ((size_t)b * 256 + r16) * 256 + 8 * g;
#pragma unroll
        for (int n = 0; n < 16; ++n) { bf16x8 sb[8];
#pragma unroll
            for (int s = 0; s < 8; ++s) sb[s] = *(const bf16x8*)(strow + (size_t)n * 16 * 256 + 32 * s);
            f32x4 a = (f32x4){0.f, 0.f, 0.f, 0.f};
#pragma unroll
            for (int s = 0; s < 8; ++s) a = mfma16(qf[s], sb[s], a);
            acc[n] = a; }
        { float f[4];
#pragma unroll
          for (int r = 0; r < 4; ++r) f[r] = exp2f(lg * (float)(16 * w + 4 * g + r + 1));
#pragma unroll
          for (int n = 0; n < 16; ++n) { acc[n][0] *= f[0]; acc[n][1] *= f[1]; acc[n][2] *= f[2]; acc[n][3] *= f[3]; } }
        __syncthreads();
        f32x4 sc[8];
#pragma unroll
        for (int mb = 0; mb < 8; ++mb) { sc[mb] = (f32x4){0.f, 0.f, 0.f, 0.f};
            if (mb <= w) { f32x4 a = (f32x4){0.f, 0.f, 0.f, 0.f};
#pragma unroll
                for (int s = 0; s < 8; ++s) { const bf16x8 kf = *(const LAS bf16x8*)(Kim + (16 * mb + r16) * RS_T + (32 * s + 8 * g) * 2); a = mfma16(kf, qf[s], a); }
                const int i = 16 * w + r16;
#pragma unroll
                for (int r = 0; r < 4; ++r) { const int j = 16 * mb + 4 * g + r; a[r] = (i >= j) ? a[r] * exp2f(lg * (float)(i - j)) : 0.f; }
                sc[mb] = a; } }
#pragma unroll
        for (int sk = 0; sk < 4; ++sk) {
            if (2 * sk <= w) { const bf16x8 pf = pack_frag(sc[2 * sk], sc[2 * sk + 1]);
#pragma unroll
                for (int n = 0; n < 16; ++n) { LAS unsigned char* b0 = Vim + (32 * sk + 4 * g + q) * RS_T + (16 * n + 4 * pp) * 2; const bf16x8 bfr = cat44(lds_tr(b0), lds_tr(b0 + 16 * RS_T));
                    acc[n] = mfma16(pf, bfr, acc[n]); } } }
        float mean[4], rstd[4];
#pragma unroll
        for (int r = 0; r < 4; ++r) { float sm = 0.f;
#pragma unroll
            for (int n = 0; n < 16; ++n) sm += acc[n][r];
            mean[r] = grp16_sum(sm, lane) * (1.0f / 256.0f); }
#pragma unroll
        for (int r = 0; r < 4; ++r) { float sq = 0.f;
#pragma unroll
            for (int n = 0; n < 16; ++n) { const float d = acc[n][r] - mean[r]; sq += d * d; }
            rstd[r] = 1.0f / sqrtf(grp16_sum(sq, lane) * (1.0f / 256.0f) + GN_EPS); }
#pragma unroll
        for (int n = 0; n < 16; ++n) { const int e = h * 256 + 16 * n + r16; const float g1 = gg[e], b1 = gb[e];
#pragma unroll
            for (int r = 0; r < 4; ++r) { const size_t row = (size_t)(nb * 128 + 16 * w + 4 * g + r);
                const float o = ((acc[n][r] - mean[r]) * rstd[r] * g1 + b1) * bf1(Gt + row * 1024 + e);
                MIX[row * 2048 + e] = (bf16)f2bf(o); } }
    }
}
constexpr int RS_SK = 144, RS_SV = 160;
__device__ __forceinline__ void phase_swa_mfma(const Params& P, const Ctx& cx, int l, LAS unsigned char* lds) {
    unsigned char* ws = cx.ws; const int tid = cx.tid, lane = cx.lane, w = cx.wave, r16 = lane & 15, g = lane >> 4, q = r16 >> 2, pp = r16 & 3;
    const bf16* AQ = (const bf16*)(ws + WS_AQ); const bf16* AK = (const bf16*)(ws + WS_AK); const bf16* AV = (const bf16*)(ws + WS_AV); bf16* MIX = (bf16*)(ws + WS_MIX);
    LAS unsigned char* Kim = lds; LAS unsigned char* Vim = lds + 256 * RS_SK;
    for (int item = cx.bid; item < 256; item += cx.G) {
        const int nb = item >> 1, hk = item & 1, hq = hk * 8 + w; const float sink = P.in[7][l * 16 + hq];
        __syncthreads();
#pragma unroll
        for (int r = 0; r < 4; ++r) { const int pc = tid + 512 * r, row = pc >> 3, c = pc & 7, gk = nb * 128 - 128 + row;
            v4u kv = (v4u){0u, 0u, 0u, 0u}, vv = (v4u){0u, 0u, 0u, 0u};
            if (gk >= 0) { kv = *(const v4u*)(AK + (size_t)gk * 128 + hk * 64 + c * 8); vv = *(const v4u*)(AV + (size_t)gk * 128 + hk * 64 + c * 8); }
            *(LAS v4u*)(Kim + row * RS_SK + c * 16) = kv; *(LAS v4u*)(Vim + row * RS_SV + c * 16) = vv; }
        __syncthreads();
#pragma unroll 1
        for (int nq = 0; nq < 8; ++nq) {
            const bf16* qrow = AQ + (size_t)(nb * 128 + 16 * nq + r16) * 1024 + hq * 64 + 8 * g;
            const bf16x8 qf0 = *(const bf16x8*)(qrow), qf1 = *(const bf16x8*)(qrow + 32);
            f32x4 sc[10];
            float mx = sink;
#pragma unroll
            for (int kb = 0; kb < 9; ++kb) { const LAS unsigned char* kp = Kim + (16 * (nq + kb) + r16) * RS_SK + 16 * g;
                f32x4 a = (f32x4){0.f, 0.f, 0.f, 0.f};
                a = mfma16(*(const LAS bf16x8*)(kp), qf0, a); a = mfma16(*(const LAS bf16x8*)(kp + 64), qf1, a);
#pragma unroll
                for (int r = 0; r < 4; ++r) { const int dl = 16 * kb + 4 * g + r - r16; const bool vis = (dl >= 1) && (dl <= 128) && (nb > 0 || 16 * (nq + kb) + 4 * g + r >= 128);
                    a[r] = vis ? a[r] : -INFINITY; mx = fmaxf(mx, a[r]); }
                sc[kb] = a; }
            sc[9] = (f32x4){0.f, 0.f, 0.f, 0.f};
            mx = fmaxf(mx, __builtin_bit_cast(float, __builtin_amdgcn_ds_bpermute((lane ^ 16) << 2, __builtin_bit_cast(int, mx))));
            mx = fmaxf(mx, __builtin_bit_cast(float, __builtin_amdgcn_ds_bpermute((lane ^ 32) << 2, __builtin_bit_cast(int, mx))));
            float sum = 0.f;
#pragma unroll
            for (int kb = 0; kb < 9; ++kb)
#pragma unroll
                for (int r = 0; r < 4; ++r) { const float pv = __expf(sc[kb][r] - mx); sc[kb][r] = pv; sum += pv; }
            sum += __builtin_bit_cast(float, __builtin_amdgcn_ds_bpermute((lane ^ 16) << 2, __builtin_bit_cast(int, sum)));
            sum += __builtin_bit_cast(float, __builtin_amdgcn_ds_bpermute((lane ^ 32) << 2, __builtin_bit_cast(int, sum)));
            const float inv = 1.0f / (sum + __expf(sink - mx));
            f32x4 o[4];
#pragma unroll
            for (int nd = 0; nd < 4; ++nd) o[nd] = (f32x4){0.f, 0.f, 0.f, 0.f};
#pragma unroll
            for (int sk = 0; sk < 5; ++sk) { const bf16x8 pf = pack_frag(sc[2 * sk] * inv, sc[2 * sk + 1] * inv);
                const int kb0 = nq + 2 * sk, kb1 = (kb0 + 1 > 15) ? 15 : kb0 + 1;
#pragma unroll
                for (int nd = 0; nd < 4; ++nd) { const bf16x8 bfr = cat44(lds_tr(Vim + (16 * kb0 + 4 * g + q) * RS_SV + (16 * nd + 4 * pp) * 2), lds_tr(Vim + (16 * kb1 + 4 * g + q) * RS_SV + (16 * nd + 4 * pp) * 2));
                    o[nd] = mfma16(pf, bfr, o[nd]); } }
#pragma unroll
            for (int nd = 0; nd < 4; ++nd)
#pragma unroll
                for (int r = 0; r < 4; ++r) MIX[(size_t)(nb * 128 + 16 * nq + 4 * g + r) * 2048 + 1024 + hq * 64 + 16 * nd + r16] = (bf16)f2bf(o[nd][r]);
        }
    }
}

__device__ __forceinline__ void phase_groupnorm(const Params& P, const Ctx& cx, int l) {
    unsigned char* ws = cx.ws; const int lane = cx.lane, wave = cx.wave, G = cx.G;
    const float* RY = (const float*)(ws + WS_RETY); const bf16* Gt = (const bf16*)(ws + WS_G); bf16* MIX = (bf16*)(ws + WS_MIX);
    const float* gg = P.in[5] + l * 1024; const float* gb = P.in[6] + l * 1024;
    const int gw = cx.bid * 8 + wave, NGW = G * 8;
    for (int it = gw; it < S * 4; it += NGW) { const int row = it >> 2, h = it & 3; const size_t off = (size_t)row * 1024 + h * 256 + 4 * lane;
        f32x4 v = *(const f32x4*)(RY + off);
        const float mean = wave_sum((v[0] + v[1]) + (v[2] + v[3]), lane) * (1.0f / 256.0f);
        v = v - mean;
        const float var = wave_sum((v[0] * v[0] + v[1] * v[1]) + (v[2] * v[2] + v[3] * v[3]), lane) * (1.0f / 256.0f);
        const float rstd = 1.0f / sqrtf(var + GN_EPS);
        const f32x4 g4 = *(const f32x4*)(gg + h * 256 + 4 * lane), b4 = *(const f32x4*)(gb + h * 256 + 4 * lane);
        const v2u gt2 = *(const v2u*)(Gt + off);
        f32x4 o = v * rstd * g4 + b4;
        o[0] *= bflo(gt2.x); o[1] *= bfhi(gt2.x); o[2] *= bflo(gt2.y); o[3] *= bfhi(gt2.y);
        v2u w; w.x = pk2(o[0], o[1]); w.y = pk2(o[2], o[3]);
        *(v2u*)(MIX + (size_t)row * 2048 + h * 256 + 4 * lane) = w; }
}
__device__ __forceinline__ void phase_ln(const Ctx& cx, const float* Y, const float* g, const float* b, float* xo, bf16* xb) {
    const int lane = cx.lane, wave = cx.wave, G = cx.G; const int gw = cx.bid * 8 + wave, NGW = G * 8;
    f32x4 g4[8], b4[8];
#pragma unroll
    for (int j = 0; j < 8; ++j) { g4[j] = ((const f32x4*)g)[64 * j + lane]; b4[j] = ((const f32x4*)b)[64 * j + lane]; }
    for (int row = gw; row < S; row += 2 * NGW) {
        const int row2 = row + NGW; const bool has2 = row2 < S; const int rb = has2 ? row2 : row;
        const f32x4* ya = (const f32x4*)(Y + (size_t)row * D) + lane; const f32x4* yb = (const f32x4*)(Y + (size_t)rb * D) + lane;
        f32x4 va[8], vb[8]; float sa = 0.f, sb = 0.f;
#pragma unroll
        for (int j = 0; j < 8; ++j) { va[j] = ya[64 * j]; vb[j] = yb[64 * j]; }
#pragma unroll
        for (int j = 0; j < 8; ++j) { sa += (va[j][0] + va[j][1]) + (va[j][2] + va[j][3]); sb += (vb[j][0] + vb[j][1]) + (vb[j][2] + vb[j][3]); }
        const float ma = wave_sum(sa, lane) * (1.0f / D), mb = wave_sum(sb, lane) * (1.0f / D); float qa = 0.f, qb = 0.f;
#pragma unroll
        for (int j = 0; j < 8; ++j) { va[j] = va[j] - ma; vb[j] = vb[j] - mb; qa += (va[j][0] * va[j][0] + va[j][1] * va[j][1]) + (va[j][2] * va[j][2] + va[j][3] * va[j][3]); qb += (vb[j][0] * vb[j][0] + vb[j][1] * vb[j][1]) + (vb[j][2] * vb[j][2] + vb[j][3] * vb[j][3]); }
        const float ra = 1.0f / sqrtf(wave_sum(qa, lane) * (1.0f / D) + LN_EPS), rbb = 1.0f / sqrtf(wave_sum(qb, lane) * (1.0f / D) + LN_EPS);
        f32x4* xa = (f32x4*)(xo + (size_t)row * D) + lane; f32x4* xbp = (f32x4*)(xo + (size_t)rb * D) + lane;
#pragma unroll
        for (int j = 0; j < 8; ++j) { const f32x4 o = va[j] * ra * g4[j] + b4[j]; xa[64 * j] = o;
            if (xb) { v2u w; w.x = pk2(o[0], o[1]); w.y = pk2(o[2], o[3]); ((v2u*)(xb + (size_t)row * D))[64 * j + lane] = w; } }
        if (has2) {
#pragma unroll
            for (int j = 0; j < 8; ++j) { const f32x4 o = vb[j] * rbb * g4[j] + b4[j]; xbp[64 * j] = o;
                if (xb) { v2u w; w.x = pk2(o[0], o[1]); w.y = pk2(o[2], o[3]); ((v2u*)(xb + (size_t)rb * D))[64 * j + lane] = w; } } }
    }
}
__device__ __forceinline__ void unpack8(const v4u h, float (&o)[8]) { o[0] = bflo(h.x); o[1] = bfhi(h.x); o[2] = bflo(h.y); o[3] = bfhi(h.y); o[4] = bflo(h.z); o[5] = bfhi(h.z); o[6] = bflo(h.w); o[7] = bfhi(h.w); }
__device__ __forceinline__ void phase_convact(const Params& P, const Ctx& cx, int l) {
    unsigned char* ws = cx.ws; const int tid = cx.tid, G = cx.G;
    const bf16* H = (const bf16*)(ws + WS_H); bf16* ACT = (bf16*)(ws + WS_ACT);
    const float* cw = P.in[11] + (size_t)l * 3 * NUP; const float* cb = P.in[12] + (size_t)l * NUP;
    const int gt = cx.bid * 512 + tid, NT = G * 512;
    for (int item = gt; item < 512 * 704; item += NT) {
        const int seg = item / 704, r = item - seg * 704, tile = r >> 4, q8 = r & 15, t0 = seg * 32;
        const int chg = 128 * tile + 8 * q8, chu = DFF + chg;
        float wg[3][8], wu[3][8], bg[8], bu[8];
#pragma unroll
        for (int k = 0; k < 3; ++k) { const f32x4 a0 = *(const f32x4*)(cw + (size_t)k * NUP + chg), a1 = *(const f32x4*)(cw + (size_t)k * NUP + chg + 4), c0 = *(const f32x4*)(cw + (size_t)k * NUP + chu), c1 = *(const f32x4*)(cw + (size_t)k * NUP + chu + 4);
#pragma unroll
            for (int e = 0; e < 4; ++e) { wg[k][e] = a0[e]; wg[k][4 + e] = a1[e]; wu[k][e] = c0[e]; wu[k][4 + e] = c1[e]; } }
        { const f32x4 a0 = *(const f32x4*)(cb + chg), a1 = *(const f32x4*)(cb + chg + 4), c0 = *(const f32x4*)(cb + chu), c1 = *(const f32x4*)(cb + chu + 4);
#pragma unroll
          for (int e = 0; e < 4; ++e) { bg[e] = a0[e]; bg[4 + e] = a1[e]; bu[e] = c0[e]; bu[4 + e] = c1[e]; } }
        const bf16* hp = H + (size_t)t0 * NUP + 256 * tile + 8 * q8;
        float g2[8], g1[8], u2[8], u1[8];
        if (t0 > 0) { unpack8(*(const v4u*)(hp - 2 * (size_t)NUP), g2); unpack8(*(const v4u*)(hp - (size_t)NUP), g1); unpack8(*(const v4u*)(hp - 2 * (size_t)NUP + 128), u2); unpack8(*(const v4u*)(hp - (size_t)NUP + 128), u1); }
        else {
#pragma unroll
            for (int e = 0; e < 8; ++e) { g2[e] = 0.f; g1[e] = 0.f; u2[e] = 0.f; u1[e] = 0.f; } }
        bf16* ap = ACT + (size_t)t0 * DFF + chg;
        v4u ng = *(const v4u*)(hp), nu = *(const v4u*)(hp + 128);
#pragma unroll 2
        for (int tt = 0; tt < 32; ++tt) {
            float g0[8], u0[8]; unpack8(ng, g0); unpack8(nu, u0);
            if (tt < 31) { ng = *(const v4u*)(hp + (size_t)(tt + 1) * NUP); nu = *(const v4u*)(hp + (size_t)(tt + 1) * NUP + 128); }
            float o[8];
#pragma unroll
            for (int e = 0; e < 8; ++e) { const float ga = bg[e] + wg[0][e] * g2[e] + wg[1][e] * g1[e] + wg[2][e] * g0[e], ua = bu[e] + wu[0][e] * u2[e] + wu[1][e] * u1[e] + wu[2][e] * u0[e];
                o[e] = ga * __builtin_amdgcn_rcpf(1.0f + __expf(-ga)) * ua; g2[e] = g1[e]; g1[e] = g0[e]; u2[e] = u1[e]; u1[e] = u0[e]; }
            v4u w; w.x = cvt2(o[0], o[1]); w.y = cvt2(o[2], o[3]); w.z = cvt2(o[4], o[5]); w.w = cvt2(o[6], o[7]);
            *(v4u*)(ap + (size_t)tt * DFF) = w;
        }
    }
}

__device__ __forceinline__ void phase_conv_fixup(const Params& P, const Ctx& cx, int l) {
    unsigned char* ws = cx.ws;
    const bf16* HALO = (const bf16*)(ws + WS_H); bf16* ACT = (bf16*)(ws + WS_ACT);
    const float* cw = P.in[11] + (size_t)l * 3 * NUP; const float* cb = P.in[12] + (size_t)l * NUP;
    const int gt = cx.bid * 512 + cx.tid, NT = cx.G * 512;
    for (int item = gt; item < 256 * 704; item += NT) {
        const int k = item / 704, r = item - k * 704, tile = r >> 4, q8 = r & 15, chg = 128 * tile + 8 * q8, chu = DFF + chg;
        float a_g[8], b_g[8], c_g[8], d_g[8], a_u[8], b_u[8], c_u[8], d_u[8];
        const bf16* hk = HALO + (size_t)k * 4 * NUP + 256 * tile + 8 * q8;
        unpack8(*(const v4u*)(hk), c_g); unpack8(*(const v4u*)(hk + NUP), d_g); unpack8(*(const v4u*)(hk + 128), c_u); unpack8(*(const v4u*)(hk + NUP + 128), d_u);
        if (k > 0) { const bf16* hm = hk - 4 * (size_t)NUP; unpack8(*(const v4u*)(hm + 2 * NUP), a_g); unpack8(*(const v4u*)(hm + 3 * NUP), b_g); unpack8(*(const v4u*)(hm + 2 * NUP + 128), a_u); unpack8(*(const v4u*)(hm + 3 * NUP + 128), b_u); }
        else {
#pragma unroll
            for (int e = 0; e < 8; ++e) { a_g[e] = 0.f; b_g[e] = 0.f; a_u[e] = 0.f; b_u[e] = 0.f; } }
        float o0[8], o1[8];
#pragma unroll
        for (int e = 0; e < 8; ++e) { const float w0g = cw[chg + e], w1g = cw[NUP + chg + e], w2g = cw[2 * NUP + chg + e], bgv = cb[chg + e], w0u = cw[chu + e], w1u = cw[NUP + chu + e], w2u = cw[2 * NUP + chu + e], buv = cb[chu + e];
            const float g0 = bgv + w0g * a_g[e] + w1g * b_g[e] + w2g * c_g[e], u0 = buv + w0u * a_u[e] + w1u * b_u[e] + w2u * c_u[e];
            const float g1 = bgv + w0g * b_g[e] + w1g * c_g[e] + w2g * d_g[e], u1 = buv + w0u * b_u[e] + w1u * c_u[e] + w2u * d_u[e];
            o0[e] = g0 * __builtin_amdgcn_rcpf(1.0f + __expf(-g0)) * u0; o1[e] = g1 * __builtin_amdgcn_rcpf(1.0f + __expf(-g1)) * u1; }
        v4u w0, w1; w0.x = cvt2(o0[0], o0[1]); w0.y = cvt2(o0[2], o0[3]); w0.z = cvt2(o0[4], o0[5]); w0.w = cvt2(o0[6], o0[7]); w1.x = cvt2(o1[0], o1[1]); w1.y = cvt2(o1[2], o1[3]); w1.z = cvt2(o1[4], o1[5]); w1.w = cvt2(o1[6], o1[7]);
        *(v4u*)(ACT + (size_t)(64 * k) * DFF + chg) = w0; *(v4u*)(ACT + (size_t)(64 * k + 1) * DFF + chg) = w1;
    }
}

#ifdef DBG_DUMP
__device__ __forceinline__ void phase_dump(const Ctx& cx, float* out, const bf16* a, int lda, const bf16* b, int ldb, const float* f) {
    const size_t gt = (size_t)cx.bid * 512 + cx.tid, NT = (size_t)cx.G * 512;
    for (size_t i = gt; i < (size_t)S * D; i += NT) { const int row = (int)(i >> 11), col = (int)(i & 2047);
        float v; if (f) v = f[i]; else if (b && col >= 1024) v = bf1(b + (size_t)row * ldb + (col - 1024)); else v = lda ? bf1(a + (size_t)row * lda + col) : bf1(a + (size_t)(row & 2047) * 2048 + col);
        out[i] = v; }
}
#endif
__global__ void __launch_bounds__(512, 2) fwd(Params P) {
    extern __shared__ __attribute__((aligned(16))) unsigned char lds_raw[];
    LAS unsigned char* lds = (LAS unsigned char*)lds_raw;
    const int wave = __builtin_amdgcn_readfirstlane(threadIdx.x >> 6), G = gridDim.x;
    unsigned char* ws = P.ws;
    volatile LAS unsigned* MISC = (volatile LAS unsigned*)(lds + MISC_OFF);
    for (int u = threadIdx.x; u < (LDS_BYTES - LDSCTL_OFF) / 4; u += 512) ((LAS unsigned*)(lds + LDSCTL_OFF))[u] = 0u;
    __syncthreads();
    const int lo = P.ph_lo, hi = P.ph_hi;
    XcdBarrier bar; bar.bar = (unsigned*)(ws + WS_CTL) + CW_BAR; bar.x = 0; bar.st = nullptr;
    if (hi - lo > 1) bar = xcd_barrier_post((unsigned*)(ws + WS_CTL) + CW_BAR, MISC + 8);
#define IN(k) (lo <= (k) && (k) < hi)
#define SEAM(k) do { if (IN(k) && IN((k) + 1)) xcd_barrier(bar); } while (0)
#define OPQ() Ctx cx; cx.lane = lane_id_asm(); { int t_ = wave; asm volatile("" : "+s"(t_)); cx.wave = t_; } { int t_ = G; asm volatile("" : "+s"(t_)); cx.G = t_; } { int t_ = blockIdx.x; asm volatile("" : "+s"(t_)); cx.bid = t_; } \
    { unsigned t_ = 0u; asm volatile("" : "+s"(t_)); cx.ws = P.ws + t_; } cx.tid = cx.wave * 64 + cx.lane; int lq = l; asm volatile("" : "+s"(lq)); (void)lq

#ifdef DBG_DUMP
    if (lo >= 1000) { const int l = 0; OPQ(); unsigned char* w = cx.ws; const int kind = lo - 1000;
        if (kind == 1) phase_dump(cx, P.out, (const bf16*)(w + WS_Q), 1024, (const bf16*)(w + WS_AQ), 1024, nullptr);
        else if (kind == 2) phase_dump(cx, P.out, (const bf16*)(w + WS_MIX), 2048, nullptr, 0, nullptr);
        else if (kind == 3) phase_dump(cx, P.out, nullptr, 0, nullptr, 0, (const float*)(w + WS_XR));
        else if (kind == 4) phase_dump(cx, P.out, (const bf16*)(w + WS_ACT), DFF, nullptr, 0, nullptr);
        else if (kind == 5) phase_dump(cx, P.out, nullptr, 0, nullptr, 0, (const float*)(w + WS_Y));
        else if (kind == 6) phase_dump(cx, P.out, (const bf16*)(w + WS_K), 1024, (const bf16*)(w + WS_V), 1024, nullptr);
        else if (kind == 7) phase_dump(cx, P.out, (const bf16*)(w + WS_XB), 2048, nullptr, 0, nullptr);
        else if (kind == 11) phase_dump(cx, P.out, (const bf16*)(w + WS_W + WL_G), 0, nullptr, 0, nullptr);
        else if (kind == 12) phase_dump(cx, P.out, (const bf16*)(w + WS_W + WL_OUT), 0, nullptr, 0, nullptr);
        else if (kind == 10) phase_dump(cx, P.out, (const bf16*)(w + WS_H) + 36 * 256, NUP, nullptr, 0, nullptr);
        else if (kind == 9) phase_dump(cx, P.out, (const bf16*)(w + WS_SG), 2048, nullptr, 0, nullptr);
        else if (kind == 8) phase_dump(cx, P.out, nullptr, 0, nullptr, 0, (const float*)(w + WS_RETY));
        return; }
#endif
    if (IN(0)) { const int l = 0; REPS(2) { __syncthreads(); OPQ(); phase_prologue(P, cx, lds); } }
    SEAM(0);

    for (int l = 0; l < DEPTH; ++l) {
        const int pb = 1 + l * NPH;
        if (IN(pb + 0)) { OPQ(); unsigned char* w = cx.ws; const bf16* wl = (const bf16*)(w + WS_W + (size_t)lq * WL_BYTES);
            pg8::Gemm g{(const bf16*)(w + WS_XB), wl + WL_IN / 2, S, INW, D}; pg8::StaticOrder So; So.init(S, INW, cx.G, cx.bid);
            pg8::EpiInProj E{(bf16*)(w + WS_Q), (bf16*)(w + WS_K), (bf16*)(w + WS_V), (bf16*)(w + WS_G), (bf16*)(w + WS_AQ), (bf16*)(w + WS_AK), (bf16*)(w + WS_AV),
                             (const float*)(w + WS_COSR), (const float*)(w + WS_SINR), (const float*)(w + WS_COSA), (const float*)(w + WS_SINA)};
            pg8::gemm_phase<pg8::EpiInProj, pg8::StaticOrder, true, true>(lds, g, So, E, cx.wave);
        }
#if PLE_EARLY
        if (IN(pb + 0)) { OPQ(); unsigned char* w = cx.ws; const bf16* wl = (const bf16*)(w + WS_W + (size_t)lq * WL_BYTES);
            const int nsub = (cx.G > 64) ? cx.G - 64 : cx.G, csub = (cx.G > 64) ? cx.bid - 64 : cx.bid;
            if (csub >= 0) {
                int kple = PLE; asm volatile("" : "+s"(kple));
                pg8::Gemm g{(const bf16*)(w + WS_PB) + (size_t)lq * S * PLE, wl + WL_P / 2, S, D, kple}; pg8::StaticOrder So; So.init(S, D, nsub, csub);
                pg8::EpiPlain E{(bf16*)(w + WS_PP)};
                pg8::gemm_phase<pg8::EpiPlain, pg8::StaticOrder, true, true>(lds, g, So, E, cx.wave); }
        }
#endif
        SEAM(pb + 0);
        if (IN(pb + 1)) {
#if RET_MFMA
            { REPS(2) { OPQ(); phase_ret_u_mfma(P, cx, lds); } }
#else
            { OPQ(); phase_ret_u_scores(P, cx, lds); }
#endif
#if SWA_MFMA
            { REPS(2) { OPQ(); phase_swa_mfma(P, cx, lq, lds); } }
#else
            { OPQ(); phase_swa(P, cx, lq, lds); }
#endif
        }
        SEAM(pb + 1);
#if RET_MFMA
        if (IN(pb + 2)) { OPQ(); phase_scan_bf16(P, cx); }
        SEAM(pb + 2);
        if (IN(pb + 3)) { REPS(2) { OPQ(); phase_ret_out_mfma(P, cx, lq, lds); } }
        SEAM(pb + 3);
#else
        if (IN(pb + 2)) { OPQ(); phase_scan(P, cx); }
        SEAM(pb + 2);
        if (IN(pb + 3)) { OPQ(); phase_ret_out(P, cx, lds); }
        SEAM(pb + 3);
        if (IN(pb + 4)) { OPQ(); phase_groupnorm(P, cx, lq); }
        SEAM(pb + 4);
#endif
        if (IN(pb + 5)) { OPQ(); unsigned char* w = cx.ws; const bf16* wl = (const bf16*)(w + WS_W + (size_t)lq * WL_BYTES);
            pg8::Gemm g{(const bf16*)(w + WS_MIX), wl + WL_OUT / 2, S, D, D}; pg8::StaticOrder So; So.init(S, D, cx.G, cx.bid);
            pg8::EpiResid<false> E{(lq == 0) ? P.in[0] : (const float*)(w + WS_XR), (float*)(w + WS_Y), ALPHA};
            pg8::gemm_phase<pg8::EpiResid<false>, pg8::StaticOrder, true, true>(lds, g, So, E, cx.wave);
        }
        SEAM(pb + 5);
        if (IN(pb + 6)) { REPS(1) { OPQ(); unsigned char* w = cx.ws; phase_ln(cx, (const float*)(w + WS_Y), P.in[8] + lq * D, P.in[9] + lq * D, (float*)(w + WS_XR), (bf16*)(w + WS_XB)); } }
        SEAM(pb + 6);
        if (IN(pb + 7)) { OPQ(); unsigned char* w = cx.ws; const bf16* wl = (const bf16*)(w + WS_W + (size_t)lq * WL_BYTES);
            pg8::Gemm g{(const bf16*)(w + WS_XB), wl + WL_UP / 2, S, NUPG, D}; pg8::StaticOrder So; So.init(S, NUPG, cx.G, cx.bid);
#if CONV_FUSED
            pg8::EpiUpConv E{(bf16*)(w + WS_ACT), (bf16*)(w + WS_H), (bf16*)(w + WS_SG), P.in[17] + lq * D, P.in[11] + (size_t)lq * 3 * NUP, P.in[12] + (size_t)lq * NUP};
            pg8::gemm_phase<pg8::EpiUpConv, pg8::StaticOrder, true, true>(lds, g, So, E, cx.wave);
#else
            pg8::EpiUp E{(bf16*)(w + WS_H), (bf16*)(w + WS_SG), P.in[17] + lq * D};
            pg8::gemm_phase<pg8::EpiUp, pg8::StaticOrder, true, true>(lds, g, So, E, cx.wave);
#endif
        }
        SEAM(pb + 7);
        if (IN(pb + 8)) {
#if !PLE_EARLY
            { OPQ(); unsigned char* w = cx.ws; const bf16* wl = (const bf16*)(w + WS_W + (size_t)lq * WL_BYTES);
              pg8::Gemm g{(const bf16*)(w + WS_PB) + (size_t)lq * S * PLE, wl + WL_P / 2, S, D, PLE}; pg8::StaticOrder So; So.init(S, D, cx.G, cx.bid);
              pg8::EpiPle E{(const bf16*)(w + WS_SG), (float*)(w + WS_Y)};
              pg8::gemm_phase<pg8::EpiPle, pg8::StaticOrder, true, true>(lds, g, So, E, cx.wave); }
#endif
#if CONV_FUSED
            { OPQ(); phase_conv_fixup(P, cx, lq); }
#else
            { REPS(1) { OPQ(); phase_convact(P, cx, lq); } }
#endif
        }
        SEAM(pb + 8);
        if (IN(pb + 9)) { OPQ(); unsigned char* w = cx.ws; const bf16* wl = (const bf16*)(w + WS_W + (size_t)lq * WL_BYTES);
            pg8::Gemm g{(const bf16*)(w + WS_ACT), wl + WL_DOWN / 2, S, D, DFF}; pg8::StaticOrder So; So.init(S, D, cx.G, cx.bid);
#if PLE_EARLY
            pg8::EpiDown E{(const float*)(w + WS_XR), (float*)(w + WS_Y), (const bf16*)(w + WS_PP), (const bf16*)(w + WS_SG), ALPHA};
            pg8::gemm_phase<pg8::EpiDown, pg8::StaticOrder, true, true>(lds, g, So, E, cx.wave);
#else
            pg8::EpiResid<true> E{(const float*)(w + WS_XR), (float*)(w + WS_Y), ALPHA};
            pg8::gemm_phase<pg8::EpiResid<true>, pg8::StaticOrder, true, true>(lds, g, So, E, cx.wave);
#endif
        }
        SEAM(pb + 9);
        if (IN(pb + 10)) { REPS(1) { OPQ(); unsigned char* w = cx.ws; const bool last = (lq == DEPTH - 1);
            phase_ln(cx, (const float*)(w + WS_Y), P.in[14] + lq * D, P.in[15] + lq * D, last ? P.out : (float*)(w + WS_XR), last ? (bf16*)nullptr : (bf16*)(w + WS_XB)); } }
        SEAM(pb + 10);
    }
#undef IN
#undef SEAM
}

extern "C" void kernel_launch(void* const* d_in, const int* in_sizes, int n_in, void* d_out, int out_size, void* d_ws, size_t ws_size, hipStream_t stream) {
    static int grid = 0;
    if (grid == 0) {
        if (n_in != 19 || in_sizes[0] != S * D || out_size != S * D || ws_size < WS_END) { fprintf(stderr, "kernel_launch: unexpected shapes (n_in %d, in0 %d, out %d, ws %zu)\n", n_in, n_in > 0 ? in_sizes[0] : -1, out_size, ws_size); grid = -1; return; }
        int dev = 0, cus = 0, per_cu = 0;
        if (hipGetDevice(&dev) != hipSuccess || hipDeviceGetAttribute(&cus, hipDeviceAttributeMultiprocessorCount, dev) != hipSuccess) { grid = -1; return; }
        if (hipFuncSetAttribute((const void*)fwd, hipFuncAttributeMaxDynamicSharedMemorySize, LDS_BYTES) != hipSuccess) { fprintf(stderr, "kernel_launch: hipFuncSetAttribute failed\n"); grid = -1; return; }
        if (hipOccupancyMaxActiveBlocksPerMultiprocessor(&per_cu, (const void*)fwd, 512, LDS_BYTES) != hipSuccess || per_cu < 1) fprintf(stderr, "kernel_launch: occupancy query says %d\n", per_cu);
        (void)hipGetLastError();
        grid = cus;
    }
    if (grid < 0) return;
    (void)hipMemsetAsync((char*)d_ws + WS_CTL, 0, CTL_ZERO_BYTES, stream);
#ifdef DBG_NANFILL
    (void)hipMemsetAsync((char*)d_ws + CTL_ZERO_BYTES, 0xFF, WS_END - CTL_ZERO_BYTES, stream);
#endif
    Params p{};
    for (int i = 0; i < 19; ++i) p.in[i] = (const float*)d_in[i];
    p.out = (float*)d_out; p.ws = (unsigned char*)d_ws;
    for (int f = 0; f < 128; ++f) p.invf_ret[f] = (float)(1.0 / std::pow(10000.0, (double)((float)f / 127.0f)));
    for (int f = 0; f < 32; ++f) p.invf_att[f] = (float)std::pow(10000.0, -(double)(2 * f) / 64.0);
    for (int h = 0; h < 4; ++h) p.lg2g[h] = (float)std::log2(1.0 - std::exp2(-5.0 - h));
#if MK_ONE_LAUNCH
    p.ph_lo = 0; p.ph_hi = NPHASES;
    hipLaunchKernelGGL(fwd, dim3(grid), dim3(512), LDS_BYTES, stream, p);
#else
#ifdef DBG_DUMP
    for (int ph = 0; ph <= DBG_STOP; ++ph) { p.ph_lo = ph; p.ph_hi = ph + 1; hipLaunchKernelGGL(fwd, dim3(grid), dim3(512), LDS_BYTES, stream, p); }
    p.ph_lo = 1000 + DBG_DUMP; p.ph_hi = p.ph_lo + 1; hipLaunchKernelGGL(fwd, dim3(grid), dim3(512), LDS_BYTES, stream, p);
#else
    for (int ph = 0; ph < NPHASES; ++ph) { p.ph_lo = ph; p.ph_hi = ph + 1; hipLaunchKernelGGL(fwd, dim3(grid), dim3(512), LDS_BYTES, stream, p); }
#endif
#endif
}
```

```cpp
#include <hip/hip_runtime.h>
#include <cstdio>
#include <cstdint>
#include <cmath>
#define MK_ONE_LAUNCH 1
namespace pg8 {
#define PG8_LAS __attribute__((address_space(3)))
typedef unsigned short bf16_t;
typedef short bf16x8 __attribute__((ext_vector_type(8)));
typedef float f32x4 __attribute__((ext_vector_type(4)));
typedef unsigned u32x4 __attribute__((ext_vector_type(4)));
constexpr int BM = 256, BK = 64, HALF = 128, HTB = HALF * BK * 2  , STAGE_BYTES = 8 * HTB, NXCD = 8, WGM = 8;

__host__ __device__ __forceinline__ int lds_byte(int r, int c) { const int st = (r >> 4) * 2 + (c >> 5), rr = r & 15, cc = c & 31, ob = rr * 64 + cc * 2; return st * 1024 + (ob ^ (((ob >> 9) & 1) << 5)); }
__host__ __device__ __forceinline__ void stage_rc(int b, int& R, int& C) { const int st = b / 1024, sb = b % 1024, swz = sb ^ (((sb >> 9) & 1) << 5); R = (st >> 1) * 16 + swz / 64; C = (st & 1) * 32 + (swz % 64) / 2; }
__host__ __device__ __forceinline__ int perm32(int rho) { const int n = rho >> 4, i = rho & 15; return 8 * (i >> 2) + 4 * n + (i & 3); }

struct Unit { int pm, pn; };
struct Gemm { const bf16_t* A; const bf16_t* Bt; int M, N, K; };

struct StaticOrder {
    int nM, nN, nwg, G, c;
    __host__ __device__ void init(int M, int N, int G_, int c_) { nM = M / BM; nN = N / BM; nwg = nM * nN; G = G_; c = c_; }
    __host__ __device__ bool next(int i, Unit& u) const {
        const long L = (long)i * G + c; if (L >= nwg) return false;
        int wgid = (int)L; { const int q = nwg / NXCD, r = nwg % NXCD, xcd = wgid % NXCD, off = wgid / NXCD; wgid = (xcd < r ? xcd * (q + 1) : r * (q + 1) + (xcd - r) * q) + off; }
        const int nig = WGM * nN, gid = wgid / nig, fm = gid * WGM, gsz = (nM - fm) < WGM ? (nM - fm) : WGM;
        u.pm = fm + ((wgid % nig) % gsz); u.pn = (wgid % nig) / gsz; return true;
    }
    __device__ __forceinline__ void a_ready(const Unit&) const {}
    __device__ __forceinline__ void done(const Unit&) const {}
};

typedef float f32x2c_t __attribute__((ext_vector_type(2))); typedef __bf16 bf16x2c_t __attribute__((ext_vector_type(2)));
__device__ __forceinline__ unsigned cvt_pk_bf16(float lo, float hi) { f32x2c_t v = {lo, hi}; bf16x2c_t b = __builtin_convertvector(v, bf16x2c_t); return __builtin_bit_cast(unsigned, b); }
typedef float f32x2 __attribute__((ext_vector_type(2)));
typedef unsigned u32x2 __attribute__((ext_vector_type(2)));
__device__ __forceinline__ float bf2f(unsigned short b) { return __uint_as_float(((unsigned)b) << 16); }
__device__ __forceinline__ u32x4 pack8(const f32x4 a, const f32x4 b) { u32x4 w; w.x = cvt_pk_bf16(a[0], a[1]); w.y = cvt_pk_bf16(a[2], a[3]); w.z = cvt_pk_bf16(b[0], b[1]); w.w = cvt_pk_bf16(b[2], b[3]); return w; }
__device__ __forceinline__ float sigmoidf_(float x) { return __builtin_amdgcn_rcpf(1.0f + __expf(-x)); }

struct EpiInProj {
    static constexpr bool PERM = true, AFTER_DRAIN = false;
    bf16_t *Q, *K, *V, *G, *AQ, *AK, *AV; const float *cosr, *sinr, *cosa, *sina;
    __device__ __forceinline__ void operator()(const f32x4 (&acc)[2][2][4][2], const Unit& u, int wr, int wc, int fr, int fq) const {
        const int row0 = u.pm * BM + wr * 64 + fr, pn = u.pn, cw = wc * 32 + 8 * fq;
        if (pn < 8) {
            bf16_t* O = pn < 4 ? Q : K; const int hcol = (pn & 3) * 256; const float sc = pn < 4 ? 1.0f : 0.0625f;
#pragma unroll
            for (int ai = 0; ai < 2; ++ai)
#pragma unroll
                for (int m = 0; m < 4; ++m) { const int row = row0 + ai * HALF + m * 16;
                    const f32x4 c0 = *(const f32x4*)(cosr + (size_t)row * 128 + cw), c1 = *(const f32x4*)(cosr + (size_t)row * 128 + cw + 4);
                    const f32x4 s0 = *(const f32x4*)(sinr + (size_t)row * 128 + cw), s1 = *(const f32x4*)(sinr + (size_t)row * 128 + cw + 4);
                    const f32x4 a0 = acc[ai][0][m][0], a1 = acc[ai][0][m][1], b0 = acc[ai][1][m][0], b1 = acc[ai][1][m][1];
                    const f32x4 o10 = (a0 * c0 - b0 * s0) * sc, o11 = (a1 * c1 - b1 * s1) * sc, o20 = (a0 * s0 + b0 * c0) * sc, o21 = (a1 * s1 + b1 * c1) * sc;
                    bf16_t* rowp = O + (size_t)row * 1024 + hcol + cw;
                    *(u32x4*)(rowp) = pack8(o10, o11); *(u32x4*)(rowp + HALF) = pack8(o20, o21); }
        } else if (pn < 16) {
            const bool gate = pn >= 12; bf16_t* O = gate ? G : V; const int hcol = (pn & 3) * 256;
#pragma unroll
            for (int ai = 0; ai < 2; ++ai)
#pragma unroll
                for (int m = 0; m < 4; ++m) { const int row = row0 + ai * HALF + m * 16; bf16_t* rowp = O + (size_t)row * 1024 + hcol + cw;
#pragma unroll
                    for (int bj = 0; bj < 2; ++bj) { f32x4 v0 = acc[ai][bj][m][0], v1 = acc[ai][bj][m][1];
                        if (gate) {
#pragma unroll
                            for (int j = 0; j < 4; ++j) { v0[j] = v0[j] * sigmoidf_(v0[j]); v1[j] = v1[j] * sigmoidf_(v1[j]); } }
                        *(u32x4*)(rowp + bj * HALF) = pack8(v0, v1); } }
        } else if (pn < 20) {
            const int t = pn - 16, i0 = 8 * fq;
#pragma unroll
            for (int ai = 0; ai < 2; ++ai)
#pragma unroll
                for (int m = 0; m < 4; ++m) { const int row = row0 + ai * HALF + m * 16;
                    const f32x4 c0 = *(const f32x4*)(cosa + (size_t)row * 32 + i0), c1 = *(const f32x4*)(cosa + (size_t)row * 32 + i0 + 4);
                    const f32x4 s0 = *(const f32x4*)(sina + (size_t)row * 32 + i0), s1 = *(const f32x4*)(sina + (size_t)row * 32 + i0 + 4);
                    const f32x4 a0 = acc[ai][0][m][0], a1 = acc[ai][0][m][1], b0 = acc[ai][1][m][0], b1 = acc[ai][1][m][1];
                    const f32x4 o10 = (a0 * c0 - b0 * s0) * 0.125f, o11 = (a1 * c1 - b1 * s1) * 0.125f, o20 = (a0 * s0 + b0 * c0) * 0.125f, o21 = (a1 * s1 + b1 * c1) * 0.125f;
                    bf16_t* rowp = AQ + (size_t)row * 1024 + t * 256 + wc * 64 + i0;
                    *(u32x4*)(rowp) = pack8(o10, o11); *(u32x4*)(rowp + 32) = pack8(o20, o21); }
        } else {
            const int i0 = 8 * fq;
            if (wc < 2) {
#pragma unroll
                for (int ai = 0; ai < 2; ++ai)
#pragma unroll
                    for (int m = 0; m < 4; ++m) { const int row = row0 + ai * HALF + m * 16;
                        const f32x4 c0 = *(const f32x4*)(cosa + (size_t)row * 32 + i0), c1 = *(const f32x4*)(cosa + (size_t)row * 32 + i0 + 4);
                        const f32x4 s0 = *(const f32x4*)(sina + (size_t)row * 32 + i0), s1 = *(const f32x4*)(sina + (size_t)row * 32 + i0 + 4);
                        const f32x4 a0 = acc[ai][0][m][0], a1 = acc[ai][0][m][1], b0 = acc[ai][1][m][0], b1 = acc[ai][1][m][1];
                        const f32x4 o10 = a0 * c0 - b0 * s0, o11 = a1 * c1 - b1 * s1, o20 = a0 * s0 + b0 * c0, o21 = a1 * s1 + b1 * c1;
                        bf16_t* rowp = AK + (size_t)row * 128 + wc * 64 + i0;
                        *(u32x4*)(rowp) = pack8(o10, o11); *(u32x4*)(rowp + 32) = pack8(o20, o21); }
            } else {
#pragma unroll
                for (int ai = 0; ai < 2; ++ai)
#pragma unroll
                    for (int m = 0; m < 4; ++m) { const int row = row0 + ai * HALF + m * 16; bf16_t* rowp = AV + (size_t)row * 128 + (wc - 2) * 32 + i0;
                        *(u32x4*)(rowp) = pack8(acc[ai][0][m][0], acc[ai][0][m][1]); *(u32x4*)(rowp + 64) = pack8(acc[ai][1][m][0], acc[ai][1][m][1]); }
            }
        }
    }
};
template <bool ADD> struct EpiResid {
    static constexpr bool PERM = false, AFTER_DRAIN = false;
    const float* base; float* Y; float alpha;
    __device__ __forceinline__ void operator()(const f32x4 (&acc)[2][2][4][2], const Unit& u, int wr, int wc, int fr, int fq) const {
        const int row0 = u.pm * BM + wr * 64 + fr, col0 = u.pn * BM + wc * 32 + 4 * fq;
#pragma unroll
        for (int ai = 0; ai < 2; ++ai)
#pragma unroll
            for (int m = 0; m < 4; ++m) { const size_t off = (size_t)(row0 + ai * HALF + m * 16) * 2048 + col0;
#pragma unroll
                for (int bj = 0; bj < 2; ++bj)
#pragma unroll
                    for (int n = 0; n < 2; ++n) { const size_t o = off + bj * HALF + n * 16; f32x4 v = acc[ai][bj][m][n] + *(const f32x4*)(base + o) * alpha;
                        if (ADD) v = v + *(const f32x4*)(Y + o); *(f32x4*)(Y + o) = v; } }
    }
};
struct EpiUp {
    static constexpr bool PERM = true, AFTER_DRAIN = false;
    bf16_t* H; bf16_t* SG; const float* bgate;
    __device__ __forceinline__ void operator()(const f32x4 (&acc)[2][2][4][2], const Unit& u, int wr, int wc, int fr, int fq) const {
        const int row0 = u.pm * BM + wr * 64 + fr, cw = wc * 32 + 8 * fq;
        if (u.pn < 44) {
#pragma unroll
            for (int ai = 0; ai < 2; ++ai)
#pragma unroll
                for (int m = 0; m < 4; ++m) { bf16_t* rowp = H + (size_t)(row0 + ai * HALF + m * 16) * 11264 + u.pn * 256 + cw;
#pragma unroll
                    for (int bj = 0; bj < 2; ++bj) *(u32x4*)(rowp + bj * HALF) = pack8(acc[ai][bj][m][0], acc[ai][bj][m][1]); }
        } else {
            const int colg = (u.pn - 44) * 256 + cw;
            f32x4 bv[2][2];
#pragma unroll
            for (int bj = 0; bj < 2; ++bj)
#pragma unroll
                for (int n = 0; n < 2; ++n) bv[bj][n] = *(const f32x4*)(bgate + colg + bj * HALF + 4 * n);
#pragma unroll
            for (int ai = 0; ai < 2; ++ai)
#pragma unroll
                for (int m = 0; m < 4; ++m) { bf16_t* rowp = SG + (size_t)(row0 + ai * HALF + m * 16) * 2048 + colg;
#pragma unroll
                    for (int bj = 0; bj < 2; ++bj) { f32x4 v0 = acc[ai][bj][m][0] + bv[bj][0], v1 = acc[ai][bj][m][1] + bv[bj][1];
#pragma unroll
                        for (int j = 0; j < 4; ++j) { v0[j] = sigmoidf_(v0[j]); v1[j] = sigmoidf_(v1[j]); }
                        *(u32x4*)(rowp + bj * HALF) = pack8(v0, v1); } }
        }
    }
};

__device__ __forceinline__ float ror1f(float x) { return __builtin_bit_cast(float, __builtin_amdgcn_update_dpp(0, __builtin_bit_cast(int, x), 0x121, 0xf, 0xf, false)); }
__device__ __forceinline__ float ror2f(float x) { return __builtin_bit_cast(float, __builtin_amdgcn_update_dpp(0, __builtin_bit_cast(int, x), 0x122, 0xf, 0xf, false)); }
struct EpiUpConv {
    static constexpr bool PERM = true, AFTER_DRAIN = false;
    bf16_t* ACT; bf16_t* HALO; bf16_t* SG; const float* bgate; const float* cw; const float* cb;
    __device__ __forceinline__ void operator()(const f32x4 (&acc)[2][2][4][2], const Unit& u, int wr, int wc, int fr, int fq) const {
        const int row0 = u.pm * BM + wr * 64 + fr, cwp = wc * 32 + 8 * fq;
        if (u.pn < 44) {
#pragma unroll
            for (int n = 0; n < 2; ++n) {
                const int chg = 128 * u.pn + cwp + 4 * n, chu = 5632 + chg;
                const f32x4 wg0 = *(const f32x4*)(cw + chg), wg1 = *(const f32x4*)(cw + 11264 + chg), wg2 = *(const f32x4*)(cw + 2 * 11264 + chg), bg = *(const f32x4*)(cb + chg);
                const f32x4 wu0 = *(const f32x4*)(cw + chu), wu1 = *(const f32x4*)(cw + 11264 + chu), wu2 = *(const f32x4*)(cw + 2 * 11264 + chu), bu = *(const f32x4*)(cb + chu);
#pragma unroll
                for (int ai = 0; ai < 2; ++ai) {
                    const int span = u.pm * 4 + ai * 2 + wr;
#pragma unroll
                    for (int m = 0; m < 4; ++m) {
                        const f32x4 cg = acc[ai][0][m][n], cu = acc[ai][1][m][n];
                        const f32x4 pg = acc[ai][0][m ? m - 1 : 0][n], pu = acc[ai][1][m ? m - 1 : 0][n];
                        f32x4 o;
#pragma unroll
                        for (int j = 0; j < 4; ++j) {
                            const float g1 = ror1f(fr == 15 ? pg[j] : cg[j]), g2 = ror2f(fr >= 14 ? pg[j] : cg[j]);
                            const float u1 = ror1f(fr == 15 ? pu[j] : cu[j]), u2 = ror2f(fr >= 14 ? pu[j] : cu[j]);
                            const float ga = bg[j] + wg0[j] * g2 + wg1[j] * g1 + wg2[j] * cg[j], ua = bu[j] + wu0[j] * u2 + wu1[j] * u1 + wu2[j] * cu[j];
                            o[j] = ga * sigmoidf_(ga) * ua; }
                        const int row = row0 + ai * HALF + m * 16;
                        u32x2 w; w.x = cvt_pk_bf16(o[0], o[1]); w.y = cvt_pk_bf16(o[2], o[3]);
                        if (m > 0 || fr >= 2) *(u32x2*)(ACT + (size_t)row * 5632 + 128 * u.pn + cwp + 4 * n) = w;
                        if ((m == 0 && fr < 2) || (m == 3 && fr >= 14)) { const int slot = (m == 0) ? fr : fr - 12;
                            bf16_t* hp = HALO + ((size_t)(span * 4 + slot)) * 11264 + 256 * u.pn + cwp + 4 * n;
                            u32x2 rg, ru; rg.x = cvt_pk_bf16(cg[0], cg[1]); rg.y = cvt_pk_bf16(cg[2], cg[3]); ru.x = cvt_pk_bf16(cu[0], cu[1]); ru.y = cvt_pk_bf16(cu[2], cu[3]);
                            *(u32x2*)(hp) = rg; *(u32x2*)(hp + HALF) = ru; }
                    }
                }
            }
        } else {
            const int colg = (u.pn - 44) * 256 + cwp;
            f32x4 bv[2][2];
#pragma unroll
            for (int bj = 0; bj < 2; ++bj)
#pragma unroll
                for (int n = 0; n < 2; ++n) bv[bj][n] = *(const f32x4*)(bgate + colg + bj * HALF + 4 * n);
#pragma unroll
            for (int ai = 0; ai < 2; ++ai)
#pragma unroll
                for (int m = 0; m < 4; ++m) { bf16_t* rowp = SG + (size_t)(row0 + ai * HALF + m * 16) * 2048 + colg;
#pragma unroll
                    for (int bj = 0; bj < 2; ++bj) { f32x4 v0 = acc[ai][bj][m][0] + bv[bj][0], v1 = acc[ai][bj][m][1] + bv[bj][1];
#pragma unroll
                        for (int j = 0; j < 4; ++j) { v0[j] = sigmoidf_(v0[j]); v1[j] = sigmoidf_(v1[j]); }
                        *(u32x4*)(rowp + bj * HALF) = pack8(v0, v1); } }
        }
    }
};

struct EpiPlain {
    static constexpr bool PERM = true, AFTER_DRAIN = false;
    bf16_t* O;
    __device__ __forceinline__ void operator()(const f32x4 (&acc)[2][2][4][2], const Unit& u, int wr, int wc, int fr, int fq) const {
        const int row0 = u.pm * BM + wr * 64 + fr, cwp = u.pn * BM + wc * 32 + 8 * fq;
#pragma unroll
        for (int ai = 0; ai < 2; ++ai)
#pragma unroll
            for (int m = 0; m < 4; ++m) { bf16_t* rowp = O + (size_t)(row0 + ai * HALF + m * 16) * 2048 + cwp;
#pragma unroll
                for (int bj = 0; bj < 2; ++bj) *(u32x4*)(rowp + bj * HALF) = pack8(acc[ai][bj][m][0], acc[ai][bj][m][1]); }
    }
};
struct EpiDown {
    static constexpr bool PERM = false, AFTER_DRAIN = false;
    const float* base; float* Y; const bf16_t* PP; const bf16_t* SG; float alpha;
    __device__ __forceinline__ void operator()(const f32x4 (&acc)[2][2][4][2], const Unit& u, int wr, int wc, int fr, int fq) const {
        const int row0 = u.pm * BM + wr * 64 + fr, col0 = u.pn * BM + wc * 32 + 4 * fq;
#pragma unroll
        for (int ai = 0; ai < 2; ++ai)
#pragma unroll
            for (int m = 0; m < 4; ++m) { const size_t off = (size_t)(row0 + ai * HALF + m * 16) * 2048 + col0;
#pragma unroll
                for (int bj = 0; bj < 2; ++bj)
#pragma unroll
                    for (int n = 0; n < 2; ++n) { const size_t o = off + bj * HALF + n * 16; const u32x2 pp = *(const u32x2*)(PP + o), sg = *(const u32x2*)(SG + o);
                        f32x4 pl; pl[0] = __uint_as_float(pp.x << 16) * __uint_as_float(sg.x << 16); pl[1] = __uint_as_float(pp.x & 0xffff0000u) * __uint_as_float(sg.x & 0xffff0000u);
                        pl[2] = __uint_as_float(pp.y << 16) * __uint_as_float(sg.y << 16); pl[3] = __uint_as_float(pp.y & 0xffff0000u) * __uint_as_float(sg.y & 0xffff0000u);
                        *(f32x4*)(Y + o) = acc[ai][bj][m][n] + *(const f32x4*)(base + o) * alpha + pl; } }
    }
};

template <bool PLE_> struct EpiResidLN {
    static constexpr bool PERM = false, AFTER_DRAIN = false;
    float* Y; const float* stats; const float* g; const float* b; const bf16_t* PP; const bf16_t* SG; float alpha;
    __device__ __forceinline__ void operator()(const f32x4 (&acc)[2][2][4][2], const Unit& u, int wr, int wc, int fr, int fq) const {
        const int row0 = u.pm * BM + wr * 64 + fr, col0 = u.pn * BM + wc * 32 + 4 * fq;
        f32x4 g4[2][2], b4[2][2];
#pragma unroll
        for (int bj = 0; bj < 2; ++bj)
#pragma unroll
            for (int n = 0; n < 2; ++n) { g4[bj][n] = *(const f32x4*)(g + col0 + bj * HALF + n * 16) * alpha; b4[bj][n] = *(const f32x4*)(b + col0 + bj * HALF + n * 16) * alpha; }
#pragma unroll
        for (int ai = 0; ai < 2; ++ai)
#pragma unroll
            for (int m = 0; m < 4; ++m) { const int row = row0 + ai * HALF + m * 16; const size_t off = (size_t)row * 2048 + col0;
                const f32x2 st = *(const f32x2*)(stats + 2 * (size_t)row);
#pragma unroll
                for (int bj = 0; bj < 2; ++bj)
#pragma unroll
                    for (int n = 0; n < 2; ++n) { const size_t o = off + bj * HALF + n * 16;
                        f32x4 v = acc[ai][bj][m][n] + (*(const f32x4*)(Y + o) - st.x) * st.y * g4[bj][n] + b4[bj][n];
                        if (PLE_) { const u32x2 pp = *(const u32x2*)(PP + o), sg = *(const u32x2*)(SG + o);
                            v[0] += __uint_as_float(pp.x << 16) * __uint_as_float(sg.x << 16); v[1] += __uint_as_float(pp.x & 0xffff0000u) * __uint_as_float(sg.x & 0xffff0000u);
                            v[2] += __uint_as_float(pp.y << 16) * __uint_as_float(sg.y << 16); v[3] += __uint_as_float(pp.y & 0xffff0000u) * __uint_as_float(sg.y & 0xffff0000u); }
                        *(f32x4*)(Y + o) = v; } }
    }
};
struct EpiPle {
    static constexpr bool PERM = false, AFTER_DRAIN = false;
    const bf16_t* SG; float* Y;
    __device__ __forceinline__ void operator()(const f32x4 (&acc)[2][2][4][2], const Unit& u, int wr, int wc, int fr, int fq) const {
        const int row0 = u.pm * BM + wr * 64 + fr, col0 = u.pn * BM + wc * 32 + 4 * fq;
#pragma unroll
        for (int ai = 0; ai < 2; ++ai)
#pragma unroll
            for (int m = 0; m < 4; ++m) { const size_t off = (size_t)(row0 + ai * HALF + m * 16) * 2048 + col0;
#pragma unroll
                for (int bj = 0; bj < 2; ++bj)
#pragma unroll
                    for (int n = 0; n < 2; ++n) { const size_t o = off + bj * HALF + n * 16; const u32x2 sg = *(const u32x2*)(SG + o);
                        f32x4 g; g[0] = __uint_as_float(sg.x << 16); g[1] = __uint_as_float(sg.x & 0xffff0000u); g[2] = __uint_as_float(sg.y << 16); g[3] = __uint_as_float(sg.y & 0xffff0000u);
                        *(f32x4*)(Y + o) = acc[ai][bj][m][n] * g; } }
    }
};
template <class Epi, class Sched, bool ALIGN_EPI = false, bool SP2 = false>
__device__ __forceinline__ void gemm_phase(PG8_LAS unsigned char* lds, const Gemm g, const Sched& S, const Epi& E, const int wid_in) {
    int lane_; asm volatile("v_mbcnt_lo_u32_b32 %0, -1, 0\n\tv_mbcnt_hi_u32_b32 %0, -1, %0" : "=v"(lane_)); const int wid = wid_in, lane = lane_, tid = wid * 64 + lane, wr = wid >> 2, wc = wid & 3, fr = lane & 15, fq = lane >> 4;
    const int K = g.K, nt = K / BK;
    unsigned voffA[2], voffB[2];
#pragma unroll
    for (int i = 0; i < 2; ++i) { int R, C; stage_rc(tid * 16 + i * 8192, R, C); const int Rb = Epi::PERM ? ((R & ~31) + perm32(R & 31)) : R;
        voffA[i] = (unsigned)(R * K + C) * 2u; voffB[i] = (unsigned)(Rb * K + C) * 2u; }
    const size_t kstep = (size_t)(BK * 2);
    const size_t hstep = (size_t)HALF * K * 2;
    const size_t tstep = 2 * hstep;
    const unsigned ldsw = (unsigned)wid * 1024u;
    const int aoff = lds_byte(wr * 64 + fr, fq * 8), boff = lds_byte(wc * 32 + fr, fq * 8);
#define PG8_SA(b, h) (((b) * 2 + (h)) * HTB)
#define PG8_SB(b, h) ((4 + (b) * 2 + (h)) * HTB)
#define PG8_STAGE(bufoff, gbase, voff) do { _Pragma("unroll") for (int _i = 0; _i < 2; ++_i) \
        __builtin_amdgcn_global_load_lds((const unsigned*)((const char*)(gbase) + (voff)[_i]), (PG8_LAS unsigned*)(lds + (bufoff) + ldsw + _i * 8192), 16, 0, 0); } while (0)
#define PG8_LDA(dst, b, h) do { _Pragma("unroll") for (int m = 0; m < 4; ++m) _Pragma("unroll") for (int k = 0; k < 2; ++k) dst[m][k] = *(const PG8_LAS bf16x8*)(lds + PG8_SA(b, h) + aoff + m * 2048 + k * 1024); } while (0)
#define PG8_LDB(dst, b, h) do { _Pragma("unroll") for (int n = 0; n < 2; ++n) _Pragma("unroll") for (int k = 0; k < 2; ++k) dst[n][k] = *(const PG8_LAS bf16x8*)(lds + PG8_SB(b, h) + boff + n * 2048 + k * 1024); } while (0)
#define PG8_MMA(ai, bj, At, Bt) do { __builtin_amdgcn_s_setprio(1); _Pragma("unroll") for (int m = 0; m < 4; ++m) _Pragma("unroll") for (int n = 0; n < 2; ++n) _Pragma("unroll") for (int k = 0; k < 2; ++k) \
        acc[ai][bj][m][n] = __builtin_amdgcn_mfma_f32_16x16x32_bf16(Bt[n][k], At[m][k], acc[ai][bj][m][n], 0, 0, 0); __builtin_amdgcn_s_setprio(0); } while (0)
#define PG8_WAIT_V(n) asm volatile("s_waitcnt vmcnt(" #n ")" ::: "memory")
#define PG8_WAIT_L(n) asm volatile("s_waitcnt lgkmcnt(" #n ")" ::: "memory")
#define PG8_BAR __builtin_amdgcn_s_barrier()
#define PG8_SCHED __builtin_amdgcn_sched_barrier(0)
    Unit cur, nxt; int ui = 0;
    if (!S.next(0, cur)) return;
    f32x4 acc[2][2][4][2];
#pragma unroll
    for (int a = 0; a < 2; ++a)
#pragma unroll
        for (int b = 0; b < 2; ++b)
#pragma unroll
            for (int m = 0; m < 4; ++m)
#pragma unroll
                for (int n = 0; n < 2; ++n) acc[a][b][m][n] = (f32x4){0.f, 0.f, 0.f, 0.f};
    bf16x8 At[4][2], B0[2][2], B1[2][2];
    const char* cA = (const char*)g.A + (size_t)cur.pm * tstep; const char* cB = (const char*)g.Bt + (size_t)cur.pn * tstep;
    S.a_ready(cur);
    if constexpr (SP2) {
        PG8_STAGE(PG8_SB(0, 0), cB, voffB); PG8_STAGE(PG8_SB(0, 1), cB + hstep, voffB); PG8_STAGE(PG8_SA(0, 0), cA, voffA); PG8_STAGE(PG8_SA(0, 1), cA + hstep, voffA);
        if (wr == 1) PG8_BAR;
        PG8_WAIT_V(2); PG8_BAR;
        PG8_STAGE(PG8_SB(1, 0), cB + kstep, voffB); PG8_STAGE(PG8_SA(1, 0), cA + kstep, voffA); PG8_STAGE(PG8_SB(1, 1), cB + hstep + kstep, voffB);
        PG8_WAIT_V(6); PG8_BAR;
    } else {
        PG8_STAGE(PG8_SB(0, 0), cB, voffB); PG8_STAGE(PG8_SA(0, 0), cA, voffA); PG8_STAGE(PG8_SB(0, 1), cB + hstep, voffB); PG8_STAGE(PG8_SA(0, 1), cA + hstep, voffA);
        if (wr == 1) PG8_BAR;
        PG8_WAIT_V(4); PG8_BAR;
        PG8_STAGE(PG8_SB(1, 0), cB + kstep, voffB); PG8_STAGE(PG8_SA(1, 0), cA + kstep, voffA); PG8_STAGE(PG8_SB(1, 1), cB + hstep + kstep, voffB);
        PG8_WAIT_V(6); PG8_BAR;
    }
    for (;;) {
        const bool has_next = S.next(ui + 1, nxt);
        const char* nA = has_next ? (const char*)g.A + (size_t)nxt.pm * tstep : cA; const char* nB = has_next ? (const char*)g.Bt + (size_t)nxt.pn * tstep : cB;
        for (int t = 0; t < nt; t += 2) {
            const bool last = (t == nt - 2);
            const char* a1 = cA + (size_t)(t + 1) * kstep;
            const char* a2 = last ? nA : cA + (size_t)(t + 2) * kstep; const char* b2 = last ? nB : cB + (size_t)(t + 2) * kstep;
            const char* a3 = a2 + kstep; const char* b3 = b2 + kstep;
            if (last && has_next) S.a_ready(nxt);
            if constexpr (SP2) {
            PG8_LDB(B0, 0, 0); PG8_LDB(B1, 0, 1); PG8_SCHED; PG8_LDA(At, 0, 0); PG8_STAGE(PG8_SA(1, 1), a1 + hstep, voffA);
            PG8_WAIT_V(8); PG8_WAIT_L(0); PG8_BAR; PG8_MMA(0, 0, At, B0); PG8_MMA(0, 1, At, B1); PG8_BAR; PG8_SCHED;
            PG8_LDA(At, 0, 1); PG8_STAGE(PG8_SB(0, 0), b2, voffB); PG8_STAGE(PG8_SB(0, 1), b2 + hstep, voffB); PG8_STAGE(PG8_SA(0, 0), a2, voffA);
            PG8_WAIT_V(8); PG8_WAIT_L(0); PG8_BAR; PG8_MMA(1, 0, At, B0); PG8_MMA(1, 1, At, B1); PG8_BAR; PG8_SCHED;
            PG8_LDB(B0, 1, 0); PG8_LDB(B1, 1, 1); PG8_SCHED; PG8_LDA(At, 1, 0); PG8_STAGE(PG8_SA(0, 1), a2 + hstep, voffA);
            PG8_WAIT_V(8); PG8_WAIT_L(0); PG8_BAR; PG8_MMA(0, 0, At, B0); PG8_MMA(0, 1, At, B1); PG8_BAR; PG8_SCHED;
            PG8_LDA(At, 1, 1); PG8_STAGE(PG8_SB(1, 0), b3, voffB); PG8_STAGE(PG8_SB(1, 1), b3 + hstep, voffB); PG8_STAGE(PG8_SA(1, 0), a3, voffA);
            PG8_WAIT_V(8); PG8_WAIT_L(0); PG8_BAR; PG8_MMA(1, 0, At, B0); PG8_MMA(1, 1, At, B1); PG8_BAR; PG8_SCHED;
            } else {
            PG8_LDB(B0, 0, 0); PG8_SCHED; PG8_LDA(At, 0, 0); PG8_STAGE(PG8_SA(1, 1), a1 + hstep, voffA);
            PG8_WAIT_L(8); PG8_BAR; PG8_WAIT_L(0); PG8_MMA(0, 0, At, B0); PG8_BAR; PG8_SCHED;
            PG8_LDB(B1, 0, 1); PG8_STAGE(PG8_SB(0, 0), b2, voffB);
            PG8_BAR; PG8_WAIT_L(0); PG8_MMA(0, 1, At, B1); PG8_BAR;
            PG8_LDA(At, 0, 1); PG8_STAGE(PG8_SA(0, 0), a2, voffA);
            PG8_BAR; PG8_WAIT_L(0); PG8_MMA(1, 0, At, B0); PG8_BAR; PG8_SCHED;
            PG8_STAGE(PG8_SB(0, 1), b2 + hstep, voffB);
            PG8_WAIT_V(6); PG8_BAR; PG8_MMA(1, 1, At, B1); PG8_BAR;
            PG8_LDB(B0, 1, 0); PG8_SCHED; PG8_LDA(At, 1, 0); PG8_STAGE(PG8_SA(0, 1), a2 + hstep, voffA);
            PG8_WAIT_L(8); PG8_BAR; PG8_WAIT_L(0); PG8_MMA(0, 0, At, B0); PG8_BAR; PG8_SCHED;
            PG8_LDB(B1, 1, 1); PG8_STAGE(PG8_SB(1, 0), b3, voffB);
            PG8_BAR; PG8_WAIT_L(0); PG8_MMA(0, 1, At, B1); PG8_BAR;
            PG8_LDA(At, 1, 1); PG8_STAGE(PG8_SA(1, 0), a3, voffA);
            PG8_BAR; PG8_WAIT_L(0); PG8_MMA(1, 0, At, B0); PG8_BAR; PG8_SCHED;
            PG8_STAGE(PG8_SB(1, 1), b3 + hstep, voffB);
            PG8_WAIT_V(6); PG8_BAR; PG8_MMA(1, 1, At, B1); PG8_BAR;
            }
        }
        if constexpr (ALIGN_EPI) { if (wr == 0) PG8_BAR; }
        if constexpr (!Epi::AFTER_DRAIN) { E(acc, cur, wr, wc, fr, fq); S.done(cur); }
        if (!has_next) break;
#pragma unroll
        for (int a = 0; a < 2; ++a)
#pragma unroll
            for (int b = 0; b < 2; ++b)
#pragma unroll
                for (int m = 0; m < 4; ++m)
#pragma unroll
                    for (int n = 0; n < 2; ++n) acc[a][b][m][n] = (f32x4){0.f, 0.f, 0.f, 0.f};
        cur = nxt; cA = nA; cB = nB; ++ui;
        if constexpr (ALIGN_EPI) { if (wr == 1) PG8_BAR; }
    }
    PG8_WAIT_V(0);
    if constexpr (!ALIGN_EPI) { if (wr == 0) PG8_BAR; }
    PG8_BAR;
    if constexpr (Epi::AFTER_DRAIN) { E.fused(acc, cur, wr, wc, fr, fq, lds, wid, lane); S.done(cur); }
#undef PG8_SA
#undef PG8_SB
#undef PG8_STAGE
#undef PG8_LDA
#undef PG8_LDB
#undef PG8_MMA
#undef PG8_WAIT_V
#undef PG8_WAIT_L
#undef PG8_BAR
#undef PG8_SCHED
}
}
#define LAS __attribute__((address_space(3)))
#define XB_TMO      128
#define XB_XCNT(j)  (256  + 64 * (j))
#define XB_XSUB(j)  (1280 + 64 * (j))
#define XB_XGEN(j)  (2304 + 64 * (j))
#define XB_TOP      3328
#define XB_TOPGEN   3392
#define XCD_BAR_WORDS 3456
#define XB_SPIN_CAP (1u << 18)

__device__ __forceinline__ unsigned xb_ld(unsigned* p)              { return __hip_atomic_load(p, __ATOMIC_RELAXED, __HIP_MEMORY_SCOPE_AGENT); }
__device__ __forceinline__ unsigned xb_add(unsigned* p, unsigned v) { return __hip_atomic_fetch_add(p, v, __ATOMIC_RELAXED, __HIP_MEMORY_SCOPE_AGENT); }
__device__ __forceinline__ unsigned xb_xcc_id() { return (unsigned)__builtin_amdgcn_s_getreg((3 << 11) | 20) & 0xFu; }
#define XB_SPIN(cond, bar) do { unsigned _sp = 0; while (cond) { __builtin_amdgcn_s_sleep(1); \
    if ((++_sp & 255u) == 0u) { if (xb_ld(&(bar)[XB_TMO])) break; if (_sp > XB_SPIN_CAP) { atomicAdd(&(bar)[XB_TMO], 1u); break; } } } } while (0)

struct XcdBarrier {
    unsigned* bar; unsigned x;
    volatile LAS unsigned* st;
};

__device__ __forceinline__ XcdBarrier xcd_barrier_post(unsigned* bar, volatile LAS unsigned* st) {
    XcdBarrier b; b.bar = bar; b.x = xb_xcc_id(); b.st = st;
    if (threadIdx.x == 0) (void)xb_add(&bar[XB_XCNT(b.x)], 1u);
    return b;
}
__device__ __forceinline__ void xcd_barrier_complete(unsigned* bar, unsigned x, unsigned& nloc, unsigned& nx) {
    const unsigned G = gridDim.x * gridDim.y * gridDim.z;
    unsigned sum, cnt, mine, sp = 0u;
    for (;;) {
        sum = 0u; cnt = 0u; mine = 0u;
#pragma unroll
        for (unsigned j = 0; j < 16; ++j) { const unsigned c = xb_ld(&bar[XB_XCNT(j)]); sum += c; cnt += (c > 0u) ? 1u : 0u; mine = (j == x) ? c : mine; }
        if (sum == G) break;
        __builtin_amdgcn_s_sleep(1);
        if ((++sp & 255u) == 0u) { if (xb_ld(&bar[XB_TMO])) break; if (sp > XB_SPIN_CAP) { atomicAdd(&bar[XB_TMO], 1u); break; } }
    }
    nloc = mine > 0u ? mine : 1u; nx = cnt > 0u ? cnt : 1u;
}

__device__ __forceinline__ void xcd_barrier(const XcdBarrier& b) {
    asm volatile("s_waitcnt vmcnt(0)" ::: "memory");
    __syncthreads();
    if (threadIdx.x == 0) {
        unsigned* bar = b.bar;
        __builtin_amdgcn_s_waitcnt(0);
        unsigned nloc = b.st[0], nx = b.st[1];
        if (nloc == 0u) { xcd_barrier_complete(bar, b.x, nloc, nx); b.st[0] = nloc; b.st[1] = nx; }
        const unsigned old = xb_add(&bar[XB_XSUB(b.x)], 1u);
        const unsigned gen = old / nloc;
        if (old + 1u == (gen + 1u) * nloc) {
            __builtin_amdgcn_fence(__ATOMIC_RELEASE, "agent");
            asm volatile("s_waitcnt vmcnt(0)" ::: "memory");
            const unsigned og = xb_add(&bar[XB_TOP], 1u);
            const unsigned tg = og / nx;
            if (og + 1u == (tg + 1u) * nx) xb_add(&bar[XB_TOPGEN], 1u);
            else XB_SPIN(xb_ld(&bar[XB_TOPGEN]) == tg, bar);
            __builtin_amdgcn_fence(__ATOMIC_ACQUIRE, "agent");
            xb_add(&bar[XB_XGEN(b.x)], 1u);
            asm volatile("s_waitcnt vmcnt(0)" ::: "memory");
        } else {
            XB_SPIN(xb_ld(&bar[XB_XGEN(b.x)]) == gen, bar);
            __builtin_amdgcn_fence(__ATOMIC_ACQUIRE, "agent");
            asm volatile("s_waitcnt vmcnt(0)" ::: "memory");
        }
    }
    __syncthreads();
}
#define GAS __attribute__((address_space(1)))

typedef unsigned short bf16;
typedef float f32x4 __attribute__((ext_vector_type(4)));
typedef unsigned v4u __attribute__((ext_vector_type(4)));
typedef unsigned v2u __attribute__((ext_vector_type(2)));
#define LDS_WAIT() asm volatile("s_waitcnt lgkmcnt(0)" ::: "memory")

#ifndef MK_ONE_LAUNCH
#define MK_ONE_LAUNCH 0
#endif
#ifndef RET_MFMA
#define RET_MFMA 1
#endif
#ifndef SWA_MFMA
#define SWA_MFMA 1
#endif
#ifndef PROBE_DUP
#define PROBE_DUP 0
#endif
#ifndef CONV_FUSED
#define CONV_FUSED 1
#endif
#ifndef PLE_EARLY
#define PLE_EARLY 1
#endif
#ifndef LN_NOXR
#define LN_NOXR 1
#endif
#define REPS(k) int nrep_ = (PROBE_DUP == (k)) ? 2 : 1; asm volatile("" : "+s"(nrep_)); for (int rep_ = 0; rep_ < nrep_; ++rep_)

constexpr int S = 16384, D = 2048, INW = 5376, DFF = 5632, NUP = 2 * DFF, NUPG = NUP + D, PLE = 256, DEPTH = 4;
constexpr float ALPHA = 1.6817928305074290f, LN_EPS = 1e-5f, GN_EPS = 1e-6f;
constexpr int NPH = 11, NPHASES = 1 + DEPTH * NPH;

constexpr size_t MiB = 1u << 20;
constexpr size_t WS_CTL = 0, CTL_ZERO_BYTES = 1 * MiB;
constexpr size_t WS_COSR = 2 * MiB, WS_SINR = 10 * MiB, WS_COSA = 18 * MiB, WS_SINA = 20 * MiB;
constexpr size_t WS_W = 32 * MiB, WL_BYTES = 104 * MiB;
constexpr size_t WL_IN = 0, WL_OUT = 21 * MiB, WL_UP = 29 * MiB, WL_G = 73 * MiB, WL_DOWN = 81 * MiB, WL_P = 103 * MiB;
constexpr size_t WS_XR = 448 * MiB, WS_XB = 576 * MiB, WS_Y = 640 * MiB;
constexpr size_t WS_Q = 768 * MiB, WS_K = 800 * MiB, WS_V = 832 * MiB, WS_G = 864 * MiB, WS_AQ = 896 * MiB, WS_AK = 928 * MiB, WS_AV = 932 * MiB;
constexpr size_t WS_MIX = 936 * MiB, WS_U = 1000 * MiB, WS_PS = 1128 * MiB, WS_RETY = 1160 * MiB;
constexpr size_t WS_H = 768 * MiB, WS_ACT = 1128 * MiB, WS_SG = 1304 * MiB, WS_PB = 1368 * MiB, WS_END = 1400 * MiB;
constexpr size_t WS_PP = 1064 * MiB;
constexpr size_t WS_ST1 = 448 * MiB, WS_ST2 = 449 * MiB;
constexpr int CW_BAR = 4096;

constexpr int RING_BYTES = 131072, LDS_BYTES = 147456, LDSCTL_OFF = LDS_BYTES - 1024, MISC_OFF = LDSCTL_OFF + 320;

__device__ __forceinline__ unsigned f2bf(float f) { unsigned u = __builtin_bit_cast(unsigned, f); return (u + 0x7fffu + ((u >> 16) & 1u)) >> 16; }
__device__ __forceinline__ unsigned pk2(float lo, float hi) { return f2bf(lo) | (f2bf(hi) << 16); }
__device__ __forceinline__ float bflo(unsigned w) { return __uint_as_float(w << 16); }
__device__ __forceinline__ float bfhi(unsigned w) { return __uint_as_float(w & 0xffff0000u); }
__device__ __forceinline__ float bf1(const bf16* p) { return __uint_as_float(((unsigned)*p) << 16); }

struct Params {
    const float* in[19]; float* out; unsigned char* ws; int ph_lo, ph_hi;
    float invf_ret[128]; float invf_att[32]; float lg2g[4];
};

struct Ctx { int tid, lane, wave, G, bid; unsigned char* ws; };

__device__ __forceinline__ int lane_id_asm() { int l; asm volatile("v_mbcnt_lo_u32_b32 %0, -1, 0\n\tv_mbcnt_hi_u32_b32 %0, -1, %0" : "=v"(l)); return l; }
__device__ __forceinline__ float wave_sum(float v, int lane) {
#pragma unroll
    for (int o = 1; o < 64; o <<= 1) v += __builtin_bit_cast(float, __builtin_amdgcn_ds_bpermute((lane ^ o) << 2, __builtin_bit_cast(int, v)));
    return v;
}
__device__ __forceinline__ void transpose_item(const float* W, int K, int N, int src_col0, bf16* WT, int dst_row0, int k0, LAS float* scr, int lane) {
#pragma unroll 8
    for (int i = 0; i < 32; ++i) { const int kk = 2 * i + (lane >> 5); scr[kk * 33 + (lane & 31)] = W[(size_t)(k0 + kk) * N + src_col0 + (lane & 31)]; }
    LDS_WAIT(); asm volatile("" ::: "memory");
    const int c = lane & 7;
#pragma unroll
    for (int j = 0; j < 4; ++j) { const int n = (lane >> 3) + 8 * j; const LAS float* s = scr + (8 * c) * 33 + n;
        v4u o; o.x = pk2(s[0 * 33], s[1 * 33]); o.y = pk2(s[2 * 33], s[3 * 33]); o.z = pk2(s[4 * 33], s[5 * 33]); o.w = pk2(s[6 * 33], s[7 * 33]);
        *(v4u*)(WT + (size_t)(dst_row0 + n) * K + k0 + 8 * c) = o; }
    LDS_WAIT(); asm volatile("" ::: "memory");
}
__device__ __forceinline__ void transpose_item64(const float* W, int K, int N, int srcA, int srcB, bf16* WT, int dst_row0, int k0, LAS float* scr, int lane) {
    const int c4 = lane & 15, gsel = c4 >> 3, col = 4 * (c4 & 7), src = (gsel ? srcB : srcA) + col, kq = lane >> 4;
    f32x4 v[16];
#pragma unroll
    for (int i = 0; i < 16; ++i) v[i] = *(const f32x4*)(W + (size_t)(k0 + 4 * i + kq) * N + src);
#pragma unroll
    for (int i = 0; i < 16; ++i) { LAS float* d = scr + (4 * i + kq) * 65 + 32 * gsel + col; d[0] = v[i][0]; d[1] = v[i][1]; d[2] = v[i][2]; d[3] = v[i][3]; }
    LDS_WAIT(); asm volatile("" ::: "memory");
    const int c = lane & 7;
#pragma unroll
    for (int j = 0; j < 8; ++j) { const int n = (lane >> 3) + 8 * j; const LAS float* s = scr + (8 * c) * 65 + n;
        v4u o; o.x = pk2(s[0 * 65], s[1 * 65]); o.y = pk2(s[2 * 65], s[3 * 65]); o.z = pk2(s[4 * 65], s[5 * 65]); o.w = pk2(s[6 * 65], s[7 * 65]);
        *(v4u*)(WT + (size_t)(dst_row0 + n) * K + k0 + 8 * c) = o; }
    LDS_WAIT(); asm volatile("" ::: "memory");
}
__device__ __forceinline__ int win_src_col(int g) {
    const int tile = g >> 3, bj = (g >> 2) & 1, wcg = g & 3;
    if (tile < 16) return 32 * g;
    if (tile < 20) return 4096 + 256 * (tile - 16) + 64 * wcg + 32 * bj;
    return wcg < 2 ? 5120 + 64 * wcg + 32 * bj : 5248 + 32 * (wcg - 2) + 64 * bj;
}
__device__ __forceinline__ int wup_src_col(int g) { const int tile = g >> 3, bj = (g >> 2) & 1, wcg = g & 3; return (bj ? DFF : 0) + 128 * tile + 32 * wcg; }

__device__ __forceinline__ void sincos_d(float angf, float& s, float& c) {
    const double a = (double)angf;
    const double k = __builtin_rint(a * 0.63661977236758134308);
    double r = __builtin_fma(-k, 1.57079632679489661923, a); r = __builtin_fma(-k, 6.123233995736766e-17, r);
    const double r2 = r * r;
    const double sp = r + r * r2 * (-1.0 / 6 + r2 * (1.0 / 120 + r2 * (-1.0 / 5040 + r2 * (1.0 / 362880 + r2 * (-1.0 / 39916800)))));
    const double cp = 1.0 + r2 * (-0.5 + r2 * (1.0 / 24 + r2 * (-1.0 / 720 + r2 * (1.0 / 40320 + r2 * (-1.0 / 3628800 + r2 * (1.0 / 479001600))))));
    const int q = ((int)k) & 3;
    const double sv = (q == 0) ? sp : (q == 1) ? cp : (q == 2) ? -sp : -cp;
    const double cv = (q == 0) ? cp : (q == 1) ? -sp : (q == 2) ? -cp : sp;
    s = (float)sv; c = (float)cv;
}

__device__ __forceinline__ void phase_prologue(const Params& P, const Ctx& cx, LAS unsigned char* lds) {
    unsigned char* ws = cx.ws; const int tid = cx.tid, lane = cx.lane, wave = cx.wave, G = cx.G;
    LAS float* scr = (LAS float*)(lds + wave * 16896);
    const int gw = cx.bid * 8 + wave, NGW = G * 8;
    constexpr int I_IN = 32 * 84, I_OUT = 32 * 32, I_UP = 32 * 176, I_G = 32 * 32, I_DN = 88 * 32, I_P = 4 * 32, I_L = I_IN + I_OUT + I_UP + I_G + I_DN + I_P;
    for (int it = gw; it < DEPTH * I_L; it += NGW) {
        const int l = it / I_L; int r = it - l * I_L;
        bf16* wl = (bf16*)(ws + WS_W + (size_t)l * WL_BYTES);
        if (r < I_IN) { const int kb = r / 84, g = r % 84; transpose_item64(P.in[3] + (size_t)l * D * INW, D, INW, win_src_col(2 * g), win_src_col(2 * g + 1), wl + WL_IN / 2, 64 * g, 64 * kb, scr, lane); continue; } r -= I_IN;
        if (r < I_OUT) { const int kb = r / 32, g = r % 32; transpose_item64(P.in[4] + (size_t)l * D * D, D, D, 64 * g, 64 * g + 32, wl + WL_OUT / 2, 64 * g, 64 * kb, scr, lane); continue; } r -= I_OUT;
        if (r < I_UP) { const int kb = r / 176, g = r % 176; transpose_item64(P.in[10] + (size_t)l * D * NUP, D, NUP, wup_src_col(2 * g), wup_src_col(2 * g + 1), wl + WL_UP / 2, 64 * g, 64 * kb, scr, lane); continue; } r -= I_UP;
        if (r < I_G) { const int kb = r / 32, g = r % 32; transpose_item64(P.in[16] + (size_t)l * D * D, D, D, 64 * g, 64 * g + 32, wl + WL_G / 2, 64 * g, 64 * kb, scr, lane); continue; } r -= I_G;
        if (r < I_DN) { const int kb = r / 32, g = r % 32; transpose_item64(P.in[13] + (size_t)l * DFF * D, DFF, D, 64 * g, 64 * g + 32, wl + WL_DOWN / 2, 64 * g, 64 * kb, scr, lane); continue; } r -= I_DN;
        { const int kb = r / 32, g = r % 32; transpose_item64(P.in[18] + (size_t)l * PLE * D, PLE, D, 64 * g, 64 * g + 32, wl + WL_P / 2, 64 * g, 64 * kb, scr, lane); }
    }
    const size_t gt = (size_t)cx.bid * 512 + tid, NT = (size_t)G * 512;
    { const float* x = P.in[0]; bf16* xb = (bf16*)(ws + WS_XB);
      for (size_t i = gt; i < (size_t)S * D / 8; i += NT) { const f32x4 a = *(const f32x4*)(x + i * 8), b = *(const f32x4*)(x + i * 8 + 4);
          v4u o; o.x = pk2(a[0], a[1]); o.y = pk2(a[2], a[3]); o.z = pk2(b[0], b[1]); o.w = pk2(b[2], b[3]); *(v4u*)(xb + i * 8) = o; } }
    { const float* p = P.in[1]; bf16* pb = (bf16*)(ws + WS_PB);
      for (size_t i = gt; i < (size_t)DEPTH * S * PLE / 8; i += NT) { const f32x4 a = *(const f32x4*)(p + i * 8), b = *(const f32x4*)(p + i * 8 + 4);
          v4u o; o.x = pk2(a[0], a[1]); o.y = pk2(a[2], a[3]); o.z = pk2(b[0], b[1]); o.w = pk2(b[2], b[3]); *(v4u*)(pb + i * 8) = o; } }
    { const int* pos = (const int*)P.in[2]; float* cosr = (float*)(ws + WS_COSR); float* sinr = (float*)(ws + WS_SINR); float* cosa = (float*)(ws + WS_COSA); float* sina = (float*)(ws + WS_SINA);
      for (size_t i = gt; i < (size_t)S * 128; i += NT) { const int t = (int)(i >> 7), f = (int)(i & 127); float s, c; sincos_d((float)pos[t] * P.invf_ret[f], s, c); cosr[i] = c; sinr[i] = s; }
      for (size_t i = gt; i < (size_t)S * 32; i += NT) { const int t = (int)(i >> 5), f = (int)(i & 31); float s, c; sincos_d((float)pos[t] * P.invf_att[f], s, c); cosa[i] = c; sina[i] = s; } }
}

template <int MT, int NT_, int KK, bool A_KFAST, bool B_NFAST, class FA, class FB, class FC>
__device__ __forceinline__ void simple_gemm(LAS unsigned char* lds, int nbatch, int tid, int G, int bid, const FA& fa, const FB& fb, const FC& fc) {
    LAS float* As = (LAS float*)lds;
    LAS float* Bs = (LAS float*)(lds + 16 * 132 * 4);
    constexpr int TM = MT / 128, TN = NT_ / 64, ITEMS_PER_B = TM * TN;
    const int tm = tid & 31, tn = tid >> 5;
    for (int item = bid; item < nbatch * ITEMS_PER_B; item += G) {
        const int b = item / ITEMS_PER_B, r = item % ITEMS_PER_B, m0 = (r / TN) * 128, n0 = (r % TN) * 64;
        float c[4][4];
#pragma unroll
        for (int i = 0; i < 4; ++i)
#pragma unroll
            for (int j = 0; j < 4; ++j) c[i][j] = 0.f;
        for (int k0 = 0; k0 < KK; k0 += 16) {
#pragma unroll
            for (int rr = 0; rr < 4; ++rr) { const int e = tid + 512 * rr; int m, k; if (A_KFAST) { k = e & 15; m = e >> 4; } else { m = e & 127; k = e >> 7; }
                As[k * 132 + m] = fa(b, m0 + m, k0 + k); }
#pragma unroll
            for (int rr = 0; rr < 2; ++rr) { const int e = tid + 512 * rr; int n, k; if (B_NFAST) { n = e & 63; k = e >> 6; } else { k = e & 15; n = e >> 4; }
                Bs[k * 68 + n] = fb(b, k0 + k, n0 + n); }
            __syncthreads();
#pragma unroll
            for (int kk = 0; kk < 16; ++kk) { const f32x4 a = *(const LAS f32x4*)(As + kk * 132 + 4 * tm), bb = *(const LAS f32x4*)(Bs + kk * 68 + 4 * tn);
#pragma unroll
                for (int i = 0; i < 4; ++i)
#pragma unroll
                    for (int j = 0; j < 4; ++j) c[i][j] += a[i] * bb[j]; }
            __syncthreads();
        }
#pragma unroll
        for (int i = 0; i < 4; ++i)
#pragma unroll
            for (int j = 0; j < 4; ++j) fc(b, m0 + 4 * tm + i, n0 + 4 * tn + j, c[i][j]);
    }
}

__device__ __forceinline__ void phase_swa(const Params& P, const Ctx& cx, int l, LAS unsigned char* lds) {
    unsigned char* ws = cx.ws; const int tid = cx.tid, G = cx.G;
    const bf16* AQ = (const bf16*)(ws + WS_AQ); const bf16* AK = (const bf16*)(ws + WS_AK); const bf16* AV = (const bf16*)(ws + WS_AV); bf16* MIX = (bf16*)(ws + WS_MIX);
    const float* sinks = P.in[7] + l * 16;
    LAS unsigned* Ks = (LAS unsigned*)lds;
    LAS unsigned* Vs = (LAS unsigned*)(lds + 256 * 33 * 4);
    for (int item = cx.bid; item < 256; item += G) {
        const int nb = item >> 1, hk = item & 1;
        __syncthreads();
        for (int e = tid; e < 256 * 32; e += 512) { const int r = e >> 5, cdw = e & 31; const int gk = nb * 128 - 128 + r;
            unsigned kv = 0u, vv = 0u; if (gk >= 0) { kv = *(const unsigned*)(AK + (size_t)gk * 128 + hk * 64 + 2 * cdw); vv = *(const unsigned*)(AV + (size_t)gk * 128 + hk * 64 + 2 * cdw); }
            Ks[r * 33 + cdw] = kv; Vs[r * 33 + cdw] = vv; }
        __syncthreads();
#pragma unroll 1
        for (int rep = 0; rep < 2; ++rep) {
            const int pair = tid + 512 * rep, i = pair & 127, g = pair >> 7, hq = hk * 8 + g; const int row = nb * 128 + i;
            float q[64], o[64];
            { const v4u* qp = (const v4u*)(AQ + (size_t)row * 1024 + hq * 64);
#pragma unroll
              for (int c8 = 0; c8 < 8; ++c8) { const v4u w = qp[c8]; q[8 * c8 + 0] = bflo(w.x); q[8 * c8 + 1] = bfhi(w.x); q[8 * c8 + 2] = bflo(w.y); q[8 * c8 + 3] = bfhi(w.y); q[8 * c8 + 4] = bflo(w.z); q[8 * c8 + 5] = bfhi(w.z); q[8 * c8 + 6] = bflo(w.w); q[8 * c8 + 7] = bfhi(w.w); } }
#pragma unroll
            for (int d = 0; d < 64; ++d) o[d] = 0.f;
            float mx = sinks[hq], den = 1.0f;
            const int jj0 = (nb == 0) ? (127 - i) : 0;
            for (int jj = jj0; jj < 128; ++jj) { const int kl = i + 1 + jj;
                float s = 0.f;
#pragma unroll
                for (int c = 0; c < 32; ++c) { const unsigned w = Ks[kl * 33 + c]; s += q[2 * c] * bflo(w) + q[2 * c + 1] * bfhi(w); }
                const float mn = fmaxf(mx, s), sc = __expf(mx - mn), p = __expf(s - mn);
                den = den * sc + p; mx = mn;
#pragma unroll
                for (int c = 0; c < 32; ++c) { const unsigned w = Vs[kl * 33 + c]; o[2 * c] = o[2 * c] * sc + p * bflo(w); o[2 * c + 1] = o[2 * c + 1] * sc + p * bfhi(w); }
            }
            const float inv = 1.0f / den;
            v4u* op = (v4u*)(MIX + (size_t)row * 2048 + 1024 + hq * 64);
#pragma unroll
            for (int c8 = 0; c8 < 8; ++c8) { v4u w; w.x = pk2(o[8 * c8] * inv, o[8 * c8 + 1] * inv); w.y = pk2(o[8 * c8 + 2] * inv, o[8 * c8 + 3] * inv); w.z = pk2(o[8 * c8 + 4] * inv, o[8 * c8 + 5] * inv); w.w = pk2(o[8 * c8 + 6] * inv, o[8 * c8 + 7] * inv); op[c8] = w; }
        }
    }
}

__device__ __forceinline__ void phase_ret_u_scores(const Params& P, const Ctx& cx, LAS unsigned char* lds) {
    unsigned char* ws = cx.ws; const int tid = cx.tid, G = cx.G;
    const bf16* Q = (const bf16*)(ws + WS_Q); const bf16* K = (const bf16*)(ws + WS_K); const bf16* V = (const bf16*)(ws + WS_V);
    float* U = (float*)(ws + WS_U); float* PS = (float*)(ws + WS_PS);
    const float lg0 = P.lg2g[0], lg1 = P.lg2g[1], lg2 = P.lg2g[2], lg3 = P.lg2g[3];
    auto lgh = [=](int h) { return h == 0 ? lg0 : h == 1 ? lg1 : h == 2 ? lg2 : lg3; };
    simple_gemm<256, 256, 128, false, true>(lds, 512, tid, G, cx.bid,
        [=](int b, int m, int k) { const int nb = b >> 2, h = b & 3; return bf1(K + (size_t)(nb * 128 + k) * 1024 + h * 256 + m) * exp2f(lgh(h) * (float)(127 - k)); },
        [=](int b, int k, int n) { const int nb = b >> 2, h = b & 3; return bf1(V + (size_t)(nb * 128 + k) * 1024 + h * 256 + n); },
        [=](int b, int m, int n, float v) { U[((size_t)b * 256 + m) * 256 + n] = v; });
    simple_gemm<128, 128, 256, true, false>(lds, 512, tid, G, cx.bid,
        [=](int b, int m, int k) { const int nb = b >> 2, h = b & 3; return bf1(Q + (size_t)(nb * 128 + m) * 1024 + h * 256 + k); },
        [=](int b, int k, int n) { const int nb = b >> 2, h = b & 3; return bf1(K + (size_t)(nb * 128 + n) * 1024 + h * 256 + k); },
        [=](int b, int m, int n, float v) { const int h = b & 3; PS[((size_t)b * 128 + m) * 128 + n] = (m >= n) ? v * exp2f(lgh(h) * (float)(m - n)) : 0.f; });
}
__device__ __forceinline__ void phase_scan(const Params& P, const Ctx& cx) {
    float* U = (float*)(cx.ws + WS_U);
    const size_t gt = (size_t)cx.bid * 512 + cx.tid, NT = (size_t)cx.G * 512;
    for (size_t idx = gt; idx < 4 * 65536; idx += NT) {
        const int h = (int)(idx >> 16); const float cd = exp2f(P.lg2g[h] * 128.0f);
        float r = 0.f;
        for (int n0 = 0; n0 < 128; n0 += 8) { float u[8];
#pragma unroll
            for (int j = 0; j < 8; ++j) u[j] = U[(size_t)(n0 + j) * 262144 + idx];
#pragma unroll
            for (int j = 0; j < 8; ++j) { U[(size_t)(n0 + j) * 262144 + idx] = r; r = r * cd + u[j]; } }
    }
}
__device__ __forceinline__ void phase_ret_out(const Params& P, const Ctx& cx, LAS unsigned char* lds) {
    unsigned char* ws = cx.ws; const int tid = cx.tid, G = cx.G;
    const bf16* Q = (const bf16*)(ws + WS_Q); const bf16* V = (const bf16*)(ws + WS_V);
    const float* Sst = (const float*)(ws + WS_U); const float* PS = (const float*)(ws + WS_PS); float* RY = (float*)(ws + WS_RETY);
    const float lg0 = P.lg2g[0], lg1 = P.lg2g[1], lg2 = P.lg2g[2], lg3 = P.lg2g[3];
    auto lgh = [=](int h) { return h == 0 ? lg0 : h == 1 ? lg1 : h == 2 ? lg2 : lg3; };
    simple_gemm<128, 256, 384, true, true>(lds, 512, tid, G, cx.bid,
        [=](int b, int m, int k) { const int nb = b >> 2, h = b & 3; return k < 128 ? PS[((size_t)b * 128 + m) * 128 + k] : bf1(Q + (size_t)(nb * 128 + m) * 1024 + h * 256 + (k - 128)) * exp2f(lgh(h) * (float)(m + 1)); },
        [=](int b, int k, int n) { const int nb = b >> 2, h = b & 3; return k < 128 ? bf1(V + (size_t)(nb * 128 + k) * 1024 + h * 256 + n) : Sst[((size_t)b * 256 + (k - 128)) * 256 + n]; },
        [=](int b, int m, int n, float v) { const int nb = b >> 2, h = b & 3; RY[(size_t)(nb * 128 + m) * 1024 + h * 256 + n] = v; });
}

typedef short bf16x8 __attribute__((ext_vector_type(8)));
typedef short s16x4 __attribute__((ext_vector_type(4)));
typedef short v4i16_t __attribute__((ext_vector_type(4)));
__device__ __forceinline__ f32x4 mfma16(bf16x8 a, bf16x8 b, f32x4 c) { return __builtin_amdgcn_mfma_f32_16x16x32_bf16(a, b, c, 0, 0, 0); }
__device__ __forceinline__ s16x4 lds_tr(LAS unsigned char* p) { return __builtin_bit_cast(s16x4, __builtin_amdgcn_ds_read_tr16_b64_v4i16((LAS v4i16_t*)p)); }
__device__ __forceinline__ bf16x8 cat44(s16x4 a, s16x4 b) { bf16x8 r; r[0] = a[0]; r[1] = a[1]; r[2] = a[2]; r[3] = a[3]; r[4] = b[0]; r[5] = b[1]; r[6] = b[2]; r[7] = b[3]; return r; }
__device__ __forceinline__ unsigned cvt2(float lo, float hi) { return pg8::cvt_pk_bf16(lo, hi); }
__device__ __forceinline__ bf16x8 pack_frag(const f32x4 a, const f32x4 b) { v4u w; w.x = cvt2(a[0], a[1]); w.y = cvt2(a[2], a[3]); w.z = cvt2(b[0], b[1]); w.w = cvt2(b[2], b[3]); return __builtin_bit_cast(bf16x8, w); }
__device__ __forceinline__ float grp16_sum(float v, int lane) {
#pragma unroll
    for (int o = 1; o < 16; o <<= 1) v += __builtin_bit_cast(float, __builtin_amdgcn_ds_bpermute((lane ^ o) << 2, __builtin_bit_cast(int, v)));
    return v;
}
constexpr int RS_T = 544;
constexpr int TILE_T = 128 * RS_T;
static_assert(2 * TILE_T <= LDSCTL_OFF, "retention tiles vs LDS control words");

template <bool DECAY> __device__ __forceinline__ void stage_tile(LAS unsigned char* img, const bf16* src, int tid, float lg) {
    v4u v[8];
#pragma unroll
    for (int r = 0; r < 8; ++r) { const int pc = tid + 512 * r, row = pc >> 5, c16 = pc & 31; v[r] = *(const v4u*)(src + (size_t)row * 1024 + c16 * 8); }
#pragma unroll
    for (int r = 0; r < 8; ++r) { const int pc = tid + 512 * r, row = pc >> 5, c16 = pc & 31; v4u w = v[r];
        if (DECAY) { const float sc = exp2f(lg * (float)(127 - row));
            w.x = cvt2(bflo(w.x) * sc, bfhi(w.x) * sc); w.y = cvt2(bflo(w.y) * sc, bfhi(w.y) * sc); w.z = cvt2(bflo(w.z) * sc, bfhi(w.z) * sc); w.w = cvt2(bflo(w.w) * sc, bfhi(w.w) * sc); }
        *(LAS v4u*)(img + row * RS_T + c16 * 16) = w; }
}

__device__ __forceinline__ void phase_ret_u_mfma(const Params& P, const Ctx& cx, LAS unsigned char* lds) {
    unsigned char* ws = cx.ws; const int tid = cx.tid, lane = cx.lane, w = cx.wave, r16 = lane & 15, g = lane >> 4, q = r16 >> 2, pp = r16 & 3;
    const bf16* K = (const bf16*)(ws + WS_K); const bf16* V = (const bf16*)(ws + WS_V); bf16* UT = (bf16*)(ws + WS_U);
    LAS unsigned char* Kim = lds; LAS unsigned char* Vim = lds + TILE_T;
    for (int b = cx.bid; b < 512; b += cx.G) {
        const int nb = b >> 2, h = b & 3;
        __syncthreads();
        stage_tile<true>(Kim, K + (size_t)nb * 128 * 1024 + h * 256, tid, P.lg2g[h]);
        stage_tile<false>(Vim, V + (size_t)nb * 128 * 1024 + h * 256, tid, 0.f);
        __syncthreads();
        f32x4 acc[2][16];
#pragma unroll
        for (int mi = 0; mi < 2; ++mi)
#pragma unroll
            for (int n = 0; n < 16; ++n) acc[mi][n] = (f32x4){0.f, 0.f, 0.f, 0.f};
#pragma unroll 1
        for (int s = 0; s < 4; ++s) {
            bf16x8 af[2];
#pragma unroll
            for (int mi = 0; mi < 2; ++mi) { LAS unsigned char* a0 = Kim + (32 * s + 8 * g + q) * RS_T + (16 * (2 * w + mi) + 4 * pp) * 2; af[mi] = cat44(lds_tr(a0), lds_tr(a0 + 4 * RS_T)); }
#pragma unroll
            for (int n = 0; n < 16; ++n) { LAS unsigned char* b0 = Vim + (32 * s + 8 * g + q) * RS_T + (16 * n + 4 * pp) * 2; const bf16x8 bfr = cat44(lds_tr(b0), lds_tr(b0 + 4 * RS_T));
                acc[0][n] = mfma16(af[0], bfr, acc[0][n]); acc[1][n] = mfma16(af[1], bfr, acc[1][n]); }
        }
#pragma unroll
        for (int mi = 0; mi < 2; ++mi)
#pragma unroll
            for (int n = 0; n < 16; ++n) { v2u o; o.x = cvt2(acc[mi][n][0], acc[mi][n][1]); o.y = cvt2(acc[mi][n][2], acc[mi][n][3]);
                *(v2u*)(UT + ((size_t)b * 256 + 16 * n + r16) * 256 + 16 * (2 * w + mi) + 4 * g) = o; }
    }
}
__device__ __forceinline__ void phase_scan_bf16(const Params& P, const Ctx& cx) {
    unsigned* UT = (unsigned*)(cx.ws + WS_U);
    const size_t gt = (size_t)cx.bid * 512 + cx.tid, NT = (size_t)cx.G * 512;
    for (size_t idx = gt; idx < 131072; idx += NT) {
        const int h = (int)(idx >> 15); const float cd = exp2f(P.lg2g[h] * 128.0f);
        float r0 = 0.f, r1 = 0.f;
        for (int n0 = 0; n0 < 128; n0 += 8) { unsigned u[8];
#pragma unroll
            for (int j = 0; j < 8; ++j) u[j] = UT[(size_t)(n0 + j) * 131072 + idx];
#pragma unroll
            for (int j = 0; j < 8; ++j) { UT[(size_t)(n0 + j) * 131072 + idx] = cvt2(r0, r1); r0 = r0 * cd + bflo(u[j]); r1 = r1 * cd + bfhi(u[j]); } }
    }
}
__device__ __forceinline__ void phase_ret_out_mfma(const Params& P, const Ctx& cx, int l, LAS unsigned char* lds) {
    unsigned char* ws = cx.ws; const int tid = cx.tid, lane = cx.lane, w = cx.wave, r16 = lane & 15, g = lane >> 4, q = r16 >> 2, pp = r16 & 3;
    const bf16* Q = (const bf16*)(ws + WS_Q); const bf16* K = (const bf16*)(ws + WS_K); const bf16* V = (const bf16*)(ws + WS_V); const bf16* ST = (const bf16*)(ws + WS_U);
    const bf16* Gt = (const bf16*)(ws + WS_G); bf16* MIX = (bf16*)(ws + WS_MIX);
    const float* gg = P.in[5] + l * 1024; const float* gb = P.in[6] + l * 1024;
    LAS unsigned char* Kim = lds; LAS unsigned char* Vim = lds + TILE_T;
    for (int b = cx.bid; b < 512; b += cx.G) {
        const int nb = b >> 2, h = b & 3; const float lg = P.lg2g[h];
        __syncthreads();
        stage_tile<false>(Kim, K + (size_t)nb * 128 * 1024 + h * 256, tid, 0.f);
        stage_tile<false>(Vim, V + (size_t)nb * 128 * 1024 + h * 256, tid, 0.f);
        bf16x8 qf[8];
        { const bf16* qrow = Q + (size_t)(nb * 128 + 16 * w + r16) * 1024 + h * 256 + 8 * g;
#pragma unroll
          for (int s = 0; s < 8; ++s) qf[s] = *(const bf16x8*)(qrow + 32 * s); }
        f32x4 acc[16];
        const bf16* strow = ST + ((size_t)b * 256 + r16) * 256 + 8 * g;
#pragma unroll
        for (int n = 0; n < 16; ++n) { bf16x8 sb[8];
#pragma unroll
            for (int s = 0; s < 8; ++s) sb[s] = *(const bf16x8*)(strow + (size_t)n * 16 * 256 + 32 * s);
            f32x4 a = (f32x4){0.f, 0.f, 0.f, 0.f};
#pragma unroll
            for (int s = 0; s < 8; ++s) a = mfma16(qf[s], sb[s], a);
            acc[n] = a; }
        { float f[4];
#pragma unroll
          for (int r = 0; r < 4; ++r) f[r] = exp2f(lg * (float)(16 * w + 4 * g + r + 1));
#pragma unroll
          for (int n = 0; n < 16; ++n) { acc[n][0] *= f[0]; acc[n][1] *= f[1]; acc[n][2] *= f[2]; acc[n][3] *= f[3]; } }
        __syncthreads();
        f32x4 sc[8];
#pragma unroll
        for (int mb = 0; mb < 8; ++mb) { sc[mb] = (f32x4){0.f, 0.f, 0.f, 0.f};
            if (mb <= w) { f32x4 a = (f32x4){0.f, 0.f, 0.f, 0.f};
#pragma unroll
                for (int s = 0; s < 8; ++s) { const bf16x8 kf = *(const LAS bf16x8*)(Kim + (16 * mb + r16) * RS_T + (32 * s + 8 * g) * 2); a = mfma16(kf, qf[s], a); }
                const int i = 16 * w + r16;
#pragma unroll
                for (int r = 0; r < 4; ++r) { const int j = 16 * mb + 4 * g + r; a[r] = (i >= j) ? a[r] * exp2f(lg * (float)(i - j)) : 0.f; }
                sc[mb] = a; } }
#pragma unroll
        for (int sk = 0; sk < 4; ++sk) {
            if (2 * sk <= w) { const bf16x8 pf = pack_frag(sc[2 * sk], sc[2 * sk + 1]);
#pragma unroll
                for (int n = 0; n < 16; ++n) { LAS unsigned char* b0 = Vim + (32 * sk + 4 * g + q) * RS_T + (16 * n + 4 * pp) * 2; const bf16x8 bfr = cat44(lds_tr(b0), lds_tr(b0 + 16 * RS_T));
                    acc[n] = mfma16(pf, bfr, acc[n]); } } }
        float mean[4], rstd[4];
#pragma unroll
        for (int r = 0; r < 4; ++r) { float sm = 0.f;
#pragma unroll
            for (int n = 0; n < 16; ++n) sm += acc[n][r];
            mean[r] = grp16_sum(sm, lane) * (1.0f / 256.0f); }
#pragma unroll
        for (int r = 0; r < 4; ++r) { float sq = 0.f;
#pragma unroll
            for (int n = 0; n < 16; ++n) { const float d = acc[n][r] - mean[r]; sq += d * d; }
            rstd[r] = 1.0f / sqrtf(grp16_sum(sq, lane) * (1.0f / 256.0f) + GN_EPS); }
#pragma unroll
        for (int n = 0; n < 16; ++n) { const int e = h * 256 + 16 * n + r16; const float g1 = gg[e], b1 = gb[e];
#pragma unroll
            for (int r = 0; r < 4; ++r) { const size_t row = (size_t)(nb * 128 + 16 * w + 4 * g + r);
                const float o = ((acc[n][r] - mean[r]) * rstd[r] * g1 + b1) * bf1(Gt + row * 1024 + e);
                MIX[row * 2048 + e] = (bf16)f2bf(o); } }
    }
}
constexpr int RS_SK = 144, RS_SV = 160;
__device__ __forceinline__ void phase_swa_mfma(const Params& P, const Ctx& cx, int l, LAS unsigned char* lds) {
    unsigned char* ws = cx.ws; const int tid = cx.tid, lane = cx.lane, w = cx.wave, r16 = lane & 15, g = lane >> 4, q = r16 >> 2, pp = r16 & 3;
    const bf16* AQ = (const bf16*)(ws + WS_AQ); const bf16* AK = (const bf16*)(ws + WS_AK); const bf16* AV = (const bf16*)(ws + WS_AV); bf16* MIX = (bf16*)(ws + WS_MIX);
    LAS unsigned char* Kim = lds; LAS unsigned char* Vim = lds + 256 * RS_SK;
    for (int item = cx.bid; item < 256; item += cx.G) {
        const int nb = item >> 1, hk = item & 1, hq = hk * 8 + w; const float sink = P.in[7][l * 16 + hq];
        __syncthreads();
#pragma unroll
        for (int r = 0; r < 4; ++r) { const int pc = tid + 512 * r, row = pc >> 3, c = pc & 7, gk = nb * 128 - 128 + row;
            v4u kv = (v4u){0u, 0u, 0u, 0u}, vv = (v4u){0u, 0u, 0u, 0u};
            if (gk >= 0) { kv = *(const v4u*)(AK + (size_t)gk * 128 + hk * 64 + c * 8); vv = *(const v4u*)(AV + (size_t)gk * 128 + hk * 64 + c * 8); }
            *(LAS v4u*)(Kim + row * RS_SK + c * 16) = kv; *(LAS v4u*)(Vim + row * RS_SV + c * 16) = vv; }
        __syncthreads();
#pragma unroll 1
        for (int nq = 0; nq < 8; ++nq) {
            const bf16* qrow = AQ + (size_t)(nb * 128 + 16 * nq + r16) * 1024 + hq * 64 + 8 * g;
            const bf16x8 qf0 = *(const bf16x8*)(qrow), qf1 = *(const bf16x8*)(qrow + 32);
            f32x4 sc[10];
            float mx = sink;
#pragma unroll
            for (int kb = 0; kb < 9; ++kb) { const LAS unsigned char* kp = Kim + (16 * (nq + kb) + r16) * RS_SK + 16 * g;
                f32x4 a = (f32x4){0.f, 0.f, 0.f, 0.f};
                a = mfma16(*(const LAS bf16x8*)(kp), qf0, a); a = mfma16(*(const LAS bf16x8*)(kp + 64), qf1, a);
#pragma unroll
                for (int r = 0; r < 4; ++r) { const int dl = 16 * kb + 4 * g + r - r16; const bool vis = (dl >= 1) && (dl <= 128) && (nb > 0 || 16 * (nq + kb) + 4 * g + r >= 128);
                    a[r] = vis ? a[r] : -INFINITY; mx = fmaxf(mx, a[r]); }
                sc[kb] = a; }
            sc[9] = (f32x4){0.f, 0.f, 0.f, 0.f};
            mx = fmaxf(mx, __builtin_bit_cast(float, __builtin_amdgcn_ds_bpermute((lane ^ 16) << 2, __builtin_bit_cast(int, mx))));
            mx = fmaxf(mx, __builtin_bit_cast(float, __builtin_amdgcn_ds_bpermute((lane ^ 32) << 2, __builtin_bit_cast(int, mx))));
            float sum = 0.f;
#pragma unroll
            for (int kb = 0; kb < 9; ++kb)
#pragma unroll
                for (int r = 0; r < 4; ++r) { const float pv = __expf(sc[kb][r] - mx); sc[kb][r] = pv; sum += pv; }
            sum += __builtin_bit_cast(float, __builtin_amdgcn_ds_bpermute((lane ^ 16) << 2, __builtin_bit_cast(int, sum)));
            sum += __builtin_bit_cast(float, __builtin_amdgcn_ds_bpermute((lane ^ 32) << 2, __builtin_bit_cast(int, sum)));
            const float inv = 1.0f / (sum + __expf(sink - mx));
            f32x4 o[4];
#pragma unroll
            for (int nd = 0; nd < 4; ++nd) o[nd] = (f32x4){0.f, 0.f, 0.f, 0.f};
#pragma unroll
            for (int sk = 0; sk < 5; ++sk) { const bf16x8 pf = pack_frag(sc[2 * sk] * inv, sc[2 * sk + 1] * inv);
                const int kb0 = nq + 2 * sk, kb1 = (kb0 + 1 > 15) ? 15 : kb0 + 1;
#pragma unroll
                for (int nd = 0; nd < 4; ++nd) { const bf16x8 bfr = cat44(lds_tr(Vim + (16 * kb0 + 4 * g + q) * RS_SV + (16 * nd + 4 * pp) * 2), lds_tr(Vim + (16 * kb1 + 4 * g + q) * RS_SV + (16 * nd + 4 * pp) * 2));
                    o[nd] = mfma16(pf, bfr, o[nd]); } }
#pragma unroll
            for (int nd = 0; nd < 4; ++nd)
#pragma unroll
                for (int r = 0; r < 4; ++r) MIX[(size_t)(nb * 128 + 16 * nq + 4 * g + r) * 2048 + 1024 + hq * 64 + 16 * nd + r16] = (bf16)f2bf(o[nd][r]);
        }
    }
}

__device__ __forceinline__ void phase_groupnorm(const Params& P, const Ctx& cx, int l) {
    unsigned char* ws = cx.ws; const int lane = cx.lane, wave = cx.wave, G = cx.G;
    const float* RY = (const float*)(ws + WS_RETY); const bf16* Gt = (const bf16*)(ws + WS_G); bf16* MIX = (bf16*)(ws + WS_MIX);
    const float* gg = P.in[5] + l * 1024; const float* gb = P.in[6] + l * 1024;
    const int gw = cx.bid * 8 + wave, NGW = G * 8;
    for (int it = gw; it < S * 4; it += NGW) { const int row = it >> 2, h = it & 3; const size_t off = (size_t)row * 1024 + h * 256 + 4 * lane;
        f32x4 v = *(const f32x4*)(RY + off);
        const float mean = wave_sum((v[0] + v[1]) + (v[2] + v[3]), lane) * (1.0f / 256.0f);
        v = v - mean;
        const float var = wave_sum((v[0] * v[0] + v[1] * v[1]) + (v[2] * v[2] + v[3] * v[3]), lane) * (1.0f / 256.0f);
        const float rstd = 1.0f / sqrtf(var + GN_EPS);
        const f32x4 g4 = *(const f32x4*)(gg + h * 256 + 4 * lane), b4 = *(const f32x4*)(gb + h * 256 + 4 * lane);
        const v2u gt2 = *(const v2u*)(Gt + off);
        f32x4 o = v * rstd * g4 + b4;
        o[0] *= bflo(gt2.x); o[1] *= bfhi(gt2.x); o[2] *= bflo(gt2.y); o[3] *= bfhi(gt2.y);
        v2u w; w.x = pk2(o[0], o[1]); w.y = pk2(o[2], o[3]);
        *(v2u*)(MIX + (size_t)row * 2048 + h * 256 + 4 * lane) = w; }
}
__device__ __forceinline__ void phase_ln(const Ctx& cx, const float* Y, const float* g, const float* b, float* xo, bf16* xb, float* stats) {
    const int lane = cx.lane, wave = cx.wave, G = cx.G; const int gw = cx.bid * 8 + wave, NGW = G * 8;
    f32x4 g4[8], b4[8];
#pragma unroll
    for (int j = 0; j < 8; ++j) { g4[j] = ((const f32x4*)g)[64 * j + lane]; b4[j] = ((const f32x4*)b)[64 * j + lane]; }
    for (int row = gw; row < S; row += 2 * NGW) {
        const int row2 = row + NGW; const bool has2 = row2 < S; const int rb = has2 ? row2 : row;
        const f32x4* ya = (const f32x4*)(Y + (size_t)row * D) + lane; const f32x4* yb = (const f32x4*)(Y + (size_t)rb * D) + lane;
        f32x4 va[8], vb[8]; float sa = 0.f, sb = 0.f;
#pragma unroll
        for (int j = 0; j < 8; ++j) { va[j] = ya[64 * j]; vb[j] = yb[64 * j]; }
#pragma unroll
        for (int j = 0; j < 8; ++j) { sa += (va[j][0] + va[j][1]) + (va[j][2] + va[j][3]); sb += (vb[j][0] + vb[j][1]) + (vb[j][2] + vb[j][3]); }
        const float ma = wave_sum(sa, lane) * (1.0f / D), mb = wave_sum(sb, lane) * (1.0f / D); float qa = 0.f, qb = 0.f;
#pragma unroll
        for (int j = 0; j < 8; ++j) { va[j] = va[j] - ma; vb[j] = vb[j] - mb; qa += (va[j][0] * va[j][0] + va[j][1] * va[j][1]) + (va[j][2] * va[j][2] + va[j][3] * va[j][3]); qb += (vb[j][0] * vb[j][0] + vb[j][1] * vb[j][1]) + (vb[j][2] * vb[j][2] + vb[j][3] * vb[j][3]); }
        const float ra = 1.0f / sqrtf(wave_sum(qa, lane) * (1.0f / D) + LN_EPS), rbb = 1.0f / sqrtf(wave_sum(qb, lane) * (1.0f / D) + LN_EPS);
        f32x4* xa = (f32x4*)(xo + (size_t)row * D) + lane; f32x4* xbp = (f32x4*)(xo + (size_t)rb * D) + lane;
        if (stats && lane == 0) { stats[2 * (size_t)row] = ma; stats[2 * (size_t)row + 1] = ra; if (has2) { stats[2 * (size_t)rb] = mb; stats[2 * (size_t)rb + 1] = rbb; } }
#pragma unroll
        for (int j = 0; j < 8; ++j) { const f32x4 o = va[j] * ra * g4[j] + b4[j]; if (xo) xa[64 * j] = o;
            if (xb) { v2u w; w.x = pk2(o[0], o[1]); w.y = pk2(o[2], o[3]); ((v2u*)(xb + (size_t)row * D))[64 * j + lane] = w; } }
        if (has2) {
#pragma unroll
            for (int j = 0; j < 8; ++j) { const f32x4 o = vb[j] * rbb * g4[j] + b4[j]; if (xo) xbp[64 * j] = o;
                if (xb) { v2u w; w.x = pk2(o[0], o[1]); w.y = pk2(o[2], o[3]); ((v2u*)(xb + (size_t)rb * D))[64 * j + lane] = w; } } }
    }
}
__device__ __forceinline__ void unpack8(const v4u h, float (&o)[8]) { o[0] = bflo(h.x); o[1] = bfhi(h.x); o[2] = bflo(h.y); o[3] = bfhi(h.y); o[4] = bflo(h.z); o[5] = bfhi(h.z); o[6] = bflo(h.w); o[7] = bfhi(h.w); }
__device__ __forceinline__ void phase_convact(const Params& P, const Ctx& cx, int l) {
    unsigned char* ws = cx.ws; const int tid = cx.tid, G = cx.G;
    const bf16* H = (const bf16*)(ws + WS_H); bf16* ACT = (bf16*)(ws + WS_ACT);
    const float* cw = P.in[11] + (size_t)l * 3 * NUP; const float* cb = P.in[12] + (size_t)l * NUP;
    const int gt = cx.bid * 512 + tid, NT = G * 512;
    for (int item = gt; item < 512 * 704; item += NT) {
        const int seg = item / 704, r = item - seg * 704, tile = r >> 4, q8 = r & 15, t0 = seg * 32;
        const int chg = 128 * tile + 8 * q8, chu = DFF + chg;
        float wg[3][8], wu[3][8], bg[8], bu[8];
#pragma unroll
        for (int k = 0; k < 3; ++k) { const f32x4 a0 = *(const f32x4*)(cw + (size_t)k * NUP + chg), a1 = *(const f32x4*)(cw + (size_t)k * NUP + chg + 4), c0 = *(const f32x4*)(cw + (size_t)k * NUP + chu), c1 = *(const f32x4*)(cw + (size_t)k * NUP + chu + 4);
#pragma unroll
            for (int e = 0; e < 4; ++e) { wg[k][e] = a0[e]; wg[k][4 + e] = a1[e]; wu[k][e] = c0[e]; wu[k][4 + e] = c1[e]; } }
        { const f32x4 a0 = *(const f32x4*)(cb + chg), a1 = *(const f32x4*)(cb + chg + 4), c0 = *(const f32x4*)(cb + chu), c1 = *(const f32x4*)(cb + chu + 4);
#pragma unroll
          for (int e = 0; e < 4; ++e) { bg[e] = a0[e]; bg[4 + e] = a1[e]; bu[e] = c0[e]; bu[4 + e] = c1[e]; } }
        const bf16* hp = H + (size_t)t0 * NUP + 256 * tile + 8 * q8;
        float g2[8], g1[8], u2[8], u1[8];
        if (t0 > 0) { unpack8(*(const v4u*)(hp - 2 * (size_t)NUP), g2); unpack8(*(const v4u*)(hp - (size_t)NUP), g1); unpack8(*(const v4u*)(hp - 2 * (size_t)NUP + 128), u2); unpack8(*(const v4u*)(hp - (size_t)NUP + 128), u1); }
        else {
#pragma unroll
            for (int e = 0; e < 8; ++e) { g2[e] = 0.f; g1[e] = 0.f; u2[e] = 0.f; u1[e] = 0.f; } }
        bf16* ap = ACT + (size_t)t0 * DFF + chg;
        v4u ng = *(const v4u*)(hp), nu = *(const v4u*)(hp + 128);
#pragma unroll 2
        for (int tt = 0; tt < 32; ++tt) {
            float g0[8], u0[8]; unpack8(ng, g0); unpack8(nu, u0);
            if (tt < 31) { ng = *(const v4u*)(hp + (size_t)(tt + 1) * NUP); nu = *(const v4u*)(hp + (size_t)(tt + 1) * NUP + 128); }
            float o[8];
#pragma unroll
            for (int e = 0; e < 8; ++e) { const float ga = bg[e] + wg[0][e] * g2[e] + wg[1][e] * g1[e] + wg[2][e] * g0[e], ua = bu[e] + wu[0][e] * u2[e] + wu[1][e] * u1[e] + wu[2][e] * u0[e];
                o[e] = ga * __builtin_amdgcn_rcpf(1.0f + __expf(-ga)) * ua; g2[e] = g1[e]; g1[e] = g0[e]; u2[e] = u1[e]; u1[e] = u0[e]; }
            v4u w; w.x = cvt2(o[0], o[1]); w.y = cvt2(o[2], o[3]); w.z = cvt2(o[4], o[5]); w.w = cvt2(o[6], o[7]);
            *(v4u*)(ap + (size_t)tt * DFF) = w;
        }
    }
}

__device__ __forceinline__ void phase_conv_fixup(const Params& P, const Ctx& cx, int l) {
    unsigned char* ws = cx.ws;
    const bf16* HALO = (const bf16*)(ws + WS_H); bf16* ACT = (bf16*)(ws + WS_ACT);
    const float* cw = P.in[11] + (size_t)l * 3 * NUP; const float* cb = P.in[12] + (size_t)l * NUP;
    const int gt = cx.bid * 512 + cx.tid, NT = cx.G * 512;
    for (int item = gt; item < 256 * 704; item += NT) {
        const int k = item / 704, r = item - k * 704, tile = r >> 4, q8 = r & 15, chg = 128 * tile + 8 * q8, chu = DFF + chg;
        float a_g[8], b_g[8], c_g[8], d_g[8], a_u[8], b_u[8], c_u[8], d_u[8];
        const bf16* hk = HALO + (size_t)k * 4 * NUP + 256 * tile + 8 * q8;
        unpack8(*(const v4u*)(hk), c_g); unpack8(*(const v4u*)(hk + NUP), d_g); unpack8(*(const v4u*)(hk + 128), c_u); unpack8(*(const v4u*)(hk + NUP + 128), d_u);
        if (k > 0) { const bf16* hm = hk - 4 * (size_t)NUP; unpack8(*(const v4u*)(hm + 2 * NUP), a_g); unpack8(*(const v4u*)(hm + 3 * NUP), b_g); unpack8(*(const v4u*)(hm + 2 * NUP + 128), a_u); unpack8(*(const v4u*)(hm + 3 * NUP + 128), b_u); }
        else {
#pragma unroll
            for (int e = 0; e < 8; ++e) { a_g[e] = 0.f; b_g[e] = 0.f; a_u[e] = 0.f; b_u[e] = 0.f; } }
        float o0[8], o1[8];
#pragma unroll
        for (int e = 0; e < 8; ++e) { const float w0g = cw[chg + e], w1g = cw[NUP + chg + e], w2g = cw[2 * NUP + chg + e], bgv = cb[chg + e], w0u = cw[chu + e], w1u = cw[NUP + chu + e], w2u = cw[2 * NUP + chu + e], buv = cb[chu + e];
            const float g0 = bgv + w0g * a_g[e] + w1g * b_g[e] + w2g * c_g[e], u0 = buv + w0u * a_u[e] + w1u * b_u[e] + w2u * c_u[e];
            const float g1 = bgv + w0g * b_g[e] + w1g * c_g[e] + w2g * d_g[e], u1 = buv + w0u * b_u[e] + w1u * c_u[e] + w2u * d_u[e];
            o0[e] = g0 * __builtin_amdgcn_rcpf(1.0f + __expf(-g0)) * u0; o1[e] = g1 * __builtin_amdgcn_rcpf(1.0f + __expf(-g1)) * u1; }
        v4u w0, w1; w0.x = cvt2(o0[0], o0[1]); w0.y = cvt2(o0[2], o0[3]); w0.z = cvt2(o0[4], o0[5]); w0.w = cvt2(o0[6], o0[7]); w1.x = cvt2(o1[0], o1[1]); w1.y = cvt2(o1[2], o1[3]); w1.z = cvt2(o1[4], o1[5]); w1.w = cvt2(o1[6], o1[7]);
        *(v4u*)(ACT + (size_t)(64 * k) * DFF + chg) = w0; *(v4u*)(ACT + (size_t)(64 * k + 1) * DFF + chg) = w1;
    }
}

#ifdef DBG_DUMP
__device__ __forceinline__ void phase_dump(const Ctx& cx, float* out, const bf16* a, int lda, const bf16* b, int ldb, const float* f) {
    const size_t gt = (size_t)cx.bid * 512 + cx.tid, NT = (size_t)cx.G * 512;
    for (size_t i = gt; i < (size_t)S * D; i += NT) { const int row = (int)(i >> 11), col = (int)(i & 2047);
        float v; if (f) v = f[i]; else if (b && col >= 1024) v = bf1(b + (size_t)row * ldb + (col - 1024)); else v = lda ? bf1(a + (size_t)row * lda + col) : bf1(a + (size_t)(row & 2047) * 2048 + col);
        out[i] = v; }
}
#endif
__global__ void __launch_bounds__(512, 2) fwd(Params P) {
    extern __shared__ __attribute__((aligned(16))) unsigned char lds_raw[];
    LAS unsigned char* lds = (LAS unsigned char*)lds_raw;
    const int wave = __builtin_amdgcn_readfirstlane(threadIdx.x >> 6), G = gridDim.x;
    unsigned char* ws = P.ws;
    volatile LAS unsigned* MISC = (volatile LAS unsigned*)(lds + MISC_OFF);
    for (int u = threadIdx.x; u < (LDS_BYTES - LDSCTL_OFF) / 4; u += 512) ((LAS unsigned*)(lds + LDSCTL_OFF))[u] = 0u;
    __syncthreads();
    const int lo = P.ph_lo, hi = P.ph_hi;
    XcdBarrier bar; bar.bar = (unsigned*)(ws + WS_CTL) + CW_BAR; bar.x = 0; bar.st = nullptr;
    if (hi - lo > 1) bar = xcd_barrier_post((unsigned*)(ws + WS_CTL) + CW_BAR, MISC + 8);
#define IN(k) (lo <= (k) && (k) < hi)
#define SEAM(k) do { if (IN(k) && IN((k) + 1)) xcd_barrier(bar); } while (0)
#define OPQ() Ctx cx; cx.lane = lane_id_asm(); { int t_ = wave; asm volatile("" : "+s"(t_)); cx.wave = t_; } { int t_ = G; asm volatile("" : "+s"(t_)); cx.G = t_; } { int t_ = blockIdx.x; asm volatile("" : "+s"(t_)); cx.bid = t_; } \
    { unsigned t_ = 0u; asm volatile("" : "+s"(t_)); cx.ws = P.ws + t_; } cx.tid = cx.wave * 64 + cx.lane; int lq = l; asm volatile("" : "+s"(lq)); (void)lq

#ifdef DBG_DUMP
    if (lo >= 1000) { const int l = 0; OPQ(); unsigned char* w = cx.ws; const int kind = lo - 1000;
        if (kind == 1) phase_dump(cx, P.out, (const bf16*)(w + WS_Q), 1024, (const bf16*)(w + WS_AQ), 1024, nullptr);
        else if (kind == 2) phase_dump(cx, P.out, (const bf16*)(w + WS_MIX), 2048, nullptr, 0, nullptr);
        else if (kind == 3) phase_dump(cx, P.out, nullptr, 0, nullptr, 0, (const float*)(w + WS_XR));
        else if (kind == 4) phase_dump(cx, P.out, (const bf16*)(w + WS_ACT), DFF, nullptr, 0, nullptr);
        else if (kind == 5) phase_dump(cx, P.out, nullptr, 0, nullptr, 0, (const float*)(w + WS_Y));
        else if (kind == 6) phase_dump(cx, P.out, (const bf16*)(w + WS_K), 1024, (const bf16*)(w + WS_V), 1024, nullptr);
        else if (kind == 7) phase_dump(cx, P.out, (const bf16*)(w + WS_XB), 2048, nullptr, 0, nullptr);
        else if (kind == 11) phase_dump(cx, P.out, (const bf16*)(w + WS_W + WL_G), 0, nullptr, 0, nullptr);
        else if (kind == 12) phase_dump(cx, P.out, (const bf16*)(w + WS_W + WL_OUT), 0, nullptr, 0, nullptr);
        else if (kind == 10) phase_dump(cx, P.out, (const bf16*)(w + WS_H) + 36 * 256, NUP, nullptr, 0, nullptr);
        else if (kind == 9) phase_dump(cx, P.out, (const bf16*)(w + WS_SG), 2048, nullptr, 0, nullptr);
        else if (kind == 8) phase_dump(cx, P.out, nullptr, 0, nullptr, 0, (const float*)(w + WS_RETY));
        return; }
#endif
    if (IN(0)) { const int l = 0; REPS(2) { __syncthreads(); OPQ(); phase_prologue(P, cx, lds); } }
    SEAM(0);

    for (int l = 0; l < DEPTH; ++l) {
        const int pb = 1 + l * NPH;
        if (IN(pb + 0)) { OPQ(); unsigned char* w = cx.ws; const bf16* wl = (const bf16*)(w + WS_W + (size_t)lq * WL_BYTES);
            pg8::Gemm g{(const bf16*)(w + WS_XB), wl + WL_IN / 2, S, INW, D}; pg8::StaticOrder So; So.init(S, INW, cx.G, cx.bid);
            pg8::EpiInProj E{(bf16*)(w + WS_Q), (bf16*)(w + WS_K), (bf16*)(w + WS_V), (bf16*)(w + WS_G), (bf16*)(w + WS_AQ), (bf16*)(w + WS_AK), (bf16*)(w + WS_AV),
                             (const float*)(w + WS_COSR), (const float*)(w + WS_SINR), (const float*)(w + WS_COSA), (const float*)(w + WS_SINA)};
            pg8::gemm_phase<pg8::EpiInProj, pg8::StaticOrder, true, true>(lds, g, So, E, cx.wave);
        }
#if PLE_EARLY
        if (IN(pb + 0)) { OPQ(); unsigned char* w = cx.ws; const bf16* wl = (const bf16*)(w + WS_W + (size_t)lq * WL_BYTES);
            const int nsub = (cx.G > 64) ? cx.G - 64 : cx.G, csub = (cx.G > 64) ? cx.bid - 64 : cx.bid;
            if (csub >= 0) {
                int kple = PLE; asm volatile("" : "+s"(kple));
                pg8::Gemm g{(const bf16*)(w + WS_PB) + (size_t)lq * S * PLE, wl + WL_P / 2, S, D, kple}; pg8::StaticOrder So; So.init(S, D, nsub, csub);
                pg8::EpiPlain E{(bf16*)(w + WS_PP)};
                pg8::gemm_phase<pg8::EpiPlain, pg8::StaticOrder, true, true>(lds, g, So, E, cx.wave); }
        }
#endif
        SEAM(pb + 0);
        if (IN(pb + 1)) {
#if RET_MFMA
            { REPS(2) { OPQ(); phase_ret_u_mfma(P, cx, lds); } }
#else
            { OPQ(); phase_ret_u_scores(P, cx, lds); }
#endif
#if SWA_MFMA
            { REPS(2) { OPQ(); phase_swa_mfma(P, cx, lq, lds); } }
#else
            { OPQ(); phase_swa(P, cx, lq, lds); }
#endif
        }
        SEAM(pb + 1);
#if RET_MFMA
        if (IN(pb + 2)) { OPQ(); phase_scan_bf16(P, cx); }
        SEAM(pb + 2);
        if (IN(pb + 3)) { REPS(2) { OPQ(); phase_ret_out_mfma(P, cx, lq, lds); } }
        SEAM(pb + 3);
#else
        if (IN(pb + 2)) { OPQ(); phase_scan(P, cx); }
        SEAM(pb + 2);
        if (IN(pb + 3)) { OPQ(); phase_ret_out(P, cx, lds); }
        SEAM(pb + 3);
        if (IN(pb + 4)) { OPQ(); phase_groupnorm(P, cx, lq); }
        SEAM(pb + 4);
#endif
        if (IN(pb + 5)) { OPQ(); unsigned char* w = cx.ws; const bf16* wl = (const bf16*)(w + WS_W + (size_t)lq * WL_BYTES);
            pg8::Gemm g{(const bf16*)(w + WS_MIX), wl + WL_OUT / 2, S, D, D}; pg8::StaticOrder So; So.init(S, D, cx.G, cx.bid);
#if LN_NOXR
            if (lq == 0) { pg8::EpiResid<false> E{P.in[0], (float*)(w + WS_Y), ALPHA};
                pg8::gemm_phase<pg8::EpiResid<false>, pg8::StaticOrder, true, true>(lds, g, So, E, cx.wave); }
            else { pg8::EpiResidLN<false> E{(float*)(w + WS_Y), (const float*)(w + WS_ST2), P.in[14] + (lq - 1) * D, P.in[15] + (lq - 1) * D, nullptr, nullptr, ALPHA};
                pg8::gemm_phase<pg8::EpiResidLN<false>, pg8::StaticOrder, true, true>(lds, g, So, E, cx.wave); }
#else
            pg8::EpiResid<false> E{(lq == 0) ? P.in[0] : (const float*)(w + WS_XR), (float*)(w + WS_Y), ALPHA};
            pg8::gemm_phase<pg8::EpiResid<false>, pg8::StaticOrder, true, true>(lds, g, So, E, cx.wave);
#endif
        }
        SEAM(pb + 5);
        if (IN(pb + 6)) { REPS(1) { OPQ(); unsigned char* w = cx.ws;
#if LN_NOXR
            phase_ln(cx, (const float*)(w + WS_Y), P.in[8] + lq * D, P.in[9] + lq * D, (float*)nullptr, (bf16*)(w + WS_XB), (float*)(w + WS_ST1));
#else
            phase_ln(cx, (const float*)(w + WS_Y), P.in[8] + lq * D, P.in[9] + lq * D, (float*)(w + WS_XR), (bf16*)(w + WS_XB), (float*)nullptr);
#endif
        } }
        SEAM(pb + 6);
        if (IN(pb + 7)) { OPQ(); unsigned char* w = cx.ws; const bf16* wl = (const bf16*)(w + WS_W + (size_t)lq * WL_BYTES);
            pg8::Gemm g{(const bf16*)(w + WS_XB), wl + WL_UP / 2, S, NUPG, D}; pg8::StaticOrder So; So.init(S, NUPG, cx.G, cx.bid);
#if CONV_FUSED
            pg8::EpiUpConv E{(bf16*)(w + WS_ACT), (bf16*)(w + WS_H), (bf16*)(w + WS_SG), P.in[17] + lq * D, P.in[11] + (size_t)lq * 3 * NUP, P.in[12] + (size_t)lq * NUP};
            pg8::gemm_phase<pg8::EpiUpConv, pg8::StaticOrder, true, true>(lds, g, So, E, cx.wave);
#else
            pg8::EpiUp E{(bf16*)(w + WS_H), (bf16*)(w + WS_SG), P.in[17] + lq * D};
            pg8::gemm_phase<pg8::EpiUp, pg8::StaticOrder, true, true>(lds, g, So, E, cx.wave);
#endif
        }
        SEAM(pb + 7);
        if (IN(pb + 8)) {
#if !PLE_EARLY
            { OPQ(); unsigned char* w = cx.ws; const bf16* wl = (const bf16*)(w + WS_W + (size_t)lq * WL_BYTES);
              pg8::Gemm g{(const bf16*)(w + WS_PB) + (size_t)lq * S * PLE, wl + WL_P / 2, S, D, PLE}; pg8::StaticOrder So; So.init(S, D, cx.G, cx.bid);
              pg8::EpiPle E{(const bf16*)(w + WS_SG), (float*)(w + WS_Y)};
              pg8::gemm_phase<pg8::EpiPle, pg8::StaticOrder, true, true>(lds, g, So, E, cx.wave); }
#endif
#if CONV_FUSED
            { OPQ(); phase_conv_fixup(P, cx, lq); }
#else
            { REPS(1) { OPQ(); phase_convact(P, cx, lq); } }
#endif
        }
        SEAM(pb + 8);
        if (IN(pb + 9)) { OPQ(); unsigned char* w = cx.ws; const bf16* wl = (const bf16*)(w + WS_W + (size_t)lq * WL_BYTES);
            pg8::Gemm g{(const bf16*)(w + WS_ACT), wl + WL_DOWN / 2, S, D, DFF}; pg8::StaticOrder So; So.init(S, D, cx.G, cx.bid);
#if PLE_EARLY
#if LN_NOXR
            pg8::EpiResidLN<true> E{(float*)(w + WS_Y), (const float*)(w + WS_ST1), P.in[8] + lq * D, P.in[9] + lq * D, (const bf16*)(w + WS_PP), (const bf16*)(w + WS_SG), ALPHA};
            pg8::gemm_phase<pg8::EpiResidLN<true>, pg8::StaticOrder, true, true>(lds, g, So, E, cx.wave);
#else
            pg8::EpiDown E{(const float*)(w + WS_XR), (float*)(w + WS_Y), (const bf16*)(w + WS_PP), (const bf16*)(w + WS_SG), ALPHA};
            pg8::gemm_phase<pg8::EpiDown, pg8::StaticOrder, true, true>(lds, g, So, E, cx.wave);
#endif
#else
            pg8::EpiResid<true> E{(const float*)(w + WS_XR), (float*)(w + WS_Y), ALPHA};
            pg8::gemm_phase<pg8::EpiResid<true>, pg8::StaticOrder, true, true>(lds, g, So, E, cx.wave);
#endif
        }
        SEAM(pb + 9);
        if (IN(pb + 10)) { REPS(1) { OPQ(); unsigned char* w = cx.ws; const bool last = (lq == DEPTH - 1);

#if LN_NOXR
            phase_ln(cx, (const float*)(w + WS_Y), P.in[14] + lq * D, P.in[15] + lq * D, last ? P.out : (float*)nullptr, last ? (bf16*)nullptr : (bf16*)(w + WS_XB), last ? (float*)nullptr : (float*)(w + WS_ST2));
#else
            phase_ln(cx, (const float*)(w + WS_Y), P.in[14] + lq * D, P.in[15] + lq * D, last ? P.out : (float*)(w + WS_XR), last ? (bf16*)nullptr : (bf16*)(w + WS_XB), (float*)nullptr);
#endif
        } }
        SEAM(pb + 10);
    }
#undef IN
#undef SEAM
}

extern "C" void kernel_launch(void* const* d_in, const int* in_sizes, int n_in, void* d_out, int out_size, void* d_ws, size_t ws_size, hipStream_t stream) {
    static int grid = 0;
    if (grid == 0) {
        if (n_in != 19 || in_sizes[0] != S * D || out_size != S * D || ws_size < WS_END) { fprintf(stderr, "kernel_launch: unexpected shapes (n_in %d, in0 %d, out %d, ws %zu)\n", n_in, n_in > 0 ? in_sizes[0] : -1, out_size, ws_size); grid = -1; return; }
        int dev = 0, cus = 0, per_cu = 0;
        if (hipGetDevice(&dev) != hipSuccess || hipDeviceGetAttribute(&cus, hipDeviceAttributeMultiprocessorCount, dev) != hipSuccess) { grid = -1; return; }
        if (hipFuncSetAttribute((const void*)fwd, hipFuncAttributeMaxDynamicSharedMemorySize, LDS_BYTES) != hipSuccess) { fprintf(stderr, "kernel_launch: hipFuncSetAttribute failed\n"); grid = -1; return; }
        if (hipOccupancyMaxActiveBlocksPerMultiprocessor(&per_cu, (const void*)fwd, 512, LDS_BYTES) != hipSuccess || per_cu < 1) fprintf(stderr, "kernel_launch: occupancy query says %d\n", per_cu);
        (void)hipGetLastError();
        grid = cus;
    }
    if (grid < 0) return;
    (void)hipMemsetAsync((char*)d_ws + WS_CTL, 0, CTL_ZERO_BYTES, stream);
#ifdef DBG_NANFILL
    (void)hipMemsetAsync((char*)d_ws + CTL_ZERO_BYTES, 0xFF, WS_END - CTL_ZERO_BYTES, stream);
#endif
    Params p{};
    for (int i = 0; i < 19; ++i) p.in[i] = (const float*)d_in[i];
    p.out = (float*)d_out; p.ws = (unsigned char*)d_ws;
    for (int f = 0; f < 128; ++f) p.invf_ret[f] = (float)(1.0 / std::pow(10000.0, (double)((float)f / 127.0f)));
    for (int f = 0; f < 32; ++f) p.invf_att[f] = (float)std::pow(10000.0, -(double)(2 * f) / 64.0);
    for (int h = 0; h < 4; ++h) p.lg2g[h] = (float)std::log2(1.0 - std::exp2(-5.0 - h));
#if MK_ONE_LAUNCH
    p.ph_lo = 0; p.ph_hi = NPHASES;
    hipLaunchKernelGGL(fwd, dim3(grid), dim3(512), LDS_BYTES, stream, p);
#else
#ifdef DBG_DUMP
    for (int ph = 0; ph <= DBG_STOP; ++ph) { p.ph_lo = ph; p.ph_hi = ph + 1; hipLaunchKernelGGL(fwd, dim3(grid), dim3(512), LDS_BYTES, stream, p); }
    p.ph_lo = 1000 + DBG_DUMP; p.ph_hi = p.ph_lo + 1; hipLaunchKernelGGL(fwd, dim3(grid), dim3(512), LDS_BYTES, stream, p);
#else
    for (int ph = 0; ph < NPHASES; ++ph) { p.ph_lo = ph; p.ph_hi = ph + 1; hipLaunchKernelGGL(fwd, dim3(grid), dim3(512), LDS_BYTES, stream, p); }
#endif
#endif
}
```

```cpp
#include <hip/hip_runtime.h>
#include <cstdio>
#include <cstdint>
#include <cmath>
#define MK_ONE_LAUNCH 1
namespace pg8 {
#define PG8_LAS __attribute__((address_space(3)))
typedef unsigned short bf16_t;
typedef short bf16x8 __attribute__((ext_vector_type(8)));
typedef float f32x4 __attribute__((ext_vector_type(4)));
typedef unsigned u32x4 __attribute__((ext_vector_type(4)));
constexpr int BM = 256, BK = 64, HALF = 128, HTB = HALF * BK * 2  , STAGE_BYTES = 8 * HTB, NXCD = 8, WGM = 8;

__host__ __device__ __forceinline__ int lds_byte(int r, int c) { const int st = (r >> 4) * 2 + (c >> 5), rr = r & 15, cc = c & 31, ob = rr * 64 + cc * 2; return st * 1024 + (ob ^ (((ob >> 9) & 1) << 5)); }
__host__ __device__ __forceinline__ void stage_rc(int b, int& R, int& C) { const int st = b / 1024, sb = b % 1024, swz = sb ^ (((sb >> 9) & 1) << 5); R = (st >> 1) * 16 + swz / 64; C = (st & 1) * 32 + (swz % 64) / 2; }
__host__ __device__ __forceinline__ int perm32(int rho) { const int n = rho >> 4, i = rho & 15; return 8 * (i >> 2) + 4 * n + (i & 3); }

struct Unit { int pm, pn; };
struct Gemm { const bf16_t* A; const bf16_t* Bt; int M, N, K; };

struct StaticOrder {
    int nM, nN, nwg, G, c;
    __host__ __device__ void init(int M, int N, int G_, int c_) { nM = M / BM; nN = N / BM; nwg = nM * nN; G = G_; c = c_; }
    __host__ __device__ bool next(int i, Unit& u) const {
        const long L = (long)i * G + c; if (L >= nwg) return false;
        int wgid = (int)L; { const int q = nwg / NXCD, r = nwg % NXCD, xcd = wgid % NXCD, off = wgid / NXCD; wgid = (xcd < r ? xcd * (q + 1) : r * (q + 1) + (xcd - r) * q) + off; }
        const int nig = WGM * nN, gid = wgid / nig, fm = gid * WGM, gsz = (nM - fm) < WGM ? (nM - fm) : WGM;
        u.pm = fm + ((wgid % nig) % gsz); u.pn = (wgid % nig) / gsz; return true;
    }
    __device__ __forceinline__ void a_ready(const Unit&) const {}
    __device__ __forceinline__ void done(const Unit&) const {}
};

typedef float f32x2c_t __attribute__((ext_vector_type(2))); typedef __bf16 bf16x2c_t __attribute__((ext_vector_type(2)));
__device__ __forceinline__ unsigned cvt_pk_bf16(float lo, float hi) { f32x2c_t v = {lo, hi}; bf16x2c_t b = __builtin_convertvector(v, bf16x2c_t); return __builtin_bit_cast(unsigned, b); }
typedef float f32x2 __attribute__((ext_vector_type(2)));
typedef unsigned u32x2 __attribute__((ext_vector_type(2)));
__device__ __forceinline__ float bf2f(unsigned short b) { return __uint_as_float(((unsigned)b) << 16); }
__device__ __forceinline__ u32x4 pack8(const f32x4 a, const f32x4 b) { u32x4 w; w.x = cvt_pk_bf16(a[0], a[1]); w.y = cvt_pk_bf16(a[2], a[3]); w.z = cvt_pk_bf16(b[0], b[1]); w.w = cvt_pk_bf16(b[2], b[3]); return w; }
__device__ __forceinline__ float sigmoidf_(float x) { return __builtin_amdgcn_rcpf(1.0f + __expf(-x)); }

struct EpiInProj {
    static constexpr bool PERM = true, AFTER_DRAIN = false;
    bf16_t *Q, *K, *V, *G, *AQ, *AK, *AV; const float *cosr, *sinr, *cosa, *sina;
    __device__ __forceinline__ void operator()(const f32x4 (&acc)[2][2][4][2], const Unit& u, int wr, int wc, int fr, int fq) const {
        const int row0 = u.pm * BM + wr * 64 + fr, pn = u.pn, cw = wc * 32 + 8 * fq;
        if (pn < 8) {
            bf16_t* O = pn < 4 ? Q : K; const int hcol = (pn & 3) * 256; const float sc = pn < 4 ? 1.0f : 0.0625f;
#pragma unroll
            for (int ai = 0; ai < 2; ++ai)
#pragma unroll
                for (int m = 0; m < 4; ++m) { const int row = row0 + ai * HALF + m * 16;
                    const f32x4 c0 = *(const f32x4*)(cosr + (size_t)row * 128 + cw), c1 = *(const f32x4*)(cosr + (size_t)row * 128 + cw + 4);
                    const f32x4 s0 = *(const f32x4*)(sinr + (size_t)row * 128 + cw), s1 = *(const f32x4*)(sinr + (size_t)row * 128 + cw + 4);
                    const f32x4 a0 = acc[ai][0][m][0], a1 = acc[ai][0][m][1], b0 = acc[ai][1][m][0], b1 = acc[ai][1][m][1];
                    const f32x4 o10 = (a0 * c0 - b0 * s0) * sc, o11 = (a1 * c1 - b1 * s1) * sc, o20 = (a0 * s0 + b0 * c0) * sc, o21 = (a1 * s1 + b1 * c1) * sc;
                    bf16_t* rowp = O + (size_t)row * 1024 + hcol + cw;
                    *(u32x4*)(rowp) = pack8(o10, o11); *(u32x4*)(rowp + HALF) = pack8(o20, o21); }
        } else if (pn < 16) {
            const bool gate = pn >= 12; bf16_t* O = gate ? G : V; const int hcol = (pn & 3) * 256;
#pragma unroll
            for (int ai = 0; ai < 2; ++ai)
#pragma unroll
                for (int m = 0; m < 4; ++m) { const int row = row0 + ai * HALF + m * 16; bf16_t* rowp = O + (size_t)row * 1024 + hcol + cw;
#pragma unroll
                    for (int bj = 0; bj < 2; ++bj) { f32x4 v0 = acc[ai][bj][m][0], v1 = acc[ai][bj][m][1];
                        if (gate) {
#pragma unroll
                            for (int j = 0; j < 4; ++j) { v0[j] = v0[j] * sigmoidf_(v0[j]); v1[j] = v1[j] * sigmoidf_(v1[j]); } }
                        *(u32x4*)(rowp + bj * HALF) = pack8(v0, v1); } }
        } else if (pn < 20) {
            const int t = pn - 16, i0 = 8 * fq;
#pragma unroll
            for (int ai = 0; ai < 2; ++ai)
#pragma unroll
                for (int m = 0; m < 4; ++m) { const int row = row0 + ai * HALF + m * 16;
                    const f32x4 c0 = *(const f32x4*)(cosa + (size_t)row * 32 + i0), c1 = *(const f32x4*)(cosa + (size_t)row * 32 + i0 + 4);
                    const f32x4 s0 = *(const f32x4*)(sina + (size_t)row * 32 + i0), s1 = *(const f32x4*)(sina + (size_t)row * 32 + i0 + 4);
                    const f32x4 a0 = acc[ai][0][m][0], a1 = acc[ai][0][m][1], b0 = acc[ai][1][m][0], b1 = acc[ai][1][m][1];
                    const f32x4 o10 = (a0 * c0 - b0 * s0) * 0.125f, o11 = (a1 * c1 - b1 * s1) * 0.125f, o20 = (a0 * s0 + b0 * c0) * 0.125f, o21 = (a1 * s1 + b1 * c1) * 0.125f;
                    bf16_t* rowp = AQ + (size_t)row * 1024 + t * 256 + wc * 64 + i0;
                    *(u32x4*)(rowp) = pack8(o10, o11); *(u32x4*)(rowp + 32) = pack8(o20, o21); }
        } else {
            const int i0 = 8 * fq;
            if (wc < 2) {
#pragma unroll
                for (int ai = 0; ai < 2; ++ai)
#pragma unroll
                    for (int m = 0; m < 4; ++m) { const int row = row0 + ai * HALF + m * 16;
                        const f32x4 c0 = *(const f32x4*)(cosa + (size_t)row * 32 + i0), c1 = *(const f32x4*)(cosa + (size_t)row * 32 + i0 + 4);
                        const f32x4 s0 = *(const f32x4*)(sina + (size_t)row * 32 + i0), s1 = *(const f32x4*)(sina + (size_t)row * 32 + i0 + 4);
                        const f32x4 a0 = acc[ai][0][m][0], a1 = acc[ai][0][m][1], b0 = acc[ai][1][m][0], b1 = acc[ai][1][m][1];
                        const f32x4 o10 = a0 * c0 - b0 * s0, o11 = a1 * c1 - b1 * s1, o20 = a0 * s0 + b0 * c0, o21 = a1 * s1 + b1 * c1;
                        bf16_t* rowp = AK + (size_t)row * 128 + wc * 64 + i0;
                        *(u32x4*)(rowp) = pack8(o10, o11); *(u32x4*)(rowp + 32) = pack8(o20, o21); }
            } else {
#pragma unroll
                for (int ai = 0; ai < 2; ++ai)
#pragma unroll
                    for (int m = 0; m < 4; ++m) { const int row = row0 + ai * HALF + m * 16; bf16_t* rowp = AV + (size_t)row * 128 + (wc - 2) * 32 + i0;
                        *(u32x4*)(rowp) = pack8(acc[ai][0][m][0], acc[ai][0][m][1]); *(u32x4*)(rowp + 64) = pack8(acc[ai][1][m][0], acc[ai][1][m][1]); }
            }
        }
    }
};
template <bool ADD> struct EpiResid {
    static constexpr bool PERM = false, AFTER_DRAIN = false;
    const float* base; float* Y; float alpha;
    __device__ __forceinline__ void operator()(const f32x4 (&acc)[2][2][4][2], const Unit& u, int wr, int wc, int fr, int fq) const {
        const int row0 = u.pm * BM + wr * 64 + fr, col0 = u.pn * BM + wc * 32 + 4 * fq;
#pragma unroll
        for (int ai = 0; ai < 2; ++ai)
#pragma unroll
            for (int m = 0; m < 4; ++m) { const size_t off = (size_t)(row0 + ai * HALF + m * 16) * 2048 + col0;
#pragma unroll
                for (int bj = 0; bj < 2; ++bj)
#pragma unroll
                    for (int n = 0; n < 2; ++n) { const size_t o = off + bj * HALF + n * 16; f32x4 v = acc[ai][bj][m][n] + *(const f32x4*)(base + o) * alpha;
                        if (ADD) v = v + *(const f32x4*)(Y + o); *(f32x4*)(Y + o) = v; } }
    }
};
struct EpiUp {
    static constexpr bool PERM = true, AFTER_DRAIN = false;
    bf16_t* H; bf16_t* SG; const float* bgate;
    __device__ __forceinline__ void operator()(const f32x4 (&acc)[2][2][4][2], const Unit& u, int wr, int wc, int fr, int fq) const {
        const int row0 = u.pm * BM + wr * 64 + fr, cw = wc * 32 + 8 * fq;
        if (u.pn < 44) {
#pragma unroll
            for (int ai = 0; ai < 2; ++ai)
#pragma unroll
                for (int m = 0; m < 4; ++m) { bf16_t* rowp = H + (size_t)(row0 + ai * HALF + m * 16) * 11264 + u.pn * 256 + cw;
#pragma unroll
                    for (int bj = 0; bj < 2; ++bj) *(u32x4*)(rowp + bj * HALF) = pack8(acc[ai][bj][m][0], acc[ai][bj][m][1]); }
        } else {
            const int colg = (u.pn - 44) * 256 + cw;
            f32x4 bv[2][2];
#pragma unroll
            for (int bj = 0; bj < 2; ++bj)
#pragma unroll
                for (int n = 0; n < 2; ++n) bv[bj][n] = *(const f32x4*)(bgate + colg + bj * HALF + 4 * n);
#pragma unroll
            for (int ai = 0; ai < 2; ++ai)
#pragma unroll
                for (int m = 0; m < 4; ++m) { bf16_t* rowp = SG + (size_t)(row0 + ai * HALF + m * 16) * 2048 + colg;
#pragma unroll
                    for (int bj = 0; bj < 2; ++bj) { f32x4 v0 = acc[ai][bj][m][0] + bv[bj][0], v1 = acc[ai][bj][m][1] + bv[bj][1];
#pragma unroll
                        for (int j = 0; j < 4; ++j) { v0[j] = sigmoidf_(v0[j]); v1[j] = sigmoidf_(v1[j]); }
                        *(u32x4*)(rowp + bj * HALF) = pack8(v0, v1); } }
        }
    }
};

__device__ __forceinline__ float ror1f(float x) { return __builtin_bit_cast(float, __builtin_amdgcn_update_dpp(0, __builtin_bit_cast(int, x), 0x121, 0xf, 0xf, false)); }
__device__ __forceinline__ float ror2f(float x) { return __builtin_bit_cast(float, __builtin_amdgcn_update_dpp(0, __builtin_bit_cast(int, x), 0x122, 0xf, 0xf, false)); }
struct EpiUpConv {
    static constexpr bool PERM = true, AFTER_DRAIN = false;
    bf16_t* ACT; bf16_t* HALO; bf16_t* SG; const float* bgate; const float* cw; const float* cb;
    __device__ __forceinline__ void operator()(const f32x4 (&acc)[2][2][4][2], const Unit& u, int wr, int wc, int fr, int fq) const {
        const int row0 = u.pm * BM + wr * 64 + fr, cwp = wc * 32 + 8 * fq;
        if (u.pn < 44) {
#pragma unroll
            for (int n = 0; n < 2; ++n) {
                const int chg = 128 * u.pn + cwp + 4 * n, chu = 5632 + chg;
                const f32x4 wg0 = *(const f32x4*)(cw + chg), wg1 = *(const f32x4*)(cw + 11264 + chg), wg2 = *(const f32x4*)(cw + 2 * 11264 + chg), bg = *(const f32x4*)(cb + chg);
                const f32x4 wu0 = *(const f32x4*)(cw + chu), wu1 = *(const f32x4*)(cw + 11264 + chu), wu2 = *(const f32x4*)(cw + 2 * 11264 + chu), bu = *(const f32x4*)(cb + chu);
#pragma unroll
                for (int ai = 0; ai < 2; ++ai) {
                    const int span = u.pm * 4 + ai * 2 + wr;
#pragma unroll
                    for (int m = 0; m < 4; ++m) {
                        const f32x4 cg = acc[ai][0][m][n], cu = acc[ai][1][m][n];
                        const f32x4 pg = acc[ai][0][m ? m - 1 : 0][n], pu = acc[ai][1][m ? m - 1 : 0][n];
                        f32x4 o;
#pragma unroll
                        for (int j = 0; j < 4; ++j) {
                            const float g1 = ror1f(fr == 15 ? pg[j] : cg[j]), g2 = ror2f(fr >= 14 ? pg[j] : cg[j]);
                            const float u1 = ror1f(fr == 15 ? pu[j] : cu[j]), u2 = ror2f(fr >= 14 ? pu[j] : cu[j]);
                            const float ga = bg[j] + wg0[j] * g2 + wg1[j] * g1 + wg2[j] * cg[j], ua = bu[j] + wu0[j] * u2 + wu1[j] * u1 + wu2[j] * cu[j];
                            o[j] = ga * sigmoidf_(ga) * ua; }
                        const int row = row0 + ai * HALF + m * 16;
                        u32x2 w; w.x = cvt_pk_bf16(o[0], o[1]); w.y = cvt_pk_bf16(o[2], o[3]);
                        if (m > 0 || fr >= 2) *(u32x2*)(ACT + (size_t)row * 5632 + 128 * u.pn + cwp + 4 * n) = w;
                        if ((m == 0 && fr < 2) || (m == 3 && fr >= 14)) { const int slot = (m == 0) ? fr : fr - 12;
                            bf16_t* hp = HALO + ((size_t)(span * 4 + slot)) * 11264 + 256 * u.pn + cwp + 4 * n;
                            u32x2 rg, ru; rg.x = cvt_pk_bf16(cg[0], cg[1]); rg.y = cvt_pk_bf16(cg[2], cg[3]); ru.x = cvt_pk_bf16(cu[0], cu[1]); ru.y = cvt_pk_bf16(cu[2], cu[3]);
                            *(u32x2*)(hp) = rg; *(u32x2*)(hp + HALF) = ru; }
                    }
                }
            }
        } else {
            const int colg = (u.pn - 44) * 256 + cwp;
            f32x4 bv[2][2];
#pragma unroll
            for (int bj = 0; bj < 2; ++bj)
#pragma unroll
                for (int n = 0; n < 2; ++n) bv[bj][n] = *(const f32x4*)(bgate + colg + bj * HALF + 4 * n);
#pragma unroll
            for (int ai = 0; ai < 2; ++ai)
#pragma unroll
                for (int m = 0; m < 4; ++m) { bf16_t* rowp = SG + (size_t)(row0 + ai * HALF + m * 16) * 2048 + colg;
#pragma unroll
                    for (int bj = 0; bj < 2; ++bj) { f32x4 v0 = acc[ai][bj][m][0] + bv[bj][0], v1 = acc[ai][bj][m][1] + bv[bj][1];
#pragma unroll
                        for (int j = 0; j < 4; ++j) { v0[j] = sigmoidf_(v0[j]); v1[j] = sigmoidf_(v1[j]); }
                        *(u32x4*)(rowp + bj * HALF) = pack8(v0, v1); } }
        }
    }
};

struct EpiPlain {
    static constexpr bool PERM = true, AFTER_DRAIN = false;
    bf16_t* O;
    __device__ __forceinline__ void operator()(const f32x4 (&acc)[2][2][4][2], const Unit& u, int wr, int wc, int fr, int fq) const {
        const int row0 = u.pm * BM + wr * 64 + fr, cwp = u.pn * BM + wc * 32 + 8 * fq;
#pragma unroll
        for (int ai = 0; ai < 2; ++ai)
#pragma unroll
            for (int m = 0; m < 4; ++m) { bf16_t* rowp = O + (size_t)(row0 + ai * HALF + m * 16) * 2048 + cwp;
#pragma unroll
                for (int bj = 0; bj < 2; ++bj) *(u32x4*)(rowp + bj * HALF) = pack8(acc[ai][bj][m][0], acc[ai][bj][m][1]); }
    }
};
struct EpiDown {
    static constexpr bool PERM = false, AFTER_DRAIN = false;
    const float* base; float* Y; const bf16_t* PP; const bf16_t* SG; float alpha;
    __device__ __forceinline__ void operator()(const f32x4 (&acc)[2][2][4][2], const Unit& u, int wr, int wc, int fr, int fq) const {
        const int row0 = u.pm * BM + wr * 64 + fr, col0 = u.pn * BM + wc * 32 + 4 * fq;
#pragma unroll
        for (int ai = 0; ai < 2; ++ai)
#pragma unroll
            for (int m = 0; m < 4; ++m) { const size_t off = (size_t)(row0 + ai * HALF + m * 16) * 2048 + col0;
#pragma unroll
                for (int bj = 0; bj < 2; ++bj)
#pragma unroll
                    for (int n = 0; n < 2; ++n) { const size_t o = off + bj * HALF + n * 16; const u32x2 pp = *(const u32x2*)(PP + o), sg = *(const u32x2*)(SG + o);
                        f32x4 pl; pl[0] = __uint_as_float(pp.x << 16) * __uint_as_float(sg.x << 16); pl[1] = __uint_as_float(pp.x & 0xffff0000u) * __uint_as_float(sg.x & 0xffff0000u);
                        pl[2] = __uint_as_float(pp.y << 16) * __uint_as_float(sg.y << 16); pl[3] = __uint_as_float(pp.y & 0xffff0000u) * __uint_as_float(sg.y & 0xffff0000u);
                        *(f32x4*)(Y + o) = acc[ai][bj][m][n] + *(const f32x4*)(base + o) * alpha + pl; } }
    }
};

template <bool PLE_> struct EpiResidLN {
    static constexpr bool PERM = false, AFTER_DRAIN = false;
    float* Y; const float* stats; const float* g; const float* b; const bf16_t* PP; const bf16_t* SG; float alpha;
    __device__ __forceinline__ void operator()(const f32x4 (&acc)[2][2][4][2], const Unit& u, int wr, int wc, int fr, int fq) const {
        const int row0 = u.pm * BM + wr * 64 + fr, col0 = u.pn * BM + wc * 32 + 4 * fq;
        f32x4 g4[2][2], b4[2][2];
#pragma unroll
        for (int bj = 0; bj < 2; ++bj)
#pragma unroll
            for (int n = 0; n < 2; ++n) { g4[bj][n] = *(const f32x4*)(g + col0 + bj * HALF + n * 16) * alpha; b4[bj][n] = *(const f32x4*)(b + col0 + bj * HALF + n * 16) * alpha; }
#pragma unroll
        for (int ai = 0; ai < 2; ++ai)
#pragma unroll
            for (int m = 0; m < 4; ++m) { const int row = row0 + ai * HALF + m * 16; const size_t off = (size_t)row * 2048 + col0;
                const f32x2 st = *(const f32x2*)(stats + 2 * (size_t)row);
#pragma unroll
                for (int bj = 0; bj < 2; ++bj)
#pragma unroll
                    for (int n = 0; n < 2; ++n) { const size_t o = off + bj * HALF + n * 16;
                        f32x4 v = acc[ai][bj][m][n] + (*(const f32x4*)(Y + o) - st.x) * st.y * g4[bj][n] + b4[bj][n];
                        if (PLE_) { const u32x2 pp = *(const u32x2*)(PP + o), sg = *(const u32x2*)(SG + o);
                            v[0] += __uint_as_float(pp.x << 16) * __uint_as_float(sg.x << 16); v[1] += __uint_as_float(pp.x & 0xffff0000u) * __uint_as_float(sg.x & 0xffff0000u);
                            v[2] += __uint_as_float(pp.y << 16) * __uint_as_float(sg.y << 16); v[3] += __uint_as_float(pp.y & 0xffff0000u) * __uint_as_float(sg.y & 0xffff0000u); }
                        *(f32x4*)(Y + o) = v; } }
    }
};
struct EpiPle {
    static constexpr bool PERM = false, AFTER_DRAIN = false;
    const bf16_t* SG; float* Y;
    __device__ __forceinline__ void operator()(const f32x4 (&acc)[2][2][4][2], const Unit& u, int wr, int wc, int fr, int fq) const {
        const int row0 = u.pm * BM + wr * 64 + fr, col0 = u.pn * BM + wc * 32 + 4 * fq;
#pragma unroll
        for (int ai = 0; ai < 2; ++ai)
#pragma unroll
            for (int m = 0; m < 4; ++m) { const size_t off = (size_t)(row0 + ai * HALF + m * 16) * 2048 + col0;
#pragma unroll
                for (int bj = 0; bj < 2; ++bj)
#pragma unroll
                    for (int n = 0; n < 2; ++n) { const size_t o = off + bj * HALF + n * 16; const u32x2 sg = *(const u32x2*)(SG + o);
                        f32x4 g; g[0] = __uint_as_float(sg.x << 16); g[1] = __uint_as_float(sg.x & 0xffff0000u); g[2] = __uint_as_float(sg.y << 16); g[3] = __uint_as_float(sg.y & 0xffff0000u);
                        *(f32x4*)(Y + o) = acc[ai][bj][m][n] * g; } }
    }
};
template <class Epi, class Sched, bool ALIGN_EPI = false, bool SP2 = false>
__device__ __forceinline__ void gemm_phase(PG8_LAS unsigned char* lds, const Gemm g, const Sched& S, const Epi& E, const int wid_in) {
    int lane_; asm volatile("v_mbcnt_lo_u32_b32 %0, -1, 0\n\tv_mbcnt_hi_u32_b32 %0, -1, %0" : "=v"(lane_)); const int wid = wid_in, lane = lane_, tid = wid * 64 + lane, wr = wid >> 2, wc = wid & 3, fr = lane & 15, fq = lane >> 4;
    const int K = g.K, nt = K / BK;
    unsigned voffA[2], voffB[2];
#pragma unroll
    for (int i = 0; i < 2; ++i) { int R, C; stage_rc(tid * 16 + i * 8192, R, C); const int Rb = Epi::PERM ? ((R & ~31) + perm32(R & 31)) : R;
        voffA[i] = (unsigned)(R * K + C) * 2u; voffB[i] = (unsigned)(Rb * K + C) * 2u; }
    const size_t kstep = (size_t)(BK * 2);
    const size_t hstep = (size_t)HALF * K * 2;
    const size_t tstep = 2 * hstep;
    const unsigned ldsw = (unsigned)wid * 1024u;
    const int aoff = lds_byte(wr * 64 + fr, fq * 8), boff = lds_byte(wc * 32 + fr, fq * 8);
#define PG8_SA(b, h) (((b) * 2 + (h)) * HTB)
#define PG8_SB(b, h) ((4 + (b) * 2 + (h)) * HTB)
#define PG8_STAGE(bufoff, gbase, voff) do { _Pragma("unroll") for (int _i = 0; _i < 2; ++_i) \
        __builtin_amdgcn_global_load_lds((const unsigned*)((const char*)(gbase) + (voff)[_i]), (PG8_LAS unsigned*)(lds + (bufoff) + ldsw + _i * 8192), 16, 0, 0); } while (0)
#define PG8_LDA(dst, b, h) do { _Pragma("unroll") for (int m = 0; m < 4; ++m) _Pragma("unroll") for (int k = 0; k < 2; ++k) dst[m][k] = *(const PG8_LAS bf16x8*)(lds + PG8_SA(b, h) + aoff + m * 2048 + k * 1024); } while (0)
#define PG8_LDB(dst, b, h) do { _Pragma("unroll") for (int n = 0; n < 2; ++n) _Pragma("unroll") for (int k = 0; k < 2; ++k) dst[n][k] = *(const PG8_LAS bf16x8*)(lds + PG8_SB(b, h) + boff + n * 2048 + k * 1024); } while (0)
#define PG8_MMA(ai, bj, At, Bt) do { __builtin_amdgcn_s_setprio(1); _Pragma("unroll") for (int m = 0; m < 4; ++m) _Pragma("unroll") for (int n = 0; n < 2; ++n) _Pragma("unroll") for (int k = 0; k < 2; ++k) \
        acc[ai][bj][m][n] = __builtin_amdgcn_mfma_f32_16x16x32_bf16(Bt[n][k], At[m][k], acc[ai][bj][m][n], 0, 0, 0); __builtin_amdgcn_s_setprio(0); } while (0)
#define PG8_WAIT_V(n) asm volatile("s_waitcnt vmcnt(" #n ")" ::: "memory")
#define PG8_WAIT_L(n) asm volatile("s_waitcnt lgkmcnt(" #n ")" ::: "memory")
#define PG8_BAR __builtin_amdgcn_s_barrier()
#define PG8_SCHED __builtin_amdgcn_sched_barrier(0)
    Unit cur, nxt; int ui = 0;
    if (!S.next(0, cur)) return;
    f32x4 acc[2][2][4][2];
#pragma unroll
    for (int a = 0; a < 2; ++a)
#pragma unroll
        for (int b = 0; b < 2; ++b)
#pragma unroll
            for (int m = 0; m < 4; ++m)
#pragma unroll
                for (int n = 0; n < 2; ++n) acc[a][b][m][n] = (f32x4){0.f, 0.f, 0.f, 0.f};
    bf16x8 At[4][2], B0[2][2], B1[2][2];
    const char* cA = (const char*)g.A + (size_t)cur.pm * tstep; const char* cB = (const char*)g.Bt + (size_t)cur.pn * tstep;
    S.a_ready(cur);
    if constexpr (SP2) {
        PG8_STAGE(PG8_SB(0, 0), cB, voffB); PG8_STAGE(PG8_SB(0, 1), cB + hstep, voffB); PG8_STAGE(PG8_SA(0, 0), cA, voffA); PG8_STAGE(PG8_SA(0, 1), cA + hstep, voffA);
        if (wr == 1) PG8_BAR;
        PG8_WAIT_V(2); PG8_BAR;
        PG8_STAGE(PG8_SB(1, 0), cB + kstep, voffB); PG8_STAGE(PG8_SA(1, 0), cA + kstep, voffA); PG8_STAGE(PG8_SB(1, 1), cB + hstep + kstep, voffB);
        PG8_WAIT_V(6); PG8_BAR;
    } else {
        PG8_STAGE(PG8_SB(0, 0), cB, voffB); PG8_STAGE(PG8_SA(0, 0), cA, voffA); PG8_STAGE(PG8_SB(0, 1), cB + hstep, voffB); PG8_STAGE(PG8_SA(0, 1), cA + hstep, voffA);
        if (wr == 1) PG8_BAR;
        PG8_WAIT_V(4); PG8_BAR;
        PG8_STAGE(PG8_SB(1, 0), cB + kstep, voffB); PG8_STAGE(PG8_SA(1, 0), cA + kstep, voffA); PG8_STAGE(PG8_SB(1, 1), cB + hstep + kstep, voffB);
        PG8_WAIT_V(6); PG8_BAR;
    }
    for (;;) {
        const bool has_next = S.next(ui + 1, nxt);
        const char* nA = has_next ? (const char*)g.A + (size_t)nxt.pm * tstep : cA; const char* nB = has_next ? (const char*)g.Bt + (size_t)nxt.pn * tstep : cB;
        for (int t = 0; t < nt; t += 2) {
            const bool last = (t == nt - 2);
            const char* a1 = cA + (size_t)(t + 1) * kstep;
            const char* a2 = last ? nA : cA + (size_t)(t + 2) * kstep; const char* b2 = last ? nB : cB + (size_t)(t + 2) * kstep;
            const char* a3 = a2 + kstep; const char* b3 = b2 + kstep;
            if (last && has_next) S.a_ready(nxt);
            if constexpr (SP2) {
            PG8_LDB(B0, 0, 0); PG8_LDB(B1, 0, 1); PG8_SCHED; PG8_LDA(At, 0, 0); PG8_STAGE(PG8_SA(1, 1), a1 + hstep, voffA);
            PG8_WAIT_V(8); PG8_WAIT_L(0); PG8_BAR; PG8_MMA(0, 0, At, B0); PG8_MMA(0, 1, At, B1); PG8_BAR; PG8_SCHED;
            PG8_LDA(At, 0, 1); PG8_STAGE(PG8_SB(0, 0), b2, voffB); PG8_STAGE(PG8_SB(0, 1), b2 + hstep, voffB); PG8_STAGE(PG8_SA(0, 0), a2, voffA);
            PG8_WAIT_V(8); PG8_WAIT_L(0); PG8_BAR; PG8_MMA(1, 0, At, B0); PG8_MMA(1, 1, At, B1); PG8_BAR; PG8_SCHED;
            PG8_LDB(B0, 1, 0); PG8_LDB(B1, 1, 1); PG8_SCHED; PG8_LDA(At, 1, 0); PG8_STAGE(PG8_SA(0, 1), a2 + hstep, voffA);
            PG8_WAIT_V(8); PG8_WAIT_L(0); PG8_BAR; PG8_MMA(0, 0, At, B0); PG8_MMA(0, 1, At, B1); PG8_BAR; PG8_SCHED;
            PG8_LDA(At, 1, 1); PG8_STAGE(PG8_SB(1, 0), b3, voffB); PG8_STAGE(PG8_SB(1, 1), b3 + hstep, voffB); PG8_STAGE(PG8_SA(1, 0), a3, voffA);
            PG8_WAIT_V(8); PG8_WAIT_L(0); PG8_BAR; PG8_MMA(1, 0, At, B0); PG8_MMA(1, 1, At, B1); PG8_BAR; PG8_SCHED;
            } else {
            PG8_LDB(B0, 0, 0); PG8_SCHED; PG8_LDA(At, 0, 0); PG8_STAGE(PG8_SA(1, 1), a1 + hstep, voffA);
            PG8_WAIT_L(8); PG8_BAR; PG8_WAIT_L(0); PG8_MMA(0, 0, At, B0); PG8_BAR; PG8_SCHED;
            PG8_LDB(B1, 0, 1); PG8_STAGE(PG8_SB(0, 0), b2, voffB);
            PG8_BAR; PG8_WAIT_L(0); PG8_MMA(0, 1, At, B1); PG8_BAR;
            PG8_LDA(At, 0, 1); PG8_STAGE(PG8_SA(0, 0), a2, voffA);
            PG8_BAR; PG8_WAIT_L(0); PG8_MMA(1, 0, At, B0); PG8_BAR; PG8_SCHED;
            PG8_STAGE(PG8_SB(0, 1), b2 + hstep, voffB);
            PG8_WAIT_V(6); PG8_BAR; PG8_MMA(1, 1, At, B1); PG8_BAR;
            PG8_LDB(B0, 1, 0); PG8_SCHED; PG8_LDA(At, 1, 0); PG8_STAGE(PG8_SA(0, 1), a2 + hstep, voffA);
            PG8_WAIT_L(8); PG8_BAR; PG8_WAIT_L(0); PG8_MMA(0, 0, At, B0); PG8_BAR; PG8_SCHED;
            PG8_LDB(B1, 1, 1); PG8_STAGE(PG8_SB(1, 0), b3, voffB);
            PG8_BAR; PG8_WAIT_L(0); PG8_MMA(0, 1, At, B1); PG8_BAR;
            PG8_LDA(At, 1, 1); PG8_STAGE(PG8_SA(1, 0), a3, voffA);
            PG8_BAR; PG8_WAIT_L(0); PG8_MMA(1, 0, At, B0); PG8_BAR; PG8_SCHED;
            PG8_STAGE(PG8_SB(1, 1), b3 + hstep, voffB);
            PG8_WAIT_V(6); PG8_BAR; PG8_MMA(1, 1, At, B1); PG8_BAR;
            }
        }
        if constexpr (ALIGN_EPI) { if (wr == 0) PG8_BAR; }
        if constexpr (!Epi::AFTER_DRAIN) { E(acc, cur, wr, wc, fr, fq); S.done(cur); }
        if (!has_next) break;
#pragma unroll
        for (int a = 0; a < 2; ++a)
#pragma unroll
            for (int b = 0; b < 2; ++b)
#pragma unroll
                for (int m = 0; m < 4; ++m)
#pragma unroll
                    for (int n = 0; n < 2; ++n) acc[a][b][m][n] = (f32x4){0.f, 0.f, 0.f, 0.f};
        cur = nxt; cA = nA; cB = nB; ++ui;
        if constexpr (ALIGN_EPI) { if (wr == 1) PG8_BAR; }
    }
    PG8_WAIT_V(0);
    if constexpr (!ALIGN_EPI) { if (wr == 0) PG8_BAR; }
    PG8_BAR;
    if constexpr (Epi::AFTER_DRAIN) { E.fused(acc, cur, wr, wc, fr, fq, lds, wid, lane); S.done(cur); }
#undef PG8_SA
#undef PG8_SB
#undef PG8_STAGE
#undef PG8_LDA
#undef PG8_LDB
#undef PG8_MMA
#undef PG8_WAIT_V
#undef PG8_WAIT_L
#undef PG8_BAR
#undef PG8_SCHED
}
}
#define LAS __attribute__((address_space(3)))
#define XB_TMO      128
#define XB_XCNT(j)  (256  + 64 * (j))
#define XB_XSUB(j)  (1280 + 64 * (j))
#define XB_XGEN(j)  (2304 + 64 * (j))
#define XB_TOP      3328
#define XB_TOPGEN   3392
#define XCD_BAR_WORDS 3456
#define XB_SPIN_CAP (1u << 18)

__device__ __forceinline__ unsigned xb_ld(unsigned* p)              { return __hip_atomic_load(p, __ATOMIC_RELAXED, __HIP_MEMORY_SCOPE_AGENT); }
__device__ __forceinline__ unsigned xb_add(unsigned* p, unsigned v) { return __hip_atomic_fetch_add(p, v, __ATOMIC_RELAXED, __HIP_MEMORY_SCOPE_AGENT); }
__device__ __forceinline__ unsigned xb_xcc_id() { return (unsigned)__builtin_amdgcn_s_getreg((3 << 11) | 20) & 0xFu; }
#define XB_SPIN(cond, bar) do { unsigned _sp = 0; while (cond) { __builtin_amdgcn_s_sleep(1); \
    if ((++_sp & 255u) == 0u) { if (xb_ld(&(bar)[XB_TMO])) break; if (_sp > XB_SPIN_CAP) { atomicAdd(&(bar)[XB_TMO], 1u); break; } } } } while (0)

struct XcdBarrier {
    unsigned* bar; unsigned x;
    volatile LAS unsigned* st;
};

__device__ __forceinline__ XcdBarrier xcd_barrier_post(unsigned* bar, volatile LAS unsigned* st) {
    XcdBarrier b; b.bar = bar; b.x = xb_xcc_id(); b.st = st;
    if (threadIdx.x == 0) (void)xb_add(&bar[XB_XCNT(b.x)], 1u);
    return b;
}
__device__ __forceinline__ void xcd_barrier_complete(unsigned* bar, unsigned x, unsigned& nloc, unsigned& nx) {
    const unsigned G = gridDim.x * gridDim.y * gridDim.z;
    unsigned sum, cnt, mine, sp = 0u;
    for (;;) {
        sum = 0u; cnt = 0u; mine = 0u;
#pragma unroll
        for (unsigned j = 0; j < 16; ++j) { const unsigned c = xb_ld(&bar[XB_XCNT(j)]); sum += c; cnt += (c > 0u) ? 1u : 0u; mine = (j == x) ? c : mine; }
        if (sum == G) break;
        __builtin_amdgcn_s_sleep(1);
        if ((++sp & 255u) == 0u) { if (xb_ld(&bar[XB_TMO])) break; if (sp > XB_SPIN_CAP) { atomicAdd(&bar[XB_TMO], 1u); break; } }
    }
    nloc = mine > 0u ? mine : 1u; nx = cnt > 0u ? cnt : 1u;
}

__device__ __forceinline__ void xcd_barrier(const XcdBarrier& b) {
    asm volatile("s_waitcnt vmcnt(0)" ::: "memory");
    __syncthreads();
    if (threadIdx.x == 0) {
        unsigned* bar = b.bar;
        __builtin_amdgcn_s_waitcnt(0);
        unsigned nloc = b.st[0], nx = b.st[1];
        if (nloc == 0u) { xcd_barrier_complete(bar, b.x, nloc, nx); b.st[0] = nloc; b.st[1] = nx; }
        const unsigned old = xb_add(&bar[XB_XSUB(b.x)], 1u);
        const unsigned gen = old / nloc;
        if (old + 1u == (gen + 1u) * nloc) {
            __builtin_amdgcn_fence(__ATOMIC_RELEASE, "agent");
            asm volatile("s_waitcnt vmcnt(0)" ::: "memory");
            const unsigned og = xb_add(&bar[XB_TOP], 1u);
            const unsigned tg = og / nx;
            if (og + 1u == (tg + 1u) * nx) xb_add(&bar[XB_TOPGEN], 1u);
            else XB_SPIN(xb_ld(&bar[XB_TOPGEN]) == tg, bar);
            __builtin_amdgcn_fence(__ATOMIC_ACQUIRE, "agent");
            xb_add(&bar[XB_XGEN(b.x)], 1u);
            asm volatile("s_waitcnt vmcnt(0)" ::: "memory");
        } else {
            XB_SPIN(xb_ld(&bar[XB_XGEN(b.x)]) == gen, bar);
            __builtin_amdgcn_fence(__ATOMIC_ACQUIRE, "agent");
            asm volatile("s_waitcnt vmcnt(0)" ::: "memory");
        }
    }
    __syncthreads();
}
#define GAS __attribute__((address_space(1)))

typedef unsigned short bf16;
typedef float f32x4 __attribute__((ext_vector_type(4)));
typedef unsigned v4u __attribute__((ext_vector_type(4)));
typedef unsigned v2u __attribute__((ext_vector_type(2)));
#define LDS_WAIT() asm volatile("s_waitcnt lgkmcnt(0)" ::: "memory")

#ifndef MK_ONE_LAUNCH
#define MK_ONE_LAUNCH 0
#endif
#ifndef RET_MFMA
#define RET_MFMA 1
#endif
#ifndef SWA_MFMA
#define SWA_MFMA 1
#endif
#ifndef PROBE_DUP
#define PROBE_DUP 0
#endif
#ifndef CONV_FUSED
#define CONV_FUSED 1
#endif
#ifndef PLE_EARLY
#define PLE_EARLY 1
#endif
#ifndef LN_NOXR
#define LN_NOXR 1
#endif
#define REPS(k) int nrep_ = (PROBE_DUP == (k)) ? 2 : 1; asm volatile("" : "+s"(nrep_)); for (int rep_ = 0; rep_ < nrep_; ++rep_)

constexpr int S = 16384, D = 2048, INW = 5376, DFF = 5632, NUP = 2 * DFF, NUPG = NUP + D, PLE = 256, DEPTH = 4;
constexpr float ALPHA = 1.6817928305074290f, LN_EPS = 1e-5f, GN_EPS = 1e-6f;
constexpr int NPH = 11, NPHASES = 1 + DEPTH * NPH;

constexpr size_t MiB = 1u << 20;
constexpr size_t WS_CTL = 0, CTL_ZERO_BYTES = 32768;
constexpr size_t WS_COSR = 2 * MiB, WS_SINR = 10 * MiB, WS_COSA = 18 * MiB, WS_SINA = 20 * MiB;
constexpr size_t WS_W = 32 * MiB, WL_BYTES = 104 * MiB;
constexpr size_t WL_IN = 0, WL_OUT = 21 * MiB, WL_UP = 29 * MiB, WL_G = 73 * MiB, WL_DOWN = 81 * MiB, WL_P = 103 * MiB;
constexpr size_t WS_XR = 448 * MiB, WS_XB = 576 * MiB, WS_Y = 640 * MiB;
constexpr size_t WS_Q = 768 * MiB, WS_K = 800 * MiB, WS_V = 832 * MiB, WS_G = 864 * MiB, WS_AQ = 896 * MiB, WS_AK = 928 * MiB, WS_AV = 932 * MiB;
constexpr size_t WS_MIX = 936 * MiB, WS_U = 1000 * MiB, WS_PS = 1128 * MiB, WS_RETY = 1160 * MiB;
constexpr size_t WS_H = 768 * MiB, WS_ACT = 1128 * MiB, WS_SG = 1304 * MiB, WS_PB = 1368 * MiB, WS_END = 1400 * MiB;
constexpr size_t WS_PP = 1064 * MiB;
constexpr size_t WS_ST1 = 448 * MiB, WS_ST2 = 449 * MiB;
constexpr int CW_BAR = 4096;
static_assert((CW_BAR + 3456) * 4 <= 32768, "barrier words inside the per-call memset");

constexpr int RING_BYTES = 131072, LDS_BYTES = 147456, LDSCTL_OFF = LDS_BYTES - 1024, MISC_OFF = LDSCTL_OFF + 320;

__device__ __forceinline__ unsigned f2bf(float f) { unsigned u = __builtin_bit_cast(unsigned, f); return (u + 0x7fffu + ((u >> 16) & 1u)) >> 16; }
__device__ __forceinline__ unsigned pk2(float lo, float hi) { return f2bf(lo) | (f2bf(hi) << 16); }
__device__ __forceinline__ float bflo(unsigned w) { return __uint_as_float(w << 16); }
__device__ __forceinline__ float bfhi(unsigned w) { return __uint_as_float(w & 0xffff0000u); }
__device__ __forceinline__ float bf1(const bf16* p) { return __uint_as_float(((unsigned)*p) << 16); }

struct Params {
    const float* in[19]; float* out; unsigned char* ws; int ph_lo, ph_hi;
    float invf_ret[128]; float invf_att[32]; float lg2g[4];
};

struct Ctx { int tid, lane, wave, G, bid; unsigned char* ws; };

__device__ __forceinline__ int lane_id_asm() { int l; asm volatile("v_mbcnt_lo_u32_b32 %0, -1, 0\n\tv_mbcnt_hi_u32_b32 %0, -1, %0" : "=v"(l)); return l; }
__device__ __forceinline__ float wave_sum(float v, int lane) {
#pragma unroll
    for (int o = 1; o < 64; o <<= 1) v += __builtin_bit_cast(float, __builtin_amdgcn_ds_bpermute((lane ^ o) << 2, __builtin_bit_cast(int, v)));
    return v;
}
__device__ __forceinline__ void transpose_item(const float* W, int K, int N, int src_col0, bf16* WT, int dst_row0, int k0, LAS float* scr, int lane) {
#pragma unroll 8
    for (int i = 0; i < 32; ++i) { const int kk = 2 * i + (lane >> 5); scr[kk * 33 + (lane & 31)] = W[(size_t)(k0 + kk) * N + src_col0 + (lane & 31)]; }
    LDS_WAIT(); asm volatile("" ::: "memory");
    const int c = lane & 7;
#pragma unroll
    for (int j = 0; j < 4; ++j) { const int n = (lane >> 3) + 8 * j; const LAS float* s = scr + (8 * c) * 33 + n;
        v4u o; o.x = pk2(s[0 * 33], s[1 * 33]); o.y = pk2(s[2 * 33], s[3 * 33]); o.z = pk2(s[4 * 33], s[5 * 33]); o.w = pk2(s[6 * 33], s[7 * 33]);
        *(v4u*)(WT + (size_t)(dst_row0 + n) * K + k0 + 8 * c) = o; }
    LDS_WAIT(); asm volatile("" ::: "memory");
}
__device__ __forceinline__ void transpose_item64(const float* W, int K, int N, int srcA, int srcB, bf16* WT, int dst_row0, int k0, LAS float* scr, int lane) {
    const int c4 = lane & 15, gsel = c4 >> 3, col = 4 * (c4 & 7), src = (gsel ? srcB : srcA) + col, kq = lane >> 4;
    f32x4 v[16];
#pragma unroll
    for (int i = 0; i < 16; ++i) v[i] = *(const f32x4*)(W + (size_t)(k0 + 4 * i + kq) * N + src);
#pragma unroll
    for (int i = 0; i < 16; ++i) { LAS float* d = scr + (4 * i + kq) * 65 + 32 * gsel + col; d[0] = v[i][0]; d[1] = v[i][1]; d[2] = v[i][2]; d[3] = v[i][3]; }
    LDS_WAIT(); asm volatile("" ::: "memory");
    const int c = lane & 7;
#pragma unroll
    for (int j = 0; j < 8; ++j) { const int n = (lane >> 3) + 8 * j; const LAS float* s = scr + (8 * c) * 65 + n;
        v4u o; o.x = pk2(s[0 * 65], s[1 * 65]); o.y = pk2(s[2 * 65], s[3 * 65]); o.z = pk2(s[4 * 65], s[5 * 65]); o.w = pk2(s[6 * 65], s[7 * 65]);
        *(v4u*)(WT + (size_t)(dst_row0 + n) * K + k0 + 8 * c) = o; }
    LDS_WAIT(); asm volatile("" ::: "memory");
}
__device__ __forceinline__ int win_src_col(int g) {
    const int tile = g >> 3, bj = (g >> 2) & 1, wcg = g & 3;
    if (tile < 16) return 32 * g;
    if (tile < 20) return 4096 + 256 * (tile - 16) + 64 * wcg + 32 * bj;
    return wcg < 2 ? 5120 + 64 * wcg + 32 * bj : 5248 + 32 * (wcg - 2) + 64 * bj;
}
__device__ __forceinline__ int wup_src_col(int g) { const int tile = g >> 3, bj = (g >> 2) & 1, wcg = g & 3; return (bj ? DFF : 0) + 128 * tile + 32 * wcg; }

__device__ __forceinline__ void sincos_d(float angf, float& s, float& c) {
    const double a = (double)angf;
    const double k = __builtin_rint(a * 0.63661977236758134308);
    double r = __builtin_fma(-k, 1.57079632679489661923, a); r = __builtin_fma(-k, 6.123233995736766e-17, r);
    const double r2 = r * r;
    const double sp = r + r * r2 * (-1.0 / 6 + r2 * (1.0 / 120 + r2 * (-1.0 / 5040 + r2 * (1.0 / 362880 + r2 * (-1.0 / 39916800)))));
    const double cp = 1.0 + r2 * (-0.5 + r2 * (1.0 / 24 + r2 * (-1.0 / 720 + r2 * (1.0 / 40320 + r2 * (-1.0 / 3628800 + r2 * (1.0 / 479001600))))));
    const int q = ((int)k) & 3;
    const double sv = (q == 0) ? sp : (q == 1) ? cp : (q == 2) ? -sp : -cp;
    const double cv = (q == 0) ? cp : (q == 1) ? -sp : (q == 2) ? -cp : sp;
    s = (float)sv; c = (float)cv;
}

__device__ __forceinline__ void phase_prologue(const Params& P, const Ctx& cx, LAS unsigned char* lds) {
    unsigned char* ws = cx.ws; const int tid = cx.tid, lane = cx.lane, wave = cx.wave, G = cx.G;
    LAS float* scr = (LAS float*)(lds + wave * 16896);
    const int gw = cx.bid * 8 + wave, NGW = G * 8;
    constexpr int I_IN = 32 * 84, I_OUT = 32 * 32, I_UP = 32 * 176, I_G = 32 * 32, I_DN = 88 * 32, I_P = 4 * 32, I_L = I_IN + I_OUT + I_UP + I_G + I_DN + I_P;
    for (int it = gw; it < DEPTH * I_L; it += NGW) {
        const int l = it / I_L; int r = it - l * I_L;
        bf16* wl = (bf16*)(ws + WS_W + (size_t)l * WL_BYTES);
        if (r < I_IN) { const int kb = r / 84, g = r % 84; transpose_item64(P.in[3] + (size_t)l * D * INW, D, INW, win_src_col(2 * g), win_src_col(2 * g + 1), wl + WL_IN / 2, 64 * g, 64 * kb, scr, lane); continue; } r -= I_IN;
        if (r < I_OUT) { const int kb = r / 32, g = r % 32; transpose_item64(P.in[4] + (size_t)l * D * D, D, D, 64 * g, 64 * g + 32, wl + WL_OUT / 2, 64 * g, 64 * kb, scr, lane); continue; } r -= I_OUT;
        if (r < I_UP) { const int kb = r / 176, g = r % 176; transpose_item64(P.in[10] + (size_t)l * D * NUP, D, NUP, wup_src_col(2 * g), wup_src_col(2 * g + 1), wl + WL_UP / 2, 64 * g, 64 * kb, scr, lane); continue; } r -= I_UP;
        if (r < I_G) { const int kb = r / 32, g = r % 32; transpose_item64(P.in[16] + (size_t)l * D * D, D, D, 64 * g, 64 * g + 32, wl + WL_G / 2, 64 * g, 64 * kb, scr, lane); continue; } r -= I_G;
        if (r < I_DN) { const int kb = r / 32, g = r % 32; transpose_item64(P.in[13] + (size_t)l * DFF * D, DFF, D, 64 * g, 64 * g + 32, wl + WL_DOWN / 2, 64 * g, 64 * kb, scr, lane); continue; } r -= I_DN;
        { const int kb = r / 32, g = r % 32; transpose_item64(P.in[18] + (size_t)l * PLE * D, PLE, D, 64 * g, 64 * g + 32, wl + WL_P / 2, 64 * g, 64 * kb, scr, lane); }
    }
    const size_t gt = (size_t)cx.bid * 512 + tid, NT = (size_t)G * 512;
    { const float* x = P.in[0]; bf16* xb = (bf16*)(ws + WS_XB);
      for (size_t i = gt; i < (size_t)S * D / 8; i += NT) { const f32x4 a = *(const f32x4*)(x + i * 8), b = *(const f32x4*)(x + i * 8 + 4);
          v4u o; o.x = pk2(a[0], a[1]); o.y = pk2(a[2], a[3]); o.z = pk2(b[0], b[1]); o.w = pk2(b[2], b[3]); *(v4u*)(xb + i * 8) = o; } }
    { const float* p = P.in[1]; bf16* pb = (bf16*)(ws + WS_PB);
      for (size_t i = gt; i < (size_t)DEPTH * S * PLE / 8; i += NT) { const f32x4 a = *(const f32x4*)(p + i * 8), b = *(const f32x4*)(p + i * 8 + 4);
          v4u o; o.x = pk2(a[0], a[1]); o.y = pk2(a[2], a[3]); o.z = pk2(b[0], b[1]); o.w = pk2(b[2], b[3]); *(v4u*)(pb + i * 8) = o; } }
    { const int* pos = (const int*)P.in[2]; float* cosr = (float*)(ws + WS_COSR); float* sinr = (float*)(ws + WS_SINR); float* cosa = (float*)(ws + WS_COSA); float* sina = (float*)(ws + WS_SINA);
      for (size_t i = gt; i < (size_t)S * 128; i += NT) { const int t = (int)(i >> 7), f = (int)(i & 127); float s, c; sincos_d((float)pos[t] * P.invf_ret[f], s, c); cosr[i] = c; sinr[i] = s; }
      for (size_t i = gt; i < (size_t)S * 32; i += NT) { const int t = (int)(i >> 5), f = (int)(i & 31); float s, c; sincos_d((float)pos[t] * P.invf_att[f], s, c); cosa[i] = c; sina[i] = s; } }
}

template <int MT, int NT_, int KK, bool A_KFAST, bool B_NFAST, class FA, class FB, class FC>
__device__ __forceinline__ void simple_gemm(LAS unsigned char* lds, int nbatch, int tid, int G, int bid, const FA& fa, const FB& fb, const FC& fc) {
    LAS float* As = (LAS float*)lds;
    LAS float* Bs = (LAS float*)(lds + 16 * 132 * 4);
    constexpr int TM = MT / 128, TN = NT_ / 64, ITEMS_PER_B = TM * TN;
    const int tm = tid & 31, tn = tid >> 5;
    for (int item = bid; item < nbatch * ITEMS_PER_B; item += G) {
        const int b = item / ITEMS_PER_B, r = item % ITEMS_PER_B, m0 = (r / TN) * 128, n0 = (r % TN) * 64;
        float c[4][4];
#pragma unroll
        for (int i = 0; i < 4; ++i)
#pragma unroll
            for (int j = 0; j < 4; ++j) c[i][j] = 0.f;
        for (int k0 = 0; k0 < KK; k0 += 16) {
#pragma unroll
            for (int rr = 0; rr < 4; ++rr) { const int e = tid + 512 * rr; int m, k; if (A_KFAST) { k = e & 15; m = e >> 4; } else { m = e & 127; k = e >> 7; }
                As[k * 132 + m] = fa(b, m0 + m, k0 + k); }
#pragma unroll
            for (int rr = 0; rr < 2; ++rr) { const int e = tid + 512 * rr; int n, k; if (B_NFAST) { n = e & 63; k = e >> 6; } else { k = e & 15; n = e >> 4; }
                Bs[k * 68 + n] = fb(b, k0 + k, n0 + n); }
            __syncthreads();
#pragma unroll
            for (int kk = 0; kk < 16; ++kk) { const f32x4 a = *(const LAS f32x4*)(As + kk * 132 + 4 * tm), bb = *(const LAS f32x4*)(Bs + kk * 68 + 4 * tn);
#pragma unroll
                for (int i = 0; i < 4; ++i)
#pragma unroll
                    for (int j = 0; j < 4; ++j) c[i][j] += a[i] * bb[j]; }
            __syncthreads();
        }
#pragma unroll
        for (int i = 0; i < 4; ++i)
#pragma unroll
            for (int j = 0; j < 4; ++j) fc(b, m0 + 4 * tm + i, n0 + 4 * tn + j, c[i][j]);
    }
}

__device__ __forceinline__ void phase_swa(const Params& P, const Ctx& cx, int l, LAS unsigned char* lds) {
    unsigned char* ws = cx.ws; const int tid = cx.tid, G = cx.G;
    const bf16* AQ = (const bf16*)(ws + WS_AQ); const bf16* AK = (const bf16*)(ws + WS_AK); const bf16* AV = (const bf16*)(ws + WS_AV); bf16* MIX = (bf16*)(ws + WS_MIX);
    const float* sinks = P.in[7] + l * 16;
    LAS unsigned* Ks = (LAS unsigned*)lds;
    LAS unsigned* Vs = (LAS unsigned*)(lds + 256 * 33 * 4);
    for (int item = cx.bid; item < 256; item += G) {
        const int nb = item >> 1, hk = item & 1;
        __syncthreads();
        for (int e = tid; e < 256 * 32; e += 512) { const int r = e >> 5, cdw = e & 31; const int gk = nb * 128 - 128 + r;
            unsigned kv = 0u, vv = 0u; if (gk >= 0) { kv = *(const unsigned*)(AK + (size_t)gk * 128 + hk * 64 + 2 * cdw); vv = *(const unsigned*)(AV + (size_t)gk * 128 + hk * 64 + 2 * cdw); }
            Ks[r * 33 + cdw] = kv; Vs[r * 33 + cdw] = vv; }
        __syncthreads();
#pragma unroll 1
        for (int rep = 0; rep < 2; ++rep) {
            const int pair = tid + 512 * rep, i = pair & 127, g = pair >> 7, hq = hk * 8 + g; const int row = nb * 128 + i;
            float q[64], o[64];
            { const v4u* qp = (const v4u*)(AQ + (size_t)row * 1024 + hq * 64);
#pragma unroll
              for (int c8 = 0; c8 < 8; ++c8) { const v4u w = qp[c8]; q[8 * c8 + 0] = bflo(w.x); q[8 * c8 + 1] = bfhi(w.x); q[8 * c8 + 2] = bflo(w.y); q[8 * c8 + 3] = bfhi(w.y); q[8 * c8 + 4] = bflo(w.z); q[8 * c8 + 5] = bfhi(w.z); q[8 * c8 + 6] = bflo(w.w); q[8 * c8 + 7] = bfhi(w.w); } }
#pragma unroll
            for (int d = 0; d < 64; ++d) o[d] = 0.f;
            float mx = sinks[hq], den = 1.0f;
            const int jj0 = (nb == 0) ? (127 - i) : 0;
            for (int jj = jj0; jj < 128; ++jj) { const int kl = i + 1 + jj;
                float s = 0.f;
#pragma unroll
                for (int c = 0; c < 32; ++c) { const unsigned w = Ks[kl * 33 + c]; s += q[2 * c] * bflo(w) + q[2 * c + 1] * bfhi(w); }
                const float mn = fmaxf(mx, s), sc = __expf(mx - mn), p = __expf(s - mn);
                den = den * sc + p; mx = mn;
#pragma unroll
                for (int c = 0; c < 32; ++c) { const unsigned w = Vs[kl * 33 + c]; o[2 * c] = o[2 * c] * sc + p * bflo(w); o[2 * c + 1] = o[2 * c + 1] * sc + p * bfhi(w); }
            }
            const float inv = 1.0f / den;
            v4u* op = (v4u*)(MIX + (size_t)row * 2048 + 1024 + hq * 64);
#pragma unroll
            for (int c8 = 0; c8 < 8; ++c8) { v4u w; w.x = pk2(o[8 * c8] * inv, o[8 * c8 + 1] * inv); w.y = pk2(o[8 * c8 + 2] * inv, o[8 * c8 + 3] * inv); w.z = pk2(o[8 * c8 + 4] * inv, o[8 * c8 + 5] * inv); w.w = pk2(o[8 * c8 + 6] * inv, o[8 * c8 + 7] * inv); op[c8] = w; }
        }
    }
}

__device__ __forceinline__ void phase_ret_u_scores(const Params& P, const Ctx& cx, LAS unsigned char* lds) {
    unsigned char* ws = cx.ws; const int tid = cx.tid, G = cx.G;
    const bf16* Q = (const bf16*)(ws + WS_Q); const bf16* K = (const bf16*)(ws + WS_K); const bf16* V = (const bf16*)(ws + WS_V);
    float* U = (float*)(ws + WS_U); float* PS = (float*)(ws + WS_PS);
    const float lg0 = P.lg2g[0], lg1 = P.lg2g[1], lg2 = P.lg2g[2], lg3 = P.lg2g[3];
    auto lgh = [=](int h) { return h == 0 ? lg0 : h == 1 ? lg1 : h == 2 ? lg2 : lg3; };
    simple_gemm<256, 256, 128, false, true>(lds, 512, tid, G, cx.bid,
        [=](int b, int m, int k) { const int nb = b >> 2, h = b & 3; return bf1(K + (size_t)(nb * 128 + k) * 1024 + h * 256 + m) * exp2f(lgh(h) * (float)(127 - k)); },
        [=](int b, int k, int n) { const int nb = b >> 2, h = b & 3; return bf1(V + (size_t)(nb * 128 + k) * 1024 + h * 256 + n); },
        [=](int b, int m, int n, float v) { U[((size_t)b * 256 + m) * 256 + n] = v; });
    simple_gemm<128, 128, 256, true, false>(lds, 512, tid, G, cx.bid,
        [=](int b, int m, int k) { const int nb = b >> 2, h = b & 3; return bf1(Q + (size_t)(nb * 128 + m) * 1024 + h * 256 + k); },
        [=](int b, int k, int n) { const int nb = b >> 2, h = b & 3; return bf1(K + (size_t)(nb * 128 + n) * 1024 + h * 256 + k); },
        [=](int b, int m, int n, float v) { const int h = b & 3; PS[((size_t)b * 128 + m) * 128 + n] = (m >= n) ? v * exp2f(lgh(h) * (float)(m - n)) : 0.f; });
}
__device__ __forceinline__ void phase_scan(const Params& P, const Ctx& cx) {
    float* U = (float*)(cx.ws + WS_U);
    const size_t gt = (size_t)cx.bid * 512 + cx.tid, NT = (size_t)cx.G * 512;
    for (size_t idx = gt; idx < 4 * 65536; idx += NT) {
        const int h = (int)(idx >> 16); const float cd = exp2f(P.lg2g[h] * 128.0f);
        float r = 0.f;
        for (int n0 = 0; n0 < 128; n0 += 8) { float u[8];
#pragma unroll
            for (int j = 0; j < 8; ++j) u[j] = U[(size_t)(n0 + j) * 262144 + idx];
#pragma unroll
            for (int j = 0; j < 8; ++j) { U[(size_t)(n0 + j) * 262144 + idx] = r; r = r * cd + u[j]; } }
    }
}
__device__ __forceinline__ void phase_ret_out(const Params& P, const Ctx& cx, LAS unsigned char* lds) {
    unsigned char* ws = cx.ws; const int tid = cx.tid, G = cx.G;
    const bf16* Q = (const bf16*)(ws + WS_Q); const bf16* V = (const bf16*)(ws + WS_V);
    const float* Sst = (const float*)(ws + WS_U); const float* PS = (const float*)(ws + WS_PS); float* RY = (float*)(ws + WS_RETY);
    const float lg0 = P.lg2g[0], lg1 = P.lg2g[1], lg2 = P.lg2g[2], lg3 = P.lg2g[3];
    auto lgh = [=](int h) { return h == 0 ? lg0 : h == 1 ? lg1 : h == 2 ? lg2 : lg3; };
    simple_gemm<128, 256, 384, true, true>(lds, 512, tid, G, cx.bid,
        [=](int b, int m, int k) { const int nb = b >> 2, h = b & 3; return k < 128 ? PS[((size_t)b * 128 + m) * 128 + k] : bf1(Q + (size_t)(nb * 128 + m) * 1024 + h * 256 + (k - 128)) * exp2f(lgh(h) * (float)(m + 1)); },
        [=](int b, int k, int n) { const int nb = b >> 2, h = b & 3; return k < 128 ? bf1(V + (size_t)(nb * 128 + k) * 1024 + h * 256 + n) : Sst[((size_t)b * 256 + (k - 128)) * 256 + n]; },
        [=](int b, int m, int n, float v) { const int nb = b >> 2, h = b & 3; RY[(size_t)(nb * 128 + m) * 1024 + h * 256 + n] = v; });
}

typedef short bf16x8 __attribute__((ext_vector_type(8)));
typedef short s16x4 __attribute__((ext_vector_type(4)));
typedef short v4i16_t __attribute__((ext_vector_type(4)));
__device__ __forceinline__ f32x4 mfma16(bf16x8 a, bf16x8 b, f32x4 c) { return __builtin_amdgcn_mfma_f32_16x16x32_bf16(a, b, c, 0, 0, 0); }
__device__ __forceinline__ s16x4 lds_tr(LAS unsigned char* p) { return __builtin_bit_cast(s16x4, __builtin_amdgcn_ds_read_tr16_b64_v4i16((LAS v4i16_t*)p)); }
__device__ __forceinline__ bf16x8 cat44(s16x4 a, s16x4 b) { bf16x8 r; r[0] = a[0]; r[1] = a[1]; r[2] = a[2]; r[3] = a[3]; r[4] = b[0]; r[5] = b[1]; r[6] = b[2]; r[7] = b[3]; return r; }
__device__ __forceinline__ unsigned cvt2(float lo, float hi) { return pg8::cvt_pk_bf16(lo, hi); }
__device__ __forceinline__ bf16x8 pack_frag(const f32x4 a, const f32x4 b) { v4u w; w.x = cvt2(a[0], a[1]); w.y = cvt2(a[2], a[3]); w.z = cvt2(b[0], b[1]); w.w = cvt2(b[2], b[3]); return __builtin_bit_cast(bf16x8, w); }
__device__ __forceinline__ float grp16_sum(float v, int lane) {
#pragma unroll
    for (int o = 1; o < 16; o <<= 1) v += __builtin_bit_cast(float, __builtin_amdgcn_ds_bpermute((lane ^ o) << 2, __builtin_bit_cast(int, v)));
    return v;
}
constexpr int RS_T = 544;
constexpr int TILE_T = 128 * RS_T;
static_assert(2 * TILE_T <= LDSCTL_OFF, "retention tiles vs LDS control words");

template <bool DECAY> __device__ __forceinline__ void stage_tile(LAS unsigned char* img, const bf16* src, int tid, float lg) {
    v4u v[8];
#pragma unroll
    for (int r = 0; r < 8; ++r) { const int pc = tid + 512 * r, row = pc >> 5, c16 = pc & 31; v[r] = *(const v4u*)(src + (size_t)row * 1024 + c16 * 8); }
#pragma unroll
    for (int r = 0; r < 8; ++r) { const int pc = tid + 512 * r, row = pc >> 5, c16 = pc & 31; v4u w = v[r];
        if (DECAY) { const float sc = exp2f(lg * (float)(127 - row));
            w.x = cvt2(bflo(w.x) * sc, bfhi(w.x) * sc); w.y = cvt2(bflo(w.y) * sc, bfhi(w.y) * sc); w.z = cvt2(bflo(w.z) * sc, bfhi(w.z) * sc); w.w = cvt2(bflo(w.w) * sc, bfhi(w.w) * sc); }
        *(LAS v4u*)(img + row * RS_T + c16 * 16) = w; }
}

__device__ __forceinline__ void phase_ret_u_mfma(const Params& P, const Ctx& cx, LAS unsigned char* lds) {
    unsigned char* ws = cx.ws; const int tid = cx.tid, lane = cx.lane, w = cx.wave, r16 = lane & 15, g = lane >> 4, q = r16 >> 2, pp = r16 & 3;
    const bf16* K = (const bf16*)(ws + WS_K); const bf16* V = (const bf16*)(ws + WS_V); bf16* UT = (bf16*)(ws + WS_U);
    LAS unsigned char* Kim = lds; LAS unsigned char* Vim = lds + TILE_T;
    for (int b = cx.bid; b < 512; b += cx.G) {
        const int nb = b >> 2, h = b & 3;
        __syncthreads();
        stage_tile<true>(Kim, K + (size_t)nb * 128 * 1024 + h * 256, tid, P.lg2g[h]);
        stage_tile<false>(Vim, V + (size_t)nb * 128 * 1024 + h * 256, tid, 0.f);
        __syncthreads();
        f32x4 acc[2][16];
#pragma unroll
        for (int mi = 0; mi < 2; ++mi)
#pragma unroll
            for (int n = 0; n < 16; ++n) acc[mi][n] = (f32x4){0.f, 0.f, 0.f, 0.f};
#pragma unroll 1
        for (int s = 0; s < 4; ++s) {
            bf16x8 af[2];
#pragma unroll
            for (int mi = 0; mi < 2; ++mi) { LAS unsigned char* a0 = Kim + (32 * s + 8 * g + q) * RS_T + (16 * (2 * w + mi) + 4 * pp) * 2; af[mi] = cat44(lds_tr(a0), lds_tr(a0 + 4 * RS_T)); }
#pragma unroll
            for (int n = 0; n < 16; ++n) { LAS unsigned char* b0 = Vim + (32 * s + 8 * g + q) * RS_T + (16 * n + 4 * pp) * 2; const bf16x8 bfr = cat44(lds_tr(b0), lds_tr(b0 + 4 * RS_T));
                acc[0][n] = mfma16(af[0], bfr, acc[0][n]); acc[1][n] = mfma16(af[1], bfr, acc[1][n]); }
        }
#pragma unroll
        for (int mi = 0; mi < 2; ++mi)
#pragma unroll
            for (int n = 0; n < 16; ++n) { v2u o; o.x = cvt2(acc[mi][n][0], acc[mi][n][1]); o.y = cvt2(acc[mi][n][2], acc[mi][n][3]);
                *(v2u*)(UT + ((size_t)b * 256 + 16 * n + r16) * 256 + 16 * (2 * w + mi) + 4 * g) = o; }
    }
}
__device__ __forceinline__ void phase_scan_bf16(const Params& P, const Ctx& cx) {
    unsigned* UT = (unsigned*)(cx.ws + WS_U);
    const size_t gt = (size_t)cx.bid * 512 + cx.tid, NT = (size_t)cx.G * 512;
    for (size_t idx = gt; idx < 131072; idx += NT) {
        const int h = (int)(idx >> 15); const float cd = exp2f(P.lg2g[h] * 128.0f);
        float r0 = 0.f, r1 = 0.f;
        for (int n0 = 0; n0 < 128; n0 += 16) { unsigned u[16];
#pragma unroll
            for (int j = 0; j < 16; ++j) u[j] = UT[(size_t)(n0 + j) * 131072 + idx];
#pragma unroll
            for (int j = 0; j < 16; ++j) { UT[(size_t)(n0 + j) * 131072 + idx] = cvt2(r0, r1); r0 = r0 * cd + bflo(u[j]); r1 = r1 * cd + bfhi(u[j]); } }
    }
}
__device__ __forceinline__ void phase_ret_out_mfma(const Params& P, const Ctx& cx, int l, LAS unsigned char* lds) {
    unsigned char* ws = cx.ws; const int tid = cx.tid, lane = cx.lane, w = cx.wave, r16 = lane & 15, g = lane >> 4, q = r16 >> 2, pp = r16 & 3;
    const bf16* Q = (const bf16*)(ws + WS_Q); const bf16* K = (const bf16*)(ws + WS_K); const bf16* V = (const bf16*)(ws + WS_V); const bf16* ST = (const bf16*)(ws + WS_U);
    const bf16* Gt = (const bf16*)(ws + WS_G); bf16* MIX = (bf16*)(ws + WS_MIX);
    const float* gg = P.in[5] + l * 1024; const float* gb = P.in[6] + l * 1024;
    LAS unsigned char* Kim = lds; LAS unsigned char* Vim = lds + TILE_T;
    for (int b = cx.bid; b < 512; b += cx.G) {
        const int nb = b >> 2, h = b & 3; const float lg = P.lg2g[h];
        __syncthreads();
        stage_tile<false>(Kim, K + (size_t)nb * 128 * 1024 + h * 256, tid, 0.f);
        stage_tile<false>(Vim, V + (size_t)nb * 128 * 1024 + h * 256, tid, 0.f);
        bf16x8 qf[8];
        { const bf16* qrow = Q + (size_t)(nb * 128 + 16 * w + r16) * 1024 + h * 256 + 8 * g;
#pragma unroll
          for (int s = 0; s < 8; ++s) qf[s] = *(const bf16x8*)(qrow + 32 * s); }
        f32x4 acc[16];
        const bf16* strow = ST + ((size_t)b * 256 + r16) * 256 + 8 * g;
#pragma unroll
        for (int n = 0; n < 16; ++n) { bf16x8 sb[8];
#pragma unroll
            for (int s = 0; s < 8; ++s) sb[s] = *(const bf16x8*)(strow + (size_t)n * 16 * 256 + 32 * s);
            f32x4 a = (f32x4){0.f, 0.f, 0.f, 0.f};
#pragma unroll
            for (int s = 0; s < 8; ++s) a = mfma16(qf[s], sb[s], a);
            acc[n] = a; }
        { float f[4];
#pragma unroll
          for (int r = 0; r < 4; ++r) f[r] = exp2f(lg * (float)(16 * w + 4 * g + r + 1));
#pragma unroll
          for (int n = 0; n < 16; ++n) { acc[n][0] *= f[0]; acc[n][1] *= f[1]; acc[n][2] *= f[2]; acc[n][3] *= f[3]; } }
        __syncthreads();
        f32x4 sc[8];
#pragma unroll
        for (int mb = 0; mb < 8; ++mb) { sc[mb] = (f32x4){0.f, 0.f, 0.f, 0.f};
            if (mb <= w) { f32x4 a = (f32x4){0.f, 0.f, 0.f, 0.f};
#pragma unroll
                for (int s = 0; s < 8; ++s) { const bf16x8 kf = *(const LAS bf16x8*)(Kim + (16 * mb + r16) * RS_T + (32 * s + 8 * g) * 2); a = mfma16(kf, qf[s], a); }
                const int i = 16 * w + r16;
#pragma unroll
                for (int r = 0; r < 4; ++r) { const int j = 16 * mb + 4 * g + r; a[r] = (i >= j) ? a[r] * exp2f(lg * (float)(i - j)) : 0.f; }
                sc[mb] = a; } }
#pragma unroll
        for (int sk = 0; sk < 4; ++sk) {
            if (2 * sk <= w) { const bf16x8 pf = pack_frag(sc[2 * sk], sc[2 * sk + 1]);
#pragma unroll
                for (int n = 0; n < 16; ++n) { LAS unsigned char* b0 = Vim + (32 * sk + 4 * g + q) * RS_T + (16 * n + 4 * pp) * 2; const bf16x8 bfr = cat44(lds_tr(b0), lds_tr(b0 + 16 * RS_T));
                    acc[n] = mfma16(pf, bfr, acc[n]); } } }
        float mean[4], rstd[4];
#pragma unroll
        for (int r = 0; r < 4; ++r) { float sm = 0.f;
#pragma unroll
            for (int n = 0; n < 16; ++n) sm += acc[n][r];
            mean[r] = grp16_sum(sm, lane) * (1.0f / 256.0f); }
#pragma unroll
        for (int r = 0; r < 4; ++r) { float sq = 0.f;
#pragma unroll
            for (int n = 0; n < 16; ++n) { const float d = acc[n][r] - mean[r]; sq += d * d; }
            rstd[r] = 1.0f / sqrtf(grp16_sum(sq, lane) * (1.0f / 256.0f) + GN_EPS); }
#pragma unroll
        for (int n = 0; n < 16; ++n) { const int e = h * 256 + 16 * n + r16; const float g1 = gg[e], b1 = gb[e];
#pragma unroll
            for (int r = 0; r < 4; ++r) { const size_t row = (size_t)(nb * 128 + 16 * w + 4 * g + r);
                const float o = ((acc[n][r] - mean[r]) * rstd[r] * g1 + b1) * bf1(Gt + row * 1024 + e);
                MIX[row * 2048 + e] = (bf16)f2bf(o); } }
    }
}
constexpr int RS_SK = 144, RS_SV = 160;
__device__ __forceinline__ void phase_swa_mfma(const Params& P, const Ctx& cx, int l, LAS unsigned char* lds) {
    unsigned char* ws = cx.ws; const int tid = cx.tid, lane = cx.lane, w = cx.wave, r16 = lane & 15, g = lane >> 4, q = r16 >> 2, pp = r16 & 3;
    const bf16* AQ = (const bf16*)(ws + WS_AQ); const bf16* AK = (const bf16*)(ws + WS_AK); const bf16* AV = (const bf16*)(ws + WS_AV); bf16* MIX = (bf16*)(ws + WS_MIX);
    LAS unsigned char* Kim = lds; LAS unsigned char* Vim = lds + 256 * RS_SK;
    for (int item = cx.bid; item < 256; item += cx.G) {
        const int nb = item >> 1, hk = item & 1, hq = hk * 8 + w; const float sink = P.in[7][l * 16 + hq];
        __syncthreads();
#pragma unroll
        for (int r = 0; r < 4; ++r) { const int pc = tid + 512 * r, row = pc >> 3, c = pc & 7, gk = nb * 128 - 128 + row;
            v4u kv = (v4u){0u, 0u, 0u, 0u}, vv = (v4u){0u, 0u, 0u, 0u};
            if (gk >= 0) { kv = *(const v4u*)(AK + (size_t)gk * 128 + hk * 64 + c * 8); vv = *(const v4u*)(AV + (size_t)gk * 128 + hk * 64 + c * 8); }
            *(LAS v4u*)(Kim + row * RS_SK + c * 16) = kv; *(LAS v4u*)(Vim + row * RS_SV + c * 16) = vv; }
        __syncthreads();
#pragma unroll 1
        for (int nq = 0; nq < 8; ++nq) {
            const bf16* qrow = AQ + (size_t)(nb * 128 + 16 * nq + r16) * 1024 + hq * 64 + 8 * g;
            const bf16x8 qf0 = *(const bf16x8*)(qrow), qf1 = *(const bf16x8*)(qrow + 32);
            f32x4 sc[10];
            float mx = sink;
#pragma unroll
            for (int kb = 0; kb < 9; ++kb) { const LAS unsigned char* kp = Kim + (16 * (nq + kb) + r16) * RS_SK + 16 * g;
                f32x4 a = (f32x4){0.f, 0.f, 0.f, 0.f};
                a = mfma16(*(const LAS bf16x8*)(kp), qf0, a); a = mfma16(*(const LAS bf16x8*)(kp + 64), qf1, a);
#pragma unroll
                for (int r = 0; r < 4; ++r) { const int dl = 16 * kb + 4 * g + r - r16; const bool vis = (dl >= 1) && (dl <= 128) && (nb > 0 || 16 * (nq + kb) + 4 * g + r >= 128);
                    a[r] = vis ? a[r] : -INFINITY; mx = fmaxf(mx, a[r]); }
                sc[kb] = a; }
            sc[9] = (f32x4){0.f, 0.f, 0.f, 0.f};
            mx = fmaxf(mx, __builtin_bit_cast(float, __builtin_amdgcn_ds_bpermute((lane ^ 16) << 2, __builtin_bit_cast(int, mx))));
            mx = fmaxf(mx, __builtin_bit_cast(float, __builtin_amdgcn_ds_bpermute((lane ^ 32) << 2, __builtin_bit_cast(int, mx))));
            float sum = 0.f;
#pragma unroll
            for (int kb = 0; kb < 9; ++kb)
#pragma unroll
                for (int r = 0; r < 4; ++r) { const float pv = __expf(sc[kb][r] - mx); sc[kb][r] = pv; sum += pv; }
            sum += __builtin_bit_cast(float, __builtin_amdgcn_ds_bpermute((lane ^ 16) << 2, __builtin_bit_cast(int, sum)));
            sum += __builtin_bit_cast(float, __builtin_amdgcn_ds_bpermute((lane ^ 32) << 2, __builtin_bit_cast(int, sum)));
            const float inv = 1.0f / (sum + __expf(sink - mx));
            f32x4 o[4];
#pragma unroll
            for (int nd = 0; nd < 4; ++nd) o[nd] = (f32x4){0.f, 0.f, 0.f, 0.f};
#pragma unroll
            for (int sk = 0; sk < 5; ++sk) { const bf16x8 pf = pack_frag(sc[2 * sk] * inv, sc[2 * sk + 1] * inv);
                const int kb0 = nq + 2 * sk, kb1 = (kb0 + 1 > 15) ? 15 : kb0 + 1;
#pragma unroll
                for (int nd = 0; nd < 4; ++nd) { const bf16x8 bfr = cat44(lds_tr(Vim + (16 * kb0 + 4 * g + q) * RS_SV + (16 * nd + 4 * pp) * 2), lds_tr(Vim + (16 * kb1 + 4 * g + q) * RS_SV + (16 * nd + 4 * pp) * 2));
                    o[nd] = mfma16(pf, bfr, o[nd]); } }
#pragma unroll
            for (int nd = 0; nd < 4; ++nd)
#pragma unroll
                for (int r = 0; r < 4; ++r) MIX[(size_t)(nb * 128 + 16 * nq + 4 * g + r) * 2048 + 1024 + hq * 64 + 16 * nd + r16] = (bf16)f2bf(o[nd][r]);
        }
    }
}

__device__ __forceinline__ void phase_groupnorm(const Params& P, const Ctx& cx, int l) {
    unsigned char* ws = cx.ws; const int lane = cx.lane, wave = cx.wave, G = cx.G;
    const float* RY = (const float*)(ws + WS_RETY); const bf16* Gt = (const bf16*)(ws + WS_G); bf16* MIX = (bf16*)(ws + WS_MIX);
    const float* gg = P.in[5] + l * 1024; const float* gb = P.in[6] + l * 1024;
    const int gw = cx.bid * 8 + wave, NGW = G * 8;
    for (int it = gw; it < S * 4; it += NGW) { const int row = it >> 2, h = it & 3; const size_t off = (size_t)row * 1024 + h * 256 + 4 * lane;
        f32x4 v = *(const f32x4*)(RY + off);
        const float mean = wave_sum((v[0] + v[1]) + (v[2] + v[3]), lane) * (1.0f / 256.0f);
        v = v - mean;
        const float var = wave_sum((v[0] * v[0] + v[1] * v[1]) + (v[2] * v[2] + v[3] * v[3]), lane) * (1.0f / 256.0f);
        const float rstd = 1.0f / sqrtf(var + GN_EPS);
        const f32x4 g4 = *(const f32x4*)(gg + h * 256 + 4 * lane), b4 = *(const f32x4*)(gb + h * 256 + 4 * lane);
        const v2u gt2 = *(const v2u*)(Gt + off);
        f32x4 o = v * rstd * g4 + b4;
        o[0] *= bflo(gt2.x); o[1] *= bfhi(gt2.x); o[2] *= bflo(gt2.y); o[3] *= bfhi(gt2.y);
        v2u w; w.x = pk2(o[0], o[1]); w.y = pk2(o[2], o[3]);
        *(v2u*)(MIX + (size_t)row * 2048 + h * 256 + 4 * lane) = w; }
}
__device__ __forceinline__ void phase_ln(const Ctx& cx, const float* Y, const float* g, const float* b, float* xo, bf16* xb, float* stats) {
    const int lane = cx.lane, wave = cx.wave, G = cx.G; const int gw = cx.bid * 8 + wave, NGW = G * 8;
    f32x4 g4[8], b4[8];
#pragma unroll
    for (int j = 0; j < 8; ++j) { g4[j] = ((const f32x4*)g)[64 * j + lane]; b4[j] = ((const f32x4*)b)[64 * j + lane]; }
    for (int row = gw; row < S; row += 2 * NGW) {
        const int row2 = row + NGW; const bool has2 = row2 < S; const int rb = has2 ? row2 : row;
        const f32x4* ya = (const f32x4*)(Y + (size_t)row * D) + lane; const f32x4* yb = (const f32x4*)(Y + (size_t)rb * D) + lane;
        f32x4 va[8], vb[8]; float sa = 0.f, sb = 0.f;
#pragma unroll
        for (int j = 0; j < 8; ++j) { va[j] = ya[64 * j]; vb[j] = yb[64 * j]; }
#pragma unroll
        for (int j = 0; j < 8; ++j) { sa += (va[j][0] + va[j][1]) + (va[j][2] + va[j][3]); sb += (vb[j][0] + vb[j][1]) + (vb[j][2] + vb[j][3]); }
        const float ma = wave_sum(sa, lane) * (1.0f / D), mb = wave_sum(sb, lane) * (1.0f / D); float qa = 0.f, qb = 0.f;
#pragma unroll
        for (int j = 0; j < 8; ++j) { va[j] = va[j] - ma; vb[j] = vb[j] - mb; qa += (va[j][0] * va[j][0] + va[j][1] * va[j][1]) + (va[j][2] * va[j][2] + va[j][3] * va[j][3]); qb += (vb[j][0] * vb[j][0] + vb[j][1] * vb[j][1]) + (vb[j][2] * vb[j][2] + vb[j][3] * vb[j][3]); }
        const float ra = 1.0f / sqrtf(wave_sum(qa, lane) * (1.0f / D) + LN_EPS), rbb = 1.0f / sqrtf(wave_sum(qb, lane) * (1.0f / D) + LN_EPS);
        f32x4* xa = (f32x4*)(xo + (size_t)row * D) + lane; f32x4* xbp = (f32x4*)(xo + (size_t)rb * D) + lane;
        if (stats && lane == 0) { stats[2 * (size_t)row] = ma; stats[2 * (size_t)row + 1] = ra; if (has2) { stats[2 * (size_t)rb] = mb; stats[2 * (size_t)rb + 1] = rbb; } }
#pragma unroll
        for (int j = 0; j < 8; ++j) { const f32x4 o = va[j] * ra * g4[j] + b4[j]; if (xo) xa[64 * j] = o;
            if (xb) { v2u w; w.x = pk2(o[0], o[1]); w.y = pk2(o[2], o[3]); ((v2u*)(xb + (size_t)row * D))[64 * j + lane] = w; } }
        if (has2) {
#pragma unroll
            for (int j = 0; j < 8; ++j) { const f32x4 o = vb[j] * rbb * g4[j] + b4[j]; if (xo) xbp[64 * j] = o;
                if (xb) { v2u w; w.x = pk2(o[0], o[1]); w.y = pk2(o[2], o[3]); ((v2u*)(xb + (size_t)rb * D))[64 * j + lane] = w; } } }
    }
}
__device__ __forceinline__ void unpack8(const v4u h, float (&o)[8]) { o[0] = bflo(h.x); o[1] = bfhi(h.x); o[2] = bflo(h.y); o[3] = bfhi(h.y); o[4] = bflo(h.z); o[5] = bfhi(h.z); o[6] = bflo(h.w); o[7] = bfhi(h.w); }
__device__ __forceinline__ void phase_convact(const Params& P, const Ctx& cx, int l) {
    unsigned char* ws = cx.ws; const int tid = cx.tid, G = cx.G;
    const bf16* H = (const bf16*)(ws + WS_H); bf16* ACT = (bf16*)(ws + WS_ACT);
    const float* cw = P.in[11] + (size_t)l * 3 * NUP; const float* cb = P.in[12] + (size_t)l * NUP;
    const int gt = cx.bid * 512 + tid, NT = G * 512;
    for (int item = gt; item < 512 * 704; item += NT) {
        const int seg = item / 704, r = item - seg * 704, tile = r >> 4, q8 = r & 15, t0 = seg * 32;
        const int chg = 128 * tile + 8 * q8, chu = DFF + chg;
        float wg[3][8], wu[3][8], bg[8], bu[8];
#pragma unroll
        for (int k = 0; k < 3; ++k) { const f32x4 a0 = *(const f32x4*)(cw + (size_t)k * NUP + chg), a1 = *(const f32x4*)(cw + (size_t)k * NUP + chg + 4), c0 = *(const f32x4*)(cw + (size_t)k * NUP + chu), c1 = *(const f32x4*)(cw + (size_t)k * NUP + chu + 4);
#pragma unroll
            for (int e = 0; e < 4; ++e) { wg[k][e] = a0[e]; wg[k][4 + e] = a1[e]; wu[k][e] = c0[e]; wu[k][4 + e] = c1[e]; } }
        { const f32x4 a0 = *(const f32x4*)(cb + chg), a1 = *(const f32x4*)(cb + chg + 4), c0 = *(const f32x4*)(cb + chu), c1 = *(const f32x4*)(cb + chu + 4);
#pragma unroll
          for (int e = 0; e < 4; ++e) { bg[e] = a0[e]; bg[4 + e] = a1[e]; bu[e] = c0[e]; bu[4 + e] = c1[e]; } }
        const bf16* hp = H + (size_t)t0 * NUP + 256 * tile + 8 * q8;
        float g2[8], g1[8], u2[8], u1[8];
        if (t0 > 0) { unpack8(*(const v4u*)(hp - 2 * (size_t)NUP), g2); unpack8(*(const v4u*)(hp - (size_t)NUP), g1); unpack8(*(const v4u*)(hp - 2 * (size_t)NUP + 128), u2); unpack8(*(const v4u*)(hp - (size_t)NUP + 128), u1); }
        else {
#pragma unroll
            for (int e = 0; e < 8; ++e) { g2[e] = 0.f; g1[e] = 0.f; u2[e] = 0.f; u1[e] = 0.f; } }
        bf16* ap = ACT + (size_t)t0 * DFF + chg;
        v4u ng = *(const v4u*)(hp), nu = *(const v4u*)(hp + 128);
#pragma unroll 2
        for (int tt = 0; tt < 32; ++tt) {
            float g0[8], u0[8]; unpack8(ng, g0); unpack8(nu, u0);
            if (tt < 31) { ng = *(const v4u*)(hp + (size_t)(tt + 1) * NUP); nu = *(const v4u*)(hp + (size_t)(tt + 1) * NUP + 128); }
            float o[8];
#pragma unroll
            for (int e = 0; e < 8; ++e) { const float ga = bg[e] + wg[0][e] * g2[e] + wg[1][e] * g1[e] + wg[2][e] * g0[e], ua = bu[e] + wu[0][e] * u2[e] + wu[1][e] * u1[e] + wu[2][e] * u0[e];
                o[e] = ga * __builtin_amdgcn_rcpf(1.0f + __expf(-ga)) * ua; g2[e] = g1[e]; g1[e] = g0[e]; u2[e] = u1[e]; u1[e] = u0[e]; }
            v4u w; w.x = cvt2(o[0], o[1]); w.y = cvt2(o[2], o[3]); w.z = cvt2(o[4], o[5]); w.w = cvt2(o[6], o[7]);
            *(v4u*)(ap + (size_t)tt * DFF) = w;
        }
    }
}

__device__ __forceinline__ void phase_conv_fixup(const Params& P, const Ctx& cx, int l) {
    unsigned char* ws = cx.ws;
    const bf16* HALO = (const bf16*)(ws + WS_H); bf16* ACT = (bf16*)(ws + WS_ACT);
    const float* cw = P.in[11] + (size_t)l * 3 * NUP; const float* cb = P.in[12] + (size_t)l * NUP;
    const int gt = cx.bid * 512 + cx.tid, NT = cx.G * 512;
    for (int item = gt; item < 256 * 704; item += NT) {
        const int k = item / 704, r = item - k * 704, tile = r >> 4, q8 = r & 15, chg = 128 * tile + 8 * q8, chu = DFF + chg;
        float a_g[8], b_g[8], c_g[8], d_g[8], a_u[8], b_u[8], c_u[8], d_u[8];
        const bf16* hk = HALO + (size_t)k * 4 * NUP + 256 * tile + 8 * q8;
        unpack8(*(const v4u*)(hk), c_g); unpack8(*(const v4u*)(hk + NUP), d_g); unpack8(*(const v4u*)(hk + 128), c_u); unpack8(*(const v4u*)(hk + NUP + 128), d_u);
        if (k > 0) { const bf16* hm = hk - 4 * (size_t)NUP; unpack8(*(const v4u*)(hm + 2 * NUP), a_g); unpack8(*(const v4u*)(hm + 3 * NUP), b_g); unpack8(*(const v4u*)(hm + 2 * NUP + 128), a_u); unpack8(*(const v4u*)(hm + 3 * NUP + 128), b_u); }
        else {
#pragma unroll
            for (int e = 0; e < 8; ++e) { a_g[e] = 0.f; b_g[e] = 0.f; a_u[e] = 0.f; b_u[e] = 0.f; } }
        float o0[8], o1[8];
#pragma unroll
        for (int e = 0; e < 8; ++e) { const float w0g = cw[chg + e], w1g = cw[NUP + chg + e], w2g = cw[2 * NUP + chg + e], bgv = cb[chg + e], w0u = cw[chu + e], w1u = cw[NUP + chu + e], w2u = cw[2 * NUP + chu + e], buv = cb[chu + e];
            const float g0 = bgv + w0g * a_g[e] + w1g * b_g[e] + w2g * c_g[e], u0 = buv + w0u * a_u[e] + w1u * b_u[e] + w2u * c_u[e];
            const float g1 = bgv + w0g * b_g[e] + w1g * c_g[e] + w2g * d_g[e], u1 = buv + w0u * b_u[e] + w1u * c_u[e] + w2u * d_u[e];
            o0[e] = g0 * __builtin_amdgcn_rcpf(1.0f + __expf(-g0)) * u0; o1[e] = g1 * __builtin_amdgcn_rcpf(1.0f + __expf(-g1)) * u1; }
        v4u w0, w1; w0.x = cvt2(o0[0], o0[1]); w0.y = cvt2(o0[2], o0[3]); w0.z = cvt2(o0[4], o0[5]); w0.w = cvt2(o0[6], o0[7]); w1.x = cvt2(o1[0], o1[1]); w1.y = cvt2(o1[2], o1[3]); w1.z = cvt2(o1[4], o1[5]); w1.w = cvt2(o1[6], o1[7]);
        *(v4u*)(ACT + (size_t)(64 * k) * DFF + chg) = w0; *(v4u*)(ACT + (size_t)(64 * k + 1) * DFF + chg) = w1;
    }
}

#ifdef DBG_DUMP
__device__ __forceinline__ void phase_dump(const Ctx& cx, float* out, const bf16* a, int lda, const bf16* b, int ldb, const float* f) {
    const size_t gt = (size_t)cx.bid * 512 + cx.tid, NT = (size_t)cx.G * 512;
    for (size_t i = gt; i < (size_t)S * D; i += NT) { const int row = (int)(i >> 11), col = (int)(i & 2047);
        float v; if (f) v = f[i]; else if (b && col >= 1024) v = bf1(b + (size_t)row * ldb + (col - 1024)); else v = lda ? bf1(a + (size_t)row * lda + col) : bf1(a + (size_t)(row & 2047) * 2048 + col);
        out[i] = v; }
}
#endif
__global__ void __launch_bounds__(512, 2) fwd(Params P) {
    extern __shared__ __attribute__((aligned(16))) unsigned char lds_raw[];
    LAS unsigned char* lds = (LAS unsigned char*)lds_raw;
    const int wave = __builtin_amdgcn_readfirstlane(threadIdx.x >> 6), G = gridDim.x;
    unsigned char* ws = P.ws;
    volatile LAS unsigned* MISC = (volatile LAS unsigned*)(lds + MISC_OFF);
    for (int u = threadIdx.x; u < (LDS_BYTES - LDSCTL_OFF) / 4; u += 512) ((LAS unsigned*)(lds + LDSCTL_OFF))[u] = 0u;
    __syncthreads();
    const int lo = P.ph_lo, hi = P.ph_hi;
    XcdBarrier bar; bar.bar = (unsigned*)(ws + WS_CTL) + CW_BAR; bar.x = 0; bar.st = nullptr;
    if (hi - lo > 1) bar = xcd_barrier_post((unsigned*)(ws + WS_CTL) + CW_BAR, MISC + 8);
#define IN(k) (lo <= (k) && (k) < hi)
#define SEAM(k) do { if (IN(k) && IN((k) + 1)) xcd_barrier(bar); } while (0)
#define OPQ() Ctx cx; cx.lane = lane_id_asm(); { int t_ = wave; asm volatile("" : "+s"(t_)); cx.wave = t_; } { int t_ = G; asm volatile("" : "+s"(t_)); cx.G = t_; } { int t_ = blockIdx.x; asm volatile("" : "+s"(t_)); cx.bid = t_; } \
    { unsigned t_ = 0u; asm volatile("" : "+s"(t_)); cx.ws = P.ws + t_; } cx.tid = cx.wave * 64 + cx.lane; int lq = l; asm volatile("" : "+s"(lq)); (void)lq

#ifdef DBG_DUMP
    if (lo >= 1000) { const int l = 0; OPQ(); unsigned char* w = cx.ws; const int kind = lo - 1000;
        if (kind == 1) phase_dump(cx, P.out, (const bf16*)(w + WS_Q), 1024, (const bf16*)(w + WS_AQ), 1024, nullptr);
        else if (kind == 2) phase_dump(cx, P.out, (const bf16*)(w + WS_MIX), 2048, nullptr, 0, nullptr);
        else if (kind == 3) phase_dump(cx, P.out, nullptr, 0, nullptr, 0, (const float*)(w + WS_XR));
        else if (kind == 4) phase_dump(cx, P.out, (const bf16*)(w + WS_ACT), DFF, nullptr, 0, nullptr);
        else if (kind == 5) phase_dump(cx, P.out, nullptr, 0, nullptr, 0, (const float*)(w + WS_Y));
        else if (kind == 6) phase_dump(cx, P.out, (const bf16*)(w + WS_K), 1024, (const bf16*)(w + WS_V), 1024, nullptr);
        else if (kind == 7) phase_dump(cx, P.out, (const bf16*)(w + WS_XB), 2048, nullptr, 0, nullptr);
        else if (kind == 11) phase_dump(cx, P.out, (const bf16*)(w + WS_W + WL_G), 0, nullptr, 0, nullptr);
        else if (kind == 12) phase_dump(cx, P.out, (const bf16*)(w + WS_W + WL_OUT), 0, nullptr, 0, nullptr);
        else if (kind == 10) phase_dump(cx, P.out, (const bf16*)(w + WS_H) + 36 * 256, NUP, nullptr, 0, nullptr);
        else if (kind == 9) phase_dump(cx, P.out, (const bf16*)(w + WS_SG), 2048, nullptr, 0, nullptr);
        else if (kind == 8) phase_dump(cx, P.out, nullptr, 0, nullptr, 0, (const float*)(w + WS_RETY));
        return; }
#endif
    if (IN(0)) { const int l = 0; REPS(2) { __syncthreads(); OPQ(); phase_prologue(P, cx, lds); } }
    SEAM(0);

    for (int l = 0; l < DEPTH; ++l) {
        const int pb = 1 + l * NPH;
        if (IN(pb + 0)) { OPQ(); unsigned char* w = cx.ws; const bf16* wl = (const bf16*)(w + WS_W + (size_t)lq * WL_BYTES);
            pg8::Gemm g{(const bf16*)(w + WS_XB), wl + WL_IN / 2, S, INW, D}; pg8::StaticOrder So; So.init(S, INW, cx.G, cx.bid);
            pg8::EpiInProj E{(bf16*)(w + WS_Q), (bf16*)(w + WS_K), (bf16*)(w + WS_V), (bf16*)(w + WS_G), (bf16*)(w + WS_AQ), (bf16*)(w + WS_AK), (bf16*)(w + WS_AV),
                             (const float*)(w + WS_COSR), (const float*)(w + WS_SINR), (const float*)(w + WS_COSA), (const float*)(w + WS_SINA)};
            pg8::gemm_phase<pg8::EpiInProj, pg8::StaticOrder, true, true>(lds, g, So, E, cx.wave);
        }
#if PLE_EARLY
        if (IN(pb + 0)) { OPQ(); unsigned char* w = cx.ws; const bf16* wl = (const bf16*)(w + WS_W + (size_t)lq * WL_BYTES);
            const int nsub = (cx.G > 64) ? cx.G - 64 : cx.G, csub = (cx.G > 64) ? cx.bid - 64 : cx.bid;
            if (csub >= 0) {
                int kple = PLE; asm volatile("" : "+s"(kple));
                pg8::Gemm g{(const bf16*)(w + WS_PB) + (size_t)lq * S * PLE, wl + WL_P / 2, S, D, kple}; pg8::StaticOrder So; So.init(S, D, nsub, csub);
                pg8::EpiPlain E{(bf16*)(w + WS_PP)};
                pg8::gemm_phase<pg8::EpiPlain, pg8::StaticOrder, true, true>(lds, g, So, E, cx.wave); }
        }
#endif
        SEAM(pb + 0);
        if (IN(pb + 1)) {
#if RET_MFMA
            { REPS(2) { OPQ(); phase_ret_u_mfma(P, cx, lds); } }
#else
            { OPQ(); phase_ret_u_scores(P, cx, lds); }
#endif
#if SWA_MFMA
            { REPS(2) { OPQ(); phase_swa_mfma(P, cx, lq, lds); } }
#else
            { OPQ(); phase_swa(P, cx, lq, lds); }
#endif
        }
        SEAM(pb + 1);
#if RET_MFMA
        if (IN(pb + 2)) { OPQ(); phase_scan_bf16(P, cx); }
        SEAM(pb + 2);
        if (IN(pb + 3)) { REPS(2) { OPQ(); phase_ret_out_mfma(P, cx, lq, lds); } }
        SEAM(pb + 3);
#else
        if (IN(pb + 2)) { OPQ(); phase_scan(P, cx); }
        SEAM(pb + 2);
        if (IN(pb + 3)) { OPQ(); phase_ret_out(P, cx, lds); }
        SEAM(pb + 3);
        if (IN(pb + 4)) { OPQ(); phase_groupnorm(P, cx, lq); }
        SEAM(pb + 4);
#endif
        if (IN(pb + 5)) { OPQ(); unsigned char* w = cx.ws; const bf16* wl = (const bf16*)(w + WS_W + (size_t)lq * WL_BYTES);
            pg8::Gemm g{(const bf16*)(w + WS_MIX), wl + WL_OUT / 2, S, D, D}; pg8::StaticOrder So; So.init(S, D, cx.G, cx.bid);
#if LN_NOXR
            if (lq == 0) { pg8::EpiResid<false> E{P.in[0], (float*)(w + WS_Y), ALPHA};
                pg8::gemm_phase<pg8::EpiResid<false>, pg8::StaticOrder, true, true>(lds, g, So, E, cx.wave); }
            else { pg8::EpiResidLN<false> E{(float*)(w + WS_Y), (const float*)(w + WS_ST2), P.in[14] + (lq - 1) * D, P.in[15] + (lq - 1) * D, nullptr, nullptr, ALPHA};
                pg8::gemm_phase<pg8::EpiResidLN<false>, pg8::StaticOrder, true, true>(lds, g, So, E, cx.wave); }
#else
            pg8::EpiResid<false> E{(lq == 0) ? P.in[0] : (const float*)(w + WS_XR), (float*)(w + WS_Y), ALPHA};
            pg8::gemm_phase<pg8::EpiResid<false>, pg8::StaticOrder, true, true>(lds, g, So, E, cx.wave);
#endif
        }
        SEAM(pb + 5);
        if (IN(pb + 6)) { REPS(1) { OPQ(); unsigned char* w = cx.ws;
#if LN_NOXR
            phase_ln(cx, (const float*)(w + WS_Y), P.in[8] + lq * D, P.in[9] + lq * D, (float*)nullptr, (bf16*)(w + WS_XB), (float*)(w + WS_ST1));
#else
            phase_ln(cx, (const float*)(w + WS_Y), P.in[8] + lq * D, P.in[9] + lq * D, (float*)(w + WS_XR), (bf16*)(w + WS_XB), (float*)nullptr);
#endif
        } }
        SEAM(pb + 6);
        if (IN(pb + 7)) { OPQ(); unsigned char* w = cx.ws; const bf16* wl = (const bf16*)(w + WS_W + (size_t)lq * WL_BYTES);
            pg8::Gemm g{(const bf16*)(w + WS_XB), wl + WL_UP / 2, S, NUPG, D}; pg8::StaticOrder So; So.init(S, NUPG, cx.G, cx.bid);
#if CONV_FUSED
            pg8::EpiUpConv E{(bf16*)(w + WS_ACT), (bf16*)(w + WS_H), (bf16*)(w + WS_SG), P.in[17] + lq * D, P.in[11] + (size_t)lq * 3 * NUP, P.in[12] + (size_t)lq * NUP};
            pg8::gemm_phase<pg8::EpiUpConv, pg8::StaticOrder, true, true>(lds, g, So, E, cx.wave);
#else
            pg8::EpiUp E{(bf16*)(w + WS_H), (bf16*)(w + WS_SG), P.in[17] + lq * D};
            pg8::gemm_phase<pg8::EpiUp, pg8::StaticOrder, true, true>(lds, g, So, E, cx.wave);
#endif
        }
        SEAM(pb + 7);
        if (IN(pb + 8)) {
#if !PLE_EARLY
            { OPQ(); unsigned char* w = cx.ws; const bf16* wl = (const bf16*)(w + WS_W + (size_t)lq * WL_BYTES);
              pg8::Gemm g{(const bf16*)(w + WS_PB) + (size_t)lq * S * PLE, wl + WL_P / 2, S, D, PLE}; pg8::StaticOrder So; So.init(S, D, cx.G, cx.bid);
              pg8::EpiPle E{(const bf16*)(w + WS_SG), (float*)(w + WS_Y)};
              pg8::gemm_phase<pg8::EpiPle, pg8::StaticOrder, true, true>(lds, g, So, E, cx.wave); }
#endif
#if CONV_FUSED
            { OPQ(); phase_conv_fixup(P, cx, lq); }
#else
            { REPS(1) { OPQ(); phase_convact(P, cx, lq); } }
#endif
        }
        SEAM(pb + 8);
        if (IN(pb + 9)) { OPQ(); unsigned char* w = cx.ws; const bf16* wl = (const bf16*)(w + WS_W + (size_t)lq * WL_BYTES);
            pg8::Gemm g{(const bf16*)(w + WS_ACT), wl + WL_DOWN / 2, S, D, DFF}; pg8::StaticOrder So; So.init(S, D, cx.G, cx.bid);
#if PLE_EARLY
#if LN_NOXR
            pg8::EpiResidLN<true> E{(float*)(w + WS_Y), (const float*)(w + WS_ST1), P.in[8] + lq * D, P.in[9] + lq * D, (const bf16*)(w + WS_PP), (const bf16*)(w + WS_SG), ALPHA};
            pg8::gemm_phase<pg8::EpiResidLN<true>, pg8::StaticOrder, true, true>(lds, g, So, E, cx.wave);
#else
            pg8::EpiDown E{(const float*)(w + WS_XR), (float*)(w + WS_Y), (const bf16*)(w + WS_PP), (const bf16*)(w + WS_SG), ALPHA};
            pg8::gemm_phase<pg8::EpiDown, pg8::StaticOrder, true, true>(lds, g, So, E, cx.wave);
#endif
#else
            pg8::EpiResid<true> E{(const float*)(w + WS_XR), (float*)(w + WS_Y), ALPHA};
            pg8::gemm_phase<pg8::EpiResid<true>, pg8::StaticOrder, true, true>(lds, g, So, E, cx.wave);
#endif
        }
        SEAM(pb + 9);
        if (IN(pb + 10)) { REPS(1) { OPQ(); unsigned char* w = cx.ws; const bool last = (lq == DEPTH - 1);

#if LN_NOXR
            phase_ln(cx, (const float*)(w + WS_Y), P.in[14] + lq * D, P.in[15] + lq * D, last ? P.out : (float*)nullptr, last ? (bf16*)nullptr : (bf16*)(w + WS_XB), last ? (float*)nullptr : (float*)(w + WS_ST2));
#else
            phase_ln(cx, (const float*)(w + WS_Y), P.in[14] + lq * D, P.in[15] + lq * D, last ? P.out : (float*)(w + WS_XR), last ? (bf16*)nullptr : (bf16*)(w + WS_XB), (float*)nullptr);
#endif
        } }
        SEAM(pb + 10);
    }
#undef IN
#undef SEAM
}

extern "C" void kernel_launch(void* const* d_in, const int* in_sizes, int n_in, void* d_out, int out_size, void* d_ws, size_t ws_size, hipStream_t stream) {
    static int grid = 0;
    if (grid == 0) {
        if (n_in != 19 || in_sizes[0] != S * D || out_size != S * D || ws_size < WS_END) { fprintf(stderr, "kernel_launch: unexpected shapes (n_in %d, in0 %d, out %d, ws %zu)\n", n_in, n_in > 0 ? in_sizes[0] : -1, out_size, ws_size); grid = -1; return; }
        int dev = 0, cus = 0, per_cu = 0;
        if (hipGetDevice(&dev) != hipSuccess || hipDeviceGetAttribute(&cus, hipDeviceAttributeMultiprocessorCount, dev) != hipSuccess) { grid = -1; return; }
        if (hipFuncSetAttribute((const void*)fwd, hipFuncAttributeMaxDynamicSharedMemorySize, LDS_BYTES) != hipSuccess) { fprintf(stderr, "kernel_launch: hipFuncSetAttribute failed\n"); grid = -1; return; }
        if (hipOccupancyMaxActiveBlocksPerMultiprocessor(&per_cu, (const void*)fwd, 512, LDS_BYTES) != hipSuccess || per_cu < 1) fprintf(stderr, "kernel_launch: occupancy query says %d\n", per_cu);
        (void)hipGetLastError();
        grid = cus;
    }
    if (grid < 0) return;
    (void)hipMemsetAsync((char*)d_ws + WS_CTL, 0, CTL_ZERO_BYTES, stream);
#ifdef DBG_NANFILL
    (void)hipMemsetAsync((char*)d_ws + CTL_ZERO_BYTES, 0xFF, WS_END - CTL_ZERO_BYTES, stream);
#endif
    Params p{};
    for (int i = 0; i < 19; ++i) p.in[i] = (const float*)d_in[i];
    p.out = (float*)d_out; p.ws = (unsigned char*)d_ws;
    for (int f = 0; f < 128; ++f) p.invf_ret[f] = (float)(1.0 / std::pow(10000.0, (double)((float)f / 127.0f)));
    for (int f = 0; f < 32; ++f) p.invf_att[f] = (float)std::pow(10000.0, -(double)(2 * f) / 64.0);
    for (int h = 0; h < 4; ++h) p.lg2g[h] = (float)std::log2(1.0 - std::exp2(-5.0 - h));
#if MK_ONE_LAUNCH
    p.ph_lo = 0; p.ph_hi = NPHASES;
    hipLaunchKernelGGL(fwd, dim3(grid), dim3(512), LDS_BYTES, stream, p);
#else
#ifdef DBG_DUMP
    for (int ph = 0; ph <= DBG_STOP; ++ph) { p.ph_lo = ph; p.ph_hi = ph + 1; hipLaunchKernelGGL(fwd, dim3(grid), dim3(512), LDS_BYTES, stream, p); }
    p.ph_lo = 1000 + DBG_DUMP; p.ph_hi = p.ph_lo + 1; hipLaunchKernelGGL(fwd, dim3(grid), dim3(512), LDS_BYTES, stream, p);
#else
    for (int ph = 0; ph < NPHASES; ++ph) { p.ph_lo = ph; p.ph_hi = ph + 1; hipLaunchKernelGGL(fwd, dim3(grid), dim3(512), LDS_BYTES, stream, p); }
#endif
#endif
}
```

```cpp
#include <hip/hip_runtime.h>
#include <cstdio>
#include <cstdint>
#include <cmath>
#define MK_ONE_LAUNCH 1
namespace pg8 {
#define PG8_LAS __attribute__((address_space(3)))
typedef unsigned short bf16_t;
typedef short bf16x8 __attribute__((ext_vector_type(8)));
typedef float f32x4 __attribute__((ext_vector_type(4)));
typedef unsigned u32x4 __attribute__((ext_vector_type(4)));
constexpr int BM = 256, BK = 64, HALF = 128, HTB = HALF * BK * 2  , STAGE_BYTES = 8 * HTB, NXCD = 8, WGM = 8;

__host__ __device__ __forceinline__ int lds_byte(int r, int c) { const int st = (r >> 4) * 2 + (c >> 5), rr = r & 15, cc = c & 31, ob = rr * 64 + cc * 2; return st * 1024 + (ob ^ (((ob >> 9) & 1) << 5)); }
__host__ __device__ __forceinline__ void stage_rc(int b, int& R, int& C) { const int st = b / 1024, sb = b % 1024, swz = sb ^ (((sb >> 9) & 1) << 5); R = (st >> 1) * 16 + swz / 64; C = (st & 1) * 32 + (swz % 64) / 2; }
__host__ __device__ __forceinline__ int perm32(int rho) { const int n = rho >> 4, i = rho & 15; return 8 * (i >> 2) + 4 * n + (i & 3); }

struct Unit { int pm, pn; };
struct Gemm { const bf16_t* A; const bf16_t* Bt; int M, N, K; };

struct StaticOrder {
    int nM, nN, nwg, G, c;
    __host__ __device__ void init(int M, int N, int G_, int c_) { nM = M / BM; nN = N / BM; nwg = nM * nN; G = G_; c = c_; }
    __host__ __device__ bool next(int i, Unit& u) const {
        const long L = (long)i * G + c; if (L >= nwg) return false;
        int wgid = (int)L; { const int q = nwg / NXCD, r = nwg % NXCD, xcd = wgid % NXCD, off = wgid / NXCD; wgid = (xcd < r ? xcd * (q + 1) : r * (q + 1) + (xcd - r) * q) + off; }
        const int nig = WGM * nN, gid = wgid / nig, fm = gid * WGM, gsz = (nM - fm) < WGM ? (nM - fm) : WGM;
        u.pm = fm + ((wgid % nig) % gsz); u.pn = (wgid % nig) / gsz; return true;
    }
    __device__ __forceinline__ void a_ready(const Unit&) const {}
    __device__ __forceinline__ void done(const Unit&) const {}
};

typedef float f32x2c_t __attribute__((ext_vector_type(2))); typedef __bf16 bf16x2c_t __attribute__((ext_vector_type(2)));
__device__ __forceinline__ unsigned cvt_pk_bf16(float lo, float hi) { f32x2c_t v = {lo, hi}; bf16x2c_t b = __builtin_convertvector(v, bf16x2c_t); return __builtin_bit_cast(unsigned, b); }
typedef float f32x2 __attribute__((ext_vector_type(2)));
typedef unsigned u32x2 __attribute__((ext_vector_type(2)));
__device__ __forceinline__ float bf2f(unsigned short b) { return __uint_as_float(((unsigned)b) << 16); }
__device__ __forceinline__ u32x4 pack8(const f32x4 a, const f32x4 b) { u32x4 w; w.x = cvt_pk_bf16(a[0], a[1]); w.y = cvt_pk_bf16(a[2], a[3]); w.z = cvt_pk_bf16(b[0], b[1]); w.w = cvt_pk_bf16(b[2], b[3]); return w; }
__device__ __forceinline__ float sigmoidf_(float x) { return __builtin_amdgcn_rcpf(1.0f + __expf(-x)); }

struct EpiInProj {
    static constexpr bool PERM = true, AFTER_DRAIN = false;
    bf16_t *Q, *K, *V, *G, *AQ, *AK, *AV; const float *cosr, *sinr, *cosa, *sina;
    __device__ __forceinline__ void operator()(const f32x4 (&acc)[2][2][4][2], const Unit& u, int wr, int wc, int fr, int fq) const {
        const int row0 = u.pm * BM + wr * 64 + fr, pn = u.pn, cw = wc * 32 + 8 * fq;
        if (pn < 8) {
            bf16_t* O = pn < 4 ? Q : K; const int hcol = (pn & 3) * 256; const float sc = pn < 4 ? 1.0f : 0.0625f;
#pragma unroll
            for (int ai = 0; ai < 2; ++ai)
#pragma unroll
                for (int m = 0; m < 4; ++m) { const int row = row0 + ai * HALF + m * 16;
                    const f32x4 c0 = *(const f32x4*)(cosr + (size_t)row * 128 + cw), c1 = *(const f32x4*)(cosr + (size_t)row * 128 + cw + 4);
                    const f32x4 s0 = *(const f32x4*)(sinr + (size_t)row * 128 + cw), s1 = *(const f32x4*)(sinr + (size_t)row * 128 + cw + 4);
                    const f32x4 a0 = acc[ai][0][m][0], a1 = acc[ai][0][m][1], b0 = acc[ai][1][m][0], b1 = acc[ai][1][m][1];
                    const f32x4 o10 = (a0 * c0 - b0 * s0) * sc, o11 = (a1 * c1 - b1 * s1) * sc, o20 = (a0 * s0 + b0 * c0) * sc, o21 = (a1 * s1 + b1 * c1) * sc;
                    bf16_t* rowp = O + (size_t)row * 1024 + hcol + cw;
                    *(u32x4*)(rowp) = pack8(o10, o11); *(u32x4*)(rowp + HALF) = pack8(o20, o21); }
        } else if (pn < 16) {
            const bool gate = pn >= 12; bf16_t* O = gate ? G : V; const int hcol = (pn & 3) * 256;
#pragma unroll
            for (int ai = 0; ai < 2; ++ai)
#pragma unroll
                for (int m = 0; m < 4; ++m) { const int row = row0 + ai * HALF + m * 16; bf16_t* rowp = O + (size_t)row * 1024 + hcol + cw;
#pragma unroll
                    for (int bj = 0; bj < 2; ++bj) { f32x4 v0 = acc[ai][bj][m][0], v1 = acc[ai][bj][m][1];
                        if (gate) {
#pragma unroll
                            for (int j = 0; j < 4; ++j) { v0[j] = v0[j] * sigmoidf_(v0[j]); v1[j] = v1[j] * sigmoidf_(v1[j]); } }
                        *(u32x4*)(rowp + bj * HALF) = pack8(v0, v1); } }
        } else if (pn < 20) {
            const int t = pn - 16, i0 = 8 * fq;
#pragma unroll
            for (int ai = 0; ai < 2; ++ai)
#pragma unroll
                for (int m = 0; m < 4; ++m) { const int row = row0 + ai * HALF + m * 16;
                    const f32x4 c0 = *(const f32x4*)(cosa + (size_t)row * 32 + i0), c1 = *(const f32x4*)(cosa + (size_t)row * 32 + i0 + 4);
                    const f32x4 s0 = *(const f32x4*)(sina + (size_t)row * 32 + i0), s1 = *(const f32x4*)(sina + (size_t)row * 32 + i0 + 4);
                    const f32x4 a0 = acc[ai][0][m][0], a1 = acc[ai][0][m][1], b0 = acc[ai][1][m][0], b1 = acc[ai][1][m][1];
                    const f32x4 o10 = (a0 * c0 - b0 * s0) * 0.125f, o11 = (a1 * c1 - b1 * s1) * 0.125f, o20 = (a0 * s0 + b0 * c0) * 0.125f, o21 = (a1 * s1 + b1 * c1) * 0.125f;
                    bf16_t* rowp = AQ + (size_t)row * 1024 + t * 256 + wc * 64 + i0;
                    *(u32x4*)(rowp) = pack8(o10, o11); *(u32x4*)(rowp + 32) = pack8(o20, o21); }
        } else {
            const int i0 = 8 * fq;
            if (wc < 2) {
#pragma unroll
                for (int ai = 0; ai < 2; ++ai)
#pragma unroll
                    for (int m = 0; m < 4; ++m) { const int row = row0 + ai * HALF + m * 16;
                        const f32x4 c0 = *(const f32x4*)(cosa + (size_t)row * 32 + i0), c1 = *(const f32x4*)(cosa + (size_t)row * 32 + i0 + 4);
                        const f32x4 s0 = *(const f32x4*)(sina + (size_t)row * 32 + i0), s1 = *(const f32x4*)(sina + (size_t)row * 32 + i0 + 4);
                        const f32x4 a0 = acc[ai][0][m][0], a1 = acc[ai][0][m][1], b0 = acc[ai][1][m][0], b1 = acc[ai][1][m][1];
                        const f32x4 o10 = a0 * c0 - b0 * s0, o11 = a1 * c1 - b1 * s1, o20 = a0 * s0 + b0 * c0, o21 = a1 * s1 + b1 * c1;
                        bf16_t* rowp = AK + (size_t)row * 128 + wc * 64 + i0;
                        *(u32x4*)(rowp) = pack8(o10, o11); *(u32x4*)(rowp + 32) = pack8(o20, o21); }
            } else {
#pragma unroll
                for (int ai = 0; ai < 2; ++ai)
#pragma unroll
                    for (int m = 0; m < 4; ++m) { const int row = row0 + ai * HALF + m * 16; bf16_t* rowp = AV + (size_t)row * 128 + (wc - 2) * 32 + i0;
                        *(u32x4*)(rowp) = pack8(acc[ai][0][m][0], acc[ai][0][m][1]); *(u32x4*)(rowp + 64) = pack8(acc[ai][1][m][0], acc[ai][1][m][1]); }
            }
        }
    }
};
template <bool ADD> struct EpiResid {
    static constexpr bool PERM = false, AFTER_DRAIN = false;
    const float* base; float* Y; float alpha;
    __device__ __forceinline__ void operator()(const f32x4 (&acc)[2][2][4][2], const Unit& u, int wr, int wc, int fr, int fq) const {
        const int row0 = u.pm * BM + wr * 64 + fr, col0 = u.pn * BM + wc * 32 + 4 * fq;
#pragma unroll
        for (int ai = 0; ai < 2; ++ai)
#pragma unroll
            for (int m = 0; m < 4; ++m) { const size_t off = (size_t)(row0 + ai * HALF + m * 16) * 2048 + col0;
#pragma unroll
                for (int bj = 0; bj < 2; ++bj)
#pragma unroll
                    for (int n = 0; n < 2; ++n) { const size_t o = off + bj * HALF + n * 16; f32x4 v = acc[ai][bj][m][n] + *(const f32x4*)(base + o) * alpha;
                        if (ADD) v = v + *(const f32x4*)(Y + o); *(f32x4*)(Y + o) = v; } }
    }
};
struct EpiUp {
    static constexpr bool PERM = true, AFTER_DRAIN = false;
    bf16_t* H; bf16_t* SG; const float* bgate;
    __device__ __forceinline__ void operator()(const f32x4 (&acc)[2][2][4][2], const Unit& u, int wr, int wc, int fr, int fq) const {
        const int row0 = u.pm * BM + wr * 64 + fr, cw = wc * 32 + 8 * fq;
        if (u.pn < 44) {
#pragma unroll
            for (int ai = 0; ai < 2; ++ai)
#pragma unroll
                for (int m = 0; m < 4; ++m) { bf16_t* rowp = H + (size_t)(row0 + ai * HALF + m * 16) * 11264 + u.pn * 256 + cw;
#pragma unroll
                    for (int bj = 0; bj < 2; ++bj) *(u32x4*)(rowp + bj * HALF) = pack8(acc[ai][bj][m][0], acc[ai][bj][m][1]); }
        } else {
            const int colg = (u.pn - 44) * 256 + cw;
            f32x4 bv[2][2];
#pragma unroll
            for (int bj = 0; bj < 2; ++bj)
#pragma unroll
                for (int n = 0; n < 2; ++n) bv[bj][n] = *(const f32x4*)(bgate + colg + bj * HALF + 4 * n);
#pragma unroll
            for (int ai = 0; ai < 2; ++ai)
#pragma unroll
                for (int m = 0; m < 4; ++m) { bf16_t* rowp = SG + (size_t)(row0 + ai * HALF + m * 16) * 2048 + colg;
#pragma unroll
                    for (int bj = 0; bj < 2; ++bj) { f32x4 v0 = acc[ai][bj][m][0] + bv[bj][0], v1 = acc[ai][bj][m][1] + bv[bj][1];
#pragma unroll
                        for (int j = 0; j < 4; ++j) { v0[j] = sigmoidf_(v0[j]); v1[j] = sigmoidf_(v1[j]); }
                        *(u32x4*)(rowp + bj * HALF) = pack8(v0, v1); } }
        }
    }
};

__device__ __forceinline__ float ror1f(float x) { return __builtin_bit_cast(float, __builtin_amdgcn_update_dpp(0, __builtin_bit_cast(int, x), 0x121, 0xf, 0xf, false)); }
__device__ __forceinline__ float ror2f(float x) { return __builtin_bit_cast(float, __builtin_amdgcn_update_dpp(0, __builtin_bit_cast(int, x), 0x122, 0xf, 0xf, false)); }
struct EpiUpConv {
    static constexpr bool PERM = true, AFTER_DRAIN = false;
    bf16_t* ACT; bf16_t* HALO; bf16_t* SG; const float* bgate; const float* cw; const float* cb;
    __device__ __forceinline__ void operator()(const f32x4 (&acc)[2][2][4][2], const Unit& u, int wr, int wc, int fr, int fq) const {
        const int row0 = u.pm * BM + wr * 64 + fr, cwp = wc * 32 + 8 * fq;
        if (u.pn < 44) {
#pragma unroll
            for (int n = 0; n < 2; ++n) {
                const int chg = 128 * u.pn + cwp + 4 * n, chu = 5632 + chg;
                const f32x4 wg0 = *(const f32x4*)(cw + chg), wg1 = *(const f32x4*)(cw + 11264 + chg), wg2 = *(const f32x4*)(cw + 2 * 11264 + chg), bg = *(const f32x4*)(cb + chg);
                const f32x4 wu0 = *(const f32x4*)(cw + chu), wu1 = *(const f32x4*)(cw + 11264 + chu), wu2 = *(const f32x4*)(cw + 2 * 11264 + chu), bu = *(const f32x4*)(cb + chu);
#pragma unroll
                for (int ai = 0; ai < 2; ++ai) {
                    const int span = u.pm * 4 + ai * 2 + wr;
#pragma unroll
                    for (int m = 0; m < 4; ++m) {
                        const f32x4 cg = acc[ai][0][m][n], cu = acc[ai][1][m][n];
                        const f32x4 pg = acc[ai][0][m ? m - 1 : 0][n], pu = acc[ai][1][m ? m - 1 : 0][n];
                        f32x4 o;
#pragma unroll
                        for (int j = 0; j < 4; ++j) {
                            const float g1 = ror1f(fr == 15 ? pg[j] : cg[j]), g2 = ror2f(fr >= 14 ? pg[j] : cg[j]);
                            const float u1 = ror1f(fr == 15 ? pu[j] : cu[j]), u2 = ror2f(fr >= 14 ? pu[j] : cu[j]);
                            const float ga = bg[j] + wg0[j] * g2 + wg1[j] * g1 + wg2[j] * cg[j], ua = bu[j] + wu0[j] * u2 + wu1[j] * u1 + wu2[j] * cu[j];
                            o[j] = ga * sigmoidf_(ga) * ua; }
                        const int row = row0 + ai * HALF + m * 16;
                        u32x2 w; w.x = cvt_pk_bf16(o[0], o[1]); w.y = cvt_pk_bf16(o[2], o[3]);
                        if (m > 0 || fr >= 2) *(u32x2*)(ACT + (size_t)row * 5632 + 128 * u.pn + cwp + 4 * n) = w;
                        if ((m == 0 && fr < 2) || (m == 3 && fr >= 14)) { const int slot = (m == 0) ? fr : fr - 12;
                            bf16_t* hp = HALO + ((size_t)(span * 4 + slot)) * 11264 + 256 * u.pn + cwp + 4 * n;
                            u32x2 rg, ru; rg.x = cvt_pk_bf16(cg[0], cg[1]); rg.y = cvt_pk_bf16(cg[2], cg[3]); ru.x = cvt_pk_bf16(cu[0], cu[1]); ru.y = cvt_pk_bf16(cu[2], cu[3]);
                            *(u32x2*)(hp) = rg; *(u32x2*)(hp + HALF) = ru; }
                    }
                }
            }
        } else {
            const int colg = (u.pn - 44) * 256 + cwp;
            f32x4 bv[2][2];
#pragma unroll
            for (int bj = 0; bj < 2; ++bj)
#pragma unroll
                for (int n = 0; n < 2; ++n) bv[bj][n] = *(const f32x4*)(bgate + colg + bj * HALF + 4 * n);
#pragma unroll
            for (int ai = 0; ai < 2; ++ai)
#pragma unroll
                for (int m = 0; m < 4; ++m) { bf16_t* rowp = SG + (size_t)(row0 + ai * HALF + m * 16) * 2048 + colg;
#pragma unroll
                    for (int bj = 0; bj < 2; ++bj) { f32x4 v0 = acc[ai][bj][m][0] + bv[bj][0], v1 = acc[ai][bj][m][1] + bv[bj][1];
#pragma unroll
                        for (int j = 0; j < 4; ++j) { v0[j] = sigmoidf_(v0[j]); v1[j] = sigmoidf_(v1[j]); }
                        *(u32x4*)(rowp + bj * HALF) = pack8(v0, v1); } }
        }
    }
};

struct EpiPlain {
    static constexpr bool PERM = true, AFTER_DRAIN = false;
    bf16_t* O;
    __device__ __forceinline__ void operator()(const f32x4 (&acc)[2][2][4][2], const Unit& u, int wr, int wc, int fr, int fq) const {
        const int row0 = u.pm * BM + wr * 64 + fr, cwp = u.pn * BM + wc * 32 + 8 * fq;
#pragma unroll
        for (int ai = 0; ai < 2; ++ai)
#pragma unroll
            for (int m = 0; m < 4; ++m) { bf16_t* rowp = O + (size_t)(row0 + ai * HALF + m * 16) * 2048 + cwp;
#pragma unroll
                for (int bj = 0; bj < 2; ++bj) *(u32x4*)(rowp + bj * HALF) = pack8(acc[ai][bj][m][0], acc[ai][bj][m][1]); }
    }
};
struct EpiDown {
    static constexpr bool PERM = false, AFTER_DRAIN = false;
    const float* base; float* Y; const bf16_t* PP; const bf16_t* SG; float alpha;
    __device__ __forceinline__ void operator()(const f32x4 (&acc)[2][2][4][2], const Unit& u, int wr, int wc, int fr, int fq) const {
        const int row0 = u.pm * BM + wr * 64 + fr, col0 = u.pn * BM + wc * 32 + 4 * fq;
#pragma unroll
        for (int ai = 0; ai < 2; ++ai)
#pragma unroll
            for (int m = 0; m < 4; ++m) { const size_t off = (size_t)(row0 + ai * HALF + m * 16) * 2048 + col0;
#pragma unroll
                for (int bj = 0; bj < 2; ++bj)
#pragma unroll
                    for (int n = 0; n < 2; ++n) { const size_t o = off + bj * HALF + n * 16; const u32x2 pp = *(const u32x2*)(PP + o), sg = *(const u32x2*)(SG + o);
                        f32x4 pl; pl[0] = __uint_as_float(pp.x << 16) * __uint_as_float(sg.x << 16); pl[1] = __uint_as_float(pp.x & 0xffff0000u) * __uint_as_float(sg.x & 0xffff0000u);
                        pl[2] = __uint_as_float(pp.y << 16) * __uint_as_float(sg.y << 16); pl[3] = __uint_as_float(pp.y & 0xffff0000u) * __uint_as_float(sg.y & 0xffff0000u);
                        *(f32x4*)(Y + o) = acc[ai][bj][m][n] + *(const f32x4*)(base + o) * alpha + pl; } }
    }
};

template <bool PLE_> struct EpiResidLN {
    static constexpr bool PERM = false, AFTER_DRAIN = false;
    float* Y; const float* stats; const float* g; const float* b; const bf16_t* PP; const bf16_t* SG; float alpha;
    __device__ __forceinline__ void operator()(const f32x4 (&acc)[2][2][4][2], const Unit& u, int wr, int wc, int fr, int fq) const {
        const int row0 = u.pm * BM + wr * 64 + fr, col0 = u.pn * BM + wc * 32 + 4 * fq;
        f32x4 g4[2][2], b4[2][2];
#pragma unroll
        for (int bj = 0; bj < 2; ++bj)
#pragma unroll
            for (int n = 0; n < 2; ++n) { g4[bj][n] = *(const f32x4*)(g + col0 + bj * HALF + n * 16) * alpha; b4[bj][n] = *(const f32x4*)(b + col0 + bj * HALF + n * 16) * alpha; }
#pragma unroll
        for (int ai = 0; ai < 2; ++ai)
#pragma unroll
            for (int m = 0; m < 4; ++m) { const int row = row0 + ai * HALF + m * 16; const size_t off = (size_t)row * 2048 + col0;
                const f32x2 st = *(const f32x2*)(stats + 2 * (size_t)row);
#pragma unroll
                for (int bj = 0; bj < 2; ++bj)
#pragma unroll
                    for (int n = 0; n < 2; ++n) { const size_t o = off + bj * HALF + n * 16;
                        f32x4 v = acc[ai][bj][m][n] + (*(const f32x4*)(Y + o) - st.x) * st.y * g4[bj][n] + b4[bj][n];
                        if (PLE_) { const u32x2 pp = *(const u32x2*)(PP + o), sg = *(const u32x2*)(SG + o);
                            v[0] += __uint_as_float(pp.x << 16) * __uint_as_float(sg.x << 16); v[1] += __uint_as_float(pp.x & 0xffff0000u) * __uint_as_float(sg.x & 0xffff0000u);
                            v[2] += __uint_as_float(pp.y << 16) * __uint_as_float(sg.y << 16); v[3] += __uint_as_float(pp.y & 0xffff0000u) * __uint_as_float(sg.y & 0xffff0000u); }
                        *(f32x4*)(Y + o) = v; } }
    }
};
struct EpiPle {
    static constexpr bool PERM = false, AFTER_DRAIN = false;
    const bf16_t* SG; float* Y;
    __device__ __forceinline__ void operator()(const f32x4 (&acc)[2][2][4][2], const Unit& u, int wr, int wc, int fr, int fq) const {
        const int row0 = u.pm * BM + wr * 64 + fr, col0 = u.pn * BM + wc * 32 + 4 * fq;
#pragma unroll
        for (int ai = 0; ai < 2; ++ai)
#pragma unroll
            for (int m = 0; m < 4; ++m) { const size_t off = (size_t)(row0 + ai * HALF + m * 16) * 2048 + col0;
#pragma unroll
                for (int bj = 0; bj < 2; ++bj)
#pragma unroll
                    for (int n = 0; n < 2; ++n) { const size_t o = off + bj * HALF + n * 16; const u32x2 sg = *(const u32x2*)(SG + o);
                        f32x4 g; g[0] = __uint_as_float(sg.x << 16); g[1] = __uint_as_float(sg.x & 0xffff0000u); g[2] = __uint_as_float(sg.y << 16); g[3] = __uint_as_float(sg.y & 0xffff0000u);
                        *(f32x4*)(Y + o) = acc[ai][bj][m][n] * g; } }
    }
};
template <class Epi, class Sched, bool ALIGN_EPI = false, bool SP2 = false>
__device__ __forceinline__ void gemm_phase(PG8_LAS unsigned char* lds, const Gemm g, const Sched& S, const Epi& E, const int wid_in) {
    int lane_; asm volatile("v_mbcnt_lo_u32_b32 %0, -1, 0\n\tv_mbcnt_hi_u32_b32 %0, -1, %0" : "=v"(lane_)); const int wid = wid_in, lane = lane_, tid = wid * 64 + lane, wr = wid >> 2, wc = wid & 3, fr = lane & 15, fq = lane >> 4;
    const int K = g.K, nt = K / BK;
    unsigned voffA[2], voffB[2];
#pragma unroll
    for (int i = 0; i < 2; ++i) { int R, C; stage_rc(tid * 16 + i * 8192, R, C); const int Rb = Epi::PERM ? ((R & ~31) + perm32(R & 31)) : R;
        voffA[i] = (unsigned)(R * K + C) * 2u; voffB[i] = (unsigned)(Rb * K + C) * 2u; }
    const size_t kstep = (size_t)(BK * 2);
    const size_t hstep = (size_t)HALF * K * 2;
    const size_t tstep = 2 * hstep;
    const unsigned ldsw = (unsigned)wid * 1024u;
    const int aoff = lds_byte(wr * 64 + fr, fq * 8), boff = lds_byte(wc * 32 + fr, fq * 8);
#define PG8_SA(b, h) (((b) * 2 + (h)) * HTB)
#define PG8_SB(b, h) ((4 + (b) * 2 + (h)) * HTB)
#define PG8_STAGE(bufoff, gbase, voff) do { _Pragma("unroll") for (int _i = 0; _i < 2; ++_i) \
        __builtin_amdgcn_global_load_lds((const unsigned*)((const char*)(gbase) + (voff)[_i]), (PG8_LAS unsigned*)(lds + (bufoff) + ldsw + _i * 8192), 16, 0, 0); } while (0)
#define PG8_LDA(dst, b, h) do { _Pragma("unroll") for (int m = 0; m < 4; ++m) _Pragma("unroll") for (int k = 0; k < 2; ++k) dst[m][k] = *(const PG8_LAS bf16x8*)(lds + PG8_SA(b, h) + aoff + m * 2048 + k * 1024); } while (0)
#define PG8_LDB(dst, b, h) do { _Pragma("unroll") for (int n = 0; n < 2; ++n) _Pragma("unroll") for (int k = 0; k < 2; ++k) dst[n][k] = *(const PG8_LAS bf16x8*)(lds + PG8_SB(b, h) + boff + n * 2048 + k * 1024); } while (0)
#define PG8_MMA(ai, bj, At, Bt) do { __builtin_amdgcn_s_setprio(1); _Pragma("unroll") for (int m = 0; m < 4; ++m) _Pragma("unroll") for (int n = 0; n < 2; ++n) _Pragma("unroll") for (int k = 0; k < 2; ++k) \
        acc[ai][bj][m][n] = __builtin_amdgcn_mfma_f32_16x16x32_bf16(Bt[n][k], At[m][k], acc[ai][bj][m][n], 0, 0, 0); __builtin_amdgcn_s_setprio(0); } while (0)
#define PG8_WAIT_V(n) asm volatile("s_waitcnt vmcnt(" #n ")" ::: "memory")
#define PG8_WAIT_L(n) asm volatile("s_waitcnt lgkmcnt(" #n ")" ::: "memory")
#define PG8_BAR __builtin_amdgcn_s_barrier()
#define PG8_SCHED __builtin_amdgcn_sched_barrier(0)
    Unit cur, nxt; int ui = 0;
    if (!S.next(0, cur)) return;
    f32x4 acc[2][2][4][2];
#pragma unroll
    for (int a = 0; a < 2; ++a)
#pragma unroll
        for (int b = 0; b < 2; ++b)
#pragma unroll
            for (int m = 0; m < 4; ++m)
#pragma unroll
                for (int n = 0; n < 2; ++n) acc[a][b][m][n] = (f32x4){0.f, 0.f, 0.f, 0.f};
    bf16x8 At[4][2], B0[2][2], B1[2][2];
    const char* cA = (const char*)g.A + (size_t)cur.pm * tstep; const char* cB = (const char*)g.Bt + (size_t)cur.pn * tstep;
    S.a_ready(cur);
    if constexpr (SP2) {
        PG8_STAGE(PG8_SB(0, 0), cB, voffB); PG8_STAGE(PG8_SB(0, 1), cB + hstep, voffB); PG8_STAGE(PG8_SA(0, 0), cA, voffA); PG8_STAGE(PG8_SA(0, 1), cA + hstep, voffA);
        if (wr == 1) PG8_BAR;
        PG8_WAIT_V(2); PG8_BAR;
        PG8_STAGE(PG8_SB(1, 0), cB + kstep, voffB); PG8_STAGE(PG8_SA(1, 0), cA + kstep, voffA); PG8_STAGE(PG8_SB(1, 1), cB + hstep + kstep, voffB);
        PG8_WAIT_V(6); PG8_BAR;
    } else {
        PG8_STAGE(PG8_SB(0, 0), cB, voffB); PG8_STAGE(PG8_SA(0, 0), cA, voffA); PG8_STAGE(PG8_SB(0, 1), cB + hstep, voffB); PG8_STAGE(PG8_SA(0, 1), cA + hstep, voffA);
        if (wr == 1) PG8_BAR;
        PG8_WAIT_V(4); PG8_BAR;
        PG8_STAGE(PG8_SB(1, 0), cB + kstep, voffB); PG8_STAGE(PG8_SA(1, 0), cA + kstep, voffA); PG8_STAGE(PG8_SB(1, 1), cB + hstep + kstep, voffB);
        PG8_WAIT_V(6); PG8_BAR;
    }
    for (;;) {
        const bool has_next = S.next(ui + 1, nxt);
        const char* nA = has_next ? (const char*)g.A + (size_t)nxt.pm * tstep : cA; const char* nB = has_next ? (const char*)g.Bt + (size_t)nxt.pn * tstep : cB;
        for (int t = 0; t < nt; t += 2) {
            const bool last = (t == nt - 2);
            const char* a1 = cA + (size_t)(t + 1) * kstep;
            const char* a2 = last ? nA : cA + (size_t)(t + 2) * kstep; const char* b2 = last ? nB : cB + (size_t)(t + 2) * kstep;
            const char* a3 = a2 + kstep; const char* b3 = b2 + kstep;
            if (last && has_next) S.a_ready(nxt);
            if constexpr (SP2) {
            PG8_LDB(B0, 0, 0); PG8_LDB(B1, 0, 1); PG8_SCHED; PG8_LDA(At, 0, 0); PG8_STAGE(PG8_SA(1, 1), a1 + hstep, voffA);
            PG8_WAIT_V(8); PG8_WAIT_L(0); PG8_BAR; PG8_MMA(0, 0, At, B0); PG8_MMA(0, 1, At, B1); PG8_BAR; PG8_SCHED;
            PG8_LDA(At, 0, 1); PG8_STAGE(PG8_SB(0, 0), b2, voffB); PG8_STAGE(PG8_SB(0, 1), b2 + hstep, voffB); PG8_STAGE(PG8_SA(0, 0), a2, voffA);
            PG8_WAIT_V(8); PG8_WAIT_L(0); PG8_BAR; PG8_MMA(1, 0, At, B0); PG8_MMA(1, 1, At, B1); PG8_BAR; PG8_SCHED;
            PG8_LDB(B0, 1, 0); PG8_LDB(B1, 1, 1); PG8_SCHED; PG8_LDA(At, 1, 0); PG8_STAGE(PG8_SA(0, 1), a2 + hstep, voffA);
            PG8_WAIT_V(8); PG8_WAIT_L(0); PG8_BAR; PG8_MMA(0, 0, At, B0); PG8_MMA(0, 1, At, B1); PG8_BAR; PG8_SCHED;
            PG8_LDA(At, 1, 1); PG8_STAGE(PG8_SB(1, 0), b3, voffB); PG8_STAGE(PG8_SB(1, 1), b3 + hstep, voffB); PG8_STAGE(PG8_SA(1, 0), a3, voffA);
            PG8_WAIT_V(8); PG8_WAIT_L(0); PG8_BAR; PG8_MMA(1, 0, At, B0); PG8_MMA(1, 1, At, B1); PG8_BAR; PG8_SCHED;
            } else {
            PG8_LDB(B0, 0, 0); PG8_SCHED; PG8_LDA(At, 0, 0); PG8_STAGE(PG8_SA(1, 1), a1 + hstep, voffA);
            PG8_WAIT_L(8); PG8_BAR; PG8_WAIT_L(0); PG8_MMA(0, 0, At, B0); PG8_BAR; PG8_SCHED;
            PG8_LDB(B1, 0, 1); PG8_STAGE(PG8_SB(0, 0), b2, voffB);
            PG8_BAR; PG8_WAIT_L(0); PG8_MMA(0, 1, At, B1); PG8_BAR;
            PG8_LDA(At, 0, 1); PG8_STAGE(PG8_SA(0, 0), a2, voffA);
            PG8_BAR; PG8_WAIT_L(0); PG8_MMA(1, 0, At, B0); PG8_BAR; PG8_SCHED;
            PG8_STAGE(PG8_SB(0, 1), b2 + hstep, voffB);
            PG8_WAIT_V(6); PG8_BAR; PG8_MMA(1, 1, At, B1); PG8_BAR;
            PG8_LDB(B0, 1, 0); PG8_SCHED; PG8_LDA(At, 1, 0); PG8_STAGE(PG8_SA(0, 1), a2 + hstep, voffA);
            PG8_WAIT_L(8); PG8_BAR; PG8_WAIT_L(0); PG8_MMA(0, 0, At, B0); PG8_BAR; PG8_SCHED;
            PG8_LDB(B1, 1, 1); PG8_STAGE(PG8_SB(1, 0), b3, voffB);
            PG8_BAR; PG8_WAIT_L(0); PG8_MMA(0, 1, At, B1); PG8_BAR;
            PG8_LDA(At, 1, 1); PG8_STAGE(PG8_SA(1, 0), a3, voffA);
            PG8_BAR; PG8_WAIT_L(0); PG8_MMA(1, 0, At, B0); PG8_BAR; PG8_SCHED;
            PG8_STAGE(PG8_SB(1, 1), b3 + hstep, voffB);
            PG8_WAIT_V(6); PG8_BAR; PG8_MMA(1, 1, At, B1); PG8_BAR;
            }
        }
        if constexpr (ALIGN_EPI) { if (wr == 0) PG8_BAR; }
        if constexpr (!Epi::AFTER_DRAIN) { E(acc, cur, wr, wc, fr, fq); S.done(cur); }
        if (!has_next) break;
#pragma unroll
        for (int a = 0; a < 2; ++a)
#pragma unroll
            for (int b = 0; b < 2; ++b)
#pragma unroll
                for (int m = 0; m < 4; ++m)
#pragma unroll
                    for (int n = 0; n < 2; ++n) acc[a][b][m][n] = (f32x4){0.f, 0.f, 0.f, 0.f};
        cur = nxt; cA = nA; cB = nB; ++ui;
        if constexpr (ALIGN_EPI) { if (wr == 1) PG8_BAR; }
    }
    PG8_WAIT_V(0);
    if constexpr (!ALIGN_EPI) { if (wr == 0) PG8_BAR; }
    PG8_BAR;
    if constexpr (Epi::AFTER_DRAIN) { E.fused(acc, cur, wr, wc, fr, fq, lds, wid, lane); S.done(cur); }
#undef PG8_SA
#undef PG8_SB
#undef PG8_STAGE
#undef PG8_LDA
#undef PG8_LDB
#undef PG8_MMA
#undef PG8_WAIT_V
#undef PG8_WAIT_L
#undef PG8_BAR
#undef PG8_SCHED
}
}
#define LAS __attribute__((address_space(3)))
#define XB_TMO      128
#define XB_XCNT(j)  (256  + 64 * (j))
#define XB_XSUB(j)  (1280 + 64 * (j))
#define XB_XGEN(j)  (2304 + 64 * (j))
#define XB_TOP      3328
#define XB_TOPGEN   3392
#define XCD_BAR_WORDS 3456
#define XB_SPIN_CAP (1u << 18)

__device__ __forceinline__ unsigned xb_ld(unsigned* p)              { return __hip_atomic_load(p, __ATOMIC_RELAXED, __HIP_MEMORY_SCOPE_AGENT); }
__device__ __forceinline__ unsigned xb_add(unsigned* p, unsigned v) { return __hip_atomic_fetch_add(p, v, __ATOMIC_RELAXED, __HIP_MEMORY_SCOPE_AGENT); }
__device__ __forceinline__ unsigned xb_xcc_id() { return (unsigned)__builtin_amdgcn_s_getreg((3 << 11) | 20) & 0xFu; }
#define XB_SPIN(cond, bar) do { unsigned _sp = 0; while (cond) { __builtin_amdgcn_s_sleep(1); \
    if ((++_sp & 255u) == 0u) { if (xb_ld(&(bar)[XB_TMO])) break; if (_sp > XB_SPIN_CAP) { atomicAdd(&(bar)[XB_TMO], 1u); break; } } } } while (0)

struct XcdBarrier {
    unsigned* bar; unsigned x;
    volatile LAS unsigned* st;
};

__device__ __forceinline__ XcdBarrier xcd_barrier_post(unsigned* bar, volatile LAS unsigned* st) {
    XcdBarrier b; b.bar = bar; b.x = xb_xcc_id(); b.st = st;
    if (threadIdx.x == 0) (void)xb_add(&bar[XB_XCNT(b.x)], 1u);
    return b;
}
__device__ __forceinline__ void xcd_barrier_complete(unsigned* bar, unsigned x, unsigned& nloc, unsigned& nx) {
    const unsigned G = gridDim.x * gridDim.y * gridDim.z;
    unsigned sum, cnt, mine, sp = 0u;
    for (;;) {
        sum = 0u; cnt = 0u; mine = 0u;
#pragma unroll
        for (unsigned j = 0; j < 16; ++j) { const unsigned c = xb_ld(&bar[XB_XCNT(j)]); sum += c; cnt += (c > 0u) ? 1u : 0u; mine = (j == x) ? c : mine; }
        if (sum == G) break;
        __builtin_amdgcn_s_sleep(1);
        if ((++sp & 255u) == 0u) { if (xb_ld(&bar[XB_TMO])) break; if (sp > XB_SPIN_CAP) { atomicAdd(&bar[XB_TMO], 1u); break; } }
    }
    nloc = mine > 0u ? mine : 1u; nx = cnt > 0u ? cnt : 1u;
}

__device__ __forceinline__ void xcd_barrier(const XcdBarrier& b) {
    asm volatile("s_waitcnt vmcnt(0)" ::: "memory");
    __syncthreads();
    if (threadIdx.x == 0) {
        unsigned* bar = b.bar;
        __builtin_amdgcn_s_waitcnt(0);
        unsigned nloc = b.st[0], nx = b.st[1];
        if (nloc == 0u) { xcd_barrier_complete(bar, b.x, nloc, nx); b.st[0] = nloc; b.st[1] = nx; }
        const unsigned old = xb_add(&bar[XB_XSUB(b.x)], 1u);
        const unsigned gen = old / nloc;
        if (old + 1u == (gen + 1u) * nloc) {
            __builtin_amdgcn_fence(__ATOMIC_RELEASE, "agent");
            asm volatile("s_waitcnt vmcnt(0)" ::: "memory");
            const unsigned og = xb_add(&bar[XB_TOP], 1u);
            const unsigned tg = og / nx;
            if (og + 1u == (tg + 1u) * nx) xb_add(&bar[XB_TOPGEN], 1u);
            else XB_SPIN(xb_ld(&bar[XB_TOPGEN]) == tg, bar);
            __builtin_amdgcn_fence(__ATOMIC_ACQUIRE, "agent");
            xb_add(&bar[XB_XGEN(b.x)], 1u);
            asm volatile("s_waitcnt vmcnt(0)" ::: "memory");
        } else {
            XB_SPIN(xb_ld(&bar[XB_XGEN(b.x)]) == gen, bar);
            __builtin_amdgcn_fence(__ATOMIC_ACQUIRE, "agent");
            asm volatile("s_waitcnt vmcnt(0)" ::: "memory");
        }
    }
    __syncthreads();
}
#define GAS __attribute__((address_space(1)))

typedef unsigned short bf16;
typedef float f32x4 __attribute__((ext_vector_type(4)));
typedef unsigned v4u __attribute__((ext_vector_type(4)));
typedef unsigned v2u __attribute__((ext_vector_type(2)));
#define LDS_WAIT() asm volatile("s_waitcnt lgkmcnt(0)" ::: "memory")

#ifndef MK_ONE_LAUNCH
#define MK_ONE_LAUNCH 0
#endif
#ifndef RET_MFMA
#define RET_MFMA 1
#endif
#ifndef SWA_MFMA
#define SWA_MFMA 1
#endif
#ifndef PROBE_DUP
#define PROBE_DUP 0
#endif
#ifndef CONV_FUSED
#define CONV_FUSED 1
#endif
#ifndef PLE_EARLY
#define PLE_EARLY 1
#endif
#ifndef LN_NOXR
#define LN_NOXR 1
#endif
#define REPS(k) int nrep_ = (PROBE_DUP == (k)) ? 2 : 1; asm volatile("" : "+s"(nrep_)); for (int rep_ = 0; rep_ < nrep_; ++rep_)

constexpr int S = 16384, D = 2048, INW = 5376, DFF = 5632, NUP = 2 * DFF, NUPG = NUP + D, PLE = 256, DEPTH = 4;
constexpr float ALPHA = 1.6817928305074290f, LN_EPS = 1e-5f, GN_EPS = 1e-6f;
constexpr int NPH = 11, NPHASES = 1 + DEPTH * NPH;

constexpr size_t MiB = 1u << 20;
constexpr size_t WS_CTL = 0, CTL_ZERO_BYTES = 32768;
constexpr size_t WS_COSR = 2 * MiB, WS_SINR = 10 * MiB, WS_COSA = 18 * MiB, WS_SINA = 20 * MiB;
constexpr size_t WS_W = 32 * MiB, WL_BYTES = 104 * MiB;
constexpr size_t WL_IN = 0, WL_OUT = 21 * MiB, WL_UP = 29 * MiB, WL_G = 73 * MiB, WL_DOWN = 81 * MiB, WL_P = 103 * MiB;
constexpr size_t WS_XR = 448 * MiB, WS_XB = 576 * MiB, WS_Y = 640 * MiB;
constexpr size_t WS_Q = 768 * MiB, WS_K = 800 * MiB, WS_V = 832 * MiB, WS_G = 864 * MiB, WS_AQ = 896 * MiB, WS_AK = 928 * MiB, WS_AV = 932 * MiB;
constexpr size_t WS_MIX = 936 * MiB, WS_U = 1000 * MiB, WS_PS = 1128 * MiB, WS_RETY = 1160 * MiB;
constexpr size_t WS_H = 768 * MiB, WS_ACT = 1128 * MiB, WS_SG = 1304 * MiB, WS_PB = 1368 * MiB, WS_END = 1400 * MiB;
constexpr size_t WS_PP = 1064 * MiB;
constexpr size_t WS_ST1 = 448 * MiB, WS_ST2 = 449 * MiB;
constexpr int CW_BAR = 4096;
static_assert((CW_BAR + 3456) * 4 <= 32768, "barrier words inside the per-call memset");

constexpr int RING_BYTES = 131072, LDS_BYTES = 147456, LDSCTL_OFF = LDS_BYTES - 1024, MISC_OFF = LDSCTL_OFF + 320;

__device__ __forceinline__ unsigned f2bf(float f) { unsigned u = __builtin_bit_cast(unsigned, f); return (u + 0x7fffu + ((u >> 16) & 1u)) >> 16; }
__device__ __forceinline__ unsigned pk2(float lo, float hi) { return f2bf(lo) | (f2bf(hi) << 16); }
__device__ __forceinline__ float bflo(unsigned w) { return __uint_as_float(w << 16); }
__device__ __forceinline__ float bfhi(unsigned w) { return __uint_as_float(w & 0xffff0000u); }
__device__ __forceinline__ float bf1(const bf16* p) { return __uint_as_float(((unsigned)*p) << 16); }

struct Params {
    const float* in[19]; float* out; unsigned char* ws; int ph_lo, ph_hi;
    float invf_ret[128]; float invf_att[32]; float lg2g[4];
};

struct Ctx { int tid, lane, wave, G, bid; unsigned char* ws; };

__device__ __forceinline__ int lane_id_asm() { int l; asm volatile("v_mbcnt_lo_u32_b32 %0, -1, 0\n\tv_mbcnt_hi_u32_b32 %0, -1, %0" : "=v"(l)); return l; }
__device__ __forceinline__ float wave_sum(float v, int lane) {
#pragma unroll
    for (int o = 1; o < 64; o <<= 1) v += __builtin_bit_cast(float, __builtin_amdgcn_ds_bpermute((lane ^ o) << 2, __builtin_bit_cast(int, v)));
    return v;
}
__device__ __forceinline__ void transpose_item(const float* W, int K, int N, int src_col0, bf16* WT, int dst_row0, int k0, LAS float* scr, int lane) {
#pragma unroll 8
    for (int i = 0; i < 32; ++i) { const int kk = 2 * i + (lane >> 5); scr[kk * 33 + (lane & 31)] = W[(size_t)(k0 + kk) * N + src_col0 + (lane & 31)]; }
    LDS_WAIT(); asm volatile("" ::: "memory");
    const int c = lane & 7;
#pragma unroll
    for (int j = 0; j < 4; ++j) { const int n = (lane >> 3) + 8 * j; const LAS float* s = scr + (8 * c) * 33 + n;
        v4u o; o.x = pk2(s[0 * 33], s[1 * 33]); o.y = pk2(s[2 * 33], s[3 * 33]); o.z = pk2(s[4 * 33], s[5 * 33]); o.w = pk2(s[6 * 33], s[7 * 33]);
        *(v4u*)(WT + (size_t)(dst_row0 + n) * K + k0 + 8 * c) = o; }
    LDS_WAIT(); asm volatile("" ::: "memory");
}
__device__ __forceinline__ void transpose_item64(const float* W, int K, int N, int srcA, int srcB, bf16* WT, int dst_row0, int k0, LAS float* scr, int lane) {
    const int c4 = lane & 15, gsel = c4 >> 3, col = 4 * (c4 & 7), src = (gsel ? srcB : srcA) + col, kq = lane >> 4;
    f32x4 v[16];
#pragma unroll
    for (int i = 0; i < 16; ++i) v[i] = *(const f32x4*)(W + (size_t)(k0 + 4 * i + kq) * N + src);
#pragma unroll
    for (int i = 0; i < 16; ++i) { LAS float* d = scr + (4 * i + kq) * 65 + 32 * gsel + col; d[0] = v[i][0]; d[1] = v[i][1]; d[2] = v[i][2]; d[3] = v[i][3]; }
    LDS_WAIT(); asm volatile("" ::: "memory");
    const int c = lane & 7;
#pragma unroll
    for (int j = 0; j < 8; ++j) { const int n = (lane >> 3) + 8 * j; const LAS float* s = scr + (8 * c) * 65 + n;
        v4u o; o.x = pk2(s[0 * 65], s[1 * 65]); o.y = pk2(s[2 * 65], s[3 * 65]); o.z = pk2(s[4 * 65], s[5 * 65]); o.w = pk2(s[6 * 65], s[7 * 65]);
        *(v4u*)(WT + (size_t)(dst_row0 + n) * K + k0 + 8 * c) = o; }
    LDS_WAIT(); asm volatile("" ::: "memory");
}
__device__ __forceinline__ int win_src_col(int g) {
    const int tile = g >> 3, bj = (g >> 2) & 1, wcg = g & 3;
    if (tile < 16) return 32 * g;
    if (tile < 20) return 4096 + 256 * (tile - 16) + 64 * wcg + 32 * bj;
    return wcg < 2 ? 5120 + 64 * wcg + 32 * bj : 5248 + 32 * (wcg - 2) + 64 * bj;
}
__device__ __forceinline__ int wup_src_col(int g) { const int tile = g >> 3, bj = (g >> 2) & 1, wcg = g & 3; return (bj ? DFF : 0) + 128 * tile + 32 * wcg; }

__device__ __forceinline__ void sincos_d(float angf, float& s, float& c) {
    const double a = (double)angf;
    const double k = __builtin_rint(a * 0.63661977236758134308);
    double r = __builtin_fma(-k, 1.57079632679489661923, a); r = __builtin_fma(-k, 6.123233995736766e-17, r);
    const double r2 = r * r;
    const double sp = r + r * r2 * (-1.0 / 6 + r2 * (1.0 / 120 + r2 * (-1.0 / 5040 + r2 * (1.0 / 362880 + r2 * (-1.0 / 39916800)))));
    const double cp = 1.0 + r2 * (-0.5 + r2 * (1.0 / 24 + r2 * (-1.0 / 720 + r2 * (1.0 / 40320 + r2 * (-1.0 / 3628800 + r2 * (1.0 / 479001600))))));
    const int q = ((int)k) & 3;
    const double sv = (q == 0) ? sp : (q == 1) ? cp : (q == 2) ? -sp : -cp;
    const double cv = (q == 0) ? cp : (q == 1) ? -sp : (q == 2) ? -cp : sp;
    s = (float)sv; c = (float)cv;
}

__device__ __forceinline__ void phase_prologue(const Params& P, const Ctx& cx, LAS unsigned char* lds) {
    unsigned char* ws = cx.ws; const int tid = cx.tid, lane = cx.lane, wave = cx.wave, G = cx.G;
    LAS float* scr = (LAS float*)(lds + wave * 16896);
    const int gw = cx.bid * 8 + wave, NGW = G * 8;
    constexpr int I_IN = 32 * 84, I_OUT = 32 * 32, I_UP = 32 * 176, I_G = 32 * 32, I_DN = 88 * 32, I_P = 4 * 32, I_L = I_IN + I_OUT + I_UP + I_G + I_DN + I_P;
    for (int it = gw; it < DEPTH * I_L; it += NGW) {
        const int l = it / I_L; int r = it - l * I_L;
        bf16* wl = (bf16*)(ws + WS_W + (size_t)l * WL_BYTES);
        if (r < I_IN) { const int kb = r / 84, g = r % 84; transpose_item64(P.in[3] + (size_t)l * D * INW, D, INW, win_src_col(2 * g), win_src_col(2 * g + 1), wl + WL_IN / 2, 64 * g, 64 * kb, scr, lane); continue; } r -= I_IN;
        if (r < I_OUT) { const int kb = r / 32, g = r % 32; transpose_item64(P.in[4] + (size_t)l * D * D, D, D, 64 * g, 64 * g + 32, wl + WL_OUT / 2, 64 * g, 64 * kb, scr, lane); continue; } r -= I_OUT;
        if (r < I_UP) { const int kb = r / 176, g = r % 176; transpose_item64(P.in[10] + (size_t)l * D * NUP, D, NUP, wup_src_col(2 * g), wup_src_col(2 * g + 1), wl + WL_UP / 2, 64 * g, 64 * kb, scr, lane); continue; } r -= I_UP;
        if (r < I_G) { const int kb = r / 32, g = r % 32; transpose_item64(P.in[16] + (size_t)l * D * D, D, D, 64 * g, 64 * g + 32, wl + WL_G / 2, 64 * g, 64 * kb, scr, lane); continue; } r -= I_G;
        if (r < I_DN) { const int kb = r / 32, g = r % 32; transpose_item64(P.in[13] + (size_t)l * DFF * D, DFF, D, 64 * g, 64 * g + 32, wl + WL_DOWN / 2, 64 * g, 64 * kb, scr, lane); continue; } r -= I_DN;
        { const int kb = r / 32, g = r % 32; transpose_item64(P.in[18] + (size_t)l * PLE * D, PLE, D, 64 * g, 64 * g + 32, wl + WL_P / 2, 64 * g, 64 * kb, scr, lane); }
    }
    const size_t gt = (size_t)cx.bid * 512 + tid, NT = (size_t)G * 512;
    { const float* x = P.in[0]; bf16* xb = (bf16*)(ws + WS_XB);
      for (size_t i = gt; i < (size_t)S * D / 8; i += NT) { const f32x4 a = *(const f32x4*)(x + i * 8), b = *(const f32x4*)(x + i * 8 + 4);
          v4u o; o.x = pk2(a[0], a[1]); o.y = pk2(a[2], a[3]); o.z = pk2(b[0], b[1]); o.w = pk2(b[2], b[3]); *(v4u*)(xb + i * 8) = o; } }
    { const float* p = P.in[1]; bf16* pb = (bf16*)(ws + WS_PB);
      for (size_t i = gt; i < (size_t)DEPTH * S * PLE / 8; i += NT) { const f32x4 a = *(const f32x4*)(p + i * 8), b = *(const f32x4*)(p + i * 8 + 4);
          v4u o; o.x = pk2(a[0], a[1]); o.y = pk2(a[2], a[3]); o.z = pk2(b[0], b[1]); o.w = pk2(b[2], b[3]); *(v4u*)(pb + i * 8) = o; } }
    { const int* pos = (const int*)P.in[2]; float* cosr = (float*)(ws + WS_COSR); float* sinr = (float*)(ws + WS_SINR); float* cosa = (float*)(ws + WS_COSA); float* sina = (float*)(ws + WS_SINA);
      for (size_t i = gt; i < (size_t)S * 128; i += NT) { const int t = (int)(i >> 7), f = (int)(i & 127); float s, c; sincos_d((float)pos[t] * P.invf_ret[f], s, c); cosr[i] = c; sinr[i] = s; }
      for (size_t i = gt; i < (size_t)S * 32; i += NT) { const int t = (int)(i >> 5), f = (int)(i & 31); float s, c; sincos_d((float)pos[t] * P.invf_att[f], s, c); cosa[i] = c; sina[i] = s; } }
}

template <int MT, int NT_, int KK, bool A_KFAST, bool B_NFAST, class FA, class FB, class FC>
__device__ __forceinline__ void simple_gemm(LAS unsigned char* lds, int nbatch, int tid, int G, int bid, const FA& fa, const FB& fb, const FC& fc) {
    LAS float* As = (LAS float*)lds;
    LAS float* Bs = (LAS float*)(lds + 16 * 132 * 4);
    constexpr int TM = MT / 128, TN = NT_ / 64, ITEMS_PER_B = TM * TN;
    const int tm = tid & 31, tn = tid >> 5;
    for (int item = bid; item < nbatch * ITEMS_PER_B; item += G) {
        const int b = item / ITEMS_PER_B, r = item % ITEMS_PER_B, m0 = (r / TN) * 128, n0 = (r % TN) * 64;
        float c[4][4];
#pragma unroll
        for (int i = 0; i < 4; ++i)
#pragma unroll
            for (int j = 0; j < 4; ++j) c[i][j] = 0.f;
        for (int k0 = 0; k0 < KK; k0 += 16) {
#pragma unroll
            for (int rr = 0; rr < 4; ++rr) { const int e = tid + 512 * rr; int m, k; if (A_KFAST) { k = e & 15; m = e >> 4; } else { m = e & 127; k = e >> 7; }
                As[k * 132 + m] = fa(b, m0 + m, k0 + k); }
#pragma unroll
            for (int rr = 0; rr < 2; ++rr) { const int e = tid + 512 * rr; int n, k; if (B_NFAST) { n = e & 63; k = e >> 6; } else { k = e & 15; n = e >> 4; }
                Bs[k * 68 + n] = fb(b, k0 + k, n0 + n); }
            __syncthreads();
#pragma unroll
            for (int kk = 0; kk < 16; ++kk) { const f32x4 a = *(const LAS f32x4*)(As + kk * 132 + 4 * tm), bb = *(const LAS f32x4*)(Bs + kk * 68 + 4 * tn);
#pragma unroll
                for (int i = 0; i < 4; ++i)
#pragma unroll
                    for (int j = 0; j < 4; ++j) c[i][j] += a[i] * bb[j]; }
            __syncthreads();
        }
#pragma unroll
        for (int i = 0; i < 4; ++i)
#pragma unroll
            for (int j = 0; j < 4; ++j) fc(b, m0 + 4 * tm + i, n0 + 4 * tn + j, c[i][j]);
    }
}

__device__ __forceinline__ void phase_swa(const Params& P, const Ctx& cx, int l, LAS unsigned char* lds) {
    unsigned char* ws = cx.ws; const int tid = cx.tid, G = cx.G;
    const bf16* AQ = (const bf16*)(ws + WS_AQ); const bf16* AK = (const bf16*)(ws + WS_AK); const bf16* AV = (const bf16*)(ws + WS_AV); bf16* MIX = (bf16*)(ws + WS_MIX);
    const float* sinks = P.in[7] + l * 16;
    LAS unsigned* Ks = (LAS unsigned*)lds;
    LAS unsigned* Vs = (LAS unsigned*)(lds + 256 * 33 * 4);
    for (int item = cx.bid; item < 256; item += G) {
        const int nb = item >> 1, hk = item & 1;
        __syncthreads();
        for (int e = tid; e < 256 * 32; e += 512) { const int r = e >> 5, cdw = e & 31; const int gk = nb * 128 - 128 + r;
            unsigned kv = 0u, vv = 0u; if (gk >= 0) { kv = *(const unsigned*)(AK + (size_t)gk * 128 + hk * 64 + 2 * cdw); vv = *(const unsigned*)(AV + (size_t)gk * 128 + hk * 64 + 2 * cdw); }
            Ks[r * 33 + cdw] = kv; Vs[r * 33 + cdw] = vv; }
        __syncthreads();
#pragma unroll 1
        for (int rep = 0; rep < 2; ++rep) {
            const int pair = tid + 512 * rep, i = pair & 127, g = pair >> 7, hq = hk * 8 + g; const int row = nb * 128 + i;
            float q[64], o[64];
            { const v4u* qp = (const v4u*)(AQ + (size_t)row * 1024 + hq * 64);
#pragma unroll
              for (int c8 = 0; c8 < 8; ++c8) { const v4u w = qp[c8]; q[8 * c8 + 0] = bflo(w.x); q[8 * c8 + 1] = bfhi(w.x); q[8 * c8 + 2] = bflo(w.y); q[8 * c8 + 3] = bfhi(w.y); q[8 * c8 + 4] = bflo(w.z); q[8 * c8 + 5] = bfhi(w.z); q[8 * c8 + 6] = bflo(w.w); q[8 * c8 + 7] = bfhi(w.w); } }
#pragma unroll
            for (int d = 0; d < 64; ++d) o[d] = 0.f;
            float mx = sinks[hq], den = 1.0f;
            const int jj0 = (nb == 0) ? (127 - i) : 0;
            for (int jj = jj0; jj < 128; ++jj) { const int kl = i + 1 + jj;
                float s = 0.f;
#pragma unroll
                for (int c = 0; c < 32; ++c) { const unsigned w = Ks[kl * 33 + c]; s += q[2 * c] * bflo(w) + q[2 * c + 1] * bfhi(w); }
                const float mn = fmaxf(mx, s), sc = __expf(mx - mn), p = __expf(s - mn);
                den = den * sc + p; mx = mn;
#pragma unroll
                for (int c = 0; c < 32; ++c) { const unsigned w = Vs[kl * 33 + c]; o[2 * c] = o[2 * c] * sc + p * bflo(w); o[2 * c + 1] = o[2 * c + 1] * sc + p * bfhi(w); }
            }
            const float inv = 1.0f / den;
            v4u* op = (v4u*)(MIX + (size_t)row * 2048 + 1024 + hq * 64);
#pragma unroll
            for (int c8 = 0; c8 < 8; ++c8) { v4u w; w.x = pk2(o[8 * c8] * inv, o[8 * c8 + 1] * inv); w.y = pk2(o[8 * c8 + 2] * inv, o[8 * c8 + 3] * inv); w.z = pk2(o[8 * c8 + 4] * inv, o[8 * c8 + 5] * inv); w.w = pk2(o[8 * c8 + 6] * inv, o[8 * c8 + 7] * inv); op[c8] = w; }
        }
    }
}

__device__ __forceinline__ void phase_ret_u_scores(const Params& P, const Ctx& cx, LAS unsigned char* lds) {
    unsigned char* ws = cx.ws; const int tid = cx.tid, G = cx.G;
    const bf16* Q = (const bf16*)(ws + WS_Q); const bf16* K = (const bf16*)(ws + WS_K); const bf16* V = (const bf16*)(ws + WS_V);
    float* U = (float*)(ws + WS_U); float* PS = (float*)(ws + WS_PS);
    const float lg0 = P.lg2g[0], lg1 = P.lg2g[1], lg2 = P.lg2g[2], lg3 = P.lg2g[3];
    auto lgh = [=](int h) { return h == 0 ? lg0 : h == 1 ? lg1 : h == 2 ? lg2 : lg3; };
    simple_gemm<256, 256, 128, false, true>(lds, 512, tid, G, cx.bid,
        [=](int b, int m, int k) { const int nb = b >> 2, h = b & 3; return bf1(K + (size_t)(nb * 128 + k) * 1024 + h * 256 + m) * exp2f(lgh(h) * (float)(127 - k)); },
        [=](int b, int k, int n) { const int nb = b >> 2, h = b & 3; return bf1(V + (size_t)(nb * 128 + k) * 1024 + h * 256 + n); },
        [=](int b, int m, int n, float v) { U[((size_t)b * 256 + m) * 256 + n] = v; });
    simple_gemm<128, 128, 256, true, false>(lds, 512, tid, G, cx.bid,
        [=](int b, int m, int k) { const int nb = b >> 2, h = b & 3; return bf1(Q + (size_t)(nb * 128 + m) * 1024 + h * 256 + k); },
        [=](int b, int k, int n) { const int nb = b >> 2, h = b & 3; return bf1(K + (size_t)(nb * 128 + n) * 1024 + h * 256 + k); },
        [=](int b, int m, int n, float v) { const int h = b & 3; PS[((size_t)b * 128 + m) * 128 + n] = (m >= n) ? v * exp2f(lgh(h) * (float)(m - n)) : 0.f; });
}
__device__ __forceinline__ void phase_scan(const Params& P, const Ctx& cx) {
    float* U = (float*)(cx.ws + WS_U);
    const size_t gt = (size_t)cx.bid * 512 + cx.tid, NT = (size_t)cx.G * 512;
    for (size_t idx = gt; idx < 4 * 65536; idx += NT) {
        const int h = (int)(idx >> 16); const float cd = exp2f(P.lg2g[h] * 128.0f);
        float r = 0.f;
        for (int n0 = 0; n0 < 128; n0 += 8) { float u[8];
#pragma unroll
            for (int j = 0; j < 8; ++j) u[j] = U[(size_t)(n0 + j) * 262144 + idx];
#pragma unroll
            for (int j = 0; j < 8; ++j) { U[(size_t)(n0 + j) * 262144 + idx] = r; r = r * cd + u[j]; } }
    }
}
__device__ __forceinline__ void phase_ret_out(const Params& P, const Ctx& cx, LAS unsigned char* lds) {
    unsigned char* ws = cx.ws; const int tid = cx.tid, G = cx.G;
    const bf16* Q = (const bf16*)(ws + WS_Q); const bf16* V = (const bf16*)(ws + WS_V);
    const float* Sst = (const float*)(ws + WS_U); const float* PS = (const float*)(ws + WS_PS); float* RY = (float*)(ws + WS_RETY);
    const float lg0 = P.lg2g[0], lg1 = P.lg2g[1], lg2 = P.lg2g[2], lg3 = P.lg2g[3];
    auto lgh = [=](int h) { return h == 0 ? lg0 : h == 1 ? lg1 : h == 2 ? lg2 : lg3; };
    simple_gemm<128, 256, 384, true, true>(lds, 512, tid, G, cx.bid,
        [=](int b, int m, int k) { const int nb = b >> 2, h = b & 3; return k < 128 ? PS[((size_t)b * 128 + m) * 128 + k] : bf1(Q + (size_t)(nb * 128 + m) * 1024 + h * 256 + (k - 128)) * exp2f(lgh(h) * (float)(m + 1)); },
        [=](int b, int k, int n) { const int nb = b >> 2, h = b & 3; return k < 128 ? bf1(V + (size_t)(nb * 128 + k) * 1024 + h * 256 + n) : Sst[((size_t)b * 256 + (k - 128)) * 256 + n]; },
        [=](int b, int m, int n, float v) { const int nb = b >> 2, h = b & 3; RY[(size_t)(nb * 128 + m) * 1024 + h * 256 + n] = v; });
}

typedef short bf16x8 __attribute__((ext_vector_type(8)));
typedef short s16x4 __attribute__((ext_vector_type(4)));
typedef short v4i16_t __attribute__((ext_vector_type(4)));
__device__ __forceinline__ f32x4 mfma16(bf16x8 a, bf16x8 b, f32x4 c) { return __builtin_amdgcn_mfma_f32_16x16x32_bf16(a, b, c, 0, 0, 0); }
__device__ __forceinline__ s16x4 lds_tr(LAS unsigned char* p) { return __builtin_bit_cast(s16x4, __builtin_amdgcn_ds_read_tr16_b64_v4i16((LAS v4i16_t*)p)); }
__device__ __forceinline__ bf16x8 cat44(s16x4 a, s16x4 b) { bf16x8 r; r[0] = a[0]; r[1] = a[1]; r[2] = a[2]; r[3] = a[3]; r[4] = b[0]; r[5] = b[1]; r[6] = b[2]; r[7] = b[3]; return r; }
__device__ __forceinline__ unsigned cvt2(float lo, float hi) { return pg8::cvt_pk_bf16(lo, hi); }
__device__ __forceinline__ bf16x8 pack_frag(const f32x4 a, const f32x4 b) { v4u w; w.x = cvt2(a[0], a[1]); w.y = cvt2(a[2], a[3]); w.z = cvt2(b[0], b[1]); w.w = cvt2(b[2], b[3]); return __builtin_bit_cast(bf16x8, w); }
__device__ __forceinline__ float grp16_sum(float v, int lane) {
#pragma unroll
    for (int o = 1; o < 16; o <<= 1) v += __builtin_bit_cast(float, __builtin_amdgcn_ds_bpermute((lane ^ o) << 2, __builtin_bit_cast(int, v)));
    return v;
}
constexpr int RS_T = 544;
constexpr int TILE_T = 128 * RS_T;
static_assert(2 * TILE_T <= LDSCTL_OFF, "retention tiles vs LDS control words");

template <bool DECAY> __device__ __forceinline__ void stage_tile(LAS unsigned char* img, const bf16* src, int tid, float lg) {
    v4u v[8];
#pragma unroll
    for (int r = 0; r < 8; ++r) { const int pc = tid + 512 * r, row = pc >> 5, c16 = pc & 31; v[r] = *(const v4u*)(src + (size_t)row * 1024 + c16 * 8); }
#pragma unroll
    for (int r = 0; r < 8; ++r) { const int pc = tid + 512 * r, row = pc >> 5, c16 = pc & 31; v4u w = v[r];
        if (DECAY) { const float sc = exp2f(lg * (float)(127 - row));
            w.x = cvt2(bflo(w.x) * sc, bfhi(w.x) * sc); w.y = cvt2(bflo(w.y) * sc, bfhi(w.y) * sc); w.z = cvt2(bflo(w.z) * sc, bfhi(w.z) * sc); w.w = cvt2(bflo(w.w) * sc, bfhi(w.w) * sc); }
        *(LAS v4u*)(img + row * RS_T + c16 * 16) = w; }
}

template <bool DECAY_A> __device__ __forceinline__ void stage_two(LAS unsigned char* imgA, const bf16* srcA, LAS unsigned char* imgB, const bf16* srcB, int tid, float lg) {
    v4u va[8], vb[8];
#pragma unroll
    for (int r = 0; r < 8; ++r) { const int pc = tid + 512 * r, row = pc >> 5, c16 = pc & 31; va[r] = *(const v4u*)(srcA + (size_t)row * 1024 + c16 * 8); vb[r] = *(const v4u*)(srcB + (size_t)row * 1024 + c16 * 8); }
#pragma unroll
    for (int r = 0; r < 8; ++r) { const int pc = tid + 512 * r, row = pc >> 5, c16 = pc & 31; v4u w = va[r];
        if (DECAY_A) { const float sc = exp2f(lg * (float)(127 - row));
            w.x = cvt2(bflo(w.x) * sc, bfhi(w.x) * sc); w.y = cvt2(bflo(w.y) * sc, bfhi(w.y) * sc); w.z = cvt2(bflo(w.z) * sc, bfhi(w.z) * sc); w.w = cvt2(bflo(w.w) * sc, bfhi(w.w) * sc); }
        *(LAS v4u*)(imgA + row * RS_T + c16 * 16) = w; *(LAS v4u*)(imgB + row * RS_T + c16 * 16) = vb[r]; }
}

__device__ __forceinline__ void phase_ret_u_mfma(const Params& P, const Ctx& cx, LAS unsigned char* lds) {
    unsigned char* ws = cx.ws; const int tid = cx.tid, lane = cx.lane, w = cx.wave, r16 = lane & 15, g = lane >> 4, q = r16 >> 2, pp = r16 & 3;
    const bf16* K = (const bf16*)(ws + WS_K); const bf16* V = (const bf16*)(ws + WS_V); bf16* UT = (bf16*)(ws + WS_U);
    LAS unsigned char* Kim = lds; LAS unsigned char* Vim = lds + TILE_T;
    for (int b = cx.bid; b < 512; b += cx.G) {
        const int nb = b >> 2, h = b & 3;
        __syncthreads();
        stage_two<true>(Kim, K + (size_t)nb * 128 * 1024 + h * 256, Vim, V + (size_t)nb * 128 * 1024 + h * 256, tid, P.lg2g[h]);
        __syncthreads();
        f32x4 acc[2][16];
#pragma unroll
        for (int mi = 0; mi < 2; ++mi)
#pragma unroll
            for (int n = 0; n < 16; ++n) acc[mi][n] = (f32x4){0.f, 0.f, 0.f, 0.f};
#pragma unroll 1
        for (int s = 0; s < 4; ++s) {
            bf16x8 af[2];
#pragma unroll
            for (int mi = 0; mi < 2; ++mi) { LAS unsigned char* a0 = Kim + (32 * s + 8 * g + q) * RS_T + (16 * (2 * w + mi) + 4 * pp) * 2; af[mi] = cat44(lds_tr(a0), lds_tr(a0 + 4 * RS_T)); }
#pragma unroll
            for (int n = 0; n < 16; ++n) { LAS unsigned char* b0 = Vim + (32 * s + 8 * g + q) * RS_T + (16 * n + 4 * pp) * 2; const bf16x8 bfr = cat44(lds_tr(b0), lds_tr(b0 + 4 * RS_T));
                acc[0][n] = mfma16(af[0], bfr, acc[0][n]); acc[1][n] = mfma16(af[1], bfr, acc[1][n]); }
        }
#pragma unroll
        for (int mi = 0; mi < 2; ++mi)
#pragma unroll
            for (int n = 0; n < 16; ++n) { v2u o; o.x = cvt2(acc[mi][n][0], acc[mi][n][1]); o.y = cvt2(acc[mi][n][2], acc[mi][n][3]);
                *(v2u*)(UT + ((size_t)b * 256 + 16 * n + r16) * 256 + 16 * (2 * w + mi) + 4 * g) = o; }
    }
}
__device__ __forceinline__ void phase_scan_bf16(const Params& P, const Ctx& cx) {
    unsigned* UT = (unsigned*)(cx.ws + WS_U);
    const size_t gt = (size_t)cx.bid * 512 + cx.tid, NT = (size_t)cx.G * 512;
    for (size_t idx = gt; idx < 131072; idx += NT) {
        const int h = (int)(idx >> 15); const float cd = exp2f(P.lg2g[h] * 128.0f);
        float r0 = 0.f, r1 = 0.f;
        for (int n0 = 0; n0 < 128; n0 += 16) { unsigned u[16];
#pragma unroll
            for (int j = 0; j < 16; ++j) u[j] = UT[(size_t)(n0 + j) * 131072 + idx];
#pragma unroll
            for (int j = 0; j < 16; ++j) { UT[(size_t)(n0 + j) * 131072 + idx] = cvt2(r0, r1); r0 = r0 * cd + bflo(u[j]); r1 = r1 * cd + bfhi(u[j]); } }
    }
}
__device__ __forceinline__ void phase_ret_out_mfma(const Params& P, const Ctx& cx, int l, LAS unsigned char* lds) {
    unsigned char* ws = cx.ws; const int tid = cx.tid, lane = cx.lane, w = cx.wave, r16 = lane & 15, g = lane >> 4, q = r16 >> 2, pp = r16 & 3;
    const bf16* Q = (const bf16*)(ws + WS_Q); const bf16* K = (const bf16*)(ws + WS_K); const bf16* V = (const bf16*)(ws + WS_V); const bf16* ST = (const bf16*)(ws + WS_U);
    const bf16* Gt = (const bf16*)(ws + WS_G); bf16* MIX = (bf16*)(ws + WS_MIX);
    const float* gg = P.in[5] + l * 1024; const float* gb = P.in[6] + l * 1024;
    LAS unsigned char* Kim = lds; LAS unsigned char* Vim = lds + TILE_T;
    for (int b = cx.bid; b < 512; b += cx.G) {
        const int nb = b >> 2, h = b & 3; const float lg = P.lg2g[h];
        __syncthreads();
        stage_two<false>(Kim, K + (size_t)nb * 128 * 1024 + h * 256, Vim, V + (size_t)nb * 128 * 1024 + h * 256, tid, 0.f);
        bf16x8 qf[8];
        { const bf16* qrow = Q + (size_t)(nb * 128 + 16 * w + r16) * 1024 + h * 256 + 8 * g;
#pragma unroll
          for (int s = 0; s < 8; ++s) qf[s] = *(const bf16x8*)(qrow + 32 * s); }
        f32x4 acc[16];
        const bf16* strow = ST + ((size_t)b * 256 + r16) * 256 + 8 * g;
#pragma unroll
        for (int n = 0; n < 16; ++n) { bf16x8 sb[8];
#pragma unroll
            for (int s = 0; s < 8; ++s) sb[s] = *(const bf16x8*)(strow + (size_t)n * 16 * 256 + 32 * s);
            f32x4 a = (f32x4){0.f, 0.f, 0.f, 0.f};
#pragma unroll
            for (int s = 0; s < 8; ++s) a = mfma16(qf[s], sb[s], a);
            acc[n] = a; }
        { float f[4];
#pragma unroll
          for (int r = 0; r < 4; ++r) f[r] = exp2f(lg * (float)(16 * w + 4 * g + r + 1));
#pragma unroll
          for (int n = 0; n < 16; ++n) { acc[n][0] *= f[0]; acc[n][1] *= f[1]; acc[n][2] *= f[2]; acc[n][3] *= f[3]; } }
        __syncthreads();
        f32x4 sc[8];
#pragma unroll
        for (int mb = 0; mb < 8; ++mb) { sc[mb] = (f32x4){0.f, 0.f, 0.f, 0.f};
            if (mb <= w) { f32x4 a = (f32x4){0.f, 0.f, 0.f, 0.f};
#pragma unroll
                for (int s = 0; s < 8; ++s) { const bf16x8 kf = *(const LAS bf16x8*)(Kim + (16 * mb + r16) * RS_T + (32 * s + 8 * g) * 2); a = mfma16(kf, qf[s], a); }
                const int i = 16 * w + r16;
#pragma unroll
                for (int r = 0; r < 4; ++r) { const int j = 16 * mb + 4 * g + r; a[r] = (i >= j) ? a[r] * exp2f(lg * (float)(i - j)) : 0.f; }
                sc[mb] = a; } }
#pragma unroll
        for (int sk = 0; sk < 4; ++sk) {
            if (2 * sk <= w) { const bf16x8 pf = pack_frag(sc[2 * sk], sc[2 * sk + 1]);
#pragma unroll
                for (int n = 0; n < 16; ++n) { LAS unsigned char* b0 = Vim + (32 * sk + 4 * g + q) * RS_T + (16 * n + 4 * pp) * 2; const bf16x8 bfr = cat44(lds_tr(b0), lds_tr(b0 + 16 * RS_T));
                    acc[n] = mfma16(pf, bfr, acc[n]); } } }
        float mean[4], rstd[4];
#pragma unroll
        for (int r = 0; r < 4; ++r) { float sm = 0.f;
#pragma unroll
            for (int n = 0; n < 16; ++n) sm += acc[n][r];
            mean[r] = grp16_sum(sm, lane) * (1.0f / 256.0f); }
#pragma unroll
        for (int r = 0; r < 4; ++r) { float sq = 0.f;
#pragma unroll
            for (int n = 0; n < 16; ++n) { const float d = acc[n][r] - mean[r]; sq += d * d; }
            rstd[r] = 1.0f / sqrtf(grp16_sum(sq, lane) * (1.0f / 256.0f) + GN_EPS); }
#pragma unroll
        for (int n = 0; n < 16; ++n) { const int e = h * 256 + 16 * n + r16; const float g1 = gg[e], b1 = gb[e];
#pragma unroll
            for (int r = 0; r < 4; ++r) { const size_t row = (size_t)(nb * 128 + 16 * w + 4 * g + r);
                const float o = ((acc[n][r] - mean[r]) * rstd[r] * g1 + b1) * bf1(Gt + row * 1024 + e);
                MIX[row * 2048 + e] = (bf16)f2bf(o); } }
    }
}
constexpr int RS_SK = 144, RS_SV = 160;
__device__ __forceinline__ void phase_swa_mfma(const Params& P, const Ctx& cx, int l, LAS unsigned char* lds) {
    unsigned char* ws = cx.ws; const int tid = cx.tid, lane = cx.lane, w = cx.wave, r16 = lane & 15, g = lane >> 4, q = r16 >> 2, pp = r16 & 3;
    const bf16* AQ = (const bf16*)(ws + WS_AQ); const bf16* AK = (const bf16*)(ws + WS_AK); const bf16* AV = (const bf16*)(ws + WS_AV); bf16* MIX = (bf16*)(ws + WS_MIX);
    LAS unsigned char* Kim = lds; LAS unsigned char* Vim = lds + 256 * RS_SK;
    for (int item = cx.bid; item < 256; item += cx.G) {
        const int nb = item >> 1, hk = item & 1, hq = hk * 8 + w; const float sink = P.in[7][l * 16 + hq];
        __syncthreads();
#pragma unroll
        for (int r = 0; r < 4; ++r) { const int pc = tid + 512 * r, row = pc >> 3, c = pc & 7, gk = nb * 128 - 128 + row;
            v4u kv = (v4u){0u, 0u, 0u, 0u}, vv = (v4u){0u, 0u, 0u, 0u};
            if (gk >= 0) { kv = *(const v4u*)(AK + (size_t)gk * 128 + hk * 64 + c * 8); vv = *(const v4u*)(AV + (size_t)gk * 128 + hk * 64 + c * 8); }
            *(LAS v4u*)(Kim + row * RS_SK + c * 16) = kv; *(LAS v4u*)(Vim + row * RS_SV + c * 16) = vv; }
        __syncthreads();
#pragma unroll 1
        for (int nq = 0; nq < 8; ++nq) {
            const bf16* qrow = AQ + (size_t)(nb * 128 + 16 * nq + r16) * 1024 + hq * 64 + 8 * g;
            const bf16x8 qf0 = *(const bf16x8*)(qrow), qf1 = *(const bf16x8*)(qrow + 32);
            f32x4 sc[10];
            float mx = sink;
#pragma unroll
            for (int kb = 0; kb < 9; ++kb) { const LAS unsigned char* kp = Kim + (16 * (nq + kb) + r16) * RS_SK + 16 * g;
                f32x4 a = (f32x4){0.f, 0.f, 0.f, 0.f};
                a = mfma16(*(const LAS bf16x8*)(kp), qf0, a); a = mfma16(*(const LAS bf16x8*)(kp + 64), qf1, a);
#pragma unroll
                for (int r = 0; r < 4; ++r) { const int dl = 16 * kb + 4 * g + r - r16; const bool vis = (dl >= 1) && (dl <= 128) && (nb > 0 || 16 * (nq + kb) + 4 * g + r >= 128);
                    a[r] = vis ? a[r] : -INFINITY; mx = fmaxf(mx, a[r]); }
                sc[kb] = a; }
            sc[9] = (f32x4){0.f, 0.f, 0.f, 0.f};
            mx = fmaxf(mx, __builtin_bit_cast(float, __builtin_amdgcn_ds_bpermute((lane ^ 16) << 2, __builtin_bit_cast(int, mx))));
            mx = fmaxf(mx, __builtin_bit_cast(float, __builtin_amdgcn_ds_bpermute((lane ^ 32) << 2, __builtin_bit_cast(int, mx))));
            float sum = 0.f;
#pragma unroll
            for (int kb = 0; kb < 9; ++kb)
#pragma unroll
                for (int r = 0; r < 4; ++r) { const float pv = __expf(sc[kb][r] - mx); sc[kb][r] = pv; sum += pv; }
            sum += __builtin_bit_cast(float, __builtin_amdgcn_ds_bpermute((lane ^ 16) << 2, __builtin_bit_cast(int, sum)));
            sum += __builtin_bit_cast(float, __builtin_amdgcn_ds_bpermute((lane ^ 32) << 2, __builtin_bit_cast(int, sum)));
            const float inv = 1.0f / (sum + __expf(sink - mx));
            f32x4 o[4];
#pragma unroll
            for (int nd = 0; nd < 4; ++nd) o[nd] = (f32x4){0.f, 0.f, 0.f, 0.f};
#pragma unroll
            for (int sk = 0; sk < 5; ++sk) { const bf16x8 pf = pack_frag(sc[2 * sk] * inv, sc[2 * sk + 1] * inv);
                const int kb0 = nq + 2 * sk, kb1 = (kb0 + 1 > 15) ? 15 : kb0 + 1;
#pragma unroll
                for (int nd = 0; nd < 4; ++nd) { const bf16x8 bfr = cat44(lds_tr(Vim + (16 * kb0 + 4 * g + q) * RS_SV + (16 * nd + 4 * pp) * 2), lds_tr(Vim + (16 * kb1 + 4 * g + q) * RS_SV + (16 * nd + 4 * pp) * 2));
                    o[nd] = mfma16(pf, bfr, o[nd]); } }
#pragma unroll
            for (int nd = 0; nd < 4; ++nd)
#pragma unroll
                for (int r = 0; r < 4; ++r) MIX[(size_t)(nb * 128 + 16 * nq + 4 * g + r) * 2048 + 1024 + hq * 64 + 16 * nd + r16] = (bf16)f2bf(o[nd][r]);
        }
    }
}

__device__ __forceinline__ void phase_groupnorm(const Params& P, const Ctx& cx, int l) {
    unsigned char* ws = cx.ws; const int lane = cx.lane, wave = cx.wave, G = cx.G;
    const float* RY = (const float*)(ws + WS_RETY); const bf16* Gt = (const bf16*)(ws + WS_G); bf16* MIX = (bf16*)(ws + WS_MIX);
    const float* gg = P.in[5] + l * 1024; const float* gb = P.in[6] + l * 1024;
    const int gw = cx.bid * 8 + wave, NGW = G * 8;
    for (int it = gw; it < S * 4; it += NGW) { const int row = it >> 2, h = it & 3; const size_t off = (size_t)row * 1024 + h * 256 + 4 * lane;
        f32x4 v = *(const f32x4*)(RY + off);
        const float mean = wave_sum((v[0] + v[1]) + (v[2] + v[3]), lane) * (1.0f / 256.0f);
        v = v - mean;
        const float var = wave_sum((v[0] * v[0] + v[1] * v[1]) + (v[2] * v[2] + v[3] * v[3]), lane) * (1.0f / 256.0f);
        const float rstd = 1.0f / sqrtf(var + GN_EPS);
        const f32x4 g4 = *(const f32x4*)(gg + h * 256 + 4 * lane), b4 = *(const f32x4*)(gb + h * 256 + 4 * lane);
        const v2u gt2 = *(const v2u*)(Gt + off);
        f32x4 o = v * rstd * g4 + b4;
        o[0] *= bflo(gt2.x); o[1] *= bfhi(gt2.x); o[2] *= bflo(gt2.y); o[3] *= bfhi(gt2.y);
        v2u w; w.x = pk2(o[0], o[1]); w.y = pk2(o[2], o[3]);
        *(v2u*)(MIX + (size_t)row * 2048 + h * 256 + 4 * lane) = w; }
}
__device__ __forceinline__ void phase_ln(const Ctx& cx, const float* Y, const float* g, const float* b, float* xo, bf16* xb, float* stats) {
    const int lane = cx.lane, wave = cx.wave, G = cx.G; const int gw = cx.bid * 8 + wave, NGW = G * 8;
    f32x4 g4[8], b4[8];
#pragma unroll
    for (int j = 0; j < 8; ++j) { g4[j] = ((const f32x4*)g)[64 * j + lane]; b4[j] = ((const f32x4*)b)[64 * j + lane]; }
    for (int row = gw; row < S; row += 2 * NGW) {
        const int row2 = row + NGW; const bool has2 = row2 < S; const int rb = has2 ? row2 : row;
        const f32x4* ya = (const f32x4*)(Y + (size_t)row * D) + lane; const f32x4* yb = (const f32x4*)(Y + (size_t)rb * D) + lane;
        f32x4 va[8], vb[8]; float sa = 0.f, sb = 0.f;
#pragma unroll
        for (int j = 0; j < 8; ++j) { va[j] = ya[64 * j]; vb[j] = yb[64 * j]; }
#pragma unroll
        for (int j = 0; j < 8; ++j) { sa += (va[j][0] + va[j][1]) + (va[j][2] + va[j][3]); sb += (vb[j][0] + vb[j][1]) + (vb[j][2] + vb[j][3]); }
        const float ma = wave_sum(sa, lane) * (1.0f / D), mb = wave_sum(sb, lane) * (1.0f / D); float qa = 0.f, qb = 0.f;
#pragma unroll
        for (int j = 0; j < 8; ++j) { va[j] = va[j] - ma; vb[j] = vb[j] - mb; qa += (va[j][0] * va[j][0] + va[j][1] * va[j][1]) + (va[j][2] * va[j][2] + va[j][3] * va[j][3]); qb += (vb[j][0] * vb[j][0] + vb[j][1] * vb[j][1]) + (vb[j][2] * vb[j][2] + vb[j][3] * vb[j][3]); }
        const float ra = 1.0f / sqrtf(wave_sum(qa, lane) * (1.0f / D) + LN_EPS), rbb = 1.0f / sqrtf(wave_sum(qb, lane) * (1.0f / D) + LN_EPS);
        f32x4* xa = (f32x4*)(xo + (size_t)row * D) + lane; f32x4* xbp = (f32x4*)(xo + (size_t)rb * D) + lane;
        if (stats && lane == 0) { stats[2 * (size_t)row] = ma; stats[2 * (size_t)row + 1] = ra; if (has2) { stats[2 * (size_t)rb] = mb; stats[2 * (size_t)rb + 1] = rbb; } }
#pragma unroll
        for (int j = 0; j < 8; ++j) { const f32x4 o = va[j] * ra * g4[j] + b4[j]; if (xo) xa[64 * j] = o;
            if (xb) { v2u w; w.x = pk2(o[0], o[1]); w.y = pk2(o[2], o[3]); ((v2u*)(xb + (size_t)row * D))[64 * j + lane] = w; } }
        if (has2) {
#pragma unroll
            for (int j = 0; j < 8; ++j) { const f32x4 o = vb[j] * rbb * g4[j] + b4[j]; if (xo) xbp[64 * j] = o;
                if (xb) { v2u w; w.x = pk2(o[0], o[1]); w.y = pk2(o[2], o[3]); ((v2u*)(xb + (size_t)rb * D))[64 * j + lane] = w; } } }
    }
}
__device__ __forceinline__ void unpack8(const v4u h, float (&o)[8]) { o[0] = bflo(h.x); o[1] = bfhi(h.x); o[2] = bflo(h.y); o[3] = bfhi(h.y); o[4] = bflo(h.z); o[5] = bfhi(h.z); o[6] = bflo(h.w); o[7] = bfhi(h.w); }
__device__ __forceinline__ void phase_convact(const Params& P, const Ctx& cx, int l) {
    unsigned char* ws = cx.ws; const int tid = cx.tid, G = cx.G;
    const bf16* H = (const bf16*)(ws + WS_H); bf16* ACT = (bf16*)(ws + WS_ACT);
    const float* cw = P.in[11] + (size_t)l * 3 * NUP; const float* cb = P.in[12] + (size_t)l * NUP;
    const int gt = cx.bid * 512 + tid, NT = G * 512;
    for (int item = gt; item < 512 * 704; item += NT) {
        const int seg = item / 704, r = item - seg * 704, tile = r >> 4, q8 = r & 15, t0 = seg * 32;
        const int chg = 128 * tile + 8 * q8, chu = DFF + chg;
        float wg[3][8], wu[3][8], bg[8], bu[8];
#pragma unroll
        for (int k = 0; k < 3; ++k) { const f32x4 a0 = *(const f32x4*)(cw + (size_t)k * NUP + chg), a1 = *(const f32x4*)(cw + (size_t)k * NUP + chg + 4), c0 = *(const f32x4*)(cw + (size_t)k * NUP + chu), c1 = *(const f32x4*)(cw + (size_t)k * NUP + chu + 4);
#pragma unroll
            for (int e = 0; e < 4; ++e) { wg[k][e] = a0[e]; wg[k][4 + e] = a1[e]; wu[k][e] = c0[e]; wu[k][4 + e] = c1[e]; } }
        { const f32x4 a0 = *(const f32x4*)(cb + chg), a1 = *(const f32x4*)(cb + chg + 4), c0 = *(const f32x4*)(cb + chu), c1 = *(const f32x4*)(cb + chu + 4);
#pragma unroll
          for (int e = 0; e < 4; ++e) { bg[e] = a0[e]; bg[4 + e] = a1[e]; bu[e] = c0[e]; bu[4 + e] = c1[e]; } }
        const bf16* hp = H + (size_t)t0 * NUP + 256 * tile + 8 * q8;
        float g2[8], g1[8], u2[8], u1[8];
        if (t0 > 0) { unpack8(*(const v4u*)(hp - 2 * (size_t)NUP), g2); unpack8(*(const v4u*)(hp - (size_t)NUP), g1); unpack8(*(const v4u*)(hp - 2 * (size_t)NUP + 128), u2); unpack8(*(const v4u*)(hp - (size_t)NUP + 128), u1); }
        else {
#pragma unroll
            for (int e = 0; e < 8; ++e) { g2[e] = 0.f; g1[e] = 0.f; u2[e] = 0.f; u1[e] = 0.f; } }
        bf16* ap = ACT + (size_t)t0 * DFF + chg;
        v4u ng = *(const v4u*)(hp), nu = *(const v4u*)(hp + 128);
#pragma unroll 2
        for (int tt = 0; tt < 32; ++tt) {
            float g0[8], u0[8]; unpack8(ng, g0); unpack8(nu, u0);
            if (tt < 31) { ng = *(const v4u*)(hp + (size_t)(tt + 1) * NUP); nu = *(const v4u*)(hp + (size_t)(tt + 1) * NUP + 128); }
            float o[8];
#pragma unroll
            for (int e = 0; e < 8; ++e) { const float ga = bg[e] + wg[0][e] * g2[e] + wg[1][e] * g1[e] + wg[2][e] * g0[e], ua = bu[e] + wu[0][e] * u2[e] + wu[1][e] * u1[e] + wu[2][e] * u0[e];
                o[e] = ga * __builtin_amdgcn_rcpf(1.0f + __expf(-ga)) * ua; g2[e] = g1[e]; g1[e] = g0[e]; u2[e] = u1[e]; u1[e] = u0[e]; }
            v4u w; w.x = cvt2(o[0], o[1]); w.y = cvt2(o[2], o[3]); w.z = cvt2(o[4], o[5]); w.w = cvt2(o[6], o[7]);
            *(v4u*)(ap + (size_t)tt * DFF) = w;
        }
    }
}

__device__ __forceinline__ void phase_conv_fixup(const Params& P, const Ctx& cx, int l) {
    unsigned char* ws = cx.ws;
    const bf16* HALO = (const bf16*)(ws + WS_H); bf16* ACT = (bf16*)(ws + WS_ACT);
    const float* cw = P.in[11] + (size_t)l * 3 * NUP; const float* cb = P.in[12] + (size_t)l * NUP;
    const int gt = cx.bid * 512 + cx.tid, NT = cx.G * 512;
    for (int item = gt; item < 256 * 704; item += NT) {
        const int k = item / 704, r = item - k * 704, tile = r >> 4, q8 = r & 15, chg = 128 * tile + 8 * q8, chu = DFF + chg;
        float a_g[8], b_g[8], c_g[8], d_g[8], a_u[8], b_u[8], c_u[8], d_u[8];
        const bf16* hk = HALO + (size_t)k * 4 * NUP + 256 * tile + 8 * q8;
        unpack8(*(const v4u*)(hk), c_g); unpack8(*(const v4u*)(hk + NUP), d_g); unpack8(*(const v4u*)(hk + 128), c_u); unpack8(*(const v4u*)(hk + NUP + 128), d_u);
        if (k > 0) { const bf16* hm = hk - 4 * (size_t)NUP; unpack8(*(const v4u*)(hm + 2 * NUP), a_g); unpack8(*(const v4u*)(hm + 3 * NUP), b_g); unpack8(*(const v4u*)(hm + 2 * NUP + 128), a_u); unpack8(*(const v4u*)(hm + 3 * NUP + 128), b_u); }
        else {
#pragma unroll
            for (int e = 0; e < 8; ++e) { a_g[e] = 0.f; b_g[e] = 0.f; a_u[e] = 0.f; b_u[e] = 0.f; } }
        float o0[8], o1[8];
#pragma unroll
        for (int e = 0; e < 8; ++e) { const float w0g = cw[chg + e], w1g = cw[NUP + chg + e], w2g = cw[2 * NUP + chg + e], bgv = cb[chg + e], w0u = cw[chu + e], w1u = cw[NUP + chu + e], w2u = cw[2 * NUP + chu + e], buv = cb[chu + e];
            const float g0 = bgv + w0g * a_g[e] + w1g * b_g[e] + w2g * c_g[e], u0 = buv + w0u * a_u[e] + w1u * b_u[e] + w2u * c_u[e];
            const float g1 = bgv + w0g * b_g[e] + w1g * c_g[e] + w2g * d_g[e], u1 = buv + w0u * b_u[e] + w1u * c_u[e] + w2u * d_u[e];
            o0[e] = g0 * __builtin_amdgcn_rcpf(1.0f + __expf(-g0)) * u0; o1[e] = g1 * __builtin_amdgcn_rcpf(1.0f + __expf(-g1)) * u1; }
        v4u w0, w1; w0.x = cvt2(o0[0], o0[1]); w0.y = cvt2(o0[2], o0[3]); w0.z = cvt2(o0[4], o0[5]); w0.w = cvt2(o0[6], o0[7]); w1.x = cvt2(o1[0], o1[1]); w1.y = cvt2(o1[2], o1[3]); w1.z = cvt2(o1[4], o1[5]); w1.w = cvt2(o1[6], o1[7]);
        *(v4u*)(ACT + (size_t)(64 * k) * DFF + chg) = w0; *(v4u*)(ACT + (size_t)(64 * k + 1) * DFF + chg) = w1;
    }
}

#ifdef DBG_DUMP
__device__ __forceinline__ void phase_dump(const Ctx& cx, float* out, const bf16* a, int lda, const bf16* b, int ldb, const float* f) {
    const size_t gt = (size_t)cx.bid * 512 + cx.tid, NT = (size_t)cx.G * 512;
    for (size_t i = gt; i < (size_t)S * D; i += NT) { const int row = (int)(i >> 11), col = (int)(i & 2047);
        float v; if (f) v = f[i]; else if (b && col >= 1024) v = bf1(b + (size_t)row * ldb + (col - 1024)); else v = lda ? bf1(a + (size_t)row * lda + col) : bf1(a + (size_t)(row & 2047) * 2048 + col);
        out[i] = v; }
}
#endif
__global__ void __launch_bounds__(512, 2) fwd(Params P) {
    extern __shared__ __attribute__((aligned(16))) unsigned char lds_raw[];
    LAS unsigned char* lds = (LAS unsigned char*)lds_raw;
    const int wave = __builtin_amdgcn_readfirstlane(threadIdx.x >> 6), G = gridDim.x;
    unsigned char* ws = P.ws;
    volatile LAS unsigned* MISC = (volatile LAS unsigned*)(lds + MISC_OFF);
    for (int u = threadIdx.x; u < (LDS_BYTES - LDSCTL_OFF) / 4; u += 512) ((LAS unsigned*)(lds + LDSCTL_OFF))[u] = 0u;
    __syncthreads();
    const int lo = P.ph_lo, hi = P.ph_hi;
    XcdBarrier bar; bar.bar = (unsigned*)(ws + WS_CTL) + CW_BAR; bar.x = 0; bar.st = nullptr;
    if (hi - lo > 1) bar = xcd_barrier_post((unsigned*)(ws + WS_CTL) + CW_BAR, MISC + 8);
#define IN(k) (lo <= (k) && (k) < hi)
#define SEAM(k) do { if (IN(k) && IN((k) + 1)) xcd_barrier(bar); } while (0)
#define OPQ() Ctx cx; cx.lane = lane_id_asm(); { int t_ = wave; asm volatile("" : "+s"(t_)); cx.wave = t_; } { int t_ = G; asm volatile("" : "+s"(t_)); cx.G = t_; } { int t_ = blockIdx.x; asm volatile("" : "+s"(t_)); cx.bid = t_; } \
    { unsigned t_ = 0u; asm volatile("" : "+s"(t_)); cx.ws = P.ws + t_; } cx.tid = cx.wave * 64 + cx.lane; int lq = l; asm volatile("" : "+s"(lq)); (void)lq

#ifdef DBG_DUMP
    if (lo >= 1000) { const int l = 0; OPQ(); unsigned char* w = cx.ws; const int kind = lo - 1000;
        if (kind == 1) phase_dump(cx, P.out, (const bf16*)(w + WS_Q), 1024, (const bf16*)(w + WS_AQ), 1024, nullptr);
        else if (kind == 2) phase_dump(cx, P.out, (const bf16*)(w + WS_MIX), 2048, nullptr, 0, nullptr);
        else if (kind == 3) phase_dump(cx, P.out, nullptr, 0, nullptr, 0, (const float*)(w + WS_XR));
        else if (kind == 4) phase_dump(cx, P.out, (const bf16*)(w + WS_ACT), DFF, nullptr, 0, nullptr);
        else if (kind == 5) phase_dump(cx, P.out, nullptr, 0, nullptr, 0, (const float*)(w + WS_Y));
        else if (kind == 6) phase_dump(cx, P.out, (const bf16*)(w + WS_K), 1024, (const bf16*)(w + WS_V), 1024, nullptr);
        else if (kind == 7) phase_dump(cx, P.out, (const bf16*)(w + WS_XB), 2048, nullptr, 0, nullptr);
        else if (kind == 11) phase_dump(cx, P.out, (const bf16*)(w + WS_W + WL_G), 0, nullptr, 0, nullptr);
        else if (kind == 12) phase_dump(cx, P.out, (const bf16*)(w + WS_W + WL_OUT), 0, nullptr, 0, nullptr);
        else if (kind == 10) phase_dump(cx, P.out, (const bf16*)(w + WS_H) + 36 * 256, NUP, nullptr, 0, nullptr);
        else if (kind == 9) phase_dump(cx, P.out, (const bf16*)(w + WS_SG), 2048, nullptr, 0, nullptr);
        else if (kind == 8) phase_dump(cx, P.out, nullptr, 0, nullptr, 0, (const float*)(w + WS_RETY));
        return; }
#endif
    if (IN(0)) { const int l = 0; REPS(2) { __syncthreads(); OPQ(); phase_prologue(P, cx, lds); } }
    SEAM(0);

    for (int l = 0; l < DEPTH; ++l) {
        const int pb = 1 + l * NPH;
        if (IN(pb + 0)) { OPQ(); unsigned char* w = cx.ws; const bf16* wl = (const bf16*)(w + WS_W + (size_t)lq * WL_BYTES);
            pg8::Gemm g{(const bf16*)(w + WS_XB), wl + WL_IN / 2, S, INW, D}; pg8::StaticOrder So; So.init(S, INW, cx.G, cx.bid);
            pg8::EpiInProj E{(bf16*)(w + WS_Q), (bf16*)(w + WS_K), (bf16*)(w + WS_V), (bf16*)(w + WS_G), (bf16*)(w + WS_AQ), (bf16*)(w + WS_AK), (bf16*)(w + WS_AV),
                             (const float*)(w + WS_COSR), (const float*)(w + WS_SINR), (const float*)(w + WS_COSA), (const float*)(w + WS_SINA)};
            pg8::gemm_phase<pg8::EpiInProj, pg8::StaticOrder, true, true>(lds, g, So, E, cx.wave);
        }
#if PLE_EARLY
        if (IN(pb + 0)) { OPQ(); unsigned char* w = cx.ws; const bf16* wl = (const bf16*)(w + WS_W + (size_t)lq * WL_BYTES);
            const int nsub = (cx.G > 64) ? cx.G - 64 : cx.G, csub = (cx.G > 64) ? cx.bid - 64 : cx.bid;
            if (csub >= 0) {
                int kple = PLE; asm volatile("" : "+s"(kple));
                pg8::Gemm g{(const bf16*)(w + WS_PB) + (size_t)lq * S * PLE, wl + WL_P / 2, S, D, kple}; pg8::StaticOrder So; So.init(S, D, nsub, csub);
                pg8::EpiPlain E{(bf16*)(w + WS_PP)};
                pg8::gemm_phase<pg8::EpiPlain, pg8::StaticOrder, true, true>(lds, g, So, E, cx.wave); }
        }
#endif
        SEAM(pb + 0);
        if (IN(pb + 1)) {
#if RET_MFMA
            { REPS(2) { OPQ(); phase_ret_u_mfma(P, cx, lds); } }
#else
            { OPQ(); phase_ret_u_scores(P, cx, lds); }
#endif
#if SWA_MFMA
            { REPS(2) { OPQ(); phase_swa_mfma(P, cx, lq, lds); } }
#else
            { OPQ(); phase_swa(P, cx, lq, lds); }
#endif
        }
        SEAM(pb + 1);
#if RET_MFMA
        if (IN(pb + 2)) { OPQ(); phase_scan_bf16(P, cx); }
        SEAM(pb + 2);
        if (IN(pb + 3)) { REPS(2) { OPQ(); phase_ret_out_mfma(P, cx, lq, lds); } }
        SEAM(pb + 3);
#else
        if (IN(pb + 2)) { OPQ(); phase_scan(P, cx); }
        SEAM(pb + 2);
        if (IN(pb + 3)) { OPQ(); phase_ret_out(P, cx, lds); }
        SEAM(pb + 3);
        if (IN(pb + 4)) { OPQ(); phase_groupnorm(P, cx, lq); }
        SEAM(pb + 4);
#endif
        if (IN(pb + 5)) { OPQ(); unsigned char* w = cx.ws; const bf16* wl = (const bf16*)(w + WS_W + (size_t)lq * WL_BYTES);
            pg8::Gemm g{(const bf16*)(w + WS_MIX), wl + WL_OUT / 2, S, D, D}; pg8::StaticOrder So; So.init(S, D, cx.G, cx.bid);
#if LN_NOXR
            if (lq == 0) { pg8::EpiResid<false> E{P.in[0], (float*)(w + WS_Y), ALPHA};
                pg8::gemm_phase<pg8::EpiResid<false>, pg8::StaticOrder, true, true>(lds, g, So, E, cx.wave); }
            else { pg8::EpiResidLN<false> E{(float*)(w + WS_Y), (const float*)(w + WS_ST2), P.in[14] + (lq - 1) * D, P.in[15] + (lq - 1) * D, nullptr, nullptr, ALPHA};
                pg8::gemm_phase<pg8::EpiResidLN<false>, pg8::StaticOrder, true, true>(lds, g, So, E, cx.wave); }
#else
            pg8::EpiResid<false> E{(lq == 0) ? P.in[0] : (const float*)(w + WS_XR), (float*)(w + WS_Y), ALPHA};
            pg8::gemm_phase<pg8::EpiResid<false>, pg8::StaticOrder, true, true>(lds, g, So, E, cx.wave);
#endif
        }
        SEAM(pb + 5);
        if (IN(pb + 6)) { REPS(1) { OPQ(); unsigned char* w = cx.ws;
#if LN_NOXR
            phase_ln(cx, (const float*)(w + WS_Y), P.in[8] + lq * D, P.in[9] + lq * D, (float*)nullptr, (bf16*)(w + WS_XB), (float*)(w + WS_ST1));
#else
            phase_ln(cx, (const float*)(w + WS_Y), P.in[8] + lq * D, P.in[9] + lq * D, (float*)(w + WS_XR), (bf16*)(w + WS_XB), (float*)nullptr);
#endif
        } }
        SEAM(pb + 6);
        if (IN(pb + 7)) { OPQ(); unsigned char* w = cx.ws; const bf16* wl = (const bf16*)(w + WS_W + (size_t)lq * WL_BYTES);
            pg8::Gemm g{(const bf16*)(w + WS_XB), wl + WL_UP / 2, S, NUPG, D}; pg8::StaticOrder So; So.init(S, NUPG, cx.G, cx.bid);
#if CONV_FUSED
            pg8::EpiUpConv E{(bf16*)(w + WS_ACT), (bf16*)(w + WS_H), (bf16*)(w + WS_SG), P.in[17] + lq * D, P.in[11] + (size_t)lq * 3 * NUP, P.in[12] + (size_t)lq * NUP};
            pg8::gemm_phase<pg8::EpiUpConv, pg8::StaticOrder, true, true>(lds, g, So, E, cx.wave);
#else
            pg8::EpiUp E{(bf16*)(w + WS_H), (bf16*)(w + WS_SG), P.in[17] + lq * D};
            pg8::gemm_phase<pg8::EpiUp, pg8::StaticOrder, true, true>(lds, g, So, E, cx.wave);
#endif
        }
        SEAM(pb + 7);
        if (IN(pb + 8)) {
#if !PLE_EARLY
            { OPQ(); unsigned char* w = cx.ws; const bf16* wl = (const bf16*)(w + WS_W + (size_t)lq * WL_BYTES);
              pg8::Gemm g{(const bf16*)(w + WS_PB) + (size_t)lq * S * PLE, wl + WL_P / 2, S, D, PLE}; pg8::StaticOrder So; So.init(S, D, cx.G, cx.bid);
              pg8::EpiPle E{(const bf16*)(w + WS_SG), (float*)(w + WS_Y)};
              pg8::gemm_phase<pg8::EpiPle, pg8::StaticOrder, true, true>(lds, g, So, E, cx.wave); }
#endif
#if CONV_FUSED
            { OPQ(); phase_conv_fixup(P, cx, lq); }
#else
            { REPS(1) { OPQ(); phase_convact(P, cx, lq); } }
#endif
        }
        SEAM(pb + 8);
        if (IN(pb + 9)) { OPQ(); unsigned char* w = cx.ws; const bf16* wl = (const bf16*)(w + WS_W + (size_t)lq * WL_BYTES);
            pg8::Gemm g{(const bf16*)(w + WS_ACT), wl + WL_DOWN / 2, S, D, DFF}; pg8::StaticOrder So; So.init(S, D, cx.G, cx.bid);
#if PLE_EARLY
#if LN_NOXR
            pg8::EpiResidLN<true> E{(float*)(w + WS_Y), (const float*)(w + WS_ST1), P.in[8] + lq * D, P.in[9] + lq * D, (const bf16*)(w + WS_PP), (const bf16*)(w + WS_SG), ALPHA};
            pg8::gemm_phase<pg8::EpiResidLN<true>, pg8::StaticOrder, true, true>(lds, g, So, E, cx.wave);
#else
            pg8::EpiDown E{(const float*)(w + WS_XR), (float*)(w + WS_Y), (const bf16*)(w + WS_PP), (const bf16*)(w + WS_SG), ALPHA};
            pg8::gemm_phase<pg8::EpiDown, pg8::StaticOrder, true, true>(lds, g, So, E, cx.wave);
#endif
#else
            pg8::EpiResid<true> E{(const float*)(w + WS_XR), (float*)(w + WS_Y), ALPHA};
            pg8::gemm_phase<pg8::EpiResid<true>, pg8::StaticOrder, true, true>(lds, g, So, E, cx.wave);
#endif
        }
        SEAM(pb + 9);
        if (IN(pb + 10)) { REPS(1) { OPQ(); unsigned char* w = cx.ws; const bool last = (lq == DEPTH - 1);

#if LN_NOXR
            phase_ln(cx, (const float*)(w + WS_Y), P.in[14] + lq * D, P.in[15] + lq * D, last ? P.out : (float*)nullptr, last ? (bf16*)nullptr : (bf16*)(w + WS_XB), last ? (float*)nullptr : (float*)(w + WS_ST2));
#else
            phase_ln(cx, (const float*)(w + WS_Y), P.in[14] + lq * D, P.in[15] + lq * D, last ? P.out : (float*)(w + WS_XR), last ? (bf16*)nullptr : (bf16*)(w + WS_XB), (float*)nullptr);
#endif
        } }
        SEAM(pb + 10);
    }
#undef IN
#undef SEAM
}

extern "C" void kernel_launch(void* const* d_in, const int* in_sizes, int n_in, void* d_out, int out_size, void* d_ws, size_t ws_size, hipStream_t stream) {
    static int grid = 0;
    if (grid == 0) {
        if (n_in != 19 || in_sizes[0] != S * D || out_size != S * D || ws_size < WS_END) { fprintf(stderr, "kernel_launch: unexpected shapes (n_in %d, in0 %d, out %d, ws %zu)\n", n_in, n_in > 0 ? in_sizes[0] : -1, out_size, ws_size); grid = -1; return; }
        int dev = 0, cus = 0, per_cu = 0;
        if (hipGetDevice(&dev) != hipSuccess || hipDeviceGetAttribute(&cus, hipDeviceAttributeMultiprocessorCount, dev) != hipSuccess) { grid = -1; return; }
        if (hipFuncSetAttribute((const void*)fwd, hipFuncAttributeMaxDynamicSharedMemorySize, LDS_BYTES) != hipSuccess) { fprintf(stderr, "kernel_launch: hipFuncSetAttribute failed\n"); grid = -1; return; }
        if (hipOccupancyMaxActiveBlocksPerMultiprocessor(&per_cu, (const void*)fwd, 512, LDS_BYTES) != hipSuccess || per_cu < 1) fprintf(stderr, "kernel_launch: occupancy query says %d\n", per_cu);
        (void)hipGetLastError();
        grid = cus;
    }
    if (grid < 0) return;
    (void)hipMemsetAsync((char*)d_ws + WS_CTL, 0, CTL_ZERO_BYTES, stream);
#ifdef DBG_NANFILL
    (void)hipMemsetAsync((char*)d_ws + CTL_ZERO_BYTES, 0xFF, WS_END - CTL_ZERO_BYTES, stream);
#endif
    Params p{};
    for (int i = 0; i < 19; ++i) p.in[i] = (const float*)d_in[i];
    p.out = (float*)d_out; p.ws = (unsigned char*)d_ws;
    for (int f = 0; f < 128; ++f) p.invf_ret[f] = (float)(1.0 / std::pow(10000.0, (double)((float)f / 127.0f)));
    for (int f = 0; f < 32; ++f) p.invf_att[f] = (float)std::pow(10000.0, -(double)(2 * f) / 64.0);
    for (int h = 0; h < 4; ++h) p.lg2g[h] = (float)std::log2(1.0 - std::exp2(-5.0 - h));
#if MK_ONE_LAUNCH
    p.ph_lo = 0; p.ph_hi = NPHASES;
    hipLaunchKernelGGL(fwd, dim3(grid), dim3(512), LDS_BYTES, stream, p);
#else
#ifdef DBG_DUMP
    for (int ph = 0; ph <= DBG_STOP; ++ph) { p.ph_lo = ph; p.ph_hi = ph + 1; hipLaunchKernelGGL(fwd, dim3(grid), dim3(512), LDS_BYTES, stream, p); }
    p.ph_lo = 1000 + DBG_DUMP; p.ph_hi = p.ph_lo + 1; hipLaunchKernelGGL(fwd, dim3(grid), dim3(512), LDS_BYTES, stream, p);
#else
    for (int ph = 0; ph < NPHASES; ++ph) { p.ph_lo = ph; p.ph_hi = ph + 1; hipLaunchKernelGGL(fwd, dim3(grid), dim3(512), LDS_BYTES, stream, p); }
#endif
#endif
}
```

```cpp
#include <hip/hip_runtime.h>
#include <cstdio>
#include <cstdint>
#include <cmath>
#define MK_ONE_LAUNCH 1
namespace pg8 {
#define PG8_LAS __attribute__((address_space(3)))
typedef unsigned short bf16_t;
typedef short bf16x8 __attribute__((ext_vector_type(8)));
typedef float f32x4 __attribute__((ext_vector_type(4)));
typedef unsigned u32x4 __attribute__((ext_vector_type(4)));
constexpr int BM = 256, BK = 64, HALF = 128, HTB = HALF * BK * 2  , STAGE_BYTES = 8 * HTB, NXCD = 8, WGM = 8;

__host__ __device__ __forceinline__ int lds_byte(int r, int c) { const int st = (r >> 4) * 2 + (c >> 5), rr = r & 15, cc = c & 31, ob = rr * 64 + cc * 2; return st * 1024 + (ob ^ (((ob >> 9) & 1) << 5)); }
__host__ __device__ __forceinline__ void stage_rc(int b, int& R, int& C) { const int st = b / 1024, sb = b % 1024, swz = sb ^ (((sb >> 9) & 1) << 5); R = (st >> 1) * 16 + swz / 64; C = (st & 1) * 32 + (swz % 64) / 2; }
__host__ __device__ __forceinline__ int perm32(int rho) { const int n = rho >> 4, i = rho & 15; return 8 * (i >> 2) + 4 * n + (i & 3); }

struct Unit { int pm, pn; };
struct Gemm { const bf16_t* A; const bf16_t* Bt; int M, N, K; };

struct StaticOrder {
    int nM, nN, nwg, G, c;
    __host__ __device__ void init(int M, int N, int G_, int c_) { nM = M / BM; nN = N / BM; nwg = nM * nN; G = G_; c = c_; }
    __host__ __device__ bool next(int i, Unit& u) const {
        const long L = (long)i * G + c; if (L >= nwg) return false;
        int wgid = (int)L; { const int q = nwg / NXCD, r = nwg % NXCD, xcd = wgid % NXCD, off = wgid / NXCD; wgid = (xcd < r ? xcd * (q + 1) : r * (q + 1) + (xcd - r) * q) + off; }
        const int nig = WGM * nN, gid = wgid / nig, fm = gid * WGM, gsz = (nM - fm) < WGM ? (nM - fm) : WGM;
        u.pm = fm + ((wgid % nig) % gsz); u.pn = (wgid % nig) / gsz; return true;
    }
    __device__ __forceinline__ void a_ready(const Unit&) const {}
    __device__ __forceinline__ void done(const Unit&) const {}
};

typedef float f32x2c_t __attribute__((ext_vector_type(2))); typedef __bf16 bf16x2c_t __attribute__((ext_vector_type(2)));
__device__ __forceinline__ unsigned cvt_pk_bf16(float lo, float hi) { f32x2c_t v = {lo, hi}; bf16x2c_t b = __builtin_convertvector(v, bf16x2c_t); return __builtin_bit_cast(unsigned, b); }
typedef float f32x2 __attribute__((ext_vector_type(2)));
typedef unsigned u32x2 __attribute__((ext_vector_type(2)));
__device__ __forceinline__ float bf2f(unsigned short b) { return __uint_as_float(((unsigned)b) << 16); }
__device__ __forceinline__ u32x4 pack8(const f32x4 a, const f32x4 b) { u32x4 w; w.x = cvt_pk_bf16(a[0], a[1]); w.y = cvt_pk_bf16(a[2], a[3]); w.z = cvt_pk_bf16(b[0], b[1]); w.w = cvt_pk_bf16(b[2], b[3]); return w; }
__device__ __forceinline__ float sigmoidf_(float x) { return __builtin_amdgcn_rcpf(1.0f + __expf(-x)); }

struct EpiInProj {
    static constexpr bool PERM = true, AFTER_DRAIN = false;
    bf16_t *Q, *K, *V, *G, *AQ, *AK, *AV; const float *cosr, *sinr, *cosa, *sina;
    __device__ __forceinline__ void operator()(const f32x4 (&acc)[2][2][4][2], const Unit& u, int wr, int wc, int fr, int fq) const {
        const int row0 = u.pm * BM + wr * 64 + fr, pn = u.pn, cw = wc * 32 + 8 * fq;
        if (pn < 8) {
            bf16_t* O = pn < 4 ? Q : K; const int hcol = (pn & 3) * 256; const float sc = pn < 4 ? 1.0f : 0.0625f;
#pragma unroll
            for (int ai = 0; ai < 2; ++ai)
#pragma unroll
                for (int m = 0; m < 4; ++m) { const int row = row0 + ai * HALF + m * 16;
                    const f32x4 c0 = *(const f32x4*)(cosr + (size_t)row * 128 + cw), c1 = *(const f32x4*)(cosr + (size_t)row * 128 + cw + 4);
                    const f32x4 s0 = *(const f32x4*)(sinr + (size_t)row * 128 + cw), s1 = *(const f32x4*)(sinr + (size_t)row * 128 + cw + 4);
                    const f32x4 a0 = acc[ai][0][m][0], a1 = acc[ai][0][m][1], b0 = acc[ai][1][m][0], b1 = acc[ai][1][m][1];
                    const f32x4 o10 = (a0 * c0 - b0 * s0) * sc, o11 = (a1 * c1 - b1 * s1) * sc, o20 = (a0 * s0 + b0 * c0) * sc, o21 = (a1 * s1 + b1 * c1) * sc;
                    bf16_t* rowp = O + (size_t)row * 1024 + hcol + cw;
                    *(u32x4*)(rowp) = pack8(o10, o11); *(u32x4*)(rowp + HALF) = pack8(o20, o21); }
        } else if (pn < 16) {
            const bool gate = pn >= 12; bf16_t* O = gate ? G : V; const int hcol = (pn & 3) * 256;
#pragma unroll
            for (int ai = 0; ai < 2; ++ai)
#pragma unroll
                for (int m = 0; m < 4; ++m) { const int row = row0 + ai * HALF + m * 16; bf16_t* rowp = O + (size_t)row * 1024 + hcol + cw;
#pragma unroll
                    for (int bj = 0; bj < 2; ++bj) { f32x4 v0 = acc[ai][bj][m][0], v1 = acc[ai][bj][m][1];
                        if (gate) {
#pragma unroll
                            for (int j = 0; j < 4; ++j) { v0[j] = v0[j] * sigmoidf_(v0[j]); v1[j] = v1[j] * sigmoidf_(v1[j]); } }
                        *(u32x4*)(rowp + bj * HALF) = pack8(v0, v1); } }
        } else if (pn < 20) {
            const int t = pn - 16, i0 = 8 * fq;
#pragma unroll
            for (int ai = 0; ai < 2; ++ai)
#pragma unroll
                for (int m = 0; m < 4; ++m) { const int row = row0 + ai * HALF + m * 16;
                    const f32x4 c0 = *(const f32x4*)(cosa + (size_t)row * 32 + i0), c1 = *(const f32x4*)(cosa + (size_t)row * 32 + i0 + 4);
                    const f32x4 s0 = *(const f32x4*)(sina + (size_t)row * 32 + i0), s1 = *(const f32x4*)(sina + (size_t)row * 32 + i0 + 4);
                    const f32x4 a0 = acc[ai][0][m][0], a1 = acc[ai][0][m][1], b0 = acc[ai][1][m][0], b1 = acc[ai][1][m][1];
                    const f32x4 o10 = (a0 * c0 - b0 * s0) * 0.125f, o11 = (a1 * c1 - b1 * s1) * 0.125f, o20 = (a0 * s0 + b0 * c0) * 0.125f, o21 = (a1 * s1 + b1 * c1) * 0.125f;
                    bf16_t* rowp = AQ + (size_t)row * 1024 + t * 256 + wc * 64 + i0;
                    *(u32x4*)(rowp) = pack8(o10, o11); *(u32x4*)(rowp + 32) = pack8(o20, o21); }
        } else {
            const int i0 = 8 * fq;
            if (wc < 2) {
#pragma unroll
                for (int ai = 0; ai < 2; ++ai)
#pragma unroll
                    for (int m = 0; m < 4; ++m) { const int row = row0 + ai * HALF + m * 16;
                        const f32x4 c0 = *(const f32x4*)(cosa + (size_t)row * 32 + i0), c1 = *(const f32x4*)(cosa + (size_t)row * 32 + i0 + 4);
                        const f32x4 s0 = *(const f32x4*)(sina + (size_t)row * 32 + i0), s1 = *(const f32x4*)(sina + (size_t)row * 32 + i0 + 4);
                        const f32x4 a0 = acc[ai][0][m][0], a1 = acc[ai][0][m][1], b0 = acc[ai][1][m][0], b1 = acc[ai][1][m][1];
                        const f32x4 o10 = a0 * c0 - b0 * s0, o11 = a1 * c1 - b1 * s1, o20 = a0 * s0 + b0 * c0, o21 = a1 * s1 + b1 * c1;
                        bf16_t* rowp = AK + (size_t)row * 128 + wc * 64 + i0;
                        *(u32x4*)(rowp) = pack8(o10, o11); *(u32x4*)(rowp + 32) = pack8(o20, o21); }
            } else {
#pragma unroll
                for (int ai = 0; ai < 2; ++ai)
#pragma unroll
                    for (int m = 0; m < 4; ++m) { const int row = row0 + ai * HALF + m * 16; bf16_t* rowp = AV + (size_t)row * 128 + (wc - 2) * 32 + i0;
                        *(u32x4*)(rowp) = pack8(acc[ai][0][m][0], acc[ai][0][m][1]); *(u32x4*)(rowp + 64) = pack8(acc[ai][1][m][0], acc[ai][1][m][1]); }
            }
        }
    }
};
template <bool ADD> struct EpiResid {
    static constexpr bool PERM = false, AFTER_DRAIN = false;
    const float* base; float* Y; float alpha;
    __device__ __forceinline__ void operator()(const f32x4 (&acc)[2][2][4][2], const Unit& u, int wr, int wc, int fr, int fq) const {
        const int row0 = u.pm * BM + wr * 64 + fr, col0 = u.pn * BM + wc * 32 + 4 * fq;
#pragma unroll
        for (int ai = 0; ai < 2; ++ai)
#pragma unroll
            for (int m = 0; m < 4; ++m) { const size_t off = (size_t)(row0 + ai * HALF + m * 16) * 2048 + col0;
#pragma unroll
                for (int bj = 0; bj < 2; ++bj)
#pragma unroll
                    for (int n = 0; n < 2; ++n) { const size_t o = off + bj * HALF + n * 16; f32x4 v = acc[ai][bj][m][n] + *(const f32x4*)(base + o) * alpha;
                        if (ADD) v = v + *(const f32x4*)(Y + o); *(f32x4*)(Y + o) = v; } }
    }
};
struct EpiUp {
    static constexpr bool PERM = true, AFTER_DRAIN = false;
    bf16_t* H; bf16_t* SG; const float* bgate;
    __device__ __forceinline__ void operator()(const f32x4 (&acc)[2][2][4][2], const Unit& u, int wr, int wc, int fr, int fq) const {
        const int row0 = u.pm * BM + wr * 64 + fr, cw = wc * 32 + 8 * fq;
        if (u.pn < 44) {
#pragma unroll
            for (int ai = 0; ai < 2; ++ai)
#pragma unroll
                for (int m = 0; m < 4; ++m) { bf16_t* rowp = H + (size_t)(row0 + ai * HALF + m * 16) * 11264 + u.pn * 256 + cw;
#pragma unroll
                    for (int bj = 0; bj < 2; ++bj) *(u32x4*)(rowp + bj * HALF) = pack8(acc[ai][bj][m][0], acc[ai][bj][m][1]); }
        } else {
            const int colg = (u.pn - 44) * 256 + cw;
            f32x4 bv[2][2];
#pragma unroll
            for (int bj = 0; bj < 2; ++bj)
#pragma unroll
                for (int n = 0; n < 2; ++n) bv[bj][n] = *(const f32x4*)(bgate + colg + bj * HALF + 4 * n);
#pragma unroll
            for (int ai = 0; ai < 2; ++ai)
#pragma unroll
                for (int m = 0; m < 4; ++m) { bf16_t* rowp = SG + (size_t)(row0 + ai * HALF + m * 16) * 2048 + colg;
#pragma unroll
                    for (int bj = 0; bj < 2; ++bj) { f32x4 v0 = acc[ai][bj][m][0] + bv[bj][0], v1 = acc[ai][bj][m][1] + bv[bj][1];
#pragma unroll
                        for (int j = 0; j < 4; ++j) { v0[j] = sigmoidf_(v0[j]); v1[j] = sigmoidf_(v1[j]); }
                        *(u32x4*)(rowp + bj * HALF) = pack8(v0, v1); } }
        }
    }
};

__device__ __forceinline__ float ror1f(float x) { return __builtin_bit_cast(float, __builtin_amdgcn_update_dpp(0, __builtin_bit_cast(int, x), 0x121, 0xf, 0xf, false)); }
__device__ __forceinline__ float ror2f(float x) { return __builtin_bit_cast(float, __builtin_amdgcn_update_dpp(0, __builtin_bit_cast(int, x), 0x122, 0xf, 0xf, false)); }
struct EpiUpConv {
    static constexpr bool PERM = true, AFTER_DRAIN = false;
    bf16_t* ACT; bf16_t* HALO; bf16_t* SG; const float* bgate; const float* cw; const float* cb;
    __device__ __forceinline__ void operator()(const f32x4 (&acc)[2][2][4][2], const Unit& u, int wr, int wc, int fr, int fq) const {
        const int row0 = u.pm * BM + wr * 64 + fr, cwp = wc * 32 + 8 * fq;
        if (u.pn < 44) {
#pragma unroll
            for (int n = 0; n < 2; ++n) {
                const int chg = 128 * u.pn + cwp + 4 * n, chu = 5632 + chg;
                const f32x4 wg0 = *(const f32x4*)(cw + chg), wg1 = *(const f32x4*)(cw + 11264 + chg), wg2 = *(const f32x4*)(cw + 2 * 11264 + chg), bg = *(const f32x4*)(cb + chg);
                const f32x4 wu0 = *(const f32x4*)(cw + chu), wu1 = *(const f32x4*)(cw + 11264 + chu), wu2 = *(const f32x4*)(cw + 2 * 11264 + chu), bu = *(const f32x4*)(cb + chu);
#pragma unroll
                for (int ai = 0; ai < 2; ++ai) {
                    const int span = u.pm * 4 + ai * 2 + wr;
#pragma unroll
                    for (int m = 0; m < 4; ++m) {
                        const f32x4 cg = acc[ai][0][m][n], cu = acc[ai][1][m][n];
                        const f32x4 pg = acc[ai][0][m ? m - 1 : 0][n], pu = acc[ai][1][m ? m - 1 : 0][n];
                        f32x4 o;
#pragma unroll
                        for (int j = 0; j < 4; ++j) {
                            const float g1 = ror1f(fr == 15 ? pg[j] : cg[j]), g2 = ror2f(fr >= 14 ? pg[j] : cg[j]);
                            const float u1 = ror1f(fr == 15 ? pu[j] : cu[j]), u2 = ror2f(fr >= 14 ? pu[j] : cu[j]);
                            const float ga = bg[j] + wg0[j] * g2 + wg1[j] * g1 + wg2[j] * cg[j], ua = bu[j] + wu0[j] * u2 + wu1[j] * u1 + wu2[j] * cu[j];
                            o[j] = ga * sigmoidf_(ga) * ua; }
                        const int row = row0 + ai * HALF + m * 16;
                        u32x2 w; w.x = cvt_pk_bf16(o[0], o[1]); w.y = cvt_pk_bf16(o[2], o[3]);
                        if (m > 0 || fr >= 2) *(u32x2*)(ACT + (size_t)row * 5632 + 128 * u.pn + cwp + 4 * n) = w;
                        if ((m == 0 && fr < 2) || (m == 3 && fr >= 14)) { const int slot = (m == 0) ? fr : fr - 12;
                            bf16_t* hp = HALO + ((size_t)(span * 4 + slot)) * 11264 + 256 * u.pn + cwp + 4 * n;
                            u32x2 rg, ru; rg.x = cvt_pk_bf16(cg[0], cg[1]); rg.y = cvt_pk_bf16(cg[2], cg[3]); ru.x = cvt_pk_bf16(cu[0], cu[1]); ru.y = cvt_pk_bf16(cu[2], cu[3]);
                            *(u32x2*)(hp) = rg; *(u32x2*)(hp + HALF) = ru; }
                    }
                }
            }
        } else {
            const int colg = (u.pn - 44) * 256 + cwp;
            f32x4 bv[2][2];
#pragma unroll
            for (int bj = 0; bj < 2; ++bj)
#pragma unroll
                for (int n = 0; n < 2; ++n) bv[bj][n] = *(const f32x4*)(bgate + colg + bj * HALF + 4 * n);
#pragma unroll
            for (int ai = 0; ai < 2; ++ai)
#pragma unroll
                for (int m = 0; m < 4; ++m) { bf16_t* rowp = SG + (size_t)(row0 + ai * HALF + m * 16) * 2048 + colg;
#pragma unroll
                    for (int bj = 0; bj < 2; ++bj) { f32x4 v0 = acc[ai][bj][m][0] + bv[bj][0], v1 = acc[ai][bj][m][1] + bv[bj][1];
#pragma unroll
                        for (int j = 0; j < 4; ++j) { v0[j] = sigmoidf_(v0[j]); v1[j] = sigmoidf_(v1[j]); }
                        *(u32x4*)(rowp + bj * HALF) = pack8(v0, v1); } }
        }
    }
};

struct EpiPlain {
    static constexpr bool PERM = true, AFTER_DRAIN = false;
    bf16_t* O;
    __device__ __forceinline__ void operator()(const f32x4 (&acc)[2][2][4][2], const Unit& u, int wr, int wc, int fr, int fq) const {
        const int row0 = u.pm * BM + wr * 64 + fr, cwp = u.pn * BM + wc * 32 + 8 * fq;
#pragma unroll
        for (int ai = 0; ai < 2; ++ai)
#pragma unroll
            for (int m = 0; m < 4; ++m) { bf16_t* rowp = O + (size_t)(row0 + ai * HALF + m * 16) * 2048 + cwp;
#pragma unroll
                for (int bj = 0; bj < 2; ++bj) *(u32x4*)(rowp + bj * HALF) = pack8(acc[ai][bj][m][0], acc[ai][bj][m][1]); }
    }
};
struct EpiDown {
    static constexpr bool PERM = false, AFTER_DRAIN = false;
    const float* base; float* Y; const bf16_t* PP; const bf16_t* SG; float alpha;
    __device__ __forceinline__ void operator()(const f32x4 (&acc)[2][2][4][2], const Unit& u, int wr, int wc, int fr, int fq) const {
        const int row0 = u.pm * BM + wr * 64 + fr, col0 = u.pn * BM + wc * 32 + 4 * fq;
#pragma unroll
        for (int ai = 0; ai < 2; ++ai)
#pragma unroll
            for (int m = 0; m < 4; ++m) { const size_t off = (size_t)(row0 + ai * HALF + m * 16) * 2048 + col0;
#pragma unroll
                for (int bj = 0; bj < 2; ++bj)
#pragma unroll
                    for (int n = 0; n < 2; ++n) { const size_t o = off + bj * HALF + n * 16; const u32x2 pp = *(const u32x2*)(PP + o), sg = *(const u32x2*)(SG + o);
                        f32x4 pl; pl[0] = __uint_as_float(pp.x << 16) * __uint_as_float(sg.x << 16); pl[1] = __uint_as_float(pp.x & 0xffff0000u) * __uint_as_float(sg.x & 0xffff0000u);
                        pl[2] = __uint_as_float(pp.y << 16) * __uint_as_float(sg.y << 16); pl[3] = __uint_as_float(pp.y & 0xffff0000u) * __uint_as_float(sg.y & 0xffff0000u);
                        *(f32x4*)(Y + o) = acc[ai][bj][m][n] + *(const f32x4*)(base + o) * alpha + pl; } }
    }
};

template <bool PLE_> struct EpiResidLN {
    static constexpr bool PERM = false, AFTER_DRAIN = false;
    float* Y; const float* stats; const float* g; const float* b; const bf16_t* PP; const bf16_t* SG; float alpha;
    __device__ __forceinline__ void operator()(const f32x4 (&acc)[2][2][4][2], const Unit& u, int wr, int wc, int fr, int fq) const {
        const int row0 = u.pm * BM + wr * 64 + fr, col0 = u.pn * BM + wc * 32 + 4 * fq;
        f32x4 g4[2][2], b4[2][2];
#pragma unroll
        for (int bj = 0; bj < 2; ++bj)
#pragma unroll
            for (int n = 0; n < 2; ++n) { g4[bj][n] = *(const f32x4*)(g + col0 + bj * HALF + n * 16) * alpha; b4[bj][n] = *(const f32x4*)(b + col0 + bj * HALF + n * 16) * alpha; }
#pragma unroll
        for (int ai = 0; ai < 2; ++ai)
#pragma unroll
            for (int m = 0; m < 4; ++m) { const int row = row0 + ai * HALF + m * 16; const size_t off = (size_t)row * 2048 + col0;
                const f32x2 st = *(const f32x2*)(stats + 2 * (size_t)row);
#pragma unroll
                for (int bj = 0; bj < 2; ++bj)
#pragma unroll
                    for (int n = 0; n < 2; ++n) { const size_t o = off + bj * HALF + n * 16;
                        f32x4 v = acc[ai][bj][m][n] + (*(const f32x4*)(Y + o) - st.x) * st.y * g4[bj][n] + b4[bj][n];
                        if (PLE_) { const u32x2 pp = *(const u32x2*)(PP + o), sg = *(const u32x2*)(SG + o);
                            v[0] += __uint_as_float(pp.x << 16) * __uint_as_float(sg.x << 16); v[1] += __uint_as_float(pp.x & 0xffff0000u) * __uint_as_float(sg.x & 0xffff0000u);
                            v[2] += __uint_as_float(pp.y << 16) * __uint_as_float(sg.y << 16); v[3] += __uint_as_float(pp.y & 0xffff0000u) * __uint_as_float(sg.y & 0xffff0000u); }
                        *(f32x4*)(Y + o) = v; } }
    }
};
struct EpiPle {
    static constexpr bool PERM = false, AFTER_DRAIN = false;
    const bf16_t* SG; float* Y;
    __device__ __forceinline__ void operator()(const f32x4 (&acc)[2][2][4][2], const Unit& u, int wr, int wc, int fr, int fq) const {
        const int row0 = u.pm * BM + wr * 64 + fr, col0 = u.pn * BM + wc * 32 + 4 * fq;
#pragma unroll
        for (int ai = 0; ai < 2; ++ai)
#pragma unroll
            for (int m = 0; m < 4; ++m) { const size_t off = (size_t)(row0 + ai * HALF + m * 16) * 2048 + col0;
#pragma unroll
                for (int bj = 0; bj < 2; ++bj)
#pragma unroll
                    for (int n = 0; n < 2; ++n) { const size_t o = off + bj * HALF + n * 16; const u32x2 sg = *(const u32x2*)(SG + o);
                        f32x4 g; g[0] = __uint_as_float(sg.x << 16); g[1] = __uint_as_float(sg.x & 0xffff0000u); g[2] = __uint_as_float(sg.y << 16); g[3] = __uint_as_float(sg.y & 0xffff0000u);
                        *(f32x4*)(Y + o) = acc[ai][bj][m][n] * g; } }
    }
};
template <class Epi, class Sched, bool ALIGN_EPI = false, bool SP2 = false>
__device__ __forceinline__ void gemm_phase(PG8_LAS unsigned char* lds, const Gemm g, const Sched& S, const Epi& E, const int wid_in) {
    int lane_; asm volatile("v_mbcnt_lo_u32_b32 %0, -1, 0\n\tv_mbcnt_hi_u32_b32 %0, -1, %0" : "=v"(lane_)); const int wid = wid_in, lane = lane_, tid = wid * 64 + lane, wr = wid >> 2, wc = wid & 3, fr = lane & 15, fq = lane >> 4;
    const int K = g.K, nt = K / BK;
    unsigned voffA[2], voffB[2];
#pragma unroll
    for (int i = 0; i < 2; ++i) { int R, C; stage_rc(tid * 16 + i * 8192, R, C); const int Rb = Epi::PERM ? ((R & ~31) + perm32(R & 31)) : R;
        voffA[i] = (unsigned)(R * K + C) * 2u; voffB[i] = (unsigned)(Rb * K + C) * 2u; }
    const size_t kstep = (size_t)(BK * 2);
    const size_t hstep = (size_t)HALF * K * 2;
    const size_t tstep = 2 * hstep;
    const unsigned ldsw = (unsigned)wid * 1024u;
    const int aoff = lds_byte(wr * 64 + fr, fq * 8), boff = lds_byte(wc * 32 + fr, fq * 8);
#define PG8_SA(b, h) (((b) * 2 + (h)) * HTB)
#define PG8_SB(b, h) ((4 + (b) * 2 + (h)) * HTB)
#define PG8_STAGE(bufoff, gbase, voff) do { _Pragma("unroll") for (int _i = 0; _i < 2; ++_i) \
        __builtin_amdgcn_global_load_lds((const unsigned*)((const char*)(gbase) + (voff)[_i]), (PG8_LAS unsigned*)(lds + (bufoff) + ldsw + _i * 8192), 16, 0, 0); } while (0)
#define PG8_LDA(dst, b, h) do { _Pragma("unroll") for (int m = 0; m < 4; ++m) _Pragma("unroll") for (int k = 0; k < 2; ++k) dst[m][k] = *(const PG8_LAS bf16x8*)(lds + PG8_SA(b, h) + aoff + m * 2048 + k * 1024); } while (0)
#define PG8_LDB(dst, b, h) do { _Pragma("unroll") for (int n = 0; n < 2; ++n) _Pragma("unroll") for (int k = 0; k < 2; ++k) dst[n][k] = *(const PG8_LAS bf16x8*)(lds + PG8_SB(b, h) + boff + n * 2048 + k * 1024); } while (0)
#define PG8_MMA(ai, bj, At, Bt) do { __builtin_amdgcn_s_setprio(1); _Pragma("unroll") for (int m = 0; m < 4; ++m) _Pragma("unroll") for (int n = 0; n < 2; ++n) _Pragma("unroll") for (int k = 0; k < 2; ++k) \
        acc[ai][bj][m][n] = __builtin_amdgcn_mfma_f32_16x16x32_bf16(Bt[n][k], At[m][k], acc[ai][bj][m][n], 0, 0, 0); __builtin_amdgcn_s_setprio(0); } while (0)
#define PG8_WAIT_V(n) asm volatile("s_waitcnt vmcnt(" #n ")" ::: "memory")
#define PG8_WAIT_L(n) asm volatile("s_waitcnt lgkmcnt(" #n ")" ::: "memory")
#define PG8_BAR __builtin_amdgcn_s_barrier()
#define PG8_SCHED __builtin_amdgcn_sched_barrier(0)
    Unit cur, nxt; int ui = 0;
    if (!S.next(0, cur)) return;
    f32x4 acc[2][2][4][2];
#pragma unroll
    for (int a = 0; a < 2; ++a)
#pragma unroll
        for (int b = 0; b < 2; ++b)
#pragma unroll
            for (int m = 0; m < 4; ++m)
#pragma unroll
                for (int n = 0; n < 2; ++n) acc[a][b][m][n] = (f32x4){0.f, 0.f, 0.f, 0.f};
    bf16x8 At[4][2], B0[2][2], B1[2][2];
    const char* cA = (const char*)g.A + (size_t)cur.pm * tstep; const char* cB = (const char*)g.Bt + (size_t)cur.pn * tstep;
    S.a_ready(cur);
    if constexpr (SP2) {
        PG8_STAGE(PG8_SB(0, 0), cB, voffB); PG8_STAGE(PG8_SB(0, 1), cB + hstep, voffB); PG8_STAGE(PG8_SA(0, 0), cA, voffA); PG8_STAGE(PG8_SA(0, 1), cA + hstep, voffA);
        if (wr == 1) PG8_BAR;
        PG8_WAIT_V(2); PG8_BAR;
        PG8_STAGE(PG8_SB(1, 0), cB + kstep, voffB); PG8_STAGE(PG8_SA(1, 0), cA + kstep, voffA); PG8_STAGE(PG8_SB(1, 1), cB + hstep + kstep, voffB);
        PG8_WAIT_V(6); PG8_BAR;
    } else {
        PG8_STAGE(PG8_SB(0, 0), cB, voffB); PG8_STAGE(PG8_SA(0, 0), cA, voffA); PG8_STAGE(PG8_SB(0, 1), cB + hstep, voffB); PG8_STAGE(PG8_SA(0, 1), cA + hstep, voffA);
        if (wr == 1) PG8_BAR;
        PG8_WAIT_V(4); PG8_BAR;
        PG8_STAGE(PG8_SB(1, 0), cB + kstep, voffB); PG8_STAGE(PG8_SA(1, 0), cA + kstep, voffA); PG8_STAGE(PG8_SB(1, 1), cB + hstep + kstep, voffB);
        PG8_WAIT_V(6); PG8_BAR;
    }
    for (;;) {
        const bool has_next = S.next(ui + 1, nxt);
        const char* nA = has_next ? (const char*)g.A + (size_t)nxt.pm * tstep : cA; const char* nB = has_next ? (const char*)g.Bt + (size_t)nxt.pn * tstep : cB;
        for (int t = 0; t < nt; t += 2) {
            const bool last = (t == nt - 2);
            const char* a1 = cA + (size_t)(t + 1) * kstep;
            const char* a2 = last ? nA : cA + (size_t)(t + 2) * kstep; const char* b2 = last ? nB : cB + (size_t)(t + 2) * kstep;
            const char* a3 = a2 + kstep; const char* b3 = b2 + kstep;
            if (last && has_next) S.a_ready(nxt);
            if constexpr (SP2) {
            PG8_LDB(B0, 0, 0); PG8_LDB(B1, 0, 1); PG8_SCHED; PG8_LDA(At, 0, 0); PG8_STAGE(PG8_SA(1, 1), a1 + hstep, voffA);
            PG8_WAIT_V(8); PG8_WAIT_L(0); PG8_BAR; PG8_MMA(0, 0, At, B0); PG8_MMA(0, 1, At, B1); PG8_BAR; PG8_SCHED;
            PG8_LDA(At, 0, 1); PG8_STAGE(PG8_SB(0, 0), b2, voffB); PG8_STAGE(PG8_SB(0, 1), b2 + hstep, voffB); PG8_STAGE(PG8_SA(0, 0), a2, voffA);
            PG8_WAIT_V(8); PG8_WAIT_L(0); PG8_BAR; PG8_MMA(1, 0, At, B0); PG8_MMA(1, 1, At, B1); PG8_BAR; PG8_SCHED;
            PG8_LDB(B0, 1, 0); PG8_LDB(B1, 1, 1); PG8_SCHED; PG8_LDA(At, 1, 0); PG8_STAGE(PG8_SA(0, 1), a2 + hstep, voffA);
            PG8_WAIT_V(8); PG8_WAIT_L(0); PG8_BAR; PG8_MMA(0, 0, At, B0); PG8_MMA(0, 1, At, B1); PG8_BAR; PG8_SCHED;
            PG8_LDA(At, 1, 1); PG8_STAGE(PG8_SB(1, 0), b3, voffB); PG8_STAGE(PG8_SB(1, 1), b3 + hstep, voffB); PG8_STAGE(PG8_SA(1, 0), a3, voffA);
            PG8_WAIT_V(8); PG8_WAIT_L(0); PG8_BAR; PG8_MMA(1, 0, At, B0); PG8_MMA(1, 1, At, B1); PG8_BAR; PG8_SCHED;
            } else {
            PG8_LDB(B0, 0, 0); PG8_SCHED; PG8_LDA(At, 0, 0); PG8_STAGE(PG8_SA(1, 1), a1 + hstep, voffA);
            PG8_WAIT_L(8); PG8_BAR; PG8_WAIT_L(0); PG8_MMA(0, 0, At, B0); PG8_BAR; PG8_SCHED;
            PG8_LDB(B1, 0, 1); PG8_STAGE(PG8_SB(0, 0), b2, voffB);
            PG8_BAR; PG8_WAIT_L(0); PG8_MMA(0, 1, At, B1); PG8_BAR;
            PG8_LDA(At, 0, 1); PG8_STAGE(PG8_SA(0, 0), a2, voffA);
            PG8_BAR; PG8_WAIT_L(0); PG8_MMA(1, 0, At, B0); PG8_BAR; PG8_SCHED;
            PG8_STAGE(PG8_SB(0, 1), b2 + hstep, voffB);
            PG8_WAIT_V(6); PG8_BAR; PG8_MMA(1, 1, At, B1); PG8_BAR;
            PG8_LDB(B0, 1, 0); PG8_SCHED; PG8_LDA(At, 1, 0); PG8_STAGE(PG8_SA(0, 1), a2 + hstep, voffA);
            PG8_WAIT_L(8); PG8_BAR; PG8_WAIT_L(0); PG8_MMA(0, 0, At, B0); PG8_BAR; PG8_SCHED;
            PG8_LDB(B1, 1, 1); PG8_STAGE(PG8_SB(1, 0), b3, voffB);
            PG8_BAR; PG8_WAIT_L(0); PG8_MMA(0, 1, At, B1); PG8_BAR;
            PG8_LDA(At, 1, 1); PG8_STAGE(PG8_SA(1, 0), a3, voffA);
            PG8_BAR; PG8_WAIT_L(0); PG8_MMA(1, 0, At, B0); PG8_BAR; PG8_SCHED;
            PG8_STAGE(PG8_SB(1, 1), b3 + hstep, voffB);
            PG8_WAIT_V(6); PG8_BAR; PG8_MMA(1, 1, At, B1); PG8_BAR;
            }
        }
        if constexpr (ALIGN_EPI) { if (wr == 0) PG8_BAR; }
        if constexpr (!Epi::AFTER_DRAIN) { E(acc, cur, wr, wc, fr, fq); S.done(cur); }
        if (!has_next) break;
#pragma unroll
        for (int a = 0; a < 2; ++a)
#pragma unroll
            for (int b = 0; b < 2; ++b)
#pragma unroll
                for (int m = 0; m < 4; ++m)
#pragma unroll
                    for (int n = 0; n < 2; ++n) acc[a][b][m][n] = (f32x4){0.f, 0.f, 0.f, 0.f};
        cur = nxt; cA = nA; cB = nB; ++ui;
        if constexpr (ALIGN_EPI) { if (wr == 1) PG8_BAR; }
    }
    PG8_WAIT_V(0);
    if constexpr (!ALIGN_EPI) { if (wr == 0) PG8_BAR; }
    PG8_BAR;
    if constexpr (Epi::AFTER_DRAIN) { E.fused(acc, cur, wr, wc, fr, fq, lds, wid, lane); S.done(cur); }
#undef PG8_SA
#undef PG8_SB
#undef PG8_STAGE
#undef PG8_LDA
#undef PG8_LDB
#undef PG8_MMA
#undef PG8_WAIT_V
#undef PG8_WAIT_L
#undef PG8_BAR
#undef PG8_SCHED
}
}
#define LAS __attribute__((address_space(3)))
#define XB_TMO      128
#define XB_XCNT(j)  (256  + 64 * (j))
#define XB_XSUB(j)  (1280 + 64 * (j))
#define XB_XGEN(j)  (2304 + 64 * (j))
#define XB_TOP      3328
#define XB_TOPGEN   3392
#define XCD_BAR_WORDS 3456
#define XB_SPIN_CAP (1u << 18)

__device__ __forceinline__ unsigned xb_ld(unsigned* p)              { return __hip_atomic_load(p, __ATOMIC_RELAXED, __HIP_MEMORY_SCOPE_AGENT); }
__device__ __forceinline__ unsigned xb_add(unsigned* p, unsigned v) { return __hip_atomic_fetch_add(p, v, __ATOMIC_RELAXED, __HIP_MEMORY_SCOPE_AGENT); }
__device__ __forceinline__ unsigned xb_xcc_id() { return (unsigned)__builtin_amdgcn_s_getreg((3 << 11) | 20) & 0xFu; }
#define XB_SPIN(cond, bar) do { unsigned _sp = 0; while (cond) { __builtin_amdgcn_s_sleep(1); \
    if ((++_sp & 255u) == 0u) { if (xb_ld(&(bar)[XB_TMO])) break; if (_sp > XB_SPIN_CAP) { atomicAdd(&(bar)[XB_TMO], 1u); break; } } } } while (0)

struct XcdBarrier {
    unsigned* bar; unsigned x;
    volatile LAS unsigned* st;
};

__device__ __forceinline__ XcdBarrier xcd_barrier_post(unsigned* bar, volatile LAS unsigned* st) {
    XcdBarrier b; b.bar = bar; b.x = xb_xcc_id(); b.st = st;
    if (threadIdx.x == 0) (void)xb_add(&bar[XB_XCNT(b.x)], 1u);
    return b;
}
__device__ __forceinline__ void xcd_barrier_complete(unsigned* bar, unsigned x, unsigned& nloc, unsigned& nx) {
    const unsigned G = gridDim.x * gridDim.y * gridDim.z;
    unsigned sum, cnt, mine, sp = 0u;
    for (;;) {
        sum = 0u; cnt = 0u; mine = 0u;
#pragma unroll
        for (unsigned j = 0; j < 16; ++j) { const unsigned c = xb_ld(&bar[XB_XCNT(j)]); sum += c; cnt += (c > 0u) ? 1u : 0u; mine = (j == x) ? c : mine; }
        if (sum == G) break;
        __builtin_amdgcn_s_sleep(1);
        if ((++sp & 255u) == 0u) { if (xb_ld(&bar[XB_TMO])) break; if (sp > XB_SPIN_CAP) { atomicAdd(&bar[XB_TMO], 1u); break; } }
    }
    nloc = mine > 0u ? mine : 1u; nx = cnt > 0u ? cnt : 1u;
}

__device__ __forceinline__ void xcd_barrier(const XcdBarrier& b) {
    asm volatile("s_waitcnt vmcnt(0)" ::: "memory");
    __syncthreads();
    if (threadIdx.x == 0) {
        unsigned* bar = b.bar;
        __builtin_amdgcn_s_waitcnt(0);
        unsigned nloc = b.st[0], nx = b.st[1];
        if (nloc == 0u) { xcd_barrier_complete(bar, b.x, nloc, nx); b.st[0] = nloc; b.st[1] = nx; }
        const unsigned old = xb_add(&bar[XB_XSUB(b.x)], 1u);
        const unsigned gen = old / nloc;
        if (old + 1u == (gen + 1u) * nloc) {
            __builtin_amdgcn_fence(__ATOMIC_RELEASE, "agent");
            asm volatile("s_waitcnt vmcnt(0)" ::: "memory");
            const unsigned og = xb_add(&bar[XB_TOP], 1u);
            const unsigned tg = og / nx;
            if (og + 1u == (tg + 1u) * nx) xb_add(&bar[XB_TOPGEN], 1u);
            else XB_SPIN(xb_ld(&bar[XB_TOPGEN]) == tg, bar);
            __builtin_amdgcn_fence(__ATOMIC_ACQUIRE, "agent");
            xb_add(&bar[XB_XGEN(b.x)], 1u);
            asm volatile("s_waitcnt vmcnt(0)" ::: "memory");
        } else {
            XB_SPIN(xb_ld(&bar[XB_XGEN(b.x)]) == gen, bar);
            __builtin_amdgcn_fence(__ATOMIC_ACQUIRE, "agent");
            asm volatile("s_waitcnt vmcnt(0)" ::: "memory");
        }
    }
    __syncthreads();
}
#define GAS __attribute__((address_space(1)))

typedef unsigned short bf16;
typedef float f32x4 __attribute__((ext_vector_type(4)));
typedef unsigned v4u __attribute__((ext_vector_type(4)));
typedef unsigned v2u __attribute__((ext_vector_type(2)));
#define LDS_WAIT() asm volatile("s_waitcnt lgkmcnt(0)" ::: "memory")

#ifndef MK_ONE_LAUNCH
#define MK_ONE_LAUNCH 0
#endif
#ifndef RET_MFMA
#define RET_MFMA 1
#endif
#ifndef SWA_MFMA
#define SWA_MFMA 1
#endif
#ifndef PROBE_DUP
#define PROBE_DUP 0
#endif
#ifndef CONV_FUSED
#define CONV_FUSED 1
#endif
#ifndef PLE_EARLY
#define PLE_EARLY 1
#endif
#ifndef LN_NOXR
#define LN_NOXR 1
#endif
#define REPS(k) int nrep_ = (PROBE_DUP == (k)) ? 2 : 1; asm volatile("" : "+s"(nrep_)); for (int rep_ = 0; rep_ < nrep_; ++rep_)

constexpr int S = 16384, D = 2048, INW = 5376, DFF = 5632, NUP = 2 * DFF, NUPG = NUP + D, PLE = 256, DEPTH = 4;
constexpr float ALPHA = 1.6817928305074290f, LN_EPS = 1e-5f, GN_EPS = 1e-6f;
constexpr int NPH = 11, NPHASES = 1 + DEPTH * NPH;

constexpr size_t MiB = 1u << 20;
constexpr size_t WS_CTL = 0, CTL_ZERO_BYTES = 32768;
constexpr size_t WS_COSR = 2 * MiB, WS_SINR = 10 * MiB, WS_COSA = 18 * MiB, WS_SINA = 20 * MiB;
constexpr size_t WS_W = 32 * MiB, WL_BYTES = 104 * MiB;
constexpr size_t WL_IN = 0, WL_OUT = 21 * MiB, WL_UP = 29 * MiB, WL_G = 73 * MiB, WL_DOWN = 81 * MiB, WL_P = 103 * MiB;
constexpr size_t WS_XR = 448 * MiB, WS_XB = 576 * MiB, WS_Y = 640 * MiB;
constexpr size_t WS_Q = 768 * MiB, WS_K = 800 * MiB, WS_V = 832 * MiB, WS_G = 864 * MiB, WS_AQ = 896 * MiB, WS_AK = 928 * MiB, WS_AV = 932 * MiB;
constexpr size_t WS_MIX = 936 * MiB, WS_U = 1000 * MiB, WS_PS = 1128 * MiB, WS_RETY = 1160 * MiB;
constexpr size_t WS_H = 768 * MiB, WS_ACT = 1128 * MiB, WS_SG = 1304 * MiB, WS_PB = 1368 * MiB, WS_END = 1400 * MiB;
constexpr size_t WS_PP = 1064 * MiB;
constexpr size_t WS_ST1 = 448 * MiB, WS_ST2 = 449 * MiB;
constexpr int CW_BAR = 4096;
static_assert((CW_BAR + 3456) * 4 <= 32768, "barrier words inside the per-call memset");

constexpr int RING_BYTES = 131072, LDS_BYTES = 147456, LDSCTL_OFF = LDS_BYTES - 1024, MISC_OFF = LDSCTL_OFF + 320;

__device__ __forceinline__ unsigned f2bf(float f) { unsigned u = __builtin_bit_cast(unsigned, f); return (u + 0x7fffu + ((u >> 16) & 1u)) >> 16; }
__device__ __forceinline__ unsigned pk2(float lo, float hi) { return f2bf(lo) | (f2bf(hi) << 16); }
__device__ __forceinline__ float bflo(unsigned w) { return __uint_as_float(w << 16); }
__device__ __forceinline__ float bfhi(unsigned w) { return __uint_as_float(w & 0xffff0000u); }
__device__ __forceinline__ float bf1(const bf16* p) { return __uint_as_float(((unsigned)*p) << 16); }

struct Params {
    const float* in[19]; float* out; unsigned char* ws; int ph_lo, ph_hi;
    float invf_ret[128]; float invf_att[32]; float lg2g[4];
};

struct Ctx { int tid, lane, wave, G, bid; unsigned char* ws; };

__device__ __forceinline__ int lane_id_asm() { int l; asm volatile("v_mbcnt_lo_u32_b32 %0, -1, 0\n\tv_mbcnt_hi_u32_b32 %0, -1, %0" : "=v"(l)); return l; }
__device__ __forceinline__ float wave_sum(float v, int lane) {
#pragma unroll
    for (int o = 1; o < 64; o <<= 1) v += __builtin_bit_cast(float, __builtin_amdgcn_ds_bpermute((lane ^ o) << 2, __builtin_bit_cast(int, v)));
    return v;
}
__device__ __forceinline__ void transpose_item(const float* W, int K, int N, int src_col0, bf16* WT, int dst_row0, int k0, LAS float* scr, int lane) {
#pragma unroll 8
    for (int i = 0; i < 32; ++i) { const int kk = 2 * i + (lane >> 5); scr[kk * 33 + (lane & 31)] = W[(size_t)(k0 + kk) * N + src_col0 + (lane & 31)]; }
    LDS_WAIT(); asm volatile("" ::: "memory");
    const int c = lane & 7;
#pragma unroll
    for (int j = 0; j < 4; ++j) { const int n = (lane >> 3) + 8 * j; const LAS float* s = scr + (8 * c) * 33 + n;
        v4u o; o.x = pk2(s[0 * 33], s[1 * 33]); o.y = pk2(s[2 * 33], s[3 * 33]); o.z = pk2(s[4 * 33], s[5 * 33]); o.w = pk2(s[6 * 33], s[7 * 33]);
        *(v4u*)(WT + (size_t)(dst_row0 + n) * K + k0 + 8 * c) = o; }
    LDS_WAIT(); asm volatile("" ::: "memory");
}
__device__ __forceinline__ void transpose_item64(const float* W, int K, int N, int srcA, int srcB, bf16* WT, int dst_row0, int k0, LAS float* scr, int lane) {
    const int c4 = lane & 15, gsel = c4 >> 3, col = 4 * (c4 & 7), src = (gsel ? srcB : srcA) + col, kq = lane >> 4;
    f32x4 v[16];
#pragma unroll
    for (int i = 0; i < 16; ++i) v[i] = *(const f32x4*)(W + (size_t)(k0 + 4 * i + kq) * N + src);
#pragma unroll
    for (int i = 0; i < 16; ++i) { LAS float* d = scr + (4 * i + kq) * 65 + 32 * gsel + col; d[0] = v[i][0]; d[1] = v[i][1]; d[2] = v[i][2]; d[3] = v[i][3]; }
    LDS_WAIT(); asm volatile("" ::: "memory");
    const int c = lane & 7;
#pragma unroll
    for (int j = 0; j < 8; ++j) { const int n = (lane >> 3) + 8 * j; const LAS float* s = scr + (8 * c) * 65 + n;
        v4u o; o.x = pk2(s[0 * 65], s[1 * 65]); o.y = pk2(s[2 * 65], s[3 * 65]); o.z = pk2(s[4 * 65], s[5 * 65]); o.w = pk2(s[6 * 65], s[7 * 65]);
        *(v4u*)(WT + (size_t)(dst_row0 + n) * K + k0 + 8 * c) = o; }
    LDS_WAIT(); asm volatile("" ::: "memory");
}
__device__ __forceinline__ int win_src_col(int g) {
    const int tile = g >> 3, bj = (g >> 2) & 1, wcg = g & 3;
    if (tile < 16) return 32 * g;
    if (tile < 20) return 4096 + 256 * (tile - 16) + 64 * wcg + 32 * bj;
    return wcg < 2 ? 5120 + 64 * wcg + 32 * bj : 5248 + 32 * (wcg - 2) + 64 * bj;
}
__device__ __forceinline__ int wup_src_col(int g) { const int tile = g >> 3, bj = (g >> 2) & 1, wcg = g & 3; return (bj ? DFF : 0) + 128 * tile + 32 * wcg; }

__device__ __forceinline__ void sincos_d(float angf, float& s, float& c) {
    const double a = (double)angf;
    const double k = __builtin_rint(a * 0.63661977236758134308);
    double r = __builtin_fma(-k, 1.57079632679489661923, a); r = __builtin_fma(-k, 6.123233995736766e-17, r);
    const double r2 = r * r;
    const double sp = r + r * r2 * (-1.0 / 6 + r2 * (1.0 / 120 + r2 * (-1.0 / 5040 + r2 * (1.0 / 362880 + r2 * (-1.0 / 39916800)))));
    const double cp = 1.0 + r2 * (-0.5 + r2 * (1.0 / 24 + r2 * (-1.0 / 720 + r2 * (1.0 / 40320 + r2 * (-1.0 / 3628800 + r2 * (1.0 / 479001600))))));
    const int q = ((int)k) & 3;
    const double sv = (q == 0) ? sp : (q == 1) ? cp : (q == 2) ? -sp : -cp;
    const double cv = (q == 0) ? cp : (q == 1) ? -sp : (q == 2) ? -cp : sp;
    s = (float)sv; c = (float)cv;
}

__device__ __forceinline__ void phase_prologue(const Params& P, const Ctx& cx, LAS unsigned char* lds) {
    unsigned char* ws = cx.ws; const int tid = cx.tid, lane = cx.lane, wave = cx.wave, G = cx.G;
    LAS float* scr = (LAS float*)(lds + wave * 16896);
    const int gw = cx.bid * 8 + wave, NGW = G * 8;
    constexpr int I_IN = 32 * 84, I_OUT = 32 * 32, I_UP = 32 * 176, I_G = 32 * 32, I_DN = 88 * 32, I_P = 4 * 32, I_L = I_IN + I_OUT + I_UP + I_G + I_DN + I_P;
    for (int it = gw; it < DEPTH * I_L; it += NGW) {
        const int l = it / I_L; int r = it - l * I_L;
        bf16* wl = (bf16*)(ws + WS_W + (size_t)l * WL_BYTES);
        if (r < I_IN) { const int kb = r / 84, g = r % 84; transpose_item64(P.in[3] + (size_t)l * D * INW, D, INW, win_src_col(2 * g), win_src_col(2 * g + 1), wl + WL_IN / 2, 64 * g, 64 * kb, scr, lane); continue; } r -= I_IN;
        if (r < I_OUT) { const int kb = r / 32, g = r % 32; transpose_item64(P.in[4] + (size_t)l * D * D, D, D, 64 * g, 64 * g + 32, wl + WL_OUT / 2, 64 * g, 64 * kb, scr, lane); continue; } r -= I_OUT;
        if (r < I_UP) { const int kb = r / 176, g = r % 176; transpose_item64(P.in[10] + (size_t)l * D * NUP, D, NUP, wup_src_col(2 * g), wup_src_col(2 * g + 1), wl + WL_UP / 2, 64 * g, 64 * kb, scr, lane); continue; } r -= I_UP;
        if (r < I_G) { const int kb = r / 32, g = r % 32; transpose_item64(P.in[16] + (size_t)l * D * D, D, D, 64 * g, 64 * g + 32, wl + WL_G / 2, 64 * g, 64 * kb, scr, lane); continue; } r -= I_G;
        if (r < I_DN) { const int kb = r / 32, g = r % 32; transpose_item64(P.in[13] + (size_t)l * DFF * D, DFF, D, 64 * g, 64 * g + 32, wl + WL_DOWN / 2, 64 * g, 64 * kb, scr, lane); continue; } r -= I_DN;
        { const int kb = r / 32, g = r % 32; transpose_item64(P.in[18] + (size_t)l * PLE * D, PLE, D, 64 * g, 64 * g + 32, wl + WL_P / 2, 64 * g, 64 * kb, scr, lane); }
    }
    const size_t gt = (size_t)cx.bid * 512 + tid, NT = (size_t)G * 512;
    { const float* x = P.in[0]; bf16* xb = (bf16*)(ws + WS_XB);
      for (size_t i = gt; i < (size_t)S * D / 8; i += NT) { const f32x4 a = *(const f32x4*)(x + i * 8), b = *(const f32x4*)(x + i * 8 + 4);
          v4u o; o.x = pk2(a[0], a[1]); o.y = pk2(a[2], a[3]); o.z = pk2(b[0], b[1]); o.w = pk2(b[2], b[3]); *(v4u*)(xb + i * 8) = o; } }
    { const float* p = P.in[1]; bf16* pb = (bf16*)(ws + WS_PB);
      for (size_t i = gt; i < (size_t)DEPTH * S * PLE / 8; i += NT) { const f32x4 a = *(const f32x4*)(p + i * 8), b = *(const f32x4*)(p + i * 8 + 4);
          v4u o; o.x = pk2(a[0], a[1]); o.y = pk2(a[2], a[3]); o.z = pk2(b[0], b[1]); o.w = pk2(b[2], b[3]); *(v4u*)(pb + i * 8) = o; } }
    { const int* pos = (const int*)P.in[2]; float* cosr = (float*)(ws + WS_COSR); float* sinr = (float*)(ws + WS_SINR); float* cosa = (float*)(ws + WS_COSA); float* sina = (float*)(ws + WS_SINA);
      for (size_t i = gt; i < (size_t)S * 128; i += NT) { const int t = (int)(i >> 7), f = (int)(i & 127); float s, c; sincos_d((float)pos[t] * P.invf_ret[f], s, c); cosr[i] = c; sinr[i] = s; }
      for (size_t i = gt; i < (size_t)S * 32; i += NT) { const int t = (int)(i >> 5), f = (int)(i & 31); float s, c; sincos_d((float)pos[t] * P.invf_att[f], s, c); cosa[i] = c; sina[i] = s; } }
}

template <int MT, int NT_, int KK, bool A_KFAST, bool B_NFAST, class FA, class FB, class FC>
__device__ __forceinline__ void simple_gemm(LAS unsigned char* lds, int nbatch, int tid, int G, int bid, const FA& fa, const FB& fb, const FC& fc) {
    LAS float* As = (LAS float*)lds;
    LAS float* Bs = (LAS float*)(lds + 16 * 132 * 4);
    constexpr int TM = MT / 128, TN = NT_ / 64, ITEMS_PER_B = TM * TN;
    const int tm = tid & 31, tn = tid >> 5;
    for (int item = bid; item < nbatch * ITEMS_PER_B; item += G) {
        const int b = item / ITEMS_PER_B, r = item % ITEMS_PER_B, m0 = (r / TN) * 128, n0 = (r % TN) * 64;
        float c[4][4];
#pragma unroll
        for (int i = 0; i < 4; ++i)
#pragma unroll
            for (int j = 0; j < 4; ++j) c[i][j] = 0.f;
        for (int k0 = 0; k0 < KK; k0 += 16) {
#pragma unroll
            for (int rr = 0; rr < 4; ++rr) { const int e = tid + 512 * rr; int m, k; if (A_KFAST) { k = e & 15; m = e >> 4; } else { m = e & 127; k = e >> 7; }
                As[k * 132 + m] = fa(b, m0 + m, k0 + k); }
#pragma unroll
            for (int rr = 0; rr < 2; ++rr) { const int e = tid + 512 * rr; int n, k; if (B_NFAST) { n = e & 63; k = e >> 6; } else { k = e & 15; n = e >> 4; }
                Bs[k * 68 + n] = fb(b, k0 + k, n0 + n); }
            __syncthreads();
#pragma unroll
            for (int kk = 0; kk < 16; ++kk) { const f32x4 a = *(const LAS f32x4*)(As + kk * 132 + 4 * tm), bb = *(const LAS f32x4*)(Bs + kk * 68 + 4 * tn);
#pragma unroll
                for (int i = 0; i < 4; ++i)
#pragma unroll
                    for (int j = 0; j < 4; ++j) c[i][j] += a[i] * bb[j]; }
            __syncthreads();
        }
#pragma unroll
        for (int i = 0; i < 4; ++i)
#pragma unroll
            for (int j = 0; j < 4; ++j) fc(b, m0 + 4 * tm + i, n0 + 4 * tn + j, c[i][j]);
    }
}

__device__ __forceinline__ void phase_swa(const Params& P, const Ctx& cx, int l, LAS unsigned char* lds) {
    unsigned char* ws = cx.ws; const int tid = cx.tid, G = cx.G;
    const bf16* AQ = (const bf16*)(ws + WS_AQ); const bf16* AK = (const bf16*)(ws + WS_AK); const bf16* AV = (const bf16*)(ws + WS_AV); bf16* MIX = (bf16*)(ws + WS_MIX);
    const float* sinks = P.in[7] + l * 16;
    LAS unsigned* Ks = (LAS unsigned*)lds;
    LAS unsigned* Vs = (LAS unsigned*)(lds + 256 * 33 * 4);
    for (int item = cx.bid; item < 256; item += G) {
        const int nb = item >> 1, hk = item & 1;
        __syncthreads();
        for (int e = tid; e < 256 * 32; e += 512) { const int r = e >> 5, cdw = e & 31; const int gk = nb * 128 - 128 + r;
            unsigned kv = 0u, vv = 0u; if (gk >= 0) { kv = *(const unsigned*)(AK + (size_t)gk * 128 + hk * 64 + 2 * cdw); vv = *(const unsigned*)(AV + (size_t)gk * 128 + hk * 64 + 2 * cdw); }
            Ks[r * 33 + cdw] = kv; Vs[r * 33 + cdw] = vv; }
        __syncthreads();
#pragma unroll 1
        for (int rep = 0; rep < 2; ++rep) {
            const int pair = tid + 512 * rep, i = pair & 127, g = pair >> 7, hq = hk * 8 + g; const int row = nb * 128 + i;
            float q[64], o[64];
            { const v4u* qp = (const v4u*)(AQ + (size_t)row * 1024 + hq * 64);
#pragma unroll
              for (int c8 = 0; c8 < 8; ++c8) { const v4u w = qp[c8]; q[8 * c8 + 0] = bflo(w.x); q[8 * c8 + 1] = bfhi(w.x); q[8 * c8 + 2] = bflo(w.y); q[8 * c8 + 3] = bfhi(w.y); q[8 * c8 + 4] = bflo(w.z); q[8 * c8 + 5] = bfhi(w.z); q[8 * c8 + 6] = bflo(w.w); q[8 * c8 + 7] = bfhi(w.w); } }
#pragma unroll
            for (int d = 0; d < 64; ++d) o[d] = 0.f;
            float mx = sinks[hq], den = 1.0f;
            const int jj0 = (nb == 0) ? (127 - i) : 0;
            for (int jj = jj0; jj < 128; ++jj) { const int kl = i + 1 + jj;
                float s = 0.f;
#pragma unroll
                for (int c = 0; c < 32; ++c) { const unsigned w = Ks[kl * 33 + c]; s += q[2 * c] * bflo(w) + q[2 * c + 1] * bfhi(w); }
                const float mn = fmaxf(mx, s), sc = __expf(mx - mn), p = __expf(s - mn);
                den = den * sc + p; mx = mn;
#pragma unroll
                for (int c = 0; c < 32; ++c) { const unsigned w = Vs[kl * 33 + c]; o[2 * c] = o[2 * c] * sc + p * bflo(w); o[2 * c + 1] = o[2 * c + 1] * sc + p * bfhi(w); }
            }
            const float inv = 1.0f / den;
            v4u* op = (v4u*)(MIX + (size_t)row * 2048 + 1024 + hq * 64);
#pragma unroll
            for (int c8 = 0; c8 < 8; ++c8) { v4u w; w.x = pk2(o[8 * c8] * inv, o[8 * c8 + 1] * inv); w.y = pk2(o[8 * c8 + 2] * inv, o[8 * c8 + 3] * inv); w.z = pk2(o[8 * c8 + 4] * inv, o[8 * c8 + 5] * inv); w.w = pk2(o[8 * c8 + 6] * inv, o[8 * c8 + 7] * inv); op[c8] = w; }
        }
    }
}

__device__ __forceinline__ void phase_ret_u_scores(const Params& P, const Ctx& cx, LAS unsigned char* lds) {
    unsigned char* ws = cx.ws; const int tid = cx.tid, G = cx.G;
    const bf16* Q = (const bf16*)(ws + WS_Q); const bf16* K = (const bf16*)(ws + WS_K); const bf16* V = (const bf16*)(ws + WS_V);
    float* U = (float*)(ws + WS_U); float* PS = (float*)(ws + WS_PS);
    const float lg0 = P.lg2g[0], lg1 = P.lg2g[1], lg2 = P.lg2g[2], lg3 = P.lg2g[3];
    auto lgh = [=](int h) { return h == 0 ? lg0 : h == 1 ? lg1 : h == 2 ? lg2 : lg3; };
    simple_gemm<256, 256, 128, false, true>(lds, 512, tid, G, cx.bid,
        [=](int b, int m, int k) { const int nb = b >> 2, h = b & 3; return bf1(K + (size_t)(nb * 128 + k) * 1024 + h * 256 + m) * exp2f(lgh(h) * (float)(127 - k)); },
        [=](int b, int k, int n) { const int nb = b >> 2, h = b & 3; return bf1(V + (size_t)(nb * 128 + k) * 1024 + h * 256 + n); },
        [=](int b, int m, int n, float v) { U[((size_t)b * 256 + m) * 256 + n] = v; });
    simple_gemm<128, 128, 256, true, false>(lds, 512, tid, G, cx.bid,
        [=](int b, int m, int k) { const int nb = b >> 2, h = b & 3; return bf1(Q + (size_t)(nb * 128 + m) * 1024 + h * 256 + k); },
        [=](int b, int k, int n) { const int nb = b >> 2, h = b & 3; return bf1(K + (size_t)(nb * 128 + n) * 1024 + h * 256 + k); },
        [=](int b, int m, int n, float v) { const int h = b & 3; PS[((size_t)b * 128 + m) * 128 + n] = (m >= n) ? v * exp2f(lgh(h) * (float)(m - n)) : 0.f; });
}
__device__ __forceinline__ void phase_scan(const Params& P, const Ctx& cx) {
    float* U = (float*)(cx.ws + WS_U);
    const size_t gt = (size_t)cx.bid * 512 + cx.tid, NT = (size_t)cx.G * 512;
    for (size_t idx = gt; idx < 4 * 65536; idx += NT) {
        const int h = (int)(idx >> 16); const float cd = exp2f(P.lg2g[h] * 128.0f);
        float r = 0.f;
        for (int n0 = 0; n0 < 128; n0 += 8) { float u[8];
#pragma unroll
            for (int j = 0; j < 8; ++j) u[j] = U[(size_t)(n0 + j) * 262144 + idx];
#pragma unroll
            for (int j = 0; j < 8; ++j) { U[(size_t)(n0 + j) * 262144 + idx] = r; r = r * cd + u[j]; } }
    }
}
__device__ __forceinline__ void phase_ret_out(const Params& P, const Ctx& cx, LAS unsigned char* lds) {
    unsigned char* ws = cx.ws; const int tid = cx.tid, G = cx.G;
    const bf16* Q = (const bf16*)(ws + WS_Q); const bf16* V = (const bf16*)(ws + WS_V);
    const float* Sst = (const float*)(ws + WS_U); const float* PS = (const float*)(ws + WS_PS); float* RY = (float*)(ws + WS_RETY);
    const float lg0 = P.lg2g[0], lg1 = P.lg2g[1], lg2 = P.lg2g[2], lg3 = P.lg2g[3];
    auto lgh = [=](int h) { return h == 0 ? lg0 : h == 1 ? lg1 : h == 2 ? lg2 : lg3; };
    simple_gemm<128, 256, 384, true, true>(lds, 512, tid, G, cx.bid,
        [=](int b, int m, int k) { const int nb = b >> 2, h = b & 3; return k < 128 ? PS[((size_t)b * 128 + m) * 128 + k] : bf1(Q + (size_t)(nb * 128 + m) * 1024 + h * 256 + (k - 128)) * exp2f(lgh(h) * (float)(m + 1)); },
        [=](int b, int k, int n) { const int nb = b >> 2, h = b & 3; return k < 128 ? bf1(V + (size_t)(nb * 128 + k) * 1024 + h * 256 + n) : Sst[((size_t)b * 256 + (k - 128)) * 256 + n]; },
        [=](int b, int m, int n, float v) { const int nb = b >> 2, h = b & 3; RY[(size_t)(nb * 128 + m) * 1024 + h * 256 + n] = v; });
}

typedef short bf16x8 __attribute__((ext_vector_type(8)));
typedef short s16x4 __attribute__((ext_vector_type(4)));
typedef short v4i16_t __attribute__((ext_vector_type(4)));
__device__ __forceinline__ f32x4 mfma16(bf16x8 a, bf16x8 b, f32x4 c) { return __builtin_amdgcn_mfma_f32_16x16x32_bf16(a, b, c, 0, 0, 0); }
__device__ __forceinline__ s16x4 lds_tr(LAS unsigned char* p) { return __builtin_bit_cast(s16x4, __builtin_amdgcn_ds_read_tr16_b64_v4i16((LAS v4i16_t*)p)); }
__device__ __forceinline__ bf16x8 cat44(s16x4 a, s16x4 b) { bf16x8 r; r[0] = a[0]; r[1] = a[1]; r[2] = a[2]; r[3] = a[3]; r[4] = b[0]; r[5] = b[1]; r[6] = b[2]; r[7] = b[3]; return r; }
__device__ __forceinline__ unsigned cvt2(float lo, float hi) { return pg8::cvt_pk_bf16(lo, hi); }
__device__ __forceinline__ bf16x8 pack_frag(const f32x4 a, const f32x4 b) { v4u w; w.x = cvt2(a[0], a[1]); w.y = cvt2(a[2], a[3]); w.z = cvt2(b[0], b[1]); w.w = cvt2(b[2], b[3]); return __builtin_bit_cast(bf16x8, w); }
__device__ __forceinline__ float grp16_sum(float v, int lane) {
#pragma unroll
    for (int o = 1; o < 16; o <<= 1) v += __builtin_bit_cast(float, __builtin_amdgcn_ds_bpermute((lane ^ o) << 2, __builtin_bit_cast(int, v)));
    return v;
}
constexpr int RS_T = 544;
constexpr int TILE_T = 128 * RS_T;
static_assert(2 * TILE_T <= LDSCTL_OFF, "retention tiles vs LDS control words");

template <bool DECAY> __device__ __forceinline__ void stage_tile(LAS unsigned char* img, const bf16* src, int tid, float lg) {
    v4u v[8];
#pragma unroll
    for (int r = 0; r < 8; ++r) { const int pc = tid + 512 * r, row = pc >> 5, c16 = pc & 31; v[r] = *(const v4u*)(src + (size_t)row * 1024 + c16 * 8); }
#pragma unroll
    for (int r = 0; r < 8; ++r) { const int pc = tid + 512 * r, row = pc >> 5, c16 = pc & 31; v4u w = v[r];
        if (DECAY) { const float sc = exp2f(lg * (float)(127 - row));
            w.x = cvt2(bflo(w.x) * sc, bfhi(w.x) * sc); w.y = cvt2(bflo(w.y) * sc, bfhi(w.y) * sc); w.z = cvt2(bflo(w.z) * sc, bfhi(w.z) * sc); w.w = cvt2(bflo(w.w) * sc, bfhi(w.w) * sc); }
        *(LAS v4u*)(img + row * RS_T + c16 * 16) = w; }
}

template <bool DECAY_A> __device__ __forceinline__ void stage_two(LAS unsigned char* imgA, const bf16* srcA, LAS unsigned char* imgB, const bf16* srcB, int tid, float lg) {
    v4u va[8], vb[8];
#pragma unroll
    for (int r = 0; r < 8; ++r) { const int pc = tid + 512 * r, row = pc >> 5, c16 = pc & 31; va[r] = *(const v4u*)(srcA + (size_t)row * 1024 + c16 * 8); vb[r] = *(const v4u*)(srcB + (size_t)row * 1024 + c16 * 8); }
#pragma unroll
    for (int r = 0; r < 8; ++r) { const int pc = tid + 512 * r, row = pc >> 5, c16 = pc & 31; v4u w = va[r];
        if (DECAY_A) { const float sc = exp2f(lg * (float)(127 - row));
            w.x = cvt2(bflo(w.x) * sc, bfhi(w.x) * sc); w.y = cvt2(bflo(w.y) * sc, bfhi(w.y) * sc); w.z = cvt2(bflo(w.z) * sc, bfhi(w.z) * sc); w.w = cvt2(bflo(w.w) * sc, bfhi(w.w) * sc); }
        *(LAS v4u*)(imgA + row * RS_T + c16 * 16) = w; *(LAS v4u*)(imgB + row * RS_T + c16 * 16) = vb[r]; }
}

__device__ __forceinline__ void phase_ret_u_mfma(const Params& P, const Ctx& cx, LAS unsigned char* lds) {
    unsigned char* ws = cx.ws; const int tid = cx.tid, lane = cx.lane, w = cx.wave, r16 = lane & 15, g = lane >> 4, q = r16 >> 2, pp = r16 & 3;
    const bf16* K = (const bf16*)(ws + WS_K); const bf16* V = (const bf16*)(ws + WS_V); bf16* UT = (bf16*)(ws + WS_U);
    LAS unsigned char* Kim = lds; LAS unsigned char* Vim = lds + TILE_T;
    for (int b = cx.bid; b < 512; b += cx.G) {
        const int nb = b >> 2, h = b & 3;
        __syncthreads();
        stage_two<true>(Kim, K + (size_t)nb * 128 * 1024 + h * 256, Vim, V + (size_t)nb * 128 * 1024 + h * 256, tid, P.lg2g[h]);
        __syncthreads();
        f32x4 acc[2][16];
#pragma unroll
        for (int mi = 0; mi < 2; ++mi)
#pragma unroll
            for (int n = 0; n < 16; ++n) acc[mi][n] = (f32x4){0.f, 0.f, 0.f, 0.f};
#pragma unroll 1
        for (int s = 0; s < 4; ++s) {
            bf16x8 af[2];
#pragma unroll
            for (int mi = 0; mi < 2; ++mi) { LAS unsigned char* a0 = Kim + (32 * s + 8 * g + q) * RS_T + (16 * (2 * w + mi) + 4 * pp) * 2; af[mi] = cat44(lds_tr(a0), lds_tr(a0 + 4 * RS_T)); }
#pragma unroll
            for (int n = 0; n < 16; ++n) { LAS unsigned char* b0 = Vim + (32 * s + 8 * g + q) * RS_T + (16 * n + 4 * pp) * 2; const bf16x8 bfr = cat44(lds_tr(b0), lds_tr(b0 + 4 * RS_T));
                acc[0][n] = mfma16(af[0], bfr, acc[0][n]); acc[1][n] = mfma16(af[1], bfr, acc[1][n]); }
        }
#pragma unroll
        for (int mi = 0; mi < 2; ++mi)
#pragma unroll
            for (int n = 0; n < 16; ++n) { v2u o; o.x = cvt2(acc[mi][n][0], acc[mi][n][1]); o.y = cvt2(acc[mi][n][2], acc[mi][n][3]);
                *(v2u*)(UT + ((size_t)b * 256 + 16 * n + r16) * 256 + 16 * (2 * w + mi) + 4 * g) = o; }
    }
}
__device__ __forceinline__ void phase_scan_bf16(const Params& P, const Ctx& cx) {
    unsigned* UT = (unsigned*)(cx.ws + WS_U);
    const size_t gt = (size_t)cx.bid * 512 + cx.tid, NT = (size_t)cx.G * 512;
    for (size_t idx = gt; idx < 131072; idx += NT) {
        const int h = (int)(idx >> 15); const float cd = exp2f(P.lg2g[h] * 128.0f);
        float r0 = 0.f, r1 = 0.f;
        for (int n0 = 0; n0 < 128; n0 += 16) { unsigned u[16];
#pragma unroll
            for (int j = 0; j < 16; ++j) u[j] = UT[(size_t)(n0 + j) * 131072 + idx];
#pragma unroll
            for (int j = 0; j < 16; ++j) { UT[(size_t)(n0 + j) * 131072 + idx] = cvt2(r0, r1); r0 = r0 * cd + bflo(u[j]); r1 = r1 * cd + bfhi(u[j]); } }
    }
}
constexpr int RS_O = 1040;
static_assert(8 * 16 * RS_O <= 2 * TILE_T, "R3 output staging fits the shared area");
__device__ __forceinline__ void phase_ret_out_mfma(const Params& P, const Ctx& cx, int l, LAS unsigned char* lds) {
    unsigned char* ws = cx.ws; const int w = cx.wave;
    const bf16* Q = (const bf16*)(ws + WS_Q); const bf16* K = (const bf16*)(ws + WS_K); const bf16* V = (const bf16*)(ws + WS_V); const bf16* ST = (const bf16*)(ws + WS_U);
    const bf16* Gt = (const bf16*)(ws + WS_G); bf16* MIX = (bf16*)(ws + WS_MIX);
    const float* gg = P.in[5] + l * 1024; const float* gb = P.in[6] + l * 1024;
    LAS unsigned char* Kim = lds; LAS unsigned char* Vim = lds + TILE_T;
    for (int b = cx.bid; b < 512; b += cx.G) {
        const int nb = b >> 2, h = b & 3; const float lg = P.lg2g[h];
        int lane = cx.lane; asm volatile("" : "+v"(lane)); const int tid = w * 64 + lane, r16 = lane & 15, g = lane >> 4, q = r16 >> 2, pp = r16 & 3;
        __syncthreads();
        { const bf16* stb = ST + (size_t)b * 65536;
#pragma unroll
          for (int hf = 0; hf < 2; ++hf) { v4u v[8];
#pragma unroll
            for (int r = 0; r < 8; ++r) { const int pc = tid + 512 * (r + 8 * hf), row = pc >> 5, c16 = pc & 31; v[r] = *(const v4u*)(stb + (size_t)row * 256 + c16 * 8); }
#pragma unroll
            for (int r = 0; r < 8; ++r) { const int pc = tid + 512 * (r + 8 * hf), row = pc >> 5, c16 = pc & 31; *(LAS v4u*)(lds + row * RS_T + c16 * 16) = v[r]; } } }
        bf16x8 qf[8];
        { const bf16* qrow = Q + (size_t)(nb * 128 + 16 * w + r16) * 1024 + h * 256 + 8 * g;
#pragma unroll
          for (int s = 0; s < 8; ++s) qf[s] = *(const bf16x8*)(qrow + 32 * s); }
        const bf16* ksrc = K + (size_t)nb * 128 * 1024 + h * 256; const bf16* vsrc = V + (size_t)nb * 128 * 1024 + h * 256;
        v4u kv[8];
#pragma unroll
        for (int r = 0; r < 8; ++r) { const int pc = tid + 512 * r, row = pc >> 5, c16 = pc & 31; kv[r] = *(const v4u*)(ksrc + (size_t)row * 1024 + c16 * 8); }
        __syncthreads();
        f32x4 acc[16];
#pragma unroll
        for (int n = 0; n < 16; ++n) { f32x4 a = (f32x4){0.f, 0.f, 0.f, 0.f};
            const LAS unsigned char* sp = lds + (16 * n + r16) * RS_T + 16 * g;
#pragma unroll
            for (int s = 0; s < 8; ++s) a = mfma16(qf[s], *(const LAS bf16x8*)(sp + 64 * s), a);
            acc[n] = a; if ((n & 3) == 3) __builtin_amdgcn_sched_barrier(0); }
        { float f[4];
#pragma unroll
          for (int r = 0; r < 4; ++r) f[r] = exp2f(lg * (float)(16 * w + 4 * g + r + 1));
#pragma unroll
          for (int n = 0; n < 16; ++n) { acc[n][0] *= f[0]; acc[n][1] *= f[1]; acc[n][2] *= f[2]; acc[n][3] *= f[3]; } }
        __syncthreads();
        v4u vv[8];
#pragma unroll
        for (int r = 0; r < 8; ++r) { const int pc = tid + 512 * r, row = pc >> 5, c16 = pc & 31; *(LAS v4u*)(Kim + row * RS_T + c16 * 16) = kv[r]; vv[r] = *(const v4u*)(vsrc + (size_t)row * 1024 + c16 * 8); }
        __syncthreads();
        f32x4 sc[8];
#pragma unroll
        for (int mb = 0; mb < 8; ++mb) { sc[mb] = (f32x4){0.f, 0.f, 0.f, 0.f};
            if (mb <= w) { f32x4 a = (f32x4){0.f, 0.f, 0.f, 0.f};
#pragma unroll
                for (int s = 0; s < 8; ++s) { const bf16x8 kf = *(const LAS bf16x8*)(Kim + (16 * mb + r16) * RS_T + (32 * s + 8 * g) * 2); a = mfma16(kf, qf[s], a); }
                const int i = 16 * w + r16;
#pragma unroll
                for (int r = 0; r < 4; ++r) { const int j = 16 * mb + 4 * g + r; a[r] = (i >= j) ? a[r] * exp2f(lg * (float)(i - j)) : 0.f; }
                sc[mb] = a; } }
#pragma unroll
        for (int r = 0; r < 8; ++r) { const int pc = tid + 512 * r, row = pc >> 5, c16 = pc & 31; *(LAS v4u*)(Vim + row * RS_T + c16 * 16) = vv[r]; }
        __syncthreads();
#pragma unroll
        for (int sk = 0; sk < 4; ++sk) {
            if (2 * sk <= w) { const bf16x8 pf = pack_frag(sc[2 * sk], sc[2 * sk + 1]);
#pragma unroll
                for (int n = 0; n < 16; ++n) { LAS unsigned char* b0 = Vim + (32 * sk + 4 * g + q) * RS_T + (16 * n + 4 * pp) * 2; const bf16x8 bfr = cat44(lds_tr(b0), lds_tr(b0 + 16 * RS_T));
                    acc[n] = mfma16(pf, bfr, acc[n]); } } }
        float mean[4], rstd[4];
#pragma unroll
        for (int r = 0; r < 4; ++r) { float sm = 0.f;
#pragma unroll
            for (int n = 0; n < 16; ++n) sm += acc[n][r];
            mean[r] = grp16_sum(sm, lane) * (1.0f / 256.0f); }
#pragma unroll
        for (int r = 0; r < 4; ++r) { float sq = 0.f;
#pragma unroll
            for (int n = 0; n < 16; ++n) { const float d = acc[n][r] - mean[r]; sq += d * d; }
            rstd[r] = 1.0f / sqrtf(grp16_sum(sq, lane) * (1.0f / 256.0f) + GN_EPS); }
        __syncthreads();
        { LAS unsigned char* ob = lds + w * (16 * RS_O);
#pragma unroll
          for (int n = 0; n < 16; ++n)
#pragma unroll
            for (int r = 0; r < 4; ++r) *(LAS float*)(ob + (4 * g + r) * RS_O + (16 * n + r16) * 4) = (acc[n][r] - mean[r]) * rstd[r];
          LDS_WAIT(); asm volatile("" ::: "memory");
          const int e0 = 8 * (lane & 31), hv = lane >> 5;
          const f32x4 g0 = *(const f32x4*)(gg + h * 256 + e0), g1 = *(const f32x4*)(gg + h * 256 + e0 + 4), b0 = *(const f32x4*)(gb + h * 256 + e0), b1 = *(const f32x4*)(gb + h * 256 + e0 + 4);
#pragma unroll
          for (int k = 0; k < 8; ++k) { const int rl = 2 * k + hv; const size_t row = (size_t)(nb * 128 + 16 * w + rl);
              const f32x4 y0 = *(const LAS f32x4*)(ob + rl * RS_O + e0 * 4), y1 = *(const LAS f32x4*)(ob + rl * RS_O + e0 * 4 + 16);
              const v4u gt = *(const v4u*)(Gt + row * 1024 + h * 256 + e0);
              const f32x4 o0 = y0 * g0 + b0, o1 = y1 * g1 + b1;
              v4u o; o.x = cvt2(o0[0] * bflo(gt.x), o0[1] * bfhi(gt.x)); o.y = cvt2(o0[2] * bflo(gt.y), o0[3] * bfhi(gt.y)); o.z = cvt2(o1[0] * bflo(gt.z), o1[1] * bfhi(gt.z)); o.w = cvt2(o1[2] * bflo(gt.w), o1[3] * bfhi(gt.w));
              *(v4u*)(MIX + row * 2048 + h * 256 + e0) = o; } }
    }
}
constexpr int RS_SK = 144, RS_SV = 160;
__device__ __forceinline__ void phase_swa_mfma(const Params& P, const Ctx& cx, int l, LAS unsigned char* lds) {
    unsigned char* ws = cx.ws; const int tid = cx.tid, lane = cx.lane, w = cx.wave, r16 = lane & 15, g = lane >> 4, q = r16 >> 2, pp = r16 & 3;
    const bf16* AQ = (const bf16*)(ws + WS_AQ); const bf16* AK = (const bf16*)(ws + WS_AK); const bf16* AV = (const bf16*)(ws + WS_AV); bf16* MIX = (bf16*)(ws + WS_MIX);
    LAS unsigned char* Kim = lds; LAS unsigned char* Vim = lds + 256 * RS_SK;
    for (int item = cx.bid; item < 256; item += cx.G) {
        const int nb = item >> 1, hk = item & 1, hq = hk * 8 + w; const float sink = P.in[7][l * 16 + hq];
        __syncthreads();
#pragma unroll
        for (int r = 0; r < 4; ++r) { const int pc = tid + 512 * r, row = pc >> 3, c = pc & 7, gk = nb * 128 - 128 + row;
            v4u kv = (v4u){0u, 0u, 0u, 0u}, vv = (v4u){0u, 0u, 0u, 0u};
            if (gk >= 0) { kv = *(const v4u*)(AK + (size_t)gk * 128 + hk * 64 + c * 8); vv = *(const v4u*)(AV + (size_t)gk * 128 + hk * 64 + c * 8); }
            *(LAS v4u*)(Kim + row * RS_SK + c * 16) = kv; *(LAS v4u*)(Vim + row * RS_SV + c * 16) = vv; }
        __syncthreads();
#pragma unroll 1
        for (int nq = 0; nq < 8; ++nq) {
            const bf16* qrow = AQ + (size_t)(nb * 128 + 16 * nq + r16) * 1024 + hq * 64 + 8 * g;
            const bf16x8 qf0 = *(const bf16x8*)(qrow), qf1 = *(const bf16x8*)(qrow + 32);
            f32x4 sc[10];
            float mx = sink;
#pragma unroll
            for (int kb = 0; kb < 9; ++kb) { const LAS unsigned char* kp = Kim + (16 * (nq + kb) + r16) * RS_SK + 16 * g;
                f32x4 a = (f32x4){0.f, 0.f, 0.f, 0.f};
                a = mfma16(*(const LAS bf16x8*)(kp), qf0, a); a = mfma16(*(const LAS bf16x8*)(kp + 64), qf1, a);
#pragma unroll
                for (int r = 0; r < 4; ++r) { const int dl = 16 * kb + 4 * g + r - r16; const bool vis = (dl >= 1) && (dl <= 128) && (nb > 0 || 16 * (nq + kb) + 4 * g + r >= 128);
                    a[r] = vis ? a[r] : -INFINITY; mx = fmaxf(mx, a[r]); }
                sc[kb] = a; }
            sc[9] = (f32x4){0.f, 0.f, 0.f, 0.f};
            mx = fmaxf(mx, __builtin_bit_cast(float, __builtin_amdgcn_ds_bpermute((lane ^ 16) << 2, __builtin_bit_cast(int, mx))));
            mx = fmaxf(mx, __builtin_bit_cast(float, __builtin_amdgcn_ds_bpermute((lane ^ 32) << 2, __builtin_bit_cast(int, mx))));
            float sum = 0.f;
#pragma unroll
            for (int kb = 0; kb < 9; ++kb)
#pragma unroll
                for (int r = 0; r < 4; ++r) { const float pv = __expf(sc[kb][r] - mx); sc[kb][r] = pv; sum += pv; }
            sum += __builtin_bit_cast(float, __builtin_amdgcn_ds_bpermute((lane ^ 16) << 2, __builtin_bit_cast(int, sum)));
            sum += __builtin_bit_cast(float, __builtin_amdgcn_ds_bpermute((lane ^ 32) << 2, __builtin_bit_cast(int, sum)));
            const float inv = 1.0f / (sum + __expf(sink - mx));
            f32x4 o[4];
#pragma unroll
            for (int nd = 0; nd < 4; ++nd) o[nd] = (f32x4){0.f, 0.f, 0.f, 0.f};
#pragma unroll
            for (int sk = 0; sk < 5; ++sk) { const bf16x8 pf = pack_frag(sc[2 * sk] * inv, sc[2 * sk + 1] * inv);
                const int kb0 = nq + 2 * sk, kb1 = (kb0 + 1 > 15) ? 15 : kb0 + 1;
#pragma unroll
                for (int nd = 0; nd < 4; ++nd) { const bf16x8 bfr = cat44(lds_tr(Vim + (16 * kb0 + 4 * g + q) * RS_SV + (16 * nd + 4 * pp) * 2), lds_tr(Vim + (16 * kb1 + 4 * g + q) * RS_SV + (16 * nd + 4 * pp) * 2));
                    o[nd] = mfma16(pf, bfr, o[nd]); } }
#pragma unroll
            for (int nd = 0; nd < 4; ++nd)
#pragma unroll
                for (int r = 0; r < 4; ++r) MIX[(size_t)(nb * 128 + 16 * nq + 4 * g + r) * 2048 + 1024 + hq * 64 + 16 * nd + r16] = (bf16)f2bf(o[nd][r]);
        }
    }
}

__device__ __forceinline__ void phase_groupnorm(const Params& P, const Ctx& cx, int l) {
    unsigned char* ws = cx.ws; const int lane = cx.lane, wave = cx.wave, G = cx.G;
    const float* RY = (const float*)(ws + WS_RETY); const bf16* Gt = (const bf16*)(ws + WS_G); bf16* MIX = (bf16*)(ws + WS_MIX);
    const float* gg = P.in[5] + l * 1024; const float* gb = P.in[6] + l * 1024;
    const int gw = cx.bid * 8 + wave, NGW = G * 8;
    for (int it = gw; it < S * 4; it += NGW) { const int row = it >> 2, h = it & 3; const size_t off = (size_t)row * 1024 + h * 256 + 4 * lane;
        f32x4 v = *(const f32x4*)(RY + off);
        const float mean = wave_sum((v[0] + v[1]) + (v[2] + v[3]), lane) * (1.0f / 256.0f);
        v = v - mean;
        const float var = wave_sum((v[0] * v[0] + v[1] * v[1]) + (v[2] * v[2] + v[3] * v[3]), lane) * (1.0f / 256.0f);
        const float rstd = 1.0f / sqrtf(var + GN_EPS);
        const f32x4 g4 = *(const f32x4*)(gg + h * 256 + 4 * lane), b4 = *(const f32x4*)(gb + h * 256 + 4 * lane);
        const v2u gt2 = *(const v2u*)(Gt + off);
        f32x4 o = v * rstd * g4 + b4;
        o[0] *= bflo(gt2.x); o[1] *= bfhi(gt2.x); o[2] *= bflo(gt2.y); o[3] *= bfhi(gt2.y);
        v2u w; w.x = pk2(o[0], o[1]); w.y = pk2(o[2], o[3]);
        *(v2u*)(MIX + (size_t)row * 2048 + h * 256 + 4 * lane) = w; }
}
__device__ __forceinline__ void phase_ln(const Ctx& cx, const float* Y, const float* g, const float* b, float* xo, bf16* xb, float* stats) {
    const int lane = cx.lane, wave = cx.wave, G = cx.G; const int gw = cx.bid * 8 + wave, NGW = G * 8;
    f32x4 g4[8], b4[8];
#pragma unroll
    for (int j = 0; j < 8; ++j) { g4[j] = ((const f32x4*)g)[64 * j + lane]; b4[j] = ((const f32x4*)b)[64 * j + lane]; }
    for (int row = gw; row < S; row += 2 * NGW) {
        const int row2 = row + NGW; const bool has2 = row2 < S; const int rb = has2 ? row2 : row;
        const f32x4* ya = (const f32x4*)(Y + (size_t)row * D) + lane; const f32x4* yb = (const f32x4*)(Y + (size_t)rb * D) + lane;
        f32x4 va[8], vb[8]; float sa = 0.f, sb = 0.f;
#pragma unroll
        for (int j = 0; j < 8; ++j) { va[j] = ya[64 * j]; vb[j] = yb[64 * j]; }
#pragma unroll
        for (int j = 0; j < 8; ++j) { sa += (va[j][0] + va[j][1]) + (va[j][2] + va[j][3]); sb += (vb[j][0] + vb[j][1]) + (vb[j][2] + vb[j][3]); }
        const float ma = wave_sum(sa, lane) * (1.0f / D), mb = wave_sum(sb, lane) * (1.0f / D); float qa = 0.f, qb = 0.f;
#pragma unroll
        for (int j = 0; j < 8; ++j) { va[j] = va[j] - ma; vb[j] = vb[j] - mb; qa += (va[j][0] * va[j][0] + va[j][1] * va[j][1]) + (va[j][2] * va[j][2] + va[j][3] * va[j][3]); qb += (vb[j][0] * vb[j][0] + vb[j][1] * vb[j][1]) + (vb[j][2] * vb[j][2] + vb[j][3] * vb[j][3]); }
        const float ra = 1.0f / sqrtf(wave_sum(qa, lane) * (1.0f / D) + LN_EPS), rbb = 1.0f / sqrtf(wave_sum(qb, lane) * (1.0f / D) + LN_EPS);
        f32x4* xa = (f32x4*)(xo + (size_t)row * D) + lane; f32x4* xbp = (f32x4*)(xo + (size_t)rb * D) + lane;
        if (stats && lane == 0) { stats[2 * (size_t)row] = ma; stats[2 * (size_t)row + 1] = ra; if (has2) { stats[2 * (size_t)rb] = mb; stats[2 * (size_t)rb + 1] = rbb; } }
#pragma unroll
        for (int j = 0; j < 8; ++j) { const f32x4 o = va[j] * ra * g4[j] + b4[j]; if (xo) xa[64 * j] = o;
            if (xb) { v2u w; w.x = pk2(o[0], o[1]); w.y = pk2(o[2], o[3]); ((v2u*)(xb + (size_t)row * D))[64 * j + lane] = w; } }
        if (has2) {
#pragma unroll
            for (int j = 0; j < 8; ++j) { const f32x4 o = vb[j] * rbb * g4[j] + b4[j]; if (xo) xbp[64 * j] = o;
                if (xb) { v2u w; w.x = pk2(o[0], o[1]); w.y = pk2(o[2], o[3]); ((v2u*)(xb + (size_t)rb * D))[64 * j + lane] = w; } } }
    }
}
__device__ __forceinline__ void unpack8(const v4u h, float (&o)[8]) { o[0] = bflo(h.x); o[1] = bfhi(h.x); o[2] = bflo(h.y); o[3] = bfhi(h.y); o[4] = bflo(h.z); o[5] = bfhi(h.z); o[6] = bflo(h.w); o[7] = bfhi(h.w); }
__device__ __forceinline__ void phase_convact(const Params& P, const Ctx& cx, int l) {
    unsigned char* ws = cx.ws; const int tid = cx.tid, G = cx.G;
    const bf16* H = (const bf16*)(ws + WS_H); bf16* ACT = (bf16*)(ws + WS_ACT);
    const float* cw = P.in[11] + (size_t)l * 3 * NUP; const float* cb = P.in[12] + (size_t)l * NUP;
    const int gt = cx.bid * 512 + tid, NT = G * 512;
    for (int item = gt; item < 512 * 704; item += NT) {
        const int seg = item / 704, r = item - seg * 704, tile = r >> 4, q8 = r & 15, t0 = seg * 32;
        const int chg = 128 * tile + 8 * q8, chu = DFF + chg;
        float wg[3][8], wu[3][8], bg[8], bu[8];
#pragma unroll
        for (int k = 0; k < 3; ++k) { const f32x4 a0 = *(const f32x4*)(cw + (size_t)k * NUP + chg), a1 = *(const f32x4*)(cw + (size_t)k * NUP + chg + 4), c0 = *(const f32x4*)(cw + (size_t)k * NUP + chu), c1 = *(const f32x4*)(cw + (size_t)k * NUP + chu + 4);
#pragma unroll
            for (int e = 0; e < 4; ++e) { wg[k][e] = a0[e]; wg[k][4 + e] = a1[e]; wu[k][e] = c0[e]; wu[k][4 + e] = c1[e]; } }
        { const f32x4 a0 = *(const f32x4*)(cb + chg), a1 = *(const f32x4*)(cb + chg + 4), c0 = *(const f32x4*)(cb + chu), c1 = *(const f32x4*)(cb + chu + 4);
#pragma unroll
          for (int e = 0; e < 4; ++e) { bg[e] = a0[e]; bg[4 + e] = a1[e]; bu[e] = c0[e]; bu[4 + e] = c1[e]; } }
        const bf16* hp = H + (size_t)t0 * NUP + 256 * tile + 8 * q8;
        float g2[8], g1[8], u2[8], u1[8];
        if (t0 > 0) { unpack8(*(const v4u*)(hp - 2 * (size_t)NUP), g2); unpack8(*(const v4u*)(hp - (size_t)NUP), g1); unpack8(*(const v4u*)(hp - 2 * (size_t)NUP + 128), u2); unpack8(*(const v4u*)(hp - (size_t)NUP + 128), u1); }
        else {
#pragma unroll
            for (int e = 0; e < 8; ++e) { g2[e] = 0.f; g1[e] = 0.f; u2[e] = 0.f; u1[e] = 0.f; } }
        bf16* ap = ACT + (size_t)t0 * DFF + chg;
        v4u ng = *(const v4u*)(hp), nu = *(const v4u*)(hp + 128);
#pragma unroll 2
        for (int tt = 0; tt < 32; ++tt) {
            float g0[8], u0[8]; unpack8(ng, g0); unpack8(nu, u0);
            if (tt < 31) { ng = *(const v4u*)(hp + (size_t)(tt + 1) * NUP); nu = *(const v4u*)(hp + (size_t)(tt + 1) * NUP + 128); }
            float o[8];
#pragma unroll
            for (int e = 0; e < 8; ++e) { const float ga = bg[e] + wg[0][e] * g2[e] + wg[1][e] * g1[e] + wg[2][e] * g0[e], ua = bu[e] + wu[0][e] * u2[e] + wu[1][e] * u1[e] + wu[2][e] * u0[e];
                o[e] = ga * __builtin_amdgcn_rcpf(1.0f + __expf(-ga)) * ua; g2[e] = g1[e]; g1[e] = g0[e]; u2[e] = u1[e]; u1[e] = u0[e]; }
            v4u w; w.x = cvt2(o[0], o[1]); w.y = cvt2(o[2], o[3]); w.z = cvt2(o[4], o[5]); w.w = cvt2(o[6], o[7]);
            *(v4u*)(ap + (size_t)tt * DFF) = w;
        }
    }
}

__device__ __forceinline__ void phase_conv_fixup(const Params& P, const Ctx& cx, int l) {
    unsigned char* ws = cx.ws;
    const bf16* HALO = (const bf16*)(ws + WS_H); bf16* ACT = (bf16*)(ws + WS_ACT);
    const float* cw = P.in[11] + (size_t)l * 3 * NUP; const float* cb = P.in[12] + (size_t)l * NUP;
    const int gt = cx.bid * 512 + cx.tid, NT = cx.G * 512;
    for (int item = gt; item < 256 * 704; item += NT) {
        const int k = item / 704, r = item - k * 704, tile = r >> 4, q8 = r & 15, chg = 128 * tile + 8 * q8, chu = DFF + chg;
        float a_g[8], b_g[8], c_g[8], d_g[8], a_u[8], b_u[8], c_u[8], d_u[8];
        const bf16* hk = HALO + (size_t)k * 4 * NUP + 256 * tile + 8 * q8;
        unpack8(*(const v4u*)(hk), c_g); unpack8(*(const v4u*)(hk + NUP), d_g); unpack8(*(const v4u*)(hk + 128), c_u); unpack8(*(const v4u*)(hk + NUP + 128), d_u);
        if (k > 0) { const bf16* hm = hk - 4 * (size_t)NUP; unpack8(*(const v4u*)(hm + 2 * NUP), a_g); unpack8(*(const v4u*)(hm + 3 * NUP), b_g); unpack8(*(const v4u*)(hm + 2 * NUP + 128), a_u); unpack8(*(const v4u*)(hm + 3 * NUP + 128), b_u); }
        else {
#pragma unroll
            for (int e = 0; e < 8; ++e) { a_g[e] = 0.f; b_g[e] = 0.f; a_u[e] = 0.f; b_u[e] = 0.f; } }
        float o0[8], o1[8];
#pragma unroll
        for (int e = 0; e < 8; ++e) { const float w0g = cw[chg + e], w1g = cw[NUP + chg + e], w2g = cw[2 * NUP + chg + e], bgv = cb[chg + e], w0u = cw[chu + e], w1u = cw[NUP + chu + e], w2u = cw[2 * NUP + chu + e], buv = cb[chu + e];
            const float g0 = bgv + w0g * a_g[e] + w1g * b_g[e] + w2g * c_g[e], u0 = buv + w0u * a_u[e] + w1u * b_u[e] + w2u * c_u[e];
            const float g1 = bgv + w0g * b_g[e] + w1g * c_g[e] + w2g * d_g[e], u1 = buv + w0u * b_u[e] + w1u * c_u[e] + w2u * d_u[e];
            o0[e] = g0 * __builtin_amdgcn_rcpf(1.0f + __expf(-g0)) * u0; o1[e] = g1 * __builtin_amdgcn_rcpf(1.0f + __expf(-g1)) * u1; }
        v4u w0, w1; w0.x = cvt2(o0[0], o0[1]); w0.y = cvt2(o0[2], o0[3]); w0.z = cvt2(o0[4], o0[5]); w0.w = cvt2(o0[6], o0[7]); w1.x = cvt2(o1[0], o1[1]); w1.y = cvt2(o1[2], o1[3]); w1.z = cvt2(o1[4], o1[5]); w1.w = cvt2(o1[6], o1[7]);
        *(v4u*)(ACT + (size_t)(64 * k) * DFF + chg) = w0; *(v4u*)(ACT + (size_t)(64 * k + 1) * DFF + chg) = w1;
    }
}

#ifdef DBG_DUMP
__device__ __forceinline__ void phase_dump(const Ctx& cx, float* out, const bf16* a, int lda, const bf16* b, int ldb, const float* f) {
    const size_t gt = (size_t)cx.bid * 512 + cx.tid, NT = (size_t)cx.G * 512;
    for (size_t i = gt; i < (size_t)S * D; i += NT) { const int row = (int)(i >> 11), col = (int)(i & 2047);
        float v; if (f) v = f[i]; else if (b && col >= 1024) v = bf1(b + (size_t)row * ldb + (col - 1024)); else v = lda ? bf1(a + (size_t)row * lda + col) : bf1(a + (size_t)(row & 2047) * 2048 + col);
        out[i] = v; }
}
#endif
__global__ void __launch_bounds__(512, 2) fwd(Params P) {
    extern __shared__ __attribute__((aligned(16))) unsigned char lds_raw[];
    LAS unsigned char* lds = (LAS unsigned char*)lds_raw;
    const int wave = __builtin_amdgcn_readfirstlane(threadIdx.x >> 6), G = gridDim.x;
    unsigned char* ws = P.ws;
    volatile LAS unsigned* MISC = (volatile LAS unsigned*)(lds + MISC_OFF);
    for (int u = threadIdx.x; u < (LDS_BYTES - LDSCTL_OFF) / 4; u += 512) ((LAS unsigned*)(lds + LDSCTL_OFF))[u] = 0u;
    __syncthreads();
    const int lo = P.ph_lo, hi = P.ph_hi;
    XcdBarrier bar; bar.bar = (unsigned*)(ws + WS_CTL) + CW_BAR; bar.x = 0; bar.st = nullptr;
    if (hi - lo > 1) bar = xcd_barrier_post((unsigned*)(ws + WS_CTL) + CW_BAR, MISC + 8);
#define IN(k) (lo <= (k) && (k) < hi)
#if PROBE_DUP == 20
#define SEAM(k) do { if (IN(k) && IN((k) + 1)) { xcd_barrier(bar); xcd_barrier(bar); } } while (0)
#else
#define SEAM(k) do { if (IN(k) && IN((k) + 1)) xcd_barrier(bar); } while (0)
#endif
#define OPQ() Ctx cx; cx.lane = lane_id_asm(); { int t_ = wave; asm volatile("" : "+s"(t_)); cx.wave = t_; } { int t_ = G; asm volatile("" : "+s"(t_)); cx.G = t_; } { int t_ = blockIdx.x; asm volatile("" : "+s"(t_)); cx.bid = t_; } \
    { unsigned t_ = 0u; asm volatile("" : "+s"(t_)); cx.ws = P.ws + t_; } cx.tid = cx.wave * 64 + cx.lane; int lq = l; asm volatile("" : "+s"(lq)); (void)lq

#ifdef DBG_DUMP
    if (lo >= 1000) { const int l = 0; OPQ(); unsigned char* w = cx.ws; const int kind = lo - 1000;
        if (kind == 1) phase_dump(cx, P.out, (const bf16*)(w + WS_Q), 1024, (const bf16*)(w + WS_AQ), 1024, nullptr);
        else if (kind == 2) phase_dump(cx, P.out, (const bf16*)(w + WS_MIX), 2048, nullptr, 0, nullptr);
        else if (kind == 3) phase_dump(cx, P.out, nullptr, 0, nullptr, 0, (const float*)(w + WS_XR));
        else if (kind == 4) phase_dump(cx, P.out, (const bf16*)(w + WS_ACT), DFF, nullptr, 0, nullptr);
        else if (kind == 5) phase_dump(cx, P.out, nullptr, 0, nullptr, 0, (const float*)(w + WS_Y));
        else if (kind == 6) phase_dump(cx, P.out, (const bf16*)(w + WS_K), 1024, (const bf16*)(w + WS_V), 1024, nullptr);
        else if (kind == 7) phase_dump(cx, P.out, (const bf16*)(w + WS_XB), 2048, nullptr, 0, nullptr);
        else if (kind == 11) phase_dump(cx, P.out, (const bf16*)(w + WS_W + WL_G), 0, nullptr, 0, nullptr);
        else if (kind == 12) phase_dump(cx, P.out, (const bf16*)(w + WS_W + WL_OUT), 0, nullptr, 0, nullptr);
        else if (kind == 10) phase_dump(cx, P.out, (const bf16*)(w + WS_H) + 36 * 256, NUP, nullptr, 0, nullptr);
        else if (kind == 9) phase_dump(cx, P.out, (const bf16*)(w + WS_SG), 2048, nullptr, 0, nullptr);
        else if (kind == 8) phase_dump(cx, P.out, nullptr, 0, nullptr, 0, (const float*)(w + WS_RETY));
        return; }
#endif
    if (IN(0)) { const int l = 0; REPS(9) { __syncthreads(); OPQ(); phase_prologue(P, cx, lds); } }
    SEAM(0);

    for (int l = 0; l < DEPTH; ++l) {
        const int pb = 1 + l * NPH;
        if (IN(pb + 0)) { REPS(3) { OPQ(); unsigned char* w = cx.ws; const bf16* wl = (const bf16*)(w + WS_W + (size_t)lq * WL_BYTES);
            pg8::Gemm g{(const bf16*)(w + WS_XB), wl + WL_IN / 2, S, INW, D}; pg8::StaticOrder So; So.init(S, INW, cx.G, cx.bid);
            pg8::EpiInProj E{(bf16*)(w + WS_Q), (bf16*)(w + WS_K), (bf16*)(w + WS_V), (bf16*)(w + WS_G), (bf16*)(w + WS_AQ), (bf16*)(w + WS_AK), (bf16*)(w + WS_AV),
                             (const float*)(w + WS_COSR), (const float*)(w + WS_SINR), (const float*)(w + WS_COSA), (const float*)(w + WS_SINA)};
            pg8::gemm_phase<pg8::EpiInProj, pg8::StaticOrder, true, true>(lds, g, So, E, cx.wave);
        } }
#if PLE_EARLY
        if (IN(pb + 0)) { OPQ(); unsigned char* w = cx.ws; const bf16* wl = (const bf16*)(w + WS_W + (size_t)lq * WL_BYTES);
            const int nsub = (cx.G > 64) ? cx.G - 64 : cx.G, csub = (cx.G > 64) ? cx.bid - 64 : cx.bid;
            if (csub >= 0) {
                int kple = PLE; asm volatile("" : "+s"(kple));
                pg8::Gemm g{(const bf16*)(w + WS_PB) + (size_t)lq * S * PLE, wl + WL_P / 2, S, D, kple}; pg8::StaticOrder So; So.init(S, D, nsub, csub);
                pg8::EpiPlain E{(bf16*)(w + WS_PP)};
                pg8::gemm_phase<pg8::EpiPlain, pg8::StaticOrder, true, true>(lds, g, So, E, cx.wave); }
        }
#endif
        SEAM(pb + 0);
        if (IN(pb + 1)) {
#if RET_MFMA
            { REPS(6) { OPQ(); phase_ret_u_mfma(P, cx, lds); } }
#else
            { OPQ(); phase_ret_u_scores(P, cx, lds); }
#endif
#if SWA_MFMA
            { REPS(8) { OPQ(); phase_swa_mfma(P, cx, lq, lds); } }
#else
            { OPQ(); phase_swa(P, cx, lq, lds); }
#endif
        }
        SEAM(pb + 1);
#if RET_MFMA
        if (IN(pb + 2)) { OPQ(); phase_scan_bf16(P, cx); }
        SEAM(pb + 2);
        if (IN(pb + 3)) { REPS(7) { OPQ(); phase_ret_out_mfma(P, cx, lq, lds); } }
        SEAM(pb + 3);
#else
        if (IN(pb + 2)) { OPQ(); phase_scan(P, cx); }
        SEAM(pb + 2);
        if (IN(pb + 3)) { OPQ(); phase_ret_out(P, cx, lds); }
        SEAM(pb + 3);
        if (IN(pb + 4)) { OPQ(); phase_groupnorm(P, cx, lq); }
        SEAM(pb + 4);
#endif
        if (IN(pb + 5)) { OPQ(); unsigned char* w = cx.ws; const bf16* wl = (const bf16*)(w + WS_W + (size_t)lq * WL_BYTES);
            pg8::Gemm g{(const bf16*)(w + WS_MIX), wl + WL_OUT / 2, S, D, D}; pg8::StaticOrder So; So.init(S, D, cx.G, cx.bid);
#if LN_NOXR
            if (lq == 0) { pg8::EpiResid<false> E{P.in[0], (float*)(w + WS_Y), ALPHA};
                pg8::gemm_phase<pg8::EpiResid<false>, pg8::StaticOrder, true, true>(lds, g, So, E, cx.wave); }
            else { pg8::EpiResidLN<false> E{(float*)(w + WS_Y), (const float*)(w + WS_ST2), P.in[14] + (lq - 1) * D, P.in[15] + (lq - 1) * D, nullptr, nullptr, ALPHA};
                pg8::gemm_phase<pg8::EpiResidLN<false>, pg8::StaticOrder, true, true>(lds, g, So, E, cx.wave); }
#else
            pg8::EpiResid<false> E{(lq == 0) ? P.in[0] : (const float*)(w + WS_XR), (float*)(w + WS_Y), ALPHA};
            pg8::gemm_phase<pg8::EpiResid<false>, pg8::StaticOrder, true, true>(lds, g, So, E, cx.wave);
#endif
        }
        SEAM(pb + 5);
        if (IN(pb + 6)) { REPS(1) { OPQ(); unsigned char* w = cx.ws;
#if LN_NOXR
            phase_ln(cx, (const float*)(w + WS_Y), P.in[8] + lq * D, P.in[9] + lq * D, (float*)nullptr, (bf16*)(w + WS_XB), (float*)(w + WS_ST1));
#else
            phase_ln(cx, (const float*)(w + WS_Y), P.in[8] + lq * D, P.in[9] + lq * D, (float*)(w + WS_XR), (bf16*)(w + WS_XB), (float*)nullptr);
#endif
        } }
        SEAM(pb + 6);
        if (IN(pb + 7)) { REPS(5) { OPQ(); unsigned char* w = cx.ws; const bf16* wl = (const bf16*)(w + WS_W + (size_t)lq * WL_BYTES);
            pg8::Gemm g{(const bf16*)(w + WS_XB), wl + WL_UP / 2, S, NUPG, D}; pg8::StaticOrder So; So.init(S, NUPG, cx.G, cx.bid);
#if CONV_FUSED
            pg8::EpiUpConv E{(bf16*)(w + WS_ACT), (bf16*)(w + WS_H), (bf16*)(w + WS_SG), P.in[17] + lq * D, P.in[11] + (size_t)lq * 3 * NUP, P.in[12] + (size_t)lq * NUP};
            pg8::gemm_phase<pg8::EpiUpConv, pg8::StaticOrder, true, true>(lds, g, So, E, cx.wave);
#else
            pg8::EpiUp E{(bf16*)(w + WS_H), (bf16*)(w + WS_SG), P.in[17] + lq * D};
            pg8::gemm_phase<pg8::EpiUp, pg8::StaticOrder, true, true>(lds, g, So, E, cx.wave);
#endif
        } }
        SEAM(pb + 7);
        if (IN(pb + 8)) {
#if !PLE_EARLY
            { OPQ(); unsigned char* w = cx.ws; const bf16* wl = (const bf16*)(w + WS_W + (size_t)lq * WL_BYTES);
              pg8::Gemm g{(const bf16*)(w + WS_PB) + (size_t)lq * S * PLE, wl + WL_P / 2, S, D, PLE}; pg8::StaticOrder So; So.init(S, D, cx.G, cx.bid);
              pg8::EpiPle E{(const bf16*)(w + WS_SG), (float*)(w + WS_Y)};
              pg8::gemm_phase<pg8::EpiPle, pg8::StaticOrder, true, true>(lds, g, So, E, cx.wave); }
#endif
#if CONV_FUSED
            { OPQ(); phase_conv_fixup(P, cx, lq); }
#else
            { REPS(1) { OPQ(); phase_convact(P, cx, lq); } }
#endif
        }
        SEAM(pb + 8);
        if (IN(pb + 9)) { OPQ(); unsigned char* w = cx.ws; const bf16* wl = (const bf16*)(w + WS_W + (size_t)lq * WL_BYTES);
            pg8::Gemm g{(const bf16*)(w + WS_ACT), wl + WL_DOWN / 2, S, D, DFF}; pg8::StaticOrder So; So.init(S, D, cx.G, cx.bid);
#if PLE_EARLY
#if LN_NOXR
            pg8::EpiResidLN<true> E{(float*)(w + WS_Y), (const float*)(w + WS_ST1), P.in[8] + lq * D, P.in[9] + lq * D, (const bf16*)(w + WS_PP), (const bf16*)(w + WS_SG), ALPHA};
            pg8::gemm_phase<pg8::EpiResidLN<true>, pg8::StaticOrder, true, true>(lds, g, So, E, cx.wave);
#else
            pg8::EpiDown E{(const float*)(w + WS_XR), (float*)(w + WS_Y), (const bf16*)(w + WS_PP), (const bf16*)(w + WS_SG), ALPHA};
            pg8::gemm_phase<pg8::EpiDown, pg8::StaticOrder, true, true>(lds, g, So, E, cx.wave);
#endif
#else
            pg8::EpiResid<true> E{(const float*)(w + WS_XR), (float*)(w + WS_Y), ALPHA};
            pg8::gemm_phase<pg8::EpiResid<true>, pg8::StaticOrder, true, true>(lds, g, So, E, cx.wave);
#endif
        }
        SEAM(pb + 9);
        if (IN(pb + 10)) { REPS(1) { OPQ(); unsigned char* w = cx.ws; const bool last = (lq == DEPTH - 1);

#if LN_NOXR
            phase_ln(cx, (const float*)(w + WS_Y), P.in[14] + lq * D, P.in[15] + lq * D, last ? P.out : (float*)nullptr, last ? (bf16*)nullptr : (bf16*)(w + WS_XB), last ? (float*)nullptr : (float*)(w + WS_ST2));
#else
            phase_ln(cx, (const float*)(w + WS_Y), P.in[14] + lq * D, P.in[15] + lq * D, last ? P.out : (float*)(w + WS_XR), last ? (bf16*)nullptr : (bf16*)(w + WS_XB), (float*)nullptr);
#endif
        } }
        SEAM(pb + 10);
    }
#undef IN
#undef SEAM
}

extern "C" void kernel_launch(void* const* d_in, const int* in_sizes, int n_in, void* d_out, int out_size, void* d_ws, size_t ws_size, hipStream_t stream) {
    static int grid = 0;
    if (grid == 0) {
        if (n_in != 19 || in_sizes[0] != S * D || out_size != S * D || ws_size < WS_END) { fprintf(stderr, "kernel_launch: unexpected shapes (n_in %d, in0 %d, out %d, ws %zu)\n", n_in, n_in > 0 ? in_sizes[0] : -1, out_size, ws_size); grid = -1; return; }
        int dev = 0, cus = 0, per_cu = 0;
        if (hipGetDevice(&dev) != hipSuccess || hipDeviceGetAttribute(&cus, hipDeviceAttributeMultiprocessorCount, dev) != hipSuccess) { grid = -1; return; }
        if (hipFuncSetAttribute((const void*)fwd, hipFuncAttributeMaxDynamicSharedMemorySize, LDS_BYTES) != hipSuccess) { fprintf(stderr, "kernel_launch: hipFuncSetAttribute failed\n"); grid = -1; return; }
        if (hipOccupancyMaxActiveBlocksPerMultiprocessor(&per_cu, (const void*)fwd, 512, LDS_BYTES) != hipSuccess || per_cu < 1) fprintf(stderr, "kernel_launch: occupancy query says %d\n", per_cu);
        (void)hipGetLastError();
        grid = cus;
    }
    if (grid < 0) return;
    (void)hipMemsetAsync((char*)d_ws + WS_CTL, 0, CTL_ZERO_BYTES, stream);
#ifdef DBG_NANFILL
    (void)hipMemsetAsync((char*)d_ws + CTL_ZERO_BYTES, 0xFF, WS_END - CTL_ZERO_BYTES, stream);
#endif
    Params p{};
    for (int i = 0; i < 19; ++i) p.in[i] = (const float*)d_in[i];
    p.out = (float*)d_out; p.ws = (unsigned char*)d_ws;
    for (int f = 0; f < 128; ++f) p.invf_ret[f] = (float)(1.0 / std::pow(10000.0, (double)((float)f / 127.0f)));
    for (int f = 0; f < 32; ++f) p.invf_att[f] = (float)std::pow(10000.0, -(double)(2 * f) / 64.0);
    for (int h = 0; h < 4; ++h) p.lg2g[h] = (float)std::log2(1.0 - std::exp2(-5.0 - h));
#if MK_ONE_LAUNCH
    p.ph_lo = 0; p.ph_hi = NPHASES;
    hipLaunchKernelGGL(fwd, dim3(grid), dim3(512), LDS_BYTES, stream, p);
#else
#ifdef DBG_DUMP
    for (int ph = 0; ph <= DBG_STOP; ++ph) { p.ph_lo = ph; p.ph_hi = ph + 1; hipLaunchKernelGGL(fwd, dim3(grid), dim3(512), LDS_BYTES, stream, p); }
    p.ph_lo = 1000 + DBG_DUMP; p.ph_hi = p.ph_lo + 1; hipLaunchKernelGGL(fwd, dim3(grid), dim3(512), LDS_BYTES, stream, p);
#else
    for (int ph = 0; ph < NPHASES; ++ph) { p.ph_lo = ph; p.ph_hi = ph + 1; hipLaunchKernelGGL(fwd, dim3(grid), dim3(512), LDS_BYTES, stream, p); }
#endif
#endif
}
```

```cpp
#include <hip/hip_runtime.h>
#include <cstdio>
#include <cstdint>
#include <cmath>
#define MK_ONE_LAUNCH 1
namespace pg8 {
#define PG8_LAS __attribute__((address_space(3)))
typedef unsigned short bf16_t;
typedef short bf16x8 __attribute__((ext_vector_type(8)));
typedef float f32x4 __attribute__((ext_vector_type(4)));
typedef unsigned u32x4 __attribute__((ext_vector_type(4)));
constexpr int BM = 256, BK = 64, HALF = 128, HTB = HALF * BK * 2  , STAGE_BYTES = 8 * HTB, NXCD = 8, WGM = 8;

__host__ __device__ __forceinline__ int lds_byte(int r, int c) { const int st = (r >> 4) * 2 + (c >> 5), rr = r & 15, cc = c & 31, ob = rr * 64 + cc * 2; return st * 1024 + (ob ^ (((ob >> 9) & 1) << 5)); }
__host__ __device__ __forceinline__ void stage_rc(int b, int& R, int& C) { const int st = b / 1024, sb = b % 1024, swz = sb ^ (((sb >> 9) & 1) << 5); R = (st >> 1) * 16 + swz / 64; C = (st & 1) * 32 + (swz % 64) / 2; }
__host__ __device__ __forceinline__ int perm32(int rho) { const int n = rho >> 4, i = rho & 15; return 8 * (i >> 2) + 4 * n + (i & 3); }

struct Unit { int pm, pn; };
struct Gemm { const bf16_t* A; const bf16_t* Bt; int M, N, K; int lda, ldb; int tiledA, tiledB; };

struct StaticOrder {
    int nM, nN, nwg, G, c;
    __host__ __device__ void init(int M, int N, int G_, int c_) { nM = M / BM; nN = N / BM; nwg = nM * nN; G = G_; c = c_; }
    __host__ __device__ bool next(int i, Unit& u) const {
        const long L = (long)i * G + c; if (L >= nwg) return false;
        int wgid = (int)L; { const int q = nwg / NXCD, r = nwg % NXCD, xcd = wgid % NXCD, off = wgid / NXCD; wgid = (xcd < r ? xcd * (q + 1) : r * (q + 1) + (xcd - r) * q) + off; }
        const int nig = WGM * nN, gid = wgid / nig, fm = gid * WGM, gsz = (nM - fm) < WGM ? (nM - fm) : WGM;
        u.pm = fm + ((wgid % nig) % gsz); u.pn = (wgid % nig) / gsz; return true;
    }
    __device__ __forceinline__ void a_ready(const Unit&) const {}
    __device__ __forceinline__ void done(const Unit&) const {}
};

typedef float f32x2c_t __attribute__((ext_vector_type(2))); typedef __bf16 bf16x2c_t __attribute__((ext_vector_type(2)));
__device__ __forceinline__ unsigned cvt_pk_bf16(float lo, float hi) { f32x2c_t v = {lo, hi}; bf16x2c_t b = __builtin_convertvector(v, bf16x2c_t); return __builtin_bit_cast(unsigned, b); }
typedef float f32x2 __attribute__((ext_vector_type(2)));
typedef unsigned u32x2 __attribute__((ext_vector_type(2)));
__host__ __device__ __forceinline__ size_t tiled_off(int row, int col, int K) { return ((size_t)((row >> 8) * (K >> 6) + (col >> 6)) * 256 + (row & 255)) * 64 + (col & 63); }
#ifndef EPI_NT
#define EPI_NT 0
#endif
template <class T> __device__ __forceinline__ void st_out(T* p, const T v) {
#if EPI_NT
    __builtin_nontemporal_store(v, p);
#else
    *p = v;
#endif
}

__device__ __forceinline__ float bf2f(unsigned short b) { return __uint_as_float(((unsigned)b) << 16); }
__device__ __forceinline__ u32x4 pack8(const f32x4 a, const f32x4 b) { u32x4 w; w.x = cvt_pk_bf16(a[0], a[1]); w.y = cvt_pk_bf16(a[2], a[3]); w.z = cvt_pk_bf16(b[0], b[1]); w.w = cvt_pk_bf16(b[2], b[3]); return w; }
__device__ __forceinline__ float sigmoidf_(float x) { return __builtin_amdgcn_rcpf(1.0f + __expf(-x)); }

struct EpiInProj {
    static constexpr bool PERM = true, AFTER_DRAIN = false;
    bf16_t *Q, *K, *V, *G, *AQ, *AK, *AV; const float *cosr, *sinr, *cosa, *sina;
    __device__ __forceinline__ void operator()(const f32x4 (&acc)[2][2][4][2], const Unit& u, int wr, int wc, int fr, int fq) const {
        const int row0 = u.pm * BM + wr * 64 + fr, pn = u.pn, cw = wc * 32 + 8 * fq;
        if (pn < 8) {
            bf16_t* O = pn < 4 ? Q : K; const int hcol = (pn & 3) * 256; const float sc = pn < 4 ? 1.0f : 0.0625f;
#pragma unroll
            for (int ai = 0; ai < 2; ++ai)
#pragma unroll
                for (int m = 0; m < 4; ++m) { const int row = row0 + ai * HALF + m * 16;
                    const f32x4 c0 = *(const f32x4*)(cosr + (size_t)row * 128 + cw), c1 = *(const f32x4*)(cosr + (size_t)row * 128 + cw + 4);
                    const f32x4 s0 = *(const f32x4*)(sinr + (size_t)row * 128 + cw), s1 = *(const f32x4*)(sinr + (size_t)row * 128 + cw + 4);
                    const f32x4 a0 = acc[ai][0][m][0], a1 = acc[ai][0][m][1], b0 = acc[ai][1][m][0], b1 = acc[ai][1][m][1];
                    const f32x4 o10 = (a0 * c0 - b0 * s0) * sc, o11 = (a1 * c1 - b1 * s1) * sc, o20 = (a0 * s0 + b0 * c0) * sc, o21 = (a1 * s1 + b1 * c1) * sc;
                    bf16_t* rowp = O + (size_t)row * 1024 + hcol + cw;
                    st_out((u32x4*)(rowp), (u32x4)(pack8(o10, o11))); st_out((u32x4*)(rowp + HALF), (u32x4)(pack8(o20, o21))); }
        } else if (pn < 16) {
            const bool gate = pn >= 12; bf16_t* O = gate ? G : V; const int hcol = (pn & 3) * 256;
#pragma unroll
            for (int ai = 0; ai < 2; ++ai)
#pragma unroll
                for (int m = 0; m < 4; ++m) { const int row = row0 + ai * HALF + m * 16; bf16_t* rowp = O + (size_t)row * 1024 + hcol + cw;
#pragma unroll
                    for (int bj = 0; bj < 2; ++bj) { f32x4 v0 = acc[ai][bj][m][0], v1 = acc[ai][bj][m][1];
                        if (gate) {
#pragma unroll
                            for (int j = 0; j < 4; ++j) { v0[j] = v0[j] * sigmoidf_(v0[j]); v1[j] = v1[j] * sigmoidf_(v1[j]); } }
                        st_out((u32x4*)(rowp + bj * HALF), (u32x4)(pack8(v0, v1))); } }
        } else if (pn < 20) {
            const int t = pn - 16, i0 = 8 * fq;
#pragma unroll
            for (int ai = 0; ai < 2; ++ai)
#pragma unroll
                for (int m = 0; m < 4; ++m) { const int row = row0 + ai * HALF + m * 16;
                    const f32x4 c0 = *(const f32x4*)(cosa + (size_t)row * 32 + i0), c1 = *(const f32x4*)(cosa + (size_t)row * 32 + i0 + 4);
                    const f32x4 s0 = *(const f32x4*)(sina + (size_t)row * 32 + i0), s1 = *(const f32x4*)(sina + (size_t)row * 32 + i0 + 4);
                    const f32x4 a0 = acc[ai][0][m][0], a1 = acc[ai][0][m][1], b0 = acc[ai][1][m][0], b1 = acc[ai][1][m][1];
                    const f32x4 o10 = (a0 * c0 - b0 * s0) * 0.125f, o11 = (a1 * c1 - b1 * s1) * 0.125f, o20 = (a0 * s0 + b0 * c0) * 0.125f, o21 = (a1 * s1 + b1 * c1) * 0.125f;
                    bf16_t* rowp = AQ + (size_t)row * 1024 + t * 256 + wc * 64 + i0;
                    st_out((u32x4*)(rowp), (u32x4)(pack8(o10, o11))); st_out((u32x4*)(rowp + 32), (u32x4)(pack8(o20, o21))); }
        } else {
            const int i0 = 8 * fq;
            if (wc < 2) {
#pragma unroll
                for (int ai = 0; ai < 2; ++ai)
#pragma unroll
                    for (int m = 0; m < 4; ++m) { const int row = row0 + ai * HALF + m * 16;
                        const f32x4 c0 = *(const f32x4*)(cosa + (size_t)row * 32 + i0), c1 = *(const f32x4*)(cosa + (size_t)row * 32 + i0 + 4);
                        const f32x4 s0 = *(const f32x4*)(sina + (size_t)row * 32 + i0), s1 = *(const f32x4*)(sina + (size_t)row * 32 + i0 + 4);
                        const f32x4 a0 = acc[ai][0][m][0], a1 = acc[ai][0][m][1], b0 = acc[ai][1][m][0], b1 = acc[ai][1][m][1];
                        const f32x4 o10 = a0 * c0 - b0 * s0, o11 = a1 * c1 - b1 * s1, o20 = a0 * s0 + b0 * c0, o21 = a1 * s1 + b1 * c1;
                        bf16_t* rowp = AK + (size_t)row * 128 + wc * 64 + i0;
                        st_out((u32x4*)(rowp), (u32x4)(pack8(o10, o11))); st_out((u32x4*)(rowp + 32), (u32x4)(pack8(o20, o21))); }
            } else {
#pragma unroll
                for (int ai = 0; ai < 2; ++ai)
#pragma unroll
                    for (int m = 0; m < 4; ++m) { const int row = row0 + ai * HALF + m * 16; bf16_t* rowp = AV + (size_t)row * 128 + (wc - 2) * 32 + i0;
                        st_out((u32x4*)(rowp), (u32x4)(pack8(acc[ai][0][m][0], acc[ai][0][m][1]))); st_out((u32x4*)(rowp + 64), (u32x4)(pack8(acc[ai][1][m][0], acc[ai][1][m][1]))); }
            }
        }
    }
};
template <bool ADD> struct EpiResid {
    static constexpr bool PERM = false, AFTER_DRAIN = false;
    const float* base; float* Y; float alpha;
    __device__ __forceinline__ void operator()(const f32x4 (&acc)[2][2][4][2], const Unit& u, int wr, int wc, int fr, int fq) const {
        const int row0 = u.pm * BM + wr * 64 + fr, col0 = u.pn * BM + wc * 32 + 4 * fq;
#pragma unroll
        for (int ai = 0; ai < 2; ++ai)
#pragma unroll
            for (int m = 0; m < 4; ++m) { const size_t off = (size_t)(row0 + ai * HALF + m * 16) * 2048 + col0;
#pragma unroll
                for (int bj = 0; bj < 2; ++bj)
#pragma unroll
                    for (int n = 0; n < 2; ++n) { const size_t o = off + bj * HALF + n * 16; f32x4 v = acc[ai][bj][m][n] + *(const f32x4*)(base + o) * alpha;
                        if (ADD) v = v + *(const f32x4*)(Y + o); st_out((f32x4*)(Y + o), (f32x4)(v)); } }
    }
};
struct EpiUp {
    static constexpr bool PERM = true, AFTER_DRAIN = false;
    bf16_t* H; bf16_t* SG; const float* bgate;
    __device__ __forceinline__ void operator()(const f32x4 (&acc)[2][2][4][2], const Unit& u, int wr, int wc, int fr, int fq) const {
        const int row0 = u.pm * BM + wr * 64 + fr, cw = wc * 32 + 8 * fq;
        if (u.pn < 44) {
#pragma unroll
            for (int ai = 0; ai < 2; ++ai)
#pragma unroll
                for (int m = 0; m < 4; ++m) { bf16_t* rowp = H + (size_t)(row0 + ai * HALF + m * 16) * 11264 + u.pn * 256 + cw;
#pragma unroll
                    for (int bj = 0; bj < 2; ++bj) st_out((u32x4*)(rowp + bj * HALF), (u32x4)(pack8(acc[ai][bj][m][0], acc[ai][bj][m][1]))); }
        } else {
            const int colg = (u.pn - 44) * 256 + cw;
            f32x4 bv[2][2];
#pragma unroll
            for (int bj = 0; bj < 2; ++bj)
#pragma unroll
                for (int n = 0; n < 2; ++n) bv[bj][n] = *(const f32x4*)(bgate + colg + bj * HALF + 4 * n);
#pragma unroll
            for (int ai = 0; ai < 2; ++ai)
#pragma unroll
                for (int m = 0; m < 4; ++m) { bf16_t* rowp = SG + (size_t)(row0 + ai * HALF + m * 16) * 2048 + colg;
#pragma unroll
                    for (int bj = 0; bj < 2; ++bj) { f32x4 v0 = acc[ai][bj][m][0] + bv[bj][0], v1 = acc[ai][bj][m][1] + bv[bj][1];
#pragma unroll
                        for (int j = 0; j < 4; ++j) { v0[j] = sigmoidf_(v0[j]); v1[j] = sigmoidf_(v1[j]); }
                        st_out((u32x4*)(rowp + bj * HALF), (u32x4)(pack8(v0, v1))); } }
        }
    }
};

__device__ __forceinline__ float ror1f(float x) { return __builtin_bit_cast(float, __builtin_amdgcn_update_dpp(0, __builtin_bit_cast(int, x), 0x121, 0xf, 0xf, false)); }
__device__ __forceinline__ float ror2f(float x) { return __builtin_bit_cast(float, __builtin_amdgcn_update_dpp(0, __builtin_bit_cast(int, x), 0x122, 0xf, 0xf, false)); }
struct EpiUpConv {
    static constexpr bool PERM = true, AFTER_DRAIN = false;
    bf16_t* ACT; bf16_t* HALO; bf16_t* SG; const float* bgate; const float* cw; const float* cb;
    __device__ __forceinline__ void operator()(const f32x4 (&acc)[2][2][4][2], const Unit& u, int wr, int wc, int fr, int fq) const {
        const int row0 = u.pm * BM + wr * 64 + fr, cwp = wc * 32 + 8 * fq;
        if (u.pn < 44) {
            f32x4 wg0_[2], wg1_[2], wg2_[2], bg_[2], wu0_[2], wu1_[2], wu2_[2], bu_[2];
#pragma unroll
            for (int n = 0; n < 2; ++n) { const int chg = 128 * u.pn + cwp + 4 * n, chu = 5632 + chg;
                wg0_[n] = *(const f32x4*)(cw + chg); wg1_[n] = *(const f32x4*)(cw + 11264 + chg); wg2_[n] = *(const f32x4*)(cw + 2 * 11264 + chg); bg_[n] = *(const f32x4*)(cb + chg);
                wu0_[n] = *(const f32x4*)(cw + chu); wu1_[n] = *(const f32x4*)(cw + 11264 + chu); wu2_[n] = *(const f32x4*)(cw + 2 * 11264 + chu); bu_[n] = *(const f32x4*)(cb + chu); }
#pragma unroll
            for (int ai = 0; ai < 2; ++ai) {
                const int span = u.pm * 4 + ai * 2 + wr;
#pragma unroll
                for (int m = 0; m < 4; ++m) {
                    const int row = row0 + ai * HALF + m * 16;
                    u32x4 w, rg, ru;
#pragma unroll
                    for (int n = 0; n < 2; ++n) {
                        const f32x4 wg0 = wg0_[n], wg1 = wg1_[n], wg2 = wg2_[n], bg = bg_[n], wu0 = wu0_[n], wu1 = wu1_[n], wu2 = wu2_[n], bu = bu_[n];
                        const f32x4 cg = acc[ai][0][m][n], cu = acc[ai][1][m][n];
                        const f32x4 pg = acc[ai][0][m ? m - 1 : 0][n], pu = acc[ai][1][m ? m - 1 : 0][n];
                        f32x4 o;
#pragma unroll
                        for (int j = 0; j < 4; ++j) {
                            const float g1 = ror1f(fr == 15 ? pg[j] : cg[j]), g2 = ror2f(fr >= 14 ? pg[j] : cg[j]);
                            const float u1 = ror1f(fr == 15 ? pu[j] : cu[j]), u2 = ror2f(fr >= 14 ? pu[j] : cu[j]);
                            const float ga = bg[j] + wg0[j] * g2 + wg1[j] * g1 + wg2[j] * cg[j], ua = bu[j] + wu0[j] * u2 + wu1[j] * u1 + wu2[j] * cu[j];
                            o[j] = ga * sigmoidf_(ga) * ua; }
                        if (n == 0) { w.x = cvt_pk_bf16(o[0], o[1]); w.y = cvt_pk_bf16(o[2], o[3]); rg.x = cvt_pk_bf16(cg[0], cg[1]); rg.y = cvt_pk_bf16(cg[2], cg[3]); ru.x = cvt_pk_bf16(cu[0], cu[1]); ru.y = cvt_pk_bf16(cu[2], cu[3]); }
                        else { w.z = cvt_pk_bf16(o[0], o[1]); w.w = cvt_pk_bf16(o[2], o[3]); rg.z = cvt_pk_bf16(cg[0], cg[1]); rg.w = cvt_pk_bf16(cg[2], cg[3]); ru.z = cvt_pk_bf16(cu[0], cu[1]); ru.w = cvt_pk_bf16(cu[2], cu[3]); }
                    }
                    if (m > 0 || fr >= 2) st_out((u32x4*)(ACT + tiled_off(row, 128 * u.pn + cwp, 5632)), (u32x4)(w));
                    if ((m == 0 && fr < 2) || (m == 3 && fr >= 14)) { const int slot = (m == 0) ? fr : fr - 12;
                        bf16_t* hp = HALO + ((size_t)(span * 4 + slot)) * 11264 + 256 * u.pn + cwp;
                        st_out((u32x4*)(hp), (u32x4)(rg)); st_out((u32x4*)(hp + HALF), (u32x4)(ru)); }
                }
            }
        } else {
            const int colg = (u.pn - 44) * 256 + cwp;
            f32x4 bv[2][2];
#pragma unroll
            for (int bj = 0; bj < 2; ++bj)
#pragma unroll
                for (int n = 0; n < 2; ++n) bv[bj][n] = *(const f32x4*)(bgate + colg + bj * HALF + 4 * n);
#pragma unroll
            for (int ai = 0; ai < 2; ++ai)
#pragma unroll
                for (int m = 0; m < 4; ++m) { bf16_t* rowp = SG + (size_t)(row0 + ai * HALF + m * 16) * 2048 + colg;
#pragma unroll
                    for (int bj = 0; bj < 2; ++bj) { f32x4 v0 = acc[ai][bj][m][0] + bv[bj][0], v1 = acc[ai][bj][m][1] + bv[bj][1];
#pragma unroll
                        for (int j = 0; j < 4; ++j) { v0[j] = sigmoidf_(v0[j]); v1[j] = sigmoidf_(v1[j]); }
                        st_out((u32x4*)(rowp + bj * HALF), (u32x4)(pack8(v0, v1))); } }
        }
    }
};

struct EpiPlain {
    static constexpr bool PERM = true, AFTER_DRAIN = false;
    bf16_t* O;
    __device__ __forceinline__ void operator()(const f32x4 (&acc)[2][2][4][2], const Unit& u, int wr, int wc, int fr, int fq) const {
        const int row0 = u.pm * BM + wr * 64 + fr, cwp = u.pn * BM + wc * 32 + 8 * fq;
#pragma unroll
        for (int ai = 0; ai < 2; ++ai)
#pragma unroll
            for (int m = 0; m < 4; ++m) { bf16_t* rowp = O + (size_t)(row0 + ai * HALF + m * 16) * 2048 + cwp;
#pragma unroll
                for (int bj = 0; bj < 2; ++bj) st_out((u32x4*)(rowp + bj * HALF), (u32x4)(pack8(acc[ai][bj][m][0], acc[ai][bj][m][1]))); }
    }
};
struct EpiDown {
    static constexpr bool PERM = false, AFTER_DRAIN = false;
    const float* base; float* Y; const bf16_t* PP; const bf16_t* SG; float alpha;
    __device__ __forceinline__ void operator()(const f32x4 (&acc)[2][2][4][2], const Unit& u, int wr, int wc, int fr, int fq) const {
        const int row0 = u.pm * BM + wr * 64 + fr, col0 = u.pn * BM + wc * 32 + 4 * fq;
#pragma unroll
        for (int ai = 0; ai < 2; ++ai)
#pragma unroll
            for (int m = 0; m < 4; ++m) { const size_t off = (size_t)(row0 + ai * HALF + m * 16) * 2048 + col0;
#pragma unroll
                for (int bj = 0; bj < 2; ++bj)
#pragma unroll
                    for (int n = 0; n < 2; ++n) { const size_t o = off + bj * HALF + n * 16; const u32x2 pp = *(const u32x2*)(PP + o), sg = *(const u32x2*)(SG + o);
                        f32x4 pl; pl[0] = __uint_as_float(pp.x << 16) * __uint_as_float(sg.x << 16); pl[1] = __uint_as_float(pp.x & 0xffff0000u) * __uint_as_float(sg.x & 0xffff0000u);
                        pl[2] = __uint_as_float(pp.y << 16) * __uint_as_float(sg.y << 16); pl[3] = __uint_as_float(pp.y & 0xffff0000u) * __uint_as_float(sg.y & 0xffff0000u);
                        st_out((f32x4*)(Y + o), (f32x4)(acc[ai][bj][m][n] + *(const f32x4*)(base + o) * alpha + pl)); } }
    }
};

template <bool PLE_> struct EpiResidLN {
    static constexpr bool PERM = false, AFTER_DRAIN = false;
    float* Y; float* Yout; const float* stats; const float* g; const float* b; const bf16_t* PP; const bf16_t* SG; float alpha;
    __device__ __forceinline__ void operator()(const f32x4 (&acc)[2][2][4][2], const Unit& u, int wr, int wc, int fr, int fq) const {
        const int row0 = u.pm * BM + wr * 64 + fr, col0 = u.pn * BM + wc * 32 + 4 * fq;
        f32x4 g4[2][2], b4[2][2];
#pragma unroll
        for (int bj = 0; bj < 2; ++bj)
#pragma unroll
            for (int n = 0; n < 2; ++n) { g4[bj][n] = *(const f32x4*)(g + col0 + bj * HALF + n * 16) * alpha; b4[bj][n] = *(const f32x4*)(b + col0 + bj * HALF + n * 16) * alpha; }
        f32x4 cy[2][2], ny[2][2]; f32x2 cst, nst;
        { const size_t off = (size_t)row0 * 2048 + col0; cst = *(const f32x2*)(stats + 2 * (size_t)row0);
#pragma unroll
          for (int bj = 0; bj < 2; ++bj)
#pragma unroll
              for (int n = 0; n < 2; ++n) cy[bj][n] = *(const f32x4*)(Y + off + bj * HALF + n * 16); }
#pragma unroll
        for (int i = 0; i < 8; ++i) { const int ai = i >> 2, m = i & 3; const size_t off = (size_t)(row0 + ai * HALF + m * 16) * 2048 + col0;
            if (i < 7) { const int rn = row0 + ((i + 1) >> 2) * HALF + ((i + 1) & 3) * 16; const size_t offn = (size_t)rn * 2048 + col0; nst = *(const f32x2*)(stats + 2 * (size_t)rn);
#pragma unroll
                for (int bj = 0; bj < 2; ++bj)
#pragma unroll
                    for (int n = 0; n < 2; ++n) ny[bj][n] = *(const f32x4*)(Y + offn + bj * HALF + n * 16); }
#pragma unroll
            for (int bj = 0; bj < 2; ++bj)
#pragma unroll
                for (int n = 0; n < 2; ++n) { const size_t o = off + bj * HALF + n * 16;
                    f32x4 v = acc[ai][bj][m][n] + (cy[bj][n] - cst.x) * cst.y * g4[bj][n] + b4[bj][n];
                    if (PLE_) { const u32x2 pp = *(const u32x2*)(PP + o), sg = *(const u32x2*)(SG + o);
                        v[0] += __uint_as_float(pp.x << 16) * __uint_as_float(sg.x << 16); v[1] += __uint_as_float(pp.x & 0xffff0000u) * __uint_as_float(sg.x & 0xffff0000u);
                        v[2] += __uint_as_float(pp.y << 16) * __uint_as_float(sg.y << 16); v[3] += __uint_as_float(pp.y & 0xffff0000u) * __uint_as_float(sg.y & 0xffff0000u); }
                    st_out((f32x4*)(Yout + o), (f32x4)(v)); }
#pragma unroll
            for (int bj = 0; bj < 2; ++bj)
#pragma unroll
                for (int n = 0; n < 2; ++n) cy[bj][n] = ny[bj][n];
            cst = nst; }
    }
};
struct EpiPle {
    static constexpr bool PERM = false, AFTER_DRAIN = false;
    const bf16_t* SG; float* Y;
    __device__ __forceinline__ void operator()(const f32x4 (&acc)[2][2][4][2], const Unit& u, int wr, int wc, int fr, int fq) const {
        const int row0 = u.pm * BM + wr * 64 + fr, col0 = u.pn * BM + wc * 32 + 4 * fq;
#pragma unroll
        for (int ai = 0; ai < 2; ++ai)
#pragma unroll
            for (int m = 0; m < 4; ++m) { const size_t off = (size_t)(row0 + ai * HALF + m * 16) * 2048 + col0;
#pragma unroll
                for (int bj = 0; bj < 2; ++bj)
#pragma unroll
                    for (int n = 0; n < 2; ++n) { const size_t o = off + bj * HALF + n * 16; const u32x2 sg = *(const u32x2*)(SG + o);
                        f32x4 g; g[0] = __uint_as_float(sg.x << 16); g[1] = __uint_as_float(sg.x & 0xffff0000u); g[2] = __uint_as_float(sg.y << 16); g[3] = __uint_as_float(sg.y & 0xffff0000u);
                        st_out((f32x4*)(Y + o), (f32x4)(acc[ai][bj][m][n] * g)); } }
    }
};
template <class Epi, class Sched, bool ALIGN_EPI = false, bool SP2 = false>
__device__ __forceinline__ void gemm_phase(PG8_LAS unsigned char* lds, const Gemm g, const Sched& S, const Epi& E, const int wid_in) {
    int lane_; asm volatile("v_mbcnt_lo_u32_b32 %0, -1, 0\n\tv_mbcnt_hi_u32_b32 %0, -1, %0" : "=v"(lane_)); const int wid = wid_in, lane = lane_, tid = wid * 64 + lane, wr = wid >> 2, wc = wid & 3, fr = lane & 15, fq = lane >> 4;
    const int K = g.K, nt = K / BK, lda = g.tiledA ? BK : (g.lda ? g.lda : K), ldb = g.tiledB ? BK : (g.ldb ? g.ldb : K);
    unsigned voffA[2], voffB[2];
#pragma unroll
    for (int i = 0; i < 2; ++i) { int R, C; stage_rc(tid * 16 + i * 8192, R, C); const int Rb = Epi::PERM ? ((R & ~31) + perm32(R & 31)) : R;
        voffA[i] = (unsigned)(R * lda + C) * 2u; voffB[i] = (unsigned)(Rb * ldb + C) * 2u; }
    const size_t kstepA = g.tiledA ? (size_t)BM * BK * 2 : (size_t)(BK * 2), kstepB = g.tiledB ? (size_t)BM * BK * 2 : (size_t)(BK * 2);
    const size_t hstepA = (size_t)HALF * lda * 2, hstepB = (size_t)HALF * ldb * 2;
    const size_t tstepA = g.tiledA ? (size_t)BM * K * 2 : 2 * hstepA, tstepB = g.tiledB ? (size_t)BM * K * 2 : 2 * hstepB;
    const unsigned ldsw = (unsigned)wid * 1024u;
    const int aoff = lds_byte(wr * 64 + fr, fq * 8), boff = lds_byte(wc * 32 + fr, fq * 8);
#define PG8_SA(b, h) (((b) * 2 + (h)) * HTB)
#define PG8_SB(b, h) ((4 + (b) * 2 + (h)) * HTB)
#define PG8_STAGE(bufoff, gbase, voff) do { _Pragma("unroll") for (int _i = 0; _i < 2; ++_i) \
        __builtin_amdgcn_global_load_lds((const unsigned*)((const char*)(gbase) + (voff)[_i]), (PG8_LAS unsigned*)(lds + (bufoff) + ldsw + _i * 8192), 16, 0, 0); } while (0)
#define PG8_LDA(dst, b, h) do { _Pragma("unroll") for (int m = 0; m < 4; ++m) _Pragma("unroll") for (int k = 0; k < 2; ++k) dst[m][k] = *(const PG8_LAS bf16x8*)(lds + PG8_SA(b, h) + aoff + m * 2048 + k * 1024); } while (0)
#define PG8_LDB(dst, b, h) do { _Pragma("unroll") for (int n = 0; n < 2; ++n) _Pragma("unroll") for (int k = 0; k < 2; ++k) dst[n][k] = *(const PG8_LAS bf16x8*)(lds + PG8_SB(b, h) + boff + n * 2048 + k * 1024); } while (0)
#define PG8_MMA(ai, bj, At, Bt) do { __builtin_amdgcn_s_setprio(1); _Pragma("unroll") for (int m = 0; m < 4; ++m) _Pragma("unroll") for (int n = 0; n < 2; ++n) _Pragma("unroll") for (int k = 0; k < 2; ++k) \
        acc[ai][bj][m][n] = __builtin_amdgcn_mfma_f32_16x16x32_bf16(Bt[n][k], At[m][k], acc[ai][bj][m][n], 0, 0, 0); __builtin_amdgcn_s_setprio(0); } while (0)
#define PG8_WAIT_V(n) asm volatile("s_waitcnt vmcnt(" #n ")" ::: "memory")
#define PG8_WAIT_L(n) asm volatile("s_waitcnt lgkmcnt(" #n ")" ::: "memory")
#define PG8_BAR __builtin_amdgcn_s_barrier()
#define PG8_SCHED __builtin_amdgcn_sched_barrier(0)
    Unit cur, nxt; int ui = 0;
    if (!S.next(0, cur)) return;
    f32x4 acc[2][2][4][2];
#pragma unroll
    for (int a = 0; a < 2; ++a)
#pragma unroll
        for (int b = 0; b < 2; ++b)
#pragma unroll
            for (int m = 0; m < 4; ++m)
#pragma unroll
                for (int n = 0; n < 2; ++n) acc[a][b][m][n] = (f32x4){0.f, 0.f, 0.f, 0.f};
    bf16x8 At[4][2], B0[2][2], B1[2][2];
    const char* cA = (const char*)g.A + (size_t)cur.pm * tstepA; const char* cB = (const char*)g.Bt + (size_t)cur.pn * tstepB;
    S.a_ready(cur);
    if constexpr (SP2) {
        PG8_STAGE(PG8_SB(0, 0), cB, voffB); PG8_STAGE(PG8_SB(0, 1), cB + hstepB, voffB); PG8_STAGE(PG8_SA(0, 0), cA, voffA); PG8_STAGE(PG8_SA(0, 1), cA + hstepA, voffA);
        if (wr == 1) PG8_BAR;
        PG8_WAIT_V(2); PG8_BAR;
        PG8_STAGE(PG8_SB(1, 0), cB + kstepB, voffB); PG8_STAGE(PG8_SA(1, 0), cA + kstepA, voffA); PG8_STAGE(PG8_SB(1, 1), cB + hstepB + kstepB, voffB);
        PG8_WAIT_V(6); PG8_BAR;
    } else {
        PG8_STAGE(PG8_SB(0, 0), cB, voffB); PG8_STAGE(PG8_SA(0, 0), cA, voffA); PG8_STAGE(PG8_SB(0, 1), cB + hstepB, voffB); PG8_STAGE(PG8_SA(0, 1), cA + hstepA, voffA);
        if (wr == 1) PG8_BAR;
        PG8_WAIT_V(4); PG8_BAR;
        PG8_STAGE(PG8_SB(1, 0), cB + kstepB, voffB); PG8_STAGE(PG8_SA(1, 0), cA + kstepA, voffA); PG8_STAGE(PG8_SB(1, 1), cB + hstepB + kstepB, voffB);
        PG8_WAIT_V(6); PG8_BAR;
    }
    for (;;) {
        const bool has_next = S.next(ui + 1, nxt);
        const char* nA = has_next ? (const char*)g.A + (size_t)nxt.pm * tstepA : cA; const char* nB = has_next ? (const char*)g.Bt + (size_t)nxt.pn * tstepB : cB;
        for (int t = 0; t < nt; t += 2) {
            const bool last = (t == nt - 2);
            const char* a1 = cA + (size_t)(t + 1) * kstepA;
            const char* a2 = last ? nA : cA + (size_t)(t + 2) * kstepA; const char* b2 = last ? nB : cB + (size_t)(t + 2) * kstepB;
            const char* a3 = a2 + kstepA; const char* b3 = b2 + kstepB;
            if (last && has_next) S.a_ready(nxt);
            if constexpr (SP2) {
            PG8_LDB(B0, 0, 0); PG8_LDB(B1, 0, 1); PG8_SCHED; PG8_LDA(At, 0, 0); PG8_STAGE(PG8_SA(1, 1), a1 + hstepA, voffA);
            PG8_WAIT_V(8); PG8_WAIT_L(0); PG8_BAR; PG8_MMA(0, 0, At, B0); PG8_MMA(0, 1, At, B1); PG8_BAR; PG8_SCHED;
            PG8_LDA(At, 0, 1); PG8_STAGE(PG8_SB(0, 0), b2, voffB); PG8_STAGE(PG8_SB(0, 1), b2 + hstepB, voffB); PG8_STAGE(PG8_SA(0, 0), a2, voffA);
            PG8_WAIT_V(8); PG8_WAIT_L(0); PG8_BAR; PG8_MMA(1, 0, At, B0); PG8_MMA(1, 1, At, B1); PG8_BAR; PG8_SCHED;
            PG8_LDB(B0, 1, 0); PG8_LDB(B1, 1, 1); PG8_SCHED; PG8_LDA(At, 1, 0); PG8_STAGE(PG8_SA(0, 1), a2 + hstepA, voffA);
            PG8_WAIT_V(8); PG8_WAIT_L(0); PG8_BAR; PG8_MMA(0, 0, At, B0); PG8_MMA(0, 1, At, B1); PG8_BAR; PG8_SCHED;
            PG8_LDA(At, 1, 1); PG8_STAGE(PG8_SB(1, 0), b3, voffB); PG8_STAGE(PG8_SB(1, 1), b3 + hstepB, voffB); PG8_STAGE(PG8_SA(1, 0), a3, voffA);
            PG8_WAIT_V(8); PG8_WAIT_L(0); PG8_BAR; PG8_MMA(1, 0, At, B0); PG8_MMA(1, 1, At, B1); PG8_BAR; PG8_SCHED;
            } else {
            PG8_LDB(B0, 0, 0); PG8_SCHED; PG8_LDA(At, 0, 0); PG8_STAGE(PG8_SA(1, 1), a1 + hstepA, voffA);
            PG8_WAIT_L(8); PG8_BAR; PG8_WAIT_L(0); PG8_MMA(0, 0, At, B0); PG8_BAR; PG8_SCHED;
            PG8_LDB(B1, 0, 1); PG8_STAGE(PG8_SB(0, 0), b2, voffB);
            PG8_BAR; PG8_WAIT_L(0); PG8_MMA(0, 1, At, B1); PG8_BAR;
            PG8_LDA(At, 0, 1); PG8_STAGE(PG8_SA(0, 0), a2, voffA);
            PG8_BAR; PG8_WAIT_L(0); PG8_MMA(1, 0, At, B0); PG8_BAR; PG8_SCHED;
            PG8_STAGE(PG8_SB(0, 1), b2 + hstepB, voffB);
            PG8_WAIT_V(6); PG8_BAR; PG8_MMA(1, 1, At, B1); PG8_BAR;
            PG8_LDB(B0, 1, 0); PG8_SCHED; PG8_LDA(At, 1, 0); PG8_STAGE(PG8_SA(0, 1), a2 + hstepA, voffA);
            PG8_WAIT_L(8); PG8_BAR; PG8_WAIT_L(0); PG8_MMA(0, 0, At, B0); PG8_BAR; PG8_SCHED;
            PG8_LDB(B1, 1, 1); PG8_STAGE(PG8_SB(1, 0), b3, voffB);
            PG8_BAR; PG8_WAIT_L(0); PG8_MMA(0, 1, At, B1); PG8_BAR;
            PG8_LDA(At, 1, 1); PG8_STAGE(PG8_SA(1, 0), a3, voffA);
            PG8_BAR; PG8_WAIT_L(0); PG8_MMA(1, 0, At, B0); PG8_BAR; PG8_SCHED;
            PG8_STAGE(PG8_SB(1, 1), b3 + hstepB, voffB);
            PG8_WAIT_V(6); PG8_BAR; PG8_MMA(1, 1, At, B1); PG8_BAR;
            }
        }
        if constexpr (ALIGN_EPI) { if (wr == 0) PG8_BAR; }
        if constexpr (!Epi::AFTER_DRAIN) { E(acc, cur, wr, wc, fr, fq); S.done(cur); }
        if (!has_next) break;
#pragma unroll
        for (int a = 0; a < 2; ++a)
#pragma unroll
            for (int b = 0; b < 2; ++b)
#pragma unroll
                for (int m = 0; m < 4; ++m)
#pragma unroll
                    for (int n = 0; n < 2; ++n) acc[a][b][m][n] = (f32x4){0.f, 0.f, 0.f, 0.f};
        cur = nxt; cA = nA; cB = nB; ++ui;
        if constexpr (ALIGN_EPI) { if (wr == 1) PG8_BAR; }
    }
    PG8_WAIT_V(0);
    if constexpr (!ALIGN_EPI) { if (wr == 0) PG8_BAR; }
    PG8_BAR;
    if constexpr (Epi::AFTER_DRAIN) { E.fused(acc, cur, wr, wc, fr, fq, lds, wid, lane); S.done(cur); }
#undef PG8_SA
#undef PG8_SB
#undef PG8_STAGE
#undef PG8_LDA
#undef PG8_LDB
#undef PG8_MMA
#undef PG8_WAIT_V
#undef PG8_WAIT_L
#undef PG8_BAR
#undef PG8_SCHED
}
}
#define LAS __attribute__((address_space(3)))
#define XB_TMO      128
#define XB_XCNT(j)  (256  + 64 * (j))
#define XB_XSUB(j)  (1280 + 64 * (j))
#define XB_XGEN(j)  (2304 + 64 * (j))
#define XB_TOP      3328
#define XB_TOPGEN   3392
#define XCD_BAR_WORDS 3456
#define XB_SPIN_CAP (1u << 18)

__device__ __forceinline__ unsigned xb_ld(unsigned* p)              { return __hip_atomic_load(p, __ATOMIC_RELAXED, __HIP_MEMORY_SCOPE_AGENT); }
__device__ __forceinline__ unsigned xb_add(unsigned* p, unsigned v) { return __hip_atomic_fetch_add(p, v, __ATOMIC_RELAXED, __HIP_MEMORY_SCOPE_AGENT); }
__device__ __forceinline__ unsigned xb_xcc_id() { return (unsigned)__builtin_amdgcn_s_getreg((3 << 11) | 20) & 0xFu; }
#define XB_SPIN(cond, bar) do { unsigned _sp = 0; while (cond) { __builtin_amdgcn_s_sleep(1); \
    if ((++_sp & 255u) == 0u) { if (xb_ld(&(bar)[XB_TMO])) break; if (_sp > XB_SPIN_CAP) { atomicAdd(&(bar)[XB_TMO], 1u); break; } } } } while (0)

struct XcdBarrier {
    unsigned* bar; unsigned x;
    volatile LAS unsigned* st;
};

__device__ __forceinline__ XcdBarrier xcd_barrier_post(unsigned* bar, volatile LAS unsigned* st) {
    XcdBarrier b; b.bar = bar; b.x = xb_xcc_id(); b.st = st;
    if (threadIdx.x == 0) (void)xb_add(&bar[XB_XCNT(b.x)], 1u);
    return b;
}
__device__ __forceinline__ void xcd_barrier_complete(unsigned* bar, unsigned x, unsigned& nloc, unsigned& nx) {
    const unsigned G = gridDim.x * gridDim.y * gridDim.z;
    unsigned sum, cnt, mine, sp = 0u;
    for (;;) {
        sum = 0u; cnt = 0u; mine = 0u;
#pragma unroll
        for (unsigned j = 0; j < 16; ++j) { const unsigned c = xb_ld(&bar[XB_XCNT(j)]); sum += c; cnt += (c > 0u) ? 1u : 0u; mine = (j == x) ? c : mine; }
        if (sum == G) break;
        __builtin_amdgcn_s_sleep(1);
        if ((++sp & 255u) == 0u) { if (xb_ld(&bar[XB_TMO])) break; if (sp > XB_SPIN_CAP) { atomicAdd(&bar[XB_TMO], 1u); break; } }
    }
    nloc = mine > 0u ? mine : 1u; nx = cnt > 0u ? cnt : 1u;
}

__device__ __forceinline__ void xcd_barrier(const XcdBarrier& b) {
    asm volatile("s_waitcnt vmcnt(0)" ::: "memory");
    __syncthreads();
    if (threadIdx.x == 0) {
        unsigned* bar = b.bar;
        __builtin_amdgcn_s_waitcnt(0);
        unsigned nloc = b.st[0], nx = b.st[1];
        if (nloc == 0u) { xcd_barrier_complete(bar, b.x, nloc, nx); b.st[0] = nloc; b.st[1] = nx; }
        const unsigned old = xb_add(&bar[XB_XSUB(b.x)], 1u);
        const unsigned gen = old / nloc;
        if (old + 1u == (gen + 1u) * nloc) {
            __builtin_amdgcn_fence(__ATOMIC_RELEASE, "agent");
            asm volatile("s_waitcnt vmcnt(0)" ::: "memory");
            const unsigned og = xb_add(&bar[XB_TOP], 1u);
            const unsigned tg = og / nx;
            if (og + 1u == (tg + 1u) * nx) xb_add(&bar[XB_TOPGEN], 1u);
            else XB_SPIN(xb_ld(&bar[XB_TOPGEN]) == tg, bar);
            __builtin_amdgcn_fence(__ATOMIC_ACQUIRE, "agent");
            xb_add(&bar[XB_XGEN(b.x)], 1u);
            asm volatile("s_waitcnt vmcnt(0)" ::: "memory");
        } else {
            XB_SPIN(xb_ld(&bar[XB_XGEN(b.x)]) == gen, bar);
            __builtin_amdgcn_fence(__ATOMIC_ACQUIRE, "agent");
            asm volatile("s_waitcnt vmcnt(0)" ::: "memory");
        }
    }
    __syncthreads();
}
#define GAS __attribute__((address_space(1)))

typedef unsigned short bf16;
typedef float f32x4 __attribute__((ext_vector_type(4)));
typedef unsigned v4u __attribute__((ext_vector_type(4)));
typedef unsigned v2u __attribute__((ext_vector_type(2)));
#define LDS_WAIT() asm volatile("s_waitcnt lgkmcnt(0)" ::: "memory")

#ifndef MK_ONE_LAUNCH
#define MK_ONE_LAUNCH 0
#endif
#ifndef RET_MFMA
#define RET_MFMA 1
#endif
#ifndef SWA_MFMA
#define SWA_MFMA 1
#endif
#ifndef PROBE_DUP
#define PROBE_DUP 0
#endif
#ifndef CONV_FUSED
#define CONV_FUSED 1
#endif
#ifndef PLE_EARLY
#define PLE_EARLY 1
#endif
#ifndef LN_NOXR
#define LN_NOXR 1
#endif
#define REPS(k) int nrep_ = (PROBE_DUP == (k)) ? 2 : 1; asm volatile("" : "+s"(nrep_)); for (int rep_ = 0; rep_ < nrep_; ++rep_)

constexpr int S = 16384, D = 2048, INW = 5376, DFF = 5632, NUP = 2 * DFF, NUPG = NUP + D, PLE = 256, DEPTH = 4;
constexpr float ALPHA = 1.6817928305074290f, LN_EPS = 1e-5f, GN_EPS = 1e-6f;
constexpr int NPH = 11, NPHASES = 1 + DEPTH * NPH;

constexpr size_t MiB = 1u << 20;
constexpr size_t WS_CTL = 0, CTL_ZERO_BYTES = 32768;
constexpr size_t WS_COSR = 2 * MiB, WS_SINR = 10 * MiB, WS_COSA = 18 * MiB, WS_SINA = 20 * MiB;
constexpr size_t WS_W = 32 * MiB, WL_BYTES = 106 * MiB;
constexpr size_t WL_IN = 0, WL_OUT = 21 * MiB, WL_UP = 29 * MiB, WL_G = 73 * MiB, WL_DOWN = 81 * MiB, WL_P = 104 * MiB;
constexpr size_t WS_XR = 530 * MiB, WS_XB = 576 * MiB, WS_Y = 640 * MiB;
constexpr size_t WS_Q = 768 * MiB, WS_K = 800 * MiB, WS_V = 832 * MiB, WS_G = 864 * MiB, WS_AQ = 896 * MiB, WS_AK = 928 * MiB, WS_AV = 932 * MiB;
constexpr size_t WS_MIX = 936 * MiB, WS_U = 1000 * MiB, WS_PS = 1128 * MiB, WS_RETY = 1160 * MiB;
constexpr size_t WS_H = 768 * MiB, WS_ACT = 1128 * MiB, WS_SG = 460 * MiB, WS_PB = 1368 * MiB, WS_END = 1400 * MiB;
constexpr size_t WS_PP = 1064 * MiB;
constexpr size_t WS_ST1 = 24 * MiB, WS_ST2 = 25 * MiB;
constexpr int CW_BAR = 4096;
static_assert((CW_BAR + 3456) * 4 <= 32768, "barrier words inside the per-call memset");

constexpr int RING_BYTES = 131072, LDS_BYTES = 147456, LDSCTL_OFF = LDS_BYTES - 1024, MISC_OFF = LDSCTL_OFF + 320;

__device__ __forceinline__ unsigned f2bf(float f) { unsigned u = __builtin_bit_cast(unsigned, f); return (u + 0x7fffu + ((u >> 16) & 1u)) >> 16; }
__device__ __forceinline__ unsigned pk2(float lo, float hi) { return f2bf(lo) | (f2bf(hi) << 16); }
__device__ __forceinline__ float bflo(unsigned w) { return __uint_as_float(w << 16); }
__device__ __forceinline__ float bfhi(unsigned w) { return __uint_as_float(w & 0xffff0000u); }
__device__ __forceinline__ float bf1(const bf16* p) { return __uint_as_float(((unsigned)*p) << 16); }

struct Params {
    const float* in[19]; float* out; unsigned char* ws; int ph_lo, ph_hi;
    float invf_ret[128]; float invf_att[32]; float lg2g[4];
};

struct Ctx { int tid, lane, wave, G, bid; unsigned char* ws; };

__device__ __forceinline__ int lane_id_asm() { int l; asm volatile("v_mbcnt_lo_u32_b32 %0, -1, 0\n\tv_mbcnt_hi_u32_b32 %0, -1, %0" : "=v"(l)); return l; }
__device__ __forceinline__ float wave_sum(float v, int lane) {
#pragma unroll
    for (int o = 1; o < 64; o <<= 1) v += __builtin_bit_cast(float, __builtin_amdgcn_ds_bpermute((lane ^ o) << 2, __builtin_bit_cast(int, v)));
    return v;
}
__device__ __forceinline__ void transpose_item(const float* W, int K, int N, int src_col0, bf16* WT, int dst_row0, int k0, LAS float* scr, int lane) {
#pragma unroll 8
    for (int i = 0; i < 32; ++i) { const int kk = 2 * i + (lane >> 5); scr[kk * 33 + (lane & 31)] = W[(size_t)(k0 + kk) * N + src_col0 + (lane & 31)]; }
    LDS_WAIT(); asm volatile("" ::: "memory");
    const int c = lane & 7;
#pragma unroll
    for (int j = 0; j < 4; ++j) { const int n = (lane >> 3) + 8 * j; const LAS float* s = scr + (8 * c) * 33 + n;
        v4u o; o.x = pk2(s[0 * 33], s[1 * 33]); o.y = pk2(s[2 * 33], s[3 * 33]); o.z = pk2(s[4 * 33], s[5 * 33]); o.w = pk2(s[6 * 33], s[7 * 33]);
        *(v4u*)(WT + (size_t)(dst_row0 + n) * K + k0 + 8 * c) = o; }
    LDS_WAIT(); asm volatile("" ::: "memory");
}
__device__ __forceinline__ void transpose_item64(const float* W, int K, int N, int srcA, int srcB, bf16* WT, int dst_row0, int k0, LAS float* scr, int lane, int tiled = 0) {
    const int c4 = lane & 15, gsel = c4 >> 3, col = 4 * (c4 & 7), src = (gsel ? srcB : srcA) + col, kq = lane >> 4;
    f32x4 v[16];
#pragma unroll
    for (int i = 0; i < 16; ++i) v[i] = *(const f32x4*)(W + (size_t)(k0 + 4 * i + kq) * N + src);
#pragma unroll
    for (int i = 0; i < 16; ++i) { LAS float* d = scr + (4 * i + kq) * 65 + 32 * gsel + col; d[0] = v[i][0]; d[1] = v[i][1]; d[2] = v[i][2]; d[3] = v[i][3]; }
    LDS_WAIT(); asm volatile("" ::: "memory");
    const int c = lane & 7;
#pragma unroll
    for (int j = 0; j < 8; ++j) { const int n = (lane >> 3) + 8 * j; const LAS float* s = scr + (8 * c) * 65 + n;
        v4u o; o.x = pk2(s[0 * 65], s[1 * 65]); o.y = pk2(s[2 * 65], s[3 * 65]); o.z = pk2(s[4 * 65], s[5 * 65]); o.w = pk2(s[6 * 65], s[7 * 65]);
        *(v4u*)(WT + (tiled ? pg8::tiled_off(dst_row0 + n, k0 + 8 * c, K) : (size_t)(dst_row0 + n) * K + k0 + 8 * c)) = o; }
    LDS_WAIT(); asm volatile("" ::: "memory");
}
__device__ __forceinline__ int win_src_col(int g) {
    const int tile = g >> 3, bj = (g >> 2) & 1, wcg = g & 3;
    if (tile < 16) return 32 * g;
    if (tile < 20) return 4096 + 256 * (tile - 16) + 64 * wcg + 32 * bj;
    return wcg < 2 ? 5120 + 64 * wcg + 32 * bj : 5248 + 32 * (wcg - 2) + 64 * bj;
}
__device__ __forceinline__ int wup_src_col(int g) { const int tile = g >> 3, bj = (g >> 2) & 1, wcg = g & 3; return (bj ? DFF : 0) + 128 * tile + 32 * wcg; }

__device__ __forceinline__ void sincos_d(float angf, float& s, float& c) {
    const double a = (double)angf;
    const double k = __builtin_rint(a * 0.63661977236758134308);
    double r = __builtin_fma(-k, 1.57079632679489661923, a); r = __builtin_fma(-k, 6.123233995736766e-17, r);
    const double r2 = r * r;
    const double sp = r + r * r2 * (-1.0 / 6 + r2 * (1.0 / 120 + r2 * (-1.0 / 5040 + r2 * (1.0 / 362880 + r2 * (-1.0 / 39916800)))));
    const double cp = 1.0 + r2 * (-0.5 + r2 * (1.0 / 24 + r2 * (-1.0 / 720 + r2 * (1.0 / 40320 + r2 * (-1.0 / 3628800 + r2 * (1.0 / 479001600))))));
    const int q = ((int)k) & 3;
    const double sv = (q == 0) ? sp : (q == 1) ? cp : (q == 2) ? -sp : -cp;
    const double cv = (q == 0) ? cp : (q == 1) ? -sp : (q == 2) ? -cp : sp;
    s = (float)sv; c = (float)cv;
}

__device__ __forceinline__ void phase_prologue(const Params& P, const Ctx& cx, LAS unsigned char* lds) {
    unsigned char* ws = cx.ws; const int tid = cx.tid, lane = cx.lane, wave = cx.wave, G = cx.G;
    LAS float* scr = (LAS float*)(lds + wave * 16896);
    const int gw = cx.bid * 8 + wave, NGW = G * 8;
    constexpr int I_IN = 32 * 84, I_OUT = 32 * 32, I_UP = 32 * 176, I_G = 32 * 32, I_DN = 88 * 32, I_P = 4 * 32, I_L = I_IN + I_OUT + I_UP + I_G + I_DN + I_P;
    for (int it = gw; it < DEPTH * I_L; it += NGW) {
        const int l = it / I_L; int r = it - l * I_L;
        bf16* wl = (bf16*)(ws + WS_W + (size_t)l * WL_BYTES);
        if (r < I_IN) { const int kb = r / 84, g = r % 84; transpose_item64(P.in[3] + (size_t)l * D * INW, D, INW, win_src_col(2 * g), win_src_col(2 * g + 1), wl + WL_IN / 2, 64 * g, 64 * kb, scr, lane); continue; } r -= I_IN;
        if (r < I_OUT) { const int kb = r / 32, g = r % 32; transpose_item64(P.in[4] + (size_t)l * D * D, D, D, 64 * g, 64 * g + 32, wl + WL_OUT / 2, 64 * g, 64 * kb, scr, lane); continue; } r -= I_OUT;
        if (r < I_UP) { const int kb = r / 176, g = r % 176; transpose_item64(P.in[10] + (size_t)l * D * NUP, D, NUP, wup_src_col(2 * g), wup_src_col(2 * g + 1), wl + WL_UP / 2, 64 * g, 64 * kb, scr, lane); continue; } r -= I_UP;
        if (r < I_G) { const int kb = r / 32, g = r % 32; transpose_item64(P.in[16] + (size_t)l * D * D, D, D, 64 * g, 64 * g + 32, wl + WL_G / 2, 64 * g, 64 * kb, scr, lane); continue; } r -= I_G;
        if (r < I_DN) { const int kb = r / 32, g = r % 32; transpose_item64(P.in[13] + (size_t)l * DFF * D, DFF, D, 64 * g, 64 * g + 32, wl + WL_DOWN / 2, 64 * g, 64 * kb, scr, lane, 1); continue; } r -= I_DN;
        { const int kb = r / 32, g = r % 32; transpose_item64(P.in[18] + (size_t)l * PLE * D, PLE, D, 64 * g, 64 * g + 32, wl + WL_P / 2, 64 * g, 64 * kb, scr, lane); }
    }
    const size_t gt = (size_t)cx.bid * 512 + tid, NT = (size_t)G * 512;
    { const float* x = P.in[0]; bf16* xb = (bf16*)(ws + WS_XB);
      for (size_t i = gt; i < (size_t)S * D / 8; i += NT) { const f32x4 a = *(const f32x4*)(x + i * 8), b = *(const f32x4*)(x + i * 8 + 4);
          v4u o; o.x = pk2(a[0], a[1]); o.y = pk2(a[2], a[3]); o.z = pk2(b[0], b[1]); o.w = pk2(b[2], b[3]); *(v4u*)(xb + i * 8) = o; } }
    { const float* p = P.in[1]; bf16* pb = (bf16*)(ws + WS_PB);
      for (size_t i = gt; i < (size_t)DEPTH * S * PLE / 8; i += NT) { const f32x4 a = *(const f32x4*)(p + i * 8), b = *(const f32x4*)(p + i * 8 + 4);
          v4u o; o.x = pk2(a[0], a[1]); o.y = pk2(a[2], a[3]); o.z = pk2(b[0], b[1]); o.w = pk2(b[2], b[3]); *(v4u*)(pb + i * 8) = o; } }
    { const int* pos = (const int*)P.in[2]; float* cosr = (float*)(ws + WS_COSR); float* sinr = (float*)(ws + WS_SINR); float* cosa = (float*)(ws + WS_COSA); float* sina = (float*)(ws + WS_SINA);
      for (size_t i = gt; i < (size_t)S * 128; i += NT) { const int t = (int)(i >> 7), f = (int)(i & 127); float s, c; sincos_d((float)pos[t] * P.invf_ret[f], s, c); cosr[i] = c; sinr[i] = s; }
      for (size_t i = gt; i < (size_t)S * 32; i += NT) { const int t = (int)(i >> 5), f = (int)(i & 31); float s, c; sincos_d((float)pos[t] * P.invf_att[f], s, c); cosa[i] = c; sina[i] = s; } }
}

template <int MT, int NT_, int KK, bool A_KFAST, bool B_NFAST, class FA, class FB, class FC>
__device__ __forceinline__ void simple_gemm(LAS unsigned char* lds, int nbatch, int tid, int G, int bid, const FA& fa, const FB& fb, const FC& fc) {
    LAS float* As = (LAS float*)lds;
    LAS float* Bs = (LAS float*)(lds + 16 * 132 * 4);
    constexpr int TM = MT / 128, TN = NT_ / 64, ITEMS_PER_B = TM * TN;
    const int tm = tid & 31, tn = tid >> 5;
    for (int item = bid; item < nbatch * ITEMS_PER_B; item += G) {
        const int b = item / ITEMS_PER_B, r = item % ITEMS_PER_B, m0 = (r / TN) * 128, n0 = (r % TN) * 64;
        float c[4][4];
#pragma unroll
        for (int i = 0; i < 4; ++i)
#pragma unroll
            for (int j = 0; j < 4; ++j) c[i][j] = 0.f;
        for (int k0 = 0; k0 < KK; k0 += 16) {
#pragma unroll
            for (int rr = 0; rr < 4; ++rr) { const int e = tid + 512 * rr; int m, k; if (A_KFAST) { k = e & 15; m = e >> 4; } else { m = e & 127; k = e >> 7; }
                As[k * 132 + m] = fa(b, m0 + m, k0 + k); }
#pragma unroll
            for (int rr = 0; rr < 2; ++rr) { const int e = tid + 512 * rr; int n, k; if (B_NFAST) { n = e & 63; k = e >> 6; } else { k = e & 15; n = e >> 4; }
                Bs[k * 68 + n] = fb(b, k0 + k, n0 + n); }
            __syncthreads();
#pragma unroll
            for (int kk = 0; kk < 16; ++kk) { const f32x4 a = *(const LAS f32x4*)(As + kk * 132 + 4 * tm), bb = *(const LAS f32x4*)(Bs + kk * 68 + 4 * tn);
#pragma unroll
                for (int i = 0; i < 4; ++i)
#pragma unroll
                    for (int j = 0; j < 4; ++j) c[i][j] += a[i] * bb[j]; }
            __syncthreads();
        }
#pragma unroll
        for (int i = 0; i < 4; ++i)
#pragma unroll
            for (int j = 0; j < 4; ++j) fc(b, m0 + 4 * tm + i, n0 + 4 * tn + j, c[i][j]);
    }
}

__device__ __forceinline__ void phase_swa(const Params& P, const Ctx& cx, int l, LAS unsigned char* lds) {
    unsigned char* ws = cx.ws; const int tid = cx.tid, G = cx.G;
    const bf16* AQ = (const bf16*)(ws + WS_AQ); const bf16* AK = (const bf16*)(ws + WS_AK); const bf16* AV = (const bf16*)(ws + WS_AV); bf16* MIX = (bf16*)(ws + WS_MIX);
    const float* sinks = P.in[7] + l * 16;
    LAS unsigned* Ks = (LAS unsigned*)lds;
    LAS unsigned* Vs = (LAS unsigned*)(lds + 256 * 33 * 4);
    for (int item = cx.bid; item < 256; item += G) {
        const int nb = item >> 1, hk = item & 1;
        __syncthreads();
        for (int e = tid; e < 256 * 32; e += 512) { const int r = e >> 5, cdw = e & 31; const int gk = nb * 128 - 128 + r;
            unsigned kv = 0u, vv = 0u; if (gk >= 0) { kv = *(const unsigned*)(AK + (size_t)gk * 128 + hk * 64 + 2 * cdw); vv = *(const unsigned*)(AV + (size_t)gk * 128 + hk * 64 + 2 * cdw); }
            Ks[r * 33 + cdw] = kv; Vs[r * 33 + cdw] = vv; }
        __syncthreads();
#pragma unroll 1
        for (int rep = 0; rep < 2; ++rep) {
            const int pair = tid + 512 * rep, i = pair & 127, g = pair >> 7, hq = hk * 8 + g; const int row = nb * 128 + i;
            float q[64], o[64];
            { const v4u* qp = (const v4u*)(AQ + (size_t)row * 1024 + hq * 64);
#pragma unroll
              for (int c8 = 0; c8 < 8; ++c8) { const v4u w = qp[c8]; q[8 * c8 + 0] = bflo(w.x); q[8 * c8 + 1] = bfhi(w.x); q[8 * c8 + 2] = bflo(w.y); q[8 * c8 + 3] = bfhi(w.y); q[8 * c8 + 4] = bflo(w.z); q[8 * c8 + 5] = bfhi(w.z); q[8 * c8 + 6] = bflo(w.w); q[8 * c8 + 7] = bfhi(w.w); } }
#pragma unroll
            for (int d = 0; d < 64; ++d) o[d] = 0.f;
            float mx = sinks[hq], den = 1.0f;
            const int jj0 = (nb == 0) ? (127 - i) : 0;
            for (int jj = jj0; jj < 128; ++jj) { const int kl = i + 1 + jj;
                float s = 0.f;
#pragma unroll
                for (int c = 0; c < 32; ++c) { const unsigned w = Ks[kl * 33 + c]; s += q[2 * c] * bflo(w) + q[2 * c + 1] * bfhi(w); }
                const float mn = fmaxf(mx, s), sc = __expf(mx - mn), p = __expf(s - mn);
                den = den * sc + p; mx = mn;
#pragma unroll
                for (int c = 0; c < 32; ++c) { const unsigned w = Vs[kl * 33 + c]; o[2 * c] = o[2 * c] * sc + p * bflo(w); o[2 * c + 1] = o[2 * c + 1] * sc + p * bfhi(w); }
            }
            const float inv = 1.0f / den;
            v4u* op = (v4u*)(MIX + (size_t)row * 2048 + 1024 + hq * 64);
#pragma unroll
            for (int c8 = 0; c8 < 8; ++c8) { v4u w; w.x = pk2(o[8 * c8] * inv, o[8 * c8 + 1] * inv); w.y = pk2(o[8 * c8 + 2] * inv, o[8 * c8 + 3] * inv); w.z = pk2(o[8 * c8 + 4] * inv, o[8 * c8 + 5] * inv); w.w = pk2(o[8 * c8 + 6] * inv, o[8 * c8 + 7] * inv); op[c8] = w; }
        }
    }
}

__device__ __forceinline__ void phase_ret_u_scores(const Params& P, const Ctx& cx, LAS unsigned char* lds) {
    unsigned char* ws = cx.ws; const int tid = cx.tid, G = cx.G;
    const bf16* Q = (const bf16*)(ws + WS_Q); const bf16* K = (const bf16*)(ws + WS_K); const bf16* V = (const bf16*)(ws + WS_V);
    float* U = (float*)(ws + WS_U); float* PS = (float*)(ws + WS_PS);
    const float lg0 = P.lg2g[0], lg1 = P.lg2g[1], lg2 = P.lg2g[2], lg3 = P.lg2g[3];
    auto lgh = [=](int h) { return h == 0 ? lg0 : h == 1 ? lg1 : h == 2 ? lg2 : lg3; };
    simple_gemm<256, 256, 128, false, true>(lds, 512, tid, G, cx.bid,
        [=](int b, int m, int k) { const int nb = b >> 2, h = b & 3; return bf1(K + (size_t)(nb * 128 + k) * 1024 + h * 256 + m) * exp2f(lgh(h) * (float)(127 - k)); },
        [=](int b, int k, int n) { const int nb = b >> 2, h = b & 3; return bf1(V + (size_t)(nb * 128 + k) * 1024 + h * 256 + n); },
        [=](int b, int m, int n, float v) { U[((size_t)b * 256 + m) * 256 + n] = v; });
    simple_gemm<128, 128, 256, true, false>(lds, 512, tid, G, cx.bid,
        [=](int b, int m, int k) { const int nb = b >> 2, h = b & 3; return bf1(Q + (size_t)(nb * 128 + m) * 1024 + h * 256 + k); },
        [=](int b, int k, int n) { const int nb = b >> 2, h = b & 3; return bf1(K + (size_t)(nb * 128 + n) * 1024 + h * 256 + k); },
        [=](int b, int m, int n, float v) { const int h = b & 3; PS[((size_t)b * 128 + m) * 128 + n] = (m >= n) ? v * exp2f(lgh(h) * (float)(m - n)) : 0.f; });
}
__device__ __forceinline__ void phase_scan(const Params& P, const Ctx& cx) {
    float* U = (float*)(cx.ws + WS_U);
    const size_t gt = (size_t)cx.bid * 512 + cx.tid, NT = (size_t)cx.G * 512;
    for (size_t idx = gt; idx < 4 * 65536; idx += NT) {
        const int h = (int)(idx >> 16); const float cd = exp2f(P.lg2g[h] * 128.0f);
        float r = 0.f;
        for (int n0 = 0; n0 < 128; n0 += 8) { float u[8];
#pragma unroll
            for (int j = 0; j < 8; ++j) u[j] = U[(size_t)(n0 + j) * 262144 + idx];
#pragma unroll
            for (int j = 0; j < 8; ++j) { U[(size_t)(n0 + j) * 262144 + idx] = r; r = r * cd + u[j]; } }
    }
}
__device__ __forceinline__ void phase_ret_out(const Params& P, const Ctx& cx, LAS unsigned char* lds) {
    unsigned char* ws = cx.ws; const int tid = cx.tid, G = cx.G;
    const bf16* Q = (const bf16*)(ws + WS_Q); const bf16* V = (const bf16*)(ws + WS_V);
    const float* Sst = (const float*)(ws + WS_U); const float* PS = (const float*)(ws + WS_PS); float* RY = (float*)(ws + WS_RETY);
    const float lg0 = P.lg2g[0], lg1 = P.lg2g[1], lg2 = P.lg2g[2], lg3 = P.lg2g[3];
    auto lgh = [=](int h) { return h == 0 ? lg0 : h == 1 ? lg1 : h == 2 ? lg2 : lg3; };
    simple_gemm<128, 256, 384, true, true>(lds, 512, tid, G, cx.bid,
        [=](int b, int m, int k) { const int nb = b >> 2, h = b & 3; return k < 128 ? PS[((size_t)b * 128 + m) * 128 + k] : bf1(Q + (size_t)(nb * 128 + m) * 1024 + h * 256 + (k - 128)) * exp2f(lgh(h) * (float)(m + 1)); },
        [=](int b, int k, int n) { const int nb = b >> 2, h = b & 3; return k < 128 ? bf1(V + (size_t)(nb * 128 + k) * 1024 + h * 256 + n) : Sst[((size_t)b * 256 + (k - 128)) * 256 + n]; },
        [=](int b, int m, int n, float v) { const int nb = b >> 2, h = b & 3; RY[(size_t)(nb * 128 + m) * 1024 + h * 256 + n] = v; });
}

typedef short bf16x8 __attribute__((ext_vector_type(8)));
typedef short s16x4 __attribute__((ext_vector_type(4)));
typedef short v4i16_t __attribute__((ext_vector_type(4)));
__device__ __forceinline__ f32x4 mfma16(bf16x8 a, bf16x8 b, f32x4 c) { return __builtin_amdgcn_mfma_f32_16x16x32_bf16(a, b, c, 0, 0, 0); }
__device__ __forceinline__ s16x4 lds_tr(LAS unsigned char* p) { return __builtin_bit_cast(s16x4, __builtin_amdgcn_ds_read_tr16_b64_v4i16((LAS v4i16_t*)p)); }
__device__ __forceinline__ bf16x8 cat44(s16x4 a, s16x4 b) { bf16x8 r; r[0] = a[0]; r[1] = a[1]; r[2] = a[2]; r[3] = a[3]; r[4] = b[0]; r[5] = b[1]; r[6] = b[2]; r[7] = b[3]; return r; }
__device__ __forceinline__ unsigned cvt2(float lo, float hi) { return pg8::cvt_pk_bf16(lo, hi); }
__device__ __forceinline__ bf16x8 pack_frag(const f32x4 a, const f32x4 b) { v4u w; w.x = cvt2(a[0], a[1]); w.y = cvt2(a[2], a[3]); w.z = cvt2(b[0], b[1]); w.w = cvt2(b[2], b[3]); return __builtin_bit_cast(bf16x8, w); }
__device__ __forceinline__ float grp16_sum(float v, int lane) {
#pragma unroll
    for (int o = 1; o < 16; o <<= 1) v += __builtin_bit_cast(float, __builtin_amdgcn_ds_bpermute((lane ^ o) << 2, __builtin_bit_cast(int, v)));
    return v;
}
constexpr int RS_T = 544;
constexpr int TILE_T = 128 * RS_T;
static_assert(2 * TILE_T <= LDSCTL_OFF, "retention tiles vs LDS control words");

template <bool DECAY> __device__ __forceinline__ void stage_tile(LAS unsigned char* img, const bf16* src, int tid, float lg) {
    v4u v[8];
#pragma unroll
    for (int r = 0; r < 8; ++r) { const int pc = tid + 512 * r, row = pc >> 5, c16 = pc & 31; v[r] = *(const v4u*)(src + (size_t)row * 1024 + c16 * 8); }
#pragma unroll
    for (int r = 0; r < 8; ++r) { const int pc = tid + 512 * r, row = pc >> 5, c16 = pc & 31; v4u w = v[r];
        if (DECAY) { const float sc = exp2f(lg * (float)(127 - row));
            w.x = cvt2(bflo(w.x) * sc, bfhi(w.x) * sc); w.y = cvt2(bflo(w.y) * sc, bfhi(w.y) * sc); w.z = cvt2(bflo(w.z) * sc, bfhi(w.z) * sc); w.w = cvt2(bflo(w.w) * sc, bfhi(w.w) * sc); }
        *(LAS v4u*)(img + row * RS_T + c16 * 16) = w; }
}

template <bool DECAY_A> __device__ __forceinline__ void stage_two(LAS unsigned char* imgA, const bf16* srcA, LAS unsigned char* imgB, const bf16* srcB, int tid, float lg) {
    v4u va[8], vb[8];
#pragma unroll
    for (int r = 0; r < 8; ++r) { const int pc = tid + 512 * r, row = pc >> 5, c16 = pc & 31; va[r] = *(const v4u*)(srcA + (size_t)row * 1024 + c16 * 8); vb[r] = *(const v4u*)(srcB + (size_t)row * 1024 + c16 * 8); }
#pragma unroll
    for (int r = 0; r < 8; ++r) { const int pc = tid + 512 * r, row = pc >> 5, c16 = pc & 31; v4u w = va[r];
        if (DECAY_A) { const float sc = exp2f(lg * (float)(127 - row));
            w.x = cvt2(bflo(w.x) * sc, bfhi(w.x) * sc); w.y = cvt2(bflo(w.y) * sc, bfhi(w.y) * sc); w.z = cvt2(bflo(w.z) * sc, bfhi(w.z) * sc); w.w = cvt2(bflo(w.w) * sc, bfhi(w.w) * sc); }
        *(LAS v4u*)(imgA + row * RS_T + c16 * 16) = w; *(LAS v4u*)(imgB + row * RS_T + c16 * 16) = vb[r]; }
}

__device__ __forceinline__ void phase_ret_u_mfma(const Params& P, const Ctx& cx, LAS unsigned char* lds) {
    unsigned char* ws = cx.ws; const int tid = cx.tid, lane = cx.lane, w = cx.wave, r16 = lane & 15, g = lane >> 4, q = r16 >> 2, pp = r16 & 3;
    const bf16* K = (const bf16*)(ws + WS_K); const bf16* V = (const bf16*)(ws + WS_V); bf16* UT = (bf16*)(ws + WS_U);
    LAS unsigned char* Kim = lds; LAS unsigned char* Vim = lds + TILE_T;
    for (int b = cx.bid; b < 512; b += cx.G) {
        const int nb = b >> 2, h = b & 3;
        __syncthreads();
        stage_two<true>(Kim, K + (size_t)nb * 128 * 1024 + h * 256, Vim, V + (size_t)nb * 128 * 1024 + h * 256, tid, P.lg2g[h]);
        __syncthreads();
        f32x4 acc[2][16];
#pragma unroll
        for (int mi = 0; mi < 2; ++mi)
#pragma unroll
            for (int n = 0; n < 16; ++n) acc[mi][n] = (f32x4){0.f, 0.f, 0.f, 0.f};
#pragma unroll 1
        for (int s = 0; s < 4; ++s) {
            bf16x8 af[2];
#pragma unroll
            for (int mi = 0; mi < 2; ++mi) { LAS unsigned char* a0 = Kim + (32 * s + 8 * g + q) * RS_T + (16 * (2 * w + mi) + 4 * pp) * 2; af[mi] = cat44(lds_tr(a0), lds_tr(a0 + 4 * RS_T)); }
#pragma unroll
            for (int n = 0; n < 16; ++n) { LAS unsigned char* b0 = Vim + (32 * s + 8 * g + q) * RS_T + (16 * n + 4 * pp) * 2; const bf16x8 bfr = cat44(lds_tr(b0), lds_tr(b0 + 4 * RS_T));
                acc[0][n] = mfma16(af[0], bfr, acc[0][n]); acc[1][n] = mfma16(af[1], bfr, acc[1][n]); }
        }
#pragma unroll
        for (int mi = 0; mi < 2; ++mi)
#pragma unroll
            for (int n = 0; n < 16; ++n) { v2u o; o.x = cvt2(acc[mi][n][0], acc[mi][n][1]); o.y = cvt2(acc[mi][n][2], acc[mi][n][3]);
                *(v2u*)(UT + ((size_t)b * 256 + 16 * n + r16) * 256 + 16 * (2 * w + mi) + 4 * g) = o; }
    }
}
__device__ __forceinline__ void phase_scan_bf16(const Params& P, const Ctx& cx) {
    unsigned* UT = (unsigned*)(cx.ws + WS_U);
    const size_t gt = (size_t)cx.bid * 512 + cx.tid, NT = (size_t)cx.G * 512;
    for (size_t idx = gt; idx < 131072; idx += NT) {
        const int h = (int)(idx >> 15); const float cd = exp2f(P.lg2g[h] * 128.0f);
        float r0 = 0.f, r1 = 0.f;
        for (int n0 = 0; n0 < 128; n0 += 16) { unsigned u[16];
#pragma unroll
            for (int j = 0; j < 16; ++j) u[j] = UT[(size_t)(n0 + j) * 131072 + idx];
#pragma unroll
            for (int j = 0; j < 16; ++j) { UT[(size_t)(n0 + j) * 131072 + idx] = cvt2(r0, r1); r0 = r0 * cd + bflo(u[j]); r1 = r1 * cd + bfhi(u[j]); } }
    }
}
constexpr int RS_O = 1040;
static_assert(8 * 16 * RS_O <= 2 * TILE_T, "R3 output staging fits the shared area");
__device__ __forceinline__ void phase_ret_out_mfma(const Params& P, const Ctx& cx, int l, LAS unsigned char* lds) {
    unsigned char* ws = cx.ws; const int w = cx.wave;
    const bf16* Q = (const bf16*)(ws + WS_Q); const bf16* K = (const bf16*)(ws + WS_K); const bf16* V = (const bf16*)(ws + WS_V); const bf16* ST = (const bf16*)(ws + WS_U);
    const bf16* Gt = (const bf16*)(ws + WS_G); bf16* MIX = (bf16*)(ws + WS_MIX);
    const float* gg = P.in[5] + l * 1024; const float* gb = P.in[6] + l * 1024;
    LAS unsigned char* Kim = lds; LAS unsigned char* Vim = lds + TILE_T;
    for (int b = cx.bid; b < 512; b += cx.G) {
        const int nb = b >> 2, h = b & 3; const float lg = P.lg2g[h];
        int lane = cx.lane; asm volatile("" : "+v"(lane)); const int tid = w * 64 + lane, r16 = lane & 15, g = lane >> 4, q = r16 >> 2, pp = r16 & 3;
        __syncthreads();
        { const bf16* stb = ST + (size_t)b * 65536;
#pragma unroll
          for (int hf = 0; hf < 2; ++hf) { v4u v[8];
#pragma unroll
            for (int r = 0; r < 8; ++r) { const int pc = tid + 512 * (r + 8 * hf), row = pc >> 5, c16 = pc & 31; v[r] = *(const v4u*)(stb + (size_t)row * 256 + c16 * 8); }
#pragma unroll
            for (int r = 0; r < 8; ++r) { const int pc = tid + 512 * (r + 8 * hf), row = pc >> 5, c16 = pc & 31; *(LAS v4u*)(lds + row * RS_T + c16 * 16) = v[r]; } } }
        bf16x8 qf[8];
        { const bf16* qrow = Q + (size_t)(nb * 128 + 16 * w + r16) * 1024 + h * 256 + 8 * g;
#pragma unroll
          for (int s = 0; s < 8; ++s) qf[s] = *(const bf16x8*)(qrow + 32 * s); }
        const bf16* ksrc = K + (size_t)nb * 128 * 1024 + h * 256; const bf16* vsrc = V + (size_t)nb * 128 * 1024 + h * 256;
        v4u kv[8];
#pragma unroll
        for (int r = 0; r < 8; ++r) { const int pc = tid + 512 * r, row = pc >> 5, c16 = pc & 31; kv[r] = *(const v4u*)(ksrc + (size_t)row * 1024 + c16 * 8); }
        __syncthreads();
        f32x4 acc[16];
#pragma unroll
        for (int n = 0; n < 16; ++n) { f32x4 a = (f32x4){0.f, 0.f, 0.f, 0.f};
            const LAS unsigned char* sp = lds + (16 * n + r16) * RS_T + 16 * g;
#pragma unroll
            for (int s = 0; s < 8; ++s) a = mfma16(qf[s], *(const LAS bf16x8*)(sp + 64 * s), a);
            acc[n] = a; if ((n & 3) == 3) __builtin_amdgcn_sched_barrier(0); }
        { float f[4];
#pragma unroll
          for (int r = 0; r < 4; ++r) f[r] = exp2f(lg * (float)(16 * w + 4 * g + r + 1));
#pragma unroll
          for (int n = 0; n < 16; ++n) { acc[n][0] *= f[0]; acc[n][1] *= f[1]; acc[n][2] *= f[2]; acc[n][3] *= f[3]; } }
        __syncthreads();
        v4u vv[8];
#pragma unroll
        for (int r = 0; r < 8; ++r) { const int pc = tid + 512 * r, row = pc >> 5, c16 = pc & 31; *(LAS v4u*)(Kim + row * RS_T + c16 * 16) = kv[r]; vv[r] = *(const v4u*)(vsrc + (size_t)row * 1024 + c16 * 8); }
        __syncthreads();
        f32x4 sc[8];
#pragma unroll
        for (int mb = 0; mb < 8; ++mb) { sc[mb] = (f32x4){0.f, 0.f, 0.f, 0.f};
            if (mb <= w) { f32x4 a = (f32x4){0.f, 0.f, 0.f, 0.f};
#pragma unroll
                for (int s = 0; s < 8; ++s) { const bf16x8 kf = *(const LAS bf16x8*)(Kim + (16 * mb + r16) * RS_T + (32 * s + 8 * g) * 2); a = mfma16(kf, qf[s], a); }
                const int i = 16 * w + r16;
#pragma unroll
                for (int r = 0; r < 4; ++r) { const int j = 16 * mb + 4 * g + r; a[r] = (i >= j) ? a[r] * exp2f(lg * (float)(i - j)) : 0.f; }
                sc[mb] = a; } }
#pragma unroll
        for (int r = 0; r < 8; ++r) { const int pc = tid + 512 * r, row = pc >> 5, c16 = pc & 31; *(LAS v4u*)(Vim + row * RS_T + c16 * 16) = vv[r]; }
        __syncthreads();
#pragma unroll
        for (int sk = 0; sk < 4; ++sk) {
            if (2 * sk <= w) { const bf16x8 pf = pack_frag(sc[2 * sk], sc[2 * sk + 1]);
#pragma unroll
                for (int n = 0; n < 16; ++n) { LAS unsigned char* b0 = Vim + (32 * sk + 4 * g + q) * RS_T + (16 * n + 4 * pp) * 2; const bf16x8 bfr = cat44(lds_tr(b0), lds_tr(b0 + 16 * RS_T));
                    acc[n] = mfma16(pf, bfr, acc[n]); } } }
        float mean[4], rstd[4];
#pragma unroll
        for (int r = 0; r < 4; ++r) { float sm = 0.f;
#pragma unroll
            for (int n = 0; n < 16; ++n) sm += acc[n][r];
            mean[r] = grp16_sum(sm, lane) * (1.0f / 256.0f); }
#pragma unroll
        for (int r = 0; r < 4; ++r) { float sq = 0.f;
#pragma unroll
            for (int n = 0; n < 16; ++n) { const float d = acc[n][r] - mean[r]; sq += d * d; }
            rstd[r] = 1.0f / sqrtf(grp16_sum(sq, lane) * (1.0f / 256.0f) + GN_EPS); }
        __syncthreads();
        { LAS unsigned char* ob = lds + w * (16 * RS_O);
#pragma unroll
          for (int n = 0; n < 16; ++n)
#pragma unroll
            for (int r = 0; r < 4; ++r) *(LAS float*)(ob + (4 * g + r) * RS_O + (16 * n + r16) * 4) = (acc[n][r] - mean[r]) * rstd[r];
          LDS_WAIT(); asm volatile("" ::: "memory");
          const int e0 = 8 * (lane & 31), hv = lane >> 5;
          const f32x4 g0 = *(const f32x4*)(gg + h * 256 + e0), g1 = *(const f32x4*)(gg + h * 256 + e0 + 4), b0 = *(const f32x4*)(gb + h * 256 + e0), b1 = *(const f32x4*)(gb + h * 256 + e0 + 4);
#pragma unroll
          for (int k = 0; k < 8; ++k) { const int rl = 2 * k + hv; const size_t row = (size_t)(nb * 128 + 16 * w + rl);
              const f32x4 y0 = *(const LAS f32x4*)(ob + rl * RS_O + e0 * 4), y1 = *(const LAS f32x4*)(ob + rl * RS_O + e0 * 4 + 16);
              const v4u gt = *(const v4u*)(Gt + row * 1024 + h * 256 + e0);
              const f32x4 o0 = y0 * g0 + b0, o1 = y1 * g1 + b1;
              v4u o; o.x = cvt2(o0[0] * bflo(gt.x), o0[1] * bfhi(gt.x)); o.y = cvt2(o0[2] * bflo(gt.y), o0[3] * bfhi(gt.y)); o.z = cvt2(o1[0] * bflo(gt.z), o1[1] * bfhi(gt.z)); o.w = cvt2(o1[2] * bflo(gt.w), o1[3] * bfhi(gt.w));
              *(v4u*)(MIX + row * 2048 + h * 256 + e0) = o; } }
    }
}
constexpr int RS_SK = 144, RS_SV = 160;
__device__ __forceinline__ void phase_swa_mfma(const Params& P, const Ctx& cx, int l, LAS unsigned char* lds) {
    unsigned char* ws = cx.ws; const int tid = cx.tid, lane = cx.lane, w = cx.wave, r16 = lane & 15, g = lane >> 4, q = r16 >> 2, pp = r16 & 3;
    const bf16* AQ = (const bf16*)(ws + WS_AQ); const bf16* AK = (const bf16*)(ws + WS_AK); const bf16* AV = (const bf16*)(ws + WS_AV); bf16* MIX = (bf16*)(ws + WS_MIX);
    LAS unsigned char* Kim = lds; LAS unsigned char* Vim = lds + 256 * RS_SK;
    for (int item = cx.bid; item < 256; item += cx.G) {
        const int nb = item >> 1, hk = item & 1, hq = hk * 8 + w; const float sink = P.in[7][l * 16 + hq];
        __syncthreads();
#pragma unroll
        for (int r = 0; r < 4; ++r) { const int pc = tid + 512 * r, row = pc >> 3, c = pc & 7, gk = nb * 128 - 128 + row;
            v4u kv = (v4u){0u, 0u, 0u, 0u}, vv = (v4u){0u, 0u, 0u, 0u};
            if (gk >= 0) { kv = *(const v4u*)(AK + (size_t)gk * 128 + hk * 64 + c * 8); vv = *(const v4u*)(AV + (size_t)gk * 128 + hk * 64 + c * 8); }
            *(LAS v4u*)(Kim + row * RS_SK + c * 16) = kv; *(LAS v4u*)(Vim + row * RS_SV + c * 16) = vv; }
        __syncthreads();
#pragma unroll 1
        for (int nq = 0; nq < 8; ++nq) {
            const bf16* qrow = AQ + (size_t)(nb * 128 + 16 * nq + r16) * 1024 + hq * 64 + 8 * g;
            const bf16x8 qf0 = *(const bf16x8*)(qrow), qf1 = *(const bf16x8*)(qrow + 32);
            f32x4 sc[10];
            float mx = sink;
#pragma unroll
            for (int kb = 0; kb < 9; ++kb) { const LAS unsigned char* kp = Kim + (16 * (nq + kb) + r16) * RS_SK + 16 * g;
                f32x4 a = (f32x4){0.f, 0.f, 0.f, 0.f};
                a = mfma16(*(const LAS bf16x8*)(kp), qf0, a); a = mfma16(*(const LAS bf16x8*)(kp + 64), qf1, a);
#pragma unroll
                for (int r = 0; r < 4; ++r) { const int dl = 16 * kb + 4 * g + r - r16; const bool vis = (dl >= 1) && (dl <= 128) && (nb > 0 || 16 * (nq + kb) + 4 * g + r >= 128);
                    a[r] = vis ? a[r] : -INFINITY; mx = fmaxf(mx, a[r]); }
                sc[kb] = a; }
            sc[9] = (f32x4){0.f, 0.f, 0.f, 0.f};
            mx = fmaxf(mx, __builtin_bit_cast(float, __builtin_amdgcn_ds_bpermute((lane ^ 16) << 2, __builtin_bit_cast(int, mx))));
            mx = fmaxf(mx, __builtin_bit_cast(float, __builtin_amdgcn_ds_bpermute((lane ^ 32) << 2, __builtin_bit_cast(int, mx))));
            float sum = 0.f;
#pragma unroll
            for (int kb = 0; kb < 9; ++kb)
#pragma unroll
                for (int r = 0; r < 4; ++r) { const float pv = __expf(sc[kb][r] - mx); sc[kb][r] = pv; sum += pv; }
            sum += __builtin_bit_cast(float, __builtin_amdgcn_ds_bpermute((lane ^ 16) << 2, __builtin_bit_cast(int, sum)));
            sum += __builtin_bit_cast(float, __builtin_amdgcn_ds_bpermute((lane ^ 32) << 2, __builtin_bit_cast(int, sum)));
            const float inv = 1.0f / (sum + __expf(sink - mx));
            f32x4 o[4];
#pragma unroll
            for (int nd = 0; nd < 4; ++nd) o[nd] = (f32x4){0.f, 0.f, 0.f, 0.f};
#pragma unroll
            for (int sk = 0; sk < 5; ++sk) { const bf16x8 pf = pack_frag(sc[2 * sk] * inv, sc[2 * sk + 1] * inv);
                const int kb0 = nq + 2 * sk, kb1 = (kb0 + 1 > 15) ? 15 : kb0 + 1;
#pragma unroll
                for (int nd = 0; nd < 4; ++nd) { const bf16x8 bfr = cat44(lds_tr(Vim + (16 * kb0 + 4 * g + q) * RS_SV + (16 * nd + 4 * pp) * 2), lds_tr(Vim + (16 * kb1 + 4 * g + q) * RS_SV + (16 * nd + 4 * pp) * 2));
                    o[nd] = mfma16(pf, bfr, o[nd]); } }
#pragma unroll
            for (int nd = 0; nd < 4; ++nd)
#pragma unroll
                for (int r = 0; r < 4; ++r) MIX[(size_t)(nb * 128 + 16 * nq + 4 * g + r) * 2048 + 1024 + hq * 64 + 16 * nd + r16] = (bf16)f2bf(o[nd][r]);
        }
    }
}

__device__ __forceinline__ void phase_groupnorm(const Params& P, const Ctx& cx, int l) {
    unsigned char* ws = cx.ws; const int lane = cx.lane, wave = cx.wave, G = cx.G;
    const float* RY = (const float*)(ws + WS_RETY); const bf16* Gt = (const bf16*)(ws + WS_G); bf16* MIX = (bf16*)(ws + WS_MIX);
    const float* gg = P.in[5] + l * 1024; const float* gb = P.in[6] + l * 1024;
    const int gw = cx.bid * 8 + wave, NGW = G * 8;
    for (int it = gw; it < S * 4; it += NGW) { const int row = it >> 2, h = it & 3; const size_t off = (size_t)row * 1024 + h * 256 + 4 * lane;
        f32x4 v = *(const f32x4*)(RY + off);
        const float mean = wave_sum((v[0] + v[1]) + (v[2] + v[3]), lane) * (1.0f / 256.0f);
        v = v - mean;
        const float var = wave_sum((v[0] * v[0] + v[1] * v[1]) + (v[2] * v[2] + v[3] * v[3]), lane) * (1.0f / 256.0f);
        const float rstd = 1.0f / sqrtf(var + GN_EPS);
        const f32x4 g4 = *(const f32x4*)(gg + h * 256 + 4 * lane), b4 = *(const f32x4*)(gb + h * 256 + 4 * lane);
        const v2u gt2 = *(const v2u*)(Gt + off);
        f32x4 o = v * rstd * g4 + b4;
        o[0] *= bflo(gt2.x); o[1] *= bfhi(gt2.x); o[2] *= bflo(gt2.y); o[3] *= bfhi(gt2.y);
        v2u w; w.x = pk2(o[0], o[1]); w.y = pk2(o[2], o[3]);
        *(v2u*)(MIX + (size_t)row * 2048 + h * 256 + 4 * lane) = w; }
}
__device__ __forceinline__ void phase_ln(const Ctx& cx, const float* Y, const float* g, const float* b, float* xo, bf16* xb, float* stats) {
    const int lane = cx.lane, wave = cx.wave, G = cx.G; const int gw = cx.bid * 8 + wave, NGW = G * 8;
    f32x4 g4[8], b4[8];
#pragma unroll
    for (int j = 0; j < 8; ++j) { g4[j] = ((const f32x4*)g)[64 * j + lane]; b4[j] = ((const f32x4*)b)[64 * j + lane]; }
    for (int row = gw; row < S; row += 2 * NGW) {
        const int row2 = row + NGW; const bool has2 = row2 < S; const int rb = has2 ? row2 : row;
        const f32x4* ya = (const f32x4*)(Y + (size_t)row * D) + lane; const f32x4* yb = (const f32x4*)(Y + (size_t)rb * D) + lane;
        f32x4 va[8], vb[8]; float sa = 0.f, sb = 0.f;
#pragma unroll
        for (int j = 0; j < 8; ++j) { va[j] = ya[64 * j]; vb[j] = yb[64 * j]; }
#pragma unroll
        for (int j = 0; j < 8; ++j) { sa += (va[j][0] + va[j][1]) + (va[j][2] + va[j][3]); sb += (vb[j][0] + vb[j][1]) + (vb[j][2] + vb[j][3]); }
        const float ma = wave_sum(sa, lane) * (1.0f / D), mb = wave_sum(sb, lane) * (1.0f / D); float qa = 0.f, qb = 0.f;
#pragma unroll
        for (int j = 0; j < 8; ++j) { va[j] = va[j] - ma; vb[j] = vb[j] - mb; qa += (va[j][0] * va[j][0] + va[j][1] * va[j][1]) + (va[j][2] * va[j][2] + va[j][3] * va[j][3]); qb += (vb[j][0] * vb[j][0] + vb[j][1] * vb[j][1]) + (vb[j][2] * vb[j][2] + vb[j][3] * vb[j][3]); }
        const float ra = 1.0f / sqrtf(wave_sum(qa, lane) * (1.0f / D) + LN_EPS), rbb = 1.0f / sqrtf(wave_sum(qb, lane) * (1.0f / D) + LN_EPS);
        f32x4* xa = (f32x4*)(xo + (size_t)row * D) + lane; f32x4* xbp = (f32x4*)(xo + (size_t)rb * D) + lane;
        if (stats && lane == 0) { stats[2 * (size_t)row] = ma; stats[2 * (size_t)row + 1] = ra; if (has2) { stats[2 * (size_t)rb] = mb; stats[2 * (size_t)rb + 1] = rbb; } }
#pragma unroll
        for (int j = 0; j < 8; ++j) { const f32x4 o = va[j] * ra * g4[j] + b4[j]; if (xo) xa[64 * j] = o;
            if (xb) { v2u w; w.x = pk2(o[0], o[1]); w.y = pk2(o[2], o[3]); ((v2u*)(xb + (size_t)row * D))[64 * j + lane] = w; } }
        if (has2) {
#pragma unroll
            for (int j = 0; j < 8; ++j) { const f32x4 o = vb[j] * rbb * g4[j] + b4[j]; if (xo) xbp[64 * j] = o;
                if (xb) { v2u w; w.x = pk2(o[0], o[1]); w.y = pk2(o[2], o[3]); ((v2u*)(xb + (size_t)rb * D))[64 * j + lane] = w; } } }
    }
}
__device__ __forceinline__ void unpack8(const v4u h, float (&o)[8]) { o[0] = bflo(h.x); o[1] = bfhi(h.x); o[2] = bflo(h.y); o[3] = bfhi(h.y); o[4] = bflo(h.z); o[5] = bfhi(h.z); o[6] = bflo(h.w); o[7] = bfhi(h.w); }
__device__ __forceinline__ void phase_convact(const Params& P, const Ctx& cx, int l) {
    unsigned char* ws = cx.ws; const int tid = cx.tid, G = cx.G;
    const bf16* H = (const bf16*)(ws + WS_H); bf16* ACT = (bf16*)(ws + WS_ACT);
    const float* cw = P.in[11] + (size_t)l * 3 * NUP; const float* cb = P.in[12] + (size_t)l * NUP;
    const int gt = cx.bid * 512 + tid, NT = G * 512;
    for (int item = gt; item < 512 * 704; item += NT) {
        const int seg = item / 704, r = item - seg * 704, tile = r >> 4, q8 = r & 15, t0 = seg * 32;
        const int chg = 128 * tile + 8 * q8, chu = DFF + chg;
        float wg[3][8], wu[3][8], bg[8], bu[8];
#pragma unroll
        for (int k = 0; k < 3; ++k) { const f32x4 a0 = *(const f32x4*)(cw + (size_t)k * NUP + chg), a1 = *(const f32x4*)(cw + (size_t)k * NUP + chg + 4), c0 = *(const f32x4*)(cw + (size_t)k * NUP + chu), c1 = *(const f32x4*)(cw + (size_t)k * NUP + chu + 4);
#pragma unroll
            for (int e = 0; e < 4; ++e) { wg[k][e] = a0[e]; wg[k][4 + e] = a1[e]; wu[k][e] = c0[e]; wu[k][4 + e] = c1[e]; } }
        { const f32x4 a0 = *(const f32x4*)(cb + chg), a1 = *(const f32x4*)(cb + chg + 4), c0 = *(const f32x4*)(cb + chu), c1 = *(const f32x4*)(cb + chu + 4);
#pragma unroll
          for (int e = 0; e < 4; ++e) { bg[e] = a0[e]; bg[4 + e] = a1[e]; bu[e] = c0[e]; bu[4 + e] = c1[e]; } }
        const bf16* hp = H + (size_t)t0 * NUP + 256 * tile + 8 * q8;
        float g2[8], g1[8], u2[8], u1[8];
        if (t0 > 0) { unpack8(*(const v4u*)(hp - 2 * (size_t)NUP), g2); unpack8(*(const v4u*)(hp - (size_t)NUP), g1); unpack8(*(const v4u*)(hp - 2 * (size_t)NUP + 128), u2); unpack8(*(const v4u*)(hp - (size_t)NUP + 128), u1); }
        else {
#pragma unroll
            for (int e = 0; e < 8; ++e) { g2[e] = 0.f; g1[e] = 0.f; u2[e] = 0.f; u1[e] = 0.f; } }
        bf16* ap = ACT + (size_t)t0 * DFF + chg;
        v4u ng = *(const v4u*)(hp), nu = *(const v4u*)(hp + 128);
#pragma unroll 2
        for (int tt = 0; tt < 32; ++tt) {
            float g0[8], u0[8]; unpack8(ng, g0); unpack8(nu, u0);
            if (tt < 31) { ng = *(const v4u*)(hp + (size_t)(tt + 1) * NUP); nu = *(const v4u*)(hp + (size_t)(tt + 1) * NUP + 128); }
            float o[8];
#pragma unroll
            for (int e = 0; e < 8; ++e) { const float ga = bg[e] + wg[0][e] * g2[e] + wg[1][e] * g1[e] + wg[2][e] * g0[e], ua = bu[e] + wu[0][e] * u2[e] + wu[1][e] * u1[e] + wu[2][e] * u0[e];
                o[e] = ga * __builtin_amdgcn_rcpf(1.0f + __expf(-ga)) * ua; g2[e] = g1[e]; g1[e] = g0[e]; u2[e] = u1[e]; u1[e] = u0[e]; }
            v4u w; w.x = cvt2(o[0], o[1]); w.y = cvt2(o[2], o[3]); w.z = cvt2(o[4], o[5]); w.w = cvt2(o[6], o[7]);
            *(v4u*)(ap + (size_t)tt * DFF) = w;
        }
    }
}

__device__ __forceinline__ void phase_conv_fixup(const Params& P, const Ctx& cx, int l) {
    unsigned char* ws = cx.ws;
    const bf16* HALO = (const bf16*)(ws + WS_H); bf16* ACT = (bf16*)(ws + WS_ACT);
    const float* cw = P.in[11] + (size_t)l * 3 * NUP; const float* cb = P.in[12] + (size_t)l * NUP;
    const int gt = cx.bid * 512 + cx.tid, NT = cx.G * 512;
    for (int item = gt; item < 256 * 704; item += NT) {
        const int k = item / 704, r = item - k * 704, tile = r >> 4, q8 = r & 15, chg = 128 * tile + 8 * q8, chu = DFF + chg;
        float a_g[8], b_g[8], c_g[8], d_g[8], a_u[8], b_u[8], c_u[8], d_u[8];
        const bf16* hk = HALO + (size_t)k * 4 * NUP + 256 * tile + 8 * q8;
        unpack8(*(const v4u*)(hk), c_g); unpack8(*(const v4u*)(hk + NUP), d_g); unpack8(*(const v4u*)(hk + 128), c_u); unpack8(*(const v4u*)(hk + NUP + 128), d_u);
        if (k > 0) { const bf16* hm = hk - 4 * (size_t)NUP; unpack8(*(const v4u*)(hm + 2 * NUP), a_g); unpack8(*(const v4u*)(hm + 3 * NUP), b_g); unpack8(*(const v4u*)(hm + 2 * NUP + 128), a_u); unpack8(*(const v4u*)(hm + 3 * NUP + 128), b_u); }
        else {
#pragma unroll
            for (int e = 0; e < 8; ++e) { a_g[e] = 0.f; b_g[e] = 0.f; a_u[e] = 0.f; b_u[e] = 0.f; } }
        float o0[8], o1[8];
#pragma unroll
        for (int e = 0; e < 8; ++e) { const float w0g = cw[chg + e], w1g = cw[NUP + chg + e], w2g = cw[2 * NUP + chg + e], bgv = cb[chg + e], w0u = cw[chu + e], w1u = cw[NUP + chu + e], w2u = cw[2 * NUP + chu + e], buv = cb[chu + e];
            const float g0 = bgv + w0g * a_g[e] + w1g * b_g[e] + w2g * c_g[e], u0 = buv + w0u * a_u[e] + w1u * b_u[e] + w2u * c_u[e];
            const float g1 = bgv + w0g * b_g[e] + w1g * c_g[e] + w2g * d_g[e], u1 = buv + w0u * b_u[e] + w1u * c_u[e] + w2u * d_u[e];
            o0[e] = g0 * __builtin_amdgcn_rcpf(1.0f + __expf(-g0)) * u0; o1[e] = g1 * __builtin_amdgcn_rcpf(1.0f + __expf(-g1)) * u1; }
        v4u w0, w1; w0.x = cvt2(o0[0], o0[1]); w0.y = cvt2(o0[2], o0[3]); w0.z = cvt2(o0[4], o0[5]); w0.w = cvt2(o0[6], o0[7]); w1.x = cvt2(o1[0], o1[1]); w1.y = cvt2(o1[2], o1[3]); w1.z = cvt2(o1[4], o1[5]); w1.w = cvt2(o1[6], o1[7]);
        *(v4u*)(ACT + pg8::tiled_off(64 * k, chg, DFF)) = w0; *(v4u*)(ACT + pg8::tiled_off(64 * k + 1, chg, DFF)) = w1;
    }
}

#ifdef DBG_DUMP
__device__ __forceinline__ void phase_dump(const Ctx& cx, float* out, const bf16* a, int lda, const bf16* b, int ldb, const float* f) {
    const size_t gt = (size_t)cx.bid * 512 + cx.tid, NT = (size_t)cx.G * 512;
    for (size_t i = gt; i < (size_t)S * D; i += NT) { const int row = (int)(i >> 11), col = (int)(i & 2047);
        float v; if (f) v = f[i]; else if (b && col >= 1024) v = bf1(b + (size_t)row * ldb + (col - 1024)); else v = lda ? bf1(a + (size_t)row * lda + col) : bf1(a + (size_t)(row & 2047) * 2048 + col);
        out[i] = v; }
}
#endif
__global__ void __launch_bounds__(512, 2) fwd(Params P) {
    extern __shared__ __attribute__((aligned(16))) unsigned char lds_raw[];
    LAS unsigned char* lds = (LAS unsigned char*)lds_raw;
    const int wave = __builtin_amdgcn_readfirstlane(threadIdx.x >> 6), G = gridDim.x;
    unsigned char* ws = P.ws;
    volatile LAS unsigned* MISC = (volatile LAS unsigned*)(lds + MISC_OFF);
    for (int u = threadIdx.x; u < (LDS_BYTES - LDSCTL_OFF) / 4; u += 512) ((LAS unsigned*)(lds + LDSCTL_OFF))[u] = 0u;
    __syncthreads();
    const int lo = P.ph_lo, hi = P.ph_hi;
    XcdBarrier bar; bar.bar = (unsigned*)(ws + WS_CTL) + CW_BAR; bar.x = 0; bar.st = nullptr;
    if (hi - lo > 1) bar = xcd_barrier_post((unsigned*)(ws + WS_CTL) + CW_BAR, MISC + 8);
#define IN(k) (lo <= (k) && (k) < hi)
#if PROBE_DUP == 20
#define SEAM(k) do { if (IN(k) && IN((k) + 1)) { xcd_barrier(bar); xcd_barrier(bar); } } while (0)
#else
#define SEAM(k) do { if (IN(k) && IN((k) + 1)) xcd_barrier(bar); } while (0)
#endif
#define OPQ() Ctx cx; cx.lane = lane_id_asm(); { int t_ = wave; asm volatile("" : "+s"(t_)); cx.wave = t_; } { int t_ = G; asm volatile("" : "+s"(t_)); cx.G = t_; } { int t_ = blockIdx.x; asm volatile("" : "+s"(t_)); cx.bid = t_; } \
    { unsigned t_ = 0u; asm volatile("" : "+s"(t_)); cx.ws = P.ws + t_; } cx.tid = cx.wave * 64 + cx.lane; int lq = l; asm volatile("" : "+s"(lq)); (void)lq

#ifdef DBG_DUMP
    if (lo >= 1000) { const int l = 0; OPQ(); unsigned char* w = cx.ws; const int kind = lo - 1000;
        if (kind == 1) phase_dump(cx, P.out, (const bf16*)(w + WS_Q), 1024, (const bf16*)(w + WS_AQ), 1024, nullptr);
        else if (kind == 2) phase_dump(cx, P.out, (const bf16*)(w + WS_MIX), 2048, nullptr, 0, nullptr);
        else if (kind == 3) phase_dump(cx, P.out, nullptr, 0, nullptr, 0, (const float*)(w + WS_XR));
        else if (kind == 4) phase_dump(cx, P.out, (const bf16*)(w + WS_ACT), DFF, nullptr, 0, nullptr);
        else if (kind == 5) phase_dump(cx, P.out, nullptr, 0, nullptr, 0, (const float*)(w + WS_Y));
        else if (kind == 6) phase_dump(cx, P.out, (const bf16*)(w + WS_K), 1024, (const bf16*)(w + WS_V), 1024, nullptr);
        else if (kind == 7) phase_dump(cx, P.out, (const bf16*)(w + WS_XB), 2048, nullptr, 0, nullptr);
        else if (kind == 11) phase_dump(cx, P.out, (const bf16*)(w + WS_W + WL_G), 0, nullptr, 0, nullptr);
        else if (kind == 12) phase_dump(cx, P.out, (const bf16*)(w + WS_W + WL_OUT), 0, nullptr, 0, nullptr);
        else if (kind == 10) phase_dump(cx, P.out, (const bf16*)(w + WS_H) + 36 * 256, NUP, nullptr, 0, nullptr);
        else if (kind == 9) phase_dump(cx, P.out, (const bf16*)(w + WS_SG), 2048, nullptr, 0, nullptr);
        else if (kind == 8) phase_dump(cx, P.out, nullptr, 0, nullptr, 0, (const float*)(w + WS_RETY));
        return; }
#endif
    if (IN(0)) { const int l = 0; REPS(9) { __syncthreads(); OPQ(); phase_prologue(P, cx, lds); } }
    SEAM(0);

    for (int l = 0; l < DEPTH; ++l) {
        const int pb = 1 + l * NPH;
        if (IN(pb + 0)) { REPS(3) { OPQ(); unsigned char* w = cx.ws; const bf16* wl = (const bf16*)(w + WS_W + (size_t)lq * WL_BYTES);
            pg8::Gemm g{(const bf16*)(w + WS_XB), wl + WL_IN / 2, S, INW, D}; pg8::StaticOrder So; So.init(S, INW, cx.G, cx.bid);
            pg8::EpiInProj E{(bf16*)(w + WS_Q), (bf16*)(w + WS_K), (bf16*)(w + WS_V), (bf16*)(w + WS_G), (bf16*)(w + WS_AQ), (bf16*)(w + WS_AK), (bf16*)(w + WS_AV),
                             (const float*)(w + WS_COSR), (const float*)(w + WS_SINR), (const float*)(w + WS_COSA), (const float*)(w + WS_SINA)};
            pg8::gemm_phase<pg8::EpiInProj, pg8::StaticOrder, true, true>(lds, g, So, E, cx.wave);
        } }
#if PLE_EARLY
        if (IN(pb + 0)) { OPQ(); unsigned char* w = cx.ws; const bf16* wl = (const bf16*)(w + WS_W + (size_t)lq * WL_BYTES);
            const int nsub = (cx.G > 64) ? cx.G - 64 : cx.G, csub = (cx.G > 64) ? cx.bid - 64 : cx.bid;
            if (csub >= 0) {
                int kple = PLE; asm volatile("" : "+s"(kple));
                pg8::Gemm g{(const bf16*)(w + WS_PB) + (size_t)lq * S * PLE, wl + WL_P / 2, S, D, kple}; pg8::StaticOrder So; So.init(S, D, nsub, csub);
                pg8::EpiPlain E{(bf16*)(w + WS_PP)};
                pg8::gemm_phase<pg8::EpiPlain, pg8::StaticOrder, true, true>(lds, g, So, E, cx.wave); }
        }
#endif
        SEAM(pb + 0);
        if (IN(pb + 1)) {
#if RET_MFMA
            { REPS(6) { OPQ(); phase_ret_u_mfma(P, cx, lds); } }
#else
            { OPQ(); phase_ret_u_scores(P, cx, lds); }
#endif
#if SWA_MFMA
            { REPS(8) { OPQ(); phase_swa_mfma(P, cx, lq, lds); } }
#else
            { OPQ(); phase_swa(P, cx, lq, lds); }
#endif
        }
        SEAM(pb + 1);
#if RET_MFMA
        if (IN(pb + 2)) { OPQ(); phase_scan_bf16(P, cx); }
        SEAM(pb + 2);
        if (IN(pb + 3)) { REPS(7) { OPQ(); phase_ret_out_mfma(P, cx, lq, lds); } }
        SEAM(pb + 3);
#else
        if (IN(pb + 2)) { OPQ(); phase_scan(P, cx); }
        SEAM(pb + 2);
        if (IN(pb + 3)) { OPQ(); phase_ret_out(P, cx, lds); }
        SEAM(pb + 3);
        if (IN(pb + 4)) { OPQ(); phase_groupnorm(P, cx, lq); }
        SEAM(pb + 4);
#endif
        if (IN(pb + 5)) { OPQ(); unsigned char* w = cx.ws; const bf16* wl = (const bf16*)(w + WS_W + (size_t)lq * WL_BYTES);
            pg8::Gemm g{(const bf16*)(w + WS_MIX), wl + WL_OUT / 2, S, D, D}; pg8::StaticOrder So; So.init(S, D, cx.G, cx.bid);
#if LN_NOXR
            if (lq == 0) { pg8::EpiResid<false> E{P.in[0], (float*)(w + WS_Y), ALPHA};
                pg8::gemm_phase<pg8::EpiResid<false>, pg8::StaticOrder, true, true>(lds, g, So, E, cx.wave); }
            else {
#if PROBE_DUP == 30
                { pg8::EpiResidLN<false> E{(float*)(w + WS_Y), (float*)(w + WS_XR + 2 * MiB), (const float*)(w + WS_ST2), P.in[14] + (lq - 1) * D, P.in[15] + (lq - 1) * D, nullptr, nullptr, ALPHA};
                  pg8::gemm_phase<pg8::EpiResidLN<false>, pg8::StaticOrder, true, true>(lds, g, So, E, cx.wave); }
#endif
                pg8::EpiResidLN<false> E{(float*)(w + WS_Y), (float*)(w + WS_Y), (const float*)(w + WS_ST2), P.in[14] + (lq - 1) * D, P.in[15] + (lq - 1) * D, nullptr, nullptr, ALPHA};
                pg8::gemm_phase<pg8::EpiResidLN<false>, pg8::StaticOrder, true, true>(lds, g, So, E, cx.wave); }
#else
            pg8::EpiResid<false> E{(lq == 0) ? P.in[0] : (const float*)(w + WS_XR), (float*)(w + WS_Y), ALPHA};
            pg8::gemm_phase<pg8::EpiResid<false>, pg8::StaticOrder, true, true>(lds, g, So, E, cx.wave);
#endif
        }
        SEAM(pb + 5);
        if (IN(pb + 6)) { REPS(1) { OPQ(); unsigned char* w = cx.ws;
#if LN_NOXR
            phase_ln(cx, (const float*)(w + WS_Y), P.in[8] + lq * D, P.in[9] + lq * D, (float*)nullptr, (bf16*)(w + WS_XB), (float*)(w + WS_ST1));
#else
            phase_ln(cx, (const float*)(w + WS_Y), P.in[8] + lq * D, P.in[9] + lq * D, (float*)(w + WS_XR), (bf16*)(w + WS_XB), (float*)nullptr);
#endif
        } }
        SEAM(pb + 6);
        if (IN(pb + 7)) { REPS(5) { OPQ(); unsigned char* w = cx.ws; const bf16* wl = (const bf16*)(w + WS_W + (size_t)lq * WL_BYTES);
            pg8::Gemm g{(const bf16*)(w + WS_XB), wl + WL_UP / 2, S, NUPG, D}; pg8::StaticOrder So; So.init(S, NUPG, cx.G, cx.bid);
#if CONV_FUSED
            pg8::EpiUpConv E{(bf16*)(w + WS_ACT), (bf16*)(w + WS_H), (bf16*)(w + WS_SG), P.in[17] + lq * D, P.in[11] + (size_t)lq * 3 * NUP, P.in[12] + (size_t)lq * NUP};
            pg8::gemm_phase<pg8::EpiUpConv, pg8::StaticOrder, true, true>(lds, g, So, E, cx.wave);
#else
            pg8::EpiUp E{(bf16*)(w + WS_H), (bf16*)(w + WS_SG), P.in[17] + lq * D};
            pg8::gemm_phase<pg8::EpiUp, pg8::StaticOrder, true, true>(lds, g, So, E, cx.wave);
#endif
        } }
        SEAM(pb + 7);
        if (IN(pb + 8)) {
#if !PLE_EARLY
            { OPQ(); unsigned char* w = cx.ws; const bf16* wl = (const bf16*)(w + WS_W + (size_t)lq * WL_BYTES);
              pg8::Gemm g{(const bf16*)(w + WS_PB) + (size_t)lq * S * PLE, wl + WL_P / 2, S, D, PLE}; pg8::StaticOrder So; So.init(S, D, cx.G, cx.bid);
              pg8::EpiPle E{(const bf16*)(w + WS_SG), (float*)(w + WS_Y)};
              pg8::gemm_phase<pg8::EpiPle, pg8::StaticOrder, true, true>(lds, g, So, E, cx.wave); }
#endif
#if CONV_FUSED
            { OPQ(); phase_conv_fixup(P, cx, lq); }
#else
            { REPS(1) { OPQ(); phase_convact(P, cx, lq); } }
#endif
        }
        SEAM(pb + 8);
        if (IN(pb + 9)) { OPQ(); unsigned char* w = cx.ws; const bf16* wl = (const bf16*)(w + WS_W + (size_t)lq * WL_BYTES);
            pg8::Gemm g{(const bf16*)(w + WS_ACT), wl + WL_DOWN / 2, S, D, DFF, 0, 0, 1, 1}; pg8::StaticOrder So; So.init(S, D, cx.G, cx.bid);
#if PLE_EARLY
#if LN_NOXR
#if PROBE_DUP == 31
            { pg8::EpiResidLN<true> E{(float*)(w + WS_Y), (float*)(w + WS_XR + 2 * MiB), (const float*)(w + WS_ST1), P.in[8] + lq * D, P.in[9] + lq * D, (const bf16*)(w + WS_PP), (const bf16*)(w + WS_SG), ALPHA};
              pg8::gemm_phase<pg8::EpiResidLN<true>, pg8::StaticOrder, true, true>(lds, g, So, E, cx.wave); }
#endif
            pg8::EpiResidLN<true> E{(float*)(w + WS_Y), (float*)(w + WS_Y), (const float*)(w + WS_ST1), P.in[8] + lq * D, P.in[9] + lq * D, (const bf16*)(w + WS_PP), (const bf16*)(w + WS_SG), ALPHA};
            pg8::gemm_phase<pg8::EpiResidLN<true>, pg8::StaticOrder, true, true>(lds, g, So, E, cx.wave);
#else
            pg8::EpiDown E{(const float*)(w + WS_XR), (float*)(w + WS_Y), (const bf16*)(w + WS_PP), (const bf16*)(w + WS_SG), ALPHA};
            pg8::gemm_phase<pg8::EpiDown, pg8::StaticOrder, true, true>(lds, g, So, E, cx.wave);
#endif
#else
            pg8::EpiResid<true> E{(const float*)(w + WS_XR), (float*)(w + WS_Y), ALPHA};
            pg8::gemm_phase<pg8::EpiResid<true>, pg8::StaticOrder, true, true>(lds, g, So, E, cx.wave);
#endif
        }
        SEAM(pb + 9);
        if (IN(pb + 10)) { REPS(1) { OPQ(); unsigned char* w = cx.ws; const bool last = (lq == DEPTH - 1);

#if LN_NOXR
            phase_ln(cx, (const float*)(w + WS_Y), P.in[14] + lq * D, P.in[15] + lq * D, last ? P.out : (float*)nullptr, last ? (bf16*)nullptr : (bf16*)(w + WS_XB), last ? (float*)nullptr : (float*)(w + WS_ST2));
#else
            phase_ln(cx, (const float*)(w + WS_Y), P.in[14] + lq * D, P.in[15] + lq * D, last ? P.out : (float*)(w + WS_XR), last ? (bf16*)nullptr : (bf16*)(w + WS_XB), (float*)nullptr);
#endif
        } }
        SEAM(pb + 10);
    }
#undef IN
#undef SEAM
}

extern "C" void kernel_launch(void* const* d_in, const int* in_sizes, int n_in, void* d_out, int out_size, void* d_ws, size_t ws_size, hipStream_t stream) {
    static int grid = 0;
    if (grid == 0) {
        if (n_in != 19 || in_sizes[0] != S * D || out_size != S * D || ws_size < WS_END) { fprintf(stderr, "kernel_launch: unexpected shapes (n_in %d, in0 %d, out %d, ws %zu)\n", n_in, n_in > 0 ? in_sizes[0] : -1, out_size, ws_size); grid = -1; return; }
        int dev = 0, cus = 0, per_cu = 0;
        if (hipGetDevice(&dev) != hipSuccess || hipDeviceGetAttribute(&cus, hipDeviceAttributeMultiprocessorCount, dev) != hipSuccess) { grid = -1; return; }
        if (hipFuncSetAttribute((const void*)fwd, hipFuncAttributeMaxDynamicSharedMemorySize, LDS_BYTES) != hipSuccess) { fprintf(stderr, "kernel_launch: hipFuncSetAttribute failed\n"); grid = -1; return; }
        if (hipOccupancyMaxActiveBlocksPerMultiprocessor(&per_cu, (const void*)fwd, 512, LDS_BYTES) != hipSuccess || per_cu < 1) fprintf(stderr, "kernel_launch: occupancy query says %d\n", per_cu);
        (void)hipGetLastError();
        grid = cus;
    }
    if (grid < 0) return;
    (void)hipMemsetAsync((char*)d_ws + WS_CTL, 0, CTL_ZERO_BYTES, stream);
#ifdef DBG_NANFILL
    (void)hipMemsetAsync((char*)d_ws + CTL_ZERO_BYTES, 0xFF, WS_END - CTL_ZERO_BYTES, stream);
#endif
    Params p{};
    for (int i = 0; i < 19; ++i) p.in[i] = (const float*)d_in[i];
    p.out = (float*)d_out; p.ws = (unsigned char*)d_ws;
    for (int f = 0; f < 128; ++f) p.invf_ret[f] = (float)(1.0 / std::pow(10000.0, (double)((float)f / 127.0f)));
    for (int f = 0; f < 32; ++f) p.invf_att[f] = (float)std::pow(10000.0, -(double)(2 * f) / 64.0);
    for (int h = 0; h < 4; ++h) p.lg2g[h] = (float)std::log2(1.0 - std::exp2(-5.0 - h));
#if MK_ONE_LAUNCH
    p.ph_lo = 0; p.ph_hi = NPHASES;
    hipLaunchKernelGGL(fwd, dim3(grid), dim3(512), LDS_BYTES, stream, p);
#else
#ifdef DBG_DUMP
    for (int ph = 0; ph <= DBG_STOP; ++ph) { p.ph_lo = ph; p.ph_hi = ph + 1; hipLaunchKernelGGL(fwd, dim3(grid), dim3(512), LDS_BYTES, stream, p); }
    p.ph_lo = 1000 + DBG_DUMP; p.ph_hi = p.ph_lo + 1; hipLaunchKernelGGL(fwd, dim3(grid), dim3(512), LDS_BYTES, stream, p);
#else
    for (int ph = 0; ph < NPHASES; ++ph) { p.ph_lo = ph; p.ph_hi = ph + 1; hipLaunchKernelGGL(fwd, dim3(grid), dim3(512), LDS_BYTES, stream, p); }
#endif
#endif
}
```

```cpp
#include <hip/hip_runtime.h>
#include <cstdio>
#include <cstdint>
#include <cmath>
#define MK_ONE_LAUNCH 1
namespace pg8 {
#define PG8_LAS __attribute__((address_space(3)))
typedef unsigned short bf16_t;
typedef short bf16x8 __attribute__((ext_vector_type(8)));
typedef float f32x4 __attribute__((ext_vector_type(4)));
typedef unsigned u32x4 __attribute__((ext_vector_type(4)));
constexpr int BM = 256, BK = 64, HALF = 128, HTB = HALF * BK * 2  , STAGE_BYTES = 8 * HTB, NXCD = 8, WGM = 8;

__host__ __device__ __forceinline__ int lds_byte(int r, int c) { const int st = (r >> 4) * 2 + (c >> 5), rr = r & 15, cc = c & 31, ob = rr * 64 + cc * 2; return st * 1024 + (ob ^ (((ob >> 9) & 1) << 5)); }
__host__ __device__ __forceinline__ void stage_rc(int b, int& R, int& C) { const int st = b / 1024, sb = b % 1024, swz = sb ^ (((sb >> 9) & 1) << 5); R = (st >> 1) * 16 + swz / 64; C = (st & 1) * 32 + (swz % 64) / 2; }
__host__ __device__ __forceinline__ int perm32(int rho) { const int n = rho >> 4, i = rho & 15; return 8 * (i >> 2) + 4 * n + (i & 3); }

struct Unit { int pm, pn; };
struct Gemm { const bf16_t* A; const bf16_t* Bt; int M, N, K; int lda, ldb; int tiledA, tiledB; };

struct StaticOrder {
    int nM, nN, nwg, G, c;
    __host__ __device__ void init(int M, int N, int G_, int c_) { nM = M / BM; nN = N / BM; nwg = nM * nN; G = G_; c = c_; }
    __host__ __device__ bool next(int i, Unit& u) const {
        const long L = (long)i * G + c; if (L >= nwg) return false;
        int wgid = (int)L; { const int q = nwg / NXCD, r = nwg % NXCD, xcd = wgid % NXCD, off = wgid / NXCD; wgid = (xcd < r ? xcd * (q + 1) : r * (q + 1) + (xcd - r) * q) + off; }
        const int nig = WGM * nN, gid = wgid / nig, fm = gid * WGM, gsz = (nM - fm) < WGM ? (nM - fm) : WGM;
        u.pm = fm + ((wgid % nig) % gsz); u.pn = (wgid % nig) / gsz; return true;
    }
    __device__ __forceinline__ void a_ready(const Unit&) const {}
    __device__ __forceinline__ void done(const Unit&) const {}
};

typedef float f32x2c_t __attribute__((ext_vector_type(2))); typedef __bf16 bf16x2c_t __attribute__((ext_vector_type(2)));
__device__ __forceinline__ unsigned cvt_pk_bf16(float lo, float hi) { f32x2c_t v = {lo, hi}; bf16x2c_t b = __builtin_convertvector(v, bf16x2c_t); return __builtin_bit_cast(unsigned, b); }
typedef float f32x2 __attribute__((ext_vector_type(2)));
typedef unsigned u32x2 __attribute__((ext_vector_type(2)));
__host__ __device__ __forceinline__ size_t tiled_off(int row, int col, int K) { return ((size_t)((row >> 8) * (K >> 6) + (col >> 6)) * 256 + (row & 255)) * 64 + (col & 63); }
#ifndef EPI_NT
#define EPI_NT 0
#endif
template <class T> __device__ __forceinline__ void st_out(T* p, const T v) {
#if EPI_NT
    __builtin_nontemporal_store(v, p);
#else
    *p = v;
#endif
}

__device__ __forceinline__ float bf2f(unsigned short b) { return __uint_as_float(((unsigned)b) << 16); }
__device__ __forceinline__ u32x4 pack8(const f32x4 a, const f32x4 b) { u32x4 w; w.x = cvt_pk_bf16(a[0], a[1]); w.y = cvt_pk_bf16(a[2], a[3]); w.z = cvt_pk_bf16(b[0], b[1]); w.w = cvt_pk_bf16(b[2], b[3]); return w; }
__device__ __forceinline__ float sigmoidf_(float x) { return __builtin_amdgcn_rcpf(1.0f + __expf(-x)); }

struct EpiInProj {
    static constexpr bool PERM = true, AFTER_DRAIN = false;
    bf16_t *Q, *K, *V, *G, *AQ, *AK, *AV; const float *cosr, *sinr, *cosa, *sina;
    __device__ __forceinline__ void operator()(const f32x4 (&acc)[2][2][4][2], const Unit& u, int wr, int wc, int fr, int fq) const {
        const int row0 = u.pm * BM + wr * 64 + fr, pn = u.pn, cw = wc * 32 + 8 * fq;
        if (pn < 8) {
            bf16_t* O = pn < 4 ? Q : K; const int hcol = (pn & 3) * 256; const float sc = pn < 4 ? 1.0f : 0.0625f;
#pragma unroll
            for (int ai = 0; ai < 2; ++ai)
#pragma unroll
                for (int m = 0; m < 4; ++m) { const int row = row0 + ai * HALF + m * 16;
                    const f32x4 c0 = *(const f32x4*)(cosr + (size_t)row * 128 + cw), c1 = *(const f32x4*)(cosr + (size_t)row * 128 + cw + 4);
                    const f32x4 s0 = *(const f32x4*)(sinr + (size_t)row * 128 + cw), s1 = *(const f32x4*)(sinr + (size_t)row * 128 + cw + 4);
                    const f32x4 a0 = acc[ai][0][m][0], a1 = acc[ai][0][m][1], b0 = acc[ai][1][m][0], b1 = acc[ai][1][m][1];
                    const f32x4 o10 = (a0 * c0 - b0 * s0) * sc, o11 = (a1 * c1 - b1 * s1) * sc, o20 = (a0 * s0 + b0 * c0) * sc, o21 = (a1 * s1 + b1 * c1) * sc;
                    bf16_t* rowp = O + (size_t)row * 1024 + hcol + cw;
                    st_out((u32x4*)(rowp), (u32x4)(pack8(o10, o11))); st_out((u32x4*)(rowp + HALF), (u32x4)(pack8(o20, o21))); }
        } else if (pn < 16) {
            const bool gate = pn >= 12; bf16_t* O = gate ? G : V; const int hcol = (pn & 3) * 256;
#pragma unroll
            for (int ai = 0; ai < 2; ++ai)
#pragma unroll
                for (int m = 0; m < 4; ++m) { const int row = row0 + ai * HALF + m * 16; bf16_t* rowp = O + (size_t)row * 1024 + hcol + cw;
#pragma unroll
                    for (int bj = 0; bj < 2; ++bj) { f32x4 v0 = acc[ai][bj][m][0], v1 = acc[ai][bj][m][1];
                        if (gate) {
#pragma unroll
                            for (int j = 0; j < 4; ++j) { v0[j] = v0[j] * sigmoidf_(v0[j]); v1[j] = v1[j] * sigmoidf_(v1[j]); } }
                        st_out((u32x4*)(rowp + bj * HALF), (u32x4)(pack8(v0, v1))); } }
        } else if (pn < 20) {
            const int t = pn - 16, i0 = 8 * fq;
#pragma unroll
            for (int ai = 0; ai < 2; ++ai)
#pragma unroll
                for (int m = 0; m < 4; ++m) { const int row = row0 + ai * HALF + m * 16;
                    const f32x4 c0 = *(const f32x4*)(cosa + (size_t)row * 32 + i0), c1 = *(const f32x4*)(cosa + (size_t)row * 32 + i0 + 4);
                    const f32x4 s0 = *(const f32x4*)(sina + (size_t)row * 32 + i0), s1 = *(const f32x4*)(sina + (size_t)row * 32 + i0 + 4);
                    const f32x4 a0 = acc[ai][0][m][0], a1 = acc[ai][0][m][1], b0 = acc[ai][1][m][0], b1 = acc[ai][1][m][1];
                    const f32x4 o10 = (a0 * c0 - b0 * s0) * 0.125f, o11 = (a1 * c1 - b1 * s1) * 0.125f, o20 = (a0 * s0 + b0 * c0) * 0.125f, o21 = (a1 * s1 + b1 * c1) * 0.125f;
                    bf16_t* rowp = AQ + (size_t)row * 1024 + t * 256 + wc * 64 + i0;
                    st_out((u32x4*)(rowp), (u32x4)(pack8(o10, o11))); st_out((u32x4*)(rowp + 32), (u32x4)(pack8(o20, o21))); }
        } else {
            const int i0 = 8 * fq;
            if (wc < 2) {
#pragma unroll
                for (int ai = 0; ai < 2; ++ai)
#pragma unroll
                    for (int m = 0; m < 4; ++m) { const int row = row0 + ai * HALF + m * 16;
                        const f32x4 c0 = *(const f32x4*)(cosa + (size_t)row * 32 + i0), c1 = *(const f32x4*)(cosa + (size_t)row * 32 + i0 + 4);
                        const f32x4 s0 = *(const f32x4*)(sina + (size_t)row * 32 + i0), s1 = *(const f32x4*)(sina + (size_t)row * 32 + i0 + 4);
                        const f32x4 a0 = acc[ai][0][m][0], a1 = acc[ai][0][m][1], b0 = acc[ai][1][m][0], b1 = acc[ai][1][m][1];
                        const f32x4 o10 = a0 * c0 - b0 * s0, o11 = a1 * c1 - b1 * s1, o20 = a0 * s0 + b0 * c0, o21 = a1 * s1 + b1 * c1;
                        bf16_t* rowp = AK + (size_t)row * 128 + wc * 64 + i0;
                        st_out((u32x4*)(rowp), (u32x4)(pack8(o10, o11))); st_out((u32x4*)(rowp + 32), (u32x4)(pack8(o20, o21))); }
            } else {
#pragma unroll
                for (int ai = 0; ai < 2; ++ai)
#pragma unroll
                    for (int m = 0; m < 4; ++m) { const int row = row0 + ai * HALF + m * 16; bf16_t* rowp = AV + (size_t)row * 128 + (wc - 2) * 32 + i0;
                        st_out((u32x4*)(rowp), (u32x4)(pack8(acc[ai][0][m][0], acc[ai][0][m][1]))); st_out((u32x4*)(rowp + 64), (u32x4)(pack8(acc[ai][1][m][0], acc[ai][1][m][1]))); }
            }
        }
    }
};
template <bool ADD> struct EpiResid {
    static constexpr bool PERM = false, AFTER_DRAIN = false;
    const float* base; float* Y; float alpha;
    __device__ __forceinline__ void operator()(const f32x4 (&acc)[2][2][4][2], const Unit& u, int wr, int wc, int fr, int fq) const {
        const int row0 = u.pm * BM + wr * 64 + fr, col0 = u.pn * BM + wc * 32 + 4 * fq;
#pragma unroll
        for (int ai = 0; ai < 2; ++ai)
#pragma unroll
            for (int m = 0; m < 4; ++m) { const size_t off = (size_t)(row0 + ai * HALF + m * 16) * 2048 + col0;
#pragma unroll
                for (int bj = 0; bj < 2; ++bj)
#pragma unroll
                    for (int n = 0; n < 2; ++n) { const size_t o = off + bj * HALF + n * 16; f32x4 v = acc[ai][bj][m][n] + *(const f32x4*)(base + o) * alpha;
                        if (ADD) v = v + *(const f32x4*)(Y + o); st_out((f32x4*)(Y + o), (f32x4)(v)); } }
    }
};
struct EpiUp {
    static constexpr bool PERM = true, AFTER_DRAIN = false;
    bf16_t* H; bf16_t* SG; const float* bgate;
    __device__ __forceinline__ void operator()(const f32x4 (&acc)[2][2][4][2], const Unit& u, int wr, int wc, int fr, int fq) const {
        const int row0 = u.pm * BM + wr * 64 + fr, cw = wc * 32 + 8 * fq;
        if (u.pn < 44) {
#pragma unroll
            for (int ai = 0; ai < 2; ++ai)
#pragma unroll
                for (int m = 0; m < 4; ++m) { bf16_t* rowp = H + (size_t)(row0 + ai * HALF + m * 16) * 11264 + u.pn * 256 + cw;
#pragma unroll
                    for (int bj = 0; bj < 2; ++bj) st_out((u32x4*)(rowp + bj * HALF), (u32x4)(pack8(acc[ai][bj][m][0], acc[ai][bj][m][1]))); }
        } else {
            const int colg = (u.pn - 44) * 256 + cw;
            f32x4 bv[2][2];
#pragma unroll
            for (int bj = 0; bj < 2; ++bj)
#pragma unroll
                for (int n = 0; n < 2; ++n) bv[bj][n] = *(const f32x4*)(bgate + colg + bj * HALF + 4 * n);
#pragma unroll
            for (int ai = 0; ai < 2; ++ai)
#pragma unroll
                for (int m = 0; m < 4; ++m) { bf16_t* rowp = SG + (size_t)(row0 + ai * HALF + m * 16) * 2048 + colg;
#pragma unroll
                    for (int bj = 0; bj < 2; ++bj) { f32x4 v0 = acc[ai][bj][m][0] + bv[bj][0], v1 = acc[ai][bj][m][1] + bv[bj][1];
#pragma unroll
                        for (int j = 0; j < 4; ++j) { v0[j] = sigmoidf_(v0[j]); v1[j] = sigmoidf_(v1[j]); }
                        st_out((u32x4*)(rowp + bj * HALF), (u32x4)(pack8(v0, v1))); } }
        }
    }
};

__device__ __forceinline__ float ror1f(float x) { return __builtin_bit_cast(float, __builtin_amdgcn_update_dpp(0, __builtin_bit_cast(int, x), 0x121, 0xf, 0xf, false)); }
__device__ __forceinline__ float ror2f(float x) { return __builtin_bit_cast(float, __builtin_amdgcn_update_dpp(0, __builtin_bit_cast(int, x), 0x122, 0xf, 0xf, false)); }
struct EpiUpConv {
    static constexpr bool PERM = true, AFTER_DRAIN = false;
    bf16_t* ACT; bf16_t* HALO; bf16_t* SG; const float* bgate; const float* cw; const float* cb;
    __device__ __forceinline__ void operator()(const f32x4 (&acc)[2][2][4][2], const Unit& u, int wr, int wc, int fr, int fq) const {
        const int row0 = u.pm * BM + wr * 64 + fr, cwp = wc * 32 + 8 * fq;
        if (u.pn < 44) {
            f32x4 wg0_[2], wg1_[2], wg2_[2], bg_[2], wu0_[2], wu1_[2], wu2_[2], bu_[2];
#pragma unroll
            for (int n = 0; n < 2; ++n) { const int chg = 128 * u.pn + cwp + 4 * n, chu = 5632 + chg;
                wg0_[n] = *(const f32x4*)(cw + chg); wg1_[n] = *(const f32x4*)(cw + 11264 + chg); wg2_[n] = *(const f32x4*)(cw + 2 * 11264 + chg); bg_[n] = *(const f32x4*)(cb + chg);
                wu0_[n] = *(const f32x4*)(cw + chu); wu1_[n] = *(const f32x4*)(cw + 11264 + chu); wu2_[n] = *(const f32x4*)(cw + 2 * 11264 + chu); bu_[n] = *(const f32x4*)(cb + chu); }
#pragma unroll
            for (int ai = 0; ai < 2; ++ai) {
                const int span = u.pm * 4 + ai * 2 + wr;
#pragma unroll
                for (int m = 0; m < 4; ++m) {
                    const int row = row0 + ai * HALF + m * 16;
                    u32x4 w, rg, ru;
#pragma unroll
                    for (int n = 0; n < 2; ++n) {
                        const f32x4 wg0 = wg0_[n], wg1 = wg1_[n], wg2 = wg2_[n], bg = bg_[n], wu0 = wu0_[n], wu1 = wu1_[n], wu2 = wu2_[n], bu = bu_[n];
                        const f32x4 cg = acc[ai][0][m][n], cu = acc[ai][1][m][n];
                        const f32x4 pg = acc[ai][0][m ? m - 1 : 0][n], pu = acc[ai][1][m ? m - 1 : 0][n];
                        f32x4 o;
#pragma unroll
                        for (int j = 0; j < 4; ++j) {
                            const float g1 = ror1f(fr == 15 ? pg[j] : cg[j]), g2 = ror2f(fr >= 14 ? pg[j] : cg[j]);
                            const float u1 = ror1f(fr == 15 ? pu[j] : cu[j]), u2 = ror2f(fr >= 14 ? pu[j] : cu[j]);
                            const float ga = bg[j] + wg0[j] * g2 + wg1[j] * g1 + wg2[j] * cg[j], ua = bu[j] + wu0[j] * u2 + wu1[j] * u1 + wu2[j] * cu[j];
                            o[j] = ga * sigmoidf_(ga) * ua; }
                        if (n == 0) { w.x = cvt_pk_bf16(o[0], o[1]); w.y = cvt_pk_bf16(o[2], o[3]); rg.x = cvt_pk_bf16(cg[0], cg[1]); rg.y = cvt_pk_bf16(cg[2], cg[3]); ru.x = cvt_pk_bf16(cu[0], cu[1]); ru.y = cvt_pk_bf16(cu[2], cu[3]); }
                        else { w.z = cvt_pk_bf16(o[0], o[1]); w.w = cvt_pk_bf16(o[2], o[3]); rg.z = cvt_pk_bf16(cg[0], cg[1]); rg.w = cvt_pk_bf16(cg[2], cg[3]); ru.z = cvt_pk_bf16(cu[0], cu[1]); ru.w = cvt_pk_bf16(cu[2], cu[3]); }
                    }
                    if (m > 0 || fr >= 2) st_out((u32x4*)(ACT + tiled_off(row, 128 * u.pn + cwp, 5632)), (u32x4)(w));
                    if ((m == 0 && fr < 2) || (m == 3 && fr >= 14)) { const int slot = (m == 0) ? fr : fr - 12;
                        bf16_t* hp = HALO + ((size_t)(span * 4 + slot)) * 11264 + 256 * u.pn + cwp;
                        st_out((u32x4*)(hp), (u32x4)(rg)); st_out((u32x4*)(hp + HALF), (u32x4)(ru)); }
                }
            }
        } else {
            const int colg = (u.pn - 44) * 256 + cwp;
            f32x4 bv[2][2];
#pragma unroll
            for (int bj = 0; bj < 2; ++bj)
#pragma unroll
                for (int n = 0; n < 2; ++n) bv[bj][n] = *(const f32x4*)(bgate + colg + bj * HALF + 4 * n);
#pragma unroll
            for (int ai = 0; ai < 2; ++ai)
#pragma unroll
                for (int m = 0; m < 4; ++m) { bf16_t* rowp = SG + (size_t)(row0 + ai * HALF + m * 16) * 2048 + colg;
#pragma unroll
                    for (int bj = 0; bj < 2; ++bj) { f32x4 v0 = acc[ai][bj][m][0] + bv[bj][0], v1 = acc[ai][bj][m][1] + bv[bj][1];
#pragma unroll
                        for (int j = 0; j < 4; ++j) { v0[j] = sigmoidf_(v0[j]); v1[j] = sigmoidf_(v1[j]); }
                        st_out((u32x4*)(rowp + bj * HALF), (u32x4)(pack8(v0, v1))); } }
        }
    }
};

struct EpiPlain {
    static constexpr bool PERM = true, AFTER_DRAIN = false;
    bf16_t* O;
    __device__ __forceinline__ void operator()(const f32x4 (&acc)[2][2][4][2], const Unit& u, int wr, int wc, int fr, int fq) const {
        const int row0 = u.pm * BM + wr * 64 + fr, cwp = u.pn * BM + wc * 32 + 8 * fq;
#pragma unroll
        for (int ai = 0; ai < 2; ++ai)
#pragma unroll
            for (int m = 0; m < 4; ++m) { bf16_t* rowp = O + (size_t)(row0 + ai * HALF + m * 16) * 2048 + cwp;
#pragma unroll
                for (int bj = 0; bj < 2; ++bj) st_out((u32x4*)(rowp + bj * HALF), (u32x4)(pack8(acc[ai][bj][m][0], acc[ai][bj][m][1]))); }
    }
};
struct EpiDown {
    static constexpr bool PERM = false, AFTER_DRAIN = false;
    const float* base; float* Y; const bf16_t* PP; const bf16_t* SG; float alpha;
    __device__ __forceinline__ void operator()(const f32x4 (&acc)[2][2][4][2], const Unit& u, int wr, int wc, int fr, int fq) const {
        const int row0 = u.pm * BM + wr * 64 + fr, col0 = u.pn * BM + wc * 32 + 4 * fq;
#pragma unroll
        for (int ai = 0; ai < 2; ++ai)
#pragma unroll
            for (int m = 0; m < 4; ++m) { const size_t off = (size_t)(row0 + ai * HALF + m * 16) * 2048 + col0;
#pragma unroll
                for (int bj = 0; bj < 2; ++bj)
#pragma unroll
                    for (int n = 0; n < 2; ++n) { const size_t o = off + bj * HALF + n * 16; const u32x2 pp = *(const u32x2*)(PP + o), sg = *(const u32x2*)(SG + o);
                        f32x4 pl; pl[0] = __uint_as_float(pp.x << 16) * __uint_as_float(sg.x << 16); pl[1] = __uint_as_float(pp.x & 0xffff0000u) * __uint_as_float(sg.x & 0xffff0000u);
                        pl[2] = __uint_as_float(pp.y << 16) * __uint_as_float(sg.y << 16); pl[3] = __uint_as_float(pp.y & 0xffff0000u) * __uint_as_float(sg.y & 0xffff0000u);
                        st_out((f32x4*)(Y + o), (f32x4)(acc[ai][bj][m][n] + *(const f32x4*)(base + o) * alpha + pl)); } }
    }
};

template <bool PLE_> struct EpiResidLN {
    static constexpr bool PERM = false, AFTER_DRAIN = false;
    float* Y; float* Yout; const float* stats; const float* g; const float* b; const bf16_t* PP; const bf16_t* SG; float alpha;
    __device__ __forceinline__ void operator()(const f32x4 (&acc)[2][2][4][2], const Unit& u, int wr, int wc, int fr, int fq) const {
        const int row0 = u.pm * BM + wr * 64 + fr, col0 = u.pn * BM + wc * 32 + 4 * fq;
        f32x4 g4[2][2], b4[2][2];
#pragma unroll
        for (int bj = 0; bj < 2; ++bj)
#pragma unroll
            for (int n = 0; n < 2; ++n) { g4[bj][n] = *(const f32x4*)(g + col0 + bj * HALF + n * 16) * alpha; b4[bj][n] = *(const f32x4*)(b + col0 + bj * HALF + n * 16) * alpha; }
        f32x4 cy[2][2], ny[2][2]; f32x2 cst, nst;
        { const size_t off = (size_t)row0 * 2048 + col0; cst = *(const f32x2*)(stats + 2 * (size_t)row0);
#pragma unroll
          for (int bj = 0; bj < 2; ++bj)
#pragma unroll
              for (int n = 0; n < 2; ++n) cy[bj][n] = *(const f32x4*)(Y + off + bj * HALF + n * 16); }
#pragma unroll
        for (int i = 0; i < 8; ++i) { const int ai = i >> 2, m = i & 3; const size_t off = (size_t)(row0 + ai * HALF + m * 16) * 2048 + col0;
            if (i < 7) { const int rn = row0 + ((i + 1) >> 2) * HALF + ((i + 1) & 3) * 16; const size_t offn = (size_t)rn * 2048 + col0; nst = *(const f32x2*)(stats + 2 * (size_t)rn);
#pragma unroll
                for (int bj = 0; bj < 2; ++bj)
#pragma unroll
                    for (int n = 0; n < 2; ++n) ny[bj][n] = *(const f32x4*)(Y + offn + bj * HALF + n * 16); }
#pragma unroll
            for (int bj = 0; bj < 2; ++bj)
#pragma unroll
                for (int n = 0; n < 2; ++n) { const size_t o = off + bj * HALF + n * 16;
                    f32x4 v = acc[ai][bj][m][n] + (cy[bj][n] - cst.x) * cst.y * g4[bj][n] + b4[bj][n];
                    if (PLE_) { const u32x2 pp = *(const u32x2*)(PP + o), sg = *(const u32x2*)(SG + o);
                        v[0] += __uint_as_float(pp.x << 16) * __uint_as_float(sg.x << 16); v[1] += __uint_as_float(pp.x & 0xffff0000u) * __uint_as_float(sg.x & 0xffff0000u);
                        v[2] += __uint_as_float(pp.y << 16) * __uint_as_float(sg.y << 16); v[3] += __uint_as_float(pp.y & 0xffff0000u) * __uint_as_float(sg.y & 0xffff0000u); }
                    st_out((f32x4*)(Yout + o), (f32x4)(v)); }
#pragma unroll
            for (int bj = 0; bj < 2; ++bj)
#pragma unroll
                for (int n = 0; n < 2; ++n) cy[bj][n] = ny[bj][n];
            cst = nst; }
    }
};
struct EpiPle {
    static constexpr bool PERM = false, AFTER_DRAIN = false;
    const bf16_t* SG; float* Y;
    __device__ __forceinline__ void operator()(const f32x4 (&acc)[2][2][4][2], const Unit& u, int wr, int wc, int fr, int fq) const {
        const int row0 = u.pm * BM + wr * 64 + fr, col0 = u.pn * BM + wc * 32 + 4 * fq;
#pragma unroll
        for (int ai = 0; ai < 2; ++ai)
#pragma unroll
            for (int m = 0; m < 4; ++m) { const size_t off = (size_t)(row0 + ai * HALF + m * 16) * 2048 + col0;
#pragma unroll
                for (int bj = 0; bj < 2; ++bj)
#pragma unroll
                    for (int n = 0; n < 2; ++n) { const size_t o = off + bj * HALF + n * 16; const u32x2 sg = *(const u32x2*)(SG + o);
                        f32x4 g; g[0] = __uint_as_float(sg.x << 16); g[1] = __uint_as_float(sg.x & 0xffff0000u); g[2] = __uint_as_float(sg.y << 16); g[3] = __uint_as_float(sg.y & 0xffff0000u);
                        st_out((f32x4*)(Y + o), (f32x4)(acc[ai][bj][m][n] * g)); } }
    }
};
template <class Epi, class Sched, bool ALIGN_EPI = false, bool SP2 = false>
__device__ __forceinline__ void gemm_phase(PG8_LAS unsigned char* lds, const Gemm g, const Sched& S, const Epi& E, const int wid_in) {
    int lane_; asm volatile("v_mbcnt_lo_u32_b32 %0, -1, 0\n\tv_mbcnt_hi_u32_b32 %0, -1, %0" : "=v"(lane_)); const int wid = wid_in, lane = lane_, tid = wid * 64 + lane, wr = wid >> 2, wc = wid & 3, fr = lane & 15, fq = lane >> 4;
    const int K = g.K, nt = K / BK, lda = g.tiledA ? BK : (g.lda ? g.lda : K), ldb = g.tiledB ? BK : (g.ldb ? g.ldb : K);
    unsigned voffA[2], voffB[2];
#pragma unroll
    for (int i = 0; i < 2; ++i) { int R, C; stage_rc(tid * 16 + i * 8192, R, C); const int Rb = Epi::PERM ? ((R & ~31) + perm32(R & 31)) : R;
        voffA[i] = (unsigned)(R * lda + C) * 2u; voffB[i] = (unsigned)(Rb * ldb + C) * 2u; }
    const size_t kstepA = g.tiledA ? (size_t)BM * BK * 2 : (size_t)(BK * 2), kstepB = g.tiledB ? (size_t)BM * BK * 2 : (size_t)(BK * 2);
    const size_t hstepA = (size_t)HALF * lda * 2, hstepB = (size_t)HALF * ldb * 2;
    const size_t tstepA = g.tiledA ? (size_t)BM * K * 2 : 2 * hstepA, tstepB = g.tiledB ? (size_t)BM * K * 2 : 2 * hstepB;
    const unsigned ldsw = (unsigned)wid * 1024u;
    const int aoff = lds_byte(wr * 64 + fr, fq * 8), boff = lds_byte(wc * 32 + fr, fq * 8);
#define PG8_SA(b, h) (((b) * 2 + (h)) * HTB)
#define PG8_SB(b, h) ((4 + (b) * 2 + (h)) * HTB)
#define PG8_STAGE(bufoff, gbase, voff) do { _Pragma("unroll") for (int _i = 0; _i < 2; ++_i) \
        __builtin_amdgcn_global_load_lds((const unsigned*)((const char*)(gbase) + (voff)[_i]), (PG8_LAS unsigned*)(lds + (bufoff) + ldsw + _i * 8192), 16, 0, 0); } while (0)
#define PG8_LDA(dst, b, h) do { _Pragma("unroll") for (int m = 0; m < 4; ++m) _Pragma("unroll") for (int k = 0; k < 2; ++k) dst[m][k] = *(const PG8_LAS bf16x8*)(lds + PG8_SA(b, h) + aoff + m * 2048 + k * 1024); } while (0)
#define PG8_LDB(dst, b, h) do { _Pragma("unroll") for (int n = 0; n < 2; ++n) _Pragma("unroll") for (int k = 0; k < 2; ++k) dst[n][k] = *(const PG8_LAS bf16x8*)(lds + PG8_SB(b, h) + boff + n * 2048 + k * 1024); } while (0)
#define PG8_MMA(ai, bj, At, Bt) do { __builtin_amdgcn_s_setprio(1); _Pragma("unroll") for (int m = 0; m < 4; ++m) _Pragma("unroll") for (int n = 0; n < 2; ++n) _Pragma("unroll") for (int k = 0; k < 2; ++k) \
        acc[ai][bj][m][n] = __builtin_amdgcn_mfma_f32_16x16x32_bf16(Bt[n][k], At[m][k], acc[ai][bj][m][n], 0, 0, 0); __builtin_amdgcn_s_setprio(0); } while (0)
#define PG8_WAIT_V(n) asm volatile("s_waitcnt vmcnt(" #n ")" ::: "memory")
#define PG8_WAIT_L(n) asm volatile("s_waitcnt lgkmcnt(" #n ")" ::: "memory")
#define PG8_BAR __builtin_amdgcn_s_barrier()
#define PG8_SCHED __builtin_amdgcn_sched_barrier(0)
    Unit cur, nxt; int ui = 0;
    if (!S.next(0, cur)) return;
    f32x4 acc[2][2][4][2];
#pragma unroll
    for (int a = 0; a < 2; ++a)
#pragma unroll
        for (int b = 0; b < 2; ++b)
#pragma unroll
            for (int m = 0; m < 4; ++m)
#pragma unroll
                for (int n = 0; n < 2; ++n) acc[a][b][m][n] = (f32x4){0.f, 0.f, 0.f, 0.f};
    bf16x8 At[4][2], B0[2][2], B1[2][2];
    const char* cA = (const char*)g.A + (size_t)cur.pm * tstepA; const char* cB = (const char*)g.Bt + (size_t)cur.pn * tstepB;
    S.a_ready(cur);
    if constexpr (SP2) {
        PG8_STAGE(PG8_SB(0, 0), cB, voffB); PG8_STAGE(PG8_SB(0, 1), cB + hstepB, voffB); PG8_STAGE(PG8_SA(0, 0), cA, voffA); PG8_STAGE(PG8_SA(0, 1), cA + hstepA, voffA);
        if (wr == 1) PG8_BAR;
        PG8_WAIT_V(2); PG8_BAR;
        PG8_STAGE(PG8_SB(1, 0), cB + kstepB, voffB); PG8_STAGE(PG8_SA(1, 0), cA + kstepA, voffA); PG8_STAGE(PG8_SB(1, 1), cB + hstepB + kstepB, voffB);
        PG8_WAIT_V(6); PG8_BAR;
    } else {
        PG8_STAGE(PG8_SB(0, 0), cB, voffB); PG8_STAGE(PG8_SA(0, 0), cA, voffA); PG8_STAGE(PG8_SB(0, 1), cB + hstepB, voffB); PG8_STAGE(PG8_SA(0, 1), cA + hstepA, voffA);
        if (wr == 1) PG8_BAR;
        PG8_WAIT_V(4); PG8_BAR;
        PG8_STAGE(PG8_SB(1, 0), cB + kstepB, voffB); PG8_STAGE(PG8_SA(1, 0), cA + kstepA, voffA); PG8_STAGE(PG8_SB(1, 1), cB + hstepB + kstepB, voffB);
        PG8_WAIT_V(6); PG8_BAR;
    }
    for (;;) {
        const bool has_next = S.next(ui + 1, nxt);
        const char* nA = has_next ? (const char*)g.A + (size_t)nxt.pm * tstepA : cA; const char* nB = has_next ? (const char*)g.Bt + (size_t)nxt.pn * tstepB : cB;
        for (int t = 0; t < nt; t += 2) {
            const bool last = (t == nt - 2);
            const char* a1 = cA + (size_t)(t + 1) * kstepA;
            const char* a2 = last ? nA : cA + (size_t)(t + 2) * kstepA; const char* b2 = last ? nB : cB + (size_t)(t + 2) * kstepB;
            const char* a3 = a2 + kstepA; const char* b3 = b2 + kstepB;
            if (last && has_next) S.a_ready(nxt);
            if constexpr (SP2) {
            PG8_LDB(B0, 0, 0); PG8_LDB(B1, 0, 1); PG8_SCHED; PG8_LDA(At, 0, 0); PG8_STAGE(PG8_SA(1, 1), a1 + hstepA, voffA);
            PG8_WAIT_V(8); PG8_WAIT_L(0); PG8_BAR; PG8_MMA(0, 0, At, B0); PG8_MMA(0, 1, At, B1); PG8_BAR; PG8_SCHED;
            PG8_LDA(At, 0, 1); PG8_STAGE(PG8_SB(0, 0), b2, voffB); PG8_STAGE(PG8_SB(0, 1), b2 + hstepB, voffB); PG8_STAGE(PG8_SA(0, 0), a2, voffA);
            PG8_WAIT_V(8); PG8_WAIT_L(0); PG8_BAR; PG8_MMA(1, 0, At, B0); PG8_MMA(1, 1, At, B1); PG8_BAR; PG8_SCHED;
            PG8_LDB(B0, 1, 0); PG8_LDB(B1, 1, 1); PG8_SCHED; PG8_LDA(At, 1, 0); PG8_STAGE(PG8_SA(0, 1), a2 + hstepA, voffA);
            PG8_WAIT_V(8); PG8_WAIT_L(0); PG8_BAR; PG8_MMA(0, 0, At, B0); PG8_MMA(0, 1, At, B1); PG8_BAR; PG8_SCHED;
            PG8_LDA(At, 1, 1); PG8_STAGE(PG8_SB(1, 0), b3, voffB); PG8_STAGE(PG8_SB(1, 1), b3 + hstepB, voffB); PG8_STAGE(PG8_SA(1, 0), a3, voffA);
            PG8_WAIT_V(8); PG8_WAIT_L(0); PG8_BAR; PG8_MMA(1, 0, At, B0); PG8_MMA(1, 1, At, B1); PG8_BAR; PG8_SCHED;
            } else {
            PG8_LDB(B0, 0, 0); PG8_SCHED; PG8_LDA(At, 0, 0); PG8_STAGE(PG8_SA(1, 1), a1 + hstepA, voffA);
            PG8_WAIT_L(8); PG8_BAR; PG8_WAIT_L(0); PG8_MMA(0, 0, At, B0); PG8_BAR; PG8_SCHED;
            PG8_LDB(B1, 0, 1); PG8_STAGE(PG8_SB(0, 0), b2, voffB);
            PG8_BAR; PG8_WAIT_L(0); PG8_MMA(0, 1, At, B1); PG8_BAR;
            PG8_LDA(At, 0, 1); PG8_STAGE(PG8_SA(0, 0), a2, voffA);
            PG8_BAR; PG8_WAIT_L(0); PG8_MMA(1, 0, At, B0); PG8_BAR; PG8_SCHED;
            PG8_STAGE(PG8_SB(0, 1), b2 + hstepB, voffB);
            PG8_WAIT_V(6); PG8_BAR; PG8_MMA(1, 1, At, B1); PG8_BAR;
            PG8_LDB(B0, 1, 0); PG8_SCHED; PG8_LDA(At, 1, 0); PG8_STAGE(PG8_SA(0, 1), a2 + hstepA, voffA);
            PG8_WAIT_L(8); PG8_BAR; PG8_WAIT_L(0); PG8_MMA(0, 0, At, B0); PG8_BAR; PG8_SCHED;
            PG8_LDB(B1, 1, 1); PG8_STAGE(PG8_SB(1, 0), b3, voffB);
            PG8_BAR; PG8_WAIT_L(0); PG8_MMA(0, 1, At, B1); PG8_BAR;
            PG8_LDA(At, 1, 1); PG8_STAGE(PG8_SA(1, 0), a3, voffA);
            PG8_BAR; PG8_WAIT_L(0); PG8_MMA(1, 0, At, B0); PG8_BAR; PG8_SCHED;
            PG8_STAGE(PG8_SB(1, 1), b3 + hstepB, voffB);
            PG8_WAIT_V(6); PG8_BAR; PG8_MMA(1, 1, At, B1); PG8_BAR;
            }
        }
        if constexpr (ALIGN_EPI) { if (wr == 0) PG8_BAR; }
        if constexpr (!Epi::AFTER_DRAIN) { E(acc, cur, wr, wc, fr, fq); S.done(cur); }
        if (!has_next) break;
#pragma unroll
        for (int a = 0; a < 2; ++a)
#pragma unroll
            for (int b = 0; b < 2; ++b)
#pragma unroll
                for (int m = 0; m < 4; ++m)
#pragma unroll
                    for (int n = 0; n < 2; ++n) acc[a][b][m][n] = (f32x4){0.f, 0.f, 0.f, 0.f};
        cur = nxt; cA = nA; cB = nB; ++ui;
        if constexpr (ALIGN_EPI) { if (wr == 1) PG8_BAR; }
    }
    PG8_WAIT_V(0);
    if constexpr (!ALIGN_EPI) { if (wr == 0) PG8_BAR; }
    PG8_BAR;
    if constexpr (Epi::AFTER_DRAIN) { E.fused(acc, cur, wr, wc, fr, fq, lds, wid, lane); S.done(cur); }
#undef PG8_SA
#undef PG8_SB
#undef PG8_STAGE
#undef PG8_LDA
#undef PG8_LDB
#undef PG8_MMA
#undef PG8_WAIT_V
#undef PG8_WAIT_L
#undef PG8_BAR
#undef PG8_SCHED
}
}
#define LAS __attribute__((address_space(3)))
#define XB_TMO      128
#define XB_XCNT(j)  (256  + 64 * (j))
#define XB_XSUB(j)  (1280 + 64 * (j))
#define XB_XGEN(j)  (2304 + 64 * (j))
#define XB_TOP      3328
#define XB_TOPGEN   3392
#define XCD_BAR_WORDS 3456
#define XB_SPIN_CAP (1u << 18)

__device__ __forceinline__ unsigned xb_ld(unsigned* p)              { return __hip_atomic_load(p, __ATOMIC_RELAXED, __HIP_MEMORY_SCOPE_AGENT); }
__device__ __forceinline__ unsigned xb_add(unsigned* p, unsigned v) { return __hip_atomic_fetch_add(p, v, __ATOMIC_RELAXED, __HIP_MEMORY_SCOPE_AGENT); }
__device__ __forceinline__ unsigned xb_xcc_id() { return (unsigned)__builtin_amdgcn_s_getreg((3 << 11) | 20) & 0xFu; }
#define XB_SPIN(cond, bar) do { unsigned _sp = 0; while (cond) { __builtin_amdgcn_s_sleep(1); \
    if ((++_sp & 255u) == 0u) { if (xb_ld(&(bar)[XB_TMO])) break; if (_sp > XB_SPIN_CAP) { atomicAdd(&(bar)[XB_TMO], 1u); break; } } } } while (0)

struct XcdBarrier {
    unsigned* bar; unsigned x;
    volatile LAS unsigned* st;
};

__device__ __forceinline__ XcdBarrier xcd_barrier_post(unsigned* bar, volatile LAS unsigned* st) {
    XcdBarrier b; b.bar = bar; b.x = xb_xcc_id(); b.st = st;
    if (threadIdx.x == 0) (void)xb_add(&bar[XB_XCNT(b.x)], 1u);
    return b;
}
__device__ __forceinline__ void xcd_barrier_complete(unsigned* bar, unsigned x, unsigned& nloc, unsigned& nx) {
    const unsigned G = gridDim.x * gridDim.y * gridDim.z;
    unsigned sum, cnt, mine, sp = 0u;
    for (;;) {
        sum = 0u; cnt = 0u; mine = 0u;
#pragma unroll
        for (unsigned j = 0; j < 16; ++j) { const unsigned c = xb_ld(&bar[XB_XCNT(j)]); sum += c; cnt += (c > 0u) ? 1u : 0u; mine = (j == x) ? c : mine; }
        if (sum == G) break;
        __builtin_amdgcn_s_sleep(1);
        if ((++sp & 255u) == 0u) { if (xb_ld(&bar[XB_TMO])) break; if (sp > XB_SPIN_CAP) { atomicAdd(&bar[XB_TMO], 1u); break; } }
    }
    nloc = mine > 0u ? mine : 1u; nx = cnt > 0u ? cnt : 1u;
}

__device__ __forceinline__ void xcd_barrier(const XcdBarrier& b) {
    asm volatile("s_waitcnt vmcnt(0)" ::: "memory");
    __syncthreads();
    if (threadIdx.x == 0) {
        unsigned* bar = b.bar;
        __builtin_amdgcn_s_waitcnt(0);
        unsigned nloc = b.st[0], nx = b.st[1];
        if (nloc == 0u) { xcd_barrier_complete(bar, b.x, nloc, nx); b.st[0] = nloc; b.st[1] = nx; }
        const unsigned old = xb_add(&bar[XB_XSUB(b.x)], 1u);
        const unsigned gen = old / nloc;
        if (old + 1u == (gen + 1u) * nloc) {
            __builtin_amdgcn_fence(__ATOMIC_RELEASE, "agent");
            asm volatile("s_waitcnt vmcnt(0)" ::: "memory");
            const unsigned og = xb_add(&bar[XB_TOP], 1u);
            const unsigned tg = og / nx;
            if (og + 1u == (tg + 1u) * nx) xb_add(&bar[XB_TOPGEN], 1u);
            else XB_SPIN(xb_ld(&bar[XB_TOPGEN]) == tg, bar);
            __builtin_amdgcn_fence(__ATOMIC_ACQUIRE, "agent");
            xb_add(&bar[XB_XGEN(b.x)], 1u);
            asm volatile("s_waitcnt vmcnt(0)" ::: "memory");
        } else {
            XB_SPIN(xb_ld(&bar[XB_XGEN(b.x)]) == gen, bar);
            __builtin_amdgcn_fence(__ATOMIC_ACQUIRE, "agent");
            asm volatile("s_waitcnt vmcnt(0)" ::: "memory");
        }
    }
    __syncthreads();
}
#define GAS __attribute__((address_space(1)))

typedef unsigned short bf16;
typedef float f32x4 __attribute__((ext_vector_type(4)));
typedef unsigned v4u __attribute__((ext_vector_type(4)));
typedef unsigned v2u __attribute__((ext_vector_type(2)));
#define LDS_WAIT() asm volatile("s_waitcnt lgkmcnt(0)" ::: "memory")

#ifndef MK_ONE_LAUNCH
#define MK_ONE_LAUNCH 0
#endif
#ifndef RET_MFMA
#define RET_MFMA 1
#endif
#ifndef SWA_MFMA
#define SWA_MFMA 1
#endif
#ifndef PROBE_DUP
#define PROBE_DUP 0
#endif
#ifndef CONV_FUSED
#define CONV_FUSED 1
#endif
#ifndef PLE_EARLY
#define PLE_EARLY 1
#endif
#ifndef LN_NOXR
#define LN_NOXR 1
#endif
#define REPS(k) int nrep_ = (PROBE_DUP == (k)) ? 2 : 1; asm volatile("" : "+s"(nrep_)); for (int rep_ = 0; rep_ < nrep_; ++rep_)

constexpr int S = 16384, D = 2048, INW = 5376, DFF = 5632, NUP = 2 * DFF, NUPG = NUP + D, PLE = 256, DEPTH = 4;
constexpr float ALPHA = 1.6817928305074290f, LN_EPS = 1e-5f, GN_EPS = 1e-6f;
constexpr int NPH = 11, NPHASES = 1 + DEPTH * NPH;

constexpr size_t MiB = 1u << 20;
constexpr size_t WS_CTL = 0, CTL_ZERO_BYTES = 32768;
constexpr size_t WS_COSR = 2 * MiB, WS_SINR = 10 * MiB, WS_COSA = 18 * MiB, WS_SINA = 20 * MiB;
constexpr size_t WS_W = 32 * MiB, WL_BYTES = 106 * MiB;
constexpr size_t WL_IN = 0, WL_OUT = 21 * MiB, WL_UP = 29 * MiB, WL_G = 73 * MiB, WL_DOWN = 81 * MiB, WL_P = 104 * MiB;
constexpr size_t WS_XR = 530 * MiB, WS_XB = 576 * MiB, WS_Y = 640 * MiB;
constexpr size_t WS_Q = 768 * MiB, WS_K = 800 * MiB, WS_V = 832 * MiB, WS_G = 864 * MiB, WS_AQ = 896 * MiB, WS_AK = 928 * MiB, WS_AV = 932 * MiB;
constexpr size_t WS_MIX = 936 * MiB, WS_U = 1000 * MiB, WS_PS = 1128 * MiB, WS_RETY = 1160 * MiB;
constexpr size_t WS_H = 768 * MiB, WS_ACT = 1128 * MiB, WS_SG = 460 * MiB, WS_PB = 1368 * MiB, WS_END = 1400 * MiB;
constexpr size_t WS_PP = 1064 * MiB;
constexpr size_t WS_ST1 = 24 * MiB, WS_ST2 = 25 * MiB;
constexpr int CW_BAR = 4096;
static_assert((CW_BAR + 3456) * 4 <= 32768, "barrier words inside the per-call memset");

constexpr int RING_BYTES = 131072, LDS_BYTES = 147456, LDSCTL_OFF = LDS_BYTES - 1024, MISC_OFF = LDSCTL_OFF + 320;

__device__ __forceinline__ unsigned f2bf(float f) { unsigned u = __builtin_bit_cast(unsigned, f); return (u + 0x7fffu + ((u >> 16) & 1u)) >> 16; }
__device__ __forceinline__ unsigned pk2(float lo, float hi) { return f2bf(lo) | (f2bf(hi) << 16); }
__device__ __forceinline__ float bflo(unsigned w) { return __uint_as_float(w << 16); }
__device__ __forceinline__ float bfhi(unsigned w) { return __uint_as_float(w & 0xffff0000u); }
__device__ __forceinline__ float bf1(const bf16* p) { return __uint_as_float(((unsigned)*p) << 16); }

struct Params {
    const float* in[19]; float* out; unsigned char* ws; int ph_lo, ph_hi;
    float invf_ret[128]; float invf_att[32]; float lg2g[4];
};

struct Ctx { int tid, lane, wave, G, bid; unsigned char* ws; };

__device__ __forceinline__ int lane_id_asm() { int l; asm volatile("v_mbcnt_lo_u32_b32 %0, -1, 0\n\tv_mbcnt_hi_u32_b32 %0, -1, %0" : "=v"(l)); return l; }
__device__ __forceinline__ float wave_sum(float v, int lane) {
#pragma unroll
    for (int o = 1; o < 64; o <<= 1) v += __builtin_bit_cast(float, __builtin_amdgcn_ds_bpermute((lane ^ o) << 2, __builtin_bit_cast(int, v)));
    return v;
}
__device__ __forceinline__ void transpose_item(const float* W, int K, int N, int src_col0, bf16* WT, int dst_row0, int k0, LAS float* scr, int lane) {
#pragma unroll 8
    for (int i = 0; i < 32; ++i) { const int kk = 2 * i + (lane >> 5); scr[kk * 33 + (lane & 31)] = W[(size_t)(k0 + kk) * N + src_col0 + (lane & 31)]; }
    LDS_WAIT(); asm volatile("" ::: "memory");
    const int c = lane & 7;
#pragma unroll
    for (int j = 0; j < 4; ++j) { const int n = (lane >> 3) + 8 * j; const LAS float* s = scr + (8 * c) * 33 + n;
        v4u o; o.x = pk2(s[0 * 33], s[1 * 33]); o.y = pk2(s[2 * 33], s[3 * 33]); o.z = pk2(s[4 * 33], s[5 * 33]); o.w = pk2(s[6 * 33], s[7 * 33]);
        *(v4u*)(WT + (size_t)(dst_row0 + n) * K + k0 + 8 * c) = o; }
    LDS_WAIT(); asm volatile("" ::: "memory");
}
__device__ __forceinline__ void transpose_item64(const float* W, int K, int N, int srcA, int srcB, bf16* WT, int dst_row0, int k0, LAS float* scr, int lane, int tiled = 0) {
    const int c4 = lane & 15, gsel = c4 >> 3, col = 4 * (c4 & 7), src = (gsel ? srcB : srcA) + col, kq = lane >> 4;
    f32x4 v[16];
#pragma unroll
    for (int i = 0; i < 16; ++i) v[i] = *(const f32x4*)(W + (size_t)(k0 + 4 * i + kq) * N + src);
#pragma unroll
    for (int i = 0; i < 16; ++i) { LAS float* d = scr + (4 * i + kq) * 65 + 32 * gsel + col; d[0] = v[i][0]; d[1] = v[i][1]; d[2] = v[i][2]; d[3] = v[i][3]; }
    LDS_WAIT(); asm volatile("" ::: "memory");
    const int c = lane & 7;
#pragma unroll
    for (int j = 0; j < 8; ++j) { const int n = (lane >> 3) + 8 * j; const LAS float* s = scr + (8 * c) * 65 + n;
        v4u o; o.x = pk2(s[0 * 65], s[1 * 65]); o.y = pk2(s[2 * 65], s[3 * 65]); o.z = pk2(s[4 * 65], s[5 * 65]); o.w = pk2(s[6 * 65], s[7 * 65]);
        *(v4u*)(WT + (tiled ? pg8::tiled_off(dst_row0 + n, k0 + 8 * c, K) : (size_t)(dst_row0 + n) * K + k0 + 8 * c)) = o; }
    LDS_WAIT(); asm volatile("" ::: "memory");
}
__device__ __forceinline__ int win_src_col(int g) {
    const int tile = g >> 3, bj = (g >> 2) & 1, wcg = g & 3;
    if (tile < 16) return 32 * g;
    if (tile < 20) return 4096 + 256 * (tile - 16) + 64 * wcg + 32 * bj;
    return wcg < 2 ? 5120 + 64 * wcg + 32 * bj : 5248 + 32 * (wcg - 2) + 64 * bj;
}
__device__ __forceinline__ int wup_src_col(int g) { const int tile = g >> 3, bj = (g >> 2) & 1, wcg = g & 3; return (bj ? DFF : 0) + 128 * tile + 32 * wcg; }

__device__ __forceinline__ void sincos_d(float angf, float& s, float& c) {
    const double a = (double)angf;
    const double k = __builtin_rint(a * 0.63661977236758134308);
    double r = __builtin_fma(-k, 1.57079632679489661923, a); r = __builtin_fma(-k, 6.123233995736766e-17, r);
    const double r2 = r * r;
    const double sp = r + r * r2 * (-1.0 / 6 + r2 * (1.0 / 120 + r2 * (-1.0 / 5040 + r2 * (1.0 / 362880 + r2 * (-1.0 / 39916800)))));
    const double cp = 1.0 + r2 * (-0.5 + r2 * (1.0 / 24 + r2 * (-1.0 / 720 + r2 * (1.0 / 40320 + r2 * (-1.0 / 3628800 + r2 * (1.0 / 479001600))))));
    const int q = ((int)k) & 3;
    const double sv = (q == 0) ? sp : (q == 1) ? cp : (q == 2) ? -sp : -cp;
    const double cv = (q == 0) ? cp : (q == 1) ? -sp : (q == 2) ? -cp : sp;
    s = (float)sv; c = (float)cv;
}

__device__ __forceinline__ void phase_prologue(const Params& P, const Ctx& cx, LAS unsigned char* lds) {
    unsigned char* ws = cx.ws; const int tid = cx.tid, lane = cx.lane, wave = cx.wave, G = cx.G;
    LAS float* scr = (LAS float*)(lds + wave * 16896);
    const int gw = cx.bid * 8 + wave, NGW = G * 8;
    constexpr int I_IN = 32 * 84, I_OUT = 32 * 32, I_UP = 32 * 176, I_G = 32 * 32, I_DN = 88 * 32, I_P = 4 * 32, I_L = I_IN + I_OUT + I_UP + I_G + I_DN + I_P;
    for (int it = gw; it < DEPTH * I_L; it += NGW) {
        const int l = it / I_L; int r = it - l * I_L;
        bf16* wl = (bf16*)(ws + WS_W + (size_t)l * WL_BYTES);
        if (r < I_IN) { const int kb = r / 84, g = r % 84; transpose_item64(P.in[3] + (size_t)l * D * INW, D, INW, win_src_col(2 * g), win_src_col(2 * g + 1), wl + WL_IN / 2, 64 * g, 64 * kb, scr, lane); continue; } r -= I_IN;
        if (r < I_OUT) { const int kb = r / 32, g = r % 32; transpose_item64(P.in[4] + (size_t)l * D * D, D, D, 64 * g, 64 * g + 32, wl + WL_OUT / 2, 64 * g, 64 * kb, scr, lane); continue; } r -= I_OUT;
        if (r < I_UP) { const int kb = r / 176, g = r % 176; transpose_item64(P.in[10] + (size_t)l * D * NUP, D, NUP, wup_src_col(2 * g), wup_src_col(2 * g + 1), wl + WL_UP / 2, 64 * g, 64 * kb, scr, lane); continue; } r -= I_UP;
        if (r < I_G) { const int kb = r / 32, g = r % 32; transpose_item64(P.in[16] + (size_t)l * D * D, D, D, 64 * g, 64 * g + 32, wl + WL_G / 2, 64 * g, 64 * kb, scr, lane); continue; } r -= I_G;
        if (r < I_DN) { const int kb = r / 32, g = r % 32; transpose_item64(P.in[13] + (size_t)l * DFF * D, DFF, D, 64 * g, 64 * g + 32, wl + WL_DOWN / 2, 64 * g, 64 * kb, scr, lane, 1); continue; } r -= I_DN;
        { const int kb = r / 32, g = r % 32; transpose_item64(P.in[18] + (size_t)l * PLE * D, PLE, D, 64 * g, 64 * g + 32, wl + WL_P / 2, 64 * g, 64 * kb, scr, lane); }
    }
    const size_t gt = (size_t)cx.bid * 512 + tid, NT = (size_t)G * 512;
    { const float* x = P.in[0]; bf16* xb = (bf16*)(ws + WS_XB);
      for (size_t i = gt; i < (size_t)S * D / 8; i += NT) { const f32x4 a = *(const f32x4*)(x + i * 8), b = *(const f32x4*)(x + i * 8 + 4);
          v4u o; o.x = pk2(a[0], a[1]); o.y = pk2(a[2], a[3]); o.z = pk2(b[0], b[1]); o.w = pk2(b[2], b[3]); *(v4u*)(xb + i * 8) = o; } }
    { const float* p = P.in[1]; bf16* pb = (bf16*)(ws + WS_PB);
      for (size_t i = gt; i < (size_t)DEPTH * S * PLE / 8; i += NT) { const f32x4 a = *(const f32x4*)(p + i * 8), b = *(const f32x4*)(p + i * 8 + 4);
          v4u o; o.x = pk2(a[0], a[1]); o.y = pk2(a[2], a[3]); o.z = pk2(b[0], b[1]); o.w = pk2(b[2], b[3]); *(v4u*)(pb + i * 8) = o; } }
    { const int* pos = (const int*)P.in[2]; float* cosr = (float*)(ws + WS_COSR); float* sinr = (float*)(ws + WS_SINR); float* cosa = (float*)(ws + WS_COSA); float* sina = (float*)(ws + WS_SINA);
      for (size_t i = gt; i < (size_t)S * 128; i += NT) { const int t = (int)(i >> 7), f = (int)(i & 127); float s, c; sincos_d((float)pos[t] * P.invf_ret[f], s, c); cosr[i] = c; sinr[i] = s; }
      for (size_t i = gt; i < (size_t)S * 32; i += NT) { const int t = (int)(i >> 5), f = (int)(i & 31); float s, c; sincos_d((float)pos[t] * P.invf_att[f], s, c); cosa[i] = c; sina[i] = s; } }
}

template <int MT, int NT_, int KK, bool A_KFAST, bool B_NFAST, class FA, class FB, class FC>
__device__ __forceinline__ void simple_gemm(LAS unsigned char* lds, int nbatch, int tid, int G, int bid, const FA& fa, const FB& fb, const FC& fc) {
    LAS float* As = (LAS float*)lds;
    LAS float* Bs = (LAS float*)(lds + 16 * 132 * 4);
    constexpr int TM = MT / 128, TN = NT_ / 64, ITEMS_PER_B = TM * TN;
    const int tm = tid & 31, tn = tid >> 5;
    for (int item = bid; item < nbatch * ITEMS_PER_B; item += G) {
        const int b = item / ITEMS_PER_B, r = item % ITEMS_PER_B, m0 = (r / TN) * 128, n0 = (r % TN) * 64;
        float c[4][4];
#pragma unroll
        for (int i = 0; i < 4; ++i)
#pragma unroll
            for (int j = 0; j < 4; ++j) c[i][j] = 0.f;
        for (int k0 = 0; k0 < KK; k0 += 16) {
#pragma unroll
            for (int rr = 0; rr < 4; ++rr) { const int e = tid + 512 * rr; int m, k; if (A_KFAST) { k = e & 15; m = e >> 4; } else { m = e & 127; k = e >> 7; }
                As[k * 132 + m] = fa(b, m0 + m, k0 + k); }
#pragma unroll
            for (int rr = 0; rr < 2; ++rr) { const int e = tid + 512 * rr; int n, k; if (B_NFAST) { n = e & 63; k = e >> 6; } else { k = e & 15; n = e >> 4; }
                Bs[k * 68 + n] = fb(b, k0 + k, n0 + n); }
            __syncthreads();
#pragma unroll
            for (int kk = 0; kk < 16; ++kk) { const f32x4 a = *(const LAS f32x4*)(As + kk * 132 + 4 * tm), bb = *(const LAS f32x4*)(Bs + kk * 68 + 4 * tn);
#pragma unroll
                for (int i = 0; i < 4; ++i)
#pragma unroll
                    for (int j = 0; j < 4; ++j) c[i][j] += a[i] * bb[j]; }
            __syncthreads();
        }
#pragma unroll
        for (int i = 0; i < 4; ++i)
#pragma unroll
            for (int j = 0; j < 4; ++j) fc(b, m0 + 4 * tm + i, n0 + 4 * tn + j, c[i][j]);
    }
}

__device__ __forceinline__ void phase_swa(const Params& P, const Ctx& cx, int l, LAS unsigned char* lds) {
    unsigned char* ws = cx.ws; const int tid = cx.tid, G = cx.G;
    const bf16* AQ = (const bf16*)(ws + WS_AQ); const bf16* AK = (const bf16*)(ws + WS_AK); const bf16* AV = (const bf16*)(ws + WS_AV); bf16* MIX = (bf16*)(ws + WS_MIX);
    const float* sinks = P.in[7] + l * 16;
    LAS unsigned* Ks = (LAS unsigned*)lds;
    LAS unsigned* Vs = (LAS unsigned*)(lds + 256 * 33 * 4);
    for (int item = cx.bid; item < 256; item += G) {
        const int nb = item >> 1, hk = item & 1;
        __syncthreads();
        for (int e = tid; e < 256 * 32; e += 512) { const int r = e >> 5, cdw = e & 31; const int gk = nb * 128 - 128 + r;
            unsigned kv = 0u, vv = 0u; if (gk >= 0) { kv = *(const unsigned*)(AK + (size_t)gk * 128 + hk * 64 + 2 * cdw); vv = *(const unsigned*)(AV + (size_t)gk * 128 + hk * 64 + 2 * cdw); }
            Ks[r * 33 + cdw] = kv; Vs[r * 33 + cdw] = vv; }
        __syncthreads();
#pragma unroll 1
        for (int rep = 0; rep < 2; ++rep) {
            const int pair = tid + 512 * rep, i = pair & 127, g = pair >> 7, hq = hk * 8 + g; const int row = nb * 128 + i;
            float q[64], o[64];
            { const v4u* qp = (const v4u*)(AQ + (size_t)row * 1024 + hq * 64);
#pragma unroll
              for (int c8 = 0; c8 < 8; ++c8) { const v4u w = qp[c8]; q[8 * c8 + 0] = bflo(w.x); q[8 * c8 + 1] = bfhi(w.x); q[8 * c8 + 2] = bflo(w.y); q[8 * c8 + 3] = bfhi(w.y); q[8 * c8 + 4] = bflo(w.z); q[8 * c8 + 5] = bfhi(w.z); q[8 * c8 + 6] = bflo(w.w); q[8 * c8 + 7] = bfhi(w.w); } }
#pragma unroll
            for (int d = 0; d < 64; ++d) o[d] = 0.f;
            float mx = sinks[hq], den = 1.0f;
            const int jj0 = (nb == 0) ? (127 - i) : 0;
            for (int jj = jj0; jj < 128; ++jj) { const int kl = i + 1 + jj;
                float s = 0.f;
#pragma unroll
                for (int c = 0; c < 32; ++c) { const unsigned w = Ks[kl * 33 + c]; s += q[2 * c] * bflo(w) + q[2 * c + 1] * bfhi(w); }
                const float mn = fmaxf(mx, s), sc = __expf(mx - mn), p = __expf(s - mn);
                den = den * sc + p; mx = mn;
#pragma unroll
                for (int c = 0; c < 32; ++c) { const unsigned w = Vs[kl * 33 + c]; o[2 * c] = o[2 * c] * sc + p * bflo(w); o[2 * c + 1] = o[2 * c + 1] * sc + p * bfhi(w); }
            }
            const float inv = 1.0f / den;
            v4u* op = (v4u*)(MIX + (size_t)row * 2048 + 1024 + hq * 64);
#pragma unroll
            for (int c8 = 0; c8 < 8; ++c8) { v4u w; w.x = pk2(o[8 * c8] * inv, o[8 * c8 + 1] * inv); w.y = pk2(o[8 * c8 + 2] * inv, o[8 * c8 + 3] * inv); w.z = pk2(o[8 * c8 + 4] * inv, o[8 * c8 + 5] * inv); w.w = pk2(o[8 * c8 + 6] * inv, o[8 * c8 + 7] * inv); op[c8] = w; }
        }
    }
}

__device__ __forceinline__ void phase_ret_u_scores(const Params& P, const Ctx& cx, LAS unsigned char* lds) {
    unsigned char* ws = cx.ws; const int tid = cx.tid, G = cx.G;
    const bf16* Q = (const bf16*)(ws + WS_Q); const bf16* K = (const bf16*)(ws + WS_K); const bf16* V = (const bf16*)(ws + WS_V);
    float* U = (float*)(ws + WS_U); float* PS = (float*)(ws + WS_PS);
    const float lg0 = P.lg2g[0], lg1 = P.lg2g[1], lg2 = P.lg2g[2], lg3 = P.lg2g[3];
    auto lgh = [=](int h) { return h == 0 ? lg0 : h == 1 ? lg1 : h == 2 ? lg2 : lg3; };
    simple_gemm<256, 256, 128, false, true>(lds, 512, tid, G, cx.bid,
        [=](int b, int m, int k) { const int nb = b >> 2, h = b & 3; return bf1(K + (size_t)(nb * 128 + k) * 1024 + h * 256 + m) * exp2f(lgh(h) * (float)(127 - k)); },
        [=](int b, int k, int n) { const int nb = b >> 2, h = b & 3; return bf1(V + (size_t)(nb * 128 + k) * 1024 + h * 256 + n); },
        [=](int b, int m, int n, float v) { U[((size_t)b * 256 + m) * 256 + n] = v; });
    simple_gemm<128, 128, 256, true, false>(lds, 512, tid, G, cx.bid,
        [=](int b, int m, int k) { const int nb = b >> 2, h = b & 3; return bf1(Q + (size_t)(nb * 128 + m) * 1024 + h * 256 + k); },
        [=](int b, int k, int n) { const int nb = b >> 2, h = b & 3; return bf1(K + (size_t)(nb * 128 + n) * 1024 + h * 256 + k); },
        [=](int b, int m, int n, float v) { const int h = b & 3; PS[((size_t)b * 128 + m) * 128 + n] = (m >= n) ? v * exp2f(lgh(h) * (float)(m - n)) : 0.f; });
}
__device__ __forceinline__ void phase_scan(const Params& P, const Ctx& cx) {
    float* U = (float*)(cx.ws + WS_U);
    const size_t gt = (size_t)cx.bid * 512 + cx.tid, NT = (size_t)cx.G * 512;
    for (size_t idx = gt; idx < 4 * 65536; idx += NT) {
        const int h = (int)(idx >> 16); const float cd = exp2f(P.lg2g[h] * 128.0f);
        float r = 0.f;
        for (int n0 = 0; n0 < 128; n0 += 8) { float u[8];
#pragma unroll
            for (int j = 0; j < 8; ++j) u[j] = U[(size_t)(n0 + j) * 262144 + idx];
#pragma unroll
            for (int j = 0; j < 8; ++j) { U[(size_t)(n0 + j) * 262144 + idx] = r; r = r * cd + u[j]; } }
    }
}
__device__ __forceinline__ void phase_ret_out(const Params& P, const Ctx& cx, LAS unsigned char* lds) {
    unsigned char* ws = cx.ws; const int tid = cx.tid, G = cx.G;
    const bf16* Q = (const bf16*)(ws + WS_Q); const bf16* V = (const bf16*)(ws + WS_V);
    const float* Sst = (const float*)(ws + WS_U); const float* PS = (const float*)(ws + WS_PS); float* RY = (float*)(ws + WS_RETY);
    const float lg0 = P.lg2g[0], lg1 = P.lg2g[1], lg2 = P.lg2g[2], lg3 = P.lg2g[3];
    auto lgh = [=](int h) { return h == 0 ? lg0 : h == 1 ? lg1 : h == 2 ? lg2 : lg3; };
    simple_gemm<128, 256, 384, true, true>(lds, 512, tid, G, cx.bid,
        [=](int b, int m, int k) { const int nb = b >> 2, h = b & 3; return k < 128 ? PS[((size_t)b * 128 + m) * 128 + k] : bf1(Q + (size_t)(nb * 128 + m) * 1024 + h * 256 + (k - 128)) * exp2f(lgh(h) * (float)(m + 1)); },
        [=](int b, int k, int n) { const int nb = b >> 2, h = b & 3; return k < 128 ? bf1(V + (size_t)(nb * 128 + k) * 1024 + h * 256 + n) : Sst[((size_t)b * 256 + (k - 128)) * 256 + n]; },
        [=](int b, int m, int n, float v) { const int nb = b >> 2, h = b & 3; RY[(size_t)(nb * 128 + m) * 1024 + h * 256 + n] = v; });
}

typedef short bf16x8 __attribute__((ext_vector_type(8)));
typedef short s16x4 __attribute__((ext_vector_type(4)));
typedef short v4i16_t __attribute__((ext_vector_type(4)));
__device__ __forceinline__ f32x4 mfma16(bf16x8 a, bf16x8 b, f32x4 c) { return __builtin_amdgcn_mfma_f32_16x16x32_bf16(a, b, c, 0, 0, 0); }
__device__ __forceinline__ s16x4 lds_tr(LAS unsigned char* p) { return __builtin_bit_cast(s16x4, __builtin_amdgcn_ds_read_tr16_b64_v4i16((LAS v4i16_t*)p)); }
__device__ __forceinline__ bf16x8 cat44(s16x4 a, s16x4 b) { bf16x8 r; r[0] = a[0]; r[1] = a[1]; r[2] = a[2]; r[3] = a[3]; r[4] = b[0]; r[5] = b[1]; r[6] = b[2]; r[7] = b[3]; return r; }
__device__ __forceinline__ unsigned cvt2(float lo, float hi) { return pg8::cvt_pk_bf16(lo, hi); }
__device__ __forceinline__ bf16x8 pack_frag(const f32x4 a, const f32x4 b) { v4u w; w.x = cvt2(a[0], a[1]); w.y = cvt2(a[2], a[3]); w.z = cvt2(b[0], b[1]); w.w = cvt2(b[2], b[3]); return __builtin_bit_cast(bf16x8, w); }
__device__ __forceinline__ float grp16_sum(float v, int lane) {
#pragma unroll
    for (int o = 1; o < 16; o <<= 1) v += __builtin_bit_cast(float, __builtin_amdgcn_ds_bpermute((lane ^ o) << 2, __builtin_bit_cast(int, v)));
    return v;
}

__device__ __forceinline__ unsigned lds_addr(const LAS unsigned char* p) { return (unsigned)(size_t)p; }
template <int O1, int O2, int O3, int O4, int O5, int O6, int O7>
__device__ __forceinline__ void lds_rd8(bf16x8 (&t)[8], unsigned a) {
    asm volatile("ds_read_b128 %0, %8\n\tds_read_b128 %1, %8 offset:%9\n\tds_read_b128 %2, %8 offset:%10\n\tds_read_b128 %3, %8 offset:%11\n\t"
                 "ds_read_b128 %4, %8 offset:%12\n\tds_read_b128 %5, %8 offset:%13\n\tds_read_b128 %6, %8 offset:%14\n\tds_read_b128 %7, %8 offset:%15\n\ts_waitcnt lgkmcnt(0)"
                 : "=&v"(t[0]), "=&v"(t[1]), "=&v"(t[2]), "=&v"(t[3]), "=&v"(t[4]), "=&v"(t[5]), "=&v"(t[6]), "=&v"(t[7])
                 : "v"(a), "i"(O1), "i"(O2), "i"(O3), "i"(O4), "i"(O5), "i"(O6), "i"(O7) : "memory");
}
template <int OA, int OB, int OC>
__device__ __forceinline__ void lds_tr8(s16x4 (&t)[8], unsigned a0, unsigned a1) {
    asm volatile("ds_read_b64_tr_b16 %0, %8\n\tds_read_b64_tr_b16 %1, %8 offset:%10\n\tds_read_b64_tr_b16 %2, %8 offset:%11\n\tds_read_b64_tr_b16 %3, %8 offset:%12\n\t"
                 "ds_read_b64_tr_b16 %4, %9\n\tds_read_b64_tr_b16 %5, %9 offset:%10\n\tds_read_b64_tr_b16 %6, %9 offset:%11\n\tds_read_b64_tr_b16 %7, %9 offset:%12\n\ts_waitcnt lgkmcnt(0)"
                 : "=&v"(t[0]), "=&v"(t[1]), "=&v"(t[2]), "=&v"(t[3]), "=&v"(t[4]), "=&v"(t[5]), "=&v"(t[6]), "=&v"(t[7])
                 : "v"(a0), "v"(a1), "i"(OA), "i"(OB), "i"(OC) : "memory");
}
constexpr int RS_T = 544;
constexpr int TILE_T = 128 * RS_T;
static_assert(2 * TILE_T <= LDSCTL_OFF, "retention tiles vs LDS control words");

template <bool DECAY> __device__ __forceinline__ void stage_tile(LAS unsigned char* img, const bf16* src, int tid, float lg) {
    v4u v[8];
#pragma unroll
    for (int r = 0; r < 8; ++r) { const int pc = tid + 512 * r, row = pc >> 5, c16 = pc & 31; v[r] = *(const v4u*)(src + (size_t)row * 1024 + c16 * 8); }
#pragma unroll
    for (int r = 0; r < 8; ++r) { const int pc = tid + 512 * r, row = pc >> 5, c16 = pc & 31; v4u w = v[r];
        if (DECAY) { const float sc = exp2f(lg * (float)(127 - row));
            w.x = cvt2(bflo(w.x) * sc, bfhi(w.x) * sc); w.y = cvt2(bflo(w.y) * sc, bfhi(w.y) * sc); w.z = cvt2(bflo(w.z) * sc, bfhi(w.z) * sc); w.w = cvt2(bflo(w.w) * sc, bfhi(w.w) * sc); }
        *(LAS v4u*)(img + row * RS_T + c16 * 16) = w; }
}

template <bool DECAY_A> __device__ __forceinline__ void stage_two(LAS unsigned char* imgA, const bf16* srcA, LAS unsigned char* imgB, const bf16* srcB, int tid, float lg) {
    v4u va[8], vb[8];
#pragma unroll
    for (int r = 0; r < 8; ++r) { const int pc = tid + 512 * r, row = pc >> 5, c16 = pc & 31; va[r] = *(const v4u*)(srcA + (size_t)row * 1024 + c16 * 8); vb[r] = *(const v4u*)(srcB + (size_t)row * 1024 + c16 * 8); }
#pragma unroll
    for (int r = 0; r < 8; ++r) { const int pc = tid + 512 * r, row = pc >> 5, c16 = pc & 31; v4u w = va[r];
        if (DECAY_A) { const float sc = exp2f(lg * (float)(127 - row));
            w.x = cvt2(bflo(w.x) * sc, bfhi(w.x) * sc); w.y = cvt2(bflo(w.y) * sc, bfhi(w.y) * sc); w.z = cvt2(bflo(w.z) * sc, bfhi(w.z) * sc); w.w = cvt2(bflo(w.w) * sc, bfhi(w.w) * sc); }
        *(LAS v4u*)(imgA + row * RS_T + c16 * 16) = w; *(LAS v4u*)(imgB + row * RS_T + c16 * 16) = vb[r]; }
}

__device__ __forceinline__ void phase_ret_u_mfma(const Params& P, const Ctx& cx, LAS unsigned char* lds) {
    unsigned char* ws = cx.ws; const int tid = cx.tid, lane = cx.lane, w = cx.wave, r16 = lane & 15, g = lane >> 4, q = r16 >> 2, pp = r16 & 3;
    const bf16* K = (const bf16*)(ws + WS_K); const bf16* V = (const bf16*)(ws + WS_V); bf16* UT = (bf16*)(ws + WS_U);
    LAS unsigned char* Kim = lds; LAS unsigned char* Vim = lds + TILE_T;
    for (int b = cx.bid; b < 512; b += cx.G) {
        const int nb = b >> 2, h = b & 3;
        __syncthreads();
        stage_two<true>(Kim, K + (size_t)nb * 128 * 1024 + h * 256, Vim, V + (size_t)nb * 128 * 1024 + h * 256, tid, P.lg2g[h]);
        __syncthreads();
        f32x4 acc[2][16];
#pragma unroll
        for (int mi = 0; mi < 2; ++mi)
#pragma unroll
            for (int n = 0; n < 16; ++n) acc[mi][n] = (f32x4){0.f, 0.f, 0.f, 0.f};
#pragma unroll 1
        for (int s = 0; s < 4; ++s) {
            bf16x8 af[2];
#pragma unroll
            for (int mi = 0; mi < 2; ++mi) { LAS unsigned char* a0 = Kim + (32 * s + 8 * g + q) * RS_T + (16 * (2 * w + mi) + 4 * pp) * 2; af[mi] = cat44(lds_tr(a0), lds_tr(a0 + 4 * RS_T)); }
#pragma unroll
            for (int ng = 0; ng < 4; ++ng) { const unsigned b0 = lds_addr(Vim + (32 * s + 8 * g + q) * RS_T + (64 * ng + 4 * pp) * 2); s16x4 t[8];
                lds_tr8<32, 64, 96>(t, b0, b0 + 4 * RS_T);
#pragma unroll
                for (int nn = 0; nn < 4; ++nn) { const bf16x8 bfr = cat44(t[nn], t[4 + nn]); const int n = 4 * ng + nn;
                    acc[0][n] = mfma16(af[0], bfr, acc[0][n]); acc[1][n] = mfma16(af[1], bfr, acc[1][n]); } }
        }
#pragma unroll
        for (int mi = 0; mi < 2; ++mi)
#pragma unroll
            for (int n = 0; n < 16; ++n) { v2u o; o.x = cvt2(acc[mi][n][0], acc[mi][n][1]); o.y = cvt2(acc[mi][n][2], acc[mi][n][3]);
                *(v2u*)(UT + ((size_t)b * 256 + 16 * n + r16) * 256 + 16 * (2 * w + mi) + 4 * g) = o; }
    }
}
__device__ __forceinline__ void phase_scan_bf16(const Params& P, const Ctx& cx) {
    unsigned* UT = (unsigned*)(cx.ws + WS_U);
    const size_t gt = (size_t)cx.bid * 512 + cx.tid, NT = (size_t)cx.G * 512;
    for (size_t idx = gt; idx < 131072; idx += NT) {
        const int h = (int)(idx >> 15); const float cd = exp2f(P.lg2g[h] * 128.0f);
        float r0 = 0.f, r1 = 0.f;
        for (int n0 = 0; n0 < 128; n0 += 16) { unsigned u[16];
#pragma unroll
            for (int j = 0; j < 16; ++j) u[j] = UT[(size_t)(n0 + j) * 131072 + idx];
#pragma unroll
            for (int j = 0; j < 16; ++j) { UT[(size_t)(n0 + j) * 131072 + idx] = cvt2(r0, r1); r0 = r0 * cd + bflo(u[j]); r1 = r1 * cd + bfhi(u[j]); } }
    }
}
constexpr int RS_O = 1040;
static_assert(8 * 16 * RS_O <= 2 * TILE_T, "R3 output staging fits the shared area");
__device__ __forceinline__ void phase_ret_out_mfma(const Params& P, const Ctx& cx, int l, LAS unsigned char* lds) {
    unsigned char* ws = cx.ws; const int w = cx.wave;
    const bf16* Q = (const bf16*)(ws + WS_Q); const bf16* K = (const bf16*)(ws + WS_K); const bf16* V = (const bf16*)(ws + WS_V); const bf16* ST = (const bf16*)(ws + WS_U);
    const bf16* Gt = (const bf16*)(ws + WS_G); bf16* MIX = (bf16*)(ws + WS_MIX);
    const float* gg = P.in[5] + l * 1024; const float* gb = P.in[6] + l * 1024;
    LAS unsigned char* Kim = lds; LAS unsigned char* Vim = lds + TILE_T;
    for (int b = cx.bid; b < 512; b += cx.G) {
        const int nb = b >> 2, h = b & 3; const float lg = P.lg2g[h];
        int lane = cx.lane; asm volatile("" : "+v"(lane)); const int tid = w * 64 + lane, r16 = lane & 15, g = lane >> 4, q = r16 >> 2, pp = r16 & 3;
        __syncthreads();
        { const bf16* stb = ST + (size_t)b * 65536;
#pragma unroll
          for (int hf = 0; hf < 2; ++hf) { v4u v[8];
#pragma unroll
            for (int r = 0; r < 8; ++r) { const int pc = tid + 512 * (r + 8 * hf), row = pc >> 5, c16 = pc & 31; v[r] = *(const v4u*)(stb + (size_t)row * 256 + c16 * 8); }
#pragma unroll
            for (int r = 0; r < 8; ++r) { const int pc = tid + 512 * (r + 8 * hf), row = pc >> 5, c16 = pc & 31; *(LAS v4u*)(lds + row * RS_T + c16 * 16) = v[r]; } } }
        bf16x8 qf[8];
        { const bf16* qrow = Q + (size_t)(nb * 128 + 16 * w + r16) * 1024 + h * 256 + 8 * g;
#pragma unroll
          for (int s = 0; s < 8; ++s) qf[s] = *(const bf16x8*)(qrow + 32 * s); }
        const bf16* ksrc = K + (size_t)nb * 128 * 1024 + h * 256; const bf16* vsrc = V + (size_t)nb * 128 * 1024 + h * 256;
        v4u kv[8];
#pragma unroll
        for (int r = 0; r < 8; ++r) { const int pc = tid + 512 * r, row = pc >> 5, c16 = pc & 31; kv[r] = *(const v4u*)(ksrc + (size_t)row * 1024 + c16 * 8); }
        __syncthreads();
        f32x4 acc[16];
#pragma unroll
        for (int n = 0; n < 16; ++n) { f32x4 a = (f32x4){0.f, 0.f, 0.f, 0.f}; bf16x8 t[8];
            lds_rd8<64, 128, 192, 256, 320, 384, 448>(t, lds_addr(lds + (16 * n + r16) * RS_T + 16 * g));
#pragma unroll
            for (int s = 0; s < 8; ++s) a = mfma16(qf[s], t[s], a);
            acc[n] = a; }
        { float f[4];
#pragma unroll
          for (int r = 0; r < 4; ++r) f[r] = exp2f(lg * (float)(16 * w + 4 * g + r + 1));
#pragma unroll
          for (int n = 0; n < 16; ++n) { acc[n][0] *= f[0]; acc[n][1] *= f[1]; acc[n][2] *= f[2]; acc[n][3] *= f[3]; } }
        __syncthreads();
        v4u vv[8];
#pragma unroll
        for (int r = 0; r < 8; ++r) { const int pc = tid + 512 * r, row = pc >> 5, c16 = pc & 31; *(LAS v4u*)(Kim + row * RS_T + c16 * 16) = kv[r]; vv[r] = *(const v4u*)(vsrc + (size_t)row * 1024 + c16 * 8); }
        __syncthreads();
        f32x4 sc[8];
#pragma unroll
        for (int mb = 0; mb < 8; ++mb) { sc[mb] = (f32x4){0.f, 0.f, 0.f, 0.f};
            if (mb <= w) { f32x4 a = (f32x4){0.f, 0.f, 0.f, 0.f}; bf16x8 t[8];
                lds_rd8<64, 128, 192, 256, 320, 384, 448>(t, lds_addr(Kim + (16 * mb + r16) * RS_T + 16 * g));
#pragma unroll
                for (int s = 0; s < 8; ++s) a = mfma16(t[s], qf[s], a);
                const int i = 16 * w + r16;
#pragma unroll
                for (int r = 0; r < 4; ++r) { const int j = 16 * mb + 4 * g + r; a[r] = (i >= j) ? a[r] * exp2f(lg * (float)(i - j)) : 0.f; }
                sc[mb] = a; } }
#pragma unroll
        for (int r = 0; r < 8; ++r) { const int pc = tid + 512 * r, row = pc >> 5, c16 = pc & 31; *(LAS v4u*)(Vim + row * RS_T + c16 * 16) = vv[r]; }
        __syncthreads();
#pragma unroll
        for (int sk = 0; sk < 4; ++sk) {
            if (2 * sk <= w) { const bf16x8 pf = pack_frag(sc[2 * sk], sc[2 * sk + 1]);
#pragma unroll
                for (int ng = 0; ng < 4; ++ng) { const unsigned b0 = lds_addr(Vim + (32 * sk + 4 * g + q) * RS_T + (64 * ng + 4 * pp) * 2); s16x4 t[8];
                    lds_tr8<32, 64, 96>(t, b0, b0 + 16 * RS_T);
#pragma unroll
                    for (int nn = 0; nn < 4; ++nn) acc[4 * ng + nn] = mfma16(pf, cat44(t[nn], t[4 + nn]), acc[4 * ng + nn]); } } }
        float mean[4], rstd[4];
#pragma unroll
        for (int r = 0; r < 4; ++r) { float sm = 0.f;
#pragma unroll
            for (int n = 0; n < 16; ++n) sm += acc[n][r];
            mean[r] = grp16_sum(sm, lane) * (1.0f / 256.0f); }
#pragma unroll
        for (int r = 0; r < 4; ++r) { float sq = 0.f;
#pragma unroll
            for (int n = 0; n < 16; ++n) { const float d = acc[n][r] - mean[r]; sq += d * d; }
            rstd[r] = 1.0f / sqrtf(grp16_sum(sq, lane) * (1.0f / 256.0f) + GN_EPS); }
        __syncthreads();
        { LAS unsigned char* ob = lds + w * (16 * RS_O);
#pragma unroll
          for (int n = 0; n < 16; ++n)
#pragma unroll
            for (int r = 0; r < 4; ++r) *(LAS float*)(ob + (4 * g + r) * RS_O + (16 * n + r16) * 4) = (acc[n][r] - mean[r]) * rstd[r];
          LDS_WAIT(); asm volatile("" ::: "memory");
          const int e0 = 8 * (lane & 31), hv = lane >> 5;
          const f32x4 g0 = *(const f32x4*)(gg + h * 256 + e0), g1 = *(const f32x4*)(gg + h * 256 + e0 + 4), b0 = *(const f32x4*)(gb + h * 256 + e0), b1 = *(const f32x4*)(gb + h * 256 + e0 + 4);
#pragma unroll
          for (int k = 0; k < 8; ++k) { const int rl = 2 * k + hv; const size_t row = (size_t)(nb * 128 + 16 * w + rl);
              const f32x4 y0 = *(const LAS f32x4*)(ob + rl * RS_O + e0 * 4), y1 = *(const LAS f32x4*)(ob + rl * RS_O + e0 * 4 + 16);
              const v4u gt = *(const v4u*)(Gt + row * 1024 + h * 256 + e0);
              const f32x4 o0 = y0 * g0 + b0, o1 = y1 * g1 + b1;
              v4u o; o.x = cvt2(o0[0] * bflo(gt.x), o0[1] * bfhi(gt.x)); o.y = cvt2(o0[2] * bflo(gt.y), o0[3] * bfhi(gt.y)); o.z = cvt2(o1[0] * bflo(gt.z), o1[1] * bfhi(gt.z)); o.w = cvt2(o1[2] * bflo(gt.w), o1[3] * bfhi(gt.w));
              *(v4u*)(MIX + row * 2048 + h * 256 + e0) = o; } }
    }
}
constexpr int RS_SK = 144, RS_SV = 160;
__device__ __forceinline__ void phase_swa_mfma(const Params& P, const Ctx& cx, int l, LAS unsigned char* lds) {
    unsigned char* ws = cx.ws; const int tid = cx.tid, lane = cx.lane, w = cx.wave, r16 = lane & 15, g = lane >> 4, q = r16 >> 2, pp = r16 & 3;
    const bf16* AQ = (const bf16*)(ws + WS_AQ); const bf16* AK = (const bf16*)(ws + WS_AK); const bf16* AV = (const bf16*)(ws + WS_AV); bf16* MIX = (bf16*)(ws + WS_MIX);
    LAS unsigned char* Kim = lds; LAS unsigned char* Vim = lds + 256 * RS_SK;
    for (int item = cx.bid; item < 256; item += cx.G) {
        const int nb = item >> 1, hk = item & 1, hq = hk * 8 + w; const float sink = P.in[7][l * 16 + hq];
        __syncthreads();
#pragma unroll
        for (int r = 0; r < 4; ++r) { const int pc = tid + 512 * r, row = pc >> 3, c = pc & 7, gk = nb * 128 - 128 + row;
            v4u kv = (v4u){0u, 0u, 0u, 0u}, vv = (v4u){0u, 0u, 0u, 0u};
            if (gk >= 0) { kv = *(const v4u*)(AK + (size_t)gk * 128 + hk * 64 + c * 8); vv = *(const v4u*)(AV + (size_t)gk * 128 + hk * 64 + c * 8); }
            *(LAS v4u*)(Kim + row * RS_SK + c * 16) = kv; *(LAS v4u*)(Vim + row * RS_SV + c * 16) = vv; }
        __syncthreads();
#pragma unroll 1
        for (int nq = 0; nq < 8; ++nq) {
            const bf16* qrow = AQ + (size_t)(nb * 128 + 16 * nq + r16) * 1024 + hq * 64 + 8 * g;
            const bf16x8 qf0 = *(const bf16x8*)(qrow), qf1 = *(const bf16x8*)(qrow + 32);
            f32x4 sc[10];
            float mx = sink;
            bf16x8 kt[18];
            { const unsigned kp0 = lds_addr(Kim + (16 * nq + r16) * RS_SK + 16 * g);
              bf16x8 t[8];
              lds_rd8<64, 16 * RS_SK, 16 * RS_SK + 64, 32 * RS_SK, 32 * RS_SK + 64, 48 * RS_SK, 48 * RS_SK + 64>(t, kp0);
#pragma unroll
              for (int i = 0; i < 8; ++i) kt[i] = t[i];
              lds_rd8<64, 16 * RS_SK, 16 * RS_SK + 64, 32 * RS_SK, 32 * RS_SK + 64, 48 * RS_SK, 48 * RS_SK + 64>(t, kp0 + 64 * RS_SK);
#pragma unroll
              for (int i = 0; i < 8; ++i) kt[8 + i] = t[i];
              kt[16] = *(const LAS bf16x8*)(Kim + (16 * (nq + 8) + r16) * RS_SK + 16 * g); kt[17] = *(const LAS bf16x8*)(Kim + (16 * (nq + 8) + r16) * RS_SK + 16 * g + 64); }
#pragma unroll
            for (int kb = 0; kb < 9; ++kb) {
                f32x4 a = (f32x4){0.f, 0.f, 0.f, 0.f};
                a = mfma16(kt[2 * kb], qf0, a); a = mfma16(kt[2 * kb + 1], qf1, a);
#pragma unroll
                for (int r = 0; r < 4; ++r) { const int dl = 16 * kb + 4 * g + r - r16; const bool vis = (dl >= 1) && (dl <= 128) && (nb > 0 || 16 * (nq + kb) + 4 * g + r >= 128);
                    a[r] = vis ? a[r] : -INFINITY; mx = fmaxf(mx, a[r]); }
                sc[kb] = a; }
            sc[9] = (f32x4){0.f, 0.f, 0.f, 0.f};
            mx = fmaxf(mx, __builtin_bit_cast(float, __builtin_amdgcn_ds_bpermute((lane ^ 16) << 2, __builtin_bit_cast(int, mx))));
            mx = fmaxf(mx, __builtin_bit_cast(float, __builtin_amdgcn_ds_bpermute((lane ^ 32) << 2, __builtin_bit_cast(int, mx))));
            float sum = 0.f;
#pragma unroll
            for (int kb = 0; kb < 9; ++kb)
#pragma unroll
                for (int r = 0; r < 4; ++r) { const float pv = __expf(sc[kb][r] - mx); sc[kb][r] = pv; sum += pv; }
            sum += __builtin_bit_cast(float, __builtin_amdgcn_ds_bpermute((lane ^ 16) << 2, __builtin_bit_cast(int, sum)));
            sum += __builtin_bit_cast(float, __builtin_amdgcn_ds_bpermute((lane ^ 32) << 2, __builtin_bit_cast(int, sum)));
            const float inv = 1.0f / (sum + __expf(sink - mx));
            f32x4 o[4];
#pragma unroll
            for (int nd = 0; nd < 4; ++nd) o[nd] = (f32x4){0.f, 0.f, 0.f, 0.f};
#pragma unroll
            for (int sk = 0; sk < 5; ++sk) { const bf16x8 pf = pack_frag(sc[2 * sk] * inv, sc[2 * sk + 1] * inv);
                const int kb0 = nq + 2 * sk, kb1 = (kb0 + 1 > 15) ? 15 : kb0 + 1;
                s16x4 t[8];
                lds_tr8<32, 64, 96>(t, lds_addr(Vim + (16 * kb0 + 4 * g + q) * RS_SV + 8 * pp), lds_addr(Vim + (16 * kb1 + 4 * g + q) * RS_SV + 8 * pp));
#pragma unroll
                for (int nd = 0; nd < 4; ++nd) o[nd] = mfma16(pf, cat44(t[nd], t[4 + nd]), o[nd]); }
#pragma unroll
            for (int nd = 0; nd < 4; ++nd)
#pragma unroll
                for (int r = 0; r < 4; ++r) MIX[(size_t)(nb * 128 + 16 * nq + 4 * g + r) * 2048 + 1024 + hq * 64 + 16 * nd + r16] = (bf16)f2bf(o[nd][r]);
        }
    }
}

__device__ __forceinline__ void phase_groupnorm(const Params& P, const Ctx& cx, int l) {
    unsigned char* ws = cx.ws; const int lane = cx.lane, wave = cx.wave, G = cx.G;
    const float* RY = (const float*)(ws + WS_RETY); const bf16* Gt = (const bf16*)(ws + WS_G); bf16* MIX = (bf16*)(ws + WS_MIX);
    const float* gg = P.in[5] + l * 1024; const float* gb = P.in[6] + l * 1024;
    const int gw = cx.bid * 8 + wave, NGW = G * 8;
    for (int it = gw; it < S * 4; it += NGW) { const int row = it >> 2, h = it & 3; const size_t off = (size_t)row * 1024 + h * 256 + 4 * lane;
        f32x4 v = *(const f32x4*)(RY + off);
        const float mean = wave_sum((v[0] + v[1]) + (v[2] + v[3]), lane) * (1.0f / 256.0f);
        v = v - mean;
        const float var = wave_sum((v[0] * v[0] + v[1] * v[1]) + (v[2] * v[2] + v[3] * v[3]), lane) * (1.0f / 256.0f);
        const float rstd = 1.0f / sqrtf(var + GN_EPS);
        const f32x4 g4 = *(const f32x4*)(gg + h * 256 + 4 * lane), b4 = *(const f32x4*)(gb + h * 256 + 4 * lane);
        const v2u gt2 = *(const v2u*)(Gt + off);
        f32x4 o = v * rstd * g4 + b4;
        o[0] *= bflo(gt2.x); o[1] *= bfhi(gt2.x); o[2] *= bflo(gt2.y); o[3] *= bfhi(gt2.y);
        v2u w; w.x = pk2(o[0], o[1]); w.y = pk2(o[2], o[3]);
        *(v2u*)(MIX + (size_t)row * 2048 + h * 256 + 4 * lane) = w; }
}
__device__ __forceinline__ void phase_ln(const Ctx& cx, const float* Y, const float* g, const float* b, float* xo, bf16* xb, float* stats) {
    const int lane = cx.lane, wave = cx.wave, G = cx.G; const int gw = cx.bid * 8 + wave, NGW = G * 8;
    f32x4 g4[8], b4[8];
#pragma unroll
    for (int j = 0; j < 8; ++j) { g4[j] = ((const f32x4*)g)[64 * j + lane]; b4[j] = ((const f32x4*)b)[64 * j + lane]; }
    for (int row = gw; row < S; row += 2 * NGW) {
        const int row2 = row + NGW; const bool has2 = row2 < S; const int rb = has2 ? row2 : row;
        const f32x4* ya = (const f32x4*)(Y + (size_t)row * D) + lane; const f32x4* yb = (const f32x4*)(Y + (size_t)rb * D) + lane;
        f32x4 va[8], vb[8]; float sa = 0.f, sb = 0.f;
#pragma unroll
        for (int j = 0; j < 8; ++j) { va[j] = ya[64 * j]; vb[j] = yb[64 * j]; }
#pragma unroll
        for (int j = 0; j < 8; ++j) { sa += (va[j][0] + va[j][1]) + (va[j][2] + va[j][3]); sb += (vb[j][0] + vb[j][1]) + (vb[j][2] + vb[j][3]); }
        const float ma = wave_sum(sa, lane) * (1.0f / D), mb = wave_sum(sb, lane) * (1.0f / D); float qa = 0.f, qb = 0.f;
#pragma unroll
        for (int j = 0; j < 8; ++j) { va[j] = va[j] - ma; vb[j] = vb[j] - mb; qa += (va[j][0] * va[j][0] + va[j][1] * va[j][1]) + (va[j][2] * va[j][2] + va[j][3] * va[j][3]); qb += (vb[j][0] * vb[j][0] + vb[j][1] * vb[j][1]) + (vb[j][2] * vb[j][2] + vb[j][3] * vb[j][3]); }
        const float ra = 1.0f / sqrtf(wave_sum(qa, lane) * (1.0f / D) + LN_EPS), rbb = 1.0f / sqrtf(wave_sum(qb, lane) * (1.0f / D) + LN_EPS);
        f32x4* xa = (f32x4*)(xo + (size_t)row * D) + lane; f32x4* xbp = (f32x4*)(xo + (size_t)rb * D) + lane;
        if (stats && lane == 0) { stats[2 * (size_t)row] = ma; stats[2 * (size_t)row + 1] = ra; if (has2) { stats[2 * (size_t)rb] = mb; stats[2 * (size_t)rb + 1] = rbb; } }
#pragma unroll
        for (int j = 0; j < 8; ++j) { const f32x4 o = va[j] * ra * g4[j] + b4[j]; if (xo) xa[64 * j] = o;
            if (xb) { v2u w; w.x = pk2(o[0], o[1]); w.y = pk2(o[2], o[3]); ((v2u*)(xb + (size_t)row * D))[64 * j + lane] = w; } }
        if (has2) {
#pragma unroll
            for (int j = 0; j < 8; ++j) { const f32x4 o = vb[j] * rbb * g4[j] + b4[j]; if (xo) xbp[64 * j] = o;
                if (xb) { v2u w; w.x = pk2(o[0], o[1]); w.y = pk2(o[2], o[3]); ((v2u*)(xb + (size_t)rb * D))[64 * j + lane] = w; } } }
    }
}
__device__ __forceinline__ void unpack8(const v4u h, float (&o)[8]) { o[0] = bflo(h.x); o[1] = bfhi(h.x); o[2] = bflo(h.y); o[3] = bfhi(h.y); o[4] = bflo(h.z); o[5] = bfhi(h.z); o[6] = bflo(h.w); o[7] = bfhi(h.w); }
__device__ __forceinline__ void phase_convact(const Params& P, const Ctx& cx, int l) {
    unsigned char* ws = cx.ws; const int tid = cx.tid, G = cx.G;
    const bf16* H = (const bf16*)(ws + WS_H); bf16* ACT = (bf16*)(ws + WS_ACT);
    const float* cw = P.in[11] + (size_t)l * 3 * NUP; const float* cb = P.in[12] + (size_t)l * NUP;
    const int gt = cx.bid * 512 + tid, NT = G * 512;
    for (int item = gt; item < 512 * 704; item += NT) {
        const int seg = item / 704, r = item - seg * 704, tile = r >> 4, q8 = r & 15, t0 = seg * 32;
        const int chg = 128 * tile + 8 * q8, chu = DFF + chg;
        float wg[3][8], wu[3][8], bg[8], bu[8];
#pragma unroll
        for (int k = 0; k < 3; ++k) { const f32x4 a0 = *(const f32x4*)(cw + (size_t)k * NUP + chg), a1 = *(const f32x4*)(cw + (size_t)k * NUP + chg + 4), c0 = *(const f32x4*)(cw + (size_t)k * NUP + chu), c1 = *(const f32x4*)(cw + (size_t)k * NUP + chu + 4);
#pragma unroll
            for (int e = 0; e < 4; ++e) { wg[k][e] = a0[e]; wg[k][4 + e] = a1[e]; wu[k][e] = c0[e]; wu[k][4 + e] = c1[e]; } }
        { const f32x4 a0 = *(const f32x4*)(cb + chg), a1 = *(const f32x4*)(cb + chg + 4), c0 = *(const f32x4*)(cb + chu), c1 = *(const f32x4*)(cb + chu + 4);
#pragma unroll
          for (int e = 0; e < 4; ++e) { bg[e] = a0[e]; bg[4 + e] = a1[e]; bu[e] = c0[e]; bu[4 + e] = c1[e]; } }
        const bf16* hp = H + (size_t)t0 * NUP + 256 * tile + 8 * q8;
        float g2[8], g1[8], u2[8], u1[8];
        if (t0 > 0) { unpack8(*(const v4u*)(hp - 2 * (size_t)NUP), g2); unpack8(*(const v4u*)(hp - (size_t)NUP), g1); unpack8(*(const v4u*)(hp - 2 * (size_t)NUP + 128), u2); unpack8(*(const v4u*)(hp - (size_t)NUP + 128), u1); }
        else {
#pragma unroll
            for (int e = 0; e < 8; ++e) { g2[e] = 0.f; g1[e] = 0.f; u2[e] = 0.f; u1[e] = 0.f; } }
        bf16* ap = ACT + (size_t)t0 * DFF + chg;
        v4u ng = *(const v4u*)(hp), nu = *(const v4u*)(hp + 128);
#pragma unroll 2
        for (int tt = 0; tt < 32; ++tt) {
            float g0[8], u0[8]; unpack8(ng, g0); unpack8(nu, u0);
            if (tt < 31) { ng = *(const v4u*)(hp + (size_t)(tt + 1) * NUP); nu = *(const v4u*)(hp + (size_t)(tt + 1) * NUP + 128); }
            float o[8];
#pragma unroll
            for (int e = 0; e < 8; ++e) { const float ga = bg[e] + wg[0][e] * g2[e] + wg[1][e] * g1[e] + wg[2][e] * g0[e], ua = bu[e] + wu[0][e] * u2[e] + wu[1][e] * u1[e] + wu[2][e] * u0[e];
                o[e] = ga * __builtin_amdgcn_rcpf(1.0f + __expf(-ga)) * ua; g2[e] = g1[e]; g1[e] = g0[e]; u2[e] = u1[e]; u1[e] = u0[e]; }
            v4u w; w.x = cvt2(o[0], o[1]); w.y = cvt2(o[2], o[3]); w.z = cvt2(o[4], o[5]); w.w = cvt2(o[6], o[7]);
            *(v4u*)(ap + (size_t)tt * DFF) = w;
        }
    }
}

__device__ __forceinline__ void phase_conv_fixup(const Params& P, const Ctx& cx, int l) {
    unsigned char* ws = cx.ws;
    const bf16* HALO = (const bf16*)(ws + WS_H); bf16* ACT = (bf16*)(ws + WS_ACT);
    const float* cw = P.in[11] + (size_t)l * 3 * NUP; const float* cb = P.in[12] + (size_t)l * NUP;
    const int gt = cx.bid * 512 + cx.tid, NT = cx.G * 512;
    for (int item = gt; item < 256 * 704; item += NT) {
        const int k = item / 704, r = item - k * 704, tile = r >> 4, q8 = r & 15, chg = 128 * tile + 8 * q8, chu = DFF + chg;
        float a_g[8], b_g[8], c_g[8], d_g[8], a_u[8], b_u[8], c_u[8], d_u[8];
        const bf16* hk = HALO + (size_t)k * 4 * NUP + 256 * tile + 8 * q8;
        unpack8(*(const v4u*)(hk), c_g); unpack8(*(const v4u*)(hk + NUP), d_g); unpack8(*(const v4u*)(hk + 128), c_u); unpack8(*(const v4u*)(hk + NUP + 128), d_u);
        if (k > 0) { const bf16* hm = hk - 4 * (size_t)NUP; unpack8(*(const v4u*)(hm + 2 * NUP), a_g); unpack8(*(const v4u*)(hm + 3 * NUP), b_g); unpack8(*(const v4u*)(hm + 2 * NUP + 128), a_u); unpack8(*(const v4u*)(hm + 3 * NUP + 128), b_u); }
        else {
#pragma unroll
            for (int e = 0; e < 8; ++e) { a_g[e] = 0.f; b_g[e] = 0.f; a_u[e] = 0.f; b_u[e] = 0.f; } }
        float o0[8], o1[8];
#pragma unroll
        for (int e = 0; e < 8; ++e) { const float w0g = cw[chg + e], w1g = cw[NUP + chg + e], w2g = cw[2 * NUP + chg + e], bgv = cb[chg + e], w0u = cw[chu + e], w1u = cw[NUP + chu + e], w2u = cw[2 * NUP + chu + e], buv = cb[chu + e];
            const float g0 = bgv + w0g * a_g[e] + w1g * b_g[e] + w2g * c_g[e], u0 = buv + w0u * a_u[e] + w1u * b_u[e] + w2u * c_u[e];
            const float g1 = bgv + w0g * b_g[e] + w1g * c_g[e] + w2g * d_g[e], u1 = buv + w0u * b_u[e] + w1u * c_u[e] + w2u * d_u[e];
            o0[e] = g0 * __builtin_amdgcn_rcpf(1.0f + __expf(-g0)) * u0; o1[e] = g1 * __builtin_amdgcn_rcpf(1.0f + __expf(-g1)) * u1; }
        v4u w0, w1; w0.x = cvt2(o0[0], o0[1]); w0.y = cvt2(o0[2], o0[3]); w0.z = cvt2(o0[4], o0[5]); w0.w = cvt2(o0[6], o0[7]); w1.x = cvt2(o1[0], o1[1]); w1.y = cvt2(o1[2], o1[3]); w1.z = cvt2(o1[4], o1[5]); w1.w = cvt2(o1[6], o1[7]);
        *(v4u*)(ACT + pg8::tiled_off(64 * k, chg, DFF)) = w0; *(v4u*)(ACT + pg8::tiled_off(64 * k + 1, chg, DFF)) = w1;
    }
}

#ifdef DBG_DUMP
__device__ __forceinline__ void phase_dump(const Ctx& cx, float* out, const bf16* a, int lda, const bf16* b, int ldb, const float* f) {
    const size_t gt = (size_t)cx.bid * 512 + cx.tid, NT = (size_t)cx.G * 512;
    for (size_t i = gt; i < (size_t)S * D; i += NT) { const int row = (int)(i >> 11), col = (int)(i & 2047);
        float v; if (f) v = f[i]; else if (b && col >= 1024) v = bf1(b + (size_t)row * ldb + (col - 1024)); else v = lda ? bf1(a + (size_t)row * lda + col) : bf1(a + (size_t)(row & 2047) * 2048 + col);
        out[i] = v; }
}
#endif
__global__ void __launch_bounds__(512, 2) fwd(Params P) {
    extern __shared__ __attribute__((aligned(16))) unsigned char lds_raw[];
    LAS unsigned char* lds = (LAS unsigned char*)lds_raw;
    const int wave = __builtin_amdgcn_readfirstlane(threadIdx.x >> 6), G = gridDim.x;
    unsigned char* ws = P.ws;
    volatile LAS unsigned* MISC = (volatile LAS unsigned*)(lds + MISC_OFF);
    for (int u = threadIdx.x; u < (LDS_BYTES - LDSCTL_OFF) / 4; u += 512) ((LAS unsigned*)(lds + LDSCTL_OFF))[u] = 0u;
    __syncthreads();
    const int lo = P.ph_lo, hi = P.ph_hi;
    XcdBarrier bar; bar.bar = (unsigned*)(ws + WS_CTL) + CW_BAR; bar.x = 0; bar.st = nullptr;
    if (hi - lo > 1) bar = xcd_barrier_post((unsigned*)(ws + WS_CTL) + CW_BAR, MISC + 8);
#define IN(k) (lo <= (k) && (k) < hi)
#if PROBE_DUP == 20
#define SEAM(k) do { if (IN(k) && IN((k) + 1)) { xcd_barrier(bar); xcd_barrier(bar); } } while (0)
#else
#define SEAM(k) do { if (IN(k) && IN((k) + 1)) xcd_barrier(bar); } while (0)
#endif
#define OPQ() Ctx cx; cx.lane = lane_id_asm(); { int t_ = wave; asm volatile("" : "+s"(t_)); cx.wave = t_; } { int t_ = G; asm volatile("" : "+s"(t_)); cx.G = t_; } { int t_ = blockIdx.x; asm volatile("" : "+s"(t_)); cx.bid = t_; } \
    { unsigned t_ = 0u; asm volatile("" : "+s"(t_)); cx.ws = P.ws + t_; } cx.tid = cx.wave * 64 + cx.lane; int lq = l; asm volatile("" : "+s"(lq)); (void)lq

#ifdef DBG_DUMP
    if (lo >= 1000) { const int l = 0; OPQ(); unsigned char* w = cx.ws; const int kind = lo - 1000;
        if (kind == 1) phase_dump(cx, P.out, (const bf16*)(w + WS_Q), 1024, (const bf16*)(w + WS_AQ), 1024, nullptr);
        else if (kind == 2) phase_dump(cx, P.out, (const bf16*)(w + WS_MIX), 2048, nullptr, 0, nullptr);
        else if (kind == 3) phase_dump(cx, P.out, nullptr, 0, nullptr, 0, (const float*)(w + WS_XR));
        else if (kind == 4) phase_dump(cx, P.out, (const bf16*)(w + WS_ACT), DFF, nullptr, 0, nullptr);
        else if (kind == 5) phase_dump(cx, P.out, nullptr, 0, nullptr, 0, (const float*)(w + WS_Y));
        else if (kind == 6) phase_dump(cx, P.out, (const bf16*)(w + WS_K), 1024, (const bf16*)(w + WS_V), 1024, nullptr);
        else if (kind == 7) phase_dump(cx, P.out, (const bf16*)(w + WS_XB), 2048, nullptr, 0, nullptr);
        else if (kind == 11) phase_dump(cx, P.out, (const bf16*)(w + WS_W + WL_G), 0, nullptr, 0, nullptr);
        else if (kind == 12) phase_dump(cx, P.out, (const bf16*)(w + WS_W + WL_OUT), 0, nullptr, 0, nullptr);
        else if (kind == 10) phase_dump(cx, P.out, (const bf16*)(w + WS_H) + 36 * 256, NUP, nullptr, 0, nullptr);
        else if (kind == 9) phase_dump(cx, P.out, (const bf16*)(w + WS_SG), 2048, nullptr, 0, nullptr);
        else if (kind == 8) phase_dump(cx, P.out, nullptr, 0, nullptr, 0, (const float*)(w + WS_RETY));
        return; }
#endif
    if (IN(0)) { const int l = 0; REPS(9) { __syncthreads(); OPQ(); phase_prologue(P, cx, lds); } }
    SEAM(0);

    for (int l = 0; l < DEPTH; ++l) {
        const int pb = 1 + l * NPH;
        if (IN(pb + 0)) { REPS(3) { OPQ(); unsigned char* w = cx.ws; const bf16* wl = (const bf16*)(w + WS_W + (size_t)lq * WL_BYTES);
            pg8::Gemm g{(const bf16*)(w + WS_XB), wl + WL_IN / 2, S, INW, D}; pg8::StaticOrder So; So.init(S, INW, cx.G, cx.bid);
            pg8::EpiInProj E{(bf16*)(w + WS_Q), (bf16*)(w + WS_K), (bf16*)(w + WS_V), (bf16*)(w + WS_G), (bf16*)(w + WS_AQ), (bf16*)(w + WS_AK), (bf16*)(w + WS_AV),
                             (const float*)(w + WS_COSR), (const float*)(w + WS_SINR), (const float*)(w + WS_COSA), (const float*)(w + WS_SINA)};
            pg8::gemm_phase<pg8::EpiInProj, pg8::StaticOrder, true, true>(lds, g, So, E, cx.wave);
        } }
#if PLE_EARLY
        if (IN(pb + 0)) { OPQ(); unsigned char* w = cx.ws; const bf16* wl = (const bf16*)(w + WS_W + (size_t)lq * WL_BYTES);
            const int nsub = (cx.G > 64) ? cx.G - 64 : cx.G, csub = (cx.G > 64) ? cx.bid - 64 : cx.bid;
            if (csub >= 0) {
                int kple = PLE; asm volatile("" : "+s"(kple));
                pg8::Gemm g{(const bf16*)(w + WS_PB) + (size_t)lq * S * PLE, wl + WL_P / 2, S, D, kple}; pg8::StaticOrder So; So.init(S, D, nsub, csub);
                pg8::EpiPlain E{(bf16*)(w + WS_PP)};
                pg8::gemm_phase<pg8::EpiPlain, pg8::StaticOrder, true, true>(lds, g, So, E, cx.wave); }
        }
#endif
        SEAM(pb + 0);
        if (IN(pb + 1)) {
#if RET_MFMA
            { REPS(6) { OPQ(); phase_ret_u_mfma(P, cx, lds); } }
#else
            { OPQ(); phase_ret_u_scores(P, cx, lds); }
#endif
#if SWA_MFMA
            { REPS(8) { OPQ(); phase_swa_mfma(P, cx, lq, lds); } }
#else
            { OPQ(); phase_swa(P, cx, lq, lds); }
#endif
        }
        SEAM(pb + 1);
#if RET_MFMA
        if (IN(pb + 2)) { OPQ(); phase_scan_bf16(P, cx); }
        SEAM(pb + 2);
        if (IN(pb + 3)) { REPS(7) { OPQ(); phase_ret_out_mfma(P, cx, lq, lds); } }
        SEAM(pb + 3);
#else
        if (IN(pb + 2)) { OPQ(); phase_scan(P, cx); }
        SEAM(pb + 2);
        if (IN(pb + 3)) { OPQ(); phase_ret_out(P, cx, lds); }
        SEAM(pb + 3);
        if (IN(pb + 4)) { OPQ(); phase_groupnorm(P, cx, lq); }
        SEAM(pb + 4);
#endif
        if (IN(pb + 5)) { OPQ(); unsigned char* w = cx.ws; const bf16* wl = (const bf16*)(w + WS_W + (size_t)lq * WL_BYTES);
            pg8::Gemm g{(const bf16*)(w + WS_MIX), wl + WL_OUT / 2, S, D, D}; pg8::StaticOrder So; So.init(S, D, cx.G, cx.bid);
#if LN_NOXR
            if (lq == 0) { pg8::EpiResid<false> E{P.in[0], (float*)(w + WS_Y), ALPHA};
                pg8::gemm_phase<pg8::EpiResid<false>, pg8::StaticOrder, true, true>(lds, g, So, E, cx.wave); }
            else {
#if PROBE_DUP == 30
                { pg8::EpiResidLN<false> E{(float*)(w + WS_Y), (float*)(w + WS_XR + 2 * MiB), (const float*)(w + WS_ST2), P.in[14] + (lq - 1) * D, P.in[15] + (lq - 1) * D, nullptr, nullptr, ALPHA};
                  pg8::gemm_phase<pg8::EpiResidLN<false>, pg8::StaticOrder, true, true>(lds, g, So, E, cx.wave); }
#endif
                pg8::EpiResidLN<false> E{(float*)(w + WS_Y), (float*)(w + WS_Y), (const float*)(w + WS_ST2), P.in[14] + (lq - 1) * D, P.in[15] + (lq - 1) * D, nullptr, nullptr, ALPHA};
                pg8::gemm_phase<pg8::EpiResidLN<false>, pg8::StaticOrder, true, true>(lds, g, So, E, cx.wave); }
#else
            pg8::EpiResid<false> E{(lq == 0) ? P.in[0] : (const float*)(w + WS_XR), (float*)(w + WS_Y), ALPHA};
            pg8::gemm_phase<pg8::EpiResid<false>, pg8::StaticOrder, true, true>(lds, g, So, E, cx.wave);
#endif
        }
        SEAM(pb + 5);
        if (IN(pb + 6)) { REPS(1) { OPQ(); unsigned char* w = cx.ws;
#if LN_NOXR
            phase_ln(cx, (const float*)(w + WS_Y), P.in[8] + lq * D, P.in[9] + lq * D, (float*)nullptr, (bf16*)(w + WS_XB), (float*)(w + WS_ST1));
#else
            phase_ln(cx, (const float*)(w + WS_Y), P.in[8] + lq * D, P.in[9] + lq * D, (float*)(w + WS_XR), (bf16*)(w + WS_XB), (float*)nullptr);
#endif
        } }
        SEAM(pb + 6);
        if (IN(pb + 7)) { REPS(5) { OPQ(); unsigned char* w = cx.ws; const bf16* wl = (const bf16*)(w + WS_W + (size_t)lq * WL_BYTES);
            pg8::Gemm g{(const bf16*)(w + WS_XB), wl + WL_UP / 2, S, NUPG, D}; pg8::StaticOrder So; So.init(S, NUPG, cx.G, cx.bid);
#if CONV_FUSED
            pg8::EpiUpConv E{(bf16*)(w + WS_ACT), (bf16*)(w + WS_H), (bf16*)(w + WS_SG), P.in[17] + lq * D, P.in[11] + (size_t)lq * 3 * NUP, P.in[12] + (size_t)lq * NUP};
            pg8::gemm_phase<pg8::EpiUpConv, pg8::StaticOrder, true, true>(lds, g, So, E, cx.wave);
#else
            pg8::EpiUp E{(bf16*)(w + WS_H), (bf16*)(w + WS_SG), P.in[17] + lq * D};
            pg8::gemm_phase<pg8::EpiUp, pg8::StaticOrder, true, true>(lds, g, So, E, cx.wave);
#endif
        } }
        SEAM(pb + 7);
        if (IN(pb + 8)) {
#if !PLE_EARLY
            { OPQ(); unsigned char* w = cx.ws; const bf16* wl = (const bf16*)(w + WS_W + (size_t)lq * WL_BYTES);
              pg8::Gemm g{(const bf16*)(w + WS_PB) + (size_t)lq * S * PLE, wl + WL_P / 2, S, D, PLE}; pg8::StaticOrder So; So.init(S, D, cx.G, cx.bid);
              pg8::EpiPle E{(const bf16*)(w + WS_SG), (float*)(w + WS_Y)};
              pg8::gemm_phase<pg8::EpiPle, pg8::StaticOrder, true, true>(lds, g, So, E, cx.wave); }
#endif
#if CONV_FUSED
            { OPQ(); phase_conv_fixup(P, cx, lq); }
#else
            { REPS(1) { OPQ(); phase_convact(P, cx, lq); } }
#endif
        }
        SEAM(pb + 8);
        if (IN(pb + 9)) { OPQ(); unsigned char* w = cx.ws; const bf16* wl = (const bf16*)(w + WS_W + (size_t)lq * WL_BYTES);
            pg8::Gemm g{(const bf16*)(w + WS_ACT), wl + WL_DOWN / 2, S, D, DFF, 0, 0, 1, 1}; pg8::StaticOrder So; So.init(S, D, cx.G, cx.bid);
#if PLE_EARLY
#if LN_NOXR
#if PROBE_DUP == 31
            { pg8::EpiResidLN<true> E{(float*)(w + WS_Y), (float*)(w + WS_XR + 2 * MiB), (const float*)(w + WS_ST1), P.in[8] + lq * D, P.in[9] + lq * D, (const bf16*)(w + WS_PP), (const bf16*)(w + WS_SG), ALPHA};
              pg8::gemm_phase<pg8::EpiResidLN<true>, pg8::StaticOrder, true, true>(lds, g, So, E, cx.wave); }
#endif
            pg8::EpiResidLN<true> E{(float*)(w + WS_Y), (float*)(w + WS_Y), (const float*)(w + WS_ST1), P.in[8] + lq * D, P.in[9] + lq * D, (const bf16*)(w + WS_PP), (const bf16*)(w + WS_SG), ALPHA};
            pg8::gemm_phase<pg8::EpiResidLN<true>, pg8::StaticOrder, true, true>(lds, g, So, E, cx.wave);
#else
            pg8::EpiDown E{(const float*)(w + WS_XR), (float*)(w + WS_Y), (const bf16*)(w + WS_PP), (const bf16*)(w + WS_SG), ALPHA};
            pg8::gemm_phase<pg8::EpiDown, pg8::StaticOrder, true, true>(lds, g, So, E, cx.wave);
#endif
#else
            pg8::EpiResid<true> E{(const float*)(w + WS_XR), (float*)(w + WS_Y), ALPHA};
            pg8::gemm_phase<pg8::EpiResid<true>, pg8::StaticOrder, true, true>(lds, g, So, E, cx.wave);
#endif
        }
        SEAM(pb + 9);
        if (IN(pb + 10)) { REPS(1) { OPQ(); unsigned char* w = cx.ws; const bool last = (lq == DEPTH - 1);

#if LN_NOXR
            phase_ln(cx, (const float*)(w + WS_Y), P.in[14] + lq * D, P.in[15] + lq * D, last ? P.out : (float*)nullptr, last ? (bf16*)nullptr : (bf16*)(w + WS_XB), last ? (float*)nullptr : (float*)(w + WS_ST2));
#else
            phase_ln(cx, (const float*)(w + WS_Y), P.in[14] + lq * D, P.in[15] + lq * D, last ? P.out : (float*)(w + WS_XR), last ? (bf16*)nullptr : (bf16*)(w + WS_XB), (float*)nullptr);
#endif
        } }
        SEAM(pb + 10);
    }
#undef IN
#undef SEAM
}

extern "C" void kernel_launch(void* const* d_in, const int* in_sizes, int n_in, void* d_out, int out_size, void* d_ws, size_t ws_size, hipStream_t stream) {
    static int grid = 0;
    if (grid == 0) {
        if (n_in != 19 || in_sizes[0] != S * D || out_size != S * D || ws_size < WS_END) { fprintf(stderr, "kernel_launch: unexpected shapes (n_in %d, in0 %d, out %d, ws %zu)\n", n_in, n_in > 0 ? in_sizes[0] : -1, out_size, ws_size); grid = -1; return; }
        int dev = 0, cus = 0, per_cu = 0;
        if (hipGetDevice(&dev) != hipSuccess || hipDeviceGetAttribute(&cus, hipDeviceAttributeMultiprocessorCount, dev) != hipSuccess) { grid = -1; return; }
        if (hipFuncSetAttribute((const void*)fwd, hipFuncAttributeMaxDynamicSharedMemorySize, LDS_BYTES) != hipSuccess) { fprintf(stderr, "kernel_launch: hipFuncSetAttribute failed\n"); grid = -1; return; }
        if (hipOccupancyMaxActiveBlocksPerMultiprocessor(&per_cu, (const void*)fwd, 512, LDS_BYTES) != hipSuccess || per_cu < 1) fprintf(stderr, "kernel_launch: occupancy query says %d\n", per_cu);
        (void)hipGetLastError();
        grid = cus;
    }
    if (grid < 0) return;
    (void)hipMemsetAsync((char*)d_ws + WS_CTL, 0, CTL_ZERO_BYTES, stream);
#ifdef DBG_NANFILL
    (void)hipMemsetAsync((char*)d_ws + CTL_ZERO_BYTES, 0xFF, WS_END - CTL_ZERO_BYTES, stream);
#endif
    Params p{};
    for (int i = 0; i < 19; ++i) p.in[i] = (const float*)d_in[i];
    p.out = (float*)d_out; p.ws = (unsigned char*)d_ws;
    for (int f = 0; f < 128; ++f) p.invf_ret[f] = (float)(1.0 / std::pow(10000.0, (double)((float)f / 127.0f)));
    for (int f = 0; f < 32; ++f) p.invf_att[f] = (float)std::pow(10000.0, -(double)(2 * f) / 64.0);
    for (int h = 0; h < 4; ++h) p.lg2g[h] = (float)std::log2(1.0 - std::exp2(-5.0 - h));
#if MK_ONE_LAUNCH
    p.ph_lo = 0; p.ph_hi = NPHASES;
    hipLaunchKernelGGL(fwd, dim3(grid), dim3(512), LDS_BYTES, stream, p);
#else
#ifdef DBG_DUMP
    for (int ph = 0; ph <= DBG_STOP; ++ph) { p.ph_lo = ph; p.ph_hi = ph + 1; hipLaunchKernelGGL(fwd, dim3(grid), dim3(512), LDS_BYTES, stream, p); }
    p.ph_lo = 1000 + DBG_DUMP; p.ph_hi = p.ph_lo + 1; hipLaunchKernelGGL(fwd, dim3(grid), dim3(512), LDS_BYTES, stream, p);
#else
    for (int ph = 0; ph < NPHASES; ++ph) { p.ph_lo = ph; p.ph_hi = ph + 1; hipLaunchKernelGGL(fwd, dim3(grid), dim3(512), LDS_BYTES, stream, p); }
#endif
#endif
}
```

```cpp
#include <hip/hip_runtime.h>
#include <cstdio>
#include <cstdint>
#include <cmath>
#define MK_ONE_LAUNCH 1
namespace pg8 {
#define PG8_LAS __attribute__((address_space(3)))
typedef unsigned short bf16_t;
typedef short bf16x8 __attribute__((ext_vector_type(8)));
typedef float f32x4 __attribute__((ext_vector_type(4)));
typedef unsigned u32x4 __attribute__((ext_vector_type(4)));
constexpr int BM = 256, BK = 64, HALF = 128, HTB = HALF * BK * 2  , STAGE_BYTES = 8 * HTB, NXCD = 8, WGM = 8;

__host__ __device__ __forceinline__ int lds_byte(int r, int c) { const int st = (r >> 4) * 2 + (c >> 5), rr = r & 15, cc = c & 31, ob = rr * 64 + cc * 2; return st * 1024 + (ob ^ (((ob >> 9) & 1) << 5)); }
__host__ __device__ __forceinline__ void stage_rc(int b, int& R, int& C) { const int st = b / 1024, sb = b % 1024, swz = sb ^ (((sb >> 9) & 1) << 5); R = (st >> 1) * 16 + swz / 64; C = (st & 1) * 32 + (swz % 64) / 2; }
__host__ __device__ __forceinline__ int perm32(int rho) { const int n = rho >> 4, i = rho & 15; return 8 * (i >> 2) + 4 * n + (i & 3); }

struct Unit { int pm, pn; };
struct Gemm { const bf16_t* A; const bf16_t* Bt; int M, N, K; int lda, ldb; int tiledA, tiledB; };

struct StaticOrder {
    int nM, nN, nwg, G, c;
    __host__ __device__ void init(int M, int N, int G_, int c_) { nM = M / BM; nN = N / BM; nwg = nM * nN; G = G_; c = c_; }
    __host__ __device__ bool next(int i, Unit& u) const {
        const long L = (long)i * G + c; if (L >= nwg) return false;
        int wgid = (int)L; { const int q = nwg / NXCD, r = nwg % NXCD, xcd = wgid % NXCD, off = wgid / NXCD; wgid = (xcd < r ? xcd * (q + 1) : r * (q + 1) + (xcd - r) * q) + off; }
        const int nig = WGM * nN, gid = wgid / nig, fm = gid * WGM, gsz = (nM - fm) < WGM ? (nM - fm) : WGM;
        u.pm = fm + ((wgid % nig) % gsz); u.pn = (wgid % nig) / gsz; return true;
    }
    __device__ __forceinline__ void a_ready(const Unit&) const {}
    __device__ __forceinline__ void done(const Unit&) const {}
};

typedef float f32x2c_t __attribute__((ext_vector_type(2))); typedef __bf16 bf16x2c_t __attribute__((ext_vector_type(2)));
__device__ __forceinline__ unsigned cvt_pk_bf16(float lo, float hi) { f32x2c_t v = {lo, hi}; bf16x2c_t b = __builtin_convertvector(v, bf16x2c_t); return __builtin_bit_cast(unsigned, b); }
typedef float f32x2 __attribute__((ext_vector_type(2)));
typedef unsigned u32x2 __attribute__((ext_vector_type(2)));
__host__ __device__ __forceinline__ size_t tiled_off(int row, int col, int K) { return ((size_t)((row >> 8) * (K >> 6) + (col >> 6)) * 256 + (row & 255)) * 64 + (col & 63); }
#ifndef EPI_NT
#define EPI_NT 0
#endif
template <class T> __device__ __forceinline__ void st_out(T* p, const T v) {
#if EPI_NT
    __builtin_nontemporal_store(v, p);
#else
    *p = v;
#endif
}

__device__ __forceinline__ float bf2f(unsigned short b) { return __uint_as_float(((unsigned)b) << 16); }
__device__ __forceinline__ u32x4 pack8(const f32x4 a, const f32x4 b) { u32x4 w; w.x = cvt_pk_bf16(a[0], a[1]); w.y = cvt_pk_bf16(a[2], a[3]); w.z = cvt_pk_bf16(b[0], b[1]); w.w = cvt_pk_bf16(b[2], b[3]); return w; }
__device__ __forceinline__ float sigmoidf_(float x) { return __builtin_amdgcn_rcpf(1.0f + __expf(-x)); }

template <bool LNFIX> struct EpiInProjT {
    static constexpr bool PERM = true, AFTER_DRAIN = false;
    bf16_t *Q, *K, *V, *G, *AQ, *AK, *AV; const float *cosr, *sinr, *cosa, *sina; const float *stats, *c1, *c2;
    __device__ __forceinline__ void operator()(f32x4 (&acc)[2][2][4][2], const Unit& u, int wr, int wc, int fr, int fq) const {
        const int row0 = u.pm * BM + wr * 64 + fr, pn = u.pn, cw = wc * 32 + 8 * fq;
        if (LNFIX) {
            f32x4 c1v[2][2], c2v[2][2];
#pragma unroll
            for (int bj = 0; bj < 2; ++bj)
#pragma unroll
                for (int n = 0; n < 2; ++n) { c1v[bj][n] = *(const f32x4*)(c1 + pn * 256 + bj * HALF + cw + 4 * n); c2v[bj][n] = *(const f32x4*)(c2 + pn * 256 + bj * HALF + cw + 4 * n); }
#pragma unroll
            for (int i = 0; i < 8; ++i) { const f32x2 st = *(const f32x2*)(stats + 2 * (size_t)(row0 + (i >> 2) * HALF + (i & 3) * 16));
#pragma unroll
                for (int bj = 0; bj < 2; ++bj)
#pragma unroll
                    for (int n = 0; n < 2; ++n) acc[i >> 2][bj][i & 3][n] = (acc[i >> 2][bj][i & 3][n] - c1v[bj][n] * st.x) * st.y + c2v[bj][n]; } }
        auto A = [&](int ai, int bj, int m, int n) -> f32x4 { return acc[ai][bj][m][n]; };
        if (pn < 8) {
            bf16_t* O = pn < 4 ? Q : K; const int hcol = (pn & 3) * 256; const float sc = pn < 4 ? 1.0f : 0.0625f;
#pragma unroll
            for (int ai = 0; ai < 2; ++ai)
#pragma unroll
                for (int m = 0; m < 4; ++m) { const int row = row0 + ai * HALF + m * 16;
                    const f32x4 c0 = *(const f32x4*)(cosr + (size_t)row * 128 + cw), c1 = *(const f32x4*)(cosr + (size_t)row * 128 + cw + 4);
                    const f32x4 s0 = *(const f32x4*)(sinr + (size_t)row * 128 + cw), s1 = *(const f32x4*)(sinr + (size_t)row * 128 + cw + 4);
                    const f32x4 a0 = A(ai, 0, m, 0), a1 = A(ai, 0, m, 1), b0 = A(ai, 1, m, 0), b1 = A(ai, 1, m, 1);
                    const f32x4 o10 = (a0 * c0 - b0 * s0) * sc, o11 = (a1 * c1 - b1 * s1) * sc, o20 = (a0 * s0 + b0 * c0) * sc, o21 = (a1 * s1 + b1 * c1) * sc;
                    bf16_t* rowp = O + (size_t)row * 1024 + hcol + cw;
                    st_out((u32x4*)(rowp), (u32x4)(pack8(o10, o11))); st_out((u32x4*)(rowp + HALF), (u32x4)(pack8(o20, o21))); }
        } else if (pn < 16) {
            const bool gate = pn >= 12; bf16_t* O = gate ? G : V; const int hcol = (pn & 3) * 256;
#pragma unroll
            for (int ai = 0; ai < 2; ++ai)
#pragma unroll
                for (int m = 0; m < 4; ++m) { const int row = row0 + ai * HALF + m * 16; bf16_t* rowp = O + (size_t)row * 1024 + hcol + cw;
#pragma unroll
                    for (int bj = 0; bj < 2; ++bj) { f32x4 v0 = A(ai, bj, m, 0), v1 = A(ai, bj, m, 1);
                        if (gate) {
#pragma unroll
                            for (int j = 0; j < 4; ++j) { v0[j] = v0[j] * sigmoidf_(v0[j]); v1[j] = v1[j] * sigmoidf_(v1[j]); } }
                        st_out((u32x4*)(rowp + bj * HALF), (u32x4)(pack8(v0, v1))); } }
        } else if (pn < 20) {
            const int t = pn - 16, i0 = 8 * fq;
#pragma unroll
            for (int ai = 0; ai < 2; ++ai)
#pragma unroll
                for (int m = 0; m < 4; ++m) { const int row = row0 + ai * HALF + m * 16;
                    const f32x4 c0 = *(const f32x4*)(cosa + (size_t)row * 32 + i0), c1 = *(const f32x4*)(cosa + (size_t)row * 32 + i0 + 4);
                    const f32x4 s0 = *(const f32x4*)(sina + (size_t)row * 32 + i0), s1 = *(const f32x4*)(sina + (size_t)row * 32 + i0 + 4);
                    const f32x4 a0 = A(ai, 0, m, 0), a1 = A(ai, 0, m, 1), b0 = A(ai, 1, m, 0), b1 = A(ai, 1, m, 1);
                    const f32x4 o10 = (a0 * c0 - b0 * s0) * 0.125f, o11 = (a1 * c1 - b1 * s1) * 0.125f, o20 = (a0 * s0 + b0 * c0) * 0.125f, o21 = (a1 * s1 + b1 * c1) * 0.125f;
                    bf16_t* rowp = AQ + (size_t)row * 1024 + t * 256 + wc * 64 + i0;
                    st_out((u32x4*)(rowp), (u32x4)(pack8(o10, o11))); st_out((u32x4*)(rowp + 32), (u32x4)(pack8(o20, o21))); }
        } else {
            const int i0 = 8 * fq;
            if (wc < 2) {
#pragma unroll
                for (int ai = 0; ai < 2; ++ai)
#pragma unroll
                    for (int m = 0; m < 4; ++m) { const int row = row0 + ai * HALF + m * 16;
                        const f32x4 c0 = *(const f32x4*)(cosa + (size_t)row * 32 + i0), c1 = *(const f32x4*)(cosa + (size_t)row * 32 + i0 + 4);
                        const f32x4 s0 = *(const f32x4*)(sina + (size_t)row * 32 + i0), s1 = *(const f32x4*)(sina + (size_t)row * 32 + i0 + 4);
                        const f32x4 a0 = A(ai, 0, m, 0), a1 = A(ai, 0, m, 1), b0 = A(ai, 1, m, 0), b1 = A(ai, 1, m, 1);
                        const f32x4 o10 = a0 * c0 - b0 * s0, o11 = a1 * c1 - b1 * s1, o20 = a0 * s0 + b0 * c0, o21 = a1 * s1 + b1 * c1;
                        bf16_t* rowp = AK + (size_t)row * 128 + wc * 64 + i0;
                        st_out((u32x4*)(rowp), (u32x4)(pack8(o10, o11))); st_out((u32x4*)(rowp + 32), (u32x4)(pack8(o20, o21))); }
            } else {
#pragma unroll
                for (int ai = 0; ai < 2; ++ai)
#pragma unroll
                    for (int m = 0; m < 4; ++m) { const int row = row0 + ai * HALF + m * 16; bf16_t* rowp = AV + (size_t)row * 128 + (wc - 2) * 32 + i0;
                        st_out((u32x4*)(rowp), (u32x4)(pack8(A(ai, 0, m, 0), A(ai, 0, m, 1)))); st_out((u32x4*)(rowp + 64), (u32x4)(pack8(A(ai, 1, m, 0), A(ai, 1, m, 1)))); }
            }
        }
    }
};
typedef EpiInProjT<false> EpiInProj;
template <bool ADD> struct EpiResid {
    static constexpr bool PERM = false, AFTER_DRAIN = false;
    const float* base; float* Y; float alpha;
    __device__ __forceinline__ void operator()(const f32x4 (&acc)[2][2][4][2], const Unit& u, int wr, int wc, int fr, int fq) const {
        const int row0 = u.pm * BM + wr * 64 + fr, col0 = u.pn * BM + wc * 32 + 4 * fq;
#pragma unroll
        for (int ai = 0; ai < 2; ++ai)
#pragma unroll
            for (int m = 0; m < 4; ++m) { const size_t off = (size_t)(row0 + ai * HALF + m * 16) * 2048 + col0;
#pragma unroll
                for (int bj = 0; bj < 2; ++bj)
#pragma unroll
                    for (int n = 0; n < 2; ++n) { const size_t o = off + bj * HALF + n * 16; f32x4 v = acc[ai][bj][m][n] + *(const f32x4*)(base + o) * alpha;
                        if (ADD) v = v + *(const f32x4*)(Y + o); st_out((f32x4*)(Y + o), (f32x4)(v)); } }
    }
};
struct EpiUp {
    static constexpr bool PERM = true, AFTER_DRAIN = false;
    bf16_t* H; bf16_t* SG; const float* bgate;
    __device__ __forceinline__ void operator()(const f32x4 (&acc)[2][2][4][2], const Unit& u, int wr, int wc, int fr, int fq) const {
        const int row0 = u.pm * BM + wr * 64 + fr, cw = wc * 32 + 8 * fq;
        if (u.pn < 44) {
#pragma unroll
            for (int ai = 0; ai < 2; ++ai)
#pragma unroll
                for (int m = 0; m < 4; ++m) { bf16_t* rowp = H + (size_t)(row0 + ai * HALF + m * 16) * 11264 + u.pn * 256 + cw;
#pragma unroll
                    for (int bj = 0; bj < 2; ++bj) st_out((u32x4*)(rowp + bj * HALF), (u32x4)(pack8(acc[ai][bj][m][0], acc[ai][bj][m][1]))); }
        } else {
            const int colg = (u.pn - 44) * 256 + cw;
            f32x4 bv[2][2];
#pragma unroll
            for (int bj = 0; bj < 2; ++bj)
#pragma unroll
                for (int n = 0; n < 2; ++n) bv[bj][n] = *(const f32x4*)(bgate + colg + bj * HALF + 4 * n);
#pragma unroll
            for (int ai = 0; ai < 2; ++ai)
#pragma unroll
                for (int m = 0; m < 4; ++m) { bf16_t* rowp = SG + (size_t)(row0 + ai * HALF + m * 16) * 2048 + colg;
#pragma unroll
                    for (int bj = 0; bj < 2; ++bj) { f32x4 v0 = acc[ai][bj][m][0] + bv[bj][0], v1 = acc[ai][bj][m][1] + bv[bj][1];
#pragma unroll
                        for (int j = 0; j < 4; ++j) { v0[j] = sigmoidf_(v0[j]); v1[j] = sigmoidf_(v1[j]); }
                        st_out((u32x4*)(rowp + bj * HALF), (u32x4)(pack8(v0, v1))); } }
        }
    }
};

__device__ __forceinline__ float ror1f(float x) { return __builtin_bit_cast(float, __builtin_amdgcn_update_dpp(0, __builtin_bit_cast(int, x), 0x121, 0xf, 0xf, false)); }
__device__ __forceinline__ float ror2f(float x) { return __builtin_bit_cast(float, __builtin_amdgcn_update_dpp(0, __builtin_bit_cast(int, x), 0x122, 0xf, 0xf, false)); }
template <bool LNFIX> struct EpiUpConvT {
    static constexpr bool PERM = true, AFTER_DRAIN = false;
    bf16_t* ACT; bf16_t* HALO; bf16_t* SG; const float* bgate; const float* cw; const float* cb; const float *stats, *c1, *c2;
    __device__ __forceinline__ void operator()(f32x4 (&acc)[2][2][4][2], const Unit& u, int wr, int wc, int fr, int fq) const {
        int cwp = wc * 32 + 8 * fq; asm volatile("" : "+v"(cwp));
        const int row0 = u.pm * BM + wr * 64 + fr;
        if (LNFIX) {
            const int cwq = cwp;
            f32x4 c1v[2][2], c2v[2][2];
#pragma unroll
            for (int bj = 0; bj < 2; ++bj)
#pragma unroll
                for (int n = 0; n < 2; ++n) { c1v[bj][n] = *(const f32x4*)(c1 + u.pn * 256 + bj * HALF + cwq + 4 * n); c2v[bj][n] = *(const f32x4*)(c2 + u.pn * 256 + bj * HALF + cwq + 4 * n); }
#pragma unroll
            for (int i = 0; i < 8; ++i) { const f32x2 st = *(const f32x2*)(stats + 2 * (size_t)(row0 + (i >> 2) * HALF + (i & 3) * 16));
#pragma unroll
                for (int bj = 0; bj < 2; ++bj)
#pragma unroll
                    for (int n = 0; n < 2; ++n) acc[i >> 2][bj][i & 3][n] = (acc[i >> 2][bj][i & 3][n] - c1v[bj][n] * st.x) * st.y + c2v[bj][n]; } }
        auto A = [&](int ai, int bj, int m, int n) -> f32x4 { return acc[ai][bj][m][n]; };
        if (u.pn < 44) {
            f32x4 wg0_[2], wg1_[2], wg2_[2], bg_[2], wu0_[2], wu1_[2], wu2_[2], bu_[2];
#pragma unroll
            for (int n = 0; n < 2; ++n) { const int chg = 128 * u.pn + cwp + 4 * n, chu = 5632 + chg;
                wg0_[n] = *(const f32x4*)(cw + chg); wg1_[n] = *(const f32x4*)(cw + 11264 + chg); wg2_[n] = *(const f32x4*)(cw + 2 * 11264 + chg); bg_[n] = *(const f32x4*)(cb + chg);
                wu0_[n] = *(const f32x4*)(cw + chu); wu1_[n] = *(const f32x4*)(cw + 11264 + chu); wu2_[n] = *(const f32x4*)(cw + 2 * 11264 + chu); bu_[n] = *(const f32x4*)(cb + chu); }
#pragma unroll
            for (int ai = 0; ai < 2; ++ai) {
                const int span = u.pm * 4 + ai * 2 + wr;
#pragma unroll
                for (int m = 0; m < 4; ++m) {
                    const int row = row0 + ai * HALF + m * 16;
                    u32x4 w, rg, ru;
#pragma unroll
                    for (int n = 0; n < 2; ++n) {
                        const f32x4 wg0 = wg0_[n], wg1 = wg1_[n], wg2 = wg2_[n], bg = bg_[n], wu0 = wu0_[n], wu1 = wu1_[n], wu2 = wu2_[n], bu = bu_[n];
                        const f32x4 cg = A(ai, 0, m, n), cu = A(ai, 1, m, n);
                        const f32x4 pg = A(ai, 0, m ? m - 1 : 0, n), pu = A(ai, 1, m ? m - 1 : 0, n);
                        f32x4 o;
#pragma unroll
                        for (int j = 0; j < 4; ++j) {
                            const float g1 = ror1f(fr == 15 ? pg[j] : cg[j]), g2 = ror2f(fr >= 14 ? pg[j] : cg[j]);
                            const float u1 = ror1f(fr == 15 ? pu[j] : cu[j]), u2 = ror2f(fr >= 14 ? pu[j] : cu[j]);
                            const float ga = bg[j] + wg0[j] * g2 + wg1[j] * g1 + wg2[j] * cg[j], ua = bu[j] + wu0[j] * u2 + wu1[j] * u1 + wu2[j] * cu[j];
                            o[j] = ga * sigmoidf_(ga) * ua; }
                        if (n == 0) { w.x = cvt_pk_bf16(o[0], o[1]); w.y = cvt_pk_bf16(o[2], o[3]); rg.x = cvt_pk_bf16(cg[0], cg[1]); rg.y = cvt_pk_bf16(cg[2], cg[3]); ru.x = cvt_pk_bf16(cu[0], cu[1]); ru.y = cvt_pk_bf16(cu[2], cu[3]); }
                        else { w.z = cvt_pk_bf16(o[0], o[1]); w.w = cvt_pk_bf16(o[2], o[3]); rg.z = cvt_pk_bf16(cg[0], cg[1]); rg.w = cvt_pk_bf16(cg[2], cg[3]); ru.z = cvt_pk_bf16(cu[0], cu[1]); ru.w = cvt_pk_bf16(cu[2], cu[3]); }
                    }
                    if (m > 0 || fr >= 2) st_out((u32x4*)(ACT + tiled_off(row, 128 * u.pn + cwp, 5632)), (u32x4)(w));
                    if ((m == 0 && fr < 2) || (m == 3 && fr >= 14)) { int frq = fr; asm volatile("" : "+v"(frq)); const int slot = (m == 0) ? frq : frq - 12;
                        bf16_t* hp = HALO + ((size_t)(span * 4 + slot)) * 11264 + 256 * u.pn + cwp;
                        st_out((u32x4*)(hp), (u32x4)(rg)); st_out((u32x4*)(hp + HALF), (u32x4)(ru)); }
                }
            }
        } else {
            const int colg = (u.pn - 44) * 256 + cwp;
            f32x4 bv[2][2];
#pragma unroll
            for (int bj = 0; bj < 2; ++bj)
#pragma unroll
                for (int n = 0; n < 2; ++n) bv[bj][n] = *(const f32x4*)(bgate + colg + bj * HALF + 4 * n);
#pragma unroll
            for (int ai = 0; ai < 2; ++ai)
#pragma unroll
                for (int m = 0; m < 4; ++m) { bf16_t* rowp = SG + (size_t)(row0 + ai * HALF + m * 16) * 2048 + colg;
#pragma unroll
                    for (int bj = 0; bj < 2; ++bj) { f32x4 v0 = A(ai, bj, m, 0) + bv[bj][0], v1 = A(ai, bj, m, 1) + bv[bj][1];
#pragma unroll
                        for (int j = 0; j < 4; ++j) { v0[j] = sigmoidf_(v0[j]); v1[j] = sigmoidf_(v1[j]); }
                        st_out((u32x4*)(rowp + bj * HALF), (u32x4)(pack8(v0, v1))); } }
        }
    }
};

typedef EpiUpConvT<false> EpiUpConv;
struct EpiPlain {
    static constexpr bool PERM = true, AFTER_DRAIN = false;
    bf16_t* O;
    __device__ __forceinline__ void operator()(const f32x4 (&acc)[2][2][4][2], const Unit& u, int wr, int wc, int fr, int fq) const {
        const int row0 = u.pm * BM + wr * 64 + fr, cwp = u.pn * BM + wc * 32 + 8 * fq;
#pragma unroll
        for (int ai = 0; ai < 2; ++ai)
#pragma unroll
            for (int m = 0; m < 4; ++m) { bf16_t* rowp = O + (size_t)(row0 + ai * HALF + m * 16) * 2048 + cwp;
#pragma unroll
                for (int bj = 0; bj < 2; ++bj) st_out((u32x4*)(rowp + bj * HALF), (u32x4)(pack8(acc[ai][bj][m][0], acc[ai][bj][m][1]))); }
    }
};
struct EpiDown {
    static constexpr bool PERM = false, AFTER_DRAIN = false;
    const float* base; float* Y; const bf16_t* PP; const bf16_t* SG; float alpha;
    __device__ __forceinline__ void operator()(const f32x4 (&acc)[2][2][4][2], const Unit& u, int wr, int wc, int fr, int fq) const {
        const int row0 = u.pm * BM + wr * 64 + fr, col0 = u.pn * BM + wc * 32 + 4 * fq;
#pragma unroll
        for (int ai = 0; ai < 2; ++ai)
#pragma unroll
            for (int m = 0; m < 4; ++m) { const size_t off = (size_t)(row0 + ai * HALF + m * 16) * 2048 + col0;
#pragma unroll
                for (int bj = 0; bj < 2; ++bj)
#pragma unroll
                    for (int n = 0; n < 2; ++n) { const size_t o = off + bj * HALF + n * 16; const u32x2 pp = *(const u32x2*)(PP + o), sg = *(const u32x2*)(SG + o);
                        f32x4 pl; pl[0] = __uint_as_float(pp.x << 16) * __uint_as_float(sg.x << 16); pl[1] = __uint_as_float(pp.x & 0xffff0000u) * __uint_as_float(sg.x & 0xffff0000u);
                        pl[2] = __uint_as_float(pp.y << 16) * __uint_as_float(sg.y << 16); pl[3] = __uint_as_float(pp.y & 0xffff0000u) * __uint_as_float(sg.y & 0xffff0000u);
                        st_out((f32x4*)(Y + o), (f32x4)(acc[ai][bj][m][n] + *(const f32x4*)(base + o) * alpha + pl)); } }
    }
};

template <bool PLE_> struct EpiResidLN {
    static constexpr bool PERM = false, AFTER_DRAIN = false;
    float* Y; float* Yout; const float* stats; const float* g; const float* b; const bf16_t* PP; const bf16_t* SG; float alpha;
    __device__ __forceinline__ void operator()(const f32x4 (&acc)[2][2][4][2], const Unit& u, int wr, int wc, int fr, int fq) const {
        const int row0 = u.pm * BM + wr * 64 + fr, col0 = u.pn * BM + wc * 32 + 4 * fq;
        f32x4 g4[2][2], b4[2][2];
#pragma unroll
        for (int bj = 0; bj < 2; ++bj)
#pragma unroll
            for (int n = 0; n < 2; ++n) { g4[bj][n] = *(const f32x4*)(g + col0 + bj * HALF + n * 16) * alpha; b4[bj][n] = *(const f32x4*)(b + col0 + bj * HALF + n * 16) * alpha; }
        f32x4 cy[2][2], ny[2][2]; f32x2 cst, nst;
        { const size_t off = (size_t)row0 * 2048 + col0; cst = *(const f32x2*)(stats + 2 * (size_t)row0);
#pragma unroll
          for (int bj = 0; bj < 2; ++bj)
#pragma unroll
              for (int n = 0; n < 2; ++n) cy[bj][n] = *(const f32x4*)(Y + off + bj * HALF + n * 16); }
#pragma unroll
        for (int i = 0; i < 8; ++i) { const int ai = i >> 2, m = i & 3; const size_t off = (size_t)(row0 + ai * HALF + m * 16) * 2048 + col0;
            if (i < 7) { const int rn = row0 + ((i + 1) >> 2) * HALF + ((i + 1) & 3) * 16; const size_t offn = (size_t)rn * 2048 + col0; nst = *(const f32x2*)(stats + 2 * (size_t)rn);
#pragma unroll
                for (int bj = 0; bj < 2; ++bj)
#pragma unroll
                    for (int n = 0; n < 2; ++n) ny[bj][n] = *(const f32x4*)(Y + offn + bj * HALF + n * 16); }
#pragma unroll
            for (int bj = 0; bj < 2; ++bj)
#pragma unroll
                for (int n = 0; n < 2; ++n) { const size_t o = off + bj * HALF + n * 16;
                    f32x4 v = acc[ai][bj][m][n] + (cy[bj][n] - cst.x) * cst.y * g4[bj][n] + b4[bj][n];
                    if (PLE_) { const u32x2 pp = *(const u32x2*)(PP + o), sg = *(const u32x2*)(SG + o);
                        v[0] += __uint_as_float(pp.x << 16) * __uint_as_float(sg.x << 16); v[1] += __uint_as_float(pp.x & 0xffff0000u) * __uint_as_float(sg.x & 0xffff0000u);
                        v[2] += __uint_as_float(pp.y << 16) * __uint_as_float(sg.y << 16); v[3] += __uint_as_float(pp.y & 0xffff0000u) * __uint_as_float(sg.y & 0xffff0000u); }
                    st_out((f32x4*)(Yout + o), (f32x4)(v)); }
#pragma unroll
            for (int bj = 0; bj < 2; ++bj)
#pragma unroll
                for (int n = 0; n < 2; ++n) cy[bj][n] = ny[bj][n];
            cst = nst; }
    }
};

template <bool LNBASE, bool PLE_, bool STATS> struct EpiRes2 {
    static constexpr bool PERM = true, AFTER_DRAIN = false;
    const float* base; float* Y; bf16_t* YB; float* pstat; const float* stats; const float* g; const float* b; const bf16_t* PP; const bf16_t* SG; float alpha;
    __device__ __forceinline__ void operator()(const f32x4 (&acc)[2][2][4][2], const Unit& u, int wr, int wc, int fr, int fq) const {
        const int row0 = u.pm * BM + wr * 64 + fr, col0 = u.pn * BM + wc * 32 + 8 * fq, lane = fq * 16 + fr;
        const float* src = LNBASE ? (const float*)Y : base;
        f32x4 g4[2][2], b4[2][2];
        if (LNBASE) {
#pragma unroll
            for (int bj = 0; bj < 2; ++bj)
#pragma unroll
                for (int n = 0; n < 2; ++n) { g4[bj][n] = *(const f32x4*)(g + col0 + bj * HALF + 4 * n) * alpha; b4[bj][n] = *(const f32x4*)(b + col0 + bj * HALF + 4 * n) * alpha; } }
        f32x4 cy[2][2], ny[2][2]; f32x2 cst = (f32x2){0.f, 1.f}, nst = (f32x2){0.f, 1.f};
        { const size_t off = (size_t)row0 * 2048 + col0; if (LNBASE) cst = *(const f32x2*)(stats + 2 * (size_t)row0);
#pragma unroll
          for (int bj = 0; bj < 2; ++bj)
#pragma unroll
              for (int n = 0; n < 2; ++n) cy[bj][n] = *(const f32x4*)(src + off + bj * HALF + 4 * n); }
#pragma unroll
        for (int i = 0; i < 8; ++i) { const int ai = i >> 2, m = i & 3, row = row0 + ai * HALF + m * 16; const size_t off = (size_t)row * 2048 + col0;
            if (i < 7) { const int rn = row0 + ((i + 1) >> 2) * HALF + ((i + 1) & 3) * 16; const size_t offn = (size_t)rn * 2048 + col0; if (LNBASE) nst = *(const f32x2*)(stats + 2 * (size_t)rn);
#pragma unroll
                for (int bj = 0; bj < 2; ++bj)
#pragma unroll
                    for (int n = 0; n < 2; ++n) ny[bj][n] = *(const f32x4*)(src + offn + bj * HALF + 4 * n); }
            float s1 = 0.f, s2 = 0.f;
#pragma unroll
            for (int bj = 0; bj < 2; ++bj) { f32x4 v[2];
#pragma unroll
                for (int n = 0; n < 2; ++n) v[n] = LNBASE ? acc[ai][bj][m][n] + (cy[bj][n] - cst.x) * cst.y * g4[bj][n] + b4[bj][n] : acc[ai][bj][m][n] + cy[bj][n] * alpha;
                if (PLE_) { const u32x4 pp = *(const u32x4*)(PP + off + bj * HALF), sg = *(const u32x4*)(SG + off + bj * HALF);
                    v[0][0] += __uint_as_float(pp.x << 16) * __uint_as_float(sg.x << 16); v[0][1] += __uint_as_float(pp.x & 0xffff0000u) * __uint_as_float(sg.x & 0xffff0000u);
                    v[0][2] += __uint_as_float(pp.y << 16) * __uint_as_float(sg.y << 16); v[0][3] += __uint_as_float(pp.y & 0xffff0000u) * __uint_as_float(sg.y & 0xffff0000u);
                    v[1][0] += __uint_as_float(pp.z << 16) * __uint_as_float(sg.z << 16); v[1][1] += __uint_as_float(pp.z & 0xffff0000u) * __uint_as_float(sg.z & 0xffff0000u);
                    v[1][2] += __uint_as_float(pp.w << 16) * __uint_as_float(sg.w << 16); v[1][3] += __uint_as_float(pp.w & 0xffff0000u) * __uint_as_float(sg.w & 0xffff0000u); }
                st_out((f32x4*)(Y + off + bj * HALF), (f32x4)(v[0])); st_out((f32x4*)(Y + off + bj * HALF + 4), (f32x4)(v[1]));
                if (STATS) { st_out((u32x4*)(YB + off + bj * HALF), (u32x4)(pack8(v[0], v[1])));
#pragma unroll
                    for (int n = 0; n < 2; ++n) { s1 += (v[n][0] + v[n][1]) + (v[n][2] + v[n][3]); s2 += (v[n][0] * v[n][0] + v[n][1] * v[n][1]) + (v[n][2] * v[n][2] + v[n][3] * v[n][3]); } } }
            if (STATS) {
                s1 += __builtin_bit_cast(float, __builtin_amdgcn_ds_bpermute((lane ^ 16) << 2, __builtin_bit_cast(int, s1))); s2 += __builtin_bit_cast(float, __builtin_amdgcn_ds_bpermute((lane ^ 16) << 2, __builtin_bit_cast(int, s2)));
                s1 += __builtin_bit_cast(float, __builtin_amdgcn_ds_bpermute((lane ^ 32) << 2, __builtin_bit_cast(int, s1))); s2 += __builtin_bit_cast(float, __builtin_amdgcn_ds_bpermute((lane ^ 32) << 2, __builtin_bit_cast(int, s2)));
                if (fq == 0) *(f32x2*)(pstat + ((size_t)row * 32 + u.pn * 4 + wc) * 2) = (f32x2){s1, s2}; }
#pragma unroll
            for (int bj = 0; bj < 2; ++bj)
#pragma unroll
                for (int n = 0; n < 2; ++n) cy[bj][n] = ny[bj][n];
            cst = nst; }
    }
};

typedef _Float16 h16x8 __attribute__((ext_vector_type(8)));
typedef float f32x8 __attribute__((ext_vector_type(8)));
template <bool LNBASE, bool PLE_> struct EpiRes3 {
    static constexpr bool PERM = true, AFTER_DRAIN = false;
    const float* base; float* Y; bf16_t* YB; _Float16* YH; float* pstat; const float* stats; const float* g; const float* b; const bf16_t* PP; const bf16_t* SG; float alpha;
    __device__ __forceinline__ void operator()(const f32x4 (&acc)[2][2][4][2], const Unit& u, int wr, int wc, int fr, int fq) const {
        const int row0 = u.pm * BM + wr * 64 + fr, col0 = u.pn * BM + wc * 32 + 8 * fq, lane = fq * 16 + fr;
        f32x4 g4[2][2], b4[2][2];
        if (LNBASE) {
#pragma unroll
            for (int bj = 0; bj < 2; ++bj)
#pragma unroll
                for (int n = 0; n < 2; ++n) { g4[bj][n] = *(const f32x4*)(g + col0 + bj * HALF + 4 * n) * alpha; b4[bj][n] = *(const f32x4*)(b + col0 + bj * HALF + 4 * n) * alpha; } }
        u32x4 cyb[2], nyb[2]; f32x4 cyf[2][2], nyf[2][2]; f32x2 cst = (f32x2){0.f, 1.f}, nst = (f32x2){0.f, 1.f};
        { const size_t off = (size_t)row0 * 2048 + col0;
          if (LNBASE) { cst = *(const f32x2*)(stats + 2 * (size_t)row0); cyb[0] = *(const u32x4*)(YH + off); cyb[1] = *(const u32x4*)(YH + off + HALF); }
          else {
#pragma unroll
              for (int bj = 0; bj < 2; ++bj)
#pragma unroll
                  for (int n = 0; n < 2; ++n) cyf[bj][n] = *(const f32x4*)(base + off + bj * HALF + 4 * n); } }
#pragma unroll
        for (int i = 0; i < 8; ++i) { const int ai = i >> 2, m = i & 3, row = row0 + ai * HALF + m * 16; const size_t off = (size_t)row * 2048 + col0;
            if (i < 7) { const int rn = row0 + ((i + 1) >> 2) * HALF + ((i + 1) & 3) * 16; const size_t offn = (size_t)rn * 2048 + col0;
                if (LNBASE) { nst = *(const f32x2*)(stats + 2 * (size_t)rn); nyb[0] = *(const u32x4*)(YH + offn); nyb[1] = *(const u32x4*)(YH + offn + HALF); }
                else {
#pragma unroll
                    for (int bj = 0; bj < 2; ++bj)
#pragma unroll
                        for (int n = 0; n < 2; ++n) nyf[bj][n] = *(const f32x4*)(base + offn + bj * HALF + 4 * n); } }
            float s1 = 0.f, s2 = 0.f;
#pragma unroll
            for (int bj = 0; bj < 2; ++bj) { f32x4 v[2];
                if (LNBASE) { const f32x8 yf = __builtin_convertvector(__builtin_bit_cast(h16x8, cyb[bj]), f32x8);
                    const f32x4 y0 = (f32x4){yf[0], yf[1], yf[2], yf[3]}, y1 = (f32x4){yf[4], yf[5], yf[6], yf[7]};
                    v[0] = acc[ai][bj][m][0] + (y0 - cst.x) * cst.y * g4[bj][0] + b4[bj][0]; v[1] = acc[ai][bj][m][1] + (y1 - cst.x) * cst.y * g4[bj][1] + b4[bj][1]; }
                else { v[0] = acc[ai][bj][m][0] + cyf[bj][0] * alpha; v[1] = acc[ai][bj][m][1] + cyf[bj][1] * alpha; }
                if (PLE_) { const u32x4 pp = *(const u32x4*)(PP + off + bj * HALF), sg = *(const u32x4*)(SG + off + bj * HALF);
                    v[0][0] += __uint_as_float(pp.x << 16) * __uint_as_float(sg.x << 16); v[0][1] += __uint_as_float(pp.x & 0xffff0000u) * __uint_as_float(sg.x & 0xffff0000u);
                    v[0][2] += __uint_as_float(pp.y << 16) * __uint_as_float(sg.y << 16); v[0][3] += __uint_as_float(pp.y & 0xffff0000u) * __uint_as_float(sg.y & 0xffff0000u);
                    v[1][0] += __uint_as_float(pp.z << 16) * __uint_as_float(sg.z << 16); v[1][1] += __uint_as_float(pp.z & 0xffff0000u) * __uint_as_float(sg.z & 0xffff0000u);
                    v[1][2] += __uint_as_float(pp.w << 16) * __uint_as_float(sg.w << 16); v[1][3] += __uint_as_float(pp.w & 0xffff0000u) * __uint_as_float(sg.w & 0xffff0000u); }
                if (Y) { st_out((f32x4*)(Y + off + bj * HALF), (f32x4)(v[0])); st_out((f32x4*)(Y + off + bj * HALF + 4), (f32x4)(v[1])); }
                const u32x4 pk = pack8(v[0], v[1]);
                st_out((u32x4*)(YB + off + bj * HALF), (u32x4)(pk));
                { const f32x8 vf = (f32x8){v[0][0], v[0][1], v[0][2], v[0][3], v[1][0], v[1][1], v[1][2], v[1][3]};
                  st_out((u32x4*)(YH + off + bj * HALF), __builtin_bit_cast(u32x4, __builtin_convertvector(vf, h16x8))); }
                const f32x4 r0 = (f32x4){__uint_as_float(pk.x << 16), __uint_as_float(pk.x & 0xffff0000u), __uint_as_float(pk.y << 16), __uint_as_float(pk.y & 0xffff0000u)};
                const f32x4 r1 = (f32x4){__uint_as_float(pk.z << 16), __uint_as_float(pk.z & 0xffff0000u), __uint_as_float(pk.w << 16), __uint_as_float(pk.w & 0xffff0000u)};
                s1 += ((r0[0] + r0[1]) + (r0[2] + r0[3])) + ((r1[0] + r1[1]) + (r1[2] + r1[3]));
                s2 += ((r0[0] * r0[0] + r0[1] * r0[1]) + (r0[2] * r0[2] + r0[3] * r0[3])) + ((r1[0] * r1[0] + r1[1] * r1[1]) + (r1[2] * r1[2] + r1[3] * r1[3])); }
            s1 += __builtin_bit_cast(float, __builtin_amdgcn_ds_bpermute((lane ^ 16) << 2, __builtin_bit_cast(int, s1))); s2 += __builtin_bit_cast(float, __builtin_amdgcn_ds_bpermute((lane ^ 16) << 2, __builtin_bit_cast(int, s2)));
            s1 += __builtin_bit_cast(float, __builtin_amdgcn_ds_bpermute((lane ^ 32) << 2, __builtin_bit_cast(int, s1))); s2 += __builtin_bit_cast(float, __builtin_amdgcn_ds_bpermute((lane ^ 32) << 2, __builtin_bit_cast(int, s2)));
            if (fq == 0) *(f32x2*)(pstat + ((size_t)row * 32 + u.pn * 4 + wc) * 2) = (f32x2){s1, s2};
            cyb[0] = nyb[0]; cyb[1] = nyb[1];
#pragma unroll
            for (int bj = 0; bj < 2; ++bj)
#pragma unroll
                for (int n = 0; n < 2; ++n) cyf[bj][n] = nyf[bj][n];
            cst = nst; }
    }
};
struct EpiPle {
    static constexpr bool PERM = false, AFTER_DRAIN = false;
    const bf16_t* SG; float* Y;
    __device__ __forceinline__ void operator()(const f32x4 (&acc)[2][2][4][2], const Unit& u, int wr, int wc, int fr, int fq) const {
        const int row0 = u.pm * BM + wr * 64 + fr, col0 = u.pn * BM + wc * 32 + 4 * fq;
#pragma unroll
        for (int ai = 0; ai < 2; ++ai)
#pragma unroll
            for (int m = 0; m < 4; ++m) { const size_t off = (size_t)(row0 + ai * HALF + m * 16) * 2048 + col0;
#pragma unroll
                for (int bj = 0; bj < 2; ++bj)
#pragma unroll
                    for (int n = 0; n < 2; ++n) { const size_t o = off + bj * HALF + n * 16; const u32x2 sg = *(const u32x2*)(SG + o);
                        f32x4 g; g[0] = __uint_as_float(sg.x << 16); g[1] = __uint_as_float(sg.x & 0xffff0000u); g[2] = __uint_as_float(sg.y << 16); g[3] = __uint_as_float(sg.y & 0xffff0000u);
                        st_out((f32x4*)(Y + o), (f32x4)(acc[ai][bj][m][n] * g)); } }
    }
};
template <class Epi, class Sched, bool ALIGN_EPI = false, bool SP2 = false>
__device__ __forceinline__ void gemm_phase(PG8_LAS unsigned char* lds, const Gemm g, const Sched& S, const Epi& E, const int wid_in) {
    int lane_; asm volatile("v_mbcnt_lo_u32_b32 %0, -1, 0\n\tv_mbcnt_hi_u32_b32 %0, -1, %0" : "=v"(lane_)); const int wid = wid_in, lane = lane_, tid = wid * 64 + lane, wr = wid >> 2, wc = wid & 3, fr = lane & 15, fq = lane >> 4;
    const int K = g.K, nt = K / BK, lda = g.tiledA ? BK : (g.lda ? g.lda : K), ldb = g.tiledB ? BK : (g.ldb ? g.ldb : K);
    unsigned voffA[2], voffB[2];
#pragma unroll
    for (int i = 0; i < 2; ++i) { int R, C; stage_rc(tid * 16 + i * 8192, R, C); const int Rb = Epi::PERM ? ((R & ~31) + perm32(R & 31)) : R;
        voffA[i] = (unsigned)(R * lda + C) * 2u; voffB[i] = (unsigned)(Rb * ldb + C) * 2u; }
    const size_t kstepA = g.tiledA ? (size_t)BM * BK * 2 : (size_t)(BK * 2), kstepB = g.tiledB ? (size_t)BM * BK * 2 : (size_t)(BK * 2);
    const size_t hstepA = (size_t)HALF * lda * 2, hstepB = (size_t)HALF * ldb * 2;
    const size_t tstepA = g.tiledA ? (size_t)BM * K * 2 : 2 * hstepA, tstepB = g.tiledB ? (size_t)BM * K * 2 : 2 * hstepB;
    const unsigned ldsw = (unsigned)wid * 1024u;
    const int aoff = lds_byte(wr * 64 + fr, fq * 8), boff = lds_byte(wc * 32 + fr, fq * 8);
#define PG8_SA(b, h) (((b) * 2 + (h)) * HTB)
#define PG8_SB(b, h) ((4 + (b) * 2 + (h)) * HTB)
#define PG8_STAGE(bufoff, gbase, voff) do { _Pragma("unroll") for (int _i = 0; _i < 2; ++_i) \
        __builtin_amdgcn_global_load_lds((const unsigned*)((const char*)(gbase) + (voff)[_i]), (PG8_LAS unsigned*)(lds + (bufoff) + ldsw + _i * 8192), 16, 0, 0); } while (0)
#define PG8_LDA(dst, b, h) do { _Pragma("unroll") for (int m = 0; m < 4; ++m) _Pragma("unroll") for (int k = 0; k < 2; ++k) dst[m][k] = *(const PG8_LAS bf16x8*)(lds + PG8_SA(b, h) + aoff + m * 2048 + k * 1024); } while (0)
#define PG8_LDB(dst, b, h) do { _Pragma("unroll") for (int n = 0; n < 2; ++n) _Pragma("unroll") for (int k = 0; k < 2; ++k) dst[n][k] = *(const PG8_LAS bf16x8*)(lds + PG8_SB(b, h) + boff + n * 2048 + k * 1024); } while (0)
#define PG8_MMA(ai, bj, At, Bt) do { __builtin_amdgcn_s_setprio(1); _Pragma("unroll") for (int m = 0; m < 4; ++m) _Pragma("unroll") for (int n = 0; n < 2; ++n) _Pragma("unroll") for (int k = 0; k < 2; ++k) \
        acc[ai][bj][m][n] = __builtin_amdgcn_mfma_f32_16x16x32_bf16(Bt[n][k], At[m][k], acc[ai][bj][m][n], 0, 0, 0); __builtin_amdgcn_s_setprio(0); } while (0)
#define PG8_WAIT_V(n) asm volatile("s_waitcnt vmcnt(" #n ")" ::: "memory")
#define PG8_WAIT_L(n) asm volatile("s_waitcnt lgkmcnt(" #n ")" ::: "memory")
#define PG8_BAR __builtin_amdgcn_s_barrier()
#define PG8_SCHED __builtin_amdgcn_sched_barrier(0)
    Unit cur, nxt; int ui = 0;
    if (!S.next(0, cur)) return;
    f32x4 acc[2][2][4][2];
#pragma unroll
    for (int a = 0; a < 2; ++a)
#pragma unroll
        for (int b = 0; b < 2; ++b)
#pragma unroll
            for (int m = 0; m < 4; ++m)
#pragma unroll
                for (int n = 0; n < 2; ++n) acc[a][b][m][n] = (f32x4){0.f, 0.f, 0.f, 0.f};
    bf16x8 At[4][2], B0[2][2], B1[2][2];
    const char* cA = (const char*)g.A + (size_t)cur.pm * tstepA; const char* cB = (const char*)g.Bt + (size_t)cur.pn * tstepB;
    S.a_ready(cur);
    if constexpr (SP2) {
        PG8_STAGE(PG8_SB(0, 0), cB, voffB); PG8_STAGE(PG8_SB(0, 1), cB + hstepB, voffB); PG8_STAGE(PG8_SA(0, 0), cA, voffA); PG8_STAGE(PG8_SA(0, 1), cA + hstepA, voffA);
        if (wr == 1) PG8_BAR;
        PG8_WAIT_V(2); PG8_BAR;
        PG8_STAGE(PG8_SB(1, 0), cB + kstepB, voffB); PG8_STAGE(PG8_SA(1, 0), cA + kstepA, voffA); PG8_STAGE(PG8_SB(1, 1), cB + hstepB + kstepB, voffB);
        PG8_WAIT_V(6); PG8_BAR;
    } else {
        PG8_STAGE(PG8_SB(0, 0), cB, voffB); PG8_STAGE(PG8_SA(0, 0), cA, voffA); PG8_STAGE(PG8_SB(0, 1), cB + hstepB, voffB); PG8_STAGE(PG8_SA(0, 1), cA + hstepA, voffA);
        if (wr == 1) PG8_BAR;
        PG8_WAIT_V(4); PG8_BAR;
        PG8_STAGE(PG8_SB(1, 0), cB + kstepB, voffB); PG8_STAGE(PG8_SA(1, 0), cA + kstepA, voffA); PG8_STAGE(PG8_SB(1, 1), cB + hstepB + kstepB, voffB);
        PG8_WAIT_V(6); PG8_BAR;
    }
    for (;;) {
        const bool has_next = S.next(ui + 1, nxt);
        const char* nA = has_next ? (const char*)g.A + (size_t)nxt.pm * tstepA : cA; const char* nB = has_next ? (const char*)g.Bt + (size_t)nxt.pn * tstepB : cB;
        for (int t = 0; t < nt; t += 2) {
            const bool last = (t == nt - 2);
            const char* a1 = cA + (size_t)(t + 1) * kstepA;
            const char* a2 = last ? nA : cA + (size_t)(t + 2) * kstepA; const char* b2 = last ? nB : cB + (size_t)(t + 2) * kstepB;
            const char* a3 = a2 + kstepA; const char* b3 = b2 + kstepB;
            if (last && has_next) S.a_ready(nxt);
            if constexpr (SP2) {
            PG8_LDB(B0, 0, 0); PG8_LDB(B1, 0, 1); PG8_SCHED; PG8_LDA(At, 0, 0); PG8_STAGE(PG8_SA(1, 1), a1 + hstepA, voffA);
            PG8_WAIT_V(8); PG8_WAIT_L(0); PG8_BAR; PG8_MMA(0, 0, At, B0); PG8_MMA(0, 1, At, B1); PG8_BAR; PG8_SCHED;
            PG8_LDA(At, 0, 1); PG8_STAGE(PG8_SB(0, 0), b2, voffB); PG8_STAGE(PG8_SB(0, 1), b2 + hstepB, voffB); PG8_STAGE(PG8_SA(0, 0), a2, voffA);
            PG8_WAIT_V(8); PG8_WAIT_L(0); PG8_BAR; PG8_MMA(1, 0, At, B0); PG8_MMA(1, 1, At, B1); PG8_BAR; PG8_SCHED;
            PG8_LDB(B0, 1, 0); PG8_LDB(B1, 1, 1); PG8_SCHED; PG8_LDA(At, 1, 0); PG8_STAGE(PG8_SA(0, 1), a2 + hstepA, voffA);
            PG8_WAIT_V(8); PG8_WAIT_L(0); PG8_BAR; PG8_MMA(0, 0, At, B0); PG8_MMA(0, 1, At, B1); PG8_BAR; PG8_SCHED;
            PG8_LDA(At, 1, 1); PG8_STAGE(PG8_SB(1, 0), b3, voffB); PG8_STAGE(PG8_SB(1, 1), b3 + hstepB, voffB); PG8_STAGE(PG8_SA(1, 0), a3, voffA);
            PG8_WAIT_V(8); PG8_WAIT_L(0); PG8_BAR; PG8_MMA(1, 0, At, B0); PG8_MMA(1, 1, At, B1); PG8_BAR; PG8_SCHED;
            } else {
            PG8_LDB(B0, 0, 0); PG8_SCHED; PG8_LDA(At, 0, 0); PG8_STAGE(PG8_SA(1, 1), a1 + hstepA, voffA);
            PG8_WAIT_L(8); PG8_BAR; PG8_WAIT_L(0); PG8_MMA(0, 0, At, B0); PG8_BAR; PG8_SCHED;
            PG8_LDB(B1, 0, 1); PG8_STAGE(PG8_SB(0, 0), b2, voffB);
            PG8_BAR; PG8_WAIT_L(0); PG8_MMA(0, 1, At, B1); PG8_BAR;
            PG8_LDA(At, 0, 1); PG8_STAGE(PG8_SA(0, 0), a2, voffA);
            PG8_BAR; PG8_WAIT_L(0); PG8_MMA(1, 0, At, B0); PG8_BAR; PG8_SCHED;
            PG8_STAGE(PG8_SB(0, 1), b2 + hstepB, voffB);
            PG8_WAIT_V(6); PG8_BAR; PG8_MMA(1, 1, At, B1); PG8_BAR;
            PG8_LDB(B0, 1, 0); PG8_SCHED; PG8_LDA(At, 1, 0); PG8_STAGE(PG8_SA(0, 1), a2 + hstepA, voffA);
            PG8_WAIT_L(8); PG8_BAR; PG8_WAIT_L(0); PG8_MMA(0, 0, At, B0); PG8_BAR; PG8_SCHED;
            PG8_LDB(B1, 1, 1); PG8_STAGE(PG8_SB(1, 0), b3, voffB);
            PG8_BAR; PG8_WAIT_L(0); PG8_MMA(0, 1, At, B1); PG8_BAR;
            PG8_LDA(At, 1, 1); PG8_STAGE(PG8_SA(1, 0), a3, voffA);
            PG8_BAR; PG8_WAIT_L(0); PG8_MMA(1, 0, At, B0); PG8_BAR; PG8_SCHED;
            PG8_STAGE(PG8_SB(1, 1), b3 + hstepB, voffB);
            PG8_WAIT_V(6); PG8_BAR; PG8_MMA(1, 1, At, B1); PG8_BAR;
            }
        }
        if constexpr (ALIGN_EPI) { if (wr == 0) PG8_BAR; }
        if constexpr (!Epi::AFTER_DRAIN) { E(acc, cur, wr, wc, fr, fq); S.done(cur); }
        if (!has_next) break;
#pragma unroll
        for (int a = 0; a < 2; ++a)
#pragma unroll
            for (int b = 0; b < 2; ++b)
#pragma unroll
                for (int m = 0; m < 4; ++m)
#pragma unroll
                    for (int n = 0; n < 2; ++n) acc[a][b][m][n] = (f32x4){0.f, 0.f, 0.f, 0.f};
        cur = nxt; cA = nA; cB = nB; ++ui;
        if constexpr (ALIGN_EPI) { if (wr == 1) PG8_BAR; }
    }
    PG8_WAIT_V(0);
    if constexpr (!ALIGN_EPI) { if (wr == 0) PG8_BAR; }
    PG8_BAR;
    if constexpr (Epi::AFTER_DRAIN) { E.fused(acc, cur, wr, wc, fr, fq, lds, wid, lane); S.done(cur); }
#undef PG8_SA
#undef PG8_SB
#undef PG8_STAGE
#undef PG8_LDA
#undef PG8_LDB
#undef PG8_MMA
#undef PG8_WAIT_V
#undef PG8_WAIT_L
#undef PG8_BAR
#undef PG8_SCHED
}
}
#define LAS __attribute__((address_space(3)))
#define XB_TMO      128
#define XB_XCNT(j)  (256  + 64 * (j))
#define XB_XSUB(j)  (1280 + 64 * (j))
#define XB_XGEN(j)  (2304 + 64 * (j))
#define XB_TOP      3328
#define XB_TOPGEN   3392
#define XCD_BAR_WORDS 3456
#define XB_SPIN_CAP (1u << 18)

__device__ __forceinline__ unsigned xb_ld(unsigned* p)              { return __hip_atomic_load(p, __ATOMIC_RELAXED, __HIP_MEMORY_SCOPE_AGENT); }
__device__ __forceinline__ unsigned xb_add(unsigned* p, unsigned v) { return __hip_atomic_fetch_add(p, v, __ATOMIC_RELAXED, __HIP_MEMORY_SCOPE_AGENT); }
__device__ __forceinline__ unsigned xb_xcc_id() { return (unsigned)__builtin_amdgcn_s_getreg((3 << 11) | 20) & 0xFu; }
#define XB_SPIN(cond, bar) do { unsigned _sp = 0; while (cond) { __builtin_amdgcn_s_sleep(1); \
    if ((++_sp & 255u) == 0u) { if (xb_ld(&(bar)[XB_TMO])) break; if (_sp > XB_SPIN_CAP) { atomicAdd(&(bar)[XB_TMO], 1u); break; } } } } while (0)

struct XcdBarrier {
    unsigned* bar; unsigned x;
    volatile LAS unsigned* st;
};

__device__ __forceinline__ XcdBarrier xcd_barrier_post(unsigned* bar, volatile LAS unsigned* st) {
    XcdBarrier b; b.bar = bar; b.x = xb_xcc_id(); b.st = st;
    if (threadIdx.x == 0) (void)xb_add(&bar[XB_XCNT(b.x)], 1u);
    return b;
}
__device__ __forceinline__ void xcd_barrier_complete(unsigned* bar, unsigned x, unsigned& nloc, unsigned& nx) {
    const unsigned G = gridDim.x * gridDim.y * gridDim.z;
    unsigned sum, cnt, mine, sp = 0u;
    for (;;) {
        sum = 0u; cnt = 0u; mine = 0u;
#pragma unroll
        for (unsigned j = 0; j < 16; ++j) { const unsigned c = xb_ld(&bar[XB_XCNT(j)]); sum += c; cnt += (c > 0u) ? 1u : 0u; mine = (j == x) ? c : mine; }
        if (sum == G) break;
        __builtin_amdgcn_s_sleep(1);
        if ((++sp & 255u) == 0u) { if (xb_ld(&bar[XB_TMO])) break; if (sp > XB_SPIN_CAP) { atomicAdd(&bar[XB_TMO], 1u); break; } }
    }
    nloc = mine > 0u ? mine : 1u; nx = cnt > 0u ? cnt : 1u;
}

__device__ __forceinline__ void xcd_barrier(const XcdBarrier& b) {
    asm volatile("s_waitcnt vmcnt(0)" ::: "memory");
    __syncthreads();
    if (threadIdx.x == 0) {
        unsigned* bar = b.bar;
        __builtin_amdgcn_s_waitcnt(0);
        unsigned nloc = b.st[0], nx = b.st[1];
        if (nloc == 0u) { xcd_barrier_complete(bar, b.x, nloc, nx); b.st[0] = nloc; b.st[1] = nx; }
        const unsigned old = xb_add(&bar[XB_XSUB(b.x)], 1u);
        const unsigned gen = old / nloc;
        if (old + 1u == (gen + 1u) * nloc) {
            __builtin_amdgcn_fence(__ATOMIC_RELEASE, "agent");
            asm volatile("s_waitcnt vmcnt(0)" ::: "memory");
            const unsigned og = xb_add(&bar[XB_TOP], 1u);
            const unsigned tg = og / nx;
            if (og + 1u == (tg + 1u) * nx) xb_add(&bar[XB_TOPGEN], 1u);
            else XB_SPIN(xb_ld(&bar[XB_TOPGEN]) == tg, bar);
            __builtin_amdgcn_fence(__ATOMIC_ACQUIRE, "agent");
            xb_add(&bar[XB_XGEN(b.x)], 1u);
            asm volatile("s_waitcnt vmcnt(0)" ::: "memory");
        } else {
            XB_SPIN(xb_ld(&bar[XB_XGEN(b.x)]) == gen, bar);
            __builtin_amdgcn_fence(__ATOMIC_ACQUIRE, "agent");
            asm volatile("s_waitcnt vmcnt(0)" ::: "memory");
        }
    }
    __syncthreads();
}
#define GAS __attribute__((address_space(1)))

typedef unsigned short bf16;
typedef float f32x4 __attribute__((ext_vector_type(4)));
typedef unsigned v4u __attribute__((ext_vector_type(4)));
typedef unsigned v2u __attribute__((ext_vector_type(2)));
#define LDS_WAIT() asm volatile("s_waitcnt lgkmcnt(0)" ::: "memory")

#ifndef MK_ONE_LAUNCH
#define MK_ONE_LAUNCH 0
#endif
#ifndef RET_MFMA
#define RET_MFMA 1
#endif
#ifndef SWA_MFMA
#define SWA_MFMA 1
#endif
#ifndef PROBE_DUP
#define PROBE_DUP 0
#endif
#ifndef CONV_FUSED
#define CONV_FUSED 1
#endif
#ifndef PLE_EARLY
#define PLE_EARLY 1
#endif
#ifndef LN_NOXR
#define LN_NOXR 1
#endif
#ifndef LN_FUSED
#define LN_FUSED 1
#endif
#ifndef RES_BF16
#define RES_BF16 1
#endif
#define REPS(k) int nrep_ = (PROBE_DUP == (k)) ? 2 : 1; asm volatile("" : "+s"(nrep_)); for (int rep_ = 0; rep_ < nrep_; ++rep_)

constexpr int INW_ = 5376, NUPG_ = 13312;
constexpr int S = 16384, D = 2048, INW = 5376, DFF = 5632, NUP = 2 * DFF, NUPG = NUP + D, PLE = 256, DEPTH = 4;
constexpr float ALPHA = 1.6817928305074290f, LN_EPS = 1e-5f, GN_EPS = 1e-6f;
constexpr int NPH = 11, NPHASES = 1 + DEPTH * NPH;

constexpr size_t MiB = 1u << 20;
constexpr size_t WS_CTL = 0, CTL_ZERO_BYTES = 1 * MiB;
constexpr size_t WS_C = 65536; constexpr int C_L = 2 * INW_ + 2 * NUPG_, C1IN = 0, C2IN = INW_, C1UP = 2 * INW_, C2UP = 2 * INW_ + NUPG_;
constexpr size_t WS_YH = 1304 * MiB;
constexpr size_t WS_CP = 540 * MiB;
constexpr size_t WS_PSTAT = 532 * MiB;
constexpr size_t WS_COSR = 2 * MiB, WS_SINR = 10 * MiB, WS_COSA = 18 * MiB, WS_SINA = 20 * MiB;
constexpr size_t WS_W = 32 * MiB, WL_BYTES = 106 * MiB;
constexpr size_t WL_IN = 0, WL_OUT = 21 * MiB, WL_UP = 29 * MiB, WL_G = 73 * MiB, WL_DOWN = 81 * MiB, WL_P = 104 * MiB;
constexpr size_t WS_XR = 530 * MiB, WS_XB = 576 * MiB, WS_Y = 640 * MiB;
constexpr size_t WS_Q = 768 * MiB, WS_K = 800 * MiB, WS_V = 832 * MiB, WS_G = 864 * MiB, WS_AQ = 896 * MiB, WS_AK = 928 * MiB, WS_AV = 932 * MiB;
constexpr size_t WS_MIX = 936 * MiB, WS_U = 1000 * MiB, WS_PS = 1128 * MiB, WS_RETY = 1160 * MiB;
constexpr size_t WS_H = 768 * MiB, WS_ACT = 1128 * MiB, WS_SG = 460 * MiB, WS_PB = 1368 * MiB, WS_END = 1400 * MiB;
constexpr size_t WS_PP = 1064 * MiB;
constexpr size_t WS_ST1 = 24 * MiB, WS_ST2 = 25 * MiB;
constexpr int CW_BAR = 4096;
static_assert((CW_BAR + 3456) * 4 <= 32768 && WS_C + (size_t)4 * C_L * 4 <= CTL_ZERO_BYTES, "barrier words and column sums inside the per-call memset");

constexpr int RING_BYTES = 131072, LDS_BYTES = 147456, LDSCTL_OFF = LDS_BYTES - 1024, MISC_OFF = LDSCTL_OFF + 320;

__device__ __forceinline__ unsigned f2bf(float f) { unsigned u = __builtin_bit_cast(unsigned, f); return (u + 0x7fffu + ((u >> 16) & 1u)) >> 16; }
__device__ __forceinline__ unsigned pk2(float lo, float hi) { return f2bf(lo) | (f2bf(hi) << 16); }
__device__ __forceinline__ float bflo(unsigned w) { return __uint_as_float(w << 16); }
__device__ __forceinline__ float bfhi(unsigned w) { return __uint_as_float(w & 0xffff0000u); }
__device__ __forceinline__ float bf1(const bf16* p) { return __uint_as_float(((unsigned)*p) << 16); }

struct Params {
    const float* in[19]; float* out; unsigned char* ws; int ph_lo, ph_hi;
    float invf_ret[128]; float invf_att[32]; float lg2g[4];
};

struct Ctx { int tid, lane, wave, G, bid; unsigned char* ws; };

__device__ __forceinline__ int lane_id_asm() { int l; asm volatile("v_mbcnt_lo_u32_b32 %0, -1, 0\n\tv_mbcnt_hi_u32_b32 %0, -1, %0" : "=v"(l)); return l; }
__device__ __forceinline__ float wave_sum(float v, int lane) {
#pragma unroll
    for (int o = 1; o < 64; o <<= 1) v += __builtin_bit_cast(float, __builtin_amdgcn_ds_bpermute((lane ^ o) << 2, __builtin_bit_cast(int, v)));
    return v;
}
__device__ __forceinline__ void transpose_item(const float* W, int K, int N, int src_col0, bf16* WT, int dst_row0, int k0, LAS float* scr, int lane) {
#pragma unroll 8
    for (int i = 0; i < 32; ++i) { const int kk = 2 * i + (lane >> 5); scr[kk * 33 + (lane & 31)] = W[(size_t)(k0 + kk) * N + src_col0 + (lane & 31)]; }
    LDS_WAIT(); asm volatile("" ::: "memory");
    const int c = lane & 7;
#pragma unroll
    for (int j = 0; j < 4; ++j) { const int n = (lane >> 3) + 8 * j; const LAS float* s = scr + (8 * c) * 33 + n;
        v4u o; o.x = pk2(s[0 * 33], s[1 * 33]); o.y = pk2(s[2 * 33], s[3 * 33]); o.z = pk2(s[4 * 33], s[5 * 33]); o.w = pk2(s[6 * 33], s[7 * 33]);
        *(v4u*)(WT + (size_t)(dst_row0 + n) * K + k0 + 8 * c) = o; }
    LDS_WAIT(); asm volatile("" ::: "memory");
}
__device__ __forceinline__ void transpose_item64(const float* W, int K, int N, int srcA, int srcB, bf16* WT, int dst_row0, int k0, LAS float* scr, int lane, int tiled = 0) {
    const int c4 = lane & 15, gsel = c4 >> 3, col = 4 * (c4 & 7), src = (gsel ? srcB : srcA) + col, kq = lane >> 4;
    f32x4 v[16];
#pragma unroll
    for (int i = 0; i < 16; ++i) v[i] = *(const f32x4*)(W + (size_t)(k0 + 4 * i + kq) * N + src);
#pragma unroll
    for (int i = 0; i < 16; ++i) { LAS float* d = scr + (4 * i + kq) * 65 + 32 * gsel + col; d[0] = v[i][0]; d[1] = v[i][1]; d[2] = v[i][2]; d[3] = v[i][3]; }
    LDS_WAIT(); asm volatile("" ::: "memory");
    const int c = lane & 7;
#pragma unroll
    for (int j = 0; j < 8; ++j) { const int n = (lane >> 3) + 8 * j; const LAS float* s = scr + (8 * c) * 65 + n;
        v4u o; o.x = pk2(s[0 * 65], s[1 * 65]); o.y = pk2(s[2 * 65], s[3 * 65]); o.z = pk2(s[4 * 65], s[5 * 65]); o.w = pk2(s[6 * 65], s[7 * 65]);
        *(v4u*)(WT + (tiled ? pg8::tiled_off(dst_row0 + n, k0 + 8 * c, K) : (size_t)(dst_row0 + n) * K + k0 + 8 * c)) = o; }
    LDS_WAIT(); asm volatile("" ::: "memory");
}
__device__ __forceinline__ void transpose_unit(const float* W, int K, int N, int srcA, int srcB, bf16* WT, int dst_row0, int kb0, int nkb, LAS float* scr, int lane, int tiled,
                                               const float* gv, const float* bv, float* c1, float* c2) {
    const int c4 = lane & 15, gsel = c4 >> 3, col = 4 * (c4 & 7), src = (gsel ? srcB : srcA) + col, kq = lane >> 4, c = lane & 7;
    f32x4 c1p = (f32x4){0.f, 0.f, 0.f, 0.f}, c2p = (f32x4){0.f, 0.f, 0.f, 0.f};
    for (int kb = kb0; kb < kb0 + nkb; ++kb) { const int k0 = 64 * kb;
        f32x4 v[16];
#pragma unroll
        for (int i = 0; i < 16; ++i) v[i] = *(const f32x4*)(W + (size_t)(k0 + 4 * i + kq) * N + src);
        if (gv) {
#pragma unroll
            for (int i = 0; i < 16; ++i) { const float gk = gv[k0 + 4 * i + kq], bk = bv[k0 + 4 * i + kq]; c2p = c2p + v[i] * bk; v[i] = v[i] * gk;
#pragma unroll
                for (int e = 0; e < 4; ++e) c1p[e] += __uint_as_float(f2bf(v[i][e]) << 16); } }
#pragma unroll
        for (int i = 0; i < 16; ++i) { LAS float* d = scr + (4 * i + kq) * 65 + 32 * gsel + col; d[0] = v[i][0]; d[1] = v[i][1]; d[2] = v[i][2]; d[3] = v[i][3]; }
        LDS_WAIT(); asm volatile("" ::: "memory");
#pragma unroll
        for (int j = 0; j < 8; ++j) { const int n = (lane >> 3) + 8 * j; const LAS float* sp = scr + (8 * c) * 65 + n;
            v4u o; o.x = pk2(sp[0 * 65], sp[1 * 65]); o.y = pk2(sp[2 * 65], sp[3 * 65]); o.z = pk2(sp[4 * 65], sp[5 * 65]); o.w = pk2(sp[6 * 65], sp[7 * 65]);
            *(v4u*)(WT + (tiled ? pg8::tiled_off(dst_row0 + n, k0 + 8 * c, K) : (size_t)(dst_row0 + n) * K + k0 + 8 * c)) = o; }
        LDS_WAIT(); asm volatile("" ::: "memory");
    }
    if (gv) {
#pragma unroll
        for (int e = 0; e < 4; ++e) {
            float a = c1p[e], b = c2p[e];
            a += __builtin_bit_cast(float, __builtin_amdgcn_ds_bpermute((lane ^ 16) << 2, __builtin_bit_cast(int, a))); b += __builtin_bit_cast(float, __builtin_amdgcn_ds_bpermute((lane ^ 16) << 2, __builtin_bit_cast(int, b)));
            a += __builtin_bit_cast(float, __builtin_amdgcn_ds_bpermute((lane ^ 32) << 2, __builtin_bit_cast(int, a))); b += __builtin_bit_cast(float, __builtin_amdgcn_ds_bpermute((lane ^ 32) << 2, __builtin_bit_cast(int, b)));
            if (kq == 0) { c1[dst_row0 + 32 * gsel + col + e] = a; c2[dst_row0 + 32 * gsel + col + e] = b; } }
    }
}
__device__ __forceinline__ int win_src_col(int g) {
    const int tile = g >> 3, bj = (g >> 2) & 1, wcg = g & 3;
    if (tile < 16) return 32 * g;
    if (tile < 20) return 4096 + 256 * (tile - 16) + 64 * wcg + 32 * bj;
    return wcg < 2 ? 5120 + 64 * wcg + 32 * bj : 5248 + 32 * (wcg - 2) + 64 * bj;
}
__device__ __forceinline__ int wup_src_col(int g) { const int tile = g >> 3, bj = (g >> 2) & 1, wcg = g & 3; return (bj ? DFF : 0) + 128 * tile + 32 * wcg; }

__device__ __forceinline__ void sincos_d(float angf, float& s, float& c) {
    const double a = (double)angf;
    const double k = __builtin_rint(a * 0.63661977236758134308);
    double r = __builtin_fma(-k, 1.57079632679489661923, a); r = __builtin_fma(-k, 6.123233995736766e-17, r);
    const double r2 = r * r;
    const double sp = r + r * r2 * (-1.0 / 6 + r2 * (1.0 / 120 + r2 * (-1.0 / 5040 + r2 * (1.0 / 362880 + r2 * (-1.0 / 39916800)))));
    const double cp = 1.0 + r2 * (-0.5 + r2 * (1.0 / 24 + r2 * (-1.0 / 720 + r2 * (1.0 / 40320 + r2 * (-1.0 / 3628800 + r2 * (1.0 / 479001600))))));
    const int q = ((int)k) & 3;
    const double sv = (q == 0) ? sp : (q == 1) ? cp : (q == 2) ? -sp : -cp;
    const double cv = (q == 0) ? cp : (q == 1) ? -sp : (q == 2) ? -cp : sp;
    s = (float)sv; c = (float)cv;
}

__device__ __forceinline__ void phase_prologue(const Params& P, const Ctx& cx, LAS unsigned char* lds) {
    unsigned char* ws = cx.ws; const int tid = cx.tid, lane = cx.lane, wave = cx.wave, G = cx.G;
    LAS float* scr = (LAS float*)(lds + wave * 16896);
    const int gw = cx.bid * 8 + wave, NGW = G * 8;
#if LN_FUSED
    constexpr int U_IN = 84 * 8, U_OUT = 32 * 8, U_UP = 176 * 8, U_G = 32 * 8, U_DN = 32 * 22, U_P = 32, U_L = U_IN + U_OUT + U_UP + U_G + U_DN + U_P;
    for (int it = gw; it < DEPTH * U_L; it += NGW) {
        const int l = it / U_L; int r = it - l * U_L;
        bf16* wl = (bf16*)(ws + WS_W + (size_t)l * WL_BYTES); float* cl0 = (float*)(ws + WS_CP) + (size_t)l * C_L;
        const float* g1 = P.in[8] + l * D; const float* b1 = P.in[9] + l * D;
        const float* g2 = l ? P.in[14] + (l - 1) * D : nullptr; const float* b2 = l ? P.in[15] + (l - 1) * D : nullptr;
        const float* W; int K = D, N = D, sa, sb, g, kc, nkb = 4, tiled = 0; bf16* WT; const float* gv = nullptr; const float* bv = nullptr; float* c1 = nullptr; float* c2 = nullptr;
        if (r < U_IN) { g = r >> 3; kc = r & 7; W = P.in[3] + (size_t)l * D * INW; N = INW; sa = win_src_col(2 * g); sb = win_src_col(2 * g + 1); WT = wl + WL_IN / 2; gv = g2; bv = b2; c1 = cl0 + C1IN; c2 = cl0 + C2IN; }
        else if ((r -= U_IN) < U_OUT) { g = r >> 3; kc = r & 7; W = P.in[4] + (size_t)l * D * D; sa = 64 * g; sb = sa + 32; WT = wl + WL_OUT / 2; }
        else if ((r -= U_OUT) < U_UP) { g = r >> 3; kc = r & 7; W = P.in[10] + (size_t)l * D * NUP; N = NUP; sa = wup_src_col(2 * g); sb = wup_src_col(2 * g + 1); WT = wl + WL_UP / 2; gv = g1; bv = b1; c1 = cl0 + C1UP; c2 = cl0 + C2UP; }
        else if ((r -= U_UP) < U_G) { g = r >> 3; kc = r & 7; W = P.in[16] + (size_t)l * D * D; sa = 64 * g; sb = sa + 32; WT = wl + WL_G / 2; gv = g1; bv = b1; c1 = cl0 + C1UP + NUP; c2 = cl0 + C2UP + NUP; }
        else if ((r -= U_G) < U_DN) { g = r / 22; kc = r % 22; W = P.in[13] + (size_t)l * DFF * D; K = DFF; sa = 64 * g; sb = sa + 32; WT = wl + WL_DOWN / 2; tiled = 1; }
        else { r -= U_DN; g = r; kc = 0; W = P.in[18] + (size_t)l * PLE * D; K = PLE; sa = 64 * g; sb = sa + 32; WT = wl + WL_P / 2; }
        if (c1) { c1 += (size_t)kc * DEPTH * C_L; c2 += (size_t)kc * DEPTH * C_L; }
        transpose_unit(W, K, N, sa, sb, WT, 64 * g, 4 * kc, nkb, scr, lane, tiled, gv, bv, c1, c2);
    }
#else
    constexpr int I_IN = 32 * 84, I_OUT = 32 * 32, I_UP = 32 * 176, I_G = 32 * 32, I_DN = 88 * 32, I_P = 4 * 32, I_L = I_IN + I_OUT + I_UP + I_G + I_DN + I_P;
    for (int it = gw; it < DEPTH * I_L; it += NGW) {
        const int l = it / I_L; int r = it - l * I_L;
        bf16* wl = (bf16*)(ws + WS_W + (size_t)l * WL_BYTES);
        if (r < I_IN) { const int kb = r / 84, g = r % 84; transpose_item64(P.in[3] + (size_t)l * D * INW, D, INW, win_src_col(2 * g), win_src_col(2 * g + 1), wl + WL_IN / 2, 64 * g, 64 * kb, scr, lane); continue; } r -= I_IN;
        if (r < I_OUT) { const int kb = r / 32, g = r % 32; transpose_item64(P.in[4] + (size_t)l * D * D, D, D, 64 * g, 64 * g + 32, wl + WL_OUT / 2, 64 * g, 64 * kb, scr, lane); continue; } r -= I_OUT;
        if (r < I_UP) { const int kb = r / 176, g = r % 176; transpose_item64(P.in[10] + (size_t)l * D * NUP, D, NUP, wup_src_col(2 * g), wup_src_col(2 * g + 1), wl + WL_UP / 2, 64 * g, 64 * kb, scr, lane); continue; } r -= I_UP;
        if (r < I_G) { const int kb = r / 32, g = r % 32; transpose_item64(P.in[16] + (size_t)l * D * D, D, D, 64 * g, 64 * g + 32, wl + WL_G / 2, 64 * g, 64 * kb, scr, lane); continue; } r -= I_G;
        if (r < I_DN) { const int kb = r / 32, g = r % 32; transpose_item64(P.in[13] + (size_t)l * DFF * D, DFF, D, 64 * g, 64 * g + 32, wl + WL_DOWN / 2, 64 * g, 64 * kb, scr, lane, 1); continue; } r -= I_DN;
        { const int kb = r / 32, g = r % 32; transpose_item64(P.in[18] + (size_t)l * PLE * D, PLE, D, 64 * g, 64 * g + 32, wl + WL_P / 2, 64 * g, 64 * kb, scr, lane); }
    }
#endif
    const size_t gt = (size_t)cx.bid * 512 + tid, NT = (size_t)G * 512;
    { const float* x = P.in[0]; bf16* xb = (bf16*)(ws + WS_XB);
      for (size_t i = gt; i < (size_t)S * D / 8; i += NT) { const f32x4 a = *(const f32x4*)(x + i * 8), b = *(const f32x4*)(x + i * 8 + 4);
          v4u o; o.x = pk2(a[0], a[1]); o.y = pk2(a[2], a[3]); o.z = pk2(b[0], b[1]); o.w = pk2(b[2], b[3]); *(v4u*)(xb + i * 8) = o; } }
    { const float* p = P.in[1]; bf16* pb = (bf16*)(ws + WS_PB);
      for (size_t i = gt; i < (size_t)DEPTH * S * PLE / 8; i += NT) { const f32x4 a = *(const f32x4*)(p + i * 8), b = *(const f32x4*)(p + i * 8 + 4);
          v4u o; o.x = pk2(a[0], a[1]); o.y = pk2(a[2], a[3]); o.z = pk2(b[0], b[1]); o.w = pk2(b[2], b[3]); *(v4u*)(pb + i * 8) = o; } }
    { const int* pos = (const int*)P.in[2]; float* cosr = (float*)(ws + WS_COSR); float* sinr = (float*)(ws + WS_SINR); float* cosa = (float*)(ws + WS_COSA); float* sina = (float*)(ws + WS_SINA);
      for (size_t i = gt; i < (size_t)S * 128; i += NT) { const int t = (int)(i >> 7), f = (int)(i & 127); float s, c; sincos_d((float)pos[t] * P.invf_ret[f], s, c); cosr[i] = c; sinr[i] = s; }
      for (size_t i = gt; i < (size_t)S * 32; i += NT) { const int t = (int)(i >> 5), f = (int)(i & 31); float s, c; sincos_d((float)pos[t] * P.invf_att[f], s, c); cosa[i] = c; sina[i] = s; } }
}

template <int MT, int NT_, int KK, bool A_KFAST, bool B_NFAST, class FA, class FB, class FC>
__device__ __forceinline__ void simple_gemm(LAS unsigned char* lds, int nbatch, int tid, int G, int bid, const FA& fa, const FB& fb, const FC& fc) {
    LAS float* As = (LAS float*)lds;
    LAS float* Bs = (LAS float*)(lds + 16 * 132 * 4);
    constexpr int TM = MT / 128, TN = NT_ / 64, ITEMS_PER_B = TM * TN;
    const int tm = tid & 31, tn = tid >> 5;
    for (int item = bid; item < nbatch * ITEMS_PER_B; item += G) {
        const int b = item / ITEMS_PER_B, r = item % ITEMS_PER_B, m0 = (r / TN) * 128, n0 = (r % TN) * 64;
        float c[4][4];
#pragma unroll
        for (int i = 0; i < 4; ++i)
#pragma unroll
            for (int j = 0; j < 4; ++j) c[i][j] = 0.f;
        for (int k0 = 0; k0 < KK; k0 += 16) {
#pragma unroll
            for (int rr = 0; rr < 4; ++rr) { const int e = tid + 512 * rr; int m, k; if (A_KFAST) { k = e & 15; m = e >> 4; } else { m = e & 127; k = e >> 7; }
                As[k * 132 + m] = fa(b, m0 + m, k0 + k); }
#pragma unroll
            for (int rr = 0; rr < 2; ++rr) { const int e = tid + 512 * rr; int n, k; if (B_NFAST) { n = e & 63; k = e >> 6; } else { k = e & 15; n = e >> 4; }
                Bs[k * 68 + n] = fb(b, k0 + k, n0 + n); }
            __syncthreads();
#pragma unroll
            for (int kk = 0; kk < 16; ++kk) { const f32x4 a = *(const LAS f32x4*)(As + kk * 132 + 4 * tm), bb = *(const LAS f32x4*)(Bs + kk * 68 + 4 * tn);
#pragma unroll
                for (int i = 0; i < 4; ++i)
#pragma unroll
                    for (int j = 0; j < 4; ++j) c[i][j] += a[i] * bb[j]; }
            __syncthreads();
        }
#pragma unroll
        for (int i = 0; i < 4; ++i)
#pragma unroll
            for (int j = 0; j < 4; ++j) fc(b, m0 + 4 * tm + i, n0 + 4 * tn + j, c[i][j]);
    }
}

__device__ __forceinline__ void phase_swa(const Params& P, const Ctx& cx, int l, LAS unsigned char* lds) {
    unsigned char* ws = cx.ws; const int tid = cx.tid, G = cx.G;
    const bf16* AQ = (const bf16*)(ws + WS_AQ); const bf16* AK = (const bf16*)(ws + WS_AK); const bf16* AV = (const bf16*)(ws + WS_AV); bf16* MIX = (bf16*)(ws + WS_MIX);
    const float* sinks = P.in[7] + l * 16;
    LAS unsigned* Ks = (LAS unsigned*)lds;
    LAS unsigned* Vs = (LAS unsigned*)(lds + 256 * 33 * 4);
    for (int item = cx.bid; item < 256; item += G) {
        const int nb = item >> 1, hk = item & 1;
        __syncthreads();
        for (int e = tid; e < 256 * 32; e += 512) { const int r = e >> 5, cdw = e & 31; const int gk = nb * 128 - 128 + r;
            unsigned kv = 0u, vv = 0u; if (gk >= 0) { kv = *(const unsigned*)(AK + (size_t)gk * 128 + hk * 64 + 2 * cdw); vv = *(const unsigned*)(AV + (size_t)gk * 128 + hk * 64 + 2 * cdw); }
            Ks[r * 33 + cdw] = kv; Vs[r * 33 + cdw] = vv; }
        __syncthreads();
#pragma unroll 1
        for (int rep = 0; rep < 2; ++rep) {
            const int pair = tid + 512 * rep, i = pair & 127, g = pair >> 7, hq = hk * 8 + g; const int row = nb * 128 + i;
            float q[64], o[64];
            { const v4u* qp = (const v4u*)(AQ + (size_t)row * 1024 + hq * 64);
#pragma unroll
              for (int c8 = 0; c8 < 8; ++c8) { const v4u w = qp[c8]; q[8 * c8 + 0] = bflo(w.x); q[8 * c8 + 1] = bfhi(w.x); q[8 * c8 + 2] = bflo(w.y); q[8 * c8 + 3] = bfhi(w.y); q[8 * c8 + 4] = bflo(w.z); q[8 * c8 + 5] = bfhi(w.z); q[8 * c8 + 6] = bflo(w.w); q[8 * c8 + 7] = bfhi(w.w); } }
#pragma unroll
            for (int d = 0; d < 64; ++d) o[d] = 0.f;
            float mx = sinks[hq], den = 1.0f;
            const int jj0 = (nb == 0) ? (127 - i) : 0;
            for (int jj = jj0; jj < 128; ++jj) { const int kl = i + 1 + jj;
                float s = 0.f;
#pragma unroll
                for (int c = 0; c < 32; ++c) { const unsigned w = Ks[kl * 33 + c]; s += q[2 * c] * bflo(w) + q[2 * c + 1] * bfhi(w); }
                const float mn = fmaxf(mx, s), sc = __expf(mx - mn), p = __expf(s - mn);
                den = den * sc + p; mx = mn;
#pragma unroll
                for (int c = 0; c < 32; ++c) { const unsigned w = Vs[kl * 33 + c]; o[2 * c] = o[2 * c] * sc + p * bflo(w); o[2 * c + 1] = o[2 * c + 1] * sc + p * bfhi(w); }
            }
            const float inv = 1.0f / den;
            v4u* op = (v4u*)(MIX + (size_t)row * 2048 + 1024 + hq * 64);
#pragma unroll
            for (int c8 = 0; c8 < 8; ++c8) { v4u w; w.x = pk2(o[8 * c8] * inv, o[8 * c8 + 1] * inv); w.y = pk2(o[8 * c8 + 2] * inv, o[8 * c8 + 3] * inv); w.z = pk2(o[8 * c8 + 4] * inv, o[8 * c8 + 5] * inv); w.w = pk2(o[8 * c8 + 6] * inv, o[8 * c8 + 7] * inv); op[c8] = w; }
        }
    }
}

__device__ __forceinline__ void phase_ret_u_scores(const Params& P, const Ctx& cx, LAS unsigned char* lds) {
    unsigned char* ws = cx.ws; const int tid = cx.tid, G = cx.G;
    const bf16* Q = (const bf16*)(ws + WS_Q); const bf16* K = (const bf16*)(ws + WS_K); const bf16* V = (const bf16*)(ws + WS_V);
    float* U = (float*)(ws + WS_U); float* PS = (float*)(ws + WS_PS);
    const float lg0 = P.lg2g[0], lg1 = P.lg2g[1], lg2 = P.lg2g[2], lg3 = P.lg2g[3];
    auto lgh = [=](int h) { return h == 0 ? lg0 : h == 1 ? lg1 : h == 2 ? lg2 : lg3; };
    simple_gemm<256, 256, 128, false, true>(lds, 512, tid, G, cx.bid,
        [=](int b, int m, int k) { const int nb = b >> 2, h = b & 3; return bf1(K + (size_t)(nb * 128 + k) * 1024 + h * 256 + m) * exp2f(lgh(h) * (float)(127 - k)); },
        [=](int b, int k, int n) { const int nb = b >> 2, h = b & 3; return bf1(V + (size_t)(nb * 128 + k) * 1024 + h * 256 + n); },
        [=](int b, int m, int n, float v) { U[((size_t)b * 256 + m) * 256 + n] = v; });
    simple_gemm<128, 128, 256, true, false>(lds, 512, tid, G, cx.bid,
        [=](int b, int m, int k) { const int nb = b >> 2, h = b & 3; return bf1(Q + (size_t)(nb * 128 + m) * 1024 + h * 256 + k); },
        [=](int b, int k, int n) { const int nb = b >> 2, h = b & 3; return bf1(K + (size_t)(nb * 128 + n) * 1024 + h * 256 + k); },
        [=](int b, int m, int n, float v) { const int h = b & 3; PS[((size_t)b * 128 + m) * 128 + n] = (m >= n) ? v * exp2f(lgh(h) * (float)(m - n)) : 0.f; });
}
__device__ __forceinline__ void phase_scan(const Params& P, const Ctx& cx) {
    float* U = (float*)(cx.ws + WS_U);
    const size_t gt = (size_t)cx.bid * 512 + cx.tid, NT = (size_t)cx.G * 512;
    for (size_t idx = gt; idx < 4 * 65536; idx += NT) {
        const int h = (int)(idx >> 16); const float cd = exp2f(P.lg2g[h] * 128.0f);
        float r = 0.f;
        for (int n0 = 0; n0 < 128; n0 += 8) { float u[8];
#pragma unroll
            for (int j = 0; j < 8; ++j) u[j] = U[(size_t)(n0 + j) * 262144 + idx];
#pragma unroll
            for (int j = 0; j < 8; ++j) { U[(size_t)(n0 + j) * 262144 + idx] = r; r = r * cd + u[j]; } }
    }
}
__device__ __forceinline__ void phase_ret_out(const Params& P, const Ctx& cx, LAS unsigned char* lds) {
    unsigned char* ws = cx.ws; const int tid = cx.tid, G = cx.G;
    const bf16* Q = (const bf16*)(ws + WS_Q); const bf16* V = (const bf16*)(ws + WS_V);
    const float* Sst = (const float*)(ws + WS_U); const float* PS = (const float*)(ws + WS_PS); float* RY = (float*)(ws + WS_RETY);
    const float lg0 = P.lg2g[0], lg1 = P.lg2g[1], lg2 = P.lg2g[2], lg3 = P.lg2g[3];
    auto lgh = [=](int h) { return h == 0 ? lg0 : h == 1 ? lg1 : h == 2 ? lg2 : lg3; };
    simple_gemm<128, 256, 384, true, true>(lds, 512, tid, G, cx.bid,
        [=](int b, int m, int k) { const int nb = b >> 2, h = b & 3; return k < 128 ? PS[((size_t)b * 128 + m) * 128 + k] : bf1(Q + (size_t)(nb * 128 + m) * 1024 + h * 256 + (k - 128)) * exp2f(lgh(h) * (float)(m + 1)); },
        [=](int b, int k, int n) { const int nb = b >> 2, h = b & 3; return k < 128 ? bf1(V + (size_t)(nb * 128 + k) * 1024 + h * 256 + n) : Sst[((size_t)b * 256 + (k - 128)) * 256 + n]; },
        [=](int b, int m, int n, float v) { const int nb = b >> 2, h = b & 3; RY[(size_t)(nb * 128 + m) * 1024 + h * 256 + n] = v; });
}

typedef short bf16x8 __attribute__((ext_vector_type(8)));
typedef short s16x4 __attribute__((ext_vector_type(4)));
typedef short v4i16_t __attribute__((ext_vector_type(4)));
__device__ __forceinline__ f32x4 mfma16(bf16x8 a, bf16x8 b, f32x4 c) { return __builtin_amdgcn_mfma_f32_16x16x32_bf16(a, b, c, 0, 0, 0); }
__device__ __forceinline__ s16x4 lds_tr(LAS unsigned char* p) { return __builtin_bit_cast(s16x4, __builtin_amdgcn_ds_read_tr16_b64_v4i16((LAS v4i16_t*)p)); }
__device__ __forceinline__ bf16x8 cat44(s16x4 a, s16x4 b) { bf16x8 r; r[0] = a[0]; r[1] = a[1]; r[2] = a[2]; r[3] = a[3]; r[4] = b[0]; r[5] = b[1]; r[6] = b[2]; r[7] = b[3]; return r; }
__device__ __forceinline__ unsigned cvt2(float lo, float hi) { return pg8::cvt_pk_bf16(lo, hi); }
__device__ __forceinline__ bf16x8 pack_frag(const f32x4 a, const f32x4 b) { v4u w; w.x = cvt2(a[0], a[1]); w.y = cvt2(a[2], a[3]); w.z = cvt2(b[0], b[1]); w.w = cvt2(b[2], b[3]); return __builtin_bit_cast(bf16x8, w); }
__device__ __forceinline__ float grp16_sum(float v, int lane) {
#pragma unroll
    for (int o = 1; o < 16; o <<= 1) v += __builtin_bit_cast(float, __builtin_amdgcn_ds_bpermute((lane ^ o) << 2, __builtin_bit_cast(int, v)));
    return v;
}

__device__ __forceinline__ unsigned lds_addr(const LAS unsigned char* p) { return (unsigned)(size_t)p; }
template <int O1, int O2, int O3, int O4, int O5, int O6, int O7>
__device__ __forceinline__ void lds_rd8(bf16x8 (&t)[8], unsigned a) {
    asm volatile("ds_read_b128 %0, %8\n\tds_read_b128 %1, %8 offset:%9\n\tds_read_b128 %2, %8 offset:%10\n\tds_read_b128 %3, %8 offset:%11\n\t"
                 "ds_read_b128 %4, %8 offset:%12\n\tds_read_b128 %5, %8 offset:%13\n\tds_read_b128 %6, %8 offset:%14\n\tds_read_b128 %7, %8 offset:%15\n\ts_waitcnt lgkmcnt(0)"
                 : "=&v"(t[0]), "=&v"(t[1]), "=&v"(t[2]), "=&v"(t[3]), "=&v"(t[4]), "=&v"(t[5]), "=&v"(t[6]), "=&v"(t[7])
                 : "v"(a), "i"(O1), "i"(O2), "i"(O3), "i"(O4), "i"(O5), "i"(O6), "i"(O7) : "memory");
}
template <int OA, int OB, int OC>
__device__ __forceinline__ void lds_tr8(s16x4 (&t)[8], unsigned a0, unsigned a1) {
    asm volatile("ds_read_b64_tr_b16 %0, %8\n\tds_read_b64_tr_b16 %1, %8 offset:%10\n\tds_read_b64_tr_b16 %2, %8 offset:%11\n\tds_read_b64_tr_b16 %3, %8 offset:%12\n\t"
                 "ds_read_b64_tr_b16 %4, %9\n\tds_read_b64_tr_b16 %5, %9 offset:%10\n\tds_read_b64_tr_b16 %6, %9 offset:%11\n\tds_read_b64_tr_b16 %7, %9 offset:%12\n\ts_waitcnt lgkmcnt(0)"
                 : "=&v"(t[0]), "=&v"(t[1]), "=&v"(t[2]), "=&v"(t[3]), "=&v"(t[4]), "=&v"(t[5]), "=&v"(t[6]), "=&v"(t[7])
                 : "v"(a0), "v"(a1), "i"(OA), "i"(OB), "i"(OC) : "memory");
}
constexpr int RS_T = 544;
constexpr int TILE_T = 128 * RS_T;
static_assert(2 * TILE_T <= LDSCTL_OFF, "retention tiles vs LDS control words");

template <bool DECAY> __device__ __forceinline__ void stage_tile(LAS unsigned char* img, const bf16* src, int tid, float lg) {
    v4u v[8];
#pragma unroll
    for (int r = 0; r < 8; ++r) { const int pc = tid + 512 * r, row = pc >> 5, c16 = pc & 31; v[r] = *(const v4u*)(src + (size_t)row * 1024 + c16 * 8); }
#pragma unroll
    for (int r = 0; r < 8; ++r) { const int pc = tid + 512 * r, row = pc >> 5, c16 = pc & 31; v4u w = v[r];
        if (DECAY) { const float sc = exp2f(lg * (float)(127 - row));
            w.x = cvt2(bflo(w.x) * sc, bfhi(w.x) * sc); w.y = cvt2(bflo(w.y) * sc, bfhi(w.y) * sc); w.z = cvt2(bflo(w.z) * sc, bfhi(w.z) * sc); w.w = cvt2(bflo(w.w) * sc, bfhi(w.w) * sc); }
        *(LAS v4u*)(img + row * RS_T + c16 * 16) = w; }
}

template <bool DECAY_A> __device__ __forceinline__ void stage_two(LAS unsigned char* imgA, const bf16* srcA, LAS unsigned char* imgB, const bf16* srcB, int tid, float lg) {
    v4u va[8], vb[8];
#pragma unroll
    for (int r = 0; r < 8; ++r) { const int pc = tid + 512 * r, row = pc >> 5, c16 = pc & 31; va[r] = *(const v4u*)(srcA + (size_t)row * 1024 + c16 * 8); vb[r] = *(const v4u*)(srcB + (size_t)row * 1024 + c16 * 8); }
#pragma unroll
    for (int r = 0; r < 8; ++r) { const int pc = tid + 512 * r, row = pc >> 5, c16 = pc & 31; v4u w = va[r];
        if (DECAY_A) { const float sc = exp2f(lg * (float)(127 - row));
            w.x = cvt2(bflo(w.x) * sc, bfhi(w.x) * sc); w.y = cvt2(bflo(w.y) * sc, bfhi(w.y) * sc); w.z = cvt2(bflo(w.z) * sc, bfhi(w.z) * sc); w.w = cvt2(bflo(w.w) * sc, bfhi(w.w) * sc); }
        *(LAS v4u*)(imgA + row * RS_T + c16 * 16) = w; *(LAS v4u*)(imgB + row * RS_T + c16 * 16) = vb[r]; }
}

__device__ __forceinline__ void phase_ret_u_mfma(const Params& P, const Ctx& cx, LAS unsigned char* lds) {
    unsigned char* ws = cx.ws; const int tid = cx.tid, lane = cx.lane, w = cx.wave, r16 = lane & 15, g = lane >> 4, q = r16 >> 2, pp = r16 & 3;
    const bf16* K = (const bf16*)(ws + WS_K); const bf16* V = (const bf16*)(ws + WS_V); bf16* UT = (bf16*)(ws + WS_U);
    LAS unsigned char* Kim = lds; LAS unsigned char* Vim = lds + TILE_T;
    for (int b = cx.bid; b < 512; b += cx.G) {
        const int nb = b >> 2, h = b & 3;
        __syncthreads();
        stage_two<true>(Kim, K + (size_t)nb * 128 * 1024 + h * 256, Vim, V + (size_t)nb * 128 * 1024 + h * 256, tid, P.lg2g[h]);
        __syncthreads();
        f32x4 acc[2][16];
#pragma unroll
        for (int mi = 0; mi < 2; ++mi)
#pragma unroll
            for (int n = 0; n < 16; ++n) acc[mi][n] = (f32x4){0.f, 0.f, 0.f, 0.f};
#pragma unroll 1
        for (int s = 0; s < 4; ++s) {
            bf16x8 af[2];
#pragma unroll
            for (int mi = 0; mi < 2; ++mi) { LAS unsigned char* a0 = Kim + (32 * s + 8 * g + q) * RS_T + (16 * (2 * w + mi) + 4 * pp) * 2; af[mi] = cat44(lds_tr(a0), lds_tr(a0 + 4 * RS_T)); }
#pragma unroll
            for (int ng = 0; ng < 4; ++ng) { const unsigned b0 = lds_addr(Vim + (32 * s + 8 * g + q) * RS_T + (64 * ng + 4 * pp) * 2); s16x4 t[8];
                lds_tr8<32, 64, 96>(t, b0, b0 + 4 * RS_T);
#pragma unroll
                for (int nn = 0; nn < 4; ++nn) { const bf16x8 bfr = cat44(t[nn], t[4 + nn]); const int n = 4 * ng + nn;
                    acc[0][n] = mfma16(af[0], bfr, acc[0][n]); acc[1][n] = mfma16(af[1], bfr, acc[1][n]); } }
        }
#pragma unroll
        for (int mi = 0; mi < 2; ++mi)
#pragma unroll
            for (int n = 0; n < 16; ++n) { v2u o; o.x = cvt2(acc[mi][n][0], acc[mi][n][1]); o.y = cvt2(acc[mi][n][2], acc[mi][n][3]);
                *(v2u*)(UT + ((size_t)b * 256 + 16 * n + r16) * 256 + 16 * (2 * w + mi) + 4 * g) = o; }
    }
}
__device__ __forceinline__ void phase_scan_bf16(const Params& P, const Ctx& cx) {
    unsigned* UT = (unsigned*)(cx.ws + WS_U);
    const size_t gt = (size_t)cx.bid * 512 + cx.tid, NT = (size_t)cx.G * 512;
    for (size_t idx = gt; idx < 131072; idx += NT) {
        const int h = (int)(idx >> 15); const float cd = exp2f(P.lg2g[h] * 128.0f);
        float r0 = 0.f, r1 = 0.f;
        for (int n0 = 0; n0 < 128; n0 += 16) { unsigned u[16];
#pragma unroll
            for (int j = 0; j < 16; ++j) u[j] = UT[(size_t)(n0 + j) * 131072 + idx];
#pragma unroll
            for (int j = 0; j < 16; ++j) { UT[(size_t)(n0 + j) * 131072 + idx] = cvt2(r0, r1); r0 = r0 * cd + bflo(u[j]); r1 = r1 * cd + bfhi(u[j]); } }
    }
}
constexpr int RS_O = 1040;
static_assert(8 * 16 * RS_O <= 2 * TILE_T, "R3 output staging fits the shared area");
__device__ __forceinline__ void phase_ret_out_mfma(const Params& P, const Ctx& cx, int l, LAS unsigned char* lds) {
    unsigned char* ws = cx.ws; const int w = cx.wave;
    const bf16* Q = (const bf16*)(ws + WS_Q); const bf16* K = (const bf16*)(ws + WS_K); const bf16* V = (const bf16*)(ws + WS_V); const bf16* ST = (const bf16*)(ws + WS_U);
    const bf16* Gt = (const bf16*)(ws + WS_G); bf16* MIX = (bf16*)(ws + WS_MIX);
    const float* gg = P.in[5] + l * 1024; const float* gb = P.in[6] + l * 1024;
    LAS unsigned char* Kim = lds; LAS unsigned char* Vim = lds + TILE_T;
    for (int b = cx.bid; b < 512; b += cx.G) {
        const int nb = b >> 2, h = b & 3; const float lg = P.lg2g[h];
        int lane = cx.lane; asm volatile("" : "+v"(lane)); const int tid = w * 64 + lane, r16 = lane & 15, g = lane >> 4, q = r16 >> 2, pp = r16 & 3;
        __syncthreads();
        { const bf16* stb = ST + (size_t)b * 65536;
#pragma unroll
          for (int hf = 0; hf < 2; ++hf) { v4u v[8];
#pragma unroll
            for (int r = 0; r < 8; ++r) { const int pc = tid + 512 * (r + 8 * hf), row = pc >> 5, c16 = pc & 31; v[r] = *(const v4u*)(stb + (size_t)row * 256 + c16 * 8); }
#pragma unroll
            for (int r = 0; r < 8; ++r) { const int pc = tid + 512 * (r + 8 * hf), row = pc >> 5, c16 = pc & 31; *(LAS v4u*)(lds + row * RS_T + c16 * 16) = v[r]; } } }
        bf16x8 qf[8];
        { const bf16* qrow = Q + (size_t)(nb * 128 + 16 * w + r16) * 1024 + h * 256 + 8 * g;
#pragma unroll
          for (int s = 0; s < 8; ++s) qf[s] = *(const bf16x8*)(qrow + 32 * s); }
        const bf16* ksrc = K + (size_t)nb * 128 * 1024 + h * 256; const bf16* vsrc = V + (size_t)nb * 128 * 1024 + h * 256;
        v4u kv[8];
#pragma unroll
        for (int r = 0; r < 8; ++r) { const int pc = tid + 512 * r, row = pc >> 5, c16 = pc & 31; kv[r] = *(const v4u*)(ksrc + (size_t)row * 1024 + c16 * 8); }
        __syncthreads();
        f32x4 acc[16];
#pragma unroll
        for (int n = 0; n < 16; ++n) { f32x4 a = (f32x4){0.f, 0.f, 0.f, 0.f}; bf16x8 t[8];
            lds_rd8<64, 128, 192, 256, 320, 384, 448>(t, lds_addr(lds + (16 * n + r16) * RS_T + 16 * g));
#pragma unroll
            for (int s = 0; s < 8; ++s) a = mfma16(qf[s], t[s], a);
            acc[n] = a; }
        { float f[4];
#pragma unroll
          for (int r = 0; r < 4; ++r) f[r] = exp2f(lg * (float)(16 * w + 4 * g + r + 1));
#pragma unroll
          for (int n = 0; n < 16; ++n) { acc[n][0] *= f[0]; acc[n][1] *= f[1]; acc[n][2] *= f[2]; acc[n][3] *= f[3]; } }
        __syncthreads();
        v4u vv[8];
#pragma unroll
        for (int r = 0; r < 8; ++r) { const int pc = tid + 512 * r, row = pc >> 5, c16 = pc & 31; *(LAS v4u*)(Kim + row * RS_T + c16 * 16) = kv[r]; vv[r] = *(const v4u*)(vsrc + (size_t)row * 1024 + c16 * 8); }
        __syncthreads();
        f32x4 sc[8];
#pragma unroll
        for (int mb = 0; mb < 8; ++mb) { sc[mb] = (f32x4){0.f, 0.f, 0.f, 0.f};
            if (mb <= w) { f32x4 a = (f32x4){0.f, 0.f, 0.f, 0.f}; bf16x8 t[8];
                lds_rd8<64, 128, 192, 256, 320, 384, 448>(t, lds_addr(Kim + (16 * mb + r16) * RS_T + 16 * g));
#pragma unroll
                for (int s = 0; s < 8; ++s) a = mfma16(t[s], qf[s], a);
                const int i = 16 * w + r16;
#pragma unroll
                for (int r = 0; r < 4; ++r) { const int j = 16 * mb + 4 * g + r; a[r] = (i >= j) ? a[r] * exp2f(lg * (float)(i - j)) : 0.f; }
                sc[mb] = a; } }
#pragma unroll
        for (int r = 0; r < 8; ++r) { const int pc = tid + 512 * r, row = pc >> 5, c16 = pc & 31; *(LAS v4u*)(Vim + row * RS_T + c16 * 16) = vv[r]; }
        __syncthreads();
#pragma unroll
        for (int sk = 0; sk < 4; ++sk) {
            if (2 * sk <= w) { const bf16x8 pf = pack_frag(sc[2 * sk], sc[2 * sk + 1]);
#pragma unroll
                for (int ng = 0; ng < 4; ++ng) { const unsigned b0 = lds_addr(Vim + (32 * sk + 4 * g + q) * RS_T + (64 * ng + 4 * pp) * 2); s16x4 t[8];
                    lds_tr8<32, 64, 96>(t, b0, b0 + 16 * RS_T);
#pragma unroll
                    for (int nn = 0; nn < 4; ++nn) acc[4 * ng + nn] = mfma16(pf, cat44(t[nn], t[4 + nn]), acc[4 * ng + nn]); } } }
        float mean[4], rstd[4];
#pragma unroll
        for (int r = 0; r < 4; ++r) { float sm = 0.f;
#pragma unroll
            for (int n = 0; n < 16; ++n) sm += acc[n][r];
            mean[r] = grp16_sum(sm, lane) * (1.0f / 256.0f); }
#pragma unroll
        for (int r = 0; r < 4; ++r) { float sq = 0.f;
#pragma unroll
            for (int n = 0; n < 16; ++n) { const float d = acc[n][r] - mean[r]; sq += d * d; }
            rstd[r] = 1.0f / sqrtf(grp16_sum(sq, lane) * (1.0f / 256.0f) + GN_EPS); }
        __syncthreads();
        { LAS unsigned char* ob = lds + w * (16 * RS_O);
#pragma unroll
          for (int n = 0; n < 16; ++n)
#pragma unroll
            for (int r = 0; r < 4; ++r) *(LAS float*)(ob + (4 * g + r) * RS_O + (16 * n + r16) * 4) = (acc[n][r] - mean[r]) * rstd[r];
          LDS_WAIT(); asm volatile("" ::: "memory");
          const int e0 = 8 * (lane & 31), hv = lane >> 5;
          const f32x4 g0 = *(const f32x4*)(gg + h * 256 + e0), g1 = *(const f32x4*)(gg + h * 256 + e0 + 4), b0 = *(const f32x4*)(gb + h * 256 + e0), b1 = *(const f32x4*)(gb + h * 256 + e0 + 4);
#pragma unroll
          for (int k = 0; k < 8; ++k) { const int rl = 2 * k + hv; const size_t row = (size_t)(nb * 128 + 16 * w + rl);
              const f32x4 y0 = *(const LAS f32x4*)(ob + rl * RS_O + e0 * 4), y1 = *(const LAS f32x4*)(ob + rl * RS_O + e0 * 4 + 16);
              const v4u gt = *(const v4u*)(Gt + row * 1024 + h * 256 + e0);
              const f32x4 o0 = y0 * g0 + b0, o1 = y1 * g1 + b1;
              v4u o; o.x = cvt2(o0[0] * bflo(gt.x), o0[1] * bfhi(gt.x)); o.y = cvt2(o0[2] * bflo(gt.y), o0[3] * bfhi(gt.y)); o.z = cvt2(o1[0] * bflo(gt.z), o1[1] * bfhi(gt.z)); o.w = cvt2(o1[2] * bflo(gt.w), o1[3] * bfhi(gt.w));
              *(v4u*)(MIX + row * 2048 + h * 256 + e0) = o; } }
    }
}
constexpr int RS_SK = 144, RS_SV = 160;
__device__ __forceinline__ void phase_swa_mfma(const Params& P, const Ctx& cx, int l, LAS unsigned char* lds) {
    unsigned char* ws = cx.ws; const int tid = cx.tid, lane = cx.lane, w = cx.wave, r16 = lane & 15, g = lane >> 4, q = r16 >> 2, pp = r16 & 3;
    const bf16* AQ = (const bf16*)(ws + WS_AQ); const bf16* AK = (const bf16*)(ws + WS_AK); const bf16* AV = (const bf16*)(ws + WS_AV); bf16* MIX = (bf16*)(ws + WS_MIX);
    LAS unsigned char* Kim = lds; LAS unsigned char* Vim = lds + 256 * RS_SK;
    for (int item = cx.bid; item < 256; item += cx.G) {
        const int nb = item >> 1, hk = item & 1, hq = hk * 8 + w; const float sink = P.in[7][l * 16 + hq];
        __syncthreads();
#pragma unroll
        for (int r = 0; r < 4; ++r) { const int pc = tid + 512 * r, row = pc >> 3, c = pc & 7, gk = nb * 128 - 128 + row;
            v4u kv = (v4u){0u, 0u, 0u, 0u}, vv = (v4u){0u, 0u, 0u, 0u};
            if (gk >= 0) { kv = *(const v4u*)(AK + (size_t)gk * 128 + hk * 64 + c * 8); vv = *(const v4u*)(AV + (size_t)gk * 128 + hk * 64 + c * 8); }
            *(LAS v4u*)(Kim + row * RS_SK + c * 16) = kv; *(LAS v4u*)(Vim + row * RS_SV + c * 16) = vv; }
        __syncthreads();
#pragma unroll 1
        for (int nq = 0; nq < 8; ++nq) {
            const bf16* qrow = AQ + (size_t)(nb * 128 + 16 * nq + r16) * 1024 + hq * 64 + 8 * g;
            const bf16x8 qf0 = *(const bf16x8*)(qrow), qf1 = *(const bf16x8*)(qrow + 32);
            f32x4 sc[10];
            float mx = sink;
            bf16x8 kt[18];
            { const unsigned kp0 = lds_addr(Kim + (16 * nq + r16) * RS_SK + 16 * g);
              bf16x8 t[8];
              lds_rd8<64, 16 * RS_SK, 16 * RS_SK + 64, 32 * RS_SK, 32 * RS_SK + 64, 48 * RS_SK, 48 * RS_SK + 64>(t, kp0);
#pragma unroll
              for (int i = 0; i < 8; ++i) kt[i] = t[i];
              lds_rd8<64, 16 * RS_SK, 16 * RS_SK + 64, 32 * RS_SK, 32 * RS_SK + 64, 48 * RS_SK, 48 * RS_SK + 64>(t, kp0 + 64 * RS_SK);
#pragma unroll
              for (int i = 0; i < 8; ++i) kt[8 + i] = t[i];
              kt[16] = *(const LAS bf16x8*)(Kim + (16 * (nq + 8) + r16) * RS_SK + 16 * g); kt[17] = *(const LAS bf16x8*)(Kim + (16 * (nq + 8) + r16) * RS_SK + 16 * g + 64); }
#pragma unroll
            for (int kb = 0; kb < 9; ++kb) {
                f32x4 a = (f32x4){0.f, 0.f, 0.f, 0.f};
                a = mfma16(kt[2 * kb], qf0, a); a = mfma16(kt[2 * kb + 1], qf1, a);
#pragma unroll
                for (int r = 0; r < 4; ++r) { const int dl = 16 * kb + 4 * g + r - r16; const bool vis = (dl >= 1) && (dl <= 128) && (nb > 0 || 16 * (nq + kb) + 4 * g + r >= 128);
                    a[r] = vis ? a[r] : -INFINITY; mx = fmaxf(mx, a[r]); }
                sc[kb] = a; }
            sc[9] = (f32x4){0.f, 0.f, 0.f, 0.f};
            mx = fmaxf(mx, __builtin_bit_cast(float, __builtin_amdgcn_ds_bpermute((lane ^ 16) << 2, __builtin_bit_cast(int, mx))));
            mx = fmaxf(mx, __builtin_bit_cast(float, __builtin_amdgcn_ds_bpermute((lane ^ 32) << 2, __builtin_bit_cast(int, mx))));
            float sum = 0.f;
#pragma unroll
            for (int kb = 0; kb < 9; ++kb)
#pragma unroll
                for (int r = 0; r < 4; ++r) { const float pv = __expf(sc[kb][r] - mx); sc[kb][r] = pv; sum += pv; }
            sum += __builtin_bit_cast(float, __builtin_amdgcn_ds_bpermute((lane ^ 16) << 2, __builtin_bit_cast(int, sum)));
            sum += __builtin_bit_cast(float, __builtin_amdgcn_ds_bpermute((lane ^ 32) << 2, __builtin_bit_cast(int, sum)));
            const float inv = 1.0f / (sum + __expf(sink - mx));
            f32x4 o[4];
#pragma unroll
            for (int nd = 0; nd < 4; ++nd) o[nd] = (f32x4){0.f, 0.f, 0.f, 0.f};
#pragma unroll
            for (int sk = 0; sk < 5; ++sk) { const bf16x8 pf = pack_frag(sc[2 * sk] * inv, sc[2 * sk + 1] * inv);
                const int kb0 = nq + 2 * sk, kb1 = (kb0 + 1 > 15) ? 15 : kb0 + 1;
                s16x4 t[8];
                lds_tr8<32, 64, 96>(t, lds_addr(Vim + (16 * kb0 + 4 * g + q) * RS_SV + 8 * pp), lds_addr(Vim + (16 * kb1 + 4 * g + q) * RS_SV + 8 * pp));
#pragma unroll
                for (int nd = 0; nd < 4; ++nd) o[nd] = mfma16(pf, cat44(t[nd], t[4 + nd]), o[nd]); }
#pragma unroll
            for (int nd = 0; nd < 4; ++nd)
#pragma unroll
                for (int r = 0; r < 4; ++r) MIX[(size_t)(nb * 128 + 16 * nq + 4 * g + r) * 2048 + 1024 + hq * 64 + 16 * nd + r16] = (bf16)f2bf(o[nd][r]);
        }
    }
}

__device__ __forceinline__ void phase_groupnorm(const Params& P, const Ctx& cx, int l) {
    unsigned char* ws = cx.ws; const int lane = cx.lane, wave = cx.wave, G = cx.G;
    const float* RY = (const float*)(ws + WS_RETY); const bf16* Gt = (const bf16*)(ws + WS_G); bf16* MIX = (bf16*)(ws + WS_MIX);
    const float* gg = P.in[5] + l * 1024; const float* gb = P.in[6] + l * 1024;
    const int gw = cx.bid * 8 + wave, NGW = G * 8;
    for (int it = gw; it < S * 4; it += NGW) { const int row = it >> 2, h = it & 3; const size_t off = (size_t)row * 1024 + h * 256 + 4 * lane;
        f32x4 v = *(const f32x4*)(RY + off);
        const float mean = wave_sum((v[0] + v[1]) + (v[2] + v[3]), lane) * (1.0f / 256.0f);
        v = v - mean;
        const float var = wave_sum((v[0] * v[0] + v[1] * v[1]) + (v[2] * v[2] + v[3] * v[3]), lane) * (1.0f / 256.0f);
        const float rstd = 1.0f / sqrtf(var + GN_EPS);
        const f32x4 g4 = *(const f32x4*)(gg + h * 256 + 4 * lane), b4 = *(const f32x4*)(gb + h * 256 + 4 * lane);
        const v2u gt2 = *(const v2u*)(Gt + off);
        f32x4 o = v * rstd * g4 + b4;
        o[0] *= bflo(gt2.x); o[1] *= bfhi(gt2.x); o[2] *= bflo(gt2.y); o[3] *= bfhi(gt2.y);
        v2u w; w.x = pk2(o[0], o[1]); w.y = pk2(o[2], o[3]);
        *(v2u*)(MIX + (size_t)row * 2048 + h * 256 + 4 * lane) = w; }
}
__device__ __forceinline__ void phase_ln(const Ctx& cx, const float* Y, const float* g, const float* b, float* xo, bf16* xb, float* stats) {
    const int lane = cx.lane, wave = cx.wave, G = cx.G; const int gw = cx.bid * 8 + wave, NGW = G * 8;
    f32x4 g4[8], b4[8];
#pragma unroll
    for (int j = 0; j < 8; ++j) { g4[j] = ((const f32x4*)g)[64 * j + lane]; b4[j] = ((const f32x4*)b)[64 * j + lane]; }
    for (int row = gw; row < S; row += 2 * NGW) {
        const int row2 = row + NGW; const bool has2 = row2 < S; const int rb = has2 ? row2 : row;
        const f32x4* ya = (const f32x4*)(Y + (size_t)row * D) + lane; const f32x4* yb = (const f32x4*)(Y + (size_t)rb * D) + lane;
        f32x4 va[8], vb[8]; float sa = 0.f, sb = 0.f;
#pragma unroll
        for (int j = 0; j < 8; ++j) { va[j] = ya[64 * j]; vb[j] = yb[64 * j]; }
#pragma unroll
        for (int j = 0; j < 8; ++j) { sa += (va[j][0] + va[j][1]) + (va[j][2] + va[j][3]); sb += (vb[j][0] + vb[j][1]) + (vb[j][2] + vb[j][3]); }
        const float ma = wave_sum(sa, lane) * (1.0f / D), mb = wave_sum(sb, lane) * (1.0f / D); float qa = 0.f, qb = 0.f;
#pragma unroll
        for (int j = 0; j < 8; ++j) { va[j] = va[j] - ma; vb[j] = vb[j] - mb; qa += (va[j][0] * va[j][0] + va[j][1] * va[j][1]) + (va[j][2] * va[j][2] + va[j][3] * va[j][3]); qb += (vb[j][0] * vb[j][0] + vb[j][1] * vb[j][1]) + (vb[j][2] * vb[j][2] + vb[j][3] * vb[j][3]); }
        const float ra = 1.0f / sqrtf(wave_sum(qa, lane) * (1.0f / D) + LN_EPS), rbb = 1.0f / sqrtf(wave_sum(qb, lane) * (1.0f / D) + LN_EPS);
        f32x4* xa = (f32x4*)(xo + (size_t)row * D) + lane; f32x4* xbp = (f32x4*)(xo + (size_t)rb * D) + lane;
        if (stats && lane == 0) { stats[2 * (size_t)row] = ma; stats[2 * (size_t)row + 1] = ra; if (has2) { stats[2 * (size_t)rb] = mb; stats[2 * (size_t)rb + 1] = rbb; } }
#pragma unroll
        for (int j = 0; j < 8; ++j) { const f32x4 o = va[j] * ra * g4[j] + b4[j]; if (xo) xa[64 * j] = o;
            if (xb) { v2u w; w.x = pk2(o[0], o[1]); w.y = pk2(o[2], o[3]); ((v2u*)(xb + (size_t)row * D))[64 * j + lane] = w; } }
        if (has2) {
#pragma unroll
            for (int j = 0; j < 8; ++j) { const f32x4 o = vb[j] * rbb * g4[j] + b4[j]; if (xo) xbp[64 * j] = o;
                if (xb) { v2u w; w.x = pk2(o[0], o[1]); w.y = pk2(o[2], o[3]); ((v2u*)(xb + (size_t)rb * D))[64 * j + lane] = w; } } }
    }
}
__device__ __forceinline__ void unpack8(const v4u h, float (&o)[8]) { o[0] = bflo(h.x); o[1] = bfhi(h.x); o[2] = bflo(h.y); o[3] = bfhi(h.y); o[4] = bflo(h.z); o[5] = bfhi(h.z); o[6] = bflo(h.w); o[7] = bfhi(h.w); }
__device__ __forceinline__ void phase_convact(const Params& P, const Ctx& cx, int l) {
    unsigned char* ws = cx.ws; const int tid = cx.tid, G = cx.G;
    const bf16* H = (const bf16*)(ws + WS_H); bf16* ACT = (bf16*)(ws + WS_ACT);
    const float* cw = P.in[11] + (size_t)l * 3 * NUP; const float* cb = P.in[12] + (size_t)l * NUP;
    const int gt = cx.bid * 512 + tid, NT = G * 512;
    for (int item = gt; item < 512 * 704; item += NT) {
        const int seg = item / 704, r = item - seg * 704, tile = r >> 4, q8 = r & 15, t0 = seg * 32;
        const int chg = 128 * tile + 8 * q8, chu = DFF + chg;
        float wg[3][8], wu[3][8], bg[8], bu[8];
#pragma unroll
        for (int k = 0; k < 3; ++k) { const f32x4 a0 = *(const f32x4*)(cw + (size_t)k * NUP + chg), a1 = *(const f32x4*)(cw + (size_t)k * NUP + chg + 4), c0 = *(const f32x4*)(cw + (size_t)k * NUP + chu), c1 = *(const f32x4*)(cw + (size_t)k * NUP + chu + 4);
#pragma unroll
            for (int e = 0; e < 4; ++e) { wg[k][e] = a0[e]; wg[k][4 + e] = a1[e]; wu[k][e] = c0[e]; wu[k][4 + e] = c1[e]; } }
        { const f32x4 a0 = *(const f32x4*)(cb + chg), a1 = *(const f32x4*)(cb + chg + 4), c0 = *(const f32x4*)(cb + chu), c1 = *(const f32x4*)(cb + chu + 4);
#pragma unroll
          for (int e = 0; e < 4; ++e) { bg[e] = a0[e]; bg[4 + e] = a1[e]; bu[e] = c0[e]; bu[4 + e] = c1[e]; } }
        const bf16* hp = H + (size_t)t0 * NUP + 256 * tile + 8 * q8;
        float g2[8], g1[8], u2[8], u1[8];
        if (t0 > 0) { unpack8(*(const v4u*)(hp - 2 * (size_t)NUP), g2); unpack8(*(const v4u*)(hp - (size_t)NUP), g1); unpack8(*(const v4u*)(hp - 2 * (size_t)NUP + 128), u2); unpack8(*(const v4u*)(hp - (size_t)NUP + 128), u1); }
        else {
#pragma unroll
            for (int e = 0; e < 8; ++e) { g2[e] = 0.f; g1[e] = 0.f; u2[e] = 0.f; u1[e] = 0.f; } }
        bf16* ap = ACT + (size_t)t0 * DFF + chg;
        v4u ng = *(const v4u*)(hp), nu = *(const v4u*)(hp + 128);
#pragma unroll 2
        for (int tt = 0; tt < 32; ++tt) {
            float g0[8], u0[8]; unpack8(ng, g0); unpack8(nu, u0);
            if (tt < 31) { ng = *(const v4u*)(hp + (size_t)(tt + 1) * NUP); nu = *(const v4u*)(hp + (size_t)(tt + 1) * NUP + 128); }
            float o[8];
#pragma unroll
            for (int e = 0; e < 8; ++e) { const float ga = bg[e] + wg[0][e] * g2[e] + wg[1][e] * g1[e] + wg[2][e] * g0[e], ua = bu[e] + wu[0][e] * u2[e] + wu[1][e] * u1[e] + wu[2][e] * u0[e];
                o[e] = ga * __builtin_amdgcn_rcpf(1.0f + __expf(-ga)) * ua; g2[e] = g1[e]; g1[e] = g0[e]; u2[e] = u1[e]; u1[e] = u0[e]; }
            v4u w; w.x = cvt2(o[0], o[1]); w.y = cvt2(o[2], o[3]); w.z = cvt2(o[4], o[5]); w.w = cvt2(o[6], o[7]);
            *(v4u*)(ap + (size_t)tt * DFF) = w;
        }
    }
}

__device__ __forceinline__ void phase_conv_fixup(const Params& P, const Ctx& cx, int l) {
    unsigned char* ws = cx.ws;
    const bf16* HALO = (const bf16*)(ws + WS_H); bf16* ACT = (bf16*)(ws + WS_ACT);
    const float* cw = P.in[11] + (size_t)l * 3 * NUP; const float* cb = P.in[12] + (size_t)l * NUP;
    const int gt = cx.bid * 512 + cx.tid, NT = cx.G * 512;
    for (int item = gt; item < 256 * 704; item += NT) {
        const int k = item / 704, r = item - k * 704, tile = r >> 4, q8 = r & 15, chg = 128 * tile + 8 * q8, chu = DFF + chg;
        float a_g[8], b_g[8], c_g[8], d_g[8], a_u[8], b_u[8], c_u[8], d_u[8];
        const bf16* hk = HALO + (size_t)k * 4 * NUP + 256 * tile + 8 * q8;
        unpack8(*(const v4u*)(hk), c_g); unpack8(*(const v4u*)(hk + NUP), d_g); unpack8(*(const v4u*)(hk + 128), c_u); unpack8(*(const v4u*)(hk + NUP + 128), d_u);
        if (k > 0) { const bf16* hm = hk - 4 * (size_t)NUP; unpack8(*(const v4u*)(hm + 2 * NUP), a_g); unpack8(*(const v4u*)(hm + 3 * NUP), b_g); unpack8(*(const v4u*)(hm + 2 * NUP + 128), a_u); unpack8(*(const v4u*)(hm + 3 * NUP + 128), b_u); }
        else {
#pragma unroll
            for (int e = 0; e < 8; ++e) { a_g[e] = 0.f; b_g[e] = 0.f; a_u[e] = 0.f; b_u[e] = 0.f; } }
        float o0[8], o1[8];
#pragma unroll
        for (int e = 0; e < 8; ++e) { const float w0g = cw[chg + e], w1g = cw[NUP + chg + e], w2g = cw[2 * NUP + chg + e], bgv = cb[chg + e], w0u = cw[chu + e], w1u = cw[NUP + chu + e], w2u = cw[2 * NUP + chu + e], buv = cb[chu + e];
            const float g0 = bgv + w0g * a_g[e] + w1g * b_g[e] + w2g * c_g[e], u0 = buv + w0u * a_u[e] + w1u * b_u[e] + w2u * c_u[e];
            const float g1 = bgv + w0g * b_g[e] + w1g * c_g[e] + w2g * d_g[e], u1 = buv + w0u * b_u[e] + w1u * c_u[e] + w2u * d_u[e];
            o0[e] = g0 * __builtin_amdgcn_rcpf(1.0f + __expf(-g0)) * u0; o1[e] = g1 * __builtin_amdgcn_rcpf(1.0f + __expf(-g1)) * u1; }
        v4u w0, w1; w0.x = cvt2(o0[0], o0[1]); w0.y = cvt2(o0[2], o0[3]); w0.z = cvt2(o0[4], o0[5]); w0.w = cvt2(o0[6], o0[7]); w1.x = cvt2(o1[0], o1[1]); w1.y = cvt2(o1[2], o1[3]); w1.z = cvt2(o1[4], o1[5]); w1.w = cvt2(o1[6], o1[7]);
        *(v4u*)(ACT + pg8::tiled_off(64 * k, chg, DFF)) = w0; *(v4u*)(ACT + pg8::tiled_off(64 * k + 1, chg, DFF)) = w1;
    }
}

#ifdef DBG_DUMP
__device__ __forceinline__ void phase_dump(const Ctx& cx, float* out, const bf16* a, int lda, const bf16* b, int ldb, const float* f) {
    const size_t gt = (size_t)cx.bid * 512 + cx.tid, NT = (size_t)cx.G * 512;
    for (size_t i = gt; i < (size_t)S * D; i += NT) { const int row = (int)(i >> 11), col = (int)(i & 2047);
        float v; if (f) v = f[i]; else if (b && col >= 1024) v = bf1(b + (size_t)row * ldb + (col - 1024)); else v = lda ? bf1(a + (size_t)row * lda + col) : bf1(a + (size_t)(row & 2047) * 2048 + col);
        out[i] = v; }
}
#endif
__device__ __forceinline__ void finalize_panel_stats(const Ctx& cx, const float* pstat, float* st, int pm) {
    const int tid = cx.tid, lane = cx.lane, row = pm * 256 + (tid >> 1), hf = tid & 1;
    const f32x4* pp = (const f32x4*)(pstat + ((size_t)row * 32 + 16 * hf) * 2);
    float s1 = 0.f, s2 = 0.f;
#pragma unroll
    for (int k = 0; k < 8; ++k) { const f32x4 v = pp[k]; s1 += v[0] + v[2]; s2 += v[1] + v[3]; }
    s1 += __builtin_bit_cast(float, __builtin_amdgcn_ds_bpermute((lane ^ 1) << 2, __builtin_bit_cast(int, s1)));
    s2 += __builtin_bit_cast(float, __builtin_amdgcn_ds_bpermute((lane ^ 1) << 2, __builtin_bit_cast(int, s2)));
    const float mean = s1 * (1.0f / D), var = fmaxf(s2 * (1.0f / D) - mean * mean, 0.f), rstd = 1.0f / sqrtf(var + LN_EPS);
    if (!hf) *(pg8::f32x2*)(st + 2 * (size_t)row) = (pg8::f32x2){mean, rstd};
}
template <class Sched> __device__ __forceinline__ void finalize_stats_for(const Ctx& cx, const Sched& So, const float* pstat, float* st) {
    int last = -1; pg8::Unit u;
    for (int i = 0; So.next(i, u); ++i) if (u.pm != last) { finalize_panel_stats(cx, pstat, st, u.pm); last = u.pm; }
    asm volatile("s_waitcnt vmcnt(0)" ::: "memory"); __syncthreads();
}
__global__ void __launch_bounds__(512, 2) fwd(Params P) {
    extern __shared__ __attribute__((aligned(16))) unsigned char lds_raw[];
    LAS unsigned char* lds = (LAS unsigned char*)lds_raw;
    const int wave = __builtin_amdgcn_readfirstlane(threadIdx.x >> 6), G = gridDim.x;
    unsigned char* ws = P.ws;
    volatile LAS unsigned* MISC = (volatile LAS unsigned*)(lds + MISC_OFF);
    for (int u = threadIdx.x; u < (LDS_BYTES - LDSCTL_OFF) / 4; u += 512) ((LAS unsigned*)(lds + LDSCTL_OFF))[u] = 0u;
    __syncthreads();
    const int lo = P.ph_lo, hi = P.ph_hi;
    XcdBarrier bar; bar.bar = (unsigned*)(ws + WS_CTL) + CW_BAR; bar.x = 0; bar.st = nullptr;
    if (hi - lo > 1) bar = xcd_barrier_post((unsigned*)(ws + WS_CTL) + CW_BAR, MISC + 8);
#define IN(k) (lo <= (k) && (k) < hi)
#if PROBE_DUP == 20
#define SEAM(k) do { if (IN(k) && IN((k) + 1)) { xcd_barrier(bar); xcd_barrier(bar); } } while (0)
#else
#define SEAM(k) do { if (IN(k) && IN((k) + 1)) xcd_barrier(bar); } while (0)
#endif
#define OPQ() Ctx cx; cx.lane = lane_id_asm(); { int t_ = wave; asm volatile("" : "+s"(t_)); cx.wave = t_; } { int t_ = G; asm volatile("" : "+s"(t_)); cx.G = t_; } { int t_ = blockIdx.x; asm volatile("" : "+s"(t_)); cx.bid = t_; } \
    { unsigned t_ = 0u; asm volatile("" : "+s"(t_)); cx.ws = P.ws + t_; } cx.tid = cx.wave * 64 + cx.lane; int lq = l; asm volatile("" : "+s"(lq)); (void)lq

#ifdef DBG_DUMP
    if (lo >= 1000) { const int l = 0; OPQ(); unsigned char* w = cx.ws; const int kind = lo - 1000;
        if (kind == 1) phase_dump(cx, P.out, (const bf16*)(w + WS_Q), 1024, (const bf16*)(w + WS_AQ), 1024, nullptr);
        else if (kind == 2) phase_dump(cx, P.out, (const bf16*)(w + WS_MIX), 2048, nullptr, 0, nullptr);
        else if (kind == 3) phase_dump(cx, P.out, nullptr, 0, nullptr, 0, (const float*)(w + WS_XR));
        else if (kind == 4) phase_dump(cx, P.out, (const bf16*)(w + WS_ACT), DFF, nullptr, 0, nullptr);
        else if (kind == 5) phase_dump(cx, P.out, nullptr, 0, nullptr, 0, (const float*)(w + WS_Y));
        else if (kind == 6) phase_dump(cx, P.out, (const bf16*)(w + WS_K), 1024, (const bf16*)(w + WS_V), 1024, nullptr);
        else if (kind == 7) phase_dump(cx, P.out, (const bf16*)(w + WS_XB), 2048, nullptr, 0, nullptr);
        else if (kind == 11) phase_dump(cx, P.out, (const bf16*)(w + WS_W + WL_G), 0, nullptr, 0, nullptr);
        else if (kind == 12) phase_dump(cx, P.out, (const bf16*)(w + WS_W + WL_OUT), 0, nullptr, 0, nullptr);
        else if (kind == 10) phase_dump(cx, P.out, (const bf16*)(w + WS_H) + 36 * 256, NUP, nullptr, 0, nullptr);
        else if (kind == 9) phase_dump(cx, P.out, (const bf16*)(w + WS_SG), 2048, nullptr, 0, nullptr);
        else if (kind == 8) phase_dump(cx, P.out, nullptr, 0, nullptr, 0, (const float*)(w + WS_RETY));
        return; }
#endif
    if (IN(0)) { const int l = 0; REPS(9) { __syncthreads(); OPQ(); phase_prologue(P, cx, lds); } }
    SEAM(0);

    for (int l = 0; l < DEPTH; ++l) {
        const int pb = 1 + l * NPH;
#if LN_FUSED
        if (l == 0 && IN(pb + 0)) { OPQ(); const float* cp = (const float*)(cx.ws + WS_CP); float* cc = (float*)(cx.ws + WS_C);
            for (int i = cx.bid * 512 + cx.tid; i < DEPTH * C_L; i += cx.G * 512) { float a = 0.f;
                if (i >= 2 * INW) {
#pragma unroll
                    for (int kc = 0; kc < 8; ++kc) a += cp[(size_t)kc * DEPTH * C_L + i]; }
                cc[i] = a; } }
#endif
        if (IN(pb + 0)) { REPS(3) { OPQ(); unsigned char* w = cx.ws; const bf16* wl = (const bf16*)(w + WS_W + (size_t)lq * WL_BYTES);
            pg8::Gemm g{(const bf16*)(w + WS_XB), wl + WL_IN / 2, S, INW, D}; pg8::StaticOrder So; So.init(S, INW, cx.G, cx.bid);
#if LN_FUSED
            if (lq > 0) { const float* cl = (const float*)(w + WS_C) + (size_t)lq * C_L;
                finalize_stats_for(cx, So, (const float*)(w + WS_PSTAT), (float*)(w + WS_ST2));
                pg8::EpiInProjT<true> E{(bf16*)(w + WS_Q), (bf16*)(w + WS_K), (bf16*)(w + WS_V), (bf16*)(w + WS_G), (bf16*)(w + WS_AQ), (bf16*)(w + WS_AK), (bf16*)(w + WS_AV),
                                        (const float*)(w + WS_COSR), (const float*)(w + WS_SINR), (const float*)(w + WS_COSA), (const float*)(w + WS_SINA), (const float*)(w + WS_ST2), cl + C1IN, cl + C2IN};
                pg8::gemm_phase<pg8::EpiInProjT<true>, pg8::StaticOrder, true, true>(lds, g, So, E, cx.wave); }
            else
#endif
            { pg8::EpiInProj E{(bf16*)(w + WS_Q), (bf16*)(w + WS_K), (bf16*)(w + WS_V), (bf16*)(w + WS_G), (bf16*)(w + WS_AQ), (bf16*)(w + WS_AK), (bf16*)(w + WS_AV),
                             (const float*)(w + WS_COSR), (const float*)(w + WS_SINR), (const float*)(w + WS_COSA), (const float*)(w + WS_SINA), nullptr, nullptr, nullptr};
              pg8::gemm_phase<pg8::EpiInProj, pg8::StaticOrder, true, true>(lds, g, So, E, cx.wave); }
        } }
#if PLE_EARLY
        if (IN(pb + 0)) { OPQ(); unsigned char* w = cx.ws; const bf16* wl = (const bf16*)(w + WS_W + (size_t)lq * WL_BYTES);
            const int nsub = (cx.G > 64) ? cx.G - 64 : cx.G, csub = (cx.G > 64) ? cx.bid - 64 : cx.bid;
            if (csub >= 0) {
                int kple = PLE; asm volatile("" : "+s"(kple));
                pg8::Gemm g{(const bf16*)(w + WS_PB) + (size_t)lq * S * PLE, wl + WL_P / 2, S, D, kple}; pg8::StaticOrder So; So.init(S, D, nsub, csub);
                pg8::EpiPlain E{(bf16*)(w + WS_PP)};
                pg8::gemm_phase<pg8::EpiPlain, pg8::StaticOrder, true, true>(lds, g, So, E, cx.wave); }
        }
#endif
        SEAM(pb + 0);
        if (IN(pb + 1)) {
#if RET_MFMA
            { REPS(6) { OPQ(); phase_ret_u_mfma(P, cx, lds); } }
#else
            { OPQ(); phase_ret_u_scores(P, cx, lds); }
#endif
#if SWA_MFMA
            { REPS(8) { OPQ(); phase_swa_mfma(P, cx, lq, lds); } }
#else
            { OPQ(); phase_swa(P, cx, lq, lds); }
#endif
        }
        SEAM(pb + 1);
#if RET_MFMA
        if (IN(pb + 2)) { OPQ(); phase_scan_bf16(P, cx); }
        SEAM(pb + 2);
        if (IN(pb + 3)) { REPS(7) { OPQ(); phase_ret_out_mfma(P, cx, lq, lds); } }
        SEAM(pb + 3);
#else
        if (IN(pb + 2)) { OPQ(); phase_scan(P, cx); }
        SEAM(pb + 2);
        if (IN(pb + 3)) { OPQ(); phase_ret_out(P, cx, lds); }
        SEAM(pb + 3);
        if (IN(pb + 4)) { OPQ(); phase_groupnorm(P, cx, lq); }
        SEAM(pb + 4);
#endif
        if (IN(pb + 5)) { OPQ(); unsigned char* w = cx.ws; const bf16* wl = (const bf16*)(w + WS_W + (size_t)lq * WL_BYTES);
            pg8::Gemm g{(const bf16*)(w + WS_MIX), wl + WL_OUT / 2, S, D, D}; pg8::StaticOrder So; So.init(S, D, cx.G, cx.bid);
#if LN_FUSED
#if RES_BF16
            if (lq == 0) { pg8::EpiRes3<false, false> E{P.in[0], nullptr, (bf16*)(w + WS_XB), (_Float16*)(w + WS_YH), (float*)(w + WS_PSTAT), nullptr, nullptr, nullptr, nullptr, nullptr, ALPHA};
                pg8::gemm_phase<pg8::EpiRes3<false, false>, pg8::StaticOrder, true, true>(lds, g, So, E, cx.wave); }
            else { pg8::EpiRes3<true, false> E{nullptr, nullptr, (bf16*)(w + WS_XB), (_Float16*)(w + WS_YH), (float*)(w + WS_PSTAT), (const float*)(w + WS_ST2), P.in[14] + (lq - 1) * D, P.in[15] + (lq - 1) * D, nullptr, nullptr, ALPHA};
                pg8::gemm_phase<pg8::EpiRes3<true, false>, pg8::StaticOrder, true, true>(lds, g, So, E, cx.wave); }
#else
            if (lq == 0) { pg8::EpiRes2<false, false, true> E{P.in[0], (float*)(w + WS_Y), (bf16*)(w + WS_XB), (float*)(w + WS_PSTAT), nullptr, nullptr, nullptr, nullptr, nullptr, ALPHA};
                pg8::gemm_phase<pg8::EpiRes2<false, false, true>, pg8::StaticOrder, true, true>(lds, g, So, E, cx.wave); }
            else { pg8::EpiRes2<true, false, true> E{nullptr, (float*)(w + WS_Y), (bf16*)(w + WS_XB), (float*)(w + WS_PSTAT), (const float*)(w + WS_ST2), P.in[14] + (lq - 1) * D, P.in[15] + (lq - 1) * D, nullptr, nullptr, ALPHA};
                pg8::gemm_phase<pg8::EpiRes2<true, false, true>, pg8::StaticOrder, true, true>(lds, g, So, E, cx.wave); }
#endif
#elif LN_NOXR
            if (lq == 0) { pg8::EpiResid<false> E{P.in[0], (float*)(w + WS_Y), ALPHA};
                pg8::gemm_phase<pg8::EpiResid<false>, pg8::StaticOrder, true, true>(lds, g, So, E, cx.wave); }
            else {
#if PROBE_DUP == 30
                { pg8::EpiResidLN<false> E{(float*)(w + WS_Y), (float*)(w + WS_XR + 2 * MiB), (const float*)(w + WS_ST2), P.in[14] + (lq - 1) * D, P.in[15] + (lq - 1) * D, nullptr, nullptr, ALPHA};
                  pg8::gemm_phase<pg8::EpiResidLN<false>, pg8::StaticOrder, true, true>(lds, g, So, E, cx.wave); }
#endif
                pg8::EpiResidLN<false> E{(float*)(w + WS_Y), (float*)(w + WS_Y), (const float*)(w + WS_ST2), P.in[14] + (lq - 1) * D, P.in[15] + (lq - 1) * D, nullptr, nullptr, ALPHA};
                pg8::gemm_phase<pg8::EpiResidLN<false>, pg8::StaticOrder, true, true>(lds, g, So, E, cx.wave); }
#else
            pg8::EpiResid<false> E{(lq == 0) ? P.in[0] : (const float*)(w + WS_XR), (float*)(w + WS_Y), ALPHA};
            pg8::gemm_phase<pg8::EpiResid<false>, pg8::StaticOrder, true, true>(lds, g, So, E, cx.wave);
#endif
        }
        SEAM(pb + 5);
#if !LN_FUSED
        if (IN(pb + 6)) { REPS(1) { OPQ(); unsigned char* w = cx.ws;
#if LN_NOXR
            phase_ln(cx, (const float*)(w + WS_Y), P.in[8] + lq * D, P.in[9] + lq * D, (float*)nullptr, (bf16*)(w + WS_XB), (float*)(w + WS_ST1));
#else
            phase_ln(cx, (const float*)(w + WS_Y), P.in[8] + lq * D, P.in[9] + lq * D, (float*)(w + WS_XR), (bf16*)(w + WS_XB), (float*)nullptr);
#endif
        } }
        SEAM(pb + 6);
#endif
        if (IN(pb + 7)) { REPS(5) { OPQ(); unsigned char* w = cx.ws; const bf16* wl = (const bf16*)(w + WS_W + (size_t)lq * WL_BYTES);
            pg8::Gemm g{(const bf16*)(w + WS_XB), wl + WL_UP / 2, S, NUPG, D}; pg8::StaticOrder So; So.init(S, NUPG, cx.G, cx.bid);
#if LN_FUSED
            { const float* cl = (const float*)(w + WS_C) + (size_t)lq * C_L;
              finalize_stats_for(cx, So, (const float*)(w + WS_PSTAT), (float*)(w + WS_ST1));
              pg8::EpiUpConvT<true> E{(bf16*)(w + WS_ACT), (bf16*)(w + WS_H), (bf16*)(w + WS_SG), P.in[17] + lq * D, P.in[11] + (size_t)lq * 3 * NUP, P.in[12] + (size_t)lq * NUP, (const float*)(w + WS_ST1), cl + C1UP, cl + C2UP};
              pg8::gemm_phase<pg8::EpiUpConvT<true>, pg8::StaticOrder, true, true>(lds, g, So, E, cx.wave); }
#elif CONV_FUSED
            pg8::EpiUpConv E{(bf16*)(w + WS_ACT), (bf16*)(w + WS_H), (bf16*)(w + WS_SG), P.in[17] + lq * D, P.in[11] + (size_t)lq * 3 * NUP, P.in[12] + (size_t)lq * NUP, nullptr, nullptr, nullptr};
            pg8::gemm_phase<pg8::EpiUpConv, pg8::StaticOrder, true, true>(lds, g, So, E, cx.wave);
#else
            pg8::EpiUp E{(bf16*)(w + WS_H), (bf16*)(w + WS_SG), P.in[17] + lq * D};
            pg8::gemm_phase<pg8::EpiUp, pg8::StaticOrder, true, true>(lds, g, So, E, cx.wave);
#endif
        } }
        SEAM(pb + 7);
        if (IN(pb + 8)) {
#if !PLE_EARLY
            { OPQ(); unsigned char* w = cx.ws; const bf16* wl = (const bf16*)(w + WS_W + (size_t)lq * WL_BYTES);
              pg8::Gemm g{(const bf16*)(w + WS_PB) + (size_t)lq * S * PLE, wl + WL_P / 2, S, D, PLE}; pg8::StaticOrder So; So.init(S, D, cx.G, cx.bid);
              pg8::EpiPle E{(const bf16*)(w + WS_SG), (float*)(w + WS_Y)};
              pg8::gemm_phase<pg8::EpiPle, pg8::StaticOrder, true, true>(lds, g, So, E, cx.wave); }
#endif
#if CONV_FUSED
            { OPQ(); phase_conv_fixup(P, cx, lq); }
#else
            { REPS(1) { OPQ(); phase_convact(P, cx, lq); } }
#endif
        }
        SEAM(pb + 8);
        if (IN(pb + 9)) { OPQ(); unsigned char* w = cx.ws; const bf16* wl = (const bf16*)(w + WS_W + (size_t)lq * WL_BYTES);
            pg8::Gemm g{(const bf16*)(w + WS_ACT), wl + WL_DOWN / 2, S, D, DFF, 0, 0, 1, 1}; pg8::StaticOrder So; So.init(S, D, cx.G, cx.bid);
#if LN_FUSED
#if RES_BF16
            pg8::EpiRes3<true, true> E{nullptr, (lq == DEPTH - 1) ? (float*)(w + WS_Y) : (float*)nullptr, (bf16*)(w + WS_XB), (_Float16*)(w + WS_YH), (float*)(w + WS_PSTAT), (const float*)(w + WS_ST1), P.in[8] + lq * D, P.in[9] + lq * D, (const bf16*)(w + WS_PP), (const bf16*)(w + WS_SG), ALPHA};
            pg8::gemm_phase<pg8::EpiRes3<true, true>, pg8::StaticOrder, true, true>(lds, g, So, E, cx.wave);
#else
            pg8::EpiRes2<true, true, true> E{nullptr, (float*)(w + WS_Y), (bf16*)(w + WS_XB), (float*)(w + WS_PSTAT), (const float*)(w + WS_ST1), P.in[8] + lq * D, P.in[9] + lq * D, (const bf16*)(w + WS_PP), (const bf16*)(w + WS_SG), ALPHA};
            pg8::gemm_phase<pg8::EpiRes2<true, true, true>, pg8::StaticOrder, true, true>(lds, g, So, E, cx.wave);
#endif
#elif PLE_EARLY
#if LN_NOXR
#if PROBE_DUP == 31
            { pg8::EpiResidLN<true> E{(float*)(w + WS_Y), (float*)(w + WS_XR + 2 * MiB), (const float*)(w + WS_ST1), P.in[8] + lq * D, P.in[9] + lq * D, (const bf16*)(w + WS_PP), (const bf16*)(w + WS_SG), ALPHA};
              pg8::gemm_phase<pg8::EpiResidLN<true>, pg8::StaticOrder, true, true>(lds, g, So, E, cx.wave); }
#endif
            pg8::EpiResidLN<true> E{(float*)(w + WS_Y), (float*)(w + WS_Y), (const float*)(w + WS_ST1), P.in[8] + lq * D, P.in[9] + lq * D, (const bf16*)(w + WS_PP), (const bf16*)(w + WS_SG), ALPHA};
            pg8::gemm_phase<pg8::EpiResidLN<true>, pg8::StaticOrder, true, true>(lds, g, So, E, cx.wave);
#else
            pg8::EpiDown E{(const float*)(w + WS_XR), (float*)(w + WS_Y), (const bf16*)(w + WS_PP), (const bf16*)(w + WS_SG), ALPHA};
            pg8::gemm_phase<pg8::EpiDown, pg8::StaticOrder, true, true>(lds, g, So, E, cx.wave);
#endif
#else
            pg8::EpiResid<true> E{(const float*)(w + WS_XR), (float*)(w + WS_Y), ALPHA};
            pg8::gemm_phase<pg8::EpiResid<true>, pg8::StaticOrder, true, true>(lds, g, So, E, cx.wave);
#endif
        }
#if LN_FUSED
        if (l == DEPTH - 1) { SEAM(pb + 9); { OPQ(); unsigned char* w = cx.ws; phase_ln(cx, (const float*)(w + WS_Y), P.in[14] + lq * D, P.in[15] + lq * D, P.out, (bf16*)nullptr, (float*)nullptr); } }
        else SEAM(pb + 9);
#else
        SEAM(pb + 9);
        if (IN(pb + 10)) { REPS(1) { OPQ(); unsigned char* w = cx.ws; const bool last = (lq == DEPTH - 1);

#if LN_NOXR
            phase_ln(cx, (const float*)(w + WS_Y), P.in[14] + lq * D, P.in[15] + lq * D, last ? P.out : (float*)nullptr, last ? (bf16*)nullptr : (bf16*)(w + WS_XB), last ? (float*)nullptr : (float*)(w + WS_ST2));
#else
            phase_ln(cx, (const float*)(w + WS_Y), P.in[14] + lq * D, P.in[15] + lq * D, last ? P.out : (float*)(w + WS_XR), last ? (bf16*)nullptr : (bf16*)(w + WS_XB), (float*)nullptr);
#endif
        } }
        SEAM(pb + 10);
#endif
    }
#undef IN
#undef SEAM
}

extern "C" void kernel_launch(void* const* d_in, const int* in_sizes, int n_in, void* d_out, int out_size, void* d_ws, size_t ws_size, hipStream_t stream) {
    static int grid = 0;
    if (grid == 0) {
        if (n_in != 19 || in_sizes[0] != S * D || out_size != S * D || ws_size < WS_END) { fprintf(stderr, "kernel_launch: unexpected shapes (n_in %d, in0 %d, out %d, ws %zu)\n", n_in, n_in > 0 ? in_sizes[0] : -1, out_size, ws_size); grid = -1; return; }
        int dev = 0, cus = 0, per_cu = 0;
        if (hipGetDevice(&dev) != hipSuccess || hipDeviceGetAttribute(&cus, hipDeviceAttributeMultiprocessorCount, dev) != hipSuccess) { grid = -1; return; }
        if (hipFuncSetAttribute((const void*)fwd, hipFuncAttributeMaxDynamicSharedMemorySize, LDS_BYTES) != hipSuccess) { fprintf(stderr, "kernel_launch: hipFuncSetAttribute failed\n"); grid = -1; return; }
        if (hipOccupancyMaxActiveBlocksPerMultiprocessor(&per_cu, (const void*)fwd, 512, LDS_BYTES) != hipSuccess || per_cu < 1) fprintf(stderr, "kernel_launch: occupancy query says %d\n", per_cu);
        (void)hipGetLastError();
        grid = cus;
    }
    if (grid < 0) return;
    (void)hipMemsetAsync((char*)d_ws + WS_CTL, 0, CTL_ZERO_BYTES, stream);
#ifdef DBG_NANFILL
    (void)hipMemsetAsync((char*)d_ws + CTL_ZERO_BYTES, 0xFF, WS_END - CTL_ZERO_BYTES, stream);
#endif
    Params p{};
    for (int i = 0; i < 19; ++i) p.in[i] = (const float*)d_in[i];
    p.out = (float*)d_out; p.ws = (unsigned char*)d_ws;
    for (int f = 0; f < 128; ++f) p.invf_ret[f] = (float)(1.0 / std::pow(10000.0, (double)((float)f / 127.0f)));
    for (int f = 0; f < 32; ++f) p.invf_att[f] = (float)std::pow(10000.0, -(double)(2 * f) / 64.0);
    for (int h = 0; h < 4; ++h) p.lg2g[h] = (float)std::log2(1.0 - std::exp2(-5.0 - h));
#if MK_ONE_LAUNCH
    p.ph_lo = 0; p.ph_hi = NPHASES;
    hipLaunchKernelGGL(fwd, dim3(grid), dim3(512), LDS_BYTES, stream, p);
#else
#ifdef DBG_DUMP
    for (int ph = 0; ph <= DBG_STOP; ++ph) { p.ph_lo = ph; p.ph_hi = ph + 1; hipLaunchKernelGGL(fwd, dim3(grid), dim3(512), LDS_BYTES, stream, p); }
    p.ph_lo = 1000 + DBG_DUMP; p.ph_hi = p.ph_lo + 1; hipLaunchKernelGGL(fwd, dim3(grid), dim3(512), LDS_BYTES, stream, p);
#else
    for (int ph = 0; ph < NPHASES; ++ph) { p.ph_lo = ph; p.ph_hi = ph + 1; hipLaunchKernelGGL(fwd, dim3(grid), dim3(512), LDS_BYTES, stream, p); }
#endif
#endif
}
```

```cpp
#include <hip/hip_runtime.h>
#include <cstdio>
#include <cstdint>
#include <cmath>
#define MK_ONE_LAUNCH 1
namespace pg8 {
#define PG8_LAS __attribute__((address_space(3)))
typedef unsigned short bf16_t;
typedef short bf16x8 __attribute__((ext_vector_type(8)));
typedef float f32x4 __attribute__((ext_vector_type(4)));
typedef unsigned u32x4 __attribute__((ext_vector_type(4)));
constexpr int BM = 256, BK = 64, HALF = 128, HTB = HALF * BK * 2  , STAGE_BYTES = 8 * HTB, NXCD = 8, WGM = 8;

__host__ __device__ __forceinline__ int lds_byte(int r, int c) { const int st = (r >> 4) * 2 + (c >> 5), rr = r & 15, cc = c & 31, ob = rr * 64 + cc * 2; return st * 1024 + (ob ^ (((ob >> 9) & 1) << 5)); }
__host__ __device__ __forceinline__ void stage_rc(int b, int& R, int& C) { const int st = b / 1024, sb = b % 1024, swz = sb ^ (((sb >> 9) & 1) << 5); R = (st >> 1) * 16 + swz / 64; C = (st & 1) * 32 + (swz % 64) / 2; }
__host__ __device__ __forceinline__ int perm32(int rho) { const int n = rho >> 4, i = rho & 15; return 8 * (i >> 2) + 4 * n + (i & 3); }

struct Unit { int pm, pn; };
struct Gemm { const bf16_t* A; const bf16_t* Bt; int M, N, K; int lda, ldb; int tiledA, tiledB; };

struct StaticOrder {
    int nM, nN, nwg, G, c;
    __host__ __device__ void init(int M, int N, int G_, int c_) { nM = M / BM; nN = N / BM; nwg = nM * nN; G = G_; c = c_; }
    __host__ __device__ bool next(int i, Unit& u) const {
        const long L = (long)i * G + c; if (L >= nwg) return false;
        int wgid = (int)L; { const int q = nwg / NXCD, r = nwg % NXCD, xcd = wgid % NXCD, off = wgid / NXCD; wgid = (xcd < r ? xcd * (q + 1) : r * (q + 1) + (xcd - r) * q) + off; }
        const int nig = WGM * nN, gid = wgid / nig, fm = gid * WGM, gsz = (nM - fm) < WGM ? (nM - fm) : WGM;
        u.pm = fm + ((wgid % nig) % gsz); u.pn = (wgid % nig) / gsz; return true;
    }
    __device__ __forceinline__ void a_ready(const Unit&) const {}
    __device__ __forceinline__ void done(const Unit&) const {}
};

typedef float f32x2c_t __attribute__((ext_vector_type(2))); typedef __bf16 bf16x2c_t __attribute__((ext_vector_type(2)));
__device__ __forceinline__ unsigned cvt_pk_bf16(float lo, float hi) { f32x2c_t v = {lo, hi}; bf16x2c_t b = __builtin_convertvector(v, bf16x2c_t); return __builtin_bit_cast(unsigned, b); }
typedef float f32x2 __attribute__((ext_vector_type(2)));
typedef unsigned u32x2 __attribute__((ext_vector_type(2)));
__host__ __device__ __forceinline__ size_t tiled_off(int row, int col, int K) { return ((size_t)((row >> 8) * (K >> 6) + (col >> 6)) * 256 + (row & 255)) * 64 + (col & 63); }
#ifndef EPI_NT
#define EPI_NT 0
#endif
template <class T> __device__ __forceinline__ void st_out(T* p, const T v) {
#if EPI_NT
    __builtin_nontemporal_store(v, p);
#else
    *p = v;
#endif
}

__device__ __forceinline__ float bf2f(unsigned short b) { return __uint_as_float(((unsigned)b) << 16); }
__device__ __forceinline__ u32x4 pack8(const f32x4 a, const f32x4 b) { u32x4 w; w.x = cvt_pk_bf16(a[0], a[1]); w.y = cvt_pk_bf16(a[2], a[3]); w.z = cvt_pk_bf16(b[0], b[1]); w.w = cvt_pk_bf16(b[2], b[3]); return w; }
__device__ __forceinline__ float sigmoidf_(float x) { return __builtin_amdgcn_rcpf(1.0f + __expf(-x)); }

template <bool LNFIX> struct EpiInProjT {
    static constexpr bool PERM = true, AFTER_DRAIN = false;
    bf16_t *Q, *K, *V, *G, *AQ, *AK, *AV; const float *cosr, *sinr, *cosa, *sina; const float *stats, *c1, *c2;
    __device__ __forceinline__ void operator()(f32x4 (&acc)[2][2][4][2], const Unit& u, int wr, int wc, int fr, int fq) const {
        const int row0 = u.pm * BM + wr * 64 + fr, pn = u.pn, cw = wc * 32 + 8 * fq;
        if (LNFIX) {
            f32x4 c1v[2][2], c2v[2][2];
#pragma unroll
            for (int bj = 0; bj < 2; ++bj)
#pragma unroll
                for (int n = 0; n < 2; ++n) { c1v[bj][n] = *(const f32x4*)(c1 + pn * 256 + bj * HALF + cw + 4 * n); c2v[bj][n] = *(const f32x4*)(c2 + pn * 256 + bj * HALF + cw + 4 * n); }
#pragma unroll
            for (int i = 0; i < 8; ++i) { const f32x2 st = *(const f32x2*)(stats + 2 * (size_t)(row0 + (i >> 2) * HALF + (i & 3) * 16));
#pragma unroll
                for (int bj = 0; bj < 2; ++bj)
#pragma unroll
                    for (int n = 0; n < 2; ++n) acc[i >> 2][bj][i & 3][n] = (acc[i >> 2][bj][i & 3][n] - c1v[bj][n] * st.x) * st.y + c2v[bj][n]; } }
        auto A = [&](int ai, int bj, int m, int n) -> f32x4 { return acc[ai][bj][m][n]; };
        if (pn < 8) {
            bf16_t* O = pn < 4 ? Q : K; const int hcol = (pn & 3) * 256; const float sc = pn < 4 ? 1.0f : 0.0625f;
#pragma unroll
            for (int ai = 0; ai < 2; ++ai)
#pragma unroll
                for (int m = 0; m < 4; ++m) { const int row = row0 + ai * HALF + m * 16;
                    const f32x4 c0 = *(const f32x4*)(cosr + (size_t)row * 128 + cw), c1 = *(const f32x4*)(cosr + (size_t)row * 128 + cw + 4);
                    const f32x4 s0 = *(const f32x4*)(sinr + (size_t)row * 128 + cw), s1 = *(const f32x4*)(sinr + (size_t)row * 128 + cw + 4);
                    const f32x4 a0 = A(ai, 0, m, 0), a1 = A(ai, 0, m, 1), b0 = A(ai, 1, m, 0), b1 = A(ai, 1, m, 1);
                    const f32x4 o10 = (a0 * c0 - b0 * s0) * sc, o11 = (a1 * c1 - b1 * s1) * sc, o20 = (a0 * s0 + b0 * c0) * sc, o21 = (a1 * s1 + b1 * c1) * sc;
                    bf16_t* rowp = O + (size_t)row * 1024 + hcol + cw;
                    st_out((u32x4*)(rowp), (u32x4)(pack8(o10, o11))); st_out((u32x4*)(rowp + HALF), (u32x4)(pack8(o20, o21))); }
        } else if (pn < 16) {
            const bool gate = pn >= 12; bf16_t* O = gate ? G : V; const int hcol = (pn & 3) * 256;
#pragma unroll
            for (int ai = 0; ai < 2; ++ai)
#pragma unroll
                for (int m = 0; m < 4; ++m) { const int row = row0 + ai * HALF + m * 16; bf16_t* rowp = O + (size_t)row * 1024 + hcol + cw;
#pragma unroll
                    for (int bj = 0; bj < 2; ++bj) { f32x4 v0 = A(ai, bj, m, 0), v1 = A(ai, bj, m, 1);
                        if (gate) {
#pragma unroll
                            for (int j = 0; j < 4; ++j) { v0[j] = v0[j] * sigmoidf_(v0[j]); v1[j] = v1[j] * sigmoidf_(v1[j]); } }
                        st_out((u32x4*)(rowp + bj * HALF), (u32x4)(pack8(v0, v1))); } }
        } else if (pn < 20) {
            const int t = pn - 16, i0 = 8 * fq;
#pragma unroll
            for (int ai = 0; ai < 2; ++ai)
#pragma unroll
                for (int m = 0; m < 4; ++m) { const int row = row0 + ai * HALF + m * 16;
                    const f32x4 c0 = *(const f32x4*)(cosa + (size_t)row * 32 + i0), c1 = *(const f32x4*)(cosa + (size_t)row * 32 + i0 + 4);
                    const f32x4 s0 = *(const f32x4*)(sina + (size_t)row * 32 + i0), s1 = *(const f32x4*)(sina + (size_t)row * 32 + i0 + 4);
                    const f32x4 a0 = A(ai, 0, m, 0), a1 = A(ai, 0, m, 1), b0 = A(ai, 1, m, 0), b1 = A(ai, 1, m, 1);
                    const f32x4 o10 = (a0 * c0 - b0 * s0) * 0.125f, o11 = (a1 * c1 - b1 * s1) * 0.125f, o20 = (a0 * s0 + b0 * c0) * 0.125f, o21 = (a1 * s1 + b1 * c1) * 0.125f;
                    bf16_t* rowp = AQ + (size_t)row * 1024 + t * 256 + wc * 64 + i0;
                    st_out((u32x4*)(rowp), (u32x4)(pack8(o10, o11))); st_out((u32x4*)(rowp + 32), (u32x4)(pack8(o20, o21))); }
        } else {
            const int i0 = 8 * fq;
            if (wc < 2) {
#pragma unroll
                for (int ai = 0; ai < 2; ++ai)
#pragma unroll
                    for (int m = 0; m < 4; ++m) { const int row = row0 + ai * HALF + m * 16;
                        const f32x4 c0 = *(const f32x4*)(cosa + (size_t)row * 32 + i0), c1 = *(const f32x4*)(cosa + (size_t)row * 32 + i0 + 4);
                        const f32x4 s0 = *(const f32x4*)(sina + (size_t)row * 32 + i0), s1 = *(const f32x4*)(sina + (size_t)row * 32 + i0 + 4);
                        const f32x4 a0 = A(ai, 0, m, 0), a1 = A(ai, 0, m, 1), b0 = A(ai, 1, m, 0), b1 = A(ai, 1, m, 1);
                        const f32x4 o10 = a0 * c0 - b0 * s0, o11 = a1 * c1 - b1 * s1, o20 = a0 * s0 + b0 * c0, o21 = a1 * s1 + b1 * c1;
                        bf16_t* rowp = AK + (size_t)row * 128 + wc * 64 + i0;
                        st_out((u32x4*)(rowp), (u32x4)(pack8(o10, o11))); st_out((u32x4*)(rowp + 32), (u32x4)(pack8(o20, o21))); }
            } else {
#pragma unroll
                for (int ai = 0; ai < 2; ++ai)
#pragma unroll
                    for (int m = 0; m < 4; ++m) { const int row = row0 + ai * HALF + m * 16; bf16_t* rowp = AV + (size_t)row * 128 + (wc - 2) * 32 + i0;
                        st_out((u32x4*)(rowp), (u32x4)(pack8(A(ai, 0, m, 0), A(ai, 0, m, 1)))); st_out((u32x4*)(rowp + 64), (u32x4)(pack8(A(ai, 1, m, 0), A(ai, 1, m, 1)))); }
            }
        }
    }
};
typedef EpiInProjT<false> EpiInProj;
template <bool ADD> struct EpiResid {
    static constexpr bool PERM = false, AFTER_DRAIN = false;
    const float* base; float* Y; float alpha;
    __device__ __forceinline__ void operator()(const f32x4 (&acc)[2][2][4][2], const Unit& u, int wr, int wc, int fr, int fq) const {
        const int row0 = u.pm * BM + wr * 64 + fr, col0 = u.pn * BM + wc * 32 + 4 * fq;
#pragma unroll
        for (int ai = 0; ai < 2; ++ai)
#pragma unroll
            for (int m = 0; m < 4; ++m) { const size_t off = (size_t)(row0 + ai * HALF + m * 16) * 2048 + col0;
#pragma unroll
                for (int bj = 0; bj < 2; ++bj)
#pragma unroll
                    for (int n = 0; n < 2; ++n) { const size_t o = off + bj * HALF + n * 16; f32x4 v = acc[ai][bj][m][n] + *(const f32x4*)(base + o) * alpha;
                        if (ADD) v = v + *(const f32x4*)(Y + o); st_out((f32x4*)(Y + o), (f32x4)(v)); } }
    }
};
struct EpiUp {
    static constexpr bool PERM = true, AFTER_DRAIN = false;
    bf16_t* H; bf16_t* SG; const float* bgate;
    __device__ __forceinline__ void operator()(const f32x4 (&acc)[2][2][4][2], const Unit& u, int wr, int wc, int fr, int fq) const {
        const int row0 = u.pm * BM + wr * 64 + fr, cw = wc * 32 + 8 * fq;
        if (u.pn < 44) {
#pragma unroll
            for (int ai = 0; ai < 2; ++ai)
#pragma unroll
                for (int m = 0; m < 4; ++m) { bf16_t* rowp = H + (size_t)(row0 + ai * HALF + m * 16) * 11264 + u.pn * 256 + cw;
#pragma unroll
                    for (int bj = 0; bj < 2; ++bj) st_out((u32x4*)(rowp + bj * HALF), (u32x4)(pack8(acc[ai][bj][m][0], acc[ai][bj][m][1]))); }
        } else {
            const int colg = (u.pn - 44) * 256 + cw;
            f32x4 bv[2][2];
#pragma unroll
            for (int bj = 0; bj < 2; ++bj)
#pragma unroll
                for (int n = 0; n < 2; ++n) bv[bj][n] = *(const f32x4*)(bgate + colg + bj * HALF + 4 * n);
#pragma unroll
            for (int ai = 0; ai < 2; ++ai)
#pragma unroll
                for (int m = 0; m < 4; ++m) { bf16_t* rowp = SG + (size_t)(row0 + ai * HALF + m * 16) * 2048 + colg;
#pragma unroll
                    for (int bj = 0; bj < 2; ++bj) { f32x4 v0 = acc[ai][bj][m][0] + bv[bj][0], v1 = acc[ai][bj][m][1] + bv[bj][1];
#pragma unroll
                        for (int j = 0; j < 4; ++j) { v0[j] = sigmoidf_(v0[j]); v1[j] = sigmoidf_(v1[j]); }
                        st_out((u32x4*)(rowp + bj * HALF), (u32x4)(pack8(v0, v1))); } }
        }
    }
};

__device__ __forceinline__ float ror1f(float x) { return __builtin_bit_cast(float, __builtin_amdgcn_update_dpp(0, __builtin_bit_cast(int, x), 0x121, 0xf, 0xf, false)); }
__device__ __forceinline__ float ror2f(float x) { return __builtin_bit_cast(float, __builtin_amdgcn_update_dpp(0, __builtin_bit_cast(int, x), 0x122, 0xf, 0xf, false)); }
template <bool LNFIX> struct EpiUpConvT {
    static constexpr bool PERM = true, AFTER_DRAIN = false;
    bf16_t* ACT; bf16_t* HALO; bf16_t* SG; const float* bgate; const float* cw; const float* cb; const float *stats, *c1, *c2;
    __device__ __forceinline__ void operator()(f32x4 (&acc)[2][2][4][2], const Unit& u, int wr, int wc, int fr, int fq) const {
        int cwp = wc * 32 + 8 * fq; asm volatile("" : "+v"(cwp));
        const int row0 = u.pm * BM + wr * 64 + fr;
        if (LNFIX) {
            const int cwq = cwp;
            f32x4 c1v[2][2], c2v[2][2];
#pragma unroll
            for (int bj = 0; bj < 2; ++bj)
#pragma unroll
                for (int n = 0; n < 2; ++n) { c1v[bj][n] = *(const f32x4*)(c1 + u.pn * 256 + bj * HALF + cwq + 4 * n); c2v[bj][n] = *(const f32x4*)(c2 + u.pn * 256 + bj * HALF + cwq + 4 * n); }
#pragma unroll
            for (int i = 0; i < 8; ++i) { const f32x2 st = *(const f32x2*)(stats + 2 * (size_t)(row0 + (i >> 2) * HALF + (i & 3) * 16));
#pragma unroll
                for (int bj = 0; bj < 2; ++bj)
#pragma unroll
                    for (int n = 0; n < 2; ++n) acc[i >> 2][bj][i & 3][n] = (acc[i >> 2][bj][i & 3][n] - c1v[bj][n] * st.x) * st.y + c2v[bj][n]; } }
        auto A = [&](int ai, int bj, int m, int n) -> f32x4 { return acc[ai][bj][m][n]; };
        if (u.pn < 44) {
            f32x4 wg0_[2], wg1_[2], wg2_[2], bg_[2], wu0_[2], wu1_[2], wu2_[2], bu_[2];
#pragma unroll
            for (int n = 0; n < 2; ++n) { const int chg = 128 * u.pn + cwp + 4 * n, chu = 5632 + chg;
                wg0_[n] = *(const f32x4*)(cw + chg); wg1_[n] = *(const f32x4*)(cw + 11264 + chg); wg2_[n] = *(const f32x4*)(cw + 2 * 11264 + chg); bg_[n] = *(const f32x4*)(cb + chg);
                wu0_[n] = *(const f32x4*)(cw + chu); wu1_[n] = *(const f32x4*)(cw + 11264 + chu); wu2_[n] = *(const f32x4*)(cw + 2 * 11264 + chu); bu_[n] = *(const f32x4*)(cb + chu); }
#pragma unroll
            for (int ai = 0; ai < 2; ++ai) {
                const int span = u.pm * 4 + ai * 2 + wr;
#pragma unroll
                for (int m = 0; m < 4; ++m) {
                    const int row = row0 + ai * HALF + m * 16;
                    u32x4 w, rg, ru;
#pragma unroll
                    for (int n = 0; n < 2; ++n) {
                        const f32x4 wg0 = wg0_[n], wg1 = wg1_[n], wg2 = wg2_[n], bg = bg_[n], wu0 = wu0_[n], wu1 = wu1_[n], wu2 = wu2_[n], bu = bu_[n];
                        const f32x4 cg = A(ai, 0, m, n), cu = A(ai, 1, m, n);
                        const f32x4 pg = A(ai, 0, m ? m - 1 : 0, n), pu = A(ai, 1, m ? m - 1 : 0, n);
                        f32x4 o;
#pragma unroll
                        for (int j = 0; j < 4; ++j) {
                            const float g1 = ror1f(fr == 15 ? pg[j] : cg[j]), g2 = ror2f(fr >= 14 ? pg[j] : cg[j]);
                            const float u1 = ror1f(fr == 15 ? pu[j] : cu[j]), u2 = ror2f(fr >= 14 ? pu[j] : cu[j]);
                            const float ga = bg[j] + wg0[j] * g2 + wg1[j] * g1 + wg2[j] * cg[j], ua = bu[j] + wu0[j] * u2 + wu1[j] * u1 + wu2[j] * cu[j];
                            o[j] = ga * sigmoidf_(ga) * ua; }
                        if (n == 0) { w.x = cvt_pk_bf16(o[0], o[1]); w.y = cvt_pk_bf16(o[2], o[3]); rg.x = cvt_pk_bf16(cg[0], cg[1]); rg.y = cvt_pk_bf16(cg[2], cg[3]); ru.x = cvt_pk_bf16(cu[0], cu[1]); ru.y = cvt_pk_bf16(cu[2], cu[3]); }
                        else { w.z = cvt_pk_bf16(o[0], o[1]); w.w = cvt_pk_bf16(o[2], o[3]); rg.z = cvt_pk_bf16(cg[0], cg[1]); rg.w = cvt_pk_bf16(cg[2], cg[3]); ru.z = cvt_pk_bf16(cu[0], cu[1]); ru.w = cvt_pk_bf16(cu[2], cu[3]); }
                    }
                    if (m > 0 || fr >= 2) st_out((u32x4*)(ACT + tiled_off(row, 128 * u.pn + cwp, 5632)), (u32x4)(w));
                    if ((m == 0 && fr < 2) || (m == 3 && fr >= 14)) { int frq = fr; asm volatile("" : "+v"(frq)); const int slot = (m == 0) ? frq : frq - 12;
                        bf16_t* hp = HALO + ((size_t)(span * 4 + slot)) * 11264 + 256 * u.pn + cwp;
                        st_out((u32x4*)(hp), (u32x4)(rg)); st_out((u32x4*)(hp + HALF), (u32x4)(ru)); }
                }
            }
        } else {
            const int colg = (u.pn - 44) * 256 + cwp;
            f32x4 bv[2][2];
#pragma unroll
            for (int bj = 0; bj < 2; ++bj)
#pragma unroll
                for (int n = 0; n < 2; ++n) bv[bj][n] = *(const f32x4*)(bgate + colg + bj * HALF + 4 * n);
#pragma unroll
            for (int ai = 0; ai < 2; ++ai)
#pragma unroll
                for (int m = 0; m < 4; ++m) { bf16_t* rowp = SG + (size_t)(row0 + ai * HALF + m * 16) * 2048 + colg;
#pragma unroll
                    for (int bj = 0; bj < 2; ++bj) { f32x4 v0 = A(ai, bj, m, 0) + bv[bj][0], v1 = A(ai, bj, m, 1) + bv[bj][1];
#pragma unroll
                        for (int j = 0; j < 4; ++j) { v0[j] = sigmoidf_(v0[j]); v1[j] = sigmoidf_(v1[j]); }
                        st_out((u32x4*)(rowp + bj * HALF), (u32x4)(pack8(v0, v1))); } }
        }
    }
};

typedef EpiUpConvT<false> EpiUpConv;
struct EpiPlain {
    static constexpr bool PERM = true, AFTER_DRAIN = false;
    bf16_t* O;
    __device__ __forceinline__ void operator()(const f32x4 (&acc)[2][2][4][2], const Unit& u, int wr, int wc, int fr, int fq) const {
        const int row0 = u.pm * BM + wr * 64 + fr, cwp = u.pn * BM + wc * 32 + 8 * fq;
#pragma unroll
        for (int ai = 0; ai < 2; ++ai)
#pragma unroll
            for (int m = 0; m < 4; ++m) { bf16_t* rowp = O + (size_t)(row0 + ai * HALF + m * 16) * 2048 + cwp;
#pragma unroll
                for (int bj = 0; bj < 2; ++bj) st_out((u32x4*)(rowp + bj * HALF), (u32x4)(pack8(acc[ai][bj][m][0], acc[ai][bj][m][1]))); }
    }
};
struct EpiDown {
    static constexpr bool PERM = false, AFTER_DRAIN = false;
    const float* base; float* Y; const bf16_t* PP; const bf16_t* SG; float alpha;
    __device__ __forceinline__ void operator()(const f32x4 (&acc)[2][2][4][2], const Unit& u, int wr, int wc, int fr, int fq) const {
        const int row0 = u.pm * BM + wr * 64 + fr, col0 = u.pn * BM + wc * 32 + 4 * fq;
#pragma unroll
        for (int ai = 0; ai < 2; ++ai)
#pragma unroll
            for (int m = 0; m < 4; ++m) { const size_t off = (size_t)(row0 + ai * HALF + m * 16) * 2048 + col0;
#pragma unroll
                for (int bj = 0; bj < 2; ++bj)
#pragma unroll
                    for (int n = 0; n < 2; ++n) { const size_t o = off + bj * HALF + n * 16; const u32x2 pp = *(const u32x2*)(PP + o), sg = *(const u32x2*)(SG + o);
                        f32x4 pl; pl[0] = __uint_as_float(pp.x << 16) * __uint_as_float(sg.x << 16); pl[1] = __uint_as_float(pp.x & 0xffff0000u) * __uint_as_float(sg.x & 0xffff0000u);
                        pl[2] = __uint_as_float(pp.y << 16) * __uint_as_float(sg.y << 16); pl[3] = __uint_as_float(pp.y & 0xffff0000u) * __uint_as_float(sg.y & 0xffff0000u);
                        st_out((f32x4*)(Y + o), (f32x4)(acc[ai][bj][m][n] + *(const f32x4*)(base + o) * alpha + pl)); } }
    }
};

template <bool PLE_> struct EpiResidLN {
    static constexpr bool PERM = false, AFTER_DRAIN = false;
    float* Y; float* Yout; const float* stats; const float* g; const float* b; const bf16_t* PP; const bf16_t* SG; float alpha;
    __device__ __forceinline__ void operator()(const f32x4 (&acc)[2][2][4][2], const Unit& u, int wr, int wc, int fr, int fq) const {
        const int row0 = u.pm * BM + wr * 64 + fr, col0 = u.pn * BM + wc * 32 + 4 * fq;
        f32x4 g4[2][2], b4[2][2];
#pragma unroll
        for (int bj = 0; bj < 2; ++bj)
#pragma unroll
            for (int n = 0; n < 2; ++n) { g4[bj][n] = *(const f32x4*)(g + col0 + bj * HALF + n * 16) * alpha; b4[bj][n] = *(const f32x4*)(b + col0 + bj * HALF + n * 16) * alpha; }
        f32x4 cy[2][2], ny[2][2]; f32x2 cst, nst;
        { const size_t off = (size_t)row0 * 2048 + col0; cst = *(const f32x2*)(stats + 2 * (size_t)row0);
#pragma unroll
          for (int bj = 0; bj < 2; ++bj)
#pragma unroll
              for (int n = 0; n < 2; ++n) cy[bj][n] = *(const f32x4*)(Y + off + bj * HALF + n * 16); }
#pragma unroll
        for (int i = 0; i < 8; ++i) { const int ai = i >> 2, m = i & 3; const size_t off = (size_t)(row0 + ai * HALF + m * 16) * 2048 + col0;
            if (i < 7) { const int rn = row0 + ((i + 1) >> 2) * HALF + ((i + 1) & 3) * 16; const size_t offn = (size_t)rn * 2048 + col0; nst = *(const f32x2*)(stats + 2 * (size_t)rn);
#pragma unroll
                for (int bj = 0; bj < 2; ++bj)
#pragma unroll
                    for (int n = 0; n < 2; ++n) ny[bj][n] = *(const f32x4*)(Y + offn + bj * HALF + n * 16); }
#pragma unroll
            for (int bj = 0; bj < 2; ++bj)
#pragma unroll
                for (int n = 0; n < 2; ++n) { const size_t o = off + bj * HALF + n * 16;
                    f32x4 v = acc[ai][bj][m][n] + (cy[bj][n] - cst.x) * cst.y * g4[bj][n] + b4[bj][n];
                    if (PLE_) { const u32x2 pp = *(const u32x2*)(PP + o), sg = *(const u32x2*)(SG + o);
                        v[0] += __uint_as_float(pp.x << 16) * __uint_as_float(sg.x << 16); v[1] += __uint_as_float(pp.x & 0xffff0000u) * __uint_as_float(sg.x & 0xffff0000u);
                        v[2] += __uint_as_float(pp.y << 16) * __uint_as_float(sg.y << 16); v[3] += __uint_as_float(pp.y & 0xffff0000u) * __uint_as_float(sg.y & 0xffff0000u); }
                    st_out((f32x4*)(Yout + o), (f32x4)(v)); }
#pragma unroll
            for (int bj = 0; bj < 2; ++bj)
#pragma unroll
                for (int n = 0; n < 2; ++n) cy[bj][n] = ny[bj][n];
            cst = nst; }
    }
};

template <bool LNBASE, bool PLE_, bool STATS> struct EpiRes2 {
    static constexpr bool PERM = true, AFTER_DRAIN = false;
    const float* base; float* Y; bf16_t* YB; float* pstat; const float* stats; const float* g; const float* b; const bf16_t* PP; const bf16_t* SG; float alpha;
    __device__ __forceinline__ void operator()(const f32x4 (&acc)[2][2][4][2], const Unit& u, int wr, int wc, int fr, int fq) const {
        const int row0 = u.pm * BM + wr * 64 + fr, col0 = u.pn * BM + wc * 32 + 8 * fq, lane = fq * 16 + fr;
        const float* src = LNBASE ? (const float*)Y : base;
        f32x4 g4[2][2], b4[2][2];
        if (LNBASE) {
#pragma unroll
            for (int bj = 0; bj < 2; ++bj)
#pragma unroll
                for (int n = 0; n < 2; ++n) { g4[bj][n] = *(const f32x4*)(g + col0 + bj * HALF + 4 * n) * alpha; b4[bj][n] = *(const f32x4*)(b + col0 + bj * HALF + 4 * n) * alpha; } }
        f32x4 cy[2][2], ny[2][2]; f32x2 cst = (f32x2){0.f, 1.f}, nst = (f32x2){0.f, 1.f};
        { const size_t off = (size_t)row0 * 2048 + col0; if (LNBASE) cst = *(const f32x2*)(stats + 2 * (size_t)row0);
#pragma unroll
          for (int bj = 0; bj < 2; ++bj)
#pragma unroll
              for (int n = 0; n < 2; ++n) cy[bj][n] = *(const f32x4*)(src + off + bj * HALF + 4 * n); }
#pragma unroll
        for (int i = 0; i < 8; ++i) { const int ai = i >> 2, m = i & 3, row = row0 + ai * HALF + m * 16; const size_t off = (size_t)row * 2048 + col0;
            if (i < 7) { const int rn = row0 + ((i + 1) >> 2) * HALF + ((i + 1) & 3) * 16; const size_t offn = (size_t)rn * 2048 + col0; if (LNBASE) nst = *(const f32x2*)(stats + 2 * (size_t)rn);
#pragma unroll
                for (int bj = 0; bj < 2; ++bj)
#pragma unroll
                    for (int n = 0; n < 2; ++n) ny[bj][n] = *(const f32x4*)(src + offn + bj * HALF + 4 * n); }
            float s1 = 0.f, s2 = 0.f;
#pragma unroll
            for (int bj = 0; bj < 2; ++bj) { f32x4 v[2];
#pragma unroll
                for (int n = 0; n < 2; ++n) v[n] = LNBASE ? acc[ai][bj][m][n] + (cy[bj][n] - cst.x) * cst.y * g4[bj][n] + b4[bj][n] : acc[ai][bj][m][n] + cy[bj][n] * alpha;
                if (PLE_) { const u32x4 pp = *(const u32x4*)(PP + off + bj * HALF), sg = *(const u32x4*)(SG + off + bj * HALF);
                    v[0][0] += __uint_as_float(pp.x << 16) * __uint_as_float(sg.x << 16); v[0][1] += __uint_as_float(pp.x & 0xffff0000u) * __uint_as_float(sg.x & 0xffff0000u);
                    v[0][2] += __uint_as_float(pp.y << 16) * __uint_as_float(sg.y << 16); v[0][3] += __uint_as_float(pp.y & 0xffff0000u) * __uint_as_float(sg.y & 0xffff0000u);
                    v[1][0] += __uint_as_float(pp.z << 16) * __uint_as_float(sg.z << 16); v[1][1] += __uint_as_float(pp.z & 0xffff0000u) * __uint_as_float(sg.z & 0xffff0000u);
                    v[1][2] += __uint_as_float(pp.w << 16) * __uint_as_float(sg.w << 16); v[1][3] += __uint_as_float(pp.w & 0xffff0000u) * __uint_as_float(sg.w & 0xffff0000u); }
                st_out((f32x4*)(Y + off + bj * HALF), (f32x4)(v[0])); st_out((f32x4*)(Y + off + bj * HALF + 4), (f32x4)(v[1]));
                if (STATS) { st_out((u32x4*)(YB + off + bj * HALF), (u32x4)(pack8(v[0], v[1])));
#pragma unroll
                    for (int n = 0; n < 2; ++n) { s1 += (v[n][0] + v[n][1]) + (v[n][2] + v[n][3]); s2 += (v[n][0] * v[n][0] + v[n][1] * v[n][1]) + (v[n][2] * v[n][2] + v[n][3] * v[n][3]); } } }
            if (STATS) {
                s1 += __builtin_bit_cast(float, __builtin_amdgcn_ds_bpermute((lane ^ 16) << 2, __builtin_bit_cast(int, s1))); s2 += __builtin_bit_cast(float, __builtin_amdgcn_ds_bpermute((lane ^ 16) << 2, __builtin_bit_cast(int, s2)));
                s1 += __builtin_bit_cast(float, __builtin_amdgcn_ds_bpermute((lane ^ 32) << 2, __builtin_bit_cast(int, s1))); s2 += __builtin_bit_cast(float, __builtin_amdgcn_ds_bpermute((lane ^ 32) << 2, __builtin_bit_cast(int, s2)));
                if (fq == 0) *(f32x2*)(pstat + ((size_t)row * 32 + u.pn * 4 + wc) * 2) = (f32x2){s1, s2}; }
#pragma unroll
            for (int bj = 0; bj < 2; ++bj)
#pragma unroll
                for (int n = 0; n < 2; ++n) cy[bj][n] = ny[bj][n];
            cst = nst; }
    }
};

typedef _Float16 h16x8 __attribute__((ext_vector_type(8)));
typedef float f32x8 __attribute__((ext_vector_type(8)));
template <bool LNBASE, bool PLE_> struct EpiRes3 {
    static constexpr bool PERM = true, AFTER_DRAIN = false;
    const float* base; float* Y; bf16_t* YB; _Float16* YH; float* pstat; const float* stats; const float* g; const float* b; const bf16_t* PP; const bf16_t* SG; float alpha;
    __device__ __forceinline__ void operator()(const f32x4 (&acc)[2][2][4][2], const Unit& u, int wr, int wc, int fr, int fq) const {
        const int row0 = u.pm * BM + wr * 64 + fr, col0 = u.pn * BM + wc * 32 + 8 * fq, lane = fq * 16 + fr;
        f32x4 g4[2][2], b4[2][2];
        if (LNBASE) {
#pragma unroll
            for (int bj = 0; bj < 2; ++bj)
#pragma unroll
                for (int n = 0; n < 2; ++n) { g4[bj][n] = *(const f32x4*)(g + col0 + bj * HALF + 4 * n) * alpha; b4[bj][n] = *(const f32x4*)(b + col0 + bj * HALF + 4 * n) * alpha; } }
        u32x4 cyb[2], nyb[2]; f32x4 cyf[2][2], nyf[2][2]; f32x2 cst = (f32x2){0.f, 1.f}, nst = (f32x2){0.f, 1.f};
        { const size_t off = (size_t)row0 * 2048 + col0;
          if (LNBASE) { cst = *(const f32x2*)(stats + 2 * (size_t)row0); cyb[0] = *(const u32x4*)(YH + off); cyb[1] = *(const u32x4*)(YH + off + HALF); }
          else {
#pragma unroll
              for (int bj = 0; bj < 2; ++bj)
#pragma unroll
                  for (int n = 0; n < 2; ++n) cyf[bj][n] = *(const f32x4*)(base + off + bj * HALF + 4 * n); } }
#pragma unroll
        for (int i = 0; i < 8; ++i) { const int ai = i >> 2, m = i & 3, row = row0 + ai * HALF + m * 16; const size_t off = (size_t)row * 2048 + col0;
            if (i < 7) { const int rn = row0 + ((i + 1) >> 2) * HALF + ((i + 1) & 3) * 16; const size_t offn = (size_t)rn * 2048 + col0;
                if (LNBASE) { nst = *(const f32x2*)(stats + 2 * (size_t)rn); nyb[0] = *(const u32x4*)(YH + offn); nyb[1] = *(const u32x4*)(YH + offn + HALF); }
                else {
#pragma unroll
                    for (int bj = 0; bj < 2; ++bj)
#pragma unroll
                        for (int n = 0; n < 2; ++n) nyf[bj][n] = *(const f32x4*)(base + offn + bj * HALF + 4 * n); } }
            float s1 = 0.f, s2 = 0.f;
#pragma unroll
            for (int bj = 0; bj < 2; ++bj) { f32x4 v[2];
                if (LNBASE) { const f32x8 yf = __builtin_convertvector(__builtin_bit_cast(h16x8, cyb[bj]), f32x8);
                    const f32x4 y0 = (f32x4){yf[0], yf[1], yf[2], yf[3]}, y1 = (f32x4){yf[4], yf[5], yf[6], yf[7]};
                    v[0] = acc[ai][bj][m][0] + (y0 - cst.x) * cst.y * g4[bj][0] + b4[bj][0]; v[1] = acc[ai][bj][m][1] + (y1 - cst.x) * cst.y * g4[bj][1] + b4[bj][1]; }
                else { v[0] = acc[ai][bj][m][0] + cyf[bj][0] * alpha; v[1] = acc[ai][bj][m][1] + cyf[bj][1] * alpha; }
                if (PLE_) { const u32x4 pp = *(const u32x4*)(PP + off + bj * HALF), sg = *(const u32x4*)(SG + off + bj * HALF);
                    v[0][0] += __uint_as_float(pp.x << 16) * __uint_as_float(sg.x << 16); v[0][1] += __uint_as_float(pp.x & 0xffff0000u) * __uint_as_float(sg.x & 0xffff0000u);
                    v[0][2] += __uint_as_float(pp.y << 16) * __uint_as_float(sg.y << 16); v[0][3] += __uint_as_float(pp.y & 0xffff0000u) * __uint_as_float(sg.y & 0xffff0000u);
                    v[1][0] += __uint_as_float(pp.z << 16) * __uint_as_float(sg.z << 16); v[1][1] += __uint_as_float(pp.z & 0xffff0000u) * __uint_as_float(sg.z & 0xffff0000u);
                    v[1][2] += __uint_as_float(pp.w << 16) * __uint_as_float(sg.w << 16); v[1][3] += __uint_as_float(pp.w & 0xffff0000u) * __uint_as_float(sg.w & 0xffff0000u); }
                if (Y) { st_out((f32x4*)(Y + off + bj * HALF), (f32x4)(v[0])); st_out((f32x4*)(Y + off + bj * HALF + 4), (f32x4)(v[1])); }
                const u32x4 pk = pack8(v[0], v[1]);
                st_out((u32x4*)(YB + off + bj * HALF), (u32x4)(pk));
                { const f32x8 vf = (f32x8){v[0][0], v[0][1], v[0][2], v[0][3], v[1][0], v[1][1], v[1][2], v[1][3]};
                  st_out((u32x4*)(YH + off + bj * HALF), __builtin_bit_cast(u32x4, __builtin_convertvector(vf, h16x8))); }
                const f32x4 r0 = (f32x4){__uint_as_float(pk.x << 16), __uint_as_float(pk.x & 0xffff0000u), __uint_as_float(pk.y << 16), __uint_as_float(pk.y & 0xffff0000u)};
                const f32x4 r1 = (f32x4){__uint_as_float(pk.z << 16), __uint_as_float(pk.z & 0xffff0000u), __uint_as_float(pk.w << 16), __uint_as_float(pk.w & 0xffff0000u)};
                s1 += ((r0[0] + r0[1]) + (r0[2] + r0[3])) + ((r1[0] + r1[1]) + (r1[2] + r1[3]));
                s2 += ((r0[0] * r0[0] + r0[1] * r0[1]) + (r0[2] * r0[2] + r0[3] * r0[3])) + ((r1[0] * r1[0] + r1[1] * r1[1]) + (r1[2] * r1[2] + r1[3] * r1[3])); }
            s1 += __builtin_bit_cast(float, __builtin_amdgcn_ds_bpermute((lane ^ 16) << 2, __builtin_bit_cast(int, s1))); s2 += __builtin_bit_cast(float, __builtin_amdgcn_ds_bpermute((lane ^ 16) << 2, __builtin_bit_cast(int, s2)));
            s1 += __builtin_bit_cast(float, __builtin_amdgcn_ds_bpermute((lane ^ 32) << 2, __builtin_bit_cast(int, s1))); s2 += __builtin_bit_cast(float, __builtin_amdgcn_ds_bpermute((lane ^ 32) << 2, __builtin_bit_cast(int, s2)));
            if (fq == 0) *(f32x2*)(pstat + ((size_t)row * 32 + u.pn * 4 + wc) * 2) = (f32x2){s1, s2};
            cyb[0] = nyb[0]; cyb[1] = nyb[1];
#pragma unroll
            for (int bj = 0; bj < 2; ++bj)
#pragma unroll
                for (int n = 0; n < 2; ++n) cyf[bj][n] = nyf[bj][n];
            cst = nst; }
    }
};
struct EpiPle {
    static constexpr bool PERM = false, AFTER_DRAIN = false;
    const bf16_t* SG; float* Y;
    __device__ __forceinline__ void operator()(const f32x4 (&acc)[2][2][4][2], const Unit& u, int wr, int wc, int fr, int fq) const {
        const int row0 = u.pm * BM + wr * 64 + fr, col0 = u.pn * BM + wc * 32 + 4 * fq;
#pragma unroll
        for (int ai = 0; ai < 2; ++ai)
#pragma unroll
            for (int m = 0; m < 4; ++m) { const size_t off = (size_t)(row0 + ai * HALF + m * 16) * 2048 + col0;
#pragma unroll
                for (int bj = 0; bj < 2; ++bj)
#pragma unroll
                    for (int n = 0; n < 2; ++n) { const size_t o = off + bj * HALF + n * 16; const u32x2 sg = *(const u32x2*)(SG + o);
                        f32x4 g; g[0] = __uint_as_float(sg.x << 16); g[1] = __uint_as_float(sg.x & 0xffff0000u); g[2] = __uint_as_float(sg.y << 16); g[3] = __uint_as_float(sg.y & 0xffff0000u);
                        st_out((f32x4*)(Y + o), (f32x4)(acc[ai][bj][m][n] * g)); } }
    }
};
template <class Epi, class Sched, bool ALIGN_EPI = false, bool SP2 = false>
__device__ __forceinline__ void gemm_phase(PG8_LAS unsigned char* lds, const Gemm g, const Sched& S, const Epi& E, const int wid_in) {
    int lane_; asm volatile("v_mbcnt_lo_u32_b32 %0, -1, 0\n\tv_mbcnt_hi_u32_b32 %0, -1, %0" : "=v"(lane_)); const int wid = wid_in, lane = lane_, tid = wid * 64 + lane, wr = wid >> 2, wc = wid & 3, fr = lane & 15, fq = lane >> 4;
    const int K = g.K, nt = K / BK, lda = g.tiledA ? BK : (g.lda ? g.lda : K), ldb = g.tiledB ? BK : (g.ldb ? g.ldb : K);
    unsigned voffA[2], voffB[2];
#pragma unroll
    for (int i = 0; i < 2; ++i) { int R, C; stage_rc(tid * 16 + i * 8192, R, C); const int Rb = Epi::PERM ? ((R & ~31) + perm32(R & 31)) : R;
        voffA[i] = (unsigned)(R * lda + C) * 2u; voffB[i] = (unsigned)(Rb * ldb + C) * 2u; }
    const size_t kstepA = g.tiledA ? (size_t)BM * BK * 2 : (size_t)(BK * 2), kstepB = g.tiledB ? (size_t)BM * BK * 2 : (size_t)(BK * 2);
    const size_t hstepA = (size_t)HALF * lda * 2, hstepB = (size_t)HALF * ldb * 2;
    const size_t tstepA = g.tiledA ? (size_t)BM * K * 2 : 2 * hstepA, tstepB = g.tiledB ? (size_t)BM * K * 2 : 2 * hstepB;
    const unsigned ldsw = (unsigned)wid * 1024u;
    const int aoff = lds_byte(wr * 64 + fr, fq * 8), boff = lds_byte(wc * 32 + fr, fq * 8);
#define PG8_SA(b, h) (((b) * 2 + (h)) * HTB)
#define PG8_SB(b, h) ((4 + (b) * 2 + (h)) * HTB)
#define PG8_STAGE(bufoff, gbase, voff) do { _Pragma("unroll") for (int _i = 0; _i < 2; ++_i) \
        __builtin_amdgcn_global_load_lds((const unsigned*)((const char*)(gbase) + (voff)[_i]), (PG8_LAS unsigned*)(lds + (bufoff) + ldsw + _i * 8192), 16, 0, 0); } while (0)
#define PG8_LDA(dst, b, h) do { _Pragma("unroll") for (int m = 0; m < 4; ++m) _Pragma("unroll") for (int k = 0; k < 2; ++k) dst[m][k] = *(const PG8_LAS bf16x8*)(lds + PG8_SA(b, h) + aoff + m * 2048 + k * 1024); } while (0)
#define PG8_LDB(dst, b, h) do { _Pragma("unroll") for (int n = 0; n < 2; ++n) _Pragma("unroll") for (int k = 0; k < 2; ++k) dst[n][k] = *(const PG8_LAS bf16x8*)(lds + PG8_SB(b, h) + boff + n * 2048 + k * 1024); } while (0)
#define PG8_MMA(ai, bj, At, Bt) do { __builtin_amdgcn_s_setprio(1); _Pragma("unroll") for (int m = 0; m < 4; ++m) _Pragma("unroll") for (int n = 0; n < 2; ++n) _Pragma("unroll") for (int k = 0; k < 2; ++k) \
        acc[ai][bj][m][n] = __builtin_amdgcn_mfma_f32_16x16x32_bf16(Bt[n][k], At[m][k], acc[ai][bj][m][n], 0, 0, 0); __builtin_amdgcn_s_setprio(0); } while (0)
#define PG8_WAIT_V(n) asm volatile("s_waitcnt vmcnt(" #n ")" ::: "memory")
#define PG8_WAIT_L(n) asm volatile("s_waitcnt lgkmcnt(" #n ")" ::: "memory")
#define PG8_BAR __builtin_amdgcn_s_barrier()
#define PG8_SCHED __builtin_amdgcn_sched_barrier(0)
    Unit cur, nxt; int ui = 0;
    if (!S.next(0, cur)) return;
    f32x4 acc[2][2][4][2];
#pragma unroll
    for (int a = 0; a < 2; ++a)
#pragma unroll
        for (int b = 0; b < 2; ++b)
#pragma unroll
            for (int m = 0; m < 4; ++m)
#pragma unroll
                for (int n = 0; n < 2; ++n) acc[a][b][m][n] = (f32x4){0.f, 0.f, 0.f, 0.f};
    bf16x8 At[4][2], B0[2][2], B1[2][2];
    const char* cA = (const char*)g.A + (size_t)cur.pm * tstepA; const char* cB = (const char*)g.Bt + (size_t)cur.pn * tstepB;
    S.a_ready(cur);
    if constexpr (SP2) {
        PG8_STAGE(PG8_SB(0, 0), cB, voffB); PG8_STAGE(PG8_SB(0, 1), cB + hstepB, voffB); PG8_STAGE(PG8_SA(0, 0), cA, voffA); PG8_STAGE(PG8_SA(0, 1), cA + hstepA, voffA);
        if (wr == 1) PG8_BAR;
        PG8_WAIT_V(2); PG8_BAR;
        PG8_STAGE(PG8_SB(1, 0), cB + kstepB, voffB); PG8_STAGE(PG8_SA(1, 0), cA + kstepA, voffA); PG8_STAGE(PG8_SB(1, 1), cB + hstepB + kstepB, voffB);
        PG8_WAIT_V(6); PG8_BAR;
    } else {
        PG8_STAGE(PG8_SB(0, 0), cB, voffB); PG8_STAGE(PG8_SA(0, 0), cA, voffA); PG8_STAGE(PG8_SB(0, 1), cB + hstepB, voffB); PG8_STAGE(PG8_SA(0, 1), cA + hstepA, voffA);
        if (wr == 1) PG8_BAR;
        PG8_WAIT_V(4); PG8_BAR;
        PG8_STAGE(PG8_SB(1, 0), cB + kstepB, voffB); PG8_STAGE(PG8_SA(1, 0), cA + kstepA, voffA); PG8_STAGE(PG8_SB(1, 1), cB + hstepB + kstepB, voffB);
        PG8_WAIT_V(6); PG8_BAR;
    }
    for (;;) {
        const bool has_next = S.next(ui + 1, nxt);
        const char* nA = has_next ? (const char*)g.A + (size_t)nxt.pm * tstepA : cA; const char* nB = has_next ? (const char*)g.Bt + (size_t)nxt.pn * tstepB : cB;
        for (int t = 0; t < nt; t += 2) {
            const bool last = (t == nt - 2);
            const char* a1 = cA + (size_t)(t + 1) * kstepA;
            const char* a2 = last ? nA : cA + (size_t)(t + 2) * kstepA; const char* b2 = last ? nB : cB + (size_t)(t + 2) * kstepB;
            const char* a3 = a2 + kstepA; const char* b3 = b2 + kstepB;
            if (last && has_next) S.a_ready(nxt);
            if constexpr (SP2) {
            PG8_LDB(B0, 0, 0); PG8_LDB(B1, 0, 1); PG8_SCHED; PG8_LDA(At, 0, 0); PG8_STAGE(PG8_SA(1, 1), a1 + hstepA, voffA);
            PG8_WAIT_V(8); PG8_WAIT_L(0); PG8_BAR; PG8_MMA(0, 0, At, B0); PG8_MMA(0, 1, At, B1); PG8_BAR; PG8_SCHED;
            PG8_LDA(At, 0, 1); PG8_STAGE(PG8_SB(0, 0), b2, voffB); PG8_STAGE(PG8_SB(0, 1), b2 + hstepB, voffB); PG8_STAGE(PG8_SA(0, 0), a2, voffA);
            PG8_WAIT_V(8); PG8_WAIT_L(0); PG8_BAR; PG8_MMA(1, 0, At, B0); PG8_MMA(1, 1, At, B1); PG8_BAR; PG8_SCHED;
            PG8_LDB(B0, 1, 0); PG8_LDB(B1, 1, 1); PG8_SCHED; PG8_LDA(At, 1, 0); PG8_STAGE(PG8_SA(0, 1), a2 + hstepA, voffA);
            PG8_WAIT_V(8); PG8_WAIT_L(0); PG8_BAR; PG8_MMA(0, 0, At, B0); PG8_MMA(0, 1, At, B1); PG8_BAR; PG8_SCHED;
            PG8_LDA(At, 1, 1); PG8_STAGE(PG8_SB(1, 0), b3, voffB); PG8_STAGE(PG8_SB(1, 1), b3 + hstepB, voffB); PG8_STAGE(PG8_SA(1, 0), a3, voffA);
            PG8_WAIT_V(8); PG8_WAIT_L(0); PG8_BAR; PG8_MMA(1, 0, At, B0); PG8_MMA(1, 1, At, B1); PG8_BAR; PG8_SCHED;
            } else {
            PG8_LDB(B0, 0, 0); PG8_SCHED; PG8_LDA(At, 0, 0); PG8_STAGE(PG8_SA(1, 1), a1 + hstepA, voffA);
            PG8_WAIT_L(8); PG8_BAR; PG8_WAIT_L(0); PG8_MMA(0, 0, At, B0); PG8_BAR; PG8_SCHED;
            PG8_LDB(B1, 0, 1); PG8_STAGE(PG8_SB(0, 0), b2, voffB);
            PG8_BAR; PG8_WAIT_L(0); PG8_MMA(0, 1, At, B1); PG8_BAR;
            PG8_LDA(At, 0, 1); PG8_STAGE(PG8_SA(0, 0), a2, voffA);
            PG8_BAR; PG8_WAIT_L(0); PG8_MMA(1, 0, At, B0); PG8_BAR; PG8_SCHED;
            PG8_STAGE(PG8_SB(0, 1), b2 + hstepB, voffB);
            PG8_WAIT_V(6); PG8_BAR; PG8_MMA(1, 1, At, B1); PG8_BAR;
            PG8_LDB(B0, 1, 0); PG8_SCHED; PG8_LDA(At, 1, 0); PG8_STAGE(PG8_SA(0, 1), a2 + hstepA, voffA);
            PG8_WAIT_L(8); PG8_BAR; PG8_WAIT_L(0); PG8_MMA(0, 0, At, B0); PG8_BAR; PG8_SCHED;
            PG8_LDB(B1, 1, 1); PG8_STAGE(PG8_SB(1, 0), b3, voffB);
            PG8_BAR; PG8_WAIT_L(0); PG8_MMA(0, 1, At, B1); PG8_BAR;
            PG8_LDA(At, 1, 1); PG8_STAGE(PG8_SA(1, 0), a3, voffA);
            PG8_BAR; PG8_WAIT_L(0); PG8_MMA(1, 0, At, B0); PG8_BAR; PG8_SCHED;
            PG8_STAGE(PG8_SB(1, 1), b3 + hstepB, voffB);
            PG8_WAIT_V(6); PG8_BAR; PG8_MMA(1, 1, At, B1); PG8_BAR;
            }
        }
        if constexpr (ALIGN_EPI) { if (wr == 0) PG8_BAR; }
        if constexpr (!Epi::AFTER_DRAIN) { E(acc, cur, wr, wc, fr, fq); S.done(cur); }
        if (!has_next) break;
#pragma unroll
        for (int a = 0; a < 2; ++a)
#pragma unroll
            for (int b = 0; b < 2; ++b)
#pragma unroll
                for (int m = 0; m < 4; ++m)
#pragma unroll
                    for (int n = 0; n < 2; ++n) acc[a][b][m][n] = (f32x4){0.f, 0.f, 0.f, 0.f};
        cur = nxt; cA = nA; cB = nB; ++ui;
        if constexpr (ALIGN_EPI) { if (wr == 1) PG8_BAR; }
    }
    PG8_WAIT_V(0);
    if constexpr (!ALIGN_EPI) { if (wr == 0) PG8_BAR; }
    PG8_BAR;
    if constexpr (Epi::AFTER_DRAIN) { E.fused(acc, cur, wr, wc, fr, fq, lds, wid, lane); S.done(cur); }
#undef PG8_SA
#undef PG8_SB
#undef PG8_STAGE
#undef PG8_LDA
#undef PG8_LDB
#undef PG8_MMA
#undef PG8_WAIT_V
#undef PG8_WAIT_L
#undef PG8_BAR
#undef PG8_SCHED
}
}
#define LAS __attribute__((address_space(3)))
#define XB_TMO      128
#define XB_XCNT(j)  (256  + 64 * (j))
#define XB_XSUB(j)  (1280 + 64 * (j))
#define XB_XGEN(j)  (2304 + 64 * (j))
#define XB_TOP      3328
#define XB_TOPGEN   3392
#define XCD_BAR_WORDS 3456
#define XB_SPIN_CAP (1u << 18)

__device__ __forceinline__ unsigned xb_ld(unsigned* p)              { return __hip_atomic_load(p, __ATOMIC_RELAXED, __HIP_MEMORY_SCOPE_AGENT); }
__device__ __forceinline__ unsigned xb_add(unsigned* p, unsigned v) { return __hip_atomic_fetch_add(p, v, __ATOMIC_RELAXED, __HIP_MEMORY_SCOPE_AGENT); }
__device__ __forceinline__ unsigned xb_xcc_id() { return (unsigned)__builtin_amdgcn_s_getreg((3 << 11) | 20) & 0xFu; }
#define XB_SPIN(cond, bar) do { unsigned _sp = 0; while (cond) { __builtin_amdgcn_s_sleep(1); \
    if ((++_sp & 255u) == 0u) { if (xb_ld(&(bar)[XB_TMO])) break; if (_sp > XB_SPIN_CAP) { atomicAdd(&(bar)[XB_TMO], 1u); break; } } } } while (0)

struct XcdBarrier {
    unsigned* bar; unsigned x;
    volatile LAS unsigned* st;
};

__device__ __forceinline__ XcdBarrier xcd_barrier_post(unsigned* bar, volatile LAS unsigned* st) {
    XcdBarrier b; b.bar = bar; b.x = xb_xcc_id(); b.st = st;
    if (threadIdx.x == 0) (void)xb_add(&bar[XB_XCNT(b.x)], 1u);
    return b;
}
__device__ __forceinline__ void xcd_barrier_complete(unsigned* bar, unsigned x, unsigned& nloc, unsigned& nx) {
    const unsigned G = gridDim.x * gridDim.y * gridDim.z;
    unsigned sum, cnt, mine, sp = 0u;
    for (;;) {
        sum = 0u; cnt = 0u; mine = 0u;
#pragma unroll
        for (unsigned j = 0; j < 16; ++j) { const unsigned c = xb_ld(&bar[XB_XCNT(j)]); sum += c; cnt += (c > 0u) ? 1u : 0u; mine = (j == x) ? c : mine; }
        if (sum == G) break;
        __builtin_amdgcn_s_sleep(1);
        if ((++sp & 255u) == 0u) { if (xb_ld(&bar[XB_TMO])) break; if (sp > XB_SPIN_CAP) { atomicAdd(&bar[XB_TMO], 1u); break; } }
    }
    nloc = mine > 0u ? mine : 1u; nx = cnt > 0u ? cnt : 1u;
}

__device__ __forceinline__ void xcd_barrier(const XcdBarrier& b) {
    asm volatile("s_waitcnt vmcnt(0)" ::: "memory");
    __syncthreads();
    if (threadIdx.x == 0) {
        unsigned* bar = b.bar;
        __builtin_amdgcn_s_waitcnt(0);
        unsigned nloc = b.st[0], nx = b.st[1];
        if (nloc == 0u) { xcd_barrier_complete(bar, b.x, nloc, nx); b.st[0] = nloc; b.st[1] = nx; }
        const unsigned old = xb_add(&bar[XB_XSUB(b.x)], 1u);
        const unsigned gen = old / nloc;
        if (old + 1u == (gen + 1u) * nloc) {
            __builtin_amdgcn_fence(__ATOMIC_RELEASE, "agent");
            asm volatile("s_waitcnt vmcnt(0)" ::: "memory");
            const unsigned og = xb_add(&bar[XB_TOP], 1u);
            const unsigned tg = og / nx;
            if (og + 1u == (tg + 1u) * nx) xb_add(&bar[XB_TOPGEN], 1u);
            else XB_SPIN(xb_ld(&bar[XB_TOPGEN]) == tg, bar);
            __builtin_amdgcn_fence(__ATOMIC_ACQUIRE, "agent");
            xb_add(&bar[XB_XGEN(b.x)], 1u);
            asm volatile("s_waitcnt vmcnt(0)" ::: "memory");
        } else {
            XB_SPIN(xb_ld(&bar[XB_XGEN(b.x)]) == gen, bar);
            __builtin_amdgcn_fence(__ATOMIC_ACQUIRE, "agent");
            asm volatile("s_waitcnt vmcnt(0)" ::: "memory");
        }
    }
    __syncthreads();
}
#define GAS __attribute__((address_space(1)))

typedef unsigned short bf16;
typedef float f32x4 __attribute__((ext_vector_type(4)));
typedef unsigned v4u __attribute__((ext_vector_type(4)));
typedef unsigned v2u __attribute__((ext_vector_type(2)));
#define LDS_WAIT() asm volatile("s_waitcnt lgkmcnt(0)" ::: "memory")

#ifndef MK_ONE_LAUNCH
#define MK_ONE_LAUNCH 0
#endif
#ifndef RET_MFMA
#define RET_MFMA 1
#endif
#ifndef SWA_MFMA
#define SWA_MFMA 1
#endif
#ifndef PROBE_DUP
#define PROBE_DUP 0
#endif
#ifndef CONV_FUSED
#define CONV_FUSED 1
#endif
#ifndef PLE_EARLY
#define PLE_EARLY 1
#endif
#ifndef LN_NOXR
#define LN_NOXR 1
#endif
#ifndef LN_FUSED
#define LN_FUSED 1
#endif
#ifndef RES_BF16
#define RES_BF16 1
#endif
#define REPS(k) int nrep_ = (PROBE_DUP == (k)) ? 2 : 1; asm volatile("" : "+s"(nrep_)); for (int rep_ = 0; rep_ < nrep_; ++rep_)

constexpr int INW_ = 5376, NUPG_ = 13312;
constexpr int S = 16384, D = 2048, INW = 5376, DFF = 5632, NUP = 2 * DFF, NUPG = NUP + D, PLE = 256, DEPTH = 4;
constexpr float ALPHA = 1.6817928305074290f, LN_EPS = 1e-5f, GN_EPS = 1e-6f;
constexpr int NPH = 11, NPHASES = 1 + DEPTH * NPH;

constexpr size_t MiB = 1u << 20;
constexpr size_t WS_CTL = 0, CTL_ZERO_BYTES = 1 * MiB;
constexpr size_t WS_C = 65536; constexpr int C_L = 2 * INW_ + 2 * NUPG_, C1IN = 0, C2IN = INW_, C1UP = 2 * INW_, C2UP = 2 * INW_ + NUPG_;
constexpr size_t WS_YH = 1304 * MiB;
constexpr size_t WS_CP = 540 * MiB;
constexpr size_t WS_PSTAT = 532 * MiB;
constexpr size_t WS_COSR = 2 * MiB, WS_SINR = 10 * MiB, WS_COSA = 18 * MiB, WS_SINA = 20 * MiB;
constexpr size_t WS_W = 32 * MiB, WL_BYTES = 106 * MiB;
constexpr size_t WL_IN = 0, WL_OUT = 21 * MiB, WL_UP = 29 * MiB, WL_G = 73 * MiB, WL_DOWN = 81 * MiB, WL_P = 104 * MiB;
constexpr size_t WS_XR = 530 * MiB, WS_XB = 576 * MiB, WS_Y = 640 * MiB;
constexpr size_t WS_Q = 768 * MiB, WS_K = 800 * MiB, WS_V = 832 * MiB, WS_G = 864 * MiB, WS_AQ = 896 * MiB, WS_AK = 928 * MiB, WS_AV = 932 * MiB;
constexpr size_t WS_MIX = 936 * MiB, WS_U = 1000 * MiB, WS_PS = 1128 * MiB, WS_RETY = 1160 * MiB;
constexpr size_t WS_H = 768 * MiB, WS_ACT = 1128 * MiB, WS_SG = 460 * MiB, WS_PB = 1368 * MiB, WS_END = 1400 * MiB;
constexpr size_t WS_PP = 1064 * MiB;
constexpr size_t WS_ST1 = 24 * MiB, WS_ST2 = 25 * MiB;
constexpr int CW_BAR = 4096;
static_assert((CW_BAR + 3456) * 4 <= 32768 && WS_C + (size_t)4 * C_L * 4 <= CTL_ZERO_BYTES, "barrier words and column sums inside the per-call memset");

constexpr int RING_BYTES = 131072, LDS_BYTES = 147456, LDSCTL_OFF = LDS_BYTES - 1024, MISC_OFF = LDSCTL_OFF + 320;

__device__ __forceinline__ unsigned f2bf(float f) { unsigned u = __builtin_bit_cast(unsigned, f); return (u + 0x7fffu + ((u >> 16) & 1u)) >> 16; }
__device__ __forceinline__ unsigned pk2(float lo, float hi) { return f2bf(lo) | (f2bf(hi) << 16); }
__device__ __forceinline__ float bflo(unsigned w) { return __uint_as_float(w << 16); }
__device__ __forceinline__ float bfhi(unsigned w) { return __uint_as_float(w & 0xffff0000u); }
__device__ __forceinline__ float bf1(const bf16* p) { return __uint_as_float(((unsigned)*p) << 16); }

struct Params {
    const float* in[19]; float* out; unsigned char* ws; int ph_lo, ph_hi;
    float invf_ret[128]; float invf_att[32]; float lg2g[4];
};

struct Ctx { int tid, lane, wave, G, bid; unsigned char* ws; };

__device__ __forceinline__ int lane_id_asm() { int l; asm volatile("v_mbcnt_lo_u32_b32 %0, -1, 0\n\tv_mbcnt_hi_u32_b32 %0, -1, %0" : "=v"(l)); return l; }
__device__ __forceinline__ float wave_sum(float v, int lane) {
#pragma unroll
    for (int o = 1; o < 64; o <<= 1) v += __builtin_bit_cast(float, __builtin_amdgcn_ds_bpermute((lane ^ o) << 2, __builtin_bit_cast(int, v)));
    return v;
}
__device__ __forceinline__ void transpose_item(const float* W, int K, int N, int src_col0, bf16* WT, int dst_row0, int k0, LAS float* scr, int lane) {
#pragma unroll 8
    for (int i = 0; i < 32; ++i) { const int kk = 2 * i + (lane >> 5); scr[kk * 33 + (lane & 31)] = W[(size_t)(k0 + kk) * N + src_col0 + (lane & 31)]; }
    LDS_WAIT(); asm volatile("" ::: "memory");
    const int c = lane & 7;
#pragma unroll
    for (int j = 0; j < 4; ++j) { const int n = (lane >> 3) + 8 * j; const LAS float* s = scr + (8 * c) * 33 + n;
        v4u o; o.x = pk2(s[0 * 33], s[1 * 33]); o.y = pk2(s[2 * 33], s[3 * 33]); o.z = pk2(s[4 * 33], s[5 * 33]); o.w = pk2(s[6 * 33], s[7 * 33]);
        *(v4u*)(WT + (size_t)(dst_row0 + n) * K + k0 + 8 * c) = o; }
    LDS_WAIT(); asm volatile("" ::: "memory");
}
__device__ __forceinline__ void transpose_item64(const float* W, int K, int N, int srcA, int srcB, bf16* WT, int dst_row0, int k0, LAS float* scr, int lane, int tiled = 0) {
    const int c4 = lane & 15, gsel = c4 >> 3, col = 4 * (c4 & 7), src = (gsel ? srcB : srcA) + col, kq = lane >> 4;
    f32x4 v[16];
#pragma unroll
    for (int i = 0; i < 16; ++i) v[i] = *(const f32x4*)(W + (size_t)(k0 + 4 * i + kq) * N + src);
#pragma unroll
    for (int i = 0; i < 16; ++i) { LAS float* d = scr + (4 * i + kq) * 65 + 32 * gsel + col; d[0] = v[i][0]; d[1] = v[i][1]; d[2] = v[i][2]; d[3] = v[i][3]; }
    LDS_WAIT(); asm volatile("" ::: "memory");
    const int c = lane & 7;
#pragma unroll
    for (int j = 0; j < 8; ++j) { const int n = (lane >> 3) + 8 * j; const LAS float* s = scr + (8 * c) * 65 + n;
        v4u o; o.x = pk2(s[0 * 65], s[1 * 65]); o.y = pk2(s[2 * 65], s[3 * 65]); o.z = pk2(s[4 * 65], s[5 * 65]); o.w = pk2(s[6 * 65], s[7 * 65]);
        *(v4u*)(WT + (tiled ? pg8::tiled_off(dst_row0 + n, k0 + 8 * c, K) : (size_t)(dst_row0 + n) * K + k0 + 8 * c)) = o; }
    LDS_WAIT(); asm volatile("" ::: "memory");
}
__device__ __forceinline__ void transpose_unit(const float* W, int K, int N, int srcA, int srcB, bf16* WT, int dst_row0, int kb0, int nkb, LAS float* scr, int lane, int tiled,
                                               const float* gv, const float* bv, float* c1, float* c2) {
    const int c4 = lane & 15, gsel = c4 >> 3, col = 4 * (c4 & 7), src = (gsel ? srcB : srcA) + col, kq = lane >> 4, c = lane & 7;
    f32x4 c1p = (f32x4){0.f, 0.f, 0.f, 0.f}, c2p = (f32x4){0.f, 0.f, 0.f, 0.f};
    for (int kb = kb0; kb < kb0 + nkb; ++kb) { const int k0 = 64 * kb;
        f32x4 v[16];
#pragma unroll
        for (int i = 0; i < 16; ++i) v[i] = *(const f32x4*)(W + (size_t)(k0 + 4 * i + kq) * N + src);
        if (gv) {
#pragma unroll
            for (int i = 0; i < 16; ++i) { const float gk = gv[k0 + 4 * i + kq], bk = bv[k0 + 4 * i + kq]; c2p = c2p + v[i] * bk; v[i] = v[i] * gk;
#pragma unroll
                for (int e = 0; e < 4; ++e) c1p[e] += __uint_as_float(f2bf(v[i][e]) << 16); } }
#pragma unroll
        for (int i = 0; i < 16; ++i) { LAS float* d = scr + (4 * i + kq) * 65 + 32 * gsel + col; d[0] = v[i][0]; d[1] = v[i][1]; d[2] = v[i][2]; d[3] = v[i][3]; }
        LDS_WAIT(); asm volatile("" ::: "memory");
#pragma unroll
        for (int j = 0; j < 8; ++j) { const int n = (lane >> 3) + 8 * j; const LAS float* sp = scr + (8 * c) * 65 + n;
            v4u o; o.x = pk2(sp[0 * 65], sp[1 * 65]); o.y = pk2(sp[2 * 65], sp[3 * 65]); o.z = pk2(sp[4 * 65], sp[5 * 65]); o.w = pk2(sp[6 * 65], sp[7 * 65]);
            *(v4u*)(WT + (tiled ? pg8::tiled_off(dst_row0 + n, k0 + 8 * c, K) : (size_t)(dst_row0 + n) * K + k0 + 8 * c)) = o; }
        LDS_WAIT(); asm volatile("" ::: "memory");
    }
    if (gv) {
#pragma unroll
        for (int e = 0; e < 4; ++e) {
            float a = c1p[e], b = c2p[e];
            a += __builtin_bit_cast(float, __builtin_amdgcn_ds_bpermute((lane ^ 16) << 2, __builtin_bit_cast(int, a))); b += __builtin_bit_cast(float, __builtin_amdgcn_ds_bpermute((lane ^ 16) << 2, __builtin_bit_cast(int, b)));
            a += __builtin_bit_cast(float, __builtin_amdgcn_ds_bpermute((lane ^ 32) << 2, __builtin_bit_cast(int, a))); b += __builtin_bit_cast(float, __builtin_amdgcn_ds_bpermute((lane ^ 32) << 2, __builtin_bit_cast(int, b)));
            if (kq == 0) { c1[dst_row0 + 32 * gsel + col + e] = a; c2[dst_row0 + 32 * gsel + col + e] = b; } }
    }
}
__device__ __forceinline__ int win_src_col(int g) {
    const int tile = g >> 3, bj = (g >> 2) & 1, wcg = g & 3;
    if (tile < 16) return 32 * g;
    if (tile < 20) return 4096 + 256 * (tile - 16) + 64 * wcg + 32 * bj;
    return wcg < 2 ? 5120 + 64 * wcg + 32 * bj : 5248 + 32 * (wcg - 2) + 64 * bj;
}
__device__ __forceinline__ int wup_src_col(int g) { const int tile = g >> 3, bj = (g >> 2) & 1, wcg = g & 3; return (bj ? DFF : 0) + 128 * tile + 32 * wcg; }

__device__ __forceinline__ void sincos_d(float angf, float& s, float& c) {
    const double a = (double)angf;
    const double k = __builtin_rint(a * 0.63661977236758134308);
    double r = __builtin_fma(-k, 1.57079632679489661923, a); r = __builtin_fma(-k, 6.123233995736766e-17, r);
    const double r2 = r * r;
    const double sp = r + r * r2 * (-1.0 / 6 + r2 * (1.0 / 120 + r2 * (-1.0 / 5040 + r2 * (1.0 / 362880 + r2 * (-1.0 / 39916800)))));
    const double cp = 1.0 + r2 * (-0.5 + r2 * (1.0 / 24 + r2 * (-1.0 / 720 + r2 * (1.0 / 40320 + r2 * (-1.0 / 3628800 + r2 * (1.0 / 479001600))))));
    const int q = ((int)k) & 3;
    const double sv = (q == 0) ? sp : (q == 1) ? cp : (q == 2) ? -sp : -cp;
    const double cv = (q == 0) ? cp : (q == 1) ? -sp : (q == 2) ? -cp : sp;
    s = (float)sv; c = (float)cv;
}

__device__ __forceinline__ void phase_prologue(const Params& P, const Ctx& cx, LAS unsigned char* lds) {
    unsigned char* ws = cx.ws; const int tid = cx.tid, lane = cx.lane, wave = cx.wave, G = cx.G;
    LAS float* scr = (LAS float*)(lds + wave * 16896);
    const int gw = cx.bid * 8 + wave, NGW = G * 8;
#if LN_FUSED
    constexpr int U_IN = 84 * 8, U_OUT = 32 * 8, U_UP = 176 * 8, U_G = 32 * 8, U_DN = 32 * 22, U_P = 32, U_L = U_IN + U_OUT + U_UP + U_G + U_DN + U_P;
    for (int it = gw; it < DEPTH * U_L; it += NGW) {
        const int l = it / U_L; int r = it - l * U_L;
        bf16* wl = (bf16*)(ws + WS_W + (size_t)l * WL_BYTES); float* cl0 = (float*)(ws + WS_CP) + (size_t)l * C_L;
        const float* g1 = P.in[8] + l * D; const float* b1 = P.in[9] + l * D;
        const float* g2 = l ? P.in[14] + (l - 1) * D : nullptr; const float* b2 = l ? P.in[15] + (l - 1) * D : nullptr;
        const float* W; int K = D, N = D, sa, sb, g, kc, nkb = 4, tiled = 0; bf16* WT; const float* gv = nullptr; const float* bv = nullptr; float* c1 = nullptr; float* c2 = nullptr;
        if (r < U_IN) { g = r >> 3; kc = r & 7; W = P.in[3] + (size_t)l * D * INW; N = INW; sa = win_src_col(2 * g); sb = win_src_col(2 * g + 1); WT = wl + WL_IN / 2; gv = g2; bv = b2; c1 = cl0 + C1IN; c2 = cl0 + C2IN; }
        else if ((r -= U_IN) < U_OUT) { g = r >> 3; kc = r & 7; W = P.in[4] + (size_t)l * D * D; sa = 64 * g; sb = sa + 32; WT = wl + WL_OUT / 2; }
        else if ((r -= U_OUT) < U_UP) { g = r >> 3; kc = r & 7; W = P.in[10] + (size_t)l * D * NUP; N = NUP; sa = wup_src_col(2 * g); sb = wup_src_col(2 * g + 1); WT = wl + WL_UP / 2; gv = g1; bv = b1; c1 = cl0 + C1UP; c2 = cl0 + C2UP; }
        else if ((r -= U_UP) < U_G) { g = r >> 3; kc = r & 7; W = P.in[16] + (size_t)l * D * D; sa = 64 * g; sb = sa + 32; WT = wl + WL_G / 2; gv = g1; bv = b1; c1 = cl0 + C1UP + NUP; c2 = cl0 + C2UP + NUP; }
        else if ((r -= U_G) < U_DN) { g = r / 22; kc = r % 22; W = P.in[13] + (size_t)l * DFF * D; K = DFF; sa = 64 * g; sb = sa + 32; WT = wl + WL_DOWN / 2; tiled = 1; }
        else { r -= U_DN; g = r; kc = 0; W = P.in[18] + (size_t)l * PLE * D; K = PLE; sa = 64 * g; sb = sa + 32; WT = wl + WL_P / 2; }
        if (c1) { c1 += (size_t)kc * DEPTH * C_L; c2 += (size_t)kc * DEPTH * C_L; }
        transpose_unit(W, K, N, sa, sb, WT, 64 * g, 4 * kc, nkb, scr, lane, tiled, gv, bv, c1, c2);
    }
#else
    constexpr int I_IN = 32 * 84, I_OUT = 32 * 32, I_UP = 32 * 176, I_G = 32 * 32, I_DN = 88 * 32, I_P = 4 * 32, I_L = I_IN + I_OUT + I_UP + I_G + I_DN + I_P;
    for (int it = gw; it < DEPTH * I_L; it += NGW) {
        const int l = it / I_L; int r = it - l * I_L;
        bf16* wl = (bf16*)(ws + WS_W + (size_t)l * WL_BYTES);
        if (r < I_IN) { const int kb = r / 84, g = r % 84; transpose_item64(P.in[3] + (size_t)l * D * INW, D, INW, win_src_col(2 * g), win_src_col(2 * g + 1), wl + WL_IN / 2, 64 * g, 64 * kb, scr, lane); continue; } r -= I_IN;
        if (r < I_OUT) { const int kb = r / 32, g = r % 32; transpose_item64(P.in[4] + (size_t)l * D * D, D, D, 64 * g, 64 * g + 32, wl + WL_OUT / 2, 64 * g, 64 * kb, scr, lane); continue; } r -= I_OUT;
        if (r < I_UP) { const int kb = r / 176, g = r % 176; transpose_item64(P.in[10] + (size_t)l * D * NUP, D, NUP, wup_src_col(2 * g), wup_src_col(2 * g + 1), wl + WL_UP / 2, 64 * g, 64 * kb, scr, lane); continue; } r -= I_UP;
        if (r < I_G) { const int kb = r / 32, g = r % 32; transpose_item64(P.in[16] + (size_t)l * D * D, D, D, 64 * g, 64 * g + 32, wl + WL_G / 2, 64 * g, 64 * kb, scr, lane); continue; } r -= I_G;
        if (r < I_DN) { const int kb = r / 32, g = r % 32; transpose_item64(P.in[13] + (size_t)l * DFF * D, DFF, D, 64 * g, 64 * g + 32, wl + WL_DOWN / 2, 64 * g, 64 * kb, scr, lane, 1); continue; } r -= I_DN;
        { const int kb = r / 32, g = r % 32; transpose_item64(P.in[18] + (size_t)l * PLE * D, PLE, D, 64 * g, 64 * g + 32, wl + WL_P / 2, 64 * g, 64 * kb, scr, lane); }
    }
#endif
    const size_t gt = (size_t)cx.bid * 512 + tid, NT = (size_t)G * 512;
    { const float* x = P.in[0]; bf16* xb = (bf16*)(ws + WS_XB);
      for (size_t i = gt; i < (size_t)S * D / 8; i += NT) { const f32x4 a = *(const f32x4*)(x + i * 8), b = *(const f32x4*)(x + i * 8 + 4);
          v4u o; o.x = pk2(a[0], a[1]); o.y = pk2(a[2], a[3]); o.z = pk2(b[0], b[1]); o.w = pk2(b[2], b[3]); *(v4u*)(xb + i * 8) = o; } }
    { const float* p = P.in[1]; bf16* pb = (bf16*)(ws + WS_PB);
      for (size_t i = gt; i < (size_t)DEPTH * S * PLE / 8; i += NT) { const f32x4 a = *(const f32x4*)(p + i * 8), b = *(const f32x4*)(p + i * 8 + 4);
          v4u o; o.x = pk2(a[0], a[1]); o.y = pk2(a[2], a[3]); o.z = pk2(b[0], b[1]); o.w = pk2(b[2], b[3]); *(v4u*)(pb + i * 8) = o; } }
    { const int* pos = (const int*)P.in[2]; float* cosr = (float*)(ws + WS_COSR); float* sinr = (float*)(ws + WS_SINR); float* cosa = (float*)(ws + WS_COSA); float* sina = (float*)(ws + WS_SINA);
      for (size_t i = gt; i < (size_t)S * 128; i += NT) { const int t = (int)(i >> 7), f = (int)(i & 127); float s, c; sincos_d((float)pos[t] * P.invf_ret[f], s, c); cosr[i] = c; sinr[i] = s; }
      for (size_t i = gt; i < (size_t)S * 32; i += NT) { const int t = (int)(i >> 5), f = (int)(i & 31); float s, c; sincos_d((float)pos[t] * P.invf_att[f], s, c); cosa[i] = c; sina[i] = s; } }
}

template <int MT, int NT_, int KK, bool A_KFAST, bool B_NFAST, class FA, class FB, class FC>
__device__ __forceinline__ void simple_gemm(LAS unsigned char* lds, int nbatch, int tid, int G, int bid, const FA& fa, const FB& fb, const FC& fc) {
    LAS float* As = (LAS float*)lds;
    LAS float* Bs = (LAS float*)(lds + 16 * 132 * 4);
    constexpr int TM = MT / 128, TN = NT_ / 64, ITEMS_PER_B = TM * TN;
    const int tm = tid & 31, tn = tid >> 5;
    for (int item = bid; item < nbatch * ITEMS_PER_B; item += G) {
        const int b = item / ITEMS_PER_B, r = item % ITEMS_PER_B, m0 = (r / TN) * 128, n0 = (r % TN) * 64;
        float c[4][4];
#pragma unroll
        for (int i = 0; i < 4; ++i)
#pragma unroll
            for (int j = 0; j < 4; ++j) c[i][j] = 0.f;
        for (int k0 = 0; k0 < KK; k0 += 16) {
#pragma unroll
            for (int rr = 0; rr < 4; ++rr) { const int e = tid + 512 * rr; int m, k; if (A_KFAST) { k = e & 15; m = e >> 4; } else { m = e & 127; k = e >> 7; }
                As[k * 132 + m] = fa(b, m0 + m, k0 + k); }
#pragma unroll
            for (int rr = 0; rr < 2; ++rr) { const int e = tid + 512 * rr; int n, k; if (B_NFAST) { n = e & 63; k = e >> 6; } else { k = e & 15; n = e >> 4; }
                Bs[k * 68 + n] = fb(b, k0 + k, n0 + n); }
            __syncthreads();
#pragma unroll
            for (int kk = 0; kk < 16; ++kk) { const f32x4 a = *(const LAS f32x4*)(As + kk * 132 + 4 * tm), bb = *(const LAS f32x4*)(Bs + kk * 68 + 4 * tn);
#pragma unroll
                for (int i = 0; i < 4; ++i)
#pragma unroll
                    for (int j = 0; j < 4; ++j) c[i][j] += a[i] * bb[j]; }
            __syncthreads();
        }
#pragma unroll
        for (int i = 0; i < 4; ++i)
#pragma unroll
            for (int j = 0; j < 4; ++j) fc(b, m0 + 4 * tm + i, n0 + 4 * tn + j, c[i][j]);
    }
}

__device__ __forceinline__ void phase_swa(const Params& P, const Ctx& cx, int l, LAS unsigned char* lds) {
    unsigned char* ws = cx.ws; const int tid = cx.tid, G = cx.G;
    const bf16* AQ = (const bf16*)(ws + WS_AQ); const bf16* AK = (const bf16*)(ws + WS_AK); const bf16* AV = (const bf16*)(ws + WS_AV); bf16* MIX = (bf16*)(ws + WS_MIX);
    const float* sinks = P.in[7] + l * 16;
    LAS unsigned* Ks = (LAS unsigned*)lds;
    LAS unsigned* Vs = (LAS unsigned*)(lds + 256 * 33 * 4);
    for (int item = cx.bid; item < 256; item += G) {
        const int nb = item >> 1, hk = item & 1;
        __syncthreads();
        for (int e = tid; e < 256 * 32; e += 512) { const int r = e >> 5, cdw = e & 31; const int gk = nb * 128 - 128 + r;
            unsigned kv = 0u, vv = 0u; if (gk >= 0) { kv = *(const unsigned*)(AK + (size_t)gk * 128 + hk * 64 + 2 * cdw); vv = *(const unsigned*)(AV + (size_t)gk * 128 + hk * 64 + 2 * cdw); }
            Ks[r * 33 + cdw] = kv; Vs[r * 33 + cdw] = vv; }
        __syncthreads();
#pragma unroll 1
        for (int rep = 0; rep < 2; ++rep) {
            const int pair = tid + 512 * rep, i = pair & 127, g = pair >> 7, hq = hk * 8 + g; const int row = nb * 128 + i;
            float q[64], o[64];
            { const v4u* qp = (const v4u*)(AQ + (size_t)row * 1024 + hq * 64);
#pragma unroll
              for (int c8 = 0; c8 < 8; ++c8) { const v4u w = qp[c8]; q[8 * c8 + 0] = bflo(w.x); q[8 * c8 + 1] = bfhi(w.x); q[8 * c8 + 2] = bflo(w.y); q[8 * c8 + 3] = bfhi(w.y); q[8 * c8 + 4] = bflo(w.z); q[8 * c8 + 5] = bfhi(w.z); q[8 * c8 + 6] = bflo(w.w); q[8 * c8 + 7] = bfhi(w.w); } }
#pragma unroll
            for (int d = 0; d < 64; ++d) o[d] = 0.f;
            float mx = sinks[hq], den = 1.0f;
            const int jj0 = (nb == 0) ? (127 - i) : 0;
            for (int jj = jj0; jj < 128; ++jj) { const int kl = i + 1 + jj;
                float s = 0.f;
#pragma unroll
                for (int c = 0; c < 32; ++c) { const unsigned w = Ks[kl * 33 + c]; s += q[2 * c] * bflo(w) + q[2 * c + 1] * bfhi(w); }
                const float mn = fmaxf(mx, s), sc = __expf(mx - mn), p = __expf(s - mn);
                den = den * sc + p; mx = mn;
#pragma unroll
                for (int c = 0; c < 32; ++c) { const unsigned w = Vs[kl * 33 + c]; o[2 * c] = o[2 * c] * sc + p * bflo(w); o[2 * c + 1] = o[2 * c + 1] * sc + p * bfhi(w); }
            }
            const float inv = 1.0f / den;
            v4u* op = (v4u*)(MIX + (size_t)row * 2048 + 1024 + hq * 64);
#pragma unroll
            for (int c8 = 0; c8 < 8; ++c8) { v4u w; w.x = pk2(o[8 * c8] * inv, o[8 * c8 + 1] * inv); w.y = pk2(o[8 * c8 + 2] * inv, o[8 * c8 + 3] * inv); w.z = pk2(o[8 * c8 + 4] * inv, o[8 * c8 + 5] * inv); w.w = pk2(o[8 * c8 + 6] * inv, o[8 * c8 + 7] * inv); op[c8] = w; }
        }
    }
}

__device__ __forceinline__ void phase_ret_u_scores(const Params& P, const Ctx& cx, LAS unsigned char* lds) {
    unsigned char* ws = cx.ws; const int tid = cx.tid, G = cx.G;
    const bf16* Q = (const bf16*)(ws + WS_Q); const bf16* K = (const bf16*)(ws + WS_K); const bf16* V = (const bf16*)(ws + WS_V);
    float* U = (float*)(ws + WS_U); float* PS = (float*)(ws + WS_PS);
    const float lg0 = P.lg2g[0], lg1 = P.lg2g[1], lg2 = P.lg2g[2], lg3 = P.lg2g[3];
    auto lgh = [=](int h) { return h == 0 ? lg0 : h == 1 ? lg1 : h == 2 ? lg2 : lg3; };
    simple_gemm<256, 256, 128, false, true>(lds, 512, tid, G, cx.bid,
        [=](int b, int m, int k) { const int nb = b >> 2, h = b & 3; return bf1(K + (size_t)(nb * 128 + k) * 1024 + h * 256 + m) * exp2f(lgh(h) * (float)(127 - k)); },
        [=](int b, int k, int n) { const int nb = b >> 2, h = b & 3; return bf1(V + (size_t)(nb * 128 + k) * 1024 + h * 256 + n); },
        [=](int b, int m, int n, float v) { U[((size_t)b * 256 + m) * 256 + n] = v; });
    simple_gemm<128, 128, 256, true, false>(lds, 512, tid, G, cx.bid,
        [=](int b, int m, int k) { const int nb = b >> 2, h = b & 3; return bf1(Q + (size_t)(nb * 128 + m) * 1024 + h * 256 + k); },
        [=](int b, int k, int n) { const int nb = b >> 2, h = b & 3; return bf1(K + (size_t)(nb * 128 + n) * 1024 + h * 256 + k); },
        [=](int b, int m, int n, float v) { const int h = b & 3; PS[((size_t)b * 128 + m) * 128 + n] = (m >= n) ? v * exp2f(lgh(h) * (float)(m - n)) : 0.f; });
}
__device__ __forceinline__ void phase_scan(const Params& P, const Ctx& cx) {
    float* U = (float*)(cx.ws + WS_U);
    const size_t gt = (size_t)cx.bid * 512 + cx.tid, NT = (size_t)cx.G * 512;
    for (size_t idx = gt; idx < 4 * 65536; idx += NT) {
        const int h = (int)(idx >> 16); const float cd = exp2f(P.lg2g[h] * 128.0f);
        float r = 0.f;
        for (int n0 = 0; n0 < 128; n0 += 8) { float u[8];
#pragma unroll
            for (int j = 0; j < 8; ++j) u[j] = U[(size_t)(n0 + j) * 262144 + idx];
#pragma unroll
            for (int j = 0; j < 8; ++j) { U[(size_t)(n0 + j) * 262144 + idx] = r; r = r * cd + u[j]; } }
    }
}
__device__ __forceinline__ void phase_ret_out(const Params& P, const Ctx& cx, LAS unsigned char* lds) {
    unsigned char* ws = cx.ws; const int tid = cx.tid, G = cx.G;
    const bf16* Q = (const bf16*)(ws + WS_Q); const bf16* V = (const bf16*)(ws + WS_V);
    const float* Sst = (const float*)(ws + WS_U); const float* PS = (const float*)(ws + WS_PS); float* RY = (float*)(ws + WS_RETY);
    const float lg0 = P.lg2g[0], lg1 = P.lg2g[1], lg2 = P.lg2g[2], lg3 = P.lg2g[3];
    auto lgh = [=](int h) { return h == 0 ? lg0 : h == 1 ? lg1 : h == 2 ? lg2 : lg3; };
    simple_gemm<128, 256, 384, true, true>(lds, 512, tid, G, cx.bid,
        [=](int b, int m, int k) { const int nb = b >> 2, h = b & 3; return k < 128 ? PS[((size_t)b * 128 + m) * 128 + k] : bf1(Q + (size_t)(nb * 128 + m) * 1024 + h * 256 + (k - 128)) * exp2f(lgh(h) * (float)(m + 1)); },
        [=](int b, int k, int n) { const int nb = b >> 2, h = b & 3; return k < 128 ? bf1(V + (size_t)(nb * 128 + k) * 1024 + h * 256 + n) : Sst[((size_t)b * 256 + (k - 128)) * 256 + n]; },
        [=](int b, int m, int n, float v) { const int nb = b >> 2, h = b & 3; RY[(size_t)(nb * 128 + m) * 1024 + h * 256 + n] = v; });
}

typedef short bf16x8 __attribute__((ext_vector_type(8)));
typedef short s16x4 __attribute__((ext_vector_type(4)));
typedef short v4i16_t __attribute__((ext_vector_type(4)));
__device__ __forceinline__ f32x4 mfma16(bf16x8 a, bf16x8 b, f32x4 c) { return __builtin_amdgcn_mfma_f32_16x16x32_bf16(a, b, c, 0, 0, 0); }
__device__ __forceinline__ s16x4 lds_tr(LAS unsigned char* p) { return __builtin_bit_cast(s16x4, __builtin_amdgcn_ds_read_tr16_b64_v4i16((LAS v4i16_t*)p)); }
__device__ __forceinline__ bf16x8 cat44(s16x4 a, s16x4 b) { bf16x8 r; r[0] = a[0]; r[1] = a[1]; r[2] = a[2]; r[3] = a[3]; r[4] = b[0]; r[5] = b[1]; r[6] = b[2]; r[7] = b[3]; return r; }
__device__ __forceinline__ unsigned cvt2(float lo, float hi) { return pg8::cvt_pk_bf16(lo, hi); }
__device__ __forceinline__ bf16x8 pack_frag(const f32x4 a, const f32x4 b) { v4u w; w.x = cvt2(a[0], a[1]); w.y = cvt2(a[2], a[3]); w.z = cvt2(b[0], b[1]); w.w = cvt2(b[2], b[3]); return __builtin_bit_cast(bf16x8, w); }
__device__ __forceinline__ float grp16_sum(float v, int lane) {
#pragma unroll
    for (int o = 1; o < 16; o <<= 1) v += __builtin_bit_cast(float, __builtin_amdgcn_ds_bpermute((lane ^ o) << 2, __builtin_bit_cast(int, v)));
    return v;
}

__device__ __forceinline__ unsigned lds_addr(const LAS unsigned char* p) { return (unsigned)(size_t)p; }
template <int O1, int O2, int O3, int O4, int O5, int O6, int O7>
__device__ __forceinline__ void lds_rd8(bf16x8 (&t)[8], unsigned a) {
    asm volatile("ds_read_b128 %0, %8\n\tds_read_b128 %1, %8 offset:%9\n\tds_read_b128 %2, %8 offset:%10\n\tds_read_b128 %3, %8 offset:%11\n\t"
                 "ds_read_b128 %4, %8 offset:%12\n\tds_read_b128 %5, %8 offset:%13\n\tds_read_b128 %6, %8 offset:%14\n\tds_read_b128 %7, %8 offset:%15\n\ts_waitcnt lgkmcnt(0)"
                 : "=&v"(t[0]), "=&v"(t[1]), "=&v"(t[2]), "=&v"(t[3]), "=&v"(t[4]), "=&v"(t[5]), "=&v"(t[6]), "=&v"(t[7])
                 : "v"(a), "i"(O1), "i"(O2), "i"(O3), "i"(O4), "i"(O5), "i"(O6), "i"(O7) : "memory");
}
template <int OA, int OB, int OC>
__device__ __forceinline__ void lds_tr8(s16x4 (&t)[8], unsigned a0, unsigned a1) {
    asm volatile("ds_read_b64_tr_b16 %0, %8\n\tds_read_b64_tr_b16 %1, %8 offset:%10\n\tds_read_b64_tr_b16 %2, %8 offset:%11\n\tds_read_b64_tr_b16 %3, %8 offset:%12\n\t"
                 "ds_read_b64_tr_b16 %4, %9\n\tds_read_b64_tr_b16 %5, %9 offset:%10\n\tds_read_b64_tr_b16 %6, %9 offset:%11\n\tds_read_b64_tr_b16 %7, %9 offset:%12\n\ts_waitcnt lgkmcnt(0)"
                 : "=&v"(t[0]), "=&v"(t[1]), "=&v"(t[2]), "=&v"(t[3]), "=&v"(t[4]), "=&v"(t[5]), "=&v"(t[6]), "=&v"(t[7])
                 : "v"(a0), "v"(a1), "i"(OA), "i"(OB), "i"(OC) : "memory");
}
constexpr int RS_T = 544;
constexpr int TILE_T = 128 * RS_T;
static_assert(2 * TILE_T <= LDSCTL_OFF, "retention tiles vs LDS control words");

template <bool DECAY> __device__ __forceinline__ void stage_tile(LAS unsigned char* img, const bf16* src, int tid, float lg) {
    v4u v[8];
#pragma unroll
    for (int r = 0; r < 8; ++r) { const int pc = tid + 512 * r, row = pc >> 5, c16 = pc & 31; v[r] = *(const v4u*)(src + (size_t)row * 1024 + c16 * 8); }
#pragma unroll
    for (int r = 0; r < 8; ++r) { const int pc = tid + 512 * r, row = pc >> 5, c16 = pc & 31; v4u w = v[r];
        if (DECAY) { const float sc = exp2f(lg * (float)(127 - row));
            w.x = cvt2(bflo(w.x) * sc, bfhi(w.x) * sc); w.y = cvt2(bflo(w.y) * sc, bfhi(w.y) * sc); w.z = cvt2(bflo(w.z) * sc, bfhi(w.z) * sc); w.w = cvt2(bflo(w.w) * sc, bfhi(w.w) * sc); }
        *(LAS v4u*)(img + row * RS_T + c16 * 16) = w; }
}

template <bool DECAY_A> __device__ __forceinline__ void stage_two(LAS unsigned char* imgA, const bf16* srcA, LAS unsigned char* imgB, const bf16* srcB, int tid, float lg) {
    v4u va[8], vb[8];
#pragma unroll
    for (int r = 0; r < 8; ++r) { const int pc = tid + 512 * r, row = pc >> 5, c16 = pc & 31; va[r] = *(const v4u*)(srcA + (size_t)row * 1024 + c16 * 8); vb[r] = *(const v4u*)(srcB + (size_t)row * 1024 + c16 * 8); }
#pragma unroll
    for (int r = 0; r < 8; ++r) { const int pc = tid + 512 * r, row = pc >> 5, c16 = pc & 31; v4u w = va[r];
        if (DECAY_A) { const float sc = exp2f(lg * (float)(127 - row));
            w.x = cvt2(bflo(w.x) * sc, bfhi(w.x) * sc); w.y = cvt2(bflo(w.y) * sc, bfhi(w.y) * sc); w.z = cvt2(bflo(w.z) * sc, bfhi(w.z) * sc); w.w = cvt2(bflo(w.w) * sc, bfhi(w.w) * sc); }
        *(LAS v4u*)(imgA + row * RS_T + c16 * 16) = w; *(LAS v4u*)(imgB + row * RS_T + c16 * 16) = vb[r]; }
}

__device__ __forceinline__ void phase_ret_u_mfma(const Params& P, const Ctx& cx, LAS unsigned char* lds) {
    unsigned char* ws = cx.ws; const int tid = cx.tid, lane = cx.lane, w = cx.wave, r16 = lane & 15, g = lane >> 4, q = r16 >> 2, pp = r16 & 3;
    const bf16* K = (const bf16*)(ws + WS_K); const bf16* V = (const bf16*)(ws + WS_V); bf16* UT = (bf16*)(ws + WS_U);
    LAS unsigned char* Kim = lds; LAS unsigned char* Vim = lds + TILE_T;
    for (int b = cx.bid; b < 512; b += cx.G) {
        const int nb = b >> 2, h = b & 3;
        __syncthreads();
        stage_two<true>(Kim, K + (size_t)nb * 128 * 1024 + h * 256, Vim, V + (size_t)nb * 128 * 1024 + h * 256, tid, P.lg2g[h]);
        __syncthreads();
        f32x4 acc[2][16];
#pragma unroll
        for (int mi = 0; mi < 2; ++mi)
#pragma unroll
            for (int n = 0; n < 16; ++n) acc[mi][n] = (f32x4){0.f, 0.f, 0.f, 0.f};
#pragma unroll 1
        for (int s = 0; s < 4; ++s) {
            bf16x8 af[2];
#pragma unroll
            for (int mi = 0; mi < 2; ++mi) { LAS unsigned char* a0 = Kim + (32 * s + 8 * g + q) * RS_T + (16 * (2 * w + mi) + 4 * pp) * 2; af[mi] = cat44(lds_tr(a0), lds_tr(a0 + 4 * RS_T)); }
#pragma unroll
            for (int ng = 0; ng < 4; ++ng) { const unsigned b0 = lds_addr(Vim + (32 * s + 8 * g + q) * RS_T + (64 * ng + 4 * pp) * 2); s16x4 t[8];
                lds_tr8<32, 64, 96>(t, b0, b0 + 4 * RS_T);
#pragma unroll
                for (int nn = 0; nn < 4; ++nn) { const bf16x8 bfr = cat44(t[nn], t[4 + nn]); const int n = 4 * ng + nn;
                    acc[0][n] = mfma16(af[0], bfr, acc[0][n]); acc[1][n] = mfma16(af[1], bfr, acc[1][n]); } }
        }
#pragma unroll
        for (int mi = 0; mi < 2; ++mi)
#pragma unroll
            for (int n = 0; n < 16; ++n) { v2u o; o.x = cvt2(acc[mi][n][0], acc[mi][n][1]); o.y = cvt2(acc[mi][n][2], acc[mi][n][3]);
                *(v2u*)(UT + ((size_t)b * 256 + 16 * n + r16) * 256 + 16 * (2 * w + mi) + 4 * g) = o; }
    }
}
__device__ __forceinline__ void phase_scan_bf16(const Params& P, const Ctx& cx) {
    unsigned* UT = (unsigned*)(cx.ws + WS_U);
    const size_t gt = (size_t)cx.bid * 512 + cx.tid, NT = (size_t)cx.G * 512;
    for (size_t idx = gt; idx < 131072; idx += NT) {
        const int h = (int)(idx >> 15); const float cd = exp2f(P.lg2g[h] * 128.0f);
        float r0 = 0.f, r1 = 0.f;
        for (int n0 = 0; n0 < 128; n0 += 16) { unsigned u[16];
#pragma unroll
            for (int j = 0; j < 16; ++j) u[j] = UT[(size_t)(n0 + j) * 131072 + idx];
#pragma unroll
            for (int j = 0; j < 16; ++j) { UT[(size_t)(n0 + j) * 131072 + idx] = cvt2(r0, r1); r0 = r0 * cd + bflo(u[j]); r1 = r1 * cd + bfhi(u[j]); } }
    }
}
constexpr int RS_O = 1040;
static_assert(8 * 16 * RS_O <= 2 * TILE_T, "R3 output staging fits the shared area");
__device__ __forceinline__ void phase_ret_out_mfma(const Params& P, const Ctx& cx, int l, LAS unsigned char* lds) {
    unsigned char* ws = cx.ws; const int w = cx.wave;
    const bf16* Q = (const bf16*)(ws + WS_Q); const bf16* K = (const bf16*)(ws + WS_K); const bf16* V = (const bf16*)(ws + WS_V); const bf16* ST = (const bf16*)(ws + WS_U);
    const bf16* Gt = (const bf16*)(ws + WS_G); bf16* MIX = (bf16*)(ws + WS_MIX);
    const float* gg = P.in[5] + l * 1024; const float* gb = P.in[6] + l * 1024;
    LAS unsigned char* Kim = lds; LAS unsigned char* Vim = lds + TILE_T;
    for (int b = cx.bid; b < 512; b += cx.G) {
        const int nb = b >> 2, h = b & 3; const float lg = P.lg2g[h];
        int lane = cx.lane; asm volatile("" : "+v"(lane)); const int tid = w * 64 + lane, r16 = lane & 15, g = lane >> 4, q = r16 >> 2, pp = r16 & 3;
        __syncthreads();
        { const bf16* stb = ST + (size_t)b * 65536;
#pragma unroll
          for (int hf = 0; hf < 2; ++hf) { v4u v[8];
#pragma unroll
            for (int r = 0; r < 8; ++r) { const int pc = tid + 512 * (r + 8 * hf), row = pc >> 5, c16 = pc & 31; v[r] = *(const v4u*)(stb + (size_t)row * 256 + c16 * 8); }
#pragma unroll
            for (int r = 0; r < 8; ++r) { const int pc = tid + 512 * (r + 8 * hf), row = pc >> 5, c16 = pc & 31; *(LAS v4u*)(lds + row * RS_T + c16 * 16) = v[r]; } } }
        bf16x8 qf[8];
        { const bf16* qrow = Q + (size_t)(nb * 128 + 16 * w + r16) * 1024 + h * 256 + 8 * g;
#pragma unroll
          for (int s = 0; s < 8; ++s) qf[s] = *(const bf16x8*)(qrow + 32 * s); }
        const bf16* ksrc = K + (size_t)nb * 128 * 1024 + h * 256; const bf16* vsrc = V + (size_t)nb * 128 * 1024 + h * 256;
        v4u kv[8];
#pragma unroll
        for (int r = 0; r < 8; ++r) { const int pc = tid + 512 * r, row = pc >> 5, c16 = pc & 31; kv[r] = *(const v4u*)(ksrc + (size_t)row * 1024 + c16 * 8); }
        __syncthreads();
        f32x4 acc[16];
#pragma unroll
        for (int n = 0; n < 16; ++n) { f32x4 a = (f32x4){0.f, 0.f, 0.f, 0.f}; bf16x8 t[8];
            lds_rd8<64, 128, 192, 256, 320, 384, 448>(t, lds_addr(lds + (16 * n + r16) * RS_T + 16 * g));
#pragma unroll
            for (int s = 0; s < 8; ++s) a = mfma16(qf[s], t[s], a);
            acc[n] = a; }
        { float f[4];
#pragma unroll
          for (int r = 0; r < 4; ++r) f[r] = exp2f(lg * (float)(16 * w + 4 * g + r + 1));
#pragma unroll
          for (int n = 0; n < 16; ++n) { acc[n][0] *= f[0]; acc[n][1] *= f[1]; acc[n][2] *= f[2]; acc[n][3] *= f[3]; } }
        __syncthreads();
        v4u vv[8];
#pragma unroll
        for (int r = 0; r < 8; ++r) { const int pc = tid + 512 * r, row = pc >> 5, c16 = pc & 31; *(LAS v4u*)(Kim + row * RS_T + c16 * 16) = kv[r]; vv[r] = *(const v4u*)(vsrc + (size_t)row * 1024 + c16 * 8); }
        __syncthreads();
        f32x4 sc[8];
#pragma unroll
        for (int mb = 0; mb < 8; ++mb) { sc[mb] = (f32x4){0.f, 0.f, 0.f, 0.f};
            if (mb <= w) { f32x4 a = (f32x4){0.f, 0.f, 0.f, 0.f}; bf16x8 t[8];
                lds_rd8<64, 128, 192, 256, 320, 384, 448>(t, lds_addr(Kim + (16 * mb + r16) * RS_T + 16 * g));
#pragma unroll
                for (int s = 0; s < 8; ++s) a = mfma16(t[s], qf[s], a);
                const int i = 16 * w + r16;
#pragma unroll
                for (int r = 0; r < 4; ++r) { const int j = 16 * mb + 4 * g + r; a[r] = (i >= j) ? a[r] * exp2f(lg * (float)(i - j)) : 0.f; }
                sc[mb] = a; } }
#pragma unroll
        for (int r = 0; r < 8; ++r) { const int pc = tid + 512 * r, row = pc >> 5, c16 = pc & 31; *(LAS v4u*)(Vim + row * RS_T + c16 * 16) = vv[r]; }
        __syncthreads();
#pragma unroll
        for (int sk = 0; sk < 4; ++sk) {
            if (2 * sk <= w) { const bf16x8 pf = pack_frag(sc[2 * sk], sc[2 * sk + 1]);
#pragma unroll
                for (int ng = 0; ng < 4; ++ng) { const unsigned b0 = lds_addr(Vim + (32 * sk + 4 * g + q) * RS_T + (64 * ng + 4 * pp) * 2); s16x4 t[8];
                    lds_tr8<32, 64, 96>(t, b0, b0 + 16 * RS_T);
#pragma unroll
                    for (int nn = 0; nn < 4; ++nn) acc[4 * ng + nn] = mfma16(pf, cat44(t[nn], t[4 + nn]), acc[4 * ng + nn]); } } }
        float mean[4], rstd[4];
#pragma unroll
        for (int r = 0; r < 4; ++r) { float sm = 0.f;
#pragma unroll
            for (int n = 0; n < 16; ++n) sm += acc[n][r];
            mean[r] = grp16_sum(sm, lane) * (1.0f / 256.0f); }
#pragma unroll
        for (int r = 0; r < 4; ++r) { float sq = 0.f;
#pragma unroll
            for (int n = 0; n < 16; ++n) { const float d = acc[n][r] - mean[r]; sq += d * d; }
            rstd[r] = 1.0f / sqrtf(grp16_sum(sq, lane) * (1.0f / 256.0f) + GN_EPS); }
        __syncthreads();
        { LAS unsigned char* ob = lds + w * (16 * RS_O);
#pragma unroll
          for (int n = 0; n < 16; ++n)
#pragma unroll
            for (int r = 0; r < 4; ++r) *(LAS float*)(ob + (4 * g + r) * RS_O + (16 * n + r16) * 4) = (acc[n][r] - mean[r]) * rstd[r];
          LDS_WAIT(); asm volatile("" ::: "memory");
          const int e0 = 8 * (lane & 31), hv = lane >> 5;
          const f32x4 g0 = *(const f32x4*)(gg + h * 256 + e0), g1 = *(const f32x4*)(gg + h * 256 + e0 + 4), b0 = *(const f32x4*)(gb + h * 256 + e0), b1 = *(const f32x4*)(gb + h * 256 + e0 + 4);
#pragma unroll
          for (int k = 0; k < 8; ++k) { const int rl = 2 * k + hv; const size_t row = (size_t)(nb * 128 + 16 * w + rl);
              const f32x4 y0 = *(const LAS f32x4*)(ob + rl * RS_O + e0 * 4), y1 = *(const LAS f32x4*)(ob + rl * RS_O + e0 * 4 + 16);
              const v4u gt = *(const v4u*)(Gt + row * 1024 + h * 256 + e0);
              const f32x4 o0 = y0 * g0 + b0, o1 = y1 * g1 + b1;
              v4u o; o.x = cvt2(o0[0] * bflo(gt.x), o0[1] * bfhi(gt.x)); o.y = cvt2(o0[2] * bflo(gt.y), o0[3] * bfhi(gt.y)); o.z = cvt2(o1[0] * bflo(gt.z), o1[1] * bfhi(gt.z)); o.w = cvt2(o1[2] * bflo(gt.w), o1[3] * bfhi(gt.w));
              *(v4u*)(MIX + row * 2048 + h * 256 + e0) = o; } }
    }
}
constexpr int RS_SK = 144, RS_SV = 160;
__device__ __forceinline__ void phase_swa_mfma(const Params& P, const Ctx& cx, int l, LAS unsigned char* lds) {
    unsigned char* ws = cx.ws; const int tid = cx.tid, lane = cx.lane, w = cx.wave, r16 = lane & 15, g = lane >> 4, q = r16 >> 2, pp = r16 & 3;
    const bf16* AQ = (const bf16*)(ws + WS_AQ); const bf16* AK = (const bf16*)(ws + WS_AK); const bf16* AV = (const bf16*)(ws + WS_AV); bf16* MIX = (bf16*)(ws + WS_MIX);
    LAS unsigned char* Kim = lds; LAS unsigned char* Vim = lds + 256 * RS_SK;
    for (int item = cx.bid; item < 256; item += cx.G) {
        const int nb = item >> 1, hk = item & 1, hq = hk * 8 + w; const float sink = P.in[7][l * 16 + hq];
        __syncthreads();
#pragma unroll
        for (int r = 0; r < 4; ++r) { const int pc = tid + 512 * r, row = pc >> 3, c = pc & 7, gk = nb * 128 - 128 + row;
            v4u kv = (v4u){0u, 0u, 0u, 0u}, vv = (v4u){0u, 0u, 0u, 0u};
            if (gk >= 0) { kv = *(const v4u*)(AK + (size_t)gk * 128 + hk * 64 + c * 8); vv = *(const v4u*)(AV + (size_t)gk * 128 + hk * 64 + c * 8); }
            *(LAS v4u*)(Kim + row * RS_SK + c * 16) = kv; *(LAS v4u*)(Vim + row * RS_SV + c * 16) = vv; }
        __syncthreads();
        const bf16* qbase = AQ + (size_t)(nb * 128 + r16) * 1024 + hq * 64 + 8 * g;
        bf16x8 qn0 = *(const bf16x8*)(qbase), qn1 = *(const bf16x8*)(qbase + 32);
#pragma unroll 1
        for (int nq = 0; nq < 8; ++nq) {
            const bf16x8 qf0 = qn0, qf1 = qn1;
            { const bf16* qrow = qbase + (size_t)(16 * (nq < 7 ? nq + 1 : 7)) * 1024; qn0 = *(const bf16x8*)(qrow); qn1 = *(const bf16x8*)(qrow + 32); }
            f32x4 sc[10];
            float mx = sink;
            bf16x8 kt[18];
            { const unsigned kp0 = lds_addr(Kim + (16 * nq + r16) * RS_SK + 16 * g);
              bf16x8 t[8];
              lds_rd8<64, 16 * RS_SK, 16 * RS_SK + 64, 32 * RS_SK, 32 * RS_SK + 64, 48 * RS_SK, 48 * RS_SK + 64>(t, kp0);
#pragma unroll
              for (int i = 0; i < 8; ++i) kt[i] = t[i];
              lds_rd8<64, 16 * RS_SK, 16 * RS_SK + 64, 32 * RS_SK, 32 * RS_SK + 64, 48 * RS_SK, 48 * RS_SK + 64>(t, kp0 + 64 * RS_SK);
#pragma unroll
              for (int i = 0; i < 8; ++i) kt[8 + i] = t[i];
              kt[16] = *(const LAS bf16x8*)(Kim + (16 * (nq + 8) + r16) * RS_SK + 16 * g); kt[17] = *(const LAS bf16x8*)(Kim + (16 * (nq + 8) + r16) * RS_SK + 16 * g + 64); }
#pragma unroll
            for (int kb = 0; kb < 9; ++kb) {
                f32x4 a = (f32x4){0.f, 0.f, 0.f, 0.f};
                a = mfma16(kt[2 * kb], qf0, a); a = mfma16(kt[2 * kb + 1], qf1, a);
#pragma unroll
                for (int r = 0; r < 4; ++r) { const int dl = 16 * kb + 4 * g + r - r16; const bool vis = (dl >= 1) && (dl <= 128) && (nb > 0 || 16 * (nq + kb) + 4 * g + r >= 128);
                    a[r] = vis ? a[r] : -INFINITY; mx = fmaxf(mx, a[r]); }
                sc[kb] = a; }
            sc[9] = (f32x4){0.f, 0.f, 0.f, 0.f};
            mx = fmaxf(mx, __builtin_bit_cast(float, __builtin_amdgcn_ds_bpermute((lane ^ 16) << 2, __builtin_bit_cast(int, mx))));
            mx = fmaxf(mx, __builtin_bit_cast(float, __builtin_amdgcn_ds_bpermute((lane ^ 32) << 2, __builtin_bit_cast(int, mx))));
            float sum = 0.f;
#pragma unroll
            for (int kb = 0; kb < 9; ++kb)
#pragma unroll
                for (int r = 0; r < 4; ++r) { const float pv = __expf(sc[kb][r] - mx); sc[kb][r] = pv; sum += pv; }
            sum += __builtin_bit_cast(float, __builtin_amdgcn_ds_bpermute((lane ^ 16) << 2, __builtin_bit_cast(int, sum)));
            sum += __builtin_bit_cast(float, __builtin_amdgcn_ds_bpermute((lane ^ 32) << 2, __builtin_bit_cast(int, sum)));
            const float inv = 1.0f / (sum + __expf(sink - mx));
            f32x4 o[4];
#pragma unroll
            for (int nd = 0; nd < 4; ++nd) o[nd] = (f32x4){0.f, 0.f, 0.f, 0.f};
#pragma unroll
            for (int sk = 0; sk < 5; ++sk) { const bf16x8 pf = pack_frag(sc[2 * sk] * inv, sc[2 * sk + 1] * inv);
                const int kb0 = nq + 2 * sk, kb1 = (kb0 + 1 > 15) ? 15 : kb0 + 1;
                s16x4 t[8];
                lds_tr8<32, 64, 96>(t, lds_addr(Vim + (16 * kb0 + 4 * g + q) * RS_SV + 8 * pp), lds_addr(Vim + (16 * kb1 + 4 * g + q) * RS_SV + 8 * pp));
#pragma unroll
                for (int nd = 0; nd < 4; ++nd) o[nd] = mfma16(pf, cat44(t[nd], t[4 + nd]), o[nd]); }
#pragma unroll
            for (int nd = 0; nd < 4; ++nd)
#pragma unroll
                for (int r = 0; r < 4; ++r) MIX[(size_t)(nb * 128 + 16 * nq + 4 * g + r) * 2048 + 1024 + hq * 64 + 16 * nd + r16] = (bf16)f2bf(o[nd][r]);
        }
    }
}

__device__ __forceinline__ void phase_groupnorm(const Params& P, const Ctx& cx, int l) {
    unsigned char* ws = cx.ws; const int lane = cx.lane, wave = cx.wave, G = cx.G;
    const float* RY = (const float*)(ws + WS_RETY); const bf16* Gt = (const bf16*)(ws + WS_G); bf16* MIX = (bf16*)(ws + WS_MIX);
    const float* gg = P.in[5] + l * 1024; const float* gb = P.in[6] + l * 1024;
    const int gw = cx.bid * 8 + wave, NGW = G * 8;
    for (int it = gw; it < S * 4; it += NGW) { const int row = it >> 2, h = it & 3; const size_t off = (size_t)row * 1024 + h * 256 + 4 * lane;
        f32x4 v = *(const f32x4*)(RY + off);
        const float mean = wave_sum((v[0] + v[1]) + (v[2] + v[3]), lane) * (1.0f / 256.0f);
        v = v - mean;
        const float var = wave_sum((v[0] * v[0] + v[1] * v[1]) + (v[2] * v[2] + v[3] * v[3]), lane) * (1.0f / 256.0f);
        const float rstd = 1.0f / sqrtf(var + GN_EPS);
        const f32x4 g4 = *(const f32x4*)(gg + h * 256 + 4 * lane), b4 = *(const f32x4*)(gb + h * 256 + 4 * lane);
        const v2u gt2 = *(const v2u*)(Gt + off);
        f32x4 o = v * rstd * g4 + b4;
        o[0] *= bflo(gt2.x); o[1] *= bfhi(gt2.x); o[2] *= bflo(gt2.y); o[3] *= bfhi(gt2.y);
        v2u w; w.x = pk2(o[0], o[1]); w.y = pk2(o[2], o[3]);
        *(v2u*)(MIX + (size_t)row * 2048 + h * 256 + 4 * lane) = w; }
}
__device__ __forceinline__ void phase_ln(const Ctx& cx, const float* Y, const float* g, const float* b, float* xo, bf16* xb, float* stats) {
    const int lane = cx.lane, wave = cx.wave, G = cx.G; const int gw = cx.bid * 8 + wave, NGW = G * 8;
    f32x4 g4[8], b4[8];
#pragma unroll
    for (int j = 0; j < 8; ++j) { g4[j] = ((const f32x4*)g)[64 * j + lane]; b4[j] = ((const f32x4*)b)[64 * j + lane]; }
    for (int row = gw; row < S; row += 2 * NGW) {
        const int row2 = row + NGW; const bool has2 = row2 < S; const int rb = has2 ? row2 : row;
        const f32x4* ya = (const f32x4*)(Y + (size_t)row * D) + lane; const f32x4* yb = (const f32x4*)(Y + (size_t)rb * D) + lane;
        f32x4 va[8], vb[8]; float sa = 0.f, sb = 0.f;
#pragma unroll
        for (int j = 0; j < 8; ++j) { va[j] = ya[64 * j]; vb[j] = yb[64 * j]; }
#pragma unroll
        for (int j = 0; j < 8; ++j) { sa += (va[j][0] + va[j][1]) + (va[j][2] + va[j][3]); sb += (vb[j][0] + vb[j][1]) + (vb[j][2] + vb[j][3]); }
        const float ma = wave_sum(sa, lane) * (1.0f / D), mb = wave_sum(sb, lane) * (1.0f / D); float qa = 0.f, qb = 0.f;
#pragma unroll
        for (int j = 0; j < 8; ++j) { va[j] = va[j] - ma; vb[j] = vb[j] - mb; qa += (va[j][0] * va[j][0] + va[j][1] * va[j][1]) + (va[j][2] * va[j][2] + va[j][3] * va[j][3]); qb += (vb[j][0] * vb[j][0] + vb[j][1] * vb[j][1]) + (vb[j][2] * vb[j][2] + vb[j][3] * vb[j][3]); }
        const float ra = 1.0f / sqrtf(wave_sum(qa, lane) * (1.0f / D) + LN_EPS), rbb = 1.0f / sqrtf(wave_sum(qb, lane) * (1.0f / D) + LN_EPS);
        f32x4* xa = (f32x4*)(xo + (size_t)row * D) + lane; f32x4* xbp = (f32x4*)(xo + (size_t)rb * D) + lane;
        if (stats && lane == 0) { stats[2 * (size_t)row] = ma; stats[2 * (size_t)row + 1] = ra; if (has2) { stats[2 * (size_t)rb] = mb; stats[2 * (size_t)rb + 1] = rbb; } }
#pragma unroll
        for (int j = 0; j < 8; ++j) { const f32x4 o = va[j] * ra * g4[j] + b4[j]; if (xo) xa[64 * j] = o;
            if (xb) { v2u w; w.x = pk2(o[0], o[1]); w.y = pk2(o[2], o[3]); ((v2u*)(xb + (size_t)row * D))[64 * j + lane] = w; } }
        if (has2) {
#pragma unroll
            for (int j = 0; j < 8; ++j) { const f32x4 o = vb[j] * rbb * g4[j] + b4[j]; if (xo) xbp[64 * j] = o;
                if (xb) { v2u w; w.x = pk2(o[0], o[1]); w.y = pk2(o[2], o[3]); ((v2u*)(xb + (size_t)rb * D))[64 * j + lane] = w; } } }
    }
}
__device__ __forceinline__ void unpack8(const v4u h, float (&o)[8]) { o[0] = bflo(h.x); o[1] = bfhi(h.x); o[2] = bflo(h.y); o[3] = bfhi(h.y); o[4] = bflo(h.z); o[5] = bfhi(h.z); o[6] = bflo(h.w); o[7] = bfhi(h.w); }
__device__ __forceinline__ void phase_convact(const Params& P, const Ctx& cx, int l) {
    unsigned char* ws = cx.ws; const int tid = cx.tid, G = cx.G;
    const bf16* H = (const bf16*)(ws + WS_H); bf16* ACT = (bf16*)(ws + WS_ACT);
    const float* cw = P.in[11] + (size_t)l * 3 * NUP; const float* cb = P.in[12] + (size_t)l * NUP;
    const int gt = cx.bid * 512 + tid, NT = G * 512;
    for (int item = gt; item < 512 * 704; item += NT) {
        const int seg = item / 704, r = item - seg * 704, tile = r >> 4, q8 = r & 15, t0 = seg * 32;
        const int chg = 128 * tile + 8 * q8, chu = DFF + chg;
        float wg[3][8], wu[3][8], bg[8], bu[8];
#pragma unroll
        for (int k = 0; k < 3; ++k) { const f32x4 a0 = *(const f32x4*)(cw + (size_t)k * NUP + chg), a1 = *(const f32x4*)(cw + (size_t)k * NUP + chg + 4), c0 = *(const f32x4*)(cw + (size_t)k * NUP + chu), c1 = *(const f32x4*)(cw + (size_t)k * NUP + chu + 4);
#pragma unroll
            for (int e = 0; e < 4; ++e) { wg[k][e] = a0[e]; wg[k][4 + e] = a1[e]; wu[k][e] = c0[e]; wu[k][4 + e] = c1[e]; } }
        { const f32x4 a0 = *(const f32x4*)(cb + chg), a1 = *(const f32x4*)(cb + chg + 4), c0 = *(const f32x4*)(cb + chu), c1 = *(const f32x4*)(cb + chu + 4);
#pragma unroll
          for (int e = 0; e < 4; ++e) { bg[e] = a0[e]; bg[4 + e] = a1[e]; bu[e] = c0[e]; bu[4 + e] = c1[e]; } }
        const bf16* hp = H + (size_t)t0 * NUP + 256 * tile + 8 * q8;
        float g2[8], g1[8], u2[8], u1[8];
        if (t0 > 0) { unpack8(*(const v4u*)(hp - 2 * (size_t)NUP), g2); unpack8(*(const v4u*)(hp - (size_t)NUP), g1); unpack8(*(const v4u*)(hp - 2 * (size_t)NUP + 128), u2); unpack8(*(const v4u*)(hp - (size_t)NUP + 128), u1); }
        else {
#pragma unroll
            for (int e = 0; e < 8; ++e) { g2[e] = 0.f; g1[e] = 0.f; u2[e] = 0.f; u1[e] = 0.f; } }
        bf16* ap = ACT + (size_t)t0 * DFF + chg;
        v4u ng = *(const v4u*)(hp), nu = *(const v4u*)(hp + 128);
#pragma unroll 2
        for (int tt = 0; tt < 32; ++tt) {
            float g0[8], u0[8]; unpack8(ng, g0); unpack8(nu, u0);
            if (tt < 31) { ng = *(const v4u*)(hp + (size_t)(tt + 1) * NUP); nu = *(const v4u*)(hp + (size_t)(tt + 1) * NUP + 128); }
            float o[8];
#pragma unroll
            for (int e = 0; e < 8; ++e) { const float ga = bg[e] + wg[0][e] * g2[e] + wg[1][e] * g1[e] + wg[2][e] * g0[e], ua = bu[e] + wu[0][e] * u2[e] + wu[1][e] * u1[e] + wu[2][e] * u0[e];
                o[e] = ga * __builtin_amdgcn_rcpf(1.0f + __expf(-ga)) * ua; g2[e] = g1[e]; g1[e] = g0[e]; u2[e] = u1[e]; u1[e] = u0[e]; }
            v4u w; w.x = cvt2(o[0], o[1]); w.y = cvt2(o[2], o[3]); w.z = cvt2(o[4], o[5]); w.w = cvt2(o[6], o[7]);
            *(v4u*)(ap + (size_t)tt * DFF) = w;
        }
    }
}

__device__ __forceinline__ void phase_conv_fixup(const Params& P, const Ctx& cx, int l) {
    unsigned char* ws = cx.ws;
    const bf16* HALO = (const bf16*)(ws + WS_H); bf16* ACT = (bf16*)(ws + WS_ACT);
    const float* cw = P.in[11] + (size_t)l * 3 * NUP; const float* cb = P.in[12] + (size_t)l * NUP;
    const int gt = cx.bid * 512 + cx.tid, NT = cx.G * 512;
    for (int item = gt; item < 256 * 704; item += NT) {
        const int k = item / 704, r = item - k * 704, tile = r >> 4, q8 = r & 15, chg = 128 * tile + 8 * q8, chu = DFF + chg;
        float a_g[8], b_g[8], c_g[8], d_g[8], a_u[8], b_u[8], c_u[8], d_u[8];
        const bf16* hk = HALO + (size_t)k * 4 * NUP + 256 * tile + 8 * q8;
        unpack8(*(const v4u*)(hk), c_g); unpack8(*(const v4u*)(hk + NUP), d_g); unpack8(*(const v4u*)(hk + 128), c_u); unpack8(*(const v4u*)(hk + NUP + 128), d_u);
        if (k > 0) { const bf16* hm = hk - 4 * (size_t)NUP; unpack8(*(const v4u*)(hm + 2 * NUP), a_g); unpack8(*(const v4u*)(hm + 3 * NUP), b_g); unpack8(*(const v4u*)(hm + 2 * NUP + 128), a_u); unpack8(*(const v4u*)(hm + 3 * NUP + 128), b_u); }
        else {
#pragma unroll
            for (int e = 0; e < 8; ++e) { a_g[e] = 0.f; b_g[e] = 0.f; a_u[e] = 0.f; b_u[e] = 0.f; } }
        float o0[8], o1[8];
#pragma unroll
        for (int e = 0; e < 8; ++e) { const float w0g = cw[chg + e], w1g = cw[NUP + chg + e], w2g = cw[2 * NUP + chg + e], bgv = cb[chg + e], w0u = cw[chu + e], w1u = cw[NUP + chu + e], w2u = cw[2 * NUP + chu + e], buv = cb[chu + e];
            const float g0 = bgv + w0g * a_g[e] + w1g * b_g[e] + w2g * c_g[e], u0 = buv + w0u * a_u[e] + w1u * b_u[e] + w2u * c_u[e];
            const float g1 = bgv + w0g * b_g[e] + w1g * c_g[e] + w2g * d_g[e], u1 = buv + w0u * b_u[e] + w1u * c_u[e] + w2u * d_u[e];
            o0[e] = g0 * __builtin_amdgcn_rcpf(1.0f + __expf(-g0)) * u0; o1[e] = g1 * __builtin_amdgcn_rcpf(1.0f + __expf(-g1)) * u1; }
        v4u w0, w1; w0.x = cvt2(o0[0], o0[1]); w0.y = cvt2(o0[2], o0[3]); w0.z = cvt2(o0[4], o0[5]); w0.w = cvt2(o0[6], o0[7]); w1.x = cvt2(o1[0], o1[1]); w1.y = cvt2(o1[2], o1[3]); w1.z = cvt2(o1[4], o1[5]); w1.w = cvt2(o1[6], o1[7]);
        *(v4u*)(ACT + pg8::tiled_off(64 * k, chg, DFF)) = w0; *(v4u*)(ACT + pg8::tiled_off(64 * k + 1, chg, DFF)) = w1;
    }
}

#ifdef DBG_DUMP
__device__ __forceinline__ void phase_dump(const Ctx& cx, float* out, const bf16* a, int lda, const bf16* b, int ldb, const float* f) {
    const size_t gt = (size_t)cx.bid * 512 + cx.tid, NT = (size_t)cx.G * 512;
    for (size_t i = gt; i < (size_t)S * D; i += NT) { const int row = (int)(i >> 11), col = (int)(i & 2047);
        float v; if (f) v = f[i]; else if (b && col >= 1024) v = bf1(b + (size_t)row * ldb + (col - 1024)); else v = lda ? bf1(a + (size_t)row * lda + col) : bf1(a + (size_t)(row & 2047) * 2048 + col);
        out[i] = v; }
}
#endif
__device__ __forceinline__ void finalize_panel_stats(const Ctx& cx, const float* pstat, float* st, int pm) {
    const int tid = cx.tid, lane = cx.lane, row = pm * 256 + (tid >> 1), hf = tid & 1;
    const f32x4* pp = (const f32x4*)(pstat + ((size_t)row * 32 + 16 * hf) * 2);
    float s1 = 0.f, s2 = 0.f;
#pragma unroll
    for (int k = 0; k < 8; ++k) { const f32x4 v = pp[k]; s1 += v[0] + v[2]; s2 += v[1] + v[3]; }
    s1 += __builtin_bit_cast(float, __builtin_amdgcn_ds_bpermute((lane ^ 1) << 2, __builtin_bit_cast(int, s1)));
    s2 += __builtin_bit_cast(float, __builtin_amdgcn_ds_bpermute((lane ^ 1) << 2, __builtin_bit_cast(int, s2)));
    const float mean = s1 * (1.0f / D), var = fmaxf(s2 * (1.0f / D) - mean * mean, 0.f), rstd = 1.0f / sqrtf(var + LN_EPS);
    if (!hf) *(pg8::f32x2*)(st + 2 * (size_t)row) = (pg8::f32x2){mean, rstd};
}
template <class Sched> __device__ __forceinline__ void finalize_stats_for(const Ctx& cx, const Sched& So, const float* pstat, float* st) {
    int last = -1; pg8::Unit u;
    for (int i = 0; So.next(i, u); ++i) if (u.pm != last) { finalize_panel_stats(cx, pstat, st, u.pm); last = u.pm; }
    asm volatile("s_waitcnt vmcnt(0)" ::: "memory"); __syncthreads();
}
__global__ void __launch_bounds__(512, 2) fwd(Params P) {
    extern __shared__ __attribute__((aligned(16))) unsigned char lds_raw[];
    LAS unsigned char* lds = (LAS unsigned char*)lds_raw;
    const int wave = __builtin_amdgcn_readfirstlane(threadIdx.x >> 6), G = gridDim.x;
    unsigned char* ws = P.ws;
    volatile LAS unsigned* MISC = (volatile LAS unsigned*)(lds + MISC_OFF);
    for (int u = threadIdx.x; u < (LDS_BYTES - LDSCTL_OFF) / 4; u += 512) ((LAS unsigned*)(lds + LDSCTL_OFF))[u] = 0u;
    __syncthreads();
    const int lo = P.ph_lo, hi = P.ph_hi;
    XcdBarrier bar; bar.bar = (unsigned*)(ws + WS_CTL) + CW_BAR; bar.x = 0; bar.st = nullptr;
    if (hi - lo > 1) bar = xcd_barrier_post((unsigned*)(ws + WS_CTL) + CW_BAR, MISC + 8);
#define IN(k) (lo <= (k) && (k) < hi)
#if PROBE_DUP == 20
#define SEAM(k) do { if (IN(k) && IN((k) + 1)) { xcd_barrier(bar); xcd_barrier(bar); } } while (0)
#else
#define SEAM(k) do { if (IN(k) && IN((k) + 1)) xcd_barrier(bar); } while (0)
#endif
#define OPQ() Ctx cx; cx.lane = lane_id_asm(); { int t_ = wave; asm volatile("" : "+s"(t_)); cx.wave = t_; } { int t_ = G; asm volatile("" : "+s"(t_)); cx.G = t_; } { int t_ = blockIdx.x; asm volatile("" : "+s"(t_)); cx.bid = t_; } \
    { unsigned t_ = 0u; asm volatile("" : "+s"(t_)); cx.ws = P.ws + t_; } cx.tid = cx.wave * 64 + cx.lane; int lq = l; asm volatile("" : "+s"(lq)); (void)lq

#ifdef DBG_DUMP
    if (lo >= 1000) { const int l = 0; OPQ(); unsigned char* w = cx.ws; const int kind = lo - 1000;
        if (kind == 1) phase_dump(cx, P.out, (const bf16*)(w + WS_Q), 1024, (const bf16*)(w + WS_AQ), 1024, nullptr);
        else if (kind == 2) phase_dump(cx, P.out, (const bf16*)(w + WS_MIX), 2048, nullptr, 0, nullptr);
        else if (kind == 3) phase_dump(cx, P.out, nullptr, 0, nullptr, 0, (const float*)(w + WS_XR));
        else if (kind == 4) phase_dump(cx, P.out, (const bf16*)(w + WS_ACT), DFF, nullptr, 0, nullptr);
        else if (kind == 5) phase_dump(cx, P.out, nullptr, 0, nullptr, 0, (const float*)(w + WS_Y));
        else if (kind == 6) phase_dump(cx, P.out, (const bf16*)(w + WS_K), 1024, (const bf16*)(w + WS_V), 1024, nullptr);
        else if (kind == 7) phase_dump(cx, P.out, (const bf16*)(w + WS_XB), 2048, nullptr, 0, nullptr);
        else if (kind == 11) phase_dump(cx, P.out, (const bf16*)(w + WS_W + WL_G), 0, nullptr, 0, nullptr);
        else if (kind == 12) phase_dump(cx, P.out, (const bf16*)(w + WS_W + WL_OUT), 0, nullptr, 0, nullptr);
        else if (kind == 10) phase_dump(cx, P.out, (const bf16*)(w + WS_H) + 36 * 256, NUP, nullptr, 0, nullptr);
        else if (kind == 9) phase_dump(cx, P.out, (const bf16*)(w + WS_SG), 2048, nullptr, 0, nullptr);
        else if (kind == 8) phase_dump(cx, P.out, nullptr, 0, nullptr, 0, (const float*)(w + WS_RETY));
        return; }
#endif
    if (IN(0)) { const int l = 0; REPS(9) { __syncthreads(); OPQ(); phase_prologue(P, cx, lds); } }
    SEAM(0);

    for (int l = 0; l < DEPTH; ++l) {
        const int pb = 1 + l * NPH;
#if LN_FUSED
        if (l == 0 && IN(pb + 0)) { OPQ(); const float* cp = (const float*)(cx.ws + WS_CP); float* cc = (float*)(cx.ws + WS_C);
            for (int i = cx.bid * 512 + cx.tid; i < DEPTH * C_L; i += cx.G * 512) { float a = 0.f;
                if (i >= 2 * INW) {
#pragma unroll
                    for (int kc = 0; kc < 8; ++kc) a += cp[(size_t)kc * DEPTH * C_L + i]; }
                cc[i] = a; } }
#endif
        if (IN(pb + 0)) { REPS(3) { OPQ(); unsigned char* w = cx.ws; const bf16* wl = (const bf16*)(w + WS_W + (size_t)lq * WL_BYTES);
            pg8::Gemm g{(const bf16*)(w + WS_XB), wl + WL_IN / 2, S, INW, D}; pg8::StaticOrder So; So.init(S, INW, cx.G, cx.bid);
#if LN_FUSED
            if (lq > 0) { const float* cl = (const float*)(w + WS_C) + (size_t)lq * C_L;
                finalize_stats_for(cx, So, (const float*)(w + WS_PSTAT), (float*)(w + WS_ST2));
                pg8::EpiInProjT<true> E{(bf16*)(w + WS_Q), (bf16*)(w + WS_K), (bf16*)(w + WS_V), (bf16*)(w + WS_G), (bf16*)(w + WS_AQ), (bf16*)(w + WS_AK), (bf16*)(w + WS_AV),
                                        (const float*)(w + WS_COSR), (const float*)(w + WS_SINR), (const float*)(w + WS_COSA), (const float*)(w + WS_SINA), (const float*)(w + WS_ST2), cl + C1IN, cl + C2IN};
                pg8::gemm_phase<pg8::EpiInProjT<true>, pg8::StaticOrder, true, true>(lds, g, So, E, cx.wave); }
            else
#endif
            { pg8::EpiInProj E{(bf16*)(w + WS_Q), (bf16*)(w + WS_K), (bf16*)(w + WS_V), (bf16*)(w + WS_G), (bf16*)(w + WS_AQ), (bf16*)(w + WS_AK), (bf16*)(w + WS_AV),
                             (const float*)(w + WS_COSR), (const float*)(w + WS_SINR), (const float*)(w + WS_COSA), (const float*)(w + WS_SINA), nullptr, nullptr, nullptr};
              pg8::gemm_phase<pg8::EpiInProj, pg8::StaticOrder, true, true>(lds, g, So, E, cx.wave); }
        } }
#if PLE_EARLY
        if (IN(pb + 0)) { OPQ(); unsigned char* w = cx.ws; const bf16* wl = (const bf16*)(w + WS_W + (size_t)lq * WL_BYTES);
            const int nsub = (cx.G > 64) ? cx.G - 64 : cx.G, csub = (cx.G > 64) ? cx.bid - 64 : cx.bid;
            if (csub >= 0) {
                int kple = PLE; asm volatile("" : "+s"(kple));
                pg8::Gemm g{(const bf16*)(w + WS_PB) + (size_t)lq * S * PLE, wl + WL_P / 2, S, D, kple}; pg8::StaticOrder So; So.init(S, D, nsub, csub);
                pg8::EpiPlain E{(bf16*)(w + WS_PP)};
                pg8::gemm_phase<pg8::EpiPlain, pg8::StaticOrder, true, true>(lds, g, So, E, cx.wave); }
        }
#endif
        SEAM(pb + 0);
        if (IN(pb + 1)) {
#if RET_MFMA
            { REPS(6) { OPQ(); phase_ret_u_mfma(P, cx, lds); } }
#else
            { OPQ(); phase_ret_u_scores(P, cx, lds); }
#endif
#if SWA_MFMA
            { REPS(8) { OPQ(); phase_swa_mfma(P, cx, lq, lds); } }
#else
            { OPQ(); phase_swa(P, cx, lq, lds); }
#endif
        }
        SEAM(pb + 1);
#if RET_MFMA
        if (IN(pb + 2)) { OPQ(); phase_scan_bf16(P, cx); }
        SEAM(pb + 2);
        if (IN(pb + 3)) { REPS(7) { OPQ(); phase_ret_out_mfma(P, cx, lq, lds); } }
        SEAM(pb + 3);
#else
        if (IN(pb + 2)) { OPQ(); phase_scan(P, cx); }
        SEAM(pb + 2);
        if (IN(pb + 3)) { OPQ(); phase_ret_out(P, cx, lds); }
        SEAM(pb + 3);
        if (IN(pb + 4)) { OPQ(); phase_groupnorm(P, cx, lq); }
        SEAM(pb + 4);
#endif
        if (IN(pb + 5)) { OPQ(); unsigned char* w = cx.ws; const bf16* wl = (const bf16*)(w + WS_W + (size_t)lq * WL_BYTES);
            pg8::Gemm g{(const bf16*)(w + WS_MIX), wl + WL_OUT / 2, S, D, D}; pg8::StaticOrder So; So.init(S, D, cx.G, cx.bid);
#if LN_FUSED
#if RES_BF16
            if (lq == 0) { pg8::EpiRes3<false, false> E{P.in[0], nullptr, (bf16*)(w + WS_XB), (_Float16*)(w + WS_YH), (float*)(w + WS_PSTAT), nullptr, nullptr, nullptr, nullptr, nullptr, ALPHA};
                pg8::gemm_phase<pg8::EpiRes3<false, false>, pg8::StaticOrder, true, true>(lds, g, So, E, cx.wave); }
            else { pg8::EpiRes3<true, false> E{nullptr, nullptr, (bf16*)(w + WS_XB), (_Float16*)(w + WS_YH), (float*)(w + WS_PSTAT), (const float*)(w + WS_ST2), P.in[14] + (lq - 1) * D, P.in[15] + (lq - 1) * D, nullptr, nullptr, ALPHA};
                pg8::gemm_phase<pg8::EpiRes3<true, false>, pg8::StaticOrder, true, true>(lds, g, So, E, cx.wave); }
#else
            if (lq == 0) { pg8::EpiRes2<false, false, true> E{P.in[0], (float*)(w + WS_Y), (bf16*)(w + WS_XB), (float*)(w + WS_PSTAT), nullptr, nullptr, nullptr, nullptr, nullptr, ALPHA};
                pg8::gemm_phase<pg8::EpiRes2<false, false, true>, pg8::StaticOrder, true, true>(lds, g, So, E, cx.wave); }
            else { pg8::EpiRes2<true, false, true> E{nullptr, (float*)(w + WS_Y), (bf16*)(w + WS_XB), (float*)(w + WS_PSTAT), (const float*)(w + WS_ST2), P.in[14] + (lq - 1) * D, P.in[15] + (lq - 1) * D, nullptr, nullptr, ALPHA};
                pg8::gemm_phase<pg8::EpiRes2<true, false, true>, pg8::StaticOrder, true, true>(lds, g, So, E, cx.wave); }
#endif
#elif LN_NOXR
            if (lq == 0) { pg8::EpiResid<false> E{P.in[0], (float*)(w + WS_Y), ALPHA};
                pg8::gemm_phase<pg8::EpiResid<false>, pg8::StaticOrder, true, true>(lds, g, So, E, cx.wave); }
            else {
#if PROBE_DUP == 30
                { pg8::EpiResidLN<false> E{(float*)(w + WS_Y), (float*)(w + WS_XR + 2 * MiB), (const float*)(w + WS_ST2), P.in[14] + (lq - 1) * D, P.in[15] + (lq - 1) * D, nullptr, nullptr, ALPHA};
                  pg8::gemm_phase<pg8::EpiResidLN<false>, pg8::StaticOrder, true, true>(lds, g, So, E, cx.wave); }
#endif
                pg8::EpiResidLN<false> E{(float*)(w + WS_Y), (float*)(w + WS_Y), (const float*)(w + WS_ST2), P.in[14] + (lq - 1) * D, P.in[15] + (lq - 1) * D, nullptr, nullptr, ALPHA};
                pg8::gemm_phase<pg8::EpiResidLN<false>, pg8::StaticOrder, true, true>(lds, g, So, E, cx.wave); }
#else
            pg8::EpiResid<false> E{(lq == 0) ? P.in[0] : (const float*)(w + WS_XR), (float*)(w + WS_Y), ALPHA};
            pg8::gemm_phase<pg8::EpiResid<false>, pg8::StaticOrder, true, true>(lds, g, So, E, cx.wave);
#endif
        }
        SEAM(pb + 5);
#if !LN_FUSED
        if (IN(pb + 6)) { REPS(1) { OPQ(); unsigned char* w = cx.ws;
#if LN_NOXR
            phase_ln(cx, (const float*)(w + WS_Y), P.in[8] + lq * D, P.in[9] + lq * D, (float*)nullptr, (bf16*)(w + WS_XB), (float*)(w + WS_ST1));
#else
            phase_ln(cx, (const float*)(w + WS_Y), P.in[8] + lq * D, P.in[9] + lq * D, (float*)(w + WS_XR), (bf16*)(w + WS_XB), (float*)nullptr);
#endif
        } }
        SEAM(pb + 6);
#endif
        if (IN(pb + 7)) { REPS(5) { OPQ(); unsigned char* w = cx.ws; const bf16* wl = (const bf16*)(w + WS_W + (size_t)lq * WL_BYTES);
            pg8::Gemm g{(const bf16*)(w + WS_XB), wl + WL_UP / 2, S, NUPG, D}; pg8::StaticOrder So; So.init(S, NUPG, cx.G, cx.bid);
#if LN_FUSED
            { const float* cl = (const float*)(w + WS_C) + (size_t)lq * C_L;
              finalize_stats_for(cx, So, (const float*)(w + WS_PSTAT), (float*)(w + WS_ST1));
              pg8::EpiUpConvT<true> E{(bf16*)(w + WS_ACT), (bf16*)(w + WS_H), (bf16*)(w + WS_SG), P.in[17] + lq * D, P.in[11] + (size_t)lq * 3 * NUP, P.in[12] + (size_t)lq * NUP, (const float*)(w + WS_ST1), cl + C1UP, cl + C2UP};
              pg8::gemm_phase<pg8::EpiUpConvT<true>, pg8::StaticOrder, true, true>(lds, g, So, E, cx.wave); }
#elif CONV_FUSED
            pg8::EpiUpConv E{(bf16*)(w + WS_ACT), (bf16*)(w + WS_H), (bf16*)(w + WS_SG), P.in[17] + lq * D, P.in[11] + (size_t)lq * 3 * NUP, P.in[12] + (size_t)lq * NUP, nullptr, nullptr, nullptr};
            pg8::gemm_phase<pg8::EpiUpConv, pg8::StaticOrder, true, true>(lds, g, So, E, cx.wave);
#else
            pg8::EpiUp E{(bf16*)(w + WS_H), (bf16*)(w + WS_SG), P.in[17] + lq * D};
            pg8::gemm_phase<pg8::EpiUp, pg8::StaticOrder, true, true>(lds, g, So, E, cx.wave);
#endif
        } }
        SEAM(pb + 7);
        if (IN(pb + 8)) {
#if !PLE_EARLY
            { OPQ(); unsigned char* w = cx.ws; const bf16* wl = (const bf16*)(w + WS_W + (size_t)lq * WL_BYTES);
              pg8::Gemm g{(const bf16*)(w + WS_PB) + (size_t)lq * S * PLE, wl + WL_P / 2, S, D, PLE}; pg8::StaticOrder So; So.init(S, D, cx.G, cx.bid);
              pg8::EpiPle E{(const bf16*)(w + WS_SG), (float*)(w + WS_Y)};
              pg8::gemm_phase<pg8::EpiPle, pg8::StaticOrder, true, true>(lds, g, So, E, cx.wave); }
#endif
#if CONV_FUSED
            { OPQ(); phase_conv_fixup(P, cx, lq); }
#else
            { REPS(1) { OPQ(); phase_convact(P, cx, lq); } }
#endif
        }
        SEAM(pb + 8);
        if (IN(pb + 9)) { OPQ(); unsigned char* w = cx.ws; const bf16* wl = (const bf16*)(w + WS_W + (size_t)lq * WL_BYTES);
            pg8::Gemm g{(const bf16*)(w + WS_ACT), wl + WL_DOWN / 2, S, D, DFF, 0, 0, 1, 1}; pg8::StaticOrder So; So.init(S, D, cx.G, cx.bid);
#if LN_FUSED
#if RES_BF16
            pg8::EpiRes3<true, true> E{nullptr, (lq == DEPTH - 1) ? (float*)(w + WS_Y) : (float*)nullptr, (bf16*)(w + WS_XB), (_Float16*)(w + WS_YH), (float*)(w + WS_PSTAT), (const float*)(w + WS_ST1), P.in[8] + lq * D, P.in[9] + lq * D, (const bf16*)(w + WS_PP), (const bf16*)(w + WS_SG), ALPHA};
            pg8::gemm_phase<pg8::EpiRes3<true, true>, pg8::StaticOrder, true, true>(lds, g, So, E, cx.wave);
#else
            pg8::EpiRes2<true, true, true> E{nullptr, (float*)(w + WS_Y), (bf16*)(w + WS_XB), (float*)(w + WS_PSTAT), (const float*)(w + WS_ST1), P.in[8] + lq * D, P.in[9] + lq * D, (const bf16*)(w + WS_PP), (const bf16*)(w + WS_SG), ALPHA};
            pg8::gemm_phase<pg8::EpiRes2<true, true, true>, pg8::StaticOrder, true, true>(lds, g, So, E, cx.wave);
#endif
#elif PLE_EARLY
#if LN_NOXR
#if PROBE_DUP == 31
            { pg8::EpiResidLN<true> E{(float*)(w + WS_Y), (float*)(w + WS_XR + 2 * MiB), (const float*)(w + WS_ST1), P.in[8] + lq * D, P.in[9] + lq * D, (const bf16*)(w + WS_PP), (const bf16*)(w + WS_SG), ALPHA};
              pg8::gemm_phase<pg8::EpiResidLN<true>, pg8::StaticOrder, true, true>(lds, g, So, E, cx.wave); }
#endif
            pg8::EpiResidLN<true> E{(float*)(w + WS_Y), (float*)(w + WS_Y), (const float*)(w + WS_ST1), P.in[8] + lq * D, P.in[9] + lq * D, (const bf16*)(w + WS_PP), (const bf16*)(w + WS_SG), ALPHA};
            pg8::gemm_phase<pg8::EpiResidLN<true>, pg8::StaticOrder, true, true>(lds, g, So, E, cx.wave);
#else
            pg8::EpiDown E{(const float*)(w + WS_XR), (float*)(w + WS_Y), (const bf16*)(w + WS_PP), (const bf16*)(w + WS_SG), ALPHA};
            pg8::gemm_phase<pg8::EpiDown, pg8::StaticOrder, true, true>(lds, g, So, E, cx.wave);
#endif
#else
            pg8::EpiResid<true> E{(const float*)(w + WS_XR), (float*)(w + WS_Y), ALPHA};
            pg8::gemm_phase<pg8::EpiResid<true>, pg8::StaticOrder, true, true>(lds, g, So, E, cx.wave);
#endif
        }
#if LN_FUSED
        if (l == DEPTH - 1) { SEAM(pb + 9); { OPQ(); unsigned char* w = cx.ws; phase_ln(cx, (const float*)(w + WS_Y), P.in[14] + lq * D, P.in[15] + lq * D, P.out, (bf16*)nullptr, (float*)nullptr); } }
        else SEAM(pb + 9);
#else
        SEAM(pb + 9);
        if (IN(pb + 10)) { REPS(1) { OPQ(); unsigned char* w = cx.ws; const bool last = (lq == DEPTH - 1);

#if LN_NOXR
            phase_ln(cx, (const float*)(w + WS_Y), P.in[14] + lq * D, P.in[15] + lq * D, last ? P.out : (float*)nullptr, last ? (bf16*)nullptr : (bf16*)(w + WS_XB), last ? (float*)nullptr : (float*)(w + WS_ST2));
#else
            phase_ln(cx, (const float*)(w + WS_Y), P.in[14] + lq * D, P.in[15] + lq * D, last ? P.out : (float*)(w + WS_XR), last ? (bf16*)nullptr : (bf16*)(w + WS_XB), (float*)nullptr);
#endif
        } }
        SEAM(pb + 10);
#endif
    }
#undef IN
#undef SEAM
}

extern "C" void kernel_launch(void* const* d_in, const int* in_sizes, int n_in, void* d_out, int out_size, void* d_ws, size_t ws_size, hipStream_t stream) {
    static int grid = 0;
    if (grid == 0) {
        if (n_in != 19 || in_sizes[0] != S * D || out_size != S * D || ws_size < WS_END) { fprintf(stderr, "kernel_launch: unexpected shapes (n_in %d, in0 %d, out %d, ws %zu)\n", n_in, n_in > 0 ? in_sizes[0] : -1, out_size, ws_size); grid = -1; return; }
        int dev = 0, cus = 0, per_cu = 0;
        if (hipGetDevice(&dev) != hipSuccess || hipDeviceGetAttribute(&cus, hipDeviceAttributeMultiprocessorCount, dev) != hipSuccess) { grid = -1; return; }
        if (hipFuncSetAttribute((const void*)fwd, hipFuncAttributeMaxDynamicSharedMemorySize, LDS_BYTES) != hipSuccess) { fprintf(stderr, "kernel_launch: hipFuncSetAttribute failed\n"); grid = -1; return; }
        if (hipOccupancyMaxActiveBlocksPerMultiprocessor(&per_cu, (const void*)fwd, 512, LDS_BYTES) != hipSuccess || per_cu < 1) fprintf(stderr, "kernel_launch: occupancy query says %d\n", per_cu);
        (void)hipGetLastError();
        grid = cus;
    }
    if (grid < 0) return;
    (void)hipMemsetAsync((char*)d_ws + WS_CTL, 0, CTL_ZERO_BYTES, stream);
#ifdef DBG_NANFILL
    (void)hipMemsetAsync((char*)d_ws + CTL_ZERO_BYTES, 0xFF, WS_END - CTL_ZERO_BYTES, stream);
#endif
    Params p{};
    for (int i = 0; i < 19; ++i) p.in[i] = (const float*)d_in[i];
    p.out = (float*)d_out; p.ws = (unsigned char*)d_ws;
    for (int f = 0; f < 128; ++f) p.invf_ret[f] = (float)(1.0 / std::pow(10000.0, (double)((float)f / 127.0f)));
    for (int f = 0; f < 32; ++f) p.invf_att[f] = (float)std::pow(10000.0, -(double)(2 * f) / 64.0);
    for (int h = 0; h < 4; ++h) p.lg2g[h] = (float)std::log2(1.0 - std::exp2(-5.0 - h));
#if MK_ONE_LAUNCH
    p.ph_lo = 0; p.ph_hi = NPHASES;
    hipLaunchKernelGGL(fwd, dim3(grid), dim3(512), LDS_BYTES, stream, p);
#else
#ifdef DBG_DUMP
    for (int ph = 0; ph <= DBG_STOP; ++ph) { p.ph_lo = ph; p.ph_hi = ph + 1; hipLaunchKernelGGL(fwd, dim3(grid), dim3(512), LDS_BYTES, stream, p); }
    p.ph_lo = 1000 + DBG_DUMP; p.ph_hi = p.ph_lo + 1; hipLaunchKernelGGL(fwd, dim3(grid), dim3(512), LDS_BYTES, stream, p);
#else
    for (int ph = 0; ph < NPHASES; ++ph) { p.ph_lo = ph; p.ph_hi = ph + 1; hipLaunchKernelGGL(fwd, dim3(grid), dim3(512), LDS_BYTES, stream, p); }
#endif
#endif
}
```

```cpp
#include <hip/hip_runtime.h>
#include <cstdio>
#include <cstdint>
#include <cmath>
#define MK_ONE_LAUNCH 1
namespace pg8 {
#define PG8_LAS __attribute__((address_space(3)))
typedef unsigned short bf16_t;
typedef short bf16x8 __attribute__((ext_vector_type(8)));
typedef float f32x4 __attribute__((ext_vector_type(4)));
typedef unsigned u32x4 __attribute__((ext_vector_type(4)));
constexpr int BM = 256, BK = 64, HALF = 128, HTB = HALF * BK * 2  , STAGE_BYTES = 8 * HTB, NXCD = 8, WGM = 8;

__host__ __device__ __forceinline__ int lds_byte(int r, int c) { const int st = (r >> 4) * 2 + (c >> 5), rr = r & 15, cc = c & 31, ob = rr * 64 + cc * 2; return st * 1024 + (ob ^ (((ob >> 9) & 1) << 5)); }
__host__ __device__ __forceinline__ void stage_rc(int b, int& R, int& C) { const int st = b / 1024, sb = b % 1024, swz = sb ^ (((sb >> 9) & 1) << 5); R = (st >> 1) * 16 + swz / 64; C = (st & 1) * 32 + (swz % 64) / 2; }
__host__ __device__ __forceinline__ int perm32(int rho) { const int n = rho >> 4, i = rho & 15; return 8 * (i >> 2) + 4 * n + (i & 3); }

struct Unit { int pm, pn; };
struct Gemm { const bf16_t* A; const bf16_t* Bt; int M, N, K; int lda, ldb; int tiledA, tiledB; };

struct StaticOrder {
    int nM, nN, nwg, G, c;
    __host__ __device__ void init(int M, int N, int G_, int c_) { nM = M / BM; nN = N / BM; nwg = nM * nN; G = G_; c = c_; }
    __host__ __device__ bool next(int i, Unit& u) const {
        const long L = (long)i * G + c; if (L >= nwg) return false;
        int wgid = (int)L; { const int q = nwg / NXCD, r = nwg % NXCD, xcd = wgid % NXCD, off = wgid / NXCD; wgid = (xcd < r ? xcd * (q + 1) : r * (q + 1) + (xcd - r) * q) + off; }
        const int nig = WGM * nN, gid = wgid / nig, fm = gid * WGM, gsz = (nM - fm) < WGM ? (nM - fm) : WGM;
        u.pm = fm + ((wgid % nig) % gsz); u.pn = (wgid % nig) / gsz; return true;
    }
    __device__ __forceinline__ void a_ready(const Unit&) const {}
    __device__ __forceinline__ void done(const Unit&) const {}
};

typedef float f32x2c_t __attribute__((ext_vector_type(2))); typedef __bf16 bf16x2c_t __attribute__((ext_vector_type(2)));
__device__ __forceinline__ unsigned cvt_pk_bf16(float lo, float hi) { f32x2c_t v = {lo, hi}; bf16x2c_t b = __builtin_convertvector(v, bf16x2c_t); return __builtin_bit_cast(unsigned, b); }
typedef float f32x2 __attribute__((ext_vector_type(2)));
typedef unsigned u32x2 __attribute__((ext_vector_type(2)));
__host__ __device__ __forceinline__ size_t tiled_off(int row, int col, int K) { return ((size_t)((row >> 8) * (K >> 6) + (col >> 6)) * 256 + (row & 255)) * 64 + (col & 63); }
#ifndef EPI_NT
#define EPI_NT 0
#endif
template <class T> __device__ __forceinline__ void st_out(T* p, const T v) {
#if EPI_NT
    __builtin_nontemporal_store(v, p);
#else
    *p = v;
#endif
}

__device__ __forceinline__ float bf2f(unsigned short b) { return __uint_as_float(((unsigned)b) << 16); }
__device__ __forceinline__ u32x4 pack8(const f32x4 a, const f32x4 b) { u32x4 w; w.x = cvt_pk_bf16(a[0], a[1]); w.y = cvt_pk_bf16(a[2], a[3]); w.z = cvt_pk_bf16(b[0], b[1]); w.w = cvt_pk_bf16(b[2], b[3]); return w; }
__device__ __forceinline__ float sigmoidf_(float x) { return __builtin_amdgcn_rcpf(1.0f + __expf(-x)); }

template <bool LNFIX> struct EpiInProjT {
    static constexpr bool PERM = true, AFTER_DRAIN = false;
    bf16_t *Q, *K, *V, *G, *AQ, *AK, *AV; const float *cosr, *sinr, *cosa, *sina; const float *stats, *c1, *c2;
    __device__ __forceinline__ void operator()(f32x4 (&acc)[2][2][4][2], const Unit& u, int wr, int wc, int fr, int fq) const {
        const int row0 = u.pm * BM + wr * 64 + fr, pn = u.pn, cw = wc * 32 + 8 * fq;
        if (LNFIX) {
            f32x4 c1v[2][2], c2v[2][2];
#pragma unroll
            for (int bj = 0; bj < 2; ++bj)
#pragma unroll
                for (int n = 0; n < 2; ++n) { c1v[bj][n] = *(const f32x4*)(c1 + pn * 256 + bj * HALF + cw + 4 * n); c2v[bj][n] = *(const f32x4*)(c2 + pn * 256 + bj * HALF + cw + 4 * n); }
#pragma unroll
            for (int i = 0; i < 8; ++i) { const f32x2 st = *(const f32x2*)(stats + 2 * (size_t)(row0 + (i >> 2) * HALF + (i & 3) * 16));
#pragma unroll
                for (int bj = 0; bj < 2; ++bj)
#pragma unroll
                    for (int n = 0; n < 2; ++n) acc[i >> 2][bj][i & 3][n] = (acc[i >> 2][bj][i & 3][n] - c1v[bj][n] * st.x) * st.y + c2v[bj][n]; } }
        auto A = [&](int ai, int bj, int m, int n) -> f32x4 { return acc[ai][bj][m][n]; };
        if (pn < 8) {
            bf16_t* O = pn < 4 ? Q : K; const int hcol = (pn & 3) * 256; const float sc = pn < 4 ? 1.0f : 0.0625f;
#pragma unroll
            for (int ai = 0; ai < 2; ++ai)
#pragma unroll
                for (int m = 0; m < 4; ++m) { const int row = row0 + ai * HALF + m * 16;
                    const f32x4 c0 = *(const f32x4*)(cosr + (size_t)row * 128 + cw), c1 = *(const f32x4*)(cosr + (size_t)row * 128 + cw + 4);
                    const f32x4 s0 = *(const f32x4*)(sinr + (size_t)row * 128 + cw), s1 = *(const f32x4*)(sinr + (size_t)row * 128 + cw + 4);
                    const f32x4 a0 = A(ai, 0, m, 0), a1 = A(ai, 0, m, 1), b0 = A(ai, 1, m, 0), b1 = A(ai, 1, m, 1);
                    const f32x4 o10 = (a0 * c0 - b0 * s0) * sc, o11 = (a1 * c1 - b1 * s1) * sc, o20 = (a0 * s0 + b0 * c0) * sc, o21 = (a1 * s1 + b1 * c1) * sc;
                    bf16_t* rowp = O + (size_t)row * 1024 + hcol + cw;
                    st_out((u32x4*)(rowp), (u32x4)(pack8(o10, o11))); st_out((u32x4*)(rowp + HALF), (u32x4)(pack8(o20, o21))); }
        } else if (pn < 16) {
            const bool gate = pn >= 12; bf16_t* O = gate ? G : V; const int hcol = (pn & 3) * 256;
#pragma unroll
            for (int ai = 0; ai < 2; ++ai)
#pragma unroll
                for (int m = 0; m < 4; ++m) { const int row = row0 + ai * HALF + m * 16; bf16_t* rowp = O + (size_t)row * 1024 + hcol + cw;
#pragma unroll
                    for (int bj = 0; bj < 2; ++bj) { f32x4 v0 = A(ai, bj, m, 0), v1 = A(ai, bj, m, 1);
                        if (gate) {
#pragma unroll
                            for (int j = 0; j < 4; ++j) { v0[j] = v0[j] * sigmoidf_(v0[j]); v1[j] = v1[j] * sigmoidf_(v1[j]); } }
                        st_out((u32x4*)(rowp + bj * HALF), (u32x4)(pack8(v0, v1))); } }
        } else if (pn < 20) {
            const int t = pn - 16, i0 = 8 * fq;
#pragma unroll
            for (int ai = 0; ai < 2; ++ai)
#pragma unroll
                for (int m = 0; m < 4; ++m) { const int row = row0 + ai * HALF + m * 16;
                    const f32x4 c0 = *(const f32x4*)(cosa + (size_t)row * 32 + i0), c1 = *(const f32x4*)(cosa + (size_t)row * 32 + i0 + 4);
                    const f32x4 s0 = *(const f32x4*)(sina + (size_t)row * 32 + i0), s1 = *(const f32x4*)(sina + (size_t)row * 32 + i0 + 4);
                    const f32x4 a0 = A(ai, 0, m, 0), a1 = A(ai, 0, m, 1), b0 = A(ai, 1, m, 0), b1 = A(ai, 1, m, 1);
                    const f32x4 o10 = (a0 * c0 - b0 * s0) * 0.125f, o11 = (a1 * c1 - b1 * s1) * 0.125f, o20 = (a0 * s0 + b0 * c0) * 0.125f, o21 = (a1 * s1 + b1 * c1) * 0.125f;
                    bf16_t* rowp = AQ + (size_t)row * 1024 + t * 256 + wc * 64 + i0;
                    st_out((u32x4*)(rowp), (u32x4)(pack8(o10, o11))); st_out((u32x4*)(rowp + 32), (u32x4)(pack8(o20, o21))); }
        } else {
            const int i0 = 8 * fq;
            if (wc < 2) {
#pragma unroll
                for (int ai = 0; ai < 2; ++ai)
#pragma unroll
                    for (int m = 0; m < 4; ++m) { const int row = row0 + ai * HALF + m * 16;
                        const f32x4 c0 = *(const f32x4*)(cosa + (size_t)row * 32 + i0), c1 = *(const f32x4*)(cosa + (size_t)row * 32 + i0 + 4);
                        const f32x4 s0 = *(const f32x4*)(sina + (size_t)row * 32 + i0), s1 = *(const f32x4*)(sina + (size_t)row * 32 + i0 + 4);
                        const f32x4 a0 = A(ai, 0, m, 0), a1 = A(ai, 0, m, 1), b0 = A(ai, 1, m, 0), b1 = A(ai, 1, m, 1);
                        const f32x4 o10 = a0 * c0 - b0 * s0, o11 = a1 * c1 - b1 * s1, o20 = a0 * s0 + b0 * c0, o21 = a1 * s1 + b1 * c1;
                        bf16_t* rowp = AK + (size_t)row * 128 + wc * 64 + i0;
                        st_out((u32x4*)(rowp), (u32x4)(pack8(o10, o11))); st_out((u32x4*)(rowp + 32), (u32x4)(pack8(o20, o21))); }
            } else {
#pragma unroll
                for (int ai = 0; ai < 2; ++ai)
#pragma unroll
                    for (int m = 0; m < 4; ++m) { const int row = row0 + ai * HALF + m * 16; bf16_t* rowp = AV + (size_t)row * 128 + (wc - 2) * 32 + i0;
                        st_out((u32x4*)(rowp), (u32x4)(pack8(A(ai, 0, m, 0), A(ai, 0, m, 1)))); st_out((u32x4*)(rowp + 64), (u32x4)(pack8(A(ai, 1, m, 0), A(ai, 1, m, 1)))); }
            }
        }
    }
};
typedef EpiInProjT<false> EpiInProj;
template <bool ADD> struct EpiResid {
    static constexpr bool PERM = false, AFTER_DRAIN = false;
    const float* base; float* Y; float alpha;
    __device__ __forceinline__ void operator()(const f32x4 (&acc)[2][2][4][2], const Unit& u, int wr, int wc, int fr, int fq) const {
        const int row0 = u.pm * BM + wr * 64 + fr, col0 = u.pn * BM + wc * 32 + 4 * fq;
#pragma unroll
        for (int ai = 0; ai < 2; ++ai)
#pragma unroll
            for (int m = 0; m < 4; ++m) { const size_t off = (size_t)(row0 + ai * HALF + m * 16) * 2048 + col0;
#pragma unroll
                for (int bj = 0; bj < 2; ++bj)
#pragma unroll
                    for (int n = 0; n < 2; ++n) { const size_t o = off + bj * HALF + n * 16; f32x4 v = acc[ai][bj][m][n] + *(const f32x4*)(base + o) * alpha;
                        if (ADD) v = v + *(const f32x4*)(Y + o); st_out((f32x4*)(Y + o), (f32x4)(v)); } }
    }
};
struct EpiUp {
    static constexpr bool PERM = true, AFTER_DRAIN = false;
    bf16_t* H; bf16_t* SG; const float* bgate;
    __device__ __forceinline__ void operator()(const f32x4 (&acc)[2][2][4][2], const Unit& u, int wr, int wc, int fr, int fq) const {
        const int row0 = u.pm * BM + wr * 64 + fr, cw = wc * 32 + 8 * fq;
        if (u.pn < 44) {
#pragma unroll
            for (int ai = 0; ai < 2; ++ai)
#pragma unroll
                for (int m = 0; m < 4; ++m) { bf16_t* rowp = H + (size_t)(row0 + ai * HALF + m * 16) * 11264 + u.pn * 256 + cw;
#pragma unroll
                    for (int bj = 0; bj < 2; ++bj) st_out((u32x4*)(rowp + bj * HALF), (u32x4)(pack8(acc[ai][bj][m][0], acc[ai][bj][m][1]))); }
        } else {
            const int colg = (u.pn - 44) * 256 + cw;
            f32x4 bv[2][2];
#pragma unroll
            for (int bj = 0; bj < 2; ++bj)
#pragma unroll
                for (int n = 0; n < 2; ++n) bv[bj][n] = *(const f32x4*)(bgate + colg + bj * HALF + 4 * n);
#pragma unroll
            for (int ai = 0; ai < 2; ++ai)
#pragma unroll
                for (int m = 0; m < 4; ++m) { bf16_t* rowp = SG + (size_t)(row0 + ai * HALF + m * 16) * 2048 + colg;
#pragma unroll
                    for (int bj = 0; bj < 2; ++bj) { f32x4 v0 = acc[ai][bj][m][0] + bv[bj][0], v1 = acc[ai][bj][m][1] + bv[bj][1];
#pragma unroll
                        for (int j = 0; j < 4; ++j) { v0[j] = sigmoidf_(v0[j]); v1[j] = sigmoidf_(v1[j]); }
                        st_out((u32x4*)(rowp + bj * HALF), (u32x4)(pack8(v0, v1))); } }
        }
    }
};

__device__ __forceinline__ float ror1f(float x) { return __builtin_bit_cast(float, __builtin_amdgcn_update_dpp(0, __builtin_bit_cast(int, x), 0x121, 0xf, 0xf, false)); }
__device__ __forceinline__ float ror2f(float x) { return __builtin_bit_cast(float, __builtin_amdgcn_update_dpp(0, __builtin_bit_cast(int, x), 0x122, 0xf, 0xf, false)); }
template <bool LNFIX> struct EpiUpConvT {
    static constexpr bool PERM = true, AFTER_DRAIN = false;
    bf16_t* ACT; bf16_t* HALO; bf16_t* SG; const float* bgate; const float* cw; const float* cb; const float *stats, *c1, *c2;
    __device__ __forceinline__ void operator()(f32x4 (&acc)[2][2][4][2], const Unit& u, int wr, int wc, int fr, int fq) const {
        int cwp = wc * 32 + 8 * fq; asm volatile("" : "+v"(cwp));
        const int row0 = u.pm * BM + wr * 64 + fr;
        if (LNFIX) {
            const int cwq = cwp;
            f32x4 c1v[2][2], c2v[2][2];
#pragma unroll
            for (int bj = 0; bj < 2; ++bj)
#pragma unroll
                for (int n = 0; n < 2; ++n) { c1v[bj][n] = *(const f32x4*)(c1 + u.pn * 256 + bj * HALF + cwq + 4 * n); c2v[bj][n] = *(const f32x4*)(c2 + u.pn * 256 + bj * HALF + cwq + 4 * n); }
#pragma unroll
            for (int i = 0; i < 8; ++i) { const f32x2 st = *(const f32x2*)(stats + 2 * (size_t)(row0 + (i >> 2) * HALF + (i & 3) * 16));
#pragma unroll
                for (int bj = 0; bj < 2; ++bj)
#pragma unroll
                    for (int n = 0; n < 2; ++n) acc[i >> 2][bj][i & 3][n] = (acc[i >> 2][bj][i & 3][n] - c1v[bj][n] * st.x) * st.y + c2v[bj][n]; } }
        auto A = [&](int ai, int bj, int m, int n) -> f32x4 { return acc[ai][bj][m][n]; };
        if (u.pn < 44) {
            f32x4 wg0_[2], wg1_[2], wg2_[2], bg_[2], wu0_[2], wu1_[2], wu2_[2], bu_[2];
#pragma unroll
            for (int n = 0; n < 2; ++n) { const int chg = 128 * u.pn + cwp + 4 * n, chu = 5632 + chg;
                wg0_[n] = *(const f32x4*)(cw + chg); wg1_[n] = *(const f32x4*)(cw + 11264 + chg); wg2_[n] = *(const f32x4*)(cw + 2 * 11264 + chg); bg_[n] = *(const f32x4*)(cb + chg);
                wu0_[n] = *(const f32x4*)(cw + chu); wu1_[n] = *(const f32x4*)(cw + 11264 + chu); wu2_[n] = *(const f32x4*)(cw + 2 * 11264 + chu); bu_[n] = *(const f32x4*)(cb + chu); }
#pragma unroll
            for (int ai = 0; ai < 2; ++ai) {
                const int span = u.pm * 4 + ai * 2 + wr;
#pragma unroll
                for (int m = 0; m < 4; ++m) {
                    const int row = row0 + ai * HALF + m * 16;
                    u32x4 w, rg, ru;
#pragma unroll
                    for (int n = 0; n < 2; ++n) {
                        const f32x4 wg0 = wg0_[n], wg1 = wg1_[n], wg2 = wg2_[n], bg = bg_[n], wu0 = wu0_[n], wu1 = wu1_[n], wu2 = wu2_[n], bu = bu_[n];
                        const f32x4 cg = A(ai, 0, m, n), cu = A(ai, 1, m, n);
                        const f32x4 pg = A(ai, 0, m ? m - 1 : 0, n), pu = A(ai, 1, m ? m - 1 : 0, n);
                        f32x4 o;
#pragma unroll
                        for (int j = 0; j < 4; ++j) {
                            const float g1 = ror1f(fr == 15 ? pg[j] : cg[j]), g2 = ror2f(fr >= 14 ? pg[j] : cg[j]);
                            const float u1 = ror1f(fr == 15 ? pu[j] : cu[j]), u2 = ror2f(fr >= 14 ? pu[j] : cu[j]);
                            const float ga = bg[j] + wg0[j] * g2 + wg1[j] * g1 + wg2[j] * cg[j], ua = bu[j] + wu0[j] * u2 + wu1[j] * u1 + wu2[j] * cu[j];
                            o[j] = ga * sigmoidf_(ga) * ua; }
                        if (n == 0) { w.x = cvt_pk_bf16(o[0], o[1]); w.y = cvt_pk_bf16(o[2], o[3]); rg.x = cvt_pk_bf16(cg[0], cg[1]); rg.y = cvt_pk_bf16(cg[2], cg[3]); ru.x = cvt_pk_bf16(cu[0], cu[1]); ru.y = cvt_pk_bf16(cu[2], cu[3]); }
                        else { w.z = cvt_pk_bf16(o[0], o[1]); w.w = cvt_pk_bf16(o[2], o[3]); rg.z = cvt_pk_bf16(cg[0], cg[1]); rg.w = cvt_pk_bf16(cg[2], cg[3]); ru.z = cvt_pk_bf16(cu[0], cu[1]); ru.w = cvt_pk_bf16(cu[2], cu[3]); }
                    }
                    if (m > 0 || fr >= 2) st_out((u32x4*)(ACT + tiled_off(row, 128 * u.pn + cwp, 5632)), (u32x4)(w));
                    if ((m == 0 && fr < 2) || (m == 3 && fr >= 14)) { int frq = fr; asm volatile("" : "+v"(frq)); const int slot = (m == 0) ? frq : frq - 12;
                        bf16_t* hp = HALO + ((size_t)(span * 4 + slot)) * 11264 + 256 * u.pn + cwp;
                        st_out((u32x4*)(hp), (u32x4)(rg)); st_out((u32x4*)(hp + HALF), (u32x4)(ru)); }
                }
            }
        } else {
            const int colg = (u.pn - 44) * 256 + cwp;
            f32x4 bv[2][2];
#pragma unroll
            for (int bj = 0; bj < 2; ++bj)
#pragma unroll
                for (int n = 0; n < 2; ++n) bv[bj][n] = *(const f32x4*)(bgate + colg + bj * HALF + 4 * n);
#pragma unroll
            for (int ai = 0; ai < 2; ++ai)
#pragma unroll
                for (int m = 0; m < 4; ++m) { bf16_t* rowp = SG + (size_t)(row0 + ai * HALF + m * 16) * 2048 + colg;
#pragma unroll
                    for (int bj = 0; bj < 2; ++bj) { f32x4 v0 = A(ai, bj, m, 0) + bv[bj][0], v1 = A(ai, bj, m, 1) + bv[bj][1];
#pragma unroll
                        for (int j = 0; j < 4; ++j) { v0[j] = sigmoidf_(v0[j]); v1[j] = sigmoidf_(v1[j]); }
                        st_out((u32x4*)(rowp + bj * HALF), (u32x4)(pack8(v0, v1))); } }
        }
    }
};

typedef EpiUpConvT<false> EpiUpConv;
struct EpiPlain {
    static constexpr bool PERM = true, AFTER_DRAIN = false;
    bf16_t* O;
    __device__ __forceinline__ void operator()(const f32x4 (&acc)[2][2][4][2], const Unit& u, int wr, int wc, int fr, int fq) const {
        const int row0 = u.pm * BM + wr * 64 + fr, cwp = u.pn * BM + wc * 32 + 8 * fq;
#pragma unroll
        for (int ai = 0; ai < 2; ++ai)
#pragma unroll
            for (int m = 0; m < 4; ++m) { bf16_t* rowp = O + (size_t)(row0 + ai * HALF + m * 16) * 2048 + cwp;
#pragma unroll
                for (int bj = 0; bj < 2; ++bj) st_out((u32x4*)(rowp + bj * HALF), (u32x4)(pack8(acc[ai][bj][m][0], acc[ai][bj][m][1]))); }
    }
};
struct EpiDown {
    static constexpr bool PERM = false, AFTER_DRAIN = false;
    const float* base; float* Y; const bf16_t* PP; const bf16_t* SG; float alpha;
    __device__ __forceinline__ void operator()(const f32x4 (&acc)[2][2][4][2], const Unit& u, int wr, int wc, int fr, int fq) const {
        const int row0 = u.pm * BM + wr * 64 + fr, col0 = u.pn * BM + wc * 32 + 4 * fq;
#pragma unroll
        for (int ai = 0; ai < 2; ++ai)
#pragma unroll
            for (int m = 0; m < 4; ++m) { const size_t off = (size_t)(row0 + ai * HALF + m * 16) * 2048 + col0;
#pragma unroll
                for (int bj = 0; bj < 2; ++bj)
#pragma unroll
                    for (int n = 0; n < 2; ++n) { const size_t o = off + bj * HALF + n * 16; const u32x2 pp = *(const u32x2*)(PP + o), sg = *(const u32x2*)(SG + o);
                        f32x4 pl; pl[0] = __uint_as_float(pp.x << 16) * __uint_as_float(sg.x << 16); pl[1] = __uint_as_float(pp.x & 0xffff0000u) * __uint_as_float(sg.x & 0xffff0000u);
                        pl[2] = __uint_as_float(pp.y << 16) * __uint_as_float(sg.y << 16); pl[3] = __uint_as_float(pp.y & 0xffff0000u) * __uint_as_float(sg.y & 0xffff0000u);
                        st_out((f32x4*)(Y + o), (f32x4)(acc[ai][bj][m][n] + *(const f32x4*)(base + o) * alpha + pl)); } }
    }
};

template <bool PLE_> struct EpiResidLN {
    static constexpr bool PERM = false, AFTER_DRAIN = false;
    float* Y; float* Yout; const float* stats; const float* g; const float* b; const bf16_t* PP; const bf16_t* SG; float alpha;
    __device__ __forceinline__ void operator()(const f32x4 (&acc)[2][2][4][2], const Unit& u, int wr, int wc, int fr, int fq) const {
        const int row0 = u.pm * BM + wr * 64 + fr, col0 = u.pn * BM + wc * 32 + 4 * fq;
        f32x4 g4[2][2], b4[2][2];
#pragma unroll
        for (int bj = 0; bj < 2; ++bj)
#pragma unroll
            for (int n = 0; n < 2; ++n) { g4[bj][n] = *(const f32x4*)(g + col0 + bj * HALF + n * 16) * alpha; b4[bj][n] = *(const f32x4*)(b + col0 + bj * HALF + n * 16) * alpha; }
        f32x4 cy[2][2], ny[2][2]; f32x2 cst, nst;
        { const size_t off = (size_t)row0 * 2048 + col0; cst = *(const f32x2*)(stats + 2 * (size_t)row0);
#pragma unroll
          for (int bj = 0; bj < 2; ++bj)
#pragma unroll
              for (int n = 0; n < 2; ++n) cy[bj][n] = *(const f32x4*)(Y + off + bj * HALF + n * 16); }
#pragma unroll
        for (int i = 0; i < 8; ++i) { const int ai = i >> 2, m = i & 3; const size_t off = (size_t)(row0 + ai * HALF + m * 16) * 2048 + col0;
            if (i < 7) { const int rn = row0 + ((i + 1) >> 2) * HALF + ((i + 1) & 3) * 16; const size_t offn = (size_t)rn * 2048 + col0; nst = *(const f32x2*)(stats + 2 * (size_t)rn);
#pragma unroll
                for (int bj = 0; bj < 2; ++bj)
#pragma unroll
                    for (int n = 0; n < 2; ++n) ny[bj][n] = *(const f32x4*)(Y + offn + bj * HALF + n * 16); }
#pragma unroll
            for (int bj = 0; bj < 2; ++bj)
#pragma unroll
                for (int n = 0; n < 2; ++n) { const size_t o = off + bj * HALF + n * 16;
                    f32x4 v = acc[ai][bj][m][n] + (cy[bj][n] - cst.x) * cst.y * g4[bj][n] + b4[bj][n];
                    if (PLE_) { const u32x2 pp = *(const u32x2*)(PP + o), sg = *(const u32x2*)(SG + o);
                        v[0] += __uint_as_float(pp.x << 16) * __uint_as_float(sg.x << 16); v[1] += __uint_as_float(pp.x & 0xffff0000u) * __uint_as_float(sg.x & 0xffff0000u);
                        v[2] += __uint_as_float(pp.y << 16) * __uint_as_float(sg.y << 16); v[3] += __uint_as_float(pp.y & 0xffff0000u) * __uint_as_float(sg.y & 0xffff0000u); }
                    st_out((f32x4*)(Yout + o), (f32x4)(v)); }
#pragma unroll
            for (int bj = 0; bj < 2; ++bj)
#pragma unroll
                for (int n = 0; n < 2; ++n) cy[bj][n] = ny[bj][n];
            cst = nst; }
    }
};

template <bool LNBASE, bool PLE_, bool STATS> struct EpiRes2 {
    static constexpr bool PERM = true, AFTER_DRAIN = false;
    const float* base; float* Y; bf16_t* YB; float* pstat; const float* stats; const float* g; const float* b; const bf16_t* PP; const bf16_t* SG; float alpha;
    __device__ __forceinline__ void operator()(const f32x4 (&acc)[2][2][4][2], const Unit& u, int wr, int wc, int fr, int fq) const {
        const int row0 = u.pm * BM + wr * 64 + fr, col0 = u.pn * BM + wc * 32 + 8 * fq, lane = fq * 16 + fr;
        const float* src = LNBASE ? (const float*)Y : base;
        f32x4 g4[2][2], b4[2][2];
        if (LNBASE) {
#pragma unroll
            for (int bj = 0; bj < 2; ++bj)
#pragma unroll
                for (int n = 0; n < 2; ++n) { g4[bj][n] = *(const f32x4*)(g + col0 + bj * HALF + 4 * n) * alpha; b4[bj][n] = *(const f32x4*)(b + col0 + bj * HALF + 4 * n) * alpha; } }
        f32x4 cy[2][2], ny[2][2]; f32x2 cst = (f32x2){0.f, 1.f}, nst = (f32x2){0.f, 1.f};
        { const size_t off = (size_t)row0 * 2048 + col0; if (LNBASE) cst = *(const f32x2*)(stats + 2 * (size_t)row0);
#pragma unroll
          for (int bj = 0; bj < 2; ++bj)
#pragma unroll
              for (int n = 0; n < 2; ++n) cy[bj][n] = *(const f32x4*)(src + off + bj * HALF + 4 * n); }
#pragma unroll
        for (int i = 0; i < 8; ++i) { const int ai = i >> 2, m = i & 3, row = row0 + ai * HALF + m * 16; const size_t off = (size_t)row * 2048 + col0;
            if (i < 7) { const int rn = row0 + ((i + 1) >> 2) * HALF + ((i + 1) & 3) * 16; const size_t offn = (size_t)rn * 2048 + col0; if (LNBASE) nst = *(const f32x2*)(stats + 2 * (size_t)rn);
#pragma unroll
                for (int bj = 0; bj < 2; ++bj)
#pragma unroll
                    for (int n = 0; n < 2; ++n) ny[bj][n] = *(const f32x4*)(src + offn + bj * HALF + 4 * n); }
            float s1 = 0.f, s2 = 0.f;
#pragma unroll
            for (int bj = 0; bj < 2; ++bj) { f32x4 v[2];
#pragma unroll
                for (int n = 0; n < 2; ++n) v[n] = LNBASE ? acc[ai][bj][m][n] + (cy[bj][n] - cst.x) * cst.y * g4[bj][n] + b4[bj][n] : acc[ai][bj][m][n] + cy[bj][n] * alpha;
                if (PLE_) { const u32x4 pp = *(const u32x4*)(PP + off + bj * HALF), sg = *(const u32x4*)(SG + off + bj * HALF);
                    v[0][0] += __uint_as_float(pp.x << 16) * __uint_as_float(sg.x << 16); v[0][1] += __uint_as_float(pp.x & 0xffff0000u) * __uint_as_float(sg.x & 0xffff0000u);
                    v[0][2] += __uint_as_float(pp.y << 16) * __uint_as_float(sg.y << 16); v[0][3] += __uint_as_float(pp.y & 0xffff0000u) * __uint_as_float(sg.y & 0xffff0000u);
                    v[1][0] += __uint_as_float(pp.z << 16) * __uint_as_float(sg.z << 16); v[1][1] += __uint_as_float(pp.z & 0xffff0000u) * __uint_as_float(sg.z & 0xffff0000u);
                    v[1][2] += __uint_as_float(pp.w << 16) * __uint_as_float(sg.w << 16); v[1][3] += __uint_as_float(pp.w & 0xffff0000u) * __uint_as_float(sg.w & 0xffff0000u); }
                st_out((f32x4*)(Y + off + bj * HALF), (f32x4)(v[0])); st_out((f32x4*)(Y + off + bj * HALF + 4), (f32x4)(v[1]));
                if (STATS) { st_out((u32x4*)(YB + off + bj * HALF), (u32x4)(pack8(v[0], v[1])));
#pragma unroll
                    for (int n = 0; n < 2; ++n) { s1 += (v[n][0] + v[n][1]) + (v[n][2] + v[n][3]); s2 += (v[n][0] * v[n][0] + v[n][1] * v[n][1]) + (v[n][2] * v[n][2] + v[n][3] * v[n][3]); } } }
            if (STATS) {
                s1 += __builtin_bit_cast(float, __builtin_amdgcn_ds_bpermute((lane ^ 16) << 2, __builtin_bit_cast(int, s1))); s2 += __builtin_bit_cast(float, __builtin_amdgcn_ds_bpermute((lane ^ 16) << 2, __builtin_bit_cast(int, s2)));
                s1 += __builtin_bit_cast(float, __builtin_amdgcn_ds_bpermute((lane ^ 32) << 2, __builtin_bit_cast(int, s1))); s2 += __builtin_bit_cast(float, __builtin_amdgcn_ds_bpermute((lane ^ 32) << 2, __builtin_bit_cast(int, s2)));
                if (fq == 0) *(f32x2*)(pstat + ((size_t)row * 32 + u.pn * 4 + wc) * 2) = (f32x2){s1, s2}; }
#pragma unroll
            for (int bj = 0; bj < 2; ++bj)
#pragma unroll
                for (int n = 0; n < 2; ++n) cy[bj][n] = ny[bj][n];
            cst = nst; }
    }
};

typedef _Float16 h16x8 __attribute__((ext_vector_type(8)));
typedef float f32x8 __attribute__((ext_vector_type(8)));
template <bool LNBASE, bool PLE_> struct EpiRes3 {
    static constexpr bool PERM = true, AFTER_DRAIN = false;
    const float* base; float* Y; bf16_t* YB; _Float16* YH; float* pstat; const float* stats; const float* g; const float* b; const bf16_t* PP; const bf16_t* SG; float alpha;
    __device__ __forceinline__ void operator()(const f32x4 (&acc)[2][2][4][2], const Unit& u, int wr, int wc, int fr, int fq) const {
        const int row0 = u.pm * BM + wr * 64 + fr, col0 = u.pn * BM + wc * 32 + 8 * fq, lane = fq * 16 + fr;
        f32x4 g4[2][2], b4[2][2];
        if (LNBASE) {
#pragma unroll
            for (int bj = 0; bj < 2; ++bj)
#pragma unroll
                for (int n = 0; n < 2; ++n) { g4[bj][n] = *(const f32x4*)(g + col0 + bj * HALF + 4 * n) * alpha; b4[bj][n] = *(const f32x4*)(b + col0 + bj * HALF + 4 * n) * alpha; } }
        u32x4 cyb[2], nyb[2]; f32x4 cyf[2][2], nyf[2][2]; f32x2 cst = (f32x2){0.f, 1.f}, nst = (f32x2){0.f, 1.f};
        { const size_t off = (size_t)row0 * 2048 + col0;
          if (LNBASE) { cst = *(const f32x2*)(stats + 2 * (size_t)row0); cyb[0] = *(const u32x4*)(YH + off); cyb[1] = *(const u32x4*)(YH + off + HALF); }
          else {
#pragma unroll
              for (int bj = 0; bj < 2; ++bj)
#pragma unroll
                  for (int n = 0; n < 2; ++n) cyf[bj][n] = *(const f32x4*)(base + off + bj * HALF + 4 * n); } }
#pragma unroll
        for (int i = 0; i < 8; ++i) { const int ai = i >> 2, m = i & 3, row = row0 + ai * HALF + m * 16; const size_t off = (size_t)row * 2048 + col0;
            if (i < 7) { const int rn = row0 + ((i + 1) >> 2) * HALF + ((i + 1) & 3) * 16; const size_t offn = (size_t)rn * 2048 + col0;
                if (LNBASE) { nst = *(const f32x2*)(stats + 2 * (size_t)rn); nyb[0] = *(const u32x4*)(YH + offn); nyb[1] = *(const u32x4*)(YH + offn + HALF); }
                else {
#pragma unroll
                    for (int bj = 0; bj < 2; ++bj)
#pragma unroll
                        for (int n = 0; n < 2; ++n) nyf[bj][n] = *(const f32x4*)(base + offn + bj * HALF + 4 * n); } }
            float s1 = 0.f, s2 = 0.f;
#pragma unroll
            for (int bj = 0; bj < 2; ++bj) { f32x4 v[2];
                if (LNBASE) { const f32x8 yf = __builtin_convertvector(__builtin_bit_cast(h16x8, cyb[bj]), f32x8);
                    const f32x4 y0 = (f32x4){yf[0], yf[1], yf[2], yf[3]}, y1 = (f32x4){yf[4], yf[5], yf[6], yf[7]};
                    v[0] = acc[ai][bj][m][0] + (y0 - cst.x) * cst.y * g4[bj][0] + b4[bj][0]; v[1] = acc[ai][bj][m][1] + (y1 - cst.x) * cst.y * g4[bj][1] + b4[bj][1]; }
                else { v[0] = acc[ai][bj][m][0] + cyf[bj][0] * alpha; v[1] = acc[ai][bj][m][1] + cyf[bj][1] * alpha; }
                if (PLE_) { const u32x4 pp = *(const u32x4*)(PP + off + bj * HALF), sg = *(const u32x4*)(SG + off + bj * HALF);
                    v[0][0] += __uint_as_float(pp.x << 16) * __uint_as_float(sg.x << 16); v[0][1] += __uint_as_float(pp.x & 0xffff0000u) * __uint_as_float(sg.x & 0xffff0000u);
                    v[0][2] += __uint_as_float(pp.y << 16) * __uint_as_float(sg.y << 16); v[0][3] += __uint_as_float(pp.y & 0xffff0000u) * __uint_as_float(sg.y & 0xffff0000u);
                    v[1][0] += __uint_as_float(pp.z << 16) * __uint_as_float(sg.z << 16); v[1][1] += __uint_as_float(pp.z & 0xffff0000u) * __uint_as_float(sg.z & 0xffff0000u);
                    v[1][2] += __uint_as_float(pp.w << 16) * __uint_as_float(sg.w << 16); v[1][3] += __uint_as_float(pp.w & 0xffff0000u) * __uint_as_float(sg.w & 0xffff0000u); }
                if (Y) { st_out((f32x4*)(Y + off + bj * HALF), (f32x4)(v[0])); st_out((f32x4*)(Y + off + bj * HALF + 4), (f32x4)(v[1])); }
                const u32x4 pk = pack8(v[0], v[1]);
                st_out((u32x4*)(YB + off + bj * HALF), (u32x4)(pk));
                { const f32x8 vf = (f32x8){v[0][0], v[0][1], v[0][2], v[0][3], v[1][0], v[1][1], v[1][2], v[1][3]};
                  st_out((u32x4*)(YH + off + bj * HALF), __builtin_bit_cast(u32x4, __builtin_convertvector(vf, h16x8))); }
                const f32x4 r0 = (f32x4){__uint_as_float(pk.x << 16), __uint_as_float(pk.x & 0xffff0000u), __uint_as_float(pk.y << 16), __uint_as_float(pk.y & 0xffff0000u)};
                const f32x4 r1 = (f32x4){__uint_as_float(pk.z << 16), __uint_as_float(pk.z & 0xffff0000u), __uint_as_float(pk.w << 16), __uint_as_float(pk.w & 0xffff0000u)};
                s1 += ((r0[0] + r0[1]) + (r0[2] + r0[3])) + ((r1[0] + r1[1]) + (r1[2] + r1[3]));
                s2 += ((r0[0] * r0[0] + r0[1] * r0[1]) + (r0[2] * r0[2] + r0[3] * r0[3])) + ((r1[0] * r1[0] + r1[1] * r1[1]) + (r1[2] * r1[2] + r1[3] * r1[3])); }
            s1 += __builtin_bit_cast(float, __builtin_amdgcn_ds_bpermute((lane ^ 16) << 2, __builtin_bit_cast(int, s1))); s2 += __builtin_bit_cast(float, __builtin_amdgcn_ds_bpermute((lane ^ 16) << 2, __builtin_bit_cast(int, s2)));
            s1 += __builtin_bit_cast(float, __builtin_amdgcn_ds_bpermute((lane ^ 32) << 2, __builtin_bit_cast(int, s1))); s2 += __builtin_bit_cast(float, __builtin_amdgcn_ds_bpermute((lane ^ 32) << 2, __builtin_bit_cast(int, s2)));
            if (fq == 0) *(f32x2*)(pstat + ((size_t)row * 32 + u.pn * 4 + wc) * 2) = (f32x2){s1, s2};
            cyb[0] = nyb[0]; cyb[1] = nyb[1];
#pragma unroll
            for (int bj = 0; bj < 2; ++bj)
#pragma unroll
                for (int n = 0; n < 2; ++n) cyf[bj][n] = nyf[bj][n];
            cst = nst; }
    }
};
struct EpiPle {
    static constexpr bool PERM = false, AFTER_DRAIN = false;
    const bf16_t* SG; float* Y;
    __device__ __forceinline__ void operator()(const f32x4 (&acc)[2][2][4][2], const Unit& u, int wr, int wc, int fr, int fq) const {
        const int row0 = u.pm * BM + wr * 64 + fr, col0 = u.pn * BM + wc * 32 + 4 * fq;
#pragma unroll
        for (int ai = 0; ai < 2; ++ai)
#pragma unroll
            for (int m = 0; m < 4; ++m) { const size_t off = (size_t)(row0 + ai * HALF + m * 16) * 2048 + col0;
#pragma unroll
                for (int bj = 0; bj < 2; ++bj)
#pragma unroll
                    for (int n = 0; n < 2; ++n) { const size_t o = off + bj * HALF + n * 16; const u32x2 sg = *(const u32x2*)(SG + o);
                        f32x4 g; g[0] = __uint_as_float(sg.x << 16); g[1] = __uint_as_float(sg.x & 0xffff0000u); g[2] = __uint_as_float(sg.y << 16); g[3] = __uint_as_float(sg.y & 0xffff0000u);
                        st_out((f32x4*)(Y + o), (f32x4)(acc[ai][bj][m][n] * g)); } }
    }
};
template <class Epi, class Sched, bool ALIGN_EPI = false, bool SP2 = false>
__device__ __forceinline__ void gemm_phase(PG8_LAS unsigned char* lds, const Gemm g, const Sched& S, const Epi& E, const int wid_in) {
    int lane_; asm volatile("v_mbcnt_lo_u32_b32 %0, -1, 0\n\tv_mbcnt_hi_u32_b32 %0, -1, %0" : "=v"(lane_)); const int wid = wid_in, lane = lane_, tid = wid * 64 + lane, wr = wid >> 2, wc = wid & 3, fr = lane & 15, fq = lane >> 4;
    const int K = g.K, nt = K / BK, lda = g.tiledA ? BK : (g.lda ? g.lda : K), ldb = g.tiledB ? BK : (g.ldb ? g.ldb : K);
    unsigned voffA[2], voffB[2];
#pragma unroll
    for (int i = 0; i < 2; ++i) { int R, C; stage_rc(tid * 16 + i * 8192, R, C); const int Rb = Epi::PERM ? ((R & ~31) + perm32(R & 31)) : R;
        voffA[i] = (unsigned)(R * lda + C) * 2u; voffB[i] = (unsigned)(Rb * ldb + C) * 2u; }
    const size_t kstepA = g.tiledA ? (size_t)BM * BK * 2 : (size_t)(BK * 2), kstepB = g.tiledB ? (size_t)BM * BK * 2 : (size_t)(BK * 2);
    const size_t hstepA = (size_t)HALF * lda * 2, hstepB = (size_t)HALF * ldb * 2;
    const size_t tstepA = g.tiledA ? (size_t)BM * K * 2 : 2 * hstepA, tstepB = g.tiledB ? (size_t)BM * K * 2 : 2 * hstepB;
    const unsigned ldsw = (unsigned)wid * 1024u;
    const int aoff = lds_byte(wr * 64 + fr, fq * 8), boff = lds_byte(wc * 32 + fr, fq * 8);
#define PG8_SA(b, h) (((b) * 2 + (h)) * HTB)
#define PG8_SB(b, h) ((4 + (b) * 2 + (h)) * HTB)
#define PG8_STAGE(bufoff, gbase, voff) do { _Pragma("unroll") for (int _i = 0; _i < 2; ++_i) \
        __builtin_amdgcn_global_load_lds((const unsigned*)((const char*)(gbase) + (voff)[_i]), (PG8_LAS unsigned*)(lds + (bufoff) + ldsw + _i * 8192), 16, 0, 0); } while (0)
#define PG8_LDA(dst, b, h) do { _Pragma("unroll") for (int m = 0; m < 4; ++m) _Pragma("unroll") for (int k = 0; k < 2; ++k) dst[m][k] = *(const PG8_LAS bf16x8*)(lds + PG8_SA(b, h) + aoff + m * 2048 + k * 1024); } while (0)
#define PG8_LDB(dst, b, h) do { _Pragma("unroll") for (int n = 0; n < 2; ++n) _Pragma("unroll") for (int k = 0; k < 2; ++k) dst[n][k] = *(const PG8_LAS bf16x8*)(lds + PG8_SB(b, h) + boff + n * 2048 + k * 1024); } while (0)
#define PG8_MMA(ai, bj, At, Bt) do { __builtin_amdgcn_s_setprio(1); _Pragma("unroll") for (int m = 0; m < 4; ++m) _Pragma("unroll") for (int n = 0; n < 2; ++n) _Pragma("unroll") for (int k = 0; k < 2; ++k) \
        acc[ai][bj][m][n] = __builtin_amdgcn_mfma_f32_16x16x32_bf16(Bt[n][k], At[m][k], acc[ai][bj][m][n], 0, 0, 0); __builtin_amdgcn_s_setprio(0); } while (0)
#define PG8_WAIT_V(n) asm volatile("s_waitcnt vmcnt(" #n ")" ::: "memory")
#define PG8_WAIT_L(n) asm volatile("s_waitcnt lgkmcnt(" #n ")" ::: "memory")
#define PG8_BAR __builtin_amdgcn_s_barrier()
#define PG8_SCHED __builtin_amdgcn_sched_barrier(0)
    Unit cur, nxt; int ui = 0;
    if (!S.next(0, cur)) return;
    f32x4 acc[2][2][4][2];
#pragma unroll
    for (int a = 0; a < 2; ++a)
#pragma unroll
        for (int b = 0; b < 2; ++b)
#pragma unroll
            for (int m = 0; m < 4; ++m)
#pragma unroll
                for (int n = 0; n < 2; ++n) acc[a][b][m][n] = (f32x4){0.f, 0.f, 0.f, 0.f};
    bf16x8 At[4][2], B0[2][2], B1[2][2];
    const char* cA = (const char*)g.A + (size_t)cur.pm * tstepA; const char* cB = (const char*)g.Bt + (size_t)cur.pn * tstepB;
    S.a_ready(cur);
    if constexpr (SP2) {
        PG8_STAGE(PG8_SB(0, 0), cB, voffB); PG8_STAGE(PG8_SB(0, 1), cB + hstepB, voffB); PG8_STAGE(PG8_SA(0, 0), cA, voffA); PG8_STAGE(PG8_SA(0, 1), cA + hstepA, voffA);
        if (wr == 1) PG8_BAR;
        PG8_WAIT_V(2); PG8_BAR;
        PG8_STAGE(PG8_SB(1, 0), cB + kstepB, voffB); PG8_STAGE(PG8_SA(1, 0), cA + kstepA, voffA); PG8_STAGE(PG8_SB(1, 1), cB + hstepB + kstepB, voffB);
        PG8_WAIT_V(6); PG8_BAR;
    } else {
        PG8_STAGE(PG8_SB(0, 0), cB, voffB); PG8_STAGE(PG8_SA(0, 0), cA, voffA); PG8_STAGE(PG8_SB(0, 1), cB + hstepB, voffB); PG8_STAGE(PG8_SA(0, 1), cA + hstepA, voffA);
        if (wr == 1) PG8_BAR;
        PG8_WAIT_V(4); PG8_BAR;
        PG8_STAGE(PG8_SB(1, 0), cB + kstepB, voffB); PG8_STAGE(PG8_SA(1, 0), cA + kstepA, voffA); PG8_STAGE(PG8_SB(1, 1), cB + hstepB + kstepB, voffB);
        PG8_WAIT_V(6); PG8_BAR;
    }
    for (;;) {
        const bool has_next = S.next(ui + 1, nxt);
        const char* nA = has_next ? (const char*)g.A + (size_t)nxt.pm * tstepA : cA; const char* nB = has_next ? (const char*)g.Bt + (size_t)nxt.pn * tstepB : cB;
        for (int t = 0; t < nt; t += 2) {
            const bool last = (t == nt - 2);
            const char* a1 = cA + (size_t)(t + 1) * kstepA;
            const char* a2 = last ? nA : cA + (size_t)(t + 2) * kstepA; const char* b2 = last ? nB : cB + (size_t)(t + 2) * kstepB;
            const char* a3 = a2 + kstepA; const char* b3 = b2 + kstepB;
            if (last && has_next) S.a_ready(nxt);
            if constexpr (SP2) {
            PG8_LDB(B0, 0, 0); PG8_LDB(B1, 0, 1); PG8_SCHED; PG8_LDA(At, 0, 0); PG8_STAGE(PG8_SA(1, 1), a1 + hstepA, voffA);
            PG8_WAIT_V(8); PG8_WAIT_L(0); PG8_BAR; PG8_MMA(0, 0, At, B0); PG8_MMA(0, 1, At, B1); PG8_BAR; PG8_SCHED;
            PG8_LDA(At, 0, 1); PG8_STAGE(PG8_SB(0, 0), b2, voffB); PG8_STAGE(PG8_SB(0, 1), b2 + hstepB, voffB); PG8_STAGE(PG8_SA(0, 0), a2, voffA);
            PG8_WAIT_V(8); PG8_WAIT_L(0); PG8_BAR; PG8_MMA(1, 0, At, B0); PG8_MMA(1, 1, At, B1); PG8_BAR; PG8_SCHED;
            PG8_LDB(B0, 1, 0); PG8_LDB(B1, 1, 1); PG8_SCHED; PG8_LDA(At, 1, 0); PG8_STAGE(PG8_SA(0, 1), a2 + hstepA, voffA);
            PG8_WAIT_V(8); PG8_WAIT_L(0); PG8_BAR; PG8_MMA(0, 0, At, B0); PG8_MMA(0, 1, At, B1); PG8_BAR; PG8_SCHED;
            PG8_LDA(At, 1, 1); PG8_STAGE(PG8_SB(1, 0), b3, voffB); PG8_STAGE(PG8_SB(1, 1), b3 + hstepB, voffB); PG8_STAGE(PG8_SA(1, 0), a3, voffA);
            PG8_WAIT_V(8); PG8_WAIT_L(0); PG8_BAR; PG8_MMA(1, 0, At, B0); PG8_MMA(1, 1, At, B1); PG8_BAR; PG8_SCHED;
            } else {
            PG8_LDB(B0, 0, 0); PG8_SCHED; PG8_LDA(At, 0, 0); PG8_STAGE(PG8_SA(1, 1), a1 + hstepA, voffA);
            PG8_WAIT_L(8); PG8_BAR; PG8_WAIT_L(0); PG8_MMA(0, 0, At, B0); PG8_BAR; PG8_SCHED;
            PG8_LDB(B1, 0, 1); PG8_STAGE(PG8_SB(0, 0), b2, voffB);
            PG8_BAR; PG8_WAIT_L(0); PG8_MMA(0, 1, At, B1); PG8_BAR;
            PG8_LDA(At, 0, 1); PG8_STAGE(PG8_SA(0, 0), a2, voffA);
            PG8_BAR; PG8_WAIT_L(0); PG8_MMA(1, 0, At, B0); PG8_BAR; PG8_SCHED;
            PG8_STAGE(PG8_SB(0, 1), b2 + hstepB, voffB);
            PG8_WAIT_V(6); PG8_BAR; PG8_MMA(1, 1, At, B1); PG8_BAR;
            PG8_LDB(B0, 1, 0); PG8_SCHED; PG8_LDA(At, 1, 0); PG8_STAGE(PG8_SA(0, 1), a2 + hstepA, voffA);
            PG8_WAIT_L(8); PG8_BAR; PG8_WAIT_L(0); PG8_MMA(0, 0, At, B0); PG8_BAR; PG8_SCHED;
            PG8_LDB(B1, 1, 1); PG8_STAGE(PG8_SB(1, 0), b3, voffB);
            PG8_BAR; PG8_WAIT_L(0); PG8_MMA(0, 1, At, B1); PG8_BAR;
            PG8_LDA(At, 1, 1); PG8_STAGE(PG8_SA(1, 0), a3, voffA);
            PG8_BAR; PG8_WAIT_L(0); PG8_MMA(1, 0, At, B0); PG8_BAR; PG8_SCHED;
            PG8_STAGE(PG8_SB(1, 1), b3 + hstepB, voffB);
            PG8_WAIT_V(6); PG8_BAR; PG8_MMA(1, 1, At, B1); PG8_BAR;
            }
        }
        if constexpr (ALIGN_EPI) { if (wr == 0) PG8_BAR; }
        if constexpr (!Epi::AFTER_DRAIN) { E(acc, cur, wr, wc, fr, fq); S.done(cur); }
        if (!has_next) break;
#pragma unroll
        for (int a = 0; a < 2; ++a)
#pragma unroll
            for (int b = 0; b < 2; ++b)
#pragma unroll
                for (int m = 0; m < 4; ++m)
#pragma unroll
                    for (int n = 0; n < 2; ++n) acc[a][b][m][n] = (f32x4){0.f, 0.f, 0.f, 0.f};
        cur = nxt; cA = nA; cB = nB; ++ui;
        if constexpr (ALIGN_EPI) { if (wr == 1) PG8_BAR; }
    }
    PG8_WAIT_V(0);
    if constexpr (!ALIGN_EPI) { if (wr == 0) PG8_BAR; }
    PG8_BAR;
    if constexpr (Epi::AFTER_DRAIN) { E.fused(acc, cur, wr, wc, fr, fq, lds, wid, lane); S.done(cur); }
#undef PG8_SA
#undef PG8_SB
#undef PG8_STAGE
#undef PG8_LDA
#undef PG8_LDB
#undef PG8_MMA
#undef PG8_WAIT_V
#undef PG8_WAIT_L
#undef PG8_BAR
#undef PG8_SCHED
}
}
#define LAS __attribute__((address_space(3)))
#define XB_TMO      128
#define XB_XCNT(j)  (256  + 64 * (j))
#define XB_XSUB(j)  (1280 + 64 * (j))
#define XB_XGEN(j)  (2304 + 64 * (j))
#define XB_TOP      3328
#define XB_TOPGEN   3392
#define XCD_BAR_WORDS 3456
#define XB_SPIN_CAP (1u << 18)

__device__ __forceinline__ unsigned xb_ld(unsigned* p)              { return __hip_atomic_load(p, __ATOMIC_RELAXED, __HIP_MEMORY_SCOPE_AGENT); }
__device__ __forceinline__ unsigned xb_add(unsigned* p, unsigned v) { return __hip_atomic_fetch_add(p, v, __ATOMIC_RELAXED, __HIP_MEMORY_SCOPE_AGENT); }
__device__ __forceinline__ unsigned xb_xcc_id() { return (unsigned)__builtin_amdgcn_s_getreg((3 << 11) | 20) & 0xFu; }
#define XB_SPIN(cond, bar) do { unsigned _sp = 0; while (cond) { __builtin_amdgcn_s_sleep(1); \
    if ((++_sp & 255u) == 0u) { if (xb_ld(&(bar)[XB_TMO])) break; if (_sp > XB_SPIN_CAP) { atomicAdd(&(bar)[XB_TMO], 1u); break; } } } } while (0)

struct XcdBarrier {
    unsigned* bar; unsigned x;
    volatile LAS unsigned* st;
};

__device__ __forceinline__ XcdBarrier xcd_barrier_post(unsigned* bar, volatile LAS unsigned* st) {
    XcdBarrier b; b.bar = bar; b.x = xb_xcc_id(); b.st = st;
    if (threadIdx.x == 0) (void)xb_add(&bar[XB_XCNT(b.x)], 1u);
    return b;
}
__device__ __forceinline__ void xcd_barrier_complete(unsigned* bar, unsigned x, unsigned& nloc, unsigned& nx) {
    const unsigned G = gridDim.x * gridDim.y * gridDim.z;
    unsigned sum, cnt, mine, sp = 0u;
    for (;;) {
        sum = 0u; cnt = 0u; mine = 0u;
#pragma unroll
        for (unsigned j = 0; j < 16; ++j) { const unsigned c = xb_ld(&bar[XB_XCNT(j)]); sum += c; cnt += (c > 0u) ? 1u : 0u; mine = (j == x) ? c : mine; }
        if (sum == G) break;
        __builtin_amdgcn_s_sleep(1);
        if ((++sp & 255u) == 0u) { if (xb_ld(&bar[XB_TMO])) break; if (sp > XB_SPIN_CAP) { atomicAdd(&bar[XB_TMO], 1u); break; } }
    }
    nloc = mine > 0u ? mine : 1u; nx = cnt > 0u ? cnt : 1u;
}

__device__ __forceinline__ void xcd_barrier(const XcdBarrier& b) {
    asm volatile("s_waitcnt vmcnt(0)" ::: "memory");
    __syncthreads();
    if (threadIdx.x == 0) {
        unsigned* bar = b.bar;
        __builtin_amdgcn_s_waitcnt(0);
        unsigned nloc = b.st[0], nx = b.st[1];
        if (nloc == 0u) { xcd_barrier_complete(bar, b.x, nloc, nx); b.st[0] = nloc; b.st[1] = nx; }
        const unsigned old = xb_add(&bar[XB_XSUB(b.x)], 1u);
        const unsigned gen = old / nloc;
        if (old + 1u == (gen + 1u) * nloc) {
            __builtin_amdgcn_fence(__ATOMIC_RELEASE, "agent");
            asm volatile("s_waitcnt vmcnt(0)" ::: "memory");
            const unsigned og = xb_add(&bar[XB_TOP], 1u);
            const unsigned tg = og / nx;
            if (og + 1u == (tg + 1u) * nx) xb_add(&bar[XB_TOPGEN], 1u);
            else XB_SPIN(xb_ld(&bar[XB_TOPGEN]) == tg, bar);
            __builtin_amdgcn_fence(__ATOMIC_ACQUIRE, "agent");
            xb_add(&bar[XB_XGEN(b.x)], 1u);
            asm volatile("s_waitcnt vmcnt(0)" ::: "memory");
        } else {
            XB_SPIN(xb_ld(&bar[XB_XGEN(b.x)]) == gen, bar);
            __builtin_amdgcn_fence(__ATOMIC_ACQUIRE, "agent");
            asm volatile("s_waitcnt vmcnt(0)" ::: "memory");
        }
    }
    __syncthreads();
}
#define GAS __attribute__((address_space(1)))

typedef unsigned short bf16;
typedef float f32x4 __attribute__((ext_vector_type(4)));
typedef unsigned v4u __attribute__((ext_vector_type(4)));
typedef unsigned v2u __attribute__((ext_vector_type(2)));
#define LDS_WAIT() asm volatile("s_waitcnt lgkmcnt(0)" ::: "memory")

#ifndef MK_ONE_LAUNCH
#define MK_ONE_LAUNCH 0
#endif
#ifndef RET_MFMA
#define RET_MFMA 1
#endif
#ifndef SWA_MFMA
#define SWA_MFMA 1
#endif
#ifndef PROBE_DUP
#define PROBE_DUP 0
#endif
#ifndef CONV_FUSED
#define CONV_FUSED 1
#endif
#ifndef PLE_EARLY
#define PLE_EARLY 1
#endif
#ifndef LN_NOXR
#define LN_NOXR 1
#endif
#ifndef LN_FUSED
#define LN_FUSED 1
#endif
#ifndef RES_BF16
#define RES_BF16 1
#endif
#define REPS(k) int nrep_ = (PROBE_DUP == (k)) ? 2 : 1; asm volatile("" : "+s"(nrep_)); for (int rep_ = 0; rep_ < nrep_; ++rep_)

constexpr int INW_ = 5376, NUPG_ = 13312;
constexpr int S = 16384, D = 2048, INW = 5376, DFF = 5632, NUP = 2 * DFF, NUPG = NUP + D, PLE = 256, DEPTH = 4;
constexpr float ALPHA = 1.6817928305074290f, LN_EPS = 1e-5f, GN_EPS = 1e-6f;
constexpr int NPH = 11, NPHASES = 1 + DEPTH * NPH;

constexpr size_t MiB = 1u << 20;
constexpr size_t WS_CTL = 0, CTL_ZERO_BYTES = 1 * MiB;
constexpr size_t WS_C = 65536; constexpr int C_L = 2 * INW_ + 2 * NUPG_, C1IN = 0, C2IN = INW_, C1UP = 2 * INW_, C2UP = 2 * INW_ + NUPG_;
constexpr size_t WS_YH = 1304 * MiB;
constexpr size_t WS_CP = 540 * MiB;
constexpr size_t WS_PSTAT = 532 * MiB;
constexpr size_t WS_COSR = 2 * MiB, WS_SINR = 10 * MiB, WS_COSA = 18 * MiB, WS_SINA = 20 * MiB;
constexpr size_t WS_W = 32 * MiB, WL_BYTES = 106 * MiB;
constexpr size_t WL_IN = 0, WL_OUT = 21 * MiB, WL_UP = 29 * MiB, WL_G = 73 * MiB, WL_DOWN = 81 * MiB, WL_P = 104 * MiB;
constexpr size_t WS_XR = 530 * MiB, WS_XB = 576 * MiB, WS_Y = 640 * MiB;
constexpr size_t WS_Q = 768 * MiB, WS_K = 800 * MiB, WS_V = 832 * MiB, WS_G = 864 * MiB, WS_AQ = 896 * MiB, WS_AK = 928 * MiB, WS_AV = 932 * MiB;
constexpr size_t WS_MIX = 936 * MiB, WS_U = 1000 * MiB, WS_PS = 1128 * MiB, WS_RETY = 1160 * MiB;
constexpr size_t WS_H = 768 * MiB, WS_ACT = 1128 * MiB, WS_SG = 460 * MiB, WS_PB = 1368 * MiB, WS_END = 1400 * MiB;
constexpr size_t WS_PP = 1064 * MiB;
constexpr size_t WS_ST1 = 24 * MiB, WS_ST2 = 25 * MiB;
constexpr int CW_BAR = 4096;
static_assert((CW_BAR + 3456) * 4 <= 32768 && WS_C + (size_t)4 * C_L * 4 <= CTL_ZERO_BYTES, "barrier words and column sums inside the per-call memset");

constexpr int RING_BYTES = 131072, LDS_BYTES = 147456, LDSCTL_OFF = LDS_BYTES - 1024, MISC_OFF = LDSCTL_OFF + 320;

__device__ __forceinline__ unsigned f2bf(float f) { unsigned u = __builtin_bit_cast(unsigned, f); return (u + 0x7fffu + ((u >> 16) & 1u)) >> 16; }
__device__ __forceinline__ unsigned pk2(float lo, float hi) { return f2bf(lo) | (f2bf(hi) << 16); }
__device__ __forceinline__ float bflo(unsigned w) { return __uint_as_float(w << 16); }
__device__ __forceinline__ float bfhi(unsigned w) { return __uint_as_float(w & 0xffff0000u); }
__device__ __forceinline__ float bf1(const bf16* p) { return __uint_as_float(((unsigned)*p) << 16); }

struct Params {
    const float* in[19]; float* out; unsigned char* ws; int ph_lo, ph_hi;
    float invf_ret[128]; float invf_att[32]; float lg2g[4];
};

struct Ctx { int tid, lane, wave, G, bid; unsigned char* ws; };

__device__ __forceinline__ int lane_id_asm() { int l; asm volatile("v_mbcnt_lo_u32_b32 %0, -1, 0\n\tv_mbcnt_hi_u32_b32 %0, -1, %0" : "=v"(l)); return l; }
__device__ __forceinline__ float wave_sum(float v, int lane) {
#pragma unroll
    for (int o = 1; o < 64; o <<= 1) v += __builtin_bit_cast(float, __builtin_amdgcn_ds_bpermute((lane ^ o) << 2, __builtin_bit_cast(int, v)));
    return v;
}
__device__ __forceinline__ void transpose_item(const float* W, int K, int N, int src_col0, bf16* WT, int dst_row0, int k0, LAS float* scr, int lane) {
#pragma unroll 8
    for (int i = 0; i < 32; ++i) { const int kk = 2 * i + (lane >> 5); scr[kk * 33 + (lane & 31)] = W[(size_t)(k0 + kk) * N + src_col0 + (lane & 31)]; }
    LDS_WAIT(); asm volatile("" ::: "memory");
    const int c = lane & 7;
#pragma unroll
    for (int j = 0; j < 4; ++j) { const int n = (lane >> 3) + 8 * j; const LAS float* s = scr + (8 * c) * 33 + n;
        v4u o; o.x = pk2(s[0 * 33], s[1 * 33]); o.y = pk2(s[2 * 33], s[3 * 33]); o.z = pk2(s[4 * 33], s[5 * 33]); o.w = pk2(s[6 * 33], s[7 * 33]);
        *(v4u*)(WT + (size_t)(dst_row0 + n) * K + k0 + 8 * c) = o; }
    LDS_WAIT(); asm volatile("" ::: "memory");
}
__device__ __forceinline__ void transpose_item64(const float* W, int K, int N, int srcA, int srcB, bf16* WT, int dst_row0, int k0, LAS float* scr, int lane, int tiled = 0) {
    const int c4 = lane & 15, gsel = c4 >> 3, col = 4 * (c4 & 7), src = (gsel ? srcB : srcA) + col, kq = lane >> 4;
    f32x4 v[16];
#pragma unroll
    for (int i = 0; i < 16; ++i) v[i] = *(const f32x4*)(W + (size_t)(k0 + 4 * i + kq) * N + src);
#pragma unroll
    for (int i = 0; i < 16; ++i) { LAS float* d = scr + (4 * i + kq) * 65 + 32 * gsel + col; d[0] = v[i][0]; d[1] = v[i][1]; d[2] = v[i][2]; d[3] = v[i][3]; }
    LDS_WAIT(); asm volatile("" ::: "memory");
    const int c = lane & 7;
#pragma unroll
    for (int j = 0; j < 8; ++j) { const int n = (lane >> 3) + 8 * j; const LAS float* s = scr + (8 * c) * 65 + n;
        v4u o; o.x = pk2(s[0 * 65], s[1 * 65]); o.y = pk2(s[2 * 65], s[3 * 65]); o.z = pk2(s[4 * 65], s[5 * 65]); o.w = pk2(s[6 * 65], s[7 * 65]);
        *(v4u*)(WT + (tiled ? pg8::tiled_off(dst_row0 + n, k0 + 8 * c, K) : (size_t)(dst_row0 + n) * K + k0 + 8 * c)) = o; }
    LDS_WAIT(); asm volatile("" ::: "memory");
}
__device__ __forceinline__ void transpose_unit(const float* W, int K, int N, int srcA, int srcB, bf16* WT, int dst_row0, int kb0, int nkb, LAS float* scr, int lane, int tiled,
                                               const float* gv, const float* bv, float* c1, float* c2) {
    const int c4 = lane & 15, gsel = c4 >> 3, col = 4 * (c4 & 7), src = (gsel ? srcB : srcA) + col, kq = lane >> 4, c = lane & 7;
    f32x4 c1p = (f32x4){0.f, 0.f, 0.f, 0.f}, c2p = (f32x4){0.f, 0.f, 0.f, 0.f};
    for (int kb = kb0; kb < kb0 + nkb; ++kb) { const int k0 = 64 * kb;
        f32x4 v[16];
#pragma unroll
        for (int i = 0; i < 16; ++i) v[i] = *(const f32x4*)(W + (size_t)(k0 + 4 * i + kq) * N + src);
        if (gv) {
#pragma unroll
            for (int i = 0; i < 16; ++i) { const float gk = gv[k0 + 4 * i + kq], bk = bv[k0 + 4 * i + kq]; c2p = c2p + v[i] * bk; v[i] = v[i] * gk;
#pragma unroll
                for (int e = 0; e < 4; ++e) c1p[e] += __uint_as_float(f2bf(v[i][e]) << 16); } }
#pragma unroll
        for (int i = 0; i < 16; ++i) { LAS float* d = scr + (4 * i + kq) * 65 + 32 * gsel + col; d[0] = v[i][0]; d[1] = v[i][1]; d[2] = v[i][2]; d[3] = v[i][3]; }
        LDS_WAIT(); asm volatile("" ::: "memory");
#pragma unroll
        for (int j = 0; j < 8; ++j) { const int n = (lane >> 3) + 8 * j; const LAS float* sp = scr + (8 * c) * 65 + n;
            v4u o; o.x = pk2(sp[0 * 65], sp[1 * 65]); o.y = pk2(sp[2 * 65], sp[3 * 65]); o.z = pk2(sp[4 * 65], sp[5 * 65]); o.w = pk2(sp[6 * 65], sp[7 * 65]);
            *(v4u*)(WT + (tiled ? pg8::tiled_off(dst_row0 + n, k0 + 8 * c, K) : (size_t)(dst_row0 + n) * K + k0 + 8 * c)) = o; }
        LDS_WAIT(); asm volatile("" ::: "memory");
    }
    if (gv) {
#pragma unroll
        for (int e = 0; e < 4; ++e) {
            float a = c1p[e], b = c2p[e];
            a += __builtin_bit_cast(float, __builtin_amdgcn_ds_bpermute((lane ^ 16) << 2, __builtin_bit_cast(int, a))); b += __builtin_bit_cast(float, __builtin_amdgcn_ds_bpermute((lane ^ 16) << 2, __builtin_bit_cast(int, b)));
            a += __builtin_bit_cast(float, __builtin_amdgcn_ds_bpermute((lane ^ 32) << 2, __builtin_bit_cast(int, a))); b += __builtin_bit_cast(float, __builtin_amdgcn_ds_bpermute((lane ^ 32) << 2, __builtin_bit_cast(int, b)));
            if (kq == 0) { c1[dst_row0 + 32 * gsel + col + e] = a; c2[dst_row0 + 32 * gsel + col + e] = b; } }
    }
}
__device__ __forceinline__ int win_src_col(int g) {
    const int tile = g >> 3, bj = (g >> 2) & 1, wcg = g & 3;
    if (tile < 16) return 32 * g;
    if (tile < 20) return 4096 + 256 * (tile - 16) + 64 * wcg + 32 * bj;
    return wcg < 2 ? 5120 + 64 * wcg + 32 * bj : 5248 + 32 * (wcg - 2) + 64 * bj;
}
__device__ __forceinline__ int wup_src_col(int g) { const int tile = g >> 3, bj = (g >> 2) & 1, wcg = g & 3; return (bj ? DFF : 0) + 128 * tile + 32 * wcg; }

__device__ __forceinline__ void sincos_d(float angf, float& s, float& c) {
    const double a = (double)angf;
    const double k = __builtin_rint(a * 0.63661977236758134308);
    double r = __builtin_fma(-k, 1.57079632679489661923, a); r = __builtin_fma(-k, 6.123233995736766e-17, r);
    const double r2 = r * r;
    const double sp = r + r * r2 * (-1.0 / 6 + r2 * (1.0 / 120 + r2 * (-1.0 / 5040 + r2 * (1.0 / 362880 + r2 * (-1.0 / 39916800)))));
    const double cp = 1.0 + r2 * (-0.5 + r2 * (1.0 / 24 + r2 * (-1.0 / 720 + r2 * (1.0 / 40320 + r2 * (-1.0 / 3628800 + r2 * (1.0 / 479001600))))));
    const int q = ((int)k) & 3;
    const double sv = (q == 0) ? sp : (q == 1) ? cp : (q == 2) ? -sp : -cp;
    const double cv = (q == 0) ? cp : (q == 1) ? -sp : (q == 2) ? -cp : sp;
    s = (float)sv; c = (float)cv;
}

__device__ __forceinline__ void phase_prologue(const Params& P, const Ctx& cx, LAS unsigned char* lds) {
    unsigned char* ws = cx.ws; const int tid = cx.tid, lane = cx.lane, wave = cx.wave, G = cx.G;
    LAS float* scr = (LAS float*)(lds + wave * 16896);
    const int gw = cx.bid * 8 + wave, NGW = G * 8;
#if LN_FUSED
    constexpr int U_IN = 84 * 8, U_OUT = 32 * 8, U_UP = 176 * 8, U_G = 32 * 8, U_DN = 32 * 22, U_P = 32, U_L = U_IN + U_OUT + U_UP + U_G + U_DN + U_P;
    for (int it = gw; it < DEPTH * U_L; it += NGW) {
        const int l = it / U_L; int r = it - l * U_L;
        bf16* wl = (bf16*)(ws + WS_W + (size_t)l * WL_BYTES); float* cl0 = (float*)(ws + WS_CP) + (size_t)l * C_L;
        const float* g1 = P.in[8] + l * D; const float* b1 = P.in[9] + l * D;
        const float* g2 = l ? P.in[14] + (l - 1) * D : nullptr; const float* b2 = l ? P.in[15] + (l - 1) * D : nullptr;
        const float* W; int K = D, N = D, sa, sb, g, kc, nkb = 4, tiled = 0; bf16* WT; const float* gv = nullptr; const float* bv = nullptr; float* c1 = nullptr; float* c2 = nullptr;
        if (r < U_IN) { g = r >> 3; kc = r & 7; W = P.in[3] + (size_t)l * D * INW; N = INW; sa = win_src_col(2 * g); sb = win_src_col(2 * g + 1); WT = wl + WL_IN / 2; gv = g2; bv = b2; c1 = cl0 + C1IN; c2 = cl0 + C2IN; }
        else if ((r -= U_IN) < U_OUT) { g = r >> 3; kc = r & 7; W = P.in[4] + (size_t)l * D * D; sa = 64 * g; sb = sa + 32; WT = wl + WL_OUT / 2; }
        else if ((r -= U_OUT) < U_UP) { g = r >> 3; kc = r & 7; W = P.in[10] + (size_t)l * D * NUP; N = NUP; sa = wup_src_col(2 * g); sb = wup_src_col(2 * g + 1); WT = wl + WL_UP / 2; gv = g1; bv = b1; c1 = cl0 + C1UP; c2 = cl0 + C2UP; }
        else if ((r -= U_UP) < U_G) { g = r >> 3; kc = r & 7; W = P.in[16] + (size_t)l * D * D; sa = 64 * g; sb = sa + 32; WT = wl + WL_G / 2; gv = g1; bv = b1; c1 = cl0 + C1UP + NUP; c2 = cl0 + C2UP + NUP; }
        else if ((r -= U_G) < U_DN) { g = r / 22; kc = r % 22; W = P.in[13] + (size_t)l * DFF * D; K = DFF; sa = 64 * g; sb = sa + 32; WT = wl + WL_DOWN / 2; tiled = 1; }
        else { r -= U_DN; g = r; kc = 0; W = P.in[18] + (size_t)l * PLE * D; K = PLE; sa = 64 * g; sb = sa + 32; WT = wl + WL_P / 2; }
        if (c1) { c1 += (size_t)kc * DEPTH * C_L; c2 += (size_t)kc * DEPTH * C_L; }
        transpose_unit(W, K, N, sa, sb, WT, 64 * g, 4 * kc, nkb, scr, lane, tiled, gv, bv, c1, c2);
    }
#else
    constexpr int I_IN = 32 * 84, I_OUT = 32 * 32, I_UP = 32 * 176, I_G = 32 * 32, I_DN = 88 * 32, I_P = 4 * 32, I_L = I_IN + I_OUT + I_UP + I_G + I_DN + I_P;
    for (int it = gw; it < DEPTH * I_L; it += NGW) {
        const int l = it / I_L; int r = it - l * I_L;
        bf16* wl = (bf16*)(ws + WS_W + (size_t)l * WL_BYTES);
        if (r < I_IN) { const int kb = r / 84, g = r % 84; transpose_item64(P.in[3] + (size_t)l * D * INW, D, INW, win_src_col(2 * g), win_src_col(2 * g + 1), wl + WL_IN / 2, 64 * g, 64 * kb, scr, lane); continue; } r -= I_IN;
        if (r < I_OUT) { const int kb = r / 32, g = r % 32; transpose_item64(P.in[4] + (size_t)l * D * D, D, D, 64 * g, 64 * g + 32, wl + WL_OUT / 2, 64 * g, 64 * kb, scr, lane); continue; } r -= I_OUT;
        if (r < I_UP) { const int kb = r / 176, g = r % 176; transpose_item64(P.in[10] + (size_t)l * D * NUP, D, NUP, wup_src_col(2 * g), wup_src_col(2 * g + 1), wl + WL_UP / 2, 64 * g, 64 * kb, scr, lane); continue; } r -= I_UP;
        if (r < I_G) { const int kb = r / 32, g = r % 32; transpose_item64(P.in[16] + (size_t)l * D * D, D, D, 64 * g, 64 * g + 32, wl + WL_G / 2, 64 * g, 64 * kb, scr, lane); continue; } r -= I_G;
        if (r < I_DN) { const int kb = r / 32, g = r % 32; transpose_item64(P.in[13] + (size_t)l * DFF * D, DFF, D, 64 * g, 64 * g + 32, wl + WL_DOWN / 2, 64 * g, 64 * kb, scr, lane, 1); continue; } r -= I_DN;
        { const int kb = r / 32, g = r % 32; transpose_item64(P.in[18] + (size_t)l * PLE * D, PLE, D, 64 * g, 64 * g + 32, wl + WL_P / 2, 64 * g, 64 * kb, scr, lane); }
    }
#endif
    const size_t gt = (size_t)cx.bid * 512 + tid, NT = (size_t)G * 512;
    { const float* x = P.in[0]; bf16* xb = (bf16*)(ws + WS_XB);
      for (size_t i = gt; i < (size_t)S * D / 8; i += NT) { const f32x4 a = *(const f32x4*)(x + i * 8), b = *(const f32x4*)(x + i * 8 + 4);
          v4u o; o.x = pk2(a[0], a[1]); o.y = pk2(a[2], a[3]); o.z = pk2(b[0], b[1]); o.w = pk2(b[2], b[3]); *(v4u*)(xb + i * 8) = o; } }
    { const float* p = P.in[1]; bf16* pb = (bf16*)(ws + WS_PB);
      for (size_t i = gt; i < (size_t)DEPTH * S * PLE / 8; i += NT) { const f32x4 a = *(const f32x4*)(p + i * 8), b = *(const f32x4*)(p + i * 8 + 4);
          v4u o; o.x = pk2(a[0], a[1]); o.y = pk2(a[2], a[3]); o.z = pk2(b[0], b[1]); o.w = pk2(b[2], b[3]); *(v4u*)(pb + i * 8) = o; } }
    { const int* pos = (const int*)P.in[2]; float* cosr = (float*)(ws + WS_COSR); float* sinr = (float*)(ws + WS_SINR); float* cosa = (float*)(ws + WS_COSA); float* sina = (float*)(ws + WS_SINA);
      for (size_t i = gt; i < (size_t)S * 128; i += NT) { const int t = (int)(i >> 7), f = (int)(i & 127); float s, c; sincos_d((float)pos[t] * P.invf_ret[f], s, c); cosr[i] = c; sinr[i] = s; }
      for (size_t i = gt; i < (size_t)S * 32; i += NT) { const int t = (int)(i >> 5), f = (int)(i & 31); float s, c; sincos_d((float)pos[t] * P.invf_att[f], s, c); cosa[i] = c; sina[i] = s; } }
}

template <int MT, int NT_, int KK, bool A_KFAST, bool B_NFAST, class FA, class FB, class FC>
__device__ __forceinline__ void simple_gemm(LAS unsigned char* lds, int nbatch, int tid, int G, int bid, const FA& fa, const FB& fb, const FC& fc) {
    LAS float* As = (LAS float*)lds;
    LAS float* Bs = (LAS float*)(lds + 16 * 132 * 4);
    constexpr int TM = MT / 128, TN = NT_ / 64, ITEMS_PER_B = TM * TN;
    const int tm = tid & 31, tn = tid >> 5;
    for (int item = bid; item < nbatch * ITEMS_PER_B; item += G) {
        const int b = item / ITEMS_PER_B, r = item % ITEMS_PER_B, m0 = (r / TN) * 128, n0 = (r % TN) * 64;
        float c[4][4];
#pragma unroll
        for (int i = 0; i < 4; ++i)
#pragma unroll
            for (int j = 0; j < 4; ++j) c[i][j] = 0.f;
        for (int k0 = 0; k0 < KK; k0 += 16) {
#pragma unroll
            for (int rr = 0; rr < 4; ++rr) { const int e = tid + 512 * rr; int m, k; if (A_KFAST) { k = e & 15; m = e >> 4; } else { m = e & 127; k = e >> 7; }
                As[k * 132 + m] = fa(b, m0 + m, k0 + k); }
#pragma unroll
            for (int rr = 0; rr < 2; ++rr) { const int e = tid + 512 * rr; int n, k; if (B_NFAST) { n = e & 63; k = e >> 6; } else { k = e & 15; n = e >> 4; }
                Bs[k * 68 + n] = fb(b, k0 + k, n0 + n); }
            __syncthreads();
#pragma unroll
            for (int kk = 0; kk < 16; ++kk) { const f32x4 a = *(const LAS f32x4*)(As + kk * 132 + 4 * tm), bb = *(const LAS f32x4*)(Bs + kk * 68 + 4 * tn);
#pragma unroll
                for (int i = 0; i < 4; ++i)
#pragma unroll
                    for (int j = 0; j < 4; ++j) c[i][j] += a[i] * bb[j]; }
            __syncthreads();
        }
#pragma unroll
        for (int i = 0; i < 4; ++i)
#pragma unroll
            for (int j = 0; j < 4; ++j) fc(b, m0 + 4 * tm + i, n0 + 4 * tn + j, c[i][j]);
    }
}

__device__ __forceinline__ void phase_swa(const Params& P, const Ctx& cx, int l, LAS unsigned char* lds) {
    unsigned char* ws = cx.ws; const int tid = cx.tid, G = cx.G;
    const bf16* AQ = (const bf16*)(ws + WS_AQ); const bf16* AK = (const bf16*)(ws + WS_AK); const bf16* AV = (const bf16*)(ws + WS_AV); bf16* MIX = (bf16*)(ws + WS_MIX);
    const float* sinks = P.in[7] + l * 16;
    LAS unsigned* Ks = (LAS unsigned*)lds;
    LAS unsigned* Vs = (LAS unsigned*)(lds + 256 * 33 * 4);
    for (int item = cx.bid; item < 256; item += G) {
        const int nb = item >> 1, hk = item & 1;
        __syncthreads();
        for (int e = tid; e < 256 * 32; e += 512) { const int r = e >> 5, cdw = e & 31; const int gk = nb * 128 - 128 + r;
            unsigned kv = 0u, vv = 0u; if (gk >= 0) { kv = *(const unsigned*)(AK + (size_t)gk * 128 + hk * 64 + 2 * cdw); vv = *(const unsigned*)(AV + (size_t)gk * 128 + hk * 64 + 2 * cdw); }
            Ks[r * 33 + cdw] = kv; Vs[r * 33 + cdw] = vv; }
        __syncthreads();
#pragma unroll 1
        for (int rep = 0; rep < 2; ++rep) {
            const int pair = tid + 512 * rep, i = pair & 127, g = pair >> 7, hq = hk * 8 + g; const int row = nb * 128 + i;
            float q[64], o[64];
            { const v4u* qp = (const v4u*)(AQ + (size_t)row * 1024 + hq * 64);
#pragma unroll
              for (int c8 = 0; c8 < 8; ++c8) { const v4u w = qp[c8]; q[8 * c8 + 0] = bflo(w.x); q[8 * c8 + 1] = bfhi(w.x); q[8 * c8 + 2] = bflo(w.y); q[8 * c8 + 3] = bfhi(w.y); q[8 * c8 + 4] = bflo(w.z); q[8 * c8 + 5] = bfhi(w.z); q[8 * c8 + 6] = bflo(w.w); q[8 * c8 + 7] = bfhi(w.w); } }
#pragma unroll
            for (int d = 0; d < 64; ++d) o[d] = 0.f;
            float mx = sinks[hq], den = 1.0f;
            const int jj0 = (nb == 0) ? (127 - i) : 0;
            for (int jj = jj0; jj < 128; ++jj) { const int kl = i + 1 + jj;
                float s = 0.f;
#pragma unroll
                for (int c = 0; c < 32; ++c) { const unsigned w = Ks[kl * 33 + c]; s += q[2 * c] * bflo(w) + q[2 * c + 1] * bfhi(w); }
                const float mn = fmaxf(mx, s), sc = __expf(mx - mn), p = __expf(s - mn);
                den = den * sc + p; mx = mn;
#pragma unroll
                for (int c = 0; c < 32; ++c) { const unsigned w = Vs[kl * 33 + c]; o[2 * c] = o[2 * c] * sc + p * bflo(w); o[2 * c + 1] = o[2 * c + 1] * sc + p * bfhi(w); }
            }
            const float inv = 1.0f / den;
            v4u* op = (v4u*)(MIX + (size_t)row * 2048 + 1024 + hq * 64);
#pragma unroll
            for (int c8 = 0; c8 < 8; ++c8) { v4u w; w.x = pk2(o[8 * c8] * inv, o[8 * c8 + 1] * inv); w.y = pk2(o[8 * c8 + 2] * inv, o[8 * c8 + 3] * inv); w.z = pk2(o[8 * c8 + 4] * inv, o[8 * c8 + 5] * inv); w.w = pk2(o[8 * c8 + 6] * inv, o[8 * c8 + 7] * inv); op[c8] = w; }
        }
    }
}

__device__ __forceinline__ void phase_ret_u_scores(const Params& P, const Ctx& cx, LAS unsigned char* lds) {
    unsigned char* ws = cx.ws; const int tid = cx.tid, G = cx.G;
    const bf16* Q = (const bf16*)(ws + WS_Q); const bf16* K = (const bf16*)(ws + WS_K); const bf16* V = (const bf16*)(ws + WS_V);
    float* U = (float*)(ws + WS_U); float* PS = (float*)(ws + WS_PS);
    const float lg0 = P.lg2g[0], lg1 = P.lg2g[1], lg2 = P.lg2g[2], lg3 = P.lg2g[3];
    auto lgh = [=](int h) { return h == 0 ? lg0 : h == 1 ? lg1 : h == 2 ? lg2 : lg3; };
    simple_gemm<256, 256, 128, false, true>(lds, 512, tid, G, cx.bid,
        [=](int b, int m, int k) { const int nb = b >> 2, h = b & 3; return bf1(K + (size_t)(nb * 128 + k) * 1024 + h * 256 + m) * exp2f(lgh(h) * (float)(127 - k)); },
        [=](int b, int k, int n) { const int nb = b >> 2, h = b & 3; return bf1(V + (size_t)(nb * 128 + k) * 1024 + h * 256 + n); },
        [=](int b, int m, int n, float v) { U[((size_t)b * 256 + m) * 256 + n] = v; });
    simple_gemm<128, 128, 256, true, false>(lds, 512, tid, G, cx.bid,
        [=](int b, int m, int k) { const int nb = b >> 2, h = b & 3; return bf1(Q + (size_t)(nb * 128 + m) * 1024 + h * 256 + k); },
        [=](int b, int k, int n) { const int nb = b >> 2, h = b & 3; return bf1(K + (size_t)(nb * 128 + n) * 1024 + h * 256 + k); },
        [=](int b, int m, int n, float v) { const int h = b & 3; PS[((size_t)b * 128 + m) * 128 + n] = (m >= n) ? v * exp2f(lgh(h) * (float)(m - n)) : 0.f; });
}
__device__ __forceinline__ void phase_scan(const Params& P, const Ctx& cx) {
    float* U = (float*)(cx.ws + WS_U);
    const size_t gt = (size_t)cx.bid * 512 + cx.tid, NT = (size_t)cx.G * 512;
    for (size_t idx = gt; idx < 4 * 65536; idx += NT) {
        const int h = (int)(idx >> 16); const float cd = exp2f(P.lg2g[h] * 128.0f);
        float r = 0.f;
        for (int n0 = 0; n0 < 128; n0 += 8) { float u[8];
#pragma unroll
            for (int j = 0; j < 8; ++j) u[j] = U[(size_t)(n0 + j) * 262144 + idx];
#pragma unroll
            for (int j = 0; j < 8; ++j) { U[(size_t)(n0 + j) * 262144 + idx] = r; r = r * cd + u[j]; } }
    }
}
__device__ __forceinline__ void phase_ret_out(const Params& P, const Ctx& cx, LAS unsigned char* lds) {
    unsigned char* ws = cx.ws; const int tid = cx.tid, G = cx.G;
    const bf16* Q = (const bf16*)(ws + WS_Q); const bf16* V = (const bf16*)(ws + WS_V);
    const float* Sst = (const float*)(ws + WS_U); const float* PS = (const float*)(ws + WS_PS); float* RY = (float*)(ws + WS_RETY);
    const float lg0 = P.lg2g[0], lg1 = P.lg2g[1], lg2 = P.lg2g[2], lg3 = P.lg2g[3];
    auto lgh = [=](int h) { return h == 0 ? lg0 : h == 1 ? lg1 : h == 2 ? lg2 : lg3; };
    simple_gemm<128, 256, 384, true, true>(lds, 512, tid, G, cx.bid,
        [=](int b, int m, int k) { const int nb = b >> 2, h = b & 3; return k < 128 ? PS[((size_t)b * 128 + m) * 128 + k] : bf1(Q + (size_t)(nb * 128 + m) * 1024 + h * 256 + (k - 128)) * exp2f(lgh(h) * (float)(m + 1)); },
        [=](int b, int k, int n) { const int nb = b >> 2, h = b & 3; return k < 128 ? bf1(V + (size_t)(nb * 128 + k) * 1024 + h * 256 + n) : Sst[((size_t)b * 256 + (k - 128)) * 256 + n]; },
        [=](int b, int m, int n, float v) { const int nb = b >> 2, h = b & 3; RY[(size_t)(nb * 128 + m) * 1024 + h * 256 + n] = v; });
}

typedef short bf16x8 __attribute__((ext_vector_type(8)));
typedef short s16x4 __attribute__((ext_vector_type(4)));
typedef short v4i16_t __attribute__((ext_vector_type(4)));
__device__ __forceinline__ f32x4 mfma16(bf16x8 a, bf16x8 b, f32x4 c) { return __builtin_amdgcn_mfma_f32_16x16x32_bf16(a, b, c, 0, 0, 0); }
__device__ __forceinline__ s16x4 lds_tr(LAS unsigned char* p) { return __builtin_bit_cast(s16x4, __builtin_amdgcn_ds_read_tr16_b64_v4i16((LAS v4i16_t*)p)); }
__device__ __forceinline__ bf16x8 cat44(s16x4 a, s16x4 b) { bf16x8 r; r[0] = a[0]; r[1] = a[1]; r[2] = a[2]; r[3] = a[3]; r[4] = b[0]; r[5] = b[1]; r[6] = b[2]; r[7] = b[3]; return r; }
__device__ __forceinline__ unsigned cvt2(float lo, float hi) { return pg8::cvt_pk_bf16(lo, hi); }
__device__ __forceinline__ bf16x8 pack_frag(const f32x4 a, const f32x4 b) { v4u w; w.x = cvt2(a[0], a[1]); w.y = cvt2(a[2], a[3]); w.z = cvt2(b[0], b[1]); w.w = cvt2(b[2], b[3]); return __builtin_bit_cast(bf16x8, w); }
__device__ __forceinline__ float grp16_sum(float v, int lane) {
#pragma unroll
    for (int o = 1; o < 16; o <<= 1) v += __builtin_bit_cast(float, __builtin_amdgcn_ds_bpermute((lane ^ o) << 2, __builtin_bit_cast(int, v)));
    return v;
}

__device__ __forceinline__ unsigned lds_addr(const LAS unsigned char* p) { return (unsigned)(size_t)p; }
template <int O1, int O2, int O3, int O4, int O5, int O6, int O7>
__device__ __forceinline__ void lds_rd8(bf16x8 (&t)[8], unsigned a) {
    asm volatile("ds_read_b128 %0, %8\n\tds_read_b128 %1, %8 offset:%9\n\tds_read_b128 %2, %8 offset:%10\n\tds_read_b128 %3, %8 offset:%11\n\t"
                 "ds_read_b128 %4, %8 offset:%12\n\tds_read_b128 %5, %8 offset:%13\n\tds_read_b128 %6, %8 offset:%14\n\tds_read_b128 %7, %8 offset:%15\n\ts_waitcnt lgkmcnt(0)"
                 : "=&v"(t[0]), "=&v"(t[1]), "=&v"(t[2]), "=&v"(t[3]), "=&v"(t[4]), "=&v"(t[5]), "=&v"(t[6]), "=&v"(t[7])
                 : "v"(a), "i"(O1), "i"(O2), "i"(O3), "i"(O4), "i"(O5), "i"(O6), "i"(O7) : "memory");
}
template <int OA, int OB, int OC>
__device__ __forceinline__ void lds_tr8(s16x4 (&t)[8], unsigned a0, unsigned a1) {
    asm volatile("ds_read_b64_tr_b16 %0, %8\n\tds_read_b64_tr_b16 %1, %8 offset:%10\n\tds_read_b64_tr_b16 %2, %8 offset:%11\n\tds_read_b64_tr_b16 %3, %8 offset:%12\n\t"
                 "ds_read_b64_tr_b16 %4, %9\n\tds_read_b64_tr_b16 %5, %9 offset:%10\n\tds_read_b64_tr_b16 %6, %9 offset:%11\n\tds_read_b64_tr_b16 %7, %9 offset:%12\n\ts_waitcnt lgkmcnt(0)"
                 : "=&v"(t[0]), "=&v"(t[1]), "=&v"(t[2]), "=&v"(t[3]), "=&v"(t[4]), "=&v"(t[5]), "=&v"(t[6]), "=&v"(t[7])
                 : "v"(a0), "v"(a1), "i"(OA), "i"(OB), "i"(OC) : "memory");
}
constexpr int RS_T = 544;
constexpr int TILE_T = 128 * RS_T;
static_assert(2 * TILE_T <= LDSCTL_OFF, "retention tiles vs LDS control words");

template <bool DECAY> __device__ __forceinline__ void stage_tile(LAS unsigned char* img, const bf16* src, int tid, float lg) {
    v4u v[8];
#pragma unroll
    for (int r = 0; r < 8; ++r) { const int pc = tid + 512 * r, row = pc >> 5, c16 = pc & 31; v[r] = *(const v4u*)(src + (size_t)row * 1024 + c16 * 8); }
#pragma unroll
    for (int r = 0; r < 8; ++r) { const int pc = tid + 512 * r, row = pc >> 5, c16 = pc & 31; v4u w = v[r];
        if (DECAY) { const float sc = exp2f(lg * (float)(127 - row));
            w.x = cvt2(bflo(w.x) * sc, bfhi(w.x) * sc); w.y = cvt2(bflo(w.y) * sc, bfhi(w.y) * sc); w.z = cvt2(bflo(w.z) * sc, bfhi(w.z) * sc); w.w = cvt2(bflo(w.w) * sc, bfhi(w.w) * sc); }
        *(LAS v4u*)(img + row * RS_T + c16 * 16) = w; }
}

template <bool DECAY_A> __device__ __forceinline__ void stage_two(LAS unsigned char* imgA, const bf16* srcA, LAS unsigned char* imgB, const bf16* srcB, int tid, float lg) {
    v4u va[8], vb[8];
#pragma unroll
    for (int r = 0; r < 8; ++r) { const int pc = tid + 512 * r, row = pc >> 5, c16 = pc & 31; va[r] = *(const v4u*)(srcA + (size_t)row * 1024 + c16 * 8); vb[r] = *(const v4u*)(srcB + (size_t)row * 1024 + c16 * 8); }
#pragma unroll
    for (int r = 0; r < 8; ++r) { const int pc = tid + 512 * r, row = pc >> 5, c16 = pc & 31; v4u w = va[r];
        if (DECAY_A) { const float sc = exp2f(lg * (float)(127 - row));
            w.x = cvt2(bflo(w.x) * sc, bfhi(w.x) * sc); w.y = cvt2(bflo(w.y) * sc, bfhi(w.y) * sc); w.z = cvt2(bflo(w.z) * sc, bfhi(w.z) * sc); w.w = cvt2(bflo(w.w) * sc, bfhi(w.w) * sc); }
        *(LAS v4u*)(imgA + row * RS_T + c16 * 16) = w; *(LAS v4u*)(imgB + row * RS_T + c16 * 16) = vb[r]; }
}

__device__ __forceinline__ void phase_ret_u_mfma(const Params& P, const Ctx& cx, LAS unsigned char* lds) {
    unsigned char* ws = cx.ws; const int tid = cx.tid, lane = cx.lane, w = cx.wave, r16 = lane & 15, g = lane >> 4, q = r16 >> 2, pp = r16 & 3;
    const bf16* K = (const bf16*)(ws + WS_K); const bf16* V = (const bf16*)(ws + WS_V); bf16* UT = (bf16*)(ws + WS_U);
    LAS unsigned char* Kim = lds; LAS unsigned char* Vim = lds + TILE_T;
    for (int b = cx.bid; b < 512; b += cx.G) {
        const int nb = b >> 2, h = b & 3;
        __syncthreads();
        stage_two<true>(Kim, K + (size_t)nb * 128 * 1024 + h * 256, Vim, V + (size_t)nb * 128 * 1024 + h * 256, tid, P.lg2g[h]);
        __syncthreads();
        f32x4 acc[2][16];
#pragma unroll
        for (int mi = 0; mi < 2; ++mi)
#pragma unroll
            for (int n = 0; n < 16; ++n) acc[mi][n] = (f32x4){0.f, 0.f, 0.f, 0.f};
#pragma unroll 1
        for (int s = 0; s < 4; ++s) {
            bf16x8 af[2];
#pragma unroll
            for (int mi = 0; mi < 2; ++mi) { LAS unsigned char* a0 = Kim + (32 * s + 8 * g + q) * RS_T + (16 * (2 * w + mi) + 4 * pp) * 2; af[mi] = cat44(lds_tr(a0), lds_tr(a0 + 4 * RS_T)); }
#pragma unroll
            for (int ng = 0; ng < 4; ++ng) { const unsigned b0 = lds_addr(Vim + (32 * s + 8 * g + q) * RS_T + (64 * ng + 4 * pp) * 2); s16x4 t[8];
                lds_tr8<32, 64, 96>(t, b0, b0 + 4 * RS_T);
#pragma unroll
                for (int nn = 0; nn < 4; ++nn) { const bf16x8 bfr = cat44(t[nn], t[4 + nn]); const int n = 4 * ng + nn;
                    acc[0][n] = mfma16(af[0], bfr, acc[0][n]); acc[1][n] = mfma16(af[1], bfr, acc[1][n]); } }
        }
#pragma unroll
        for (int mi = 0; mi < 2; ++mi)
#pragma unroll
            for (int n = 0; n < 16; ++n) { v2u o; o.x = cvt2(acc[mi][n][0], acc[mi][n][1]); o.y = cvt2(acc[mi][n][2], acc[mi][n][3]);
                *(v2u*)(UT + ((size_t)b * 256 + 16 * n + r16) * 256 + 16 * (2 * w + mi) + 4 * g) = o; }
    }
}
__device__ __forceinline__ void phase_scan_bf16(const Params& P, const Ctx& cx) {
    unsigned* UT = (unsigned*)(cx.ws + WS_U);
    const size_t gt = (size_t)cx.bid * 512 + cx.tid, NT = (size_t)cx.G * 512;
    for (size_t idx = gt; idx < 131072; idx += NT) {
        const int h = (int)(idx >> 15); const float cd = exp2f(P.lg2g[h] * 128.0f);
        float r0 = 0.f, r1 = 0.f;
        for (int n0 = 0; n0 < 128; n0 += 32) { unsigned u[32];
#pragma unroll
            for (int j = 0; j < 32; ++j) u[j] = UT[(size_t)(n0 + j) * 131072 + idx];
#pragma unroll
            for (int j = 0; j < 32; ++j) { UT[(size_t)(n0 + j) * 131072 + idx] = cvt2(r0, r1); r0 = r0 * cd + bflo(u[j]); r1 = r1 * cd + bfhi(u[j]); } }
    }
}
constexpr int RS_O = 1040;
static_assert(8 * 16 * RS_O <= 2 * TILE_T, "R3 output staging fits the shared area");
__device__ __forceinline__ void phase_ret_out_mfma(const Params& P, const Ctx& cx, int l, LAS unsigned char* lds) {
    unsigned char* ws = cx.ws; const int w = cx.wave;
    const bf16* Q = (const bf16*)(ws + WS_Q); const bf16* K = (const bf16*)(ws + WS_K); const bf16* V = (const bf16*)(ws + WS_V); const bf16* ST = (const bf16*)(ws + WS_U);
    const bf16* Gt = (const bf16*)(ws + WS_G); bf16* MIX = (bf16*)(ws + WS_MIX);
    const float* gg = P.in[5] + l * 1024; const float* gb = P.in[6] + l * 1024;
    LAS unsigned char* Kim = lds; LAS unsigned char* Vim = lds + TILE_T;
    for (int b = cx.bid; b < 512; b += cx.G) {
        const int nb = b >> 2, h = b & 3; const float lg = P.lg2g[h];
        int lane = cx.lane; asm volatile("" : "+v"(lane)); const int tid = w * 64 + lane, r16 = lane & 15, g = lane >> 4, q = r16 >> 2, pp = r16 & 3;
        __syncthreads();
        { const bf16* stb = ST + (size_t)b * 65536;
          v4u v[16];
#pragma unroll
          for (int r = 0; r < 16; ++r) { const int pc = tid + 512 * r, row = pc >> 5, c16 = pc & 31; v[r] = *(const v4u*)(stb + (size_t)row * 256 + c16 * 8); }
#pragma unroll
          for (int r = 0; r < 16; ++r) { const int pc = tid + 512 * r, row = pc >> 5, c16 = pc & 31; *(LAS v4u*)(lds + row * RS_T + c16 * 16) = v[r]; } }
        bf16x8 qf[8];
        { const bf16* qrow = Q + (size_t)(nb * 128 + 16 * w + r16) * 1024 + h * 256 + 8 * g;
#pragma unroll
          for (int s = 0; s < 8; ++s) qf[s] = *(const bf16x8*)(qrow + 32 * s); }
        const bf16* ksrc = K + (size_t)nb * 128 * 1024 + h * 256; const bf16* vsrc = V + (size_t)nb * 128 * 1024 + h * 256;
        v4u kv[8];
#pragma unroll
        for (int r = 0; r < 8; ++r) { const int pc = tid + 512 * r, row = pc >> 5, c16 = pc & 31; kv[r] = *(const v4u*)(ksrc + (size_t)row * 1024 + c16 * 8); }
        __syncthreads();
        f32x4 acc[16];
#pragma unroll
        for (int n = 0; n < 16; ++n) { f32x4 a = (f32x4){0.f, 0.f, 0.f, 0.f}; bf16x8 t[8];
            lds_rd8<64, 128, 192, 256, 320, 384, 448>(t, lds_addr(lds + (16 * n + r16) * RS_T + 16 * g));
#pragma unroll
            for (int s = 0; s < 8; ++s) a = mfma16(qf[s], t[s], a);
            acc[n] = a; }
        { float f[4];
#pragma unroll
          for (int r = 0; r < 4; ++r) f[r] = exp2f(lg * (float)(16 * w + 4 * g + r + 1));
#pragma unroll
          for (int n = 0; n < 16; ++n) { acc[n][0] *= f[0]; acc[n][1] *= f[1]; acc[n][2] *= f[2]; acc[n][3] *= f[3]; } }
        __syncthreads();
        v4u vv[8];
#pragma unroll
        for (int r = 0; r < 8; ++r) { const int pc = tid + 512 * r, row = pc >> 5, c16 = pc & 31; *(LAS v4u*)(Kim + row * RS_T + c16 * 16) = kv[r]; vv[r] = *(const v4u*)(vsrc + (size_t)row * 1024 + c16 * 8); }
        __syncthreads();
        f32x4 sc[8];
#pragma unroll
        for (int mb = 0; mb < 8; ++mb) { sc[mb] = (f32x4){0.f, 0.f, 0.f, 0.f};
            if (mb <= w) { f32x4 a = (f32x4){0.f, 0.f, 0.f, 0.f}; bf16x8 t[8];
                lds_rd8<64, 128, 192, 256, 320, 384, 448>(t, lds_addr(Kim + (16 * mb + r16) * RS_T + 16 * g));
#pragma unroll
                for (int s = 0; s < 8; ++s) a = mfma16(t[s], qf[s], a);
                const int i = 16 * w + r16;
#pragma unroll
                for (int r = 0; r < 4; ++r) { const int j = 16 * mb + 4 * g + r; a[r] = (i >= j) ? a[r] * exp2f(lg * (float)(i - j)) : 0.f; }
                sc[mb] = a; } }
#pragma unroll
        for (int r = 0; r < 8; ++r) { const int pc = tid + 512 * r, row = pc >> 5, c16 = pc & 31; *(LAS v4u*)(Vim + row * RS_T + c16 * 16) = vv[r]; }
        __syncthreads();
#pragma unroll
        for (int sk = 0; sk < 4; ++sk) {
            if (2 * sk <= w) { const bf16x8 pf = pack_frag(sc[2 * sk], sc[2 * sk + 1]);
#pragma unroll
                for (int ng = 0; ng < 4; ++ng) { const unsigned b0 = lds_addr(Vim + (32 * sk + 4 * g + q) * RS_T + (64 * ng + 4 * pp) * 2); s16x4 t[8];
                    lds_tr8<32, 64, 96>(t, b0, b0 + 16 * RS_T);
#pragma unroll
                    for (int nn = 0; nn < 4; ++nn) acc[4 * ng + nn] = mfma16(pf, cat44(t[nn], t[4 + nn]), acc[4 * ng + nn]); } } }
        float mean[4], rstd[4];
#pragma unroll
        for (int r = 0; r < 4; ++r) { float sm = 0.f;
#pragma unroll
            for (int n = 0; n < 16; ++n) sm += acc[n][r];
            mean[r] = grp16_sum(sm, lane) * (1.0f / 256.0f); }
#pragma unroll
        for (int r = 0; r < 4; ++r) { float sq = 0.f;
#pragma unroll
            for (int n = 0; n < 16; ++n) { const float d = acc[n][r] - mean[r]; sq += d * d; }
            rstd[r] = 1.0f / sqrtf(grp16_sum(sq, lane) * (1.0f / 256.0f) + GN_EPS); }
        __syncthreads();
        { LAS unsigned char* ob = lds + w * (16 * RS_O);
#pragma unroll
          for (int n = 0; n < 16; ++n)
#pragma unroll
            for (int r = 0; r < 4; ++r) *(LAS float*)(ob + (4 * g + r) * RS_O + (16 * n + r16) * 4) = (acc[n][r] - mean[r]) * rstd[r];
          LDS_WAIT(); asm volatile("" ::: "memory");
          const int e0 = 8 * (lane & 31), hv = lane >> 5;
          const f32x4 g0 = *(const f32x4*)(gg + h * 256 + e0), g1 = *(const f32x4*)(gg + h * 256 + e0 + 4), b0 = *(const f32x4*)(gb + h * 256 + e0), b1 = *(const f32x4*)(gb + h * 256 + e0 + 4);
#pragma unroll
          for (int k = 0; k < 8; ++k) { const int rl = 2 * k + hv; const size_t row = (size_t)(nb * 128 + 16 * w + rl);
              const f32x4 y0 = *(const LAS f32x4*)(ob + rl * RS_O + e0 * 4), y1 = *(const LAS f32x4*)(ob + rl * RS_O + e0 * 4 + 16);
              const v4u gt = *(const v4u*)(Gt + row * 1024 + h * 256 + e0);
              const f32x4 o0 = y0 * g0 + b0, o1 = y1 * g1 + b1;
              v4u o; o.x = cvt2(o0[0] * bflo(gt.x), o0[1] * bfhi(gt.x)); o.y = cvt2(o0[2] * bflo(gt.y), o0[3] * bfhi(gt.y)); o.z = cvt2(o1[0] * bflo(gt.z), o1[1] * bfhi(gt.z)); o.w = cvt2(o1[2] * bflo(gt.w), o1[3] * bfhi(gt.w));
              *(v4u*)(MIX + row * 2048 + h * 256 + e0) = o; } }
    }
}
constexpr int RS_SK = 144, RS_SV = 160;
__device__ __forceinline__ void phase_swa_mfma(const Params& P, const Ctx& cx, int l, LAS unsigned char* lds) {
    unsigned char* ws = cx.ws; const int tid = cx.tid, lane = cx.lane, w = cx.wave, r16 = lane & 15, g = lane >> 4, q = r16 >> 2, pp = r16 & 3;
    const bf16* AQ = (const bf16*)(ws + WS_AQ); const bf16* AK = (const bf16*)(ws + WS_AK); const bf16* AV = (const bf16*)(ws + WS_AV); bf16* MIX = (bf16*)(ws + WS_MIX);
    LAS unsigned char* Kim = lds; LAS unsigned char* Vim = lds + 256 * RS_SK;
    for (int item = cx.bid; item < 256; item += cx.G) {
        const int nb = item >> 1, hk = item & 1, hq = hk * 8 + w; const float sink = P.in[7][l * 16 + hq];
        __syncthreads();
#pragma unroll
        for (int r = 0; r < 4; ++r) { const int pc = tid + 512 * r, row = pc >> 3, c = pc & 7, gk = nb * 128 - 128 + row;
            v4u kv = (v4u){0u, 0u, 0u, 0u}, vv = (v4u){0u, 0u, 0u, 0u};
            if (gk >= 0) { kv = *(const v4u*)(AK + (size_t)gk * 128 + hk * 64 + c * 8); vv = *(const v4u*)(AV + (size_t)gk * 128 + hk * 64 + c * 8); }
            *(LAS v4u*)(Kim + row * RS_SK + c * 16) = kv; *(LAS v4u*)(Vim + row * RS_SV + c * 16) = vv; }
        __syncthreads();
        const bf16* qbase = AQ + (size_t)(nb * 128 + r16) * 1024 + hq * 64 + 8 * g;
        bf16x8 qn0 = *(const bf16x8*)(qbase), qn1 = *(const bf16x8*)(qbase + 32);
#pragma unroll 1
        for (int nq = 0; nq < 8; ++nq) {
            const bf16x8 qf0 = qn0, qf1 = qn1;
            { const bf16* qrow = qbase + (size_t)(16 * (nq < 7 ? nq + 1 : 7)) * 1024; qn0 = *(const bf16x8*)(qrow); qn1 = *(const bf16x8*)(qrow + 32); }
            f32x4 sc[10];
            float mx = sink;
            bf16x8 kt[18];
            { const unsigned kp0 = lds_addr(Kim + (16 * nq + r16) * RS_SK + 16 * g);
              bf16x8 t[8];
              lds_rd8<64, 16 * RS_SK, 16 * RS_SK + 64, 32 * RS_SK, 32 * RS_SK + 64, 48 * RS_SK, 48 * RS_SK + 64>(t, kp0);
#pragma unroll
              for (int i = 0; i < 8; ++i) kt[i] = t[i];
              lds_rd8<64, 16 * RS_SK, 16 * RS_SK + 64, 32 * RS_SK, 32 * RS_SK + 64, 48 * RS_SK, 48 * RS_SK + 64>(t, kp0 + 64 * RS_SK);
#pragma unroll
              for (int i = 0; i < 8; ++i) kt[8 + i] = t[i];
              kt[16] = *(const LAS bf16x8*)(Kim + (16 * (nq + 8) + r16) * RS_SK + 16 * g); kt[17] = *(const LAS bf16x8*)(Kim + (16 * (nq + 8) + r16) * RS_SK + 16 * g + 64); }
#pragma unroll
            for (int kb = 0; kb < 9; ++kb) {
                f32x4 a = (f32x4){0.f, 0.f, 0.f, 0.f};
                a = mfma16(kt[2 * kb], qf0, a); a = mfma16(kt[2 * kb + 1], qf1, a);
#pragma unroll
                for (int r = 0; r < 4; ++r) { const int dl = 16 * kb + 4 * g + r - r16; const bool vis = (dl >= 1) && (dl <= 128) && (nb > 0 || 16 * (nq + kb) + 4 * g + r >= 128);
                    a[r] = vis ? a[r] : -INFINITY; mx = fmaxf(mx, a[r]); }
                sc[kb] = a; }
            sc[9] = (f32x4){0.f, 0.f, 0.f, 0.f};
            mx = fmaxf(mx, __builtin_bit_cast(float, __builtin_amdgcn_ds_bpermute((lane ^ 16) << 2, __builtin_bit_cast(int, mx))));
            mx = fmaxf(mx, __builtin_bit_cast(float, __builtin_amdgcn_ds_bpermute((lane ^ 32) << 2, __builtin_bit_cast(int, mx))));
            float sum = 0.f;
#pragma unroll
            for (int kb = 0; kb < 9; ++kb)
#pragma unroll
                for (int r = 0; r < 4; ++r) { const float pv = __expf(sc[kb][r] - mx); sc[kb][r] = pv; sum += pv; }
            sum += __builtin_bit_cast(float, __builtin_amdgcn_ds_bpermute((lane ^ 16) << 2, __builtin_bit_cast(int, sum)));
            sum += __builtin_bit_cast(float, __builtin_amdgcn_ds_bpermute((lane ^ 32) << 2, __builtin_bit_cast(int, sum)));
            const float inv = 1.0f / (sum + __expf(sink - mx));
            f32x4 o[4];
#pragma unroll
            for (int nd = 0; nd < 4; ++nd) o[nd] = (f32x4){0.f, 0.f, 0.f, 0.f};
#pragma unroll
            for (int sk = 0; sk < 5; ++sk) { const bf16x8 pf = pack_frag(sc[2 * sk] * inv, sc[2 * sk + 1] * inv);
                const int kb0 = nq + 2 * sk, kb1 = (kb0 + 1 > 15) ? 15 : kb0 + 1;
                s16x4 t[8];
                lds_tr8<32, 64, 96>(t, lds_addr(Vim + (16 * kb0 + 4 * g + q) * RS_SV + 8 * pp), lds_addr(Vim + (16 * kb1 + 4 * g + q) * RS_SV + 8 * pp));
#pragma unroll
                for (int nd = 0; nd < 4; ++nd) o[nd] = mfma16(pf, cat44(t[nd], t[4 + nd]), o[nd]); }
#pragma unroll
            for (int nd = 0; nd < 4; ++nd)
#pragma unroll
                for (int r = 0; r < 4; ++r) MIX[(size_t)(nb * 128 + 16 * nq + 4 * g + r) * 2048 + 1024 + hq * 64 + 16 * nd + r16] = (bf16)f2bf(o[nd][r]);
        }
    }
}

__device__ __forceinline__ void phase_groupnorm(const Params& P, const Ctx& cx, int l) {
    unsigned char* ws = cx.ws; const int lane = cx.lane, wave = cx.wave, G = cx.G;
    const float* RY = (const float*)(ws + WS_RETY); const bf16* Gt = (const bf16*)(ws + WS_G); bf16* MIX = (bf16*)(ws + WS_MIX);
    const float* gg = P.in[5] + l * 1024; const float* gb = P.in[6] + l * 1024;
    const int gw = cx.bid * 8 + wave, NGW = G * 8;
    for (int it = gw; it < S * 4; it += NGW) { const int row = it >> 2, h = it & 3; const size_t off = (size_t)row * 1024 + h * 256 + 4 * lane;
        f32x4 v = *(const f32x4*)(RY + off);
        const float mean = wave_sum((v[0] + v[1]) + (v[2] + v[3]), lane) * (1.0f / 256.0f);
        v = v - mean;
        const float var = wave_sum((v[0] * v[0] + v[1] * v[1]) + (v[2] * v[2] + v[3] * v[3]), lane) * (1.0f / 256.0f);
        const float rstd = 1.0f / sqrtf(var + GN_EPS);
        const f32x4 g4 = *(const f32x4*)(gg + h * 256 + 4 * lane), b4 = *(const f32x4*)(gb + h * 256 + 4 * lane);
        const v2u gt2 = *(const v2u*)(Gt + off);
        f32x4 o = v * rstd * g4 + b4;
        o[0] *= bflo(gt2.x); o[1] *= bfhi(gt2.x); o[2] *= bflo(gt2.y); o[3] *= bfhi(gt2.y);
        v2u w; w.x = pk2(o[0], o[1]); w.y = pk2(o[2], o[3]);
        *(v2u*)(MIX + (size_t)row * 2048 + h * 256 + 4 * lane) = w; }
}
__device__ __forceinline__ void phase_ln(const Ctx& cx, const float* Y, const float* g, const float* b, float* xo, bf16* xb, float* stats) {
    const int lane = cx.lane, wave = cx.wave, G = cx.G; const int gw = cx.bid * 8 + wave, NGW = G * 8;
    f32x4 g4[8], b4[8];
#pragma unroll
    for (int j = 0; j < 8; ++j) { g4[j] = ((const f32x4*)g)[64 * j + lane]; b4[j] = ((const f32x4*)b)[64 * j + lane]; }
    for (int row = gw; row < S; row += 2 * NGW) {
        const int row2 = row + NGW; const bool has2 = row2 < S; const int rb = has2 ? row2 : row;
        const f32x4* ya = (const f32x4*)(Y + (size_t)row * D) + lane; const f32x4* yb = (const f32x4*)(Y + (size_t)rb * D) + lane;
        f32x4 va[8], vb[8]; float sa = 0.f, sb = 0.f;
#pragma unroll
        for (int j = 0; j < 8; ++j) { va[j] = ya[64 * j]; vb[j] = yb[64 * j]; }
#pragma unroll
        for (int j = 0; j < 8; ++j) { sa += (va[j][0] + va[j][1]) + (va[j][2] + va[j][3]); sb += (vb[j][0] + vb[j][1]) + (vb[j][2] + vb[j][3]); }
        const float ma = wave_sum(sa, lane) * (1.0f / D), mb = wave_sum(sb, lane) * (1.0f / D); float qa = 0.f, qb = 0.f;
#pragma unroll
        for (int j = 0; j < 8; ++j) { va[j] = va[j] - ma; vb[j] = vb[j] - mb; qa += (va[j][0] * va[j][0] + va[j][1] * va[j][1]) + (va[j][2] * va[j][2] + va[j][3] * va[j][3]); qb += (vb[j][0] * vb[j][0] + vb[j][1] * vb[j][1]) + (vb[j][2] * vb[j][2] + vb[j][3] * vb[j][3]); }
        const float ra = 1.0f / sqrtf(wave_sum(qa, lane) * (1.0f / D) + LN_EPS), rbb = 1.0f / sqrtf(wave_sum(qb, lane) * (1.0f / D) + LN_EPS);
        f32x4* xa = (f32x4*)(xo + (size_t)row * D) + lane; f32x4* xbp = (f32x4*)(xo + (size_t)rb * D) + lane;
        if (stats && lane == 0) { stats[2 * (size_t)row] = ma; stats[2 * (size_t)row + 1] = ra; if (has2) { stats[2 * (size_t)rb] = mb; stats[2 * (size_t)rb + 1] = rbb; } }
#pragma unroll
        for (int j = 0; j < 8; ++j) { const f32x4 o = va[j] * ra * g4[j] + b4[j]; if (xo) xa[64 * j] = o;
            if (xb) { v2u w; w.x = pk2(o[0], o[1]); w.y = pk2(o[2], o[3]); ((v2u*)(xb + (size_t)row * D))[64 * j + lane] = w; } }
        if (has2) {
#pragma unroll
            for (int j = 0; j < 8; ++j) { const f32x4 o = vb[j] * rbb * g4[j] + b4[j]; if (xo) xbp[64 * j] = o;
                if (xb) { v2u w; w.x = pk2(o[0], o[1]); w.y = pk2(o[2], o[3]); ((v2u*)(xb + (size_t)rb * D))[64 * j + lane] = w; } } }
    }
}
__device__ __forceinline__ void unpack8(const v4u h, float (&o)[8]) { o[0] = bflo(h.x); o[1] = bfhi(h.x); o[2] = bflo(h.y); o[3] = bfhi(h.y); o[4] = bflo(h.z); o[5] = bfhi(h.z); o[6] = bflo(h.w); o[7] = bfhi(h.w); }
__device__ __forceinline__ void phase_convact(const Params& P, const Ctx& cx, int l) {
    unsigned char* ws = cx.ws; const int tid = cx.tid, G = cx.G;
    const bf16* H = (const bf16*)(ws + WS_H); bf16* ACT = (bf16*)(ws + WS_ACT);
    const float* cw = P.in[11] + (size_t)l * 3 * NUP; const float* cb = P.in[12] + (size_t)l * NUP;
    const int gt = cx.bid * 512 + tid, NT = G * 512;
    for (int item = gt; item < 512 * 704; item += NT) {
        const int seg = item / 704, r = item - seg * 704, tile = r >> 4, q8 = r & 15, t0 = seg * 32;
        const int chg = 128 * tile + 8 * q8, chu = DFF + chg;
        float wg[3][8], wu[3][8], bg[8], bu[8];
#pragma unroll
        for (int k = 0; k < 3; ++k) { const f32x4 a0 = *(const f32x4*)(cw + (size_t)k * NUP + chg), a1 = *(const f32x4*)(cw + (size_t)k * NUP + chg + 4), c0 = *(const f32x4*)(cw + (size_t)k * NUP + chu), c1 = *(const f32x4*)(cw + (size_t)k * NUP + chu + 4);
#pragma unroll
            for (int e = 0; e < 4; ++e) { wg[k][e] = a0[e]; wg[k][4 + e] = a1[e]; wu[k][e] = c0[e]; wu[k][4 + e] = c1[e]; } }
        { const f32x4 a0 = *(const f32x4*)(cb + chg), a1 = *(const f32x4*)(cb + chg + 4), c0 = *(const f32x4*)(cb + chu), c1 = *(const f32x4*)(cb + chu + 4);
#pragma unroll
          for (int e = 0; e < 4; ++e) { bg[e] = a0[e]; bg[4 + e] = a1[e]; bu[e] = c0[e]; bu[4 + e] = c1[e]; } }
        const bf16* hp = H + (size_t)t0 * NUP + 256 * tile + 8 * q8;
        float g2[8], g1[8], u2[8], u1[8];
        if (t0 > 0) { unpack8(*(const v4u*)(hp - 2 * (size_t)NUP), g2); unpack8(*(const v4u*)(hp - (size_t)NUP), g1); unpack8(*(const v4u*)(hp - 2 * (size_t)NUP + 128), u2); unpack8(*(const v4u*)(hp - (size_t)NUP + 128), u1); }
        else {
#pragma unroll
            for (int e = 0; e < 8; ++e) { g2[e] = 0.f; g1[e] = 0.f; u2[e] = 0.f; u1[e] = 0.f; } }
        bf16* ap = ACT + (size_t)t0 * DFF + chg;
        v4u ng = *(const v4u*)(hp), nu = *(const v4u*)(hp + 128);
#pragma unroll 2
        for (int tt = 0; tt < 32; ++tt) {
            float g0[8], u0[8]; unpack8(ng, g0); unpack8(nu, u0);
            if (tt < 31) { ng = *(const v4u*)(hp + (size_t)(tt + 1) * NUP); nu = *(const v4u*)(hp + (size_t)(tt + 1) * NUP + 128); }
            float o[8];
#pragma unroll
            for (int e = 0; e < 8; ++e) { const float ga = bg[e] + wg[0][e] * g2[e] + wg[1][e] * g1[e] + wg[2][e] * g0[e], ua = bu[e] + wu[0][e] * u2[e] + wu[1][e] * u1[e] + wu[2][e] * u0[e];
                o[e] = ga * __builtin_amdgcn_rcpf(1.0f + __expf(-ga)) * ua; g2[e] = g1[e]; g1[e] = g0[e]; u2[e] = u1[e]; u1[e] = u0[e]; }
            v4u w; w.x = cvt2(o[0], o[1]); w.y = cvt2(o[2], o[3]); w.z = cvt2(o[4], o[5]); w.w = cvt2(o[6], o[7]);
            *(v4u*)(ap + (size_t)tt * DFF) = w;
        }
    }
}

__device__ __forceinline__ void phase_conv_fixup(const Params& P, const Ctx& cx, int l) {
    unsigned char* ws = cx.ws;
    const bf16* HALO = (const bf16*)(ws + WS_H); bf16* ACT = (bf16*)(ws + WS_ACT);
    const float* cw = P.in[11] + (size_t)l * 3 * NUP; const float* cb = P.in[12] + (size_t)l * NUP;
    const int gt = cx.bid * 512 + cx.tid, NT = cx.G * 512;
    for (int item = gt; item < 256 * 704; item += NT) {
        const int k = item / 704, r = item - k * 704, tile = r >> 4, q8 = r & 15, chg = 128 * tile + 8 * q8, chu = DFF + chg;
        float a_g[8], b_g[8], c_g[8], d_g[8], a_u[8], b_u[8], c_u[8], d_u[8];
        const bf16* hk = HALO + (size_t)k * 4 * NUP + 256 * tile + 8 * q8;
        unpack8(*(const v4u*)(hk), c_g); unpack8(*(const v4u*)(hk + NUP), d_g); unpack8(*(const v4u*)(hk + 128), c_u); unpack8(*(const v4u*)(hk + NUP + 128), d_u);
        if (k > 0) { const bf16* hm = hk - 4 * (size_t)NUP; unpack8(*(const v4u*)(hm + 2 * NUP), a_g); unpack8(*(const v4u*)(hm + 3 * NUP), b_g); unpack8(*(const v4u*)(hm + 2 * NUP + 128), a_u); unpack8(*(const v4u*)(hm + 3 * NUP + 128), b_u); }
        else {
#pragma unroll
            for (int e = 0; e < 8; ++e) { a_g[e] = 0.f; b_g[e] = 0.f; a_u[e] = 0.f; b_u[e] = 0.f; } }
        float o0[8], o1[8];
#pragma unroll
        for (int e = 0; e < 8; ++e) { const float w0g = cw[chg + e], w1g = cw[NUP + chg + e], w2g = cw[2 * NUP + chg + e], bgv = cb[chg + e], w0u = cw[chu + e], w1u = cw[NUP + chu + e], w2u = cw[2 * NUP + chu + e], buv = cb[chu + e];
            const float g0 = bgv + w0g * a_g[e] + w1g * b_g[e] + w2g * c_g[e], u0 = buv + w0u * a_u[e] + w1u * b_u[e] + w2u * c_u[e];
            const float g1 = bgv + w0g * b_g[e] + w1g * c_g[e] + w2g * d_g[e], u1 = buv + w0u * b_u[e] + w1u * c_u[e] + w2u * d_u[e];
            o0[e] = g0 * __builtin_amdgcn_rcpf(1.0f + __expf(-g0)) * u0; o1[e] = g1 * __builtin_amdgcn_rcpf(1.0f + __expf(-g1)) * u1; }
        v4u w0, w1; w0.x = cvt2(o0[0], o0[1]); w0.y = cvt2(o0[2], o0[3]); w0.z = cvt2(o0[4], o0[5]); w0.w = cvt2(o0[6], o0[7]); w1.x = cvt2(o1[0], o1[1]); w1.y = cvt2(o1[2], o1[3]); w1.z = cvt2(o1[4], o1[5]); w1.w = cvt2(o1[6], o1[7]);
        *(v4u*)(ACT + pg8::tiled_off(64 * k, chg, DFF)) = w0; *(v4u*)(ACT + pg8::tiled_off(64 * k + 1, chg, DFF)) = w1;
    }
}

#ifdef DBG_DUMP
__device__ __forceinline__ void phase_dump(const Ctx& cx, float* out, const bf16* a, int lda, const bf16* b, int ldb, const float* f) {
    const size_t gt = (size_t)cx.bid * 512 + cx.tid, NT = (size_t)cx.G * 512;
    for (size_t i = gt; i < (size_t)S * D; i += NT) { const int row = (int)(i >> 11), col = (int)(i & 2047);
        float v; if (f) v = f[i]; else if (b && col >= 1024) v = bf1(b + (size_t)row * ldb + (col - 1024)); else v = lda ? bf1(a + (size_t)row * lda + col) : bf1(a + (size_t)(row & 2047) * 2048 + col);
        out[i] = v; }
}
#endif
__device__ __forceinline__ void finalize_panel_stats(const Ctx& cx, const float* pstat, float* st, int pm) {
    const int tid = cx.tid, lane = cx.lane, row = pm * 256 + (tid >> 1), hf = tid & 1;
    const f32x4* pp = (const f32x4*)(pstat + ((size_t)row * 32 + 16 * hf) * 2);
    float s1 = 0.f, s2 = 0.f;
#pragma unroll
    for (int k = 0; k < 8; ++k) { const f32x4 v = pp[k]; s1 += v[0] + v[2]; s2 += v[1] + v[3]; }
    s1 += __builtin_bit_cast(float, __builtin_amdgcn_ds_bpermute((lane ^ 1) << 2, __builtin_bit_cast(int, s1)));
    s2 += __builtin_bit_cast(float, __builtin_amdgcn_ds_bpermute((lane ^ 1) << 2, __builtin_bit_cast(int, s2)));
    const float mean = s1 * (1.0f / D), var = fmaxf(s2 * (1.0f / D) - mean * mean, 0.f), rstd = 1.0f / sqrtf(var + LN_EPS);
    if (!hf) *(pg8::f32x2*)(st + 2 * (size_t)row) = (pg8::f32x2){mean, rstd};
}
template <class Sched> __device__ __forceinline__ void finalize_stats_for(const Ctx& cx, const Sched& So, const float* pstat, float* st) {
    int last = -1; pg8::Unit u;
    for (int i = 0; So.next(i, u); ++i) if (u.pm != last) { finalize_panel_stats(cx, pstat, st, u.pm); last = u.pm; }
    asm volatile("s_waitcnt vmcnt(0)" ::: "memory"); __syncthreads();
}
__global__ void __launch_bounds__(512, 2) fwd(Params P) {
    extern __shared__ __attribute__((aligned(16))) unsigned char lds_raw[];
    LAS unsigned char* lds = (LAS unsigned char*)lds_raw;
    const int wave = __builtin_amdgcn_readfirstlane(threadIdx.x >> 6), G = gridDim.x;
    unsigned char* ws = P.ws;
    volatile LAS unsigned* MISC = (volatile LAS unsigned*)(lds + MISC_OFF);
    for (int u = threadIdx.x; u < (LDS_BYTES - LDSCTL_OFF) / 4; u += 512) ((LAS unsigned*)(lds + LDSCTL_OFF))[u] = 0u;
    __syncthreads();
    const int lo = P.ph_lo, hi = P.ph_hi;
    XcdBarrier bar; bar.bar = (unsigned*)(ws + WS_CTL) + CW_BAR; bar.x = 0; bar.st = nullptr;
    if (hi - lo > 1) bar = xcd_barrier_post((unsigned*)(ws + WS_CTL) + CW_BAR, MISC + 8);
#define IN(k) (lo <= (k) && (k) < hi)
#if PROBE_DUP == 20
#define SEAM(k) do { if (IN(k) && IN((k) + 1)) { xcd_barrier(bar); xcd_barrier(bar); } } while (0)
#else
#define SEAM(k) do { if (IN(k) && IN((k) + 1)) xcd_barrier(bar); } while (0)
#endif
#define OPQ() Ctx cx; cx.lane = lane_id_asm(); { int t_ = wave; asm volatile("" : "+s"(t_)); cx.wave = t_; } { int t_ = G; asm volatile("" : "+s"(t_)); cx.G = t_; } { int t_ = blockIdx.x; asm volatile("" : "+s"(t_)); cx.bid = t_; } \
    { unsigned t_ = 0u; asm volatile("" : "+s"(t_)); cx.ws = P.ws + t_; } cx.tid = cx.wave * 64 + cx.lane; int lq = l; asm volatile("" : "+s"(lq)); (void)lq

#ifdef DBG_DUMP
    if (lo >= 1000) { const int l = 0; OPQ(); unsigned char* w = cx.ws; const int kind = lo - 1000;
        if (kind == 1) phase_dump(cx, P.out, (const bf16*)(w + WS_Q), 1024, (const bf16*)(w + WS_AQ), 1024, nullptr);
        else if (kind == 2) phase_dump(cx, P.out, (const bf16*)(w + WS_MIX), 2048, nullptr, 0, nullptr);
        else if (kind == 3) phase_dump(cx, P.out, nullptr, 0, nullptr, 0, (const float*)(w + WS_XR));
        else if (kind == 4) phase_dump(cx, P.out, (const bf16*)(w + WS_ACT), DFF, nullptr, 0, nullptr);
        else if (kind == 5) phase_dump(cx, P.out, nullptr, 0, nullptr, 0, (const float*)(w + WS_Y));
        else if (kind == 6) phase_dump(cx, P.out, (const bf16*)(w + WS_K), 1024, (const bf16*)(w + WS_V), 1024, nullptr);
        else if (kind == 7) phase_dump(cx, P.out, (const bf16*)(w + WS_XB), 2048, nullptr, 0, nullptr);
        else if (kind == 11) phase_dump(cx, P.out, (const bf16*)(w + WS_W + WL_G), 0, nullptr, 0, nullptr);
        else if (kind == 12) phase_dump(cx, P.out, (const bf16*)(w + WS_W + WL_OUT), 0, nullptr, 0, nullptr);
        else if (kind == 10) phase_dump(cx, P.out, (const bf16*)(w + WS_H) + 36 * 256, NUP, nullptr, 0, nullptr);
        else if (kind == 9) phase_dump(cx, P.out, (const bf16*)(w + WS_SG), 2048, nullptr, 0, nullptr);
        else if (kind == 8) phase_dump(cx, P.out, nullptr, 0, nullptr, 0, (const float*)(w + WS_RETY));
        return; }
#endif
    if (IN(0)) { const int l = 0; REPS(9) { __syncthreads(); OPQ(); phase_prologue(P, cx, lds); } }
    SEAM(0);

    for (int l = 0; l < DEPTH; ++l) {
        const int pb = 1 + l * NPH;
#if LN_FUSED
        if (l == 0 && IN(pb + 0)) { OPQ(); const float* cp = (const float*)(cx.ws + WS_CP); float* cc = (float*)(cx.ws + WS_C);
            for (int i = cx.bid * 512 + cx.tid; i < DEPTH * C_L; i += cx.G * 512) { float a = 0.f;
                if (i >= 2 * INW) {
#pragma unroll
                    for (int kc = 0; kc < 8; ++kc) a += cp[(size_t)kc * DEPTH * C_L + i]; }
                cc[i] = a; } }
#endif
        if (IN(pb + 0)) { REPS(3) { OPQ(); unsigned char* w = cx.ws; const bf16* wl = (const bf16*)(w + WS_W + (size_t)lq * WL_BYTES);
            pg8::Gemm g{(const bf16*)(w + WS_XB), wl + WL_IN / 2, S, INW, D}; pg8::StaticOrder So; So.init(S, INW, cx.G, cx.bid);
#if LN_FUSED
            if (lq > 0) { const float* cl = (const float*)(w + WS_C) + (size_t)lq * C_L;
                finalize_stats_for(cx, So, (const float*)(w + WS_PSTAT), (float*)(w + WS_ST2));
                pg8::EpiInProjT<true> E{(bf16*)(w + WS_Q), (bf16*)(w + WS_K), (bf16*)(w + WS_V), (bf16*)(w + WS_G), (bf16*)(w + WS_AQ), (bf16*)(w + WS_AK), (bf16*)(w + WS_AV),
                                        (const float*)(w + WS_COSR), (const float*)(w + WS_SINR), (const float*)(w + WS_COSA), (const float*)(w + WS_SINA), (const float*)(w + WS_ST2), cl + C1IN, cl + C2IN};
                pg8::gemm_phase<pg8::EpiInProjT<true>, pg8::StaticOrder, true, true>(lds, g, So, E, cx.wave); }
            else
#endif
            { pg8::EpiInProj E{(bf16*)(w + WS_Q), (bf16*)(w + WS_K), (bf16*)(w + WS_V), (bf16*)(w + WS_G), (bf16*)(w + WS_AQ), (bf16*)(w + WS_AK), (bf16*)(w + WS_AV),
                             (const float*)(w + WS_COSR), (const float*)(w + WS_SINR), (const float*)(w + WS_COSA), (const float*)(w + WS_SINA), nullptr, nullptr, nullptr};
              pg8::gemm_phase<pg8::EpiInProj, pg8::StaticOrder, true, true>(lds, g, So, E, cx.wave); }
        } }
#if PLE_EARLY
        if (IN(pb + 0)) { OPQ(); unsigned char* w = cx.ws; const bf16* wl = (const bf16*)(w + WS_W + (size_t)lq * WL_BYTES);
            const int nsub = (cx.G > 64) ? cx.G - 64 : cx.G, csub = (cx.G > 64) ? cx.bid - 64 : cx.bid;
            if (csub >= 0) {
                int kple = PLE; asm volatile("" : "+s"(kple));
                pg8::Gemm g{(const bf16*)(w + WS_PB) + (size_t)lq * S * PLE, wl + WL_P / 2, S, D, kple}; pg8::StaticOrder So; So.init(S, D, nsub, csub);
                pg8::EpiPlain E{(bf16*)(w + WS_PP)};
                pg8::gemm_phase<pg8::EpiPlain, pg8::StaticOrder, true, true>(lds, g, So, E, cx.wave); }
        }
#endif
        SEAM(pb + 0);
        if (IN(pb + 1)) {
#if RET_MFMA
            { REPS(6) { OPQ(); phase_ret_u_mfma(P, cx, lds); } }
#else
            { OPQ(); phase_ret_u_scores(P, cx, lds); }
#endif
#if SWA_MFMA
            { REPS(8) { OPQ(); phase_swa_mfma(P, cx, lq, lds); } }
#else
            { OPQ(); phase_swa(P, cx, lq, lds); }
#endif
        }
        SEAM(pb + 1);
#if RET_MFMA
        if (IN(pb + 2)) { OPQ(); phase_scan_bf16(P, cx); }
        SEAM(pb + 2);
        if (IN(pb + 3)) { REPS(7) { OPQ(); phase_ret_out_mfma(P, cx, lq, lds); } }
        SEAM(pb + 3);
#else
        if (IN(pb + 2)) { OPQ(); phase_scan(P, cx); }
        SEAM(pb + 2);
        if (IN(pb + 3)) { OPQ(); phase_ret_out(P, cx, lds); }
        SEAM(pb + 3);
        if (IN(pb + 4)) { OPQ(); phase_groupnorm(P, cx, lq); }
        SEAM(pb + 4);
#endif
        if (IN(pb + 5)) { OPQ(); unsigned char* w = cx.ws; const bf16* wl = (const bf16*)(w + WS_W + (size_t)lq * WL_BYTES);
            pg8::Gemm g{(const bf16*)(w + WS_MIX), wl + WL_OUT / 2, S, D, D}; pg8::StaticOrder So; So.init(S, D, cx.G, cx.bid);
#if LN_FUSED
#if RES_BF16
            if (lq == 0) { pg8::EpiRes3<false, false> E{P.in[0], nullptr, (bf16*)(w + WS_XB), (_Float16*)(w + WS_YH), (float*)(w + WS_PSTAT), nullptr, nullptr, nullptr, nullptr, nullptr, ALPHA};
                pg8::gemm_phase<pg8::EpiRes3<false, false>, pg8::StaticOrder, true, true>(lds, g, So, E, cx.wave); }
            else { pg8::EpiRes3<true, false> E{nullptr, nullptr, (bf16*)(w + WS_XB), (_Float16*)(w + WS_YH), (float*)(w + WS_PSTAT), (const float*)(w + WS_ST2), P.in[14] + (lq - 1) * D, P.in[15] + (lq - 1) * D, nullptr, nullptr, ALPHA};
                pg8::gemm_phase<pg8::EpiRes3<true, false>, pg8::StaticOrder, true, true>(lds, g, So, E, cx.wave); }
#else
            if (lq == 0) { pg8::EpiRes2<false, false, true> E{P.in[0], (float*)(w + WS_Y), (bf16*)(w + WS_XB), (float*)(w + WS_PSTAT), nullptr, nullptr, nullptr, nullptr, nullptr, ALPHA};
                pg8::gemm_phase<pg8::EpiRes2<false, false, true>, pg8::StaticOrder, true, true>(lds, g, So, E, cx.wave); }
            else { pg8::EpiRes2<true, false, true> E{nullptr, (float*)(w + WS_Y), (bf16*)(w + WS_XB), (float*)(w + WS_PSTAT), (const float*)(w + WS_ST2), P.in[14] + (lq - 1) * D, P.in[15] + (lq - 1) * D, nullptr, nullptr, ALPHA};
                pg8::gemm_phase<pg8::EpiRes2<true, false, true>, pg8::StaticOrder, true, true>(lds, g, So, E, cx.wave); }
#endif
#elif LN_NOXR
            if (lq == 0) { pg8::EpiResid<false> E{P.in[0], (float*)(w + WS_Y), ALPHA};
                pg8::gemm_phase<pg8::EpiResid<false>, pg8::StaticOrder, true, true>(lds, g, So, E, cx.wave); }
            else {
#if PROBE_DUP == 30
                { pg8::EpiResidLN<false> E{(float*)(w + WS_Y), (float*)(w + WS_XR + 2 * MiB), (const float*)(w + WS_ST2), P.in[14] + (lq - 1) * D, P.in[15] + (lq - 1) * D, nullptr, nullptr, ALPHA};
                  pg8::gemm_phase<pg8::EpiResidLN<false>, pg8::StaticOrder, true, true>(lds, g, So, E, cx.wave); }
#endif
                pg8::EpiResidLN<false> E{(float*)(w + WS_Y), (float*)(w + WS_Y), (const float*)(w + WS_ST2), P.in[14] + (lq - 1) * D, P.in[15] + (lq - 1) * D, nullptr, nullptr, ALPHA};
                pg8::gemm_phase<pg8::EpiResidLN<false>, pg8::StaticOrder, true, true>(lds, g, So, E, cx.wave); }
#else
            pg8::EpiResid<false> E{(lq == 0) ? P.in[0] : (const float*)(w + WS_XR), (float*)(w + WS_Y), ALPHA};
            pg8::gemm_phase<pg8::EpiResid<false>, pg8::StaticOrder, true, true>(lds, g, So, E, cx.wave);
#endif
        }
        SEAM(pb + 5);
#if !LN_FUSED
        if (IN(pb + 6)) { REPS(1) { OPQ(); unsigned char* w = cx.ws;
#if LN_NOXR
            phase_ln(cx, (const float*)(w + WS_Y), P.in[8] + lq * D, P.in[9] + lq * D, (float*)nullptr, (bf16*)(w + WS_XB), (float*)(w + WS_ST1));
#else
            phase_ln(cx, (const float*)(w + WS_Y), P.in[8] + lq * D, P.in[9] + lq * D, (float*)(w + WS_XR), (bf16*)(w + WS_XB), (float*)nullptr);
#endif
        } }
        SEAM(pb + 6);
#endif
        if (IN(pb + 7)) { REPS(5) { OPQ(); unsigned char* w = cx.ws; const bf16* wl = (const bf16*)(w + WS_W + (size_t)lq * WL_BYTES);
            pg8::Gemm g{(const bf16*)(w + WS_XB), wl + WL_UP / 2, S, NUPG, D}; pg8::StaticOrder So; So.init(S, NUPG, cx.G, cx.bid);
#if LN_FUSED
            { const float* cl = (const float*)(w + WS_C) + (size_t)lq * C_L;
              finalize_stats_for(cx, So, (const float*)(w + WS_PSTAT), (float*)(w + WS_ST1));
              pg8::EpiUpConvT<true> E{(bf16*)(w + WS_ACT), (bf16*)(w + WS_H), (bf16*)(w + WS_SG), P.in[17] + lq * D, P.in[11] + (size_t)lq * 3 * NUP, P.in[12] + (size_t)lq * NUP, (const float*)(w + WS_ST1), cl + C1UP, cl + C2UP};
              pg8::gemm_phase<pg8::EpiUpConvT<true>, pg8::StaticOrder, true, true>(lds, g, So, E, cx.wave); }
#elif CONV_FUSED
            pg8::EpiUpConv E{(bf16*)(w + WS_ACT), (bf16*)(w + WS_H), (bf16*)(w + WS_SG), P.in[17] + lq * D, P.in[11] + (size_t)lq * 3 * NUP, P.in[12] + (size_t)lq * NUP, nullptr, nullptr, nullptr};
            pg8::gemm_phase<pg8::EpiUpConv, pg8::StaticOrder, true, true>(lds, g, So, E, cx.wave);
#else
            pg8::EpiUp E{(bf16*)(w + WS_H), (bf16*)(w + WS_SG), P.in[17] + lq * D};
            pg8::gemm_phase<pg8::EpiUp, pg8::StaticOrder, true, true>(lds, g, So, E, cx.wave);
#endif
        } }
        SEAM(pb + 7);
        if (IN(pb + 8)) {
#if !PLE_EARLY
            { OPQ(); unsigned char* w = cx.ws; const bf16* wl = (const bf16*)(w + WS_W + (size_t)lq * WL_BYTES);
              pg8::Gemm g{(const bf16*)(w + WS_PB) + (size_t)lq * S * PLE, wl + WL_P / 2, S, D, PLE}; pg8::StaticOrder So; So.init(S, D, cx.G, cx.bid);
              pg8::EpiPle E{(const bf16*)(w + WS_SG), (float*)(w + WS_Y)};
              pg8::gemm_phase<pg8::EpiPle, pg8::StaticOrder, true, true>(lds, g, So, E, cx.wave); }
#endif
#if CONV_FUSED
            { OPQ(); phase_conv_fixup(P, cx, lq); }
#else
            { REPS(1) { OPQ(); phase_convact(P, cx, lq); } }
#endif
        }
        SEAM(pb + 8);
        if (IN(pb + 9)) { OPQ(); unsigned char* w = cx.ws; const bf16* wl = (const bf16*)(w + WS_W + (size_t)lq * WL_BYTES);
            pg8::Gemm g{(const bf16*)(w + WS_ACT), wl + WL_DOWN / 2, S, D, DFF, 0, 0, 1, 1}; pg8::StaticOrder So; So.init(S, D, cx.G, cx.bid);
#if LN_FUSED
#if RES_BF16
            pg8::EpiRes3<true, true> E{nullptr, (lq == DEPTH - 1) ? (float*)(w + WS_Y) : (float*)nullptr, (bf16*)(w + WS_XB), (_Float16*)(w + WS_YH), (float*)(w + WS_PSTAT), (const float*)(w + WS_ST1), P.in[8] + lq * D, P.in[9] + lq * D, (const bf16*)(w + WS_PP), (const bf16*)(w + WS_SG), ALPHA};
            pg8::gemm_phase<pg8::EpiRes3<true, true>, pg8::StaticOrder, true, true>(lds, g, So, E, cx.wave);
#else
            pg8::EpiRes2<true, true, true> E{nullptr, (float*)(w + WS_Y), (bf16*)(w + WS_XB), (float*)(w + WS_PSTAT), (const float*)(w + WS_ST1), P.in[8] + lq * D, P.in[9] + lq * D, (const bf16*)(w + WS_PP), (const bf16*)(w + WS_SG), ALPHA};
            pg8::gemm_phase<pg8::EpiRes2<true, true, true>, pg8::StaticOrder, true, true>(lds, g, So, E, cx.wave);
#endif
#elif PLE_EARLY
#if LN_NOXR
#if PROBE_DUP == 31
            { pg8::EpiResidLN<true> E{(float*)(w + WS_Y), (float*)(w + WS_XR + 2 * MiB), (const float*)(w + WS_ST1), P.in[8] + lq * D, P.in[9] + lq * D, (const bf16*)(w + WS_PP), (const bf16*)(w + WS_SG), ALPHA};
              pg8::gemm_phase<pg8::EpiResidLN<true>, pg8::StaticOrder, true, true>(lds, g, So, E, cx.wave); }
#endif
            pg8::EpiResidLN<true> E{(float*)(w + WS_Y), (float*)(w + WS_Y), (const float*)(w + WS_ST1), P.in[8] + lq * D, P.in[9] + lq * D, (const bf16*)(w + WS_PP), (const bf16*)(w + WS_SG), ALPHA};
            pg8::gemm_phase<pg8::EpiResidLN<true>, pg8::StaticOrder, true, true>(lds, g, So, E, cx.wave);
#else
            pg8::EpiDown E{(const float*)(w + WS_XR), (float*)(w + WS_Y), (const bf16*)(w + WS_PP), (const bf16*)(w + WS_SG), ALPHA};
            pg8::gemm_phase<pg8::EpiDown, pg8::StaticOrder, true, true>(lds, g, So, E, cx.wave);
#endif
#else
            pg8::EpiResid<true> E{(const float*)(w + WS_XR), (float*)(w + WS_Y), ALPHA};
            pg8::gemm_phase<pg8::EpiResid<true>, pg8::StaticOrder, true, true>(lds, g, So, E, cx.wave);
#endif
        }
#if LN_FUSED
        if (l == DEPTH - 1) { SEAM(pb + 9); { OPQ(); unsigned char* w = cx.ws; phase_ln(cx, (const float*)(w + WS_Y), P.in[14] + lq * D, P.in[15] + lq * D, P.out, (bf16*)nullptr, (float*)nullptr); } }
        else SEAM(pb + 9);
#else
        SEAM(pb + 9);
        if (IN(pb + 10)) { REPS(1) { OPQ(); unsigned char* w = cx.ws; const bool last = (lq == DEPTH - 1);

#if LN_NOXR
            phase_ln(cx, (const float*)(w + WS_Y), P.in[14] + lq * D, P.in[15] + lq * D, last ? P.out : (float*)nullptr, last ? (bf16*)nullptr : (bf16*)(w + WS_XB), last ? (float*)nullptr : (float*)(w + WS_ST2));
#else
            phase_ln(cx, (const float*)(w + WS_Y), P.in[14] + lq * D, P.in[15] + lq * D, last ? P.out : (float*)(w + WS_XR), last ? (bf16*)nullptr : (bf16*)(w + WS_XB), (float*)nullptr);
#endif
        } }
        SEAM(pb + 10);
#endif
    }
#undef IN
#undef SEAM
}

extern "C" void kernel_launch(void* const* d_in, const int* in_sizes, int n_in, void* d_out, int out_size, void* d_ws, size_t ws_size, hipStream_t stream) {
    static int grid = 0;
    if (grid == 0) {
        if (n_in != 19 || in_sizes[0] != S * D || out_size != S * D || ws_size < WS_END) { fprintf(stderr, "kernel_launch: unexpected shapes (n_in %d, in0 %d, out %d, ws %zu)\n", n_in, n_in > 0 ? in_sizes[0] : -1, out_size, ws_size); grid = -1; return; }
        int dev = 0, cus = 0, per_cu = 0;
        if (hipGetDevice(&dev) != hipSuccess || hipDeviceGetAttribute(&cus, hipDeviceAttributeMultiprocessorCount, dev) != hipSuccess) { grid = -1; return; }
        if (hipFuncSetAttribute((const void*)fwd, hipFuncAttributeMaxDynamicSharedMemorySize, LDS_BYTES) != hipSuccess) { fprintf(stderr, "kernel_launch: hipFuncSetAttribute failed\n"); grid = -1; return; }
        if (hipOccupancyMaxActiveBlocksPerMultiprocessor(&per_cu, (const void*)fwd, 512, LDS_BYTES) != hipSuccess || per_cu < 1) fprintf(stderr, "kernel_launch: occupancy query says %d\n", per_cu);
        (void)hipGetLastError();
        grid = cus;
    }
    if (grid < 0) return;
    (void)hipMemsetAsync((char*)d_ws + WS_CTL, 0, CTL_ZERO_BYTES, stream);
#ifdef DBG_NANFILL
    (void)hipMemsetAsync((char*)d_ws + CTL_ZERO_BYTES, 0xFF, WS_END - CTL_ZERO_BYTES, stream);
#endif
    Params p{};
    for (int i = 0; i < 19; ++i) p.in[i] = (const float*)d_in[i];
    p.out = (float*)d_out; p.ws = (unsigned char*)d_ws;
    for (int f = 0; f < 128; ++f) p.invf_ret[f] = (float)(1.0 / std::pow(10000.0, (double)((float)f / 127.0f)));
    for (int f = 0; f < 32; ++f) p.invf_att[f] = (float)std::pow(10000.0, -(double)(2 * f) / 64.0);
    for (int h = 0; h < 4; ++h) p.lg2g[h] = (float)std::log2(1.0 - std::exp2(-5.0 - h));
#if MK_ONE_LAUNCH
    p.ph_lo = 0; p.ph_hi = NPHASES;
    hipLaunchKernelGGL(fwd, dim3(grid), dim3(512), LDS_BYTES, stream, p);
#else
#ifdef DBG_DUMP
    for (int ph = 0; ph <= DBG_STOP; ++ph) { p.ph_lo = ph; p.ph_hi = ph + 1; hipLaunchKernelGGL(fwd, dim3(grid), dim3(512), LDS_BYTES, stream, p); }
    p.ph_lo = 1000 + DBG_DUMP; p.ph_hi = p.ph_lo + 1; hipLaunchKernelGGL(fwd, dim3(grid), dim3(512), LDS_BYTES, stream, p);
#else
    for (int ph = 0; ph < NPHASES; ++ph) { p.ph_lo = ph; p.ph_hi = ph + 1; hipLaunchKernelGGL(fwd, dim3(grid), dim3(512), LDS_BYTES, stream, p); }
#endif
#endif
}
```

```cpp
#include <hip/hip_runtime.h>
#include <cstdio>
#include <cstdint>
#include <cmath>

#define MK_ONE_LAUNCH 1
#define EPI_PD 3
#define GB_LDS 1
namespace pg8 {
#define PG8_LAS __attribute__((address_space(3)))
typedef unsigned short bf16_t;
typedef short bf16x8 __attribute__((ext_vector_type(8)));
typedef float f32x4 __attribute__((ext_vector_type(4)));
typedef unsigned u32x4 __attribute__((ext_vector_type(4)));
constexpr int BM = 256, BK = 64, HALF = 128, HTB = HALF * BK * 2  , STAGE_BYTES = 8 * HTB, NXCD = 8, WGM = 8;

__host__ __device__ __forceinline__ int lds_byte(int r, int c) { const int st = (r >> 4) * 2 + (c >> 5), rr = r & 15, cc = c & 31, ob = rr * 64 + cc * 2; return st * 1024 + (ob ^ (((ob >> 9) & 1) << 5)); }
__host__ __device__ __forceinline__ void stage_rc(int b, int& R, int& C) { const int st = b / 1024, sb = b % 1024, swz = sb ^ (((sb >> 9) & 1) << 5); R = (st >> 1) * 16 + swz / 64; C = (st & 1) * 32 + (swz % 64) / 2; }
__host__ __device__ __forceinline__ int perm32(int rho) { const int n = rho >> 4, i = rho & 15; return 8 * (i >> 2) + 4 * n + (i & 3); }

#ifndef FAST_NEXT
#define FAST_NEXT 1
#endif
#ifndef KREV
#define KREV 0
#endif
struct Unit { int pm, pn; };
struct Gemm { const bf16_t* A; const bf16_t* Bt; int M, N, K; int lda, ldb; int tiledA, tiledB; };

struct StaticOrder {
    int nM, nN, nwg, G, c;
    __host__ __device__ void init(int M, int N, int G_, int c_) { nM = M / BM; nN = N / BM; nwg = nM * nN; G = G_; c = c_; }
    __host__ __device__ bool next(int i, Unit& u) const {
#if FAST_NEXT
        if (G == 256 && nM == 64) { const int Lf = i * 256 + c; if (Lf >= nwg) return false; u.pm = 8 * (c & 7) + ((c >> 3) & 7); u.pn = 4 * i + (c >> 6); return true; }
#endif
        const long L = (long)i * G + c; if (L >= nwg) return false;
        int wgid = (int)L; { const int q = nwg / NXCD, r = nwg % NXCD, xcd = wgid % NXCD, off = wgid / NXCD; wgid = (xcd < r ? xcd * (q + 1) : r * (q + 1) + (xcd - r) * q) + off; }
        const int nig = WGM * nN, gid = wgid / nig, fm = gid * WGM, gsz = (nM - fm) < WGM ? (nM - fm) : WGM;
        u.pm = fm + ((wgid % nig) % gsz); u.pn = (wgid % nig) / gsz; return true;
    }
    __device__ __forceinline__ void a_ready(const Unit&) const {}
    __device__ __forceinline__ void done(const Unit&) const {}
};

template <class E> struct PermA { static constexpr bool value = false; };
template <class E> struct SeedK { static constexpr bool value = false; };
template <class E> struct RelaxW { static constexpr int value = 0; };
template <class E> struct PreK { static constexpr bool value = false; };
struct InProjOrder : StaticOrder {
    unsigned* kv;
    __device__ __forceinline__ void done(const Unit& u) const {
        if (kv != nullptr && u.pn >= 4 && u.pn < 12) { asm volatile("s_waitcnt vmcnt(0)" ::: "memory");
            int l_; asm volatile("v_mbcnt_lo_u32_b32 %0, -1, 0\n\tv_mbcnt_hi_u32_b32 %0, -1, %0" : "=v"(l_));
            if (l_ == 0) (void)__hip_atomic_fetch_add(kv, 1u, __ATOMIC_RELAXED, __HIP_MEMORY_SCOPE_AGENT); }
    }
};
struct PleOrder {
    StaticOrder a, b; bool extra;
    __host__ __device__ bool next(int i, Unit& u) const { if (i < 2) return a.next(i, u); return (extra && i < 4) ? b.next(i + 4, u) : false; }
    __device__ __forceinline__ void a_ready(const Unit&) const {}
    __device__ __forceinline__ void done(const Unit&) const {}
};
struct SyncOrder : StaticOrder {
    unsigned* cnt; unsigned nloc;
    __device__ __forceinline__ void a_ready(const Unit&) const {
        if (cnt != nullptr) {
            int l_; asm volatile("v_mbcnt_lo_u32_b32 %0, -1, 0\n\tv_mbcnt_hi_u32_b32 %0, -1, %0" : "=v"(l_));
            if (threadIdx.x < 64 && l_ == 0) { const unsigned old = __hip_atomic_fetch_add(cnt, 1u, __ATOMIC_RELAXED, __HIP_MEMORY_SCOPE_AGENT), tgt = (old / nloc + 1u) * nloc; unsigned sp = 0u;
                while (__hip_atomic_load(cnt, __ATOMIC_RELAXED, __HIP_MEMORY_SCOPE_AGENT) < tgt && ++sp < (1u << 16)) __builtin_amdgcn_s_sleep(1); }
            asm volatile("" ::: "memory"); __builtin_amdgcn_s_barrier(); asm volatile("" ::: "memory"); }
    }
};
struct HotOrder {
    StaticOrder b;
    __host__ __device__ void init(int M, int N, int G_, int c_) { b.init(M, N, G_, c_); }
    __host__ __device__ bool next(int i, Unit& u) const { const bool ok = b.next(i, u); u.pm = 0; u.pn = 0; return ok; }
    __device__ __forceinline__ void a_ready(const Unit&) const {}
    __device__ __forceinline__ void done(const Unit&) const {}
};
struct RotOrder {
    StaticOrder b; int cnt, rot;
    __host__ __device__ void init(int M, int N, int G_, int c_) { b.init(M, N, G_, c_); cnt = (b.nwg - c_ + G_ - 1) / G_; rot = (b.nwg % G_ == 0) ? ((c_ % NXCD) * cnt) / NXCD : 0; }
    __host__ __device__ bool next(int i, Unit& u) const { if (i >= cnt) return false; int j = i + rot; if (j >= cnt) j -= cnt; return b.next(j, u); }
    __device__ __forceinline__ void a_ready(const Unit&) const {}
    __device__ __forceinline__ void done(const Unit&) const {}
};

typedef float f32x2c_t __attribute__((ext_vector_type(2))); typedef __bf16 bf16x2c_t __attribute__((ext_vector_type(2)));
__device__ __forceinline__ unsigned cvt_pk_bf16(float lo, float hi) { f32x2c_t v = {lo, hi}; bf16x2c_t b = __builtin_convertvector(v, bf16x2c_t); return __builtin_bit_cast(unsigned, b); }
typedef float f32x2 __attribute__((ext_vector_type(2)));
typedef unsigned u32x2 __attribute__((ext_vector_type(2)));
__host__ __device__ __forceinline__ size_t tiled_off(int row, int col, int K) { return ((size_t)((row >> 8) * (K >> 6) + (col >> 6)) * 256 + (row & 255)) * 64 + (col & 63); }
#ifndef EPI_NT
#define EPI_NT 0
#endif
#ifndef EPI_SC1
#define EPI_SC1 0
#endif
#ifndef RES_STREAM
#define RES_STREAM 0
#endif
template <class T> __device__ __forceinline__ T ld_stream(const T* p) {
#if RES_STREAM
    return __builtin_nontemporal_load(p);
#else
    return *p;
#endif
}
#ifndef YH_NT
#define YH_NT 0
#endif
template <class T> __device__ __forceinline__ void st_stream(T* p, const T v) {
#if RES_STREAM || YH_NT
    __builtin_nontemporal_store(v, p);
#else
    *p = v;
#endif
}
#ifndef HALO_WT
#define HALO_WT 1
#endif
template <class T> __device__ __forceinline__ void st_wt(T* p, const T v) { static_assert(sizeof(T) == 16, "st_wt: 16-byte vectors only"); asm volatile("global_store_dwordx4 %0, %1, off sc1\n\ts_nop 1" :: "v"(p), "v"(v) : "memory"); }
template <class T> __device__ __forceinline__ void st_out(T* p, const T v) {
#if EPI_SC1
    static_assert(sizeof(T) == 16, "st_out: 16-byte vectors only");
    asm volatile("global_store_dwordx4 %0, %1, off sc1\n\ts_nop 1" :: "v"(p), "v"(v));
#elif EPI_NT
    __builtin_nontemporal_store(v, p);
#else
    *p = v;
#endif
}

__device__ __forceinline__ float bf2f(unsigned short b) { return __uint_as_float(((unsigned)b) << 16); }
__device__ __forceinline__ u32x4 pack8(const f32x4 a, const f32x4 b) { u32x4 w; w.x = cvt_pk_bf16(a[0], a[1]); w.y = cvt_pk_bf16(a[2], a[3]); w.z = cvt_pk_bf16(b[0], b[1]); w.w = cvt_pk_bf16(b[2], b[3]); return w; }
__device__ __forceinline__ float sigmoidf_(float x) { return __builtin_amdgcn_rcpf(1.0f + __expf(-x)); }

#ifndef TAB_H
#define TAB_H 0
#endif
typedef _Float16 tab_h8 __attribute__((ext_vector_type(8))); typedef float tab_f8 __attribute__((ext_vector_type(8)));
__device__ __forceinline__ void ld_tab(const float* cosb, const float* sinb, unsigned idx, f32x4& c0, f32x4& c1, f32x4& s0, f32x4& s1) {
#if TAB_H
    const tab_f8 cf = __builtin_convertvector(*(const tab_h8*)((const char*)cosb + 2u * idx), tab_f8), sf = __builtin_convertvector(*(const tab_h8*)((const char*)sinb + 2u * idx), tab_f8);
    c0 = (f32x4){cf[0], cf[1], cf[2], cf[3]}; c1 = (f32x4){cf[4], cf[5], cf[6], cf[7]}; s0 = (f32x4){sf[0], sf[1], sf[2], sf[3]}; s1 = (f32x4){sf[4], sf[5], sf[6], sf[7]};
#else
    c0 = *(const f32x4*)((const char*)cosb + 4u * idx); c1 = *(const f32x4*)((const char*)cosb + 4u * (idx + 4u)); s0 = *(const f32x4*)((const char*)sinb + 4u * idx); s1 = *(const f32x4*)((const char*)sinb + 4u * (idx + 4u));
#endif
}
template <bool LNFIX> struct EpiInProjT {
    static constexpr bool PERM = true, AFTER_DRAIN = false;
    bf16_t *Q, *K, *V, *G, *AQ, *AK, *AV; const float *cosr, *sinr, *cosa, *sina; const float *stats, *c1, *c2;
    __device__ __forceinline__ void operator()(f32x4 (&acc)[2][2][4][2], const Unit& u, int wr, int wc, int fr, int fq) const {
        int cw = wc * 32 + 8 * fq, frq = fr; asm volatile("" : "+v"(cw), "+v"(frq));
        const int row0 = u.pm * BM + wr * 64 + frq, pn = u.pn; const unsigned cwu = (unsigned)cw;
        if (LNFIX) {
            f32x4 c1v[2][2], c2v[2][2];
#pragma unroll
            for (int bj = 0; bj < 2; ++bj)
#pragma unroll
                for (int n = 0; n < 2; ++n) { c1v[bj][n] = *(const f32x4*)((const char*)c1 + 4u * ((unsigned)(pn * 256 + bj * HALF + 4 * n) + cwu)); c2v[bj][n] = *(const f32x4*)((const char*)c2 + 4u * ((unsigned)(pn * 256 + bj * HALF + 4 * n) + cwu)); }
#pragma unroll
            for (int i = 0; i < 8; ++i) { const f32x2 st = *(const f32x2*)((const char*)stats + 8u * (unsigned)(row0 + (i >> 2) * HALF + (i & 3) * 16));
#pragma unroll
                for (int bj = 0; bj < 2; ++bj)
#pragma unroll
                    for (int n = 0; n < 2; ++n) acc[i >> 2][bj][i & 3][n] = (acc[i >> 2][bj][i & 3][n] - c1v[bj][n] * st.x) * st.y + c2v[bj][n]; } }
        auto A = [&](int ai, int bj, int m, int n) -> f32x4 { return acc[ai][bj][m][n]; };
        if (pn < 8) {
            bf16_t* O = pn < 4 ? Q : K; const int hcol = (pn & 3) * 256; const float sc = pn < 4 ? 1.0f : 0.0625f;
#pragma unroll
            for (int ai = 0; ai < 2; ++ai)
#pragma unroll
                for (int m = 0; m < 4; ++m) { const unsigned row = (unsigned)(row0 + ai * HALF + m * 16);
                    f32x4 c0, c1, s0, s1; ld_tab(cosr, sinr, row * 128u + cwu, c0, c1, s0, s1);
                    const f32x4 a0 = A(ai, 0, m, 0), a1 = A(ai, 0, m, 1), b0 = A(ai, 1, m, 0), b1 = A(ai, 1, m, 1);
                    const f32x4 o10 = (a0 * c0 - b0 * s0) * sc, o11 = (a1 * c1 - b1 * s1) * sc, o20 = (a0 * s0 + b0 * c0) * sc, o21 = (a1 * s1 + b1 * c1) * sc;
                    bf16_t* rowp = (bf16_t*)((char*)O + 2u * (row * 1024u + (unsigned)hcol + cwu));
                    st_out((u32x4*)(rowp), (u32x4)(pack8(o10, o11))); st_out((u32x4*)(rowp + HALF), (u32x4)(pack8(o20, o21))); }
        } else if (pn < 16) {
            const bool gate = pn >= 12; bf16_t* O = gate ? G : V; const int hcol = (pn & 3) * 256;
#pragma unroll
            for (int ai = 0; ai < 2; ++ai)
#pragma unroll
                for (int m = 0; m < 4; ++m) { const unsigned row = (unsigned)(row0 + ai * HALF + m * 16); bf16_t* rowp = (bf16_t*)((char*)O + 2u * (row * 1024u + (unsigned)hcol + cwu));
#pragma unroll
                    for (int bj = 0; bj < 2; ++bj) { f32x4 v0 = A(ai, bj, m, 0), v1 = A(ai, bj, m, 1);
                        if (gate) {
#pragma unroll
                            for (int j = 0; j < 4; ++j) { v0[j] = v0[j] * sigmoidf_(v0[j]); v1[j] = v1[j] * sigmoidf_(v1[j]); } }
                        st_out((u32x4*)(rowp + bj * HALF), (u32x4)(pack8(v0, v1))); } }
        } else if (pn < 20) {
            const int t = pn - 16, i0 = 8 * fq;
#pragma unroll
            for (int ai = 0; ai < 2; ++ai)
#pragma unroll
                for (int m = 0; m < 4; ++m) { const unsigned row = (unsigned)(row0 + ai * HALF + m * 16);
                    f32x4 c0, c1, s0, s1; ld_tab(cosa, sina, row * 32u + (unsigned)i0, c0, c1, s0, s1);
                    const f32x4 a0 = A(ai, 0, m, 0), a1 = A(ai, 0, m, 1), b0 = A(ai, 1, m, 0), b1 = A(ai, 1, m, 1);
                    const f32x4 o10 = (a0 * c0 - b0 * s0) * 0.125f, o11 = (a1 * c1 - b1 * s1) * 0.125f, o20 = (a0 * s0 + b0 * c0) * 0.125f, o21 = (a1 * s1 + b1 * c1) * 0.125f;
                    bf16_t* rowp = (bf16_t*)((char*)AQ + 2u * (row * 1024u + (unsigned)(t * 256 + wc * 64 + i0)));
                    st_out((u32x4*)(rowp), (u32x4)(pack8(o10, o11))); st_out((u32x4*)(rowp + 32), (u32x4)(pack8(o20, o21))); }
        } else {
            const int i0 = 8 * fq;
            if (wc < 2) {
#pragma unroll
                for (int ai = 0; ai < 2; ++ai)
#pragma unroll
                    for (int m = 0; m < 4; ++m) { const unsigned row = (unsigned)(row0 + ai * HALF + m * 16);
                        f32x4 c0, c1, s0, s1; ld_tab(cosa, sina, row * 32u + (unsigned)i0, c0, c1, s0, s1);
                        const f32x4 a0 = A(ai, 0, m, 0), a1 = A(ai, 0, m, 1), b0 = A(ai, 1, m, 0), b1 = A(ai, 1, m, 1);
                        const f32x4 o10 = a0 * c0 - b0 * s0, o11 = a1 * c1 - b1 * s1, o20 = a0 * s0 + b0 * c0, o21 = a1 * s1 + b1 * c1;
                        bf16_t* rowp = (bf16_t*)((char*)AK + 2u * (row * 128u + (unsigned)(wc * 64 + i0)));
                        st_out((u32x4*)(rowp), (u32x4)(pack8(o10, o11))); st_out((u32x4*)(rowp + 32), (u32x4)(pack8(o20, o21))); }
            } else {
#pragma unroll
                for (int ai = 0; ai < 2; ++ai)
#pragma unroll
                    for (int m = 0; m < 4; ++m) { const unsigned row = (unsigned)(row0 + ai * HALF + m * 16); bf16_t* rowp = (bf16_t*)((char*)AV + 2u * (row * 128u + (unsigned)((wc - 2) * 32 + i0)));
                        st_out((u32x4*)(rowp), (u32x4)(pack8(A(ai, 0, m, 0), A(ai, 0, m, 1)))); st_out((u32x4*)(rowp + 64), (u32x4)(pack8(A(ai, 1, m, 0), A(ai, 1, m, 1)))); }
            }
        }
    }
};
typedef EpiInProjT<false> EpiInProj;
template <bool ADD> struct EpiResid {
    static constexpr bool PERM = false, AFTER_DRAIN = false;
    const float* base; float* Y; float alpha;
    __device__ __forceinline__ void operator()(const f32x4 (&acc)[2][2][4][2], const Unit& u, int wr, int wc, int fr, int fq) const {
        const int row0 = u.pm * BM + wr * 64 + fr, col0 = u.pn * BM + wc * 32 + 4 * fq;
#pragma unroll
        for (int ai = 0; ai < 2; ++ai)
#pragma unroll
            for (int m = 0; m < 4; ++m) { const size_t off = (size_t)(row0 + ai * HALF + m * 16) * 2048 + col0;
#pragma unroll
                for (int bj = 0; bj < 2; ++bj)
#pragma unroll
                    for (int n = 0; n < 2; ++n) { const size_t o = off + bj * HALF + n * 16; f32x4 v = acc[ai][bj][m][n] + *(const f32x4*)(base + o) * alpha;
                        if (ADD) v = v + *(const f32x4*)(Y + o); st_out((f32x4*)(Y + o), (f32x4)(v)); } }
    }
};
struct EpiUp {
    static constexpr bool PERM = true, AFTER_DRAIN = false;
    bf16_t* H; bf16_t* SG; const float* bgate;
    __device__ __forceinline__ void operator()(const f32x4 (&acc)[2][2][4][2], const Unit& u, int wr, int wc, int fr, int fq) const {
        const int row0 = u.pm * BM + wr * 64 + fr, cw = wc * 32 + 8 * fq;
        if (u.pn < 44) {
#pragma unroll
            for (int ai = 0; ai < 2; ++ai)
#pragma unroll
                for (int m = 0; m < 4; ++m) { bf16_t* rowp = H + (size_t)(row0 + ai * HALF + m * 16) * 11264 + u.pn * 256 + cw;
#pragma unroll
                    for (int bj = 0; bj < 2; ++bj) st_out((u32x4*)(rowp + bj * HALF), (u32x4)(pack8(acc[ai][bj][m][0], acc[ai][bj][m][1]))); }
        } else {
            const int colg = (u.pn - 44) * 256 + cw;
            f32x4 bv[2][2];
#pragma unroll
            for (int bj = 0; bj < 2; ++bj)
#pragma unroll
                for (int n = 0; n < 2; ++n) bv[bj][n] = *(const f32x4*)(bgate + colg + bj * HALF + 4 * n);
#pragma unroll
            for (int ai = 0; ai < 2; ++ai)
#pragma unroll
                for (int m = 0; m < 4; ++m) { bf16_t* rowp = SG + (size_t)(row0 + ai * HALF + m * 16) * 2048 + colg;
#pragma unroll
                    for (int bj = 0; bj < 2; ++bj) { f32x4 v0 = acc[ai][bj][m][0] + bv[bj][0], v1 = acc[ai][bj][m][1] + bv[bj][1];
#pragma unroll
                        for (int j = 0; j < 4; ++j) { v0[j] = sigmoidf_(v0[j]); v1[j] = sigmoidf_(v1[j]); }
                        st_out((u32x4*)(rowp + bj * HALF), (u32x4)(pack8(v0, v1))); } }
        }
    }
};

#ifndef DPP_BC
#define DPP_BC true
#endif
__device__ __forceinline__ float ror1f(float x) { return __builtin_bit_cast(float, __builtin_amdgcn_update_dpp(0, __builtin_bit_cast(int, x), 0x121, 0xf, 0xf, DPP_BC)); }
__device__ __forceinline__ float ror2f(float x) { return __builtin_bit_cast(float, __builtin_amdgcn_update_dpp(0, __builtin_bit_cast(int, x), 0x122, 0xf, 0xf, DPP_BC)); }
typedef _Float16 h16x8 __attribute__((ext_vector_type(8)));
typedef float f32x8 __attribute__((ext_vector_type(8)));
#ifndef TFOLD
#define TFOLD 0
#endif
#ifndef LAST_H
#define LAST_H 1
#endif
#ifndef PSG
#define PSG 0
#endif
#ifndef SEED_PLE
#define SEED_PLE 0
#endif
#ifndef ROWP
#define ROWP 1
#endif
#ifndef PST_T
#define PST_T 1
#endif
#ifndef CONV_ST16
#define CONV_ST16 1
#endif
#ifndef UP_PREK
#define UP_PREK 2
#endif
#ifndef RELAX_UP
#define RELAX_UP 0
#endif
#ifndef CONVW_PF
#define CONVW_PF 0
#endif
#ifndef ROWP_ST16
#define ROWP_ST16 0
#endif
#ifndef GB_LDS
#define GB_LDS 0
#endif
#ifndef PLE_PF
#define PLE_PF 0
#endif
#ifndef EPI_PD
#define EPI_PD 2
#endif
#ifndef GATE_PD
#define GATE_PD 3
#endif
template <bool LNFIX> struct EpiUpConvT {
    static constexpr bool PERM = true, AFTER_DRAIN = false;
    bf16_t* ACT; bf16_t* HALO; bf16_t* SG; const float* bgate; const float* cw; const float* cb; const float *stats, *c1, *c2;
    const _Float16* YHr; const bf16_t* PPr; const float* g1; const float* b1; float alpha; unsigned sp;
#if defined(PROBE_DUP) && PROBE_DUP >= 90 && PROBE_DUP <= 93
    int mode;
#define UPMODE(b) ((mode >> (b)) & 1)
#else
#define UPMODE(b) 0
#endif
#if UP_PREK == 2
    typedef __attribute__((address_space(3))) unsigned lds_u32;
    __device__ __forceinline__ void pre_w(const Unit& u, int wr, int wc, int lane) const {
        if (u.pn < 44) { const unsigned slot = sp + (unsigned)(wc * 2 + wr) * 1024u; const unsigned chg = 4u * (unsigned)(128 * u.pn + 32 * wc + (lane & 31)), chu = chg + 4u * 5632u; const bool hi = lane >= 32;
            __builtin_amdgcn_global_load_lds((const unsigned*)((const char*)cw + (chg + (hi ? 4u * 11264u : 0u))), (lds_u32*)(unsigned long)(slot), 4, 0, 0);
            __builtin_amdgcn_global_load_lds((const unsigned*)((const char*)(hi ? cb : cw) + (chg + (hi ? 0u : 8u * 11264u))), (lds_u32*)(unsigned long)(slot + 256u), 4, 0, 0);
            __builtin_amdgcn_global_load_lds((const unsigned*)((const char*)cw + (chu + (hi ? 4u * 11264u : 0u))), (lds_u32*)(unsigned long)(slot + 512u), 4, 0, 0);
            __builtin_amdgcn_global_load_lds((const unsigned*)((const char*)(hi ? cb : cw) + (chu + (hi ? 0u : 8u * 11264u))), (lds_u32*)(unsigned long)(slot + 768u), 4, 0, 0); }
    }
    __device__ __forceinline__ void pre_phase(const Unit& u, int wr, int wc, int lane) const { pre_w(u, wr, wc, lane); }
    __device__ __forceinline__ void pre_next(const Unit& u, int wr, int wc, int lane) const { pre_w(u, wr, wc, lane); }
#elif UP_PREK
    typedef __attribute__((address_space(3))) unsigned lds_u32;
    __device__ __forceinline__ void pre_cols(const Unit& u, int wr, int wc, int lane) const {
        const unsigned slot = sp + (unsigned)(wc * 2 + wr) * 1536u; const unsigned col = (unsigned)(u.pn * 256 + (lane >> 5) * HALF + wc * 32 + (lane & 31));
        __builtin_amdgcn_global_load_lds((const unsigned*)((const char*)c1 + 4u * col), (lds_u32*)(unsigned long)(slot + 1024u), 4, 0, 0);
        __builtin_amdgcn_global_load_lds((const unsigned*)((const char*)c2 + 4u * col), (lds_u32*)(unsigned long)(slot + 1280u), 4, 0, 0);
    }
    __device__ __forceinline__ void pre_phase(const Unit& u, int wr, int wc, int lane) const {
        const unsigned slot = sp + (unsigned)(wc * 2 + wr) * 1536u; const unsigned row = (unsigned)(u.pm * BM + (lane >> 5) * HALF + wr * 64 + ((2 * lane) & 63));
        __builtin_amdgcn_global_load_lds((const unsigned*)((const char*)stats + 8u * row), (lds_u32*)(unsigned long)slot, 16, 0, 0);
        pre_cols(u, wr, wc, lane);
    }
    __device__ __forceinline__ void pre_next(const Unit& u, int wr, int wc, int lane) const { pre_cols(u, wr, wc, lane); }
#endif
    __device__ __forceinline__ void operator()(f32x4 (&acc)[2][2][4][2], const Unit& u, int wr, int wc, int fr, int fq) const {
        int cwp = wc * 32 + 8 * fq; asm volatile("" : "+v"(cwp));
#if defined(PROBE_DUP) && PROBE_DUP == 81
        asm volatile("s_waitcnt vmcnt(0)" ::: "memory");
#endif
        const int row0 = u.pm * BM + wr * 64 + fr;
#if ROWP
        int fr4 = 4 * fr; asm volatile("" : "+v"(fr4));
        const int rowp0 = u.pm * BM + wr * 64 + fr4;
#define UPROW(ai, m) (rowp0 + (ai) * HALF + (m))
#else
#define UPROW(ai, m) (row0 + (ai) * HALF + (m) * 16)
#endif
#if ROWP && CONVW_PF
        f32x4 cwv[2][8];
        auto ldcw = [&](int n) { const unsigned cg4 = 4u * (unsigned)(128 * u.pn + cwp + 4 * n), cu4 = cg4 + 4u * 5632u;
            cwv[n][0] = *(const f32x4*)((const char*)cw + cg4); cwv[n][1] = *(const f32x4*)((const char*)cw + (cg4 + 4u * 11264u)); cwv[n][2] = *(const f32x4*)((const char*)cw + (cg4 + 8u * 11264u)); cwv[n][3] = *(const f32x4*)((const char*)cb + cg4);
            cwv[n][4] = *(const f32x4*)((const char*)cw + cu4); cwv[n][5] = *(const f32x4*)((const char*)cw + (cu4 + 4u * 11264u)); cwv[n][6] = *(const f32x4*)((const char*)cw + (cu4 + 8u * 11264u)); cwv[n][7] = *(const f32x4*)((const char*)cb + cu4); };
        if (CONVW_PF == 1 && u.pn < 44) ldcw(0);
#endif
        if (LNFIX && !UPMODE(1)) {
            const int cwq = cwp;
            f32x4 c1v[2][2], c2v[2][2];
#if UP_PREK == 1 && ROWP
            const unsigned slot_ = sp + (unsigned)(wc * 2 + wr) * 1536u;
            typedef __attribute__((address_space(3))) f32x4 lds_f4; typedef __attribute__((address_space(3))) f32x2 lds_f2;
#pragma unroll
            for (int bj = 0; bj < 2; ++bj)
#pragma unroll
                for (int n = 0; n < 2; ++n) { const unsigned o = 4u * (unsigned)(bj * 32 + 4 * n) + 4u * (unsigned)(cwq & 31);
                    c1v[bj][n] = *(const lds_f4*)(unsigned long)(slot_ + 1024u + o); c2v[bj][n] = *(const lds_f4*)(unsigned long)(slot_ + 1280u + o); }
#pragma unroll
            for (int i = 0; i < 8; ++i) { const f32x2 st = *(const lds_f2*)(unsigned long)(slot_ + 8u * (unsigned)((i >> 2) * 64 + (i & 3)) + 8u * (unsigned)fr4);
#else
#pragma unroll
            for (int bj = 0; bj < 2; ++bj)
#pragma unroll
                for (int n = 0; n < 2; ++n) { c1v[bj][n] = *(const f32x4*)((const char*)c1 + 4u * (unsigned)(u.pn * 256 + bj * HALF + cwq + 4 * n)); c2v[bj][n] = *(const f32x4*)((const char*)c2 + 4u * (unsigned)(u.pn * 256 + bj * HALF + cwq + 4 * n)); }
#pragma unroll
            for (int i = 0; i < 8; ++i) { const f32x2 st = *(const f32x2*)((const char*)stats + 8u * (unsigned)UPROW(i >> 2, i & 3));
#endif
#pragma unroll
                for (int bj = 0; bj < 2; ++bj)
#pragma unroll
                    for (int n = 0; n < 2; ++n) acc[i >> 2][bj][i & 3][n] = (acc[i >> 2][bj][i & 3][n] - c1v[bj][n] * st.x) * st.y + c2v[bj][n]; } }
        auto A = [&](int ai, int bj, int m, int n) -> f32x4 { return acc[ai][bj][m][n]; };
        if (UPMODE(0)) {
#pragma unroll
            for (int i = 0; i < 32; ++i) asm volatile("" :: "v"(acc[i >> 4][(i >> 3) & 1][(i >> 1) & 3][i & 1]));
            return; }
#if ROWP
        if (u.pn < 44) {
            bf16_t* const actb = (bf16_t*)((char*)ACT + 2u * ((((unsigned)(u.pm * (5632 >> 6) + 2 * u.pn + (cwp >> 6)) * 256u + (unsigned)(wr * 64 + fr4)) * 64u) + (unsigned)(cwp & 63)));
#if ROWP_ST16
            u32x2 wlo[2][4];
#endif
#if UP_PREK == 2 && CONV_ST16
            {   typedef __attribute__((address_space(3))) f32x4 lds_f4w;
                const unsigned actoff_ = 2u * ((((unsigned)(u.pm * (5632 >> 6) + 2 * u.pn + (cwp >> 6)) * 256u + (unsigned)(wr * 64 + fr4)) * 64u) + (unsigned)(cwp & 63));
#pragma unroll
                for (int ai = 0; ai < 2; ++ai) { u32x2 wlo[4];
#pragma unroll
                    for (int n = 0; n < 2; ++n) {
                        const unsigned wo_ = sp + (unsigned)(wc * 2 + wr) * 1024u + 4u * (unsigned)((cwp & 31) + 4 * n);
                        const f32x4 wg0 = *(const lds_f4w*)(unsigned long)(wo_), wg1 = *(const lds_f4w*)(unsigned long)(wo_ + 128u), wg2 = *(const lds_f4w*)(unsigned long)(wo_ + 256u), bg = *(const lds_f4w*)(unsigned long)(wo_ + 384u);
                        const f32x4 wu0 = *(const lds_f4w*)(unsigned long)(wo_ + 512u), wu1 = *(const lds_f4w*)(unsigned long)(wo_ + 640u), wu2 = *(const lds_f4w*)(unsigned long)(wo_ + 768u), bu = *(const lds_f4w*)(unsigned long)(wo_ + 896u);
#pragma unroll
                        for (int m = 3; m >= 0; --m) {
                            f32x4 sg3, su3;
                            if (m <= 1) {
#pragma unroll
                                for (int j = 0; j < 4; ++j) { sg3[j] = ror1f(A(ai, 0, 3, n)[j]); su3[j] = ror1f(A(ai, 1, 3, n)[j]); } }
                            f32x4 xg2, xu2;
                            if (m >= 2) { xg2 = A(ai, 0, m - 2, n); xu2 = A(ai, 1, m - 2, n); }
                            else if (m == 1) { xg2 = sg3; xu2 = su3; }
                            else {
#pragma unroll
                                for (int j = 0; j < 4; ++j) { xg2[j] = ror1f(A(ai, 0, 2, n)[j]); xu2[j] = ror1f(A(ai, 1, 2, n)[j]); } }
                            const f32x4 xg1 = m >= 1 ? A(ai, 0, m - 1, n) : sg3, xu1 = m >= 1 ? A(ai, 1, m - 1, n) : su3, xg0 = A(ai, 0, m, n), xu0 = A(ai, 1, m, n);
                            const f32x4 ga = bg + wg0 * xg2 + wg1 * xg1 + wg2 * xg0, ua = bu + wu0 * xu2 + wu1 * xu1 + wu2 * xu0;
                            f32x4 o;
#pragma unroll
                            for (int j = 0; j < 4; ++j) o[j] = ga[j] * sigmoidf_(ga[j]) * ua[j];
                            u32x2 w; w.x = cvt_pk_bf16(o[0], o[1]); w.y = cvt_pk_bf16(o[2], o[3]);
                            if (n == 0) wlo[m] = w;
                            else if (m >= 2 || fr != 0) st_out((u32x4*)((char*)ACT + (actoff_ + 2u * (unsigned)((ai * 128 + m) * 64))), (u32x4){wlo[m].x, wlo[m].y, w.x, w.y}); } } } }
#else
#if defined(PROBE_DUP) && PROBE_DUP == 80
            int nrp_ = 2; asm volatile("" : "+s"(nrp_));
            for (int rp_ = 0; rp_ < nrp_; ++rp_) {
#endif
#if CONVW_PF
            if (CONVW_PF == 2) ldcw(0);
            ldcw(1);
#endif
#pragma unroll
            for (int n = 0; n < 2; ++n) {
#if UP_PREK == 2
                typedef __attribute__((address_space(3))) f32x4 lds_f4w;
                const unsigned wo_ = sp + (unsigned)(wc * 2 + wr) * 1024u + 4u * (unsigned)((cwp & 31) + 4 * n);
                const f32x4 wg0 = *(const lds_f4w*)(unsigned long)(wo_), wg1 = *(const lds_f4w*)(unsigned long)(wo_ + 128u), wg2 = *(const lds_f4w*)(unsigned long)(wo_ + 256u), bg = *(const lds_f4w*)(unsigned long)(wo_ + 384u);
                const f32x4 wu0 = *(const lds_f4w*)(unsigned long)(wo_ + 512u), wu1 = *(const lds_f4w*)(unsigned long)(wo_ + 640u), wu2 = *(const lds_f4w*)(unsigned long)(wo_ + 768u), bu = *(const lds_f4w*)(unsigned long)(wo_ + 896u);
#elif CONVW_PF
                const f32x4 wg0 = cwv[n][0], wg1 = cwv[n][1], wg2 = cwv[n][2], bg = cwv[n][3], wu0 = cwv[n][4], wu1 = cwv[n][5], wu2 = cwv[n][6], bu = cwv[n][7];
#else
                const int chg = 128 * u.pn + cwp + 4 * n, chu = 5632 + chg;
                const unsigned cg4 = 4u * (unsigned)chg, cu4 = 4u * (unsigned)chu;
                const f32x4 wg0 = *(const f32x4*)((const char*)cw + cg4), wg1 = *(const f32x4*)((const char*)cw + (cg4 + 4u * 11264u)), wg2 = *(const f32x4*)((const char*)cw + (cg4 + 8u * 11264u)), bg = *(const f32x4*)((const char*)cb + cg4);
                const f32x4 wu0 = *(const f32x4*)((const char*)cw + cu4), wu1 = *(const f32x4*)((const char*)cw + (cu4 + 4u * 11264u)), wu2 = *(const f32x4*)((const char*)cw + (cu4 + 8u * 11264u)), bu = *(const f32x4*)((const char*)cb + cu4);
#endif
#pragma unroll
                for (int ai = 0; ai < 2; ++ai) {
                    f32x4 sg3, su3;
#pragma unroll
                    for (int m = 3; m >= 0; --m) {
                        if (m == 1) {
#pragma unroll
                            for (int j = 0; j < 4; ++j) { sg3[j] = ror1f(A(ai, 0, 3, n)[j]); su3[j] = ror1f(A(ai, 1, 3, n)[j]); } }
                        f32x4 xg2, xu2;
                        if (m >= 2) { xg2 = A(ai, 0, m - 2, n); xu2 = A(ai, 1, m - 2, n); }
                        else if (m == 1) { xg2 = sg3; xu2 = su3; }
                        else {
#pragma unroll
                            for (int j = 0; j < 4; ++j) { xg2[j] = ror1f(A(ai, 0, 2, n)[j]); xu2[j] = ror1f(A(ai, 1, 2, n)[j]); } }
                        const f32x4 xg1 = m >= 1 ? A(ai, 0, m - 1, n) : sg3, xu1 = m >= 1 ? A(ai, 1, m - 1, n) : su3, xg0 = A(ai, 0, m, n), xu0 = A(ai, 1, m, n);
                        const f32x4 ga = bg + wg0 * xg2 + wg1 * xg1 + wg2 * xg0, ua = bu + wu0 * xu2 + wu1 * xu1 + wu2 * xu0;
                        f32x4 o;
#pragma unroll
                        for (int j = 0; j < 4; ++j) o[j] = ga[j] * sigmoidf_(ga[j]) * ua[j];
#if ROWP_ST16
                        u32x2 w; w.x = cvt_pk_bf16(o[0], o[1]); w.y = cvt_pk_bf16(o[2], o[3]);
                        if (n == 0) wlo[ai][m] = w;
                        else if (m >= 2 || fr != 0) st_out((u32x4*)(ACT + tiled_off(UPROW(ai, m), 128 * u.pn + cwp, 5632)), (u32x4){wlo[ai][m].x, wlo[ai][m].y, w.x, w.y});
#else
                        if (m >= 2 || fr != 0) { u32x2 w; w.x = cvt_pk_bf16(o[0], o[1]); w.y = cvt_pk_bf16(o[2], o[3]); *(u32x2*)(actb + (ai * 128 + m) * 64 + 4 * n) = w; }
#endif
                    }
                }
            }
#if defined(PROBE_DUP) && PROBE_DUP == 80
            }
#endif
#endif
#pragma unroll
            for (int e = 0; e < 2; ++e)
                if (fr == (e ? 15 : 0)) {
#pragma unroll
                    for (int ai = 0; ai < 2; ++ai) { const int span = u.pm * 4 + ai * 2 + wr;
#pragma unroll
                        for (int k = 0; k < 2; ++k) { const int m = 2 * e + k;
                            bf16_t* hp = (bf16_t*)((char*)HALO + 2u * ((unsigned)(span * 4 + m) * 11264u + (unsigned)(256 * u.pn + cwp)));
#if HALO_WT
                            if (e) { st_wt((u32x4*)(hp), (u32x4)(pack8(A(ai, 0, m, 0), A(ai, 0, m, 1)))); st_wt((u32x4*)(hp + HALF), (u32x4)(pack8(A(ai, 1, m, 0), A(ai, 1, m, 1)))); }
                            else
#endif
                            { st_out((u32x4*)(hp), (u32x4)(pack8(A(ai, 0, m, 0), A(ai, 0, m, 1)))); st_out((u32x4*)(hp + HALF), (u32x4)(pack8(A(ai, 1, m, 0), A(ai, 1, m, 1)))); } } } }
        } else
#else
        if (u.pn < 44) {
            f32x4 wg0_[2], wg1_[2], wg2_[2], bg_[2], wu0_[2], wu1_[2], wu2_[2], bu_[2];
#pragma unroll
            for (int n = 0; n < 2; ++n) { const int chg = 128 * u.pn + cwp + 4 * n, chu = 5632 + chg;
                wg0_[n] = *(const f32x4*)(cw + chg); wg1_[n] = *(const f32x4*)(cw + 11264 + chg); wg2_[n] = *(const f32x4*)(cw + 2 * 11264 + chg); bg_[n] = *(const f32x4*)(cb + chg);
                wu0_[n] = *(const f32x4*)(cw + chu); wu1_[n] = *(const f32x4*)(cw + 11264 + chu); wu2_[n] = *(const f32x4*)(cw + 2 * 11264 + chu); bu_[n] = *(const f32x4*)(cb + chu); }
#pragma unroll
            for (int ai = 0; ai < 2; ++ai) {
                const int span = u.pm * 4 + ai * 2 + wr;
#pragma unroll
                for (int m = 0; m < 4; ++m) {
                    const int row = row0 + ai * HALF + m * 16;
                    u32x4 w, rg, ru;
#pragma unroll
                    for (int n = 0; n < 2; ++n) {
                        const f32x4 wg0 = wg0_[n], wg1 = wg1_[n], wg2 = wg2_[n], bg = bg_[n], wu0 = wu0_[n], wu1 = wu1_[n], wu2 = wu2_[n], bu = bu_[n];
                        const f32x4 cg = A(ai, 0, m, n), cu = A(ai, 1, m, n);
                        const f32x4 pg = A(ai, 0, m ? m - 1 : 0, n), pu = A(ai, 1, m ? m - 1 : 0, n);
                        f32x4 o;
#pragma unroll
                        for (int j = 0; j < 4; ++j) {
                            const float g1 = ror1f(fr == 15 ? pg[j] : cg[j]), g2 = ror2f(fr >= 14 ? pg[j] : cg[j]);
                            const float u1 = ror1f(fr == 15 ? pu[j] : cu[j]), u2 = ror2f(fr >= 14 ? pu[j] : cu[j]);
                            const float ga = bg[j] + wg0[j] * g2 + wg1[j] * g1 + wg2[j] * cg[j], ua = bu[j] + wu0[j] * u2 + wu1[j] * u1 + wu2[j] * cu[j];
                            o[j] = ga * sigmoidf_(ga) * ua; }
                        if (n == 0) { w.x = cvt_pk_bf16(o[0], o[1]); w.y = cvt_pk_bf16(o[2], o[3]); rg.x = cvt_pk_bf16(cg[0], cg[1]); rg.y = cvt_pk_bf16(cg[2], cg[3]); ru.x = cvt_pk_bf16(cu[0], cu[1]); ru.y = cvt_pk_bf16(cu[2], cu[3]); }
                        else { w.z = cvt_pk_bf16(o[0], o[1]); w.w = cvt_pk_bf16(o[2], o[3]); rg.z = cvt_pk_bf16(cg[0], cg[1]); rg.w = cvt_pk_bf16(cg[2], cg[3]); ru.z = cvt_pk_bf16(cu[0], cu[1]); ru.w = cvt_pk_bf16(cu[2], cu[3]); }
                    }
                    if (m > 0 || fr >= 2) st_out((u32x4*)(ACT + tiled_off(row, 128 * u.pn + cwp, 5632)), (u32x4)(w));
                    if ((m == 0 && fr < 2) || (m == 3 && fr >= 14)) { int frq = fr; asm volatile("" : "+v"(frq)); const int slot = (m == 0) ? frq : frq - 12;
                        bf16_t* hp = HALO + ((size_t)(span * 4 + slot)) * 11264 + 256 * u.pn + cwp;
                        st_out((u32x4*)(hp), (u32x4)(rg)); st_out((u32x4*)(hp + HALF), (u32x4)(ru)); }
                }
            }
        } else
#endif
        {
            const int colg = (u.pn - 44) * 256 + cwp;
#if TFOLD
            __attribute__((address_space(3))) f32x4* slot = (__attribute__((address_space(3))) f32x4*)(unsigned long)(sp + (unsigned)(wc * 2 + wr) * 1024u);
            if (fr == 0) {
#pragma unroll
                for (int bj = 0; bj < 2; ++bj)
#pragma unroll
                    for (int n = 0; n < 2; ++n) { const int e = (bj * 2 + n) * 4 + fq, c = colg + bj * HALF + 4 * n;
                        slot[e] = *(const f32x4*)(bgate + c); slot[16 + e] = *(const f32x4*)(g1 + c) * alpha; slot[32 + e] = *(const f32x4*)(b1 + c) * alpha; } }
            __builtin_amdgcn_fence(__ATOMIC_RELEASE, "wavefront"); __builtin_amdgcn_wave_barrier(); __builtin_amdgcn_fence(__ATOMIC_ACQUIRE, "wavefront");
            u32x4 sgp[2][2][4];
#pragma unroll
            for (int bj = 0; bj < 2; ++bj) { const f32x4 bb0 = slot[(bj * 2 + 0) * 4 + fq], bb1 = slot[(bj * 2 + 1) * 4 + fq];
#pragma unroll
                for (int ai = 0; ai < 2; ++ai)
#pragma unroll
                    for (int m = 0; m < 4; ++m) { f32x4 v0 = acc[ai][bj][m][0] + bb0, v1 = acc[ai][bj][m][1] + bb1;
#pragma unroll
                        for (int j = 0; j < 4; ++j) { v0[j] = sigmoidf_(v0[j]); v1[j] = sigmoidf_(v1[j]); }
                        u32x4 pk = pack8(v0, v1); unsigned k0 = pk.x, k1 = pk.y, k2 = pk.z, k3 = pk.w; asm volatile("" : "+v"(k0), "+v"(k1), "+v"(k2), "+v"(k3)); sgp[ai][bj][m] = (u32x4){k0, k1, k2, k3}; } }
            int colq = colg, rowq = row0; asm volatile("" : "+v"(colq), "+v"(rowq) : "v"(sgp[1][1][3].w));
            constexpr int GPD = GATE_PD;
            u32x4 yq[GPD][2], pq[GPD][2]; f32x2 sq[GPD];
#pragma unroll
            for (int d = 0; d < GPD; ++d) { const unsigned rn = (unsigned)(rowq + (d >> 2) * HALF + (d & 3) * 16), offn = rn * 2048u + (unsigned)colq; sq[d] = *(const f32x2*)(stats + 2u * rn);
                yq[d][0] = *(const u32x4*)(YHr + offn); yq[d][1] = *(const u32x4*)(YHr + offn + HALF); pq[d][0] = *(const u32x4*)(PPr + offn); pq[d][1] = *(const u32x4*)(PPr + offn + HALF); }
#pragma unroll
            for (int i = 0; i < 8; ++i) { const int ai = i >> 2, m = i & 3, sl = i % GPD; const unsigned off = (unsigned)(rowq + ai * HALF + m * 16) * 2048u + (unsigned)colq;
                const u32x4 cy0 = yq[sl][0], cy1 = yq[sl][1], cp0 = pq[sl][0], cp1 = pq[sl][1]; const f32x2 cs = sq[sl];
                if (i + GPD < 8) { const unsigned rn = (unsigned)(rowq + ((i + GPD) >> 2) * HALF + ((i + GPD) & 3) * 16), offn = rn * 2048u + (unsigned)colq; sq[sl] = *(const f32x2*)(stats + 2u * rn);
                    yq[sl][0] = *(const u32x4*)(YHr + offn); yq[sl][1] = *(const u32x4*)(YHr + offn + HALF); pq[sl][0] = *(const u32x4*)(PPr + offn); pq[sl][1] = *(const u32x4*)(PPr + offn + HALF); }
#pragma unroll
                for (int bj = 0; bj < 2; ++bj) { const u32x4 sv = sgp[ai][bj][m], pp = bj ? cp1 : cp0;
                    unsigned so = sp + (unsigned)(wc * 2 + wr) * 1024u + (unsigned)fq * 16u; asm volatile("" : "+v"(so));
                    __attribute__((address_space(3))) f32x4* sq_ = (__attribute__((address_space(3))) f32x4*)(unsigned long)so;
                    const f32x4 g0 = sq_[16 + (bj * 2 + 0) * 4], g1v = sq_[16 + (bj * 2 + 1) * 4], b0 = sq_[32 + (bj * 2 + 0) * 4], b1v = sq_[32 + (bj * 2 + 1) * 4];
                    const f32x8 yf = __builtin_convertvector(__builtin_bit_cast(h16x8, bj ? cy1 : cy0), f32x8);
                    const f32x4 y0 = (f32x4){yf[0], yf[1], yf[2], yf[3]}, y1 = (f32x4){yf[4], yf[5], yf[6], yf[7]};
                    const f32x4 p0 = (f32x4){__uint_as_float(pp.x << 16), __uint_as_float(pp.x & 0xffff0000u), __uint_as_float(pp.y << 16), __uint_as_float(pp.y & 0xffff0000u)};
                    const f32x4 p1 = (f32x4){__uint_as_float(pp.z << 16), __uint_as_float(pp.z & 0xffff0000u), __uint_as_float(pp.w << 16), __uint_as_float(pp.w & 0xffff0000u)};
                    const f32x4 v0 = (f32x4){__uint_as_float(sv.x << 16), __uint_as_float(sv.x & 0xffff0000u), __uint_as_float(sv.y << 16), __uint_as_float(sv.y & 0xffff0000u)};
                    const f32x4 v1 = (f32x4){__uint_as_float(sv.z << 16), __uint_as_float(sv.z & 0xffff0000u), __uint_as_float(sv.w << 16), __uint_as_float(sv.w & 0xffff0000u)};
                    const f32x4 t0 = (y0 - cs.x) * cs.y * g0 + b0 + p0 * v0, t1 = (y1 - cs.x) * cs.y * g1v + b1v + p1 * v1;
                    const f32x8 tf = (f32x8){t0[0], t0[1], t0[2], t0[3], t1[0], t1[1], t1[2], t1[3]};
                    st_out((u32x4*)((_Float16*)SG + off + bj * HALF), __builtin_bit_cast(u32x4, __builtin_convertvector(tf, h16x8))); } }
#else
            f32x4 bv[2][2];
#pragma unroll
            for (int bj = 0; bj < 2; ++bj)
#pragma unroll
                for (int n = 0; n < 2; ++n) bv[bj][n] = *(const f32x4*)((const char*)bgate + 4u * (unsigned)(colg + bj * HALF + 4 * n));
#if PSG
            u32x4 pq[2][2];
#pragma unroll
            for (int d = 0; d < 2; ++d) { const unsigned o = 2u * ((unsigned)UPROW(d >> 2, d & 3) * 2048u + (unsigned)colg); pq[d][0] = *(const u32x4*)((const char*)PPr + o); pq[d][1] = *(const u32x4*)((const char*)PPr + (o + 2u * HALF)); }
#pragma unroll
            for (int i = 0; i < 8; ++i) { const int ai = i >> 2, m = i & 3; const unsigned ro = 2u * ((unsigned)UPROW(ai, m) * 2048u + (unsigned)colg);
                const u32x4 cp0 = pq[i & 1][0], cp1 = pq[i & 1][1];
                if (i + 2 < 8) { const unsigned o = 2u * ((unsigned)UPROW((i + 2) >> 2, (i + 2) & 3) * 2048u + (unsigned)colg); pq[i & 1][0] = *(const u32x4*)((const char*)PPr + o); pq[i & 1][1] = *(const u32x4*)((const char*)PPr + (o + 2u * HALF)); }
#pragma unroll
                for (int bj = 0; bj < 2; ++bj) { f32x4 v0 = A(ai, bj, m, 0) + bv[bj][0], v1 = A(ai, bj, m, 1) + bv[bj][1]; const u32x4 pp = bj ? cp1 : cp0;
#pragma unroll
                    for (int j = 0; j < 4; ++j) { v0[j] = sigmoidf_(v0[j]); v1[j] = sigmoidf_(v1[j]); }
                    v0[0] *= __uint_as_float(pp.x << 16); v0[1] *= __uint_as_float(pp.x & 0xffff0000u); v0[2] *= __uint_as_float(pp.y << 16); v0[3] *= __uint_as_float(pp.y & 0xffff0000u);
                    v1[0] *= __uint_as_float(pp.z << 16); v1[1] *= __uint_as_float(pp.z & 0xffff0000u); v1[2] *= __uint_as_float(pp.w << 16); v1[3] *= __uint_as_float(pp.w & 0xffff0000u);
                    st_out((u32x4*)((char*)SG + (ro + 2u * (unsigned)(bj * HALF))), (u32x4)(pack8(v0, v1))); } }
#else
#pragma unroll
            for (int ai = 0; ai < 2; ++ai)
#pragma unroll
                for (int m = 0; m < 4; ++m) { bf16_t* rowp = (bf16_t*)((char*)SG + 2u * ((unsigned)UPROW(ai, m) * 2048u + (unsigned)colg));
#pragma unroll
                    for (int bj = 0; bj < 2; ++bj) { f32x4 v0 = A(ai, bj, m, 0) + bv[bj][0], v1 = A(ai, bj, m, 1) + bv[bj][1];
#pragma unroll
                        for (int j = 0; j < 4; ++j) { v0[j] = sigmoidf_(v0[j]); v1[j] = sigmoidf_(v1[j]); }
                        st_out((u32x4*)(rowp + bj * HALF), (u32x4)(pack8(v0, v1))); } }
#endif
#endif
        }
    }
};

typedef EpiUpConvT<false> EpiUpConv;
#if UP_PREK && ROWP
template <> struct PreK<EpiUpConvT<true>> { static constexpr bool value = true; };
#endif
#if RELAX_UP
template <> struct RelaxW<EpiUpConvT<true>> { static constexpr int value = 32; };
#endif
#if ROWP
static_assert(!TFOLD, "ROWP: the TFOLD gate-tile path still uses the natural row order");
template <> struct PermA<EpiUpConvT<true>> { static constexpr bool value = true; };
template <> struct PermA<EpiUpConvT<false>> { static constexpr bool value = true; };
#endif
struct EpiPlain {
    static constexpr bool PERM = true, AFTER_DRAIN = false;
    bf16_t* O;
    __device__ __forceinline__ void operator()(const f32x4 (&acc)[2][2][4][2], const Unit& u, int wr, int wc, int fr, int fq) const {
        const int row0 = u.pm * BM + wr * 64 + fr, cwp = u.pn * BM + wc * 32 + 8 * fq;
#pragma unroll
        for (int ai = 0; ai < 2; ++ai)
#pragma unroll
            for (int m = 0; m < 4; ++m) { bf16_t* rowp = O + (size_t)(row0 + ai * HALF + m * 16) * 2048 + cwp;
#pragma unroll
                for (int bj = 0; bj < 2; ++bj) st_out((u32x4*)(rowp + bj * HALF), (u32x4)(pack8(acc[ai][bj][m][0], acc[ai][bj][m][1]))); }
    }
};
struct EpiDown {
    static constexpr bool PERM = false, AFTER_DRAIN = false;
    const float* base; float* Y; const bf16_t* PP; const bf16_t* SG; float alpha;
    __device__ __forceinline__ void operator()(const f32x4 (&acc)[2][2][4][2], const Unit& u, int wr, int wc, int fr, int fq) const {
        const int row0 = u.pm * BM + wr * 64 + fr, col0 = u.pn * BM + wc * 32 + 4 * fq;
#pragma unroll
        for (int ai = 0; ai < 2; ++ai)
#pragma unroll
            for (int m = 0; m < 4; ++m) { const size_t off = (size_t)(row0 + ai * HALF + m * 16) * 2048 + col0;
#pragma unroll
                for (int bj = 0; bj < 2; ++bj)
#pragma unroll
                    for (int n = 0; n < 2; ++n) { const size_t o = off + bj * HALF + n * 16; const u32x2 pp = *(const u32x2*)(PP + o), sg = *(const u32x2*)(SG + o);
                        f32x4 pl; pl[0] = __uint_as_float(pp.x << 16) * __uint_as_float(sg.x << 16); pl[1] = __uint_as_float(pp.x & 0xffff0000u) * __uint_as_float(sg.x & 0xffff0000u);
                        pl[2] = __uint_as_float(pp.y << 16) * __uint_as_float(sg.y << 16); pl[3] = __uint_as_float(pp.y & 0xffff0000u) * __uint_as_float(sg.y & 0xffff0000u);
                        st_out((f32x4*)(Y + o), (f32x4)(acc[ai][bj][m][n] + *(const f32x4*)(base + o) * alpha + pl)); } }
    }
};

template <bool PLE_> struct EpiResidLN {
    static constexpr bool PERM = false, AFTER_DRAIN = false;
    float* Y; float* Yout; const float* stats; const float* g; const float* b; const bf16_t* PP; const bf16_t* SG; float alpha;
    __device__ __forceinline__ void operator()(const f32x4 (&acc)[2][2][4][2], const Unit& u, int wr, int wc, int fr, int fq) const {
        const int row0 = u.pm * BM + wr * 64 + fr, col0 = u.pn * BM + wc * 32 + 4 * fq;
        f32x4 g4[2][2], b4[2][2];
#pragma unroll
        for (int bj = 0; bj < 2; ++bj)
#pragma unroll
            for (int n = 0; n < 2; ++n) { g4[bj][n] = *(const f32x4*)(g + col0 + bj * HALF + n * 16) * alpha; b4[bj][n] = *(const f32x4*)(b + col0 + bj * HALF + n * 16) * alpha; }
        f32x4 cy[2][2], ny[2][2]; f32x2 cst, nst;
        { const size_t off = (size_t)row0 * 2048 + col0; cst = *(const f32x2*)(stats + 2 * (size_t)row0);
#pragma unroll
          for (int bj = 0; bj < 2; ++bj)
#pragma unroll
              for (int n = 0; n < 2; ++n) cy[bj][n] = *(const f32x4*)(Y + off + bj * HALF + n * 16); }
#pragma unroll
        for (int i = 0; i < 8; ++i) { const int ai = i >> 2, m = i & 3; const size_t off = (size_t)(row0 + ai * HALF + m * 16) * 2048 + col0;
            if (i < 7) { const int rn = row0 + ((i + 1) >> 2) * HALF + ((i + 1) & 3) * 16; const size_t offn = (size_t)rn * 2048 + col0; nst = *(const f32x2*)(stats + 2 * (size_t)rn);
#pragma unroll
                for (int bj = 0; bj < 2; ++bj)
#pragma unroll
                    for (int n = 0; n < 2; ++n) ny[bj][n] = *(const f32x4*)(Y + offn + bj * HALF + n * 16); }
#pragma unroll
            for (int bj = 0; bj < 2; ++bj)
#pragma unroll
                for (int n = 0; n < 2; ++n) { const size_t o = off + bj * HALF + n * 16;
                    f32x4 v = acc[ai][bj][m][n] + (cy[bj][n] - cst.x) * cst.y * g4[bj][n] + b4[bj][n];
                    if (PLE_) { const u32x2 pp = *(const u32x2*)(PP + o), sg = *(const u32x2*)(SG + o);
                        v[0] += __uint_as_float(pp.x << 16) * __uint_as_float(sg.x << 16); v[1] += __uint_as_float(pp.x & 0xffff0000u) * __uint_as_float(sg.x & 0xffff0000u);
                        v[2] += __uint_as_float(pp.y << 16) * __uint_as_float(sg.y << 16); v[3] += __uint_as_float(pp.y & 0xffff0000u) * __uint_as_float(sg.y & 0xffff0000u); }
                    st_out((f32x4*)(Yout + o), (f32x4)(v)); }
#pragma unroll
            for (int bj = 0; bj < 2; ++bj)
#pragma unroll
                for (int n = 0; n < 2; ++n) cy[bj][n] = ny[bj][n];
            cst = nst; }
    }
};

template <bool LNBASE, bool PLE_, bool STATS> struct EpiRes2 {
    static constexpr bool PERM = true, AFTER_DRAIN = false;
    const float* base; float* Y; bf16_t* YB; float* pstat; const float* stats; const float* g; const float* b; const bf16_t* PP; const bf16_t* SG; float alpha;
    __device__ __forceinline__ void operator()(const f32x4 (&acc)[2][2][4][2], const Unit& u, int wr, int wc, int fr, int fq) const {
        const int row0 = u.pm * BM + wr * 64 + fr, col0 = u.pn * BM + wc * 32 + 8 * fq, lane = fq * 16 + fr;
        const float* src = LNBASE ? (const float*)Y : base;
        f32x4 g4[2][2], b4[2][2];
        if (LNBASE) {
#pragma unroll
            for (int bj = 0; bj < 2; ++bj)
#pragma unroll
                for (int n = 0; n < 2; ++n) { g4[bj][n] = *(const f32x4*)(g + col0 + bj * HALF + 4 * n) * alpha; b4[bj][n] = *(const f32x4*)(b + col0 + bj * HALF + 4 * n) * alpha; } }
        f32x4 cy[2][2], ny[2][2]; f32x2 cst = (f32x2){0.f, 1.f}, nst = (f32x2){0.f, 1.f};
        { const size_t off = (size_t)row0 * 2048 + col0; if (LNBASE) cst = *(const f32x2*)(stats + 2 * (size_t)row0);
#pragma unroll
          for (int bj = 0; bj < 2; ++bj)
#pragma unroll
              for (int n = 0; n < 2; ++n) cy[bj][n] = *(const f32x4*)(src + off + bj * HALF + 4 * n); }
#pragma unroll
        for (int i = 0; i < 8; ++i) { const int ai = i >> 2, m = i & 3, row = row0 + ai * HALF + m * 16; const size_t off = (size_t)row * 2048 + col0;
            if (i < 7) { const int rn = row0 + ((i + 1) >> 2) * HALF + ((i + 1) & 3) * 16; const size_t offn = (size_t)rn * 2048 + col0; if (LNBASE) nst = *(const f32x2*)(stats + 2 * (size_t)rn);
#pragma unroll
                for (int bj = 0; bj < 2; ++bj)
#pragma unroll
                    for (int n = 0; n < 2; ++n) ny[bj][n] = *(const f32x4*)(src + offn + bj * HALF + 4 * n); }
            float s1 = 0.f, s2 = 0.f;
#pragma unroll
            for (int bj = 0; bj < 2; ++bj) { f32x4 v[2];
#pragma unroll
                for (int n = 0; n < 2; ++n) v[n] = LNBASE ? acc[ai][bj][m][n] + (cy[bj][n] - cst.x) * cst.y * g4[bj][n] + b4[bj][n] : acc[ai][bj][m][n] + cy[bj][n] * alpha;
                if (PLE_) { const u32x4 pp = *(const u32x4*)(PP + off + bj * HALF), sg = *(const u32x4*)(SG + off + bj * HALF);
                    v[0][0] += __uint_as_float(pp.x << 16) * __uint_as_float(sg.x << 16); v[0][1] += __uint_as_float(pp.x & 0xffff0000u) * __uint_as_float(sg.x & 0xffff0000u);
                    v[0][2] += __uint_as_float(pp.y << 16) * __uint_as_float(sg.y << 16); v[0][3] += __uint_as_float(pp.y & 0xffff0000u) * __uint_as_float(sg.y & 0xffff0000u);
                    v[1][0] += __uint_as_float(pp.z << 16) * __uint_as_float(sg.z << 16); v[1][1] += __uint_as_float(pp.z & 0xffff0000u) * __uint_as_float(sg.z & 0xffff0000u);
                    v[1][2] += __uint_as_float(pp.w << 16) * __uint_as_float(sg.w << 16); v[1][3] += __uint_as_float(pp.w & 0xffff0000u) * __uint_as_float(sg.w & 0xffff0000u); }
                st_out((f32x4*)(Y + off + bj * HALF), (f32x4)(v[0])); st_out((f32x4*)(Y + off + bj * HALF + 4), (f32x4)(v[1]));
                if (STATS) { st_out((u32x4*)(YB + off + bj * HALF), (u32x4)(pack8(v[0], v[1])));
#pragma unroll
                    for (int n = 0; n < 2; ++n) { s1 += (v[n][0] + v[n][1]) + (v[n][2] + v[n][3]); s2 += (v[n][0] * v[n][0] + v[n][1] * v[n][1]) + (v[n][2] * v[n][2] + v[n][3] * v[n][3]); } } }
            if (STATS) {
                s1 += __builtin_bit_cast(float, __builtin_amdgcn_ds_bpermute((lane ^ 16) << 2, __builtin_bit_cast(int, s1))); s2 += __builtin_bit_cast(float, __builtin_amdgcn_ds_bpermute((lane ^ 16) << 2, __builtin_bit_cast(int, s2)));
                s1 += __builtin_bit_cast(float, __builtin_amdgcn_ds_bpermute((lane ^ 32) << 2, __builtin_bit_cast(int, s1))); s2 += __builtin_bit_cast(float, __builtin_amdgcn_ds_bpermute((lane ^ 32) << 2, __builtin_bit_cast(int, s2)));
                #if PST_T
                if (fq == 0) *(f32x2*)(pstat + ((size_t)(u.pn * 4 + wc) * 16384 + row) * 2) = (f32x2){s1, s2}; }
#else
                if (fq == 0) *(f32x2*)(pstat + ((size_t)row * 32 + u.pn * 4 + wc) * 2) = (f32x2){s1, s2}; }
#endif
#pragma unroll
            for (int bj = 0; bj < 2; ++bj)
#pragma unroll
                for (int n = 0; n < 2; ++n) cy[bj][n] = ny[bj][n];
            cst = nst; }
    }
};

struct EpiNull {
    static constexpr bool PERM = true, AFTER_DRAIN = false;
    __device__ __forceinline__ void operator()(const f32x4 (&acc)[2][2][4][2], const Unit&, int, int, int, int) const {
#pragma unroll
        for (int i = 0; i < 32; ++i) asm volatile("" :: "v"(acc[i >> 4][(i >> 3) & 1][(i >> 1) & 3][i & 1]));
    }
};
template <bool LNBASE, bool PLE_, bool TB = false> struct EpiRes3 {
    static constexpr bool PERM = true, AFTER_DRAIN = false;
    const float* base; float* Y; bf16_t* YB; _Float16* YH; float* pstat; const float* stats; const float* g; const float* b; const bf16_t* PP; const bf16_t* SG;
#if defined(PROBE_DUP) && (PROBE_DUP == 42 || PROBE_DUP == 43)
    _Float16* YHw;
#define EPIRES3_YHW YHw
#else
#define EPIRES3_YHW YH
#endif
    float alpha;
    static constexpr bool SEEDED = PLE_ && !TB && (SEED_PLE != 0);
    __device__ __forceinline__ void seed_issue(const Unit& u, int q, int wr, int wc, int fr, int fq, u32x4& d0, u32x4& d1) const {
        const int i = q >> 1, bj = q & 1; const unsigned off = (unsigned)(u.pm * BM + wr * 64 + fr + (i >> 2) * HALF + (i & 3) * 16) * 2048u + (unsigned)(u.pn * BM + wc * 32 + 8 * fq + bj * HALF);
        const unsigned ob = 2u * off;
        asm volatile("global_load_dwordx4 %0, %2, %3\n\tglobal_load_dwordx4 %1, %2, %4" : "=&v"(d0), "=&v"(d1) : "v"(ob), "s"(PP), "s"(SG) : "memory");
    }
    __device__ __forceinline__ void seed_wait(u32x4& d0, u32x4& d1) const { asm volatile("s_waitcnt vmcnt(16)" : "+v"(d0), "+v"(d1) :: "memory"); }
    template <int Q> __device__ __forceinline__ void seed_add1(f32x4 (&acc)[2][2][4][2], const u32x4 pp, const u32x4 sg) const {
        constexpr int ai = Q >> 3, m = (Q >> 1) & 3, bj = Q & 1;
        f32x4 a0 = acc[ai][bj][m][0], a1 = acc[ai][bj][m][1];
        a0[0] += __uint_as_float(pp.x << 16) * __uint_as_float(sg.x << 16); a0[1] += __uint_as_float(pp.x & 0xffff0000u) * __uint_as_float(sg.x & 0xffff0000u);
        a0[2] += __uint_as_float(pp.y << 16) * __uint_as_float(sg.y << 16); a0[3] += __uint_as_float(pp.y & 0xffff0000u) * __uint_as_float(sg.y & 0xffff0000u);
        a1[0] += __uint_as_float(pp.z << 16) * __uint_as_float(sg.z << 16); a1[1] += __uint_as_float(pp.z & 0xffff0000u) * __uint_as_float(sg.z & 0xffff0000u);
        a1[2] += __uint_as_float(pp.w << 16) * __uint_as_float(sg.w << 16); a1[3] += __uint_as_float(pp.w & 0xffff0000u) * __uint_as_float(sg.w & 0xffff0000u);
        acc[ai][bj][m][0] = a0; acc[ai][bj][m][1] = a1;
    }
    __device__ __forceinline__ void seed_add(f32x4 (&acc)[2][2][4][2], int q, const u32x4 pp, const u32x4 sg) const {
        switch (q) {
            case 0: seed_add1<0>(acc, pp, sg); break; case 1: seed_add1<1>(acc, pp, sg); break; case 2: seed_add1<2>(acc, pp, sg); break; case 3: seed_add1<3>(acc, pp, sg); break;
            case 4: seed_add1<4>(acc, pp, sg); break; case 5: seed_add1<5>(acc, pp, sg); break; case 6: seed_add1<6>(acc, pp, sg); break; case 7: seed_add1<7>(acc, pp, sg); break;
            case 8: seed_add1<8>(acc, pp, sg); break; case 9: seed_add1<9>(acc, pp, sg); break; case 10: seed_add1<10>(acc, pp, sg); break; case 11: seed_add1<11>(acc, pp, sg); break;
            case 12: seed_add1<12>(acc, pp, sg); break; case 13: seed_add1<13>(acc, pp, sg); break; case 14: seed_add1<14>(acc, pp, sg); break; default: seed_add1<15>(acc, pp, sg); break; }
    }
    __device__ __forceinline__ void operator()(const f32x4 (&acc)[2][2][4][2], const Unit& u, int wr, int wc, int fr, int fq) const {
        const int row0 = u.pm * BM + wr * 64 + fr, col0 = u.pn * BM + wc * 32 + 8 * fq, lane = fq * 16 + fr;
        const _Float16* const src = TB ? (const _Float16*)PP : (const _Float16*)YH;
#if GB_LDS
        extern __shared__ __attribute__((aligned(16))) unsigned char lds_raw[];
        PG8_LAS unsigned char* const gbs_ = (PG8_LAS unsigned char*)lds_raw + 135168 + (wc * 2 + wr) * 1024;
        if (LNBASE && !TB) { const int t_ = lane & 15, sel_ = lane >> 4;
            if (sel_ < 2) { const f32x4 v_ = *(const f32x4*)((sel_ ? b : g) + u.pn * BM + wc * 32 + (t_ >> 3) * HALF + 4 * (t_ & 7)) * alpha; *(PG8_LAS f32x4*)(gbs_ + 256 * sel_ + 16 * t_) = v_; }
            asm volatile("s_waitcnt lgkmcnt(0)" ::: "memory"); }
#else
        f32x4 g4[2][2], b4[2][2];
        if (LNBASE && !TB) {
#pragma unroll
            for (int bj = 0; bj < 2; ++bj)
#pragma unroll
                for (int n = 0; n < 2; ++n) { g4[bj][n] = *(const f32x4*)(g + col0 + bj * HALF + 4 * n) * alpha; b4[bj][n] = *(const f32x4*)(b + col0 + bj * HALF + 4 * n) * alpha; } }
#endif
        constexpr bool PF = PLE_ && !TB && (PLE_PF != 0);
#if GB_LDS
        constexpr int PD = LNBASE ? EPI_PD : 2;
#else
        constexpr int PD = LNBASE ? (PF ? 1 : EPI_PD) : 2;
#endif
        u32x4 ybq[PD][2]; f32x2 stq[PD]; f32x4 yfq[PD][2][2];
        u32x4 ppq[1][2], sgq[1][2];
#pragma unroll
        for (int d = 0; d < PD; ++d) { const int rn = row0 + (d >> 2) * HALF + (d & 3) * 16; const unsigned offn = (unsigned)rn * 2048u + (unsigned)col0;
            if (PF && d == 0) { ppq[0][0] = *(const u32x4*)(PP + offn); ppq[0][1] = *(const u32x4*)(PP + offn + HALF); sgq[0][0] = *(const u32x4*)(SG + offn); sgq[0][1] = *(const u32x4*)(SG + offn + HALF); }
            if (LNBASE) { if (!TB) stq[d] = *(const f32x2*)(stats + 2u * (unsigned)rn); ybq[d][0] = ld_stream((const u32x4*)(src + offn)); ybq[d][1] = ld_stream((const u32x4*)(src + offn + HALF)); }
            else {
#pragma unroll
                for (int bj = 0; bj < 2; ++bj)
#pragma unroll
                    for (int n = 0; n < 2; ++n) yfq[d][bj][n] = *(const f32x4*)(base + offn + bj * HALF + 4 * n); } }
#pragma unroll
        for (int i = 0; i < 8; ++i) { const int ai = i >> 2, m = i & 3, row = row0 + ai * HALF + m * 16; const unsigned off = (unsigned)row * 2048u + (unsigned)col0;
            const int sl = i % PD;
            u32x4 cyb[2]; f32x4 cyf[2][2]; f32x2 cst = (f32x2){0.f, 1.f};
            u32x4 cpp[2], csg[2];
            if (PF) { cpp[0] = ppq[0][0]; cpp[1] = ppq[0][1]; csg[0] = sgq[0][0]; csg[1] = sgq[0][1];
                if (i + 1 < 8) { const unsigned o1 = (unsigned)(row0 + ((i + 1) >> 2) * HALF + ((i + 1) & 3) * 16) * 2048u + (unsigned)col0;
                    ppq[0][0] = *(const u32x4*)(PP + o1); ppq[0][1] = *(const u32x4*)(PP + o1 + HALF); sgq[0][0] = *(const u32x4*)(SG + o1); sgq[0][1] = *(const u32x4*)(SG + o1 + HALF); } }
            if (LNBASE) { cyb[0] = ybq[sl][0]; cyb[1] = ybq[sl][1]; if (!TB) cst = stq[sl]; }
            else {
#pragma unroll
                for (int bj = 0; bj < 2; ++bj)
#pragma unroll
                    for (int n = 0; n < 2; ++n) cyf[bj][n] = yfq[sl][bj][n]; }
            if (i + PD < 8) { const int rn = row0 + ((i + PD) >> 2) * HALF + ((i + PD) & 3) * 16; const unsigned offn = (unsigned)rn * 2048u + (unsigned)col0;
                if (LNBASE) { if (!TB) stq[sl] = *(const f32x2*)(stats + 2u * (unsigned)rn); ybq[sl][0] = ld_stream((const u32x4*)(src + offn)); ybq[sl][1] = ld_stream((const u32x4*)(src + offn + HALF)); }
                else {
#pragma unroll
                    for (int bj = 0; bj < 2; ++bj)
#pragma unroll
                        for (int n = 0; n < 2; ++n) yfq[sl][bj][n] = *(const f32x4*)(base + offn + bj * HALF + 4 * n); } }
            float s1 = 0.f, s2 = 0.f;
#pragma unroll
            for (int bj = 0; bj < 2; ++bj) { f32x4 v[2];
#if GB_LDS
                f32x4 g4[2][2], b4[2][2];
                if (LNBASE && !TB) { g4[bj][0] = *(const PG8_LAS f32x4*)(gbs_ + 4 * (bj * 32 + 8 * fq)); g4[bj][1] = *(const PG8_LAS f32x4*)(gbs_ + 4 * (bj * 32 + 8 * fq + 4));
                    b4[bj][0] = *(const PG8_LAS f32x4*)(gbs_ + 256 + 4 * (bj * 32 + 8 * fq)); b4[bj][1] = *(const PG8_LAS f32x4*)(gbs_ + 256 + 4 * (bj * 32 + 8 * fq + 4)); }
#endif
                if (LNBASE) { const f32x8 yf = __builtin_convertvector(__builtin_bit_cast(h16x8, cyb[bj]), f32x8);
                    const f32x4 y0 = (f32x4){yf[0], yf[1], yf[2], yf[3]}, y1 = (f32x4){yf[4], yf[5], yf[6], yf[7]};
                    if (TB) { v[0] = acc[ai][bj][m][0] + y0; v[1] = acc[ai][bj][m][1] + y1; }
                    else { v[0] = acc[ai][bj][m][0] + (y0 - cst.x) * cst.y * g4[bj][0] + b4[bj][0]; v[1] = acc[ai][bj][m][1] + (y1 - cst.x) * cst.y * g4[bj][1] + b4[bj][1]; } }
                else { v[0] = acc[ai][bj][m][0] + cyf[bj][0] * alpha; v[1] = acc[ai][bj][m][1] + cyf[bj][1] * alpha; }
#if PSG
                if (PLE_ && !TB) { const u32x4 ps = ld_stream((const u32x4*)(SG + off + bj * HALF));
                    v[0][0] += __uint_as_float(ps.x << 16); v[0][1] += __uint_as_float(ps.x & 0xffff0000u); v[0][2] += __uint_as_float(ps.y << 16); v[0][3] += __uint_as_float(ps.y & 0xffff0000u);
                    v[1][0] += __uint_as_float(ps.z << 16); v[1][1] += __uint_as_float(ps.z & 0xffff0000u); v[1][2] += __uint_as_float(ps.w << 16); v[1][3] += __uint_as_float(ps.w & 0xffff0000u); }
                else
#endif
                if (PLE_ && !TB && !SEEDED) { const u32x4 pp = PF ? cpp[bj] : ld_stream((const u32x4*)(PP + off + bj * HALF)), sg = PF ? csg[bj] : ld_stream((const u32x4*)(SG + off + bj * HALF));
                    v[0][0] += __uint_as_float(pp.x << 16) * __uint_as_float(sg.x << 16); v[0][1] += __uint_as_float(pp.x & 0xffff0000u) * __uint_as_float(sg.x & 0xffff0000u);
                    v[0][2] += __uint_as_float(pp.y << 16) * __uint_as_float(sg.y << 16); v[0][3] += __uint_as_float(pp.y & 0xffff0000u) * __uint_as_float(sg.y & 0xffff0000u);
                    v[1][0] += __uint_as_float(pp.z << 16) * __uint_as_float(sg.z << 16); v[1][1] += __uint_as_float(pp.z & 0xffff0000u) * __uint_as_float(sg.z & 0xffff0000u);
                    v[1][2] += __uint_as_float(pp.w << 16) * __uint_as_float(sg.w << 16); v[1][3] += __uint_as_float(pp.w & 0xffff0000u) * __uint_as_float(sg.w & 0xffff0000u); }
#if LAST_H
                const u32x4 pk = pack8(v[0], v[1]);
                if (!Y) st_out((u32x4*)(YB + off + bj * HALF), (u32x4)(pk));
#else
                if (Y) { st_out((f32x4*)(Y + off + bj * HALF), (f32x4)(v[0])); st_out((f32x4*)(Y + off + bj * HALF + 4), (f32x4)(v[1])); }
                const u32x4 pk = pack8(v[0], v[1]);
                st_out((u32x4*)(YB + off + bj * HALF), (u32x4)(pk));
#endif
                { const f32x8 vf = (f32x8){v[0][0], v[0][1], v[0][2], v[0][3], v[1][0], v[1][1], v[1][2], v[1][3]};
                  st_stream((u32x4*)(EPIRES3_YHW + off + bj * HALF), __builtin_bit_cast(u32x4, __builtin_convertvector(vf, h16x8))); }
                const f32x4 r0 = (f32x4){__uint_as_float(pk.x << 16), __uint_as_float(pk.x & 0xffff0000u), __uint_as_float(pk.y << 16), __uint_as_float(pk.y & 0xffff0000u)};
                const f32x4 r1 = (f32x4){__uint_as_float(pk.z << 16), __uint_as_float(pk.z & 0xffff0000u), __uint_as_float(pk.w << 16), __uint_as_float(pk.w & 0xffff0000u)};
                s1 += ((r0[0] + r0[1]) + (r0[2] + r0[3])) + ((r1[0] + r1[1]) + (r1[2] + r1[3]));
                s2 += ((r0[0] * r0[0] + r0[1] * r0[1]) + (r0[2] * r0[2] + r0[3] * r0[3])) + ((r1[0] * r1[0] + r1[1] * r1[1]) + (r1[2] * r1[2] + r1[3] * r1[3])); }
            s1 += __builtin_bit_cast(float, __builtin_amdgcn_ds_bpermute((lane ^ 16) << 2, __builtin_bit_cast(int, s1))); s2 += __builtin_bit_cast(float, __builtin_amdgcn_ds_bpermute((lane ^ 16) << 2, __builtin_bit_cast(int, s2)));
            s1 += __builtin_bit_cast(float, __builtin_amdgcn_ds_bpermute((lane ^ 32) << 2, __builtin_bit_cast(int, s1))); s2 += __builtin_bit_cast(float, __builtin_amdgcn_ds_bpermute((lane ^ 32) << 2, __builtin_bit_cast(int, s2)));
            #if PST_T
            if (fq == 0) *(f32x2*)(pstat + ((unsigned)(u.pn * 4 + wc) * 16384u + (unsigned)row) * 2u) = (f32x2){s1, s2}; }
#else
            if (fq == 0) *(f32x2*)(pstat + ((unsigned)row * 32u + (unsigned)(u.pn * 4 + wc)) * 2u) = (f32x2){s1, s2}; }
#endif
    }
};
#if SEED_PLE
template <> struct SeedK<EpiRes3<true, true, false>> { static constexpr bool value = true; };
#endif
struct EpiPle {
    static constexpr bool PERM = false, AFTER_DRAIN = false;
    const bf16_t* SG; float* Y;
    __device__ __forceinline__ void operator()(const f32x4 (&acc)[2][2][4][2], const Unit& u, int wr, int wc, int fr, int fq) const {
        const int row0 = u.pm * BM + wr * 64 + fr, col0 = u.pn * BM + wc * 32 + 4 * fq;
#pragma unroll
        for (int ai = 0; ai < 2; ++ai)
#pragma unroll
            for (int m = 0; m < 4; ++m) { const size_t off = (size_t)(row0 + ai * HALF + m * 16) * 2048 + col0;
#pragma unroll
                for (int bj = 0; bj < 2; ++bj)
#pragma unroll
                    for (int n = 0; n < 2; ++n) { const size_t o = off + bj * HALF + n * 16; const u32x2 sg = *(const u32x2*)(SG + o);
                        f32x4 g; g[0] = __uint_as_float(sg.x << 16); g[1] = __uint_as_float(sg.x & 0xffff0000u); g[2] = __uint_as_float(sg.y << 16); g[3] = __uint_as_float(sg.y & 0xffff0000u);
                        st_out((f32x4*)(Y + o), (f32x4)(acc[ai][bj][m][n] * g)); } }
    }
};
template <class Epi, class Sched, bool ALIGN_EPI = false, bool SP2 = false>
__device__ __forceinline__ void gemm_phase(PG8_LAS unsigned char* lds, const Gemm g, const Sched& S, const Epi& E, const int wid_in) {
    int lane_; asm volatile("v_mbcnt_lo_u32_b32 %0, -1, 0\n\tv_mbcnt_hi_u32_b32 %0, -1, %0" : "=v"(lane_)); const int wid = wid_in, lane = lane_, tid = wid * 64 + lane, wr = wid >> 2, wc = wid & 3, fr = lane & 15, fq = lane >> 4;
    const int K = g.K, nt = K / BK, lda = g.tiledA ? BK : (g.lda ? g.lda : K), ldb = g.tiledB ? BK : (g.ldb ? g.ldb : K);
    unsigned voffA[2], voffB[2];
#pragma unroll
    for (int i = 0; i < 2; ++i) { int R, C; stage_rc(tid * 16 + i * 8192, R, C); const int Rb = Epi::PERM ? ((R & ~31) + perm32(R & 31)) : R;
        const int Ra = PermA<Epi>::value ? ((R & 64) | ((R & 15) << 2) | ((R >> 4) & 3)) : R;
        voffA[i] = (unsigned)(Ra * lda + C) * 2u; voffB[i] = (unsigned)(Rb * ldb + C) * 2u; }
    const size_t kstepA = g.tiledA ? (size_t)BM * BK * 2 : (size_t)(BK * 2), kstepB = g.tiledB ? (size_t)BM * BK * 2 : (size_t)(BK * 2);
    const size_t hstepA = (size_t)HALF * lda * 2, hstepB = (size_t)HALF * ldb * 2;
    const size_t tstepA = g.tiledA ? (size_t)BM * K * 2 : 2 * hstepA, tstepB = g.tiledB ? (size_t)BM * K * 2 : 2 * hstepB;
    const unsigned ldsw = (unsigned)wid * 1024u;
    const int aoff = lds_byte(wr * 64 + fr, fq * 8), boff = lds_byte(wc * 32 + fr, fq * 8);
#define PG8_SA(b, h) (((b) * 2 + (h)) * HTB)
#define PG8_SB(b, h) ((4 + (b) * 2 + (h)) * HTB)
#define PG8_STAGE(bufoff, gbase, voff) do { _Pragma("unroll") for (int _i = 0; _i < 2; ++_i) \
        __builtin_amdgcn_global_load_lds((const unsigned*)((const char*)(gbase) + (voff)[_i]), (PG8_LAS unsigned*)(lds + (bufoff) + ldsw + _i * 8192), 16, 0, 0); } while (0)
#define PG8_LDA(dst, b, h) do { _Pragma("unroll") for (int m = 0; m < 4; ++m) _Pragma("unroll") for (int k = 0; k < 2; ++k) dst[m][k] = *(const PG8_LAS bf16x8*)(lds + PG8_SA(b, h) + aoff + m * 2048 + k * 1024); } while (0)
#define PG8_LDB(dst, b, h) do { _Pragma("unroll") for (int n = 0; n < 2; ++n) _Pragma("unroll") for (int k = 0; k < 2; ++k) dst[n][k] = *(const PG8_LAS bf16x8*)(lds + PG8_SB(b, h) + boff + n * 2048 + k * 1024); } while (0)
#define PG8_MMA(ai, bj, At, Bt) do { __builtin_amdgcn_s_setprio(1); _Pragma("unroll") for (int m = 0; m < 4; ++m) _Pragma("unroll") for (int n = 0; n < 2; ++n) _Pragma("unroll") for (int k = 0; k < 2; ++k) \
        acc[ai][bj][m][n] = __builtin_amdgcn_mfma_f32_16x16x32_bf16(Bt[n][k], At[m][k], acc[ai][bj][m][n], 0, 0, 0); __builtin_amdgcn_s_setprio(0); } while (0)
#define PG8_WAIT_V(n) asm volatile("s_waitcnt vmcnt(" #n ")" ::: "memory")
#define PG8_WAIT_L(n) asm volatile("s_waitcnt lgkmcnt(" #n ")" ::: "memory")
#define PG8_BAR __builtin_amdgcn_s_barrier()
#define PG8_SCHED __builtin_amdgcn_sched_barrier(0)
    Unit cur, nxt; int ui = 0;
    if (!S.next(0, cur)) return;
    f32x4 acc[2][2][4][2];
#pragma unroll
    for (int a = 0; a < 2; ++a)
#pragma unroll
        for (int b = 0; b < 2; ++b)
#pragma unroll
            for (int m = 0; m < 4; ++m)
#pragma unroll
                for (int n = 0; n < 2; ++n) acc[a][b][m][n] = (f32x4){0.f, 0.f, 0.f, 0.f};
    bf16x8 At[4][2], B0[2][2], B1[2][2];
    const char* cA = (const char*)g.A + (size_t)cur.pm * tstepA; const char* cB = (const char*)g.Bt + (size_t)cur.pn * tstepB;
    S.a_ready(cur);
    if constexpr (PreK<Epi>::value) E.pre_phase(cur, wr, wc, lane);
    if constexpr (SP2) {
        PG8_STAGE(PG8_SB(0, 0), cB, voffB); PG8_STAGE(PG8_SB(0, 1), cB + hstepB, voffB); PG8_STAGE(PG8_SA(0, 0), cA, voffA); PG8_STAGE(PG8_SA(0, 1), cA + hstepA, voffA);
        if (wr == 1) PG8_BAR;
        PG8_WAIT_V(2); PG8_BAR;
        PG8_STAGE(PG8_SB(1, 0), cB + kstepB, voffB); PG8_STAGE(PG8_SA(1, 0), cA + kstepA, voffA); PG8_STAGE(PG8_SB(1, 1), cB + hstepB + kstepB, voffB);
        PG8_WAIT_V(6); PG8_BAR;
    } else {
        PG8_STAGE(PG8_SB(0, 0), cB, voffB); PG8_STAGE(PG8_SA(0, 0), cA, voffA); PG8_STAGE(PG8_SB(0, 1), cB + hstepB, voffB); PG8_STAGE(PG8_SA(0, 1), cA + hstepA, voffA);
        if (wr == 1) PG8_BAR;
        PG8_WAIT_V(4); PG8_BAR;
        PG8_STAGE(PG8_SB(1, 0), cB + kstepB, voffB); PG8_STAGE(PG8_SA(1, 0), cA + kstepA, voffA); PG8_STAGE(PG8_SB(1, 1), cB + hstepB + kstepB, voffB);
        PG8_WAIT_V(6); PG8_BAR;
    }
    long sA = (long)kstepA, sB = (long)kstepB;
    for (;;) {
        const bool has_next = S.next(ui + 1, nxt);
        const bool nrev = (KREV != 0) && has_next && ((ui + 1) & 1);
        const long nsA = has_next ? (nrev ? -(long)kstepA : (long)kstepA) : sA, nsB = has_next ? (nrev ? -(long)kstepB : (long)kstepB) : sB;
        const char* nA = has_next ? (const char*)g.A + (size_t)nxt.pm * tstepA + (nrev ? (size_t)(nt - 1) * kstepA : (size_t)0) : cA;
        const char* nB = has_next ? (const char*)g.Bt + (size_t)nxt.pn * tstepB + (nrev ? (size_t)(nt - 1) * kstepB : (size_t)0) : cB;
        for (int t = 0; t < nt; t += 2) {
            const bool last = (t == nt - 2);
            const char* a1 = cA + (long)(t + 1) * sA;
            const char* a2 = last ? nA : cA + (long)(t + 2) * sA; const char* b2 = last ? nB : cB + (long)(t + 2) * sB;
            const char* a3 = a2 + (last ? nsA : sA); const char* b3 = b2 + (last ? nsB : sB);
            if (last && has_next) S.a_ready(nxt);
            u32x4 sd0, sd1;
            if constexpr (SeedK<Epi>::value) { if ((t >> 1) < 16) E.seed_issue(cur, t >> 1, wr, wc, fr, fq, sd0, sd1); }
            if constexpr (SP2) {
            const int relax_ = __builtin_amdgcn_readfirstlane(((RelaxW<Epi>::value != 0) && t == 0 && ui > 0) ? 1 : 0);
            PG8_LDB(B0, 0, 0); PG8_LDB(B1, 0, 1); PG8_SCHED; PG8_LDA(At, 0, 0); PG8_STAGE(PG8_SA(1, 1), a1 + hstepA, voffA);
            if constexpr (RelaxW<Epi>::value != 0) asm volatile("s_cmp_eq_u32 %0, 0\n\ts_cbranch_scc1 .Lrwa%=\n\ts_waitcnt vmcnt(40)\n\ts_branch .Lrwb%=\n.Lrwa%=:\n\ts_waitcnt vmcnt(8)\n.Lrwb%=:" :: "s"(relax_) : "memory", "scc"); else PG8_WAIT_V(8);
            PG8_WAIT_L(0); PG8_BAR; PG8_MMA(0, 0, At, B0); PG8_MMA(0, 1, At, B1); PG8_BAR; PG8_SCHED;
            PG8_LDA(At, 0, 1); PG8_STAGE(PG8_SB(0, 0), b2, voffB); PG8_STAGE(PG8_SB(0, 1), b2 + hstepB, voffB); PG8_STAGE(PG8_SA(0, 0), a2, voffA);
            if constexpr (RelaxW<Epi>::value != 0) asm volatile("s_cmp_eq_u32 %0, 0\n\ts_cbranch_scc1 .Lrwa%=\n\ts_waitcnt vmcnt(40)\n\ts_branch .Lrwb%=\n.Lrwa%=:\n\ts_waitcnt vmcnt(8)\n.Lrwb%=:" :: "s"(relax_) : "memory", "scc"); else PG8_WAIT_V(8);
            PG8_WAIT_L(0); PG8_BAR; PG8_MMA(1, 0, At, B0); PG8_MMA(1, 1, At, B1); PG8_BAR; PG8_SCHED;
            PG8_LDB(B0, 1, 0); PG8_LDB(B1, 1, 1); PG8_SCHED; PG8_LDA(At, 1, 0); PG8_STAGE(PG8_SA(0, 1), a2 + hstepA, voffA);
            PG8_WAIT_V(8); PG8_WAIT_L(0); PG8_BAR; PG8_MMA(0, 0, At, B0); PG8_MMA(0, 1, At, B1); PG8_BAR; PG8_SCHED;
            PG8_LDA(At, 1, 1); PG8_STAGE(PG8_SB(1, 0), b3, voffB); PG8_STAGE(PG8_SB(1, 1), b3 + hstepB, voffB); PG8_STAGE(PG8_SA(1, 0), a3, voffA);
            PG8_WAIT_V(8); PG8_WAIT_L(0); PG8_BAR; PG8_MMA(1, 0, At, B0); PG8_MMA(1, 1, At, B1); PG8_BAR; PG8_SCHED;
            } else {
            PG8_LDB(B0, 0, 0); PG8_SCHED; PG8_LDA(At, 0, 0); PG8_STAGE(PG8_SA(1, 1), a1 + hstepA, voffA);
            PG8_WAIT_L(8); PG8_BAR; PG8_WAIT_L(0); PG8_MMA(0, 0, At, B0); PG8_BAR; PG8_SCHED;
            PG8_LDB(B1, 0, 1); PG8_STAGE(PG8_SB(0, 0), b2, voffB);
            PG8_BAR; PG8_WAIT_L(0); PG8_MMA(0, 1, At, B1); PG8_BAR;
            PG8_LDA(At, 0, 1); PG8_STAGE(PG8_SA(0, 0), a2, voffA);
            PG8_BAR; PG8_WAIT_L(0); PG8_MMA(1, 0, At, B0); PG8_BAR; PG8_SCHED;
            PG8_STAGE(PG8_SB(0, 1), b2 + hstepB, voffB);
            PG8_WAIT_V(6); PG8_BAR; PG8_MMA(1, 1, At, B1); PG8_BAR;
            PG8_LDB(B0, 1, 0); PG8_SCHED; PG8_LDA(At, 1, 0); PG8_STAGE(PG8_SA(0, 1), a2 + hstepA, voffA);
            PG8_WAIT_L(8); PG8_BAR; PG8_WAIT_L(0); PG8_MMA(0, 0, At, B0); PG8_BAR; PG8_SCHED;
            PG8_LDB(B1, 1, 1); PG8_STAGE(PG8_SB(1, 0), b3, voffB);
            PG8_BAR; PG8_WAIT_L(0); PG8_MMA(0, 1, At, B1); PG8_BAR;
            PG8_LDA(At, 1, 1); PG8_STAGE(PG8_SA(1, 0), a3, voffA);
            PG8_BAR; PG8_WAIT_L(0); PG8_MMA(1, 0, At, B0); PG8_BAR; PG8_SCHED;
            PG8_STAGE(PG8_SB(1, 1), b3 + hstepB, voffB);
            PG8_WAIT_V(6); PG8_BAR; PG8_MMA(1, 1, At, B1); PG8_BAR;
            }
            if constexpr (SeedK<Epi>::value) { if ((t >> 1) < 16) { E.seed_wait(sd0, sd1); E.seed_add(acc, t >> 1, sd0, sd1); } }
        }
        if constexpr (ALIGN_EPI) { if (wr == 0) PG8_BAR; }
        if constexpr (!Epi::AFTER_DRAIN) { E(acc, cur, wr, wc, fr, fq); S.done(cur); if constexpr (PreK<Epi>::value) { if (has_next) E.pre_next(nxt, wr, wc, lane); } }
        if (!has_next) break;
#pragma unroll
        for (int a = 0; a < 2; ++a)
#pragma unroll
            for (int b = 0; b < 2; ++b)
#pragma unroll
                for (int m = 0; m < 4; ++m)
#pragma unroll
                    for (int n = 0; n < 2; ++n) acc[a][b][m][n] = (f32x4){0.f, 0.f, 0.f, 0.f};
        cur = nxt; cA = nA; cB = nB; sA = nsA; sB = nsB; ++ui;
        if constexpr (ALIGN_EPI) { if (wr == 1) PG8_BAR; }
    }
    PG8_WAIT_V(0);
    if constexpr (!ALIGN_EPI) { if (wr == 0) PG8_BAR; }
    PG8_BAR;
    if constexpr (Epi::AFTER_DRAIN) { E.fused(acc, cur, wr, wc, fr, fq, lds, wid, lane); S.done(cur); }
#undef PG8_SA
#undef PG8_SB
#undef PG8_STAGE
#undef PG8_LDA
#undef PG8_LDB
#undef PG8_MMA
#undef PG8_WAIT_V
#undef PG8_WAIT_L
#undef PG8_BAR
#undef PG8_SCHED
}
}
#define LAS __attribute__((address_space(3)))
#define XB_TMO      128
#define XB_XCNT(j)  (256  + 64 * (j))
#define XB_XSUB(j)  (1280 + 64 * (j))
#define XB_XGEN(j)  (2304 + 64 * (j))
#define XB_TOP      3328
#define XB_TOPGEN   3392
#define XCD_BAR_WORDS 3456
#define XB_SPIN_CAP (1u << 18)

__device__ __forceinline__ unsigned xb_ld(unsigned* p)              { return __hip_atomic_load(p, __ATOMIC_RELAXED, __HIP_MEMORY_SCOPE_AGENT); }
__device__ __forceinline__ unsigned xb_add(unsigned* p, unsigned v) { return __hip_atomic_fetch_add(p, v, __ATOMIC_RELAXED, __HIP_MEMORY_SCOPE_AGENT); }
__device__ __forceinline__ unsigned xb_xcc_id() { return (unsigned)__builtin_amdgcn_s_getreg((3 << 11) | 20) & 0xFu; }
#define XB_SPIN(cond, bar) do { unsigned _sp = 0; while (cond) { __builtin_amdgcn_s_sleep(1); \
    if ((++_sp & 255u) == 0u) { if (xb_ld(&(bar)[XB_TMO])) break; if (_sp > XB_SPIN_CAP) { atomicAdd(&(bar)[XB_TMO], 1u); break; } } } } while (0)

struct XcdBarrier {
    unsigned* bar; unsigned x;
    volatile LAS unsigned* st;
};

__device__ __forceinline__ XcdBarrier xcd_barrier_post(unsigned* bar, volatile LAS unsigned* st) {
    XcdBarrier b; b.bar = bar; b.x = xb_xcc_id(); b.st = st;
    if (threadIdx.x == 0) (void)xb_add(&bar[XB_XCNT(b.x)], 1u);
    return b;
}
__device__ __forceinline__ void xcd_barrier_complete(unsigned* bar, unsigned x, unsigned& nloc, unsigned& nx) {
    const unsigned G = gridDim.x * gridDim.y * gridDim.z;
    unsigned sum, cnt, mine, sp = 0u;
    for (;;) {
        sum = 0u; cnt = 0u; mine = 0u;
#pragma unroll
        for (unsigned j = 0; j < 16; ++j) { const unsigned c = xb_ld(&bar[XB_XCNT(j)]); sum += c; cnt += (c > 0u) ? 1u : 0u; mine = (j == x) ? c : mine; }
        if (sum == G) break;
        __builtin_amdgcn_s_sleep(1);
        if ((++sp & 255u) == 0u) { if (xb_ld(&bar[XB_TMO])) break; if (sp > XB_SPIN_CAP) { atomicAdd(&bar[XB_TMO], 1u); break; } }
    }
    nloc = mine > 0u ? mine : 1u; nx = cnt > 0u ? cnt : 1u;
}

__device__ __forceinline__ void xcd_barrier(const XcdBarrier& b) {
    asm volatile("s_waitcnt vmcnt(0)" ::: "memory");
    __syncthreads();
    if (threadIdx.x == 0) {
        unsigned* bar = b.bar;
        __builtin_amdgcn_s_waitcnt(0);
        unsigned nloc = b.st[0], nx = b.st[1];
        if (nloc == 0u) { xcd_barrier_complete(bar, b.x, nloc, nx); b.st[0] = nloc; b.st[1] = nx; }
        const unsigned old = xb_add(&bar[XB_XSUB(b.x)], 1u);
        const unsigned gen = old / nloc;
        if (old + 1u == (gen + 1u) * nloc) {
            __builtin_amdgcn_fence(__ATOMIC_RELEASE, "agent");
            asm volatile("s_waitcnt vmcnt(0)" ::: "memory");
            const unsigned og = xb_add(&bar[XB_TOP], 1u);
            const unsigned tg = og / nx;
            if (og + 1u == (tg + 1u) * nx) xb_add(&bar[XB_TOPGEN], 1u);
            else XB_SPIN(xb_ld(&bar[XB_TOPGEN]) == tg, bar);
            __builtin_amdgcn_fence(__ATOMIC_ACQUIRE, "agent");
            xb_add(&bar[XB_XGEN(b.x)], 1u);
            asm volatile("s_waitcnt vmcnt(0)" ::: "memory");
        } else {
            XB_SPIN(xb_ld(&bar[XB_XGEN(b.x)]) == gen, bar);
            __builtin_amdgcn_fence(__ATOMIC_ACQUIRE, "agent");
            asm volatile("s_waitcnt vmcnt(0)" ::: "memory");
        }
    }
    __syncthreads();
}

__device__ __forceinline__ void xcd_barrier_local(const XcdBarrier& b) {
    asm volatile("s_waitcnt vmcnt(0)" ::: "memory");
    __syncthreads();
    if (threadIdx.x == 0) {
        unsigned* bar = b.bar;
        __builtin_amdgcn_s_waitcnt(0);
        unsigned nloc = b.st[0], nx = b.st[1];
        if (nloc == 0u) { xcd_barrier_complete(bar, b.x, nloc, nx); b.st[0] = nloc; b.st[1] = nx; }
        const unsigned old = xb_add(&bar[XB_XSUB(b.x)], 1u);
        const unsigned gen = old / nloc;
        if (old + 1u == (gen + 1u) * nloc) xb_add(&bar[XB_XGEN(b.x)], 1u);
        else XB_SPIN(xb_ld(&bar[XB_XGEN(b.x)]) == gen, bar);
        __builtin_amdgcn_fence(__ATOMIC_ACQUIRE, "agent");
        asm volatile("s_waitcnt vmcnt(0)" ::: "memory");
    }
    __syncthreads();
}
#define GAS __attribute__((address_space(1)))

typedef unsigned short bf16;
typedef float f32x4 __attribute__((ext_vector_type(4)));
typedef unsigned v4u __attribute__((ext_vector_type(4)));
typedef unsigned v2u __attribute__((ext_vector_type(2)));
#define LDS_WAIT() asm volatile("s_waitcnt lgkmcnt(0)" ::: "memory")

#ifndef MK_ONE_LAUNCH
#define MK_ONE_LAUNCH 0
#endif
#ifndef RET_MFMA
#define RET_MFMA 1
#endif
#ifndef SWA_MFMA
#define SWA_MFMA 1
#endif
#ifndef PROBE_DUP
#define PROBE_DUP 0
#endif
#if PROBE_DUP == 42 || PROBE_DUP == 43
#define YHW_ARG (_Float16*)(w + WS_YH),
#else
#define YHW_ARG
#endif
#ifndef PRO_NKB
#define PRO_NKB 4
#endif
#ifndef W_LATE
#define W_LATE 0
#endif
#ifndef UP_ROT
#define UP_ROT 0
#endif
#ifndef UP_SYNC
#define UP_SYNC 0
#endif
#if UP_ROT
#define UPORDER pg8::RotOrder
#elif UP_SYNC
#define UPORDER pg8::SyncOrder
#else
#define UPORDER pg8::StaticOrder
#endif
#ifndef P8_LOCAL
#define P8_LOCAL 0
#endif
#ifndef XLOC
#define XLOC 1
#endif
#ifndef MERGE_R1
#define MERGE_R1 1
#endif
#ifndef FIX_RED
#define FIX_RED 0
#endif
#ifndef PRO_GFAST
#define PRO_GFAST 1
#endif
#ifndef LN_LOCAL
#define LN_LOCAL 0
#endif
#ifndef PLE_ALIGN
#define PLE_ALIGN false
#endif
#ifndef SWA_KWIN
#define SWA_KWIN 1
#endif
#ifndef FUSE_SCAN
#define FUSE_SCAN 1
#endif
#ifndef SWA_OT
#define SWA_OT 1
#endif
#ifndef CODE_PAD
#define CODE_PAD 0
#endif
#ifndef PLE_BAL
#define PLE_BAL 0
#endif
#ifndef SWA_IN_P3
#define SWA_IN_P3 0
#endif
#ifndef UP_ALIGN
#define UP_ALIGN true
#endif
#ifndef UP_SP2
#define UP_SP2 true
#endif
#ifndef PANEL_SEAMS
#define PANEL_SEAMS 0
#endif
#ifndef PROBE_TICKS
#define PROBE_TICKS 2000
#endif
#ifndef PROBE_BLOCK
#define PROBE_BLOCK 0
#endif
#ifndef PROBE_MASK
#define PROBE_MASK 0xffff
#endif
#ifndef CONV_FUSED
#define CONV_FUSED 1
#endif
#ifndef PLE_EARLY
#define PLE_EARLY 1
#endif
#ifndef LN_NOXR
#define LN_NOXR 1
#endif
#ifndef LN_FUSED
#define LN_FUSED 1
#endif
#ifndef RES_BF16
#define RES_BF16 1
#endif
#define REPS(k) int nrep_ = (PROBE_DUP == (k)) ? 2 : 1; asm volatile("" : "+s"(nrep_)); for (int rep_ = 0; rep_ < nrep_; ++rep_)

constexpr int INW_ = 5376, NUPG_ = 13312;
constexpr int S = 16384, D = 2048, INW = 5376, DFF = 5632, NUP = 2 * DFF, NUPG = NUP + D, PLE = 256, DEPTH = 4;
constexpr float ALPHA = 1.6817928305074290f, LN_EPS = 1e-5f, GN_EPS = 1e-6f;
constexpr int NPH = 11, NPHASES = 1 + DEPTH * NPH;

constexpr size_t MiB = 1u << 20;
constexpr size_t WS_CTL = 0, CTL_ZERO_BYTES = 1 * MiB;
constexpr size_t WS_C = 65536; constexpr int C_L = 2 * INW_ + 2 * NUPG_, C1IN = 0, C2IN = INW_, C1UP = 2 * INW_, C2UP = 2 * INW_ + NUPG_;
constexpr size_t WS_YH = 1304 * MiB;
constexpr size_t WS_CP = 540 * MiB;
constexpr size_t WS_PSTAT = 532 * MiB;
constexpr size_t WS_COSR = 2 * MiB, WS_SINR = 10 * MiB, WS_COSA = 18 * MiB, WS_SINA = 20 * MiB;
constexpr size_t WS_W = 32 * MiB, WL_BYTES = 106 * MiB;
constexpr size_t WL_IN = 0, WL_OUT = 21 * MiB, WL_UP = 29 * MiB, WL_G = 73 * MiB, WL_DOWN = 81 * MiB, WL_P = 104 * MiB;
constexpr size_t WS_XR = 530 * MiB, WS_XB = 576 * MiB, WS_Y = 640 * MiB;
constexpr size_t WS_Q = 768 * MiB, WS_K = 800 * MiB, WS_V = 832 * MiB, WS_G = 864 * MiB, WS_AQ = 896 * MiB, WS_AK = 928 * MiB, WS_AV = 932 * MiB;
constexpr size_t WS_MIX = 936 * MiB, WS_U = 1000 * MiB, WS_PS = 1128 * MiB, WS_RETY = 1160 * MiB;
#if XLOC
constexpr size_t WS_H = 704 * MiB;
constexpr size_t WS_PP2 = 640 * MiB;
#else
constexpr size_t WS_H = 768 * MiB, WS_PP2 = 1064 * MiB;
#endif
constexpr size_t WS_ACT = 1128 * MiB, WS_SG = 460 * MiB, WS_PB = 1368 * MiB, WS_END = 1400 * MiB;
constexpr size_t WS_PP = 1064 * MiB;
constexpr size_t WS_ST1 = 24 * MiB, WS_ST2 = 25 * MiB;
constexpr int CW_BAR = 4096, CW_PANEL = 204800, CW_XT = 212992, CW_KV = 216064, CW_US = 217088, CW_HB = 218112;
static_assert((CW_BAR + 3456) * 4 <= 32768 && WS_C + (size_t)4 * C_L * 4 <= CTL_ZERO_BYTES, "barrier words and column sums inside the per-call memset");

constexpr int RING_BYTES = 131072, LDS_BYTES = 147456, LDSCTL_OFF = LDS_BYTES - 1024, MISC_OFF = LDSCTL_OFF + 320;

__device__ __forceinline__ unsigned f2bf(float f) { unsigned u = __builtin_bit_cast(unsigned, f); return (u + 0x7fffu + ((u >> 16) & 1u)) >> 16; }
__device__ __forceinline__ unsigned pk2(float lo, float hi) { return f2bf(lo) | (f2bf(hi) << 16); }
__device__ __forceinline__ float bflo(unsigned w) { return __uint_as_float(w << 16); }
__device__ __forceinline__ float bfhi(unsigned w) { return __uint_as_float(w & 0xffff0000u); }
__device__ __forceinline__ float bf1(const bf16* p) { return __uint_as_float(((unsigned)*p) << 16); }

struct Params {
    const float* in[19]; float* out; unsigned char* ws; int ph_lo, ph_hi;
    float invf_ret[128]; float invf_att[32]; float lg2g[4];
};

struct Ctx { int tid, lane, wave, G, bid; unsigned char* ws; };

__device__ __forceinline__ int lane_id_asm() { int l; asm volatile("v_mbcnt_lo_u32_b32 %0, -1, 0\n\tv_mbcnt_hi_u32_b32 %0, -1, %0" : "=v"(l)); return l; }
__device__ __forceinline__ float wave_sum(float v, int lane) {
#pragma unroll
    for (int o = 1; o < 64; o <<= 1) v += __builtin_bit_cast(float, __builtin_amdgcn_ds_bpermute((lane ^ o) << 2, __builtin_bit_cast(int, v)));
    return v;
}
__device__ __forceinline__ void transpose_item(const float* W, int K, int N, int src_col0, bf16* WT, int dst_row0, int k0, LAS float* scr, int lane) {
#pragma unroll 8
    for (int i = 0; i < 32; ++i) { const int kk = 2 * i + (lane >> 5); scr[kk * 33 + (lane & 31)] = W[(size_t)(k0 + kk) * N + src_col0 + (lane & 31)]; }
    LDS_WAIT(); asm volatile("" ::: "memory");
    const int c = lane & 7;
#pragma unroll
    for (int j = 0; j < 4; ++j) { const int n = (lane >> 3) + 8 * j; const LAS float* s = scr + (8 * c) * 33 + n;
        v4u o; o.x = pk2(s[0 * 33], s[1 * 33]); o.y = pk2(s[2 * 33], s[3 * 33]); o.z = pk2(s[4 * 33], s[5 * 33]); o.w = pk2(s[6 * 33], s[7 * 33]);
        *(v4u*)(WT + (size_t)(dst_row0 + n) * K + k0 + 8 * c) = o; }
    LDS_WAIT(); asm volatile("" ::: "memory");
}
__device__ __forceinline__ void transpose_item64(const float* W, int K, int N, int srcA, int srcB, bf16* WT, int dst_row0, int k0, LAS float* scr, int lane, int tiled = 0) {
    const int c4 = lane & 15, gsel = c4 >> 3, col = 4 * (c4 & 7), src = (gsel ? srcB : srcA) + col, kq = lane >> 4;
    f32x4 v[16];
#pragma unroll
    for (int i = 0; i < 16; ++i) v[i] = *(const f32x4*)(W + (size_t)(k0 + 4 * i + kq) * N + src);
#pragma unroll
    for (int i = 0; i < 16; ++i) { LAS float* d = scr + (4 * i + kq) * 65 + 32 * gsel + col; d[0] = v[i][0]; d[1] = v[i][1]; d[2] = v[i][2]; d[3] = v[i][3]; }
    LDS_WAIT(); asm volatile("" ::: "memory");
    const int c = lane & 7;
#pragma unroll
    for (int j = 0; j < 8; ++j) { const int n = (lane >> 3) + 8 * j; const LAS float* s = scr + (8 * c) * 65 + n;
        v4u o; o.x = pk2(s[0 * 65], s[1 * 65]); o.y = pk2(s[2 * 65], s[3 * 65]); o.z = pk2(s[4 * 65], s[5 * 65]); o.w = pk2(s[6 * 65], s[7 * 65]);
        *(v4u*)(WT + (tiled ? pg8::tiled_off(dst_row0 + n, k0 + 8 * c, K) : (size_t)(dst_row0 + n) * K + k0 + 8 * c)) = o; }
    LDS_WAIT(); asm volatile("" ::: "memory");
}
__device__ __forceinline__ void transpose_unit(const float* W, int K, int N, int srcA, int srcB, bf16* WT, int dst_row0, int kb0, int nkb, LAS float* scr, int lane, int tiled,
                                               const float* gv, const float* bv, float* c1, float* c2) {
    const int c4 = lane & 15, gsel = c4 >> 3, col = 4 * (c4 & 7), src = (gsel ? srcB : srcA) + col, kq = lane >> 4, c = lane & 7;
    f32x4 c1p = (f32x4){0.f, 0.f, 0.f, 0.f}, c2p = (f32x4){0.f, 0.f, 0.f, 0.f};
    for (int kb = kb0; kb < kb0 + nkb; ++kb) { const int k0 = 64 * kb;
        f32x4 v[16];
#pragma unroll
        for (int i = 0; i < 16; ++i) v[i] = *(const f32x4*)(W + (size_t)(k0 + 4 * i + kq) * N + src);
        if (gv) {
#pragma unroll
            for (int i = 0; i < 16; ++i) { const float gk = gv[k0 + 4 * i + kq], bk = bv[k0 + 4 * i + kq]; c2p = c2p + v[i] * bk; v[i] = v[i] * gk;
#pragma unroll
                for (int e = 0; e < 4; ++e) c1p[e] += __uint_as_float(f2bf(v[i][e]) << 16); } }
#pragma unroll
        for (int i = 0; i < 16; ++i) { LAS float* d = scr + (4 * i + kq) * 65 + 32 * gsel + col; d[0] = v[i][0]; d[1] = v[i][1]; d[2] = v[i][2]; d[3] = v[i][3]; }
        LDS_WAIT(); asm volatile("" ::: "memory");
#pragma unroll
        for (int j = 0; j < 8; ++j) { const int n = (lane >> 3) + 8 * j; const LAS float* sp = scr + (8 * c) * 65 + n;
            v4u o; o.x = pk2(sp[0 * 65], sp[1 * 65]); o.y = pk2(sp[2 * 65], sp[3 * 65]); o.z = pk2(sp[4 * 65], sp[5 * 65]); o.w = pk2(sp[6 * 65], sp[7 * 65]);
            *(v4u*)(WT + (tiled ? pg8::tiled_off(dst_row0 + n, k0 + 8 * c, K) : (size_t)(dst_row0 + n) * K + k0 + 8 * c)) = o; }
        LDS_WAIT(); asm volatile("" ::: "memory");
    }
    if (gv) {
#pragma unroll
        for (int e = 0; e < 4; ++e) {
            float a = c1p[e], b = c2p[e];
            a += __builtin_bit_cast(float, __builtin_amdgcn_ds_bpermute((lane ^ 16) << 2, __builtin_bit_cast(int, a))); b += __builtin_bit_cast(float, __builtin_amdgcn_ds_bpermute((lane ^ 16) << 2, __builtin_bit_cast(int, b)));
            a += __builtin_bit_cast(float, __builtin_amdgcn_ds_bpermute((lane ^ 32) << 2, __builtin_bit_cast(int, a))); b += __builtin_bit_cast(float, __builtin_amdgcn_ds_bpermute((lane ^ 32) << 2, __builtin_bit_cast(int, b)));
            if (kq == 0) { c1[dst_row0 + 32 * gsel + col + e] = a; c2[dst_row0 + 32 * gsel + col + e] = b; } }
    }
}
__device__ __forceinline__ int win_src_col(int g) {
    const int tile = g >> 3, bj = (g >> 2) & 1, wcg = g & 3;
    if (tile < 16) return 32 * g;
    if (tile < 20) return 4096 + 256 * (tile - 16) + 64 * wcg + 32 * bj;
    return wcg < 2 ? 5120 + 64 * wcg + 32 * bj : 5248 + 32 * (wcg - 2) + 64 * bj;
}
__device__ __forceinline__ int wup_src_col(int g) { const int tile = g >> 3, bj = (g >> 2) & 1, wcg = g & 3; return (bj ? DFF : 0) + 128 * tile + 32 * wcg; }

__device__ __forceinline__ void sincos_d(float angf, float& s, float& c) {
    const double a = (double)angf;
    const double k = __builtin_rint(a * 0.63661977236758134308);
    double r = __builtin_fma(-k, 1.57079632679489661923, a); r = __builtin_fma(-k, 6.123233995736766e-17, r);
    const double r2 = r * r;
    const double sp = r + r * r2 * (-1.0 / 6 + r2 * (1.0 / 120 + r2 * (-1.0 / 5040 + r2 * (1.0 / 362880 + r2 * (-1.0 / 39916800)))));
    const double cp = 1.0 + r2 * (-0.5 + r2 * (1.0 / 24 + r2 * (-1.0 / 720 + r2 * (1.0 / 40320 + r2 * (-1.0 / 3628800 + r2 * (1.0 / 479001600))))));
    const int q = ((int)k) & 3;
    const double sv = (q == 0) ? sp : (q == 1) ? cp : (q == 2) ? -sp : -cp;
    const double cv = (q == 0) ? cp : (q == 1) ? -sp : (q == 2) ? -cp : sp;
    s = (float)sv; c = (float)cv;
}

__device__ __forceinline__ void phase_prologue(const Params& P, const Ctx& cx, LAS unsigned char* lds) {
    unsigned char* ws = cx.ws; const int tid = cx.tid, lane = cx.lane, wave = cx.wave, G = cx.G;
    LAS float* scr = (LAS float*)(lds + wave * 16896);
    const int gw = cx.bid * 8 + wave, NGW = G * 8;
#if LN_FUSED
    constexpr int NKB = PRO_NKB, KCH = 32 / NKB, U_IN = 84 * KCH, U_OUT = 32 * KCH, U_UP = 176 * KCH, U_G = 32 * KCH, U_DN = 32 * (88 / NKB), U_P = 32 * (4 / NKB), U_L = U_IN + U_OUT + U_UP + U_G + U_DN + U_P;
    for (int it = gw; it < DEPTH * U_L; it += NGW) {
        const int l = it / U_L; int r = it - l * U_L;
        bf16* wl = (bf16*)(ws + WS_W + (size_t)l * WL_BYTES); float* cl0 = (float*)(ws + WS_CP) + (size_t)l * C_L;
        const float* g1 = P.in[8] + l * D; const float* b1 = P.in[9] + l * D;
        const float* g2 = l ? P.in[14] + (l - 1) * D : nullptr; const float* b2 = l ? P.in[15] + (l - 1) * D : nullptr;
        const float* W; int K = D, N = D, sa, sb, g, kc, nkb = NKB, tiled = 0; bf16* WT; const float* gv = nullptr; const float* bv = nullptr; float* c1 = nullptr; float* c2 = nullptr;
        if (r < U_IN) { if (PRO_GFAST) { g = r % 84; kc = r / 84; } else { g = r / KCH; kc = r % KCH; } W = P.in[3] + (size_t)l * D * INW; N = INW; sa = win_src_col(2 * g); sb = win_src_col(2 * g + 1); WT = wl + WL_IN / 2; gv = g2; bv = b2; c1 = cl0 + C1IN; c2 = cl0 + C2IN; }
        else if ((r -= U_IN) < U_OUT) { if (W_LATE && l > 0) continue;
            if (PRO_GFAST) { g = r % 32; kc = r / 32; } else { g = r / KCH; kc = r % KCH; } W = P.in[4] + (size_t)l * D * D; sa = 64 * g; sb = sa + 32; WT = wl + WL_OUT / 2; }
        else if ((r -= U_OUT) < U_UP) { if (PRO_GFAST) { g = r % 176; kc = r / 176; } else { g = r / KCH; kc = r % KCH; } W = P.in[10] + (size_t)l * D * NUP; N = NUP; sa = wup_src_col(2 * g); sb = wup_src_col(2 * g + 1); WT = wl + WL_UP / 2; gv = g1; bv = b1; c1 = cl0 + C1UP; c2 = cl0 + C2UP; }
        else if ((r -= U_UP) < U_G) { if (PRO_GFAST) { g = r % 32; kc = r / 32; } else { g = r / KCH; kc = r % KCH; } W = P.in[16] + (size_t)l * D * D; sa = 64 * g; sb = sa + 32; WT = wl + WL_G / 2; gv = g1; bv = b1; c1 = cl0 + C1UP + NUP; c2 = cl0 + C2UP + NUP; }
        else if ((r -= U_G) < U_DN) { if (W_LATE && l > 0) continue;
            if (PRO_GFAST) { g = r % 32; kc = r / 32; } else { g = r / (88 / NKB); kc = r % (88 / NKB); } W = P.in[13] + (size_t)l * DFF * D; K = DFF; sa = 64 * g; sb = sa + 32; WT = wl + WL_DOWN / 2; tiled = 1; }
        else { r -= U_DN; g = r / (4 / NKB); kc = r % (4 / NKB); W = P.in[18] + (size_t)l * PLE * D; K = PLE; sa = 64 * g; sb = sa + 32; WT = wl + WL_P / 2; }
        if (c1) { c1 += (size_t)kc * DEPTH * C_L; c2 += (size_t)kc * DEPTH * C_L; }
        transpose_unit(W, K, N, sa, sb, WT, 64 * g, NKB * kc, nkb, scr, lane, tiled, gv, bv, c1, c2);
    }
#else
    constexpr int I_IN = 32 * 84, I_OUT = 32 * 32, I_UP = 32 * 176, I_G = 32 * 32, I_DN = 88 * 32, I_P = 4 * 32, I_L = I_IN + I_OUT + I_UP + I_G + I_DN + I_P;
    for (int it = gw; it < DEPTH * I_L; it += NGW) {
        const int l = it / I_L; int r = it - l * I_L;
        bf16* wl = (bf16*)(ws + WS_W + (size_t)l * WL_BYTES);
        if (r < I_IN) { const int kb = r / 84, g = r % 84; transpose_item64(P.in[3] + (size_t)l * D * INW, D, INW, win_src_col(2 * g), win_src_col(2 * g + 1), wl + WL_IN / 2, 64 * g, 64 * kb, scr, lane); continue; } r -= I_IN;
        if (r < I_OUT) { const int kb = r / 32, g = r % 32; transpose_item64(P.in[4] + (size_t)l * D * D, D, D, 64 * g, 64 * g + 32, wl + WL_OUT / 2, 64 * g, 64 * kb, scr, lane); continue; } r -= I_OUT;
        if (r < I_UP) { const int kb = r / 176, g = r % 176; transpose_item64(P.in[10] + (size_t)l * D * NUP, D, NUP, wup_src_col(2 * g), wup_src_col(2 * g + 1), wl + WL_UP / 2, 64 * g, 64 * kb, scr, lane); continue; } r -= I_UP;
        if (r < I_G) { const int kb = r / 32, g = r % 32; transpose_item64(P.in[16] + (size_t)l * D * D, D, D, 64 * g, 64 * g + 32, wl + WL_G / 2, 64 * g, 64 * kb, scr, lane); continue; } r -= I_G;
        if (r < I_DN) { const int kb = r / 32, g = r % 32; transpose_item64(P.in[13] + (size_t)l * DFF * D, DFF, D, 64 * g, 64 * g + 32, wl + WL_DOWN / 2, 64 * g, 64 * kb, scr, lane, 1); continue; } r -= I_DN;
        { const int kb = r / 32, g = r % 32; transpose_item64(P.in[18] + (size_t)l * PLE * D, PLE, D, 64 * g, 64 * g + 32, wl + WL_P / 2, 64 * g, 64 * kb, scr, lane); }
    }
#endif
    const size_t gt = (size_t)cx.bid * 512 + tid, NT = (size_t)G * 512;
    { const float* x = P.in[0]; bf16* xb = (bf16*)(ws + WS_XB);
      for (size_t i = gt; i < (size_t)S * D / 8; i += NT) { const f32x4 a = *(const f32x4*)(x + i * 8), b = *(const f32x4*)(x + i * 8 + 4);
          v4u o; o.x = pk2(a[0], a[1]); o.y = pk2(a[2], a[3]); o.z = pk2(b[0], b[1]); o.w = pk2(b[2], b[3]); *(v4u*)(xb + i * 8) = o; } }
    { const float* p = P.in[1]; bf16* pb = (bf16*)(ws + WS_PB);
      for (size_t i = gt; i < (size_t)DEPTH * S * PLE / 8; i += NT) { const f32x4 a = *(const f32x4*)(p + i * 8), b = *(const f32x4*)(p + i * 8 + 4);
          v4u o; o.x = pk2(a[0], a[1]); o.y = pk2(a[2], a[3]); o.z = pk2(b[0], b[1]); o.w = pk2(b[2], b[3]); *(v4u*)(pb + i * 8) = o; } }
    { const int* pos = (const int*)P.in[2]; float* cosr = (float*)(ws + WS_COSR); float* sinr = (float*)(ws + WS_SINR); float* cosa = (float*)(ws + WS_COSA); float* sina = (float*)(ws + WS_SINA);
      for (size_t i = gt; i < (size_t)S * 128; i += NT) { const int t = (int)(i >> 7), f = (int)(i & 127); float s, c; sincos_d((float)pos[t] * P.invf_ret[f], s, c);
#if TAB_H
          ((_Float16*)cosr)[i] = (_Float16)c; ((_Float16*)sinr)[i] = (_Float16)s; }
#else
          cosr[i] = c; sinr[i] = s; }
#endif
      for (size_t i = gt; i < (size_t)S * 32; i += NT) { const int t = (int)(i >> 5), f = (int)(i & 31); float s, c; sincos_d((float)pos[t] * P.invf_att[f], s, c);
#if TAB_H
          ((_Float16*)cosa)[i] = (_Float16)c; ((_Float16*)sina)[i] = (_Float16)s; } }
#else
          cosa[i] = c; sina[i] = s; } }
#endif
}

template <int MT, int NT_, int KK, bool A_KFAST, bool B_NFAST, class FA, class FB, class FC>
__device__ __forceinline__ void simple_gemm(LAS unsigned char* lds, int nbatch, int tid, int G, int bid, const FA& fa, const FB& fb, const FC& fc) {
    LAS float* As = (LAS float*)lds;
    LAS float* Bs = (LAS float*)(lds + 16 * 132 * 4);
    constexpr int TM = MT / 128, TN = NT_ / 64, ITEMS_PER_B = TM * TN;
    const int tm = tid & 31, tn = tid >> 5;
    for (int item = bid; item < nbatch * ITEMS_PER_B; item += G) {
        const int b = item / ITEMS_PER_B, r = item % ITEMS_PER_B, m0 = (r / TN) * 128, n0 = (r % TN) * 64;
        float c[4][4];
#pragma unroll
        for (int i = 0; i < 4; ++i)
#pragma unroll
            for (int j = 0; j < 4; ++j) c[i][j] = 0.f;
        for (int k0 = 0; k0 < KK; k0 += 16) {
#pragma unroll
            for (int rr = 0; rr < 4; ++rr) { const int e = tid + 512 * rr; int m, k; if (A_KFAST) { k = e & 15; m = e >> 4; } else { m = e & 127; k = e >> 7; }
                As[k * 132 + m] = fa(b, m0 + m, k0 + k); }
#pragma unroll
            for (int rr = 0; rr < 2; ++rr) { const int e = tid + 512 * rr; int n, k; if (B_NFAST) { n = e & 63; k = e >> 6; } else { k = e & 15; n = e >> 4; }
                Bs[k * 68 + n] = fb(b, k0 + k, n0 + n); }
            __syncthreads();
#pragma unroll
            for (int kk = 0; kk < 16; ++kk) { const f32x4 a = *(const LAS f32x4*)(As + kk * 132 + 4 * tm), bb = *(const LAS f32x4*)(Bs + kk * 68 + 4 * tn);
#pragma unroll
                for (int i = 0; i < 4; ++i)
#pragma unroll
                    for (int j = 0; j < 4; ++j) c[i][j] += a[i] * bb[j]; }
            __syncthreads();
        }
#pragma unroll
        for (int i = 0; i < 4; ++i)
#pragma unroll
            for (int j = 0; j < 4; ++j) fc(b, m0 + 4 * tm + i, n0 + 4 * tn + j, c[i][j]);
    }
}

__device__ __forceinline__ void phase_swa(const Params& P, const Ctx& cx, int l, LAS unsigned char* lds) {
    unsigned char* ws = cx.ws; const int tid = cx.tid, G = cx.G;
    const bf16* AQ = (const bf16*)(ws + WS_AQ); const bf16* AK = (const bf16*)(ws + WS_AK); const bf16* AV = (const bf16*)(ws + WS_AV); bf16* MIX = (bf16*)(ws + WS_MIX);
    const float* sinks = P.in[7] + l * 16;
    LAS unsigned* Ks = (LAS unsigned*)lds;
    LAS unsigned* Vs = (LAS unsigned*)(lds + 256 * 33 * 4);
    for (int item = cx.bid; item < 256; item += G) {
        const int nb = item >> 1, hk = item & 1;
        __syncthreads();
        for (int e = tid; e < 256 * 32; e += 512) { const int r = e >> 5, cdw = e & 31; const int gk = nb * 128 - 128 + r;
            unsigned kv = 0u, vv = 0u; if (gk >= 0) { kv = *(const unsigned*)(AK + (size_t)gk * 128 + hk * 64 + 2 * cdw); vv = *(const unsigned*)(AV + (size_t)gk * 128 + hk * 64 + 2 * cdw); }
            Ks[r * 33 + cdw] = kv; Vs[r * 33 + cdw] = vv; }
        __syncthreads();
#pragma unroll 1
        for (int rep = 0; rep < 2; ++rep) {
            const int pair = tid + 512 * rep, i = pair & 127, g = pair >> 7, hq = hk * 8 + g; const int row = nb * 128 + i;
            float q[64], o[64];
            { const v4u* qp = (const v4u*)(AQ + (size_t)row * 1024 + hq * 64);
#pragma unroll
              for (int c8 = 0; c8 < 8; ++c8) { const v4u w = qp[c8]; q[8 * c8 + 0] = bflo(w.x); q[8 * c8 + 1] = bfhi(w.x); q[8 * c8 + 2] = bflo(w.y); q[8 * c8 + 3] = bfhi(w.y); q[8 * c8 + 4] = bflo(w.z); q[8 * c8 + 5] = bfhi(w.z); q[8 * c8 + 6] = bflo(w.w); q[8 * c8 + 7] = bfhi(w.w); } }
#pragma unroll
            for (int d = 0; d < 64; ++d) o[d] = 0.f;
            float mx = sinks[hq], den = 1.0f;
            const int jj0 = (nb == 0) ? (127 - i) : 0;
            for (int jj = jj0; jj < 128; ++jj) { const int kl = i + 1 + jj;
                float s = 0.f;
#pragma unroll
                for (int c = 0; c < 32; ++c) { const unsigned w = Ks[kl * 33 + c]; s += q[2 * c] * bflo(w) + q[2 * c + 1] * bfhi(w); }
                const float mn = fmaxf(mx, s), sc = __expf(mx - mn), p = __expf(s - mn);
                den = den * sc + p; mx = mn;
#pragma unroll
                for (int c = 0; c < 32; ++c) { const unsigned w = Vs[kl * 33 + c]; o[2 * c] = o[2 * c] * sc + p * bflo(w); o[2 * c + 1] = o[2 * c + 1] * sc + p * bfhi(w); }
            }
            const float inv = 1.0f / den;
            v4u* op = (v4u*)(MIX + (size_t)row * 2048 + 1024 + hq * 64);
#pragma unroll
            for (int c8 = 0; c8 < 8; ++c8) { v4u w; w.x = pk2(o[8 * c8] * inv, o[8 * c8 + 1] * inv); w.y = pk2(o[8 * c8 + 2] * inv, o[8 * c8 + 3] * inv); w.z = pk2(o[8 * c8 + 4] * inv, o[8 * c8 + 5] * inv); w.w = pk2(o[8 * c8 + 6] * inv, o[8 * c8 + 7] * inv); op[c8] = w; }
        }
    }
}

__device__ __forceinline__ void phase_ret_u_scores(const Params& P, const Ctx& cx, LAS unsigned char* lds) {
    unsigned char* ws = cx.ws; const int tid = cx.tid, G = cx.G;
    const bf16* Q = (const bf16*)(ws + WS_Q); const bf16* K = (const bf16*)(ws + WS_K); const bf16* V = (const bf16*)(ws + WS_V);
    float* U = (float*)(ws + WS_U); float* PS = (float*)(ws + WS_PS);
    const float lg0 = P.lg2g[0], lg1 = P.lg2g[1], lg2 = P.lg2g[2], lg3 = P.lg2g[3];
    auto lgh = [=](int h) { return h == 0 ? lg0 : h == 1 ? lg1 : h == 2 ? lg2 : lg3; };
    simple_gemm<256, 256, 128, false, true>(lds, 512, tid, G, cx.bid,
        [=](int b, int m, int k) { const int nb = b >> 2, h = b & 3; return bf1(K + (size_t)(nb * 128 + k) * 1024 + h * 256 + m) * exp2f(lgh(h) * (float)(127 - k)); },
        [=](int b, int k, int n) { const int nb = b >> 2, h = b & 3; return bf1(V + (size_t)(nb * 128 + k) * 1024 + h * 256 + n); },
        [=](int b, int m, int n, float v) { U[((size_t)b * 256 + m) * 256 + n] = v; });
    simple_gemm<128, 128, 256, true, false>(lds, 512, tid, G, cx.bid,
        [=](int b, int m, int k) { const int nb = b >> 2, h = b & 3; return bf1(Q + (size_t)(nb * 128 + m) * 1024 + h * 256 + k); },
        [=](int b, int k, int n) { const int nb = b >> 2, h = b & 3; return bf1(K + (size_t)(nb * 128 + n) * 1024 + h * 256 + k); },
        [=](int b, int m, int n, float v) { const int h = b & 3; PS[((size_t)b * 128 + m) * 128 + n] = (m >= n) ? v * exp2f(lgh(h) * (float)(m - n)) : 0.f; });
}
__device__ __forceinline__ void phase_scan(const Params& P, const Ctx& cx) {
    float* U = (float*)(cx.ws + WS_U);
    const size_t gt = (size_t)cx.bid * 512 + cx.tid, NT = (size_t)cx.G * 512;
    for (size_t idx = gt; idx < 4 * 65536; idx += NT) {
        const int h = (int)(idx >> 16); const float cd = exp2f(P.lg2g[h] * 128.0f);
        float r = 0.f;
        for (int n0 = 0; n0 < 128; n0 += 8) { float u[8];
#pragma unroll
            for (int j = 0; j < 8; ++j) u[j] = U[(size_t)(n0 + j) * 262144 + idx];
#pragma unroll
            for (int j = 0; j < 8; ++j) { U[(size_t)(n0 + j) * 262144 + idx] = r; r = r * cd + u[j]; } }
    }
}
__device__ __forceinline__ void phase_ret_out(const Params& P, const Ctx& cx, LAS unsigned char* lds) {
    unsigned char* ws = cx.ws; const int tid = cx.tid, G = cx.G;
    const bf16* Q = (const bf16*)(ws + WS_Q); const bf16* V = (const bf16*)(ws + WS_V);
    const float* Sst = (const float*)(ws + WS_U); const float* PS = (const float*)(ws + WS_PS); float* RY = (float*)(ws + WS_RETY);
    const float lg0 = P.lg2g[0], lg1 = P.lg2g[1], lg2 = P.lg2g[2], lg3 = P.lg2g[3];
    auto lgh = [=](int h) { return h == 0 ? lg0 : h == 1 ? lg1 : h == 2 ? lg2 : lg3; };
    simple_gemm<128, 256, 384, true, true>(lds, 512, tid, G, cx.bid,
        [=](int b, int m, int k) { const int nb = b >> 2, h = b & 3; return k < 128 ? PS[((size_t)b * 128 + m) * 128 + k] : bf1(Q + (size_t)(nb * 128 + m) * 1024 + h * 256 + (k - 128)) * exp2f(lgh(h) * (float)(m + 1)); },
        [=](int b, int k, int n) { const int nb = b >> 2, h = b & 3; return k < 128 ? bf1(V + (size_t)(nb * 128 + k) * 1024 + h * 256 + n) : Sst[((size_t)b * 256 + (k - 128)) * 256 + n]; },
        [=](int b, int m, int n, float v) { const int nb = b >> 2, h = b & 3; RY[(size_t)(nb * 128 + m) * 1024 + h * 256 + n] = v; });
}

typedef short bf16x8 __attribute__((ext_vector_type(8)));
typedef short s16x4 __attribute__((ext_vector_type(4)));
typedef short v4i16_t __attribute__((ext_vector_type(4)));
__device__ __forceinline__ f32x4 mfma16(bf16x8 a, bf16x8 b, f32x4 c) { return __builtin_amdgcn_mfma_f32_16x16x32_bf16(a, b, c, 0, 0, 0); }
__device__ __forceinline__ s16x4 lds_tr(LAS unsigned char* p) { return __builtin_bit_cast(s16x4, __builtin_amdgcn_ds_read_tr16_b64_v4i16((LAS v4i16_t*)p)); }
__device__ __forceinline__ bf16x8 cat44(s16x4 a, s16x4 b) { bf16x8 r; r[0] = a[0]; r[1] = a[1]; r[2] = a[2]; r[3] = a[3]; r[4] = b[0]; r[5] = b[1]; r[6] = b[2]; r[7] = b[3]; return r; }
__device__ __forceinline__ unsigned cvt2(float lo, float hi) { return pg8::cvt_pk_bf16(lo, hi); }
__device__ __forceinline__ bf16x8 pack_frag(const f32x4 a, const f32x4 b) { v4u w; w.x = cvt2(a[0], a[1]); w.y = cvt2(a[2], a[3]); w.z = cvt2(b[0], b[1]); w.w = cvt2(b[2], b[3]); return __builtin_bit_cast(bf16x8, w); }
__device__ __forceinline__ float grp16_sum(float v, int lane) {
#pragma unroll
    for (int o = 1; o < 16; o <<= 1) v += __builtin_bit_cast(float, __builtin_amdgcn_ds_bpermute((lane ^ o) << 2, __builtin_bit_cast(int, v)));
    return v;
}

__device__ __forceinline__ unsigned lds_addr(const LAS unsigned char* p) { return (unsigned)(size_t)p; }
template <int O1, int O2, int O3, int O4, int O5, int O6, int O7>
__device__ __forceinline__ void lds_rd8(bf16x8 (&t)[8], unsigned a) {
    asm volatile("ds_read_b128 %0, %8\n\tds_read_b128 %1, %8 offset:%9\n\tds_read_b128 %2, %8 offset:%10\n\tds_read_b128 %3, %8 offset:%11\n\t"
                 "ds_read_b128 %4, %8 offset:%12\n\tds_read_b128 %5, %8 offset:%13\n\tds_read_b128 %6, %8 offset:%14\n\tds_read_b128 %7, %8 offset:%15\n\ts_waitcnt lgkmcnt(0)"
                 : "=&v"(t[0]), "=&v"(t[1]), "=&v"(t[2]), "=&v"(t[3]), "=&v"(t[4]), "=&v"(t[5]), "=&v"(t[6]), "=&v"(t[7])
                 : "v"(a), "i"(O1), "i"(O2), "i"(O3), "i"(O4), "i"(O5), "i"(O6), "i"(O7) : "memory");
}
template <int OA, int OB, int OC>
__device__ __forceinline__ void lds_tr8(s16x4 (&t)[8], unsigned a0, unsigned a1) {
    asm volatile("ds_read_b64_tr_b16 %0, %8\n\tds_read_b64_tr_b16 %1, %8 offset:%10\n\tds_read_b64_tr_b16 %2, %8 offset:%11\n\tds_read_b64_tr_b16 %3, %8 offset:%12\n\t"
                 "ds_read_b64_tr_b16 %4, %9\n\tds_read_b64_tr_b16 %5, %9 offset:%10\n\tds_read_b64_tr_b16 %6, %9 offset:%11\n\tds_read_b64_tr_b16 %7, %9 offset:%12\n\ts_waitcnt lgkmcnt(0)"
                 : "=&v"(t[0]), "=&v"(t[1]), "=&v"(t[2]), "=&v"(t[3]), "=&v"(t[4]), "=&v"(t[5]), "=&v"(t[6]), "=&v"(t[7])
                 : "v"(a0), "v"(a1), "i"(OA), "i"(OB), "i"(OC) : "memory");
}
constexpr int RS_T = 544;
constexpr int TILE_T = 128 * RS_T;
static_assert(2 * TILE_T <= LDSCTL_OFF, "retention tiles vs LDS control words");

template <bool DECAY> __device__ __forceinline__ void stage_tile(LAS unsigned char* img, const bf16* src, int tid, float lg) {
    v4u v[8];
#pragma unroll
    for (int r = 0; r < 8; ++r) { const int pc = tid + 512 * r, row = pc >> 5, c16 = pc & 31; v[r] = *(const v4u*)(src + (size_t)row * 1024 + c16 * 8); }
#pragma unroll
    for (int r = 0; r < 8; ++r) { const int pc = tid + 512 * r, row = pc >> 5, c16 = pc & 31; v4u w = v[r];
        if (DECAY) { const float sc = exp2f(lg * (float)(127 - row));
            w.x = cvt2(bflo(w.x) * sc, bfhi(w.x) * sc); w.y = cvt2(bflo(w.y) * sc, bfhi(w.y) * sc); w.z = cvt2(bflo(w.z) * sc, bfhi(w.z) * sc); w.w = cvt2(bflo(w.w) * sc, bfhi(w.w) * sc); }
        *(LAS v4u*)(img + row * RS_T + c16 * 16) = w; }
}

template <bool DECAY_A> __device__ __forceinline__ void stage_two(LAS unsigned char* imgA, const bf16* srcA, LAS unsigned char* imgB, const bf16* srcB, int tid, float lg) {
    v4u va[8], vb[8];
#pragma unroll
    for (int r = 0; r < 8; ++r) { const int pc = tid + 512 * r, row = pc >> 5, c16 = pc & 31; va[r] = *(const v4u*)(srcA + (size_t)row * 1024 + c16 * 8); vb[r] = *(const v4u*)(srcB + (size_t)row * 1024 + c16 * 8); }
#pragma unroll
    for (int r = 0; r < 8; ++r) { const int pc = tid + 512 * r, row = pc >> 5, c16 = pc & 31; v4u w = va[r];
        if (DECAY_A) { const float sc = exp2f(lg * (float)(127 - row));
            w.x = cvt2(bflo(w.x) * sc, bfhi(w.x) * sc); w.y = cvt2(bflo(w.y) * sc, bfhi(w.y) * sc); w.z = cvt2(bflo(w.z) * sc, bfhi(w.z) * sc); w.w = cvt2(bflo(w.w) * sc, bfhi(w.w) * sc); }
        *(LAS v4u*)(imgA + row * RS_T + c16 * 16) = w; *(LAS v4u*)(imgB + row * RS_T + c16 * 16) = vb[r]; }
}

__device__ __forceinline__ void phase_ret_u_mfma(const Params& P, const Ctx& cx, LAS unsigned char* lds, const bool light_only) {
    unsigned char* ws = cx.ws; const int tid = cx.tid, lane = cx.lane, w = cx.wave, r16 = lane & 15, g = lane >> 4, q = r16 >> 2, pp = r16 & 3;
    const bf16* K = (const bf16*)(ws + WS_K); const bf16* V = (const bf16*)(ws + WS_V); bf16* UT = (bf16*)(ws + WS_U);
    LAS unsigned char* Kim = lds; LAS unsigned char* Vim = lds + TILE_T;
    const bool al_ = XLOC && cx.G == 4 * (S / 256);
    const int first_ = al_ ? (light_only ? (cx.bid >> 3) - 8 : (cx.bid >> 3)) : cx.bid, stride_ = al_ ? (light_only ? 24 : 32) : cx.G, count_ = al_ ? 64 : 512, base_ = al_ ? 64 * (cx.bid & 7) : 0;
    for (int v_ = first_; v_ >= 0 && v_ < count_; v_ += stride_) { const int b = base_ + v_;
        const int nb = b >> 2, h = b & 3;
        __syncthreads();
        stage_two<true>(Kim, K + (size_t)nb * 128 * 1024 + h * 256, Vim, V + (size_t)nb * 128 * 1024 + h * 256, tid, P.lg2g[h]);
        __syncthreads();
        f32x4 acc[2][16];
#pragma unroll
        for (int mi = 0; mi < 2; ++mi)
#pragma unroll
            for (int n = 0; n < 16; ++n) acc[mi][n] = (f32x4){0.f, 0.f, 0.f, 0.f};
#pragma unroll 1
        for (int s = 0; s < 4; ++s) {
            bf16x8 af[2];
#pragma unroll
            for (int mi = 0; mi < 2; ++mi) { LAS unsigned char* a0 = Kim + (32 * s + 8 * g + q) * RS_T + (16 * (2 * w + mi) + 4 * pp) * 2; af[mi] = cat44(lds_tr(a0), lds_tr(a0 + 4 * RS_T)); }
#pragma unroll
            for (int ng = 0; ng < 4; ++ng) { const unsigned b0 = lds_addr(Vim + (32 * s + 8 * g + q) * RS_T + (64 * ng + 4 * pp) * 2); s16x4 t[8];
                lds_tr8<32, 64, 96>(t, b0, b0 + 4 * RS_T);
#pragma unroll
                for (int nn = 0; nn < 4; ++nn) { const bf16x8 bfr = cat44(t[nn], t[4 + nn]); const int n = 4 * ng + nn;
                    acc[0][n] = mfma16(af[0], bfr, acc[0][n]); acc[1][n] = mfma16(af[1], bfr, acc[1][n]); } }
        }
#pragma unroll
        for (int mi = 0; mi < 2; ++mi)
#pragma unroll
            for (int n = 0; n < 16; ++n) { v2u o; o.x = cvt2(acc[mi][n][0], acc[mi][n][1]); o.y = cvt2(acc[mi][n][2], acc[mi][n][3]);
                *(v2u*)(UT + ((size_t)b * 256 + 16 * n + r16) * 256 + 16 * (2 * w + mi) + 4 * g) = o; }
    }
}
__device__ __forceinline__ void phase_scan_bf16(const Params& P, const Ctx& cx) {
    unsigned* UT = (unsigned*)(cx.ws + WS_U);
    const size_t gt = (size_t)cx.bid * 512 + cx.tid, NT = (size_t)cx.G * 512;
    for (size_t idx = gt; idx < 131072; idx += NT) {
        const int h = (int)(idx >> 15); const float cd = exp2f(P.lg2g[h] * 128.0f);
        float r0 = 0.f, r1 = 0.f;
        for (int n0 = 0; n0 < 128; n0 += 32) { unsigned u[32];
#pragma unroll
            for (int j = 0; j < 32; ++j) u[j] = UT[(size_t)(n0 + j) * 131072 + idx];
#pragma unroll
            for (int j = 0; j < 32; ++j) { UT[(size_t)(n0 + j) * 131072 + idx] = cvt2(r0, r1); r0 = r0 * cd + bflo(u[j]); r1 = r1 * cd + bfhi(u[j]); } }
    }
}
constexpr int RS_O = 1040;
static_assert(8 * 16 * RS_O <= 2 * TILE_T, "R3 output staging fits the shared area");
__device__ __forceinline__ void phase_ret_out_mfma(const Params& P, const Ctx& cx, int l, LAS unsigned char* lds) {
    unsigned char* ws = cx.ws; const int w = cx.wave;
    const bf16* Q = (const bf16*)(ws + WS_Q); const bf16* K = (const bf16*)(ws + WS_K); const bf16* V = (const bf16*)(ws + WS_V); const bf16* ST = (const bf16*)(ws + WS_U);
    const bf16* Gt = (const bf16*)(ws + WS_G); bf16* MIX = (bf16*)(ws + WS_MIX);
    const float* gg = P.in[5] + l * 1024; const float* gb = P.in[6] + l * 1024;
    LAS unsigned char* Kim = lds; LAS unsigned char* Vim = lds + TILE_T;
    const bool al_ = XLOC && cx.G == 4 * (S / 256);
    for (int k_ = 0; ; ++k_) { const int b = al_ ? 64 * (cx.bid & 7) + (cx.bid >> 3) + 32 * k_ : cx.bid + k_ * cx.G; if (b >= 512 || (al_ && k_ >= 2)) break;
        const int nb = b >> 2, h = b & 3; const float lg = P.lg2g[h];
        int lane = cx.lane; asm volatile("" : "+v"(lane)); const int tid = w * 64 + lane, r16 = lane & 15, g = lane >> 4, q = r16 >> 2, pp = r16 & 3;
        __syncthreads();
        { const bf16* stb = ST + (size_t)b * 65536;
          v4u v[16];
#pragma unroll
          for (int r = 0; r < 16; ++r) { const int pc = tid + 512 * r, row = pc >> 5, c16 = pc & 31; v[r] = *(const v4u*)(stb + (size_t)row * 256 + c16 * 8); }
#pragma unroll
          for (int r = 0; r < 16; ++r) { const int pc = tid + 512 * r, row = pc >> 5, c16 = pc & 31; *(LAS v4u*)(lds + row * RS_T + c16 * 16) = v[r]; } }
        bf16x8 qf[8];
        { const bf16* qrow = Q + (size_t)(nb * 128 + 16 * w + r16) * 1024 + h * 256 + 8 * g;
#pragma unroll
          for (int s = 0; s < 8; ++s) qf[s] = *(const bf16x8*)(qrow + 32 * s); }
        const bf16* ksrc = K + (size_t)nb * 128 * 1024 + h * 256; const bf16* vsrc = V + (size_t)nb * 128 * 1024 + h * 256;
        v4u kv[8];
#pragma unroll
        for (int r = 0; r < 8; ++r) { const int pc = tid + 512 * r, row = pc >> 5, c16 = pc & 31; kv[r] = *(const v4u*)(ksrc + (size_t)row * 1024 + c16 * 8); }
        __syncthreads();
        f32x4 acc[16];
#pragma unroll
        for (int n = 0; n < 16; ++n) { f32x4 a = (f32x4){0.f, 0.f, 0.f, 0.f}; bf16x8 t[8];
            lds_rd8<64, 128, 192, 256, 320, 384, 448>(t, lds_addr(lds + (16 * n + r16) * RS_T + 16 * g));
#pragma unroll
            for (int s = 0; s < 8; ++s) a = mfma16(qf[s], t[s], a);
            acc[n] = a; }
        { float f[4];
#pragma unroll
          for (int r = 0; r < 4; ++r) f[r] = exp2f(lg * (float)(16 * w + 4 * g + r + 1));
#pragma unroll
          for (int n = 0; n < 16; ++n) { acc[n][0] *= f[0]; acc[n][1] *= f[1]; acc[n][2] *= f[2]; acc[n][3] *= f[3]; } }
        __syncthreads();
        v4u vv[8];
#pragma unroll
        for (int r = 0; r < 8; ++r) { const int pc = tid + 512 * r, row = pc >> 5, c16 = pc & 31; *(LAS v4u*)(Kim + row * RS_T + c16 * 16) = kv[r]; vv[r] = *(const v4u*)(vsrc + (size_t)row * 1024 + c16 * 8); }
        __syncthreads();
        f32x4 sc[8];
#pragma unroll
        for (int mb = 0; mb < 8; ++mb) { sc[mb] = (f32x4){0.f, 0.f, 0.f, 0.f};
            if (mb <= w) { f32x4 a = (f32x4){0.f, 0.f, 0.f, 0.f}; bf16x8 t[8];
                lds_rd8<64, 128, 192, 256, 320, 384, 448>(t, lds_addr(Kim + (16 * mb + r16) * RS_T + 16 * g));
#pragma unroll
                for (int s = 0; s < 8; ++s) a = mfma16(t[s], qf[s], a);
                const int i = 16 * w + r16;
#pragma unroll
                for (int r = 0; r < 4; ++r) { const int j = 16 * mb + 4 * g + r; a[r] = (i >= j) ? a[r] * exp2f(lg * (float)(i - j)) : 0.f; }
                sc[mb] = a; } }
#pragma unroll
        for (int r = 0; r < 8; ++r) { const int pc = tid + 512 * r, row = pc >> 5, c16 = pc & 31; *(LAS v4u*)(Vim + row * RS_T + c16 * 16) = vv[r]; }
        __syncthreads();
#pragma unroll
        for (int sk = 0; sk < 4; ++sk) {
            if (2 * sk <= w) { const bf16x8 pf = pack_frag(sc[2 * sk], sc[2 * sk + 1]);
#pragma unroll
                for (int ng = 0; ng < 4; ++ng) { const unsigned b0 = lds_addr(Vim + (32 * sk + 4 * g + q) * RS_T + (64 * ng + 4 * pp) * 2); s16x4 t[8];
                    lds_tr8<32, 64, 96>(t, b0, b0 + 16 * RS_T);
#pragma unroll
                    for (int nn = 0; nn < 4; ++nn) acc[4 * ng + nn] = mfma16(pf, cat44(t[nn], t[4 + nn]), acc[4 * ng + nn]); } } }
        float mean[4], rstd[4];
#pragma unroll
        for (int r = 0; r < 4; ++r) { float sm = 0.f;
#pragma unroll
            for (int n = 0; n < 16; ++n) sm += acc[n][r];
            mean[r] = grp16_sum(sm, lane) * (1.0f / 256.0f); }
#pragma unroll
        for (int r = 0; r < 4; ++r) { float sq = 0.f;
#pragma unroll
            for (int n = 0; n < 16; ++n) { const float d = acc[n][r] - mean[r]; sq += d * d; }
            rstd[r] = 1.0f / sqrtf(grp16_sum(sq, lane) * (1.0f / 256.0f) + GN_EPS); }
        __syncthreads();
        { LAS unsigned char* ob = lds + w * (16 * RS_O);
#pragma unroll
          for (int n = 0; n < 16; ++n)
#pragma unroll
            for (int r = 0; r < 4; ++r) *(LAS float*)(ob + (4 * g + r) * RS_O + (16 * n + r16) * 4) = (acc[n][r] - mean[r]) * rstd[r];
          LDS_WAIT(); asm volatile("" ::: "memory");
          const int e0 = 8 * (lane & 31), hv = lane >> 5;
          const f32x4 g0 = *(const f32x4*)(gg + h * 256 + e0), g1 = *(const f32x4*)(gg + h * 256 + e0 + 4), b0 = *(const f32x4*)(gb + h * 256 + e0), b1 = *(const f32x4*)(gb + h * 256 + e0 + 4);
#pragma unroll
          for (int k = 0; k < 8; ++k) { const int rl = 2 * k + hv; const size_t row = (size_t)(nb * 128 + 16 * w + rl);
              const f32x4 y0 = *(const LAS f32x4*)(ob + rl * RS_O + e0 * 4), y1 = *(const LAS f32x4*)(ob + rl * RS_O + e0 * 4 + 16);
              const v4u gt = *(const v4u*)(Gt + row * 1024 + h * 256 + e0);
              const f32x4 o0 = y0 * g0 + b0, o1 = y1 * g1 + b1;
              v4u o; o.x = cvt2(o0[0] * bflo(gt.x), o0[1] * bfhi(gt.x)); o.y = cvt2(o0[2] * bflo(gt.y), o0[3] * bfhi(gt.y)); o.z = cvt2(o1[0] * bflo(gt.z), o1[1] * bfhi(gt.z)); o.w = cvt2(o1[2] * bflo(gt.w), o1[3] * bfhi(gt.w));
              *(v4u*)(MIX + row * 2048 + h * 256 + e0) = o; } }
    }
}
constexpr int RS_SK = 144, RS_SV = 160;
__device__ __forceinline__ void phase_swa_mfma(const Params& P, const Ctx& cx, int l, LAS unsigned char* lds) {
    unsigned char* ws = cx.ws; const int tid = cx.tid, lane = cx.lane, w = cx.wave, r16 = lane & 15, g = lane >> 4, q = r16 >> 2, pp = r16 & 3;
    const bf16* AQ = (const bf16*)(ws + WS_AQ); const bf16* AK = (const bf16*)(ws + WS_AK); const bf16* AV = (const bf16*)(ws + WS_AV); bf16* MIX = (bf16*)(ws + WS_MIX);
    LAS unsigned char* Kim = lds; LAS unsigned char* Vim = lds + 256 * RS_SK;
    const bool al_ = XLOC && cx.G == 4 * (S / 256);
    for (int item = al_ ? 32 * (cx.bid & 7) + (cx.bid >> 3) : cx.bid, k_ = 0; item < 256 && !(al_ && k_ > 0); item += cx.G, ++k_) {
        const int nb = item >> 1, hk = item & 1, hq = hk * 8 + w; const float sink = P.in[7][l * 16 + hq];
        __syncthreads();
#pragma unroll
        for (int r = 0; r < 4; ++r) { const int pc = tid + 512 * r, row = pc >> 3, c = pc & 7, gk = nb * 128 - 128 + row;
            v4u kv = (v4u){0u, 0u, 0u, 0u}, vv = (v4u){0u, 0u, 0u, 0u};
            if (gk >= 0) { kv = *(const v4u*)(AK + (size_t)gk * 128 + hk * 64 + c * 8); vv = *(const v4u*)(AV + (size_t)gk * 128 + hk * 64 + c * 8); }
            *(LAS v4u*)(Kim + row * RS_SK + c * 16) = kv; *(LAS v4u*)(Vim + row * RS_SV + c * 16) = vv; }
        __syncthreads();
        const bf16* qbase = AQ + (size_t)(nb * 128 + r16) * 1024 + hq * 64 + 8 * g;
        bf16x8 qn0 = *(const bf16x8*)(qbase), qn1 = *(const bf16x8*)(qbase + 32);
        const bool fs_ = (FUSE_SCAN != 0) && al_;
        unsigned* const sut = (unsigned*)(ws + WS_U) + ((unsigned)cx.bid * 512u + (unsigned)tid);
        const float scd = exp2f(P.lg2g[(cx.bid * 512 + tid) >> 15] * 128.0f); float sr0 = 0.f, sr1 = 0.f;
#if SWA_KWIN
        bf16x8 kt[18];
        { const unsigned kp0 = lds_addr(Kim + r16 * RS_SK + 16 * g);
          bf16x8 t[8];
          lds_rd8<64, 16 * RS_SK, 16 * RS_SK + 64, 32 * RS_SK, 32 * RS_SK + 64, 48 * RS_SK, 48 * RS_SK + 64>(t, kp0);
#pragma unroll
          for (int i = 0; i < 8; ++i) kt[i] = t[i];
          lds_rd8<64, 16 * RS_SK, 16 * RS_SK + 64, 32 * RS_SK, 32 * RS_SK + 64, 48 * RS_SK, 48 * RS_SK + 64>(t, kp0 + 64 * RS_SK);
#pragma unroll
          for (int i = 0; i < 8; ++i) kt[8 + i] = t[i]; }
#endif
#pragma unroll 1
        for (int nq = 0; nq < 8; ++nq) {
            unsigned su[16];
            if (fs_) {
#pragma unroll
                for (int j = 0; j < 16; ++j) su[j] = sut[(size_t)(16 * nq + j) * 131072]; }
            const bf16x8 qf0 = qn0, qf1 = qn1;
            { const bf16* qrow = qbase + (size_t)(16 * (nq < 7 ? nq + 1 : 7)) * 1024; qn0 = *(const bf16x8*)(qrow); qn1 = *(const bf16x8*)(qrow + 32); }
            f32x4 sc[10];
            float mx = sink;
#if SWA_KWIN
            kt[16] = *(const LAS bf16x8*)(Kim + (16 * (nq + 8) + r16) * RS_SK + 16 * g); kt[17] = *(const LAS bf16x8*)(Kim + (16 * (nq + 8) + r16) * RS_SK + 16 * g + 64);
#else
            bf16x8 kt[18];
            { const unsigned kp0 = lds_addr(Kim + (16 * nq + r16) * RS_SK + 16 * g);
              bf16x8 t[8];
              lds_rd8<64, 16 * RS_SK, 16 * RS_SK + 64, 32 * RS_SK, 32 * RS_SK + 64, 48 * RS_SK, 48 * RS_SK + 64>(t, kp0);
#pragma unroll
              for (int i = 0; i < 8; ++i) kt[i] = t[i];
              lds_rd8<64, 16 * RS_SK, 16 * RS_SK + 64, 32 * RS_SK, 32 * RS_SK + 64, 48 * RS_SK, 48 * RS_SK + 64>(t, kp0 + 64 * RS_SK);
#pragma unroll
              for (int i = 0; i < 8; ++i) kt[8 + i] = t[i];
              kt[16] = *(const LAS bf16x8*)(Kim + (16 * (nq + 8) + r16) * RS_SK + 16 * g); kt[17] = *(const LAS bf16x8*)(Kim + (16 * (nq + 8) + r16) * RS_SK + 16 * g + 64); }
#endif
#pragma unroll
            for (int kb = 0; kb < 9; ++kb) {
                f32x4 a = (f32x4){0.f, 0.f, 0.f, 0.f};
                a = mfma16(kt[2 * kb], qf0, a); a = mfma16(kt[2 * kb + 1], qf1, a);
#pragma unroll
                for (int r = 0; r < 4; ++r) { const int dl = 16 * kb + 4 * g + r - r16; const bool vis = (dl >= 1) && (dl <= 128) && (nb > 0 || 16 * (nq + kb) + 4 * g + r >= 128);
                    a[r] = vis ? a[r] : -INFINITY; mx = fmaxf(mx, a[r]); }
                sc[kb] = a; }
            sc[9] = (f32x4){0.f, 0.f, 0.f, 0.f};
            mx = fmaxf(mx, __builtin_bit_cast(float, __builtin_amdgcn_ds_bpermute((lane ^ 16) << 2, __builtin_bit_cast(int, mx))));
            mx = fmaxf(mx, __builtin_bit_cast(float, __builtin_amdgcn_ds_bpermute((lane ^ 32) << 2, __builtin_bit_cast(int, mx))));
            float sum = 0.f;
#pragma unroll
            for (int kb = 0; kb < 9; ++kb)
#pragma unroll
                for (int r = 0; r < 4; ++r) { const float pv = __expf(sc[kb][r] - mx); sc[kb][r] = pv; sum += pv; }
            sum += __builtin_bit_cast(float, __builtin_amdgcn_ds_bpermute((lane ^ 16) << 2, __builtin_bit_cast(int, sum)));
            sum += __builtin_bit_cast(float, __builtin_amdgcn_ds_bpermute((lane ^ 32) << 2, __builtin_bit_cast(int, sum)));
            const float inv = 1.0f / (sum + __expf(sink - mx));
            f32x4 o[4];
#pragma unroll
            for (int nd = 0; nd < 4; ++nd) o[nd] = (f32x4){0.f, 0.f, 0.f, 0.f};
#pragma unroll
            for (int sk = 0; sk < 5; ++sk) { const bf16x8 pf = pack_frag(sc[2 * sk] * inv, sc[2 * sk + 1] * inv);
                const int kb0 = nq + 2 * sk, kb1 = (kb0 + 1 > 15) ? 15 : kb0 + 1;
                s16x4 t[8];
                lds_tr8<32, 64, 96>(t, lds_addr(Vim + (16 * kb0 + 4 * g + q) * RS_SV + 8 * pp), lds_addr(Vim + (16 * kb1 + 4 * g + q) * RS_SV + 8 * pp));
#pragma unroll
#if SWA_OT
                for (int nd = 0; nd < 4; ++nd) o[nd] = mfma16(cat44(t[nd], t[4 + nd]), pf, o[nd]); }
#pragma unroll
            for (int nd = 0; nd < 4; ++nd) { v2u w; w.x = cvt2(o[nd][0], o[nd][1]); w.y = cvt2(o[nd][2], o[nd][3]);
                *(v2u*)((char*)MIX + 2u * ((unsigned)(nb * 128 + 16 * nq + r16) * 2048u + (unsigned)(1024 + hq * 64 + 16 * nd + 4 * g))) = w; }
#else
                for (int nd = 0; nd < 4; ++nd) o[nd] = mfma16(pf, cat44(t[nd], t[4 + nd]), o[nd]); }
#pragma unroll
            for (int nd = 0; nd < 4; ++nd)
#pragma unroll
                for (int r = 0; r < 4; ++r) MIX[(size_t)(nb * 128 + 16 * nq + 4 * g + r) * 2048 + 1024 + hq * 64 + 16 * nd + r16] = (bf16)f2bf(o[nd][r]);
#endif
            if (fs_) {
#pragma unroll
                for (int j = 0; j < 16; ++j) { sut[(size_t)(16 * nq + j) * 131072] = cvt2(sr0, sr1); sr0 = sr0 * scd + bflo(su[j]); sr1 = sr1 * scd + bfhi(su[j]); } }
#if SWA_KWIN
#pragma unroll
            for (int i = 0; i < 16; ++i) kt[i] = kt[i + 2];
#endif
        }
    }
}

__device__ __forceinline__ void phase_groupnorm(const Params& P, const Ctx& cx, int l) {
    unsigned char* ws = cx.ws; const int lane = cx.lane, wave = cx.wave, G = cx.G;
    const float* RY = (const float*)(ws + WS_RETY); const bf16* Gt = (const bf16*)(ws + WS_G); bf16* MIX = (bf16*)(ws + WS_MIX);
    const float* gg = P.in[5] + l * 1024; const float* gb = P.in[6] + l * 1024;
    const int gw = cx.bid * 8 + wave, NGW = G * 8;
    for (int it = gw; it < S * 4; it += NGW) { const int row = it >> 2, h = it & 3; const size_t off = (size_t)row * 1024 + h * 256 + 4 * lane;
        f32x4 v = *(const f32x4*)(RY + off);
        const float mean = wave_sum((v[0] + v[1]) + (v[2] + v[3]), lane) * (1.0f / 256.0f);
        v = v - mean;
        const float var = wave_sum((v[0] * v[0] + v[1] * v[1]) + (v[2] * v[2] + v[3] * v[3]), lane) * (1.0f / 256.0f);
        const float rstd = 1.0f / sqrtf(var + GN_EPS);
        const f32x4 g4 = *(const f32x4*)(gg + h * 256 + 4 * lane), b4 = *(const f32x4*)(gb + h * 256 + 4 * lane);
        const v2u gt2 = *(const v2u*)(Gt + off);
        f32x4 o = v * rstd * g4 + b4;
        o[0] *= bflo(gt2.x); o[1] *= bfhi(gt2.x); o[2] *= bflo(gt2.y); o[3] *= bfhi(gt2.y);
        v2u w; w.x = pk2(o[0], o[1]); w.y = pk2(o[2], o[3]);
        *(v2u*)(MIX + (size_t)row * 2048 + h * 256 + 4 * lane) = w; }
}
__device__ __forceinline__ void phase_ln(const Ctx& cx, const float* Y, const float* g, const float* b, float* xo, bf16* xb, float* stats) {
    const int lane = cx.lane, wave = cx.wave, G = cx.G; const int gw = cx.bid * 8 + wave, NGW = G * 8;
    f32x4 g4[8], b4[8];
#pragma unroll
    for (int j = 0; j < 8; ++j) { g4[j] = ((const f32x4*)g)[64 * j + lane]; b4[j] = ((const f32x4*)b)[64 * j + lane]; }
    for (int row = gw; row < S; row += 2 * NGW) {
        const int row2 = row + NGW; const bool has2 = row2 < S; const int rb = has2 ? row2 : row;
        const f32x4* ya = (const f32x4*)(Y + (size_t)row * D) + lane; const f32x4* yb = (const f32x4*)(Y + (size_t)rb * D) + lane;
        f32x4 va[8], vb[8]; float sa = 0.f, sb = 0.f;
#pragma unroll
        for (int j = 0; j < 8; ++j) { va[j] = ya[64 * j]; vb[j] = yb[64 * j]; }
#pragma unroll
        for (int j = 0; j < 8; ++j) { sa += (va[j][0] + va[j][1]) + (va[j][2] + va[j][3]); sb += (vb[j][0] + vb[j][1]) + (vb[j][2] + vb[j][3]); }
        const float ma = wave_sum(sa, lane) * (1.0f / D), mb = wave_sum(sb, lane) * (1.0f / D); float qa = 0.f, qb = 0.f;
#pragma unroll
        for (int j = 0; j < 8; ++j) { va[j] = va[j] - ma; vb[j] = vb[j] - mb; qa += (va[j][0] * va[j][0] + va[j][1] * va[j][1]) + (va[j][2] * va[j][2] + va[j][3] * va[j][3]); qb += (vb[j][0] * vb[j][0] + vb[j][1] * vb[j][1]) + (vb[j][2] * vb[j][2] + vb[j][3] * vb[j][3]); }
        const float ra = 1.0f / sqrtf(wave_sum(qa, lane) * (1.0f / D) + LN_EPS), rbb = 1.0f / sqrtf(wave_sum(qb, lane) * (1.0f / D) + LN_EPS);
        f32x4* xa = (f32x4*)(xo + (size_t)row * D) + lane; f32x4* xbp = (f32x4*)(xo + (size_t)rb * D) + lane;
        if (stats && lane == 0) { stats[2 * (size_t)row] = ma; stats[2 * (size_t)row + 1] = ra; if (has2) { stats[2 * (size_t)rb] = mb; stats[2 * (size_t)rb + 1] = rbb; } }
#pragma unroll
        for (int j = 0; j < 8; ++j) { const f32x4 o = va[j] * ra * g4[j] + b4[j]; if (xo) xa[64 * j] = o;
            if (xb) { v2u w; w.x = pk2(o[0], o[1]); w.y = pk2(o[2], o[3]); ((v2u*)(xb + (size_t)row * D))[64 * j + lane] = w; } }
        if (has2) {
#pragma unroll
            for (int j = 0; j < 8; ++j) { const f32x4 o = vb[j] * rbb * g4[j] + b4[j]; if (xo) xbp[64 * j] = o;
                if (xb) { v2u w; w.x = pk2(o[0], o[1]); w.y = pk2(o[2], o[3]); ((v2u*)(xb + (size_t)rb * D))[64 * j + lane] = w; } } }
    }
}
__device__ __forceinline__ void phase_ln_h(const Ctx& cx, const _Float16* Y, const float* g, const float* b, float* xo, const bool own_panel) {
    typedef _Float16 h16x8_t __attribute__((ext_vector_type(8))); typedef float f32x8_t __attribute__((ext_vector_type(8)));
    const int lane = cx.lane, wave = cx.wave, G = cx.G; const int gw = cx.bid * 8 + wave, NGW = G * 8;
    const int pbase = (8 * (cx.bid & 7) + ((cx.bid >> 3) & 7)) * 256 + (cx.bid >> 6) * 64 + wave * 8;
    for (int it = 0, row = own_panel ? pbase : gw; own_panel ? it < 4 : row < S; ++it, row += own_panel ? 1 : 2 * NGW) {
        const int row2 = own_panel ? row + 4 : row + NGW; const bool has2 = row2 < S; const int rb = has2 ? row2 : row;
        const v4u* ya = (const v4u*)(Y + (size_t)row * D) + lane; const v4u* yb = (const v4u*)(Y + (size_t)rb * D) + lane;
        v4u ha[4], hb[4];
#pragma unroll
        for (int j = 0; j < 4; ++j) { ha[j] = ya[64 * j]; hb[j] = yb[64 * j]; }
        f32x8_t va[4], vb[4]; float sa = 0.f, sb = 0.f;
#pragma unroll
        for (int j = 0; j < 4; ++j) { va[j] = __builtin_convertvector(__builtin_bit_cast(h16x8_t, ha[j]), f32x8_t); vb[j] = __builtin_convertvector(__builtin_bit_cast(h16x8_t, hb[j]), f32x8_t);
#pragma unroll
            for (int e = 0; e < 8; ++e) { sa += va[j][e]; sb += vb[j][e]; } }
        const float ma = wave_sum(sa, lane) * (1.0f / D), mb = wave_sum(sb, lane) * (1.0f / D); float qa = 0.f, qb = 0.f;
#pragma unroll
        for (int j = 0; j < 4; ++j)
#pragma unroll
            for (int e = 0; e < 8; ++e) { va[j][e] -= ma; vb[j][e] -= mb; qa += va[j][e] * va[j][e]; qb += vb[j][e] * vb[j][e]; }
        const float ra = 1.0f / sqrtf(wave_sum(qa, lane) * (1.0f / D) + LN_EPS), rbb = 1.0f / sqrtf(wave_sum(qb, lane) * (1.0f / D) + LN_EPS);
#pragma unroll
        for (int j = 0; j < 4; ++j) { const int c0 = 8 * (64 * j + lane);
            const f32x4 g0 = *(const f32x4*)(g + c0), g1 = *(const f32x4*)(g + c0 + 4), b0 = *(const f32x4*)(b + c0), b1 = *(const f32x4*)(b + c0 + 4);
            { const f32x4 o0 = (f32x4){va[j][0], va[j][1], va[j][2], va[j][3]} * ra * g0 + b0, o1 = (f32x4){va[j][4], va[j][5], va[j][6], va[j][7]} * ra * g1 + b1;
              *(f32x4*)(xo + (size_t)row * D + c0) = o0; *(f32x4*)(xo + (size_t)row * D + c0 + 4) = o1; }
            if (has2) { const f32x4 o0 = (f32x4){vb[j][0], vb[j][1], vb[j][2], vb[j][3]} * rbb * g0 + b0, o1 = (f32x4){vb[j][4], vb[j][5], vb[j][6], vb[j][7]} * rbb * g1 + b1;
              *(f32x4*)(xo + (size_t)rb * D + c0) = o0; *(f32x4*)(xo + (size_t)rb * D + c0 + 4) = o1; } }
    }
}
__device__ __forceinline__ void unpack8(const v4u h, float (&o)[8]) { o[0] = bflo(h.x); o[1] = bfhi(h.x); o[2] = bflo(h.y); o[3] = bfhi(h.y); o[4] = bflo(h.z); o[5] = bfhi(h.z); o[6] = bflo(h.w); o[7] = bfhi(h.w); }
__device__ __forceinline__ void phase_convact(const Params& P, const Ctx& cx, int l) {
    unsigned char* ws = cx.ws; const int tid = cx.tid, G = cx.G;
    const bf16* H = (const bf16*)(ws + WS_H); bf16* ACT = (bf16*)(ws + WS_ACT);
    const float* cw = P.in[11] + (size_t)l * 3 * NUP; const float* cb = P.in[12] + (size_t)l * NUP;
    const int gt = cx.bid * 512 + tid, NT = G * 512;
    for (int item = gt; item < 512 * 704; item += NT) {
        const int seg = item / 704, r = item - seg * 704, tile = r >> 4, q8 = r & 15, t0 = seg * 32;
        const int chg = 128 * tile + 8 * q8, chu = DFF + chg;
        float wg[3][8], wu[3][8], bg[8], bu[8];
#pragma unroll
        for (int k = 0; k < 3; ++k) { const f32x4 a0 = *(const f32x4*)(cw + (size_t)k * NUP + chg), a1 = *(const f32x4*)(cw + (size_t)k * NUP + chg + 4), c0 = *(const f32x4*)(cw + (size_t)k * NUP + chu), c1 = *(const f32x4*)(cw + (size_t)k * NUP + chu + 4);
#pragma unroll
            for (int e = 0; e < 4; ++e) { wg[k][e] = a0[e]; wg[k][4 + e] = a1[e]; wu[k][e] = c0[e]; wu[k][4 + e] = c1[e]; } }
        { const f32x4 a0 = *(const f32x4*)(cb + chg), a1 = *(const f32x4*)(cb + chg + 4), c0 = *(const f32x4*)(cb + chu), c1 = *(const f32x4*)(cb + chu + 4);
#pragma unroll
          for (int e = 0; e < 4; ++e) { bg[e] = a0[e]; bg[4 + e] = a1[e]; bu[e] = c0[e]; bu[4 + e] = c1[e]; } }
        const bf16* hp = H + (size_t)t0 * NUP + 256 * tile + 8 * q8;
        float g2[8], g1[8], u2[8], u1[8];
        if (t0 > 0) { unpack8(*(const v4u*)(hp - 2 * (size_t)NUP), g2); unpack8(*(const v4u*)(hp - (size_t)NUP), g1); unpack8(*(const v4u*)(hp - 2 * (size_t)NUP + 128), u2); unpack8(*(const v4u*)(hp - (size_t)NUP + 128), u1); }
        else {
#pragma unroll
            for (int e = 0; e < 8; ++e) { g2[e] = 0.f; g1[e] = 0.f; u2[e] = 0.f; u1[e] = 0.f; } }
        bf16* ap = ACT + (size_t)t0 * DFF + chg;
        v4u ng = *(const v4u*)(hp), nu = *(const v4u*)(hp + 128);
#pragma unroll 2
        for (int tt = 0; tt < 32; ++tt) {
            float g0[8], u0[8]; unpack8(ng, g0); unpack8(nu, u0);
            if (tt < 31) { ng = *(const v4u*)(hp + (size_t)(tt + 1) * NUP); nu = *(const v4u*)(hp + (size_t)(tt + 1) * NUP + 128); }
            float o[8];
#pragma unroll
            for (int e = 0; e < 8; ++e) { const float ga = bg[e] + wg[0][e] * g2[e] + wg[1][e] * g1[e] + wg[2][e] * g0[e], ua = bu[e] + wu[0][e] * u2[e] + wu[1][e] * u1[e] + wu[2][e] * u0[e];
                o[e] = ga * __builtin_amdgcn_rcpf(1.0f + __expf(-ga)) * ua; g2[e] = g1[e]; g1[e] = g0[e]; u2[e] = u1[e]; u1[e] = u0[e]; }
            v4u w; w.x = cvt2(o[0], o[1]); w.y = cvt2(o[2], o[3]); w.z = cvt2(o[4], o[5]); w.w = cvt2(o[6], o[7]);
            *(v4u*)(ap + (size_t)tt * DFF) = w;
        }
    }
}

__device__ __forceinline__ void phase_conv_fixup(const Params& P, const Ctx& cx, int l, int base, int cnt, int first, int stride) {
    unsigned char* ws = cx.ws;
    const bf16* HALO = (const bf16*)(ws + WS_H); bf16* ACT = (bf16*)(ws + WS_ACT);
    const float* cw = P.in[11] + (size_t)l * 3 * NUP; const float* cb = P.in[12] + (size_t)l * NUP;
    for (int idx = first; idx < cnt; idx += stride) { const int item = base + idx;
        const int k = item / 704, r = item - k * 704, tile = r >> 4, q8 = r & 15, chg = 128 * tile + 8 * q8, chu = DFF + chg;
        float a_g[8], b_g[8], c_g[8], d_g[8], a_u[8], b_u[8], c_u[8], d_u[8];
        const bf16* hk = HALO + (size_t)k * 4 * NUP + 256 * tile + 8 * q8;
        unpack8(*(const v4u*)(hk), c_g); unpack8(*(const v4u*)(hk + NUP), d_g); unpack8(*(const v4u*)(hk + 128), c_u); unpack8(*(const v4u*)(hk + NUP + 128), d_u);
        if (k > 0) { const bf16* hm = hk - 4 * (size_t)NUP; unpack8(*(const v4u*)(hm + 2 * NUP), a_g); unpack8(*(const v4u*)(hm + 3 * NUP), b_g); unpack8(*(const v4u*)(hm + 2 * NUP + 128), a_u); unpack8(*(const v4u*)(hm + 3 * NUP + 128), b_u); }
        else {
#pragma unroll
            for (int e = 0; e < 8; ++e) { a_g[e] = 0.f; b_g[e] = 0.f; a_u[e] = 0.f; b_u[e] = 0.f; } }
        float o0[8], o1[8];
#pragma unroll
        for (int e = 0; e < 8; ++e) { const float w0g = cw[chg + e], w1g = cw[NUP + chg + e], w2g = cw[2 * NUP + chg + e], bgv = cb[chg + e], w0u = cw[chu + e], w1u = cw[NUP + chu + e], w2u = cw[2 * NUP + chu + e], buv = cb[chu + e];
            const float g0 = bgv + w0g * a_g[e] + w1g * b_g[e] + w2g * c_g[e], u0 = buv + w0u * a_u[e] + w1u * b_u[e] + w2u * c_u[e];
            const float g1 = bgv + w0g * b_g[e] + w1g * c_g[e] + w2g * d_g[e], u1 = buv + w0u * b_u[e] + w1u * c_u[e] + w2u * d_u[e];
            o0[e] = g0 * __builtin_amdgcn_rcpf(1.0f + __expf(-g0)) * u0; o1[e] = g1 * __builtin_amdgcn_rcpf(1.0f + __expf(-g1)) * u1; }
        v4u w0, w1; w0.x = cvt2(o0[0], o0[1]); w0.y = cvt2(o0[2], o0[3]); w0.z = cvt2(o0[4], o0[5]); w0.w = cvt2(o0[6], o0[7]); w1.x = cvt2(o1[0], o1[1]); w1.y = cvt2(o1[2], o1[3]); w1.z = cvt2(o1[4], o1[5]); w1.w = cvt2(o1[6], o1[7]);
        *(v4u*)(ACT + pg8::tiled_off(64 * k, chg, DFF)) = w0; *(v4u*)(ACT + pg8::tiled_off(64 * k + 1, chg, DFF)) = w1;
    }
}

#ifdef DBG_DUMP
__device__ __forceinline__ void phase_dump(const Ctx& cx, float* out, const bf16* a, int lda, const bf16* b, int ldb, const float* f) {
    const size_t gt = (size_t)cx.bid * 512 + cx.tid, NT = (size_t)cx.G * 512;
    for (size_t i = gt; i < (size_t)S * D; i += NT) { const int row = (int)(i >> 11), col = (int)(i & 2047);
        float v; if (f) v = f[i]; else if (b && col >= 1024) v = bf1(b + (size_t)row * ldb + (col - 1024)); else v = lda ? bf1(a + (size_t)row * lda + col) : bf1(a + (size_t)(row & 2047) * 2048 + col);
        out[i] = v; }
}
#endif
__device__ __forceinline__ void finalize_panel_stats(const Ctx& cx, const float* pstat, float* st, int pm) {
    const int tid = cx.tid, lane = cx.lane, row = pm * 256 + (tid >> 1), hf = tid & 1;
    float s1 = 0.f, s2 = 0.f;
#if PST_T
    const pg8::f32x2* pp = (const pg8::f32x2*)(pstat + ((size_t)(16 * hf) * S + row) * 2);
#pragma unroll
    for (int k = 0; k < 16; ++k) { const pg8::f32x2 v = pp[(size_t)k * S]; s1 += v[0]; s2 += v[1]; }
#else
    const f32x4* pp = (const f32x4*)(pstat + ((size_t)row * 32 + 16 * hf) * 2);
#pragma unroll
    for (int k = 0; k < 8; ++k) { const f32x4 v = pp[k]; s1 += v[0] + v[2]; s2 += v[1] + v[3]; }
#endif
    s1 += __builtin_bit_cast(float, __builtin_amdgcn_ds_bpermute((lane ^ 1) << 2, __builtin_bit_cast(int, s1)));
    s2 += __builtin_bit_cast(float, __builtin_amdgcn_ds_bpermute((lane ^ 1) << 2, __builtin_bit_cast(int, s2)));
    const float mean = s1 * (1.0f / D), var = fmaxf(s2 * (1.0f / D) - mean * mean, 0.f), rstd = 1.0f / sqrtf(var + LN_EPS);
    if (!hf) *(pg8::f32x2*)(st + 2 * (size_t)row) = (pg8::f32x2){mean, rstd};
}
template <class Sched> __device__ __forceinline__ void finalize_stats_for(const Ctx& cx, const Sched& So, const float* pstat, float* st) {
    int last = -1; pg8::Unit u;
    for (int i = 0; So.next(i, u); ++i) if (u.pm != last) { finalize_panel_stats(cx, pstat, st, u.pm); last = u.pm; }
    asm volatile("s_waitcnt vmcnt(0)" ::: "memory"); __syncthreads();
}
__device__ __forceinline__ void panel_barrier(unsigned* cnt, unsigned target, unsigned* bar) {
    asm volatile("s_waitcnt vmcnt(0)" ::: "memory");
    __syncthreads();
    if (threadIdx.x == 0) {
        __builtin_amdgcn_s_waitcnt(0);
        __builtin_amdgcn_fence(__ATOMIC_RELEASE, "agent");
        asm volatile("s_waitcnt vmcnt(0)" ::: "memory");
        (void)xb_add(cnt, 1u);
        XB_SPIN(xb_ld(cnt) < target, bar);
        __builtin_amdgcn_fence(__ATOMIC_ACQUIRE, "agent");
        asm volatile("s_waitcnt vmcnt(0)" ::: "memory");
    }
    __syncthreads();
}
__device__ __forceinline__ void panel_barrier_local(unsigned* cnt, unsigned target, unsigned* bar) {
    asm volatile("s_waitcnt vmcnt(0)" ::: "memory");
    __syncthreads();
    if (threadIdx.x == 0) {
        __builtin_amdgcn_s_waitcnt(0);
        (void)xb_add(cnt, 1u);
        XB_SPIN(xb_ld(cnt) < target, bar);
        __builtin_amdgcn_fence(__ATOMIC_ACQUIRE, "agent");
        asm volatile("s_waitcnt vmcnt(0)" ::: "memory");
    }
    __syncthreads();
}
__global__ void __launch_bounds__(512, 2) fwd(Params P) {
    extern __shared__ __attribute__((aligned(16))) unsigned char lds_raw[];
    LAS unsigned char* lds = (LAS unsigned char*)lds_raw;
#if CODE_PAD > 0
    asm volatile(".rept %0\n\ts_nop 0\n\t.endr" :: "n"(CODE_PAD));
#endif
    const int wave = __builtin_amdgcn_readfirstlane(threadIdx.x >> 6), G = gridDim.x;
    unsigned char* ws = P.ws;
    volatile LAS unsigned* MISC = (volatile LAS unsigned*)(lds + MISC_OFF);
    for (int u = threadIdx.x; u < (LDS_BYTES - LDSCTL_OFF) / 4; u += 512) ((LAS unsigned*)(lds + LDSCTL_OFF))[u] = 0u;
    __syncthreads();
    const int lo = P.ph_lo, hi = P.ph_hi; const int cx0G = G;
#if PROBE_DUP == 60
    if (wave == 0 && lane_id_asm() == 0) { const unsigned long long c0_ = __builtin_amdgcn_s_memtime(), r0_ = __builtin_amdgcn_s_memrealtime(); MISC[34] = (unsigned)c0_; MISC[35] = (unsigned)(c0_ >> 32); MISC[36] = (unsigned)r0_; MISC[37] = (unsigned)(r0_ >> 32); }
#endif
    XcdBarrier bar; bar.bar = (unsigned*)(ws + WS_CTL) + CW_BAR; bar.x = 0; bar.st = nullptr;
    if (hi - lo > 1) { bar = xcd_barrier_post((unsigned*)(ws + WS_CTL) + CW_BAR, MISC + 8);
        if (threadIdx.x == 0) ((unsigned*)(ws + WS_CTL))[CW_XT + blockIdx.x] = bar.x + 1u; }
#define IN(k) (lo <= (k) && (k) < hi)
#if PROBE_DUP == 20
#define SEAM(k) do { if (IN(k) && IN((k) + 1)) { xcd_barrier(bar); xcd_barrier(bar); } } while (0)
#elif PROBE_DUP == 40
#define SEAM(k) do { if (IN(k) && IN((k) + 1)) { if (wave == 0 && lane_id_asm() == 0) MISC[33] = (unsigned)__builtin_amdgcn_s_memrealtime(); xcd_barrier(bar); if (wave == 0 && lane_id_asm() == 0 && (k) > 0 && ((PROBE_MASK >> (((k) - 1) % NPH)) & 1)) MISC[32] = MISC[32] + ((unsigned)__builtin_amdgcn_s_memrealtime() - MISC[33]); } } while (0)
#else
#define SEAM(k) do { if (IN(k) && IN((k) + 1)) xcd_barrier(bar); } while (0)
#endif
#define OPQ() Ctx cx; cx.lane = lane_id_asm(); { int t_ = wave; asm volatile("" : "+s"(t_)); cx.wave = t_; } { int t_ = G; asm volatile("" : "+s"(t_)); cx.G = t_; } { int t_ = blockIdx.x; asm volatile("" : "+s"(t_)); cx.bid = t_; } \
    { unsigned t_ = 0u; asm volatile("" : "+s"(t_)); cx.ws = P.ws + t_; } cx.tid = cx.wave * 64 + cx.lane; int lq = l; asm volatile("" : "+s"(lq)); (void)lq

#ifdef DBG_DUMP
    if (lo >= 1000) { const int l = 0; OPQ(); unsigned char* w = cx.ws; const int kind = lo - 1000;
        if (kind == 1) phase_dump(cx, P.out, (const bf16*)(w + WS_Q), 1024, (const bf16*)(w + WS_AQ), 1024, nullptr);
        else if (kind == 2) phase_dump(cx, P.out, (const bf16*)(w + WS_MIX), 2048, nullptr, 0, nullptr);
        else if (kind == 3) phase_dump(cx, P.out, nullptr, 0, nullptr, 0, (const float*)(w + WS_XR));
        else if (kind == 4) phase_dump(cx, P.out, (const bf16*)(w + WS_ACT), DFF, nullptr, 0, nullptr);
        else if (kind == 5) phase_dump(cx, P.out, nullptr, 0, nullptr, 0, (const float*)(w + WS_Y));
        else if (kind == 6) phase_dump(cx, P.out, (const bf16*)(w + WS_K), 1024, (const bf16*)(w + WS_V), 1024, nullptr);
        else if (kind == 7) phase_dump(cx, P.out, (const bf16*)(w + WS_XB), 2048, nullptr, 0, nullptr);
        else if (kind == 11) phase_dump(cx, P.out, (const bf16*)(w + WS_W + WL_G), 0, nullptr, 0, nullptr);
        else if (kind == 12) phase_dump(cx, P.out, (const bf16*)(w + WS_W + WL_OUT), 0, nullptr, 0, nullptr);
        else if (kind == 10) phase_dump(cx, P.out, (const bf16*)(w + WS_H) + 36 * 256, NUP, nullptr, 0, nullptr);
        else if (kind == 9) phase_dump(cx, P.out, (const bf16*)(w + WS_SG), 2048, nullptr, 0, nullptr);
        else if (kind == 8) phase_dump(cx, P.out, nullptr, 0, nullptr, 0, (const float*)(w + WS_RETY));
        return; }
#endif
    if (IN(0)) { const int l = 0; REPS(9) { __syncthreads(); OPQ(); phase_prologue(P, cx, lds); } }
    SEAM(0);
#if XLOC
    if (IN(0) && IN(1)) { const unsigned* xt = (const unsigned*)(ws + WS_CTL) + CW_XT; const int t = wave * 64 + lane_id_asm();
        const int ok = __syncthreads_and((G == 4 * (S / 256)) && (t >= G || (xt[t] != 0u && xt[t] == xt[t & 7])));
#if PROBE_DUP == 70
        if (!ok) { const unsigned long long t0_ = __builtin_amdgcn_s_memrealtime(); while (__builtin_amdgcn_s_memrealtime() - t0_ < 50000ull) __builtin_amdgcn_s_sleep(8); }
#endif
#ifdef FORCE_NOLOCAL
        if (t == 0) MISC[40] = 0u;
#else
        if (t == 0) MISC[40] = ok ? 1u : 0u;
#endif
        __syncthreads(); }
#if PROBE_DUP == 40
#define SEAM_L(k) do { if (IN(k) && IN((k) + 1)) { if (wave == 0 && lane_id_asm() == 0) MISC[33] = (unsigned)__builtin_amdgcn_s_memrealtime(); if (__builtin_amdgcn_readfirstlane((int)MISC[40])) xcd_barrier_local(bar); else xcd_barrier(bar); \
    if (wave == 0 && lane_id_asm() == 0 && (k) > 0 && ((PROBE_MASK >> (((k) - 1) % NPH)) & 1)) MISC[32] = MISC[32] + ((unsigned)__builtin_amdgcn_s_memrealtime() - MISC[33]); } } while (0)
#else
#define SEAM_L(k) do { if (IN(k) && IN((k) + 1)) { if (__builtin_amdgcn_readfirstlane((int)MISC[40])) xcd_barrier_local(bar); else xcd_barrier(bar); } } while (0)
#endif
#if PANEL_SEAMS
#define SEAM_P(k, j) do { if (IN(k) && IN((k) + 1)) { if (__builtin_amdgcn_readfirstlane((int)MISC[40])) { unsigned* ctl_ = (unsigned*)(ws + WS_CTL); const int c_ = blockIdx.x; \
        panel_barrier_local(ctl_ + CW_PANEL + 64 * (8 * (c_ & 7) + ((c_ >> 3) & 7)), 4u * (unsigned)(3 * l + (j) + 1), ctl_ + CW_BAR); } else xcd_barrier(bar); } } while (0)
#else
#define SEAM_P(k, j) SEAM_L(k)
#endif
#else
#define SEAM_L(k) SEAM(k)
#define SEAM_P(k, j) SEAM(k)
#endif

    for (int l = 0; l < DEPTH; ++l) {
        const int pb = 1 + l * NPH;
#if LN_FUSED
        if (l == 0 && IN(pb + 0)) { OPQ(); const float* cp = (const float*)(cx.ws + WS_CP); float* cc = (float*)(cx.ws + WS_C);
            for (int i = cx.bid * 512 + cx.tid; i < DEPTH * C_L; i += cx.G * 512) { float a = 0.f;
                if (i >= 2 * INW) {
#pragma unroll 8
                    for (int kc = 0; kc < 32 / PRO_NKB; ++kc) a += cp[(size_t)kc * DEPTH * C_L + i]; }
                cc[i] = a; } }
#endif
        if (IN(pb + 0)) { REPS(3) { OPQ(); unsigned char* w = cx.ws; const bf16* wl = (const bf16*)(w + WS_W + (size_t)lq * WL_BYTES);
            pg8::Gemm g{(const bf16*)(w + WS_XB), wl + WL_IN / 2, S, INW, D}; pg8::InProjOrder So; So.init(S, INW, cx.G, cx.bid);
            So.kv = (MERGE_R1 && XLOC && __builtin_amdgcn_readfirstlane((int)MISC[40])) ? (unsigned*)(w + WS_CTL) + CW_KV + 64 * (cx.bid & 7) : (unsigned*)nullptr;
#if LN_FUSED
            if (lq > 0) { const float* cl = (const float*)(w + WS_C) + (size_t)lq * C_L;
                finalize_stats_for(cx, So, (const float*)(w + WS_PSTAT), (float*)(w + WS_ST2));
                pg8::EpiInProjT<true> E{(bf16*)(w + WS_Q), (bf16*)(w + WS_K), (bf16*)(w + WS_V), (bf16*)(w + WS_G), (bf16*)(w + WS_AQ), (bf16*)(w + WS_AK), (bf16*)(w + WS_AV),
                                        (const float*)(w + WS_COSR), (const float*)(w + WS_SINR), (const float*)(w + WS_COSA), (const float*)(w + WS_SINA), (const float*)(w + WS_ST2), cl + C1IN, cl + C2IN};
                pg8::gemm_phase<pg8::EpiInProjT<true>, pg8::InProjOrder, true, true>(lds, g, So, E, cx.wave); }
            else
#endif
            { pg8::EpiInProj E{(bf16*)(w + WS_Q), (bf16*)(w + WS_K), (bf16*)(w + WS_V), (bf16*)(w + WS_G), (bf16*)(w + WS_AQ), (bf16*)(w + WS_AK), (bf16*)(w + WS_AV),
                             (const float*)(w + WS_COSR), (const float*)(w + WS_SINR), (const float*)(w + WS_COSA), (const float*)(w + WS_SINA), nullptr, nullptr, nullptr};
              pg8::gemm_phase<pg8::EpiInProj, pg8::InProjOrder, true, true>(lds, g, So, E, cx.wave); }
        } }
#if PLE_EARLY
        if (IN(pb + 0)) { REPS(71) { OPQ(); unsigned char* w = cx.ws; const bf16* wl = (const bf16*)(w + WS_W + (size_t)lq * WL_BYTES);
            const int nsub = (cx.G > 64) ? cx.G - 64 : cx.G, csub = (cx.G > 64) ? cx.bid - 64 : cx.bid;
            if (csub >= 0) {
                int kple = PLE; asm volatile("" : "+s"(kple));
                pg8::Gemm g{(const bf16*)(w + WS_PB) + (size_t)lq * S * PLE, wl + WL_P / 2, S, D, kple};
#if PLE_BAL
                if (cx.G == 4 * (S / 256)) { pg8::PleOrder So; So.a.init(S, D, 192, csub); So.b.init(S, D, 64, csub >= 128 ? csub - 128 : 0); So.extra = csub >= 128;
                    pg8::EpiPlain E{(bf16*)(w + ((lq & 1) ? WS_PP2 : WS_PP))};
                    pg8::gemm_phase<pg8::EpiPlain, pg8::PleOrder, true, true>(lds, g, So, E, cx.wave); }
                else
#endif
                { pg8::StaticOrder So; So.init(S, D, nsub, csub);
                  pg8::EpiPlain E{(bf16*)(w + ((lq & 1) ? WS_PP2 : WS_PP))};
                  pg8::gemm_phase<pg8::EpiPlain, pg8::StaticOrder, PLE_ALIGN, true>(lds, g, So, E, cx.wave); } }
#if W_LATE
            if (csub >= 0 && lq + 1 < DEPTH) { __syncthreads();
                constexpr int KCH = 32 / PRO_NKB, U_OUT = 32 * KCH, U_DN = 32 * (88 / PRO_NKB);
                const int l1 = lq + 1; bf16* wl1 = (bf16*)(w + WS_W + (size_t)l1 * WL_BYTES); LAS float* scr = (LAS float*)(lds + cx.wave * 16896);
                for (int r = csub * 8 + cx.wave; r < U_OUT + U_DN; r += nsub * 8) {
                    const bool isout = r < U_OUT; const int rr = isout ? r : r - U_OUT, per = isout ? KCH : 88 / PRO_NKB, g = rr / per, kc = rr % per;
                    transpose_unit(isout ? P.in[4] + (size_t)l1 * D * D : P.in[13] + (size_t)l1 * DFF * D, isout ? D : DFF, D, 64 * g, 64 * g + 32, isout ? wl1 + WL_OUT / 2 : wl1 + WL_DOWN / 2, 64 * g, PRO_NKB * kc, PRO_NKB, scr, cx.lane, isout ? 0 : 1,
                                   nullptr, nullptr, nullptr, nullptr); }
                __syncthreads(); }
#endif
        } }
#endif
#if MERGE_R1 && XLOC && RET_MFMA
        if (IN(pb + 0)) { const int xl = __builtin_amdgcn_readfirstlane((int)MISC[40]);
            if (xl) { if (blockIdx.x >= 64) { unsigned* ctl_ = (unsigned*)(ws + WS_CTL); unsigned* kvp = ctl_ + CW_KV + 64 * (blockIdx.x & 7);
                    if (wave == 0 && lane_id_asm() == 0) { XB_SPIN(xb_ld(kvp) < 512u * (unsigned)(l + 1), ctl_ + CW_BAR); __builtin_amdgcn_fence(__ATOMIC_ACQUIRE, "agent"); asm volatile("s_waitcnt vmcnt(0)" ::: "memory"); }
                    __syncthreads(); } }
            else if (IN(pb + 1)) xcd_barrier(bar);
            { REPS(6) { OPQ(); phase_ret_u_mfma(P, cx, lds, xl != 0); } } }
#else
        SEAM_L(pb + 0);
#endif
        if (IN(pb + 1)) {
#if RET_MFMA
#if !(MERGE_R1 && XLOC)
            { REPS(6) { OPQ(); phase_ret_u_mfma(P, cx, lds, false); } }
#endif
#else
            { OPQ(); phase_ret_u_scores(P, cx, lds); }
#endif
#if SWA_MFMA
#if !XLOC
            { REPS(8) { OPQ(); phase_swa_mfma(P, cx, lq, lds); } }
#endif
#else
            { OPQ(); phase_swa(P, cx, lq, lds); }
#endif
        }
        SEAM(pb + 1);
#if RET_MFMA
        if (IN(pb + 2)) { OPQ(); if (!(FUSE_SCAN && XLOC && SWA_MFMA && !SWA_IN_P3 && cx.G == 4 * (S / 256))) phase_scan_bf16(P, cx); }
#if XLOC && SWA_MFMA && !SWA_IN_P3
        if (IN(pb + 2)) { REPS(8) { OPQ(); phase_swa_mfma(P, cx, lq, lds); } }
#endif
        SEAM(pb + 2);
#if XLOC && SWA_MFMA && SWA_IN_P3
        if (IN(pb + 3)) { int swa_first = (blockIdx.x >> 3) & 1; asm volatile("" : "+s"(swa_first));
            for (int step = 0; step < 2; ++step) {
                if ((step == 0) == (swa_first != 0)) { OPQ(); phase_swa_mfma(P, cx, lq, lds); }
                else { OPQ(); phase_ret_out_mfma(P, cx, lq, lds); } } }
#else
        if (IN(pb + 3)) { REPS(7) { OPQ(); phase_ret_out_mfma(P, cx, lq, lds); } }
#endif
        SEAM_L(pb + 3);
#else
        if (IN(pb + 2)) { OPQ(); phase_scan(P, cx); }
        SEAM(pb + 2);
        if (IN(pb + 3)) { OPQ(); phase_ret_out(P, cx, lds); }
        SEAM(pb + 3);
        if (IN(pb + 4)) { OPQ(); phase_groupnorm(P, cx, lq); }
        SEAM(pb + 4);
#endif
        if (IN(pb + 5)) { OPQ(); unsigned char* w = cx.ws; const bf16* wl = (const bf16*)(w + WS_W + (size_t)lq * WL_BYTES);
            pg8::Gemm g{(const bf16*)(w + WS_MIX), wl + WL_OUT / 2, S, D, D}; pg8::StaticOrder So; So.init(S, D, cx.G, cx.bid);
#if LN_FUSED
#if RES_BF16
            if (lq == 0) { pg8::EpiRes3<false, false> E{P.in[0], nullptr, (bf16*)(w + WS_XB), (_Float16*)(w + WS_YH), (float*)(w + WS_PSTAT), nullptr, nullptr, nullptr, nullptr, nullptr, YHW_ARG ALPHA};
                pg8::gemm_phase<pg8::EpiRes3<false, false>, pg8::StaticOrder, true, true>(lds, g, So, E, cx.wave); }
            else { pg8::EpiRes3<true, false> E{nullptr, nullptr, (bf16*)(w + WS_XB), (_Float16*)(w + WS_YH), (float*)(w + WS_PSTAT), (const float*)(w + WS_ST2), P.in[14] + (lq - 1) * D, P.in[15] + (lq - 1) * D, nullptr, nullptr, YHW_ARG ALPHA};
                pg8::gemm_phase<pg8::EpiRes3<true, false>, pg8::StaticOrder, true, true>(lds, g, So, E, cx.wave); }
#else
            if (lq == 0) { pg8::EpiRes2<false, false, true> E{P.in[0], (float*)(w + WS_Y), (bf16*)(w + WS_XB), (float*)(w + WS_PSTAT), nullptr, nullptr, nullptr, nullptr, nullptr, ALPHA};
                pg8::gemm_phase<pg8::EpiRes2<false, false, true>, pg8::StaticOrder, true, true>(lds, g, So, E, cx.wave); }
            else { pg8::EpiRes2<true, false, true> E{nullptr, (float*)(w + WS_Y), (bf16*)(w + WS_XB), (float*)(w + WS_PSTAT), (const float*)(w + WS_ST2), P.in[14] + (lq - 1) * D, P.in[15] + (lq - 1) * D, nullptr, nullptr, ALPHA};
                pg8::gemm_phase<pg8::EpiRes2<true, false, true>, pg8::StaticOrder, true, true>(lds, g, So, E, cx.wave); }
#endif
#elif LN_NOXR
            if (lq == 0) { pg8::EpiResid<false> E{P.in[0], (float*)(w + WS_Y), ALPHA};
                pg8::gemm_phase<pg8::EpiResid<false>, pg8::StaticOrder, true, true>(lds, g, So, E, cx.wave); }
            else {
#if PROBE_DUP == 30
                { pg8::EpiResidLN<false> E{(float*)(w + WS_Y), (float*)(w + WS_XR + 2 * MiB), (const float*)(w + WS_ST2), P.in[14] + (lq - 1) * D, P.in[15] + (lq - 1) * D, nullptr, nullptr, ALPHA};
                  pg8::gemm_phase<pg8::EpiResidLN<false>, pg8::StaticOrder, true, true>(lds, g, So, E, cx.wave); }
#endif
                pg8::EpiResidLN<false> E{(float*)(w + WS_Y), (float*)(w + WS_Y), (const float*)(w + WS_ST2), P.in[14] + (lq - 1) * D, P.in[15] + (lq - 1) * D, nullptr, nullptr, ALPHA};
                pg8::gemm_phase<pg8::EpiResidLN<false>, pg8::StaticOrder, true, true>(lds, g, So, E, cx.wave); }
#else
            pg8::EpiResid<false> E{(lq == 0) ? P.in[0] : (const float*)(w + WS_XR), (float*)(w + WS_Y), ALPHA};
            pg8::gemm_phase<pg8::EpiResid<false>, pg8::StaticOrder, true, true>(lds, g, So, E, cx.wave);
#endif
        }
        SEAM_P(pb + 5, 0);
#if !LN_FUSED
        if (IN(pb + 6)) { REPS(1) { OPQ(); unsigned char* w = cx.ws;
#if LN_NOXR
            phase_ln(cx, (const float*)(w + WS_Y), P.in[8] + lq * D, P.in[9] + lq * D, (float*)nullptr, (bf16*)(w + WS_XB), (float*)(w + WS_ST1));
#else
            phase_ln(cx, (const float*)(w + WS_Y), P.in[8] + lq * D, P.in[9] + lq * D, (float*)(w + WS_XR), (bf16*)(w + WS_XB), (float*)nullptr);
#endif
        } }
        SEAM(pb + 6);
#endif
#if PROBE_DUP == 61 || PROBE_DUP == 62
        if (IN(pb + 7)) { OPQ(); unsigned char* w = cx.ws; const bf16* wl = (const bf16*)(w + WS_W + (size_t)lq * WL_BYTES);
            pg8::Gemm g{(const bf16*)(w + WS_XB), wl + WL_UP / 2, S, NUPG, D};
#if PROBE_DUP == 61
            pg8::HotOrder So; So.init(S, NUPG, cx.G, cx.bid); pg8::EpiNull E0; pg8::gemm_phase<pg8::EpiNull, pg8::HotOrder, true, true>(lds, g, So, E0, cx.wave);
#else
            pg8::StaticOrder So; So.init(S, NUPG, cx.G, cx.bid); pg8::EpiNull E0; pg8::gemm_phase<pg8::EpiNull, pg8::StaticOrder, true, true>(lds, g, So, E0, cx.wave);
#endif
        }
#endif
#if PROBE_DUP >= 90 && PROBE_DUP <= 93
#undef REPS
#define REPS(k) int nrep_ = ((k) == 5) ? 2 : 1; asm volatile("" : "+s"(nrep_)); for (int rep_ = 0; rep_ < nrep_; ++rep_)
#endif
        if (IN(pb + 7)) { REPS(5) { OPQ(); unsigned char* w = cx.ws; const bf16* wl = (const bf16*)(w + WS_W + (size_t)lq * WL_BYTES);
            pg8::Gemm g{(const bf16*)(w + WS_XB), wl + WL_UP / 2, S, NUPG, D}; UPORDER So; So.init(S, NUPG, cx.G, cx.bid);
#if UP_SYNC && !UP_ROT
            So.cnt = (XLOC && __builtin_amdgcn_readfirstlane((int)MISC[40])) ? (unsigned*)(w + WS_CTL) + CW_US + 64 * (cx.bid & 7) : (unsigned*)nullptr; So.nloc = 32u;
#endif
#if LN_FUSED
            { const float* cl = (const float*)(w + WS_C) + (size_t)lq * C_L;
              finalize_stats_for(cx, So, (const float*)(w + WS_PSTAT), (float*)(w + WS_ST1));
              pg8::EpiUpConvT<true> E{(bf16*)(w + WS_ACT), (bf16*)(w + WS_H), (bf16*)(w + WS_SG), P.in[17] + lq * D, P.in[11] + (size_t)lq * 3 * NUP, P.in[12] + (size_t)lq * NUP, (const float*)(w + WS_ST1), cl + C1UP, cl + C2UP,
                                      (const _Float16*)(w + WS_YH), (const bf16*)(w + ((lq & 1) ? WS_PP2 : WS_PP)), P.in[8] + lq * D, P.in[9] + lq * D, ALPHA, (unsigned)(unsigned long)(lds + RING_BYTES)
#if PROBE_DUP >= 90 && PROBE_DUP <= 93
                                      , (nrep_ == 2 && rep_ == 0) ? (PROBE_DUP - 90) : 0
#endif
                                      };
              pg8::gemm_phase<pg8::EpiUpConvT<true>, UPORDER, true, UP_SP2>(lds, g, So, E, cx.wave); }
#elif CONV_FUSED
            pg8::EpiUpConv E{(bf16*)(w + WS_ACT), (bf16*)(w + WS_H), (bf16*)(w + WS_SG), P.in[17] + lq * D, P.in[11] + (size_t)lq * 3 * NUP, P.in[12] + (size_t)lq * NUP, nullptr, nullptr, nullptr};
            pg8::gemm_phase<pg8::EpiUpConv, pg8::StaticOrder, true, true>(lds, g, So, E, cx.wave);
#else
            pg8::EpiUp E{(bf16*)(w + WS_H), (bf16*)(w + WS_SG), P.in[17] + lq * D};
            pg8::gemm_phase<pg8::EpiUp, pg8::StaticOrder, true, true>(lds, g, So, E, cx.wave);
#endif
        } }
#if HALO_WT && XLOC && CONV_FUSED
        if (IN(pb + 7) && IN(pb + 8)) {
            if (__builtin_amdgcn_readfirstlane((int)MISC[40])) { unsigned* ctl_ = (unsigned*)(ws + WS_CTL); const int c_ = blockIdx.x, cls_ = c_ & 7, pic_ = (c_ >> 3) & 7;
                if (pic_ == 7) { asm volatile("s_waitcnt vmcnt(0)" ::: "memory"); __syncthreads(); if (wave == 0 && lane_id_asm() == 0) (void)xb_add(ctl_ + CW_HB + 64 * cls_, 1u); }
                xcd_barrier_local(bar);
                if (pic_ == 0 && cls_ > 0) { if (wave == 0 && lane_id_asm() == 0) { XB_SPIN(xb_ld(ctl_ + CW_HB + 64 * (cls_ - 1)) < 4u * (unsigned)(l + 1), ctl_ + CW_BAR); __builtin_amdgcn_fence(__ATOMIC_ACQUIRE, "agent"); asm volatile("s_waitcnt vmcnt(0)" ::: "memory"); }
                    __syncthreads(); } }
            else xcd_barrier(bar); }
#else
        SEAM(pb + 7);
#endif
        if (IN(pb + 8)) {
#if !PLE_EARLY
            { OPQ(); unsigned char* w = cx.ws; const bf16* wl = (const bf16*)(w + WS_W + (size_t)lq * WL_BYTES);
              pg8::Gemm g{(const bf16*)(w + WS_PB) + (size_t)lq * S * PLE, wl + WL_P / 2, S, D, PLE}; pg8::StaticOrder So; So.init(S, D, cx.G, cx.bid);
              pg8::EpiPle E{(const bf16*)(w + WS_SG), (float*)(w + WS_Y)};
              pg8::gemm_phase<pg8::EpiPle, pg8::StaticOrder, true, true>(lds, g, So, E, cx.wave); }
#endif
#if CONV_FUSED
            { OPQ(); int base = 0, cnt = 256 * 704, first = cx.bid * 512 + cx.tid, stride = cx.G * 512, pmq = -1;
              if ((P8_LOCAL || XLOC) && cx.G == 4 * (S / 256) && IN(pb + 9)) { const int c = cx.bid, pm0 = 8 * (c & 7) + ((c >> 3) & 7), j0 = c >> 6;
                  base = pm0 * 2816; cnt = 2816; first = j0 * 512 + cx.tid; stride = 2048; pmq = pm0;
#if FIX_RED
                  if (__builtin_amdgcn_readfirstlane((int)MISC[40])) { first = cx.tid; stride = 512; }
#endif
              }
              phase_conv_fixup(P, cx, lq, base, cnt, first, stride);
              if (P8_LOCAL && pmq >= 0) panel_barrier((unsigned*)(cx.ws + WS_CTL) + CW_PANEL + 64 * pmq, 4u * (unsigned)(lq + 1), (unsigned*)(cx.ws + WS_CTL) + CW_BAR); }
#else
            { REPS(1) { OPQ(); phase_convact(P, cx, lq); } }
#endif
        }
#if P8_LOCAL && CONV_FUSED
        if (!(cx0G == 4 * (S / 256) && IN(pb + 8) && IN(pb + 9))) SEAM(pb + 8);
#else
#if FIX_RED
        if (IN(pb + 8) && IN(pb + 9)) { if (G == 4 * (S / 256) && __builtin_amdgcn_readfirstlane((int)MISC[40])) { asm volatile("s_waitcnt vmcnt(0)" ::: "memory"); __builtin_amdgcn_fence(__ATOMIC_ACQUIRE, "agent"); __syncthreads(); } else xcd_barrier(bar); }
#else
        SEAM_P(pb + 8, 1);
#endif
#endif
#if PROBE_DUP == 51
        if (IN(pb + 9) && ((blockIdx.x >> 3) & 4)) { const unsigned long long t0_ = __builtin_amdgcn_s_memrealtime(); while (__builtin_amdgcn_s_memrealtime() - t0_ < (unsigned long long)PROBE_TICKS) __builtin_amdgcn_s_sleep(8); }
#endif
#if PROBE_DUP == 50
        if (IN(pb + 9) && (blockIdx.x & 7) >= 4) { const unsigned long long t0_ = __builtin_amdgcn_s_memrealtime(); while (__builtin_amdgcn_s_memrealtime() - t0_ < (unsigned long long)PROBE_TICKS) __builtin_amdgcn_s_sleep(8); }
#endif
        if (IN(pb + 9)) { REPS(42) { OPQ(); unsigned char* w = cx.ws; const bf16* wl = (const bf16*)(w + WS_W + (size_t)lq * WL_BYTES);
            const bool dry = (nrep_ == 2 && rep_ == 0); (void)dry;
            pg8::Gemm g{(const bf16*)(w + WS_ACT), wl + WL_DOWN / 2, S, D, DFF, 0, 0, 1, 1}; pg8::StaticOrder So; So.init(S, D, cx.G, cx.bid);
#if LN_FUSED
#if RES_BF16
#if PROBE_DUP == 41
            { pg8::EpiNull E0; pg8::gemm_phase<pg8::EpiNull, pg8::StaticOrder, true, true>(lds, g, So, E0, cx.wave); }
#endif
#if TFOLD
#if PROBE_DUP == 42
            pg8::EpiRes3<true, false, true> E{nullptr, (lq == DEPTH - 1 && !dry) ? (float*)(w + WS_Y) : (float*)nullptr, dry ? (bf16*)(w + WS_Y) : (bf16*)(w + WS_XB), (_Float16*)(w + WS_YH), (float*)(w + WS_PSTAT), nullptr, nullptr, nullptr, (const bf16*)(w + WS_SG), nullptr, dry ? (_Float16*)(w + WS_Y + 64 * MiB) : (_Float16*)(w + WS_YH), ALPHA};
#else
            pg8::EpiRes3<true, false, true> E{nullptr, (lq == DEPTH - 1) ? (float*)(w + WS_Y) : (float*)nullptr, (bf16*)(w + WS_XB), (_Float16*)(w + WS_YH), (float*)(w + WS_PSTAT), nullptr, nullptr, nullptr, (const bf16*)(w + WS_SG), nullptr, YHW_ARG ALPHA};
#endif
            pg8::gemm_phase<pg8::EpiRes3<true, false, true>, pg8::StaticOrder, true, true>(lds, g, So, E, cx.wave);
#else
            pg8::EpiRes3<true, true> E{nullptr, (lq == DEPTH - 1) ? (float*)(w + WS_Y) : (float*)nullptr, (bf16*)(w + WS_XB), (_Float16*)(w + WS_YH), (float*)(w + WS_PSTAT), (const float*)(w + WS_ST1), P.in[8] + lq * D, P.in[9] + lq * D, (const bf16*)(w + ((lq & 1) ? WS_PP2 : WS_PP)), (const bf16*)(w + WS_SG), YHW_ARG ALPHA};
            pg8::gemm_phase<pg8::EpiRes3<true, true>, pg8::StaticOrder, true, true>(lds, g, So, E, cx.wave);
#endif
#else
            pg8::EpiRes2<true, true, true> E{nullptr, (float*)(w + WS_Y), (bf16*)(w + WS_XB), (float*)(w + WS_PSTAT), (const float*)(w + WS_ST1), P.in[8] + lq * D, P.in[9] + lq * D, (const bf16*)(w + WS_PP), (const bf16*)(w + WS_SG), ALPHA};
            pg8::gemm_phase<pg8::EpiRes2<true, true, true>, pg8::StaticOrder, true, true>(lds, g, So, E, cx.wave);
#endif
#elif PLE_EARLY
#if LN_NOXR
#if PROBE_DUP == 31
            { pg8::EpiResidLN<true> E{(float*)(w + WS_Y), (float*)(w + WS_XR + 2 * MiB), (const float*)(w + WS_ST1), P.in[8] + lq * D, P.in[9] + lq * D, (const bf16*)(w + WS_PP), (const bf16*)(w + WS_SG), ALPHA};
              pg8::gemm_phase<pg8::EpiResidLN<true>, pg8::StaticOrder, true, true>(lds, g, So, E, cx.wave); }
#endif
            pg8::EpiResidLN<true> E{(float*)(w + WS_Y), (float*)(w + WS_Y), (const float*)(w + WS_ST1), P.in[8] + lq * D, P.in[9] + lq * D, (const bf16*)(w + WS_PP), (const bf16*)(w + WS_SG), ALPHA};
            pg8::gemm_phase<pg8::EpiResidLN<true>, pg8::StaticOrder, true, true>(lds, g, So, E, cx.wave);
#else
            pg8::EpiDown E{(const float*)(w + WS_XR), (float*)(w + WS_Y), (const bf16*)(w + WS_PP), (const bf16*)(w + WS_SG), ALPHA};
            pg8::gemm_phase<pg8::EpiDown, pg8::StaticOrder, true, true>(lds, g, So, E, cx.wave);
#endif
#else
            pg8::EpiResid<true> E{(const float*)(w + WS_XR), (float*)(w + WS_Y), ALPHA};
            pg8::gemm_phase<pg8::EpiResid<true>, pg8::StaticOrder, true, true>(lds, g, So, E, cx.wave);
#endif
        } }
#if LN_FUSED
#if LAST_H
#if LN_LOCAL && XLOC
        if (l == DEPTH - 1) { SEAM_L(pb + 9); { OPQ(); unsigned char* w = cx.ws; phase_ln_h(cx, (const _Float16*)(w + WS_YH), P.in[14] + lq * D, P.in[15] + lq * D, P.out, IN(pb + 9) && __builtin_amdgcn_readfirstlane((int)MISC[40]) != 0); } }
#else
        if (l == DEPTH - 1) { SEAM(pb + 9); { OPQ(); unsigned char* w = cx.ws; phase_ln_h(cx, (const _Float16*)(w + WS_YH), P.in[14] + lq * D, P.in[15] + lq * D, P.out, false); } }
#endif
#else
        if (l == DEPTH - 1) { SEAM(pb + 9); { OPQ(); unsigned char* w = cx.ws; phase_ln(cx, (const float*)(w + WS_Y), P.in[14] + lq * D, P.in[15] + lq * D, P.out, (bf16*)nullptr, (float*)nullptr); } }
#endif
        else SEAM_P(pb + 9, 2);
#else
        SEAM(pb + 9);
        if (IN(pb + 10)) { REPS(1) { OPQ(); unsigned char* w = cx.ws; const bool last = (lq == DEPTH - 1);

#if LN_NOXR
            phase_ln(cx, (const float*)(w + WS_Y), P.in[14] + lq * D, P.in[15] + lq * D, last ? P.out : (float*)nullptr, last ? (bf16*)nullptr : (bf16*)(w + WS_XB), last ? (float*)nullptr : (float*)(w + WS_ST2));
#else
            phase_ln(cx, (const float*)(w + WS_Y), P.in[14] + lq * D, P.in[15] + lq * D, last ? P.out : (float*)(w + WS_XR), last ? (bf16*)nullptr : (bf16*)(w + WS_XB), (float*)nullptr);
#endif
        } }
        SEAM(pb + 10);
#endif
    }
#if PROBE_DUP == 60
    __syncthreads(); asm volatile("s_waitcnt vmcnt(0)" ::: "memory");
    if (blockIdx.x == PROBE_BLOCK && wave == 0 && lane_id_asm() == 0) { const unsigned long long c1_ = __builtin_amdgcn_s_memtime(), r1_ = __builtin_amdgcn_s_memrealtime();
        const unsigned long long c0_ = ((unsigned long long)MISC[35] << 32) | MISC[34], r0_ = ((unsigned long long)MISC[37] << 32) | MISC[36];
        P.out[5000u + 7u * PROBE_BLOCK] += (float)((double)(c1_ - c0_) / (double)(r1_ - r0_)); }
#endif
#if PROBE_DUP == 40
    __syncthreads(); asm volatile("s_waitcnt vmcnt(0)" ::: "memory");
    if (blockIdx.x == PROBE_BLOCK && wave == 0 && lane_id_asm() == 0) { const unsigned cell = 5000u + 7u * PROBE_BLOCK; P.out[cell] += (float)MISC[32] * 1e-4f; }
#endif
#undef IN
#undef SEAM
}

extern "C" void kernel_launch(void* const* d_in, const int* in_sizes, int n_in, void* d_out, int out_size, void* d_ws, size_t ws_size, hipStream_t stream) {
    static int grid = 0;
    if (grid == 0) {
        if (n_in != 19 || in_sizes[0] != S * D || out_size != S * D || ws_size < WS_END) { fprintf(stderr, "kernel_launch: unexpected shapes (n_in %d, in0 %d, out %d, ws %zu)\n", n_in, n_in > 0 ? in_sizes[0] : -1, out_size, ws_size); grid = -1; return; }
        int dev = 0, cus = 0, per_cu = 0;
        if (hipGetDevice(&dev) != hipSuccess || hipDeviceGetAttribute(&cus, hipDeviceAttributeMultiprocessorCount, dev) != hipSuccess) { grid = -1; return; }
        if (hipFuncSetAttribute((const void*)fwd, hipFuncAttributeMaxDynamicSharedMemorySize, LDS_BYTES) != hipSuccess) { fprintf(stderr, "kernel_launch: hipFuncSetAttribute failed\n"); grid = -1; return; }
        if (hipOccupancyMaxActiveBlocksPerMultiprocessor(&per_cu, (const void*)fwd, 512, LDS_BYTES) != hipSuccess || per_cu < 1) fprintf(stderr, "kernel_launch: occupancy query says %d\n", per_cu);
        (void)hipGetLastError();
        grid = cus;
    }
    if (grid < 0) return;
    (void)hipMemsetAsync((char*)d_ws + WS_CTL, 0, CTL_ZERO_BYTES, stream);
#ifdef DBG_NANFILL
    (void)hipMemsetAsync((char*)d_ws + CTL_ZERO_BYTES, 0xFF, WS_END - CTL_ZERO_BYTES, stream);
#endif
    Params p{};
    for (int i = 0; i < 19; ++i) p.in[i] = (const float*)d_in[i];
    p.out = (float*)d_out; p.ws = (unsigned char*)d_ws;
    for (int f = 0; f < 128; ++f) p.invf_ret[f] = (float)(1.0 / std::pow(10000.0, (double)((float)f / 127.0f)));
    for (int f = 0; f < 32; ++f) p.invf_att[f] = (float)std::pow(10000.0, -(double)(2 * f) / 64.0);
    for (int h = 0; h < 4; ++h) p.lg2g[h] = (float)std::log2(1.0 - std::exp2(-5.0 - h));
#if MK_ONE_LAUNCH
    p.ph_lo = 0; p.ph_hi = NPHASES;
    hipLaunchKernelGGL(fwd, dim3(grid), dim3(512), LDS_BYTES, stream, p);
#else
#ifdef DBG_DUMP
    for (int ph = 0; ph <= DBG_STOP; ++ph) { p.ph_lo = ph; p.ph_hi = ph + 1; hipLaunchKernelGGL(fwd, dim3(grid), dim3(512), LDS_BYTES, stream, p); }
    p.ph_lo = 1000 + DBG_DUMP; p.ph_hi = p.ph_lo + 1; hipLaunchKernelGGL(fwd, dim3(grid), dim3(512), LDS_BYTES, stream, p);
#else
    for (int ph = 0; ph < NPHASES; ++ph) { p.ph_lo = ph; p.ph_hi = ph + 1; hipLaunchKernelGGL(fwd, dim3(grid), dim3(512), LDS_BYTES, stream, p); }
#endif
#endif
}
```

```cpp
#include <hip/hip_runtime.h>
#include <cstdio>
#include <cstdint>
#include <cmath>

#define MK_ONE_LAUNCH 1
#define INP_PREK 1
namespace pg8 {
#define PG8_LAS __attribute__((address_space(3)))
typedef unsigned short bf16_t;
typedef short bf16x8 __attribute__((ext_vector_type(8)));
typedef float f32x4 __attribute__((ext_vector_type(4)));
typedef unsigned u32x4 __attribute__((ext_vector_type(4)));
constexpr int BM = 256, BK = 64, HALF = 128, HTB = HALF * BK * 2  , STAGE_BYTES = 8 * HTB, NXCD = 8, WGM = 8;

__host__ __device__ __forceinline__ int lds_byte(int r, int c) { const int st = (r >> 4) * 2 + (c >> 5), rr = r & 15, cc = c & 31, ob = rr * 64 + cc * 2; return st * 1024 + (ob ^ (((ob >> 9) & 1) << 5)); }
__host__ __device__ __forceinline__ void stage_rc(int b, int& R, int& C) { const int st = b / 1024, sb = b % 1024, swz = sb ^ (((sb >> 9) & 1) << 5); R = (st >> 1) * 16 + swz / 64; C = (st & 1) * 32 + (swz % 64) / 2; }
__host__ __device__ __forceinline__ int perm32(int rho) { const int n = rho >> 4, i = rho & 15; return 8 * (i >> 2) + 4 * n + (i & 3); }

#ifndef FAST_NEXT
#define FAST_NEXT 1
#endif
#ifndef KREV
#define KREV 0
#endif
struct Unit { int pm, pn; };
struct Gemm { const bf16_t* A; const bf16_t* Bt; int M, N, K; int lda, ldb; int tiledA, tiledB; };

struct StaticOrder {
    int nM, nN, nwg, G, c;
    __host__ __device__ void init(int M, int N, int G_, int c_) { nM = M / BM; nN = N / BM; nwg = nM * nN; G = G_; c = c_; }
    __host__ __device__ bool next(int i, Unit& u) const {
#if FAST_NEXT
        if (G == 256 && nM == 64) { const int Lf = i * 256 + c; if (Lf >= nwg) return false; u.pm = 8 * (c & 7) + ((c >> 3) & 7); u.pn = 4 * i + (c >> 6); return true; }
#endif
        const long L = (long)i * G + c; if (L >= nwg) return false;
        int wgid = (int)L; { const int q = nwg / NXCD, r = nwg % NXCD, xcd = wgid % NXCD, off = wgid / NXCD; wgid = (xcd < r ? xcd * (q + 1) : r * (q + 1) + (xcd - r) * q) + off; }
        const int nig = WGM * nN, gid = wgid / nig, fm = gid * WGM, gsz = (nM - fm) < WGM ? (nM - fm) : WGM;
        u.pm = fm + ((wgid % nig) % gsz); u.pn = (wgid % nig) / gsz; return true;
    }
    __device__ __forceinline__ void a_ready(const Unit&) const {}
    __device__ __forceinline__ void done(const Unit&) const {}
};

template <class E> struct PermA { static constexpr bool value = false; };
template <class E> struct SeedK { static constexpr bool value = false; };
template <class E> struct RelaxW { static constexpr int value = 0; };
template <class E> struct PreK { static constexpr bool value = false; };
struct InProjOrder : StaticOrder {
    unsigned* kv;
    __device__ __forceinline__ void done(const Unit& u) const {
        if (kv != nullptr && u.pn >= 4 && u.pn < 12) { asm volatile("s_waitcnt vmcnt(0)" ::: "memory");
            int l_; asm volatile("v_mbcnt_lo_u32_b32 %0, -1, 0\n\tv_mbcnt_hi_u32_b32 %0, -1, %0" : "=v"(l_));
            if (l_ == 0) (void)__hip_atomic_fetch_add(kv, 1u, __ATOMIC_RELAXED, __HIP_MEMORY_SCOPE_AGENT); }
    }
};
struct PleOrder {
    StaticOrder a, b; bool extra;
    __host__ __device__ bool next(int i, Unit& u) const { if (i < 2) return a.next(i, u); return (extra && i < 4) ? b.next(i + 4, u) : false; }
    __device__ __forceinline__ void a_ready(const Unit&) const {}
    __device__ __forceinline__ void done(const Unit&) const {}
};
struct SyncOrder : StaticOrder {
    unsigned* cnt; unsigned nloc;
    __device__ __forceinline__ void a_ready(const Unit&) const {
        if (cnt != nullptr) {
            int l_; asm volatile("v_mbcnt_lo_u32_b32 %0, -1, 0\n\tv_mbcnt_hi_u32_b32 %0, -1, %0" : "=v"(l_));
            if (threadIdx.x < 64 && l_ == 0) { const unsigned old = __hip_atomic_fetch_add(cnt, 1u, __ATOMIC_RELAXED, __HIP_MEMORY_SCOPE_AGENT), tgt = (old / nloc + 1u) * nloc; unsigned sp = 0u;
                while (__hip_atomic_load(cnt, __ATOMIC_RELAXED, __HIP_MEMORY_SCOPE_AGENT) < tgt && ++sp < (1u << 16)) __builtin_amdgcn_s_sleep(1); }
            asm volatile("" ::: "memory"); __builtin_amdgcn_s_barrier(); asm volatile("" ::: "memory"); }
    }
};
struct HotOrder {
    StaticOrder b;
    __host__ __device__ void init(int M, int N, int G_, int c_) { b.init(M, N, G_, c_); }
    __host__ __device__ bool next(int i, Unit& u) const { const bool ok = b.next(i, u); u.pm = 0; u.pn = 0; return ok; }
    __device__ __forceinline__ void a_ready(const Unit&) const {}
    __device__ __forceinline__ void done(const Unit&) const {}
};
struct RotOrder {
    StaticOrder b; int cnt, rot;
    __host__ __device__ void init(int M, int N, int G_, int c_) { b.init(M, N, G_, c_); cnt = (b.nwg - c_ + G_ - 1) / G_; rot = (b.nwg % G_ == 0) ? ((c_ % NXCD) * cnt) / NXCD : 0; }
    __host__ __device__ bool next(int i, Unit& u) const { if (i >= cnt) return false; int j = i + rot; if (j >= cnt) j -= cnt; return b.next(j, u); }
    __device__ __forceinline__ void a_ready(const Unit&) const {}
    __device__ __forceinline__ void done(const Unit&) const {}
};

typedef float f32x2c_t __attribute__((ext_vector_type(2))); typedef __bf16 bf16x2c_t __attribute__((ext_vector_type(2)));
__device__ __forceinline__ unsigned cvt_pk_bf16(float lo, float hi) { f32x2c_t v = {lo, hi}; bf16x2c_t b = __builtin_convertvector(v, bf16x2c_t); return __builtin_bit_cast(unsigned, b); }
typedef float f32x2 __attribute__((ext_vector_type(2)));
typedef unsigned u32x2 __attribute__((ext_vector_type(2)));
__host__ __device__ __forceinline__ size_t tiled_off(int row, int col, int K) { return ((size_t)((row >> 8) * (K >> 6) + (col >> 6)) * 256 + (row & 255)) * 64 + (col & 63); }
#ifndef EPI_NT
#define EPI_NT 0
#endif
#ifndef EPI_SC1
#define EPI_SC1 0
#endif
#ifndef RES_STREAM
#define RES_STREAM 0
#endif
template <class T> __device__ __forceinline__ T ld_stream(const T* p) {
#if RES_STREAM
    return __builtin_nontemporal_load(p);
#else
    return *p;
#endif
}
#ifndef YH_NT
#define YH_NT 0
#endif
template <class T> __device__ __forceinline__ void st_stream(T* p, const T v) {
#if RES_STREAM || YH_NT
    __builtin_nontemporal_store(v, p);
#else
    *p = v;
#endif
}
#ifndef HALO_WT
#define HALO_WT 1
#endif
template <class T> __device__ __forceinline__ void st_wt(T* p, const T v) { static_assert(sizeof(T) == 16, "st_wt: 16-byte vectors only"); asm volatile("global_store_dwordx4 %0, %1, off sc1\n\ts_nop 1" :: "v"(p), "v"(v) : "memory"); }
template <class T> __device__ __forceinline__ void st_out(T* p, const T v) {
#if EPI_SC1
    static_assert(sizeof(T) == 16, "st_out: 16-byte vectors only");
    asm volatile("global_store_dwordx4 %0, %1, off sc1\n\ts_nop 1" :: "v"(p), "v"(v));
#elif EPI_NT
    __builtin_nontemporal_store(v, p);
#else
    *p = v;
#endif
}

__device__ __forceinline__ float bf2f(unsigned short b) { return __uint_as_float(((unsigned)b) << 16); }
__device__ __forceinline__ u32x4 pack8(const f32x4 a, const f32x4 b) { u32x4 w; w.x = cvt_pk_bf16(a[0], a[1]); w.y = cvt_pk_bf16(a[2], a[3]); w.z = cvt_pk_bf16(b[0], b[1]); w.w = cvt_pk_bf16(b[2], b[3]); return w; }
__device__ __forceinline__ float sigmoidf_(float x) { return __builtin_amdgcn_rcpf(1.0f + __expf(-x)); }

#ifndef TAB_H
#define TAB_H 0
#endif
typedef _Float16 tab_h8 __attribute__((ext_vector_type(8))); typedef float tab_f8 __attribute__((ext_vector_type(8)));
__device__ __forceinline__ void ld_tab(const float* cosb, const float* sinb, unsigned idx, f32x4& c0, f32x4& c1, f32x4& s0, f32x4& s1) {
#if TAB_H
    const tab_f8 cf = __builtin_convertvector(*(const tab_h8*)((const char*)cosb + 2u * idx), tab_f8), sf = __builtin_convertvector(*(const tab_h8*)((const char*)sinb + 2u * idx), tab_f8);
    c0 = (f32x4){cf[0], cf[1], cf[2], cf[3]}; c1 = (f32x4){cf[4], cf[5], cf[6], cf[7]}; s0 = (f32x4){sf[0], sf[1], sf[2], sf[3]}; s1 = (f32x4){sf[4], sf[5], sf[6], sf[7]};
#else
    c0 = *(const f32x4*)((const char*)cosb + 4u * idx); c1 = *(const f32x4*)((const char*)cosb + 4u * (idx + 4u)); s0 = *(const f32x4*)((const char*)sinb + 4u * idx); s1 = *(const f32x4*)((const char*)sinb + 4u * (idx + 4u));
#endif
}
template <bool LNFIX> struct EpiInProjT {
    static constexpr bool PERM = true, AFTER_DRAIN = false;
    bf16_t *Q, *K, *V, *G, *AQ, *AK, *AV; const float *cosr, *sinr, *cosa, *sina; const float *stats, *c1, *c2;
#if INP_PREK
    typedef __attribute__((address_space(3))) unsigned lds_u32;
    static __device__ __forceinline__ unsigned slot_of(int wr, int wc) { extern __shared__ __attribute__((aligned(16))) unsigned char lds_raw[]; return (unsigned)(unsigned long)((PG8_LAS unsigned char*)lds_raw + 131072) + (unsigned)(wc * 2 + wr) * 1536u; }
    __device__ __forceinline__ void pre_cols(const Unit& u, int wr, int wc, int lane) const {
        const unsigned slot = slot_of(wr, wc); const unsigned col = (unsigned)(u.pn * 256 + (lane >> 5) * HALF + wc * 32 + (lane & 31));
        __builtin_amdgcn_global_load_lds((const unsigned*)((const char*)c1 + 4u * col), (lds_u32*)(unsigned long)(slot + 1024u), 4, 0, 0);
        __builtin_amdgcn_global_load_lds((const unsigned*)((const char*)c2 + 4u * col), (lds_u32*)(unsigned long)(slot + 1280u), 4, 0, 0);
    }
    __device__ __forceinline__ void pre_phase(const Unit& u, int wr, int wc, int lane) const {
        const unsigned slot = slot_of(wr, wc); const unsigned row = (unsigned)(u.pm * BM + (lane >> 5) * HALF + wr * 64 + ((2 * lane) & 63));
        __builtin_amdgcn_global_load_lds((const unsigned*)((const char*)stats + 8u * row), (lds_u32*)(unsigned long)slot, 16, 0, 0);
        pre_cols(u, wr, wc, lane);
    }
    __device__ __forceinline__ void pre_next(const Unit& u, int wr, int wc, int lane) const { pre_cols(u, wr, wc, lane); }
#endif
    __device__ __forceinline__ void operator()(f32x4 (&acc)[2][2][4][2], const Unit& u, int wr, int wc, int fr, int fq) const {
        int cw = wc * 32 + 8 * fq, frq = fr; asm volatile("" : "+v"(cw), "+v"(frq));
        const int row0 = u.pm * BM + wr * 64 + frq, pn = u.pn; const unsigned cwu = (unsigned)cw;
        if (LNFIX) {
            f32x4 c1v[2][2], c2v[2][2];
#if INP_PREK
            const unsigned slot_ = slot_of(wr, wc);
            typedef __attribute__((address_space(3))) f32x4 lds_f4; typedef __attribute__((address_space(3))) f32x2 lds_f2;
#pragma unroll
            for (int bj = 0; bj < 2; ++bj)
#pragma unroll
                for (int n = 0; n < 2; ++n) { const unsigned o = 4u * (unsigned)(bj * 32 + 4 * n) + 4u * (cwu & 31u);
                    c1v[bj][n] = *(const lds_f4*)(unsigned long)(slot_ + 1024u + o); c2v[bj][n] = *(const lds_f4*)(unsigned long)(slot_ + 1280u + o); }
#pragma unroll
            for (int i = 0; i < 8; ++i) { const f32x2 st = *(const lds_f2*)(unsigned long)(slot_ + 8u * (unsigned)((i >> 2) * 64 + (i & 3) * 16) + 8u * (unsigned)frq);
#else
#pragma unroll
            for (int bj = 0; bj < 2; ++bj)
#pragma unroll
                for (int n = 0; n < 2; ++n) { c1v[bj][n] = *(const f32x4*)((const char*)c1 + 4u * ((unsigned)(pn * 256 + bj * HALF + 4 * n) + cwu)); c2v[bj][n] = *(const f32x4*)((const char*)c2 + 4u * ((unsigned)(pn * 256 + bj * HALF + 4 * n) + cwu)); }
#pragma unroll
            for (int i = 0; i < 8; ++i) { const f32x2 st = *(const f32x2*)((const char*)stats + 8u * (unsigned)(row0 + (i >> 2) * HALF + (i & 3) * 16));
#endif
#pragma unroll
                for (int bj = 0; bj < 2; ++bj)
#pragma unroll
                    for (int n = 0; n < 2; ++n) acc[i >> 2][bj][i & 3][n] = (acc[i >> 2][bj][i & 3][n] - c1v[bj][n] * st.x) * st.y + c2v[bj][n]; } }
        auto A = [&](int ai, int bj, int m, int n) -> f32x4 { return acc[ai][bj][m][n]; };
        if (pn < 8) {
            bf16_t* O = pn < 4 ? Q : K; const int hcol = (pn & 3) * 256; const float sc = pn < 4 ? 1.0f : 0.0625f;
#pragma unroll
            for (int ai = 0; ai < 2; ++ai)
#pragma unroll
                for (int m = 0; m < 4; ++m) { const unsigned row = (unsigned)(row0 + ai * HALF + m * 16);
                    f32x4 c0, c1, s0, s1; ld_tab(cosr, sinr, row * 128u + cwu, c0, c1, s0, s1);
                    const f32x4 a0 = A(ai, 0, m, 0), a1 = A(ai, 0, m, 1), b0 = A(ai, 1, m, 0), b1 = A(ai, 1, m, 1);
                    const f32x4 o10 = (a0 * c0 - b0 * s0) * sc, o11 = (a1 * c1 - b1 * s1) * sc, o20 = (a0 * s0 + b0 * c0) * sc, o21 = (a1 * s1 + b1 * c1) * sc;
                    bf16_t* rowp = (bf16_t*)((char*)O + 2u * (row * 1024u + (unsigned)hcol + cwu));
                    st_out((u32x4*)(rowp), (u32x4)(pack8(o10, o11))); st_out((u32x4*)(rowp + HALF), (u32x4)(pack8(o20, o21))); }
        } else if (pn < 16) {
            const bool gate = pn >= 12; bf16_t* O = gate ? G : V; const int hcol = (pn & 3) * 256;
#pragma unroll
            for (int ai = 0; ai < 2; ++ai)
#pragma unroll
                for (int m = 0; m < 4; ++m) { const unsigned row = (unsigned)(row0 + ai * HALF + m * 16); bf16_t* rowp = (bf16_t*)((char*)O + 2u * (row * 1024u + (unsigned)hcol + cwu));
#pragma unroll
                    for (int bj = 0; bj < 2; ++bj) { f32x4 v0 = A(ai, bj, m, 0), v1 = A(ai, bj, m, 1);
                        if (gate) {
#pragma unroll
                            for (int j = 0; j < 4; ++j) { v0[j] = v0[j] * sigmoidf_(v0[j]); v1[j] = v1[j] * sigmoidf_(v1[j]); } }
                        st_out((u32x4*)(rowp + bj * HALF), (u32x4)(pack8(v0, v1))); } }
        } else if (pn < 20) {
            const int t = pn - 16, i0 = 8 * fq;
#pragma unroll
            for (int ai = 0; ai < 2; ++ai)
#pragma unroll
                for (int m = 0; m < 4; ++m) { const unsigned row = (unsigned)(row0 + ai * HALF + m * 16);
                    f32x4 c0, c1, s0, s1; ld_tab(cosa, sina, row * 32u + (unsigned)i0, c0, c1, s0, s1);
                    const f32x4 a0 = A(ai, 0, m, 0), a1 = A(ai, 0, m, 1), b0 = A(ai, 1, m, 0), b1 = A(ai, 1, m, 1);
                    const f32x4 o10 = (a0 * c0 - b0 * s0) * 0.125f, o11 = (a1 * c1 - b1 * s1) * 0.125f, o20 = (a0 * s0 + b0 * c0) * 0.125f, o21 = (a1 * s1 + b1 * c1) * 0.125f;
                    bf16_t* rowp = (bf16_t*)((char*)AQ + 2u * (row * 1024u + (unsigned)(t * 256 + wc * 64 + i0)));
                    st_out((u32x4*)(rowp), (u32x4)(pack8(o10, o11))); st_out((u32x4*)(rowp + 32), (u32x4)(pack8(o20, o21))); }
        } else {
            const int i0 = 8 * fq;
            if (wc < 2) {
#pragma unroll
                for (int ai = 0; ai < 2; ++ai)
#pragma unroll
                    for (int m = 0; m < 4; ++m) { const unsigned row = (unsigned)(row0 + ai * HALF + m * 16);
                        f32x4 c0, c1, s0, s1; ld_tab(cosa, sina, row * 32u + (unsigned)i0, c0, c1, s0, s1);
                        const f32x4 a0 = A(ai, 0, m, 0), a1 = A(ai, 0, m, 1), b0 = A(ai, 1, m, 0), b1 = A(ai, 1, m, 1);
                        const f32x4 o10 = a0 * c0 - b0 * s0, o11 = a1 * c1 - b1 * s1, o20 = a0 * s0 + b0 * c0, o21 = a1 * s1 + b1 * c1;
                        bf16_t* rowp = (bf16_t*)((char*)AK + 2u * (row * 128u + (unsigned)(wc * 64 + i0)));
                        st_out((u32x4*)(rowp), (u32x4)(pack8(o10, o11))); st_out((u32x4*)(rowp + 32), (u32x4)(pack8(o20, o21))); }
            } else {
#pragma unroll
                for (int ai = 0; ai < 2; ++ai)
#pragma unroll
                    for (int m = 0; m < 4; ++m) { const unsigned row = (unsigned)(row0 + ai * HALF + m * 16); bf16_t* rowp = (bf16_t*)((char*)AV + 2u * (row * 128u + (unsigned)((wc - 2) * 32 + i0)));
                        st_out((u32x4*)(rowp), (u32x4)(pack8(A(ai, 0, m, 0), A(ai, 0, m, 1)))); st_out((u32x4*)(rowp + 64), (u32x4)(pack8(A(ai, 1, m, 0), A(ai, 1, m, 1)))); }
            }
        }
    }
};
typedef EpiInProjT<false> EpiInProj;
#if INP_PREK
template <> struct PreK<EpiInProjT<true>> { static constexpr bool value = true; };
#endif
template <bool ADD> struct EpiResid {
    static constexpr bool PERM = false, AFTER_DRAIN = false;
    const float* base; float* Y; float alpha;
    __device__ __forceinline__ void operator()(const f32x4 (&acc)[2][2][4][2], const Unit& u, int wr, int wc, int fr, int fq) const {
        const int row0 = u.pm * BM + wr * 64 + fr, col0 = u.pn * BM + wc * 32 + 4 * fq;
#pragma unroll
        for (int ai = 0; ai < 2; ++ai)
#pragma unroll
            for (int m = 0; m < 4; ++m) { const size_t off = (size_t)(row0 + ai * HALF + m * 16) * 2048 + col0;
#pragma unroll
                for (int bj = 0; bj < 2; ++bj)
#pragma unroll
                    for (int n = 0; n < 2; ++n) { const size_t o = off + bj * HALF + n * 16; f32x4 v = acc[ai][bj][m][n] + *(const f32x4*)(base + o) * alpha;
                        if (ADD) v = v + *(const f32x4*)(Y + o); st_out((f32x4*)(Y + o), (f32x4)(v)); } }
    }
};
struct EpiUp {
    static constexpr bool PERM = true, AFTER_DRAIN = false;
    bf16_t* H; bf16_t* SG; const float* bgate;
    __device__ __forceinline__ void operator()(const f32x4 (&acc)[2][2][4][2], const Unit& u, int wr, int wc, int fr, int fq) const {
        const int row0 = u.pm * BM + wr * 64 + fr, cw = wc * 32 + 8 * fq;
        if (u.pn < 44) {
#pragma unroll
            for (int ai = 0; ai < 2; ++ai)
#pragma unroll
                for (int m = 0; m < 4; ++m) { bf16_t* rowp = H + (size_t)(row0 + ai * HALF + m * 16) * 11264 + u.pn * 256 + cw;
#pragma unroll
                    for (int bj = 0; bj < 2; ++bj) st_out((u32x4*)(rowp + bj * HALF), (u32x4)(pack8(acc[ai][bj][m][0], acc[ai][bj][m][1]))); }
        } else {
            const int colg = (u.pn - 44) * 256 + cw;
            f32x4 bv[2][2];
#pragma unroll
            for (int bj = 0; bj < 2; ++bj)
#pragma unroll
                for (int n = 0; n < 2; ++n) bv[bj][n] = *(const f32x4*)(bgate + colg + bj * HALF + 4 * n);
#pragma unroll
            for (int ai = 0; ai < 2; ++ai)
#pragma unroll
                for (int m = 0; m < 4; ++m) { bf16_t* rowp = SG + (size_t)(row0 + ai * HALF + m * 16) * 2048 + colg;
#pragma unroll
                    for (int bj = 0; bj < 2; ++bj) { f32x4 v0 = acc[ai][bj][m][0] + bv[bj][0], v1 = acc[ai][bj][m][1] + bv[bj][1];
#pragma unroll
                        for (int j = 0; j < 4; ++j) { v0[j] = sigmoidf_(v0[j]); v1[j] = sigmoidf_(v1[j]); }
                        st_out((u32x4*)(rowp + bj * HALF), (u32x4)(pack8(v0, v1))); } }
        }
    }
};

#ifndef DPP_BC
#define DPP_BC true
#endif
__device__ __forceinline__ float ror1f(float x) { return __builtin_bit_cast(float, __builtin_amdgcn_update_dpp(0, __builtin_bit_cast(int, x), 0x121, 0xf, 0xf, DPP_BC)); }
__device__ __forceinline__ float ror2f(float x) { return __builtin_bit_cast(float, __builtin_amdgcn_update_dpp(0, __builtin_bit_cast(int, x), 0x122, 0xf, 0xf, DPP_BC)); }
typedef _Float16 h16x8 __attribute__((ext_vector_type(8)));
typedef float f32x8 __attribute__((ext_vector_type(8)));
#ifndef TFOLD
#define TFOLD 0
#endif
#ifndef LAST_H
#define LAST_H 1
#endif
#ifndef PSG
#define PSG 0
#endif
#ifndef SEED_PLE
#define SEED_PLE 0
#endif
#ifndef ROWP
#define ROWP 1
#endif
#ifndef PST_T
#define PST_T 1
#endif
#ifndef CONV_ST16
#define CONV_ST16 1
#endif
#ifndef UP_PREK
#define UP_PREK 2
#endif
#ifndef RELAX_UP
#define RELAX_UP 0
#endif
#ifndef CONVW_PF
#define CONVW_PF 0
#endif
#ifndef ROWP_ST16
#define ROWP_ST16 0
#endif
#ifndef INP_PREK
#define INP_PREK 0
#endif
#ifndef GB_LDS
#define GB_LDS 0
#endif
#ifndef PLE_PF
#define PLE_PF 0
#endif
#ifndef EPI_PD
#define EPI_PD 2
#endif
#ifndef GATE_PD
#define GATE_PD 3
#endif
template <bool LNFIX> struct EpiUpConvT {
    static constexpr bool PERM = true, AFTER_DRAIN = false;
    bf16_t* ACT; bf16_t* HALO; bf16_t* SG; const float* bgate; const float* cw; const float* cb; const float *stats, *c1, *c2;
    const _Float16* YHr; const bf16_t* PPr; const float* g1; const float* b1; float alpha; unsigned sp;
#if defined(PROBE_DUP) && PROBE_DUP >= 90 && PROBE_DUP <= 93
    int mode;
#define UPMODE(b) ((mode >> (b)) & 1)
#else
#define UPMODE(b) 0
#endif
#if UP_PREK == 2
    typedef __attribute__((address_space(3))) unsigned lds_u32;
    __device__ __forceinline__ void pre_w(const Unit& u, int wr, int wc, int lane) const {
        if (u.pn < 44) { const unsigned slot = sp + (unsigned)(wc * 2 + wr) * 1024u; const unsigned chg = 4u * (unsigned)(128 * u.pn + 32 * wc + (lane & 31)), chu = chg + 4u * 5632u; const bool hi = lane >= 32;
            __builtin_amdgcn_global_load_lds((const unsigned*)((const char*)cw + (chg + (hi ? 4u * 11264u : 0u))), (lds_u32*)(unsigned long)(slot), 4, 0, 0);
            __builtin_amdgcn_global_load_lds((const unsigned*)((const char*)(hi ? cb : cw) + (chg + (hi ? 0u : 8u * 11264u))), (lds_u32*)(unsigned long)(slot + 256u), 4, 0, 0);
            __builtin_amdgcn_global_load_lds((const unsigned*)((const char*)cw + (chu + (hi ? 4u * 11264u : 0u))), (lds_u32*)(unsigned long)(slot + 512u), 4, 0, 0);
            __builtin_amdgcn_global_load_lds((const unsigned*)((const char*)(hi ? cb : cw) + (chu + (hi ? 0u : 8u * 11264u))), (lds_u32*)(unsigned long)(slot + 768u), 4, 0, 0); }
    }
    __device__ __forceinline__ void pre_phase(const Unit& u, int wr, int wc, int lane) const { pre_w(u, wr, wc, lane); }
    __device__ __forceinline__ void pre_next(const Unit& u, int wr, int wc, int lane) const { pre_w(u, wr, wc, lane); }
#elif UP_PREK
    typedef __attribute__((address_space(3))) unsigned lds_u32;
    __device__ __forceinline__ void pre_cols(const Unit& u, int wr, int wc, int lane) const {
        const unsigned slot = sp + (unsigned)(wc * 2 + wr) * 1536u; const unsigned col = (unsigned)(u.pn * 256 + (lane >> 5) * HALF + wc * 32 + (lane & 31));
        __builtin_amdgcn_global_load_lds((const unsigned*)((const char*)c1 + 4u * col), (lds_u32*)(unsigned long)(slot + 1024u), 4, 0, 0);
        __builtin_amdgcn_global_load_lds((const unsigned*)((const char*)c2 + 4u * col), (lds_u32*)(unsigned long)(slot + 1280u), 4, 0, 0);
    }
    __device__ __forceinline__ void pre_phase(const Unit& u, int wr, int wc, int lane) const {
        const unsigned slot = sp + (unsigned)(wc * 2 + wr) * 1536u; const unsigned row = (unsigned)(u.pm * BM + (lane >> 5) * HALF + wr * 64 + ((2 * lane) & 63));
        __builtin_amdgcn_global_load_lds((const unsigned*)((const char*)stats + 8u * row), (lds_u32*)(unsigned long)slot, 16, 0, 0);
        pre_cols(u, wr, wc, lane);
    }
    __device__ __forceinline__ void pre_next(const Unit& u, int wr, int wc, int lane) const { pre_cols(u, wr, wc, lane); }
#endif
    __device__ __forceinline__ void operator()(f32x4 (&acc)[2][2][4][2], const Unit& u, int wr, int wc, int fr, int fq) const {
        int cwp = wc * 32 + 8 * fq; asm volatile("" : "+v"(cwp));
#if defined(PROBE_DUP) && PROBE_DUP == 81
        asm volatile("s_waitcnt vmcnt(0)" ::: "memory");
#endif
        const int row0 = u.pm * BM + wr * 64 + fr;
#if ROWP
        int fr4 = 4 * fr; asm volatile("" : "+v"(fr4));
        const int rowp0 = u.pm * BM + wr * 64 + fr4;
#define UPROW(ai, m) (rowp0 + (ai) * HALF + (m))
#else
#define UPROW(ai, m) (row0 + (ai) * HALF + (m) * 16)
#endif
#if ROWP && CONVW_PF
        f32x4 cwv[2][8];
        auto ldcw = [&](int n) { const unsigned cg4 = 4u * (unsigned)(128 * u.pn + cwp + 4 * n), cu4 = cg4 + 4u * 5632u;
            cwv[n][0] = *(const f32x4*)((const char*)cw + cg4); cwv[n][1] = *(const f32x4*)((const char*)cw + (cg4 + 4u * 11264u)); cwv[n][2] = *(const f32x4*)((const char*)cw + (cg4 + 8u * 11264u)); cwv[n][3] = *(const f32x4*)((const char*)cb + cg4);
            cwv[n][4] = *(const f32x4*)((const char*)cw + cu4); cwv[n][5] = *(const f32x4*)((const char*)cw + (cu4 + 4u * 11264u)); cwv[n][6] = *(const f32x4*)((const char*)cw + (cu4 + 8u * 11264u)); cwv[n][7] = *(const f32x4*)((const char*)cb + cu4); };
        if (CONVW_PF == 1 && u.pn < 44) ldcw(0);
#endif
        if (LNFIX && !UPMODE(1)) {
            const int cwq = cwp;
            f32x4 c1v[2][2], c2v[2][2];
#if UP_PREK == 1 && ROWP
            const unsigned slot_ = sp + (unsigned)(wc * 2 + wr) * 1536u;
            typedef __attribute__((address_space(3))) f32x4 lds_f4; typedef __attribute__((address_space(3))) f32x2 lds_f2;
#pragma unroll
            for (int bj = 0; bj < 2; ++bj)
#pragma unroll
                for (int n = 0; n < 2; ++n) { const unsigned o = 4u * (unsigned)(bj * 32 + 4 * n) + 4u * (unsigned)(cwq & 31);
                    c1v[bj][n] = *(const lds_f4*)(unsigned long)(slot_ + 1024u + o); c2v[bj][n] = *(const lds_f4*)(unsigned long)(slot_ + 1280u + o); }
#pragma unroll
            for (int i = 0; i < 8; ++i) { const f32x2 st = *(const lds_f2*)(unsigned long)(slot_ + 8u * (unsigned)((i >> 2) * 64 + (i & 3)) + 8u * (unsigned)fr4);
#else
#pragma unroll
            for (int bj = 0; bj < 2; ++bj)
#pragma unroll
                for (int n = 0; n < 2; ++n) { c1v[bj][n] = *(const f32x4*)((const char*)c1 + 4u * (unsigned)(u.pn * 256 + bj * HALF + cwq + 4 * n)); c2v[bj][n] = *(const f32x4*)((const char*)c2 + 4u * (unsigned)(u.pn * 256 + bj * HALF + cwq + 4 * n)); }
#pragma unroll
            for (int i = 0; i < 8; ++i) { const f32x2 st = *(const f32x2*)((const char*)stats + 8u * (unsigned)UPROW(i >> 2, i & 3));
#endif
#pragma unroll
                for (int bj = 0; bj < 2; ++bj)
#pragma unroll
                    for (int n = 0; n < 2; ++n) acc[i >> 2][bj][i & 3][n] = (acc[i >> 2][bj][i & 3][n] - c1v[bj][n] * st.x) * st.y + c2v[bj][n]; } }
        auto A = [&](int ai, int bj, int m, int n) -> f32x4 { return acc[ai][bj][m][n]; };
        if (UPMODE(0)) {
#pragma unroll
            for (int i = 0; i < 32; ++i) asm volatile("" :: "v"(acc[i >> 4][(i >> 3) & 1][(i >> 1) & 3][i & 1]));
            return; }
#if ROWP
        if (u.pn < 44) {
            bf16_t* const actb = (bf16_t*)((char*)ACT + 2u * ((((unsigned)(u.pm * (5632 >> 6) + 2 * u.pn + (cwp >> 6)) * 256u + (unsigned)(wr * 64 + fr4)) * 64u) + (unsigned)(cwp & 63)));
#if ROWP_ST16
            u32x2 wlo[2][4];
#endif
#if UP_PREK == 2 && CONV_ST16
            {   typedef __attribute__((address_space(3))) f32x4 lds_f4w;
                const unsigned actoff_ = 2u * ((((unsigned)(u.pm * (5632 >> 6) + 2 * u.pn + (cwp >> 6)) * 256u + (unsigned)(wr * 64 + fr4)) * 64u) + (unsigned)(cwp & 63));
#pragma unroll
                for (int ai = 0; ai < 2; ++ai) { u32x2 wlo[4];
#pragma unroll
                    for (int n = 0; n < 2; ++n) {
                        const unsigned wo_ = sp + (unsigned)(wc * 2 + wr) * 1024u + 4u * (unsigned)((cwp & 31) + 4 * n);
                        const f32x4 wg0 = *(const lds_f4w*)(unsigned long)(wo_), wg1 = *(const lds_f4w*)(unsigned long)(wo_ + 128u), wg2 = *(const lds_f4w*)(unsigned long)(wo_ + 256u), bg = *(const lds_f4w*)(unsigned long)(wo_ + 384u);
                        const f32x4 wu0 = *(const lds_f4w*)(unsigned long)(wo_ + 512u), wu1 = *(const lds_f4w*)(unsigned long)(wo_ + 640u), wu2 = *(const lds_f4w*)(unsigned long)(wo_ + 768u), bu = *(const lds_f4w*)(unsigned long)(wo_ + 896u);
#pragma unroll
                        for (int m = 3; m >= 0; --m) {
                            f32x4 sg3, su3;
                            if (m <= 1) {
#pragma unroll
                                for (int j = 0; j < 4; ++j) { sg3[j] = ror1f(A(ai, 0, 3, n)[j]); su3[j] = ror1f(A(ai, 1, 3, n)[j]); } }
                            f32x4 xg2, xu2;
                            if (m >= 2) { xg2 = A(ai, 0, m - 2, n); xu2 = A(ai, 1, m - 2, n); }
                            else if (m == 1) { xg2 = sg3; xu2 = su3; }
                            else {
#pragma unroll
                                for (int j = 0; j < 4; ++j) { xg2[j] = ror1f(A(ai, 0, 2, n)[j]); xu2[j] = ror1f(A(ai, 1, 2, n)[j]); } }
                            const f32x4 xg1 = m >= 1 ? A(ai, 0, m - 1, n) : sg3, xu1 = m >= 1 ? A(ai, 1, m - 1, n) : su3, xg0 = A(ai, 0, m, n), xu0 = A(ai, 1, m, n);
                            const f32x4 ga = bg + wg0 * xg2 + wg1 * xg1 + wg2 * xg0, ua = bu + wu0 * xu2 + wu1 * xu1 + wu2 * xu0;
                            f32x4 o;
#pragma unroll
                            for (int j = 0; j < 4; ++j) o[j] = ga[j] * sigmoidf_(ga[j]) * ua[j];
                            u32x2 w; w.x = cvt_pk_bf16(o[0], o[1]); w.y = cvt_pk_bf16(o[2], o[3]);
                            if (n == 0) wlo[m] = w;
                            else if (m >= 2 || fr != 0) st_out((u32x4*)((char*)ACT + (actoff_ + 2u * (unsigned)((ai * 128 + m) * 64))), (u32x4){wlo[m].x, wlo[m].y, w.x, w.y}); } } } }
#else
#if defined(PROBE_DUP) && PROBE_DUP == 80
            int nrp_ = 2; asm volatile("" : "+s"(nrp_));
            for (int rp_ = 0; rp_ < nrp_; ++rp_) {
#endif
#if CONVW_PF
            if (CONVW_PF == 2) ldcw(0);
            ldcw(1);
#endif
#pragma unroll
            for (int n = 0; n < 2; ++n) {
#if UP_PREK == 2
                typedef __attribute__((address_space(3))) f32x4 lds_f4w;
                const unsigned wo_ = sp + (unsigned)(wc * 2 + wr) * 1024u + 4u * (unsigned)((cwp & 31) + 4 * n);
                const f32x4 wg0 = *(const lds_f4w*)(unsigned long)(wo_), wg1 = *(const lds_f4w*)(unsigned long)(wo_ + 128u), wg2 = *(const lds_f4w*)(unsigned long)(wo_ + 256u), bg = *(const lds_f4w*)(unsigned long)(wo_ + 384u);
                const f32x4 wu0 = *(const lds_f4w*)(unsigned long)(wo_ + 512u), wu1 = *(const lds_f4w*)(unsigned long)(wo_ + 640u), wu2 = *(const lds_f4w*)(unsigned long)(wo_ + 768u), bu = *(const lds_f4w*)(unsigned long)(wo_ + 896u);
#elif CONVW_PF
                const f32x4 wg0 = cwv[n][0], wg1 = cwv[n][1], wg2 = cwv[n][2], bg = cwv[n][3], wu0 = cwv[n][4], wu1 = cwv[n][5], wu2 = cwv[n][6], bu = cwv[n][7];
#else
                const int chg = 128 * u.pn + cwp + 4 * n, chu = 5632 + chg;
                const unsigned cg4 = 4u * (unsigned)chg, cu4 = 4u * (unsigned)chu;
                const f32x4 wg0 = *(const f32x4*)((const char*)cw + cg4), wg1 = *(const f32x4*)((const char*)cw + (cg4 + 4u * 11264u)), wg2 = *(const f32x4*)((const char*)cw + (cg4 + 8u * 11264u)), bg = *(const f32x4*)((const char*)cb + cg4);
                const f32x4 wu0 = *(const f32x4*)((const char*)cw + cu4), wu1 = *(const f32x4*)((const char*)cw + (cu4 + 4u * 11264u)), wu2 = *(const f32x4*)((const char*)cw + (cu4 + 8u * 11264u)), bu = *(const f32x4*)((const char*)cb + cu4);
#endif
#pragma unroll
                for (int ai = 0; ai < 2; ++ai) {
                    f32x4 sg3, su3;
#pragma unroll
                    for (int m = 3; m >= 0; --m) {
                        if (m == 1) {
#pragma unroll
                            for (int j = 0; j < 4; ++j) { sg3[j] = ror1f(A(ai, 0, 3, n)[j]); su3[j] = ror1f(A(ai, 1, 3, n)[j]); } }
                        f32x4 xg2, xu2;
                        if (m >= 2) { xg2 = A(ai, 0, m - 2, n); xu2 = A(ai, 1, m - 2, n); }
                        else if (m == 1) { xg2 = sg3; xu2 = su3; }
                        else {
#pragma unroll
                            for (int j = 0; j < 4; ++j) { xg2[j] = ror1f(A(ai, 0, 2, n)[j]); xu2[j] = ror1f(A(ai, 1, 2, n)[j]); } }
                        const f32x4 xg1 = m >= 1 ? A(ai, 0, m - 1, n) : sg3, xu1 = m >= 1 ? A(ai, 1, m - 1, n) : su3, xg0 = A(ai, 0, m, n), xu0 = A(ai, 1, m, n);
                        const f32x4 ga = bg + wg0 * xg2 + wg1 * xg1 + wg2 * xg0, ua = bu + wu0 * xu2 + wu1 * xu1 + wu2 * xu0;
                        f32x4 o;
#pragma unroll
                        for (int j = 0; j < 4; ++j) o[j] = ga[j] * sigmoidf_(ga[j]) * ua[j];
#if ROWP_ST16
                        u32x2 w; w.x = cvt_pk_bf16(o[0], o[1]); w.y = cvt_pk_bf16(o[2], o[3]);
                        if (n == 0) wlo[ai][m] = w;
                        else if (m >= 2 || fr != 0) st_out((u32x4*)(ACT + tiled_off(UPROW(ai, m), 128 * u.pn + cwp, 5632)), (u32x4){wlo[ai][m].x, wlo[ai][m].y, w.x, w.y});
#else
                        if (m >= 2 || fr != 0) { u32x2 w; w.x = cvt_pk_bf16(o[0], o[1]); w.y = cvt_pk_bf16(o[2], o[3]); *(u32x2*)(actb + (ai * 128 + m) * 64 + 4 * n) = w; }
#endif
                    }
                }
            }
#if defined(PROBE_DUP) && PROBE_DUP == 80
            }
#endif
#endif
#pragma unroll
            for (int e = 0; e < 2; ++e)
                if (fr == (e ? 15 : 0)) {
#pragma unroll
                    for (int ai = 0; ai < 2; ++ai) { const int span = u.pm * 4 + ai * 2 + wr;
#pragma unroll
                        for (int k = 0; k < 2; ++k) { const int m = 2 * e + k;
                            bf16_t* hp = (bf16_t*)((char*)HALO + 2u * ((unsigned)(span * 4 + m) * 11264u + (unsigned)(256 * u.pn + cwp)));
#if HALO_WT
                            if (e) { st_wt((u32x4*)(hp), (u32x4)(pack8(A(ai, 0, m, 0), A(ai, 0, m, 1)))); st_wt((u32x4*)(hp + HALF), (u32x4)(pack8(A(ai, 1, m, 0), A(ai, 1, m, 1)))); }
                            else
#endif
                            { st_out((u32x4*)(hp), (u32x4)(pack8(A(ai, 0, m, 0), A(ai, 0, m, 1)))); st_out((u32x4*)(hp + HALF), (u32x4)(pack8(A(ai, 1, m, 0), A(ai, 1, m, 1)))); } } } }
        } else
#else
        if (u.pn < 44) {
            f32x4 wg0_[2], wg1_[2], wg2_[2], bg_[2], wu0_[2], wu1_[2], wu2_[2], bu_[2];
#pragma unroll
            for (int n = 0; n < 2; ++n) { const int chg = 128 * u.pn + cwp + 4 * n, chu = 5632 + chg;
                wg0_[n] = *(const f32x4*)(cw + chg); wg1_[n] = *(const f32x4*)(cw + 11264 + chg); wg2_[n] = *(const f32x4*)(cw + 2 * 11264 + chg); bg_[n] = *(const f32x4*)(cb + chg);
                wu0_[n] = *(const f32x4*)(cw + chu); wu1_[n] = *(const f32x4*)(cw + 11264 + chu); wu2_[n] = *(const f32x4*)(cw + 2 * 11264 + chu); bu_[n] = *(const f32x4*)(cb + chu); }
#pragma unroll
            for (int ai = 0; ai < 2; ++ai) {
                const int span = u.pm * 4 + ai * 2 + wr;
#pragma unroll
                for (int m = 0; m < 4; ++m) {
                    const int row = row0 + ai * HALF + m * 16;
                    u32x4 w, rg, ru;
#pragma unroll
                    for (int n = 0; n < 2; ++n) {
                        const f32x4 wg0 = wg0_[n], wg1 = wg1_[n], wg2 = wg2_[n], bg = bg_[n], wu0 = wu0_[n], wu1 = wu1_[n], wu2 = wu2_[n], bu = bu_[n];
                        const f32x4 cg = A(ai, 0, m, n), cu = A(ai, 1, m, n);
                        const f32x4 pg = A(ai, 0, m ? m - 1 : 0, n), pu = A(ai, 1, m ? m - 1 : 0, n);
                        f32x4 o;
#pragma unroll
                        for (int j = 0; j < 4; ++j) {
                            const float g1 = ror1f(fr == 15 ? pg[j] : cg[j]), g2 = ror2f(fr >= 14 ? pg[j] : cg[j]);
                            const float u1 = ror1f(fr == 15 ? pu[j] : cu[j]), u2 = ror2f(fr >= 14 ? pu[j] : cu[j]);
                            const float ga = bg[j] + wg0[j] * g2 + wg1[j] * g1 + wg2[j] * cg[j], ua = bu[j] + wu0[j] * u2 + wu1[j] * u1 + wu2[j] * cu[j];
                            o[j] = ga * sigmoidf_(ga) * ua; }
                        if (n == 0) { w.x = cvt_pk_bf16(o[0], o[1]); w.y = cvt_pk_bf16(o[2], o[3]); rg.x = cvt_pk_bf16(cg[0], cg[1]); rg.y = cvt_pk_bf16(cg[2], cg[3]); ru.x = cvt_pk_bf16(cu[0], cu[1]); ru.y = cvt_pk_bf16(cu[2], cu[3]); }
                        else { w.z = cvt_pk_bf16(o[0], o[1]); w.w = cvt_pk_bf16(o[2], o[3]); rg.z = cvt_pk_bf16(cg[0], cg[1]); rg.w = cvt_pk_bf16(cg[2], cg[3]); ru.z = cvt_pk_bf16(cu[0], cu[1]); ru.w = cvt_pk_bf16(cu[2], cu[3]); }
                    }
                    if (m > 0 || fr >= 2) st_out((u32x4*)(ACT + tiled_off(row, 128 * u.pn + cwp, 5632)), (u32x4)(w));
                    if ((m == 0 && fr < 2) || (m == 3 && fr >= 14)) { int frq = fr; asm volatile("" : "+v"(frq)); const int slot = (m == 0) ? frq : frq - 12;
                        bf16_t* hp = HALO + ((size_t)(span * 4 + slot)) * 11264 + 256 * u.pn + cwp;
                        st_out((u32x4*)(hp), (u32x4)(rg)); st_out((u32x4*)(hp + HALF), (u32x4)(ru)); }
                }
            }
        } else
#endif
        {
            const int colg = (u.pn - 44) * 256 + cwp;
#if TFOLD
            __attribute__((address_space(3))) f32x4* slot = (__attribute__((address_space(3))) f32x4*)(unsigned long)(sp + (unsigned)(wc * 2 + wr) * 1024u);
            if (fr == 0) {
#pragma unroll
                for (int bj = 0; bj < 2; ++bj)
#pragma unroll
                    for (int n = 0; n < 2; ++n) { const int e = (bj * 2 + n) * 4 + fq, c = colg + bj * HALF + 4 * n;
                        slot[e] = *(const f32x4*)(bgate + c); slot[16 + e] = *(const f32x4*)(g1 + c) * alpha; slot[32 + e] = *(const f32x4*)(b1 + c) * alpha; } }
            __builtin_amdgcn_fence(__ATOMIC_RELEASE, "wavefront"); __builtin_amdgcn_wave_barrier(); __builtin_amdgcn_fence(__ATOMIC_ACQUIRE, "wavefront");
            u32x4 sgp[2][2][4];
#pragma unroll
            for (int bj = 0; bj < 2; ++bj) { const f32x4 bb0 = slot[(bj * 2 + 0) * 4 + fq], bb1 = slot[(bj * 2 + 1) * 4 + fq];
#pragma unroll
                for (int ai = 0; ai < 2; ++ai)
#pragma unroll
                    for (int m = 0; m < 4; ++m) { f32x4 v0 = acc[ai][bj][m][0] + bb0, v1 = acc[ai][bj][m][1] + bb1;
#pragma unroll
                        for (int j = 0; j < 4; ++j) { v0[j] = sigmoidf_(v0[j]); v1[j] = sigmoidf_(v1[j]); }
                        u32x4 pk = pack8(v0, v1); unsigned k0 = pk.x, k1 = pk.y, k2 = pk.z, k3 = pk.w; asm volatile("" : "+v"(k0), "+v"(k1), "+v"(k2), "+v"(k3)); sgp[ai][bj][m] = (u32x4){k0, k1, k2, k3}; } }
            int colq = colg, rowq = row0; asm volatile("" : "+v"(colq), "+v"(rowq) : "v"(sgp[1][1][3].w));
            constexpr int GPD = GATE_PD;
            u32x4 yq[GPD][2], pq[GPD][2]; f32x2 sq[GPD];
#pragma unroll
            for (int d = 0; d < GPD; ++d) { const unsigned rn = (unsigned)(rowq + (d >> 2) * HALF + (d & 3) * 16), offn = rn * 2048u + (unsigned)colq; sq[d] = *(const f32x2*)(stats + 2u * rn);
                yq[d][0] = *(const u32x4*)(YHr + offn); yq[d][1] = *(const u32x4*)(YHr + offn + HALF); pq[d][0] = *(const u32x4*)(PPr + offn); pq[d][1] = *(const u32x4*)(PPr + offn + HALF); }
#pragma unroll
            for (int i = 0; i < 8; ++i) { const int ai = i >> 2, m = i & 3, sl = i % GPD; const unsigned off = (unsigned)(rowq + ai * HALF + m * 16) * 2048u + (unsigned)colq;
                const u32x4 cy0 = yq[sl][0], cy1 = yq[sl][1], cp0 = pq[sl][0], cp1 = pq[sl][1]; const f32x2 cs = sq[sl];
                if (i + GPD < 8) { const unsigned rn = (unsigned)(rowq + ((i + GPD) >> 2) * HALF + ((i + GPD) & 3) * 16), offn = rn * 2048u + (unsigned)colq; sq[sl] = *(const f32x2*)(stats + 2u * rn);
                    yq[sl][0] = *(const u32x4*)(YHr + offn); yq[sl][1] = *(const u32x4*)(YHr + offn + HALF); pq[sl][0] = *(const u32x4*)(PPr + offn); pq[sl][1] = *(const u32x4*)(PPr + offn + HALF); }
#pragma unroll
                for (int bj = 0; bj < 2; ++bj) { const u32x4 sv = sgp[ai][bj][m], pp = bj ? cp1 : cp0;
                    unsigned so = sp + (unsigned)(wc * 2 + wr) * 1024u + (unsigned)fq * 16u; asm volatile("" : "+v"(so));
                    __attribute__((address_space(3))) f32x4* sq_ = (__attribute__((address_space(3))) f32x4*)(unsigned long)so;
                    const f32x4 g0 = sq_[16 + (bj * 2 + 0) * 4], g1v = sq_[16 + (bj * 2 + 1) * 4], b0 = sq_[32 + (bj * 2 + 0) * 4], b1v = sq_[32 + (bj * 2 + 1) * 4];
                    const f32x8 yf = __builtin_convertvector(__builtin_bit_cast(h16x8, bj ? cy1 : cy0), f32x8);
                    const f32x4 y0 = (f32x4){yf[0], yf[1], yf[2], yf[3]}, y1 = (f32x4){yf[4], yf[5], yf[6], yf[7]};
                    const f32x4 p0 = (f32x4){__uint_as_float(pp.x << 16), __uint_as_float(pp.x & 0xffff0000u), __uint_as_float(pp.y << 16), __uint_as_float(pp.y & 0xffff0000u)};
                    const f32x4 p1 = (f32x4){__uint_as_float(pp.z << 16), __uint_as_float(pp.z & 0xffff0000u), __uint_as_float(pp.w << 16), __uint_as_float(pp.w & 0xffff0000u)};
                    const f32x4 v0 = (f32x4){__uint_as_float(sv.x << 16), __uint_as_float(sv.x & 0xffff0000u), __uint_as_float(sv.y << 16), __uint_as_float(sv.y & 0xffff0000u)};
                    const f32x4 v1 = (f32x4){__uint_as_float(sv.z << 16), __uint_as_float(sv.z & 0xffff0000u), __uint_as_float(sv.w << 16), __uint_as_float(sv.w & 0xffff0000u)};
                    const f32x4 t0 = (y0 - cs.x) * cs.y * g0 + b0 + p0 * v0, t1 = (y1 - cs.x) * cs.y * g1v + b1v + p1 * v1;
                    const f32x8 tf = (f32x8){t0[0], t0[1], t0[2], t0[3], t1[0], t1[1], t1[2], t1[3]};
                    st_out((u32x4*)((_Float16*)SG + off + bj * HALF), __builtin_bit_cast(u32x4, __builtin_convertvector(tf, h16x8))); } }
#else
            f32x4 bv[2][2];
#pragma unroll
            for (int bj = 0; bj < 2; ++bj)
#pragma unroll
                for (int n = 0; n < 2; ++n) bv[bj][n] = *(const f32x4*)((const char*)bgate + 4u * (unsigned)(colg + bj * HALF + 4 * n));
#if PSG
            u32x4 pq[2][2];
#pragma unroll
            for (int d = 0; d < 2; ++d) { const unsigned o = 2u * ((unsigned)UPROW(d >> 2, d & 3) * 2048u + (unsigned)colg); pq[d][0] = *(const u32x4*)((const char*)PPr + o); pq[d][1] = *(const u32x4*)((const char*)PPr + (o + 2u * HALF)); }
#pragma unroll
            for (int i = 0; i < 8; ++i) { const int ai = i >> 2, m = i & 3; const unsigned ro = 2u * ((unsigned)UPROW(ai, m) * 2048u + (unsigned)colg);
                const u32x4 cp0 = pq[i & 1][0], cp1 = pq[i & 1][1];
                if (i + 2 < 8) { const unsigned o = 2u * ((unsigned)UPROW((i + 2) >> 2, (i + 2) & 3) * 2048u + (unsigned)colg); pq[i & 1][0] = *(const u32x4*)((const char*)PPr + o); pq[i & 1][1] = *(const u32x4*)((const char*)PPr + (o + 2u * HALF)); }
#pragma unroll
                for (int bj = 0; bj < 2; ++bj) { f32x4 v0 = A(ai, bj, m, 0) + bv[bj][0], v1 = A(ai, bj, m, 1) + bv[bj][1]; const u32x4 pp = bj ? cp1 : cp0;
#pragma unroll
                    for (int j = 0; j < 4; ++j) { v0[j] = sigmoidf_(v0[j]); v1[j] = sigmoidf_(v1[j]); }
                    v0[0] *= __uint_as_float(pp.x << 16); v0[1] *= __uint_as_float(pp.x & 0xffff0000u); v0[2] *= __uint_as_float(pp.y << 16); v0[3] *= __uint_as_float(pp.y & 0xffff0000u);
                    v1[0] *= __uint_as_float(pp.z << 16); v1[1] *= __uint_as_float(pp.z & 0xffff0000u); v1[2] *= __uint_as_float(pp.w << 16); v1[3] *= __uint_as_float(pp.w & 0xffff0000u);
                    st_out((u32x4*)((char*)SG + (ro + 2u * (unsigned)(bj * HALF))), (u32x4)(pack8(v0, v1))); } }
#else
#pragma unroll
            for (int ai = 0; ai < 2; ++ai)
#pragma unroll
                for (int m = 0; m < 4; ++m) { bf16_t* rowp = (bf16_t*)((char*)SG + 2u * ((unsigned)UPROW(ai, m) * 2048u + (unsigned)colg));
#pragma unroll
                    for (int bj = 0; bj < 2; ++bj) { f32x4 v0 = A(ai, bj, m, 0) + bv[bj][0], v1 = A(ai, bj, m, 1) + bv[bj][1];
#pragma unroll
                        for (int j = 0; j < 4; ++j) { v0[j] = sigmoidf_(v0[j]); v1[j] = sigmoidf_(v1[j]); }
                        st_out((u32x4*)(rowp + bj * HALF), (u32x4)(pack8(v0, v1))); } }
#endif
#endif
        }
    }
};

typedef EpiUpConvT<false> EpiUpConv;
#if UP_PREK && ROWP
template <> struct PreK<EpiUpConvT<true>> { static constexpr bool value = true; };
#endif
#if RELAX_UP
template <> struct RelaxW<EpiUpConvT<true>> { static constexpr int value = 32; };
#endif
#if ROWP
static_assert(!TFOLD, "ROWP: the TFOLD gate-tile path still uses the natural row order");
template <> struct PermA<EpiUpConvT<true>> { static constexpr bool value = true; };
template <> struct PermA<EpiUpConvT<false>> { static constexpr bool value = true; };
#endif
struct EpiPlain {
    static constexpr bool PERM = true, AFTER_DRAIN = false;
    bf16_t* O;
    __device__ __forceinline__ void operator()(const f32x4 (&acc)[2][2][4][2], const Unit& u, int wr, int wc, int fr, int fq) const {
        const int row0 = u.pm * BM + wr * 64 + fr, cwp = u.pn * BM + wc * 32 + 8 * fq;
#pragma unroll
        for (int ai = 0; ai < 2; ++ai)
#pragma unroll
            for (int m = 0; m < 4; ++m) { bf16_t* rowp = O + (size_t)(row0 + ai * HALF + m * 16) * 2048 + cwp;
#pragma unroll
                for (int bj = 0; bj < 2; ++bj) st_out((u32x4*)(rowp + bj * HALF), (u32x4)(pack8(acc[ai][bj][m][0], acc[ai][bj][m][1]))); }
    }
};
struct EpiDown {
    static constexpr bool PERM = false, AFTER_DRAIN = false;
    const float* base; float* Y; const bf16_t* PP; const bf16_t* SG; float alpha;
    __device__ __forceinline__ void operator()(const f32x4 (&acc)[2][2][4][2], const Unit& u, int wr, int wc, int fr, int fq) const {
        const int row0 = u.pm * BM + wr * 64 + fr, col0 = u.pn * BM + wc * 32 + 4 * fq;
#pragma unroll
        for (int ai = 0; ai < 2; ++ai)
#pragma unroll
            for (int m = 0; m < 4; ++m) { const size_t off = (size_t)(row0 + ai * HALF + m * 16) * 2048 + col0;
#pragma unroll
                for (int bj = 0; bj < 2; ++bj)
#pragma unroll
                    for (int n = 0; n < 2; ++n) { const size_t o = off + bj * HALF + n * 16; const u32x2 pp = *(const u32x2*)(PP + o), sg = *(const u32x2*)(SG + o);
                        f32x4 pl; pl[0] = __uint_as_float(pp.x << 16) * __uint_as_float(sg.x << 16); pl[1] = __uint_as_float(pp.x & 0xffff0000u) * __uint_as_float(sg.x & 0xffff0000u);
                        pl[2] = __uint_as_float(pp.y << 16) * __uint_as_float(sg.y << 16); pl[3] = __uint_as_float(pp.y & 0xffff0000u) * __uint_as_float(sg.y & 0xffff0000u);
                        st_out((f32x4*)(Y + o), (f32x4)(acc[ai][bj][m][n] + *(const f32x4*)(base + o) * alpha + pl)); } }
    }
};

template <bool PLE_> struct EpiResidLN {
    static constexpr bool PERM = false, AFTER_DRAIN = false;
    float* Y; float* Yout; const float* stats; const float* g; const float* b; const bf16_t* PP; const bf16_t* SG; float alpha;
    __device__ __forceinline__ void operator()(const f32x4 (&acc)[2][2][4][2], const Unit& u, int wr, int wc, int fr, int fq) const {
        const int row0 = u.pm * BM + wr * 64 + fr, col0 = u.pn * BM + wc * 32 + 4 * fq;
        f32x4 g4[2][2], b4[2][2];
#pragma unroll
        for (int bj = 0; bj < 2; ++bj)
#pragma unroll
            for (int n = 0; n < 2; ++n) { g4[bj][n] = *(const f32x4*)(g + col0 + bj * HALF + n * 16) * alpha; b4[bj][n] = *(const f32x4*)(b + col0 + bj * HALF + n * 16) * alpha; }
        f32x4 cy[2][2], ny[2][2]; f32x2 cst, nst;
        { const size_t off = (size_t)row0 * 2048 + col0; cst = *(const f32x2*)(stats + 2 * (size_t)row0);
#pragma unroll
          for (int bj = 0; bj < 2; ++bj)
#pragma unroll
              for (int n = 0; n < 2; ++n) cy[bj][n] = *(const f32x4*)(Y + off + bj * HALF + n * 16); }
#pragma unroll
        for (int i = 0; i < 8; ++i) { const int ai = i >> 2, m = i & 3; const size_t off = (size_t)(row0 + ai * HALF + m * 16) * 2048 + col0;
            if (i < 7) { const int rn = row0 + ((i + 1) >> 2) * HALF + ((i + 1) & 3) * 16; const size_t offn = (size_t)rn * 2048 + col0; nst = *(const f32x2*)(stats + 2 * (size_t)rn);
#pragma unroll
                for (int bj = 0; bj < 2; ++bj)
#pragma unroll
                    for (int n = 0; n < 2; ++n) ny[bj][n] = *(const f32x4*)(Y + offn + bj * HALF + n * 16); }
#pragma unroll
            for (int bj = 0; bj < 2; ++bj)
#pragma unroll
                for (int n = 0; n < 2; ++n) { const size_t o = off + bj * HALF + n * 16;
                    f32x4 v = acc[ai][bj][m][n] + (cy[bj][n] - cst.x) * cst.y * g4[bj][n] + b4[bj][n];
                    if (PLE_) { const u32x2 pp = *(const u32x2*)(PP + o), sg = *(const u32x2*)(SG + o);
                        v[0] += __uint_as_float(pp.x << 16) * __uint_as_float(sg.x << 16); v[1] += __uint_as_float(pp.x & 0xffff0000u) * __uint_as_float(sg.x & 0xffff0000u);
                        v[2] += __uint_as_float(pp.y << 16) * __uint_as_float(sg.y << 16); v[3] += __uint_as_float(pp.y & 0xffff0000u) * __uint_as_float(sg.y & 0xffff0000u); }
                    st_out((f32x4*)(Yout + o), (f32x4)(v)); }
#pragma unroll
            for (int bj = 0; bj < 2; ++bj)
#pragma unroll
                for (int n = 0; n < 2; ++n) cy[bj][n] = ny[bj][n];
            cst = nst; }
    }
};

template <bool LNBASE, bool PLE_, bool STATS> struct EpiRes2 {
    static constexpr bool PERM = true, AFTER_DRAIN = false;
    const float* base; float* Y; bf16_t* YB; float* pstat; const float* stats; const float* g; const float* b; const bf16_t* PP; const bf16_t* SG; float alpha;
    __device__ __forceinline__ void operator()(const f32x4 (&acc)[2][2][4][2], const Unit& u, int wr, int wc, int fr, int fq) const {
        const int row0 = u.pm * BM + wr * 64 + fr, col0 = u.pn * BM + wc * 32 + 8 * fq, lane = fq * 16 + fr;
        const float* src = LNBASE ? (const float*)Y : base;
        f32x4 g4[2][2], b4[2][2];
        if (LNBASE) {
#pragma unroll
            for (int bj = 0; bj < 2; ++bj)
#pragma unroll
                for (int n = 0; n < 2; ++n) { g4[bj][n] = *(const f32x4*)(g + col0 + bj * HALF + 4 * n) * alpha; b4[bj][n] = *(const f32x4*)(b + col0 + bj * HALF + 4 * n) * alpha; } }
        f32x4 cy[2][2], ny[2][2]; f32x2 cst = (f32x2){0.f, 1.f}, nst = (f32x2){0.f, 1.f};
        { const size_t off = (size_t)row0 * 2048 + col0; if (LNBASE) cst = *(const f32x2*)(stats + 2 * (size_t)row0);
#pragma unroll
          for (int bj = 0; bj < 2; ++bj)
#pragma unroll
              for (int n = 0; n < 2; ++n) cy[bj][n] = *(const f32x4*)(src + off + bj * HALF + 4 * n); }
#pragma unroll
        for (int i = 0; i < 8; ++i) { const int ai = i >> 2, m = i & 3, row = row0 + ai * HALF + m * 16; const size_t off = (size_t)row * 2048 + col0;
            if (i < 7) { const int rn = row0 + ((i + 1) >> 2) * HALF + ((i + 1) & 3) * 16; const size_t offn = (size_t)rn * 2048 + col0; if (LNBASE) nst = *(const f32x2*)(stats + 2 * (size_t)rn);
#pragma unroll
                for (int bj = 0; bj < 2; ++bj)
#pragma unroll
                    for (int n = 0; n < 2; ++n) ny[bj][n] = *(const f32x4*)(src + offn + bj * HALF + 4 * n); }
            float s1 = 0.f, s2 = 0.f;
#pragma unroll
            for (int bj = 0; bj < 2; ++bj) { f32x4 v[2];
#pragma unroll
                for (int n = 0; n < 2; ++n) v[n] = LNBASE ? acc[ai][bj][m][n] + (cy[bj][n] - cst.x) * cst.y * g4[bj][n] + b4[bj][n] : acc[ai][bj][m][n] + cy[bj][n] * alpha;
                if (PLE_) { const u32x4 pp = *(const u32x4*)(PP + off + bj * HALF), sg = *(const u32x4*)(SG + off + bj * HALF);
                    v[0][0] += __uint_as_float(pp.x << 16) * __uint_as_float(sg.x << 16); v[0][1] += __uint_as_float(pp.x & 0xffff0000u) * __uint_as_float(sg.x & 0xffff0000u);
                    v[0][2] += __uint_as_float(pp.y << 16) * __uint_as_float(sg.y << 16); v[0][3] += __uint_as_float(pp.y & 0xffff0000u) * __uint_as_float(sg.y & 0xffff0000u);
                    v[1][0] += __uint_as_float(pp.z << 16) * __uint_as_float(sg.z << 16); v[1][1] += __uint_as_float(pp.z & 0xffff0000u) * __uint_as_float(sg.z & 0xffff0000u);
                    v[1][2] += __uint_as_float(pp.w << 16) * __uint_as_float(sg.w << 16); v[1][3] += __uint_as_float(pp.w & 0xffff0000u) * __uint_as_float(sg.w & 0xffff0000u); }
                st_out((f32x4*)(Y + off + bj * HALF), (f32x4)(v[0])); st_out((f32x4*)(Y + off + bj * HALF + 4), (f32x4)(v[1]));
                if (STATS) { st_out((u32x4*)(YB + off + bj * HALF), (u32x4)(pack8(v[0], v[1])));
#pragma unroll
                    for (int n = 0; n < 2; ++n) { s1 += (v[n][0] + v[n][1]) + (v[n][2] + v[n][3]); s2 += (v[n][0] * v[n][0] + v[n][1] * v[n][1]) + (v[n][2] * v[n][2] + v[n][3] * v[n][3]); } } }
            if (STATS) {
                s1 += __builtin_bit_cast(float, __builtin_amdgcn_ds_bpermute((lane ^ 16) << 2, __builtin_bit_cast(int, s1))); s2 += __builtin_bit_cast(float, __builtin_amdgcn_ds_bpermute((lane ^ 16) << 2, __builtin_bit_cast(int, s2)));
                s1 += __builtin_bit_cast(float, __builtin_amdgcn_ds_bpermute((lane ^ 32) << 2, __builtin_bit_cast(int, s1))); s2 += __builtin_bit_cast(float, __builtin_amdgcn_ds_bpermute((lane ^ 32) << 2, __builtin_bit_cast(int, s2)));
                #if PST_T
                if (fq == 0) *(f32x2*)(pstat + ((size_t)(u.pn * 4 + wc) * 16384 + row) * 2) = (f32x2){s1, s2}; }
#else
                if (fq == 0) *(f32x2*)(pstat + ((size_t)row * 32 + u.pn * 4 + wc) * 2) = (f32x2){s1, s2}; }
#endif
#pragma unroll
            for (int bj = 0; bj < 2; ++bj)
#pragma unroll
                for (int n = 0; n < 2; ++n) cy[bj][n] = ny[bj][n];
            cst = nst; }
    }
};

struct EpiNull {
    static constexpr bool PERM = true, AFTER_DRAIN = false;
    __device__ __forceinline__ void operator()(const f32x4 (&acc)[2][2][4][2], const Unit&, int, int, int, int) const {
#pragma unroll
        for (int i = 0; i < 32; ++i) asm volatile("" :: "v"(acc[i >> 4][(i >> 3) & 1][(i >> 1) & 3][i & 1]));
    }
};
template <bool LNBASE, bool PLE_, bool TB = false> struct EpiRes3 {
    static constexpr bool PERM = true, AFTER_DRAIN = false;
    const float* base; float* Y; bf16_t* YB; _Float16* YH; float* pstat; const float* stats; const float* g; const float* b; const bf16_t* PP; const bf16_t* SG;
#if defined(PROBE_DUP) && (PROBE_DUP == 42 || PROBE_DUP == 43)
    _Float16* YHw;
#define EPIRES3_YHW YHw
#else
#define EPIRES3_YHW YH
#endif
    float alpha;
    static constexpr bool SEEDED = PLE_ && !TB && (SEED_PLE != 0);
    __device__ __forceinline__ void seed_issue(const Unit& u, int q, int wr, int wc, int fr, int fq, u32x4& d0, u32x4& d1) const {
        const int i = q >> 1, bj = q & 1; const unsigned off = (unsigned)(u.pm * BM + wr * 64 + fr + (i >> 2) * HALF + (i & 3) * 16) * 2048u + (unsigned)(u.pn * BM + wc * 32 + 8 * fq + bj * HALF);
        const unsigned ob = 2u * off;
        asm volatile("global_load_dwordx4 %0, %2, %3\n\tglobal_load_dwordx4 %1, %2, %4" : "=&v"(d0), "=&v"(d1) : "v"(ob), "s"(PP), "s"(SG) : "memory");
    }
    __device__ __forceinline__ void seed_wait(u32x4& d0, u32x4& d1) const { asm volatile("s_waitcnt vmcnt(16)" : "+v"(d0), "+v"(d1) :: "memory"); }
    template <int Q> __device__ __forceinline__ void seed_add1(f32x4 (&acc)[2][2][4][2], const u32x4 pp, const u32x4 sg) const {
        constexpr int ai = Q >> 3, m = (Q >> 1) & 3, bj = Q & 1;
        f32x4 a0 = acc[ai][bj][m][0], a1 = acc[ai][bj][m][1];
        a0[0] += __uint_as_float(pp.x << 16) * __uint_as_float(sg.x << 16); a0[1] += __uint_as_float(pp.x & 0xffff0000u) * __uint_as_float(sg.x & 0xffff0000u);
        a0[2] += __uint_as_float(pp.y << 16) * __uint_as_float(sg.y << 16); a0[3] += __uint_as_float(pp.y & 0xffff0000u) * __uint_as_float(sg.y & 0xffff0000u);
        a1[0] += __uint_as_float(pp.z << 16) * __uint_as_float(sg.z << 16); a1[1] += __uint_as_float(pp.z & 0xffff0000u) * __uint_as_float(sg.z & 0xffff0000u);
        a1[2] += __uint_as_float(pp.w << 16) * __uint_as_float(sg.w << 16); a1[3] += __uint_as_float(pp.w & 0xffff0000u) * __uint_as_float(sg.w & 0xffff0000u);
        acc[ai][bj][m][0] = a0; acc[ai][bj][m][1] = a1;
    }
    __device__ __forceinline__ void seed_add(f32x4 (&acc)[2][2][4][2], int q, const u32x4 pp, const u32x4 sg) const {
        switch (q) {
            case 0: seed_add1<0>(acc, pp, sg); break; case 1: seed_add1<1>(acc, pp, sg); break; case 2: seed_add1<2>(acc, pp, sg); break; case 3: seed_add1<3>(acc, pp, sg); break;
            case 4: seed_add1<4>(acc, pp, sg); break; case 5: seed_add1<5>(acc, pp, sg); break; case 6: seed_add1<6>(acc, pp, sg); break; case 7: seed_add1<7>(acc, pp, sg); break;
            case 8: seed_add1<8>(acc, pp, sg); break; case 9: seed_add1<9>(acc, pp, sg); break; case 10: seed_add1<10>(acc, pp, sg); break; case 11: seed_add1<11>(acc, pp, sg); break;
            case 12: seed_add1<12>(acc, pp, sg); break; case 13: seed_add1<13>(acc, pp, sg); break; case 14: seed_add1<14>(acc, pp, sg); break; default: seed_add1<15>(acc, pp, sg); break; }
    }
    __device__ __forceinline__ void operator()(const f32x4 (&acc)[2][2][4][2], const Unit& u, int wr, int wc, int fr, int fq) const {
        const int row0 = u.pm * BM + wr * 64 + fr, col0 = u.pn * BM + wc * 32 + 8 * fq, lane = fq * 16 + fr;
        const _Float16* const src = TB ? (const _Float16*)PP : (const _Float16*)YH;
#if GB_LDS
        extern __shared__ __attribute__((aligned(16))) unsigned char lds_raw[];
        PG8_LAS unsigned char* const gbs_ = (PG8_LAS unsigned char*)lds_raw + 135168 + (wc * 2 + wr) * 1024;
        if (LNBASE && !TB) { const int t_ = lane & 15, sel_ = lane >> 4;
            if (sel_ < 2) { const f32x4 v_ = *(const f32x4*)((sel_ ? b : g) + u.pn * BM + wc * 32 + (t_ >> 3) * HALF + 4 * (t_ & 7)) * alpha; *(PG8_LAS f32x4*)(gbs_ + 256 * sel_ + 16 * t_) = v_; }
            asm volatile("s_waitcnt lgkmcnt(0)" ::: "memory"); }
#else
        f32x4 g4[2][2], b4[2][2];
        if (LNBASE && !TB) {
#pragma unroll
            for (int bj = 0; bj < 2; ++bj)
#pragma unroll
                for (int n = 0; n < 2; ++n) { g4[bj][n] = *(const f32x4*)(g + col0 + bj * HALF + 4 * n) * alpha; b4[bj][n] = *(const f32x4*)(b + col0 + bj * HALF + 4 * n) * alpha; } }
#endif
        constexpr bool PF = PLE_ && !TB && (PLE_PF != 0);
#if GB_LDS
        constexpr int PD = LNBASE ? EPI_PD : 2;
#else
        constexpr int PD = LNBASE ? (PF ? 1 : EPI_PD) : 2;
#endif
        u32x4 ybq[PD][2]; f32x2 stq[PD]; f32x4 yfq[PD][2][2];
        u32x4 ppq[1][2], sgq[1][2];
#pragma unroll
        for (int d = 0; d < PD; ++d) { const int rn = row0 + (d >> 2) * HALF + (d & 3) * 16; const unsigned offn = (unsigned)rn * 2048u + (unsigned)col0;
            if (PF && d == 0) { ppq[0][0] = *(const u32x4*)(PP + offn); ppq[0][1] = *(const u32x4*)(PP + offn + HALF); sgq[0][0] = *(const u32x4*)(SG + offn); sgq[0][1] = *(const u32x4*)(SG + offn + HALF); }
            if (LNBASE) { if (!TB) stq[d] = *(const f32x2*)(stats + 2u * (unsigned)rn); ybq[d][0] = ld_stream((const u32x4*)(src + offn)); ybq[d][1] = ld_stream((const u32x4*)(src + offn + HALF)); }
            else {
#pragma unroll
                for (int bj = 0; bj < 2; ++bj)
#pragma unroll
                    for (int n = 0; n < 2; ++n) yfq[d][bj][n] = *(const f32x4*)(base + offn + bj * HALF + 4 * n); } }
#pragma unroll
        for (int i = 0; i < 8; ++i) { const int ai = i >> 2, m = i & 3, row = row0 + ai * HALF + m * 16; const unsigned off = (unsigned)row * 2048u + (unsigned)col0;
            const int sl = i % PD;
            u32x4 cyb[2]; f32x4 cyf[2][2]; f32x2 cst = (f32x2){0.f, 1.f};
            u32x4 cpp[2], csg[2];
            if (PF) { cpp[0] = ppq[0][0]; cpp[1] = ppq[0][1]; csg[0] = sgq[0][0]; csg[1] = sgq[0][1];
                if (i + 1 < 8) { const unsigned o1 = (unsigned)(row0 + ((i + 1) >> 2) * HALF + ((i + 1) & 3) * 16) * 2048u + (unsigned)col0;
                    ppq[0][0] = *(const u32x4*)(PP + o1); ppq[0][1] = *(const u32x4*)(PP + o1 + HALF); sgq[0][0] = *(const u32x4*)(SG + o1); sgq[0][1] = *(const u32x4*)(SG + o1 + HALF); } }
            if (LNBASE) { cyb[0] = ybq[sl][0]; cyb[1] = ybq[sl][1]; if (!TB) cst = stq[sl]; }
            else {
#pragma unroll
                for (int bj = 0; bj < 2; ++bj)
#pragma unroll
                    for (int n = 0; n < 2; ++n) cyf[bj][n] = yfq[sl][bj][n]; }
            if (i + PD < 8) { const int rn = row0 + ((i + PD) >> 2) * HALF + ((i + PD) & 3) * 16; const unsigned offn = (unsigned)rn * 2048u + (unsigned)col0;
                if (LNBASE) { if (!TB) stq[sl] = *(const f32x2*)(stats + 2u * (unsigned)rn); ybq[sl][0] = ld_stream((const u32x4*)(src + offn)); ybq[sl][1] = ld_stream((const u32x4*)(src + offn + HALF)); }
                else {
#pragma unroll
                    for (int bj = 0; bj < 2; ++bj)
#pragma unroll
                        for (int n = 0; n < 2; ++n) yfq[sl][bj][n] = *(const f32x4*)(base + offn + bj * HALF + 4 * n); } }
            float s1 = 0.f, s2 = 0.f;
#pragma unroll
            for (int bj = 0; bj < 2; ++bj) { f32x4 v[2];
#if GB_LDS
                f32x4 g4[2][2], b4[2][2];
                if (LNBASE && !TB) { g4[bj][0] = *(const PG8_LAS f32x4*)(gbs_ + 4 * (bj * 32 + 8 * fq)); g4[bj][1] = *(const PG8_LAS f32x4*)(gbs_ + 4 * (bj * 32 + 8 * fq + 4));
                    b4[bj][0] = *(const PG8_LAS f32x4*)(gbs_ + 256 + 4 * (bj * 32 + 8 * fq)); b4[bj][1] = *(const PG8_LAS f32x4*)(gbs_ + 256 + 4 * (bj * 32 + 8 * fq + 4)); }
#endif
                if (LNBASE) { const f32x8 yf = __builtin_convertvector(__builtin_bit_cast(h16x8, cyb[bj]), f32x8);
                    const f32x4 y0 = (f32x4){yf[0], yf[1], yf[2], yf[3]}, y1 = (f32x4){yf[4], yf[5], yf[6], yf[7]};
                    if (TB) { v[0] = acc[ai][bj][m][0] + y0; v[1] = acc[ai][bj][m][1] + y1; }
                    else { v[0] = acc[ai][bj][m][0] + (y0 - cst.x) * cst.y * g4[bj][0] + b4[bj][0]; v[1] = acc[ai][bj][m][1] + (y1 - cst.x) * cst.y * g4[bj][1] + b4[bj][1]; } }
                else { v[0] = acc[ai][bj][m][0] + cyf[bj][0] * alpha; v[1] = acc[ai][bj][m][1] + cyf[bj][1] * alpha; }
#if PSG
                if (PLE_ && !TB) { const u32x4 ps = ld_stream((const u32x4*)(SG + off + bj * HALF));
                    v[0][0] += __uint_as_float(ps.x << 16); v[0][1] += __uint_as_float(ps.x & 0xffff0000u); v[0][2] += __uint_as_float(ps.y << 16); v[0][3] += __uint_as_float(ps.y & 0xffff0000u);
                    v[1][0] += __uint_as_float(ps.z << 16); v[1][1] += __uint_as_float(ps.z & 0xffff0000u); v[1][2] += __uint_as_float(ps.w << 16); v[1][3] += __uint_as_float(ps.w & 0xffff0000u); }
                else
#endif
                if (PLE_ && !TB && !SEEDED) { const u32x4 pp = PF ? cpp[bj] : ld_stream((const u32x4*)(PP + off + bj * HALF)), sg = PF ? csg[bj] : ld_stream((const u32x4*)(SG + off + bj * HALF));
                    v[0][0] += __uint_as_float(pp.x << 16) * __uint_as_float(sg.x << 16); v[0][1] += __uint_as_float(pp.x & 0xffff0000u) * __uint_as_float(sg.x & 0xffff0000u);
                    v[0][2] += __uint_as_float(pp.y << 16) * __uint_as_float(sg.y << 16); v[0][3] += __uint_as_float(pp.y & 0xffff0000u) * __uint_as_float(sg.y & 0xffff0000u);
                    v[1][0] += __uint_as_float(pp.z << 16) * __uint_as_float(sg.z << 16); v[1][1] += __uint_as_float(pp.z & 0xffff0000u) * __uint_as_float(sg.z & 0xffff0000u);
                    v[1][2] += __uint_as_float(pp.w << 16) * __uint_as_float(sg.w << 16); v[1][3] += __uint_as_float(pp.w & 0xffff0000u) * __uint_as_float(sg.w & 0xffff0000u); }
#if LAST_H
                const u32x4 pk = pack8(v[0], v[1]);
                if (!Y) st_out((u32x4*)(YB + off + bj * HALF), (u32x4)(pk));
#else
                if (Y) { st_out((f32x4*)(Y + off + bj * HALF), (f32x4)(v[0])); st_out((f32x4*)(Y + off + bj * HALF + 4), (f32x4)(v[1])); }
                const u32x4 pk = pack8(v[0], v[1]);
                st_out((u32x4*)(YB + off + bj * HALF), (u32x4)(pk));
#endif
                { const f32x8 vf = (f32x8){v[0][0], v[0][1], v[0][2], v[0][3], v[1][0], v[1][1], v[1][2], v[1][3]};
                  st_stream((u32x4*)(EPIRES3_YHW + off + bj * HALF), __builtin_bit_cast(u32x4, __builtin_convertvector(vf, h16x8))); }
                const f32x4 r0 = (f32x4){__uint_as_float(pk.x << 16), __uint_as_float(pk.x & 0xffff0000u), __uint_as_float(pk.y << 16), __uint_as_float(pk.y & 0xffff0000u)};
                const f32x4 r1 = (f32x4){__uint_as_float(pk.z << 16), __uint_as_float(pk.z & 0xffff0000u), __uint_as_float(pk.w << 16), __uint_as_float(pk.w & 0xffff0000u)};
                s1 += ((r0[0] + r0[1]) + (r0[2] + r0[3])) + ((r1[0] + r1[1]) + (r1[2] + r1[3]));
                s2 += ((r0[0] * r0[0] + r0[1] * r0[1]) + (r0[2] * r0[2] + r0[3] * r0[3])) + ((r1[0] * r1[0] + r1[1] * r1[1]) + (r1[2] * r1[2] + r1[3] * r1[3])); }
            s1 += __builtin_bit_cast(float, __builtin_amdgcn_ds_bpermute((lane ^ 16) << 2, __builtin_bit_cast(int, s1))); s2 += __builtin_bit_cast(float, __builtin_amdgcn_ds_bpermute((lane ^ 16) << 2, __builtin_bit_cast(int, s2)));
            s1 += __builtin_bit_cast(float, __builtin_amdgcn_ds_bpermute((lane ^ 32) << 2, __builtin_bit_cast(int, s1))); s2 += __builtin_bit_cast(float, __builtin_amdgcn_ds_bpermute((lane ^ 32) << 2, __builtin_bit_cast(int, s2)));
            #if PST_T
            if (fq == 0) *(f32x2*)(pstat + ((unsigned)(u.pn * 4 + wc) * 16384u + (unsigned)row) * 2u) = (f32x2){s1, s2}; }
#else
            if (fq == 0) *(f32x2*)(pstat + ((unsigned)row * 32u + (unsigned)(u.pn * 4 + wc)) * 2u) = (f32x2){s1, s2}; }
#endif
    }
};
#if SEED_PLE
template <> struct SeedK<EpiRes3<true, true, false>> { static constexpr bool value = true; };
#endif
struct EpiPle {
    static constexpr bool PERM = false, AFTER_DRAIN = false;
    const bf16_t* SG; float* Y;
    __device__ __forceinline__ void operator()(const f32x4 (&acc)[2][2][4][2], const Unit& u, int wr, int wc, int fr, int fq) const {
        const int row0 = u.pm * BM + wr * 64 + fr, col0 = u.pn * BM + wc * 32 + 4 * fq;
#pragma unroll
        for (int ai = 0; ai < 2; ++ai)
#pragma unroll
            for (int m = 0; m < 4; ++m) { const size_t off = (size_t)(row0 + ai * HALF + m * 16) * 2048 + col0;
#pragma unroll
                for (int bj = 0; bj < 2; ++bj)
#pragma unroll
                    for (int n = 0; n < 2; ++n) { const size_t o = off + bj * HALF + n * 16; const u32x2 sg = *(const u32x2*)(SG + o);
                        f32x4 g; g[0] = __uint_as_float(sg.x << 16); g[1] = __uint_as_float(sg.x & 0xffff0000u); g[2] = __uint_as_float(sg.y << 16); g[3] = __uint_as_float(sg.y & 0xffff0000u);
                        st_out((f32x4*)(Y + o), (f32x4)(acc[ai][bj][m][n] * g)); } }
    }
};
template <class Epi, class Sched, bool ALIGN_EPI = false, bool SP2 = false>
__device__ __forceinline__ void gemm_phase(PG8_LAS unsigned char* lds, const Gemm g, const Sched& S, const Epi& E, const int wid_in) {
    int lane_; asm volatile("v_mbcnt_lo_u32_b32 %0, -1, 0\n\tv_mbcnt_hi_u32_b32 %0, -1, %0" : "=v"(lane_)); const int wid = wid_in, lane = lane_, tid = wid * 64 + lane, wr = wid >> 2, wc = wid & 3, fr = lane & 15, fq = lane >> 4;
    const int K = g.K, nt = K / BK, lda = g.tiledA ? BK : (g.lda ? g.lda : K), ldb = g.tiledB ? BK : (g.ldb ? g.ldb : K);
    unsigned voffA[2], voffB[2];
#pragma unroll
    for (int i = 0; i < 2; ++i) { int R, C; stage_rc(tid * 16 + i * 8192, R, C); const int Rb = Epi::PERM ? ((R & ~31) + perm32(R & 31)) : R;
        const int Ra = PermA<Epi>::value ? ((R & 64) | ((R & 15) << 2) | ((R >> 4) & 3)) : R;
        voffA[i] = (unsigned)(Ra * lda + C) * 2u; voffB[i] = (unsigned)(Rb * ldb + C) * 2u; }
    const size_t kstepA = g.tiledA ? (size_t)BM * BK * 2 : (size_t)(BK * 2), kstepB = g.tiledB ? (size_t)BM * BK * 2 : (size_t)(BK * 2);
    const size_t hstepA = (size_t)HALF * lda * 2, hstepB = (size_t)HALF * ldb * 2;
    const size_t tstepA = g.tiledA ? (size_t)BM * K * 2 : 2 * hstepA, tstepB = g.tiledB ? (size_t)BM * K * 2 : 2 * hstepB;
    const unsigned ldsw = (unsigned)wid * 1024u;
    const int aoff = lds_byte(wr * 64 + fr, fq * 8), boff = lds_byte(wc * 32 + fr, fq * 8);
#define PG8_SA(b, h) (((b) * 2 + (h)) * HTB)
#define PG8_SB(b, h) ((4 + (b) * 2 + (h)) * HTB)
#define PG8_STAGE(bufoff, gbase, voff) do { _Pragma("unroll") for (int _i = 0; _i < 2; ++_i) \
        __builtin_amdgcn_global_load_lds((const unsigned*)((const char*)(gbase) + (voff)[_i]), (PG8_LAS unsigned*)(lds + (bufoff) + ldsw + _i * 8192), 16, 0, 0); } while (0)
#define PG8_LDA(dst, b, h) do { _Pragma("unroll") for (int m = 0; m < 4; ++m) _Pragma("unroll") for (int k = 0; k < 2; ++k) dst[m][k] = *(const PG8_LAS bf16x8*)(lds + PG8_SA(b, h) + aoff + m * 2048 + k * 1024); } while (0)
#define PG8_LDB(dst, b, h) do { _Pragma("unroll") for (int n = 0; n < 2; ++n) _Pragma("unroll") for (int k = 0; k < 2; ++k) dst[n][k] = *(const PG8_LAS bf16x8*)(lds + PG8_SB(b, h) + boff + n * 2048 + k * 1024); } while (0)
#define PG8_MMA(ai, bj, At, Bt) do { __builtin_amdgcn_s_setprio(1); _Pragma("unroll") for (int m = 0; m < 4; ++m) _Pragma("unroll") for (int n = 0; n < 2; ++n) _Pragma("unroll") for (int k = 0; k < 2; ++k) \
        acc[ai][bj][m][n] = __builtin_amdgcn_mfma_f32_16x16x32_bf16(Bt[n][k], At[m][k], acc[ai][bj][m][n], 0, 0, 0); __builtin_amdgcn_s_setprio(0); } while (0)
#define PG8_WAIT_V(n) asm volatile("s_waitcnt vmcnt(" #n ")" ::: "memory")
#define PG8_WAIT_L(n) asm volatile("s_waitcnt lgkmcnt(" #n ")" ::: "memory")
#define PG8_BAR __builtin_amdgcn_s_barrier()
#define PG8_SCHED __builtin_amdgcn_sched_barrier(0)
    Unit cur, nxt; int ui = 0;
    if (!S.next(0, cur)) return;
    f32x4 acc[2][2][4][2];
#pragma unroll
    for (int a = 0; a < 2; ++a)
#pragma unroll
        for (int b = 0; b < 2; ++b)
#pragma unroll
            for (int m = 0; m < 4; ++m)
#pragma unroll
                for (int n = 0; n < 2; ++n) acc[a][b][m][n] = (f32x4){0.f, 0.f, 0.f, 0.f};
    bf16x8 At[4][2], B0[2][2], B1[2][2];
    const char* cA = (const char*)g.A + (size_t)cur.pm * tstepA; const char* cB = (const char*)g.Bt + (size_t)cur.pn * tstepB;
    S.a_ready(cur);
    if constexpr (PreK<Epi>::value) E.pre_phase(cur, wr, wc, lane);
    if constexpr (SP2) {
        PG8_STAGE(PG8_SB(0, 0), cB, voffB); PG8_STAGE(PG8_SB(0, 1), cB + hstepB, voffB); PG8_STAGE(PG8_SA(0, 0), cA, voffA); PG8_STAGE(PG8_SA(0, 1), cA + hstepA, voffA);
        if (wr == 1) PG8_BAR;
        PG8_WAIT_V(2); PG8_BAR;
        PG8_STAGE(PG8_SB(1, 0), cB + kstepB, voffB); PG8_STAGE(PG8_SA(1, 0), cA + kstepA, voffA); PG8_STAGE(PG8_SB(1, 1), cB + hstepB + kstepB, voffB);
        PG8_WAIT_V(6); PG8_BAR;
    } else {
        PG8_STAGE(PG8_SB(0, 0), cB, voffB); PG8_STAGE(PG8_SA(0, 0), cA, voffA); PG8_STAGE(PG8_SB(0, 1), cB + hstepB, voffB); PG8_STAGE(PG8_SA(0, 1), cA + hstepA, voffA);
        if (wr == 1) PG8_BAR;
        PG8_WAIT_V(4); PG8_BAR;
        PG8_STAGE(PG8_SB(1, 0), cB + kstepB, voffB); PG8_STAGE(PG8_SA(1, 0), cA + kstepA, voffA); PG8_STAGE(PG8_SB(1, 1), cB + hstepB + kstepB, voffB);
        PG8_WAIT_V(6); PG8_BAR;
    }
    long sA = (long)kstepA, sB = (long)kstepB;
    for (;;) {
        const bool has_next = S.next(ui + 1, nxt);
        const bool nrev = (KREV != 0) && has_next && ((ui + 1) & 1);
        const long nsA = has_next ? (nrev ? -(long)kstepA : (long)kstepA) : sA, nsB = has_next ? (nrev ? -(long)kstepB : (long)kstepB) : sB;
        const char* nA = has_next ? (const char*)g.A + (size_t)nxt.pm * tstepA + (nrev ? (size_t)(nt - 1) * kstepA : (size_t)0) : cA;
        const char* nB = has_next ? (const char*)g.Bt + (size_t)nxt.pn * tstepB + (nrev ? (size_t)(nt - 1) * kstepB : (size_t)0) : cB;
        for (int t = 0; t < nt; t += 2) {
            const bool last = (t == nt - 2);
            const char* a1 = cA + (long)(t + 1) * sA;
            const char* a2 = last ? nA : cA + (long)(t + 2) * sA; const char* b2 = last ? nB : cB + (long)(t + 2) * sB;
            const char* a3 = a2 + (last ? nsA : sA); const char* b3 = b2 + (last ? nsB : sB);
            if (last && has_next) S.a_ready(nxt);
            u32x4 sd0, sd1;
            if constexpr (SeedK<Epi>::value) { if ((t >> 1) < 16) E.seed_issue(cur, t >> 1, wr, wc, fr, fq, sd0, sd1); }
            if constexpr (SP2) {
            const int relax_ = __builtin_amdgcn_readfirstlane(((RelaxW<Epi>::value != 0) && t == 0 && ui > 0) ? 1 : 0);
            PG8_LDB(B0, 0, 0); PG8_LDB(B1, 0, 1); PG8_SCHED; PG8_LDA(At, 0, 0); PG8_STAGE(PG8_SA(1, 1), a1 + hstepA, voffA);
            if constexpr (RelaxW<Epi>::value != 0) asm volatile("s_cmp_eq_u32 %0, 0\n\ts_cbranch_scc1 .Lrwa%=\n\ts_waitcnt vmcnt(40)\n\ts_branch .Lrwb%=\n.Lrwa%=:\n\ts_waitcnt vmcnt(8)\n.Lrwb%=:" :: "s"(relax_) : "memory", "scc"); else PG8_WAIT_V(8);
            PG8_WAIT_L(0); PG8_BAR; PG8_MMA(0, 0, At, B0); PG8_MMA(0, 1, At, B1); PG8_BAR; PG8_SCHED;
            PG8_LDA(At, 0, 1); PG8_STAGE(PG8_SB(0, 0), b2, voffB); PG8_STAGE(PG8_SB(0, 1), b2 + hstepB, voffB); PG8_STAGE(PG8_SA(0, 0), a2, voffA);
            if constexpr (RelaxW<Epi>::value != 0) asm volatile("s_cmp_eq_u32 %0, 0\n\ts_cbranch_scc1 .Lrwa%=\n\ts_waitcnt vmcnt(40)\n\ts_branch .Lrwb%=\n.Lrwa%=:\n\ts_waitcnt vmcnt(8)\n.Lrwb%=:" :: "s"(relax_) : "memory", "scc"); else PG8_WAIT_V(8);
            PG8_WAIT_L(0); PG8_BAR; PG8_MMA(1, 0, At, B0); PG8_MMA(1, 1, At, B1); PG8_BAR; PG8_SCHED;
            PG8_LDB(B0, 1, 0); PG8_LDB(B1, 1, 1); PG8_SCHED; PG8_LDA(At, 1, 0); PG8_STAGE(PG8_SA(0, 1), a2 + hstepA, voffA);
            PG8_WAIT_V(8); PG8_WAIT_L(0); PG8_BAR; PG8_MMA(0, 0, At, B0); PG8_MMA(0, 1, At, B1); PG8_BAR; PG8_SCHED;
            PG8_LDA(At, 1, 1); PG8_STAGE(PG8_SB(1, 0), b3, voffB); PG8_STAGE(PG8_SB(1, 1), b3 + hstepB, voffB); PG8_STAGE(PG8_SA(1, 0), a3, voffA);
            PG8_WAIT_V(8); PG8_WAIT_L(0); PG8_BAR; PG8_MMA(1, 0, At, B0); PG8_MMA(1, 1, At, B1); PG8_BAR; PG8_SCHED;
            } else {
            PG8_LDB(B0, 0, 0); PG8_SCHED; PG8_LDA(At, 0, 0); PG8_STAGE(PG8_SA(1, 1), a1 + hstepA, voffA);
            PG8_WAIT_L(8); PG8_BAR; PG8_WAIT_L(0); PG8_MMA(0, 0, At, B0); PG8_BAR; PG8_SCHED;
            PG8_LDB(B1, 0, 1); PG8_STAGE(PG8_SB(0, 0), b2, voffB);
            PG8_BAR; PG8_WAIT_L(0); PG8_MMA(0, 1, At, B1); PG8_BAR;
            PG8_LDA(At, 0, 1); PG8_STAGE(PG8_SA(0, 0), a2, voffA);
            PG8_BAR; PG8_WAIT_L(0); PG8_MMA(1, 0, At, B0); PG8_BAR; PG8_SCHED;
            PG8_STAGE(PG8_SB(0, 1), b2 + hstepB, voffB);
            PG8_WAIT_V(6); PG8_BAR; PG8_MMA(1, 1, At, B1); PG8_BAR;
            PG8_LDB(B0, 1, 0); PG8_SCHED; PG8_LDA(At, 1, 0); PG8_STAGE(PG8_SA(0, 1), a2 + hstepA, voffA);
            PG8_WAIT_L(8); PG8_BAR; PG8_WAIT_L(0); PG8_MMA(0, 0, At, B0); PG8_BAR; PG8_SCHED;
            PG8_LDB(B1, 1, 1); PG8_STAGE(PG8_SB(1, 0), b3, voffB);
            PG8_BAR; PG8_WAIT_L(0); PG8_MMA(0, 1, At, B1); PG8_BAR;
            PG8_LDA(At, 1, 1); PG8_STAGE(PG8_SA(1, 0), a3, voffA);
            PG8_BAR; PG8_WAIT_L(0); PG8_MMA(1, 0, At, B0); PG8_BAR; PG8_SCHED;
            PG8_STAGE(PG8_SB(1, 1), b3 + hstepB, voffB);
            PG8_WAIT_V(6); PG8_BAR; PG8_MMA(1, 1, At, B1); PG8_BAR;
            }
            if constexpr (SeedK<Epi>::value) { if ((t >> 1) < 16) { E.seed_wait(sd0, sd1); E.seed_add(acc, t >> 1, sd0, sd1); } }
        }
        if constexpr (ALIGN_EPI) { if (wr == 0) PG8_BAR; }
        if constexpr (!Epi::AFTER_DRAIN) { E(acc, cur, wr, wc, fr, fq); S.done(cur); if constexpr (PreK<Epi>::value) { if (has_next) E.pre_next(nxt, wr, wc, lane); } }
        if (!has_next) break;
#pragma unroll
        for (int a = 0; a < 2; ++a)
#pragma unroll
            for (int b = 0; b < 2; ++b)
#pragma unroll
                for (int m = 0; m < 4; ++m)
#pragma unroll
                    for (int n = 0; n < 2; ++n) acc[a][b][m][n] = (f32x4){0.f, 0.f, 0.f, 0.f};
        cur = nxt; cA = nA; cB = nB; sA = nsA; sB = nsB; ++ui;
        if constexpr (ALIGN_EPI) { if (wr == 1) PG8_BAR; }
    }
    PG8_WAIT_V(0);
    if constexpr (!ALIGN_EPI) { if (wr == 0) PG8_BAR; }
    PG8_BAR;
    if constexpr (Epi::AFTER_DRAIN) { E.fused(acc, cur, wr, wc, fr, fq, lds, wid, lane); S.done(cur); }
#undef PG8_SA
#undef PG8_SB
#undef PG8_STAGE
#undef PG8_LDA
#undef PG8_LDB
#undef PG8_MMA
#undef PG8_WAIT_V
#undef PG8_WAIT_L
#undef PG8_BAR
#undef PG8_SCHED
}
}
#define LAS __attribute__((address_space(3)))
#define XB_TMO      128
#define XB_XCNT(j)  (256  + 64 * (j))
#define XB_XSUB(j)  (1280 + 64 * (j))
#define XB_XGEN(j)  (2304 + 64 * (j))
#define XB_TOP      3328
#define XB_TOPGEN   3392
#define XCD_BAR_WORDS 3456
#define XB_SPIN_CAP (1u << 18)

__device__ __forceinline__ unsigned xb_ld(unsigned* p)              { return __hip_atomic_load(p, __ATOMIC_RELAXED, __HIP_MEMORY_SCOPE_AGENT); }
__device__ __forceinline__ unsigned xb_add(unsigned* p, unsigned v) { return __hip_atomic_fetch_add(p, v, __ATOMIC_RELAXED, __HIP_MEMORY_SCOPE_AGENT); }
__device__ __forceinline__ unsigned xb_xcc_id() { return (unsigned)__builtin_amdgcn_s_getreg((3 << 11) | 20) & 0xFu; }
#define XB_SPIN(cond, bar) do { unsigned _sp = 0; while (cond) { __builtin_amdgcn_s_sleep(1); \
    if ((++_sp & 255u) == 0u) { if (xb_ld(&(bar)[XB_TMO])) break; if (_sp > XB_SPIN_CAP) { atomicAdd(&(bar)[XB_TMO], 1u); break; } } } } while (0)

struct XcdBarrier {
    unsigned* bar; unsigned x;
    volatile LAS unsigned* st;
};

__device__ __forceinline__ XcdBarrier xcd_barrier_post(unsigned* bar, volatile LAS unsigned* st) {
    XcdBarrier b; b.bar = bar; b.x = xb_xcc_id(); b.st = st;
    if (threadIdx.x == 0) (void)xb_add(&bar[XB_XCNT(b.x)], 1u);
    return b;
}
__device__ __forceinline__ void xcd_barrier_complete(unsigned* bar, unsigned x, unsigned& nloc, unsigned& nx) {
    const unsigned G = gridDim.x * gridDim.y * gridDim.z;
    unsigned sum, cnt, mine, sp = 0u;
    for (;;) {
        sum = 0u; cnt = 0u; mine = 0u;
#pragma unroll
        for (unsigned j = 0; j < 16; ++j) { const unsigned c = xb_ld(&bar[XB_XCNT(j)]); sum += c; cnt += (c > 0u) ? 1u : 0u; mine = (j == x) ? c : mine; }
        if (sum == G) break;
        __builtin_amdgcn_s_sleep(1);
        if ((++sp & 255u) == 0u) { if (xb_ld(&bar[XB_TMO])) break; if (sp > XB_SPIN_CAP) { atomicAdd(&bar[XB_TMO], 1u); break; } }
    }
    nloc = mine > 0u ? mine : 1u; nx = cnt > 0u ? cnt : 1u;
}

__device__ __forceinline__ void xcd_barrier(const XcdBarrier& b) {
    asm volatile("s_waitcnt vmcnt(0)" ::: "memory");
    __syncthreads();
    if (threadIdx.x == 0) {
        unsigned* bar = b.bar;
        __builtin_amdgcn_s_waitcnt(0);
        unsigned nloc = b.st[0], nx = b.st[1];
        if (nloc == 0u) { xcd_barrier_complete(bar, b.x, nloc, nx); b.st[0] = nloc; b.st[1] = nx; }
        const unsigned old = xb_add(&bar[XB_XSUB(b.x)], 1u);
        const unsigned gen = old / nloc;
        if (old + 1u == (gen + 1u) * nloc) {
            __builtin_amdgcn_fence(__ATOMIC_RELEASE, "agent");
            asm volatile("s_waitcnt vmcnt(0)" ::: "memory");
            const unsigned og = xb_add(&bar[XB_TOP], 1u);
            const unsigned tg = og / nx;
            if (og + 1u == (tg + 1u) * nx) xb_add(&bar[XB_TOPGEN], 1u);
            else XB_SPIN(xb_ld(&bar[XB_TOPGEN]) == tg, bar);
            __builtin_amdgcn_fence(__ATOMIC_ACQUIRE, "agent");
            xb_add(&bar[XB_XGEN(b.x)], 1u);
            asm volatile("s_waitcnt vmcnt(0)" ::: "memory");
        } else {
            XB_SPIN(xb_ld(&bar[XB_XGEN(b.x)]) == gen, bar);
            __builtin_amdgcn_fence(__ATOMIC_ACQUIRE, "agent");
            asm volatile("s_waitcnt vmcnt(0)" ::: "memory");
        }
    }
    __syncthreads();
}

__device__ __forceinline__ void xcd_barrier_local(const XcdBarrier& b) {
    asm volatile("s_waitcnt vmcnt(0)" ::: "memory");
    __syncthreads();
    if (threadIdx.x == 0) {
        unsigned* bar = b.bar;
        __builtin_amdgcn_s_waitcnt(0);
        unsigned nloc = b.st[0], nx = b.st[1];
        if (nloc == 0u) { xcd_barrier_complete(bar, b.x, nloc, nx); b.st[0] = nloc; b.st[1] = nx; }
        const unsigned old = xb_add(&bar[XB_XSUB(b.x)], 1u);
        const unsigned gen = old / nloc;
        if (old + 1u == (gen + 1u) * nloc) xb_add(&bar[XB_XGEN(b.x)], 1u);
        else XB_SPIN(xb_ld(&bar[XB_XGEN(b.x)]) == gen, bar);
        __builtin_amdgcn_fence(__ATOMIC_ACQUIRE, "agent");
        asm volatile("s_waitcnt vmcnt(0)" ::: "memory");
    }
    __syncthreads();
}
#define GAS __attribute__((address_space(1)))

typedef unsigned short bf16;
typedef float f32x4 __attribute__((ext_vector_type(4)));
typedef unsigned v4u __attribute__((ext_vector_type(4)));
typedef unsigned v2u __attribute__((ext_vector_type(2)));
#define LDS_WAIT() asm volatile("s_waitcnt lgkmcnt(0)" ::: "memory")

#ifndef MK_ONE_LAUNCH
#define MK_ONE_LAUNCH 0
#endif
#ifndef RET_MFMA
#define RET_MFMA 1
#endif
#ifndef SWA_MFMA
#define SWA_MFMA 1
#endif
#ifndef PROBE_DUP
#define PROBE_DUP 0
#endif
#if PROBE_DUP == 42 || PROBE_DUP == 43
#define YHW_ARG (_Float16*)(w + WS_YH),
#else
#define YHW_ARG
#endif
#ifndef PRO_NKB
#define PRO_NKB 4
#endif
#ifndef W_LATE
#define W_LATE 0
#endif
#ifndef UP_ROT
#define UP_ROT 0
#endif
#ifndef UP_SYNC
#define UP_SYNC 0
#endif
#if UP_ROT
#define UPORDER pg8::RotOrder
#elif UP_SYNC
#define UPORDER pg8::SyncOrder
#else
#define UPORDER pg8::StaticOrder
#endif
#ifndef P8_LOCAL
#define P8_LOCAL 0
#endif
#ifndef XLOC
#define XLOC 1
#endif
#ifndef MERGE_R1
#define MERGE_R1 1
#endif
#ifndef FIX_RED
#define FIX_RED 0
#endif
#ifndef PRO_GFAST
#define PRO_GFAST 1
#endif
#ifndef LN_LOCAL
#define LN_LOCAL 0
#endif
#ifndef PLE_ALIGN
#define PLE_ALIGN false
#endif
#ifndef SWA_KWIN
#define SWA_KWIN 1
#endif
#ifndef FUSE_SCAN
#define FUSE_SCAN 1
#endif
#ifndef SWA_OT
#define SWA_OT 1
#endif
#ifndef CODE_PAD
#define CODE_PAD 0
#endif
#ifndef PLE_BAL
#define PLE_BAL 0
#endif
#ifndef SWA_IN_P3
#define SWA_IN_P3 0
#endif
#ifndef UP_ALIGN
#define UP_ALIGN true
#endif
#ifndef UP_SP2
#define UP_SP2 true
#endif
#ifndef PANEL_SEAMS
#define PANEL_SEAMS 0
#endif
#ifndef PROBE_TICKS
#define PROBE_TICKS 2000
#endif
#ifndef PROBE_BLOCK
#define PROBE_BLOCK 0
#endif
#ifndef PROBE_MASK
#define PROBE_MASK 0xffff
#endif
#ifndef CONV_FUSED
#define CONV_FUSED 1
#endif
#ifndef PLE_EARLY
#define PLE_EARLY 1
#endif
#ifndef LN_NOXR
#define LN_NOXR 1
#endif
#ifndef LN_FUSED
#define LN_FUSED 1
#endif
#ifndef RES_BF16
#define RES_BF16 1
#endif
#define REPS(k) int nrep_ = (PROBE_DUP == (k)) ? 2 : 1; asm volatile("" : "+s"(nrep_)); for (int rep_ = 0; rep_ < nrep_; ++rep_)

constexpr int INW_ = 5376, NUPG_ = 13312;
constexpr int S = 16384, D = 2048, INW = 5376, DFF = 5632, NUP = 2 * DFF, NUPG = NUP + D, PLE = 256, DEPTH = 4;
constexpr float ALPHA = 1.6817928305074290f, LN_EPS = 1e-5f, GN_EPS = 1e-6f;
constexpr int NPH = 11, NPHASES = 1 + DEPTH * NPH;

constexpr size_t MiB = 1u << 20;
constexpr size_t WS_CTL = 0, CTL_ZERO_BYTES = 1 * MiB;
constexpr size_t WS_C = 65536; constexpr int C_L = 2 * INW_ + 2 * NUPG_, C1IN = 0, C2IN = INW_, C1UP = 2 * INW_, C2UP = 2 * INW_ + NUPG_;
constexpr size_t WS_YH = 1304 * MiB;
constexpr size_t WS_CP = 540 * MiB;
constexpr size_t WS_PSTAT = 532 * MiB;
constexpr size_t WS_COSR = 2 * MiB, WS_SINR = 10 * MiB, WS_COSA = 18 * MiB, WS_SINA = 20 * MiB;
constexpr size_t WS_W = 32 * MiB, WL_BYTES = 106 * MiB;
constexpr size_t WL_IN = 0, WL_OUT = 21 * MiB, WL_UP = 29 * MiB, WL_G = 73 * MiB, WL_DOWN = 81 * MiB, WL_P = 104 * MiB;
constexpr size_t WS_XR = 530 * MiB, WS_XB = 576 * MiB, WS_Y = 640 * MiB;
constexpr size_t WS_Q = 768 * MiB, WS_K = 800 * MiB, WS_V = 832 * MiB, WS_G = 864 * MiB, WS_AQ = 896 * MiB, WS_AK = 928 * MiB, WS_AV = 932 * MiB;
constexpr size_t WS_MIX = 936 * MiB, WS_U = 1000 * MiB, WS_PS = 1128 * MiB, WS_RETY = 1160 * MiB;
#if XLOC
constexpr size_t WS_H = 704 * MiB;
constexpr size_t WS_PP2 = 640 * MiB;
#else
constexpr size_t WS_H = 768 * MiB, WS_PP2 = 1064 * MiB;
#endif
constexpr size_t WS_ACT = 1128 * MiB, WS_SG = 460 * MiB, WS_PB = 1368 * MiB, WS_END = 1400 * MiB;
constexpr size_t WS_PP = 1064 * MiB;
constexpr size_t WS_ST1 = 24 * MiB, WS_ST2 = 25 * MiB;
constexpr int CW_BAR = 4096, CW_PANEL = 204800, CW_XT = 212992, CW_KV = 216064, CW_US = 217088, CW_HB = 218112;
static_assert((CW_BAR + 3456) * 4 <= 32768 && WS_C + (size_t)4 * C_L * 4 <= CTL_ZERO_BYTES, "barrier words and column sums inside the per-call memset");

constexpr int RING_BYTES = 131072, LDS_BYTES = 147456, LDSCTL_OFF = LDS_BYTES - 1024, MISC_OFF = LDSCTL_OFF + 320;

__device__ __forceinline__ unsigned f2bf(float f) { unsigned u = __builtin_bit_cast(unsigned, f); return (u + 0x7fffu + ((u >> 16) & 1u)) >> 16; }
__device__ __forceinline__ unsigned pk2(float lo, float hi) { return f2bf(lo) | (f2bf(hi) << 16); }
__device__ __forceinline__ float bflo(unsigned w) { return __uint_as_float(w << 16); }
__device__ __forceinline__ float bfhi(unsigned w) { return __uint_as_float(w & 0xffff0000u); }
__device__ __forceinline__ float bf1(const bf16* p) { return __uint_as_float(((unsigned)*p) << 16); }

struct Params {
    const float* in[19]; float* out; unsigned char* ws; int ph_lo, ph_hi;
    float invf_ret[128]; float invf_att[32]; float lg2g[4];
};

struct Ctx { int tid, lane, wave, G, bid; unsigned char* ws; };

__device__ __forceinline__ int lane_id_asm() { int l; asm volatile("v_mbcnt_lo_u32_b32 %0, -1, 0\n\tv_mbcnt_hi_u32_b32 %0, -1, %0" : "=v"(l)); return l; }
__device__ __forceinline__ float wave_sum(float v, int lane) {
#pragma unroll
    for (int o = 1; o < 64; o <<= 1) v += __builtin_bit_cast(float, __builtin_amdgcn_ds_bpermute((lane ^ o) << 2, __builtin_bit_cast(int, v)));
    return v;
}
__device__ __forceinline__ void transpose_item(const float* W, int K, int N, int src_col0, bf16* WT, int dst_row0, int k0, LAS float* scr, int lane) {
#pragma unroll 8
    for (int i = 0; i < 32; ++i) { const int kk = 2 * i + (lane >> 5); scr[kk * 33 + (lane & 31)] = W[(size_t)(k0 + kk) * N + src_col0 + (lane & 31)]; }
    LDS_WAIT(); asm volatile("" ::: "memory");
    const int c = lane & 7;
#pragma unroll
    for (int j = 0; j < 4; ++j) { const int n = (lane >> 3) + 8 * j; const LAS float* s = scr + (8 * c) * 33 + n;
        v4u o; o.x = pk2(s[0 * 33], s[1 * 33]); o.y = pk2(s[2 * 33], s[3 * 33]); o.z = pk2(s[4 * 33], s[5 * 33]); o.w = pk2(s[6 * 33], s[7 * 33]);
        *(v4u*)(WT + (size_t)(dst_row0 + n) * K + k0 + 8 * c) = o; }
    LDS_WAIT(); asm volatile("" ::: "memory");
}
__device__ __forceinline__ void transpose_item64(const float* W, int K, int N, int srcA, int srcB, bf16* WT, int dst_row0, int k0, LAS float* scr, int lane, int tiled = 0) {
    const int c4 = lane & 15, gsel = c4 >> 3, col = 4 * (c4 & 7), src = (gsel ? srcB : srcA) + col, kq = lane >> 4;
    f32x4 v[16];
#pragma unroll
    for (int i = 0; i < 16; ++i) v[i] = *(const f32x4*)(W + (size_t)(k0 + 4 * i + kq) * N + src);
#pragma unroll
    for (int i = 0; i < 16; ++i) { LAS float* d = scr + (4 * i + kq) * 65 + 32 * gsel + col; d[0] = v[i][0]; d[1] = v[i][1]; d[2] = v[i][2]; d[3] = v[i][3]; }
    LDS_WAIT(); asm volatile("" ::: "memory");
    const int c = lane & 7;
#pragma unroll
    for (int j = 0; j < 8; ++j) { const int n = (lane >> 3) + 8 * j; const LAS float* s = scr + (8 * c) * 65 + n;
        v4u o; o.x = pk2(s[0 * 65], s[1 * 65]); o.y = pk2(s[2 * 65], s[3 * 65]); o.z = pk2(s[4 * 65], s[5 * 65]); o.w = pk2(s[6 * 65], s[7 * 65]);
        *(v4u*)(WT + (tiled ? pg8::tiled_off(dst_row0 + n, k0 + 8 * c, K) : (size_t)(dst_row0 + n) * K + k0 + 8 * c)) = o; }
    LDS_WAIT(); asm volatile("" ::: "memory");
}
__device__ __forceinline__ void transpose_unit(const float* W, int K, int N, int srcA, int srcB, bf16* WT, int dst_row0, int kb0, int nkb, LAS float* scr, int lane, int tiled,
                                               const float* gv, const float* bv, float* c1, float* c2) {
    const int c4 = lane & 15, gsel = c4 >> 3, col = 4 * (c4 & 7), src = (gsel ? srcB : srcA) + col, kq = lane >> 4, c = lane & 7;
    f32x4 c1p = (f32x4){0.f, 0.f, 0.f, 0.f}, c2p = (f32x4){0.f, 0.f, 0.f, 0.f};
    for (int kb = kb0; kb < kb0 + nkb; ++kb) { const int k0 = 64 * kb;
        f32x4 v[16];
#pragma unroll
        for (int i = 0; i < 16; ++i) v[i] = *(const f32x4*)(W + (size_t)(k0 + 4 * i + kq) * N + src);
        if (gv) {
#pragma unroll
            for (int i = 0; i < 16; ++i) { const float gk = gv[k0 + 4 * i + kq], bk = bv[k0 + 4 * i + kq]; c2p = c2p + v[i] * bk; v[i] = v[i] * gk;
#pragma unroll
                for (int e = 0; e < 4; ++e) c1p[e] += __uint_as_float(f2bf(v[i][e]) << 16); } }
#pragma unroll
        for (int i = 0; i < 16; ++i) { LAS float* d = scr + (4 * i + kq) * 65 + 32 * gsel + col; d[0] = v[i][0]; d[1] = v[i][1]; d[2] = v[i][2]; d[3] = v[i][3]; }
        LDS_WAIT(); asm volatile("" ::: "memory");
#pragma unroll
        for (int j = 0; j < 8; ++j) { const int n = (lane >> 3) + 8 * j; const LAS float* sp = scr + (8 * c) * 65 + n;
            v4u o; o.x = pk2(sp[0 * 65], sp[1 * 65]); o.y = pk2(sp[2 * 65], sp[3 * 65]); o.z = pk2(sp[4 * 65], sp[5 * 65]); o.w = pk2(sp[6 * 65], sp[7 * 65]);
            *(v4u*)(WT + (tiled ? pg8::tiled_off(dst_row0 + n, k0 + 8 * c, K) : (size_t)(dst_row0 + n) * K + k0 + 8 * c)) = o; }
        LDS_WAIT(); asm volatile("" ::: "memory");
    }
    if (gv) {
#pragma unroll
        for (int e = 0; e < 4; ++e) {
            float a = c1p[e], b = c2p[e];
            a += __builtin_bit_cast(float, __builtin_amdgcn_ds_bpermute((lane ^ 16) << 2, __builtin_bit_cast(int, a))); b += __builtin_bit_cast(float, __builtin_amdgcn_ds_bpermute((lane ^ 16) << 2, __builtin_bit_cast(int, b)));
            a += __builtin_bit_cast(float, __builtin_amdgcn_ds_bpermute((lane ^ 32) << 2, __builtin_bit_cast(int, a))); b += __builtin_bit_cast(float, __builtin_amdgcn_ds_bpermute((lane ^ 32) << 2, __builtin_bit_cast(int, b)));
            if (kq == 0) { c1[dst_row0 + 32 * gsel + col + e] = a; c2[dst_row0 + 32 * gsel + col + e] = b; } }
    }
}
__device__ __forceinline__ int win_src_col(int g) {
    const int tile = g >> 3, bj = (g >> 2) & 1, wcg = g & 3;
    if (tile < 16) return 32 * g;
    if (tile < 20) return 4096 + 256 * (tile - 16) + 64 * wcg + 32 * bj;
    return wcg < 2 ? 5120 + 64 * wcg + 32 * bj : 5248 + 32 * (wcg - 2) + 64 * bj;
}
__device__ __forceinline__ int wup_src_col(int g) { const int tile = g >> 3, bj = (g >> 2) & 1, wcg = g & 3; return (bj ? DFF : 0) + 128 * tile + 32 * wcg; }

__device__ __forceinline__ void sincos_d(float angf, float& s, float& c) {
    const double a = (double)angf;
    const double k = __builtin_rint(a * 0.63661977236758134308);
    double r = __builtin_fma(-k, 1.57079632679489661923, a); r = __builtin_fma(-k, 6.123233995736766e-17, r);
    const double r2 = r * r;
    const double sp = r + r * r2 * (-1.0 / 6 + r2 * (1.0 / 120 + r2 * (-1.0 / 5040 + r2 * (1.0 / 362880 + r2 * (-1.0 / 39916800)))));
    const double cp = 1.0 + r2 * (-0.5 + r2 * (1.0 / 24 + r2 * (-1.0 / 720 + r2 * (1.0 / 40320 + r2 * (-1.0 / 3628800 + r2 * (1.0 / 479001600))))));
    const int q = ((int)k) & 3;
    const double sv = (q == 0) ? sp : (q == 1) ? cp : (q == 2) ? -sp : -cp;
    const double cv = (q == 0) ? cp : (q == 1) ? -sp : (q == 2) ? -cp : sp;
    s = (float)sv; c = (float)cv;
}

__device__ __forceinline__ void phase_prologue(const Params& P, const Ctx& cx, LAS unsigned char* lds) {
    unsigned char* ws = cx.ws; const int tid = cx.tid, lane = cx.lane, wave = cx.wave, G = cx.G;
    LAS float* scr = (LAS float*)(lds + wave * 16896);
    const int gw = cx.bid * 8 + wave, NGW = G * 8;
#if LN_FUSED
    constexpr int NKB = PRO_NKB, KCH = 32 / NKB, U_IN = 84 * KCH, U_OUT = 32 * KCH, U_UP = 176 * KCH, U_G = 32 * KCH, U_DN = 32 * (88 / NKB), U_P = 32 * (4 / NKB), U_L = U_IN + U_OUT + U_UP + U_G + U_DN + U_P;
    for (int it = gw; it < DEPTH * U_L; it += NGW) {
        const int l = it / U_L; int r = it - l * U_L;
        bf16* wl = (bf16*)(ws + WS_W + (size_t)l * WL_BYTES); float* cl0 = (float*)(ws + WS_CP) + (size_t)l * C_L;
        const float* g1 = P.in[8] + l * D; const float* b1 = P.in[9] + l * D;
        const float* g2 = l ? P.in[14] + (l - 1) * D : nullptr; const float* b2 = l ? P.in[15] + (l - 1) * D : nullptr;
        const float* W; int K = D, N = D, sa, sb, g, kc, nkb = NKB, tiled = 0; bf16* WT; const float* gv = nullptr; const float* bv = nullptr; float* c1 = nullptr; float* c2 = nullptr;
        if (r < U_IN) { if (PRO_GFAST) { g = r % 84; kc = r / 84; } else { g = r / KCH; kc = r % KCH; } W = P.in[3] + (size_t)l * D * INW; N = INW; sa = win_src_col(2 * g); sb = win_src_col(2 * g + 1); WT = wl + WL_IN / 2; gv = g2; bv = b2; c1 = cl0 + C1IN; c2 = cl0 + C2IN; }
        else if ((r -= U_IN) < U_OUT) { if (W_LATE && l > 0) continue;
            if (PRO_GFAST) { g = r % 32; kc = r / 32; } else { g = r / KCH; kc = r % KCH; } W = P.in[4] + (size_t)l * D * D; sa = 64 * g; sb = sa + 32; WT = wl + WL_OUT / 2; }
        else if ((r -= U_OUT) < U_UP) { if (PRO_GFAST) { g = r % 176; kc = r / 176; } else { g = r / KCH; kc = r % KCH; } W = P.in[10] + (size_t)l * D * NUP; N = NUP; sa = wup_src_col(2 * g); sb = wup_src_col(2 * g + 1); WT = wl + WL_UP / 2; gv = g1; bv = b1; c1 = cl0 + C1UP; c2 = cl0 + C2UP; }
        else if ((r -= U_UP) < U_G) { if (PRO_GFAST) { g = r % 32; kc = r / 32; } else { g = r / KCH; kc = r % KCH; } W = P.in[16] + (size_t)l * D * D; sa = 64 * g; sb = sa + 32; WT = wl + WL_G / 2; gv = g1; bv = b1; c1 = cl0 + C1UP + NUP; c2 = cl0 + C2UP + NUP; }
        else if ((r -= U_G) < U_DN) { if (W_LATE && l > 0) continue;
            if (PRO_GFAST) { g = r % 32; kc = r / 32; } else { g = r / (88 / NKB); kc = r % (88 / NKB); } W = P.in[13] + (size_t)l * DFF * D; K = DFF; sa = 64 * g; sb = sa + 32; WT = wl + WL_DOWN / 2; tiled = 1; }
        else { r -= U_DN; g = r / (4 / NKB); kc = r % (4 / NKB); W = P.in[18] + (size_t)l * PLE * D; K = PLE; sa = 64 * g; sb = sa + 32; WT = wl + WL_P / 2; }
        if (c1) { c1 += (size_t)kc * DEPTH * C_L; c2 += (size_t)kc * DEPTH * C_L; }
        transpose_unit(W, K, N, sa, sb, WT, 64 * g, NKB * kc, nkb, scr, lane, tiled, gv, bv, c1, c2);
    }
#else
    constexpr int I_IN = 32 * 84, I_OUT = 32 * 32, I_UP = 32 * 176, I_G = 32 * 32, I_DN = 88 * 32, I_P = 4 * 32, I_L = I_IN + I_OUT + I_UP + I_G + I_DN + I_P;
    for (int it = gw; it < DEPTH * I_L; it += NGW) {
        const int l = it / I_L; int r = it - l * I_L;
        bf16* wl = (bf16*)(ws + WS_W + (size_t)l * WL_BYTES);
        if (r < I_IN) { const int kb = r / 84, g = r % 84; transpose_item64(P.in[3] + (size_t)l * D * INW, D, INW, win_src_col(2 * g), win_src_col(2 * g + 1), wl + WL_IN / 2, 64 * g, 64 * kb, scr, lane); continue; } r -= I_IN;
        if (r < I_OUT) { const int kb = r / 32, g = r % 32; transpose_item64(P.in[4] + (size_t)l * D * D, D, D, 64 * g, 64 * g + 32, wl + WL_OUT / 2, 64 * g, 64 * kb, scr, lane); continue; } r -= I_OUT;
        if (r < I_UP) { const int kb = r / 176, g = r % 176; transpose_item64(P.in[10] + (size_t)l * D * NUP, D, NUP, wup_src_col(2 * g), wup_src_col(2 * g + 1), wl + WL_UP / 2, 64 * g, 64 * kb, scr, lane); continue; } r -= I_UP;
        if (r < I_G) { const int kb = r / 32, g = r % 32; transpose_item64(P.in[16] + (size_t)l * D * D, D, D, 64 * g, 64 * g + 32, wl + WL_G / 2, 64 * g, 64 * kb, scr, lane); continue; } r -= I_G;
        if (r < I_DN) { const int kb = r / 32, g = r % 32; transpose_item64(P.in[13] + (size_t)l * DFF * D, DFF, D, 64 * g, 64 * g + 32, wl + WL_DOWN / 2, 64 * g, 64 * kb, scr, lane, 1); continue; } r -= I_DN;
        { const int kb = r / 32, g = r % 32; transpose_item64(P.in[18] + (size_t)l * PLE * D, PLE, D, 64 * g, 64 * g + 32, wl + WL_P / 2, 64 * g, 64 * kb, scr, lane); }
    }
#endif
    const size_t gt = (size_t)cx.bid * 512 + tid, NT = (size_t)G * 512;
    { const float* x = P.in[0]; bf16* xb = (bf16*)(ws + WS_XB);
      for (size_t i = gt; i < (size_t)S * D / 8; i += NT) { const f32x4 a = *(const f32x4*)(x + i * 8), b = *(const f32x4*)(x + i * 8 + 4);
          v4u o; o.x = pk2(a[0], a[1]); o.y = pk2(a[2], a[3]); o.z = pk2(b[0], b[1]); o.w = pk2(b[2], b[3]); *(v4u*)(xb + i * 8) = o; } }
    { const float* p = P.in[1]; bf16* pb = (bf16*)(ws + WS_PB);
      for (size_t i = gt; i < (size_t)DEPTH * S * PLE / 8; i += NT) { const f32x4 a = *(const f32x4*)(p + i * 8), b = *(const f32x4*)(p + i * 8 + 4);
          v4u o; o.x = pk2(a[0], a[1]); o.y = pk2(a[2], a[3]); o.z = pk2(b[0], b[1]); o.w = pk2(b[2], b[3]); *(v4u*)(pb + i * 8) = o; } }
    { const int* pos = (const int*)P.in[2]; float* cosr = (float*)(ws + WS_COSR); float* sinr = (float*)(ws + WS_SINR); float* cosa = (float*)(ws + WS_COSA); float* sina = (float*)(ws + WS_SINA);
      for (size_t i = gt; i < (size_t)S * 128; i += NT) { const int t = (int)(i >> 7), f = (int)(i & 127); float s, c; sincos_d((float)pos[t] * P.invf_ret[f], s, c);
#if TAB_H
          ((_Float16*)cosr)[i] = (_Float16)c; ((_Float16*)sinr)[i] = (_Float16)s; }
#else
          cosr[i] = c; sinr[i] = s; }
#endif
      for (size_t i = gt; i < (size_t)S * 32; i += NT) { const int t = (int)(i >> 5), f = (int)(i & 31); float s, c; sincos_d((float)pos[t] * P.invf_att[f], s, c);
#if TAB_H
          ((_Float16*)cosa)[i] = (_Float16)c; ((_Float16*)sina)[i] = (_Float16)s; } }
#else
          cosa[i] = c; sina[i] = s; } }
#endif
}

template <int MT, int NT_, int KK, bool A_KFAST, bool B_NFAST, class FA, class FB, class FC>
__device__ __forceinline__ void simple_gemm(LAS unsigned char* lds, int nbatch, int tid, int G, int bid, const FA& fa, const FB& fb, const FC& fc) {
    LAS float* As = (LAS float*)lds;
    LAS float* Bs = (LAS float*)(lds + 16 * 132 * 4);
    constexpr int TM = MT / 128, TN = NT_ / 64, ITEMS_PER_B = TM * TN;
    const int tm = tid & 31, tn = tid >> 5;
    for (int item = bid; item < nbatch * ITEMS_PER_B; item += G) {
        const int b = item / ITEMS_PER_B, r = item % ITEMS_PER_B, m0 = (r / TN) * 128, n0 = (r % TN) * 64;
        float c[4][4];
#pragma unroll
        for (int i = 0; i < 4; ++i)
#pragma unroll
            for (int j = 0; j < 4; ++j) c[i][j] = 0.f;
        for (int k0 = 0; k0 < KK; k0 += 16) {
#pragma unroll
            for (int rr = 0; rr < 4; ++rr) { const int e = tid + 512 * rr; int m, k; if (A_KFAST) { k = e & 15; m = e >> 4; } else { m = e & 127; k = e >> 7; }
                As[k * 132 + m] = fa(b, m0 + m, k0 + k); }
#pragma unroll
            for (int rr = 0; rr < 2; ++rr) { const int e = tid + 512 * rr; int n, k; if (B_NFAST) { n = e & 63; k = e >> 6; } else { k = e & 15; n = e >> 4; }
                Bs[k * 68 + n] = fb(b, k0 + k, n0 + n); }
            __syncthreads();
#pragma unroll
            for (int kk = 0; kk < 16; ++kk) { const f32x4 a = *(const LAS f32x4*)(As + kk * 132 + 4 * tm), bb = *(const LAS f32x4*)(Bs + kk * 68 + 4 * tn);
#pragma unroll
                for (int i = 0; i < 4; ++i)
#pragma unroll
                    for (int j = 0; j < 4; ++j) c[i][j] += a[i] * bb[j]; }
            __syncthreads();
        }
#pragma unroll
        for (int i = 0; i < 4; ++i)
#pragma unroll
            for (int j = 0; j < 4; ++j) fc(b, m0 + 4 * tm + i, n0 + 4 * tn + j, c[i][j]);
    }
}

__device__ __forceinline__ void phase_swa(const Params& P, const Ctx& cx, int l, LAS unsigned char* lds) {
    unsigned char* ws = cx.ws; const int tid = cx.tid, G = cx.G;
    const bf16* AQ = (const bf16*)(ws + WS_AQ); const bf16* AK = (const bf16*)(ws + WS_AK); const bf16* AV = (const bf16*)(ws + WS_AV); bf16* MIX = (bf16*)(ws + WS_MIX);
    const float* sinks = P.in[7] + l * 16;
    LAS unsigned* Ks = (LAS unsigned*)lds;
    LAS unsigned* Vs = (LAS unsigned*)(lds + 256 * 33 * 4);
    for (int item = cx.bid; item < 256; item += G) {
        const int nb = item >> 1, hk = item & 1;
        __syncthreads();
        for (int e = tid; e < 256 * 32; e += 512) { const int r = e >> 5, cdw = e & 31; const int gk = nb * 128 - 128 + r;
            unsigned kv = 0u, vv = 0u; if (gk >= 0) { kv = *(const unsigned*)(AK + (size_t)gk * 128 + hk * 64 + 2 * cdw); vv = *(const unsigned*)(AV + (size_t)gk * 128 + hk * 64 + 2 * cdw); }
            Ks[r * 33 + cdw] = kv; Vs[r * 33 + cdw] = vv; }
        __syncthreads();
#pragma unroll 1
        for (int rep = 0; rep < 2; ++rep) {
            const int pair = tid + 512 * rep, i = pair & 127, g = pair >> 7, hq = hk * 8 + g; const int row = nb * 128 + i;
            float q[64], o[64];
            { const v4u* qp = (const v4u*)(AQ + (size_t)row * 1024 + hq * 64);
#pragma unroll
              for (int c8 = 0; c8 < 8; ++c8) { const v4u w = qp[c8]; q[8 * c8 + 0] = bflo(w.x); q[8 * c8 + 1] = bfhi(w.x); q[8 * c8 + 2] = bflo(w.y); q[8 * c8 + 3] = bfhi(w.y); q[8 * c8 + 4] = bflo(w.z); q[8 * c8 + 5] = bfhi(w.z); q[8 * c8 + 6] = bflo(w.w); q[8 * c8 + 7] = bfhi(w.w); } }
#pragma unroll
            for (int d = 0; d < 64; ++d) o[d] = 0.f;
            float mx = sinks[hq], den = 1.0f;
            const int jj0 = (nb == 0) ? (127 - i) : 0;
            for (int jj = jj0; jj < 128; ++jj) { const int kl = i + 1 + jj;
                float s = 0.f;
#pragma unroll
                for (int c = 0; c < 32; ++c) { const unsigned w = Ks[kl * 33 + c]; s += q[2 * c] * bflo(w) + q[2 * c + 1] * bfhi(w); }
                const float mn = fmaxf(mx, s), sc = __expf(mx - mn), p = __expf(s - mn);
                den = den * sc + p; mx = mn;
#pragma unroll
                for (int c = 0; c < 32; ++c) { const unsigned w = Vs[kl * 33 + c]; o[2 * c] = o[2 * c] * sc + p * bflo(w); o[2 * c + 1] = o[2 * c + 1] * sc + p * bfhi(w); }
            }
            const float inv = 1.0f / den;
            v4u* op = (v4u*)(MIX + (size_t)row * 2048 + 1024 + hq * 64);
#pragma unroll
            for (int c8 = 0; c8 < 8; ++c8) { v4u w; w.x = pk2(o[8 * c8] * inv, o[8 * c8 + 1] * inv); w.y = pk2(o[8 * c8 + 2] * inv, o[8 * c8 + 3] * inv); w.z = pk2(o[8 * c8 + 4] * inv, o[8 * c8 + 5] * inv); w.w = pk2(o[8 * c8 + 6] * inv, o[8 * c8 + 7] * inv); op[c8] = w; }
        }
    }
}

__device__ __forceinline__ void phase_ret_u_scores(const Params& P, const Ctx& cx, LAS unsigned char* lds) {
    unsigned char* ws = cx.ws; const int tid = cx.tid, G = cx.G;
    const bf16* Q = (const bf16*)(ws + WS_Q); const bf16* K = (const bf16*)(ws + WS_K); const bf16* V = (const bf16*)(ws + WS_V);
    float* U = (float*)(ws + WS_U); float* PS = (float*)(ws + WS_PS);
    const float lg0 = P.lg2g[0], lg1 = P.lg2g[1], lg2 = P.lg2g[2], lg3 = P.lg2g[3];
    auto lgh = [=](int h) { return h == 0 ? lg0 : h == 1 ? lg1 : h == 2 ? lg2 : lg3; };
    simple_gemm<256, 256, 128, false, true>(lds, 512, tid, G, cx.bid,
        [=](int b, int m, int k) { const int nb = b >> 2, h = b & 3; return bf1(K + (size_t)(nb * 128 + k) * 1024 + h * 256 + m) * exp2f(lgh(h) * (float)(127 - k)); },
        [=](int b, int k, int n) { const int nb = b >> 2, h = b & 3; return bf1(V + (size_t)(nb * 128 + k) * 1024 + h * 256 + n); },
        [=](int b, int m, int n, float v) { U[((size_t)b * 256 + m) * 256 + n] = v; });
    simple_gemm<128, 128, 256, true, false>(lds, 512, tid, G, cx.bid,
        [=](int b, int m, int k) { const int nb = b >> 2, h = b & 3; return bf1(Q + (size_t)(nb * 128 + m) * 1024 + h * 256 + k); },
        [=](int b, int k, int n) { const int nb = b >> 2, h = b & 3; return bf1(K + (size_t)(nb * 128 + n) * 1024 + h * 256 + k); },
        [=](int b, int m, int n, float v) { const int h = b & 3; PS[((size_t)b * 128 + m) * 128 + n] = (m >= n) ? v * exp2f(lgh(h) * (float)(m - n)) : 0.f; });
}
__device__ __forceinline__ void phase_scan(const Params& P, const Ctx& cx) {
    float* U = (float*)(cx.ws + WS_U);
    const size_t gt = (size_t)cx.bid * 512 + cx.tid, NT = (size_t)cx.G * 512;
    for (size_t idx = gt; idx < 4 * 65536; idx += NT) {
        const int h = (int)(idx >> 16); const float cd = exp2f(P.lg2g[h] * 128.0f);
        float r = 0.f;
        for (int n0 = 0; n0 < 128; n0 += 8) { float u[8];
#pragma unroll
            for (int j = 0; j < 8; ++j) u[j] = U[(size_t)(n0 + j) * 262144 + idx];
#pragma unroll
            for (int j = 0; j < 8; ++j) { U[(size_t)(n0 + j) * 262144 + idx] = r; r = r * cd + u[j]; } }
    }
}
__device__ __forceinline__ void phase_ret_out(const Params& P, const Ctx& cx, LAS unsigned char* lds) {
    unsigned char* ws = cx.ws; const int tid = cx.tid, G = cx.G;
    const bf16* Q = (const bf16*)(ws + WS_Q); const bf16* V = (const bf16*)(ws + WS_V);
    const float* Sst = (const float*)(ws + WS_U); const float* PS = (const float*)(ws + WS_PS); float* RY = (float*)(ws + WS_RETY);
    const float lg0 = P.lg2g[0], lg1 = P.lg2g[1], lg2 = P.lg2g[2], lg3 = P.lg2g[3];
    auto lgh = [=](int h) { return h == 0 ? lg0 : h == 1 ? lg1 : h == 2 ? lg2 : lg3; };
    simple_gemm<128, 256, 384, true, true>(lds, 512, tid, G, cx.bid,
        [=](int b, int m, int k) { const int nb = b >> 2, h = b & 3; return k < 128 ? PS[((size_t)b * 128 + m) * 128 + k] : bf1(Q + (size_t)(nb * 128 + m) * 1024 + h * 256 + (k - 128)) * exp2f(lgh(h) * (float)(m + 1)); },
        [=](int b, int k, int n) { const int nb = b >> 2, h = b & 3; return k < 128 ? bf1(V + (size_t)(nb * 128 + k) * 1024 + h * 256 + n) : Sst[((size_t)b * 256 + (k - 128)) * 256 + n]; },
        [=](int b, int m, int n, float v) { const int nb = b >> 2, h = b & 3; RY[(size_t)(nb * 128 + m) * 1024 + h * 256 + n] = v; });
}

typedef short bf16x8 __attribute__((ext_vector_type(8)));
typedef short s16x4 __attribute__((ext_vector_type(4)));
typedef short v4i16_t __attribute__((ext_vector_type(4)));
__device__ __forceinline__ f32x4 mfma16(bf16x8 a, bf16x8 b, f32x4 c) { return __builtin_amdgcn_mfma_f32_16x16x32_bf16(a, b, c, 0, 0, 0); }
__device__ __forceinline__ s16x4 lds_tr(LAS unsigned char* p) { return __builtin_bit_cast(s16x4, __builtin_amdgcn_ds_read_tr16_b64_v4i16((LAS v4i16_t*)p)); }
__device__ __forceinline__ bf16x8 cat44(s16x4 a, s16x4 b) { bf16x8 r; r[0] = a[0]; r[1] = a[1]; r[2] = a[2]; r[3] = a[3]; r[4] = b[0]; r[5] = b[1]; r[6] = b[2]; r[7] = b[3]; return r; }
__device__ __forceinline__ unsigned cvt2(float lo, float hi) { return pg8::cvt_pk_bf16(lo, hi); }
__device__ __forceinline__ bf16x8 pack_frag(const f32x4 a, const f32x4 b) { v4u w; w.x = cvt2(a[0], a[1]); w.y = cvt2(a[2], a[3]); w.z = cvt2(b[0], b[1]); w.w = cvt2(b[2], b[3]); return __builtin_bit_cast(bf16x8, w); }
__device__ __forceinline__ float grp16_sum(float v, int lane) {
#pragma unroll
    for (int o = 1; o < 16; o <<= 1) v += __builtin_bit_cast(float, __builtin_amdgcn_ds_bpermute((lane ^ o) << 2, __builtin_bit_cast(int, v)));
    return v;
}

__device__ __forceinline__ unsigned lds_addr(const LAS unsigned char* p) { return (unsigned)(size_t)p; }
template <int O1, int O2, int O3, int O4, int O5, int O6, int O7>
__device__ __forceinline__ void lds_rd8(bf16x8 (&t)[8], unsigned a) {
    asm volatile("ds_read_b128 %0, %8\n\tds_read_b128 %1, %8 offset:%9\n\tds_read_b128 %2, %8 offset:%10\n\tds_read_b128 %3, %8 offset:%11\n\t"
                 "ds_read_b128 %4, %8 offset:%12\n\tds_read_b128 %5, %8 offset:%13\n\tds_read_b128 %6, %8 offset:%14\n\tds_read_b128 %7, %8 offset:%15\n\ts_waitcnt lgkmcnt(0)"
                 : "=&v"(t[0]), "=&v"(t[1]), "=&v"(t[2]), "=&v"(t[3]), "=&v"(t[4]), "=&v"(t[5]), "=&v"(t[6]), "=&v"(t[7])
                 : "v"(a), "i"(O1), "i"(O2), "i"(O3), "i"(O4), "i"(O5), "i"(O6), "i"(O7) : "memory");
}
template <int OA, int OB, int OC>
__device__ __forceinline__ void lds_tr8(s16x4 (&t)[8], unsigned a0, unsigned a1) {
    asm volatile("ds_read_b64_tr_b16 %0, %8\n\tds_read_b64_tr_b16 %1, %8 offset:%10\n\tds_read_b64_tr_b16 %2, %8 offset:%11\n\tds_read_b64_tr_b16 %3, %8 offset:%12\n\t"
                 "ds_read_b64_tr_b16 %4, %9\n\tds_read_b64_tr_b16 %5, %9 offset:%10\n\tds_read_b64_tr_b16 %6, %9 offset:%11\n\tds_read_b64_tr_b16 %7, %9 offset:%12\n\ts_waitcnt lgkmcnt(0)"
                 : "=&v"(t[0]), "=&v"(t[1]), "=&v"(t[2]), "=&v"(t[3]), "=&v"(t[4]), "=&v"(t[5]), "=&v"(t[6]), "=&v"(t[7])
                 : "v"(a0), "v"(a1), "i"(OA), "i"(OB), "i"(OC) : "memory");
}
constexpr int RS_T = 544;
constexpr int TILE_T = 128 * RS_T;
static_assert(2 * TILE_T <= LDSCTL_OFF, "retention tiles vs LDS control words");

template <bool DECAY> __device__ __forceinline__ void stage_tile(LAS unsigned char* img, const bf16* src, int tid, float lg) {
    v4u v[8];
#pragma unroll
    for (int r = 0; r < 8; ++r) { const int pc = tid + 512 * r, row = pc >> 5, c16 = pc & 31; v[r] = *(const v4u*)(src + (size_t)row * 1024 + c16 * 8); }
#pragma unroll
    for (int r = 0; r < 8; ++r) { const int pc = tid + 512 * r, row = pc >> 5, c16 = pc & 31; v4u w = v[r];
        if (DECAY) { const float sc = exp2f(lg * (float)(127 - row));
            w.x = cvt2(bflo(w.x) * sc, bfhi(w.x) * sc); w.y = cvt2(bflo(w.y) * sc, bfhi(w.y) * sc); w.z = cvt2(bflo(w.z) * sc, bfhi(w.z) * sc); w.w = cvt2(bflo(w.w) * sc, bfhi(w.w) * sc); }
        *(LAS v4u*)(img + row * RS_T + c16 * 16) = w; }
}

template <bool DECAY_A> __device__ __forceinline__ void stage_two(LAS unsigned char* imgA, const bf16* srcA, LAS unsigned char* imgB, const bf16* srcB, int tid, float lg) {
    v4u va[8], vb[8];
#pragma unroll
    for (int r = 0; r < 8; ++r) { const int pc = tid + 512 * r, row = pc >> 5, c16 = pc & 31; va[r] = *(const v4u*)(srcA + (size_t)row * 1024 + c16 * 8); vb[r] = *(const v4u*)(srcB + (size_t)row * 1024 + c16 * 8); }
#pragma unroll
    for (int r = 0; r < 8; ++r) { const int pc = tid + 512 * r, row = pc >> 5, c16 = pc & 31; v4u w = va[r];
        if (DECAY_A) { const float sc = exp2f(lg * (float)(127 - row));
            w.x = cvt2(bflo(w.x) * sc, bfhi(w.x) * sc); w.y = cvt2(bflo(w.y) * sc, bfhi(w.y) * sc); w.z = cvt2(bflo(w.z) * sc, bfhi(w.z) * sc); w.w = cvt2(bflo(w.w) * sc, bfhi(w.w) * sc); }
        *(LAS v4u*)(imgA + row * RS_T + c16 * 16) = w; *(LAS v4u*)(imgB + row * RS_T + c16 * 16) = vb[r]; }
}

__device__ __forceinline__ void phase_ret_u_mfma(const Params& P, const Ctx& cx, LAS unsigned char* lds, const bool light_only) {
    unsigned char* ws = cx.ws; const int tid = cx.tid, lane = cx.lane, w = cx.wave, r16 = lane & 15, g = lane >> 4, q = r16 >> 2, pp = r16 & 3;
    const bf16* K = (const bf16*)(ws + WS_K); const bf16* V = (const bf16*)(ws + WS_V); bf16* UT = (bf16*)(ws + WS_U);
    LAS unsigned char* Kim = lds; LAS unsigned char* Vim = lds + TILE_T;
    const bool al_ = XLOC && cx.G == 4 * (S / 256);
    const int first_ = al_ ? (light_only ? (cx.bid >> 3) - 8 : (cx.bid >> 3)) : cx.bid, stride_ = al_ ? (light_only ? 24 : 32) : cx.G, count_ = al_ ? 64 : 512, base_ = al_ ? 64 * (cx.bid & 7) : 0;
    for (int v_ = first_; v_ >= 0 && v_ < count_; v_ += stride_) { const int b = base_ + v_;
        const int nb = b >> 2, h = b & 3;
        __syncthreads();
        stage_two<true>(Kim, K + (size_t)nb * 128 * 1024 + h * 256, Vim, V + (size_t)nb * 128 * 1024 + h * 256, tid, P.lg2g[h]);
        __syncthreads();
        f32x4 acc[2][16];
#pragma unroll
        for (int mi = 0; mi < 2; ++mi)
#pragma unroll
            for (int n = 0; n < 16; ++n) acc[mi][n] = (f32x4){0.f, 0.f, 0.f, 0.f};
#pragma unroll 1
        for (int s = 0; s < 4; ++s) {
            bf16x8 af[2];
#pragma unroll
            for (int mi = 0; mi < 2; ++mi) { LAS unsigned char* a0 = Kim + (32 * s + 8 * g + q) * RS_T + (16 * (2 * w + mi) + 4 * pp) * 2; af[mi] = cat44(lds_tr(a0), lds_tr(a0 + 4 * RS_T)); }
#pragma unroll
            for (int ng = 0; ng < 4; ++ng) { const unsigned b0 = lds_addr(Vim + (32 * s + 8 * g + q) * RS_T + (64 * ng + 4 * pp) * 2); s16x4 t[8];
                lds_tr8<32, 64, 96>(t, b0, b0 + 4 * RS_T);
#pragma unroll
                for (int nn = 0; nn < 4; ++nn) { const bf16x8 bfr = cat44(t[nn], t[4 + nn]); const int n = 4 * ng + nn;
                    acc[0][n] = mfma16(af[0], bfr, acc[0][n]); acc[1][n] = mfma16(af[1], bfr, acc[1][n]); } }
        }
#pragma unroll
        for (int mi = 0; mi < 2; ++mi)
#pragma unroll
            for (int n = 0; n < 16; ++n) { v2u o; o.x = cvt2(acc[mi][n][0], acc[mi][n][1]); o.y = cvt2(acc[mi][n][2], acc[mi][n][3]);
                *(v2u*)(UT + ((size_t)b * 256 + 16 * n + r16) * 256 + 16 * (2 * w + mi) + 4 * g) = o; }
    }
}
__device__ __forceinline__ void phase_scan_bf16(const Params& P, const Ctx& cx) {
    unsigned* UT = (unsigned*)(cx.ws + WS_U);
    const size_t gt = (size_t)cx.bid * 512 + cx.tid, NT = (size_t)cx.G * 512;
    for (size_t idx = gt; idx < 131072; idx += NT) {
        const int h = (int)(idx >> 15); const float cd = exp2f(P.lg2g[h] * 128.0f);
        float r0 = 0.f, r1 = 0.f;
        for (int n0 = 0; n0 < 128; n0 += 32) { unsigned u[32];
#pragma unroll
            for (int j = 0; j < 32; ++j) u[j] = UT[(size_t)(n0 + j) * 131072 + idx];
#pragma unroll
            for (int j = 0; j < 32; ++j) { UT[(size_t)(n0 + j) * 131072 + idx] = cvt2(r0, r1); r0 = r0 * cd + bflo(u[j]); r1 = r1 * cd + bfhi(u[j]); } }
    }
}
constexpr int RS_O = 1040;
static_assert(8 * 16 * RS_O <= 2 * TILE_T, "R3 output staging fits the shared area");
__device__ __forceinline__ void phase_ret_out_mfma(const Params& P, const Ctx& cx, int l, LAS unsigned char* lds) {
    unsigned char* ws = cx.ws; const int w = cx.wave;
    const bf16* Q = (const bf16*)(ws + WS_Q); const bf16* K = (const bf16*)(ws + WS_K); const bf16* V = (const bf16*)(ws + WS_V); const bf16* ST = (const bf16*)(ws + WS_U);
    const bf16* Gt = (const bf16*)(ws + WS_G); bf16* MIX = (bf16*)(ws + WS_MIX);
    const float* gg = P.in[5] + l * 1024; const float* gb = P.in[6] + l * 1024;
    LAS unsigned char* Kim = lds; LAS unsigned char* Vim = lds + TILE_T;
    const bool al_ = XLOC && cx.G == 4 * (S / 256);
    for (int k_ = 0; ; ++k_) { const int b = al_ ? 64 * (cx.bid & 7) + (cx.bid >> 3) + 32 * k_ : cx.bid + k_ * cx.G; if (b >= 512 || (al_ && k_ >= 2)) break;
        const int nb = b >> 2, h = b & 3; const float lg = P.lg2g[h];
        int lane = cx.lane; asm volatile("" : "+v"(lane)); const int tid = w * 64 + lane, r16 = lane & 15, g = lane >> 4, q = r16 >> 2, pp = r16 & 3;
        __syncthreads();
        { const bf16* stb = ST + (size_t)b * 65536;
          v4u v[16];
#pragma unroll
          for (int r = 0; r < 16; ++r) { const int pc = tid + 512 * r, row = pc >> 5, c16 = pc & 31; v[r] = *(const v4u*)(stb + (size_t)row * 256 + c16 * 8); }
#pragma unroll
          for (int r = 0; r < 16; ++r) { const int pc = tid + 512 * r, row = pc >> 5, c16 = pc & 31; *(LAS v4u*)(lds + row * RS_T + c16 * 16) = v[r]; } }
        bf16x8 qf[8];
        { const bf16* qrow = Q + (size_t)(nb * 128 + 16 * w + r16) * 1024 + h * 256 + 8 * g;
#pragma unroll
          for (int s = 0; s < 8; ++s) qf[s] = *(const bf16x8*)(qrow + 32 * s); }
        const bf16* ksrc = K + (size_t)nb * 128 * 1024 + h * 256; const bf16* vsrc = V + (size_t)nb * 128 * 1024 + h * 256;
        v4u kv[8];
#pragma unroll
        for (int r = 0; r < 8; ++r) { const int pc = tid + 512 * r, row = pc >> 5, c16 = pc & 31; kv[r] = *(const v4u*)(ksrc + (size_t)row * 1024 + c16 * 8); }
        __syncthreads();
        f32x4 acc[16];
#pragma unroll
        for (int n = 0; n < 16; ++n) { f32x4 a = (f32x4){0.f, 0.f, 0.f, 0.f}; bf16x8 t[8];
            lds_rd8<64, 128, 192, 256, 320, 384, 448>(t, lds_addr(lds + (16 * n + r16) * RS_T + 16 * g));
#pragma unroll
            for (int s = 0; s < 8; ++s) a = mfma16(qf[s], t[s], a);
            acc[n] = a; }
        { float f[4];
#pragma unroll
          for (int r = 0; r < 4; ++r) f[r] = exp2f(lg * (float)(16 * w + 4 * g + r + 1));
#pragma unroll
          for (int n = 0; n < 16; ++n) { acc[n][0] *= f[0]; acc[n][1] *= f[1]; acc[n][2] *= f[2]; acc[n][3] *= f[3]; } }
        __syncthreads();
        v4u vv[8];
#pragma unroll
        for (int r = 0; r < 8; ++r) { const int pc = tid + 512 * r, row = pc >> 5, c16 = pc & 31; *(LAS v4u*)(Kim + row * RS_T + c16 * 16) = kv[r]; vv[r] = *(const v4u*)(vsrc + (size_t)row * 1024 + c16 * 8); }
        __syncthreads();
        f32x4 sc[8];
#pragma unroll
        for (int mb = 0; mb < 8; ++mb) { sc[mb] = (f32x4){0.f, 0.f, 0.f, 0.f};
            if (mb <= w) { f32x4 a = (f32x4){0.f, 0.f, 0.f, 0.f}; bf16x8 t[8];
                lds_rd8<64, 128, 192, 256, 320, 384, 448>(t, lds_addr(Kim + (16 * mb + r16) * RS_T + 16 * g));
#pragma unroll
                for (int s = 0; s < 8; ++s) a = mfma16(t[s], qf[s], a);
                const int i = 16 * w + r16;
#pragma unroll
                for (int r = 0; r < 4; ++r) { const int j = 16 * mb + 4 * g + r; a[r] = (i >= j) ? a[r] * exp2f(lg * (float)(i - j)) : 0.f; }
                sc[mb] = a; } }
#pragma unroll
        for (int r = 0; r < 8; ++r) { const int pc = tid + 512 * r, row = pc >> 5, c16 = pc & 31; *(LAS v4u*)(Vim + row * RS_T + c16 * 16) = vv[r]; }
        __syncthreads();
#pragma unroll
        for (int sk = 0; sk < 4; ++sk) {
            if (2 * sk <= w) { const bf16x8 pf = pack_frag(sc[2 * sk], sc[2 * sk + 1]);
#pragma unroll
                for (int ng = 0; ng < 4; ++ng) { const unsigned b0 = lds_addr(Vim + (32 * sk + 4 * g + q) * RS_T + (64 * ng + 4 * pp) * 2); s16x4 t[8];
                    lds_tr8<32, 64, 96>(t, b0, b0 + 16 * RS_T);
#pragma unroll
                    for (int nn = 0; nn < 4; ++nn) acc[4 * ng + nn] = mfma16(pf, cat44(t[nn], t[4 + nn]), acc[4 * ng + nn]); } } }
        float mean[4], rstd[4];
#pragma unroll
        for (int r = 0; r < 4; ++r) { float sm = 0.f;
#pragma unroll
            for (int n = 0; n < 16; ++n) sm += acc[n][r];
            mean[r] = grp16_sum(sm, lane) * (1.0f / 256.0f); }
#pragma unroll
        for (int r = 0; r < 4; ++r) { float sq = 0.f;
#pragma unroll
            for (int n = 0; n < 16; ++n) { const float d = acc[n][r] - mean[r]; sq += d * d; }
            rstd[r] = 1.0f / sqrtf(grp16_sum(sq, lane) * (1.0f / 256.0f) + GN_EPS); }
        __syncthreads();
        { LAS unsigned char* ob = lds + w * (16 * RS_O);
#pragma unroll
          for (int n = 0; n < 16; ++n)
#pragma unroll
            for (int r = 0; r < 4; ++r) *(LAS float*)(ob + (4 * g + r) * RS_O + (16 * n + r16) * 4) = (acc[n][r] - mean[r]) * rstd[r];
          LDS_WAIT(); asm volatile("" ::: "memory");
          const int e0 = 8 * (lane & 31), hv = lane >> 5;
          const f32x4 g0 = *(const f32x4*)(gg + h * 256 + e0), g1 = *(const f32x4*)(gg + h * 256 + e0 + 4), b0 = *(const f32x4*)(gb + h * 256 + e0), b1 = *(const f32x4*)(gb + h * 256 + e0 + 4);
#pragma unroll
          for (int k = 0; k < 8; ++k) { const int rl = 2 * k + hv; const size_t row = (size_t)(nb * 128 + 16 * w + rl);
              const f32x4 y0 = *(const LAS f32x4*)(ob + rl * RS_O + e0 * 4), y1 = *(const LAS f32x4*)(ob + rl * RS_O + e0 * 4 + 16);
              const v4u gt = *(const v4u*)(Gt + row * 1024 + h * 256 + e0);
              const f32x4 o0 = y0 * g0 + b0, o1 = y1 * g1 + b1;
              v4u o; o.x = cvt2(o0[0] * bflo(gt.x), o0[1] * bfhi(gt.x)); o.y = cvt2(o0[2] * bflo(gt.y), o0[3] * bfhi(gt.y)); o.z = cvt2(o1[0] * bflo(gt.z), o1[1] * bfhi(gt.z)); o.w = cvt2(o1[2] * bflo(gt.w), o1[3] * bfhi(gt.w));
              *(v4u*)(MIX + row * 2048 + h * 256 + e0) = o; } }
    }
}
constexpr int RS_SK = 144, RS_SV = 160;
__device__ __forceinline__ void phase_swa_mfma(const Params& P, const Ctx& cx, int l, LAS unsigned char* lds) {
    unsigned char* ws = cx.ws; const int tid = cx.tid, lane = cx.lane, w = cx.wave, r16 = lane & 15, g = lane >> 4, q = r16 >> 2, pp = r16 & 3;
    const bf16* AQ = (const bf16*)(ws + WS_AQ); const bf16* AK = (const bf16*)(ws + WS_AK); const bf16* AV = (const bf16*)(ws + WS_AV); bf16* MIX = (bf16*)(ws + WS_MIX);
    LAS unsigned char* Kim = lds; LAS unsigned char* Vim = lds + 256 * RS_SK;
    const bool al_ = XLOC && cx.G == 4 * (S / 256);
    for (int item = al_ ? 32 * (cx.bid & 7) + (cx.bid >> 3) : cx.bid, k_ = 0; item < 256 && !(al_ && k_ > 0); item += cx.G, ++k_) {
        const int nb = item >> 1, hk = item & 1, hq = hk * 8 + w; const float sink = P.in[7][l * 16 + hq];
        __syncthreads();
#pragma unroll
        for (int r = 0; r < 4; ++r) { const int pc = tid + 512 * r, row = pc >> 3, c = pc & 7, gk = nb * 128 - 128 + row;
            v4u kv = (v4u){0u, 0u, 0u, 0u}, vv = (v4u){0u, 0u, 0u, 0u};
            if (gk >= 0) { kv = *(const v4u*)(AK + (size_t)gk * 128 + hk * 64 + c * 8); vv = *(const v4u*)(AV + (size_t)gk * 128 + hk * 64 + c * 8); }
            *(LAS v4u*)(Kim + row * RS_SK + c * 16) = kv; *(LAS v4u*)(Vim + row * RS_SV + c * 16) = vv; }
        __syncthreads();
        const bf16* qbase = AQ + (size_t)(nb * 128 + r16) * 1024 + hq * 64 + 8 * g;
        bf16x8 qn0 = *(const bf16x8*)(qbase), qn1 = *(const bf16x8*)(qbase + 32);
        const bool fs_ = (FUSE_SCAN != 0) && al_;
        unsigned* const sut = (unsigned*)(ws + WS_U) + ((unsigned)cx.bid * 512u + (unsigned)tid);
        const float scd = exp2f(P.lg2g[(cx.bid * 512 + tid) >> 15] * 128.0f); float sr0 = 0.f, sr1 = 0.f;
#if SWA_KWIN
        bf16x8 kt[18];
        { const unsigned kp0 = lds_addr(Kim + r16 * RS_SK + 16 * g);
          bf16x8 t[8];
          lds_rd8<64, 16 * RS_SK, 16 * RS_SK + 64, 32 * RS_SK, 32 * RS_SK + 64, 48 * RS_SK, 48 * RS_SK + 64>(t, kp0);
#pragma unroll
          for (int i = 0; i < 8; ++i) kt[i] = t[i];
          lds_rd8<64, 16 * RS_SK, 16 * RS_SK + 64, 32 * RS_SK, 32 * RS_SK + 64, 48 * RS_SK, 48 * RS_SK + 64>(t, kp0 + 64 * RS_SK);
#pragma unroll
          for (int i = 0; i < 8; ++i) kt[8 + i] = t[i]; }
#endif
#pragma unroll 1
        for (int nq = 0; nq < 8; ++nq) {
            unsigned su[16];
            if (fs_) {
#pragma unroll
                for (int j = 0; j < 16; ++j) su[j] = sut[(size_t)(16 * nq + j) * 131072]; }
            const bf16x8 qf0 = qn0, qf1 = qn1;
            { const bf16* qrow = qbase + (size_t)(16 * (nq < 7 ? nq + 1 : 7)) * 1024; qn0 = *(const bf16x8*)(qrow); qn1 = *(const bf16x8*)(qrow + 32); }
            f32x4 sc[10];
            float mx = sink;
#if SWA_KWIN
            kt[16] = *(const LAS bf16x8*)(Kim + (16 * (nq + 8) + r16) * RS_SK + 16 * g); kt[17] = *(const LAS bf16x8*)(Kim + (16 * (nq + 8) + r16) * RS_SK + 16 * g + 64);
#else
            bf16x8 kt[18];
            { const unsigned kp0 = lds_addr(Kim + (16 * nq + r16) * RS_SK + 16 * g);
              bf16x8 t[8];
              lds_rd8<64, 16 * RS_SK, 16 * RS_SK + 64, 32 * RS_SK, 32 * RS_SK + 64, 48 * RS_SK, 48 * RS_SK + 64>(t, kp0);
#pragma unroll
              for (int i = 0; i < 8; ++i) kt[i] = t[i];
              lds_rd8<64, 16 * RS_SK, 16 * RS_SK + 64, 32 * RS_SK, 32 * RS_SK + 64, 48 * RS_SK, 48 * RS_SK + 64>(t, kp0 + 64 * RS_SK);
#pragma unroll
              for (int i = 0; i < 8; ++i) kt[8 + i] = t[i];
              kt[16] = *(const LAS bf16x8*)(Kim + (16 * (nq + 8) + r16) * RS_SK + 16 * g); kt[17] = *(const LAS bf16x8*)(Kim + (16 * (nq + 8) + r16) * RS_SK + 16 * g + 64); }
#endif
#pragma unroll
            for (int kb = 0; kb < 9; ++kb) {
                f32x4 a = (f32x4){0.f, 0.f, 0.f, 0.f};
                a = mfma16(kt[2 * kb], qf0, a); a = mfma16(kt[2 * kb + 1], qf1, a);
#pragma unroll
                for (int r = 0; r < 4; ++r) { const int dl = 16 * kb + 4 * g + r - r16; const bool vis = (dl >= 1) && (dl <= 128) && (nb > 0 || 16 * (nq + kb) + 4 * g + r >= 128);
                    a[r] = vis ? a[r] : -INFINITY; mx = fmaxf(mx, a[r]); }
                sc[kb] = a; }
            sc[9] = (f32x4){0.f, 0.f, 0.f, 0.f};
            mx = fmaxf(mx, __builtin_bit_cast(float, __builtin_amdgcn_ds_bpermute((lane ^ 16) << 2, __builtin_bit_cast(int, mx))));
            mx = fmaxf(mx, __builtin_bit_cast(float, __builtin_amdgcn_ds_bpermute((lane ^ 32) << 2, __builtin_bit_cast(int, mx))));
            float sum = 0.f;
#pragma unroll
            for (int kb = 0; kb < 9; ++kb)
#pragma unroll
                for (int r = 0; r < 4; ++r) { const float pv = __expf(sc[kb][r] - mx); sc[kb][r] = pv; sum += pv; }
            sum += __builtin_bit_cast(float, __builtin_amdgcn_ds_bpermute((lane ^ 16) << 2, __builtin_bit_cast(int, sum)));
            sum += __builtin_bit_cast(float, __builtin_amdgcn_ds_bpermute((lane ^ 32) << 2, __builtin_bit_cast(int, sum)));
            const float inv = 1.0f / (sum + __expf(sink - mx));
            f32x4 o[4];
#pragma unroll
            for (int nd = 0; nd < 4; ++nd) o[nd] = (f32x4){0.f, 0.f, 0.f, 0.f};
#pragma unroll
            for (int sk = 0; sk < 5; ++sk) { const bf16x8 pf = pack_frag(sc[2 * sk] * inv, sc[2 * sk + 1] * inv);
                const int kb0 = nq + 2 * sk, kb1 = (kb0 + 1 > 15) ? 15 : kb0 + 1;
                s16x4 t[8];
                lds_tr8<32, 64, 96>(t, lds_addr(Vim + (16 * kb0 + 4 * g + q) * RS_SV + 8 * pp), lds_addr(Vim + (16 * kb1 + 4 * g + q) * RS_SV + 8 * pp));
#pragma unroll
#if SWA_OT
                for (int nd = 0; nd < 4; ++nd) o[nd] = mfma16(cat44(t[nd], t[4 + nd]), pf, o[nd]); }
#pragma unroll
            for (int nd = 0; nd < 4; ++nd) { v2u w; w.x = cvt2(o[nd][0], o[nd][1]); w.y = cvt2(o[nd][2], o[nd][3]);
                *(v2u*)((char*)MIX + 2u * ((unsigned)(nb * 128 + 16 * nq + r16) * 2048u + (unsigned)(1024 + hq * 64 + 16 * nd + 4 * g))) = w; }
#else
                for (int nd = 0; nd < 4; ++nd) o[nd] = mfma16(pf, cat44(t[nd], t[4 + nd]), o[nd]); }
#pragma unroll
            for (int nd = 0; nd < 4; ++nd)
#pragma unroll
                for (int r = 0; r < 4; ++r) MIX[(size_t)(nb * 128 + 16 * nq + 4 * g + r) * 2048 + 1024 + hq * 64 + 16 * nd + r16] = (bf16)f2bf(o[nd][r]);
#endif
            if (fs_) {
#pragma unroll
                for (int j = 0; j < 16; ++j) { sut[(size_t)(16 * nq + j) * 131072] = cvt2(sr0, sr1); sr0 = sr0 * scd + bflo(su[j]); sr1 = sr1 * scd + bfhi(su[j]); } }
#if SWA_KWIN
#pragma unroll
            for (int i = 0; i < 16; ++i) kt[i] = kt[i + 2];
#endif
        }
    }
}

__device__ __forceinline__ void phase_groupnorm(const Params& P, const Ctx& cx, int l) {
    unsigned char* ws = cx.ws; const int lane = cx.lane, wave = cx.wave, G = cx.G;
    const float* RY = (const float*)(ws + WS_RETY); const bf16* Gt = (const bf16*)(ws + WS_G); bf16* MIX = (bf16*)(ws + WS_MIX);
    const float* gg = P.in[5] + l * 1024; const float* gb = P.in[6] + l * 1024;
    const int gw = cx.bid * 8 + wave, NGW = G * 8;
    for (int it = gw; it < S * 4; it += NGW) { const int row = it >> 2, h = it & 3; const size_t off = (size_t)row * 1024 + h * 256 + 4 * lane;
        f32x4 v = *(const f32x4*)(RY + off);
        const float mean = wave_sum((v[0] + v[1]) + (v[2] + v[3]), lane) * (1.0f / 256.0f);
        v = v - mean;
        const float var = wave_sum((v[0] * v[0] + v[1] * v[1]) + (v[2] * v[2] + v[3] * v[3]), lane) * (1.0f / 256.0f);
        const float rstd = 1.0f / sqrtf(var + GN_EPS);
        const f32x4 g4 = *(const f32x4*)(gg + h * 256 + 4 * lane), b4 = *(const f32x4*)(gb + h * 256 + 4 * lane);
        const v2u gt2 = *(const v2u*)(Gt + off);
        f32x4 o = v * rstd * g4 + b4;
        o[0] *= bflo(gt2.x); o[1] *= bfhi(gt2.x); o[2] *= bflo(gt2.y); o[3] *= bfhi(gt2.y);
        v2u w; w.x = pk2(o[0], o[1]); w.y = pk2(o[2], o[3]);
        *(v2u*)(MIX + (size_t)row * 2048 + h * 256 + 4 * lane) = w; }
}
__device__ __forceinline__ void phase_ln(const Ctx& cx, const float* Y, const float* g, const float* b, float* xo, bf16* xb, float* stats) {
    const int lane = cx.lane, wave = cx.wave, G = cx.G; const int gw = cx.bid * 8 + wave, NGW = G * 8;
    f32x4 g4[8], b4[8];
#pragma unroll
    for (int j = 0; j < 8; ++j) { g4[j] = ((const f32x4*)g)[64 * j + lane]; b4[j] = ((const f32x4*)b)[64 * j + lane]; }
    for (int row = gw; row < S; row += 2 * NGW) {
        const int row2 = row + NGW; const bool has2 = row2 < S; const int rb = has2 ? row2 : row;
        const f32x4* ya = (const f32x4*)(Y + (size_t)row * D) + lane; const f32x4* yb = (const f32x4*)(Y + (size_t)rb * D) + lane;
        f32x4 va[8], vb[8]; float sa = 0.f, sb = 0.f;
#pragma unroll
        for (int j = 0; j < 8; ++j) { va[j] = ya[64 * j]; vb[j] = yb[64 * j]; }
#pragma unroll
        for (int j = 0; j < 8; ++j) { sa += (va[j][0] + va[j][1]) + (va[j][2] + va[j][3]); sb += (vb[j][0] + vb[j][1]) + (vb[j][2] + vb[j][3]); }
        const float ma = wave_sum(sa, lane) * (1.0f / D), mb = wave_sum(sb, lane) * (1.0f / D); float qa = 0.f, qb = 0.f;
#pragma unroll
        for (int j = 0; j < 8; ++j) { va[j] = va[j] - ma; vb[j] = vb[j] - mb; qa += (va[j][0] * va[j][0] + va[j][1] * va[j][1]) + (va[j][2] * va[j][2] + va[j][3] * va[j][3]); qb += (vb[j][0] * vb[j][0] + vb[j][1] * vb[j][1]) + (vb[j][2] * vb[j][2] + vb[j][3] * vb[j][3]); }
        const float ra = 1.0f / sqrtf(wave_sum(qa, lane) * (1.0f / D) + LN_EPS), rbb = 1.0f / sqrtf(wave_sum(qb, lane) * (1.0f / D) + LN_EPS);
        f32x4* xa = (f32x4*)(xo + (size_t)row * D) + lane; f32x4* xbp = (f32x4*)(xo + (size_t)rb * D) + lane;
        if (stats && lane == 0) { stats[2 * (size_t)row] = ma; stats[2 * (size_t)row + 1] = ra; if (has2) { stats[2 * (size_t)rb] = mb; stats[2 * (size_t)rb + 1] = rbb; } }
#pragma unroll
        for (int j = 0; j < 8; ++j) { const f32x4 o = va[j] * ra * g4[j] + b4[j]; if (xo) xa[64 * j] = o;
            if (xb) { v2u w; w.x = pk2(o[0], o[1]); w.y = pk2(o[2], o[3]); ((v2u*)(xb + (size_t)row * D))[64 * j + lane] = w; } }
        if (has2) {
#pragma unroll
            for (int j = 0; j < 8; ++j) { const f32x4 o = vb[j] * rbb * g4[j] + b4[j]; if (xo) xbp[64 * j] = o;
                if (xb) { v2u w; w.x = pk2(o[0], o[1]); w.y = pk2(o[2], o[3]); ((v2u*)(xb + (size_t)rb * D))[64 * j + lane] = w; } } }
    }
}
__device__ __forceinline__ void phase_ln_h(const Ctx& cx, const _Float16* Y, const float* g, const float* b, float* xo, const bool own_panel) {
    typedef _Float16 h16x8_t __attribute__((ext_vector_type(8))); typedef float f32x8_t __attribute__((ext_vector_type(8)));
    const int lane = cx.lane, wave = cx.wave, G = cx.G; const int gw = cx.bid * 8 + wave, NGW = G * 8;
    const int pbase = (8 * (cx.bid & 7) + ((cx.bid >> 3) & 7)) * 256 + (cx.bid >> 6) * 64 + wave * 8;
    for (int it = 0, row = own_panel ? pbase : gw; own_panel ? it < 4 : row < S; ++it, row += own_panel ? 1 : 2 * NGW) {
        const int row2 = own_panel ? row + 4 : row + NGW; const bool has2 = row2 < S; const int rb = has2 ? row2 : row;
        const v4u* ya = (const v4u*)(Y + (size_t)row * D) + lane; const v4u* yb = (const v4u*)(Y + (size_t)rb * D) + lane;
        v4u ha[4], hb[4];
#pragma unroll
        for (int j = 0; j < 4; ++j) { ha[j] = ya[64 * j]; hb[j] = yb[64 * j]; }
        f32x8_t va[4], vb[4]; float sa = 0.f, sb = 0.f;
#pragma unroll
        for (int j = 0; j < 4; ++j) { va[j] = __builtin_convertvector(__builtin_bit_cast(h16x8_t, ha[j]), f32x8_t); vb[j] = __builtin_convertvector(__builtin_bit_cast(h16x8_t, hb[j]), f32x8_t);
#pragma unroll
            for (int e = 0; e < 8; ++e) { sa += va[j][e]; sb += vb[j][e]; } }
        const float ma = wave_sum(sa, lane) * (1.0f / D), mb = wave_sum(sb, lane) * (1.0f / D); float qa = 0.f, qb = 0.f;
#pragma unroll
        for (int j = 0; j < 4; ++j)
#pragma unroll
            for (int e = 0; e < 8; ++e) { va[j][e] -= ma; vb[j][e] -= mb; qa += va[j][e] * va[j][e]; qb += vb[j][e] * vb[j][e]; }
        const float ra = 1.0f / sqrtf(wave_sum(qa, lane) * (1.0f / D) + LN_EPS), rbb = 1.0f / sqrtf(wave_sum(qb, lane) * (1.0f / D) + LN_EPS);
#pragma unroll
        for (int j = 0; j < 4; ++j) { const int c0 = 8 * (64 * j + lane);
            const f32x4 g0 = *(const f32x4*)(g + c0), g1 = *(const f32x4*)(g + c0 + 4), b0 = *(const f32x4*)(b + c0), b1 = *(const f32x4*)(b + c0 + 4);
            { const f32x4 o0 = (f32x4){va[j][0], va[j][1], va[j][2], va[j][3]} * ra * g0 + b0, o1 = (f32x4){va[j][4], va[j][5], va[j][6], va[j][7]} * ra * g1 + b1;
              *(f32x4*)(xo + (size_t)row * D + c0) = o0; *(f32x4*)(xo + (size_t)row * D + c0 + 4) = o1; }
            if (has2) { const f32x4 o0 = (f32x4){vb[j][0], vb[j][1], vb[j][2], vb[j][3]} * rbb * g0 + b0, o1 = (f32x4){vb[j][4], vb[j][5], vb[j][6], vb[j][7]} * rbb * g1 + b1;
              *(f32x4*)(xo + (size_t)rb * D + c0) = o0; *(f32x4*)(xo + (size_t)rb * D + c0 + 4) = o1; } }
    }
}
__device__ __forceinline__ void unpack8(const v4u h, float (&o)[8]) { o[0] = bflo(h.x); o[1] = bfhi(h.x); o[2] = bflo(h.y); o[3] = bfhi(h.y); o[4] = bflo(h.z); o[5] = bfhi(h.z); o[6] = bflo(h.w); o[7] = bfhi(h.w); }
__device__ __forceinline__ void phase_convact(const Params& P, const Ctx& cx, int l) {
    unsigned char* ws = cx.ws; const int tid = cx.tid, G = cx.G;
    const bf16* H = (const bf16*)(ws + WS_H); bf16* ACT = (bf16*)(ws + WS_ACT);
    const float* cw = P.in[11] + (size_t)l * 3 * NUP; const float* cb = P.in[12] + (size_t)l * NUP;
    const int gt = cx.bid * 512 + tid, NT = G * 512;
    for (int item = gt; item < 512 * 704; item += NT) {
        const int seg = item / 704, r = item - seg * 704, tile = r >> 4, q8 = r & 15, t0 = seg * 32;
        const int chg = 128 * tile + 8 * q8, chu = DFF + chg;
        float wg[3][8], wu[3][8], bg[8], bu[8];
#pragma unroll
        for (int k = 0; k < 3; ++k) { const f32x4 a0 = *(const f32x4*)(cw + (size_t)k * NUP + chg), a1 = *(const f32x4*)(cw + (size_t)k * NUP + chg + 4), c0 = *(const f32x4*)(cw + (size_t)k * NUP + chu), c1 = *(const f32x4*)(cw + (size_t)k * NUP + chu + 4);
#pragma unroll
            for (int e = 0; e < 4; ++e) { wg[k][e] = a0[e]; wg[k][4 + e] = a1[e]; wu[k][e] = c0[e]; wu[k][4 + e] = c1[e]; } }
        { const f32x4 a0 = *(const f32x4*)(cb + chg), a1 = *(const f32x4*)(cb + chg + 4), c0 = *(const f32x4*)(cb + chu), c1 = *(const f32x4*)(cb + chu + 4);
#pragma unroll
          for (int e = 0; e < 4; ++e) { bg[e] = a0[e]; bg[4 + e] = a1[e]; bu[e] = c0[e]; bu[4 + e] = c1[e]; } }
        const bf16* hp = H + (size_t)t0 * NUP + 256 * tile + 8 * q8;
        float g2[8], g1[8], u2[8], u1[8];
        if (t0 > 0) { unpack8(*(const v4u*)(hp - 2 * (size_t)NUP), g2); unpack8(*(const v4u*)(hp - (size_t)NUP), g1); unpack8(*(const v4u*)(hp - 2 * (size_t)NUP + 128), u2); unpack8(*(const v4u*)(hp - (size_t)NUP + 128), u1); }
        else {
#pragma unroll
            for (int e = 0; e < 8; ++e) { g2[e] = 0.f; g1[e] = 0.f; u2[e] = 0.f; u1[e] = 0.f; } }
        bf16* ap = ACT + (size_t)t0 * DFF + chg;
        v4u ng = *(const v4u*)(hp), nu = *(const v4u*)(hp + 128);
#pragma unroll 2
        for (int tt = 0; tt < 32; ++tt) {
            float g0[8], u0[8]; unpack8(ng, g0); unpack8(nu, u0);
            if (tt < 31) { ng = *(const v4u*)(hp + (size_t)(tt + 1) * NUP); nu = *(const v4u*)(hp + (size_t)(tt + 1) * NUP + 128); }
            float o[8];
#pragma unroll
            for (int e = 0; e < 8; ++e) { const float ga = bg[e] + wg[0][e] * g2[e] + wg[1][e] * g1[e] + wg[2][e] * g0[e], ua = bu[e] + wu[0][e] * u2[e] + wu[1][e] * u1[e] + wu[2][e] * u0[e];
                o[e] = ga * __builtin_amdgcn_rcpf(1.0f + __expf(-ga)) * ua; g2[e] = g1[e]; g1[e] = g0[e]; u2[e] = u1[e]; u1[e] = u0[e]; }
            v4u w; w.x = cvt2(o[0], o[1]); w.y = cvt2(o[2], o[3]); w.z = cvt2(o[4], o[5]); w.w = cvt2(o[6], o[7]);
            *(v4u*)(ap + (size_t)tt * DFF) = w;
        }
    }
}

__device__ __forceinline__ void phase_conv_fixup(const Params& P, const Ctx& cx, int l, int base, int cnt, int first, int stride) {
    unsigned char* ws = cx.ws;
    const bf16* HALO = (const bf16*)(ws + WS_H); bf16* ACT = (bf16*)(ws + WS_ACT);
    const float* cw = P.in[11] + (size_t)l * 3 * NUP; const float* cb = P.in[12] + (size_t)l * NUP;
    for (int idx = first; idx < cnt; idx += stride) { const int item = base + idx;
        const int k = item / 704, r = item - k * 704, tile = r >> 4, q8 = r & 15, chg = 128 * tile + 8 * q8, chu = DFF + chg;
        float a_g[8], b_g[8], c_g[8], d_g[8], a_u[8], b_u[8], c_u[8], d_u[8];
        const bf16* hk = HALO + (size_t)k * 4 * NUP + 256 * tile + 8 * q8;
        unpack8(*(const v4u*)(hk), c_g); unpack8(*(const v4u*)(hk + NUP), d_g); unpack8(*(const v4u*)(hk + 128), c_u); unpack8(*(const v4u*)(hk + NUP + 128), d_u);
        if (k > 0) { const bf16* hm = hk - 4 * (size_t)NUP; unpack8(*(const v4u*)(hm + 2 * NUP), a_g); unpack8(*(const v4u*)(hm + 3 * NUP), b_g); unpack8(*(const v4u*)(hm + 2 * NUP + 128), a_u); unpack8(*(const v4u*)(hm + 3 * NUP + 128), b_u); }
        else {
#pragma unroll
            for (int e = 0; e < 8; ++e) { a_g[e] = 0.f; b_g[e] = 0.f; a_u[e] = 0.f; b_u[e] = 0.f; } }
        float o0[8], o1[8];
#pragma unroll
        for (int e = 0; e < 8; ++e) { const float w0g = cw[chg + e], w1g = cw[NUP + chg + e], w2g = cw[2 * NUP + chg + e], bgv = cb[chg + e], w0u = cw[chu + e], w1u = cw[NUP + chu + e], w2u = cw[2 * NUP + chu + e], buv = cb[chu + e];
            const float g0 = bgv + w0g * a_g[e] + w1g * b_g[e] + w2g * c_g[e], u0 = buv + w0u * a_u[e] + w1u * b_u[e] + w2u * c_u[e];
            const float g1 = bgv + w0g * b_g[e] + w1g * c_g[e] + w2g * d_g[e], u1 = buv + w0u * b_u[e] + w1u * c_u[e] + w2u * d_u[e];
            o0[e] = g0 * __builtin_amdgcn_rcpf(1.0f + __expf(-g0)) * u0; o1[e] = g1 * __builtin_amdgcn_rcpf(1.0f + __expf(-g1)) * u1; }
        v4u w0, w1; w0.x = cvt2(o0[0], o0[1]); w0.y = cvt2(o0[2], o0[3]); w0.z = cvt2(o0[4], o0[5]); w0.w = cvt2(o0[6], o0[7]); w1.x = cvt2(o1[0], o1[1]); w1.y = cvt2(o1[2], o1[3]); w1.z = cvt2(o1[4], o1[5]); w1.w = cvt2(o1[6], o1[7]);
        *(v4u*)(ACT + pg8::tiled_off(64 * k, chg, DFF)) = w0; *(v4u*)(ACT + pg8::tiled_off(64 * k + 1, chg, DFF)) = w1;
    }
}

#ifdef DBG_DUMP
__device__ __forceinline__ void phase_dump(const Ctx& cx, float* out, const bf16* a, int lda, const bf16* b, int ldb, const float* f) {
    const size_t gt = (size_t)cx.bid * 512 + cx.tid, NT = (size_t)cx.G * 512;
    for (size_t i = gt; i < (size_t)S * D; i += NT) { const int row = (int)(i >> 11), col = (int)(i & 2047);
        float v; if (f) v = f[i]; else if (b && col >= 1024) v = bf1(b + (size_t)row * ldb + (col - 1024)); else v = lda ? bf1(a + (size_t)row * lda + col) : bf1(a + (size_t)(row & 2047) * 2048 + col);
        out[i] = v; }
}
#endif
__device__ __forceinline__ void finalize_panel_stats(const Ctx& cx, const float* pstat, float* st, int pm) {
    const int tid = cx.tid, lane = cx.lane, row = pm * 256 + (tid >> 1), hf = tid & 1;
    float s1 = 0.f, s2 = 0.f;
#if PST_T
    const pg8::f32x2* pp = (const pg8::f32x2*)(pstat + ((size_t)(16 * hf) * S + row) * 2);
#pragma unroll
    for (int k = 0; k < 16; ++k) { const pg8::f32x2 v = pp[(size_t)k * S]; s1 += v[0]; s2 += v[1]; }
#else
    const f32x4* pp = (const f32x4*)(pstat + ((size_t)row * 32 + 16 * hf) * 2);
#pragma unroll
    for (int k = 0; k < 8; ++k) { const f32x4 v = pp[k]; s1 += v[0] + v[2]; s2 += v[1] + v[3]; }
#endif
    s1 += __builtin_bit_cast(float, __builtin_amdgcn_ds_bpermute((lane ^ 1) << 2, __builtin_bit_cast(int, s1)));
    s2 += __builtin_bit_cast(float, __builtin_amdgcn_ds_bpermute((lane ^ 1) << 2, __builtin_bit_cast(int, s2)));
    const float mean = s1 * (1.0f / D), var = fmaxf(s2 * (1.0f / D) - mean * mean, 0.f), rstd = 1.0f / sqrtf(var + LN_EPS);
    if (!hf) *(pg8::f32x2*)(st + 2 * (size_t)row) = (pg8::f32x2){mean, rstd};
}
template <class Sched> __device__ __forceinline__ void finalize_stats_for(const Ctx& cx, const Sched& So, const float* pstat, float* st) {
    int last = -1; pg8::Unit u;
    for (int i = 0; So.next(i, u); ++i) if (u.pm != last) { finalize_panel_stats(cx, pstat, st, u.pm); last = u.pm; }
    asm volatile("s_waitcnt vmcnt(0)" ::: "memory"); __syncthreads();
}
__device__ __forceinline__ void panel_barrier(unsigned* cnt, unsigned target, unsigned* bar) {
    asm volatile("s_waitcnt vmcnt(0)" ::: "memory");
    __syncthreads();
    if (threadIdx.x == 0) {
        __builtin_amdgcn_s_waitcnt(0);
        __builtin_amdgcn_fence(__ATOMIC_RELEASE, "agent");
        asm volatile("s_waitcnt vmcnt(0)" ::: "memory");
        (void)xb_add(cnt, 1u);
        XB_SPIN(xb_ld(cnt) < target, bar);
        __builtin_amdgcn_fence(__ATOMIC_ACQUIRE, "agent");
        asm volatile("s_waitcnt vmcnt(0)" ::: "memory");
    }
    __syncthreads();
}
__device__ __forceinline__ void panel_barrier_local(unsigned* cnt, unsigned target, unsigned* bar) {
    asm volatile("s_waitcnt vmcnt(0)" ::: "memory");
    __syncthreads();
    if (threadIdx.x == 0) {
        __builtin_amdgcn_s_waitcnt(0);
        (void)xb_add(cnt, 1u);
        XB_SPIN(xb_ld(cnt) < target, bar);
        __builtin_amdgcn_fence(__ATOMIC_ACQUIRE, "agent");
        asm volatile("s_waitcnt vmcnt(0)" ::: "memory");
    }
    __syncthreads();
}
__global__ void __launch_bounds__(512, 2) fwd(Params P) {
    extern __shared__ __attribute__((aligned(16))) unsigned char lds_raw[];
    LAS unsigned char* lds = (LAS unsigned char*)lds_raw;
#if CODE_PAD > 0
    asm volatile(".rept %0\n\ts_nop 0\n\t.endr" :: "n"(CODE_PAD));
#endif
    const int wave = __builtin_amdgcn_readfirstlane(threadIdx.x >> 6), G = gridDim.x;
    unsigned char* ws = P.ws;
    volatile LAS unsigned* MISC = (volatile LAS unsigned*)(lds + MISC_OFF);
    for (int u = threadIdx.x; u < (LDS_BYTES - LDSCTL_OFF) / 4; u += 512) ((LAS unsigned*)(lds + LDSCTL_OFF))[u] = 0u;
    __syncthreads();
    const int lo = P.ph_lo, hi = P.ph_hi; const int cx0G = G;
#if PROBE_DUP == 60
    if (wave == 0 && lane_id_asm() == 0) { const unsigned long long c0_ = __builtin_amdgcn_s_memtime(), r0_ = __builtin_amdgcn_s_memrealtime(); MISC[34] = (unsigned)c0_; MISC[35] = (unsigned)(c0_ >> 32); MISC[36] = (unsigned)r0_; MISC[37] = (unsigned)(r0_ >> 32); }
#endif
    XcdBarrier bar; bar.bar = (unsigned*)(ws + WS_CTL) + CW_BAR; bar.x = 0; bar.st = nullptr;
    if (hi - lo > 1) { bar = xcd_barrier_post((unsigned*)(ws + WS_CTL) + CW_BAR, MISC + 8);
        if (threadIdx.x == 0) ((unsigned*)(ws + WS_CTL))[CW_XT + blockIdx.x] = bar.x + 1u; }
#define IN(k) (lo <= (k) && (k) < hi)
#if PROBE_DUP == 20
#define SEAM(k) do { if (IN(k) && IN((k) + 1)) { xcd_barrier(bar); xcd_barrier(bar); } } while (0)
#elif PROBE_DUP == 40
#define SEAM(k) do { if (IN(k) && IN((k) + 1)) { if (wave == 0 && lane_id_asm() == 0) MISC[33] = (unsigned)__builtin_amdgcn_s_memrealtime(); xcd_barrier(bar); if (wave == 0 && lane_id_asm() == 0 && (k) > 0 && ((PROBE_MASK >> (((k) - 1) % NPH)) & 1)) MISC[32] = MISC[32] + ((unsigned)__builtin_amdgcn_s_memrealtime() - MISC[33]); } } while (0)
#else
#define SEAM(k) do { if (IN(k) && IN((k) + 1)) xcd_barrier(bar); } while (0)
#endif
#define OPQ() Ctx cx; cx.lane = lane_id_asm(); { int t_ = wave; asm volatile("" : "+s"(t_)); cx.wave = t_; } { int t_ = G; asm volatile("" : "+s"(t_)); cx.G = t_; } { int t_ = blockIdx.x; asm volatile("" : "+s"(t_)); cx.bid = t_; } \
    { unsigned t_ = 0u; asm volatile("" : "+s"(t_)); cx.ws = P.ws + t_; } cx.tid = cx.wave * 64 + cx.lane; int lq = l; asm volatile("" : "+s"(lq)); (void)lq

#ifdef DBG_DUMP
    if (lo >= 1000) { const int l = 0; OPQ(); unsigned char* w = cx.ws; const int kind = lo - 1000;
        if (kind == 1) phase_dump(cx, P.out, (const bf16*)(w + WS_Q), 1024, (const bf16*)(w + WS_AQ), 1024, nullptr);
        else if (kind == 2) phase_dump(cx, P.out, (const bf16*)(w + WS_MIX), 2048, nullptr, 0, nullptr);
        else if (kind == 3) phase_dump(cx, P.out, nullptr, 0, nullptr, 0, (const float*)(w + WS_XR));
        else if (kind == 4) phase_dump(cx, P.out, (const bf16*)(w + WS_ACT), DFF, nullptr, 0, nullptr);
        else if (kind == 5) phase_dump(cx, P.out, nullptr, 0, nullptr, 0, (const float*)(w + WS_Y));
        else if (kind == 6) phase_dump(cx, P.out, (const bf16*)(w + WS_K), 1024, (const bf16*)(w + WS_V), 1024, nullptr);
        else if (kind == 7) phase_dump(cx, P.out, (const bf16*)(w + WS_XB), 2048, nullptr, 0, nullptr);
        else if (kind == 11) phase_dump(cx, P.out, (const bf16*)(w + WS_W + WL_G), 0, nullptr, 0, nullptr);
        else if (kind == 12) phase_dump(cx, P.out, (const bf16*)(w + WS_W + WL_OUT), 0, nullptr, 0, nullptr);
        else if (kind == 10) phase_dump(cx, P.out, (const bf16*)(w + WS_H) + 36 * 256, NUP, nullptr, 0, nullptr);
        else if (kind == 9) phase_dump(cx, P.out, (const bf16*)(w + WS_SG), 2048, nullptr, 0, nullptr);
        else if (kind == 8) phase_dump(cx, P.out, nullptr, 0, nullptr, 0, (const float*)(w + WS_RETY));
        return; }
#endif
    if (IN(0)) { const int l = 0; REPS(9) { __syncthreads(); OPQ(); phase_prologue(P, cx, lds); } }
    SEAM(0);
#if XLOC
    if (IN(0) && IN(1)) { const unsigned* xt = (const unsigned*)(ws + WS_CTL) + CW_XT; const int t = wave * 64 + lane_id_asm();
        const int ok = __syncthreads_and((G == 4 * (S / 256)) && (t >= G || (xt[t] != 0u && xt[t] == xt[t & 7])));
#if PROBE_DUP == 70
        if (!ok) { const unsigned long long t0_ = __builtin_amdgcn_s_memrealtime(); while (__builtin_amdgcn_s_memrealtime() - t0_ < 50000ull) __builtin_amdgcn_s_sleep(8); }
#endif
#ifdef FORCE_NOLOCAL
        if (t == 0) MISC[40] = 0u;
#else
        if (t == 0) MISC[40] = ok ? 1u : 0u;
#endif
        __syncthreads(); }
#if PROBE_DUP == 40
#define SEAM_L(k) do { if (IN(k) && IN((k) + 1)) { if (wave == 0 && lane_id_asm() == 0) MISC[33] = (unsigned)__builtin_amdgcn_s_memrealtime(); if (__builtin_amdgcn_readfirstlane((int)MISC[40])) xcd_barrier_local(bar); else xcd_barrier(bar); \
    if (wave == 0 && lane_id_asm() == 0 && (k) > 0 && ((PROBE_MASK >> (((k) - 1) % NPH)) & 1)) MISC[32] = MISC[32] + ((unsigned)__builtin_amdgcn_s_memrealtime() - MISC[33]); } } while (0)
#else
#define SEAM_L(k) do { if (IN(k) && IN((k) + 1)) { if (__builtin_amdgcn_readfirstlane((int)MISC[40])) xcd_barrier_local(bar); else xcd_barrier(bar); } } while (0)
#endif
#if PANEL_SEAMS
#define SEAM_P(k, j) do { if (IN(k) && IN((k) + 1)) { if (__builtin_amdgcn_readfirstlane((int)MISC[40])) { unsigned* ctl_ = (unsigned*)(ws + WS_CTL); const int c_ = blockIdx.x; \
        panel_barrier_local(ctl_ + CW_PANEL + 64 * (8 * (c_ & 7) + ((c_ >> 3) & 7)), 4u * (unsigned)(3 * l + (j) + 1), ctl_ + CW_BAR); } else xcd_barrier(bar); } } while (0)
#else
#define SEAM_P(k, j) SEAM_L(k)
#endif
#else
#define SEAM_L(k) SEAM(k)
#define SEAM_P(k, j) SEAM(k)
#endif

    for (int l = 0; l < DEPTH; ++l) {
        const int pb = 1 + l * NPH;
#if LN_FUSED
        if (l == 0 && IN(pb + 0)) { OPQ(); const float* cp = (const float*)(cx.ws + WS_CP); float* cc = (float*)(cx.ws + WS_C);
            for (int i = cx.bid * 512 + cx.tid; i < DEPTH * C_L; i += cx.G * 512) { float a = 0.f;
                if (i >= 2 * INW) {
#pragma unroll 8
                    for (int kc = 0; kc < 32 / PRO_NKB; ++kc) a += cp[(size_t)kc * DEPTH * C_L + i]; }
                cc[i] = a; } }
#endif
        if (IN(pb + 0)) { REPS(3) { OPQ(); unsigned char* w = cx.ws; const bf16* wl = (const bf16*)(w + WS_W + (size_t)lq * WL_BYTES);
            pg8::Gemm g{(const bf16*)(w + WS_XB), wl + WL_IN / 2, S, INW, D}; pg8::InProjOrder So; So.init(S, INW, cx.G, cx.bid);
            So.kv = (MERGE_R1 && XLOC && __builtin_amdgcn_readfirstlane((int)MISC[40])) ? (unsigned*)(w + WS_CTL) + CW_KV + 64 * (cx.bid & 7) : (unsigned*)nullptr;
#if LN_FUSED
            if (lq > 0) { const float* cl = (const float*)(w + WS_C) + (size_t)lq * C_L;
                finalize_stats_for(cx, So, (const float*)(w + WS_PSTAT), (float*)(w + WS_ST2));
                pg8::EpiInProjT<true> E{(bf16*)(w + WS_Q), (bf16*)(w + WS_K), (bf16*)(w + WS_V), (bf16*)(w + WS_G), (bf16*)(w + WS_AQ), (bf16*)(w + WS_AK), (bf16*)(w + WS_AV),
                                        (const float*)(w + WS_COSR), (const float*)(w + WS_SINR), (const float*)(w + WS_COSA), (const float*)(w + WS_SINA), (const float*)(w + WS_ST2), cl + C1IN, cl + C2IN};
                pg8::gemm_phase<pg8::EpiInProjT<true>, pg8::InProjOrder, true, true>(lds, g, So, E, cx.wave); }
            else
#endif
            { pg8::EpiInProj E{(bf16*)(w + WS_Q), (bf16*)(w + WS_K), (bf16*)(w + WS_V), (bf16*)(w + WS_G), (bf16*)(w + WS_AQ), (bf16*)(w + WS_AK), (bf16*)(w + WS_AV),
                             (const float*)(w + WS_COSR), (const float*)(w + WS_SINR), (const float*)(w + WS_COSA), (const float*)(w + WS_SINA), nullptr, nullptr, nullptr};
              pg8::gemm_phase<pg8::EpiInProj, pg8::InProjOrder, true, true>(lds, g, So, E, cx.wave); }
        } }
#if PLE_EARLY
        if (IN(pb + 0)) { REPS(71) { OPQ(); unsigned char* w = cx.ws; const bf16* wl = (const bf16*)(w + WS_W + (size_t)lq * WL_BYTES);
            const int nsub = (cx.G > 64) ? cx.G - 64 : cx.G, csub = (cx.G > 64) ? cx.bid - 64 : cx.bid;
            if (csub >= 0) {
                int kple = PLE; asm volatile("" : "+s"(kple));
                pg8::Gemm g{(const bf16*)(w + WS_PB) + (size_t)lq * S * PLE, wl + WL_P / 2, S, D, kple};
#if PLE_BAL
                if (cx.G == 4 * (S / 256)) { pg8::PleOrder So; So.a.init(S, D, 192, csub); So.b.init(S, D, 64, csub >= 128 ? csub - 128 : 0); So.extra = csub >= 128;
                    pg8::EpiPlain E{(bf16*)(w + ((lq & 1) ? WS_PP2 : WS_PP))};
                    pg8::gemm_phase<pg8::EpiPlain, pg8::PleOrder, true, true>(lds, g, So, E, cx.wave); }
                else
#endif
                { pg8::StaticOrder So; So.init(S, D, nsub, csub);
                  pg8::EpiPlain E{(bf16*)(w + ((lq & 1) ? WS_PP2 : WS_PP))};
                  pg8::gemm_phase<pg8::EpiPlain, pg8::StaticOrder, PLE_ALIGN, true>(lds, g, So, E, cx.wave); } }
#if W_LATE
            if (csub >= 0 && lq + 1 < DEPTH) { __syncthreads();
                constexpr int KCH = 32 / PRO_NKB, U_OUT = 32 * KCH, U_DN = 32 * (88 / PRO_NKB);
                const int l1 = lq + 1; bf16* wl1 = (bf16*)(w + WS_W + (size_t)l1 * WL_BYTES); LAS float* scr = (LAS float*)(lds + cx.wave * 16896);
                for (int r = csub * 8 + cx.wave; r < U_OUT + U_DN; r += nsub * 8) {
                    const bool isout = r < U_OUT; const int rr = isout ? r : r - U_OUT, per = isout ? KCH : 88 / PRO_NKB, g = rr / per, kc = rr % per;
                    transpose_unit(isout ? P.in[4] + (size_t)l1 * D * D : P.in[13] + (size_t)l1 * DFF * D, isout ? D : DFF, D, 64 * g, 64 * g + 32, isout ? wl1 + WL_OUT / 2 : wl1 + WL_DOWN / 2, 64 * g, PRO_NKB * kc, PRO_NKB, scr, cx.lane, isout ? 0 : 1,
                                   nullptr, nullptr, nullptr, nullptr); }
                __syncthreads(); }
#endif
        } }
#endif
#if MERGE_R1 && XLOC && RET_MFMA
        if (IN(pb + 0)) { const int xl = __builtin_amdgcn_readfirstlane((int)MISC[40]);
            if (xl) { if (blockIdx.x >= 64) { unsigned* ctl_ = (unsigned*)(ws + WS_CTL); unsigned* kvp = ctl_ + CW_KV + 64 * (blockIdx.x & 7);
                    if (wave == 0 && lane_id_asm() == 0) { XB_SPIN(xb_ld(kvp) < 512u * (unsigned)(l + 1), ctl_ + CW_BAR); __builtin_amdgcn_fence(__ATOMIC_ACQUIRE, "agent"); asm volatile("s_waitcnt vmcnt(0)" ::: "memory"); }
                    __syncthreads(); } }
            else if (IN(pb + 1)) xcd_barrier(bar);
            { REPS(6) { OPQ(); phase_ret_u_mfma(P, cx, lds, xl != 0); } } }
#else
        SEAM_L(pb + 0);
#endif
        if (IN(pb + 1)) {
#if RET_MFMA
#if !(MERGE_R1 && XLOC)
            { REPS(6) { OPQ(); phase_ret_u_mfma(P, cx, lds, false); } }
#endif
#else
            { OPQ(); phase_ret_u_scores(P, cx, lds); }
#endif
#if SWA_MFMA
#if !XLOC
            { REPS(8) { OPQ(); phase_swa_mfma(P, cx, lq, lds); } }
#endif
#else
            { OPQ(); phase_swa(P, cx, lq, lds); }
#endif
        }
        SEAM(pb + 1);
#if RET_MFMA
        if (IN(pb + 2)) { OPQ(); if (!(FUSE_SCAN && XLOC && SWA_MFMA && !SWA_IN_P3 && cx.G == 4 * (S / 256))) phase_scan_bf16(P, cx); }
#if XLOC && SWA_MFMA && !SWA_IN_P3
        if (IN(pb + 2)) { REPS(8) { OPQ(); phase_swa_mfma(P, cx, lq, lds); } }
#endif
        SEAM(pb + 2);
#if XLOC && SWA_MFMA && SWA_IN_P3
        if (IN(pb + 3)) { int swa_first = (blockIdx.x >> 3) & 1; asm volatile("" : "+s"(swa_first));
            for (int step = 0; step < 2; ++step) {
                if ((step == 0) == (swa_first != 0)) { OPQ(); phase_swa_mfma(P, cx, lq, lds); }
                else { OPQ(); phase_ret_out_mfma(P, cx, lq, lds); } } }
#else
        if (IN(pb + 3)) { REPS(7) { OPQ(); phase_ret_out_mfma(P, cx, lq, lds); } }
#endif
        SEAM_L(pb + 3);
#else
        if (IN(pb + 2)) { OPQ(); phase_scan(P, cx); }
        SEAM(pb + 2);
        if (IN(pb + 3)) { OPQ(); phase_ret_out(P, cx, lds); }
        SEAM(pb + 3);
        if (IN(pb + 4)) { OPQ(); phase_groupnorm(P, cx, lq); }
        SEAM(pb + 4);
#endif
        if (IN(pb + 5)) { OPQ(); unsigned char* w = cx.ws; const bf16* wl = (const bf16*)(w + WS_W + (size_t)lq * WL_BYTES);
            pg8::Gemm g{(const bf16*)(w + WS_MIX), wl + WL_OUT / 2, S, D, D}; pg8::StaticOrder So; So.init(S, D, cx.G, cx.bid);
#if LN_FUSED
#if RES_BF16
            if (lq == 0) { pg8::EpiRes3<false, false> E{P.in[0], nullptr, (bf16*)(w + WS_XB), (_Float16*)(w + WS_YH), (float*)(w + WS_PSTAT), nullptr, nullptr, nullptr, nullptr, nullptr, YHW_ARG ALPHA};
                pg8::gemm_phase<pg8::EpiRes3<false, false>, pg8::StaticOrder, true, true>(lds, g, So, E, cx.wave); }
            else { pg8::EpiRes3<true, false> E{nullptr, nullptr, (bf16*)(w + WS_XB), (_Float16*)(w + WS_YH), (float*)(w + WS_PSTAT), (const float*)(w + WS_ST2), P.in[14] + (lq - 1) * D, P.in[15] + (lq - 1) * D, nullptr, nullptr, YHW_ARG ALPHA};
                pg8::gemm_phase<pg8::EpiRes3<true, false>, pg8::StaticOrder, true, true>(lds, g, So, E, cx.wave); }
#else
            if (lq == 0) { pg8::EpiRes2<false, false, true> E{P.in[0], (float*)(w + WS_Y), (bf16*)(w + WS_XB), (float*)(w + WS_PSTAT), nullptr, nullptr, nullptr, nullptr, nullptr, ALPHA};
                pg8::gemm_phase<pg8::EpiRes2<false, false, true>, pg8::StaticOrder, true, true>(lds, g, So, E, cx.wave); }
            else { pg8::EpiRes2<true, false, true> E{nullptr, (float*)(w + WS_Y), (bf16*)(w + WS_XB), (float*)(w + WS_PSTAT), (const float*)(w + WS_ST2), P.in[14] + (lq - 1) * D, P.in[15] + (lq - 1) * D, nullptr, nullptr, ALPHA};
                pg8::gemm_phase<pg8::EpiRes2<true, false, true>, pg8::StaticOrder, true, true>(lds, g, So, E, cx.wave); }
#endif
#elif LN_NOXR
            if (lq == 0) { pg8::EpiResid<false> E{P.in[0], (float*)(w + WS_Y), ALPHA};
                pg8::gemm_phase<pg8::EpiResid<false>, pg8::StaticOrder, true, true>(lds, g, So, E, cx.wave); }
            else {
#if PROBE_DUP == 30
                { pg8::EpiResidLN<false> E{(float*)(w + WS_Y), (float*)(w + WS_XR + 2 * MiB), (const float*)(w + WS_ST2), P.in[14] + (lq - 1) * D, P.in[15] + (lq - 1) * D, nullptr, nullptr, ALPHA};
                  pg8::gemm_phase<pg8::EpiResidLN<false>, pg8::StaticOrder, true, true>(lds, g, So, E, cx.wave); }
#endif
                pg8::EpiResidLN<false> E{(float*)(w + WS_Y), (float*)(w + WS_Y), (const float*)(w + WS_ST2), P.in[14] + (lq - 1) * D, P.in[15] + (lq - 1) * D, nullptr, nullptr, ALPHA};
                pg8::gemm_phase<pg8::EpiResidLN<false>, pg8::StaticOrder, true, true>(lds, g, So, E, cx.wave); }
#else
            pg8::EpiResid<false> E{(lq == 0) ? P.in[0] : (const float*)(w + WS_XR), (float*)(w + WS_Y), ALPHA};
            pg8::gemm_phase<pg8::EpiResid<false>, pg8::StaticOrder, true, true>(lds, g, So, E, cx.wave);
#endif
        }
        SEAM_P(pb + 5, 0);
#if !LN_FUSED
        if (IN(pb + 6)) { REPS(1) { OPQ(); unsigned char* w = cx.ws;
#if LN_NOXR
            phase_ln(cx, (const float*)(w + WS_Y), P.in[8] + lq * D, P.in[9] + lq * D, (float*)nullptr, (bf16*)(w + WS_XB), (float*)(w + WS_ST1));
#else
            phase_ln(cx, (const float*)(w + WS_Y), P.in[8] + lq * D, P.in[9] + lq * D, (float*)(w + WS_XR), (bf16*)(w + WS_XB), (float*)nullptr);
#endif
        } }
        SEAM(pb + 6);
#endif
#if PROBE_DUP == 61 || PROBE_DUP == 62
        if (IN(pb + 7)) { OPQ(); unsigned char* w = cx.ws; const bf16* wl = (const bf16*)(w + WS_W + (size_t)lq * WL_BYTES);
            pg8::Gemm g{(const bf16*)(w + WS_XB), wl + WL_UP / 2, S, NUPG, D};
#if PROBE_DUP == 61
            pg8::HotOrder So; So.init(S, NUPG, cx.G, cx.bid); pg8::EpiNull E0; pg8::gemm_phase<pg8::EpiNull, pg8::HotOrder, true, true>(lds, g, So, E0, cx.wave);
#else
            pg8::StaticOrder So; So.init(S, NUPG, cx.G, cx.bid); pg8::EpiNull E0; pg8::gemm_phase<pg8::EpiNull, pg8::StaticOrder, true, true>(lds, g, So, E0, cx.wave);
#endif
        }
#endif
#if PROBE_DUP >= 90 && PROBE_DUP <= 93
#undef REPS
#define REPS(k) int nrep_ = ((k) == 5) ? 2 : 1; asm volatile("" : "+s"(nrep_)); for (int rep_ = 0; rep_ < nrep_; ++rep_)
#endif
        if (IN(pb + 7)) { REPS(5) { OPQ(); unsigned char* w = cx.ws; const bf16* wl = (const bf16*)(w + WS_W + (size_t)lq * WL_BYTES);
            pg8::Gemm g{(const bf16*)(w + WS_XB), wl + WL_UP / 2, S, NUPG, D}; UPORDER So; So.init(S, NUPG, cx.G, cx.bid);
#if UP_SYNC && !UP_ROT
            So.cnt = (XLOC && __builtin_amdgcn_readfirstlane((int)MISC[40])) ? (unsigned*)(w + WS_CTL) + CW_US + 64 * (cx.bid & 7) : (unsigned*)nullptr; So.nloc = 32u;
#endif
#if LN_FUSED
            { const float* cl = (const float*)(w + WS_C) + (size_t)lq * C_L;
              finalize_stats_for(cx, So, (const float*)(w + WS_PSTAT), (float*)(w + WS_ST1));
              pg8::EpiUpConvT<true> E{(bf16*)(w + WS_ACT), (bf16*)(w + WS_H), (bf16*)(w + WS_SG), P.in[17] + lq * D, P.in[11] + (size_t)lq * 3 * NUP, P.in[12] + (size_t)lq * NUP, (const float*)(w + WS_ST1), cl + C1UP, cl + C2UP,
                                      (const _Float16*)(w + WS_YH), (const bf16*)(w + ((lq & 1) ? WS_PP2 : WS_PP)), P.in[8] + lq * D, P.in[9] + lq * D, ALPHA, (unsigned)(unsigned long)(lds + RING_BYTES)
#if PROBE_DUP >= 90 && PROBE_DUP <= 93
                                      , (nrep_ == 2 && rep_ == 0) ? (PROBE_DUP - 90) : 0
#endif
                                      };
              pg8::gemm_phase<pg8::EpiUpConvT<true>, UPORDER, true, UP_SP2>(lds, g, So, E, cx.wave); }
#elif CONV_FUSED
            pg8::EpiUpConv E{(bf16*)(w + WS_ACT), (bf16*)(w + WS_H), (bf16*)(w + WS_SG), P.in[17] + lq * D, P.in[11] + (size_t)lq * 3 * NUP, P.in[12] + (size_t)lq * NUP, nullptr, nullptr, nullptr};
            pg8::gemm_phase<pg8::EpiUpConv, pg8::StaticOrder, true, true>(lds, g, So, E, cx.wave);
#else
            pg8::EpiUp E{(bf16*)(w + WS_H), (bf16*)(w + WS_SG), P.in[17] + lq * D};
            pg8::gemm_phase<pg8::EpiUp, pg8::StaticOrder, true, true>(lds, g, So, E, cx.wave);
#endif
        } }
#if HALO_WT && XLOC && CONV_FUSED
        if (IN(pb + 7) && IN(pb + 8)) {
            if (__builtin_amdgcn_readfirstlane((int)MISC[40])) { unsigned* ctl_ = (unsigned*)(ws + WS_CTL); const int c_ = blockIdx.x, cls_ = c_ & 7, pic_ = (c_ >> 3) & 7;
                if (pic_ == 7) { asm volatile("s_waitcnt vmcnt(0)" ::: "memory"); __syncthreads(); if (wave == 0 && lane_id_asm() == 0) (void)xb_add(ctl_ + CW_HB + 64 * cls_, 1u); }
                xcd_barrier_local(bar);
                if (pic_ == 0 && cls_ > 0) { if (wave == 0 && lane_id_asm() == 0) { XB_SPIN(xb_ld(ctl_ + CW_HB + 64 * (cls_ - 1)) < 4u * (unsigned)(l + 1), ctl_ + CW_BAR); __builtin_amdgcn_fence(__ATOMIC_ACQUIRE, "agent"); asm volatile("s_waitcnt vmcnt(0)" ::: "memory"); }
                    __syncthreads(); } }
            else xcd_barrier(bar); }
#else
        SEAM(pb + 7);
#endif
        if (IN(pb + 8)) {
#if !PLE_EARLY
            { OPQ(); unsigned char* w = cx.ws; const bf16* wl = (const bf16*)(w + WS_W + (size_t)lq * WL_BYTES);
              pg8::Gemm g{(const bf16*)(w + WS_PB) + (size_t)lq * S * PLE, wl + WL_P / 2, S, D, PLE}; pg8::StaticOrder So; So.init(S, D, cx.G, cx.bid);
              pg8::EpiPle E{(const bf16*)(w + WS_SG), (float*)(w + WS_Y)};
              pg8::gemm_phase<pg8::EpiPle, pg8::StaticOrder, true, true>(lds, g, So, E, cx.wave); }
#endif
#if CONV_FUSED
            { OPQ(); int base = 0, cnt = 256 * 704, first = cx.bid * 512 + cx.tid, stride = cx.G * 512, pmq = -1;
              if ((P8_LOCAL || XLOC) && cx.G == 4 * (S / 256) && IN(pb + 9)) { const int c = cx.bid, pm0 = 8 * (c & 7) + ((c >> 3) & 7), j0 = c >> 6;
                  base = pm0 * 2816; cnt = 2816; first = j0 * 512 + cx.tid; stride = 2048; pmq = pm0;
#if FIX_RED
                  if (__builtin_amdgcn_readfirstlane((int)MISC[40])) { first = cx.tid; stride = 512; }
#endif
              }
              phase_conv_fixup(P, cx, lq, base, cnt, first, stride);
              if (P8_LOCAL && pmq >= 0) panel_barrier((unsigned*)(cx.ws + WS_CTL) + CW_PANEL + 64 * pmq, 4u * (unsigned)(lq + 1), (unsigned*)(cx.ws + WS_CTL) + CW_BAR); }
#else
            { REPS(1) { OPQ(); phase_convact(P, cx, lq); } }
#endif
        }
#if P8_LOCAL && CONV_FUSED
        if (!(cx0G == 4 * (S / 256) && IN(pb + 8) && IN(pb + 9))) SEAM(pb + 8);
#else
#if FIX_RED
        if (IN(pb + 8) && IN(pb + 9)) { if (G == 4 * (S / 256) && __builtin_amdgcn_readfirstlane((int)MISC[40])) { asm volatile("s_waitcnt vmcnt(0)" ::: "memory"); __builtin_amdgcn_fence(__ATOMIC_ACQUIRE, "agent"); __syncthreads(); } else xcd_barrier(bar); }
#else
        SEAM_P(pb + 8, 1);
#endif
#endif
#if PROBE_DUP == 51
        if (IN(pb + 9) && ((blockIdx.x >> 3) & 4)) { const unsigned long long t0_ = __builtin_amdgcn_s_memrealtime(); while (__builtin_amdgcn_s_memrealtime() - t0_ < (unsigned long long)PROBE_TICKS) __builtin_amdgcn_s_sleep(8); }
#endif
#if PROBE_DUP == 50
        if (IN(pb + 9) && (blockIdx.x & 7) >= 4) { const unsigned long long t0_ = __builtin_amdgcn_s_memrealtime(); while (__builtin_amdgcn_s_memrealtime() - t0_ < (unsigned long long)PROBE_TICKS) __builtin_amdgcn_s_sleep(8); }
#endif
        if (IN(pb + 9)) { REPS(42) { OPQ(); unsigned char* w = cx.ws; const bf16* wl = (const bf16*)(w + WS_W + (size_t)lq * WL_BYTES);
            const bool dry = (nrep_ == 2 && rep_ == 0); (void)dry;
            pg8::Gemm g{(const bf16*)(w + WS_ACT), wl + WL_DOWN / 2, S, D, DFF, 0, 0, 1, 1}; pg8::StaticOrder So; So.init(S, D, cx.G, cx.bid);
#if LN_FUSED
#if RES_BF16
#if PROBE_DUP == 41
            { pg8::EpiNull E0; pg8::gemm_phase<pg8::EpiNull, pg8::StaticOrder, true, true>(lds, g, So, E0, cx.wave); }
#endif
#if TFOLD
#if PROBE_DUP == 42
            pg8::EpiRes3<true, false, true> E{nullptr, (lq == DEPTH - 1 && !dry) ? (float*)(w + WS_Y) : (float*)nullptr, dry ? (bf16*)(w + WS_Y) : (bf16*)(w + WS_XB), (_Float16*)(w + WS_YH), (float*)(w + WS_PSTAT), nullptr, nullptr, nullptr, (const bf16*)(w + WS_SG), nullptr, dry ? (_Float16*)(w + WS_Y + 64 * MiB) : (_Float16*)(w + WS_YH), ALPHA};
#else
            pg8::EpiRes3<true, false, true> E{nullptr, (lq == DEPTH - 1) ? (float*)(w + WS_Y) : (float*)nullptr, (bf16*)(w + WS_XB), (_Float16*)(w + WS_YH), (float*)(w + WS_PSTAT), nullptr, nullptr, nullptr, (const bf16*)(w + WS_SG), nullptr, YHW_ARG ALPHA};
#endif
            pg8::gemm_phase<pg8::EpiRes3<true, false, true>, pg8::StaticOrder, true, true>(lds, g, So, E, cx.wave);
#else
            pg8::EpiRes3<true, true> E{nullptr, (lq == DEPTH - 1) ? (float*)(w + WS_Y) : (float*)nullptr, (bf16*)(w + WS_XB), (_Float16*)(w + WS_YH), (float*)(w + WS_PSTAT), (const float*)(w + WS_ST1), P.in[8] + lq * D, P.in[9] + lq * D, (const bf16*)(w + ((lq & 1) ? WS_PP2 : WS_PP)), (const bf16*)(w + WS_SG), YHW_ARG ALPHA};
            pg8::gemm_phase<pg8::EpiRes3<true, true>, pg8::StaticOrder, true, true>(lds, g, So, E, cx.wave);
#endif
#else
            pg8::EpiRes2<true, true, true> E{nullptr, (float*)(w + WS_Y), (bf16*)(w + WS_XB), (float*)(w + WS_PSTAT), (const float*)(w + WS_ST1), P.in[8] + lq * D, P.in[9] + lq * D, (const bf16*)(w + WS_PP), (const bf16*)(w + WS_SG), ALPHA};
            pg8::gemm_phase<pg8::EpiRes2<true, true, true>, pg8::StaticOrder, true, true>(lds, g, So, E, cx.wave);
#endif
#elif PLE_EARLY
#if LN_NOXR
#if PROBE_DUP == 31
            { pg8::EpiResidLN<true> E{(float*)(w + WS_Y), (float*)(w + WS_XR + 2 * MiB), (const float*)(w + WS_ST1), P.in[8] + lq * D, P.in[9] + lq * D, (const bf16*)(w + WS_PP), (const bf16*)(w + WS_SG), ALPHA};
              pg8::gemm_phase<pg8::EpiResidLN<true>, pg8::StaticOrder, true, true>(lds, g, So, E, cx.wave); }
#endif
            pg8::EpiResidLN<true> E{(float*)(w + WS_Y), (float*)(w + WS_Y), (const float*)(w + WS_ST1), P.in[8] + lq * D, P.in[9] + lq * D, (const bf16*)(w + WS_PP), (const bf16*)(w + WS_SG), ALPHA};
            pg8::gemm_phase<pg8::EpiResidLN<true>, pg8::StaticOrder, true, true>(lds, g, So, E, cx.wave);
#else
            pg8::EpiDown E{(const float*)(w + WS_XR), (float*)(w + WS_Y), (const bf16*)(w + WS_PP), (const bf16*)(w + WS_SG), ALPHA};
            pg8::gemm_phase<pg8::EpiDown, pg8::StaticOrder, true, true>(lds, g, So, E, cx.wave);
#endif
#else
            pg8::EpiResid<true> E{(const float*)(w + WS_XR), (float*)(w + WS_Y), ALPHA};
            pg8::gemm_phase<pg8::EpiResid<true>, pg8::StaticOrder, true, true>(lds, g, So, E, cx.wave);
#endif
        } }
#if LN_FUSED
#if LAST_H
#if LN_LOCAL && XLOC
        if (l == DEPTH - 1) { SEAM_L(pb + 9); { OPQ(); unsigned char* w = cx.ws; phase_ln_h(cx, (const _Float16*)(w + WS_YH), P.in[14] + lq * D, P.in[15] + lq * D, P.out, IN(pb + 9) && __builtin_amdgcn_readfirstlane((int)MISC[40]) != 0); } }
#else
        if (l == DEPTH - 1) { SEAM(pb + 9); { OPQ(); unsigned char* w = cx.ws; phase_ln_h(cx, (const _Float16*)(w + WS_YH), P.in[14] + lq * D, P.in[15] + lq * D, P.out, false); } }
#endif
#else
        if (l == DEPTH - 1) { SEAM(pb + 9); { OPQ(); unsigned char* w = cx.ws; phase_ln(cx, (const float*)(w + WS_Y), P.in[14] + lq * D, P.in[15] + lq * D, P.out, (bf16*)nullptr, (float*)nullptr); } }
#endif
        else SEAM_P(pb + 9, 2);
#else
        SEAM(pb + 9);
        if (IN(pb + 10)) { REPS(1) { OPQ(); unsigned char* w = cx.ws; const bool last = (lq == DEPTH - 1);

#if LN_NOXR
            phase_ln(cx, (const float*)(w + WS_Y), P.in[14] + lq * D, P.in[15] + lq * D, last ? P.out : (float*)nullptr, last ? (bf16*)nullptr : (bf16*)(w + WS_XB), last ? (float*)nullptr : (float*)(w + WS_ST2));
#else
            phase_ln(cx, (const float*)(w + WS_Y), P.in[14] + lq * D, P.in[15] + lq * D, last ? P.out : (float*)(w + WS_XR), last ? (bf16*)nullptr : (bf16*)(w + WS_XB), (float*)nullptr);
#endif
        } }
        SEAM(pb + 10);
#endif
    }
#if PROBE_DUP == 60
    __syncthreads(); asm volatile("s_waitcnt vmcnt(0)" ::: "memory");
    if (blockIdx.x == PROBE_BLOCK && wave == 0 && lane_id_asm() == 0) { const unsigned long long c1_ = __builtin_amdgcn_s_memtime(), r1_ = __builtin_amdgcn_s_memrealtime();
        const unsigned long long c0_ = ((unsigned long long)MISC[35] << 32) | MISC[34], r0_ = ((unsigned long long)MISC[37] << 32) | MISC[36];
        P.out[5000u + 7u * PROBE_BLOCK] += (float)((double)(c1_ - c0_) / (double)(r1_ - r0_)); }
#endif
#if PROBE_DUP == 40
    __syncthreads(); asm volatile("s_waitcnt vmcnt(0)" ::: "memory");
    if (blockIdx.x == PROBE_BLOCK && wave == 0 && lane_id_asm() == 0) { const unsigned cell = 5000u + 7u * PROBE_BLOCK; P.out[cell] += (float)MISC[32] * 1e-4f; }
#endif
#undef IN
#undef SEAM
}

extern "C" void kernel_launch(void* const* d_in, const int* in_sizes, int n_in, void* d_out, int out_size, void* d_ws, size_t ws_size, hipStream_t stream) {
    static int grid = 0;
    if (grid == 0) {
        if (n_in != 19 || in_sizes[0] != S * D || out_size != S * D || ws_size < WS_END) { fprintf(stderr, "kernel_launch: unexpected shapes (n_in %d, in0 %d, out %d, ws %zu)\n", n_in, n_in > 0 ? in_sizes[0] : -1, out_size, ws_size); grid = -1; return; }
        int dev = 0, cus = 0, per_cu = 0;
        if (hipGetDevice(&dev) != hipSuccess || hipDeviceGetAttribute(&cus, hipDeviceAttributeMultiprocessorCount, dev) != hipSuccess) { grid = -1; return; }
        if (hipFuncSetAttribute((const void*)fwd, hipFuncAttributeMaxDynamicSharedMemorySize, LDS_BYTES) != hipSuccess) { fprintf(stderr, "kernel_launch: hipFuncSetAttribute failed\n"); grid = -1; return; }
        if (hipOccupancyMaxActiveBlocksPerMultiprocessor(&per_cu, (const void*)fwd, 512, LDS_BYTES) != hipSuccess || per_cu < 1) fprintf(stderr, "kernel_launch: occupancy query says %d\n", per_cu);
        (void)hipGetLastError();
        grid = cus;
    }
    if (grid < 0) return;
    (void)hipMemsetAsync((char*)d_ws + WS_CTL, 0, CTL_ZERO_BYTES, stream);
#ifdef DBG_NANFILL
    (void)hipMemsetAsync((char*)d_ws + CTL_ZERO_BYTES, 0xFF, WS_END - CTL_ZERO_BYTES, stream);
#endif
    Params p{};
    for (int i = 0; i < 19; ++i) p.in[i] = (const float*)d_in[i];
    p.out = (float*)d_out; p.ws = (unsigned char*)d_ws;
    for (int f = 0; f < 128; ++f) p.invf_ret[f] = (float)(1.0 / std::pow(10000.0, (double)((float)f / 127.0f)));
    for (int f = 0; f < 32; ++f) p.invf_att[f] = (float)std::pow(10000.0, -(double)(2 * f) / 64.0);
    for (int h = 0; h < 4; ++h) p.lg2g[h] = (float)std::log2(1.0 - std::exp2(-5.0 - h));
#if MK_ONE_LAUNCH
    p.ph_lo = 0; p.ph_hi = NPHASES;
    hipLaunchKernelGGL(fwd, dim3(grid), dim3(512), LDS_BYTES, stream, p);
#else
#ifdef DBG_DUMP
    for (int ph = 0; ph <= DBG_STOP; ++ph) { p.ph_lo = ph; p.ph_hi = ph + 1; hipLaunchKernelGGL(fwd, dim3(grid), dim3(512), LDS_BYTES, stream, p); }
    p.ph_lo = 1000 + DBG_DUMP; p.ph_hi = p.ph_lo + 1; hipLaunchKernelGGL(fwd, dim3(grid), dim3(512), LDS_BYTES, stream, p);
#else
    for (int ph = 0; ph < NPHASES; ++ph) { p.ph_lo = ph; p.ph_hi = ph + 1; hipLaunchKernelGGL(fwd, dim3(grid), dim3(512), LDS_BYTES, stream, p); }
#endif
#endif
}
```
